# Optimizing an MI355X kernel written in HIP

```python
import math
import jax, jax.numpy as jnp
from jax import lax
import numpy as np

D_MODEL = 1024
BATCH = 2
SEQ = 8192
DEPTH = 2

RW_HEAD = 64
RW_WIDTH = D_MODEL // 2
RW_HEADS = RW_WIDTH // RW_HEAD
RW_DECAY_LORA = 64
RW_AAA_LORA = 64
RW_GATE_LORA = 128
RW_GN_EPS = 64e-5
RW_IN = 3 * RW_WIDTH + RW_DECAY_LORA + RW_AAA_LORA + RW_GATE_LORA
GLA_HEADS = 4
GLA_DK = 64
GLA_DV = 128
GLA_GATE_LORA = 16
GLA_GATE_TAU = 16.0
GLA_IN = 2 * GLA_HEADS * GLA_DK + 2 * GLA_HEADS * GLA_DV + GLA_GATE_LORA
S5_GROUP = 16
S5_WIDTH = D_MODEL // 2
S5_GROUPS = S5_WIDTH // S5_GROUP
S5_STATE = 64
HG_DK = 128
HG_WIDTH = D_MODEL // 2
HG_HEADS = HG_WIDTH // HG_DK
HG_DV = HG_WIDTH // HG_HEADS
CD_IN = S5_WIDTH + 4 * HG_WIDTH
CHUNK = 64
NORM_EPS = 1e-5
MOE_GROUPS = 4
MOE_PER_GROUP = 8
N_EXPERTS = MOE_GROUPS * MOE_PER_GROUP
EXPERT_HIDDEN = 512
TOP_K = 2
MOE_BLOCK = 128
DN_ALPHA = (2.0 * DEPTH) ** 0.25
DN_BETA = (8.0 * DEPTH) ** -0.25
N_EVEN = (DEPTH + 1) // 2
N_ODD = DEPTH // 2

kernel_name = "hybrid_rwkv7_gla_s5_hgrn2_hmoe_deepnorm"

F32 = jnp.float32


def _split(t, sizes):
    return jnp.split(t, np.cumsum(sizes)[:-1].tolist(), axis=-1)


def _heads(t, n):
    return t.reshape(t.shape[:-1] + (n, t.shape[-1] // n))


def _layer_norm(x, g, b):
    xf = x.astype(F32)
    mu = jnp.mean(xf, -1, keepdims=True)
    var = jnp.mean(jnp.square(xf - mu), -1, keepdims=True)
    return ((xf - mu) * lax.rsqrt(var + NORM_EPS) * g + b).astype(x.dtype)


def _gated_head_rmsnorm(o, gate, g):
    of = o.astype(F32)
    of = of * lax.rsqrt(jnp.mean(of * of, -1, keepdims=True) + NORM_EPS) * g
    out = of * jax.nn.silu(gate.astype(F32))
    return out.reshape(out.shape[:-2] + (-1,))


def _chunked_gated_linear_attention(q, k, v, log_g):
    B_, L, H, K = q.shape
    V = v.shape[-1]
    n = L // CHUNK

    def to_chunks(t):
        t = t.astype(F32).reshape(B_, n, CHUNK, H, t.shape[-1])
        return jnp.transpose(t, (1, 0, 3, 2, 4))

    qc, kc, vc, gc = (to_chunks(t) for t in (q, k, v, log_g))
    causal = jnp.tril(jnp.ones((CHUNK, CHUNK), bool))[:, :, None]

    def step(S, inp):
        q_c, k_c, v_c, g_c = inp
        b = jnp.cumsum(g_c, axis=2)
        b_last = b[:, :, -1]
        o_inter = jnp.einsum('bhck,bhkv->bhcv', q_c * jnp.exp(b), S)
        diff = b[:, :, :, None, :] - b[:, :, None, :, :]
        decay = jnp.exp(jnp.where(causal, diff, -jnp.inf))
        scores = jnp.einsum('bhik,bhjk,bhijk->bhij', q_c, k_c, decay)
        o = o_inter + jnp.einsum('bhij,bhjv->bhiv', scores, v_c)
        k_dec = k_c * jnp.exp(b_last[:, :, None, :] - b)
        S = jnp.exp(b_last)[..., None] * S + jnp.einsum('bhjk,bhjv->bhkv', k_dec, v_c)
        return S, o

    S0 = jnp.zeros((B_, H, K, V), F32)
    _, o = lax.scan(step, S0, (qc, kc, vc, gc))
    return jnp.transpose(o, (1, 0, 3, 2, 4)).reshape(B_, L, H, V).astype(v.dtype)


def _rwkv7_time_mix(p, mu, w0, w2, a0, a2, g2, k_k, k_a, r_k, gn_g, gn_b):
    B_, L, _ = p.shape
    prev = jnp.pad(p, ((0, 0), (1, 0), (0, 0)))[:, :-1]
    p = p + mu * (prev - p)
    r, wl, k, v, al, gl = _split(p, [RW_WIDTH, RW_DECAY_LORA, RW_WIDTH, RW_WIDTH, RW_AAA_LORA, RW_GATE_LORA])
    w = -jax.nn.softplus(-(w0 + jnp.tanh(wl) @ w2)) - 0.5
    a = jax.nn.sigmoid(a0 + al @ a2)
    g = jax.nn.sigmoid(gl) @ g2
    kk = _heads((k * k_k).astype(F32), RW_HEADS)
    kk = kk / jnp.maximum(jnp.sqrt(jnp.sum(kk * kk, -1, keepdims=True)), 1e-12)
    k = k * (1.0 + (a - 1.0) * k_a)
    rh, kh, vh, ah = (_heads(t.astype(F32), RW_HEADS) for t in (r, k, v, a))
    decay = jnp.exp(-jnp.exp(_heads(w.astype(F32), RW_HEADS)))
    xs = tuple(jnp.moveaxis(t, 1, 0) for t in (rh, decay, kh, vh, -kk, kk * ah))

    def step(S, inp):
        r_t, w_t, k_t, v_t, a_t, b_t = inp
        sa = jnp.einsum('bhvk,bhk->bhv', S, a_t)
        S = S * w_t[:, :, None, :] + sa[..., None] * b_t[:, :, None, :] + v_t[..., None] * k_t[:, :, None, :]
        return S, jnp.einsum('bhvk,bhk->bhv', S, r_t)

    S0 = jnp.zeros((B_, RW_HEADS, RW_HEAD, RW_HEAD), F32)
    _, y = lax.scan(step, S0, xs)
    y = jnp.moveaxis(y, 0, 1)
    mean = jnp.mean(y, -1, keepdims=True)
    var = jnp.mean(jnp.square(y - mean), -1, keepdims=True)
    y = ((y - mean) * lax.rsqrt(var + RW_GN_EPS)).reshape(B_, L, RW_WIDTH) * gn_g + gn_b
    bonus = (jnp.sum(rh * kh * r_k, -1, keepdims=True) * vh).reshape(B_, L, RW_WIDTH)
    return ((y + bonus) * g).astype(p.dtype)


def _gla(q, k, v, gk_low, gate, gk_w2, gk_b, norm_g):
    log_a = jax.nn.log_sigmoid((gk_low @ gk_w2 + gk_b).astype(F32)) / GLA_GATE_TAU
    o = _chunked_gated_linear_attention(
        _heads(q, GLA_HEADS) * (GLA_DK ** -0.5), _heads(k, GLA_HEADS),
        _heads(v, GLA_HEADS), _heads(log_a, GLA_HEADS))
    return _gated_head_rmsnorm(o, _heads(gate, GLA_HEADS), norm_g).astype(q.dtype)


def _hgrn2(q, f, i, gate, lb, norm_g):
    ff = f.astype(F32)
    forget = lb + (1.0 - lb) * jax.nn.sigmoid(ff)
    inp_gate = (1.0 - lb) * jax.nn.sigmoid(-ff)
    o = _chunked_gated_linear_attention(
        _heads(jax.nn.silu(q), HG_HEADS), _heads(inp_gate, HG_HEADS),
        _heads(i, HG_HEADS), _heads(jnp.log(forget), HG_HEADS))
    return _gated_head_rmsnorm(o, _heads(gate, HG_HEADS), norm_g).astype(q.dtype)


def _s5(u, a_re, a_im, log_dt, b_re, b_im, c_re, c_im, d, glu_w, glu_b):
    B_, L, _ = u.shape
    uf = u.astype(F32)
    ug = uf.reshape(B_, L, S5_GROUPS, S5_GROUP)
    lam_re = jnp.minimum(a_re.astype(F32), -1e-4)
    lam_im = a_im.astype(F32)
    dt = jnp.exp(log_dt.astype(F32))[:, None]
    mag = jnp.exp(lam_re * dt)
    abar_re = mag * jnp.cos(lam_im * dt)
    abar_im = mag * jnp.sin(lam_im * dt)
    den = lam_re * lam_re + lam_im * lam_im
    num_re = abar_re - 1.0
    z_re = (num_re * lam_re + abar_im * lam_im) / den
    z_im = (abar_im * lam_re - num_re * lam_im) / den
    bu_re = jnp.einsum('blgc,gnc->blgn', ug, b_re.astype(F32))
    bu_im = jnp.einsum('blgc,gnc->blgn', ug, b_im.astype(F32))
    x_re = z_re * bu_re - z_im * bu_im
    x_im = z_re * bu_im + z_im * bu_re
    at_re = jnp.broadcast_to(abar_re, x_re.shape)
    at_im = jnp.broadcast_to(abar_im, x_im.shape)

    def combine(e1, e2):
        a1r, a1i, b1r, b1i = e1
        a2r, a2i, b2r, b2i = e2
        return (a2r * a1r - a2i * a1i, a2r * a1i + a2i * a1r,
                a2r * b1r - a2i * b1i + b2r, a2r * b1i + a2i * b1r + b2i)

    _, _, h_re, h_im = lax.associative_scan(combine, (at_re, at_im, x_re, x_im), axis=1)
    y = (jnp.einsum('blgn,gcn->blgc', h_re, c_re.astype(F32))
         - jnp.einsum('blgn,gcn->blgc', h_im, c_im.astype(F32)))
    y = y.reshape(B_, L, S5_WIDTH) + d * uf
    y = jax.nn.gelu(y)
    y = y * jax.nn.sigmoid(y @ glu_w.astype(F32) + glu_b)
    return y.astype(u.dtype)


def _mixer_rwkv7_gla(h, w_in, rw_mu, rw_w0, rw_w2, rw_a0, rw_a2, rw_g2, rw_k_k, rw_k_a,
                     rw_r_k, rw_gn_g, rw_gn_b, gla_gk_w2, gla_gk_b, gla_norm_g, w_out):
    p = h @ w_in
    p_rw, q, k, v, gk_low, gate = _split(
        p, [RW_IN, GLA_HEADS * GLA_DK, GLA_HEADS * GLA_DK, GLA_HEADS * GLA_DV, GLA_GATE_LORA, GLA_HEADS * GLA_DV])
    y_rw = _rwkv7_time_mix(p_rw, rw_mu, rw_w0, rw_w2, rw_a0, rw_a2, rw_g2, rw_k_k, rw_k_a, rw_r_k, rw_gn_g, rw_gn_b)
    y_gla = _gla(q, k, v, gk_low, gate, gla_gk_w2, gla_gk_b, gla_norm_g)
    return jnp.concatenate([y_rw, y_gla], -1).astype(h.dtype) @ w_out


def _mixer_s5_hgrn2(h, w_in, s5_a_re, s5_a_im, s5_log_dt, s5_b_re, s5_b_im, s5_c_re, s5_c_im,
                    s5_d, s5_glu_w, s5_glu_b, lb, hg_norm_g, w_out):
    p = h @ w_in
    u, q, f, i, gate = _split(p, [S5_WIDTH, HG_WIDTH, HG_WIDTH, HG_WIDTH, HG_WIDTH])
    y_s5 = _s5(u, s5_a_re, s5_a_im, s5_log_dt, s5_b_re, s5_b_im, s5_c_re, s5_c_im, s5_d, s5_glu_w, s5_glu_b)
    y_hg = _hgrn2(q, f, i, gate, lb, hg_norm_g)
    return jnp.concatenate([y_s5, y_hg], -1).astype(h.dtype) @ w_out


def _expert_dispatch(xt, expert, gate, w1, w3, w2):
    T, D = xt.shape
    A = T * TOP_K
    e_flat = expert.reshape(A)
    tok_flat = jnp.repeat(jnp.arange(T, dtype=jnp.int32), TOP_K)
    g_flat = gate.reshape(A)
    order = jnp.argsort(e_flat)
    e_s, tok_s, g_s = e_flat[order], tok_flat[order], g_flat[order]
    counts = jnp.bincount(e_flat, length=N_EXPERTS)
    padded = (counts + MOE_BLOCK - 1) // MOE_BLOCK * MOE_BLOCK
    start = jnp.cumsum(counts) - counts
    pend = jnp.cumsum(padded)
    pstart = pend - padded
    dest = pstart[e_s] + (jnp.arange(A, dtype=jnp.int32) - start[e_s])
    n_blocks = -(-A // MOE_BLOCK) + N_EXPERTS
    R = n_blocks * MOE_BLOCK
    row_tok = jnp.full((R,), T, jnp.int32).at[dest].set(tok_s)
    x_pad = jnp.concatenate([xt, jnp.zeros((1, D), xt.dtype)], 0)
    x_rows = x_pad[row_tok].reshape(n_blocks, MOE_BLOCK, D)
    block_e = jnp.minimum(jnp.searchsorted(pend, jnp.arange(n_blocks) * MOE_BLOCK, side='right'), N_EXPERTS - 1)

    def run_block(args):
        xb, e = args
        hid = jax.nn.silu(xb @ w1[e]) * (xb @ w3[e])
        return hid @ w2[e]

    y_rows = lax.map(run_block, (x_rows, block_e)).reshape(R, D)
    y = jnp.zeros((T, D), F32).at[tok_s].add(g_s[:, None] * y_rows[dest].astype(F32))
    return y.astype(xt.dtype)


def _hierarchical_moe(x, wg, bg, we, be, w1, w3, w2):
    B_, L, D = x.shape
    T = B_ * L
    xt = x.reshape(T, D)
    xf = xt.astype(F32)
    coarse = jax.nn.softmax(xf @ wg.astype(F32) + bg, axis=-1)
    p_grp, grp = lax.top_k(coarse, 1)
    grp = grp[:, 0]
    fine_all = jnp.einsum('td,gde->tge', xf, we.astype(F32)) + be
    fine = jax.nn.softmax(fine_all[jnp.arange(T), grp], axis=-1)
    top_p, top_j = lax.top_k(fine, TOP_K)
    gate = p_grp * (top_p / jnp.sum(top_p, -1, keepdims=True))
    expert = grp[:, None] * MOE_PER_GROUP + top_j
    return _expert_dispatch(xt, expert, gate, w1, w3, w2).reshape(B_, L, D)


def setup_inputs(seed: int = 0) -> dict:
    key = jax.random.key(seed)
    keys = jax.random.split(key, 48)
    ks = iter([keys[n] for n in range(48)])

    def nrm(shape, scale):
        return jax.random.normal(next(ks), shape, F32) * scale

    E, O = N_EVEN, N_ODD
    ratio = jnp.arange(RW_WIDTH, dtype=F32) / (RW_WIDTH - 1)
    w0_base = -6.5 + 5.0 * ratio ** 0.85
    n_idx = jnp.arange(S5_STATE, dtype=F32)
    return {
        "x": nrm((BATCH, SEQ, D_MODEL), 1.0),
        "ab_w_in": nrm((E, D_MODEL, RW_IN + GLA_IN), D_MODEL ** -0.5),
        "rw_mu": jax.random.uniform(next(ks), (E, RW_IN), F32),
        "rw_w0": w0_base + nrm((E, RW_WIDTH), 0.1),
        "rw_w2": nrm((E, RW_DECAY_LORA, RW_WIDTH), 0.5 * RW_DECAY_LORA ** -0.5),
        "rw_a0": nrm((E, RW_WIDTH), 0.1),
        "rw_a2": nrm((E, RW_AAA_LORA, RW_WIDTH), RW_AAA_LORA ** -0.5),
        "rw_g2": nrm((E, RW_GATE_LORA, RW_WIDTH), RW_GATE_LORA ** -0.5),
        "rw_k_k": 0.85 + nrm((E, RW_WIDTH), 0.02),
        "rw_k_a": 1.0 + nrm((E, RW_WIDTH), 0.02),
        "rw_r_k": -0.04 + nrm((E, RW_HEADS, RW_HEAD), 0.1),
        "rw_gn_g": 1.0 + nrm((E, RW_WIDTH), 0.02),
        "rw_gn_b": nrm((E, RW_WIDTH), 0.02),
        "gla_gk_w2": nrm((E, GLA_GATE_LORA, GLA_HEADS * GLA_DK), GLA_GATE_LORA ** -0.5),
        "gla_gk_b": nrm((E, GLA_HEADS * GLA_DK), 0.02),
        "gla_norm_g": 1.0 + nrm((E, GLA_DV), 0.02),
        "ab_w_out": nrm((E, D_MODEL, D_MODEL), DN_BETA * D_MODEL ** -0.5),
        "cd_w_in": nrm((O, D_MODEL, CD_IN), D_MODEL ** -0.5),
        "s5_a_re": -0.5 + nrm((O, S5_GROUPS, S5_STATE), 0.01),
        "s5_a_im": math.pi * n_idx + nrm((O, S5_GROUPS, S5_STATE), 0.01),
        "s5_log_dt": jax.random.uniform(next(ks), (O, S5_GROUPS), F32, math.log(1e-3), math.log(1e-1)),
        "s5_b_re": nrm((O, S5_GROUPS, S5_STATE, S5_GROUP), (2 * S5_GROUP) ** -0.5),
        "s5_b_im": nrm((O, S5_GROUPS, S5_STATE, S5_GROUP), (2 * S5_GROUP) ** -0.5),
        "s5_c_re": nrm((O, S5_GROUPS, S5_GROUP, S5_STATE), S5_STATE ** -0.5),
        "s5_c_im": nrm((O, S5_GROUPS, S5_GROUP, S5_STATE), S5_STATE ** -0.5),
        "s5_d": nrm((O, S5_WIDTH), 1.0),
        "s5_glu_w": nrm((O, S5_WIDTH, S5_WIDTH), S5_WIDTH ** -0.5),
        "s5_glu_b": nrm((O, S5_WIDTH), 0.02),
        "hg_lb": 1.0 + nrm((DEPTH, HG_WIDTH), 0.1),
        "hg_norm_g": 1.0 + nrm((O, HG_DV), 0.02),
        "cd_w_out": nrm((O, D_MODEL, D_MODEL), DN_BETA * D_MODEL ** -0.5),
        "ln1_g": 1.0 + nrm((DEPTH, D_MODEL), 0.02),
        "ln1_b": nrm((DEPTH, D_MODEL), 0.02),
        "moe_wg": nrm((DEPTH, D_MODEL, MOE_GROUPS), D_MODEL ** -0.5),
        "moe_bg": nrm((DEPTH, MOE_GROUPS), 0.01),
        "moe_we": nrm((DEPTH, MOE_GROUPS, D_MODEL, MOE_PER_GROUP), D_MODEL ** -0.5),
        "moe_be": nrm((DEPTH, MOE_GROUPS, MOE_PER_GROUP), 0.01),
        "moe_w1": nrm((DEPTH, N_EXPERTS, D_MODEL, EXPERT_HIDDEN), D_MODEL ** -0.5),
        "moe_w3": nrm((DEPTH, N_EXPERTS, D_MODEL, EXPERT_HIDDEN), D_MODEL ** -0.5),
        "moe_w2": nrm((DEPTH, N_EXPERTS, EXPERT_HIDDEN, D_MODEL), DN_BETA * EXPERT_HIDDEN ** -0.5),
        "ln2_g": 1.0 + nrm((DEPTH, D_MODEL), 0.02),
        "ln2_b": nrm((DEPTH, D_MODEL), 0.02),
    }


def reference(x, ab_w_in, rw_mu, rw_w0, rw_w2, rw_a0, rw_a2, rw_g2, rw_k_k, rw_k_a, rw_r_k,
              rw_gn_g, rw_gn_b, gla_gk_w2, gla_gk_b, gla_norm_g, ab_w_out,
              cd_w_in, s5_a_re, s5_a_im, s5_log_dt, s5_b_re, s5_b_im, s5_c_re, s5_c_im,
              s5_d, s5_glu_w, s5_glu_b, hg_lb, hg_norm_g, cd_w_out,
              ln1_g, ln1_b, moe_wg, moe_bg, moe_we, moe_be, moe_w1, moe_w3, moe_w2, ln2_g, ln2_b):
    h = x
    lb_sm = jax.nn.softmax(hg_lb.astype(F32), axis=0)
    lower_bounds = jnp.cumsum(lb_sm, axis=0) - lb_sm[0]
    for layer in range(DEPTH):
        j = layer // 2
        if layer % 2 == 0:
            mix = _mixer_rwkv7_gla(h, ab_w_in[j], rw_mu[j], rw_w0[j], rw_w2[j], rw_a0[j], rw_a2[j], rw_g2[j],
                                   rw_k_k[j], rw_k_a[j], rw_r_k[j], rw_gn_g[j], rw_gn_b[j],
                                   gla_gk_w2[j], gla_gk_b[j], gla_norm_g[j], ab_w_out[j])
        else:
            mix = _mixer_s5_hgrn2(h, cd_w_in[j], s5_a_re[j], s5_a_im[j], s5_log_dt[j], s5_b_re[j], s5_b_im[j],
                                  s5_c_re[j], s5_c_im[j], s5_d[j], s5_glu_w[j], s5_glu_b[j],
                                  lower_bounds[layer], hg_norm_g[j], cd_w_out[j])
        h = _layer_norm(DN_ALPHA * h + mix, ln1_g[layer], ln1_b[layer])
        ffn = _hierarchical_moe(h, moe_wg[layer], moe_bg[layer], moe_we[layer], moe_be[layer],
                                moe_w1[layer], moe_w3[layer], moe_w2[layer])
        h = _layer_norm(DN_ALPHA * h + ffn, ln2_g[layer], ln2_b[layer])
    return h
```

```cpp
#include <hip/hip_runtime.h>
#include <cstdio>
#include <cstdint>

#define GAS __attribute__((address_space(1)))
#define LAS __attribute__((address_space(3)))
typedef unsigned short bf16_t;
typedef float f32x4 __attribute__((ext_vector_type(4)));
typedef unsigned u32x4 __attribute__((ext_vector_type(4)));
typedef unsigned u32x2 __attribute__((ext_vector_type(2)));

#ifndef MK_SINGLE
#define MK_SINGLE 0
#endif

constexpr int T_ = 16384, L_ = 8192, D_ = 1024;
constexpr int NIN0 = 3344, NIN0P = 3584, NIN1 = 2560;
constexpr int NLORA = 1536;
constexpr int RMAX = 40960;
constexpr int MOE_PAD = 256;
constexpr float DN_ALPHA = 1.41421356237f;
constexpr float LN_EPS = 1e-5f;
constexpr int NTHREADS = 512, NWAVES = 8;

constexpr size_t MiB = 1u << 20;
constexpr size_t WS_CTL = 0, CTL_ZERO_BYTES = 1 * MiB;
constexpr size_t WS_HB = 116 * MiB;
constexpr size_t WS_HA = 149 * MiB;
constexpr size_t WS_ROUTE = 213 * MiB;
constexpr size_t WS_BIG = 214 * MiB;
constexpr size_t WS_P = WS_BIG;
constexpr size_t WS_LO = WS_BIG + 112 * MiB;
constexpr size_t WS_SCAN = WS_BIG + 160 * MiB;
constexpr size_t WS_GLALA = WS_BIG + 256 * MiB;
constexpr size_t WS_BON = WS_BIG + 272 * MiB;
constexpr size_t WS_APRIME = WS_BIG + 273 * MiB;
constexpr size_t WS_YS5B = WS_BIG + 80 * MiB;
constexpr size_t WS_XR = WS_BIG;
constexpr size_t WS_HID = WS_BIG + 80 * MiB;
constexpr size_t WS_Y = WS_BIG + 120 * MiB;
constexpr size_t WS_END = 512 * MiB;
constexpr int CW_BAR = 4096;
constexpr int CW_CNT = 8192;

__device__ __forceinline__ float bf2f(bf16_t b) { return __uint_as_float(((unsigned)b) << 16); }
__device__ __forceinline__ bf16_t f2bf(float f) { unsigned u = __float_as_uint(f); u += 0x7fffu + ((u >> 16) & 1u); return (bf16_t)(u >> 16); }
__device__ __forceinline__ unsigned pk2(float lo, float hi) { return (unsigned)f2bf(lo) | ((unsigned)f2bf(hi) << 16); }
__device__ __forceinline__ float sigm(float x) { return 1.f / (1.f + __expf(-x)); }
__device__ __forceinline__ float siluf(float x) { return x * sigm(x); }
__device__ __forceinline__ float softplusf(float x) { return fmaxf(x, 0.f) + log1pf(__expf(-fabsf(x))); }
__device__ __forceinline__ float gelu_tanh(float x) { const float u = 0.7978845608028654f * (x + 0.044715f * x * x * x); return 0.5f * x * (1.f + tanhf(u)); }
__device__ __forceinline__ float wave_sum(float v) {
#pragma unroll
    for (int o = 1; o < 64; o <<= 1) v += __shfl_xor(v, o);
    return v;
}

struct Args {
    const float* in[42];
    float* out;
    unsigned char* ws;
    int ph_lo, ph_hi;
};

template <bool DUAL, class AF, class WF, class EF>
__device__ __forceinline__ void naive_gemm(LAS float* lds, int M, int N, int K, AF arow, WF wbase, int ldw, EF epi) {
    LAS float* As = lds;
    LAS float* Bs = lds + 64 * 33;
    LAS float* Bs2 = Bs + 32 * 64;
    const int tid = threadIdx.x, ty = tid >> 4, tx = tid & 15;
    const int tm = (M + 63) / 64, tn = (N + 63) / 64;
    for (int tile = blockIdx.x; tile < tm * tn; tile += gridDim.x) {
        const int m0 = (tile / tn) * 64, n0 = (tile % tn) * 64;
        const float* W = wbase(m0, 0);
        const float* W2 = DUAL ? wbase(m0, 1) : W;
        float acc[2][4], acc2[2][4];
#pragma unroll
        for (int i = 0; i < 2; ++i)
#pragma unroll
            for (int j = 0; j < 4; ++j) { acc[i][j] = 0.f; acc2[i][j] = 0.f; }
        for (int k0 = 0; k0 < K; k0 += 32) {
#pragma unroll
            for (int i = 0; i < 4; ++i) {
                const int idx = tid + i * 512, r = idx >> 5, kk = idx & 31, m = m0 + r;
                As[r * 33 + kk] = (m < M) ? bf2f(arow(m)[k0 + kk]) : 0.f;
            }
#pragma unroll
            for (int i = 0; i < 4; ++i) {
                const int idx = tid + i * 512, kk = idx >> 6, n = idx & 63;
                const bool ok = (n0 + n) < N;
                Bs[kk * 64 + n] = ok ? W[(size_t)(k0 + kk) * ldw + n0 + n] : 0.f;
                if (DUAL) Bs2[kk * 64 + n] = ok ? W2[(size_t)(k0 + kk) * ldw + n0 + n] : 0.f;
            }
            __syncthreads();
#pragma unroll 8
            for (int kk = 0; kk < 32; ++kk) {
                const float a0 = As[(ty * 2) * 33 + kk], a1 = As[(ty * 2 + 1) * 33 + kk];
#pragma unroll
                for (int j = 0; j < 4; ++j) {
                    const float b = Bs[kk * 64 + tx * 4 + j];
                    acc[0][j] += a0 * b; acc[1][j] += a1 * b;
                    if (DUAL) { const float b2 = Bs2[kk * 64 + tx * 4 + j]; acc2[0][j] += a0 * b2; acc2[1][j] += a1 * b2; }
                }
            }
            __syncthreads();
        }
#pragma unroll
        for (int i = 0; i < 2; ++i)
#pragma unroll
            for (int j = 0; j < 4; ++j) {
                const int m = m0 + ty * 2 + i, n = n0 + tx * 4 + j;
                if (m < M && n < N) epi(m, n, acc[i][j], acc2[i][j]);
            }
    }
}

__device__ __forceinline__ void ph_prologue(const float* x, bf16_t* hb) {
    const size_t n4 = (size_t)T_ * D_ / 4;
    for (size_t i = (size_t)blockIdx.x * NTHREADS + threadIdx.x; i < n4; i += (size_t)gridDim.x * NTHREADS) {
        const f32x4 v = ((const f32x4*)x)[i];
        u32x2 o; o.x = pk2(v.x, v.y); o.y = pk2(v.z, v.w);
        ((u32x2*)hb)[i] = o;
    }
    for (size_t i = (size_t)blockIdx.x * NTHREADS + threadIdx.x; i < (size_t)256 * D_ / 2; i += (size_t)gridDim.x * NTHREADS)
        ((unsigned*)(hb + (size_t)T_ * D_))[i] = 0u;
}

__device__ __forceinline__ float p0_shift(const bf16_t* P, const float* mu, int t, int c) {
    const float p = bf2f(P[(size_t)t * NIN0P + c]);
    const float pv = ((t & (L_ - 1)) == 0) ? 0.f : bf2f(P[(size_t)(t - 1) * NIN0P + c]);
    return p + mu[c] * (pv - p);
}
__device__ __forceinline__ void ph_prepA0(const bf16_t* P, const float* mu, const float* gk_w2, const float* gk_b, bf16_t* Ap, float* gla_la) {
    for (int chunk = blockIdx.x; chunk < T_ / 64; chunk += gridDim.x) {
        for (int idx = threadIdx.x; idx < 64 * 256; idx += NTHREADS) {
            const int tl = idx >> 8, j = idx & 255, t = chunk * 64 + tl;
            float v;
            if (j < 64) v = tanhf(p0_shift(P, mu, t, 512 + j));
            else if (j < 128) v = p0_shift(P, mu, t, 1600 + (j - 64));
            else v = sigm(p0_shift(P, mu, t, 1664 + (j - 128)));
            Ap[(size_t)t * 256 + j] = f2bf(v);
            float gk = gk_b[j];
#pragma unroll
            for (int i = 0; i < 16; ++i) gk += bf2f(P[(size_t)t * NIN0P + 2816 + i]) * gk_w2[i * 256 + j];
            const float ls = fminf(gk, 0.f) - log1pf(__expf(-fabsf(gk)));
            gla_la[(size_t)t * 256 + j] = ls * (1.f / 16.f);
        }
    }
}

__device__ __forceinline__ void ph_prepB0(const bf16_t* P, const bf16_t* LO, const float* mu, const float* w0, const float* a0, const float* k_k, const float* k_a,
                                          const float* r_k, bf16_t* SC, float* BON) {
    const int wave = threadIdx.x >> 6, lane = threadIdx.x & 63;
    for (int item = blockIdx.x * NWAVES + wave; item < T_ * 8; item += gridDim.x * NWAVES) {
        const int t = item >> 3, h = item & 7, c = h * 64 + lane;
        const float r = p0_shift(P, mu, t, c), k = p0_shift(P, mu, t, 576 + c), v = p0_shift(P, mu, t, 1088 + c);
        const float low = bf2f(LO[(size_t)t * NLORA + c]), loa = bf2f(LO[(size_t)t * NLORA + 512 + c]);
        const float xw = w0[c] + low;
        const float wraw = -softplusf(-xw) - 0.5f;
        const float ld = -__expf(wraw);
        const float a = sigm(a0[c] + loa);
        const float kkr = k * k_k[c];
        const float ss = wave_sum(kkr * kkr);
        const float kk = kkr / fmaxf(sqrtf(ss), 1e-12f);
        const float kp = k * (1.f + (a - 1.f) * k_a[c]);
        const float bon = wave_sum(r * kp * r_k[c]);
        const size_t o = (size_t)t * 512 + c, S1 = (size_t)T_ * 512;
        SC[o] = f2bf(r); SC[S1 + o] = f2bf(ld); SC[2 * S1 + o] = f2bf(kp); SC[3 * S1 + o] = f2bf(v); SC[4 * S1 + o] = f2bf(kk); SC[5 * S1 + o] = f2bf(a);
        if (lane == 0) BON[(size_t)t * 8 + h] = bon;
    }
}

__device__ __forceinline__ void naive_rwkv_scan(LAS float* lds, const bf16_t* SC, float* YRW, int bh) {
    constexpr int TS = 32;
    const int b = bh >> 3, h = bh & 7;
    LAS float* Lnkk = lds;
    LAS float* Ldec = lds + TS * 64;
    LAS float* Lab = lds + 2 * TS * 64;
    LAS float* Lkp = lds + 3 * TS * 64;
    LAS float* Lr = lds + 4 * TS * 64;
    LAS float* Lv = lds + 5 * TS * 64;
    const size_t S1 = (size_t)T_ * 512;
    float S[64];
#pragma unroll
    for (int k = 0; k < 64; ++k) S[k] = 0.f;
    const int lane = threadIdx.x & 63, wave = threadIdx.x >> 6;
    for (int t0 = 0; t0 < L_; t0 += TS) {
        for (int idx = threadIdx.x; idx < TS * 64; idx += NTHREADS) {
            const int s = idx >> 6, k = idx & 63;
            const size_t o = (size_t)(b * L_ + t0 + s) * 512 + h * 64 + k;
            const float r = bf2f(SC[o]), ld = bf2f(SC[S1 + o]), kp = bf2f(SC[2 * S1 + o]), v = bf2f(SC[3 * S1 + o]), kk = bf2f(SC[4 * S1 + o]), a = bf2f(SC[5 * S1 + o]);
            Lnkk[idx] = -kk; Ldec[idx] = __expf(ld); Lab[idx] = kk * a; Lkp[idx] = kp; Lr[idx] = r; Lv[idx] = v;
        }
        __syncthreads();
        if (wave == 0) {
            for (int s = 0; s < TS; ++s) {
                float sa = 0.f;
#pragma unroll
                for (int k = 0; k < 64; ++k) sa += S[k] * Lnkk[s * 64 + k];
                const float vv = Lv[s * 64 + lane];
                float y = 0.f;
#pragma unroll
                for (int k = 0; k < 64; ++k) {
                    S[k] = S[k] * Ldec[s * 64 + k] + sa * Lab[s * 64 + k] + vv * Lkp[s * 64 + k];
                    y += S[k] * Lr[s * 64 + k];
                }
                YRW[(size_t)(b * L_ + t0 + s) * 512 + h * 64 + lane] = y;
            }
        }
        __syncthreads();
    }
}

template <int K, class LDF, class LVF>
__device__ __forceinline__ void naive_gla_scan(LAS float* lds, LDF ld, LVF lv, float* OG, int b, int h) {
    constexpr int TS = 16;
    LAS float* Lq = lds;
    LAS float* Lk = lds + TS * K;
    LAS float* Le = lds + 2 * TS * K;
    LAS float* Lv = lds + 3 * TS * K;
    float S[K];
#pragma unroll
    for (int k = 0; k < K; ++k) S[k] = 0.f;
    const int tid = threadIdx.x;
    for (int t0 = 0; t0 < L_; t0 += TS) {
        for (int idx = tid; idx < TS * K; idx += NTHREADS) {
            const int s = idx / K, k = idx % K;
            float q, kk, e; ld(b * L_ + t0 + s, h * K + k, q, kk, e);
            Lq[idx] = q; Lk[idx] = kk; Le[idx] = e;
        }
        for (int idx = tid; idx < TS * 128; idx += NTHREADS) {
            const int s = idx >> 7, vc = idx & 127;
            Lv[idx] = lv(b * L_ + t0 + s, h * 128 + vc);
        }
        __syncthreads();
        if (tid < 128) {
            for (int s = 0; s < TS; ++s) {
                const float vv = Lv[s * 128 + tid];
                float o = 0.f;
#pragma unroll
                for (int k = 0; k < K; ++k) {
                    S[k] = S[k] * Le[s * K + k] + Lk[s * K + k] * vv;
                    o += Lq[s * K + k] * S[k];
                }
                OG[(size_t)(b * L_ + t0 + s) * 512 + h * 128 + tid] = o;
            }
        }
        __syncthreads();
    }
}

__device__ __forceinline__ void ph_fin0(const float* YRW, const float* OG, const bf16_t* P, const bf16_t* LO, const bf16_t* SC, const float* BON,
                                        const float* gn_g, const float* gn_b, const float* norm_g, bf16_t* Ymix) {
    const int wave = threadIdx.x >> 6, lane = threadIdx.x & 63;
    const size_t S1 = (size_t)T_ * 512;
    for (int item = blockIdx.x * NWAVES + wave; item < T_ * 12; item += gridDim.x * NWAVES) {
        const int t = item / 12, u = item % 12;
        if (u < 8) {
            const int c = u * 64 + lane;
            const float y = YRW[(size_t)t * 512 + c];
            const float mean = wave_sum(y) * (1.f / 64.f);
            const float d = y - mean;
            const float var = wave_sum(d * d) * (1.f / 64.f);
            const float yn = d * rsqrtf(var + 64e-5f) * gn_g[c] + gn_b[c];
            const float v = bf2f(SC[3 * S1 + (size_t)t * 512 + c]);
            const float g = bf2f(LO[(size_t)t * NLORA + 1024 + c]);
            Ymix[(size_t)t * D_ + c] = f2bf((yn + BON[(size_t)t * 8 + u] * v) * g);
        } else {
            const int h = u - 8;
            const float o0 = OG[(size_t)t * 512 + h * 128 + lane], o1 = OG[(size_t)t * 512 + h * 128 + 64 + lane];
            const float ms = wave_sum(o0 * o0 + o1 * o1) * (1.f / 128.f);
            const float rs = rsqrtf(ms + LN_EPS);
            const float g0 = bf2f(P[(size_t)t * NIN0P + 2832 + h * 128 + lane]), g1 = bf2f(P[(size_t)t * NIN0P + 2832 + h * 128 + 64 + lane]);
            Ymix[(size_t)t * D_ + 512 + h * 128 + lane] = f2bf(o0 * rs * norm_g[lane] * siluf(g0));
            Ymix[(size_t)t * D_ + 512 + h * 128 + 64 + lane] = f2bf(o1 * rs * norm_g[64 + lane] * siluf(g1));
        }
    }
}

__device__ __forceinline__ void ph_ln_router(const float* src, float* hf, bf16_t* hb, const float* lg, const float* lb, const float* wg, const float* bg,
                                             const float* we, const float* be, int* tok_e, int* tok_slot, float* tok_g, unsigned* cnt) {
    const int wave = threadIdx.x >> 6, lane = threadIdx.x & 63;
    for (int t = blockIdx.x * NWAVES + wave; t < T_; t += gridDim.x * NWAVES) {
        const f32x4* xr = (const f32x4*)(src + (size_t)t * D_) + lane;
        f32x4 v[4]; float s = 0.f;
#pragma unroll
        for (int j = 0; j < 4; ++j) { v[j] = xr[64 * j]; s += (v[j].x + v[j].y) + (v[j].z + v[j].w); }
        const float mean = wave_sum(s) * (1.f / D_);
        float s2 = 0.f;
#pragma unroll
        for (int j = 0; j < 4; ++j) { v[j] = v[j] - mean; s2 += (v[j].x * v[j].x + v[j].y * v[j].y) + (v[j].z * v[j].z + v[j].w * v[j].w); }
        const float rstd = rsqrtf(wave_sum(s2) * (1.f / D_) + LN_EPS);
#pragma unroll
        for (int j = 0; j < 4; ++j) {
            const f32x4 g = ((const f32x4*)lg)[lane + 64 * j], bb = ((const f32x4*)lb)[lane + 64 * j];
            v[j] = v[j] * rstd * g + bb;
            ((f32x4*)(hf + (size_t)t * D_))[lane + 64 * j] = v[j];
            u32x2 o; o.x = pk2(v[j].x, v[j].y); o.y = pk2(v[j].z, v[j].w);
            ((u32x2*)(hb + (size_t)t * D_))[lane + 64 * j] = o;
        }
        float cl[4] = {0.f, 0.f, 0.f, 0.f};
#pragma unroll
        for (int j = 0; j < 4; ++j)
#pragma unroll
            for (int e = 0; e < 4; ++e) {
                const int d = 4 * (lane + 64 * j) + e;
                const f32x4 w = *(const f32x4*)(wg + (size_t)d * 4);
                const float xv = v[j][e];
                cl[0] += xv * w.x; cl[1] += xv * w.y; cl[2] += xv * w.z; cl[3] += xv * w.w;
            }
#pragma unroll
        for (int g = 0; g < 4; ++g) cl[g] = wave_sum(cl[g]) + bg[g];
        int grp = 0; float mx = cl[0];
#pragma unroll
        for (int g = 1; g < 4; ++g) if (cl[g] > mx) { mx = cl[g]; grp = g; }
        float den = 0.f;
#pragma unroll
        for (int g = 0; g < 4; ++g) den += __expf(cl[g] - mx);
        const float p_grp = 1.f / den;
        float fl[8];
#pragma unroll
        for (int e = 0; e < 8; ++e) fl[e] = 0.f;
        const float* weg = we + (size_t)grp * D_ * 8;
#pragma unroll
        for (int j = 0; j < 4; ++j)
#pragma unroll
            for (int e = 0; e < 4; ++e) {
                const int d = 4 * (lane + 64 * j) + e;
                const f32x4 w0 = *(const f32x4*)(weg + (size_t)d * 8), w1 = *(const f32x4*)(weg + (size_t)d * 8 + 4);
                const float xv = v[j][e];
                fl[0] += xv * w0.x; fl[1] += xv * w0.y; fl[2] += xv * w0.z; fl[3] += xv * w0.w;
                fl[4] += xv * w1.x; fl[5] += xv * w1.y; fl[6] += xv * w1.z; fl[7] += xv * w1.w;
            }
#pragma unroll
        for (int e = 0; e < 8; ++e) fl[e] = wave_sum(fl[e]) + be[grp * 8 + e];
        int j0 = 0; float m0 = fl[0];
#pragma unroll
        for (int e = 1; e < 8; ++e) if (fl[e] > m0) { m0 = fl[e]; j0 = e; }
        int j1 = -1; float m1 = -3.0e38f;
#pragma unroll
        for (int e = 0; e < 8; ++e) if (e != j0 && fl[e] > m1) { m1 = fl[e]; j1 = e; }
        const float e1 = __expf(m1 - m0);
        const float g0 = p_grp / (1.f + e1), g1 = p_grp * e1 / (1.f + e1);
        if (lane == 0) {
            const int ex0 = grp * 8 + j0, ex1 = grp * 8 + j1;
            const unsigned s0 = atomicAdd(&cnt[ex0], 1u), s1 = atomicAdd(&cnt[ex1], 1u);
            tok_e[2 * t] = ex0; tok_e[2 * t + 1] = ex1;
            tok_slot[2 * t] = (int)s0; tok_slot[2 * t + 1] = (int)s1;
            tok_g[2 * t] = g0; tok_g[2 * t + 1] = g1;
        }
    }
}

__device__ __forceinline__ void moe_offsets(LAS int* pst, const unsigned* cnt) {
    if (threadIdx.x == 0) {
        int acc = 0;
        for (int e = 0; e < 32; ++e) { pst[e] = acc; const int c = (int)cnt[e]; acc += (c + MOE_PAD - 1) / MOE_PAD * MOE_PAD; }
        pst[32] = acc;
    }
    __syncthreads();
}
__device__ __forceinline__ int moe_expert_of_row(const LAS int* pst, int r) {
    int e = 0;
#pragma unroll 1
    for (int i = 1; i < 32; ++i) if (r >= pst[i]) e = i;
    return e;
}

__device__ __forceinline__ void ph_dispatch(LAS int* pst, const unsigned* cnt, const bf16_t* hb, const int* tok_e, const int* tok_slot, int* tok_dest, bf16_t* XR) {
    moe_offsets(pst, cnt);
    const int wave = threadIdx.x >> 6, lane = threadIdx.x & 63;
    for (int item = blockIdx.x * NWAVES + wave; item < T_ * 2; item += gridDim.x * NWAVES) {
        const int t = item >> 1;
        const int e = tok_e[item], dest = pst[e] + tok_slot[item];
        if (lane == 0) tok_dest[item] = dest;
        const u32x4* src = (const u32x4*)(hb + (size_t)t * D_);
        u32x4* dst = (u32x4*)(XR + (size_t)dest * D_);
        dst[lane] = src[lane]; dst[lane + 64] = src[lane + 64];
    }
    const int R = pst[32];
    for (int r = blockIdx.x * NWAVES + wave; r < R; r += gridDim.x * NWAVES) {
        const int e = moe_expert_of_row(pst, r);
        if (r - pst[e] >= (int)cnt[e]) {
            u32x4* dst = (u32x4*)(XR + (size_t)r * D_);
            const u32x4 z = {0u, 0u, 0u, 0u};
            dst[lane] = z; dst[lane + 64] = z;
        }
    }
}

__device__ __forceinline__ void ph_combine_ln(const float* hf, const bf16_t* Y, const int* tok_dest, const float* tok_g, const float* lg, const float* lb, float* outf, bf16_t* hb) {
    const int wave = threadIdx.x >> 6, lane = threadIdx.x & 63;
    for (int t = blockIdx.x * NWAVES + wave; t < T_; t += gridDim.x * NWAVES) {
        const int d0 = tok_dest[2 * t], d1 = tok_dest[2 * t + 1];
        const float g0 = tok_g[2 * t], g1 = tok_g[2 * t + 1];
        f32x4 v[4]; float s = 0.f;
#pragma unroll
        for (int j = 0; j < 4; ++j) {
            const f32x4 h = ((const f32x4*)(hf + (size_t)t * D_))[lane + 64 * j];
            const u32x2 y0 = ((const u32x2*)(Y + (size_t)d0 * D_))[lane + 64 * j], y1 = ((const u32x2*)(Y + (size_t)d1 * D_))[lane + 64 * j];
            f32x4 a, b;
            a.x = __uint_as_float(y0.x << 16); a.y = __uint_as_float(y0.x & 0xffff0000u); a.z = __uint_as_float(y0.y << 16); a.w = __uint_as_float(y0.y & 0xffff0000u);
            b.x = __uint_as_float(y1.x << 16); b.y = __uint_as_float(y1.x & 0xffff0000u); b.z = __uint_as_float(y1.y << 16); b.w = __uint_as_float(y1.y & 0xffff0000u);
            v[j] = h * DN_ALPHA + (a * g0 + b * g1);
            s += (v[j].x + v[j].y) + (v[j].z + v[j].w);
        }
        const float mean = wave_sum(s) * (1.f / D_);
        float s2 = 0.f;
#pragma unroll
        for (int j = 0; j < 4; ++j) { v[j] = v[j] - mean; s2 += (v[j].x * v[j].x + v[j].y * v[j].y) + (v[j].z * v[j].z + v[j].w * v[j].w); }
        const float rstd = rsqrtf(wave_sum(s2) * (1.f / D_) + LN_EPS);
#pragma unroll
        for (int j = 0; j < 4; ++j) {
            const f32x4 g = ((const f32x4*)lg)[lane + 64 * j], bb = ((const f32x4*)lb)[lane + 64 * j];
            v[j] = v[j] * rstd * g + bb;
            ((f32x4*)(outf + (size_t)t * D_))[lane + 64 * j] = v[j];
            u32x2 o; o.x = pk2(v[j].x, v[j].y); o.y = pk2(v[j].z, v[j].w);
            ((u32x2*)(hb + (size_t)t * D_))[lane + 64 * j] = o;
        }
    }
}

__device__ __forceinline__ void naive_s5_scan(const bf16_t* P1, const float* a_re, const float* a_im, const float* log_dt, const float* b_re, const float* b_im,
                                              const float* c_re, const float* c_im, const float* dvec, float* YS5, bf16_t* YS5B, int pair) {
    const int lane = threadIdx.x & 63;
    const int b = pair >> 5, g = pair & 31, n = lane;
    const float lam_re = fminf(a_re[g * 64 + n], -1e-4f), lam_im = a_im[g * 64 + n];
    const float dt = __expf(log_dt[g]);
    const float mag = __expf(lam_re * dt);
    const float ab_re = mag * cosf(lam_im * dt), ab_im = mag * sinf(lam_im * dt);
    const float den = lam_re * lam_re + lam_im * lam_im;
    const float num_re = ab_re - 1.f;
    const float z_re = (num_re * lam_re + ab_im * lam_im) / den;
    const float z_im = (ab_im * lam_re - num_re * lam_im) / den;
    float bre[16], bim[16], cre[16], cim[16];
#pragma unroll
    for (int c = 0; c < 16; ++c) {
        bre[c] = b_re[(size_t)(g * 64 + n) * 16 + c]; bim[c] = b_im[(size_t)(g * 64 + n) * 16 + c];
        cre[c] = c_re[(size_t)(g * 16 + c) * 64 + n]; cim[c] = c_im[(size_t)(g * 16 + c) * 64 + n];
    }
    const float dd = (lane < 16) ? dvec[g * 16 + lane] : 0.f;
    float h_re = 0.f, h_im = 0.f;
    for (int tt = 0; tt < L_; ++tt) {
        const size_t t = (size_t)b * L_ + tt;
        const float ul = (lane < 16) ? bf2f(P1[t * NIN1 + g * 16 + lane]) : 0.f;
        float bur = 0.f, bui = 0.f;
#pragma unroll
        for (int c = 0; c < 16; ++c) { const float u = __shfl(ul, c); bur += u * bre[c]; bui += u * bim[c]; }
        const float x_re = z_re * bur - z_im * bui, x_im = z_re * bui + z_im * bur;
        const float nh_re = ab_re * h_re - ab_im * h_im + x_re;
        const float nh_im = ab_re * h_im + ab_im * h_re + x_im;
        h_re = nh_re; h_im = nh_im;
        float yv = 0.f;
#pragma unroll
        for (int c = 0; c < 16; ++c) { const float y = wave_sum(h_re * cre[c] - h_im * cim[c]); if (lane == c) yv = y; }
        if (lane < 16) {
            const float y = gelu_tanh(yv + dd * ul);
            YS5[t * 512 + g * 16 + lane] = y;
            YS5B[t * 512 + g * 16 + lane] = f2bf(y);
        }
    }
}

__device__ __forceinline__ void ph_fin1(const float* OG, const bf16_t* P1, const float* norm_g, bf16_t* Ymix) {
    const int wave = threadIdx.x >> 6, lane = threadIdx.x & 63;
    for (int item = blockIdx.x * NWAVES + wave; item < T_ * 4; item += gridDim.x * NWAVES) {
        const int t = item >> 2, h = item & 3;
        const float o0 = OG[(size_t)t * 512 + h * 128 + lane], o1 = OG[(size_t)t * 512 + h * 128 + 64 + lane];
        const float ms = wave_sum(o0 * o0 + o1 * o1) * (1.f / 128.f);
        const float rs = rsqrtf(ms + LN_EPS);
        const float g0 = bf2f(P1[(size_t)t * NIN1 + 2048 + h * 128 + lane]), g1 = bf2f(P1[(size_t)t * NIN1 + 2048 + h * 128 + 64 + lane]);
        Ymix[(size_t)t * D_ + 512 + h * 128 + lane] = f2bf(o0 * rs * norm_g[lane] * siluf(g0));
        Ymix[(size_t)t * D_ + 512 + h * 128 + 64 + lane] = f2bf(o1 * rs * norm_g[64 + lane] * siluf(g1));
    }
}

constexpr int LDS_BYTES = 147456;
enum Phase {
    PH_PROLOGUE = 0,
    PH_INPROJ0, PH_PREPA0, PH_LORA0, PH_PREPB0, PH_SCAN0, PH_FIN0, PH_OUTPROJ0, PH_LN1_0, PH_DISP0, PH_UP0, PH_DOWN0, PH_COMB0,
    PH_INPROJ1, PH_SCAN1, PH_FIN1, PH_GLU1, PH_OUTPROJ1, PH_LN1_1, PH_DISP1, PH_UP1, PH_DOWN1, PH_COMB1,
    PH_COUNT
};

template <int PLO, int PHI>
__device__ __forceinline__ void mega_body(const Args& args, unsigned char* lds_raw) {
    LAS unsigned char* lds = (LAS unsigned char*)lds_raw;
    LAS float* ldsf = (LAS float*)lds;
    unsigned char* ws = args.ws;
    unsigned* ctl = (unsigned*)(ws + WS_CTL);
    bf16_t* HB = (bf16_t*)(ws + WS_HB);
    float* HA = (float*)(ws + WS_HA);
    float* YRW = HA;
    float* OG = HA + (size_t)T_ * 512;
    bf16_t* P = (bf16_t*)(ws + WS_P);
    bf16_t* LO = (bf16_t*)(ws + WS_LO);
    bf16_t* SC = (bf16_t*)(ws + WS_SCAN);
    float* GLALA = (float*)(ws + WS_GLALA);
    float* BON = (float*)(ws + WS_BON);
    bf16_t* AP = (bf16_t*)(ws + WS_APRIME);
    bf16_t* YS5B = (bf16_t*)(ws + WS_YS5B);
    bf16_t* XR = (bf16_t*)(ws + WS_XR);
    bf16_t* HID = (bf16_t*)(ws + WS_HID);
    bf16_t* Y = (bf16_t*)(ws + WS_Y);
    int* tok_e = (int*)(ws + WS_ROUTE);
    int* tok_slot = tok_e + 2 * T_;
    int* tok_dest = tok_slot + 2 * T_;
    float* tok_g = (float*)(tok_dest + 2 * T_);
    bf16_t* Ymix = HB;
#define IN(k) (PLO <= (k) && (k) < PHI)
    const float* const* in = args.in;

    if (IN(PH_PROLOGUE)) ph_prologue(in[0], HB);

    if (IN(PH_INPROJ0)) {
        const float* W = in[1];
        naive_gemm<false>(ldsf, T_, NIN0, D_, [&](int m) { return HB + (size_t)m * D_; }, [&](int, int) { return W; }, NIN0,
                          [&](int m, int n, float a, float) { P[(size_t)m * NIN0P + n] = f2bf(a); });
    }
    if (IN(PH_PREPA0)) ph_prepA0(P, in[2], in[13], in[14], AP, GLALA);
    if (IN(PH_LORA0)) {
        const float* w2 = in[4]; const float* a2 = in[6]; const float* g2 = in[7];
        naive_gemm<false>(ldsf, T_, 512, 64, [&](int m) { return AP + (size_t)m * 256; }, [&](int, int) { return w2; }, 512,
                          [&](int m, int n, float a, float) { LO[(size_t)m * NLORA + n] = f2bf(a); });
        naive_gemm<false>(ldsf, T_, 512, 64, [&](int m) { return AP + (size_t)m * 256 + 64; }, [&](int, int) { return a2; }, 512,
                          [&](int m, int n, float a, float) { LO[(size_t)m * NLORA + 512 + n] = f2bf(a); });
        naive_gemm<false>(ldsf, T_, 512, 128, [&](int m) { return AP + (size_t)m * 256 + 128; }, [&](int, int) { return g2; }, 512,
                          [&](int m, int n, float a, float) { LO[(size_t)m * NLORA + 1024 + n] = f2bf(a); });
    }
    if (IN(PH_PREPB0)) ph_prepB0(P, LO, in[2], in[3], in[5], in[8], in[9], in[10], SC, BON);
    if (IN(PH_SCAN0)) {
        const int bid = blockIdx.x;
        if (bid < 16) naive_rwkv_scan(ldsf, SC, YRW, bid);
        else if (bid < 24) {
            const int bh = bid - 16;
            naive_gla_scan<64>(ldsf,
                [&](int t, int ck, float& q, float& kk, float& e) {
                    q = bf2f(P[(size_t)t * NIN0P + 1792 + ck]) * 0.125f; kk = bf2f(P[(size_t)t * NIN0P + 2048 + ck]); e = __expf(GLALA[(size_t)t * 256 + ck]); },
                [&](int t, int cv) { return bf2f(P[(size_t)t * NIN0P + 2304 + cv]); }, OG, bh >> 2, bh & 3);
        }
    }
    if (IN(PH_FIN0)) ph_fin0(YRW, OG, P, LO, SC, BON, in[11], in[12], in[15], Ymix);

#pragma unroll
    for (int layer = 0; layer < 2; ++layer) {
        const int base = layer == 0 ? PH_OUTPROJ0 : PH_OUTPROJ1;
        float* V1 = layer == 0 ? args.out : HA;
        const float* resid = layer == 0 ? in[0] : args.out;
        float* H1 = HA;
        unsigned* cnt = ctl + CW_CNT + 64 * layer;
        if (IN(base + 0)) {
            const float* W = layer == 0 ? in[16] : in[30];
            naive_gemm<false>(ldsf, T_, D_, D_, [&](int m) { return Ymix + (size_t)m * D_; }, [&](int, int) { return W; }, D_,
                              [&](int m, int n, float a, float) { V1[(size_t)m * D_ + n] = DN_ALPHA * resid[(size_t)m * D_ + n] + a; });
        }
        if (IN(base + 1)) ph_ln_router(V1, H1, HB, in[31] + layer * D_, in[32] + layer * D_, in[33] + (size_t)layer * D_ * 4, in[34] + layer * 4,
                                       in[35] + (size_t)layer * 4 * D_ * 8, in[36] + layer * 32, tok_e, tok_slot, tok_g, cnt);
        if (IN(base + 2)) ph_dispatch((LAS int*)lds, cnt, HB, tok_e, tok_slot, tok_dest, XR);
        if (IN(base + 3)) {
            LAS int* pst = (LAS int*)(lds + 65536);
            moe_offsets(pst, cnt);
            const float* w1 = in[37] + (size_t)layer * 32 * D_ * 512; const float* w3 = in[38] + (size_t)layer * 32 * D_ * 512;
            naive_gemm<true>(ldsf, pst[32], 512, D_, [&](int m) { return XR + (size_t)m * D_; },
                             [&](int m0, int which) { const int e = moe_expert_of_row(pst, m0); return (which ? w3 : w1) + (size_t)e * D_ * 512; }, 512,
                             [&](int m, int n, float a, float b) { HID[(size_t)m * 512 + n] = f2bf(siluf(a) * b); });
        }
        if (IN(base + 4)) {
            LAS int* pst = (LAS int*)(lds + 65536);
            moe_offsets(pst, cnt);
            const float* w2 = in[39] + (size_t)layer * 32 * 512 * D_;
            naive_gemm<false>(ldsf, pst[32], D_, 512, [&](int m) { return HID + (size_t)m * 512; },
                              [&](int m0, int) { const int e = moe_expert_of_row(pst, m0); return w2 + (size_t)e * 512 * D_; }, D_,
                              [&](int m, int n, float a, float) { Y[(size_t)m * D_ + n] = f2bf(a); });
        }
        if (IN(base + 5)) ph_combine_ln(H1, Y, tok_dest, tok_g, in[40] + layer * D_, in[41] + layer * D_, args.out, HB);

        if (layer == 0) {
            if (IN(PH_INPROJ1)) {
                const float* W = in[17];
                naive_gemm<false>(ldsf, T_, NIN1, D_, [&](int m) { return HB + (size_t)m * D_; }, [&](int, int) { return W; }, NIN1,
                                  [&](int m, int n, float a, float) { P[(size_t)m * NIN1 + n] = f2bf(a); });
            }
            if (IN(PH_SCAN1)) {
                const int bid = blockIdx.x;
                if (bid < 8) {
                    const float* hg_lb = in[28];
                    naive_gla_scan<128>(ldsf,
                        [&](int t, int ck, float& q, float& kk, float& e) {
                            const float l0 = hg_lb[ck], l1 = hg_lb[512 + ck];
                            const float lbv = 1.f / (1.f + __expf(l0 - l1));
                            const float f = bf2f(P[(size_t)t * NIN1 + 1024 + ck]);
                            const float sg = sigm(f);
                            q = siluf(bf2f(P[(size_t)t * NIN1 + 512 + ck])); kk = (1.f - lbv) * (1.f - sg); e = lbv + (1.f - lbv) * sg; },
                        [&](int t, int cv) { return bf2f(P[(size_t)t * NIN1 + 1536 + cv]); }, OG, bid >> 2, bid & 3);
                } else if (bid < 16) {
                    const int pair = (bid - 8) * 8 + (threadIdx.x >> 6);
                    naive_s5_scan(P, in[18], in[19], in[20], in[21], in[22], in[23], in[24], in[25], YRW, YS5B, pair);
                }
            }
            if (IN(PH_FIN1)) ph_fin1(OG, P, in[29], Ymix);
            if (IN(PH_GLU1)) {
                const float* W = in[26]; const float* gb = in[27];
                naive_gemm<false>(ldsf, T_, 512, 512, [&](int m) { return YS5B + (size_t)m * 512; }, [&](int, int) { return W; }, 512,
                                  [&](int m, int n, float a, float) { const float y = YRW[(size_t)m * 512 + n]; Ymix[(size_t)m * D_ + n] = f2bf(y * sigm(a + gb[n])); });
            }
        }
    }
#undef IN
}
template <int PLO, int PHI>
__global__ void __launch_bounds__(NTHREADS, 2) mega(Args args) {
    extern __shared__ __attribute__((aligned(16))) unsigned char lds_raw[];
    mega_body<PLO, PHI>(args, lds_raw);
}

#include <utility>
template <int... I> static void set_attrs(std::integer_sequence<int, I...>) {
    (void)std::initializer_list<int>{ ((void)hipFuncSetAttribute((const void*)mega<I, I + 1>, hipFuncAttributeMaxDynamicSharedMemorySize, LDS_BYTES), 0)... };
}
template <int I> static int launch_one(int grid, hipStream_t stream, const Args& a) {
    hipLaunchKernelGGL((mega<I, I + 1>), dim3(grid), dim3(NTHREADS), LDS_BYTES, stream, a);
    return 0;
}
template <int... I> static void launch_all(std::integer_sequence<int, I...>, int grid, hipStream_t stream, const Args& a) {
    (void)std::initializer_list<int>{ launch_one<I>(grid, stream, a)... };
}
extern "C" void kernel_launch(void* const* d_in, const int* in_sizes, int n_in, void* d_out, int out_size, void* d_ws, size_t ws_size, hipStream_t stream) {
    static int grid = 0;
    if (grid == 0) {
        if (n_in != 42 || out_size != T_ * D_ || ws_size < WS_END) { fprintf(stderr, "kernel_launch: unexpected shapes n_in %d out %d ws %zu\n", n_in, out_size, ws_size); grid = -1; return; }
        int dev = 0, cus = 0, per_cu = 0;
        hipGetDevice(&dev);
        hipDeviceGetAttribute(&cus, hipDeviceAttributeMultiprocessorCount, dev);
        set_attrs(std::make_integer_sequence<int, PH_COUNT>{});
        (void)hipGetLastError();
        if (per_cu < 1) per_cu = 1;
        grid = cus * 1;
        fprintf(stderr, "kernel_launch: cus %d per_cu %d grid %d\n", cus, per_cu, grid);
    }
    if (grid < 0) return;
    hipMemsetAsync((char*)d_ws + WS_CTL, 0, CTL_ZERO_BYTES, stream);
    Args a{};
    for (int i = 0; i < 42; ++i) a.in[i] = (const float*)d_in[i];
    a.out = (float*)d_out; a.ws = (unsigned char*)d_ws;
    launch_all(std::make_integer_sequence<int, PH_COUNT>{}, grid, stream, a);
}
```

```cpp
#include <hip/hip_runtime.h>
#include <cstdio>
#include <cstdint>

#define GAS __attribute__((address_space(1)))
#define LAS __attribute__((address_space(3)))
typedef unsigned short bf16_t;
typedef float f32x4 __attribute__((ext_vector_type(4)));
typedef unsigned u32x4 __attribute__((ext_vector_type(4)));
typedef unsigned u32x2 __attribute__((ext_vector_type(2)));

#ifndef MK_SINGLE
#define MK_SINGLE 1
#endif

constexpr int T_ = 16384, L_ = 8192, D_ = 1024;
constexpr int NIN0 = 3344, NIN0P = 3584, NIN1 = 2560;
constexpr int NLORA = 1536;
constexpr int RMAX = 40960;
constexpr int MOE_PAD = 256;
constexpr float DN_ALPHA = 1.41421356237f;
constexpr float LN_EPS = 1e-5f;
constexpr int NTHREADS = 512, NWAVES = 8;

constexpr size_t MiB = 1u << 20;
constexpr size_t WS_CTL = 0, CTL_ZERO_BYTES = 1 * MiB;
constexpr size_t WS_HB = 116 * MiB;
constexpr size_t WS_HA = 149 * MiB;
constexpr size_t WS_ROUTE = 213 * MiB;
constexpr size_t WS_BIG = 214 * MiB;
constexpr size_t WS_P = WS_BIG;
constexpr size_t WS_LO = WS_BIG + 112 * MiB;
constexpr size_t WS_SCAN = WS_BIG + 160 * MiB;
constexpr size_t WS_GLALA = WS_BIG + 256 * MiB;
constexpr size_t WS_BON = WS_BIG + 272 * MiB;
constexpr size_t WS_APRIME = WS_BIG + 273 * MiB;
constexpr size_t WS_YS5B = WS_BIG + 80 * MiB;
constexpr size_t WS_XR = WS_BIG;
constexpr size_t WS_HID = WS_BIG + 80 * MiB;
constexpr size_t WS_Y = WS_BIG + 120 * MiB;
constexpr size_t WS_END = 512 * MiB;
constexpr int CW_BAR = 4096;
constexpr int CW_CNT = 8192;

__device__ __forceinline__ float bf2f(bf16_t b) { return __uint_as_float(((unsigned)b) << 16); }
__device__ __forceinline__ bf16_t f2bf(float f) { unsigned u = __float_as_uint(f); u += 0x7fffu + ((u >> 16) & 1u); return (bf16_t)(u >> 16); }
__device__ __forceinline__ unsigned pk2(float lo, float hi) { return (unsigned)f2bf(lo) | ((unsigned)f2bf(hi) << 16); }
__device__ __forceinline__ float sigm(float x) { return 1.f / (1.f + __expf(-x)); }
__device__ __forceinline__ float siluf(float x) { return x * sigm(x); }
__device__ __forceinline__ float softplusf(float x) { return fmaxf(x, 0.f) + log1pf(__expf(-fabsf(x))); }
__device__ __forceinline__ float gelu_tanh(float x) { const float u = 0.7978845608028654f * (x + 0.044715f * x * x * x); return 0.5f * x * (1.f + tanhf(u)); }
__device__ __forceinline__ float wave_sum(float v) {
#pragma unroll
    for (int o = 1; o < 64; o <<= 1) v += __shfl_xor(v, o);
    return v;
}


#define XB_TMO      128
#define XB_XCNT(j)  (256  + 64 * (j))
#define XB_XSUB(j)  (1280 + 64 * (j))
#define XB_XGEN(j)  (2304 + 64 * (j))
#define XB_TOP      3328
#define XB_TOPGEN   3392
#define XCD_BAR_WORDS 3456
#define XB_SPIN_CAP (1u << 18)
__device__ __forceinline__ unsigned xb_ld(unsigned* p)              { return __hip_atomic_load(p, __ATOMIC_RELAXED, __HIP_MEMORY_SCOPE_AGENT); }
__device__ __forceinline__ unsigned xb_add(unsigned* p, unsigned v) { return __hip_atomic_fetch_add(p, v, __ATOMIC_RELAXED, __HIP_MEMORY_SCOPE_AGENT); }
__device__ __forceinline__ unsigned xb_xcc_id() { return (unsigned)__builtin_amdgcn_s_getreg((3 << 11) | 20) & 0xFu; }
#define XB_SPIN(cond, bar) do { unsigned _sp = 0; while (cond) { __builtin_amdgcn_s_sleep(1); \
    if ((++_sp & 255u) == 0u) { if (xb_ld(&(bar)[XB_TMO])) break; if (_sp > XB_SPIN_CAP) { atomicAdd(&(bar)[XB_TMO], 1u); break; } } } } while (0)
struct XcdBarrier { unsigned* bar; unsigned x; volatile LAS unsigned* st; };
__device__ __forceinline__ XcdBarrier xcd_barrier_post(unsigned* bar, volatile LAS unsigned* st) {
    XcdBarrier b; b.bar = bar; b.x = xb_xcc_id(); b.st = st;
    if (threadIdx.x == 0) (void)xb_add(&bar[XB_XCNT(b.x)], 1u);
    return b;
}
__device__ __forceinline__ void xcd_barrier_complete(unsigned* bar, unsigned x, unsigned& nloc, unsigned& nx) {
    const unsigned G = gridDim.x * gridDim.y * gridDim.z;
    unsigned sum, cnt, mine, sp = 0u;
    for (;;) {
        sum = 0u; cnt = 0u; mine = 0u;
#pragma unroll
        for (unsigned j = 0; j < 16; ++j) { const unsigned c = xb_ld(&bar[XB_XCNT(j)]); sum += c; cnt += (c > 0u) ? 1u : 0u; mine = (j == x) ? c : mine; }
        if (sum == G) break;
        __builtin_amdgcn_s_sleep(1);
        if ((++sp & 255u) == 0u) { if (xb_ld(&bar[XB_TMO])) break; if (sp > XB_SPIN_CAP) { atomicAdd(&bar[XB_TMO], 1u); break; } }
    }
    nloc = mine > 0u ? mine : 1u; nx = cnt > 0u ? cnt : 1u;
}
__device__ __forceinline__ void xcd_barrier(const XcdBarrier& b) {
    asm volatile("s_waitcnt vmcnt(0)" ::: "memory");
    __syncthreads();
    if (threadIdx.x == 0) {
        unsigned* bar = b.bar;
        __builtin_amdgcn_s_waitcnt(0);
        unsigned nloc = b.st[0], nx = b.st[1];
        if (nloc == 0u) { xcd_barrier_complete(bar, b.x, nloc, nx); b.st[0] = nloc; b.st[1] = nx; }
        const unsigned old = xb_add(&bar[XB_XSUB(b.x)], 1u);
        const unsigned gen = old / nloc;
        if (old + 1u == (gen + 1u) * nloc) {
            __builtin_amdgcn_fence(__ATOMIC_RELEASE, "agent");
            asm volatile("s_waitcnt vmcnt(0)" ::: "memory");
            const unsigned og = xb_add(&bar[XB_TOP], 1u);
            const unsigned tg = og / nx;
            if (og + 1u == (tg + 1u) * nx) xb_add(&bar[XB_TOPGEN], 1u);
            else XB_SPIN(xb_ld(&bar[XB_TOPGEN]) == tg, bar);
            __builtin_amdgcn_fence(__ATOMIC_ACQUIRE, "agent");
            xb_add(&bar[XB_XGEN(b.x)], 1u);
            asm volatile("s_waitcnt vmcnt(0)" ::: "memory");
        } else {
            XB_SPIN(xb_ld(&bar[XB_XGEN(b.x)]) == gen, bar);
            __builtin_amdgcn_fence(__ATOMIC_ACQUIRE, "agent");
            asm volatile("s_waitcnt vmcnt(0)" ::: "memory");
        }
    }
    __syncthreads();
}

struct Args {
    const float* in[42];
    float* out;
    unsigned char* ws;
    int ph_lo, ph_hi;
};

template <bool DUAL, class AF, class WF, class EF>
__device__ __forceinline__ void naive_gemm(LAS float* lds, int M, int N, int K, AF arow, WF wbase, int ldw, EF epi) {
    LAS float* As = lds;
    LAS float* Bs = lds + 64 * 33;
    LAS float* Bs2 = Bs + 32 * 64;
    const int tid = threadIdx.x, ty = tid >> 4, tx = tid & 15;
    const int tm = (M + 63) / 64, tn = (N + 63) / 64;
    for (int tile = blockIdx.x; tile < tm * tn; tile += gridDim.x) {
        const int m0 = (tile / tn) * 64, n0 = (tile % tn) * 64;
        const float* W = wbase(m0, 0);
        const float* W2 = DUAL ? wbase(m0, 1) : W;
        float acc[2][4], acc2[2][4];
#pragma unroll
        for (int i = 0; i < 2; ++i)
#pragma unroll
            for (int j = 0; j < 4; ++j) { acc[i][j] = 0.f; acc2[i][j] = 0.f; }
        for (int k0 = 0; k0 < K; k0 += 32) {
#pragma unroll
            for (int i = 0; i < 4; ++i) {
                const int idx = tid + i * 512, r = idx >> 5, kk = idx & 31, m = m0 + r;
                As[r * 33 + kk] = (m < M) ? bf2f(arow(m)[k0 + kk]) : 0.f;
            }
#pragma unroll
            for (int i = 0; i < 4; ++i) {
                const int idx = tid + i * 512, kk = idx >> 6, n = idx & 63;
                const bool ok = (n0 + n) < N;
                Bs[kk * 64 + n] = ok ? W[(size_t)(k0 + kk) * ldw + n0 + n] : 0.f;
                if (DUAL) Bs2[kk * 64 + n] = ok ? W2[(size_t)(k0 + kk) * ldw + n0 + n] : 0.f;
            }
            __syncthreads();
#pragma unroll 8
            for (int kk = 0; kk < 32; ++kk) {
                const float a0 = As[(ty * 2) * 33 + kk], a1 = As[(ty * 2 + 1) * 33 + kk];
#pragma unroll
                for (int j = 0; j < 4; ++j) {
                    const float b = Bs[kk * 64 + tx * 4 + j];
                    acc[0][j] += a0 * b; acc[1][j] += a1 * b;
                    if (DUAL) { const float b2 = Bs2[kk * 64 + tx * 4 + j]; acc2[0][j] += a0 * b2; acc2[1][j] += a1 * b2; }
                }
            }
            __syncthreads();
        }
#pragma unroll
        for (int i = 0; i < 2; ++i)
#pragma unroll
            for (int j = 0; j < 4; ++j) {
                const int m = m0 + ty * 2 + i, n = n0 + tx * 4 + j;
                if (m < M && n < N) epi(m, n, acc[i][j], acc2[i][j]);
            }
    }
}

__device__ __forceinline__ void ph_prologue(const float* x, bf16_t* hb) {
    const size_t n4 = (size_t)T_ * D_ / 4;
    for (size_t i = (size_t)blockIdx.x * NTHREADS + threadIdx.x; i < n4; i += (size_t)gridDim.x * NTHREADS) {
        const f32x4 v = ((const f32x4*)x)[i];
        u32x2 o; o.x = pk2(v.x, v.y); o.y = pk2(v.z, v.w);
        ((u32x2*)hb)[i] = o;
    }
    for (size_t i = (size_t)blockIdx.x * NTHREADS + threadIdx.x; i < (size_t)256 * D_ / 2; i += (size_t)gridDim.x * NTHREADS)
        ((unsigned*)(hb + (size_t)T_ * D_))[i] = 0u;
}

__device__ __forceinline__ float p0_shift(const bf16_t* P, const float* mu, int t, int c) {
    const float p = bf2f(P[(size_t)t * NIN0P + c]);
    const float pv = ((t & (L_ - 1)) == 0) ? 0.f : bf2f(P[(size_t)(t - 1) * NIN0P + c]);
    return p + mu[c] * (pv - p);
}
__device__ __forceinline__ void ph_prepA0(const bf16_t* P, const float* mu, const float* gk_w2, const float* gk_b, bf16_t* Ap, float* gla_la) {
    for (int chunk = blockIdx.x; chunk < T_ / 64; chunk += gridDim.x) {
        for (int idx = threadIdx.x; idx < 64 * 256; idx += NTHREADS) {
            const int tl = idx >> 8, j = idx & 255, t = chunk * 64 + tl;
            float v;
            if (j < 64) v = tanhf(p0_shift(P, mu, t, 512 + j));
            else if (j < 128) v = p0_shift(P, mu, t, 1600 + (j - 64));
            else v = sigm(p0_shift(P, mu, t, 1664 + (j - 128)));
            Ap[(size_t)t * 256 + j] = f2bf(v);
            float gk = gk_b[j];
#pragma unroll
            for (int i = 0; i < 16; ++i) gk += bf2f(P[(size_t)t * NIN0P + 2816 + i]) * gk_w2[i * 256 + j];
            const float ls = fminf(gk, 0.f) - log1pf(__expf(-fabsf(gk)));
            gla_la[(size_t)t * 256 + j] = ls * (1.f / 16.f);
        }
    }
}

__device__ __forceinline__ void ph_prepB0(const bf16_t* P, const bf16_t* LO, const float* mu, const float* w0, const float* a0, const float* k_k, const float* k_a,
                                          const float* r_k, bf16_t* SC, float* BON) {
    const int wave = threadIdx.x >> 6, lane = threadIdx.x & 63;
    for (int item = blockIdx.x * NWAVES + wave; item < T_ * 8; item += gridDim.x * NWAVES) {
        const int t = item >> 3, h = item & 7, c = h * 64 + lane;
        const float r = p0_shift(P, mu, t, c), k = p0_shift(P, mu, t, 576 + c), v = p0_shift(P, mu, t, 1088 + c);
        const float low = bf2f(LO[(size_t)t * NLORA + c]), loa = bf2f(LO[(size_t)t * NLORA + 512 + c]);
        const float xw = w0[c] + low;
        const float wraw = -softplusf(-xw) - 0.5f;
        const float ld = -__expf(wraw);
        const float a = sigm(a0[c] + loa);
        const float kkr = k * k_k[c];
        const float ss = wave_sum(kkr * kkr);
        const float kk = kkr / fmaxf(sqrtf(ss), 1e-12f);
        const float kp = k * (1.f + (a - 1.f) * k_a[c]);
        const float bon = wave_sum(r * kp * r_k[c]);
        const size_t o = (size_t)t * 512 + c, S1 = (size_t)T_ * 512;
        SC[o] = f2bf(r); SC[S1 + o] = f2bf(ld); SC[2 * S1 + o] = f2bf(kp); SC[3 * S1 + o] = f2bf(v); SC[4 * S1 + o] = f2bf(kk); SC[5 * S1 + o] = f2bf(a);
        if (lane == 0) BON[(size_t)t * 8 + h] = bon;
    }
}

__device__ __forceinline__ void naive_rwkv_scan(LAS float* lds, const bf16_t* SC, float* YRW, int bh) {
    constexpr int TS = 32;
    const int b = bh >> 3, h = bh & 7;
    LAS float* Lnkk = lds;
    LAS float* Ldec = lds + TS * 64;
    LAS float* Lab = lds + 2 * TS * 64;
    LAS float* Lkp = lds + 3 * TS * 64;
    LAS float* Lr = lds + 4 * TS * 64;
    LAS float* Lv = lds + 5 * TS * 64;
    const size_t S1 = (size_t)T_ * 512;
    float S[64];
#pragma unroll
    for (int k = 0; k < 64; ++k) S[k] = 0.f;
    const int lane = threadIdx.x & 63, wave = threadIdx.x >> 6;
    for (int t0 = 0; t0 < L_; t0 += TS) {
        for (int idx = threadIdx.x; idx < TS * 64; idx += NTHREADS) {
            const int s = idx >> 6, k = idx & 63;
            const size_t o = (size_t)(b * L_ + t0 + s) * 512 + h * 64 + k;
            const float r = bf2f(SC[o]), ld = bf2f(SC[S1 + o]), kp = bf2f(SC[2 * S1 + o]), v = bf2f(SC[3 * S1 + o]), kk = bf2f(SC[4 * S1 + o]), a = bf2f(SC[5 * S1 + o]);
            Lnkk[idx] = -kk; Ldec[idx] = __expf(ld); Lab[idx] = kk * a; Lkp[idx] = kp; Lr[idx] = r; Lv[idx] = v;
        }
        __syncthreads();
        if (wave == 0) {
            for (int s = 0; s < TS; ++s) {
                float sa = 0.f;
#pragma unroll
                for (int k = 0; k < 64; ++k) sa += S[k] * Lnkk[s * 64 + k];
                const float vv = Lv[s * 64 + lane];
                float y = 0.f;
#pragma unroll
                for (int k = 0; k < 64; ++k) {
                    S[k] = S[k] * Ldec[s * 64 + k] + sa * Lab[s * 64 + k] + vv * Lkp[s * 64 + k];
                    y += S[k] * Lr[s * 64 + k];
                }
                YRW[(size_t)(b * L_ + t0 + s) * 512 + h * 64 + lane] = y;
            }
        }
        __syncthreads();
    }
}

template <int K, class LDF, class LVF>
__device__ __forceinline__ void naive_gla_scan(LAS float* lds, LDF ld, LVF lv, float* OG, int b, int h) {
    constexpr int TS = 16;
    LAS float* Lq = lds;
    LAS float* Lk = lds + TS * K;
    LAS float* Le = lds + 2 * TS * K;
    LAS float* Lv = lds + 3 * TS * K;
    float S[K];
#pragma unroll
    for (int k = 0; k < K; ++k) S[k] = 0.f;
    const int tid = threadIdx.x;
    for (int t0 = 0; t0 < L_; t0 += TS) {
        for (int idx = tid; idx < TS * K; idx += NTHREADS) {
            const int s = idx / K, k = idx % K;
            float q, kk, e; ld(b * L_ + t0 + s, h * K + k, q, kk, e);
            Lq[idx] = q; Lk[idx] = kk; Le[idx] = e;
        }
        for (int idx = tid; idx < TS * 128; idx += NTHREADS) {
            const int s = idx >> 7, vc = idx & 127;
            Lv[idx] = lv(b * L_ + t0 + s, h * 128 + vc);
        }
        __syncthreads();
        if (tid < 128) {
            for (int s = 0; s < TS; ++s) {
                const float vv = Lv[s * 128 + tid];
                float o = 0.f;
#pragma unroll
                for (int k = 0; k < K; ++k) {
                    S[k] = S[k] * Le[s * K + k] + Lk[s * K + k] * vv;
                    o += Lq[s * K + k] * S[k];
                }
                OG[(size_t)(b * L_ + t0 + s) * 512 + h * 128 + tid] = o;
            }
        }
        __syncthreads();
    }
}

__device__ __forceinline__ void ph_fin0(const float* YRW, const float* OG, const bf16_t* P, const bf16_t* LO, const bf16_t* SC, const float* BON,
                                        const float* gn_g, const float* gn_b, const float* norm_g, bf16_t* Ymix) {
    const int wave = threadIdx.x >> 6, lane = threadIdx.x & 63;
    const size_t S1 = (size_t)T_ * 512;
    for (int item = blockIdx.x * NWAVES + wave; item < T_ * 12; item += gridDim.x * NWAVES) {
        const int t = item / 12, u = item % 12;
        if (u < 8) {
            const int c = u * 64 + lane;
            const float y = YRW[(size_t)t * 512 + c];
            const float mean = wave_sum(y) * (1.f / 64.f);
            const float d = y - mean;
            const float var = wave_sum(d * d) * (1.f / 64.f);
            const float yn = d * rsqrtf(var + 64e-5f) * gn_g[c] + gn_b[c];
            const float v = bf2f(SC[3 * S1 + (size_t)t * 512 + c]);
            const float g = bf2f(LO[(size_t)t * NLORA + 1024 + c]);
            Ymix[(size_t)t * D_ + c] = f2bf((yn + BON[(size_t)t * 8 + u] * v) * g);
        } else {
            const int h = u - 8;
            const float o0 = OG[(size_t)t * 512 + h * 128 + lane], o1 = OG[(size_t)t * 512 + h * 128 + 64 + lane];
            const float ms = wave_sum(o0 * o0 + o1 * o1) * (1.f / 128.f);
            const float rs = rsqrtf(ms + LN_EPS);
            const float g0 = bf2f(P[(size_t)t * NIN0P + 2832 + h * 128 + lane]), g1 = bf2f(P[(size_t)t * NIN0P + 2832 + h * 128 + 64 + lane]);
            Ymix[(size_t)t * D_ + 512 + h * 128 + lane] = f2bf(o0 * rs * norm_g[lane] * siluf(g0));
            Ymix[(size_t)t * D_ + 512 + h * 128 + 64 + lane] = f2bf(o1 * rs * norm_g[64 + lane] * siluf(g1));
        }
    }
}

__device__ __forceinline__ void ph_ln_router(const float* src, float* hf, bf16_t* hb, const float* lg, const float* lb, const float* wg, const float* bg,
                                             const float* we, const float* be, int* tok_e, int* tok_slot, float* tok_g, unsigned* cnt) {
    const int wave = threadIdx.x >> 6, lane = threadIdx.x & 63;
    for (int t = blockIdx.x * NWAVES + wave; t < T_; t += gridDim.x * NWAVES) {
        const f32x4* xr = (const f32x4*)(src + (size_t)t * D_) + lane;
        f32x4 v[4]; float s = 0.f;
#pragma unroll
        for (int j = 0; j < 4; ++j) { v[j] = xr[64 * j]; s += (v[j].x + v[j].y) + (v[j].z + v[j].w); }
        const float mean = wave_sum(s) * (1.f / D_);
        float s2 = 0.f;
#pragma unroll
        for (int j = 0; j < 4; ++j) { v[j] = v[j] - mean; s2 += (v[j].x * v[j].x + v[j].y * v[j].y) + (v[j].z * v[j].z + v[j].w * v[j].w); }
        const float rstd = rsqrtf(wave_sum(s2) * (1.f / D_) + LN_EPS);
#pragma unroll
        for (int j = 0; j < 4; ++j) {
            const f32x4 g = ((const f32x4*)lg)[lane + 64 * j], bb = ((const f32x4*)lb)[lane + 64 * j];
            v[j] = v[j] * rstd * g + bb;
            ((f32x4*)(hf + (size_t)t * D_))[lane + 64 * j] = v[j];
            u32x2 o; o.x = pk2(v[j].x, v[j].y); o.y = pk2(v[j].z, v[j].w);
            ((u32x2*)(hb + (size_t)t * D_))[lane + 64 * j] = o;
        }
        float cl[4] = {0.f, 0.f, 0.f, 0.f};
#pragma unroll
        for (int j = 0; j < 4; ++j)
#pragma unroll
            for (int e = 0; e < 4; ++e) {
                const int d = 4 * (lane + 64 * j) + e;
                const f32x4 w = *(const f32x4*)(wg + (size_t)d * 4);
                const float xv = v[j][e];
                cl[0] += xv * w.x; cl[1] += xv * w.y; cl[2] += xv * w.z; cl[3] += xv * w.w;
            }
#pragma unroll
        for (int g = 0; g < 4; ++g) cl[g] = wave_sum(cl[g]) + bg[g];
        int grp = 0; float mx = cl[0];
#pragma unroll
        for (int g = 1; g < 4; ++g) if (cl[g] > mx) { mx = cl[g]; grp = g; }
        float den = 0.f;
#pragma unroll
        for (int g = 0; g < 4; ++g) den += __expf(cl[g] - mx);
        const float p_grp = 1.f / den;
        float fl[8];
#pragma unroll
        for (int e = 0; e < 8; ++e) fl[e] = 0.f;
        const float* weg = we + (size_t)grp * D_ * 8;
#pragma unroll
        for (int j = 0; j < 4; ++j)
#pragma unroll
            for (int e = 0; e < 4; ++e) {
                const int d = 4 * (lane + 64 * j) + e;
                const f32x4 w0 = *(const f32x4*)(weg + (size_t)d * 8), w1 = *(const f32x4*)(weg + (size_t)d * 8 + 4);
                const float xv = v[j][e];
                fl[0] += xv * w0.x; fl[1] += xv * w0.y; fl[2] += xv * w0.z; fl[3] += xv * w0.w;
                fl[4] += xv * w1.x; fl[5] += xv * w1.y; fl[6] += xv * w1.z; fl[7] += xv * w1.w;
            }
#pragma unroll
        for (int e = 0; e < 8; ++e) fl[e] = wave_sum(fl[e]) + be[grp * 8 + e];
        int j0 = 0; float m0 = fl[0];
#pragma unroll
        for (int e = 1; e < 8; ++e) if (fl[e] > m0) { m0 = fl[e]; j0 = e; }
        int j1 = -1; float m1 = -3.0e38f;
#pragma unroll
        for (int e = 0; e < 8; ++e) if (e != j0 && fl[e] > m1) { m1 = fl[e]; j1 = e; }
        const float e1 = __expf(m1 - m0);
        const float g0 = p_grp / (1.f + e1), g1 = p_grp * e1 / (1.f + e1);
        if (lane == 0) {
            const int ex0 = grp * 8 + j0, ex1 = grp * 8 + j1;
            const unsigned s0 = atomicAdd(&cnt[ex0], 1u), s1 = atomicAdd(&cnt[ex1], 1u);
            tok_e[2 * t] = ex0; tok_e[2 * t + 1] = ex1;
            tok_slot[2 * t] = (int)s0; tok_slot[2 * t + 1] = (int)s1;
            tok_g[2 * t] = g0; tok_g[2 * t + 1] = g1;
        }
    }
}

__device__ __forceinline__ void moe_offsets(LAS int* pst, const unsigned* cnt) {
    if (threadIdx.x == 0) {
        int acc = 0;
        for (int e = 0; e < 32; ++e) { pst[e] = acc; const int c = (int)cnt[e]; acc += (c + MOE_PAD - 1) / MOE_PAD * MOE_PAD; }
        pst[32] = acc;
    }
    __syncthreads();
}
__device__ __forceinline__ int moe_expert_of_row(const LAS int* pst, int r) {
    int e = 0;
#pragma unroll 1
    for (int i = 1; i < 32; ++i) if (r >= pst[i]) e = i;
    return e;
}

__device__ __forceinline__ void ph_dispatch(LAS int* pst, const unsigned* cnt, const bf16_t* hb, const int* tok_e, const int* tok_slot, int* tok_dest, bf16_t* XR) {
    moe_offsets(pst, cnt);
    const int wave = threadIdx.x >> 6, lane = threadIdx.x & 63;
    for (int item = blockIdx.x * NWAVES + wave; item < T_ * 2; item += gridDim.x * NWAVES) {
        const int t = item >> 1;
        const int e = tok_e[item], dest = pst[e] + tok_slot[item];
        if (lane == 0) tok_dest[item] = dest;
        const u32x4* src = (const u32x4*)(hb + (size_t)t * D_);
        u32x4* dst = (u32x4*)(XR + (size_t)dest * D_);
        dst[lane] = src[lane]; dst[lane + 64] = src[lane + 64];
    }
    const int R = pst[32];
    for (int r = blockIdx.x * NWAVES + wave; r < R; r += gridDim.x * NWAVES) {
        const int e = moe_expert_of_row(pst, r);
        if (r - pst[e] >= (int)cnt[e]) {
            u32x4* dst = (u32x4*)(XR + (size_t)r * D_);
            const u32x4 z = {0u, 0u, 0u, 0u};
            dst[lane] = z; dst[lane + 64] = z;
        }
    }
}

__device__ __forceinline__ void ph_combine_ln(const float* hf, const bf16_t* Y, const int* tok_dest, const float* tok_g, const float* lg, const float* lb, float* outf, bf16_t* hb) {
    const int wave = threadIdx.x >> 6, lane = threadIdx.x & 63;
    for (int t = blockIdx.x * NWAVES + wave; t < T_; t += gridDim.x * NWAVES) {
        const int d0 = tok_dest[2 * t], d1 = tok_dest[2 * t + 1];
        const float g0 = tok_g[2 * t], g1 = tok_g[2 * t + 1];
        f32x4 v[4]; float s = 0.f;
#pragma unroll
        for (int j = 0; j < 4; ++j) {
            const f32x4 h = ((const f32x4*)(hf + (size_t)t * D_))[lane + 64 * j];
            const u32x2 y0 = ((const u32x2*)(Y + (size_t)d0 * D_))[lane + 64 * j], y1 = ((const u32x2*)(Y + (size_t)d1 * D_))[lane + 64 * j];
            f32x4 a, b;
            a.x = __uint_as_float(y0.x << 16); a.y = __uint_as_float(y0.x & 0xffff0000u); a.z = __uint_as_float(y0.y << 16); a.w = __uint_as_float(y0.y & 0xffff0000u);
            b.x = __uint_as_float(y1.x << 16); b.y = __uint_as_float(y1.x & 0xffff0000u); b.z = __uint_as_float(y1.y << 16); b.w = __uint_as_float(y1.y & 0xffff0000u);
            v[j] = h * DN_ALPHA + (a * g0 + b * g1);
            s += (v[j].x + v[j].y) + (v[j].z + v[j].w);
        }
        const float mean = wave_sum(s) * (1.f / D_);
        float s2 = 0.f;
#pragma unroll
        for (int j = 0; j < 4; ++j) { v[j] = v[j] - mean; s2 += (v[j].x * v[j].x + v[j].y * v[j].y) + (v[j].z * v[j].z + v[j].w * v[j].w); }
        const float rstd = rsqrtf(wave_sum(s2) * (1.f / D_) + LN_EPS);
#pragma unroll
        for (int j = 0; j < 4; ++j) {
            const f32x4 g = ((const f32x4*)lg)[lane + 64 * j], bb = ((const f32x4*)lb)[lane + 64 * j];
            v[j] = v[j] * rstd * g + bb;
            ((f32x4*)(outf + (size_t)t * D_))[lane + 64 * j] = v[j];
            u32x2 o; o.x = pk2(v[j].x, v[j].y); o.y = pk2(v[j].z, v[j].w);
            ((u32x2*)(hb + (size_t)t * D_))[lane + 64 * j] = o;
        }
    }
}

__device__ __forceinline__ void naive_s5_scan(const bf16_t* P1, const float* a_re, const float* a_im, const float* log_dt, const float* b_re, const float* b_im,
                                              const float* c_re, const float* c_im, const float* dvec, float* YS5, bf16_t* YS5B, int pair) {
    const int lane = threadIdx.x & 63;
    const int b = pair >> 5, g = pair & 31, n = lane;
    const float lam_re = fminf(a_re[g * 64 + n], -1e-4f), lam_im = a_im[g * 64 + n];
    const float dt = __expf(log_dt[g]);
    const float mag = __expf(lam_re * dt);
    const float ab_re = mag * cosf(lam_im * dt), ab_im = mag * sinf(lam_im * dt);
    const float den = lam_re * lam_re + lam_im * lam_im;
    const float num_re = ab_re - 1.f;
    const float z_re = (num_re * lam_re + ab_im * lam_im) / den;
    const float z_im = (ab_im * lam_re - num_re * lam_im) / den;
    float bre[16], bim[16], cre[16], cim[16];
#pragma unroll
    for (int c = 0; c < 16; ++c) {
        bre[c] = b_re[(size_t)(g * 64 + n) * 16 + c]; bim[c] = b_im[(size_t)(g * 64 + n) * 16 + c];
        cre[c] = c_re[(size_t)(g * 16 + c) * 64 + n]; cim[c] = c_im[(size_t)(g * 16 + c) * 64 + n];
    }
    const float dd = (lane < 16) ? dvec[g * 16 + lane] : 0.f;
    float h_re = 0.f, h_im = 0.f;
    for (int tt = 0; tt < L_; ++tt) {
        const size_t t = (size_t)b * L_ + tt;
        const float ul = (lane < 16) ? bf2f(P1[t * NIN1 + g * 16 + lane]) : 0.f;
        float bur = 0.f, bui = 0.f;
#pragma unroll
        for (int c = 0; c < 16; ++c) { const float u = __shfl(ul, c); bur += u * bre[c]; bui += u * bim[c]; }
        const float x_re = z_re * bur - z_im * bui, x_im = z_re * bui + z_im * bur;
        const float nh_re = ab_re * h_re - ab_im * h_im + x_re;
        const float nh_im = ab_re * h_im + ab_im * h_re + x_im;
        h_re = nh_re; h_im = nh_im;
        float yv = 0.f;
#pragma unroll
        for (int c = 0; c < 16; ++c) { const float y = wave_sum(h_re * cre[c] - h_im * cim[c]); if (lane == c) yv = y; }
        if (lane < 16) {
            const float y = gelu_tanh(yv + dd * ul);
            YS5[t * 512 + g * 16 + lane] = y;
            YS5B[t * 512 + g * 16 + lane] = f2bf(y);
        }
    }
}

__device__ __forceinline__ void ph_fin1(const float* OG, const bf16_t* P1, const float* norm_g, bf16_t* Ymix) {
    const int wave = threadIdx.x >> 6, lane = threadIdx.x & 63;
    for (int item = blockIdx.x * NWAVES + wave; item < T_ * 4; item += gridDim.x * NWAVES) {
        const int t = item >> 2, h = item & 3;
        const float o0 = OG[(size_t)t * 512 + h * 128 + lane], o1 = OG[(size_t)t * 512 + h * 128 + 64 + lane];
        const float ms = wave_sum(o0 * o0 + o1 * o1) * (1.f / 128.f);
        const float rs = rsqrtf(ms + LN_EPS);
        const float g0 = bf2f(P1[(size_t)t * NIN1 + 2048 + h * 128 + lane]), g1 = bf2f(P1[(size_t)t * NIN1 + 2048 + h * 128 + 64 + lane]);
        Ymix[(size_t)t * D_ + 512 + h * 128 + lane] = f2bf(o0 * rs * norm_g[lane] * siluf(g0));
        Ymix[(size_t)t * D_ + 512 + h * 128 + 64 + lane] = f2bf(o1 * rs * norm_g[64 + lane] * siluf(g1));
    }
}

constexpr int LDS_BYTES = 147456;
constexpr int MISC_OFF = 131072 + 8192;
enum Phase {
    PH_PROLOGUE = 0,
    PH_INPROJ0, PH_PREPA0, PH_LORA0, PH_PREPB0, PH_SCAN0, PH_FIN0, PH_OUTPROJ0, PH_LN1_0, PH_DISP0, PH_UP0, PH_DOWN0, PH_COMB0,
    PH_INPROJ1, PH_SCAN1, PH_FIN1, PH_GLU1, PH_OUTPROJ1, PH_LN1_1, PH_DISP1, PH_UP1, PH_DOWN1, PH_COMB1,
    PH_COUNT
};

typedef const Args __attribute__((address_space(4)))* KArgsP;
__device__ __forceinline__ KArgsP fresh_args() { KArgsP p = (KArgsP)__builtin_amdgcn_kernarg_segment_ptr(); asm volatile("" : "+s"(p)); return p; }
#define PHASE_BEGIN KArgsP ap = fresh_args(); unsigned char* const ws = ap->ws; (void)ws;
#define INP(i) (ap->in[i])
#define W_CTL ((unsigned*)(ws + WS_CTL))
#define W_HB ((bf16_t*)(ws + WS_HB))
#define W_HA ((float*)(ws + WS_HA))
#define W_YRW W_HA
#define W_OG (W_HA + (size_t)T_ * 512)
#define W_P ((bf16_t*)(ws + WS_P))
#define W_LO ((bf16_t*)(ws + WS_LO))
#define W_SC ((bf16_t*)(ws + WS_SCAN))
#define W_GLALA ((float*)(ws + WS_GLALA))
#define W_BON ((float*)(ws + WS_BON))
#define W_AP ((bf16_t*)(ws + WS_APRIME))
#define W_YS5B ((bf16_t*)(ws + WS_YS5B))
#define W_XR ((bf16_t*)(ws + WS_XR))
#define W_HID ((bf16_t*)(ws + WS_HID))
#define W_Y ((bf16_t*)(ws + WS_Y))
#define W_TOKE ((int*)(ws + WS_ROUTE))
#define W_TOKSLOT (W_TOKE + 2 * T_)
#define W_TOKDEST (W_TOKE + 4 * T_)
#define W_TOKG ((float*)(W_TOKE + 6 * T_))
#define W_YMIX W_HB

template <int PLO, int PHI>
__device__ __forceinline__ void mega_body(unsigned char* lds_raw) {
    LAS unsigned char* lds = (LAS unsigned char*)lds_raw;
    LAS float* ldsf = (LAS float*)lds;
#define IN(k) (PLO <= (k) && (k) < PHI)
    constexpr bool MULTI = (PHI - PLO) > 1;
    XcdBarrier bar; bar.bar = nullptr; bar.x = 0; bar.st = (volatile LAS unsigned*)(lds + MISC_OFF) + 8;
    if (MULTI) {
        PHASE_BEGIN
        volatile LAS unsigned* MISC = (volatile LAS unsigned*)(lds + MISC_OFF);
        if (threadIdx.x < 32) MISC[threadIdx.x] = 0u;
        __syncthreads();
        bar = xcd_barrier_post(W_CTL + CW_BAR, MISC + 8);
    }
#define SEAM(k) do { if (IN(k) && IN((k) + 1)) { PHASE_BEGIN bar.bar = W_CTL + CW_BAR; xcd_barrier(bar); } } while (0)

    if (IN(PH_PROLOGUE)) { PHASE_BEGIN ph_prologue(INP(0), W_HB); }
    SEAM(PH_PROLOGUE);
    if (IN(PH_INPROJ0)) {
        PHASE_BEGIN
        const float* W = INP(1); const bf16_t* A = W_HB; bf16_t* P = W_P;
        naive_gemm<false>(ldsf, T_, NIN0, D_, [&](int m) { return A + (size_t)m * D_; }, [&](int, int) { return W; }, NIN0,
                          [&](int m, int n, float a, float) { P[(size_t)m * NIN0P + n] = f2bf(a); });
    }
    SEAM(PH_INPROJ0);
    if (IN(PH_PREPA0)) { PHASE_BEGIN ph_prepA0(W_P, INP(2), INP(13), INP(14), W_AP, W_GLALA); }
    SEAM(PH_PREPA0);
    if (IN(PH_LORA0)) {
        PHASE_BEGIN
        const float* w2 = INP(4); const float* a2 = INP(6); const float* g2 = INP(7); const bf16_t* AP = W_AP; bf16_t* LO = W_LO;
        naive_gemm<false>(ldsf, T_, 512, 64, [&](int m) { return AP + (size_t)m * 256; }, [&](int, int) { return w2; }, 512,
                          [&](int m, int n, float a, float) { LO[(size_t)m * NLORA + n] = f2bf(a); });
        naive_gemm<false>(ldsf, T_, 512, 64, [&](int m) { return AP + (size_t)m * 256 + 64; }, [&](int, int) { return a2; }, 512,
                          [&](int m, int n, float a, float) { LO[(size_t)m * NLORA + 512 + n] = f2bf(a); });
        naive_gemm<false>(ldsf, T_, 512, 128, [&](int m) { return AP + (size_t)m * 256 + 128; }, [&](int, int) { return g2; }, 512,
                          [&](int m, int n, float a, float) { LO[(size_t)m * NLORA + 1024 + n] = f2bf(a); });
    }
    SEAM(PH_LORA0);
    if (IN(PH_PREPB0)) { PHASE_BEGIN ph_prepB0(W_P, W_LO, INP(2), INP(3), INP(5), INP(8), INP(9), INP(10), W_SC, W_BON); }
    SEAM(PH_PREPB0);
    if (IN(PH_SCAN0)) {
        PHASE_BEGIN
        const int bid = blockIdx.x;
        if (bid < 16) naive_rwkv_scan(ldsf, W_SC, W_YRW, bid);
        else if (bid < 24) {
            const int bh = bid - 16;
            const bf16_t* P = W_P; const float* GLALA = W_GLALA;
            naive_gla_scan<64>(ldsf,
                [&](int t, int ck, float& q, float& kk, float& e) {
                    q = bf2f(P[(size_t)t * NIN0P + 1792 + ck]) * 0.125f; kk = bf2f(P[(size_t)t * NIN0P + 2048 + ck]); e = __expf(GLALA[(size_t)t * 256 + ck]); },
                [&](int t, int cv) { return bf2f(P[(size_t)t * NIN0P + 2304 + cv]); }, W_OG, bh >> 2, bh & 3);
        }
    }
    SEAM(PH_SCAN0);
    if (IN(PH_FIN0)) { PHASE_BEGIN ph_fin0(W_YRW, W_OG, W_P, W_LO, W_SC, W_BON, INP(11), INP(12), INP(15), W_YMIX); }
    SEAM(PH_FIN0);

#pragma unroll
    for (int layer = 0; layer < 2; ++layer) {
        const int base = layer == 0 ? PH_OUTPROJ0 : PH_OUTPROJ1;
        if (IN(base + 0)) {
            PHASE_BEGIN
            const float* W = layer == 0 ? INP(16) : INP(30);
            float* V1 = layer == 0 ? ap->out : W_HA;
            const float* resid = layer == 0 ? INP(0) : ap->out;
            const bf16_t* Ymix = W_YMIX;
            naive_gemm<false>(ldsf, T_, D_, D_, [&](int m) { return Ymix + (size_t)m * D_; }, [&](int, int) { return W; }, D_,
                              [&](int m, int n, float a, float) { V1[(size_t)m * D_ + n] = DN_ALPHA * resid[(size_t)m * D_ + n] + a; });
        }
        SEAM(base + 0);
        if (IN(base + 1)) {
            PHASE_BEGIN
            const float* V1 = layer == 0 ? ap->out : W_HA;
            ph_ln_router(V1, W_HA, W_HB, INP(31) + layer * D_, INP(32) + layer * D_, INP(33) + (size_t)layer * D_ * 4, INP(34) + layer * 4,
                         INP(35) + (size_t)layer * 4 * D_ * 8, INP(36) + layer * 32, W_TOKE, W_TOKSLOT, W_TOKG, W_CTL + CW_CNT + 64 * layer);
        }
        SEAM(base + 1);
        if (IN(base + 2)) { PHASE_BEGIN ph_dispatch((LAS int*)lds, W_CTL + CW_CNT + 64 * layer, W_HB, W_TOKE, W_TOKSLOT, W_TOKDEST, W_XR); }
        SEAM(base + 2);
        if (IN(base + 3)) {
            PHASE_BEGIN
            LAS int* pst = (LAS int*)(lds + 65536);
            moe_offsets(pst, W_CTL + CW_CNT + 64 * layer);
            const float* w1 = INP(37) + (size_t)layer * 32 * D_ * 512; const float* w3 = INP(38) + (size_t)layer * 32 * D_ * 512;
            const bf16_t* XR = W_XR; bf16_t* HID = W_HID;
            naive_gemm<true>(ldsf, pst[32], 512, D_, [&](int m) { return XR + (size_t)m * D_; },
                             [&](int m0, int which) { const int e = moe_expert_of_row(pst, m0); return (which ? w3 : w1) + (size_t)e * D_ * 512; }, 512,
                             [&](int m, int n, float a, float b) { HID[(size_t)m * 512 + n] = f2bf(siluf(a) * b); });
        }
        SEAM(base + 3);
        if (IN(base + 4)) {
            PHASE_BEGIN
            LAS int* pst = (LAS int*)(lds + 65536);
            moe_offsets(pst, W_CTL + CW_CNT + 64 * layer);
            const float* w2 = INP(39) + (size_t)layer * 32 * 512 * D_;
            const bf16_t* HID = W_HID; bf16_t* Y = W_Y;
            naive_gemm<false>(ldsf, pst[32], D_, 512, [&](int m) { return HID + (size_t)m * 512; },
                              [&](int m0, int) { const int e = moe_expert_of_row(pst, m0); return w2 + (size_t)e * 512 * D_; }, D_,
                              [&](int m, int n, float a, float) { Y[(size_t)m * D_ + n] = f2bf(a); });
        }
        SEAM(base + 4);
        if (IN(base + 5)) { PHASE_BEGIN ph_combine_ln(W_HA, W_Y, W_TOKDEST, W_TOKG, INP(40) + layer * D_, INP(41) + layer * D_, ap->out, W_HB); }
        SEAM(base + 5);

        if (layer == 0) {
            if (IN(PH_INPROJ1)) {
                PHASE_BEGIN
                const float* W = INP(17); const bf16_t* A = W_HB; bf16_t* P = W_P;
                naive_gemm<false>(ldsf, T_, NIN1, D_, [&](int m) { return A + (size_t)m * D_; }, [&](int, int) { return W; }, NIN1,
                                  [&](int m, int n, float a, float) { P[(size_t)m * NIN1 + n] = f2bf(a); });
            }
            SEAM(PH_INPROJ1);
            if (IN(PH_SCAN1)) {
                PHASE_BEGIN
                const int bid = blockIdx.x;
                const bf16_t* P = W_P;
                if (bid < 8) {
                    const float* hg_lb = INP(28);
                    naive_gla_scan<128>(ldsf,
                        [&](int t, int ck, float& q, float& kk, float& e) {
                            const float l0 = hg_lb[ck], l1 = hg_lb[512 + ck];
                            const float lbv = 1.f / (1.f + __expf(l0 - l1));
                            const float f = bf2f(P[(size_t)t * NIN1 + 1024 + ck]);
                            const float sg = sigm(f);
                            q = siluf(bf2f(P[(size_t)t * NIN1 + 512 + ck])); kk = (1.f - lbv) * (1.f - sg); e = lbv + (1.f - lbv) * sg; },
                        [&](int t, int cv) { return bf2f(P[(size_t)t * NIN1 + 1536 + cv]); }, W_OG, bid >> 2, bid & 3);
                } else if (bid < 16) {
                    const int pair = (bid - 8) * 8 + (threadIdx.x >> 6);
                    naive_s5_scan(P, INP(18), INP(19), INP(20), INP(21), INP(22), INP(23), INP(24), INP(25), W_YRW, W_YS5B, pair);
                }
            }
            SEAM(PH_SCAN1);
            if (IN(PH_FIN1)) { PHASE_BEGIN ph_fin1(W_OG, W_P, INP(29), W_YMIX); }
            SEAM(PH_FIN1);
            if (IN(PH_GLU1)) {
                PHASE_BEGIN
                const float* W = INP(26); const float* gb = INP(27); const bf16_t* YS5B = W_YS5B; const float* YRW = W_YRW; bf16_t* Ymix = W_YMIX;
                naive_gemm<false>(ldsf, T_, 512, 512, [&](int m) { return YS5B + (size_t)m * 512; }, [&](int, int) { return W; }, 512,
                                  [&](int m, int n, float a, float) { const float y = YRW[(size_t)m * 512 + n]; Ymix[(size_t)m * D_ + n] = f2bf(y * sigm(a + gb[n])); });
            }
            SEAM(PH_GLU1);
        }
    }
#undef IN
}
template <int PLO, int PHI>
__global__ void __launch_bounds__(NTHREADS, 2) mega(Args args) {
    extern __shared__ __attribute__((aligned(16))) unsigned char lds_raw[];
    mega_body<PLO, PHI>(lds_raw);
}

#include <utility>
template <int... I> static void set_attrs(std::integer_sequence<int, I...>) {
    (void)std::initializer_list<int>{ ((void)hipFuncSetAttribute((const void*)mega<I, I + 1>, hipFuncAttributeMaxDynamicSharedMemorySize, LDS_BYTES), 0)... };
}
template <int I> static int launch_one(int grid, hipStream_t stream, const Args& a) {
    hipLaunchKernelGGL((mega<I, I + 1>), dim3(grid), dim3(NTHREADS), LDS_BYTES, stream, a);
    return 0;
}
template <int... I> static void launch_all(std::integer_sequence<int, I...>, int grid, hipStream_t stream, const Args& a) {
    (void)std::initializer_list<int>{ launch_one<I>(grid, stream, a)... };
}
extern "C" void kernel_launch(void* const* d_in, const int* in_sizes, int n_in, void* d_out, int out_size, void* d_ws, size_t ws_size, hipStream_t stream) {
    static int grid = 0;
    if (grid == 0) {
        if (n_in != 42 || out_size != T_ * D_ || ws_size < WS_END) { fprintf(stderr, "kernel_launch: unexpected shapes n_in %d out %d ws %zu\n", n_in, out_size, ws_size); grid = -1; return; }
        int dev = 0, cus = 0, per_cu = 0;
        hipGetDevice(&dev);
        hipDeviceGetAttribute(&cus, hipDeviceAttributeMultiprocessorCount, dev);
        set_attrs(std::make_integer_sequence<int, PH_COUNT>{});
        hipFuncSetAttribute((const void*)mega<0, PH_COUNT>, hipFuncAttributeMaxDynamicSharedMemorySize, LDS_BYTES);
        hipOccupancyMaxActiveBlocksPerMultiprocessor(&per_cu, (const void*)mega<0, PH_COUNT>, NTHREADS, LDS_BYTES);
        (void)hipGetLastError();
        if (per_cu < 1) per_cu = 1;
        grid = cus * 1;
        fprintf(stderr, "kernel_launch: cus %d per_cu %d grid %d\n", cus, per_cu, grid);
    }
    if (grid < 0) return;
    hipMemsetAsync((char*)d_ws + WS_CTL, 0, CTL_ZERO_BYTES, stream);
    Args a{};
    for (int i = 0; i < 42; ++i) a.in[i] = (const float*)d_in[i];
    a.out = (float*)d_out; a.ws = (unsigned char*)d_ws;
#if MK_SINGLE
    void* kargs[] = {(void*)&a};
    hipError_t e = hipLaunchCooperativeKernel((const void*)mega<0, PH_COUNT>, dim3(grid), dim3(NTHREADS), kargs, LDS_BYTES, stream);
    if (e != hipSuccess) fprintf(stderr, "cooperative launch failed: %s (grid %d)\n", hipGetErrorString(e), grid);
#else
    launch_all(std::make_integer_sequence<int, PH_COUNT>{}, grid, stream, a);
#endif
}
#ifdef TEST_RANGES
template __global__ void mega<0, 5>(Args);
template __global__ void mega<5, 7>(Args);
template __global__ void mega<7, 13>(Args);
template __global__ void mega<13, 14>(Args);
template __global__ void mega<14, 17>(Args);
template __global__ void mega<13, 17>(Args);
template __global__ void mega<17, 23>(Args);
template __global__ void mega<0, 13>(Args);
#endif
```

```cpp
#include <hip/hip_runtime.h>
#include <cstdio>
#include <cstdint>

#define GAS __attribute__((address_space(1)))
#define LAS __attribute__((address_space(3)))
typedef unsigned short bf16_t;
typedef float f32x4 __attribute__((ext_vector_type(4)));
typedef unsigned u32x4 __attribute__((ext_vector_type(4)));
typedef unsigned u32x2 __attribute__((ext_vector_type(2)));
__device__ __forceinline__ int launder_tid() { int t = (int)threadIdx.x; asm volatile("" : "+v"(t)); return t; }
#define TIDX launder_tid()

#ifndef FAST_GEMM
#define FAST_GEMM 1
#endif
#ifndef MK_SINGLE
#define MK_SINGLE 1
#endif

constexpr int T_ = 16384, L_ = 8192, D_ = 1024;
constexpr int NIN0 = 3344, NIN0P = 3584, NIN1 = 2560;
constexpr int NLORA = 1536;
constexpr int RMAX = 40960;
constexpr int MOE_PAD = 256;
constexpr float DN_ALPHA = 1.41421356237f;
constexpr float LN_EPS = 1e-5f;
constexpr int NTHREADS = 512, NWAVES = 8;

constexpr size_t MiB = 1u << 20;
constexpr size_t WS_CTL = 0, CTL_ZERO_BYTES = 1 * MiB;
constexpr size_t WS_WIN0 = 2 * MiB;
constexpr size_t WS_WOUT0 = 9 * MiB;
constexpr size_t WS_WIN1 = 11 * MiB;
constexpr size_t WS_WOUT1 = 16 * MiB;
constexpr size_t WS_WGLU = 18 * MiB;
constexpr size_t WS_WLORA = 19 * MiB;
constexpr size_t WS_W13 = 20 * MiB;
constexpr size_t WS_W2 = 84 * MiB;
constexpr size_t WS_HB = 116 * MiB;
constexpr size_t WS_HA = 149 * MiB;
constexpr size_t WS_ROUTE = 213 * MiB;
constexpr size_t WS_BIG = 214 * MiB;
constexpr size_t WS_P = WS_BIG;
constexpr size_t WS_LO = WS_BIG + 112 * MiB;
constexpr size_t WS_SCAN = WS_BIG + 160 * MiB;
constexpr size_t WS_GLALA = WS_BIG + 256 * MiB;
constexpr size_t WS_BON = WS_BIG + 272 * MiB;
constexpr size_t WS_APRIME = WS_BIG + 273 * MiB;
constexpr size_t WS_YS5B = WS_BIG + 80 * MiB;
constexpr size_t WS_XR = WS_BIG;
constexpr size_t WS_HID = WS_BIG + 80 * MiB;
constexpr size_t WS_Y = WS_BIG + 120 * MiB;
constexpr size_t WS_END = 512 * MiB;
constexpr int CW_BAR = 4096;
constexpr int CW_CNT = 8192;

__device__ __forceinline__ float bf2f(bf16_t b) { return __uint_as_float(((unsigned)b) << 16); }
__device__ __forceinline__ bf16_t f2bf(float f) { unsigned u = __float_as_uint(f); u += 0x7fffu + ((u >> 16) & 1u); return (bf16_t)(u >> 16); }
__device__ __forceinline__ unsigned pk2(float lo, float hi) { return (unsigned)f2bf(lo) | ((unsigned)f2bf(hi) << 16); }
__device__ __forceinline__ float sigm(float x) { return 1.f / (1.f + __expf(-x)); }
__device__ __forceinline__ float siluf(float x) { return x * sigm(x); }
__device__ __forceinline__ float softplusf(float x) { return fmaxf(x, 0.f) + log1pf(__expf(-fabsf(x))); }
__device__ __forceinline__ float gelu_tanh(float x) { const float u = 0.7978845608028654f * (x + 0.044715f * x * x * x); return 0.5f * x * (1.f + tanhf(u)); }
__device__ __forceinline__ float wave_sum(float v) {
#pragma unroll
    for (int o = 1; o < 64; o <<= 1) v += __shfl_xor(v, o);
    return v;
}


namespace pg8 {
#define PG8_LAS __attribute__((address_space(3)))
typedef unsigned short bf16_t;
typedef short bf16x8 __attribute__((ext_vector_type(8)));
typedef float f32x4 __attribute__((ext_vector_type(4)));
typedef unsigned u32x4 __attribute__((ext_vector_type(4)));
constexpr int BM = 256, BK = 64, HALF = 128, HTB = HALF * BK * 2  , STAGE_BYTES = 8 * HTB, NXCD = 8, WGM = 8;

__host__ __device__ __forceinline__ int lds_byte(int r, int c) { const int st = (r >> 4) * 2 + (c >> 5), rr = r & 15, cc = c & 31, ob = rr * 64 + cc * 2; return st * 1024 + (ob ^ (((ob >> 9) & 1) << 5)); }
__host__ __device__ __forceinline__ void stage_rc(int b, int& R, int& C) { const int st = b / 1024, sb = b % 1024, swz = sb ^ (((sb >> 9) & 1) << 5); R = (st >> 1) * 16 + swz / 64; C = (st & 1) * 32 + (swz % 64) / 2; }
__host__ __device__ __forceinline__ int perm32(int rho) { const int n = rho >> 4, i = rho & 15; return 8 * (i >> 2) + 4 * n + (i & 3); }

struct Unit { int pm, pn, pb; };
struct Gemm { const bf16_t* A; const bf16_t* Bt; int M, N, K; };

struct StaticOrder {
    int nM, nN, nwg, G, c;
    __host__ __device__ void init(int M, int N, int G_, int c_) { nM = M / BM; nN = N / BM; nwg = nM * nN; G = G_; c = c_; }
    __host__ __device__ bool next(int i, Unit& u) const {
        const long L = (long)i * G + c; if (L >= nwg) return false;
        int wgid = (int)L; { const int q = nwg / NXCD, r = nwg % NXCD, xcd = wgid % NXCD, off = wgid / NXCD; wgid = (xcd < r ? xcd * (q + 1) : r * (q + 1) + (xcd - r) * q) + off; }
        const int nig = WGM * nN, gid = wgid / nig, fm = gid * WGM, gsz = (nM - fm) < WGM ? (nM - fm) : WGM;
        u.pm = fm + ((wgid % nig) % gsz); u.pn = (wgid % nig) / gsz; u.pb = u.pn; return true;
    }
    __device__ __forceinline__ void a_ready(const Unit&) const {}
    __device__ __forceinline__ void done(const Unit&) const {}
};

__device__ __forceinline__ unsigned cvt_pk_bf16(float lo, float hi) { unsigned r; asm volatile("v_cvt_pk_bf16_f32 %0, %1, %2" : "=v"(r) : "v"(lo), "v"(hi)); return r; }
typedef float f32x2 __attribute__((ext_vector_type(2)));

template <class Epi, class Sched, bool ALIGN_EPI = false, bool SP2 = false>
__device__ __forceinline__ void gemm_phase(PG8_LAS unsigned char* lds, const Gemm g, const Sched& S, const Epi& E) {
    const int tid = TIDX, wid = __builtin_amdgcn_readfirstlane(tid >> 6), lane = tid & 63, wr = wid >> 2, wc = wid & 3, fr = lane & 15, fq = lane >> 4;
    const int K = g.K, nt = K / BK;
    unsigned voffA[2], voffB[2];
#pragma unroll
    for (int i = 0; i < 2; ++i) { int R, C; stage_rc(tid * 16 + i * 8192, R, C); const int Rb = Epi::PERM ? ((R & ~31) + perm32(R & 31)) : R;
        voffA[i] = (unsigned)(R * K + C) * 2u; voffB[i] = (unsigned)(Rb * K + C) * 2u; }
    const size_t kstep = (size_t)(BK * 2);
    const size_t hstep = (size_t)HALF * K * 2;
    const size_t tstep = 2 * hstep;
    const unsigned ldsw = (unsigned)wid * 1024u;
    const int aoff = lds_byte(wr * 64 + fr, fq * 8), boff = lds_byte(wc * 32 + fr, fq * 8);
#define PG8_SA(b, h) (((b) * 2 + (h)) * HTB)
#define PG8_SB(b, h) ((4 + (b) * 2 + (h)) * HTB)
#define PG8_STAGE(bufoff, gbase, voff) do { _Pragma("unroll") for (int _i = 0; _i < 2; ++_i) \
        __builtin_amdgcn_global_load_lds((const unsigned*)((const char*)(gbase) + (voff)[_i]), (PG8_LAS unsigned*)(lds + (bufoff) + ldsw + _i * 8192), 16, 0, 0); } while (0)
#define PG8_LDA(dst, b, h) do { _Pragma("unroll") for (int m = 0; m < 4; ++m) _Pragma("unroll") for (int k = 0; k < 2; ++k) dst[m][k] = *(const PG8_LAS bf16x8*)(lds + PG8_SA(b, h) + aoff + m * 2048 + k * 1024); } while (0)
#define PG8_LDB(dst, b, h) do { _Pragma("unroll") for (int n = 0; n < 2; ++n) _Pragma("unroll") for (int k = 0; k < 2; ++k) dst[n][k] = *(const PG8_LAS bf16x8*)(lds + PG8_SB(b, h) + boff + n * 2048 + k * 1024); } while (0)
#define PG8_MMA(ai, bj, At, Bt) do { __builtin_amdgcn_s_setprio(1); _Pragma("unroll") for (int m = 0; m < 4; ++m) _Pragma("unroll") for (int n = 0; n < 2; ++n) _Pragma("unroll") for (int k = 0; k < 2; ++k) \
        acc[ai][bj][m][n] = __builtin_amdgcn_mfma_f32_16x16x32_bf16(Bt[n][k], At[m][k], acc[ai][bj][m][n], 0, 0, 0); __builtin_amdgcn_s_setprio(0); } while (0)
#define PG8_WAIT_V(n) asm volatile("s_waitcnt vmcnt(" #n ")" ::: "memory")
#define PG8_WAIT_L(n) asm volatile("s_waitcnt lgkmcnt(" #n ")" ::: "memory")
#define PG8_BAR __builtin_amdgcn_s_barrier()
#define PG8_SCHED __builtin_amdgcn_sched_barrier(0)
    Unit cur, nxt; int ui = 0;
    if (!S.next(0, cur)) return;
    f32x4 acc[2][2][4][2];
#pragma unroll
    for (int a = 0; a < 2; ++a)
#pragma unroll
        for (int b = 0; b < 2; ++b)
#pragma unroll
            for (int m = 0; m < 4; ++m)
#pragma unroll
                for (int n = 0; n < 2; ++n) acc[a][b][m][n] = (f32x4){0.f, 0.f, 0.f, 0.f};
    bf16x8 At[4][2], B0[2][2], B1[2][2];
    const char* cA = (const char*)g.A + (size_t)cur.pm * tstep; const char* cB = (const char*)g.Bt + (size_t)cur.pb * tstep;
    S.a_ready(cur);
    if constexpr (SP2) {
        PG8_STAGE(PG8_SB(0, 0), cB, voffB); PG8_STAGE(PG8_SB(0, 1), cB + hstep, voffB); PG8_STAGE(PG8_SA(0, 0), cA, voffA); PG8_STAGE(PG8_SA(0, 1), cA + hstep, voffA);
        if (wr == 1) PG8_BAR;
        PG8_WAIT_V(2); PG8_BAR;
        PG8_STAGE(PG8_SB(1, 0), cB + kstep, voffB); PG8_STAGE(PG8_SA(1, 0), cA + kstep, voffA); PG8_STAGE(PG8_SB(1, 1), cB + hstep + kstep, voffB);
        PG8_WAIT_V(6); PG8_BAR;
    } else {
        PG8_STAGE(PG8_SB(0, 0), cB, voffB); PG8_STAGE(PG8_SA(0, 0), cA, voffA); PG8_STAGE(PG8_SB(0, 1), cB + hstep, voffB); PG8_STAGE(PG8_SA(0, 1), cA + hstep, voffA);
        if (wr == 1) PG8_BAR;
        PG8_WAIT_V(4); PG8_BAR;
        PG8_STAGE(PG8_SB(1, 0), cB + kstep, voffB); PG8_STAGE(PG8_SA(1, 0), cA + kstep, voffA); PG8_STAGE(PG8_SB(1, 1), cB + hstep + kstep, voffB);
        PG8_WAIT_V(6); PG8_BAR;
    }
    for (;;) {
        const bool has_next = S.next(ui + 1, nxt);
        const char* nA = has_next ? (const char*)g.A + (size_t)nxt.pm * tstep : cA; const char* nB = has_next ? (const char*)g.Bt + (size_t)nxt.pb * tstep : cB;
        for (int t = 0; t < nt; t += 2) {
            const bool last = (t == nt - 2);
            const char* a1 = cA + (size_t)(t + 1) * kstep;
            const char* a2 = last ? nA : cA + (size_t)(t + 2) * kstep; const char* b2 = last ? nB : cB + (size_t)(t + 2) * kstep;
            const char* a3 = a2 + kstep; const char* b3 = b2 + kstep;
            if (last && has_next) S.a_ready(nxt);
            if constexpr (SP2) {
            PG8_LDB(B0, 0, 0); PG8_LDB(B1, 0, 1); PG8_SCHED; PG8_LDA(At, 0, 0); PG8_STAGE(PG8_SA(1, 1), a1 + hstep, voffA);
            PG8_WAIT_V(8); PG8_WAIT_L(0); PG8_BAR; PG8_MMA(0, 0, At, B0); PG8_MMA(0, 1, At, B1); PG8_BAR; PG8_SCHED;
            PG8_LDA(At, 0, 1); PG8_STAGE(PG8_SB(0, 0), b2, voffB); PG8_STAGE(PG8_SB(0, 1), b2 + hstep, voffB); PG8_STAGE(PG8_SA(0, 0), a2, voffA);
            PG8_WAIT_V(8); PG8_WAIT_L(0); PG8_BAR; PG8_MMA(1, 0, At, B0); PG8_MMA(1, 1, At, B1); PG8_BAR; PG8_SCHED;
            PG8_LDB(B0, 1, 0); PG8_LDB(B1, 1, 1); PG8_SCHED; PG8_LDA(At, 1, 0); PG8_STAGE(PG8_SA(0, 1), a2 + hstep, voffA);
            PG8_WAIT_V(8); PG8_WAIT_L(0); PG8_BAR; PG8_MMA(0, 0, At, B0); PG8_MMA(0, 1, At, B1); PG8_BAR; PG8_SCHED;
            PG8_LDA(At, 1, 1); PG8_STAGE(PG8_SB(1, 0), b3, voffB); PG8_STAGE(PG8_SB(1, 1), b3 + hstep, voffB); PG8_STAGE(PG8_SA(1, 0), a3, voffA);
            PG8_WAIT_V(8); PG8_WAIT_L(0); PG8_BAR; PG8_MMA(1, 0, At, B0); PG8_MMA(1, 1, At, B1); PG8_BAR; PG8_SCHED;
            } else {
            PG8_LDB(B0, 0, 0); PG8_SCHED; PG8_LDA(At, 0, 0); PG8_STAGE(PG8_SA(1, 1), a1 + hstep, voffA);
            PG8_WAIT_L(8); PG8_BAR; PG8_WAIT_L(0); PG8_MMA(0, 0, At, B0); PG8_BAR; PG8_SCHED;
            PG8_LDB(B1, 0, 1); PG8_STAGE(PG8_SB(0, 0), b2, voffB);
            PG8_BAR; PG8_WAIT_L(0); PG8_MMA(0, 1, At, B1); PG8_BAR;
            PG8_LDA(At, 0, 1); PG8_STAGE(PG8_SA(0, 0), a2, voffA);
            PG8_BAR; PG8_WAIT_L(0); PG8_MMA(1, 0, At, B0); PG8_BAR; PG8_SCHED;
            PG8_STAGE(PG8_SB(0, 1), b2 + hstep, voffB);
            PG8_WAIT_V(6); PG8_BAR; PG8_MMA(1, 1, At, B1); PG8_BAR;
            PG8_LDB(B0, 1, 0); PG8_SCHED; PG8_LDA(At, 1, 0); PG8_STAGE(PG8_SA(0, 1), a2 + hstep, voffA);
            PG8_WAIT_L(8); PG8_BAR; PG8_WAIT_L(0); PG8_MMA(0, 0, At, B0); PG8_BAR; PG8_SCHED;
            PG8_LDB(B1, 1, 1); PG8_STAGE(PG8_SB(1, 0), b3, voffB);
            PG8_BAR; PG8_WAIT_L(0); PG8_MMA(0, 1, At, B1); PG8_BAR;
            PG8_LDA(At, 1, 1); PG8_STAGE(PG8_SA(1, 0), a3, voffA);
            PG8_BAR; PG8_WAIT_L(0); PG8_MMA(1, 0, At, B0); PG8_BAR; PG8_SCHED;
            PG8_STAGE(PG8_SB(1, 1), b3 + hstep, voffB);
            PG8_WAIT_V(6); PG8_BAR; PG8_MMA(1, 1, At, B1); PG8_BAR;
            }
        }
        if constexpr (ALIGN_EPI) { if (wr == 0) PG8_BAR; }
        if constexpr (!Epi::AFTER_DRAIN) { E(acc, cur, wr, wc, fr, fq); S.done(cur); }
        if (!has_next) break;
#pragma unroll
        for (int a = 0; a < 2; ++a)
#pragma unroll
            for (int b = 0; b < 2; ++b)
#pragma unroll
                for (int m = 0; m < 4; ++m)
#pragma unroll
                    for (int n = 0; n < 2; ++n) acc[a][b][m][n] = (f32x4){0.f, 0.f, 0.f, 0.f};
        cur = nxt; cA = nA; cB = nB; ++ui;
        if constexpr (ALIGN_EPI) { if (wr == 1) PG8_BAR; }
    }
    PG8_WAIT_V(0);
    if constexpr (!ALIGN_EPI) { if (wr == 0) PG8_BAR; }
    PG8_BAR;
    if constexpr (Epi::AFTER_DRAIN) { E.fused(acc, cur, wr, wc, fr, fq, lds, wid, lane); S.done(cur); }
#undef PG8_SA
#undef PG8_SB
#undef PG8_STAGE
#undef PG8_LDA
#undef PG8_LDB
#undef PG8_MMA
#undef PG8_WAIT_V
#undef PG8_WAIT_L
#undef PG8_BAR
#undef PG8_SCHED
}

struct EpiStoreBf16 {
    static constexpr bool PERM = true, AFTER_DRAIN = false;
    bf16_t* O; int ldc;
    __device__ __forceinline__ void operator()(const f32x4 (&acc)[2][2][4][2], const Unit& u, int wr, int wc, int fr, int fq) const {
        const int row0 = u.pm * BM + wr * 64 + fr, col0 = u.pn * BM + wc * 32 + 8 * fq;
#pragma unroll
        for (int ai = 0; ai < 2; ++ai)
#pragma unroll
            for (int m = 0; m < 4; ++m) { bf16_t* rowp = O + (size_t)(row0 + ai * HALF + m * 16) * ldc + col0;
#pragma unroll
                for (int bj = 0; bj < 2; ++bj) { const f32x4 v0 = acc[ai][bj][m][0], v1 = acc[ai][bj][m][1];
                    u32x4 w; w.x = cvt_pk_bf16(v0[0], v0[1]); w.y = cvt_pk_bf16(v0[2], v0[3]); w.z = cvt_pk_bf16(v1[0], v1[1]); w.w = cvt_pk_bf16(v1[2], v1[3]);
                    *(u32x4*)(rowp + bj * HALF) = w; } }
    }
};
struct EpiResidF32 {
    static constexpr bool PERM = false, AFTER_DRAIN = false;
    const float* resid; float* out; int ldc; float alpha;
    __device__ __forceinline__ void operator()(const f32x4 (&acc)[2][2][4][2], const Unit& u, int wr, int wc, int fr, int fq) const {
        const int row0 = u.pm * BM + wr * 64 + fr, col0 = u.pn * BM + wc * 32 + 4 * fq;
#pragma unroll
        for (int ai = 0; ai < 2; ++ai)
#pragma unroll
            for (int m = 0; m < 4; ++m) { const size_t off = (size_t)(row0 + ai * HALF + m * 16) * ldc + col0;
#pragma unroll
                for (int bj = 0; bj < 2; ++bj)
#pragma unroll
                    for (int n = 0; n < 2; ++n) { const size_t o = off + bj * HALF + n * 16; *(f32x4*)(out + o) = *(const f32x4*)(resid + o) * alpha + acc[ai][bj][m][n]; } }
    }
};
__device__ __forceinline__ float fast_sigm(float x) { return __builtin_amdgcn_rcpf(1.f + __expf(-x)); }
struct EpiSwiglu {
    static constexpr bool PERM = true, AFTER_DRAIN = false;
    bf16_t* HID;
    __device__ __forceinline__ void operator()(const f32x4 (&acc)[2][2][4][2], const Unit& u, int wr, int wc, int fr, int fq) const {
        const int row0 = u.pm * BM + wr * 64 + fr, h0 = u.pn * 128 + wc * 16 + 4 * fq;
#pragma unroll
        for (int ai = 0; ai < 2; ++ai)
#pragma unroll
            for (int m = 0; m < 4; ++m) { bf16_t* rowp = HID + (size_t)(row0 + ai * HALF + m * 16) * 512 + h0;
#pragma unroll
                for (int bj = 0; bj < 2; ++bj) { const f32x4 a = acc[ai][bj][m][0], b = acc[ai][bj][m][1]; f32x4 h;
#pragma unroll
                    for (int j = 0; j < 4; ++j) h[j] = a[j] * fast_sigm(a[j]) * b[j];
                    typedef unsigned u32x2v __attribute__((ext_vector_type(2)));
                    u32x2v w; w.x = cvt_pk_bf16(h[0], h[1]); w.y = cvt_pk_bf16(h[2], h[3]);
                    *(u32x2v*)(rowp + bj * 64) = w; } }
    }
};
struct EpiGlu {
    static constexpr bool PERM = true, AFTER_DRAIN = false;
    const float* ysrc; int ldy; const float* bias; bf16_t* O; int ldc;
    __device__ __forceinline__ void operator()(const f32x4 (&acc)[2][2][4][2], const Unit& u, int wr, int wc, int fr, int fq) const {
        const int row0 = u.pm * BM + wr * 64 + fr, col0 = u.pn * BM + wc * 32 + 8 * fq;
#pragma unroll
        for (int ai = 0; ai < 2; ++ai)
#pragma unroll
            for (int m = 0; m < 4; ++m) { const int row = row0 + ai * HALF + m * 16;
#pragma unroll
                for (int bj = 0; bj < 2; ++bj) { const int col = col0 + bj * HALF;
                    const f32x4 y0 = *(const f32x4*)(ysrc + (size_t)row * ldy + col), y1 = *(const f32x4*)(ysrc + (size_t)row * ldy + col + 4);
                    const f32x4 b0 = *(const f32x4*)(bias + col), b1 = *(const f32x4*)(bias + col + 4);
                    f32x4 v0 = acc[ai][bj][m][0] + b0, v1 = acc[ai][bj][m][1] + b1;
#pragma unroll
                    for (int j = 0; j < 4; ++j) { v0[j] = y0[j] * fast_sigm(v0[j]); v1[j] = y1[j] * fast_sigm(v1[j]); }
                    u32x4 w; w.x = cvt_pk_bf16(v0[0], v0[1]); w.y = cvt_pk_bf16(v0[2], v0[3]); w.z = cvt_pk_bf16(v1[0], v1[1]); w.w = cvt_pk_bf16(v1[2], v1[3]);
                    *(u32x4*)(O + (size_t)row * ldc + col) = w; } }
    }
};
struct MoeOrder {
    int ntiles, nN, G, c; const PG8_LAS int* tile_e;
    __device__ __forceinline__ bool next(int i, Unit& u) const {
        const int L = i * G + c; if (L >= ntiles * nN) return false;
        u.pm = L / nN; u.pn = L % nN; u.pb = tile_e[u.pm] * nN + u.pn; return true;
    }
    __device__ __forceinline__ void a_ready(const Unit&) const {}
    __device__ __forceinline__ void done(const Unit&) const {}
};
}

#define XB_TMO      128
#define XB_XCNT(j)  (256  + 64 * (j))
#define XB_XSUB(j)  (1280 + 64 * (j))
#define XB_XGEN(j)  (2304 + 64 * (j))
#define XB_TOP      3328
#define XB_TOPGEN   3392
#define XCD_BAR_WORDS 3456
#define XB_SPIN_CAP (1u << 18)
__device__ __forceinline__ unsigned xb_ld(unsigned* p)              { return __hip_atomic_load(p, __ATOMIC_RELAXED, __HIP_MEMORY_SCOPE_AGENT); }
__device__ __forceinline__ unsigned xb_add(unsigned* p, unsigned v) { return __hip_atomic_fetch_add(p, v, __ATOMIC_RELAXED, __HIP_MEMORY_SCOPE_AGENT); }
__device__ __forceinline__ unsigned xb_xcc_id() { return (unsigned)__builtin_amdgcn_s_getreg((3 << 11) | 20) & 0xFu; }
#define XB_SPIN(cond, bar) do { unsigned _sp = 0; while (cond) { __builtin_amdgcn_s_sleep(1); \
    if ((++_sp & 255u) == 0u) { if (xb_ld(&(bar)[XB_TMO])) break; if (_sp > XB_SPIN_CAP) { atomicAdd(&(bar)[XB_TMO], 1u); break; } } } } while (0)
struct XcdBarrier { unsigned* bar; unsigned x; volatile LAS unsigned* st; };
__device__ __forceinline__ XcdBarrier xcd_barrier_post(unsigned* bar, volatile LAS unsigned* st) {
    XcdBarrier b; b.bar = bar; b.x = xb_xcc_id(); b.st = st;
    if (TIDX == 0) (void)xb_add(&bar[XB_XCNT(b.x)], 1u);
    return b;
}
__device__ __forceinline__ void xcd_barrier_complete(unsigned* bar, unsigned x, unsigned& nloc, unsigned& nx) {
    const unsigned G = gridDim.x;
    unsigned sum, cnt, mine, sp = 0u;
    for (;;) {
        sum = 0u; cnt = 0u; mine = 0u;
#pragma unroll
        for (unsigned j = 0; j < 16; ++j) { const unsigned c = xb_ld(&bar[XB_XCNT(j)]); sum += c; cnt += (c > 0u) ? 1u : 0u; mine = (j == x) ? c : mine; }
        if (sum == G) break;
        __builtin_amdgcn_s_sleep(1);
        if ((++sp & 255u) == 0u) { if (xb_ld(&bar[XB_TMO])) break; if (sp > XB_SPIN_CAP) { atomicAdd(&bar[XB_TMO], 1u); break; } }
    }
    nloc = mine > 0u ? mine : 1u; nx = cnt > 0u ? cnt : 1u;
}
__device__ __forceinline__ void xcd_barrier(const XcdBarrier& b) {
    asm volatile("s_waitcnt vmcnt(0)" ::: "memory");
    __syncthreads();
    if (TIDX == 0) {
        unsigned* bar = b.bar;
        __builtin_amdgcn_s_waitcnt(0);
        unsigned nloc = b.st[0], nx = b.st[1];
        if (nloc == 0u) { xcd_barrier_complete(bar, b.x, nloc, nx); b.st[0] = nloc; b.st[1] = nx; }
        const unsigned old = xb_add(&bar[XB_XSUB(b.x)], 1u);
        const unsigned gen = old / nloc;
        if (old + 1u == (gen + 1u) * nloc) {
            __builtin_amdgcn_fence(__ATOMIC_RELEASE, "agent");
            asm volatile("s_waitcnt vmcnt(0)" ::: "memory");
            const unsigned og = xb_add(&bar[XB_TOP], 1u);
            const unsigned tg = og / nx;
            if (og + 1u == (tg + 1u) * nx) xb_add(&bar[XB_TOPGEN], 1u);
            else XB_SPIN(xb_ld(&bar[XB_TOPGEN]) == tg, bar);
            __builtin_amdgcn_fence(__ATOMIC_ACQUIRE, "agent");
            xb_add(&bar[XB_XGEN(b.x)], 1u);
            asm volatile("s_waitcnt vmcnt(0)" ::: "memory");
        } else {
            XB_SPIN(xb_ld(&bar[XB_XGEN(b.x)]) == gen, bar);
            __builtin_amdgcn_fence(__ATOMIC_ACQUIRE, "agent");
            asm volatile("s_waitcnt vmcnt(0)" ::: "memory");
        }
    }
    __syncthreads();
}

struct Args {
    const float* in[42];
    float* out;
    unsigned char* ws;
    int ph_lo, ph_hi;
};

template <bool DUAL, class AF, class WF, class EF>
__device__ __forceinline__ void naive_gemm(LAS float* lds, int M, int N, int K, AF arow, WF wbase, int ldw, EF epi) {
    LAS float* As = lds;
    LAS float* Bs = lds + 64 * 33;
    LAS float* Bs2 = Bs + 32 * 64;
    const int tid = TIDX, ty = tid >> 4, tx = tid & 15;
    const int tm = (M + 63) / 64, tn = (N + 63) / 64;
    for (int tile = blockIdx.x; tile < tm * tn; tile += gridDim.x) {
        const int m0 = (tile / tn) * 64, n0 = (tile % tn) * 64;
        const float* W = wbase(m0, 0);
        const float* W2 = DUAL ? wbase(m0, 1) : W;
        float acc[2][4], acc2[2][4];
#pragma unroll
        for (int i = 0; i < 2; ++i)
#pragma unroll
            for (int j = 0; j < 4; ++j) { acc[i][j] = 0.f; acc2[i][j] = 0.f; }
        for (int k0 = 0; k0 < K; k0 += 32) {
#pragma unroll
            for (int i = 0; i < 4; ++i) {
                const int idx = tid + i * 512, r = idx >> 5, kk = idx & 31, m = m0 + r;
                As[r * 33 + kk] = (m < M) ? bf2f(arow(m)[k0 + kk]) : 0.f;
            }
#pragma unroll
            for (int i = 0; i < 4; ++i) {
                const int idx = tid + i * 512, kk = idx >> 6, n = idx & 63;
                const bool ok = (n0 + n) < N;
                Bs[kk * 64 + n] = ok ? W[(size_t)(k0 + kk) * ldw + n0 + n] : 0.f;
                if (DUAL) Bs2[kk * 64 + n] = ok ? W2[(size_t)(k0 + kk) * ldw + n0 + n] : 0.f;
            }
            __syncthreads();
#pragma unroll 8
            for (int kk = 0; kk < 32; ++kk) {
                const float a0 = As[(ty * 2) * 33 + kk], a1 = As[(ty * 2 + 1) * 33 + kk];
#pragma unroll
                for (int j = 0; j < 4; ++j) {
                    const float b = Bs[kk * 64 + tx * 4 + j];
                    acc[0][j] += a0 * b; acc[1][j] += a1 * b;
                    if (DUAL) { const float b2 = Bs2[kk * 64 + tx * 4 + j]; acc2[0][j] += a0 * b2; acc2[1][j] += a1 * b2; }
                }
            }
            __syncthreads();
        }
#pragma unroll
        for (int i = 0; i < 2; ++i)
#pragma unroll
            for (int j = 0; j < 4; ++j) {
                const int m = m0 + ty * 2 + i, n = n0 + tx * 4 + j;
                if (m < M && n < N) epi(m, n, acc[i][j], acc2[i][j]);
            }
    }
}

template <class SRC, class DROW>
__device__ __forceinline__ void xpose_item(SRC src, DROW drow, bf16_t* WT, int ldk, LAS float* scr, int k0, int n0, int lane) {
#pragma unroll 8
    for (int i = 0; i < 32; ++i) { const int kk = 2 * i + (lane >> 5); scr[kk * 33 + (lane & 31)] = src(k0 + kk, n0 + (lane & 31)); }
    asm volatile("s_waitcnt lgkmcnt(0)" ::: "memory");
    const int c = lane & 7;
#pragma unroll
    for (int j = 0; j < 4; ++j) {
        const int n = (lane >> 3) + 8 * j; const LAS float* sp = scr + (8 * c) * 33 + n;
        u32x4 o; o.x = pk2(sp[0 * 33], sp[1 * 33]); o.y = pk2(sp[2 * 33], sp[3 * 33]); o.z = pk2(sp[4 * 33], sp[5 * 33]); o.w = pk2(sp[6 * 33], sp[7 * 33]);
        *(u32x4*)(WT + (size_t)drow(n0 + n) * ldk + k0 + 8 * c) = o;
    }
    asm volatile("s_waitcnt lgkmcnt(0)" ::: "memory");
}
__device__ __forceinline__ void convert_plain(const float* W, int K, int N, int NP, bf16_t* WT, LAS float* scr, int gw, int ngw, int lane) {
    const int nblk = NP / 32, nitems = (K / 64) * nblk;
    for (int it = gw; it < nitems; it += ngw) {
        const int k0 = 64 * (it / nblk), n0 = 32 * (it % nblk);
        xpose_item([&](int k, int n) { return n < N ? W[(size_t)k * N + n] : 0.f; }, [&](int n) { return n; }, WT, K, scr, k0, n0, lane);
    }
}
__device__ __forceinline__ void convert_lora(const float* w2, const float* a2, const float* g2, bf16_t* WT, LAS float* scr, int gw, int ngw, int lane) {
    const int nblk = NLORA / 32, nitems = 4 * nblk;
    for (int it = gw; it < nitems; it += ngw) {
        const int k0 = 64 * (it / nblk), n0 = 32 * (it % nblk);
        xpose_item([&](int k, int n) {
            if (n < 512) return k < 64 ? w2[k * 512 + n] : 0.f;
            if (n < 1024) return (k >= 64 && k < 128) ? a2[(k - 64) * 512 + (n - 512)] : 0.f;
            return k >= 128 ? g2[(k - 128) * 512 + (n - 1024)] : 0.f; }, [&](int n) { return n; }, WT, 256, scr, k0, n0, lane);
    }
}
__device__ __forceinline__ void convert_moe(const float* w1, const float* w3, const float* w2, bf16_t* W13, bf16_t* W2T, LAS float* scr, int gw, int ngw, int lane) {
    constexpr int I13 = 16 * 32, I2 = 8 * 32, IE = I13 + I2;
    for (int it = gw; it < 32 * IE; it += ngw) {
        const int e = it / IE, r = it % IE;
        if (r < I13) {
            const int k0 = 64 * (r / 32), n0 = 32 * (r % 32);
            const float* a = w1 + (size_t)e * D_ * 512; const float* b = w3 + (size_t)e * D_ * 512;
            xpose_item([&](int k, int n) { return n < 512 ? a[(size_t)k * 512 + n] : b[(size_t)k * 512 + (n - 512)]; },
                       [&](int n) { const int c = n & 511; return (c >> 2) * 8 + (n >> 9) * 4 + (c & 3); }, W13 + (size_t)e * 1024 * 1024, 1024, scr, k0, n0, lane);
        } else {
            const int rr = r - I13, k0 = 64 * (rr / 32), n0 = 32 * (rr % 32);
            const float* a = w2 + (size_t)e * 512 * D_;
            xpose_item([&](int k, int n) { return a[(size_t)k * D_ + n]; }, [&](int n) { return n; }, W2T + (size_t)e * 1024 * 512, 512, scr, k0, n0, lane);
        }
    }
}

__device__ __forceinline__ void ph_prologue(const float* x, bf16_t* hb) {
    const size_t n4 = (size_t)T_ * D_ / 4;
    for (size_t i = (size_t)blockIdx.x * NTHREADS + TIDX; i < n4; i += (size_t)gridDim.x * NTHREADS) {
        const f32x4 v = ((const f32x4*)x)[i];
        u32x2 o; o.x = pk2(v.x, v.y); o.y = pk2(v.z, v.w);
        ((u32x2*)hb)[i] = o;
    }
    for (size_t i = (size_t)blockIdx.x * NTHREADS + TIDX; i < (size_t)256 * D_ / 2; i += (size_t)gridDim.x * NTHREADS)
        ((unsigned*)(hb + (size_t)T_ * D_))[i] = 0u;
}

__device__ __forceinline__ float p0_shift(const bf16_t* P, const float* mu, int t, int c) {
    const float p = bf2f(P[(size_t)t * NIN0P + c]);
    const float pv = ((t & (L_ - 1)) == 0) ? 0.f : bf2f(P[(size_t)(t - 1) * NIN0P + c]);
    return p + mu[c] * (pv - p);
}
__device__ __forceinline__ void ph_prepA0(const bf16_t* P, const float* mu, const float* gk_w2, const float* gk_b, bf16_t* Ap, float* gla_la) {
    for (int chunk = blockIdx.x; chunk < T_ / 64; chunk += gridDim.x) {
        for (int idx = TIDX; idx < 64 * 256; idx += NTHREADS) {
            const int tl = idx >> 8, j = idx & 255, t = chunk * 64 + tl;
            float v;
            if (j < 64) v = tanhf(p0_shift(P, mu, t, 512 + j));
            else if (j < 128) v = p0_shift(P, mu, t, 1600 + (j - 64));
            else v = sigm(p0_shift(P, mu, t, 1664 + (j - 128)));
            Ap[(size_t)t * 256 + j] = f2bf(v);
            float gk = gk_b[j];
#pragma unroll
            for (int i = 0; i < 16; ++i) gk += bf2f(P[(size_t)t * NIN0P + 2816 + i]) * gk_w2[i * 256 + j];
            const float ls = fminf(gk, 0.f) - log1pf(__expf(-fabsf(gk)));
            gla_la[(size_t)t * 256 + j] = ls * (1.f / 16.f);
        }
    }
}

__device__ __forceinline__ void ph_prepB0(const bf16_t* P, const bf16_t* LO, const float* mu, const float* w0, const float* a0, const float* k_k, const float* k_a,
                                          const float* r_k, bf16_t* SC, float* BON) {
    const int wave = TIDX >> 6, lane = TIDX & 63;
    for (int item = blockIdx.x * NWAVES + wave; item < T_ * 8; item += gridDim.x * NWAVES) {
        const int t = item >> 3, h = item & 7, c = h * 64 + lane;
        const float r = p0_shift(P, mu, t, c), k = p0_shift(P, mu, t, 576 + c), v = p0_shift(P, mu, t, 1088 + c);
        const float low = bf2f(LO[(size_t)t * NLORA + c]), loa = bf2f(LO[(size_t)t * NLORA + 512 + c]);
        const float xw = w0[c] + low;
        const float wraw = -softplusf(-xw) - 0.5f;
        const float ld = -__expf(wraw);
        const float a = sigm(a0[c] + loa);
        const float kkr = k * k_k[c];
        const float ss = wave_sum(kkr * kkr);
        const float kk = kkr / fmaxf(sqrtf(ss), 1e-12f);
        const float kp = k * (1.f + (a - 1.f) * k_a[c]);
        const float bon = wave_sum(r * kp * r_k[c]);
        const size_t o = (size_t)t * 512 + c, S1 = (size_t)T_ * 512;
        SC[o] = f2bf(r); SC[S1 + o] = f2bf(ld); SC[2 * S1 + o] = f2bf(kp); SC[3 * S1 + o] = f2bf(v); SC[4 * S1 + o] = f2bf(kk); SC[5 * S1 + o] = f2bf(a);
        if (lane == 0) BON[(size_t)t * 8 + h] = bon;
    }
}

__device__ __forceinline__ void naive_rwkv_scan(LAS float* lds, const bf16_t* SC, float* YRW, int bh) {
    constexpr int TS = 32;
    const int b = bh >> 3, h = bh & 7;
    LAS float* Lnkk = lds;
    LAS float* Ldec = lds + TS * 64;
    LAS float* Lab = lds + 2 * TS * 64;
    LAS float* Lkp = lds + 3 * TS * 64;
    LAS float* Lr = lds + 4 * TS * 64;
    LAS float* Lv = lds + 5 * TS * 64;
    const size_t S1 = (size_t)T_ * 512;
    float S[64];
#pragma unroll
    for (int k = 0; k < 64; ++k) S[k] = 0.f;
    const int lane = TIDX & 63, wave = TIDX >> 6;
    for (int t0 = 0; t0 < L_; t0 += TS) {
        for (int idx = TIDX; idx < TS * 64; idx += NTHREADS) {
            const int s = idx >> 6, k = idx & 63;
            const size_t o = (size_t)(b * L_ + t0 + s) * 512 + h * 64 + k;
            const float r = bf2f(SC[o]), ld = bf2f(SC[S1 + o]), kp = bf2f(SC[2 * S1 + o]), v = bf2f(SC[3 * S1 + o]), kk = bf2f(SC[4 * S1 + o]), a = bf2f(SC[5 * S1 + o]);
            Lnkk[idx] = -kk; Ldec[idx] = __expf(ld); Lab[idx] = kk * a; Lkp[idx] = kp; Lr[idx] = r; Lv[idx] = v;
        }
        __syncthreads();
        if (wave == 0) {
            for (int s = 0; s < TS; ++s) {
                float sa = 0.f;
#pragma unroll
                for (int k = 0; k < 64; ++k) sa += S[k] * Lnkk[s * 64 + k];
                const float vv = Lv[s * 64 + lane];
                float y = 0.f;
#pragma unroll
                for (int k = 0; k < 64; ++k) {
                    S[k] = S[k] * Ldec[s * 64 + k] + sa * Lab[s * 64 + k] + vv * Lkp[s * 64 + k];
                    y += S[k] * Lr[s * 64 + k];
                }
                YRW[(size_t)(b * L_ + t0 + s) * 512 + h * 64 + lane] = y;
            }
        }
        __syncthreads();
    }
}

template <int K, class LDF, class LVF>
__device__ __forceinline__ void naive_gla_scan(LAS float* lds, LDF ld, LVF lv, float* OG, int b, int h) {
    constexpr int TS = 16;
    LAS float* Lq = lds;
    LAS float* Lk = lds + TS * K;
    LAS float* Le = lds + 2 * TS * K;
    LAS float* Lv = lds + 3 * TS * K;
    float S[K];
#pragma unroll
    for (int k = 0; k < K; ++k) S[k] = 0.f;
    const int tid = TIDX;
    for (int t0 = 0; t0 < L_; t0 += TS) {
        for (int idx = tid; idx < TS * K; idx += NTHREADS) {
            const int s = idx / K, k = idx % K;
            float q, kk, e; ld(b * L_ + t0 + s, h * K + k, q, kk, e);
            Lq[idx] = q; Lk[idx] = kk; Le[idx] = e;
        }
        for (int idx = tid; idx < TS * 128; idx += NTHREADS) {
            const int s = idx >> 7, vc = idx & 127;
            Lv[idx] = lv(b * L_ + t0 + s, h * 128 + vc);
        }
        __syncthreads();
        if (tid < 128) {
            for (int s = 0; s < TS; ++s) {
                const float vv = Lv[s * 128 + tid];
                float o = 0.f;
#pragma unroll
                for (int k = 0; k < K; ++k) {
                    S[k] = S[k] * Le[s * K + k] + Lk[s * K + k] * vv;
                    o += Lq[s * K + k] * S[k];
                }
                OG[(size_t)(b * L_ + t0 + s) * 512 + h * 128 + tid] = o;
            }
        }
        __syncthreads();
    }
}

__device__ __forceinline__ void ph_fin0(const float* YRW, const float* OG, const bf16_t* P, const bf16_t* LO, const bf16_t* SC, const float* BON,
                                        const float* gn_g, const float* gn_b, const float* norm_g, bf16_t* Ymix) {
    const int wave = TIDX >> 6, lane = TIDX & 63;
    const size_t S1 = (size_t)T_ * 512;
    for (int item = blockIdx.x * NWAVES + wave; item < T_ * 12; item += gridDim.x * NWAVES) {
        const int t = item / 12, u = item % 12;
        if (u < 8) {
            const int c = u * 64 + lane;
            const float y = YRW[(size_t)t * 512 + c];
            const float mean = wave_sum(y) * (1.f / 64.f);
            const float d = y - mean;
            const float var = wave_sum(d * d) * (1.f / 64.f);
            const float yn = d * rsqrtf(var + 64e-5f) * gn_g[c] + gn_b[c];
            const float v = bf2f(SC[3 * S1 + (size_t)t * 512 + c]);
            const float g = bf2f(LO[(size_t)t * NLORA + 1024 + c]);
            Ymix[(size_t)t * D_ + c] = f2bf((yn + BON[(size_t)t * 8 + u] * v) * g);
        } else {
            const int h = u - 8;
            const float o0 = OG[(size_t)t * 512 + h * 128 + lane], o1 = OG[(size_t)t * 512 + h * 128 + 64 + lane];
            const float ms = wave_sum(o0 * o0 + o1 * o1) * (1.f / 128.f);
            const float rs = rsqrtf(ms + LN_EPS);
            const float g0 = bf2f(P[(size_t)t * NIN0P + 2832 + h * 128 + lane]), g1 = bf2f(P[(size_t)t * NIN0P + 2832 + h * 128 + 64 + lane]);
            Ymix[(size_t)t * D_ + 512 + h * 128 + lane] = f2bf(o0 * rs * norm_g[lane] * siluf(g0));
            Ymix[(size_t)t * D_ + 512 + h * 128 + 64 + lane] = f2bf(o1 * rs * norm_g[64 + lane] * siluf(g1));
        }
    }
}

__device__ __forceinline__ void ph_ln_router(const float* src, float* hf, bf16_t* hb, const float* lg, const float* lb, const float* wg, const float* bg,
                                             const float* we, const float* be, int* tok_e, int* tok_slot, float* tok_g, unsigned* cnt) {
    const int wave = TIDX >> 6, lane = TIDX & 63;
    for (int t = blockIdx.x * NWAVES + wave; t < T_; t += gridDim.x * NWAVES) {
        const f32x4* xr = (const f32x4*)(src + (size_t)t * D_) + lane;
        f32x4 v[4]; float s = 0.f;
#pragma unroll
        for (int j = 0; j < 4; ++j) { v[j] = xr[64 * j]; s += (v[j].x + v[j].y) + (v[j].z + v[j].w); }
        const float mean = wave_sum(s) * (1.f / D_);
        float s2 = 0.f;
#pragma unroll
        for (int j = 0; j < 4; ++j) { v[j] = v[j] - mean; s2 += (v[j].x * v[j].x + v[j].y * v[j].y) + (v[j].z * v[j].z + v[j].w * v[j].w); }
        const float rstd = rsqrtf(wave_sum(s2) * (1.f / D_) + LN_EPS);
#pragma unroll
        for (int j = 0; j < 4; ++j) {
            const f32x4 g = ((const f32x4*)lg)[lane + 64 * j], bb = ((const f32x4*)lb)[lane + 64 * j];
            v[j] = v[j] * rstd * g + bb;
            ((f32x4*)(hf + (size_t)t * D_))[lane + 64 * j] = v[j];
            u32x2 o; o.x = pk2(v[j].x, v[j].y); o.y = pk2(v[j].z, v[j].w);
            ((u32x2*)(hb + (size_t)t * D_))[lane + 64 * j] = o;
        }
        float cl[4] = {0.f, 0.f, 0.f, 0.f};
#pragma unroll
        for (int j = 0; j < 4; ++j)
#pragma unroll
            for (int e = 0; e < 4; ++e) {
                const int d = 4 * (lane + 64 * j) + e;
                const f32x4 w = *(const f32x4*)(wg + (size_t)d * 4);
                const float xv = v[j][e];
                cl[0] += xv * w.x; cl[1] += xv * w.y; cl[2] += xv * w.z; cl[3] += xv * w.w;
            }
#pragma unroll
        for (int g = 0; g < 4; ++g) cl[g] = wave_sum(cl[g]) + bg[g];
        int grp = 0; float mx = cl[0];
#pragma unroll
        for (int g = 1; g < 4; ++g) if (cl[g] > mx) { mx = cl[g]; grp = g; }
        float den = 0.f;
#pragma unroll
        for (int g = 0; g < 4; ++g) den += __expf(cl[g] - mx);
        const float p_grp = 1.f / den;
        float fl[8];
#pragma unroll
        for (int e = 0; e < 8; ++e) fl[e] = 0.f;
        const float* weg = we + (size_t)grp * D_ * 8;
#pragma unroll
        for (int j = 0; j < 4; ++j)
#pragma unroll
            for (int e = 0; e < 4; ++e) {
                const int d = 4 * (lane + 64 * j) + e;
                const f32x4 w0 = *(const f32x4*)(weg + (size_t)d * 8), w1 = *(const f32x4*)(weg + (size_t)d * 8 + 4);
                const float xv = v[j][e];
                fl[0] += xv * w0.x; fl[1] += xv * w0.y; fl[2] += xv * w0.z; fl[3] += xv * w0.w;
                fl[4] += xv * w1.x; fl[5] += xv * w1.y; fl[6] += xv * w1.z; fl[7] += xv * w1.w;
            }
#pragma unroll
        for (int e = 0; e < 8; ++e) fl[e] = wave_sum(fl[e]) + be[grp * 8 + e];
        int j0 = 0; float m0 = fl[0];
#pragma unroll
        for (int e = 1; e < 8; ++e) if (fl[e] > m0) { m0 = fl[e]; j0 = e; }
        int j1 = -1; float m1 = -3.0e38f;
#pragma unroll
        for (int e = 0; e < 8; ++e) if (e != j0 && fl[e] > m1) { m1 = fl[e]; j1 = e; }
        const float e1 = __expf(m1 - m0);
        const float g0 = p_grp / (1.f + e1), g1 = p_grp * e1 / (1.f + e1);
        if (lane == 0) {
            const int ex0 = grp * 8 + j0, ex1 = grp * 8 + j1;
            const unsigned s0 = atomicAdd(&cnt[ex0], 1u), s1 = atomicAdd(&cnt[ex1], 1u);
            tok_e[2 * t] = ex0; tok_e[2 * t + 1] = ex1;
            tok_slot[2 * t] = (int)s0; tok_slot[2 * t + 1] = (int)s1;
            tok_g[2 * t] = g0; tok_g[2 * t + 1] = g1;
        }
    }
}

__device__ __forceinline__ void moe_offsets(LAS int* pst, const unsigned* cnt) {
    if (TIDX == 0) {
        int acc = 0;
        for (int e = 0; e < 32; ++e) { pst[e] = acc; const int c = (int)cnt[e]; acc += (c + MOE_PAD - 1) / MOE_PAD * MOE_PAD; }
        pst[32] = acc;
    }
    __syncthreads();
}
__device__ __forceinline__ int moe_expert_of_row(const LAS int* pst, int r) {
    int e = 0;
#pragma unroll 1
    for (int i = 1; i < 32; ++i) if (r >= pst[i]) e = i;
    return e;
}

__device__ __forceinline__ void ph_dispatch(LAS int* pst, const unsigned* cnt, const bf16_t* hb, const int* tok_e, const int* tok_slot, int* tok_dest, bf16_t* XR) {
    moe_offsets(pst, cnt);
    const int wave = TIDX >> 6, lane = TIDX & 63;
    for (int item = blockIdx.x * NWAVES + wave; item < T_ * 2; item += gridDim.x * NWAVES) {
        const int t = item >> 1;
        const int e = tok_e[item], dest = pst[e] + tok_slot[item];
        if (lane == 0) tok_dest[item] = dest;
        const u32x4* src = (const u32x4*)(hb + (size_t)t * D_);
        u32x4* dst = (u32x4*)(XR + (size_t)dest * D_);
        dst[lane] = src[lane]; dst[lane + 64] = src[lane + 64];
    }
    const int R = pst[32];
    for (int r = blockIdx.x * NWAVES + wave; r < R; r += gridDim.x * NWAVES) {
        const int e = moe_expert_of_row(pst, r);
        if (r - pst[e] >= (int)cnt[e]) {
            u32x4* dst = (u32x4*)(XR + (size_t)r * D_);
            const u32x4 z = {0u, 0u, 0u, 0u};
            dst[lane] = z; dst[lane + 64] = z;
        }
    }
}

__device__ __forceinline__ void ph_combine_ln(const float* hf, const bf16_t* Y, const int* tok_dest, const float* tok_g, const float* lg, const float* lb, float* outf, bf16_t* hb) {
    const int wave = TIDX >> 6, lane = TIDX & 63;
    for (int t = blockIdx.x * NWAVES + wave; t < T_; t += gridDim.x * NWAVES) {
        const int d0 = tok_dest[2 * t], d1 = tok_dest[2 * t + 1];
        const float g0 = tok_g[2 * t], g1 = tok_g[2 * t + 1];
        f32x4 v[4]; float s = 0.f;
#pragma unroll
        for (int j = 0; j < 4; ++j) {
            const f32x4 h = ((const f32x4*)(hf + (size_t)t * D_))[lane + 64 * j];
            const u32x2 y0 = ((const u32x2*)(Y + (size_t)d0 * D_))[lane + 64 * j], y1 = ((const u32x2*)(Y + (size_t)d1 * D_))[lane + 64 * j];
            f32x4 a, b;
            a.x = __uint_as_float(y0.x << 16); a.y = __uint_as_float(y0.x & 0xffff0000u); a.z = __uint_as_float(y0.y << 16); a.w = __uint_as_float(y0.y & 0xffff0000u);
            b.x = __uint_as_float(y1.x << 16); b.y = __uint_as_float(y1.x & 0xffff0000u); b.z = __uint_as_float(y1.y << 16); b.w = __uint_as_float(y1.y & 0xffff0000u);
            v[j] = h * DN_ALPHA + (a * g0 + b * g1);
            s += (v[j].x + v[j].y) + (v[j].z + v[j].w);
        }
        const float mean = wave_sum(s) * (1.f / D_);
        float s2 = 0.f;
#pragma unroll
        for (int j = 0; j < 4; ++j) { v[j] = v[j] - mean; s2 += (v[j].x * v[j].x + v[j].y * v[j].y) + (v[j].z * v[j].z + v[j].w * v[j].w); }
        const float rstd = rsqrtf(wave_sum(s2) * (1.f / D_) + LN_EPS);
#pragma unroll
        for (int j = 0; j < 4; ++j) {
            const f32x4 g = ((const f32x4*)lg)[lane + 64 * j], bb = ((const f32x4*)lb)[lane + 64 * j];
            v[j] = v[j] * rstd * g + bb;
            ((f32x4*)(outf + (size_t)t * D_))[lane + 64 * j] = v[j];
            u32x2 o; o.x = pk2(v[j].x, v[j].y); o.y = pk2(v[j].z, v[j].w);
            ((u32x2*)(hb + (size_t)t * D_))[lane + 64 * j] = o;
        }
    }
}

__device__ __forceinline__ void naive_s5_scan(const bf16_t* P1, const float* a_re, const float* a_im, const float* log_dt, const float* b_re, const float* b_im,
                                              const float* c_re, const float* c_im, const float* dvec, float* YS5, bf16_t* YS5B, int pair) {
    const int lane = TIDX & 63;
    const int b = pair >> 5, g = pair & 31, n = lane;
    const float lam_re = fminf(a_re[g * 64 + n], -1e-4f), lam_im = a_im[g * 64 + n];
    const float dt = __expf(log_dt[g]);
    const float mag = __expf(lam_re * dt);
    const float ab_re = mag * cosf(lam_im * dt), ab_im = mag * sinf(lam_im * dt);
    const float den = lam_re * lam_re + lam_im * lam_im;
    const float num_re = ab_re - 1.f;
    const float z_re = (num_re * lam_re + ab_im * lam_im) / den;
    const float z_im = (ab_im * lam_re - num_re * lam_im) / den;
    float bre[16], bim[16], cre[16], cim[16];
#pragma unroll
    for (int c = 0; c < 16; ++c) {
        bre[c] = b_re[(size_t)(g * 64 + n) * 16 + c]; bim[c] = b_im[(size_t)(g * 64 + n) * 16 + c];
        cre[c] = c_re[(size_t)(g * 16 + c) * 64 + n]; cim[c] = c_im[(size_t)(g * 16 + c) * 64 + n];
    }
    const float dd = (lane < 16) ? dvec[g * 16 + lane] : 0.f;
    float h_re = 0.f, h_im = 0.f;
    for (int tt = 0; tt < L_; ++tt) {
        const size_t t = (size_t)b * L_ + tt;
        const float ul = (lane < 16) ? bf2f(P1[t * NIN1 + g * 16 + lane]) : 0.f;
        float bur = 0.f, bui = 0.f;
#pragma unroll
        for (int c = 0; c < 16; ++c) { const float u = __shfl(ul, c); bur += u * bre[c]; bui += u * bim[c]; }
        const float x_re = z_re * bur - z_im * bui, x_im = z_re * bui + z_im * bur;
        const float nh_re = ab_re * h_re - ab_im * h_im + x_re;
        const float nh_im = ab_re * h_im + ab_im * h_re + x_im;
        h_re = nh_re; h_im = nh_im;
        float yv = 0.f;
#pragma unroll
        for (int c = 0; c < 16; ++c) { const float y = wave_sum(h_re * cre[c] - h_im * cim[c]); if (lane == c) yv = y; }
        if (lane < 16) {
            const float y = gelu_tanh(yv + dd * ul);
            YS5[t * 512 + g * 16 + lane] = y;
            YS5B[t * 512 + g * 16 + lane] = f2bf(y);
        }
    }
}

__device__ __forceinline__ void ph_fin1(const float* OG, const bf16_t* P1, const float* norm_g, bf16_t* Ymix) {
    const int wave = TIDX >> 6, lane = TIDX & 63;
    for (int item = blockIdx.x * NWAVES + wave; item < T_ * 4; item += gridDim.x * NWAVES) {
        const int t = item >> 2, h = item & 3;
        const float o0 = OG[(size_t)t * 512 + h * 128 + lane], o1 = OG[(size_t)t * 512 + h * 128 + 64 + lane];
        const float ms = wave_sum(o0 * o0 + o1 * o1) * (1.f / 128.f);
        const float rs = rsqrtf(ms + LN_EPS);
        const float g0 = bf2f(P1[(size_t)t * NIN1 + 2048 + h * 128 + lane]), g1 = bf2f(P1[(size_t)t * NIN1 + 2048 + h * 128 + 64 + lane]);
        Ymix[(size_t)t * D_ + 512 + h * 128 + lane] = f2bf(o0 * rs * norm_g[lane] * siluf(g0));
        Ymix[(size_t)t * D_ + 512 + h * 128 + 64 + lane] = f2bf(o1 * rs * norm_g[64 + lane] * siluf(g1));
    }
}

constexpr int LDS_BYTES = 147456;
constexpr int MISC_OFF = 131072 + 8192;
enum Phase {
    PH_PROLOGUE = 0,
    PH_INPROJ0, PH_PREPA0, PH_LORA0, PH_PREPB0, PH_SCAN0, PH_FIN0, PH_OUTPROJ0, PH_LN1_0, PH_DISP0, PH_UP0, PH_DOWN0, PH_COMB0,
    PH_INPROJ1, PH_SCAN1, PH_FIN1, PH_GLU1, PH_OUTPROJ1, PH_LN1_1, PH_DISP1, PH_UP1, PH_DOWN1, PH_COMB1,
    PH_COUNT
};

typedef const Args __attribute__((address_space(4)))* KArgsP;
__device__ __forceinline__ KArgsP fresh_args() { KArgsP p = (KArgsP)__builtin_amdgcn_kernarg_segment_ptr(); asm volatile("" : "+s"(p)); return p; }
#define PHASE_BEGIN KArgsP ap = fresh_args(); unsigned char* const ws = ap->ws; (void)ws;
#define INP(i) (ap->in[i])
#define W_CTL ((unsigned*)(ws + WS_CTL))
#define W_HB ((bf16_t*)(ws + WS_HB))
#define W_WIN0 ((bf16_t*)(ws + WS_WIN0))
#define W_WOUT0 ((bf16_t*)(ws + WS_WOUT0))
#define W_WIN1 ((bf16_t*)(ws + WS_WIN1))
#define W_WOUT1 ((bf16_t*)(ws + WS_WOUT1))
#define W_WGLU ((bf16_t*)(ws + WS_WGLU))
#define W_WLORA ((bf16_t*)(ws + WS_WLORA))
#define W_W13 ((bf16_t*)(ws + WS_W13))
#define W_W2 ((bf16_t*)(ws + WS_W2))
#define W_HA ((float*)(ws + WS_HA))
#define W_YRW W_HA
#define W_OG (W_HA + (size_t)T_ * 512)
#define W_P ((bf16_t*)(ws + WS_P))
#define W_LO ((bf16_t*)(ws + WS_LO))
#define W_SC ((bf16_t*)(ws + WS_SCAN))
#define W_GLALA ((float*)(ws + WS_GLALA))
#define W_BON ((float*)(ws + WS_BON))
#define W_AP ((bf16_t*)(ws + WS_APRIME))
#define W_YS5B ((bf16_t*)(ws + WS_YS5B))
#define W_XR ((bf16_t*)(ws + WS_XR))
#define W_HID ((bf16_t*)(ws + WS_HID))
#define W_Y ((bf16_t*)(ws + WS_Y))
#define W_TOKE ((int*)(ws + WS_ROUTE))
#define W_TOKSLOT (W_TOKE + 2 * T_)
#define W_TOKDEST (W_TOKE + 4 * T_)
#define W_TOKG ((float*)(W_TOKE + 6 * T_))
#define W_YMIX W_HB

template <int PLO, int PHI>
__device__ __forceinline__ void mega_body(unsigned char* lds_raw) {
    LAS unsigned char* lds = (LAS unsigned char*)lds_raw;
    LAS float* ldsf = (LAS float*)lds;
#define IN(k) (PLO <= (k) && (k) < PHI)
    constexpr bool MULTI = (PHI - PLO) > 1;
    XcdBarrier bar; bar.bar = nullptr; bar.x = 0; bar.st = (volatile LAS unsigned*)(lds + MISC_OFF) + 8;
    if (MULTI) {
        PHASE_BEGIN
        volatile LAS unsigned* MISC = (volatile LAS unsigned*)(lds + MISC_OFF);
        if (TIDX < 32) MISC[TIDX] = 0u;
        __syncthreads();
        bar = xcd_barrier_post(W_CTL + CW_BAR, MISC + 8);
    }
#define SEAM(k) do { if (IN(k) && IN((k) + 1)) { PHASE_BEGIN bar.bar = W_CTL + CW_BAR; xcd_barrier(bar); } } while (0)

    if (IN(PH_PROLOGUE)) {
        PHASE_BEGIN ph_prologue(INP(0), W_HB);
#if FAST_GEMM
        LAS float* scr = ldsf + (TIDX >> 6) * (64 * 33);
        const int gw = blockIdx.x * NWAVES + (TIDX >> 6), ngw = gridDim.x * NWAVES, lane = TIDX & 63;
        convert_plain(INP(1), D_, NIN0, NIN0P, W_WIN0, scr, gw, ngw, lane);
        convert_plain(INP(16), D_, D_, D_, W_WOUT0, scr, gw, ngw, lane);
        convert_plain(INP(17), D_, NIN1, NIN1, W_WIN1, scr, gw, ngw, lane);
        convert_plain(INP(30), D_, D_, D_, W_WOUT1, scr, gw, ngw, lane);
        convert_plain(INP(26), 512, 512, 512, W_WGLU, scr, gw, ngw, lane);
        convert_lora(INP(4), INP(6), INP(7), W_WLORA, scr, gw, ngw, lane);
        convert_moe(INP(37), INP(38), INP(39), W_W13, W_W2, scr, gw, ngw, lane);
#endif
    }
    SEAM(PH_PROLOGUE);
    if (IN(PH_INPROJ0)) {
        PHASE_BEGIN
#if FAST_GEMM
        { pg8::Gemm g{W_HB, W_WIN0, T_, NIN0P, D_}; pg8::StaticOrder S; S.init(T_, NIN0P, (int)gridDim.x, (int)blockIdx.x); pg8::EpiStoreBf16 E{W_P, NIN0P};
          pg8::gemm_phase<pg8::EpiStoreBf16, pg8::StaticOrder, true, true>(lds, g, S, E); }
#else
        const float* W = INP(1); const bf16_t* A = W_HB; bf16_t* P = W_P;
        naive_gemm<false>(ldsf, T_, NIN0, D_, [&](int m) { return A + (size_t)m * D_; }, [&](int, int) { return W; }, NIN0,
                          [&](int m, int n, float a, float) { P[(size_t)m * NIN0P + n] = f2bf(a); });
#endif
    }
    SEAM(PH_INPROJ0);
    if (IN(PH_PREPA0)) { PHASE_BEGIN ph_prepA0(W_P, INP(2), INP(13), INP(14), W_AP, W_GLALA); }
    SEAM(PH_PREPA0);
    if (IN(PH_LORA0)) {
        PHASE_BEGIN
#if FAST_GEMM
        { pg8::Gemm g{W_AP, W_WLORA, T_, NLORA, 256}; pg8::StaticOrder S; S.init(T_, NLORA, (int)gridDim.x, (int)blockIdx.x); pg8::EpiStoreBf16 E{W_LO, NLORA};
          pg8::gemm_phase<pg8::EpiStoreBf16, pg8::StaticOrder, true, true>(lds, g, S, E); }
#else
        const float* w2 = INP(4); const float* a2 = INP(6); const float* g2 = INP(7); const bf16_t* AP = W_AP; bf16_t* LO = W_LO;
        naive_gemm<false>(ldsf, T_, 512, 64, [&](int m) { return AP + (size_t)m * 256; }, [&](int, int) { return w2; }, 512,
                          [&](int m, int n, float a, float) { LO[(size_t)m * NLORA + n] = f2bf(a); });
        naive_gemm<false>(ldsf, T_, 512, 64, [&](int m) { return AP + (size_t)m * 256 + 64; }, [&](int, int) { return a2; }, 512,
                          [&](int m, int n, float a, float) { LO[(size_t)m * NLORA + 512 + n] = f2bf(a); });
        naive_gemm<false>(ldsf, T_, 512, 128, [&](int m) { return AP + (size_t)m * 256 + 128; }, [&](int, int) { return g2; }, 512,
                          [&](int m, int n, float a, float) { LO[(size_t)m * NLORA + 1024 + n] = f2bf(a); });
#endif
    }
    SEAM(PH_LORA0);
    if (IN(PH_PREPB0)) { PHASE_BEGIN ph_prepB0(W_P, W_LO, INP(2), INP(3), INP(5), INP(8), INP(9), INP(10), W_SC, W_BON); }
    SEAM(PH_PREPB0);
    if (IN(PH_SCAN0)) {
        PHASE_BEGIN
        const int bid = blockIdx.x;
        if (bid < 16) naive_rwkv_scan(ldsf, W_SC, W_YRW, bid);
        else if (bid < 24) {
            const int bh = bid - 16;
            const bf16_t* P = W_P; const float* GLALA = W_GLALA;
            naive_gla_scan<64>(ldsf,
                [&](int t, int ck, float& q, float& kk, float& e) {
                    q = bf2f(P[(size_t)t * NIN0P + 1792 + ck]) * 0.125f; kk = bf2f(P[(size_t)t * NIN0P + 2048 + ck]); e = __expf(GLALA[(size_t)t * 256 + ck]); },
                [&](int t, int cv) { return bf2f(P[(size_t)t * NIN0P + 2304 + cv]); }, W_OG, bh >> 2, bh & 3);
        }
    }
    SEAM(PH_SCAN0);
    if (IN(PH_FIN0)) { PHASE_BEGIN ph_fin0(W_YRW, W_OG, W_P, W_LO, W_SC, W_BON, INP(11), INP(12), INP(15), W_YMIX); }
    SEAM(PH_FIN0);

#pragma unroll
    for (int layer = 0; layer < 2; ++layer) {
        const int base = layer == 0 ? PH_OUTPROJ0 : PH_OUTPROJ1;
        if (IN(base + 0)) {
            PHASE_BEGIN
            const float* W = layer == 0 ? INP(16) : INP(30);
            float* V1 = layer == 0 ? ap->out : W_HA;
            const float* resid = layer == 0 ? INP(0) : ap->out;
#if FAST_GEMM
            (void)W;
            { pg8::Gemm g{W_YMIX, layer == 0 ? W_WOUT0 : W_WOUT1, T_, D_, D_}; pg8::StaticOrder S; S.init(T_, D_, (int)gridDim.x, (int)blockIdx.x); pg8::EpiResidF32 E{resid, V1, D_, DN_ALPHA};
              pg8::gemm_phase<pg8::EpiResidF32, pg8::StaticOrder, true, true>(lds, g, S, E); }
#else
            const bf16_t* Ymix = W_YMIX;
            naive_gemm<false>(ldsf, T_, D_, D_, [&](int m) { return Ymix + (size_t)m * D_; }, [&](int, int) { return W; }, D_,
                              [&](int m, int n, float a, float) { V1[(size_t)m * D_ + n] = DN_ALPHA * resid[(size_t)m * D_ + n] + a; });
#endif
        }
        SEAM(base + 0);
        if (IN(base + 1)) {
            PHASE_BEGIN
            const float* V1 = layer == 0 ? ap->out : W_HA;
            ph_ln_router(V1, W_HA, W_HB, INP(31) + layer * D_, INP(32) + layer * D_, INP(33) + (size_t)layer * D_ * 4, INP(34) + layer * 4,
                         INP(35) + (size_t)layer * 4 * D_ * 8, INP(36) + layer * 32, W_TOKE, W_TOKSLOT, W_TOKG, W_CTL + CW_CNT + 64 * layer);
        }
        SEAM(base + 1);
        if (IN(base + 2)) { PHASE_BEGIN ph_dispatch((LAS int*)lds, W_CTL + CW_CNT + 64 * layer, W_HB, W_TOKE, W_TOKSLOT, W_TOKDEST, W_XR); }
        SEAM(base + 2);
        if (IN(base + 3)) {
            PHASE_BEGIN
#if FAST_GEMM
            { LAS int* pst = (LAS int*)(lds + 131072 + 2048); LAS int* tile_e = (LAS int*)(lds + 131072 + 1024);
              moe_offsets(pst, W_CTL + CW_CNT + 64 * layer);
              const int ntiles = pst[32] / 256;
              if ((int)TIDX < ntiles) tile_e[TIDX] = moe_expert_of_row(pst, TIDX * 256);
              __syncthreads();
              pg8::Gemm g{W_XR, W_W13, ntiles * 256, 1024, D_}; pg8::MoeOrder S{ntiles, 4, (int)gridDim.x, (int)blockIdx.x, tile_e}; pg8::EpiSwiglu E{W_HID};
              pg8::gemm_phase<pg8::EpiSwiglu, pg8::MoeOrder, true, true>(lds, g, S, E); }
#else
            LAS int* pst = (LAS int*)(lds + 65536);
            moe_offsets(pst, W_CTL + CW_CNT + 64 * layer);
            const float* w1 = INP(37) + (size_t)layer * 32 * D_ * 512; const float* w3 = INP(38) + (size_t)layer * 32 * D_ * 512;
            const bf16_t* XR = W_XR; bf16_t* HID = W_HID;
            naive_gemm<true>(ldsf, pst[32], 512, D_, [&](int m) { return XR + (size_t)m * D_; },
                             [&](int m0, int which) { const int e = moe_expert_of_row(pst, m0); return (which ? w3 : w1) + (size_t)e * D_ * 512; }, 512,
                             [&](int m, int n, float a, float b) { HID[(size_t)m * 512 + n] = f2bf(siluf(a) * b); });
#endif
        }
        SEAM(base + 3);
        if (IN(base + 4)) {
            PHASE_BEGIN
#if FAST_GEMM
            { LAS int* pst = (LAS int*)(lds + 131072 + 2048); LAS int* tile_e = (LAS int*)(lds + 131072 + 1024);
              moe_offsets(pst, W_CTL + CW_CNT + 64 * layer);
              const int ntiles = pst[32] / 256;
              if ((int)TIDX < ntiles) tile_e[TIDX] = moe_expert_of_row(pst, TIDX * 256);
              __syncthreads();
              pg8::Gemm g{W_HID, W_W2, ntiles * 256, 1024, 512}; pg8::MoeOrder S{ntiles, 4, (int)gridDim.x, (int)blockIdx.x, tile_e}; pg8::EpiStoreBf16 E{W_Y, D_};
              pg8::gemm_phase<pg8::EpiStoreBf16, pg8::MoeOrder, true, true>(lds, g, S, E); }
#else
            LAS int* pst = (LAS int*)(lds + 65536);
            moe_offsets(pst, W_CTL + CW_CNT + 64 * layer);
            const float* w2 = INP(39) + (size_t)layer * 32 * 512 * D_;
            const bf16_t* HID = W_HID; bf16_t* Y = W_Y;
            naive_gemm<false>(ldsf, pst[32], D_, 512, [&](int m) { return HID + (size_t)m * 512; },
                              [&](int m0, int) { const int e = moe_expert_of_row(pst, m0); return w2 + (size_t)e * 512 * D_; }, D_,
                              [&](int m, int n, float a, float) { Y[(size_t)m * D_ + n] = f2bf(a); });
#endif
        }
        SEAM(base + 4);
        if (IN(base + 5)) { PHASE_BEGIN ph_combine_ln(W_HA, W_Y, W_TOKDEST, W_TOKG, INP(40) + layer * D_, INP(41) + layer * D_, ap->out, W_HB); }
        SEAM(base + 5);

        if (layer == 0) {
            if (IN(PH_INPROJ1)) {
                PHASE_BEGIN
#if FAST_GEMM
                { pg8::Gemm g{W_HB, W_WIN1, T_, NIN1, D_}; pg8::StaticOrder S; S.init(T_, NIN1, (int)gridDim.x, (int)blockIdx.x); pg8::EpiStoreBf16 E{W_P, NIN1};
                  pg8::gemm_phase<pg8::EpiStoreBf16, pg8::StaticOrder, true, true>(lds, g, S, E); }
#else
                const float* W = INP(17); const bf16_t* A = W_HB; bf16_t* P = W_P;
                naive_gemm<false>(ldsf, T_, NIN1, D_, [&](int m) { return A + (size_t)m * D_; }, [&](int, int) { return W; }, NIN1,
                                  [&](int m, int n, float a, float) { P[(size_t)m * NIN1 + n] = f2bf(a); });
#endif
            }
            SEAM(PH_INPROJ1);
            if (IN(PH_SCAN1)) {
                PHASE_BEGIN
                const int bid = blockIdx.x;
                const bf16_t* P = W_P;
                if (bid < 8) {
                    const float* hg_lb = INP(28);
                    naive_gla_scan<128>(ldsf,
                        [&](int t, int ck, float& q, float& kk, float& e) {
                            const float l0 = hg_lb[ck], l1 = hg_lb[512 + ck];
                            const float lbv = 1.f / (1.f + __expf(l0 - l1));
                            const float f = bf2f(P[(size_t)t * NIN1 + 1024 + ck]);
                            const float sg = sigm(f);
                            q = siluf(bf2f(P[(size_t)t * NIN1 + 512 + ck])); kk = (1.f - lbv) * (1.f - sg); e = lbv + (1.f - lbv) * sg; },
                        [&](int t, int cv) { return bf2f(P[(size_t)t * NIN1 + 1536 + cv]); }, W_OG, bid >> 2, bid & 3);
                } else if (bid < 16) {
                    const int pair = (bid - 8) * 8 + (TIDX >> 6);
                    naive_s5_scan(P, INP(18), INP(19), INP(20), INP(21), INP(22), INP(23), INP(24), INP(25), W_YRW, W_YS5B, pair);
                }
#if FAST_GEMM
                else {
                    LAS float* scr = ldsf + (TIDX >> 6) * (64 * 33);
                    convert_moe(INP(37) + (size_t)32 * D_ * 512, INP(38) + (size_t)32 * D_ * 512, INP(39) + (size_t)32 * 512 * D_, W_W13, W_W2, scr,
                                (bid - 16) * NWAVES + (TIDX >> 6), ((int)gridDim.x - 16) * NWAVES, TIDX & 63);
                }
#endif
            }
            SEAM(PH_SCAN1);
            if (IN(PH_FIN1)) { PHASE_BEGIN ph_fin1(W_OG, W_P, INP(29), W_YMIX); }
            SEAM(PH_FIN1);
            if (IN(PH_GLU1)) {
                PHASE_BEGIN
#if FAST_GEMM
                { pg8::Gemm g{W_YS5B, W_WGLU, T_, 512, 512}; pg8::StaticOrder S; S.init(T_, 512, (int)gridDim.x, (int)blockIdx.x); pg8::EpiGlu E{W_YRW, 512, INP(27), W_YMIX, D_};
                  pg8::gemm_phase<pg8::EpiGlu, pg8::StaticOrder, true, true>(lds, g, S, E); }
#else
                const float* W = INP(26); const float* gb = INP(27); const bf16_t* YS5B = W_YS5B; const float* YRW = W_YRW; bf16_t* Ymix = W_YMIX;
                naive_gemm<false>(ldsf, T_, 512, 512, [&](int m) { return YS5B + (size_t)m * 512; }, [&](int, int) { return W; }, 512,
                                  [&](int m, int n, float a, float) { const float y = YRW[(size_t)m * 512 + n]; Ymix[(size_t)m * D_ + n] = f2bf(y * sigm(a + gb[n])); });
#endif
            }
            SEAM(PH_GLU1);
        }
    }
#undef IN
}
template <int PLO, int PHI>
__global__ void __launch_bounds__(NTHREADS, 2) mega(Args args) {
    extern __shared__ __attribute__((aligned(16))) unsigned char lds_raw[];
    mega_body<PLO, PHI>(lds_raw);
}

#include <utility>
template <int... I> static void set_attrs(std::integer_sequence<int, I...>) {
    (void)std::initializer_list<int>{ ((void)hipFuncSetAttribute((const void*)mega<I, I + 1>, hipFuncAttributeMaxDynamicSharedMemorySize, LDS_BYTES), 0)... };
}
template <int I> static int launch_one(int grid, hipStream_t stream, const Args& a) {
    hipLaunchKernelGGL((mega<I, I + 1>), dim3(grid), dim3(NTHREADS), LDS_BYTES, stream, a);
    return 0;
}
template <int... I> static void launch_all(std::integer_sequence<int, I...>, int grid, hipStream_t stream, const Args& a) {
    (void)std::initializer_list<int>{ launch_one<I>(grid, stream, a)... };
}
extern "C" void kernel_launch(void* const* d_in, const int* in_sizes, int n_in, void* d_out, int out_size, void* d_ws, size_t ws_size, hipStream_t stream) {
    static int grid = 0;
    if (grid == 0) {
        if (n_in != 42 || out_size != T_ * D_ || ws_size < WS_END) { fprintf(stderr, "kernel_launch: unexpected shapes n_in %d out %d ws %zu\n", n_in, out_size, ws_size); grid = -1; return; }
        int dev = 0, cus = 0, per_cu = 0;
        hipGetDevice(&dev);
        hipDeviceGetAttribute(&cus, hipDeviceAttributeMultiprocessorCount, dev);
        set_attrs(std::make_integer_sequence<int, PH_COUNT>{});
        hipFuncSetAttribute((const void*)mega<0, PH_COUNT>, hipFuncAttributeMaxDynamicSharedMemorySize, LDS_BYTES);
        hipOccupancyMaxActiveBlocksPerMultiprocessor(&per_cu, (const void*)mega<0, PH_COUNT>, NTHREADS, LDS_BYTES);
        (void)hipGetLastError();
        if (per_cu < 1) per_cu = 1;
        grid = cus * 1;
        fprintf(stderr, "kernel_launch: cus %d per_cu %d grid %d\n", cus, per_cu, grid);
    }
    if (grid < 0) return;
    hipMemsetAsync((char*)d_ws + WS_CTL, 0, CTL_ZERO_BYTES, stream);
    Args a{};
    for (int i = 0; i < 42; ++i) a.in[i] = (const float*)d_in[i];
    a.out = (float*)d_out; a.ws = (unsigned char*)d_ws;
#if MK_SINGLE
    void* kargs[] = {(void*)&a};
    hipError_t e = hipLaunchCooperativeKernel((const void*)mega<0, PH_COUNT>, dim3(grid), dim3(NTHREADS), kargs, LDS_BYTES, stream);
    if (e != hipSuccess) fprintf(stderr, "cooperative launch failed: %s (grid %d)\n", hipGetErrorString(e), grid);
#else
    launch_all(std::make_integer_sequence<int, PH_COUNT>{}, grid, stream, a);
#endif
}
#ifdef TEST_RANGES
template __global__ void mega<0, 2>(Args);
template __global__ void mega<1, 3>(Args);
template __global__ void mega<1, 4>(Args);
template __global__ void mega<3, 8>(Args);
template __global__ void mega<7, 13>(Args);
template __global__ void mega<10, 12>(Args);
template __global__ void mega<13, 17>(Args);
template __global__ void mega<0, 13>(Args);
#endif
```

```cpp
#include <hip/hip_runtime.h>
#include <cstdio>
#include <cstdint>

#define GAS __attribute__((address_space(1)))
#define LAS __attribute__((address_space(3)))
typedef unsigned short bf16_t;
typedef float f32x4 __attribute__((ext_vector_type(4)));
typedef unsigned u32x4 __attribute__((ext_vector_type(4)));
typedef unsigned u32x2 __attribute__((ext_vector_type(2)));
__device__ __forceinline__ int launder_tid() { int t = (int)threadIdx.x; asm volatile("" : "+v"(t)); return t; }
#define TIDX launder_tid()

#ifndef FAST_GEMM
#define FAST_GEMM 1
#endif
#ifndef FAST_GLA0
#define FAST_GLA0 1
#endif
#ifndef FAST_HG
#define FAST_HG 1
#endif
#ifndef FAST_S5
#define FAST_S5 1
#endif
#ifndef MK_SINGLE
#define MK_SINGLE 1
#endif

constexpr int T_ = 16384, L_ = 8192, D_ = 1024;
constexpr int NIN0 = 3344, NIN0P = 3584, NIN1 = 2560;
constexpr int NLORA = 1536;
constexpr int RMAX = 40960;
constexpr int MOE_PAD = 256;
constexpr float DN_ALPHA = 1.41421356237f;
constexpr float LN_EPS = 1e-5f;
constexpr int NTHREADS = 512, NWAVES = 8;

constexpr size_t MiB = 1u << 20;
constexpr size_t WS_CTL = 0, CTL_ZERO_BYTES = 1 * MiB;
constexpr size_t WS_WIN0 = 2 * MiB;
constexpr size_t WS_WOUT0 = 9 * MiB;
constexpr size_t WS_WIN1 = 11 * MiB;
constexpr size_t WS_WOUT1 = 16 * MiB;
constexpr size_t WS_WGLU = 18 * MiB;
constexpr size_t WS_WLORA = 19 * MiB;
constexpr size_t WS_W13 = 20 * MiB;
constexpr size_t WS_W2 = 84 * MiB;
constexpr size_t WS_HB = 116 * MiB;
constexpr size_t WS_HA = 149 * MiB;
constexpr size_t WS_ROUTE = 213 * MiB;
constexpr size_t WS_BIG = 214 * MiB;
constexpr size_t WS_P = WS_BIG;
constexpr size_t WS_LO = WS_BIG + 112 * MiB;
constexpr size_t WS_SCAN = WS_BIG + 160 * MiB;
constexpr size_t WS_GLALA = WS_BIG + 256 * MiB;
constexpr size_t WS_BON = WS_BIG + 272 * MiB;
constexpr size_t WS_APRIME = WS_BIG + 273 * MiB;
constexpr size_t WS_YS5B = WS_BIG + 80 * MiB;
constexpr size_t WS_XR = WS_BIG;
constexpr size_t WS_HID = WS_BIG + 80 * MiB;
constexpr size_t WS_Y = WS_BIG + 120 * MiB;
constexpr size_t WS_END = 512 * MiB;
constexpr int CW_BAR = 4096;
constexpr int CW_CNT = 8192;

__device__ __forceinline__ float bf2f(bf16_t b) { return __uint_as_float(((unsigned)b) << 16); }
__device__ __forceinline__ bf16_t f2bf(float f) { unsigned u = __float_as_uint(f); u += 0x7fffu + ((u >> 16) & 1u); return (bf16_t)(u >> 16); }
__device__ __forceinline__ unsigned pk2(float lo, float hi) { return (unsigned)f2bf(lo) | ((unsigned)f2bf(hi) << 16); }
__device__ __forceinline__ float sigm(float x) { return 1.f / (1.f + __expf(-x)); }
__device__ __forceinline__ float siluf(float x) { return x * sigm(x); }
__device__ __forceinline__ float softplusf(float x) { return fmaxf(x, 0.f) + log1pf(__expf(-fabsf(x))); }
__device__ __forceinline__ float gelu_tanh(float x) { const float u = 0.7978845608028654f * (x + 0.044715f * x * x * x); return 0.5f * x * (1.f + tanhf(u)); }
__device__ __forceinline__ float wave_sum(float v) {
#pragma unroll
    for (int o = 1; o < 64; o <<= 1) v += __shfl_xor(v, o);
    return v;
}


namespace pg8 {
#define PG8_LAS __attribute__((address_space(3)))
typedef unsigned short bf16_t;
typedef short bf16x8 __attribute__((ext_vector_type(8)));
typedef float f32x4 __attribute__((ext_vector_type(4)));
typedef unsigned u32x4 __attribute__((ext_vector_type(4)));
constexpr int BM = 256, BK = 64, HALF = 128, HTB = HALF * BK * 2  , STAGE_BYTES = 8 * HTB, NXCD = 8, WGM = 8;

__host__ __device__ __forceinline__ int lds_byte(int r, int c) { const int st = (r >> 4) * 2 + (c >> 5), rr = r & 15, cc = c & 31, ob = rr * 64 + cc * 2; return st * 1024 + (ob ^ (((ob >> 9) & 1) << 5)); }
__host__ __device__ __forceinline__ void stage_rc(int b, int& R, int& C) { const int st = b / 1024, sb = b % 1024, swz = sb ^ (((sb >> 9) & 1) << 5); R = (st >> 1) * 16 + swz / 64; C = (st & 1) * 32 + (swz % 64) / 2; }
__host__ __device__ __forceinline__ int perm32(int rho) { const int n = rho >> 4, i = rho & 15; return 8 * (i >> 2) + 4 * n + (i & 3); }

struct Unit { int pm, pn, pb; };
struct Gemm { const bf16_t* A; const bf16_t* Bt; int M, N, K, lda; };

struct StaticOrder {
    int nM, nN, nwg, G, c;
    __host__ __device__ void init(int M, int N, int G_, int c_) { nM = M / BM; nN = N / BM; nwg = nM * nN; G = G_; c = c_; }
    __host__ __device__ bool next(int i, Unit& u) const {
        const long L = (long)i * G + c; if (L >= nwg) return false;
        int wgid = (int)L; { const int q = nwg / NXCD, r = nwg % NXCD, xcd = wgid % NXCD, off = wgid / NXCD; wgid = (xcd < r ? xcd * (q + 1) : r * (q + 1) + (xcd - r) * q) + off; }
        const int nig = WGM * nN, gid = wgid / nig, fm = gid * WGM, gsz = (nM - fm) < WGM ? (nM - fm) : WGM;
        u.pm = fm + ((wgid % nig) % gsz); u.pn = (wgid % nig) / gsz; u.pb = u.pn; return true;
    }
    __device__ __forceinline__ void a_ready(const Unit&) const {}
    __device__ __forceinline__ void done(const Unit&) const {}
};

__device__ __forceinline__ unsigned cvt_pk_bf16(float lo, float hi) { unsigned r; asm volatile("v_cvt_pk_bf16_f32 %0, %1, %2" : "=v"(r) : "v"(lo), "v"(hi)); return r; }
typedef float f32x2 __attribute__((ext_vector_type(2)));

template <class Epi, class Sched, bool ALIGN_EPI = false, bool SP2 = false>
__device__ __forceinline__ void gemm_phase(PG8_LAS unsigned char* lds, const Gemm g, const Sched& S, const Epi& E) {
    const int tid = TIDX, wid = __builtin_amdgcn_readfirstlane(tid >> 6), lane = tid & 63, wr = wid >> 2, wc = wid & 3, fr = lane & 15, fq = lane >> 4;
    const int K = g.K, nt = K / BK, lda = g.lda ? g.lda : g.K;
    unsigned voffA[2], voffB[2];
#pragma unroll
    for (int i = 0; i < 2; ++i) { int R, C; stage_rc(tid * 16 + i * 8192, R, C); const int Rb = Epi::PERM ? ((R & ~31) + perm32(R & 31)) : R;
        voffA[i] = (unsigned)(R * lda + C) * 2u; voffB[i] = (unsigned)(Rb * K + C) * 2u; }
    const size_t kstep = (size_t)(BK * 2);
    const size_t hstep = (size_t)HALF * K * 2;
    const size_t tstep = 2 * hstep;
    const size_t hstepA = (size_t)HALF * lda * 2, tstepA = 2 * hstepA;
    const unsigned ldsw = (unsigned)wid * 1024u;
    const int aoff = lds_byte(wr * 64 + fr, fq * 8), boff = lds_byte(wc * 32 + fr, fq * 8);
#define PG8_SA(b, h) (((b) * 2 + (h)) * HTB)
#define PG8_SB(b, h) ((4 + (b) * 2 + (h)) * HTB)
#define PG8_STAGE(bufoff, gbase, voff) do { _Pragma("unroll") for (int _i = 0; _i < 2; ++_i) \
        __builtin_amdgcn_global_load_lds((const unsigned*)((const char*)(gbase) + (voff)[_i]), (PG8_LAS unsigned*)(lds + (bufoff) + ldsw + _i * 8192), 16, 0, 0); } while (0)
#define PG8_LDA(dst, b, h) do { _Pragma("unroll") for (int m = 0; m < 4; ++m) _Pragma("unroll") for (int k = 0; k < 2; ++k) dst[m][k] = *(const PG8_LAS bf16x8*)(lds + PG8_SA(b, h) + aoff + m * 2048 + k * 1024); } while (0)
#define PG8_LDB(dst, b, h) do { _Pragma("unroll") for (int n = 0; n < 2; ++n) _Pragma("unroll") for (int k = 0; k < 2; ++k) dst[n][k] = *(const PG8_LAS bf16x8*)(lds + PG8_SB(b, h) + boff + n * 2048 + k * 1024); } while (0)
#define PG8_MMA(ai, bj, At, Bt) do { __builtin_amdgcn_s_setprio(1); _Pragma("unroll") for (int m = 0; m < 4; ++m) _Pragma("unroll") for (int n = 0; n < 2; ++n) _Pragma("unroll") for (int k = 0; k < 2; ++k) \
        acc[ai][bj][m][n] = __builtin_amdgcn_mfma_f32_16x16x32_bf16(Bt[n][k], At[m][k], acc[ai][bj][m][n], 0, 0, 0); __builtin_amdgcn_s_setprio(0); } while (0)
#define PG8_WAIT_V(n) asm volatile("s_waitcnt vmcnt(" #n ")" ::: "memory")
#define PG8_WAIT_L(n) asm volatile("s_waitcnt lgkmcnt(" #n ")" ::: "memory")
#define PG8_BAR __builtin_amdgcn_s_barrier()
#define PG8_SCHED __builtin_amdgcn_sched_barrier(0)
    Unit cur, nxt; int ui = 0;
    if (!S.next(0, cur)) return;
    f32x4 acc[2][2][4][2];
#pragma unroll
    for (int a = 0; a < 2; ++a)
#pragma unroll
        for (int b = 0; b < 2; ++b)
#pragma unroll
            for (int m = 0; m < 4; ++m)
#pragma unroll
                for (int n = 0; n < 2; ++n) acc[a][b][m][n] = (f32x4){0.f, 0.f, 0.f, 0.f};
    bf16x8 At[4][2], B0[2][2], B1[2][2];
    const char* cA = (const char*)g.A + (size_t)cur.pm * tstepA; const char* cB = (const char*)g.Bt + (size_t)cur.pb * tstep;
    S.a_ready(cur);
    if constexpr (SP2) {
        PG8_STAGE(PG8_SB(0, 0), cB, voffB); PG8_STAGE(PG8_SB(0, 1), cB + hstep, voffB); PG8_STAGE(PG8_SA(0, 0), cA, voffA); PG8_STAGE(PG8_SA(0, 1), cA + hstepA, voffA);
        if (wr == 1) PG8_BAR;
        PG8_WAIT_V(2); PG8_BAR;
        PG8_STAGE(PG8_SB(1, 0), cB + kstep, voffB); PG8_STAGE(PG8_SA(1, 0), cA + kstep, voffA); PG8_STAGE(PG8_SB(1, 1), cB + hstep + kstep, voffB);
        PG8_WAIT_V(6); PG8_BAR;
    } else {
        PG8_STAGE(PG8_SB(0, 0), cB, voffB); PG8_STAGE(PG8_SA(0, 0), cA, voffA); PG8_STAGE(PG8_SB(0, 1), cB + hstep, voffB); PG8_STAGE(PG8_SA(0, 1), cA + hstepA, voffA);
        if (wr == 1) PG8_BAR;
        PG8_WAIT_V(4); PG8_BAR;
        PG8_STAGE(PG8_SB(1, 0), cB + kstep, voffB); PG8_STAGE(PG8_SA(1, 0), cA + kstep, voffA); PG8_STAGE(PG8_SB(1, 1), cB + hstep + kstep, voffB);
        PG8_WAIT_V(6); PG8_BAR;
    }
    for (;;) {
        const bool has_next = S.next(ui + 1, nxt);
        const char* nA = has_next ? (const char*)g.A + (size_t)nxt.pm * tstepA : cA; const char* nB = has_next ? (const char*)g.Bt + (size_t)nxt.pb * tstep : cB;
        for (int t = 0; t < nt; t += 2) {
            const bool last = (t == nt - 2);
            const char* a1 = cA + (size_t)(t + 1) * kstep;
            const char* a2 = last ? nA : cA + (size_t)(t + 2) * kstep; const char* b2 = last ? nB : cB + (size_t)(t + 2) * kstep;
            const char* a3 = a2 + kstep; const char* b3 = b2 + kstep;
            if (last && has_next) S.a_ready(nxt);
            if constexpr (SP2) {
            PG8_LDB(B0, 0, 0); PG8_LDB(B1, 0, 1); PG8_SCHED; PG8_LDA(At, 0, 0); PG8_STAGE(PG8_SA(1, 1), a1 + hstepA, voffA);
            PG8_WAIT_V(8); PG8_WAIT_L(0); PG8_BAR; PG8_MMA(0, 0, At, B0); PG8_MMA(0, 1, At, B1); PG8_BAR; PG8_SCHED;
            PG8_LDA(At, 0, 1); PG8_STAGE(PG8_SB(0, 0), b2, voffB); PG8_STAGE(PG8_SB(0, 1), b2 + hstep, voffB); PG8_STAGE(PG8_SA(0, 0), a2, voffA);
            PG8_WAIT_V(8); PG8_WAIT_L(0); PG8_BAR; PG8_MMA(1, 0, At, B0); PG8_MMA(1, 1, At, B1); PG8_BAR; PG8_SCHED;
            PG8_LDB(B0, 1, 0); PG8_LDB(B1, 1, 1); PG8_SCHED; PG8_LDA(At, 1, 0); PG8_STAGE(PG8_SA(0, 1), a2 + hstepA, voffA);
            PG8_WAIT_V(8); PG8_WAIT_L(0); PG8_BAR; PG8_MMA(0, 0, At, B0); PG8_MMA(0, 1, At, B1); PG8_BAR; PG8_SCHED;
            PG8_LDA(At, 1, 1); PG8_STAGE(PG8_SB(1, 0), b3, voffB); PG8_STAGE(PG8_SB(1, 1), b3 + hstep, voffB); PG8_STAGE(PG8_SA(1, 0), a3, voffA);
            PG8_WAIT_V(8); PG8_WAIT_L(0); PG8_BAR; PG8_MMA(1, 0, At, B0); PG8_MMA(1, 1, At, B1); PG8_BAR; PG8_SCHED;
            } else {
            PG8_LDB(B0, 0, 0); PG8_SCHED; PG8_LDA(At, 0, 0); PG8_STAGE(PG8_SA(1, 1), a1 + hstepA, voffA);
            PG8_WAIT_L(8); PG8_BAR; PG8_WAIT_L(0); PG8_MMA(0, 0, At, B0); PG8_BAR; PG8_SCHED;
            PG8_LDB(B1, 0, 1); PG8_STAGE(PG8_SB(0, 0), b2, voffB);
            PG8_BAR; PG8_WAIT_L(0); PG8_MMA(0, 1, At, B1); PG8_BAR;
            PG8_LDA(At, 0, 1); PG8_STAGE(PG8_SA(0, 0), a2, voffA);
            PG8_BAR; PG8_WAIT_L(0); PG8_MMA(1, 0, At, B0); PG8_BAR; PG8_SCHED;
            PG8_STAGE(PG8_SB(0, 1), b2 + hstep, voffB);
            PG8_WAIT_V(6); PG8_BAR; PG8_MMA(1, 1, At, B1); PG8_BAR;
            PG8_LDB(B0, 1, 0); PG8_SCHED; PG8_LDA(At, 1, 0); PG8_STAGE(PG8_SA(0, 1), a2 + hstepA, voffA);
            PG8_WAIT_L(8); PG8_BAR; PG8_WAIT_L(0); PG8_MMA(0, 0, At, B0); PG8_BAR; PG8_SCHED;
            PG8_LDB(B1, 1, 1); PG8_STAGE(PG8_SB(1, 0), b3, voffB);
            PG8_BAR; PG8_WAIT_L(0); PG8_MMA(0, 1, At, B1); PG8_BAR;
            PG8_LDA(At, 1, 1); PG8_STAGE(PG8_SA(1, 0), a3, voffA);
            PG8_BAR; PG8_WAIT_L(0); PG8_MMA(1, 0, At, B0); PG8_BAR; PG8_SCHED;
            PG8_STAGE(PG8_SB(1, 1), b3 + hstep, voffB);
            PG8_WAIT_V(6); PG8_BAR; PG8_MMA(1, 1, At, B1); PG8_BAR;
            }
        }
        if constexpr (ALIGN_EPI) { if (wr == 0) PG8_BAR; }
        if constexpr (!Epi::AFTER_DRAIN) { E(acc, cur, wr, wc, fr, fq); S.done(cur); }
        if (!has_next) break;
#pragma unroll
        for (int a = 0; a < 2; ++a)
#pragma unroll
            for (int b = 0; b < 2; ++b)
#pragma unroll
                for (int m = 0; m < 4; ++m)
#pragma unroll
                    for (int n = 0; n < 2; ++n) acc[a][b][m][n] = (f32x4){0.f, 0.f, 0.f, 0.f};
        cur = nxt; cA = nA; cB = nB; ++ui;
        if constexpr (ALIGN_EPI) { if (wr == 1) PG8_BAR; }
    }
    PG8_WAIT_V(0);
    if constexpr (!ALIGN_EPI) { if (wr == 0) PG8_BAR; }
    PG8_BAR;
    if constexpr (Epi::AFTER_DRAIN) { E.fused(acc, cur, wr, wc, fr, fq, lds, wid, lane); S.done(cur); }
#undef PG8_SA
#undef PG8_SB
#undef PG8_STAGE
#undef PG8_LDA
#undef PG8_LDB
#undef PG8_MMA
#undef PG8_WAIT_V
#undef PG8_WAIT_L
#undef PG8_BAR
#undef PG8_SCHED
}

struct EpiStoreBf16 {
    static constexpr bool PERM = true, AFTER_DRAIN = false;
    bf16_t* O; int ldc; int split_cols; size_t split_stride;
    __device__ __forceinline__ void operator()(const f32x4 (&acc)[2][2][4][2], const Unit& u, int wr, int wc, int fr, int fq) const {
        int colt = u.pn * BM; bf16_t* base = O;
        if (split_cols) { const int t = colt / split_cols; base += (size_t)t * split_stride; colt -= t * split_cols; }
        const int row0 = u.pm * BM + wr * 64 + fr, col0 = colt + wc * 32 + 8 * fq;
#pragma unroll
        for (int ai = 0; ai < 2; ++ai)
#pragma unroll
            for (int m = 0; m < 4; ++m) { bf16_t* rowp = base + (size_t)(row0 + ai * HALF + m * 16) * ldc + col0;
#pragma unroll
                for (int bj = 0; bj < 2; ++bj) { const f32x4 v0 = acc[ai][bj][m][0], v1 = acc[ai][bj][m][1];
                    u32x4 w; w.x = cvt_pk_bf16(v0[0], v0[1]); w.y = cvt_pk_bf16(v0[2], v0[3]); w.z = cvt_pk_bf16(v1[0], v1[1]); w.w = cvt_pk_bf16(v1[2], v1[3]);
                    *(u32x4*)(rowp + bj * HALF) = w; } }
    }
};
struct EpiResidF32 {
    static constexpr bool PERM = false, AFTER_DRAIN = false;
    const float* resid; float* out; int ldc; float alpha;
    __device__ __forceinline__ void operator()(const f32x4 (&acc)[2][2][4][2], const Unit& u, int wr, int wc, int fr, int fq) const {
        const int row0 = u.pm * BM + wr * 64 + fr, col0 = u.pn * BM + wc * 32 + 4 * fq;
#pragma unroll
        for (int ai = 0; ai < 2; ++ai)
#pragma unroll
            for (int m = 0; m < 4; ++m) { const size_t off = (size_t)(row0 + ai * HALF + m * 16) * ldc + col0;
#pragma unroll
                for (int bj = 0; bj < 2; ++bj)
#pragma unroll
                    for (int n = 0; n < 2; ++n) { const size_t o = off + bj * HALF + n * 16; *(f32x4*)(out + o) = *(const f32x4*)(resid + o) * alpha + acc[ai][bj][m][n]; } }
    }
};
__device__ __forceinline__ float fast_sigm(float x) { return __builtin_amdgcn_rcpf(1.f + __expf(-x)); }
struct EpiSwiglu {
    static constexpr bool PERM = true, AFTER_DRAIN = false;
    bf16_t* HID;
    __device__ __forceinline__ void operator()(const f32x4 (&acc)[2][2][4][2], const Unit& u, int wr, int wc, int fr, int fq) const {
        const int row0 = u.pm * BM + wr * 64 + fr, h0 = u.pn * 128 + wc * 16 + 4 * fq;
#pragma unroll
        for (int ai = 0; ai < 2; ++ai)
#pragma unroll
            for (int m = 0; m < 4; ++m) { bf16_t* rowp = HID + (size_t)(row0 + ai * HALF + m * 16) * 512 + h0;
#pragma unroll
                for (int bj = 0; bj < 2; ++bj) { const f32x4 a = acc[ai][bj][m][0], b = acc[ai][bj][m][1]; f32x4 h;
#pragma unroll
                    for (int j = 0; j < 4; ++j) h[j] = a[j] * fast_sigm(a[j]) * b[j];
                    typedef unsigned u32x2v __attribute__((ext_vector_type(2)));
                    u32x2v w; w.x = cvt_pk_bf16(h[0], h[1]); w.y = cvt_pk_bf16(h[2], h[3]);
                    *(u32x2v*)(rowp + bj * 64) = w; } }
    }
};
struct EpiGlu {
    static constexpr bool PERM = true, AFTER_DRAIN = false;
    const float* ysrc; int ldy; const float* bias; bf16_t* O; int ldc;
    __device__ __forceinline__ void operator()(const f32x4 (&acc)[2][2][4][2], const Unit& u, int wr, int wc, int fr, int fq) const {
        const int row0 = u.pm * BM + wr * 64 + fr, col0 = u.pn * BM + wc * 32 + 8 * fq;
#pragma unroll
        for (int ai = 0; ai < 2; ++ai)
#pragma unroll
            for (int m = 0; m < 4; ++m) { const int row = row0 + ai * HALF + m * 16;
#pragma unroll
                for (int bj = 0; bj < 2; ++bj) { const int col = col0 + bj * HALF;
                    const f32x4 y0 = *(const f32x4*)(ysrc + (size_t)row * ldy + col), y1 = *(const f32x4*)(ysrc + (size_t)row * ldy + col + 4);
                    const f32x4 b0 = *(const f32x4*)(bias + col), b1 = *(const f32x4*)(bias + col + 4);
                    f32x4 v0 = acc[ai][bj][m][0] + b0, v1 = acc[ai][bj][m][1] + b1;
#pragma unroll
                    for (int j = 0; j < 4; ++j) { v0[j] = y0[j] * fast_sigm(v0[j]); v1[j] = y1[j] * fast_sigm(v1[j]); }
                    u32x4 w; w.x = cvt_pk_bf16(v0[0], v0[1]); w.y = cvt_pk_bf16(v0[2], v0[3]); w.z = cvt_pk_bf16(v1[0], v1[1]); w.w = cvt_pk_bf16(v1[2], v1[3]);
                    *(u32x4*)(O + (size_t)row * ldc + col) = w; } }
    }
};
struct EpiStoreF32 {
    static constexpr bool PERM = false, AFTER_DRAIN = false;
    float* out; int ldc;
    __device__ __forceinline__ void operator()(const f32x4 (&acc)[2][2][4][2], const Unit& u, int wr, int wc, int fr, int fq) const {
        const int row0 = u.pm * BM + wr * 64 + fr, col0 = u.pn * BM + wc * 32 + 4 * fq;
#pragma unroll
        for (int ai = 0; ai < 2; ++ai)
#pragma unroll
            for (int m = 0; m < 4; ++m) { const size_t off = (size_t)(row0 + ai * HALF + m * 16) * ldc + col0;
#pragma unroll
                for (int bj = 0; bj < 2; ++bj)
#pragma unroll
                    for (int n = 0; n < 2; ++n) *(f32x4*)(out + off + bj * HALF + n * 16) = acc[ai][bj][m][n]; }
    }
};
struct EpiS5Y {
    static constexpr bool PERM = false, AFTER_DRAIN = false;
    const bf16_t* P1; const float* dvec; float* YS5; bf16_t* YS5B;
    __device__ __forceinline__ void operator()(const f32x4 (&acc)[2][2][4][2], const Unit& u, int wr, int wc, int fr, int fq) const {
        const int g = u.pm >> 1, ch = g * 16 + 4 * fq;
        const f32x4 dd = *(const f32x4*)(dvec + ch);
#pragma unroll
        for (int ai = 0; ai < 2; ++ai)
#pragma unroll
            for (int m = 0; m < 4; ++m) {
                const int bc = (u.pm & 1) * 256 + ai * HALF + wr * 64 + m * 16 + fr, b = bc >> 8, c32 = bc & 255;
#pragma unroll
                for (int bj = 0; bj < 2; ++bj)
#pragma unroll
                    for (int n = 0; n < 2; ++n) {
                        const int i = 16 * u.pn + 8 * bj + 2 * wc + n;
                        const size_t t = (size_t)b * 8192 + c32 * 32 + i;
                        typedef unsigned u32x2v __attribute__((ext_vector_type(2)));
                        const u32x2v uu = *(const u32x2v*)(P1 + t * 2560 + ch);
                        f32x4 uv; uv[0] = __uint_as_float(uu.x << 16); uv[1] = __uint_as_float(uu.x & 0xffff0000u); uv[2] = __uint_as_float(uu.y << 16); uv[3] = __uint_as_float(uu.y & 0xffff0000u);
                        f32x4 y = acc[ai][bj][m][n] + dd * uv;
#pragma unroll
                        for (int j = 0; j < 4; ++j) { const float x = y[j]; const float tt = 0.7978845608028654f * (x + 0.044715f * x * x * x); y[j] = 0.5f * x * (1.f + tanhf(tt)); }
                        *(f32x4*)(YS5 + t * 512 + ch) = y;
                        u32x2v w; w.x = cvt_pk_bf16(y[0], y[1]); w.y = cvt_pk_bf16(y[2], y[3]);
                        *(u32x2v*)(YS5B + t * 512 + ch) = w;
                    }
            }
    }
};
struct MoeOrder {
    int ntiles, nN, G, c; const PG8_LAS int* tile_e;
    __device__ __forceinline__ bool next(int i, Unit& u) const {
        const int L = i * G + c; if (L >= ntiles * nN) return false;
        u.pm = L / nN; u.pn = L % nN; u.pb = tile_e[u.pm] * nN + u.pn; return true;
    }
    __device__ __forceinline__ void a_ready(const Unit&) const {}
    __device__ __forceinline__ void done(const Unit&) const {}
};
}

#define XB_TMO      128
#define XB_XCNT(j)  (256  + 64 * (j))
#define XB_XSUB(j)  (1280 + 64 * (j))
#define XB_XGEN(j)  (2304 + 64 * (j))
#define XB_TOP      3328
#define XB_TOPGEN   3392
#define XCD_BAR_WORDS 3456
#define XB_SPIN_CAP (1u << 18)
__device__ __forceinline__ unsigned xb_ld(unsigned* p)              { return __hip_atomic_load(p, __ATOMIC_RELAXED, __HIP_MEMORY_SCOPE_AGENT); }
__device__ __forceinline__ unsigned xb_add(unsigned* p, unsigned v) { return __hip_atomic_fetch_add(p, v, __ATOMIC_RELAXED, __HIP_MEMORY_SCOPE_AGENT); }
__device__ __forceinline__ unsigned xb_xcc_id() { return (unsigned)__builtin_amdgcn_s_getreg((3 << 11) | 20) & 0xFu; }
#define XB_SPIN(cond, bar) do { unsigned _sp = 0; while (cond) { __builtin_amdgcn_s_sleep(1); \
    if ((++_sp & 255u) == 0u) { if (xb_ld(&(bar)[XB_TMO])) break; if (_sp > XB_SPIN_CAP) { atomicAdd(&(bar)[XB_TMO], 1u); break; } } } } while (0)
struct XcdBarrier { unsigned* bar; unsigned x; volatile LAS unsigned* st; };
__device__ __forceinline__ XcdBarrier xcd_barrier_post(unsigned* bar, volatile LAS unsigned* st) {
    XcdBarrier b; b.bar = bar; b.x = xb_xcc_id(); b.st = st;
    if (TIDX == 0) (void)xb_add(&bar[XB_XCNT(b.x)], 1u);
    return b;
}
__device__ __forceinline__ void xcd_barrier_complete(unsigned* bar, unsigned x, unsigned& nloc, unsigned& nx) {
    const unsigned G = gridDim.x;
    unsigned sum, cnt, mine, sp = 0u;
    for (;;) {
        sum = 0u; cnt = 0u; mine = 0u;
#pragma unroll
        for (unsigned j = 0; j < 16; ++j) { const unsigned c = xb_ld(&bar[XB_XCNT(j)]); sum += c; cnt += (c > 0u) ? 1u : 0u; mine = (j == x) ? c : mine; }
        if (sum == G) break;
        __builtin_amdgcn_s_sleep(1);
        if ((++sp & 255u) == 0u) { if (xb_ld(&bar[XB_TMO])) break; if (sp > XB_SPIN_CAP) { atomicAdd(&bar[XB_TMO], 1u); break; } }
    }
    nloc = mine > 0u ? mine : 1u; nx = cnt > 0u ? cnt : 1u;
}
__device__ __forceinline__ void xcd_barrier(const XcdBarrier& b) {
    asm volatile("s_waitcnt vmcnt(0)" ::: "memory");
    __syncthreads();
    if (TIDX == 0) {
        unsigned* bar = b.bar;
        __builtin_amdgcn_s_waitcnt(0);
        unsigned nloc = b.st[0], nx = b.st[1];
        if (nloc == 0u) { xcd_barrier_complete(bar, b.x, nloc, nx); b.st[0] = nloc; b.st[1] = nx; }
        const unsigned old = xb_add(&bar[XB_XSUB(b.x)], 1u);
        const unsigned gen = old / nloc;
        if (old + 1u == (gen + 1u) * nloc) {
            __builtin_amdgcn_fence(__ATOMIC_RELEASE, "agent");
            asm volatile("s_waitcnt vmcnt(0)" ::: "memory");
            const unsigned og = xb_add(&bar[XB_TOP], 1u);
            const unsigned tg = og / nx;
            if (og + 1u == (tg + 1u) * nx) xb_add(&bar[XB_TOPGEN], 1u);
            else XB_SPIN(xb_ld(&bar[XB_TOPGEN]) == tg, bar);
            __builtin_amdgcn_fence(__ATOMIC_ACQUIRE, "agent");
            xb_add(&bar[XB_XGEN(b.x)], 1u);
            asm volatile("s_waitcnt vmcnt(0)" ::: "memory");
        } else {
            XB_SPIN(xb_ld(&bar[XB_XGEN(b.x)]) == gen, bar);
            __builtin_amdgcn_fence(__ATOMIC_ACQUIRE, "agent");
            asm volatile("s_waitcnt vmcnt(0)" ::: "memory");
        }
    }
    __syncthreads();
}


typedef short bf16x8 __attribute__((ext_vector_type(8)));
struct GlaBufs { bf16_t* QT; bf16_t* KT; bf16_t* KDT; bf16_t* VT; float* DG; float* DS; bf16_t* SP; };
__device__ __forceinline__ float logsigf(float x) { return fminf(x, 0.f) - log1pf(__expf(-fabsf(x))); }

template <int K, int LAYER>
__device__ __forceinline__ void gla_prep_tile(LAS float* lds, const bf16_t* P, const float* aux0, const float* aux1, const GlaBufs& B, int cg) {
    constexpr int HK = 4 * K, KP = K + 1;
    LAS float* G = lds;
    LAS float* KR = lds + 64 * KP;
    LAS float* LV = lds + 2 * 64 * KP;
    const int tid = TIDX, lane = tid & 63, wave = tid >> 6;
    const int t0 = cg * 64;
    for (int h = 0; h < 4; ++h) {
        for (int idx = tid; idx < 64 * K; idx += NTHREADS) {
            const int t = idx / K, k = idx % K, ck = h * K + k;
            float g, kr;
            if (LAYER == 0) {
                const bf16_t* row = P + (size_t)(t0 + t) * NIN0P;
                float gk = aux1[ck];
#pragma unroll
                for (int i = 0; i < 16; ++i) gk += bf2f(row[2816 + i]) * aux0[i * 256 + ck];
                g = logsigf(gk) * (1.f / 16.f);
                kr = bf2f(row[2048 + ck]);
            } else {
                const bf16_t* row = P + (size_t)(t0 + t) * NIN1;
                const float lbv = 1.f / (1.f + __expf(aux0[ck] - aux0[512 + ck]));
                const float sg = sigm(bf2f(row[1024 + ck]));
                g = __logf(lbv + (1.f - lbv) * sg);
                kr = (1.f - lbv) * (1.f - sg);
            }
            G[t * KP + k] = g; KR[t * KP + k] = kr;
        }
        for (int idx = tid; idx < 64 * 128; idx += NTHREADS) {
            const int t = idx >> 7, vc = idx & 127;
            LV[t * 129 + vc] = bf2f(LAYER == 0 ? P[(size_t)(t0 + t) * NIN0P + 2304 + h * 128 + vc] : P[(size_t)(t0 + t) * NIN1 + 1536 + h * 128 + vc]);
        }
        __syncthreads();
        for (int k = wave; k < K; k += NWAVES) {
            float v = G[lane * KP + k];
#pragma unroll
            for (int o = 1; o < 64; o <<= 1) { const float n = __shfl_up(v, o); if (lane >= o) v += n; }
            G[lane * KP + k] = v;
        }
        __syncthreads();
        for (int idx = tid; idx < 64 * K; idx += NTHREADS) {
            const int t = idx / K, k = idx % K, ck = h * K + k;
            const float b = G[t * KP + k];
            float q;
            if (LAYER == 0) q = bf2f(P[(size_t)(t0 + t) * NIN0P + 1792 + ck]) * 0.125f;
            else q = siluf(bf2f(P[(size_t)(t0 + t) * NIN1 + 512 + ck]));
            B.QT[(size_t)(t0 + t) * HK + ck] = f2bf(q * __expf(b));
            B.KT[(size_t)(t0 + t) * HK + ck] = f2bf(KR[t * KP + k] * __expf(-b));
        }
        for (int idx = tid; idx < 64 * K; idx += NTHREADS) {
            const int k = idx >> 6, t = idx & 63, ck = h * K + k;
            const float bl = G[63 * KP + k];
            B.KDT[((size_t)cg * HK + ck) * 64 + t] = f2bf(KR[t * KP + k] * __expf(bl - G[t * KP + k]));
            if (t == 0) B.DG[(size_t)cg * HK + ck] = __expf(bl);
        }
        for (int idx = tid; idx < 64 * 128; idx += NTHREADS) {
            const int vc = idx >> 6, t = idx & 63;
            B.VT[((size_t)cg * 512 + h * 128 + vc) * 64 + t] = f2bf(LV[t * 129 + vc]);
        }
        __syncthreads();
    }
}

template <int K>
__device__ __forceinline__ void gla_pass1_unit(const GlaBufs& B, int unit, int lane) {
    constexpr int HK = 4 * K, KT16 = K / 16;
    const int item = unit / KT16, kt = unit % KT16, cg = item >> 2, h = item & 3;
    const int r = lane & 15, q = lane >> 4;
    const bf16_t* ap = B.KDT + ((size_t)cg * HK + h * K + kt * 16 + r) * 64 + 8 * q;
    const bf16x8 a0 = *(const bf16x8*)ap, a1 = *(const bf16x8*)(ap + 32);
    float* dsp = B.DS + ((size_t)item * 128 + r) * K + kt * 16 + 4 * q;
#pragma unroll
    for (int vt = 0; vt < 8; ++vt) {
        const bf16_t* bp = B.VT + ((size_t)cg * 512 + h * 128 + vt * 16 + r) * 64 + 8 * q;
        const bf16x8 b0 = *(const bf16x8*)bp, b1 = *(const bf16x8*)(bp + 32);
        f32x4 acc = {0.f, 0.f, 0.f, 0.f};
        acc = __builtin_amdgcn_mfma_f32_16x16x32_bf16(a0, b0, acc, 0, 0, 0);
        acc = __builtin_amdgcn_mfma_f32_16x16x32_bf16(a1, b1, acc, 0, 0, 0);
        *(f32x4*)(dsp + (size_t)vt * 16 * K) = acc;
    }
}

template <int K>
__device__ __forceinline__ void gla_pass2(const GlaBufs& B, int gthread, int gthreads) {
    constexpr int HK = 4 * K;
    const float* __restrict__ DS = B.DS; const float* __restrict__ DG = B.DG; bf16_t* __restrict__ SP = B.SP;
    for (int e = gthread; e < 8 * 128 * K; e += gthreads) {
        const int k = e % K, v = (e / K) & 127, bh = e / (K * 128), b = bh >> 2, h = bh & 3;
        float S = 0.f;
#pragma unroll 8
        for (int c = 0; c < 128; ++c) {
            const int cg = b * 128 + c;
            const size_t idx = ((size_t)(cg * 4 + h) * 128 + v) * K + k;
            const float d = DG[(size_t)cg * HK + h * K + k], ds = DS[idx];
            SP[idx] = f2bf(S);
            S = d * S + ds;
        }
    }
}

template <int K, int LAYER>
__device__ __forceinline__ void gla_pass3_item(LAS unsigned char* lds, const bf16_t* P, const float* norm_g, const GlaBufs& B, bf16_t* Ymix, int item) {
    constexpr int HK = 4 * K, KS = K / 32;
    LAS bf16_t* Ls = (LAS bf16_t*)lds;
    LAS float* Lo = (LAS float*)(lds + 64 * 72 * 2);
    const int tid = TIDX, lane = tid & 63, wave = tid >> 6, r = lane & 15, q = lane >> 4;
    const int cg = item >> 2, h = item & 3, t0 = cg * 64;
    const int it = wave >> 1, i0 = it * 16;
    bf16x8 qf[KS];
#pragma unroll
    for (int s = 0; s < KS; ++s) qf[s] = *(const bf16x8*)(B.QT + (size_t)(t0 + i0 + r) * HK + h * K + 32 * s + 8 * q);
#pragma unroll
    for (int jj2 = 0; jj2 < 2; ++jj2) {
        const int j0 = ((wave & 1) * 2 + jj2) * 16;
        f32x4 acc = {0.f, 0.f, 0.f, 0.f};
        if (j0 <= i0) {
#pragma unroll
            for (int s = 0; s < KS; ++s) {
                const bf16x8 kf = *(const bf16x8*)(B.KT + (size_t)(t0 + j0 + r) * HK + h * K + 32 * s + 8 * q);
                acc = __builtin_amdgcn_mfma_f32_16x16x32_bf16(kf, qf[s], acc, 0, 0, 0);
            }
        }
        const int i = i0 + r;
        u32x2 w;
        w.x = pk2((j0 + 4 * q + 0) <= i ? acc[0] : 0.f, (j0 + 4 * q + 1) <= i ? acc[1] : 0.f);
        w.y = pk2((j0 + 4 * q + 2) <= i ? acc[2] : 0.f, (j0 + 4 * q + 3) <= i ? acc[3] : 0.f);
        *(LAS u32x2*)(Ls + i * 72 + j0 + 4 * q) = w;
    }
    __syncthreads();
    const bf16x8 sf0 = *(const LAS bf16x8*)(Ls + (i0 + r) * 72 + 8 * q), sf1 = *(const LAS bf16x8*)(Ls + (i0 + r) * 72 + 32 + 8 * q);
#pragma unroll
    for (int vv = 0; vv < 4; ++vv) {
        const int v0 = ((wave & 1) * 4 + vv) * 16;
        f32x4 acc = {0.f, 0.f, 0.f, 0.f};
#pragma unroll
        for (int s = 0; s < KS; ++s) {
            const bf16x8 sp = *(const bf16x8*)(B.SP + ((size_t)item * 128 + v0 + r) * K + 32 * s + 8 * q);
            acc = __builtin_amdgcn_mfma_f32_16x16x32_bf16(sp, qf[s], acc, 0, 0, 0);
        }
        const bf16_t* vp = B.VT + ((size_t)cg * 512 + h * 128 + v0 + r) * 64 + 8 * q;
        const bf16x8 vf0 = *(const bf16x8*)vp, vf1 = *(const bf16x8*)(vp + 32);
        acc = __builtin_amdgcn_mfma_f32_16x16x32_bf16(vf0, sf0, acc, 0, 0, 0);
        acc = __builtin_amdgcn_mfma_f32_16x16x32_bf16(vf1, sf1, acc, 0, 0, 0);
        *(LAS f32x4*)(Lo + (i0 + r) * 132 + v0 + 4 * q) = acc;
    }
    __syncthreads();
#pragma unroll 2
    for (int rr = 0; rr < 8; ++rr) {
        const int i = wave * 8 + rr, t = t0 + i;
        const float o0 = Lo[i * 132 + lane], o1 = Lo[i * 132 + 64 + lane];
        const float ms = wave_sum(o0 * o0 + o1 * o1) * (1.f / 128.f);
        const float rs = rsqrtf(ms + LN_EPS);
        float g0, g1;
        if (LAYER == 0) { g0 = bf2f(P[(size_t)t * NIN0P + 2832 + h * 128 + lane]); g1 = bf2f(P[(size_t)t * NIN0P + 2832 + h * 128 + 64 + lane]); }
        else { g0 = bf2f(P[(size_t)t * NIN1 + 2048 + h * 128 + lane]); g1 = bf2f(P[(size_t)t * NIN1 + 2048 + h * 128 + 64 + lane]); }
        Ymix[(size_t)t * D_ + 512 + h * 128 + lane] = f2bf(o0 * rs * norm_g[lane] * siluf(g0));
        Ymix[(size_t)t * D_ + 512 + h * 128 + 64 + lane] = f2bf(o1 * rs * norm_g[64 + lane] * siluf(g1));
    }
    __syncthreads();
}

__device__ __forceinline__ void sub_barrier(unsigned* ctr, unsigned nblocks) {
    asm volatile("s_waitcnt vmcnt(0)" ::: "memory");
    __syncthreads();
    if (TIDX == 0) {
        __builtin_amdgcn_fence(__ATOMIC_RELEASE, "agent");
        asm volatile("s_waitcnt vmcnt(0)" ::: "memory");
        xb_add(ctr, 1u);
        unsigned sp = 0;
        while (xb_ld(ctr) < nblocks) { __builtin_amdgcn_s_sleep(2); if (++sp > (1u << 22)) break; }
        __builtin_amdgcn_fence(__ATOMIC_ACQUIRE, "agent");
        asm volatile("s_waitcnt vmcnt(0)" ::: "memory");
    }
    __syncthreads();
}


__device__ __forceinline__ void s5_tables(LAS float* lds, const float* a_re, const float* a_im, const float* log_dt, const float* b_re, const float* b_im,
                                          const float* c_re, const float* c_im, bf16_t* MB, bf16_t* WE, int g) {
    LAS float* pwr = lds;
    LAS float* pwi = pwr + 33 * 64;
    LAS float* zbr = pwi + 33 * 64;
    LAS float* zbi = zbr + 1024;
    LAS float* cr = zbi + 1024;
    LAS float* ci = cr + 1024;
    LAS float* kern = ci + 1024;
    const int tid = TIDX;
    if (tid < 64) {
        const int n = tid;
        const float lam_re = fminf(a_re[g * 64 + n], -1e-4f), lam_im = a_im[g * 64 + n];
        const float dt = __expf(log_dt[g]);
        const float mag = __expf(lam_re * dt);
        const float ab_re = mag * cosf(lam_im * dt), ab_im = mag * sinf(lam_im * dt);
        const float den = lam_re * lam_re + lam_im * lam_im;
        const float num_re = ab_re - 1.f;
        const float z_re = (num_re * lam_re + ab_im * lam_im) / den;
        const float z_im = (ab_im * lam_re - num_re * lam_im) / den;
        for (int tau = 0; tau <= 32; ++tau) {
            const float m = __expf(lam_re * dt * (float)tau), ang = lam_im * dt * (float)tau;
            pwr[tau * 64 + n] = m * cosf(ang); pwi[tau * 64 + n] = m * sinf(ang);
        }
        for (int c = 0; c < 16; ++c) {
            const float br = b_re[(size_t)(g * 64 + n) * 16 + c], bi = b_im[(size_t)(g * 64 + n) * 16 + c];
            zbr[n * 16 + c] = z_re * br - z_im * bi; zbi[n * 16 + c] = z_re * bi + z_im * br;
        }
    }
    for (int idx = tid; idx < 1024; idx += NTHREADS) { cr[idx] = c_re[(size_t)g * 1024 + idx]; ci[idx] = c_im[(size_t)g * 1024 + idx]; }
    __syncthreads();
    for (int idx = tid; idx < 32 * 256; idx += NTHREADS) {
        const int tau = idx >> 8, c = (idx >> 4) & 15, cp = idx & 15;
        float acc = 0.f;
        for (int n = 0; n < 64; ++n) {
            const float pr = pwr[tau * 64 + n], pi = pwi[tau * 64 + n], zr = zbr[n * 16 + cp], zi = zbi[n * 16 + cp];
            const float wr = pr * zr - pi * zi, wi = pr * zi + pi * zr;
            acc += cr[c * 64 + n] * wr - ci[c * 64 + n] * wi;
        }
        kern[idx] = acc;
    }
    __syncthreads();
    for (int idx = tid; idx < 512 * 640; idx += NTHREADS) {
        const int row = idx / 640, col = idx % 640, i = row >> 4, c = row & 15;
        float v;
        if (col < 512) { const int j = col >> 4, cp = col & 15; v = (j <= i) ? kern[((i - j) * 16 + c) * 16 + cp] : 0.f; }
        else if (col < 576) { const int n = col - 512; v = cr[c * 64 + n] * pwr[(i + 1) * 64 + n] - ci[c * 64 + n] * pwi[(i + 1) * 64 + n]; }
        else { const int n = col - 576; v = -(cr[c * 64 + n] * pwi[(i + 1) * 64 + n] + ci[c * 64 + n] * pwr[(i + 1) * 64 + n]); }
        MB[((size_t)g * 512 + row) * 640 + col] = f2bf(v);
    }
    for (int idx = tid; idx < 256 * 512; idx += NTHREADS) {
        const int np = idx >> 9, col = idx & 511;
        float v = 0.f;
        if (np < 128) {
            const int n = np & 63, j = col >> 4, cp = col & 15;
            const float pr = pwr[(31 - j) * 64 + n], pi = pwi[(31 - j) * 64 + n], zr = zbr[n * 16 + cp], zi = zbi[n * 16 + cp];
            v = np < 64 ? (pr * zr - pi * zi) : (pr * zi + pi * zr);
        }
        WE[((size_t)g * 256 + np) * 512 + col] = f2bf(v);
    }
    __syncthreads();
}
__device__ __forceinline__ void s5_fill_ua(const bf16_t* P1, bf16_t* UA, int gw, int ngw, int lane) {
    for (int t = gw; t < T_; t += ngw) {
        const int b = t >> 13, tt = t & 8191, c32 = tt >> 5, j = tt & 31, g = lane >> 1, c0 = (lane & 1) * 8;
        const u32x4 v = *(const u32x4*)(P1 + (size_t)t * NIN1 + 8 * lane);
        *(u32x4*)(UA + ((size_t)g * 512 + b * 256 + c32) * 640 + j * 16 + c0) = v;
    }
}
__device__ __forceinline__ void s5_carry(const float* a_re, const float* a_im, const float* log_dt, const float* E, bf16_t* UA, int th) {
    const int n = th & 63, g = (th >> 6) & 31, b = th >> 11;
    const float lam_re = fminf(a_re[g * 64 + n], -1e-4f), lam_im = a_im[g * 64 + n];
    const float dt = __expf(log_dt[g]);
    const float m = __expf(lam_re * dt * 32.f), ang = lam_im * dt * 32.f;
    const float ar = m * cosf(ang), ai = m * sinf(ang);
    float hr = 0.f, hi = 0.f;
#pragma unroll 8
    for (int c = 0; c < 256; ++c) {
        const size_t row = (size_t)g * 512 + b * 256 + c;
        const float er = E[row * 256 + n], ei = E[row * 256 + 64 + n];
        UA[row * 640 + 512 + n] = f2bf(hr); UA[row * 640 + 576 + n] = f2bf(hi);
        const float nr = ar * hr - ai * hi + er, ni = ar * hi + ai * hr + ei;
        hr = nr; hi = ni;
    }
}

struct Args {
    const float* in[42];
    float* out;
    unsigned char* ws;
    int ph_lo, ph_hi;
};

template <bool DUAL, class AF, class WF, class EF>
__device__ __forceinline__ void naive_gemm(LAS float* lds, int M, int N, int K, AF arow, WF wbase, int ldw, EF epi) {
    LAS float* As = lds;
    LAS float* Bs = lds + 64 * 33;
    LAS float* Bs2 = Bs + 32 * 64;
    const int tid = TIDX, ty = tid >> 4, tx = tid & 15;
    const int tm = (M + 63) / 64, tn = (N + 63) / 64;
    for (int tile = blockIdx.x; tile < tm * tn; tile += gridDim.x) {
        const int m0 = (tile / tn) * 64, n0 = (tile % tn) * 64;
        const float* W = wbase(m0, 0);
        const float* W2 = DUAL ? wbase(m0, 1) : W;
        float acc[2][4], acc2[2][4];
#pragma unroll
        for (int i = 0; i < 2; ++i)
#pragma unroll
            for (int j = 0; j < 4; ++j) { acc[i][j] = 0.f; acc2[i][j] = 0.f; }
        for (int k0 = 0; k0 < K; k0 += 32) {
#pragma unroll
            for (int i = 0; i < 4; ++i) {
                const int idx = tid + i * 512, r = idx >> 5, kk = idx & 31, m = m0 + r;
                As[r * 33 + kk] = (m < M) ? bf2f(arow(m)[k0 + kk]) : 0.f;
            }
#pragma unroll
            for (int i = 0; i < 4; ++i) {
                const int idx = tid + i * 512, kk = idx >> 6, n = idx & 63;
                const bool ok = (n0 + n) < N;
                Bs[kk * 64 + n] = ok ? W[(size_t)(k0 + kk) * ldw + n0 + n] : 0.f;
                if (DUAL) Bs2[kk * 64 + n] = ok ? W2[(size_t)(k0 + kk) * ldw + n0 + n] : 0.f;
            }
            __syncthreads();
#pragma unroll 8
            for (int kk = 0; kk < 32; ++kk) {
                const float a0 = As[(ty * 2) * 33 + kk], a1 = As[(ty * 2 + 1) * 33 + kk];
#pragma unroll
                for (int j = 0; j < 4; ++j) {
                    const float b = Bs[kk * 64 + tx * 4 + j];
                    acc[0][j] += a0 * b; acc[1][j] += a1 * b;
                    if (DUAL) { const float b2 = Bs2[kk * 64 + tx * 4 + j]; acc2[0][j] += a0 * b2; acc2[1][j] += a1 * b2; }
                }
            }
            __syncthreads();
        }
#pragma unroll
        for (int i = 0; i < 2; ++i)
#pragma unroll
            for (int j = 0; j < 4; ++j) {
                const int m = m0 + ty * 2 + i, n = n0 + tx * 4 + j;
                if (m < M && n < N) epi(m, n, acc[i][j], acc2[i][j]);
            }
    }
}

template <class SRC, class DROW>
__device__ __forceinline__ void xpose_item(SRC src, DROW drow, bf16_t* WT, int ldk, LAS float* scr, int k0, int n0, int lane) {
#pragma unroll 8
    for (int i = 0; i < 32; ++i) { const int kk = 2 * i + (lane >> 5); scr[kk * 33 + (lane & 31)] = src(k0 + kk, n0 + (lane & 31)); }
    asm volatile("s_waitcnt lgkmcnt(0)" ::: "memory");
    const int c = lane & 7;
#pragma unroll
    for (int j = 0; j < 4; ++j) {
        const int n = (lane >> 3) + 8 * j; const LAS float* sp = scr + (8 * c) * 33 + n;
        u32x4 o; o.x = pk2(sp[0 * 33], sp[1 * 33]); o.y = pk2(sp[2 * 33], sp[3 * 33]); o.z = pk2(sp[4 * 33], sp[5 * 33]); o.w = pk2(sp[6 * 33], sp[7 * 33]);
        *(u32x4*)(WT + (size_t)drow(n0 + n) * ldk + k0 + 8 * c) = o;
    }
    asm volatile("s_waitcnt lgkmcnt(0)" ::: "memory");
}
__device__ __forceinline__ void convert_plain(const float* W, int K, int N, int NP, bf16_t* WT, LAS float* scr, int gw, int ngw, int lane) {
    const int nblk = NP / 32, nitems = (K / 64) * nblk;
    for (int it = gw; it < nitems; it += ngw) {
        const int k0 = 64 * (it / nblk), n0 = 32 * (it % nblk);
        xpose_item([&](int k, int n) { return n < N ? W[(size_t)k * N + n] : 0.f; }, [&](int n) { return n; }, WT, K, scr, k0, n0, lane);
    }
}
__device__ __forceinline__ void convert_lora(const float* w2, const float* a2, const float* g2, bf16_t* WT, LAS float* scr, int gw, int ngw, int lane) {
    const int nblk = NLORA / 32, nitems = 4 * nblk;
    for (int it = gw; it < nitems; it += ngw) {
        const int k0 = 64 * (it / nblk), n0 = 32 * (it % nblk);
        xpose_item([&](int k, int n) {
            if (n < 512) return k < 64 ? w2[k * 512 + n] : 0.f;
            if (n < 1024) return (k >= 64 && k < 128) ? a2[(k - 64) * 512 + (n - 512)] : 0.f;
            return k >= 128 ? g2[(k - 128) * 512 + (n - 1024)] : 0.f; }, [&](int n) { return n; }, WT, 256, scr, k0, n0, lane);
    }
}
__device__ __forceinline__ void convert_moe(const float* w1, const float* w3, const float* w2, bf16_t* W13, bf16_t* W2T, LAS float* scr, int gw, int ngw, int lane) {
    constexpr int I13 = 16 * 32, I2 = 8 * 32, IE = I13 + I2;
    for (int it = gw; it < 32 * IE; it += ngw) {
        const int e = it / IE, r = it % IE;
        if (r < I13) {
            const int k0 = 64 * (r / 32), n0 = 32 * (r % 32);
            const float* a = w1 + (size_t)e * D_ * 512; const float* b = w3 + (size_t)e * D_ * 512;
            xpose_item([&](int k, int n) { return n < 512 ? a[(size_t)k * 512 + n] : b[(size_t)k * 512 + (n - 512)]; },
                       [&](int n) { const int c = n & 511; return (c >> 2) * 8 + (n >> 9) * 4 + (c & 3); }, W13 + (size_t)e * 1024 * 1024, 1024, scr, k0, n0, lane);
        } else {
            const int rr = r - I13, k0 = 64 * (rr / 32), n0 = 32 * (rr % 32);
            const float* a = w2 + (size_t)e * 512 * D_;
            xpose_item([&](int k, int n) { return a[(size_t)k * D_ + n]; }, [&](int n) { return n; }, W2T + (size_t)e * 1024 * 512, 512, scr, k0, n0, lane);
        }
    }
}

__device__ __forceinline__ void ph_prologue(const float* x, bf16_t* hb) {
    const size_t n4 = (size_t)T_ * D_ / 4;
    for (size_t i = (size_t)blockIdx.x * NTHREADS + TIDX; i < n4; i += (size_t)gridDim.x * NTHREADS) {
        const f32x4 v = ((const f32x4*)x)[i];
        u32x2 o; o.x = pk2(v.x, v.y); o.y = pk2(v.z, v.w);
        ((u32x2*)hb)[i] = o;
    }
    for (size_t i = (size_t)blockIdx.x * NTHREADS + TIDX; i < (size_t)256 * D_ / 2; i += (size_t)gridDim.x * NTHREADS)
        ((unsigned*)(hb + (size_t)T_ * D_))[i] = 0u;
}

__device__ __forceinline__ float p0_shift(const bf16_t* P, const float* mu, int t, int c) {
    const float p = bf2f(P[(size_t)t * NIN0P + c]);
    const float pv = ((t & (L_ - 1)) == 0) ? 0.f : bf2f(P[(size_t)(t - 1) * NIN0P + c]);
    return p + mu[c] * (pv - p);
}
template <bool WITH_GLA>
__device__ __forceinline__ void ph_prepA0(const bf16_t* P, const float* mu, const float* gk_w2, const float* gk_b, bf16_t* Ap, float* gla_la) {
    for (int chunk = blockIdx.x; chunk < T_ / 64; chunk += gridDim.x) {
        for (int idx = TIDX; idx < 64 * 256; idx += NTHREADS) {
            const int tl = idx >> 8, j = idx & 255, t = chunk * 64 + tl;
            float v;
            if (j < 64) v = tanhf(p0_shift(P, mu, t, 512 + j));
            else if (j < 128) v = p0_shift(P, mu, t, 1600 + (j - 64));
            else v = sigm(p0_shift(P, mu, t, 1664 + (j - 128)));
            Ap[(size_t)t * 256 + j] = f2bf(v);
            if (WITH_GLA) {
                float gk = gk_b[j];
#pragma unroll
                for (int i = 0; i < 16; ++i) gk += bf2f(P[(size_t)t * NIN0P + 2816 + i]) * gk_w2[i * 256 + j];
                const float ls = fminf(gk, 0.f) - log1pf(__expf(-fabsf(gk)));
                gla_la[(size_t)t * 256 + j] = ls * (1.f / 16.f);
            }
        }
    }
}

__device__ __forceinline__ void ph_prepB0(const bf16_t* P, const bf16_t* LO, const float* mu, const float* w0, const float* a0, const float* k_k, const float* k_a,
                                          const float* r_k, bf16_t* SC, float* BON) {
    const int wave = TIDX >> 6, lane = TIDX & 63;
    for (int item = blockIdx.x * NWAVES + wave; item < T_ * 8; item += gridDim.x * NWAVES) {
        const int t = item >> 3, h = item & 7, c = h * 64 + lane;
        const float r = p0_shift(P, mu, t, c), k = p0_shift(P, mu, t, 576 + c), v = p0_shift(P, mu, t, 1088 + c);
        const float low = bf2f(LO[(size_t)t * 512 + c]), loa = bf2f(LO[(size_t)T_ * 512 + (size_t)t * 512 + c]);
        const float xw = w0[c] + low;
        const float wraw = -softplusf(-xw) - 0.5f;
        const float ld = -__expf(wraw);
        const float a = sigm(a0[c] + loa);
        const float kkr = k * k_k[c];
        const float ss = wave_sum(kkr * kkr);
        const float kk = kkr / fmaxf(sqrtf(ss), 1e-12f);
        const float kp = k * (1.f + (a - 1.f) * k_a[c]);
        const float bon = wave_sum(r * kp * r_k[c]);
        const size_t o = (size_t)t * 512 + c, S1 = (size_t)T_ * 512;
        SC[o] = f2bf(r); SC[S1 + o] = f2bf(ld); SC[2 * S1 + o] = f2bf(kp); SC[3 * S1 + o] = f2bf(v); SC[4 * S1 + o] = f2bf(kk); SC[5 * S1 + o] = f2bf(a);
        if (lane == 0) BON[(size_t)t * 8 + h] = bon;
    }
}

__device__ __forceinline__ void naive_rwkv_scan(LAS float* lds, const bf16_t* SC, float* YRW, int bh) {
    constexpr int TS = 32;
    const int b = bh >> 3, h = bh & 7;
    LAS float* Lnkk = lds;
    LAS float* Ldec = lds + TS * 64;
    LAS float* Lab = lds + 2 * TS * 64;
    LAS float* Lkp = lds + 3 * TS * 64;
    LAS float* Lr = lds + 4 * TS * 64;
    LAS float* Lv = lds + 5 * TS * 64;
    const size_t S1 = (size_t)T_ * 512;
    float S[64];
#pragma unroll
    for (int k = 0; k < 64; ++k) S[k] = 0.f;
    const int lane = TIDX & 63, wave = TIDX >> 6;
    for (int t0 = 0; t0 < L_; t0 += TS) {
        for (int idx = TIDX; idx < TS * 64; idx += NTHREADS) {
            const int s = idx >> 6, k = idx & 63;
            const size_t o = (size_t)(b * L_ + t0 + s) * 512 + h * 64 + k;
            const float r = bf2f(SC[o]), ld = bf2f(SC[S1 + o]), kp = bf2f(SC[2 * S1 + o]), v = bf2f(SC[3 * S1 + o]), kk = bf2f(SC[4 * S1 + o]), a = bf2f(SC[5 * S1 + o]);
            Lnkk[idx] = -kk; Ldec[idx] = __expf(ld); Lab[idx] = kk * a; Lkp[idx] = kp; Lr[idx] = r; Lv[idx] = v;
        }
        __syncthreads();
        if (wave == 0) {
            for (int s = 0; s < TS; ++s) {
                float sa = 0.f;
#pragma unroll
                for (int k = 0; k < 64; ++k) sa += S[k] * Lnkk[s * 64 + k];
                const float vv = Lv[s * 64 + lane];
                float y = 0.f;
#pragma unroll
                for (int k = 0; k < 64; ++k) {
                    S[k] = S[k] * Ldec[s * 64 + k] + sa * Lab[s * 64 + k] + vv * Lkp[s * 64 + k];
                    y += S[k] * Lr[s * 64 + k];
                }
                YRW[(size_t)(b * L_ + t0 + s) * 512 + h * 64 + lane] = y;
            }
        }
        __syncthreads();
    }
}

template <int K, class LDF, class LVF>
__device__ __forceinline__ void naive_gla_scan(LAS float* lds, LDF ld, LVF lv, float* OG, int b, int h) {
    constexpr int TS = 16;
    LAS float* Lq = lds;
    LAS float* Lk = lds + TS * K;
    LAS float* Le = lds + 2 * TS * K;
    LAS float* Lv = lds + 3 * TS * K;
    float S[K];
#pragma unroll
    for (int k = 0; k < K; ++k) S[k] = 0.f;
    const int tid = TIDX;
    for (int t0 = 0; t0 < L_; t0 += TS) {
        for (int idx = tid; idx < TS * K; idx += NTHREADS) {
            const int s = idx / K, k = idx % K;
            float q, kk, e; ld(b * L_ + t0 + s, h * K + k, q, kk, e);
            Lq[idx] = q; Lk[idx] = kk; Le[idx] = e;
        }
        for (int idx = tid; idx < TS * 128; idx += NTHREADS) {
            const int s = idx >> 7, vc = idx & 127;
            Lv[idx] = lv(b * L_ + t0 + s, h * 128 + vc);
        }
        __syncthreads();
        if (tid < 128) {
            for (int s = 0; s < TS; ++s) {
                const float vv = Lv[s * 128 + tid];
                float o = 0.f;
#pragma unroll
                for (int k = 0; k < K; ++k) {
                    S[k] = S[k] * Le[s * K + k] + Lk[s * K + k] * vv;
                    o += Lq[s * K + k] * S[k];
                }
                OG[(size_t)(b * L_ + t0 + s) * 512 + h * 128 + tid] = o;
            }
        }
        __syncthreads();
    }
}

template <bool WITH_GLA>
__device__ __forceinline__ void ph_fin0(const float* YRW, const float* OG, const bf16_t* P, const bf16_t* LO, const bf16_t* SC, const float* BON,
                                        const float* gn_g, const float* gn_b, const float* norm_g, bf16_t* Ymix) {
    const int wave = TIDX >> 6, lane = TIDX & 63;
    const size_t S1 = (size_t)T_ * 512;
    constexpr int NU = WITH_GLA ? 12 : 8;
    for (int item = blockIdx.x * NWAVES + wave; item < T_ * NU; item += gridDim.x * NWAVES) {
        const int t = item / NU, u = item % NU;
        if (u < 8) {
            const int c = u * 64 + lane;
            const float y = YRW[(size_t)t * 512 + c];
            const float mean = wave_sum(y) * (1.f / 64.f);
            const float d = y - mean;
            const float var = wave_sum(d * d) * (1.f / 64.f);
            const float yn = d * rsqrtf(var + 64e-5f) * gn_g[c] + gn_b[c];
            const float v = bf2f(SC[3 * S1 + (size_t)t * 512 + c]);
            const float g = bf2f(LO[(size_t)2 * T_ * 512 + (size_t)t * 512 + c]);
            Ymix[(size_t)t * D_ + c] = f2bf((yn + BON[(size_t)t * 8 + u] * v) * g);
        } else {
            const int h = u - 8;
            const float o0 = OG[(size_t)t * 512 + h * 128 + lane], o1 = OG[(size_t)t * 512 + h * 128 + 64 + lane];
            const float ms = wave_sum(o0 * o0 + o1 * o1) * (1.f / 128.f);
            const float rs = rsqrtf(ms + LN_EPS);
            const float g0 = bf2f(P[(size_t)t * NIN0P + 2832 + h * 128 + lane]), g1 = bf2f(P[(size_t)t * NIN0P + 2832 + h * 128 + 64 + lane]);
            Ymix[(size_t)t * D_ + 512 + h * 128 + lane] = f2bf(o0 * rs * norm_g[lane] * siluf(g0));
            Ymix[(size_t)t * D_ + 512 + h * 128 + 64 + lane] = f2bf(o1 * rs * norm_g[64 + lane] * siluf(g1));
        }
    }
}

__device__ __forceinline__ void ph_ln_router(const float* src, float* hf, bf16_t* hb, const float* lg, const float* lb, const float* wg, const float* bg,
                                             const float* we, const float* be, int* tok_e, int* tok_slot, float* tok_g, unsigned* cnt) {
    const int wave = TIDX >> 6, lane = TIDX & 63;
    for (int t = blockIdx.x * NWAVES + wave; t < T_; t += gridDim.x * NWAVES) {
        const f32x4* xr = (const f32x4*)(src + (size_t)t * D_) + lane;
        f32x4 v[4]; float s = 0.f;
#pragma unroll
        for (int j = 0; j < 4; ++j) { v[j] = xr[64 * j]; s += (v[j].x + v[j].y) + (v[j].z + v[j].w); }
        const float mean = wave_sum(s) * (1.f / D_);
        float s2 = 0.f;
#pragma unroll
        for (int j = 0; j < 4; ++j) { v[j] = v[j] - mean; s2 += (v[j].x * v[j].x + v[j].y * v[j].y) + (v[j].z * v[j].z + v[j].w * v[j].w); }
        const float rstd = rsqrtf(wave_sum(s2) * (1.f / D_) + LN_EPS);
#pragma unroll
        for (int j = 0; j < 4; ++j) {
            const f32x4 g = ((const f32x4*)lg)[lane + 64 * j], bb = ((const f32x4*)lb)[lane + 64 * j];
            v[j] = v[j] * rstd * g + bb;
            ((f32x4*)(hf + (size_t)t * D_))[lane + 64 * j] = v[j];
            u32x2 o; o.x = pk2(v[j].x, v[j].y); o.y = pk2(v[j].z, v[j].w);
            ((u32x2*)(hb + (size_t)t * D_))[lane + 64 * j] = o;
        }
        float cl[4] = {0.f, 0.f, 0.f, 0.f};
#pragma unroll
        for (int j = 0; j < 4; ++j)
#pragma unroll
            for (int e = 0; e < 4; ++e) {
                const int d = 4 * (lane + 64 * j) + e;
                const f32x4 w = *(const f32x4*)(wg + (size_t)d * 4);
                const float xv = v[j][e];
                cl[0] += xv * w.x; cl[1] += xv * w.y; cl[2] += xv * w.z; cl[3] += xv * w.w;
            }
#pragma unroll
        for (int g = 0; g < 4; ++g) cl[g] = wave_sum(cl[g]) + bg[g];
        int grp = 0; float mx = cl[0];
#pragma unroll
        for (int g = 1; g < 4; ++g) if (cl[g] > mx) { mx = cl[g]; grp = g; }
        float den = 0.f;
#pragma unroll
        for (int g = 0; g < 4; ++g) den += __expf(cl[g] - mx);
        const float p_grp = 1.f / den;
        float fl[8];
#pragma unroll
        for (int e = 0; e < 8; ++e) fl[e] = 0.f;
        const float* weg = we + (size_t)grp * D_ * 8;
#pragma unroll
        for (int j = 0; j < 4; ++j)
#pragma unroll
            for (int e = 0; e < 4; ++e) {
                const int d = 4 * (lane + 64 * j) + e;
                const f32x4 w0 = *(const f32x4*)(weg + (size_t)d * 8), w1 = *(const f32x4*)(weg + (size_t)d * 8 + 4);
                const float xv = v[j][e];
                fl[0] += xv * w0.x; fl[1] += xv * w0.y; fl[2] += xv * w0.z; fl[3] += xv * w0.w;
                fl[4] += xv * w1.x; fl[5] += xv * w1.y; fl[6] += xv * w1.z; fl[7] += xv * w1.w;
            }
#pragma unroll
        for (int e = 0; e < 8; ++e) fl[e] = wave_sum(fl[e]) + be[grp * 8 + e];
        int j0 = 0; float m0 = fl[0];
#pragma unroll
        for (int e = 1; e < 8; ++e) if (fl[e] > m0) { m0 = fl[e]; j0 = e; }
        int j1 = -1; float m1 = -3.0e38f;
#pragma unroll
        for (int e = 0; e < 8; ++e) if (e != j0 && fl[e] > m1) { m1 = fl[e]; j1 = e; }
        const float e1 = __expf(m1 - m0);
        const float g0 = p_grp / (1.f + e1), g1 = p_grp * e1 / (1.f + e1);
        if (lane == 0) {
            const int ex0 = grp * 8 + j0, ex1 = grp * 8 + j1;
            const unsigned s0 = atomicAdd(&cnt[ex0], 1u), s1 = atomicAdd(&cnt[ex1], 1u);
            tok_e[2 * t] = ex0; tok_e[2 * t + 1] = ex1;
            tok_slot[2 * t] = (int)s0; tok_slot[2 * t + 1] = (int)s1;
            tok_g[2 * t] = g0; tok_g[2 * t + 1] = g1;
        }
    }
}

__device__ __forceinline__ void moe_offsets(LAS int* pst, const unsigned* cnt) {
    if (TIDX == 0) {
        int acc = 0;
        for (int e = 0; e < 32; ++e) { pst[e] = acc; const int c = (int)cnt[e]; acc += (c + MOE_PAD - 1) / MOE_PAD * MOE_PAD; }
        pst[32] = acc;
    }
    __syncthreads();
}
__device__ __forceinline__ int moe_expert_of_row(const LAS int* pst, int r) {
    int e = 0;
#pragma unroll 1
    for (int i = 1; i < 32; ++i) if (r >= pst[i]) e = i;
    return e;
}

__device__ __forceinline__ void ph_dispatch(LAS int* pst, const unsigned* cnt, const bf16_t* hb, const int* tok_e, const int* tok_slot, int* tok_dest, bf16_t* XR) {
    moe_offsets(pst, cnt);
    const int wave = TIDX >> 6, lane = TIDX & 63;
    for (int item = blockIdx.x * NWAVES + wave; item < T_ * 2; item += gridDim.x * NWAVES) {
        const int t = item >> 1;
        const int e = tok_e[item], dest = pst[e] + tok_slot[item];
        if (lane == 0) tok_dest[item] = dest;
        const u32x4* src = (const u32x4*)(hb + (size_t)t * D_);
        u32x4* dst = (u32x4*)(XR + (size_t)dest * D_);
        dst[lane] = src[lane]; dst[lane + 64] = src[lane + 64];
    }
    const int R = pst[32];
    for (int r = blockIdx.x * NWAVES + wave; r < R; r += gridDim.x * NWAVES) {
        const int e = moe_expert_of_row(pst, r);
        if (r - pst[e] >= (int)cnt[e]) {
            u32x4* dst = (u32x4*)(XR + (size_t)r * D_);
            const u32x4 z = {0u, 0u, 0u, 0u};
            dst[lane] = z; dst[lane + 64] = z;
        }
    }
}

__device__ __forceinline__ void ph_combine_ln(const float* hf, const bf16_t* Y, const int* tok_dest, const float* tok_g, const float* lg, const float* lb, float* outf, bf16_t* hb) {
    const int wave = TIDX >> 6, lane = TIDX & 63;
    for (int t = blockIdx.x * NWAVES + wave; t < T_; t += gridDim.x * NWAVES) {
        const int d0 = tok_dest[2 * t], d1 = tok_dest[2 * t + 1];
        const float g0 = tok_g[2 * t], g1 = tok_g[2 * t + 1];
        f32x4 v[4]; float s = 0.f;
#pragma unroll
        for (int j = 0; j < 4; ++j) {
            const f32x4 h = ((const f32x4*)(hf + (size_t)t * D_))[lane + 64 * j];
            const u32x2 y0 = ((const u32x2*)(Y + (size_t)d0 * D_))[lane + 64 * j], y1 = ((const u32x2*)(Y + (size_t)d1 * D_))[lane + 64 * j];
            f32x4 a, b;
            a.x = __uint_as_float(y0.x << 16); a.y = __uint_as_float(y0.x & 0xffff0000u); a.z = __uint_as_float(y0.y << 16); a.w = __uint_as_float(y0.y & 0xffff0000u);
            b.x = __uint_as_float(y1.x << 16); b.y = __uint_as_float(y1.x & 0xffff0000u); b.z = __uint_as_float(y1.y << 16); b.w = __uint_as_float(y1.y & 0xffff0000u);
            v[j] = h * DN_ALPHA + (a * g0 + b * g1);
            s += (v[j].x + v[j].y) + (v[j].z + v[j].w);
        }
        const float mean = wave_sum(s) * (1.f / D_);
        float s2 = 0.f;
#pragma unroll
        for (int j = 0; j < 4; ++j) { v[j] = v[j] - mean; s2 += (v[j].x * v[j].x + v[j].y * v[j].y) + (v[j].z * v[j].z + v[j].w * v[j].w); }
        const float rstd = rsqrtf(wave_sum(s2) * (1.f / D_) + LN_EPS);
#pragma unroll
        for (int j = 0; j < 4; ++j) {
            const f32x4 g = ((const f32x4*)lg)[lane + 64 * j], bb = ((const f32x4*)lb)[lane + 64 * j];
            v[j] = v[j] * rstd * g + bb;
            ((f32x4*)(outf + (size_t)t * D_))[lane + 64 * j] = v[j];
            u32x2 o; o.x = pk2(v[j].x, v[j].y); o.y = pk2(v[j].z, v[j].w);
            ((u32x2*)(hb + (size_t)t * D_))[lane + 64 * j] = o;
        }
    }
}

__device__ __forceinline__ void naive_s5_scan(const bf16_t* P1, const float* a_re, const float* a_im, const float* log_dt, const float* b_re, const float* b_im,
                                              const float* c_re, const float* c_im, const float* dvec, float* YS5, bf16_t* YS5B, int pair) {
    const int lane = TIDX & 63;
    const int b = pair >> 5, g = pair & 31, n = lane;
    const float lam_re = fminf(a_re[g * 64 + n], -1e-4f), lam_im = a_im[g * 64 + n];
    const float dt = __expf(log_dt[g]);
    const float mag = __expf(lam_re * dt);
    const float ab_re = mag * cosf(lam_im * dt), ab_im = mag * sinf(lam_im * dt);
    const float den = lam_re * lam_re + lam_im * lam_im;
    const float num_re = ab_re - 1.f;
    const float z_re = (num_re * lam_re + ab_im * lam_im) / den;
    const float z_im = (ab_im * lam_re - num_re * lam_im) / den;
    float bre[16], bim[16], cre[16], cim[16];
#pragma unroll
    for (int c = 0; c < 16; ++c) {
        bre[c] = b_re[(size_t)(g * 64 + n) * 16 + c]; bim[c] = b_im[(size_t)(g * 64 + n) * 16 + c];
        cre[c] = c_re[(size_t)(g * 16 + c) * 64 + n]; cim[c] = c_im[(size_t)(g * 16 + c) * 64 + n];
    }
    const float dd = (lane < 16) ? dvec[g * 16 + lane] : 0.f;
    float h_re = 0.f, h_im = 0.f;
    for (int tt = 0; tt < L_; ++tt) {
        const size_t t = (size_t)b * L_ + tt;
        const float ul = (lane < 16) ? bf2f(P1[t * NIN1 + g * 16 + lane]) : 0.f;
        float bur = 0.f, bui = 0.f;
#pragma unroll
        for (int c = 0; c < 16; ++c) { const float u = __shfl(ul, c); bur += u * bre[c]; bui += u * bim[c]; }
        const float x_re = z_re * bur - z_im * bui, x_im = z_re * bui + z_im * bur;
        const float nh_re = ab_re * h_re - ab_im * h_im + x_re;
        const float nh_im = ab_re * h_im + ab_im * h_re + x_im;
        h_re = nh_re; h_im = nh_im;
        float yv = 0.f;
#pragma unroll
        for (int c = 0; c < 16; ++c) { const float y = wave_sum(h_re * cre[c] - h_im * cim[c]); if (lane == c) yv = y; }
        if (lane < 16) {
            const float y = gelu_tanh(yv + dd * ul);
            YS5[t * 512 + g * 16 + lane] = y;
            YS5B[t * 512 + g * 16 + lane] = f2bf(y);
        }
    }
}

__device__ __forceinline__ void ph_fin1(const float* OG, const bf16_t* P1, const float* norm_g, bf16_t* Ymix) {
    const int wave = TIDX >> 6, lane = TIDX & 63;
    for (int item = blockIdx.x * NWAVES + wave; item < T_ * 4; item += gridDim.x * NWAVES) {
        const int t = item >> 2, h = item & 3;
        const float o0 = OG[(size_t)t * 512 + h * 128 + lane], o1 = OG[(size_t)t * 512 + h * 128 + 64 + lane];
        const float ms = wave_sum(o0 * o0 + o1 * o1) * (1.f / 128.f);
        const float rs = rsqrtf(ms + LN_EPS);
        const float g0 = bf2f(P1[(size_t)t * NIN1 + 2048 + h * 128 + lane]), g1 = bf2f(P1[(size_t)t * NIN1 + 2048 + h * 128 + 64 + lane]);
        Ymix[(size_t)t * D_ + 512 + h * 128 + lane] = f2bf(o0 * rs * norm_g[lane] * siluf(g0));
        Ymix[(size_t)t * D_ + 512 + h * 128 + 64 + lane] = f2bf(o1 * rs * norm_g[64 + lane] * siluf(g1));
    }
}

constexpr int LDS_BYTES = 147456;
constexpr int MISC_OFF = 131072 + 8192;
enum Phase {
    PH_PROLOGUE = 0,
    PH_INPROJ0, PH_PREPA0, PH_LORA0, PH_PREPB0, PH_SCAN0, PH_FIN0, PH_OUTPROJ0, PH_LN1_0, PH_DISP0, PH_UP0, PH_DOWN0, PH_COMB0,
    PH_INPROJ1, PH_L1A, PH_L1B, PH_L1C, PH_L1D, PH_SCAN1, PH_FIN1, PH_GLU1, PH_OUTPROJ1, PH_LN1_1, PH_DISP1, PH_UP1, PH_DOWN1, PH_COMB1,
    PH_COUNT
};

typedef const Args __attribute__((address_space(4)))* KArgsP;
__device__ __forceinline__ KArgsP fresh_args() { KArgsP p = (KArgsP)__builtin_amdgcn_kernarg_segment_ptr(); asm volatile("" : "+s"(p)); return p; }
#define PHASE_BEGIN KArgsP ap = fresh_args(); unsigned char* const ws = ap->ws; (void)ws;
#define INP(i) (ap->in[i])
#define W_CTL ((unsigned*)(ws + WS_CTL))
#define W_HB ((bf16_t*)(ws + WS_HB))
#define W_WIN0 ((bf16_t*)(ws + WS_WIN0))
#define W_WOUT0 ((bf16_t*)(ws + WS_WOUT0))
#define W_WIN1 ((bf16_t*)(ws + WS_WIN1))
#define W_WOUT1 ((bf16_t*)(ws + WS_WOUT1))
#define W_WGLU ((bf16_t*)(ws + WS_WGLU))
#define W_WLORA ((bf16_t*)(ws + WS_WLORA))
#define W_W13 ((bf16_t*)(ws + WS_W13))
#define W_W2 ((bf16_t*)(ws + WS_W2))
#define W_HA ((float*)(ws + WS_HA))
#define W_YRW W_HA
#define W_OG (W_HA + (size_t)T_ * 512)
#define W_P ((bf16_t*)(ws + WS_P))
#define W_LO ((bf16_t*)(ws + WS_LO))
#define W_SC ((bf16_t*)(ws + WS_SCAN))
#define W_GLALA ((float*)(ws + WS_GLALA))
#define W_BON ((float*)(ws + WS_BON))
#define W_AP ((bf16_t*)(ws + WS_APRIME))
#define W_YS5B ((bf16_t*)(ws + WS_YS5B))
#define W_XR ((bf16_t*)(ws + WS_XR))
#define W_HID ((bf16_t*)(ws + WS_HID))
#define W_Y ((bf16_t*)(ws + WS_Y))
#define W_TOKE ((int*)(ws + WS_ROUTE))
#define W_TOKSLOT (W_TOKE + 2 * T_)
#define W_TOKDEST (W_TOKE + 4 * T_)
#define W_TOKG ((float*)(W_TOKE + 6 * T_))
#define W_YMIX W_HB
#define BIGP(mib) (ws + WS_BIG + (size_t)(mib) * MiB)
#define GLA0_BUFS GlaBufs{(bf16_t*)BIGP(256), (bf16_t*)BIGP(264), (bf16_t*)(ws + WS_HB), (bf16_t*)BIGP(273), (float*)BIGP(289), W_HA + (size_t)T_ * 512, (bf16_t*)BIGP(112)}
#define HG_BUFS GlaBufs{(bf16_t*)BIGP(96), (bf16_t*)BIGP(112), (bf16_t*)BIGP(144), (bf16_t*)BIGP(128), (float*)BIGP(176), (float*)BIGP(177), (bf16_t*)BIGP(144)}
#define W_S5WE ((bf16_t*)BIGP(160))
#define W_S5UA ((bf16_t*)BIGP(241))
#define W_S5MB ((bf16_t*)BIGP(261))
#define W_S5E ((float*)BIGP(281))
#define CW_SUB 12288

#define IN(k) (PLO <= (k) && (k) < PHI)
#define SEAM(k) do { if (IN(k) && IN((k) + 1)) { PHASE_BEGIN XcdBarrier bar_; bar_.bar = W_CTL + CW_BAR; bar_.x = xb_xcc_id(); bar_.st = (volatile LAS unsigned*)(lds + MISC_OFF) + 8; xcd_barrier(bar_); } } while (0)
template <int PLO, int PHI, int layer>
__device__ __forceinline__ void moe_layer(LAS unsigned char* lds) {
    LAS float* ldsf = (LAS float*)lds; (void)ldsf;
        const int base = layer == 0 ? PH_OUTPROJ0 : PH_OUTPROJ1;
        if (IN(base + 0)) {
            PHASE_BEGIN
            const float* W = layer == 0 ? INP(16) : INP(30);
            float* V1 = layer == 0 ? ap->out : W_HA;
            const float* resid = layer == 0 ? INP(0) : ap->out;
#if FAST_GEMM
            (void)W;
            { pg8::Gemm g{W_YMIX, layer == 0 ? W_WOUT0 : W_WOUT1, T_, D_, D_}; pg8::StaticOrder S; S.init(T_, D_, (int)gridDim.x, (int)blockIdx.x); pg8::EpiResidF32 E{resid, V1, D_, DN_ALPHA};
              pg8::gemm_phase<pg8::EpiResidF32, pg8::StaticOrder, true, true>(lds, g, S, E); }
#else
            const bf16_t* Ymix = W_YMIX;
            naive_gemm<false>(ldsf, T_, D_, D_, [&](int m) { return Ymix + (size_t)m * D_; }, [&](int, int) { return W; }, D_,
                              [&](int m, int n, float a, float) { V1[(size_t)m * D_ + n] = DN_ALPHA * resid[(size_t)m * D_ + n] + a; });
#endif
        }
        SEAM(base + 0);
        if (IN(base + 1)) {
            PHASE_BEGIN
            const float* V1 = layer == 0 ? ap->out : W_HA;
            ph_ln_router(V1, W_HA, W_HB, INP(31) + layer * D_, INP(32) + layer * D_, INP(33) + (size_t)layer * D_ * 4, INP(34) + layer * 4,
                         INP(35) + (size_t)layer * 4 * D_ * 8, INP(36) + layer * 32, W_TOKE, W_TOKSLOT, W_TOKG, W_CTL + CW_CNT + 64 * layer);
        }
        SEAM(base + 1);
        if (IN(base + 2)) { PHASE_BEGIN ph_dispatch((LAS int*)lds, W_CTL + CW_CNT + 64 * layer, W_HB, W_TOKE, W_TOKSLOT, W_TOKDEST, W_XR); }
        SEAM(base + 2);
        if (IN(base + 3)) {
            PHASE_BEGIN
#if FAST_GEMM
            { LAS int* pst = (LAS int*)(lds + 131072 + 2048); LAS int* tile_e = (LAS int*)(lds + 131072 + 1024);
              moe_offsets(pst, W_CTL + CW_CNT + 64 * layer);
              const int ntiles = pst[32] / 256;
              if ((int)TIDX < ntiles) tile_e[TIDX] = moe_expert_of_row(pst, TIDX * 256);
              __syncthreads();
              pg8::Gemm g{W_XR, W_W13, ntiles * 256, 1024, D_}; pg8::MoeOrder S{ntiles, 4, (int)gridDim.x, (int)blockIdx.x, tile_e}; pg8::EpiSwiglu E{W_HID};
              pg8::gemm_phase<pg8::EpiSwiglu, pg8::MoeOrder, true, true>(lds, g, S, E); }
#else
            LAS int* pst = (LAS int*)(lds + 65536);
            moe_offsets(pst, W_CTL + CW_CNT + 64 * layer);
            const float* w1 = INP(37) + (size_t)layer * 32 * D_ * 512; const float* w3 = INP(38) + (size_t)layer * 32 * D_ * 512;
            const bf16_t* XR = W_XR; bf16_t* HID = W_HID;
            naive_gemm<true>(ldsf, pst[32], 512, D_, [&](int m) { return XR + (size_t)m * D_; },
                             [&](int m0, int which) { const int e = moe_expert_of_row(pst, m0); return (which ? w3 : w1) + (size_t)e * D_ * 512; }, 512,
                             [&](int m, int n, float a, float b) { HID[(size_t)m * 512 + n] = f2bf(siluf(a) * b); });
#endif
        }
        SEAM(base + 3);
        if (IN(base + 4)) {
            PHASE_BEGIN
#if FAST_GEMM
            { LAS int* pst = (LAS int*)(lds + 131072 + 2048); LAS int* tile_e = (LAS int*)(lds + 131072 + 1024);
              moe_offsets(pst, W_CTL + CW_CNT + 64 * layer);
              const int ntiles = pst[32] / 256;
              if ((int)TIDX < ntiles) tile_e[TIDX] = moe_expert_of_row(pst, TIDX * 256);
              __syncthreads();
              pg8::Gemm g{W_HID, W_W2, ntiles * 256, 1024, 512}; pg8::MoeOrder S{ntiles, 4, (int)gridDim.x, (int)blockIdx.x, tile_e}; pg8::EpiStoreBf16 E{W_Y, D_, 0, 0};
              pg8::gemm_phase<pg8::EpiStoreBf16, pg8::MoeOrder, true, true>(lds, g, S, E); }
#else
            LAS int* pst = (LAS int*)(lds + 65536);
            moe_offsets(pst, W_CTL + CW_CNT + 64 * layer);
            const float* w2 = INP(39) + (size_t)layer * 32 * 512 * D_;
            const bf16_t* HID = W_HID; bf16_t* Y = W_Y;
            naive_gemm<false>(ldsf, pst[32], D_, 512, [&](int m) { return HID + (size_t)m * 512; },
                              [&](int m0, int) { const int e = moe_expert_of_row(pst, m0); return w2 + (size_t)e * 512 * D_; }, D_,
                              [&](int m, int n, float a, float) { Y[(size_t)m * D_ + n] = f2bf(a); });
#endif
        }
        SEAM(base + 4);
        if (IN(base + 5)) { PHASE_BEGIN ph_combine_ln(W_HA, W_Y, W_TOKDEST, W_TOKG, INP(40) + layer * D_, INP(41) + layer * D_, ap->out, W_HB); }
        SEAM(base + 5);

}

template <int PLO, int PHI>
__device__ __forceinline__ void mega_body(unsigned char* lds_raw) {
    LAS unsigned char* lds = (LAS unsigned char*)lds_raw;
    LAS float* ldsf = (LAS float*)lds;
    constexpr bool MULTI = (PHI - PLO) > 1;
    if (MULTI) {
        PHASE_BEGIN
        volatile LAS unsigned* MISC = (volatile LAS unsigned*)(lds + MISC_OFF);
        if (TIDX < 32) MISC[TIDX] = 0u;
        __syncthreads();
        (void)xcd_barrier_post(W_CTL + CW_BAR, MISC + 8);
    }

    if (IN(PH_PROLOGUE)) {
        PHASE_BEGIN ph_prologue(INP(0), W_HB);
#if FAST_GEMM
        LAS float* scr = ldsf + (TIDX >> 6) * (64 * 33);
        const int gw = blockIdx.x * NWAVES + (TIDX >> 6), ngw = gridDim.x * NWAVES, lane = TIDX & 63;
        convert_plain(INP(1), D_, NIN0, NIN0P, W_WIN0, scr, gw, ngw, lane);
        convert_plain(INP(16), D_, D_, D_, W_WOUT0, scr, gw, ngw, lane);
        convert_plain(INP(17), D_, NIN1, NIN1, W_WIN1, scr, gw, ngw, lane);
        convert_plain(INP(30), D_, D_, D_, W_WOUT1, scr, gw, ngw, lane);
        convert_plain(INP(26), 512, 512, 512, W_WGLU, scr, gw, ngw, lane);
        convert_lora(INP(4), INP(6), INP(7), W_WLORA, scr, gw, ngw, lane);
        convert_moe(INP(37), INP(38), INP(39), W_W13, W_W2, scr, gw, ngw, lane);
#endif
    }
    SEAM(PH_PROLOGUE);
    if (IN(PH_INPROJ0)) {
        PHASE_BEGIN
#if FAST_GEMM
        { pg8::Gemm g{W_HB, W_WIN0, T_, NIN0P, D_}; pg8::StaticOrder S; S.init(T_, NIN0P, (int)gridDim.x, (int)blockIdx.x); pg8::EpiStoreBf16 E{W_P, NIN0P, 0, 0};
          pg8::gemm_phase<pg8::EpiStoreBf16, pg8::StaticOrder, true, true>(lds, g, S, E); }
#else
        const float* W = INP(1); const bf16_t* A = W_HB; bf16_t* P = W_P;
        naive_gemm<false>(ldsf, T_, NIN0, D_, [&](int m) { return A + (size_t)m * D_; }, [&](int, int) { return W; }, NIN0,
                          [&](int m, int n, float a, float) { P[(size_t)m * NIN0P + n] = f2bf(a); });
#endif
    }
    SEAM(PH_INPROJ0);
    if (IN(PH_PREPA0)) { PHASE_BEGIN ph_prepA0<!FAST_GLA0>(W_P, INP(2), INP(13), INP(14), W_AP, W_GLALA); }
    SEAM(PH_PREPA0);
    if (IN(PH_LORA0)) {
        PHASE_BEGIN
#if FAST_GEMM
        { pg8::Gemm g{W_AP, W_WLORA, T_, NLORA, 256}; pg8::StaticOrder S; S.init(T_, NLORA, (int)gridDim.x, (int)blockIdx.x); pg8::EpiStoreBf16 E{W_LO, 512, 512, (size_t)T_ * 512};
          pg8::gemm_phase<pg8::EpiStoreBf16, pg8::StaticOrder, true, true>(lds, g, S, E); }
#else
        const float* w2 = INP(4); const float* a2 = INP(6); const float* g2 = INP(7); const bf16_t* AP = W_AP; bf16_t* LO = W_LO;
        naive_gemm<false>(ldsf, T_, 512, 64, [&](int m) { return AP + (size_t)m * 256; }, [&](int, int) { return w2; }, 512,
                          [&](int m, int n, float a, float) { LO[(size_t)m * 512 + n] = f2bf(a); });
        naive_gemm<false>(ldsf, T_, 512, 64, [&](int m) { return AP + (size_t)m * 256 + 64; }, [&](int, int) { return a2; }, 512,
                          [&](int m, int n, float a, float) { LO[(size_t)T_ * 512 + (size_t)m * 512 + n] = f2bf(a); });
        naive_gemm<false>(ldsf, T_, 512, 128, [&](int m) { return AP + (size_t)m * 256 + 128; }, [&](int, int) { return g2; }, 512,
                          [&](int m, int n, float a, float) { LO[(size_t)2 * T_ * 512 + (size_t)m * 512 + n] = f2bf(a); });
#endif
    }
    SEAM(PH_LORA0);
    if (IN(PH_PREPB0)) {
        PHASE_BEGIN ph_prepB0(W_P, W_LO, INP(2), INP(3), INP(5), INP(8), INP(9), INP(10), W_SC, W_BON);
#if FAST_GLA0
        { const GlaBufs GB = GLA0_BUFS; __syncthreads();
          for (int cg = blockIdx.x; cg < 256; cg += gridDim.x) gla_prep_tile<64, 0>(ldsf, W_P, INP(13), INP(14), GB, cg); }
#endif
    }
    SEAM(PH_PREPB0);
    if (IN(PH_SCAN0)) {
        PHASE_BEGIN
        const int bid = blockIdx.x;
        constexpr int NRW = 16;
        if (bid < NRW) naive_rwkv_scan(ldsf, W_SC, W_YRW, bid);
#if FAST_GLA0
        else {
            const GlaBufs GB = GLA0_BUFS;
            const int nb = (int)gridDim.x - NRW, b0 = bid - NRW, wave = TIDX >> 6, lane = TIDX & 63;
            for (int u = b0 * NWAVES + wave; u < 1024 * 4; u += nb * NWAVES) gla_pass1_unit<64>(GB, u, lane);
            sub_barrier(W_CTL + CW_SUB, (unsigned)nb);
            gla_pass2<64>(GB, b0 * NTHREADS + TIDX, nb * NTHREADS);
            sub_barrier(W_CTL + CW_SUB + 64, (unsigned)nb);
            for (int it = b0; it < 1024; it += nb) gla_pass3_item<64, 0>(lds, W_P, INP(15), GB, W_YMIX, it);
        }
#else
        else if (bid < 24) {
            const int bh = bid - 16;
            const bf16_t* P = W_P; const float* GLALA = W_GLALA;
            naive_gla_scan<64>(ldsf,
                [&](int t, int ck, float& q, float& kk, float& e) {
                    q = bf2f(P[(size_t)t * NIN0P + 1792 + ck]) * 0.125f; kk = bf2f(P[(size_t)t * NIN0P + 2048 + ck]); e = __expf(GLALA[(size_t)t * 256 + ck]); },
                [&](int t, int cv) { return bf2f(P[(size_t)t * NIN0P + 2304 + cv]); }, W_OG, bh >> 2, bh & 3);
        }
#endif
    }
    SEAM(PH_SCAN0);
    if (IN(PH_FIN0)) { PHASE_BEGIN ph_fin0<!FAST_GLA0>(W_YRW, W_OG, W_P, W_LO, W_SC, W_BON, INP(11), INP(12), INP(15), W_YMIX); }
    SEAM(PH_FIN0);

    moe_layer<PLO, PHI, 0>(lds);
            if (IN(PH_INPROJ1)) {
                PHASE_BEGIN
#if FAST_GEMM
                { pg8::Gemm g{W_HB, W_WIN1, T_, NIN1, D_}; pg8::StaticOrder S; S.init(T_, NIN1, (int)gridDim.x, (int)blockIdx.x); pg8::EpiStoreBf16 E{W_P, NIN1, 0, 0};
                  pg8::gemm_phase<pg8::EpiStoreBf16, pg8::StaticOrder, true, true>(lds, g, S, E); }
#else
                const float* W = INP(17); const bf16_t* A = W_HB; bf16_t* P = W_P;
                naive_gemm<false>(ldsf, T_, NIN1, D_, [&](int m) { return A + (size_t)m * D_; }, [&](int, int) { return W; }, NIN1,
                                  [&](int m, int n, float a, float) { P[(size_t)m * NIN1 + n] = f2bf(a); });
#endif
            }
            SEAM(PH_INPROJ1);
            if (IN(PH_L1A)) {
                PHASE_BEGIN
#if FAST_S5
                if (blockIdx.x >= 224) s5_tables(ldsf, INP(18), INP(19), INP(20), INP(21), INP(22), INP(23), INP(24), W_S5MB, W_S5WE, (int)blockIdx.x - 224);
                s5_fill_ua(W_P, W_S5UA, blockIdx.x * NWAVES + (TIDX >> 6), gridDim.x * NWAVES, TIDX & 63);
                __syncthreads();
#endif
#if FAST_HG
                { const GlaBufs GB = HG_BUFS;
                  for (int cg = blockIdx.x; cg < 256; cg += gridDim.x) gla_prep_tile<128, 1>(ldsf, W_P, INP(28), nullptr, GB, cg); }
#endif
            }
            SEAM(PH_L1A);
            if (IN(PH_L1B)) {
                PHASE_BEGIN
                const int bid = blockIdx.x;
#if FAST_S5
                if (bid < 64) {
                    LAS int* tile_e = (LAS int*)(lds + 131072 + 1024);
                    if (TIDX < 64) tile_e[TIDX] = TIDX >> 1;
                    __syncthreads();
                    pg8::Gemm g{W_S5UA, W_S5WE, 64 * 256, 256, 512, 640}; pg8::MoeOrder S{64, 1, 64, bid, tile_e}; pg8::EpiStoreF32 E{W_S5E, 256};
                    pg8::gemm_phase<pg8::EpiStoreF32, pg8::MoeOrder, true, true>(lds, g, S, E);
                }
#endif
#if FAST_HG
                if (bid >= 64) {
                    const GlaBufs GB = HG_BUFS;
                    const int nb = (int)gridDim.x - 64, b0 = bid - 64, wave = TIDX >> 6, lane = TIDX & 63;
                    for (int u = b0 * NWAVES + wave; u < 1024 * 8; u += nb * NWAVES) gla_pass1_unit<128>(GB, u, lane);
                }
#endif
            }
            SEAM(PH_L1B);
            if (IN(PH_L1C)) {
                PHASE_BEGIN
                const int bid = blockIdx.x;
#if FAST_S5
                if (bid < 8) s5_carry(INP(18), INP(19), INP(20), W_S5E, W_S5UA, bid * NTHREADS + TIDX);
#endif
#if FAST_HG
                if (bid >= 8) { const GlaBufs GB = HG_BUFS; gla_pass2<128>(GB, (bid - 8) * NTHREADS + TIDX, ((int)gridDim.x - 8) * NTHREADS); }
#endif
#if FAST_GEMM
                { LAS float* scr = ldsf + (TIDX >> 6) * (64 * 33);
                  convert_moe(INP(37) + (size_t)32 * D_ * 512, INP(38) + (size_t)32 * D_ * 512, INP(39) + (size_t)32 * 512 * D_, W_W13, W_W2, scr,
                              bid * NWAVES + (TIDX >> 6), (int)gridDim.x * NWAVES, TIDX & 63); }
#endif
            }
            SEAM(PH_L1C);
            if (IN(PH_L1D)) {
                PHASE_BEGIN
                const int bid = blockIdx.x;
#if FAST_S5
                if (bid < 128) {
                    LAS int* tile_e = (LAS int*)(lds + 131072 + 1024);
                    if (TIDX < 64) tile_e[TIDX] = TIDX >> 1;
                    __syncthreads();
                    pg8::Gemm g{W_S5UA, W_S5MB, 64 * 256, 512, 640, 640}; pg8::MoeOrder S{64, 2, 128, bid, tile_e}; pg8::EpiS5Y E{W_P, INP(25), W_YRW, W_YS5B};
                    pg8::gemm_phase<pg8::EpiS5Y, pg8::MoeOrder, true, true>(lds, g, S, E);
                }
#endif
#if FAST_HG
                if (bid >= 128) {
                    const GlaBufs GB = HG_BUFS;
                    for (int it = bid - 128; it < 1024; it += (int)gridDim.x - 128) gla_pass3_item<128, 1>(lds, W_P, INP(29), GB, W_YMIX, it);
                }
#endif
            }
            SEAM(PH_L1D);
            if (IN(PH_SCAN1)) {
                PHASE_BEGIN
                const int bid = blockIdx.x;
                const bf16_t* P = W_P; (void)P; (void)bid;
#if !FAST_HG
                if (bid < 8) {
                    const float* hg_lb = INP(28);
                    naive_gla_scan<128>(ldsf,
                        [&](int t, int ck, float& q, float& kk, float& e) {
                            const float l0 = hg_lb[ck], l1 = hg_lb[512 + ck];
                            const float lbv = 1.f / (1.f + __expf(l0 - l1));
                            const float f = bf2f(P[(size_t)t * NIN1 + 1024 + ck]);
                            const float sg = sigm(f);
                            q = siluf(bf2f(P[(size_t)t * NIN1 + 512 + ck])); kk = (1.f - lbv) * (1.f - sg); e = lbv + (1.f - lbv) * sg; },
                        [&](int t, int cv) { return bf2f(P[(size_t)t * NIN1 + 1536 + cv]); }, W_OG, bid >> 2, bid & 3);
                }
#endif
#if !FAST_S5
                if (bid >= 8 && bid < 16) {
                    const int pair = (bid - 8) * 8 + (TIDX >> 6);
                    naive_s5_scan(P, INP(18), INP(19), INP(20), INP(21), INP(22), INP(23), INP(24), INP(25), W_YRW, W_YS5B, pair);
                }
#endif
            }
            SEAM(PH_SCAN1);
#if !FAST_HG
            if (IN(PH_FIN1)) { PHASE_BEGIN ph_fin1(W_OG, W_P, INP(29), W_YMIX); }
#endif
            SEAM(PH_FIN1);
            if (IN(PH_GLU1)) {
                PHASE_BEGIN
#if FAST_GEMM
                { pg8::Gemm g{W_YS5B, W_WGLU, T_, 512, 512}; pg8::StaticOrder S; S.init(T_, 512, (int)gridDim.x, (int)blockIdx.x); pg8::EpiGlu E{W_YRW, 512, INP(27), W_YMIX, D_};
                  pg8::gemm_phase<pg8::EpiGlu, pg8::StaticOrder, true, true>(lds, g, S, E); }
#else
                const float* W = INP(26); const float* gb = INP(27); const bf16_t* YS5B = W_YS5B; const float* YRW = W_YRW; bf16_t* Ymix = W_YMIX;
                naive_gemm<false>(ldsf, T_, 512, 512, [&](int m) { return YS5B + (size_t)m * 512; }, [&](int, int) { return W; }, 512,
                                  [&](int m, int n, float a, float) { const float y = YRW[(size_t)m * 512 + n]; Ymix[(size_t)m * D_ + n] = f2bf(y * sigm(a + gb[n])); });
#endif
            }
            SEAM(PH_GLU1);
    moe_layer<PLO, PHI, 1>(lds);
#undef IN
}
template <int PLO, int PHI>
__global__ void __launch_bounds__(NTHREADS, 2) mega(Args args) {
    extern __shared__ __attribute__((aligned(16))) unsigned char lds_raw[];
    mega_body<PLO, PHI>(lds_raw);
}

#include <utility>
template <int... I> static void set_attrs(std::integer_sequence<int, I...>) {
    (void)std::initializer_list<int>{ ((void)hipFuncSetAttribute((const void*)mega<I, I + 1>, hipFuncAttributeMaxDynamicSharedMemorySize, LDS_BYTES), 0)... };
}
template <int I> static int launch_one(int grid, hipStream_t stream, const Args& a) {
    hipLaunchKernelGGL((mega<I, I + 1>), dim3(grid), dim3(NTHREADS), LDS_BYTES, stream, a);
    return 0;
}
template <int... I> static void launch_all(std::integer_sequence<int, I...>, int grid, hipStream_t stream, const Args& a) {
    (void)std::initializer_list<int>{ launch_one<I>(grid, stream, a)... };
}
extern "C" void kernel_launch(void* const* d_in, const int* in_sizes, int n_in, void* d_out, int out_size, void* d_ws, size_t ws_size, hipStream_t stream) {
    static int grid = 0;
    if (grid == 0) {
        if (n_in != 42 || out_size != T_ * D_ || ws_size < WS_END) { fprintf(stderr, "kernel_launch: unexpected shapes n_in %d out %d ws %zu\n", n_in, out_size, ws_size); grid = -1; return; }
        int dev = 0, cus = 0, per_cu = 0;
        hipGetDevice(&dev);
        hipDeviceGetAttribute(&cus, hipDeviceAttributeMultiprocessorCount, dev);
        set_attrs(std::make_integer_sequence<int, PH_COUNT>{});
        hipFuncSetAttribute((const void*)mega<0, PH_COUNT>, hipFuncAttributeMaxDynamicSharedMemorySize, LDS_BYTES);
        hipOccupancyMaxActiveBlocksPerMultiprocessor(&per_cu, (const void*)mega<0, PH_COUNT>, NTHREADS, LDS_BYTES);
        (void)hipGetLastError();
        if (per_cu < 1) per_cu = 1;
        grid = cus * 1;
        fprintf(stderr, "kernel_launch: cus %d per_cu %d grid %d\n", cus, per_cu, grid);
    }
    if (grid < 0) return;
    hipMemsetAsync((char*)d_ws + WS_CTL, 0, CTL_ZERO_BYTES, stream);
    Args a{};
    for (int i = 0; i < 42; ++i) a.in[i] = (const float*)d_in[i];
    a.out = (float*)d_out; a.ws = (unsigned char*)d_ws;
#if MK_SINGLE
    void* kargs[] = {(void*)&a};
    hipError_t e = hipLaunchCooperativeKernel((const void*)mega<0, PH_COUNT>, dim3(grid), dim3(NTHREADS), kargs, LDS_BYTES, stream);
    if (e != hipSuccess) fprintf(stderr, "cooperative launch failed: %s (grid %d)\n", hipGetErrorString(e), grid);
#else
    launch_all(std::make_integer_sequence<int, PH_COUNT>{}, grid, stream, a);
#endif
}
#ifdef TEST_RANGES
template __global__ void mega<0, 2>(Args);
template __global__ void mega<1, 3>(Args);
template __global__ void mega<1, 4>(Args);
template __global__ void mega<3, 8>(Args);
template __global__ void mega<7, 13>(Args);
template __global__ void mega<10, 12>(Args);
template __global__ void mega<13, 17>(Args);
template __global__ void mega<0, 13>(Args);
#endif
```

```cpp
#include <hip/hip_runtime.h>
#include <cstdio>
#include <cstdint>

#define GAS __attribute__((address_space(1)))
#define LAS __attribute__((address_space(3)))
typedef unsigned short bf16_t;
typedef float f32x4 __attribute__((ext_vector_type(4)));
typedef unsigned u32x4 __attribute__((ext_vector_type(4)));
typedef unsigned u32x2 __attribute__((ext_vector_type(2)));
__device__ __forceinline__ int launder_tid() { int t = (int)threadIdx.x; asm volatile("" : "+v"(t)); return t; }
#define TIDX launder_tid()

#ifndef FAST_GEMM
#define FAST_GEMM 1
#endif
#ifndef FAST_RWKV
#define FAST_RWKV 1
#endif
#ifndef FAST_GLA0
#define FAST_GLA0 1
#endif
#ifndef FAST_HG
#define FAST_HG 1
#endif
#ifndef FAST_S5
#define FAST_S5 1
#endif
#ifndef MK_SINGLE
#define MK_SINGLE 1
#endif

constexpr int T_ = 16384, L_ = 8192, D_ = 1024;
constexpr int NIN0 = 3344, NIN0P = 3584, NIN1 = 2560;
constexpr int NLORA = 1536;
constexpr int RMAX = 40960;
constexpr int MOE_PAD = 256;
constexpr float DN_ALPHA = 1.41421356237f;
constexpr float LN_EPS = 1e-5f;
constexpr int NTHREADS = 512, NWAVES = 8;

constexpr size_t MiB = 1u << 20;
constexpr size_t WS_CTL = 0, CTL_ZERO_BYTES = 1 * MiB;
constexpr size_t WS_WIN0 = 2 * MiB;
constexpr size_t WS_WOUT0 = 9 * MiB;
constexpr size_t WS_WIN1 = 11 * MiB;
constexpr size_t WS_WOUT1 = 16 * MiB;
constexpr size_t WS_WGLU = 18 * MiB;
constexpr size_t WS_WLORA = 19 * MiB;
constexpr size_t WS_W13 = 20 * MiB;
constexpr size_t WS_W2 = 84 * MiB;
constexpr size_t WS_HB = 116 * MiB;
constexpr size_t WS_HA = 149 * MiB;
constexpr size_t WS_ROUTE = 213 * MiB;
constexpr size_t WS_BIG = 214 * MiB;
constexpr size_t WS_P = WS_BIG;
constexpr size_t WS_LO = WS_BIG + 112 * MiB;
constexpr size_t WS_SCAN = WS_BIG + 160 * MiB;
constexpr size_t WS_GLALA = WS_BIG + 256 * MiB;
constexpr size_t WS_BON = WS_BIG + 272 * MiB;
constexpr size_t WS_APRIME = WS_BIG + 273 * MiB;
constexpr size_t WS_YS5B = WS_BIG + 80 * MiB;
constexpr size_t WS_XR = WS_BIG;
constexpr size_t WS_HID = WS_BIG + 80 * MiB;
constexpr size_t WS_Y = WS_BIG + 120 * MiB;
constexpr size_t WS_END = 512 * MiB;
constexpr int CW_BAR = 4096;
constexpr int CW_CNT = 8192;

__device__ __forceinline__ float bf2f(bf16_t b) { return __uint_as_float(((unsigned)b) << 16); }
__device__ __forceinline__ bf16_t f2bf(float f) { unsigned u = __float_as_uint(f); u += 0x7fffu + ((u >> 16) & 1u); return (bf16_t)(u >> 16); }
__device__ __forceinline__ unsigned pk2(float lo, float hi) { return (unsigned)f2bf(lo) | ((unsigned)f2bf(hi) << 16); }
__device__ __forceinline__ float sigm(float x) { return 1.f / (1.f + __expf(-x)); }
__device__ __forceinline__ float siluf(float x) { return x * sigm(x); }
__device__ __forceinline__ float softplusf(float x) { return fmaxf(x, 0.f) + log1pf(__expf(-fabsf(x))); }
__device__ __forceinline__ float gelu_tanh(float x) { const float u = 0.7978845608028654f * (x + 0.044715f * x * x * x); return 0.5f * x * (1.f + tanhf(u)); }
__device__ __forceinline__ float wave_sum(float v) {
#pragma unroll
    for (int o = 1; o < 64; o <<= 1) v += __shfl_xor(v, o);
    return v;
}


namespace pg8 {
#define PG8_LAS __attribute__((address_space(3)))
typedef unsigned short bf16_t;
typedef short bf16x8 __attribute__((ext_vector_type(8)));
typedef float f32x4 __attribute__((ext_vector_type(4)));
typedef unsigned u32x4 __attribute__((ext_vector_type(4)));
constexpr int BM = 256, BK = 64, HALF = 128, HTB = HALF * BK * 2  , STAGE_BYTES = 8 * HTB, NXCD = 8, WGM = 8;

__host__ __device__ __forceinline__ int lds_byte(int r, int c) { const int st = (r >> 4) * 2 + (c >> 5), rr = r & 15, cc = c & 31, ob = rr * 64 + cc * 2; return st * 1024 + (ob ^ (((ob >> 9) & 1) << 5)); }
__host__ __device__ __forceinline__ void stage_rc(int b, int& R, int& C) { const int st = b / 1024, sb = b % 1024, swz = sb ^ (((sb >> 9) & 1) << 5); R = (st >> 1) * 16 + swz / 64; C = (st & 1) * 32 + (swz % 64) / 2; }
__host__ __device__ __forceinline__ int perm32(int rho) { const int n = rho >> 4, i = rho & 15; return 8 * (i >> 2) + 4 * n + (i & 3); }

struct Unit { int pm, pn, pb; };
struct Gemm { const bf16_t* A; const bf16_t* Bt; int M, N, K, lda; };

struct StaticOrder {
    int nM, nN, nwg, G, c;
    __host__ __device__ void init(int M, int N, int G_, int c_) { nM = M / BM; nN = N / BM; nwg = nM * nN; G = G_; c = c_; }
    __host__ __device__ bool next(int i, Unit& u) const {
        const long L = (long)i * G + c; if (L >= nwg) return false;
        int wgid = (int)L; { const int q = nwg / NXCD, r = nwg % NXCD, xcd = wgid % NXCD, off = wgid / NXCD; wgid = (xcd < r ? xcd * (q + 1) : r * (q + 1) + (xcd - r) * q) + off; }
        const int nig = WGM * nN, gid = wgid / nig, fm = gid * WGM, gsz = (nM - fm) < WGM ? (nM - fm) : WGM;
        u.pm = fm + ((wgid % nig) % gsz); u.pn = (wgid % nig) / gsz; u.pb = u.pn; return true;
    }
    __device__ __forceinline__ void a_ready(const Unit&) const {}
    __device__ __forceinline__ void done(const Unit&) const {}
};

__device__ __forceinline__ unsigned cvt_pk_bf16(float lo, float hi) { unsigned r; asm volatile("v_cvt_pk_bf16_f32 %0, %1, %2" : "=v"(r) : "v"(lo), "v"(hi)); return r; }
typedef float f32x2 __attribute__((ext_vector_type(2)));

template <class Epi, class Sched, bool ALIGN_EPI = false, bool SP2 = false>
__device__ __forceinline__ void gemm_phase(PG8_LAS unsigned char* lds, const Gemm g, const Sched& S, const Epi& E) {
    const int tid = TIDX, wid = __builtin_amdgcn_readfirstlane(tid >> 6), lane = tid & 63, wr = wid >> 2, wc = wid & 3, fr = lane & 15, fq = lane >> 4;
    const int K = g.K, nt = K / BK, lda = g.lda ? g.lda : g.K;
    unsigned voffA[2], voffB[2];
#pragma unroll
    for (int i = 0; i < 2; ++i) { int R, C; stage_rc(tid * 16 + i * 8192, R, C); const int Rb = Epi::PERM ? ((R & ~31) + perm32(R & 31)) : R;
        voffA[i] = (unsigned)(R * lda + C) * 2u; voffB[i] = (unsigned)(Rb * K + C) * 2u; }
    const size_t kstep = (size_t)(BK * 2);
    const size_t hstep = (size_t)HALF * K * 2;
    const size_t tstep = 2 * hstep;
    const size_t hstepA = (size_t)HALF * lda * 2, tstepA = 2 * hstepA;
    const unsigned ldsw = (unsigned)wid * 1024u;
    const int aoff = lds_byte(wr * 64 + fr, fq * 8), boff = lds_byte(wc * 32 + fr, fq * 8);
#define PG8_SA(b, h) (((b) * 2 + (h)) * HTB)
#define PG8_SB(b, h) ((4 + (b) * 2 + (h)) * HTB)
#define PG8_STAGE(bufoff, gbase, voff) do { _Pragma("unroll") for (int _i = 0; _i < 2; ++_i) \
        __builtin_amdgcn_global_load_lds((const unsigned*)((const char*)(gbase) + (voff)[_i]), (PG8_LAS unsigned*)(lds + (bufoff) + ldsw + _i * 8192), 16, 0, 0); } while (0)
#define PG8_LDA(dst, b, h) do { _Pragma("unroll") for (int m = 0; m < 4; ++m) _Pragma("unroll") for (int k = 0; k < 2; ++k) dst[m][k] = *(const PG8_LAS bf16x8*)(lds + PG8_SA(b, h) + aoff + m * 2048 + k * 1024); } while (0)
#define PG8_LDB(dst, b, h) do { _Pragma("unroll") for (int n = 0; n < 2; ++n) _Pragma("unroll") for (int k = 0; k < 2; ++k) dst[n][k] = *(const PG8_LAS bf16x8*)(lds + PG8_SB(b, h) + boff + n * 2048 + k * 1024); } while (0)
#define PG8_MMA(ai, bj, At, Bt) do { __builtin_amdgcn_s_setprio(1); _Pragma("unroll") for (int m = 0; m < 4; ++m) _Pragma("unroll") for (int n = 0; n < 2; ++n) _Pragma("unroll") for (int k = 0; k < 2; ++k) \
        acc[ai][bj][m][n] = __builtin_amdgcn_mfma_f32_16x16x32_bf16(Bt[n][k], At[m][k], acc[ai][bj][m][n], 0, 0, 0); __builtin_amdgcn_s_setprio(0); } while (0)
#define PG8_WAIT_V(n) asm volatile("s_waitcnt vmcnt(" #n ")" ::: "memory")
#define PG8_WAIT_L(n) asm volatile("s_waitcnt lgkmcnt(" #n ")" ::: "memory")
#define PG8_BAR __builtin_amdgcn_s_barrier()
#define PG8_SCHED __builtin_amdgcn_sched_barrier(0)
    Unit cur, nxt; int ui = 0;
    if (!S.next(0, cur)) return;
    f32x4 acc[2][2][4][2];
#pragma unroll
    for (int a = 0; a < 2; ++a)
#pragma unroll
        for (int b = 0; b < 2; ++b)
#pragma unroll
            for (int m = 0; m < 4; ++m)
#pragma unroll
                for (int n = 0; n < 2; ++n) acc[a][b][m][n] = (f32x4){0.f, 0.f, 0.f, 0.f};
    bf16x8 At[4][2], B0[2][2], B1[2][2];
    const char* cA = (const char*)g.A + (size_t)cur.pm * tstepA; const char* cB = (const char*)g.Bt + (size_t)cur.pb * tstep;
    S.a_ready(cur);
    if constexpr (SP2) {
        PG8_STAGE(PG8_SB(0, 0), cB, voffB); PG8_STAGE(PG8_SB(0, 1), cB + hstep, voffB); PG8_STAGE(PG8_SA(0, 0), cA, voffA); PG8_STAGE(PG8_SA(0, 1), cA + hstepA, voffA);
        if (wr == 1) PG8_BAR;
        PG8_WAIT_V(2); PG8_BAR;
        PG8_STAGE(PG8_SB(1, 0), cB + kstep, voffB); PG8_STAGE(PG8_SA(1, 0), cA + kstep, voffA); PG8_STAGE(PG8_SB(1, 1), cB + hstep + kstep, voffB);
        PG8_WAIT_V(6); PG8_BAR;
    } else {
        PG8_STAGE(PG8_SB(0, 0), cB, voffB); PG8_STAGE(PG8_SA(0, 0), cA, voffA); PG8_STAGE(PG8_SB(0, 1), cB + hstep, voffB); PG8_STAGE(PG8_SA(0, 1), cA + hstepA, voffA);
        if (wr == 1) PG8_BAR;
        PG8_WAIT_V(4); PG8_BAR;
        PG8_STAGE(PG8_SB(1, 0), cB + kstep, voffB); PG8_STAGE(PG8_SA(1, 0), cA + kstep, voffA); PG8_STAGE(PG8_SB(1, 1), cB + hstep + kstep, voffB);
        PG8_WAIT_V(6); PG8_BAR;
    }
    for (;;) {
        const bool has_next = S.next(ui + 1, nxt);
        const char* nA = has_next ? (const char*)g.A + (size_t)nxt.pm * tstepA : cA; const char* nB = has_next ? (const char*)g.Bt + (size_t)nxt.pb * tstep : cB;
        for (int t = 0; t < nt; t += 2) {
            const bool last = (t == nt - 2);
            const char* a1 = cA + (size_t)(t + 1) * kstep;
            const char* a2 = last ? nA : cA + (size_t)(t + 2) * kstep; const char* b2 = last ? nB : cB + (size_t)(t + 2) * kstep;
            const char* a3 = a2 + kstep; const char* b3 = b2 + kstep;
            if (last && has_next) S.a_ready(nxt);
            if constexpr (SP2) {
            PG8_LDB(B0, 0, 0); PG8_LDB(B1, 0, 1); PG8_SCHED; PG8_LDA(At, 0, 0); PG8_STAGE(PG8_SA(1, 1), a1 + hstepA, voffA);
            PG8_WAIT_V(8); PG8_WAIT_L(0); PG8_BAR; PG8_MMA(0, 0, At, B0); PG8_MMA(0, 1, At, B1); PG8_BAR; PG8_SCHED;
            PG8_LDA(At, 0, 1); PG8_STAGE(PG8_SB(0, 0), b2, voffB); PG8_STAGE(PG8_SB(0, 1), b2 + hstep, voffB); PG8_STAGE(PG8_SA(0, 0), a2, voffA);
            PG8_WAIT_V(8); PG8_WAIT_L(0); PG8_BAR; PG8_MMA(1, 0, At, B0); PG8_MMA(1, 1, At, B1); PG8_BAR; PG8_SCHED;
            PG8_LDB(B0, 1, 0); PG8_LDB(B1, 1, 1); PG8_SCHED; PG8_LDA(At, 1, 0); PG8_STAGE(PG8_SA(0, 1), a2 + hstepA, voffA);
            PG8_WAIT_V(8); PG8_WAIT_L(0); PG8_BAR; PG8_MMA(0, 0, At, B0); PG8_MMA(0, 1, At, B1); PG8_BAR; PG8_SCHED;
            PG8_LDA(At, 1, 1); PG8_STAGE(PG8_SB(1, 0), b3, voffB); PG8_STAGE(PG8_SB(1, 1), b3 + hstep, voffB); PG8_STAGE(PG8_SA(1, 0), a3, voffA);
            PG8_WAIT_V(8); PG8_WAIT_L(0); PG8_BAR; PG8_MMA(1, 0, At, B0); PG8_MMA(1, 1, At, B1); PG8_BAR; PG8_SCHED;
            } else {
            PG8_LDB(B0, 0, 0); PG8_SCHED; PG8_LDA(At, 0, 0); PG8_STAGE(PG8_SA(1, 1), a1 + hstepA, voffA);
            PG8_WAIT_L(8); PG8_BAR; PG8_WAIT_L(0); PG8_MMA(0, 0, At, B0); PG8_BAR; PG8_SCHED;
            PG8_LDB(B1, 0, 1); PG8_STAGE(PG8_SB(0, 0), b2, voffB);
            PG8_BAR; PG8_WAIT_L(0); PG8_MMA(0, 1, At, B1); PG8_BAR;
            PG8_LDA(At, 0, 1); PG8_STAGE(PG8_SA(0, 0), a2, voffA);
            PG8_BAR; PG8_WAIT_L(0); PG8_MMA(1, 0, At, B0); PG8_BAR; PG8_SCHED;
            PG8_STAGE(PG8_SB(0, 1), b2 + hstep, voffB);
            PG8_WAIT_V(6); PG8_BAR; PG8_MMA(1, 1, At, B1); PG8_BAR;
            PG8_LDB(B0, 1, 0); PG8_SCHED; PG8_LDA(At, 1, 0); PG8_STAGE(PG8_SA(0, 1), a2 + hstepA, voffA);
            PG8_WAIT_L(8); PG8_BAR; PG8_WAIT_L(0); PG8_MMA(0, 0, At, B0); PG8_BAR; PG8_SCHED;
            PG8_LDB(B1, 1, 1); PG8_STAGE(PG8_SB(1, 0), b3, voffB);
            PG8_BAR; PG8_WAIT_L(0); PG8_MMA(0, 1, At, B1); PG8_BAR;
            PG8_LDA(At, 1, 1); PG8_STAGE(PG8_SA(1, 0), a3, voffA);
            PG8_BAR; PG8_WAIT_L(0); PG8_MMA(1, 0, At, B0); PG8_BAR; PG8_SCHED;
            PG8_STAGE(PG8_SB(1, 1), b3 + hstep, voffB);
            PG8_WAIT_V(6); PG8_BAR; PG8_MMA(1, 1, At, B1); PG8_BAR;
            }
        }
        if constexpr (ALIGN_EPI) { if (wr == 0) PG8_BAR; }
        if constexpr (!Epi::AFTER_DRAIN) { E(acc, cur, wr, wc, fr, fq); S.done(cur); }
        if (!has_next) break;
#pragma unroll
        for (int a = 0; a < 2; ++a)
#pragma unroll
            for (int b = 0; b < 2; ++b)
#pragma unroll
                for (int m = 0; m < 4; ++m)
#pragma unroll
                    for (int n = 0; n < 2; ++n) acc[a][b][m][n] = (f32x4){0.f, 0.f, 0.f, 0.f};
        cur = nxt; cA = nA; cB = nB; ++ui;
        if constexpr (ALIGN_EPI) { if (wr == 1) PG8_BAR; }
    }
    PG8_WAIT_V(0);
    if constexpr (!ALIGN_EPI) { if (wr == 0) PG8_BAR; }
    PG8_BAR;
    if constexpr (Epi::AFTER_DRAIN) { E.fused(acc, cur, wr, wc, fr, fq, lds, wid, lane); S.done(cur); }
#undef PG8_SA
#undef PG8_SB
#undef PG8_STAGE
#undef PG8_LDA
#undef PG8_LDB
#undef PG8_MMA
#undef PG8_WAIT_V
#undef PG8_WAIT_L
#undef PG8_BAR
#undef PG8_SCHED
}

struct EpiStoreBf16 {
    static constexpr bool PERM = true, AFTER_DRAIN = false;
    bf16_t* O; int ldc; int split_cols; size_t split_stride;
    __device__ __forceinline__ void operator()(const f32x4 (&acc)[2][2][4][2], const Unit& u, int wr, int wc, int fr, int fq) const {
        int colt = u.pn * BM; bf16_t* base = O;
        if (split_cols) { const int t = colt / split_cols; base += (size_t)t * split_stride; colt -= t * split_cols; }
        const int row0 = u.pm * BM + wr * 64 + fr, col0 = colt + wc * 32 + 8 * fq;
#pragma unroll
        for (int ai = 0; ai < 2; ++ai)
#pragma unroll
            for (int m = 0; m < 4; ++m) { bf16_t* rowp = base + (size_t)(row0 + ai * HALF + m * 16) * ldc + col0;
#pragma unroll
                for (int bj = 0; bj < 2; ++bj) { const f32x4 v0 = acc[ai][bj][m][0], v1 = acc[ai][bj][m][1];
                    u32x4 w; w.x = cvt_pk_bf16(v0[0], v0[1]); w.y = cvt_pk_bf16(v0[2], v0[3]); w.z = cvt_pk_bf16(v1[0], v1[1]); w.w = cvt_pk_bf16(v1[2], v1[3]);
                    *(u32x4*)(rowp + bj * HALF) = w; } }
    }
};
struct EpiResidF32 {
    static constexpr bool PERM = false, AFTER_DRAIN = false;
    const float* resid; float* out; int ldc; float alpha;
    __device__ __forceinline__ void operator()(const f32x4 (&acc)[2][2][4][2], const Unit& u, int wr, int wc, int fr, int fq) const {
        const int row0 = u.pm * BM + wr * 64 + fr, col0 = u.pn * BM + wc * 32 + 4 * fq;
#pragma unroll
        for (int ai = 0; ai < 2; ++ai)
#pragma unroll
            for (int m = 0; m < 4; ++m) { const size_t off = (size_t)(row0 + ai * HALF + m * 16) * ldc + col0;
#pragma unroll
                for (int bj = 0; bj < 2; ++bj)
#pragma unroll
                    for (int n = 0; n < 2; ++n) { const size_t o = off + bj * HALF + n * 16; *(f32x4*)(out + o) = *(const f32x4*)(resid + o) * alpha + acc[ai][bj][m][n]; } }
    }
};
__device__ __forceinline__ float fast_sigm(float x) { return __builtin_amdgcn_rcpf(1.f + __expf(-x)); }
struct EpiSwiglu {
    static constexpr bool PERM = true, AFTER_DRAIN = false;
    bf16_t* HID;
    __device__ __forceinline__ void operator()(const f32x4 (&acc)[2][2][4][2], const Unit& u, int wr, int wc, int fr, int fq) const {
        const int row0 = u.pm * BM + wr * 64 + fr, h0 = u.pn * 128 + wc * 16 + 4 * fq;
#pragma unroll
        for (int ai = 0; ai < 2; ++ai)
#pragma unroll
            for (int m = 0; m < 4; ++m) { bf16_t* rowp = HID + (size_t)(row0 + ai * HALF + m * 16) * 512 + h0;
#pragma unroll
                for (int bj = 0; bj < 2; ++bj) { const f32x4 a = acc[ai][bj][m][0], b = acc[ai][bj][m][1]; f32x4 h;
#pragma unroll
                    for (int j = 0; j < 4; ++j) h[j] = a[j] * fast_sigm(a[j]) * b[j];
                    typedef unsigned u32x2v __attribute__((ext_vector_type(2)));
                    u32x2v w; w.x = cvt_pk_bf16(h[0], h[1]); w.y = cvt_pk_bf16(h[2], h[3]);
                    *(u32x2v*)(rowp + bj * 64) = w; } }
    }
};
struct EpiGlu {
    static constexpr bool PERM = true, AFTER_DRAIN = false;
    const float* ysrc; int ldy; const float* bias; bf16_t* O; int ldc;
    __device__ __forceinline__ void operator()(const f32x4 (&acc)[2][2][4][2], const Unit& u, int wr, int wc, int fr, int fq) const {
        const int row0 = u.pm * BM + wr * 64 + fr, col0 = u.pn * BM + wc * 32 + 8 * fq;
#pragma unroll
        for (int ai = 0; ai < 2; ++ai)
#pragma unroll
            for (int m = 0; m < 4; ++m) { const int row = row0 + ai * HALF + m * 16;
#pragma unroll
                for (int bj = 0; bj < 2; ++bj) { const int col = col0 + bj * HALF;
                    const f32x4 y0 = *(const f32x4*)(ysrc + (size_t)row * ldy + col), y1 = *(const f32x4*)(ysrc + (size_t)row * ldy + col + 4);
                    const f32x4 b0 = *(const f32x4*)(bias + col), b1 = *(const f32x4*)(bias + col + 4);
                    f32x4 v0 = acc[ai][bj][m][0] + b0, v1 = acc[ai][bj][m][1] + b1;
#pragma unroll
                    for (int j = 0; j < 4; ++j) { v0[j] = y0[j] * fast_sigm(v0[j]); v1[j] = y1[j] * fast_sigm(v1[j]); }
                    u32x4 w; w.x = cvt_pk_bf16(v0[0], v0[1]); w.y = cvt_pk_bf16(v0[2], v0[3]); w.z = cvt_pk_bf16(v1[0], v1[1]); w.w = cvt_pk_bf16(v1[2], v1[3]);
                    *(u32x4*)(O + (size_t)row * ldc + col) = w; } }
    }
};
struct EpiStoreF32 {
    static constexpr bool PERM = false, AFTER_DRAIN = false;
    float* out; int ldc;
    __device__ __forceinline__ void operator()(const f32x4 (&acc)[2][2][4][2], const Unit& u, int wr, int wc, int fr, int fq) const {
        const int row0 = u.pm * BM + wr * 64 + fr, col0 = u.pn * BM + wc * 32 + 4 * fq;
#pragma unroll
        for (int ai = 0; ai < 2; ++ai)
#pragma unroll
            for (int m = 0; m < 4; ++m) { const size_t off = (size_t)(row0 + ai * HALF + m * 16) * ldc + col0;
#pragma unroll
                for (int bj = 0; bj < 2; ++bj)
#pragma unroll
                    for (int n = 0; n < 2; ++n) *(f32x4*)(out + off + bj * HALF + n * 16) = acc[ai][bj][m][n]; }
    }
};
struct EpiS5Y {
    static constexpr bool PERM = false, AFTER_DRAIN = false;
    const bf16_t* P1; const float* dvec; float* YS5; bf16_t* YS5B;
    __device__ __forceinline__ void operator()(const f32x4 (&acc)[2][2][4][2], const Unit& u, int wr, int wc, int fr, int fq) const {
        const int g = u.pm >> 1, ch = g * 16 + 4 * fq;
        const f32x4 dd = *(const f32x4*)(dvec + ch);
#pragma unroll
        for (int ai = 0; ai < 2; ++ai)
#pragma unroll
            for (int m = 0; m < 4; ++m) {
                const int bc = (u.pm & 1) * 256 + ai * HALF + wr * 64 + m * 16 + fr, b = bc >> 8, c32 = bc & 255;
#pragma unroll
                for (int bj = 0; bj < 2; ++bj)
#pragma unroll
                    for (int n = 0; n < 2; ++n) {
                        const int i = 16 * u.pn + 8 * bj + 2 * wc + n;
                        const size_t t = (size_t)b * 8192 + c32 * 32 + i;
                        typedef unsigned u32x2v __attribute__((ext_vector_type(2)));
                        const u32x2v uu = *(const u32x2v*)(P1 + t * 2560 + ch);
                        f32x4 uv; uv[0] = __uint_as_float(uu.x << 16); uv[1] = __uint_as_float(uu.x & 0xffff0000u); uv[2] = __uint_as_float(uu.y << 16); uv[3] = __uint_as_float(uu.y & 0xffff0000u);
                        f32x4 y = acc[ai][bj][m][n] + dd * uv;
#pragma unroll
                        for (int j = 0; j < 4; ++j) { const float x = y[j]; const float tt = 0.7978845608028654f * (x + 0.044715f * x * x * x); y[j] = 0.5f * x * (1.f + tanhf(tt)); }
                        *(f32x4*)(YS5 + t * 512 + ch) = y;
                        u32x2v w; w.x = cvt_pk_bf16(y[0], y[1]); w.y = cvt_pk_bf16(y[2], y[3]);
                        *(u32x2v*)(YS5B + t * 512 + ch) = w;
                    }
            }
    }
};
struct MoeOrder {
    int ntiles, nN, G, c; const PG8_LAS int* tile_e;
    __device__ __forceinline__ bool next(int i, Unit& u) const {
        const int L = i * G + c; if (L >= ntiles * nN) return false;
        u.pm = L / nN; u.pn = L % nN; u.pb = tile_e[u.pm] * nN + u.pn; return true;
    }
    __device__ __forceinline__ void a_ready(const Unit&) const {}
    __device__ __forceinline__ void done(const Unit&) const {}
};
}

#define XB_TMO      128
#define XB_XCNT(j)  (256  + 64 * (j))
#define XB_XSUB(j)  (1280 + 64 * (j))
#define XB_XGEN(j)  (2304 + 64 * (j))
#define XB_TOP      3328
#define XB_TOPGEN   3392
#define XCD_BAR_WORDS 3456
#define XB_SPIN_CAP (1u << 18)
__device__ __forceinline__ unsigned xb_ld(unsigned* p)              { return __hip_atomic_load(p, __ATOMIC_RELAXED, __HIP_MEMORY_SCOPE_AGENT); }
__device__ __forceinline__ unsigned xb_add(unsigned* p, unsigned v) { return __hip_atomic_fetch_add(p, v, __ATOMIC_RELAXED, __HIP_MEMORY_SCOPE_AGENT); }
__device__ __forceinline__ unsigned xb_xcc_id() { return (unsigned)__builtin_amdgcn_s_getreg((3 << 11) | 20) & 0xFu; }
#define XB_SPIN(cond, bar) do { unsigned _sp = 0; while (cond) { __builtin_amdgcn_s_sleep(1); \
    if ((++_sp & 255u) == 0u) { if (xb_ld(&(bar)[XB_TMO])) break; if (_sp > XB_SPIN_CAP) { atomicAdd(&(bar)[XB_TMO], 1u); break; } } } } while (0)
struct XcdBarrier { unsigned* bar; unsigned x; volatile LAS unsigned* st; };
__device__ __forceinline__ XcdBarrier xcd_barrier_post(unsigned* bar, volatile LAS unsigned* st) {
    XcdBarrier b; b.bar = bar; b.x = xb_xcc_id(); b.st = st;
    if (TIDX == 0) (void)xb_add(&bar[XB_XCNT(b.x)], 1u);
    return b;
}
__device__ __forceinline__ void xcd_barrier_complete(unsigned* bar, unsigned x, unsigned& nloc, unsigned& nx) {
    const unsigned G = gridDim.x;
    unsigned sum, cnt, mine, sp = 0u;
    for (;;) {
        sum = 0u; cnt = 0u; mine = 0u;
#pragma unroll
        for (unsigned j = 0; j < 16; ++j) { const unsigned c = xb_ld(&bar[XB_XCNT(j)]); sum += c; cnt += (c > 0u) ? 1u : 0u; mine = (j == x) ? c : mine; }
        if (sum == G) break;
        __builtin_amdgcn_s_sleep(1);
        if ((++sp & 255u) == 0u) { if (xb_ld(&bar[XB_TMO])) break; if (sp > XB_SPIN_CAP) { atomicAdd(&bar[XB_TMO], 1u); break; } }
    }
    nloc = mine > 0u ? mine : 1u; nx = cnt > 0u ? cnt : 1u;
}
__device__ __forceinline__ void xcd_barrier(const XcdBarrier& b) {
    asm volatile("s_waitcnt vmcnt(0)" ::: "memory");
    __syncthreads();
    if (TIDX == 0) {
        unsigned* bar = b.bar;
        __builtin_amdgcn_s_waitcnt(0);
        unsigned nloc = b.st[0], nx = b.st[1];
        if (nloc == 0u) { xcd_barrier_complete(bar, b.x, nloc, nx); b.st[0] = nloc; b.st[1] = nx; }
        const unsigned old = xb_add(&bar[XB_XSUB(b.x)], 1u);
        const unsigned gen = old / nloc;
        if (old + 1u == (gen + 1u) * nloc) {
            __builtin_amdgcn_fence(__ATOMIC_RELEASE, "agent");
            asm volatile("s_waitcnt vmcnt(0)" ::: "memory");
            const unsigned og = xb_add(&bar[XB_TOP], 1u);
            const unsigned tg = og / nx;
            if (og + 1u == (tg + 1u) * nx) xb_add(&bar[XB_TOPGEN], 1u);
            else XB_SPIN(xb_ld(&bar[XB_TOPGEN]) == tg, bar);
            __builtin_amdgcn_fence(__ATOMIC_ACQUIRE, "agent");
            xb_add(&bar[XB_XGEN(b.x)], 1u);
            asm volatile("s_waitcnt vmcnt(0)" ::: "memory");
        } else {
            XB_SPIN(xb_ld(&bar[XB_XGEN(b.x)]) == gen, bar);
            __builtin_amdgcn_fence(__ATOMIC_ACQUIRE, "agent");
            asm volatile("s_waitcnt vmcnt(0)" ::: "memory");
        }
    }
    __syncthreads();
}


typedef short bf16x8 __attribute__((ext_vector_type(8)));
struct GlaBufs { bf16_t* QT; bf16_t* KT; bf16_t* KDT; bf16_t* VT; float* DG; float* DS; bf16_t* SP; };
__device__ __forceinline__ float logsigf(float x) { return fminf(x, 0.f) - log1pf(__expf(-fabsf(x))); }

template <int K, int LAYER>
__device__ __forceinline__ void gla_prep_tile(LAS float* lds, const bf16_t* P, const float* aux0, const float* aux1, const GlaBufs& B, int cg) {
    constexpr int HK = 4 * K, KP = K + 1;
    LAS float* G = lds;
    LAS float* KR = lds + 64 * KP;
    LAS float* LV = lds + 2 * 64 * KP;
    const int tid = TIDX, lane = tid & 63, wave = tid >> 6;
    const int t0 = cg * 64;
    for (int h = 0; h < 4; ++h) {
        for (int idx = tid; idx < 64 * K; idx += NTHREADS) {
            const int t = idx / K, k = idx % K, ck = h * K + k;
            float g, kr;
            if (LAYER == 0) {
                const bf16_t* row = P + (size_t)(t0 + t) * NIN0P;
                float gk = aux1[ck];
#pragma unroll
                for (int i = 0; i < 16; ++i) gk += bf2f(row[2816 + i]) * aux0[i * 256 + ck];
                g = logsigf(gk) * (1.f / 16.f);
                kr = bf2f(row[2048 + ck]);
            } else {
                const bf16_t* row = P + (size_t)(t0 + t) * NIN1;
                const float lbv = 1.f / (1.f + __expf(aux0[ck] - aux0[512 + ck]));
                const float sg = sigm(bf2f(row[1024 + ck]));
                g = __logf(lbv + (1.f - lbv) * sg);
                kr = (1.f - lbv) * (1.f - sg);
            }
            G[t * KP + k] = g; KR[t * KP + k] = kr;
        }
        for (int idx = tid; idx < 64 * 128; idx += NTHREADS) {
            const int t = idx >> 7, vc = idx & 127;
            LV[t * 129 + vc] = bf2f(LAYER == 0 ? P[(size_t)(t0 + t) * NIN0P + 2304 + h * 128 + vc] : P[(size_t)(t0 + t) * NIN1 + 1536 + h * 128 + vc]);
        }
        __syncthreads();
        for (int k = wave; k < K; k += NWAVES) {
            float v = G[lane * KP + k];
#pragma unroll
            for (int o = 1; o < 64; o <<= 1) { const float n = __shfl_up(v, o); if (lane >= o) v += n; }
            G[lane * KP + k] = v;
        }
        __syncthreads();
        for (int idx = tid; idx < 64 * K; idx += NTHREADS) {
            const int t = idx / K, k = idx % K, ck = h * K + k;
            const float b = G[t * KP + k];
            float q;
            if (LAYER == 0) q = bf2f(P[(size_t)(t0 + t) * NIN0P + 1792 + ck]) * 0.125f;
            else q = siluf(bf2f(P[(size_t)(t0 + t) * NIN1 + 512 + ck]));
            B.QT[(size_t)(t0 + t) * HK + ck] = f2bf(q * __expf(b));
            B.KT[(size_t)(t0 + t) * HK + ck] = f2bf(KR[t * KP + k] * __expf(-b));
        }
        for (int idx = tid; idx < 64 * K; idx += NTHREADS) {
            const int k = idx >> 6, t = idx & 63, ck = h * K + k;
            const float bl = G[63 * KP + k];
            B.KDT[((size_t)cg * HK + ck) * 64 + t] = f2bf(KR[t * KP + k] * __expf(bl - G[t * KP + k]));
            if (t == 0) B.DG[(size_t)cg * HK + ck] = __expf(bl);
        }
        for (int idx = tid; idx < 64 * 128; idx += NTHREADS) {
            const int vc = idx >> 6, t = idx & 63;
            B.VT[((size_t)cg * 512 + h * 128 + vc) * 64 + t] = f2bf(LV[t * 129 + vc]);
        }
        __syncthreads();
    }
}

template <int K>
__device__ __forceinline__ void gla_pass1_unit(const GlaBufs& B, int unit, int lane) {
    constexpr int HK = 4 * K, KT16 = K / 16;
    const int item = unit / KT16, kt = unit % KT16, cg = item >> 2, h = item & 3;
    const int r = lane & 15, q = lane >> 4;
    const bf16_t* ap = B.KDT + ((size_t)cg * HK + h * K + kt * 16 + r) * 64 + 8 * q;
    const bf16x8 a0 = *(const bf16x8*)ap, a1 = *(const bf16x8*)(ap + 32);
    float* dsp = B.DS + ((size_t)item * 128 + r) * K + kt * 16 + 4 * q;
#pragma unroll
    for (int vt = 0; vt < 8; ++vt) {
        const bf16_t* bp = B.VT + ((size_t)cg * 512 + h * 128 + vt * 16 + r) * 64 + 8 * q;
        const bf16x8 b0 = *(const bf16x8*)bp, b1 = *(const bf16x8*)(bp + 32);
        f32x4 acc = {0.f, 0.f, 0.f, 0.f};
        acc = __builtin_amdgcn_mfma_f32_16x16x32_bf16(a0, b0, acc, 0, 0, 0);
        acc = __builtin_amdgcn_mfma_f32_16x16x32_bf16(a1, b1, acc, 0, 0, 0);
        *(f32x4*)(dsp + (size_t)vt * 16 * K) = acc;
    }
}

template <int K>
__device__ __forceinline__ void gla_pass2(const GlaBufs& B, int gthread, int gthreads) {
    constexpr int HK = 4 * K;
    const float* __restrict__ DS = B.DS; const float* __restrict__ DG = B.DG; bf16_t* __restrict__ SP = B.SP;
    for (int e = gthread; e < 8 * 128 * K; e += gthreads) {
        const int k = e % K, v = (e / K) & 127, bh = e / (K * 128), b = bh >> 2, h = bh & 3;
        float S = 0.f;
#pragma unroll 8
        for (int c = 0; c < 128; ++c) {
            const int cg = b * 128 + c;
            const size_t idx = ((size_t)(cg * 4 + h) * 128 + v) * K + k;
            const float d = DG[(size_t)cg * HK + h * K + k], ds = DS[idx];
            SP[idx] = f2bf(S);
            S = d * S + ds;
        }
    }
}

template <int K, int LAYER>
__device__ __forceinline__ void gla_pass3_item(LAS unsigned char* lds, const bf16_t* P, const float* norm_g, const GlaBufs& B, bf16_t* Ymix, int item) {
    constexpr int HK = 4 * K, KS = K / 32;
    LAS bf16_t* Ls = (LAS bf16_t*)lds;
    LAS float* Lo = (LAS float*)(lds + 64 * 72 * 2);
    const int tid = TIDX, lane = tid & 63, wave = tid >> 6, r = lane & 15, q = lane >> 4;
    const int cg = item >> 2, h = item & 3, t0 = cg * 64;
    const int it = wave >> 1, i0 = it * 16;
    bf16x8 qf[KS];
#pragma unroll
    for (int s = 0; s < KS; ++s) qf[s] = *(const bf16x8*)(B.QT + (size_t)(t0 + i0 + r) * HK + h * K + 32 * s + 8 * q);
#pragma unroll
    for (int jj2 = 0; jj2 < 2; ++jj2) {
        const int j0 = ((wave & 1) * 2 + jj2) * 16;
        f32x4 acc = {0.f, 0.f, 0.f, 0.f};
        if (j0 <= i0) {
#pragma unroll
            for (int s = 0; s < KS; ++s) {
                const bf16x8 kf = *(const bf16x8*)(B.KT + (size_t)(t0 + j0 + r) * HK + h * K + 32 * s + 8 * q);
                acc = __builtin_amdgcn_mfma_f32_16x16x32_bf16(kf, qf[s], acc, 0, 0, 0);
            }
        }
        const int i = i0 + r;
        u32x2 w;
        w.x = pk2((j0 + 4 * q + 0) <= i ? acc[0] : 0.f, (j0 + 4 * q + 1) <= i ? acc[1] : 0.f);
        w.y = pk2((j0 + 4 * q + 2) <= i ? acc[2] : 0.f, (j0 + 4 * q + 3) <= i ? acc[3] : 0.f);
        *(LAS u32x2*)(Ls + i * 72 + j0 + 4 * q) = w;
    }
    __syncthreads();
    const bf16x8 sf0 = *(const LAS bf16x8*)(Ls + (i0 + r) * 72 + 8 * q), sf1 = *(const LAS bf16x8*)(Ls + (i0 + r) * 72 + 32 + 8 * q);
#pragma unroll
    for (int vv = 0; vv < 4; ++vv) {
        const int v0 = ((wave & 1) * 4 + vv) * 16;
        f32x4 acc = {0.f, 0.f, 0.f, 0.f};
#pragma unroll
        for (int s = 0; s < KS; ++s) {
            const bf16x8 sp = *(const bf16x8*)(B.SP + ((size_t)item * 128 + v0 + r) * K + 32 * s + 8 * q);
            acc = __builtin_amdgcn_mfma_f32_16x16x32_bf16(sp, qf[s], acc, 0, 0, 0);
        }
        const bf16_t* vp = B.VT + ((size_t)cg * 512 + h * 128 + v0 + r) * 64 + 8 * q;
        const bf16x8 vf0 = *(const bf16x8*)vp, vf1 = *(const bf16x8*)(vp + 32);
        acc = __builtin_amdgcn_mfma_f32_16x16x32_bf16(vf0, sf0, acc, 0, 0, 0);
        acc = __builtin_amdgcn_mfma_f32_16x16x32_bf16(vf1, sf1, acc, 0, 0, 0);
        *(LAS f32x4*)(Lo + (i0 + r) * 132 + v0 + 4 * q) = acc;
    }
    __syncthreads();
#pragma unroll 2
    for (int rr = 0; rr < 8; ++rr) {
        const int i = wave * 8 + rr, t = t0 + i;
        const float o0 = Lo[i * 132 + lane], o1 = Lo[i * 132 + 64 + lane];
        const float ms = wave_sum(o0 * o0 + o1 * o1) * (1.f / 128.f);
        const float rs = rsqrtf(ms + LN_EPS);
        float g0, g1;
        if (LAYER == 0) { g0 = bf2f(P[(size_t)t * NIN0P + 2832 + h * 128 + lane]); g1 = bf2f(P[(size_t)t * NIN0P + 2832 + h * 128 + 64 + lane]); }
        else { g0 = bf2f(P[(size_t)t * NIN1 + 2048 + h * 128 + lane]); g1 = bf2f(P[(size_t)t * NIN1 + 2048 + h * 128 + 64 + lane]); }
        Ymix[(size_t)t * D_ + 512 + h * 128 + lane] = f2bf(o0 * rs * norm_g[lane] * siluf(g0));
        Ymix[(size_t)t * D_ + 512 + h * 128 + 64 + lane] = f2bf(o1 * rs * norm_g[64 + lane] * siluf(g1));
    }
    __syncthreads();
}


template <int CTRL> __device__ __forceinline__ float dppf(float x) { return __builtin_bit_cast(float, __builtin_amdgcn_mov_dpp(__builtin_bit_cast(int, x), CTRL, 0xf, 0xf, true)); }
__device__ __forceinline__ float reduce32(float x) {
    x += dppf<0xB1>(x);
    x += dppf<0x4E>(x);
    x += dppf<0x141>(x);
    x += dppf<0x140>(x);
    auto sw = __builtin_amdgcn_permlane16_swap(__float_as_uint(x), __float_as_uint(x), false, false);
    return __uint_as_float(sw[0]) + __uint_as_float(sw[1]);
}
__device__ __forceinline__ void rwkv_scan_v1(LAS float* lds, const bf16_t* SC, float* YRW, int unit) {
    constexpr int TS = 32, TILE = 5 * TS * 64 + TS * 16;
    const int bh = unit >> 2, qr = unit & 3, b = bh >> 3, h = bh & 7;
    const int tid = TIDX, lane = tid & 63, wave = tid >> 6, cp = lane & 31, rl = wave * 2 + (lane >> 5);
    const size_t S1 = (size_t)T_ * 512;
    const int chunk = tid & 255, ls = chunk >> 3, lc0 = (chunk & 7) * 8, half = tid >> 8;
    const bf16_t* g0 = SC + (half == 0 ? 0 : 4 * S1) + (size_t)(b * L_ + ls) * 512 + h * 64 + lc0;
    const bf16_t* g1 = SC + (half == 0 ? 1 * S1 : 5 * S1) + (size_t)(b * L_ + ls) * 512 + h * 64 + lc0;
    const bf16_t* g2 = (half == 0) ? SC + 2 * S1 + (size_t)(b * L_ + ls) * 512 + h * 64 + lc0
                                   : SC + 3 * S1 + (size_t)(b * L_ + ls) * 512 + h * 64 + qr * 16 + (lc0 & 8);
    u32x4 p0, p1, p2;
    p0 = *(const u32x4*)g0; p1 = *(const u32x4*)g1; p2 = *(const u32x4*)g2;
    float S0 = 0.f, S1v = 0.f;
    auto unpack8 = [](const u32x4 v, float* f) {
        f[0] = __uint_as_float(v.x << 16); f[1] = __uint_as_float(v.x & 0xffff0000u); f[2] = __uint_as_float(v.y << 16); f[3] = __uint_as_float(v.y & 0xffff0000u);
        f[4] = __uint_as_float(v.z << 16); f[5] = __uint_as_float(v.z & 0xffff0000u); f[6] = __uint_as_float(v.w << 16); f[7] = __uint_as_float(v.w & 0xffff0000u); };
    auto stage = [&](LAS float* buf) {
        float f0[8], f1[8], f2[8];
        unpack8(p0, f0); unpack8(p1, f1); unpack8(p2, f2);
        if (half == 0) {
#pragma unroll
            for (int j = 0; j < 8; ++j) { buf[(4 * TS + ls) * 64 + lc0 + j] = f0[j]; buf[(1 * TS + ls) * 64 + lc0 + j] = __expf(f1[j]); buf[(3 * TS + ls) * 64 + lc0 + j] = f2[j]; }
        } else {
#pragma unroll
            for (int j = 0; j < 8; ++j) { buf[(0 * TS + ls) * 64 + lc0 + j] = -f0[j]; buf[(2 * TS + ls) * 64 + lc0 + j] = f0[j] * f1[j]; }
            if ((chunk & 7) < 2) {
#pragma unroll
                for (int j = 0; j < 8; ++j) buf[5 * TS * 64 + ls * 16 + (lc0 & 8) + j] = f2[j];
            }
        }
    };
    stage(lds);
    __syncthreads();
    for (int t0 = 0; t0 < L_; t0 += TS) {
        LAS float* cur = lds + ((t0 / TS) & 1) * TILE;
        LAS float* nxt = lds + (((t0 / TS) & 1) ^ 1) * TILE;
        const bool more = (t0 + TS) < L_;
        if (more) { const size_t adv = (size_t)(t0 + TS) * 512; p0 = *(const u32x4*)(g0 + adv); p1 = *(const u32x4*)(g1 + adv); p2 = *(const u32x4*)(g2 + adv); }
        float* yout = YRW + (size_t)(b * L_ + t0) * 512 + h * 64 + qr * 16 + rl;
#pragma unroll 4
        for (int s = 0; s < TS; ++s) {
            typedef float f32x2v __attribute__((ext_vector_type(2)));
            const f32x2v a2 = *(const LAS f32x2v*)(cur + (0 * TS + s) * 64 + 2 * cp);
            const f32x2v w2 = *(const LAS f32x2v*)(cur + (1 * TS + s) * 64 + 2 * cp);
            const f32x2v b2 = *(const LAS f32x2v*)(cur + (2 * TS + s) * 64 + 2 * cp);
            const f32x2v k2 = *(const LAS f32x2v*)(cur + (3 * TS + s) * 64 + 2 * cp);
            const f32x2v r2 = *(const LAS f32x2v*)(cur + (4 * TS + s) * 64 + 2 * cp);
            const float vv = cur[5 * TS * 64 + s * 16 + rl];
            const float sa = reduce32(S0 * a2.x + S1v * a2.y);
            S0 = S0 * w2.x + (sa * b2.x + vv * k2.x);
            S1v = S1v * w2.y + (sa * b2.y + vv * k2.y);
            const float y = reduce32(S0 * r2.x + S1v * r2.y);
            if (cp == 0) yout[(size_t)s * 512] = y;
        }
        if (more) stage(nxt);
        __syncthreads();
    }
}

__device__ __forceinline__ void sub_barrier(unsigned* ctr, unsigned nblocks) {
    asm volatile("s_waitcnt vmcnt(0)" ::: "memory");
    __syncthreads();
    if (TIDX == 0) {
        __builtin_amdgcn_fence(__ATOMIC_RELEASE, "agent");
        asm volatile("s_waitcnt vmcnt(0)" ::: "memory");
        xb_add(ctr, 1u);
        unsigned sp = 0;
        while (xb_ld(ctr) < nblocks) { __builtin_amdgcn_s_sleep(2); if (++sp > (1u << 22)) break; }
        __builtin_amdgcn_fence(__ATOMIC_ACQUIRE, "agent");
        asm volatile("s_waitcnt vmcnt(0)" ::: "memory");
    }
    __syncthreads();
}


__device__ __forceinline__ void s5_tables(LAS float* lds, const float* a_re, const float* a_im, const float* log_dt, const float* b_re, const float* b_im,
                                          const float* c_re, const float* c_im, bf16_t* MB, bf16_t* WE, int g) {
    LAS float* pwr = lds;
    LAS float* pwi = pwr + 33 * 64;
    LAS float* zbr = pwi + 33 * 64;
    LAS float* zbi = zbr + 1024;
    LAS float* cr = zbi + 1024;
    LAS float* ci = cr + 1024;
    LAS float* kern = ci + 1024;
    const int tid = TIDX;
    if (tid < 64) {
        const int n = tid;
        const float lam_re = fminf(a_re[g * 64 + n], -1e-4f), lam_im = a_im[g * 64 + n];
        const float dt = __expf(log_dt[g]);
        const float mag = __expf(lam_re * dt);
        const float ab_re = mag * cosf(lam_im * dt), ab_im = mag * sinf(lam_im * dt);
        const float den = lam_re * lam_re + lam_im * lam_im;
        const float num_re = ab_re - 1.f;
        const float z_re = (num_re * lam_re + ab_im * lam_im) / den;
        const float z_im = (ab_im * lam_re - num_re * lam_im) / den;
        for (int tau = 0; tau <= 32; ++tau) {
            const float m = __expf(lam_re * dt * (float)tau), ang = lam_im * dt * (float)tau;
            pwr[tau * 64 + n] = m * cosf(ang); pwi[tau * 64 + n] = m * sinf(ang);
        }
        for (int c = 0; c < 16; ++c) {
            const float br = b_re[(size_t)(g * 64 + n) * 16 + c], bi = b_im[(size_t)(g * 64 + n) * 16 + c];
            zbr[n * 16 + c] = z_re * br - z_im * bi; zbi[n * 16 + c] = z_re * bi + z_im * br;
        }
    }
    for (int idx = tid; idx < 1024; idx += NTHREADS) { cr[idx] = c_re[(size_t)g * 1024 + idx]; ci[idx] = c_im[(size_t)g * 1024 + idx]; }
    __syncthreads();
    for (int idx = tid; idx < 32 * 256; idx += NTHREADS) {
        const int tau = idx >> 8, c = (idx >> 4) & 15, cp = idx & 15;
        float acc = 0.f;
        for (int n = 0; n < 64; ++n) {
            const float pr = pwr[tau * 64 + n], pi = pwi[tau * 64 + n], zr = zbr[n * 16 + cp], zi = zbi[n * 16 + cp];
            const float wr = pr * zr - pi * zi, wi = pr * zi + pi * zr;
            acc += cr[c * 64 + n] * wr - ci[c * 64 + n] * wi;
        }
        kern[idx] = acc;
    }
    __syncthreads();
    for (int idx = tid; idx < 512 * 640; idx += NTHREADS) {
        const int row = idx / 640, col = idx % 640, i = row >> 4, c = row & 15;
        float v;
        if (col < 512) { const int j = col >> 4, cp = col & 15; v = (j <= i) ? kern[((i - j) * 16 + c) * 16 + cp] : 0.f; }
        else if (col < 576) { const int n = col - 512; v = cr[c * 64 + n] * pwr[(i + 1) * 64 + n] - ci[c * 64 + n] * pwi[(i + 1) * 64 + n]; }
        else { const int n = col - 576; v = -(cr[c * 64 + n] * pwi[(i + 1) * 64 + n] + ci[c * 64 + n] * pwr[(i + 1) * 64 + n]); }
        MB[((size_t)g * 512 + row) * 640 + col] = f2bf(v);
    }
    for (int idx = tid; idx < 256 * 512; idx += NTHREADS) {
        const int np = idx >> 9, col = idx & 511;
        float v = 0.f;
        if (np < 128) {
            const int n = np & 63, j = col >> 4, cp = col & 15;
            const float pr = pwr[(31 - j) * 64 + n], pi = pwi[(31 - j) * 64 + n], zr = zbr[n * 16 + cp], zi = zbi[n * 16 + cp];
            v = np < 64 ? (pr * zr - pi * zi) : (pr * zi + pi * zr);
        }
        WE[((size_t)g * 256 + np) * 512 + col] = f2bf(v);
    }
    __syncthreads();
}
__device__ __forceinline__ void s5_fill_ua(const bf16_t* P1, bf16_t* UA, int gw, int ngw, int lane) {
    for (int t = gw; t < T_; t += ngw) {
        const int b = t >> 13, tt = t & 8191, c32 = tt >> 5, j = tt & 31, g = lane >> 1, c0 = (lane & 1) * 8;
        const u32x4 v = *(const u32x4*)(P1 + (size_t)t * NIN1 + 8 * lane);
        *(u32x4*)(UA + ((size_t)g * 512 + b * 256 + c32) * 640 + j * 16 + c0) = v;
    }
}
__device__ __forceinline__ void s5_carry(const float* a_re, const float* a_im, const float* log_dt, const float* E, bf16_t* UA, int th) {
    const int n = th & 63, g = (th >> 6) & 31, b = th >> 11;
    const float lam_re = fminf(a_re[g * 64 + n], -1e-4f), lam_im = a_im[g * 64 + n];
    const float dt = __expf(log_dt[g]);
    const float m = __expf(lam_re * dt * 32.f), ang = lam_im * dt * 32.f;
    const float ar = m * cosf(ang), ai = m * sinf(ang);
    float hr = 0.f, hi = 0.f;
#pragma unroll 8
    for (int c = 0; c < 256; ++c) {
        const size_t row = (size_t)g * 512 + b * 256 + c;
        const float er = E[row * 256 + n], ei = E[row * 256 + 64 + n];
        UA[row * 640 + 512 + n] = f2bf(hr); UA[row * 640 + 576 + n] = f2bf(hi);
        const float nr = ar * hr - ai * hi + er, ni = ar * hi + ai * hr + ei;
        hr = nr; hi = ni;
    }
}

struct Args {
    const float* in[42];
    float* out;
    unsigned char* ws;
    int ph_lo, ph_hi;
};

template <bool DUAL, class AF, class WF, class EF>
__device__ __forceinline__ void naive_gemm(LAS float* lds, int M, int N, int K, AF arow, WF wbase, int ldw, EF epi) {
    LAS float* As = lds;
    LAS float* Bs = lds + 64 * 33;
    LAS float* Bs2 = Bs + 32 * 64;
    const int tid = TIDX, ty = tid >> 4, tx = tid & 15;
    const int tm = (M + 63) / 64, tn = (N + 63) / 64;
    for (int tile = blockIdx.x; tile < tm * tn; tile += gridDim.x) {
        const int m0 = (tile / tn) * 64, n0 = (tile % tn) * 64;
        const float* W = wbase(m0, 0);
        const float* W2 = DUAL ? wbase(m0, 1) : W;
        float acc[2][4], acc2[2][4];
#pragma unroll
        for (int i = 0; i < 2; ++i)
#pragma unroll
            for (int j = 0; j < 4; ++j) { acc[i][j] = 0.f; acc2[i][j] = 0.f; }
        for (int k0 = 0; k0 < K; k0 += 32) {
#pragma unroll
            for (int i = 0; i < 4; ++i) {
                const int idx = tid + i * 512, r = idx >> 5, kk = idx & 31, m = m0 + r;
                As[r * 33 + kk] = (m < M) ? bf2f(arow(m)[k0 + kk]) : 0.f;
            }
#pragma unroll
            for (int i = 0; i < 4; ++i) {
                const int idx = tid + i * 512, kk = idx >> 6, n = idx & 63;
                const bool ok = (n0 + n) < N;
                Bs[kk * 64 + n] = ok ? W[(size_t)(k0 + kk) * ldw + n0 + n] : 0.f;
                if (DUAL) Bs2[kk * 64 + n] = ok ? W2[(size_t)(k0 + kk) * ldw + n0 + n] : 0.f;
            }
            __syncthreads();
#pragma unroll 8
            for (int kk = 0; kk < 32; ++kk) {
                const float a0 = As[(ty * 2) * 33 + kk], a1 = As[(ty * 2 + 1) * 33 + kk];
#pragma unroll
                for (int j = 0; j < 4; ++j) {
                    const float b = Bs[kk * 64 + tx * 4 + j];
                    acc[0][j] += a0 * b; acc[1][j] += a1 * b;
                    if (DUAL) { const float b2 = Bs2[kk * 64 + tx * 4 + j]; acc2[0][j] += a0 * b2; acc2[1][j] += a1 * b2; }
                }
            }
            __syncthreads();
        }
#pragma unroll
        for (int i = 0; i < 2; ++i)
#pragma unroll
            for (int j = 0; j < 4; ++j) {
                const int m = m0 + ty * 2 + i, n = n0 + tx * 4 + j;
                if (m < M && n < N) epi(m, n, acc[i][j], acc2[i][j]);
            }
    }
}

template <class SRC, class DROW>
__device__ __forceinline__ void xpose_item(SRC src, DROW drow, bf16_t* WT, int ldk, LAS float* scr, int k0, int n0, int lane) {
#pragma unroll 8
    for (int i = 0; i < 32; ++i) { const int kk = 2 * i + (lane >> 5); scr[kk * 33 + (lane & 31)] = src(k0 + kk, n0 + (lane & 31)); }
    asm volatile("s_waitcnt lgkmcnt(0)" ::: "memory");
    const int c = lane & 7;
#pragma unroll
    for (int j = 0; j < 4; ++j) {
        const int n = (lane >> 3) + 8 * j; const LAS float* sp = scr + (8 * c) * 33 + n;
        u32x4 o; o.x = pk2(sp[0 * 33], sp[1 * 33]); o.y = pk2(sp[2 * 33], sp[3 * 33]); o.z = pk2(sp[4 * 33], sp[5 * 33]); o.w = pk2(sp[6 * 33], sp[7 * 33]);
        *(u32x4*)(WT + (size_t)drow(n0 + n) * ldk + k0 + 8 * c) = o;
    }
    asm volatile("s_waitcnt lgkmcnt(0)" ::: "memory");
}
__device__ __forceinline__ void convert_plain(const float* W, int K, int N, int NP, bf16_t* WT, LAS float* scr, int gw, int ngw, int lane) {
    const int nblk = NP / 32, nitems = (K / 64) * nblk;
    for (int it = gw; it < nitems; it += ngw) {
        const int k0 = 64 * (it / nblk), n0 = 32 * (it % nblk);
        xpose_item([&](int k, int n) { return n < N ? W[(size_t)k * N + n] : 0.f; }, [&](int n) { return n; }, WT, K, scr, k0, n0, lane);
    }
}
__device__ __forceinline__ void convert_lora(const float* w2, const float* a2, const float* g2, bf16_t* WT, LAS float* scr, int gw, int ngw, int lane) {
    const int nblk = NLORA / 32, nitems = 4 * nblk;
    for (int it = gw; it < nitems; it += ngw) {
        const int k0 = 64 * (it / nblk), n0 = 32 * (it % nblk);
        xpose_item([&](int k, int n) {
            if (n < 512) return k < 64 ? w2[k * 512 + n] : 0.f;
            if (n < 1024) return (k >= 64 && k < 128) ? a2[(k - 64) * 512 + (n - 512)] : 0.f;
            return k >= 128 ? g2[(k - 128) * 512 + (n - 1024)] : 0.f; }, [&](int n) { return n; }, WT, 256, scr, k0, n0, lane);
    }
}
__device__ __forceinline__ void convert_moe(const float* w1, const float* w3, const float* w2, bf16_t* W13, bf16_t* W2T, LAS float* scr, int gw, int ngw, int lane) {
    constexpr int I13 = 16 * 32, I2 = 8 * 32, IE = I13 + I2;
    for (int it = gw; it < 32 * IE; it += ngw) {
        const int e = it / IE, r = it % IE;
        if (r < I13) {
            const int k0 = 64 * (r / 32), n0 = 32 * (r % 32);
            const float* a = w1 + (size_t)e * D_ * 512; const float* b = w3 + (size_t)e * D_ * 512;
            xpose_item([&](int k, int n) { return n < 512 ? a[(size_t)k * 512 + n] : b[(size_t)k * 512 + (n - 512)]; },
                       [&](int n) { const int c = n & 511; return (c >> 2) * 8 + (n >> 9) * 4 + (c & 3); }, W13 + (size_t)e * 1024 * 1024, 1024, scr, k0, n0, lane);
        } else {
            const int rr = r - I13, k0 = 64 * (rr / 32), n0 = 32 * (rr % 32);
            const float* a = w2 + (size_t)e * 512 * D_;
            xpose_item([&](int k, int n) { return a[(size_t)k * D_ + n]; }, [&](int n) { return n; }, W2T + (size_t)e * 1024 * 512, 512, scr, k0, n0, lane);
        }
    }
}

__device__ __forceinline__ void ph_prologue(const float* x, bf16_t* hb) {
    const size_t n4 = (size_t)T_ * D_ / 4;
    for (size_t i = (size_t)blockIdx.x * NTHREADS + TIDX; i < n4; i += (size_t)gridDim.x * NTHREADS) {
        const f32x4 v = ((const f32x4*)x)[i];
        u32x2 o; o.x = pk2(v.x, v.y); o.y = pk2(v.z, v.w);
        ((u32x2*)hb)[i] = o;
    }
    for (size_t i = (size_t)blockIdx.x * NTHREADS + TIDX; i < (size_t)256 * D_ / 2; i += (size_t)gridDim.x * NTHREADS)
        ((unsigned*)(hb + (size_t)T_ * D_))[i] = 0u;
}

__device__ __forceinline__ float p0_shift(const bf16_t* P, const float* mu, int t, int c) {
    const float p = bf2f(P[(size_t)t * NIN0P + c]);
    const float pv = ((t & (L_ - 1)) == 0) ? 0.f : bf2f(P[(size_t)(t - 1) * NIN0P + c]);
    return p + mu[c] * (pv - p);
}
template <bool WITH_GLA>
__device__ __forceinline__ void ph_prepA0(const bf16_t* P, const float* mu, const float* gk_w2, const float* gk_b, bf16_t* Ap, float* gla_la) {
    for (int chunk = blockIdx.x; chunk < T_ / 64; chunk += gridDim.x) {
        for (int idx = TIDX; idx < 64 * 256; idx += NTHREADS) {
            const int tl = idx >> 8, j = idx & 255, t = chunk * 64 + tl;
            float v;
            if (j < 64) v = tanhf(p0_shift(P, mu, t, 512 + j));
            else if (j < 128) v = p0_shift(P, mu, t, 1600 + (j - 64));
            else v = sigm(p0_shift(P, mu, t, 1664 + (j - 128)));
            Ap[(size_t)t * 256 + j] = f2bf(v);
            if (WITH_GLA) {
                float gk = gk_b[j];
#pragma unroll
                for (int i = 0; i < 16; ++i) gk += bf2f(P[(size_t)t * NIN0P + 2816 + i]) * gk_w2[i * 256 + j];
                const float ls = fminf(gk, 0.f) - log1pf(__expf(-fabsf(gk)));
                gla_la[(size_t)t * 256 + j] = ls * (1.f / 16.f);
            }
        }
    }
}

__device__ __forceinline__ void ph_prepB0(const bf16_t* P, const bf16_t* LO, const float* mu, const float* w0, const float* a0, const float* k_k, const float* k_a,
                                          const float* r_k, bf16_t* SC, float* BON) {
    const int wave = TIDX >> 6, lane = TIDX & 63;
    for (int item = blockIdx.x * NWAVES + wave; item < T_ * 8; item += gridDim.x * NWAVES) {
        const int t = item >> 3, h = item & 7, c = h * 64 + lane;
        const float r = p0_shift(P, mu, t, c), k = p0_shift(P, mu, t, 576 + c), v = p0_shift(P, mu, t, 1088 + c);
        const float low = bf2f(LO[(size_t)t * 512 + c]), loa = bf2f(LO[(size_t)T_ * 512 + (size_t)t * 512 + c]);
        const float xw = w0[c] + low;
        const float wraw = -softplusf(-xw) - 0.5f;
        const float ld = -__expf(wraw);
        const float a = sigm(a0[c] + loa);
        const float kkr = k * k_k[c];
        const float ss = wave_sum(kkr * kkr);
        const float kk = kkr / fmaxf(sqrtf(ss), 1e-12f);
        const float kp = k * (1.f + (a - 1.f) * k_a[c]);
        const float bon = wave_sum(r * kp * r_k[c]);
        const size_t o = (size_t)t * 512 + c, S1 = (size_t)T_ * 512;
        SC[o] = f2bf(r); SC[S1 + o] = f2bf(ld); SC[2 * S1 + o] = f2bf(kp); SC[3 * S1 + o] = f2bf(v); SC[4 * S1 + o] = f2bf(kk); SC[5 * S1 + o] = f2bf(a);
        if (lane == 0) BON[(size_t)t * 8 + h] = bon;
    }
}

__device__ __forceinline__ void naive_rwkv_scan(LAS float* lds, const bf16_t* SC, float* YRW, int bh) {
    constexpr int TS = 32;
    const int b = bh >> 3, h = bh & 7;
    LAS float* Lnkk = lds;
    LAS float* Ldec = lds + TS * 64;
    LAS float* Lab = lds + 2 * TS * 64;
    LAS float* Lkp = lds + 3 * TS * 64;
    LAS float* Lr = lds + 4 * TS * 64;
    LAS float* Lv = lds + 5 * TS * 64;
    const size_t S1 = (size_t)T_ * 512;
    float S[64];
#pragma unroll
    for (int k = 0; k < 64; ++k) S[k] = 0.f;
    const int lane = TIDX & 63, wave = TIDX >> 6;
    for (int t0 = 0; t0 < L_; t0 += TS) {
        for (int idx = TIDX; idx < TS * 64; idx += NTHREADS) {
            const int s = idx >> 6, k = idx & 63;
            const size_t o = (size_t)(b * L_ + t0 + s) * 512 + h * 64 + k;
            const float r = bf2f(SC[o]), ld = bf2f(SC[S1 + o]), kp = bf2f(SC[2 * S1 + o]), v = bf2f(SC[3 * S1 + o]), kk = bf2f(SC[4 * S1 + o]), a = bf2f(SC[5 * S1 + o]);
            Lnkk[idx] = -kk; Ldec[idx] = __expf(ld); Lab[idx] = kk * a; Lkp[idx] = kp; Lr[idx] = r; Lv[idx] = v;
        }
        __syncthreads();
        if (wave == 0) {
            for (int s = 0; s < TS; ++s) {
                float sa = 0.f;
#pragma unroll
                for (int k = 0; k < 64; ++k) sa += S[k] * Lnkk[s * 64 + k];
                const float vv = Lv[s * 64 + lane];
                float y = 0.f;
#pragma unroll
                for (int k = 0; k < 64; ++k) {
                    S[k] = S[k] * Ldec[s * 64 + k] + sa * Lab[s * 64 + k] + vv * Lkp[s * 64 + k];
                    y += S[k] * Lr[s * 64 + k];
                }
                YRW[(size_t)(b * L_ + t0 + s) * 512 + h * 64 + lane] = y;
            }
        }
        __syncthreads();
    }
}

template <int K, class LDF, class LVF>
__device__ __forceinline__ void naive_gla_scan(LAS float* lds, LDF ld, LVF lv, float* OG, int b, int h) {
    constexpr int TS = 16;
    LAS float* Lq = lds;
    LAS float* Lk = lds + TS * K;
    LAS float* Le = lds + 2 * TS * K;
    LAS float* Lv = lds + 3 * TS * K;
    float S[K];
#pragma unroll
    for (int k = 0; k < K; ++k) S[k] = 0.f;
    const int tid = TIDX;
    for (int t0 = 0; t0 < L_; t0 += TS) {
        for (int idx = tid; idx < TS * K; idx += NTHREADS) {
            const int s = idx / K, k = idx % K;
            float q, kk, e; ld(b * L_ + t0 + s, h * K + k, q, kk, e);
            Lq[idx] = q; Lk[idx] = kk; Le[idx] = e;
        }
        for (int idx = tid; idx < TS * 128; idx += NTHREADS) {
            const int s = idx >> 7, vc = idx & 127;
            Lv[idx] = lv(b * L_ + t0 + s, h * 128 + vc);
        }
        __syncthreads();
        if (tid < 128) {
            for (int s = 0; s < TS; ++s) {
                const float vv = Lv[s * 128 + tid];
                float o = 0.f;
#pragma unroll
                for (int k = 0; k < K; ++k) {
                    S[k] = S[k] * Le[s * K + k] + Lk[s * K + k] * vv;
                    o += Lq[s * K + k] * S[k];
                }
                OG[(size_t)(b * L_ + t0 + s) * 512 + h * 128 + tid] = o;
            }
        }
        __syncthreads();
    }
}

template <bool WITH_GLA>
__device__ __forceinline__ void ph_fin0(const float* YRW, const float* OG, const bf16_t* P, const bf16_t* LO, const bf16_t* SC, const float* BON,
                                        const float* gn_g, const float* gn_b, const float* norm_g, bf16_t* Ymix) {
    const int wave = TIDX >> 6, lane = TIDX & 63;
    const size_t S1 = (size_t)T_ * 512;
    constexpr int NU = WITH_GLA ? 12 : 8;
    for (int item = blockIdx.x * NWAVES + wave; item < T_ * NU; item += gridDim.x * NWAVES) {
        const int t = item / NU, u = item % NU;
        if (u < 8) {
            const int c = u * 64 + lane;
            const float y = YRW[(size_t)t * 512 + c];
            const float mean = wave_sum(y) * (1.f / 64.f);
            const float d = y - mean;
            const float var = wave_sum(d * d) * (1.f / 64.f);
            const float yn = d * rsqrtf(var + 64e-5f) * gn_g[c] + gn_b[c];
            const float v = bf2f(SC[3 * S1 + (size_t)t * 512 + c]);
            const float g = bf2f(LO[(size_t)2 * T_ * 512 + (size_t)t * 512 + c]);
            Ymix[(size_t)t * D_ + c] = f2bf((yn + BON[(size_t)t * 8 + u] * v) * g);
        } else {
            const int h = u - 8;
            const float o0 = OG[(size_t)t * 512 + h * 128 + lane], o1 = OG[(size_t)t * 512 + h * 128 + 64 + lane];
            const float ms = wave_sum(o0 * o0 + o1 * o1) * (1.f / 128.f);
            const float rs = rsqrtf(ms + LN_EPS);
            const float g0 = bf2f(P[(size_t)t * NIN0P + 2832 + h * 128 + lane]), g1 = bf2f(P[(size_t)t * NIN0P + 2832 + h * 128 + 64 + lane]);
            Ymix[(size_t)t * D_ + 512 + h * 128 + lane] = f2bf(o0 * rs * norm_g[lane] * siluf(g0));
            Ymix[(size_t)t * D_ + 512 + h * 128 + 64 + lane] = f2bf(o1 * rs * norm_g[64 + lane] * siluf(g1));
        }
    }
}

__device__ __forceinline__ void ph_ln_router(const float* src, float* hf, bf16_t* hb, const float* lg, const float* lb, const float* wg, const float* bg,
                                             const float* we, const float* be, int* tok_e, int* tok_slot, float* tok_g, unsigned* cnt) {
    const int wave = TIDX >> 6, lane = TIDX & 63;
    for (int t = blockIdx.x * NWAVES + wave; t < T_; t += gridDim.x * NWAVES) {
        const f32x4* xr = (const f32x4*)(src + (size_t)t * D_) + lane;
        f32x4 v[4]; float s = 0.f;
#pragma unroll
        for (int j = 0; j < 4; ++j) { v[j] = xr[64 * j]; s += (v[j].x + v[j].y) + (v[j].z + v[j].w); }
        const float mean = wave_sum(s) * (1.f / D_);
        float s2 = 0.f;
#pragma unroll
        for (int j = 0; j < 4; ++j) { v[j] = v[j] - mean; s2 += (v[j].x * v[j].x + v[j].y * v[j].y) + (v[j].z * v[j].z + v[j].w * v[j].w); }
        const float rstd = rsqrtf(wave_sum(s2) * (1.f / D_) + LN_EPS);
#pragma unroll
        for (int j = 0; j < 4; ++j) {
            const f32x4 g = ((const f32x4*)lg)[lane + 64 * j], bb = ((const f32x4*)lb)[lane + 64 * j];
            v[j] = v[j] * rstd * g + bb;
            ((f32x4*)(hf + (size_t)t * D_))[lane + 64 * j] = v[j];
            u32x2 o; o.x = pk2(v[j].x, v[j].y); o.y = pk2(v[j].z, v[j].w);
            ((u32x2*)(hb + (size_t)t * D_))[lane + 64 * j] = o;
        }
        float cl[4] = {0.f, 0.f, 0.f, 0.f};
#pragma unroll
        for (int j = 0; j < 4; ++j)
#pragma unroll
            for (int e = 0; e < 4; ++e) {
                const int d = 4 * (lane + 64 * j) + e;
                const f32x4 w = *(const f32x4*)(wg + (size_t)d * 4);
                const float xv = v[j][e];
                cl[0] += xv * w.x; cl[1] += xv * w.y; cl[2] += xv * w.z; cl[3] += xv * w.w;
            }
#pragma unroll
        for (int g = 0; g < 4; ++g) cl[g] = wave_sum(cl[g]) + bg[g];
        int grp = 0; float mx = cl[0];
#pragma unroll
        for (int g = 1; g < 4; ++g) if (cl[g] > mx) { mx = cl[g]; grp = g; }
        float den = 0.f;
#pragma unroll
        for (int g = 0; g < 4; ++g) den += __expf(cl[g] - mx);
        const float p_grp = 1.f / den;
        float fl[8];
#pragma unroll
        for (int e = 0; e < 8; ++e) fl[e] = 0.f;
        const float* weg = we + (size_t)grp * D_ * 8;
#pragma unroll
        for (int j = 0; j < 4; ++j)
#pragma unroll
            for (int e = 0; e < 4; ++e) {
                const int d = 4 * (lane + 64 * j) + e;
                const f32x4 w0 = *(const f32x4*)(weg + (size_t)d * 8), w1 = *(const f32x4*)(weg + (size_t)d * 8 + 4);
                const float xv = v[j][e];
                fl[0] += xv * w0.x; fl[1] += xv * w0.y; fl[2] += xv * w0.z; fl[3] += xv * w0.w;
                fl[4] += xv * w1.x; fl[5] += xv * w1.y; fl[6] += xv * w1.z; fl[7] += xv * w1.w;
            }
#pragma unroll
        for (int e = 0; e < 8; ++e) fl[e] = wave_sum(fl[e]) + be[grp * 8 + e];
        int j0 = 0; float m0 = fl[0];
#pragma unroll
        for (int e = 1; e < 8; ++e) if (fl[e] > m0) { m0 = fl[e]; j0 = e; }
        int j1 = -1; float m1 = -3.0e38f;
#pragma unroll
        for (int e = 0; e < 8; ++e) if (e != j0 && fl[e] > m1) { m1 = fl[e]; j1 = e; }
        const float e1 = __expf(m1 - m0);
        const float g0 = p_grp / (1.f + e1), g1 = p_grp * e1 / (1.f + e1);
        if (lane == 0) {
            const int ex0 = grp * 8 + j0, ex1 = grp * 8 + j1;
            const unsigned s0 = atomicAdd(&cnt[ex0], 1u), s1 = atomicAdd(&cnt[ex1], 1u);
            tok_e[2 * t] = ex0; tok_e[2 * t + 1] = ex1;
            tok_slot[2 * t] = (int)s0; tok_slot[2 * t + 1] = (int)s1;
            tok_g[2 * t] = g0; tok_g[2 * t + 1] = g1;
        }
    }
}

__device__ __forceinline__ void moe_offsets(LAS int* pst, const unsigned* cnt) {
    if (TIDX == 0) {
        int acc = 0;
        for (int e = 0; e < 32; ++e) { pst[e] = acc; const int c = (int)cnt[e]; acc += (c + MOE_PAD - 1) / MOE_PAD * MOE_PAD; }
        pst[32] = acc;
    }
    __syncthreads();
}
__device__ __forceinline__ int moe_expert_of_row(const LAS int* pst, int r) {
    int e = 0;
#pragma unroll 1
    for (int i = 1; i < 32; ++i) if (r >= pst[i]) e = i;
    return e;
}

__device__ __forceinline__ void ph_dispatch(LAS int* pst, const unsigned* cnt, const bf16_t* hb, const int* tok_e, const int* tok_slot, int* tok_dest, bf16_t* XR) {
    moe_offsets(pst, cnt);
    const int wave = TIDX >> 6, lane = TIDX & 63;
    for (int item = blockIdx.x * NWAVES + wave; item < T_ * 2; item += gridDim.x * NWAVES) {
        const int t = item >> 1;
        const int e = tok_e[item], dest = pst[e] + tok_slot[item];
        if (lane == 0) tok_dest[item] = dest;
        const u32x4* src = (const u32x4*)(hb + (size_t)t * D_);
        u32x4* dst = (u32x4*)(XR + (size_t)dest * D_);
        dst[lane] = src[lane]; dst[lane + 64] = src[lane + 64];
    }
    const int R = pst[32];
    for (int r = blockIdx.x * NWAVES + wave; r < R; r += gridDim.x * NWAVES) {
        const int e = moe_expert_of_row(pst, r);
        if (r - pst[e] >= (int)cnt[e]) {
            u32x4* dst = (u32x4*)(XR + (size_t)r * D_);
            const u32x4 z = {0u, 0u, 0u, 0u};
            dst[lane] = z; dst[lane + 64] = z;
        }
    }
}

__device__ __forceinline__ void ph_combine_ln(const float* hf, const bf16_t* Y, const int* tok_dest, const float* tok_g, const float* lg, const float* lb, float* outf, bf16_t* hb) {
    const int wave = TIDX >> 6, lane = TIDX & 63;
    for (int t = blockIdx.x * NWAVES + wave; t < T_; t += gridDim.x * NWAVES) {
        const int d0 = tok_dest[2 * t], d1 = tok_dest[2 * t + 1];
        const float g0 = tok_g[2 * t], g1 = tok_g[2 * t + 1];
        f32x4 v[4]; float s = 0.f;
#pragma unroll
        for (int j = 0; j < 4; ++j) {
            const f32x4 h = ((const f32x4*)(hf + (size_t)t * D_))[lane + 64 * j];
            const u32x2 y0 = ((const u32x2*)(Y + (size_t)d0 * D_))[lane + 64 * j], y1 = ((const u32x2*)(Y + (size_t)d1 * D_))[lane + 64 * j];
            f32x4 a, b;
            a.x = __uint_as_float(y0.x << 16); a.y = __uint_as_float(y0.x & 0xffff0000u); a.z = __uint_as_float(y0.y << 16); a.w = __uint_as_float(y0.y & 0xffff0000u);
            b.x = __uint_as_float(y1.x << 16); b.y = __uint_as_float(y1.x & 0xffff0000u); b.z = __uint_as_float(y1.y << 16); b.w = __uint_as_float(y1.y & 0xffff0000u);
            v[j] = h * DN_ALPHA + (a * g0 + b * g1);
            s += (v[j].x + v[j].y) + (v[j].z + v[j].w);
        }
        const float mean = wave_sum(s) * (1.f / D_);
        float s2 = 0.f;
#pragma unroll
        for (int j = 0; j < 4; ++j) { v[j] = v[j] - mean; s2 += (v[j].x * v[j].x + v[j].y * v[j].y) + (v[j].z * v[j].z + v[j].w * v[j].w); }
        const float rstd = rsqrtf(wave_sum(s2) * (1.f / D_) + LN_EPS);
#pragma unroll
        for (int j = 0; j < 4; ++j) {
            const f32x4 g = ((const f32x4*)lg)[lane + 64 * j], bb = ((const f32x4*)lb)[lane + 64 * j];
            v[j] = v[j] * rstd * g + bb;
            ((f32x4*)(outf + (size_t)t * D_))[lane + 64 * j] = v[j];
            u32x2 o; o.x = pk2(v[j].x, v[j].y); o.y = pk2(v[j].z, v[j].w);
            ((u32x2*)(hb + (size_t)t * D_))[lane + 64 * j] = o;
        }
    }
}

__device__ __forceinline__ void naive_s5_scan(const bf16_t* P1, const float* a_re, const float* a_im, const float* log_dt, const float* b_re, const float* b_im,
                                              const float* c_re, const float* c_im, const float* dvec, float* YS5, bf16_t* YS5B, int pair) {
    const int lane = TIDX & 63;
    const int b = pair >> 5, g = pair & 31, n = lane;
    const float lam_re = fminf(a_re[g * 64 + n], -1e-4f), lam_im = a_im[g * 64 + n];
    const float dt = __expf(log_dt[g]);
    const float mag = __expf(lam_re * dt);
    const float ab_re = mag * cosf(lam_im * dt), ab_im = mag * sinf(lam_im * dt);
    const float den = lam_re * lam_re + lam_im * lam_im;
    const float num_re = ab_re - 1.f;
    const float z_re = (num_re * lam_re + ab_im * lam_im) / den;
    const float z_im = (ab_im * lam_re - num_re * lam_im) / den;
    float bre[16], bim[16], cre[16], cim[16];
#pragma unroll
    for (int c = 0; c < 16; ++c) {
        bre[c] = b_re[(size_t)(g * 64 + n) * 16 + c]; bim[c] = b_im[(size_t)(g * 64 + n) * 16 + c];
        cre[c] = c_re[(size_t)(g * 16 + c) * 64 + n]; cim[c] = c_im[(size_t)(g * 16 + c) * 64 + n];
    }
    const float dd = (lane < 16) ? dvec[g * 16 + lane] : 0.f;
    float h_re = 0.f, h_im = 0.f;
    for (int tt = 0; tt < L_; ++tt) {
        const size_t t = (size_t)b * L_ + tt;
        const float ul = (lane < 16) ? bf2f(P1[t * NIN1 + g * 16 + lane]) : 0.f;
        float bur = 0.f, bui = 0.f;
#pragma unroll
        for (int c = 0; c < 16; ++c) { const float u = __shfl(ul, c); bur += u * bre[c]; bui += u * bim[c]; }
        const float x_re = z_re * bur - z_im * bui, x_im = z_re * bui + z_im * bur;
        const float nh_re = ab_re * h_re - ab_im * h_im + x_re;
        const float nh_im = ab_re * h_im + ab_im * h_re + x_im;
        h_re = nh_re; h_im = nh_im;
        float yv = 0.f;
#pragma unroll
        for (int c = 0; c < 16; ++c) { const float y = wave_sum(h_re * cre[c] - h_im * cim[c]); if (lane == c) yv = y; }
        if (lane < 16) {
            const float y = gelu_tanh(yv + dd * ul);
            YS5[t * 512 + g * 16 + lane] = y;
            YS5B[t * 512 + g * 16 + lane] = f2bf(y);
        }
    }
}

__device__ __forceinline__ void ph_fin1(const float* OG, const bf16_t* P1, const float* norm_g, bf16_t* Ymix) {
    const int wave = TIDX >> 6, lane = TIDX & 63;
    for (int item = blockIdx.x * NWAVES + wave; item < T_ * 4; item += gridDim.x * NWAVES) {
        const int t = item >> 2, h = item & 3;
        const float o0 = OG[(size_t)t * 512 + h * 128 + lane], o1 = OG[(size_t)t * 512 + h * 128 + 64 + lane];
        const float ms = wave_sum(o0 * o0 + o1 * o1) * (1.f / 128.f);
        const float rs = rsqrtf(ms + LN_EPS);
        const float g0 = bf2f(P1[(size_t)t * NIN1 + 2048 + h * 128 + lane]), g1 = bf2f(P1[(size_t)t * NIN1 + 2048 + h * 128 + 64 + lane]);
        Ymix[(size_t)t * D_ + 512 + h * 128 + lane] = f2bf(o0 * rs * norm_g[lane] * siluf(g0));
        Ymix[(size_t)t * D_ + 512 + h * 128 + 64 + lane] = f2bf(o1 * rs * norm_g[64 + lane] * siluf(g1));
    }
}

constexpr int LDS_BYTES = 147456;
constexpr int MISC_OFF = 131072 + 8192;
enum Phase {
    PH_PROLOGUE = 0,
    PH_INPROJ0, PH_PREPA0, PH_LORA0, PH_PREPB0, PH_SCAN0, PH_FIN0, PH_OUTPROJ0, PH_LN1_0, PH_DISP0, PH_UP0, PH_DOWN0, PH_COMB0,
    PH_INPROJ1, PH_L1A, PH_L1B, PH_L1C, PH_L1D, PH_SCAN1, PH_FIN1, PH_GLU1, PH_OUTPROJ1, PH_LN1_1, PH_DISP1, PH_UP1, PH_DOWN1, PH_COMB1,
    PH_COUNT
};

typedef const Args __attribute__((address_space(4)))* KArgsP;
__device__ __forceinline__ KArgsP fresh_args() { KArgsP p = (KArgsP)__builtin_amdgcn_kernarg_segment_ptr(); asm volatile("" : "+s"(p)); return p; }
#define PHASE_BEGIN KArgsP ap = fresh_args(); unsigned char* const ws = ap->ws; (void)ws;
#define INP(i) (ap->in[i])
#define W_CTL ((unsigned*)(ws + WS_CTL))
#define W_HB ((bf16_t*)(ws + WS_HB))
#define W_WIN0 ((bf16_t*)(ws + WS_WIN0))
#define W_WOUT0 ((bf16_t*)(ws + WS_WOUT0))
#define W_WIN1 ((bf16_t*)(ws + WS_WIN1))
#define W_WOUT1 ((bf16_t*)(ws + WS_WOUT1))
#define W_WGLU ((bf16_t*)(ws + WS_WGLU))
#define W_WLORA ((bf16_t*)(ws + WS_WLORA))
#define W_W13 ((bf16_t*)(ws + WS_W13))
#define W_W2 ((bf16_t*)(ws + WS_W2))
#define W_HA ((float*)(ws + WS_HA))
#define W_YRW W_HA
#define W_OG (W_HA + (size_t)T_ * 512)
#define W_P ((bf16_t*)(ws + WS_P))
#define W_LO ((bf16_t*)(ws + WS_LO))
#define W_SC ((bf16_t*)(ws + WS_SCAN))
#define W_GLALA ((float*)(ws + WS_GLALA))
#define W_BON ((float*)(ws + WS_BON))
#define W_AP ((bf16_t*)(ws + WS_APRIME))
#define W_YS5B ((bf16_t*)(ws + WS_YS5B))
#define W_XR ((bf16_t*)(ws + WS_XR))
#define W_HID ((bf16_t*)(ws + WS_HID))
#define W_Y ((bf16_t*)(ws + WS_Y))
#define W_TOKE ((int*)(ws + WS_ROUTE))
#define W_TOKSLOT (W_TOKE + 2 * T_)
#define W_TOKDEST (W_TOKE + 4 * T_)
#define W_TOKG ((float*)(W_TOKE + 6 * T_))
#define W_YMIX W_HB
#define BIGP(mib) (ws + WS_BIG + (size_t)(mib) * MiB)
#define GLA0_BUFS GlaBufs{(bf16_t*)BIGP(256), (bf16_t*)BIGP(264), (bf16_t*)(ws + WS_HB), (bf16_t*)BIGP(273), (float*)BIGP(289), W_HA + (size_t)T_ * 512, (bf16_t*)BIGP(112)}
#define HG_BUFS GlaBufs{(bf16_t*)BIGP(96), (bf16_t*)BIGP(112), (bf16_t*)BIGP(144), (bf16_t*)BIGP(128), (float*)BIGP(176), (float*)BIGP(177), (bf16_t*)BIGP(144)}
#define W_S5WE ((bf16_t*)BIGP(160))
#define W_S5UA ((bf16_t*)BIGP(241))
#define W_S5MB ((bf16_t*)BIGP(261))
#define W_S5E ((float*)BIGP(281))
#define CW_SUB 12288

#define IN(k) (PLO <= (k) && (k) < PHI)
#define SEAM(k) do { if (IN(k) && IN((k) + 1)) { PHASE_BEGIN XcdBarrier bar_; bar_.bar = W_CTL + CW_BAR; bar_.x = xb_xcc_id(); bar_.st = (volatile LAS unsigned*)(lds + MISC_OFF) + 8; xcd_barrier(bar_); } } while (0)
template <int PLO, int PHI, int layer>
__device__ __forceinline__ void moe_layer(LAS unsigned char* lds) {
    LAS float* ldsf = (LAS float*)lds; (void)ldsf;
        const int base = layer == 0 ? PH_OUTPROJ0 : PH_OUTPROJ1;
        if (IN(base + 0)) {
            PHASE_BEGIN
            const float* W = layer == 0 ? INP(16) : INP(30);
            float* V1 = layer == 0 ? ap->out : W_HA;
            const float* resid = layer == 0 ? INP(0) : ap->out;
#if FAST_GEMM
            (void)W;
            { pg8::Gemm g{W_YMIX, layer == 0 ? W_WOUT0 : W_WOUT1, T_, D_, D_}; pg8::StaticOrder S; S.init(T_, D_, (int)gridDim.x, (int)blockIdx.x); pg8::EpiResidF32 E{resid, V1, D_, DN_ALPHA};
              pg8::gemm_phase<pg8::EpiResidF32, pg8::StaticOrder, true, true>(lds, g, S, E); }
#else
            const bf16_t* Ymix = W_YMIX;
            naive_gemm<false>(ldsf, T_, D_, D_, [&](int m) { return Ymix + (size_t)m * D_; }, [&](int, int) { return W; }, D_,
                              [&](int m, int n, float a, float) { V1[(size_t)m * D_ + n] = DN_ALPHA * resid[(size_t)m * D_ + n] + a; });
#endif
        }
        SEAM(base + 0);
        if (IN(base + 1)) {
            PHASE_BEGIN
            const float* V1 = layer == 0 ? ap->out : W_HA;
            ph_ln_router(V1, W_HA, W_HB, INP(31) + layer * D_, INP(32) + layer * D_, INP(33) + (size_t)layer * D_ * 4, INP(34) + layer * 4,
                         INP(35) + (size_t)layer * 4 * D_ * 8, INP(36) + layer * 32, W_TOKE, W_TOKSLOT, W_TOKG, W_CTL + CW_CNT + 64 * layer);
        }
        SEAM(base + 1);
        if (IN(base + 2)) { PHASE_BEGIN ph_dispatch((LAS int*)lds, W_CTL + CW_CNT + 64 * layer, W_HB, W_TOKE, W_TOKSLOT, W_TOKDEST, W_XR); }
        SEAM(base + 2);
        if (IN(base + 3)) {
            PHASE_BEGIN
#if FAST_GEMM
            { LAS int* pst = (LAS int*)(lds + 131072 + 2048); LAS int* tile_e = (LAS int*)(lds + 131072 + 1024);
              moe_offsets(pst, W_CTL + CW_CNT + 64 * layer);
              const int ntiles = pst[32] / 256;
              if ((int)TIDX < ntiles) tile_e[TIDX] = moe_expert_of_row(pst, TIDX * 256);
              __syncthreads();
              pg8::Gemm g{W_XR, W_W13, ntiles * 256, 1024, D_}; pg8::MoeOrder S{ntiles, 4, (int)gridDim.x, (int)blockIdx.x, tile_e}; pg8::EpiSwiglu E{W_HID};
              pg8::gemm_phase<pg8::EpiSwiglu, pg8::MoeOrder, true, true>(lds, g, S, E); }
#else
            LAS int* pst = (LAS int*)(lds + 65536);
            moe_offsets(pst, W_CTL + CW_CNT + 64 * layer);
            const float* w1 = INP(37) + (size_t)layer * 32 * D_ * 512; const float* w3 = INP(38) + (size_t)layer * 32 * D_ * 512;
            const bf16_t* XR = W_XR; bf16_t* HID = W_HID;
            naive_gemm<true>(ldsf, pst[32], 512, D_, [&](int m) { return XR + (size_t)m * D_; },
                             [&](int m0, int which) { const int e = moe_expert_of_row(pst, m0); return (which ? w3 : w1) + (size_t)e * D_ * 512; }, 512,
                             [&](int m, int n, float a, float b) { HID[(size_t)m * 512 + n] = f2bf(siluf(a) * b); });
#endif
        }
        SEAM(base + 3);
        if (IN(base + 4)) {
            PHASE_BEGIN
#if FAST_GEMM
            { LAS int* pst = (LAS int*)(lds + 131072 + 2048); LAS int* tile_e = (LAS int*)(lds + 131072 + 1024);
              moe_offsets(pst, W_CTL + CW_CNT + 64 * layer);
              const int ntiles = pst[32] / 256;
              if ((int)TIDX < ntiles) tile_e[TIDX] = moe_expert_of_row(pst, TIDX * 256);
              __syncthreads();
              pg8::Gemm g{W_HID, W_W2, ntiles * 256, 1024, 512}; pg8::MoeOrder S{ntiles, 4, (int)gridDim.x, (int)blockIdx.x, tile_e}; pg8::EpiStoreBf16 E{W_Y, D_, 0, 0};
              pg8::gemm_phase<pg8::EpiStoreBf16, pg8::MoeOrder, true, true>(lds, g, S, E); }
#else
            LAS int* pst = (LAS int*)(lds + 65536);
            moe_offsets(pst, W_CTL + CW_CNT + 64 * layer);
            const float* w2 = INP(39) + (size_t)layer * 32 * 512 * D_;
            const bf16_t* HID = W_HID; bf16_t* Y = W_Y;
            naive_gemm<false>(ldsf, pst[32], D_, 512, [&](int m) { return HID + (size_t)m * 512; },
                              [&](int m0, int) { const int e = moe_expert_of_row(pst, m0); return w2 + (size_t)e * 512 * D_; }, D_,
                              [&](int m, int n, float a, float) { Y[(size_t)m * D_ + n] = f2bf(a); });
#endif
        }
        SEAM(base + 4);
        if (IN(base + 5)) { PHASE_BEGIN ph_combine_ln(W_HA, W_Y, W_TOKDEST, W_TOKG, INP(40) + layer * D_, INP(41) + layer * D_, ap->out, W_HB); }
        SEAM(base + 5);

}

template <int PLO, int PHI>
__device__ __forceinline__ void mega_body(unsigned char* lds_raw) {
    LAS unsigned char* lds = (LAS unsigned char*)lds_raw;
    LAS float* ldsf = (LAS float*)lds;
    constexpr bool MULTI = (PHI - PLO) > 1;
    if (MULTI) {
        PHASE_BEGIN
        volatile LAS unsigned* MISC = (volatile LAS unsigned*)(lds + MISC_OFF);
        if (TIDX < 32) MISC[TIDX] = 0u;
        __syncthreads();
        (void)xcd_barrier_post(W_CTL + CW_BAR, MISC + 8);
    }

    if (IN(PH_PROLOGUE)) {
        PHASE_BEGIN ph_prologue(INP(0), W_HB);
#if FAST_GEMM
        LAS float* scr = ldsf + (TIDX >> 6) * (64 * 33);
        const int gw = blockIdx.x * NWAVES + (TIDX >> 6), ngw = gridDim.x * NWAVES, lane = TIDX & 63;
        convert_plain(INP(1), D_, NIN0, NIN0P, W_WIN0, scr, gw, ngw, lane);
        convert_plain(INP(16), D_, D_, D_, W_WOUT0, scr, gw, ngw, lane);
        convert_plain(INP(17), D_, NIN1, NIN1, W_WIN1, scr, gw, ngw, lane);
        convert_plain(INP(30), D_, D_, D_, W_WOUT1, scr, gw, ngw, lane);
        convert_plain(INP(26), 512, 512, 512, W_WGLU, scr, gw, ngw, lane);
        convert_lora(INP(4), INP(6), INP(7), W_WLORA, scr, gw, ngw, lane);
        convert_moe(INP(37), INP(38), INP(39), W_W13, W_W2, scr, gw, ngw, lane);
#endif
    }
    SEAM(PH_PROLOGUE);
    if (IN(PH_INPROJ0)) {
        PHASE_BEGIN
#if FAST_GEMM
        { pg8::Gemm g{W_HB, W_WIN0, T_, NIN0P, D_}; pg8::StaticOrder S; S.init(T_, NIN0P, (int)gridDim.x, (int)blockIdx.x); pg8::EpiStoreBf16 E{W_P, NIN0P, 0, 0};
          pg8::gemm_phase<pg8::EpiStoreBf16, pg8::StaticOrder, true, true>(lds, g, S, E); }
#else
        const float* W = INP(1); const bf16_t* A = W_HB; bf16_t* P = W_P;
        naive_gemm<false>(ldsf, T_, NIN0, D_, [&](int m) { return A + (size_t)m * D_; }, [&](int, int) { return W; }, NIN0,
                          [&](int m, int n, float a, float) { P[(size_t)m * NIN0P + n] = f2bf(a); });
#endif
    }
    SEAM(PH_INPROJ0);
    if (IN(PH_PREPA0)) { PHASE_BEGIN ph_prepA0<!FAST_GLA0>(W_P, INP(2), INP(13), INP(14), W_AP, W_GLALA); }
    SEAM(PH_PREPA0);
    if (IN(PH_LORA0)) {
        PHASE_BEGIN
#if FAST_GEMM
        { pg8::Gemm g{W_AP, W_WLORA, T_, NLORA, 256}; pg8::StaticOrder S; S.init(T_, NLORA, (int)gridDim.x, (int)blockIdx.x); pg8::EpiStoreBf16 E{W_LO, 512, 512, (size_t)T_ * 512};
          pg8::gemm_phase<pg8::EpiStoreBf16, pg8::StaticOrder, true, true>(lds, g, S, E); }
#else
        const float* w2 = INP(4); const float* a2 = INP(6); const float* g2 = INP(7); const bf16_t* AP = W_AP; bf16_t* LO = W_LO;
        naive_gemm<false>(ldsf, T_, 512, 64, [&](int m) { return AP + (size_t)m * 256; }, [&](int, int) { return w2; }, 512,
                          [&](int m, int n, float a, float) { LO[(size_t)m * 512 + n] = f2bf(a); });
        naive_gemm<false>(ldsf, T_, 512, 64, [&](int m) { return AP + (size_t)m * 256 + 64; }, [&](int, int) { return a2; }, 512,
                          [&](int m, int n, float a, float) { LO[(size_t)T_ * 512 + (size_t)m * 512 + n] = f2bf(a); });
        naive_gemm<false>(ldsf, T_, 512, 128, [&](int m) { return AP + (size_t)m * 256 + 128; }, [&](int, int) { return g2; }, 512,
                          [&](int m, int n, float a, float) { LO[(size_t)2 * T_ * 512 + (size_t)m * 512 + n] = f2bf(a); });
#endif
    }
    SEAM(PH_LORA0);
    if (IN(PH_PREPB0)) {
        PHASE_BEGIN ph_prepB0(W_P, W_LO, INP(2), INP(3), INP(5), INP(8), INP(9), INP(10), W_SC, W_BON);
#if FAST_GLA0
        { const GlaBufs GB = GLA0_BUFS; __syncthreads();
          for (int cg = blockIdx.x; cg < 256; cg += gridDim.x) gla_prep_tile<64, 0>(ldsf, W_P, INP(13), INP(14), GB, cg); }
#endif
    }
    SEAM(PH_PREPB0);
    if (IN(PH_SCAN0)) {
        PHASE_BEGIN
        const int bid = blockIdx.x;
#if FAST_RWKV
        constexpr int NRW = 64;
        if (bid < NRW) rwkv_scan_v1(ldsf, W_SC, W_YRW, bid);
#else
        constexpr int NRW = 16;
        if (bid < NRW) naive_rwkv_scan(ldsf, W_SC, W_YRW, bid);
#endif
#if FAST_GLA0
        else {
            const GlaBufs GB = GLA0_BUFS;
            const int nb = (int)gridDim.x - NRW, b0 = bid - NRW, wave = TIDX >> 6, lane = TIDX & 63;
            for (int u = b0 * NWAVES + wave; u < 1024 * 4; u += nb * NWAVES) gla_pass1_unit<64>(GB, u, lane);
            sub_barrier(W_CTL + CW_SUB, (unsigned)nb);
            gla_pass2<64>(GB, b0 * NTHREADS + TIDX, nb * NTHREADS);
            sub_barrier(W_CTL + CW_SUB + 64, (unsigned)nb);
            for (int it = b0; it < 1024; it += nb) gla_pass3_item<64, 0>(lds, W_P, INP(15), GB, W_YMIX, it);
        }
#else
        else if (bid < 24) {
            const int bh = bid - 16;
            const bf16_t* P = W_P; const float* GLALA = W_GLALA;
            naive_gla_scan<64>(ldsf,
                [&](int t, int ck, float& q, float& kk, float& e) {
                    q = bf2f(P[(size_t)t * NIN0P + 1792 + ck]) * 0.125f; kk = bf2f(P[(size_t)t * NIN0P + 2048 + ck]); e = __expf(GLALA[(size_t)t * 256 + ck]); },
                [&](int t, int cv) { return bf2f(P[(size_t)t * NIN0P + 2304 + cv]); }, W_OG, bh >> 2, bh & 3);
        }
#endif
    }
    SEAM(PH_SCAN0);
    if (IN(PH_FIN0)) { PHASE_BEGIN ph_fin0<!FAST_GLA0>(W_YRW, W_OG, W_P, W_LO, W_SC, W_BON, INP(11), INP(12), INP(15), W_YMIX); }
    SEAM(PH_FIN0);

    moe_layer<PLO, PHI, 0>(lds);
            if (IN(PH_INPROJ1)) {
                PHASE_BEGIN
#if FAST_GEMM
                { pg8::Gemm g{W_HB, W_WIN1, T_, NIN1, D_}; pg8::StaticOrder S; S.init(T_, NIN1, (int)gridDim.x, (int)blockIdx.x); pg8::EpiStoreBf16 E{W_P, NIN1, 0, 0};
                  pg8::gemm_phase<pg8::EpiStoreBf16, pg8::StaticOrder, true, true>(lds, g, S, E); }
#else
                const float* W = INP(17); const bf16_t* A = W_HB; bf16_t* P = W_P;
                naive_gemm<false>(ldsf, T_, NIN1, D_, [&](int m) { return A + (size_t)m * D_; }, [&](int, int) { return W; }, NIN1,
                                  [&](int m, int n, float a, float) { P[(size_t)m * NIN1 + n] = f2bf(a); });
#endif
            }
            SEAM(PH_INPROJ1);
            if (IN(PH_L1A)) {
                PHASE_BEGIN
#if FAST_S5
                if (blockIdx.x >= 224) s5_tables(ldsf, INP(18), INP(19), INP(20), INP(21), INP(22), INP(23), INP(24), W_S5MB, W_S5WE, (int)blockIdx.x - 224);
                s5_fill_ua(W_P, W_S5UA, blockIdx.x * NWAVES + (TIDX >> 6), gridDim.x * NWAVES, TIDX & 63);
                __syncthreads();
#endif
#if FAST_HG
                { const GlaBufs GB = HG_BUFS;
                  for (int cg = blockIdx.x; cg < 256; cg += gridDim.x) gla_prep_tile<128, 1>(ldsf, W_P, INP(28), nullptr, GB, cg); }
#endif
            }
            SEAM(PH_L1A);
            if (IN(PH_L1B)) {
                PHASE_BEGIN
                const int bid = blockIdx.x;
#if FAST_S5
                if (bid < 64) {
                    LAS int* tile_e = (LAS int*)(lds + 131072 + 1024);
                    if (TIDX < 64) tile_e[TIDX] = TIDX >> 1;
                    __syncthreads();
                    pg8::Gemm g{W_S5UA, W_S5WE, 64 * 256, 256, 512, 640}; pg8::MoeOrder S{64, 1, 64, bid, tile_e}; pg8::EpiStoreF32 E{W_S5E, 256};
                    pg8::gemm_phase<pg8::EpiStoreF32, pg8::MoeOrder, true, true>(lds, g, S, E);
                }
#endif
#if FAST_HG
                if (bid >= 64) {
                    const GlaBufs GB = HG_BUFS;
                    const int nb = (int)gridDim.x - 64, b0 = bid - 64, wave = TIDX >> 6, lane = TIDX & 63;
                    for (int u = b0 * NWAVES + wave; u < 1024 * 8; u += nb * NWAVES) gla_pass1_unit<128>(GB, u, lane);
                }
#endif
            }
            SEAM(PH_L1B);
            if (IN(PH_L1C)) {
                PHASE_BEGIN
                const int bid = blockIdx.x;
#if FAST_S5
                if (bid < 8) s5_carry(INP(18), INP(19), INP(20), W_S5E, W_S5UA, bid * NTHREADS + TIDX);
#endif
#if FAST_HG
                if (bid >= 8) { const GlaBufs GB = HG_BUFS; gla_pass2<128>(GB, (bid - 8) * NTHREADS + TIDX, ((int)gridDim.x - 8) * NTHREADS); }
#endif
#if FAST_GEMM
                { LAS float* scr = ldsf + (TIDX >> 6) * (64 * 33);
                  convert_moe(INP(37) + (size_t)32 * D_ * 512, INP(38) + (size_t)32 * D_ * 512, INP(39) + (size_t)32 * 512 * D_, W_W13, W_W2, scr,
                              bid * NWAVES + (TIDX >> 6), (int)gridDim.x * NWAVES, TIDX & 63); }
#endif
            }
            SEAM(PH_L1C);
            if (IN(PH_L1D)) {
                PHASE_BEGIN
                const int bid = blockIdx.x;
#if FAST_S5
                if (bid < 128) {
                    LAS int* tile_e = (LAS int*)(lds + 131072 + 1024);
                    if (TIDX < 64) tile_e[TIDX] = TIDX >> 1;
                    __syncthreads();
                    pg8::Gemm g{W_S5UA, W_S5MB, 64 * 256, 512, 640, 640}; pg8::MoeOrder S{64, 2, 128, bid, tile_e}; pg8::EpiS5Y E{W_P, INP(25), W_YRW, W_YS5B};
                    pg8::gemm_phase<pg8::EpiS5Y, pg8::MoeOrder, true, true>(lds, g, S, E);
                }
#endif
#if FAST_HG
                if (bid >= 128) {
                    const GlaBufs GB = HG_BUFS;
                    for (int it = bid - 128; it < 1024; it += (int)gridDim.x - 128) gla_pass3_item<128, 1>(lds, W_P, INP(29), GB, W_YMIX, it);
                }
#endif
            }
            SEAM(PH_L1D);
            if (IN(PH_SCAN1)) {
                PHASE_BEGIN
                const int bid = blockIdx.x;
                const bf16_t* P = W_P; (void)P; (void)bid;
#if !FAST_HG
                if (bid < 8) {
                    const float* hg_lb = INP(28);
                    naive_gla_scan<128>(ldsf,
                        [&](int t, int ck, float& q, float& kk, float& e) {
                            const float l0 = hg_lb[ck], l1 = hg_lb[512 + ck];
                            const float lbv = 1.f / (1.f + __expf(l0 - l1));
                            const float f = bf2f(P[(size_t)t * NIN1 + 1024 + ck]);
                            const float sg = sigm(f);
                            q = siluf(bf2f(P[(size_t)t * NIN1 + 512 + ck])); kk = (1.f - lbv) * (1.f - sg); e = lbv + (1.f - lbv) * sg; },
                        [&](int t, int cv) { return bf2f(P[(size_t)t * NIN1 + 1536 + cv]); }, W_OG, bid >> 2, bid & 3);
                }
#endif
#if !FAST_S5
                if (bid >= 8 && bid < 16) {
                    const int pair = (bid - 8) * 8 + (TIDX >> 6);
                    naive_s5_scan(P, INP(18), INP(19), INP(20), INP(21), INP(22), INP(23), INP(24), INP(25), W_YRW, W_YS5B, pair);
                }
#endif
            }
            SEAM(PH_SCAN1);
#if !FAST_HG
            if (IN(PH_FIN1)) { PHASE_BEGIN ph_fin1(W_OG, W_P, INP(29), W_YMIX); }
#endif
            SEAM(PH_FIN1);
            if (IN(PH_GLU1)) {
                PHASE_BEGIN
#if FAST_GEMM
                { pg8::Gemm g{W_YS5B, W_WGLU, T_, 512, 512}; pg8::StaticOrder S; S.init(T_, 512, (int)gridDim.x, (int)blockIdx.x); pg8::EpiGlu E{W_YRW, 512, INP(27), W_YMIX, D_};
                  pg8::gemm_phase<pg8::EpiGlu, pg8::StaticOrder, true, true>(lds, g, S, E); }
#else
                const float* W = INP(26); const float* gb = INP(27); const bf16_t* YS5B = W_YS5B; const float* YRW = W_YRW; bf16_t* Ymix = W_YMIX;
                naive_gemm<false>(ldsf, T_, 512, 512, [&](int m) { return YS5B + (size_t)m * 512; }, [&](int, int) { return W; }, 512,
                                  [&](int m, int n, float a, float) { const float y = YRW[(size_t)m * 512 + n]; Ymix[(size_t)m * D_ + n] = f2bf(y * sigm(a + gb[n])); });
#endif
            }
            SEAM(PH_GLU1);
    moe_layer<PLO, PHI, 1>(lds);
#undef IN
}
template <int PLO, int PHI>
__global__ void __launch_bounds__(NTHREADS, 2) mega(Args args) {
    extern __shared__ __attribute__((aligned(16))) unsigned char lds_raw[];
    mega_body<PLO, PHI>(lds_raw);
}

#include <utility>
template <int... I> static void set_attrs(std::integer_sequence<int, I...>) {
    (void)std::initializer_list<int>{ ((void)hipFuncSetAttribute((const void*)mega<I, I + 1>, hipFuncAttributeMaxDynamicSharedMemorySize, LDS_BYTES), 0)... };
}
template <int I> static int launch_one(int grid, hipStream_t stream, const Args& a) {
    hipLaunchKernelGGL((mega<I, I + 1>), dim3(grid), dim3(NTHREADS), LDS_BYTES, stream, a);
    return 0;
}
template <int... I> static void launch_all(std::integer_sequence<int, I...>, int grid, hipStream_t stream, const Args& a) {
    (void)std::initializer_list<int>{ launch_one<I>(grid, stream, a)... };
}
extern "C" void kernel_launch(void* const* d_in, const int* in_sizes, int n_in, void* d_out, int out_size, void* d_ws, size_t ws_size, hipStream_t stream) {
    static int grid = 0;
    if (grid == 0) {
        if (n_in != 42 || out_size != T_ * D_ || ws_size < WS_END) { fprintf(stderr, "kernel_launch: unexpected shapes n_in %d out %d ws %zu\n", n_in, out_size, ws_size); grid = -1; return; }
        int dev = 0, cus = 0, per_cu = 0;
        hipGetDevice(&dev);
        hipDeviceGetAttribute(&cus, hipDeviceAttributeMultiprocessorCount, dev);
        set_attrs(std::make_integer_sequence<int, PH_COUNT>{});
        hipFuncSetAttribute((const void*)mega<0, PH_COUNT>, hipFuncAttributeMaxDynamicSharedMemorySize, LDS_BYTES);
        hipOccupancyMaxActiveBlocksPerMultiprocessor(&per_cu, (const void*)mega<0, PH_COUNT>, NTHREADS, LDS_BYTES);
        (void)hipGetLastError();
        if (per_cu < 1) per_cu = 1;
        grid = cus * 1;
        fprintf(stderr, "kernel_launch: cus %d per_cu %d grid %d\n", cus, per_cu, grid);
    }
    if (grid < 0) return;
    hipMemsetAsync((char*)d_ws + WS_CTL, 0, CTL_ZERO_BYTES, stream);
    Args a{};
    for (int i = 0; i < 42; ++i) a.in[i] = (const float*)d_in[i];
    a.out = (float*)d_out; a.ws = (unsigned char*)d_ws;
#if MK_SINGLE
    void* kargs[] = {(void*)&a};
    hipError_t e = hipLaunchCooperativeKernel((const void*)mega<0, PH_COUNT>, dim3(grid), dim3(NTHREADS), kargs, LDS_BYTES, stream);
    if (e != hipSuccess) fprintf(stderr, "cooperative launch failed: %s (grid %d)\n", hipGetErrorString(e), grid);
#else
    launch_all(std::make_integer_sequence<int, PH_COUNT>{}, grid, stream, a);
#endif
}
#ifdef TEST_RANGES
template __global__ void mega<0, 2>(Args);
template __global__ void mega<1, 3>(Args);
template __global__ void mega<1, 4>(Args);
template __global__ void mega<3, 8>(Args);
template __global__ void mega<7, 13>(Args);
template __global__ void mega<10, 12>(Args);
template __global__ void mega<13, 17>(Args);
template __global__ void mega<0, 13>(Args);
#endif
```

```cpp
#include <hip/hip_runtime.h>
#include <cstdio>
#include <cstdint>

#define GAS __attribute__((address_space(1)))
#define LAS __attribute__((address_space(3)))
typedef unsigned short bf16_t;
typedef float f32x4 __attribute__((ext_vector_type(4)));
typedef unsigned u32x4 __attribute__((ext_vector_type(4)));
typedef unsigned u32x2 __attribute__((ext_vector_type(2)));
__device__ __forceinline__ int launder_tid() { int t = (int)threadIdx.x; asm volatile("" : "+v"(t)); return t; }
#define TIDX launder_tid()

#ifndef FAST_GEMM
#define FAST_GEMM 1
#endif
#ifndef FAST_RWKV
#define FAST_RWKV 1
#endif
#ifndef FAST_GLA0
#define FAST_GLA0 1
#endif
#ifndef FAST_HG
#define FAST_HG 1
#endif
#ifndef FAST_S5
#define FAST_S5 1
#endif
#ifndef MK_SINGLE
#define MK_SINGLE 1
#endif

constexpr int T_ = 16384, L_ = 8192, D_ = 1024;
constexpr int NIN0 = 3344, NIN0P = 3584, NIN1 = 2560;
constexpr int NLORA = 1536;
constexpr int RMAX = 40960;
constexpr int MOE_PAD = 256;
constexpr float DN_ALPHA = 1.41421356237f;
constexpr float LN_EPS = 1e-5f;
constexpr int NTHREADS = 512, NWAVES = 8;

constexpr size_t MiB = 1u << 20;
constexpr size_t WS_CTL = 0, CTL_ZERO_BYTES = 1 * MiB;
constexpr size_t WS_WIN0 = 2 * MiB;
constexpr size_t WS_WOUT0 = 9 * MiB;
constexpr size_t WS_WIN1 = 11 * MiB;
constexpr size_t WS_WOUT1 = 16 * MiB;
constexpr size_t WS_WGLU = 18 * MiB;
constexpr size_t WS_WLORA = 19 * MiB;
constexpr size_t WS_W13 = 20 * MiB;
constexpr size_t WS_W2 = 84 * MiB;
constexpr size_t WS_HB = 116 * MiB;
constexpr size_t WS_HA = 149 * MiB;
constexpr size_t WS_ROUTE = 213 * MiB;
constexpr size_t WS_BIG = 214 * MiB;
constexpr size_t WS_P = WS_BIG;
constexpr size_t WS_LO = WS_BIG + 112 * MiB;
constexpr size_t WS_SCAN = WS_BIG + 160 * MiB;
constexpr size_t WS_GLALA = WS_BIG + 256 * MiB;
constexpr size_t WS_BON = WS_BIG + 272 * MiB;
constexpr size_t WS_APRIME = WS_BIG + 273 * MiB;
constexpr size_t WS_YS5B = WS_BIG + 80 * MiB;
constexpr size_t WS_XR = WS_BIG;
constexpr size_t WS_HID = WS_BIG + 80 * MiB;
constexpr size_t WS_Y = WS_BIG + 120 * MiB;
constexpr size_t WS_END = 512 * MiB;
constexpr int CW_BAR = 4096;
constexpr int CW_CNT = 8192;

__device__ __forceinline__ float bf2f(bf16_t b) { return __uint_as_float(((unsigned)b) << 16); }
__device__ __forceinline__ bf16_t f2bf(float f) { unsigned u = __float_as_uint(f); u += 0x7fffu + ((u >> 16) & 1u); return (bf16_t)(u >> 16); }
__device__ __forceinline__ unsigned pk2(float lo, float hi) { return (unsigned)f2bf(lo) | ((unsigned)f2bf(hi) << 16); }
__device__ __forceinline__ float sigm(float x) { return 1.f / (1.f + __expf(-x)); }
__device__ __forceinline__ float siluf(float x) { return x * sigm(x); }
__device__ __forceinline__ float softplusf(float x) { return fmaxf(x, 0.f) + log1pf(__expf(-fabsf(x))); }
__device__ __forceinline__ float gelu_tanh(float x) { const float u = 0.7978845608028654f * (x + 0.044715f * x * x * x); return 0.5f * x * (1.f + tanhf(u)); }
__device__ __forceinline__ float wave_sum(float v) {
#pragma unroll
    for (int o = 1; o < 64; o <<= 1) v += __shfl_xor(v, o);
    return v;
}


namespace pg8 {
#define PG8_LAS __attribute__((address_space(3)))
typedef unsigned short bf16_t;
typedef short bf16x8 __attribute__((ext_vector_type(8)));
typedef float f32x4 __attribute__((ext_vector_type(4)));
typedef unsigned u32x4 __attribute__((ext_vector_type(4)));
constexpr int BM = 256, BK = 64, HALF = 128, HTB = HALF * BK * 2  , STAGE_BYTES = 8 * HTB, NXCD = 8, WGM = 8;

__host__ __device__ __forceinline__ int lds_byte(int r, int c) { const int st = (r >> 4) * 2 + (c >> 5), rr = r & 15, cc = c & 31, ob = rr * 64 + cc * 2; return st * 1024 + (ob ^ (((ob >> 9) & 1) << 5)); }
__host__ __device__ __forceinline__ void stage_rc(int b, int& R, int& C) { const int st = b / 1024, sb = b % 1024, swz = sb ^ (((sb >> 9) & 1) << 5); R = (st >> 1) * 16 + swz / 64; C = (st & 1) * 32 + (swz % 64) / 2; }
__host__ __device__ __forceinline__ int perm32(int rho) { const int n = rho >> 4, i = rho & 15; return 8 * (i >> 2) + 4 * n + (i & 3); }

struct Unit { int pm, pn, pb; };
struct Gemm { const bf16_t* A; const bf16_t* Bt; int M, N, K, lda; };

struct StaticOrder {
    int nM, nN, nwg, G, c;
    __host__ __device__ void init(int M, int N, int G_, int c_) { nM = M / BM; nN = N / BM; nwg = nM * nN; G = G_; c = c_; }
    __host__ __device__ bool next(int i, Unit& u) const {
        const long L = (long)i * G + c; if (L >= nwg) return false;
        int wgid = (int)L; { const int q = nwg / NXCD, r = nwg % NXCD, xcd = wgid % NXCD, off = wgid / NXCD; wgid = (xcd < r ? xcd * (q + 1) : r * (q + 1) + (xcd - r) * q) + off; }
        const int nig = WGM * nN, gid = wgid / nig, fm = gid * WGM, gsz = (nM - fm) < WGM ? (nM - fm) : WGM;
        u.pm = fm + ((wgid % nig) % gsz); u.pn = (wgid % nig) / gsz; u.pb = u.pn; return true;
    }
    __device__ __forceinline__ void a_ready(const Unit&) const {}
    __device__ __forceinline__ void done(const Unit&) const {}
};

__device__ __forceinline__ unsigned cvt_pk_bf16(float lo, float hi) { unsigned r; asm volatile("v_cvt_pk_bf16_f32 %0, %1, %2" : "=v"(r) : "v"(lo), "v"(hi)); return r; }
typedef float f32x2 __attribute__((ext_vector_type(2)));

template <class Epi, class Sched, bool ALIGN_EPI = false, bool SP2 = false>
__device__ __forceinline__ void gemm_phase(PG8_LAS unsigned char* lds, const Gemm g, const Sched& S, const Epi& E) {
    const int tid = TIDX, wid = __builtin_amdgcn_readfirstlane(tid >> 6), lane = tid & 63, wr = wid >> 2, wc = wid & 3, fr = lane & 15, fq = lane >> 4;
    const int K = g.K, nt = K / BK, lda = g.lda ? g.lda : g.K;
    unsigned voffA[2], voffB[2];
#pragma unroll
    for (int i = 0; i < 2; ++i) { int R, C; stage_rc(tid * 16 + i * 8192, R, C); const int Rb = Epi::PERM ? ((R & ~31) + perm32(R & 31)) : R;
        voffA[i] = (unsigned)(R * lda + C) * 2u; voffB[i] = (unsigned)(Rb * K + C) * 2u; }
    const size_t kstep = (size_t)(BK * 2);
    const size_t hstep = (size_t)HALF * K * 2;
    const size_t tstep = 2 * hstep;
    const size_t hstepA = (size_t)HALF * lda * 2, tstepA = 2 * hstepA;
    const unsigned ldsw = (unsigned)wid * 1024u;
    const int aoff = lds_byte(wr * 64 + fr, fq * 8), boff = lds_byte(wc * 32 + fr, fq * 8);
#define PG8_SA(b, h) (((b) * 2 + (h)) * HTB)
#define PG8_SB(b, h) ((4 + (b) * 2 + (h)) * HTB)
#define PG8_STAGE(bufoff, gbase, voff) do { _Pragma("unroll") for (int _i = 0; _i < 2; ++_i) \
        __builtin_amdgcn_global_load_lds((const unsigned*)((const char*)(gbase) + (voff)[_i]), (PG8_LAS unsigned*)(lds + (bufoff) + ldsw + _i * 8192), 16, 0, 0); } while (0)
#define PG8_LDA(dst, b, h) do { _Pragma("unroll") for (int m = 0; m < 4; ++m) _Pragma("unroll") for (int k = 0; k < 2; ++k) dst[m][k] = *(const PG8_LAS bf16x8*)(lds + PG8_SA(b, h) + aoff + m * 2048 + k * 1024); } while (0)
#define PG8_LDB(dst, b, h) do { _Pragma("unroll") for (int n = 0; n < 2; ++n) _Pragma("unroll") for (int k = 0; k < 2; ++k) dst[n][k] = *(const PG8_LAS bf16x8*)(lds + PG8_SB(b, h) + boff + n * 2048 + k * 1024); } while (0)
#define PG8_MMA(ai, bj, At, Bt) do { __builtin_amdgcn_s_setprio(1); _Pragma("unroll") for (int m = 0; m < 4; ++m) _Pragma("unroll") for (int n = 0; n < 2; ++n) _Pragma("unroll") for (int k = 0; k < 2; ++k) \
        acc[ai][bj][m][n] = __builtin_amdgcn_mfma_f32_16x16x32_bf16(Bt[n][k], At[m][k], acc[ai][bj][m][n], 0, 0, 0); __builtin_amdgcn_s_setprio(0); } while (0)
#define PG8_WAIT_V(n) asm volatile("s_waitcnt vmcnt(" #n ")" ::: "memory")
#define PG8_WAIT_L(n) asm volatile("s_waitcnt lgkmcnt(" #n ")" ::: "memory")
#define PG8_BAR __builtin_amdgcn_s_barrier()
#define PG8_SCHED __builtin_amdgcn_sched_barrier(0)
    Unit cur, nxt; int ui = 0;
    if (!S.next(0, cur)) return;
    f32x4 acc[2][2][4][2];
#pragma unroll
    for (int a = 0; a < 2; ++a)
#pragma unroll
        for (int b = 0; b < 2; ++b)
#pragma unroll
            for (int m = 0; m < 4; ++m)
#pragma unroll
                for (int n = 0; n < 2; ++n) acc[a][b][m][n] = (f32x4){0.f, 0.f, 0.f, 0.f};
    bf16x8 At[4][2], B0[2][2], B1[2][2];
    const char* cA = (const char*)g.A + (size_t)cur.pm * tstepA; const char* cB = (const char*)g.Bt + (size_t)cur.pb * tstep;
    S.a_ready(cur);
    if constexpr (SP2) {
        PG8_STAGE(PG8_SB(0, 0), cB, voffB); PG8_STAGE(PG8_SB(0, 1), cB + hstep, voffB); PG8_STAGE(PG8_SA(0, 0), cA, voffA); PG8_STAGE(PG8_SA(0, 1), cA + hstepA, voffA);
        if (wr == 1) PG8_BAR;
        PG8_WAIT_V(2); PG8_BAR;
        PG8_STAGE(PG8_SB(1, 0), cB + kstep, voffB); PG8_STAGE(PG8_SA(1, 0), cA + kstep, voffA); PG8_STAGE(PG8_SB(1, 1), cB + hstep + kstep, voffB);
        PG8_WAIT_V(6); PG8_BAR;
    } else {
        PG8_STAGE(PG8_SB(0, 0), cB, voffB); PG8_STAGE(PG8_SA(0, 0), cA, voffA); PG8_STAGE(PG8_SB(0, 1), cB + hstep, voffB); PG8_STAGE(PG8_SA(0, 1), cA + hstepA, voffA);
        if (wr == 1) PG8_BAR;
        PG8_WAIT_V(4); PG8_BAR;
        PG8_STAGE(PG8_SB(1, 0), cB + kstep, voffB); PG8_STAGE(PG8_SA(1, 0), cA + kstep, voffA); PG8_STAGE(PG8_SB(1, 1), cB + hstep + kstep, voffB);
        PG8_WAIT_V(6); PG8_BAR;
    }
    for (;;) {
        const bool has_next = S.next(ui + 1, nxt);
        const char* nA = has_next ? (const char*)g.A + (size_t)nxt.pm * tstepA : cA; const char* nB = has_next ? (const char*)g.Bt + (size_t)nxt.pb * tstep : cB;
        for (int t = 0; t < nt; t += 2) {
            const bool last = (t == nt - 2);
            const char* a1 = cA + (size_t)(t + 1) * kstep;
            const char* a2 = last ? nA : cA + (size_t)(t + 2) * kstep; const char* b2 = last ? nB : cB + (size_t)(t + 2) * kstep;
            const char* a3 = a2 + kstep; const char* b3 = b2 + kstep;
            if (last && has_next) S.a_ready(nxt);
            if constexpr (SP2) {
            PG8_LDB(B0, 0, 0); PG8_LDB(B1, 0, 1); PG8_SCHED; PG8_LDA(At, 0, 0); PG8_STAGE(PG8_SA(1, 1), a1 + hstepA, voffA);
            PG8_WAIT_V(8); PG8_WAIT_L(0); PG8_BAR; PG8_MMA(0, 0, At, B0); PG8_MMA(0, 1, At, B1); PG8_BAR; PG8_SCHED;
            PG8_LDA(At, 0, 1); PG8_STAGE(PG8_SB(0, 0), b2, voffB); PG8_STAGE(PG8_SB(0, 1), b2 + hstep, voffB); PG8_STAGE(PG8_SA(0, 0), a2, voffA);
            PG8_WAIT_V(8); PG8_WAIT_L(0); PG8_BAR; PG8_MMA(1, 0, At, B0); PG8_MMA(1, 1, At, B1); PG8_BAR; PG8_SCHED;
            PG8_LDB(B0, 1, 0); PG8_LDB(B1, 1, 1); PG8_SCHED; PG8_LDA(At, 1, 0); PG8_STAGE(PG8_SA(0, 1), a2 + hstepA, voffA);
            PG8_WAIT_V(8); PG8_WAIT_L(0); PG8_BAR; PG8_MMA(0, 0, At, B0); PG8_MMA(0, 1, At, B1); PG8_BAR; PG8_SCHED;
            PG8_LDA(At, 1, 1); PG8_STAGE(PG8_SB(1, 0), b3, voffB); PG8_STAGE(PG8_SB(1, 1), b3 + hstep, voffB); PG8_STAGE(PG8_SA(1, 0), a3, voffA);
            PG8_WAIT_V(8); PG8_WAIT_L(0); PG8_BAR; PG8_MMA(1, 0, At, B0); PG8_MMA(1, 1, At, B1); PG8_BAR; PG8_SCHED;
            } else {
            PG8_LDB(B0, 0, 0); PG8_SCHED; PG8_LDA(At, 0, 0); PG8_STAGE(PG8_SA(1, 1), a1 + hstepA, voffA);
            PG8_WAIT_L(8); PG8_BAR; PG8_WAIT_L(0); PG8_MMA(0, 0, At, B0); PG8_BAR; PG8_SCHED;
            PG8_LDB(B1, 0, 1); PG8_STAGE(PG8_SB(0, 0), b2, voffB);
            PG8_BAR; PG8_WAIT_L(0); PG8_MMA(0, 1, At, B1); PG8_BAR;
            PG8_LDA(At, 0, 1); PG8_STAGE(PG8_SA(0, 0), a2, voffA);
            PG8_BAR; PG8_WAIT_L(0); PG8_MMA(1, 0, At, B0); PG8_BAR; PG8_SCHED;
            PG8_STAGE(PG8_SB(0, 1), b2 + hstep, voffB);
            PG8_WAIT_V(6); PG8_BAR; PG8_MMA(1, 1, At, B1); PG8_BAR;
            PG8_LDB(B0, 1, 0); PG8_SCHED; PG8_LDA(At, 1, 0); PG8_STAGE(PG8_SA(0, 1), a2 + hstepA, voffA);
            PG8_WAIT_L(8); PG8_BAR; PG8_WAIT_L(0); PG8_MMA(0, 0, At, B0); PG8_BAR; PG8_SCHED;
            PG8_LDB(B1, 1, 1); PG8_STAGE(PG8_SB(1, 0), b3, voffB);
            PG8_BAR; PG8_WAIT_L(0); PG8_MMA(0, 1, At, B1); PG8_BAR;
            PG8_LDA(At, 1, 1); PG8_STAGE(PG8_SA(1, 0), a3, voffA);
            PG8_BAR; PG8_WAIT_L(0); PG8_MMA(1, 0, At, B0); PG8_BAR; PG8_SCHED;
            PG8_STAGE(PG8_SB(1, 1), b3 + hstep, voffB);
            PG8_WAIT_V(6); PG8_BAR; PG8_MMA(1, 1, At, B1); PG8_BAR;
            }
        }
        if constexpr (ALIGN_EPI) { if (wr == 0) PG8_BAR; }
        if constexpr (!Epi::AFTER_DRAIN) { E(acc, cur, wr, wc, fr, fq); S.done(cur); }
        if (!has_next) break;
#pragma unroll
        for (int a = 0; a < 2; ++a)
#pragma unroll
            for (int b = 0; b < 2; ++b)
#pragma unroll
                for (int m = 0; m < 4; ++m)
#pragma unroll
                    for (int n = 0; n < 2; ++n) acc[a][b][m][n] = (f32x4){0.f, 0.f, 0.f, 0.f};
        cur = nxt; cA = nA; cB = nB; ++ui;
        if constexpr (ALIGN_EPI) { if (wr == 1) PG8_BAR; }
    }
    PG8_WAIT_V(0);
    if constexpr (!ALIGN_EPI) { if (wr == 0) PG8_BAR; }
    PG8_BAR;
    if constexpr (Epi::AFTER_DRAIN) { E.fused(acc, cur, wr, wc, fr, fq, lds, wid, lane); S.done(cur); }
#undef PG8_SA
#undef PG8_SB
#undef PG8_STAGE
#undef PG8_LDA
#undef PG8_LDB
#undef PG8_MMA
#undef PG8_WAIT_V
#undef PG8_WAIT_L
#undef PG8_BAR
#undef PG8_SCHED
}

struct EpiStoreBf16 {
    static constexpr bool PERM = true, AFTER_DRAIN = false;
    bf16_t* O; int ldc; int split_cols; size_t split_stride;
    __device__ __forceinline__ void operator()(const f32x4 (&acc)[2][2][4][2], const Unit& u, int wr, int wc, int fr, int fq) const {
        int colt = u.pn * BM; bf16_t* base = O;
        if (split_cols) { const int t = colt / split_cols; base += (size_t)t * split_stride; colt -= t * split_cols; }
        const int row0 = u.pm * BM + wr * 64 + fr, col0 = colt + wc * 32 + 8 * fq;
#pragma unroll
        for (int ai = 0; ai < 2; ++ai)
#pragma unroll
            for (int m = 0; m < 4; ++m) { bf16_t* rowp = base + (size_t)(row0 + ai * HALF + m * 16) * ldc + col0;
#pragma unroll
                for (int bj = 0; bj < 2; ++bj) { const f32x4 v0 = acc[ai][bj][m][0], v1 = acc[ai][bj][m][1];
                    u32x4 w; w.x = cvt_pk_bf16(v0[0], v0[1]); w.y = cvt_pk_bf16(v0[2], v0[3]); w.z = cvt_pk_bf16(v1[0], v1[1]); w.w = cvt_pk_bf16(v1[2], v1[3]);
                    *(u32x4*)(rowp + bj * HALF) = w; } }
    }
};
struct EpiResidF32 {
    static constexpr bool PERM = false, AFTER_DRAIN = false;
    const float* resid; float* out; int ldc; float alpha;
    __device__ __forceinline__ void operator()(const f32x4 (&acc)[2][2][4][2], const Unit& u, int wr, int wc, int fr, int fq) const {
        const int row0 = u.pm * BM + wr * 64 + fr, col0 = u.pn * BM + wc * 32 + 4 * fq;
#pragma unroll
        for (int ai = 0; ai < 2; ++ai)
#pragma unroll
            for (int m = 0; m < 4; ++m) { const size_t off = (size_t)(row0 + ai * HALF + m * 16) * ldc + col0;
#pragma unroll
                for (int bj = 0; bj < 2; ++bj)
#pragma unroll
                    for (int n = 0; n < 2; ++n) { const size_t o = off + bj * HALF + n * 16; *(f32x4*)(out + o) = *(const f32x4*)(resid + o) * alpha + acc[ai][bj][m][n]; } }
    }
};
__device__ __forceinline__ float fast_sigm(float x) { return __builtin_amdgcn_rcpf(1.f + __expf(-x)); }
struct EpiSwiglu {
    static constexpr bool PERM = true, AFTER_DRAIN = false;
    bf16_t* HID;
    __device__ __forceinline__ void operator()(const f32x4 (&acc)[2][2][4][2], const Unit& u, int wr, int wc, int fr, int fq) const {
        const int row0 = u.pm * BM + wr * 64 + fr, h0 = u.pn * 128 + wc * 16 + 4 * fq;
#pragma unroll
        for (int ai = 0; ai < 2; ++ai)
#pragma unroll
            for (int m = 0; m < 4; ++m) { bf16_t* rowp = HID + (size_t)(row0 + ai * HALF + m * 16) * 512 + h0;
#pragma unroll
                for (int bj = 0; bj < 2; ++bj) { const f32x4 a = acc[ai][bj][m][0], b = acc[ai][bj][m][1]; f32x4 h;
#pragma unroll
                    for (int j = 0; j < 4; ++j) h[j] = a[j] * fast_sigm(a[j]) * b[j];
                    typedef unsigned u32x2v __attribute__((ext_vector_type(2)));
                    u32x2v w; w.x = cvt_pk_bf16(h[0], h[1]); w.y = cvt_pk_bf16(h[2], h[3]);
                    *(u32x2v*)(rowp + bj * 64) = w; } }
    }
};
struct EpiGlu {
    static constexpr bool PERM = true, AFTER_DRAIN = false;
    const float* ysrc; int ldy; const float* bias; bf16_t* O; int ldc;
    __device__ __forceinline__ void operator()(const f32x4 (&acc)[2][2][4][2], const Unit& u, int wr, int wc, int fr, int fq) const {
        const int row0 = u.pm * BM + wr * 64 + fr, col0 = u.pn * BM + wc * 32 + 8 * fq;
#pragma unroll
        for (int ai = 0; ai < 2; ++ai)
#pragma unroll
            for (int m = 0; m < 4; ++m) { const int row = row0 + ai * HALF + m * 16;
#pragma unroll
                for (int bj = 0; bj < 2; ++bj) { const int col = col0 + bj * HALF;
                    const f32x4 y0 = *(const f32x4*)(ysrc + (size_t)row * ldy + col), y1 = *(const f32x4*)(ysrc + (size_t)row * ldy + col + 4);
                    const f32x4 b0 = *(const f32x4*)(bias + col), b1 = *(const f32x4*)(bias + col + 4);
                    f32x4 v0 = acc[ai][bj][m][0] + b0, v1 = acc[ai][bj][m][1] + b1;
#pragma unroll
                    for (int j = 0; j < 4; ++j) { v0[j] = y0[j] * fast_sigm(v0[j]); v1[j] = y1[j] * fast_sigm(v1[j]); }
                    u32x4 w; w.x = cvt_pk_bf16(v0[0], v0[1]); w.y = cvt_pk_bf16(v0[2], v0[3]); w.z = cvt_pk_bf16(v1[0], v1[1]); w.w = cvt_pk_bf16(v1[2], v1[3]);
                    *(u32x4*)(O + (size_t)row * ldc + col) = w; } }
    }
};
struct EpiStoreF32 {
    static constexpr bool PERM = false, AFTER_DRAIN = false;
    float* out; int ldc;
    __device__ __forceinline__ void operator()(const f32x4 (&acc)[2][2][4][2], const Unit& u, int wr, int wc, int fr, int fq) const {
        const int row0 = u.pm * BM + wr * 64 + fr, col0 = u.pn * BM + wc * 32 + 4 * fq;
#pragma unroll
        for (int ai = 0; ai < 2; ++ai)
#pragma unroll
            for (int m = 0; m < 4; ++m) { const size_t off = (size_t)(row0 + ai * HALF + m * 16) * ldc + col0;
#pragma unroll
                for (int bj = 0; bj < 2; ++bj)
#pragma unroll
                    for (int n = 0; n < 2; ++n) *(f32x4*)(out + off + bj * HALF + n * 16) = acc[ai][bj][m][n]; }
    }
};
struct EpiS5Y {
    static constexpr bool PERM = false, AFTER_DRAIN = false;
    const bf16_t* P1; const float* dvec; float* YS5; bf16_t* YS5B;
    __device__ __forceinline__ void operator()(const f32x4 (&acc)[2][2][4][2], const Unit& u, int wr, int wc, int fr, int fq) const {
        const int g = u.pm >> 1, ch = g * 16 + 4 * fq;
        const f32x4 dd = *(const f32x4*)(dvec + ch);
#pragma unroll
        for (int ai = 0; ai < 2; ++ai)
#pragma unroll
            for (int m = 0; m < 4; ++m) {
                const int bc = (u.pm & 1) * 256 + ai * HALF + wr * 64 + m * 16 + fr, b = bc >> 8, c32 = bc & 255;
#pragma unroll
                for (int bj = 0; bj < 2; ++bj)
#pragma unroll
                    for (int n = 0; n < 2; ++n) {
                        const int i = 16 * u.pn + 8 * bj + 2 * wc + n;
                        const size_t t = (size_t)b * 8192 + c32 * 32 + i;
                        typedef unsigned u32x2v __attribute__((ext_vector_type(2)));
                        const u32x2v uu = *(const u32x2v*)(P1 + t * 2560 + ch);
                        f32x4 uv; uv[0] = __uint_as_float(uu.x << 16); uv[1] = __uint_as_float(uu.x & 0xffff0000u); uv[2] = __uint_as_float(uu.y << 16); uv[3] = __uint_as_float(uu.y & 0xffff0000u);
                        f32x4 y = acc[ai][bj][m][n] + dd * uv;
#pragma unroll
                        for (int j = 0; j < 4; ++j) { const float x = y[j]; const float tt = 0.7978845608028654f * (x + 0.044715f * x * x * x); y[j] = 0.5f * x * (1.f + tanhf(tt)); }
                        *(f32x4*)(YS5 + t * 512 + ch) = y;
                        u32x2v w; w.x = cvt_pk_bf16(y[0], y[1]); w.y = cvt_pk_bf16(y[2], y[3]);
                        *(u32x2v*)(YS5B + t * 512 + ch) = w;
                    }
            }
    }
};
struct MoeOrder {
    int ntiles, nN, G, c; const PG8_LAS int* tile_e;
    __device__ __forceinline__ bool next(int i, Unit& u) const {
        const int L = i * G + c; if (L >= ntiles * nN) return false;
        u.pm = L / nN; u.pn = L % nN; u.pb = tile_e[u.pm] * nN + u.pn; return true;
    }
    __device__ __forceinline__ void a_ready(const Unit&) const {}
    __device__ __forceinline__ void done(const Unit&) const {}
};
}

#define XB_TMO      128
#define XB_XCNT(j)  (256  + 64 * (j))
#define XB_XSUB(j)  (1280 + 64 * (j))
#define XB_XGEN(j)  (2304 + 64 * (j))
#define XB_TOP      3328
#define XB_TOPGEN   3392
#define XCD_BAR_WORDS 3456
#define XB_SPIN_CAP (1u << 18)
__device__ __forceinline__ unsigned xb_ld(unsigned* p)              { return __hip_atomic_load(p, __ATOMIC_RELAXED, __HIP_MEMORY_SCOPE_AGENT); }
__device__ __forceinline__ unsigned xb_add(unsigned* p, unsigned v) { return __hip_atomic_fetch_add(p, v, __ATOMIC_RELAXED, __HIP_MEMORY_SCOPE_AGENT); }
__device__ __forceinline__ unsigned xb_xcc_id() { return (unsigned)__builtin_amdgcn_s_getreg((3 << 11) | 20) & 0xFu; }
#define XB_SPIN(cond, bar) do { unsigned _sp = 0; while (cond) { __builtin_amdgcn_s_sleep(1); \
    if ((++_sp & 255u) == 0u) { if (xb_ld(&(bar)[XB_TMO])) break; if (_sp > XB_SPIN_CAP) { atomicAdd(&(bar)[XB_TMO], 1u); break; } } } } while (0)
struct XcdBarrier { unsigned* bar; unsigned x; volatile LAS unsigned* st; };
__device__ __forceinline__ XcdBarrier xcd_barrier_post(unsigned* bar, volatile LAS unsigned* st) {
    XcdBarrier b; b.bar = bar; b.x = xb_xcc_id(); b.st = st;
    if (TIDX == 0) (void)xb_add(&bar[XB_XCNT(b.x)], 1u);
    return b;
}
__device__ __forceinline__ void xcd_barrier_complete(unsigned* bar, unsigned x, unsigned& nloc, unsigned& nx) {
    const unsigned G = gridDim.x;
    unsigned sum, cnt, mine, sp = 0u;
    for (;;) {
        sum = 0u; cnt = 0u; mine = 0u;
#pragma unroll
        for (unsigned j = 0; j < 16; ++j) { const unsigned c = xb_ld(&bar[XB_XCNT(j)]); sum += c; cnt += (c > 0u) ? 1u : 0u; mine = (j == x) ? c : mine; }
        if (sum == G) break;
        __builtin_amdgcn_s_sleep(1);
        if ((++sp & 255u) == 0u) { if (xb_ld(&bar[XB_TMO])) break; if (sp > XB_SPIN_CAP) { atomicAdd(&bar[XB_TMO], 1u); break; } }
    }
    nloc = mine > 0u ? mine : 1u; nx = cnt > 0u ? cnt : 1u;
}
__device__ __forceinline__ void xcd_barrier(const XcdBarrier& b) {
    asm volatile("s_waitcnt vmcnt(0)" ::: "memory");
    __syncthreads();
    if (TIDX == 0) {
        unsigned* bar = b.bar;
        __builtin_amdgcn_s_waitcnt(0);
        unsigned nloc = b.st[0], nx = b.st[1];
        if (nloc == 0u) { xcd_barrier_complete(bar, b.x, nloc, nx); b.st[0] = nloc; b.st[1] = nx; }
        const unsigned old = xb_add(&bar[XB_XSUB(b.x)], 1u);
        const unsigned gen = old / nloc;
        if (old + 1u == (gen + 1u) * nloc) {
            __builtin_amdgcn_fence(__ATOMIC_RELEASE, "agent");
            asm volatile("s_waitcnt vmcnt(0)" ::: "memory");
            const unsigned og = xb_add(&bar[XB_TOP], 1u);
            const unsigned tg = og / nx;
            if (og + 1u == (tg + 1u) * nx) xb_add(&bar[XB_TOPGEN], 1u);
            else XB_SPIN(xb_ld(&bar[XB_TOPGEN]) == tg, bar);
            __builtin_amdgcn_fence(__ATOMIC_ACQUIRE, "agent");
            xb_add(&bar[XB_XGEN(b.x)], 1u);
            asm volatile("s_waitcnt vmcnt(0)" ::: "memory");
        } else {
            XB_SPIN(xb_ld(&bar[XB_XGEN(b.x)]) == gen, bar);
            __builtin_amdgcn_fence(__ATOMIC_ACQUIRE, "agent");
            asm volatile("s_waitcnt vmcnt(0)" ::: "memory");
        }
    }
    __syncthreads();
}


typedef short bf16x8 __attribute__((ext_vector_type(8)));
struct GlaBufs { bf16_t* QT; bf16_t* KT; bf16_t* KDT; bf16_t* VT; float* DG; float* DS; bf16_t* SP; };
__device__ __forceinline__ float logsigf(float x) { return fminf(x, 0.f) - log1pf(__expf(-fabsf(x))); }

template <int K, int LAYER>
__device__ __forceinline__ void gla_prep_tile(LAS float* lds, const bf16_t* P, const float* aux0, const float* aux1, const GlaBufs& B, int cg) {
    constexpr int HK = 4 * K, KP = K + 1;
    LAS float* G = lds;
    LAS float* KR = lds + 64 * KP;
    LAS float* LV = lds + 2 * 64 * KP;
    const int tid = TIDX, lane = tid & 63, wave = tid >> 6;
    const int t0 = cg * 64;
    for (int h = 0; h < 4; ++h) {
        for (int idx = tid; idx < 64 * K; idx += NTHREADS) {
            const int t = idx / K, k = idx % K, ck = h * K + k;
            float g, kr;
            if (LAYER == 0) {
                const bf16_t* row = P + (size_t)(t0 + t) * NIN0P;
                float gk = aux1[ck];
#pragma unroll
                for (int i = 0; i < 16; ++i) gk += bf2f(row[2816 + i]) * aux0[i * 256 + ck];
                g = logsigf(gk) * (1.f / 16.f);
                kr = bf2f(row[2048 + ck]);
            } else {
                const bf16_t* row = P + (size_t)(t0 + t) * NIN1;
                const float lbv = 1.f / (1.f + __expf(aux0[ck] - aux0[512 + ck]));
                const float sg = sigm(bf2f(row[1024 + ck]));
                g = __logf(lbv + (1.f - lbv) * sg);
                kr = (1.f - lbv) * (1.f - sg);
            }
            G[t * KP + k] = g; KR[t * KP + k] = kr;
        }
        for (int idx = tid; idx < 64 * 128; idx += NTHREADS) {
            const int t = idx >> 7, vc = idx & 127;
            LV[t * 129 + vc] = bf2f(LAYER == 0 ? P[(size_t)(t0 + t) * NIN0P + 2304 + h * 128 + vc] : P[(size_t)(t0 + t) * NIN1 + 1536 + h * 128 + vc]);
        }
        __syncthreads();
        for (int k = wave; k < K; k += NWAVES) {
            float v = G[lane * KP + k];
#pragma unroll
            for (int o = 1; o < 64; o <<= 1) { const float n = __shfl_up(v, o); if (lane >= o) v += n; }
            G[lane * KP + k] = v;
        }
        __syncthreads();
        for (int idx = tid; idx < 64 * K; idx += NTHREADS) {
            const int t = idx / K, k = idx % K, ck = h * K + k;
            const float b = G[t * KP + k];
            float q;
            if (LAYER == 0) q = bf2f(P[(size_t)(t0 + t) * NIN0P + 1792 + ck]) * 0.125f;
            else q = siluf(bf2f(P[(size_t)(t0 + t) * NIN1 + 512 + ck]));
            B.QT[(size_t)(t0 + t) * HK + ck] = f2bf(q * __expf(b));
            B.KT[(size_t)(t0 + t) * HK + ck] = f2bf(KR[t * KP + k] * __expf(-b));
        }
        for (int idx = tid; idx < 64 * K; idx += NTHREADS) {
            const int k = idx >> 6, t = idx & 63, ck = h * K + k;
            const float bl = G[63 * KP + k];
            B.KDT[((size_t)cg * HK + ck) * 64 + t] = f2bf(KR[t * KP + k] * __expf(bl - G[t * KP + k]));
            if (t == 0) B.DG[(size_t)cg * HK + ck] = __expf(bl);
        }
        for (int idx = tid; idx < 64 * 128; idx += NTHREADS) {
            const int vc = idx >> 6, t = idx & 63;
            B.VT[((size_t)cg * 512 + h * 128 + vc) * 64 + t] = f2bf(LV[t * 129 + vc]);
        }
        __syncthreads();
    }
}

template <int K>
__device__ __forceinline__ void gla_pass1_unit(const GlaBufs& B, int unit, int lane) {
    constexpr int HK = 4 * K, KT16 = K / 16;
    const int item = unit / KT16, kt = unit % KT16, cg = item >> 2, h = item & 3;
    const int r = lane & 15, q = lane >> 4;
    const bf16_t* ap = B.KDT + ((size_t)cg * HK + h * K + kt * 16 + r) * 64 + 8 * q;
    const bf16x8 a0 = *(const bf16x8*)ap, a1 = *(const bf16x8*)(ap + 32);
    float* dsp = B.DS + ((size_t)item * 128 + r) * K + kt * 16 + 4 * q;
#pragma unroll
    for (int vt = 0; vt < 8; ++vt) {
        const bf16_t* bp = B.VT + ((size_t)cg * 512 + h * 128 + vt * 16 + r) * 64 + 8 * q;
        const bf16x8 b0 = *(const bf16x8*)bp, b1 = *(const bf16x8*)(bp + 32);
        f32x4 acc = {0.f, 0.f, 0.f, 0.f};
        acc = __builtin_amdgcn_mfma_f32_16x16x32_bf16(a0, b0, acc, 0, 0, 0);
        acc = __builtin_amdgcn_mfma_f32_16x16x32_bf16(a1, b1, acc, 0, 0, 0);
        *(f32x4*)(dsp + (size_t)vt * 16 * K) = acc;
    }
}

template <int K>
__device__ __forceinline__ void gla_pass2(const GlaBufs& B, int gthread, int gthreads) {
    constexpr int HK = 4 * K;
    const float* __restrict__ DS = B.DS; const float* __restrict__ DG = B.DG; bf16_t* __restrict__ SP = B.SP;
    for (int e = gthread; e < 8 * 128 * K; e += gthreads) {
        const int k = e % K, v = (e / K) & 127, bh = e / (K * 128), b = bh >> 2, h = bh & 3;
        float S = 0.f;
#pragma unroll 8
        for (int c = 0; c < 128; ++c) {
            const int cg = b * 128 + c;
            const size_t idx = ((size_t)(cg * 4 + h) * 128 + v) * K + k;
            const float d = DG[(size_t)cg * HK + h * K + k], ds = DS[idx];
            SP[idx] = f2bf(S);
            S = d * S + ds;
        }
    }
}

template <int K, int LAYER>
__device__ __forceinline__ void gla_pass3_item(LAS unsigned char* lds, const bf16_t* P, const float* norm_g, const GlaBufs& B, bf16_t* Ymix, int item) {
    constexpr int HK = 4 * K, KS = K / 32;
    LAS bf16_t* Ls = (LAS bf16_t*)lds;
    LAS float* Lo = (LAS float*)(lds + 64 * 72 * 2);
    const int tid = TIDX, lane = tid & 63, wave = tid >> 6, r = lane & 15, q = lane >> 4;
    const int cg = item >> 2, h = item & 3, t0 = cg * 64;
    const int it = wave >> 1, i0 = it * 16;
    bf16x8 qf[KS];
#pragma unroll
    for (int s = 0; s < KS; ++s) qf[s] = *(const bf16x8*)(B.QT + (size_t)(t0 + i0 + r) * HK + h * K + 32 * s + 8 * q);
#pragma unroll
    for (int jj2 = 0; jj2 < 2; ++jj2) {
        const int j0 = ((wave & 1) * 2 + jj2) * 16;
        f32x4 acc = {0.f, 0.f, 0.f, 0.f};
        if (j0 <= i0) {
#pragma unroll
            for (int s = 0; s < KS; ++s) {
                const bf16x8 kf = *(const bf16x8*)(B.KT + (size_t)(t0 + j0 + r) * HK + h * K + 32 * s + 8 * q);
                acc = __builtin_amdgcn_mfma_f32_16x16x32_bf16(kf, qf[s], acc, 0, 0, 0);
            }
        }
        const int i = i0 + r;
        u32x2 w;
        w.x = pk2((j0 + 4 * q + 0) <= i ? acc[0] : 0.f, (j0 + 4 * q + 1) <= i ? acc[1] : 0.f);
        w.y = pk2((j0 + 4 * q + 2) <= i ? acc[2] : 0.f, (j0 + 4 * q + 3) <= i ? acc[3] : 0.f);
        *(LAS u32x2*)(Ls + i * 72 + j0 + 4 * q) = w;
    }
    __syncthreads();
    const bf16x8 sf0 = *(const LAS bf16x8*)(Ls + (i0 + r) * 72 + 8 * q), sf1 = *(const LAS bf16x8*)(Ls + (i0 + r) * 72 + 32 + 8 * q);
#pragma unroll
    for (int vv = 0; vv < 4; ++vv) {
        const int v0 = ((wave & 1) * 4 + vv) * 16;
        f32x4 acc = {0.f, 0.f, 0.f, 0.f};
#pragma unroll
        for (int s = 0; s < KS; ++s) {
            const bf16x8 sp = *(const bf16x8*)(B.SP + ((size_t)item * 128 + v0 + r) * K + 32 * s + 8 * q);
            acc = __builtin_amdgcn_mfma_f32_16x16x32_bf16(sp, qf[s], acc, 0, 0, 0);
        }
        const bf16_t* vp = B.VT + ((size_t)cg * 512 + h * 128 + v0 + r) * 64 + 8 * q;
        const bf16x8 vf0 = *(const bf16x8*)vp, vf1 = *(const bf16x8*)(vp + 32);
        acc = __builtin_amdgcn_mfma_f32_16x16x32_bf16(vf0, sf0, acc, 0, 0, 0);
        acc = __builtin_amdgcn_mfma_f32_16x16x32_bf16(vf1, sf1, acc, 0, 0, 0);
        *(LAS f32x4*)(Lo + (i0 + r) * 132 + v0 + 4 * q) = acc;
    }
    __syncthreads();
#pragma unroll 2
    for (int rr = 0; rr < 8; ++rr) {
        const int i = wave * 8 + rr, t = t0 + i;
        const float o0 = Lo[i * 132 + lane], o1 = Lo[i * 132 + 64 + lane];
        const float ms = wave_sum(o0 * o0 + o1 * o1) * (1.f / 128.f);
        const float rs = rsqrtf(ms + LN_EPS);
        float g0, g1;
        if (LAYER == 0) { g0 = bf2f(P[(size_t)t * NIN0P + 2832 + h * 128 + lane]); g1 = bf2f(P[(size_t)t * NIN0P + 2832 + h * 128 + 64 + lane]); }
        else { g0 = bf2f(P[(size_t)t * NIN1 + 2048 + h * 128 + lane]); g1 = bf2f(P[(size_t)t * NIN1 + 2048 + h * 128 + 64 + lane]); }
        Ymix[(size_t)t * D_ + 512 + h * 128 + lane] = f2bf(o0 * rs * norm_g[lane] * siluf(g0));
        Ymix[(size_t)t * D_ + 512 + h * 128 + 64 + lane] = f2bf(o1 * rs * norm_g[64 + lane] * siluf(g1));
    }
    __syncthreads();
}


template <int CTRL> __device__ __forceinline__ float dppf(float x) { return __builtin_bit_cast(float, __builtin_amdgcn_mov_dpp(__builtin_bit_cast(int, x), CTRL, 0xf, 0xf, true)); }
__device__ __forceinline__ float reduce32(float x) {
    x += dppf<0xB1>(x);
    x += dppf<0x4E>(x);
    x += dppf<0x141>(x);
    x += dppf<0x140>(x);
    auto sw = __builtin_amdgcn_permlane16_swap(__float_as_uint(x), __float_as_uint(x), false, false);
    return __uint_as_float(sw[0]) + __uint_as_float(sw[1]);
}
__device__ __forceinline__ void rwkv_scan_v1(LAS float* lds, const bf16_t* SC, float* YRW, int unit) {
    constexpr int TS = 32, TILE = 5 * TS * 64 + TS * 16;
    const int bh = unit >> 2, qr = unit & 3, b = bh >> 3, h = bh & 7;
    const int tid = TIDX, lane = tid & 63, wave = tid >> 6, cp = lane & 31, rl = wave * 2 + (lane >> 5);
    const size_t S1 = (size_t)T_ * 512;
    const int chunk = tid & 255, ls = chunk >> 3, lc0 = (chunk & 7) * 8, half = tid >> 8;
    const bf16_t* g0 = SC + (half == 0 ? 0 : 4 * S1) + (size_t)(b * L_ + ls) * 512 + h * 64 + lc0;
    const bf16_t* g1 = SC + (half == 0 ? 1 * S1 : 5 * S1) + (size_t)(b * L_ + ls) * 512 + h * 64 + lc0;
    const bf16_t* g2 = (half == 0) ? SC + 2 * S1 + (size_t)(b * L_ + ls) * 512 + h * 64 + lc0
                                   : SC + 3 * S1 + (size_t)(b * L_ + ls) * 512 + h * 64 + qr * 16 + (lc0 & 8);
    u32x4 p0, p1, p2;
    p0 = *(const u32x4*)g0; p1 = *(const u32x4*)g1; p2 = *(const u32x4*)g2;
    float S0 = 0.f, S1v = 0.f;
    auto unpack8 = [](const u32x4 v, float* f) {
        f[0] = __uint_as_float(v.x << 16); f[1] = __uint_as_float(v.x & 0xffff0000u); f[2] = __uint_as_float(v.y << 16); f[3] = __uint_as_float(v.y & 0xffff0000u);
        f[4] = __uint_as_float(v.z << 16); f[5] = __uint_as_float(v.z & 0xffff0000u); f[6] = __uint_as_float(v.w << 16); f[7] = __uint_as_float(v.w & 0xffff0000u); };
    auto stage = [&](LAS float* buf) {
        float f0[8], f1[8], f2[8];
        unpack8(p0, f0); unpack8(p1, f1); unpack8(p2, f2);
        if (half == 0) {
#pragma unroll
            for (int j = 0; j < 8; ++j) { buf[(4 * TS + ls) * 64 + lc0 + j] = f0[j]; buf[(1 * TS + ls) * 64 + lc0 + j] = __expf(f1[j]); buf[(3 * TS + ls) * 64 + lc0 + j] = f2[j]; }
        } else {
#pragma unroll
            for (int j = 0; j < 8; ++j) { buf[(0 * TS + ls) * 64 + lc0 + j] = -f0[j]; buf[(2 * TS + ls) * 64 + lc0 + j] = f0[j] * f1[j]; }
            if ((chunk & 7) < 2) {
#pragma unroll
                for (int j = 0; j < 8; ++j) buf[5 * TS * 64 + ls * 16 + (lc0 & 8) + j] = f2[j];
            }
        }
    };
    stage(lds);
    __syncthreads();
    for (int t0 = 0; t0 < L_; t0 += TS) {
        LAS float* cur = lds + ((t0 / TS) & 1) * TILE;
        LAS float* nxt = lds + (((t0 / TS) & 1) ^ 1) * TILE;
        const bool more = (t0 + TS) < L_;
        if (more) { const size_t adv = (size_t)(t0 + TS) * 512; p0 = *(const u32x4*)(g0 + adv); p1 = *(const u32x4*)(g1 + adv); p2 = *(const u32x4*)(g2 + adv); }
        float* yout = YRW + (size_t)(b * L_ + t0) * 512 + h * 64 + qr * 16 + rl;
        typedef float f32x2v __attribute__((ext_vector_type(2)));
        f32x2v a2 = *(const LAS f32x2v*)(cur + (0 * TS) * 64 + 2 * cp), w2 = *(const LAS f32x2v*)(cur + (1 * TS) * 64 + 2 * cp), b2 = *(const LAS f32x2v*)(cur + (2 * TS) * 64 + 2 * cp),
               k2 = *(const LAS f32x2v*)(cur + (3 * TS) * 64 + 2 * cp), r2 = *(const LAS f32x2v*)(cur + (4 * TS) * 64 + 2 * cp);
        float vv = cur[5 * TS * 64 + rl];
        float ysel = 0.f;
#pragma unroll
        for (int s = 0; s < TS; ++s) {
            const int sn = (s + 1) & (TS - 1);
            const f32x2v a2n = *(const LAS f32x2v*)(cur + (0 * TS + sn) * 64 + 2 * cp), w2n = *(const LAS f32x2v*)(cur + (1 * TS + sn) * 64 + 2 * cp),
                         b2n = *(const LAS f32x2v*)(cur + (2 * TS + sn) * 64 + 2 * cp), k2n = *(const LAS f32x2v*)(cur + (3 * TS + sn) * 64 + 2 * cp),
                         r2n = *(const LAS f32x2v*)(cur + (4 * TS + sn) * 64 + 2 * cp);
            const float vvn = cur[5 * TS * 64 + sn * 16 + rl];
            const float sa = reduce32(S0 * a2.x + S1v * a2.y);
            S0 = S0 * w2.x + (sa * b2.x + vv * k2.x);
            S1v = S1v * w2.y + (sa * b2.y + vv * k2.y);
            const float y = reduce32(S0 * r2.x + S1v * r2.y);
            ysel = (cp == s) ? y : ysel;
            a2 = a2n; w2 = w2n; b2 = b2n; k2 = k2n; r2 = r2n; vv = vvn;
        }
        yout[(size_t)cp * 512] = ysel;
        if (more) stage(nxt);
        __syncthreads();
    }
}

__device__ __forceinline__ void sub_barrier(unsigned* ctr, unsigned nblocks) {
    asm volatile("s_waitcnt vmcnt(0)" ::: "memory");
    __syncthreads();
    if (TIDX == 0) {
        __builtin_amdgcn_fence(__ATOMIC_RELEASE, "agent");
        asm volatile("s_waitcnt vmcnt(0)" ::: "memory");
        xb_add(ctr, 1u);
        unsigned sp = 0;
        while (xb_ld(ctr) < nblocks) { __builtin_amdgcn_s_sleep(2); if (++sp > (1u << 22)) break; }
        __builtin_amdgcn_fence(__ATOMIC_ACQUIRE, "agent");
        asm volatile("s_waitcnt vmcnt(0)" ::: "memory");
    }
    __syncthreads();
}


__device__ __forceinline__ void s5_tables(LAS float* lds, const float* a_re, const float* a_im, const float* log_dt, const float* b_re, const float* b_im,
                                          const float* c_re, const float* c_im, bf16_t* MB, bf16_t* WE, int g) {
    LAS float* pwr = lds;
    LAS float* pwi = pwr + 33 * 64;
    LAS float* zbr = pwi + 33 * 64;
    LAS float* zbi = zbr + 1024;
    LAS float* cr = zbi + 1024;
    LAS float* ci = cr + 1024;
    LAS float* kern = ci + 1024;
    const int tid = TIDX;
    if (tid < 64) {
        const int n = tid;
        const float lam_re = fminf(a_re[g * 64 + n], -1e-4f), lam_im = a_im[g * 64 + n];
        const float dt = __expf(log_dt[g]);
        const float mag = __expf(lam_re * dt);
        const float ab_re = mag * cosf(lam_im * dt), ab_im = mag * sinf(lam_im * dt);
        const float den = lam_re * lam_re + lam_im * lam_im;
        const float num_re = ab_re - 1.f;
        const float z_re = (num_re * lam_re + ab_im * lam_im) / den;
        const float z_im = (ab_im * lam_re - num_re * lam_im) / den;
        for (int tau = 0; tau <= 32; ++tau) {
            const float m = __expf(lam_re * dt * (float)tau), ang = lam_im * dt * (float)tau;
            pwr[tau * 64 + n] = m * cosf(ang); pwi[tau * 64 + n] = m * sinf(ang);
        }
        for (int c = 0; c < 16; ++c) {
            const float br = b_re[(size_t)(g * 64 + n) * 16 + c], bi = b_im[(size_t)(g * 64 + n) * 16 + c];
            zbr[n * 16 + c] = z_re * br - z_im * bi; zbi[n * 16 + c] = z_re * bi + z_im * br;
        }
    }
    for (int idx = tid; idx < 1024; idx += NTHREADS) { cr[idx] = c_re[(size_t)g * 1024 + idx]; ci[idx] = c_im[(size_t)g * 1024 + idx]; }
    __syncthreads();
    for (int idx = tid; idx < 32 * 256; idx += NTHREADS) {
        const int tau = idx >> 8, c = (idx >> 4) & 15, cp = idx & 15;
        float acc = 0.f;
        for (int n = 0; n < 64; ++n) {
            const float pr = pwr[tau * 64 + n], pi = pwi[tau * 64 + n], zr = zbr[n * 16 + cp], zi = zbi[n * 16 + cp];
            const float wr = pr * zr - pi * zi, wi = pr * zi + pi * zr;
            acc += cr[c * 64 + n] * wr - ci[c * 64 + n] * wi;
        }
        kern[idx] = acc;
    }
    __syncthreads();
    for (int idx = tid; idx < 512 * 640; idx += NTHREADS) {
        const int row = idx / 640, col = idx % 640, i = row >> 4, c = row & 15;
        float v;
        if (col < 512) { const int j = col >> 4, cp = col & 15; v = (j <= i) ? kern[((i - j) * 16 + c) * 16 + cp] : 0.f; }
        else if (col < 576) { const int n = col - 512; v = cr[c * 64 + n] * pwr[(i + 1) * 64 + n] - ci[c * 64 + n] * pwi[(i + 1) * 64 + n]; }
        else { const int n = col - 576; v = -(cr[c * 64 + n] * pwi[(i + 1) * 64 + n] + ci[c * 64 + n] * pwr[(i + 1) * 64 + n]); }
        MB[((size_t)g * 512 + row) * 640 + col] = f2bf(v);
    }
    for (int idx = tid; idx < 256 * 512; idx += NTHREADS) {
        const int np = idx >> 9, col = idx & 511;
        float v = 0.f;
        if (np < 128) {
            const int n = np & 63, j = col >> 4, cp = col & 15;
            const float pr = pwr[(31 - j) * 64 + n], pi = pwi[(31 - j) * 64 + n], zr = zbr[n * 16 + cp], zi = zbi[n * 16 + cp];
            v = np < 64 ? (pr * zr - pi * zi) : (pr * zi + pi * zr);
        }
        WE[((size_t)g * 256 + np) * 512 + col] = f2bf(v);
    }
    __syncthreads();
}
__device__ __forceinline__ void s5_fill_ua(const bf16_t* P1, bf16_t* UA, int gw, int ngw, int lane) {
    for (int t = gw; t < T_; t += ngw) {
        const int b = t >> 13, tt = t & 8191, c32 = tt >> 5, j = tt & 31, g = lane >> 1, c0 = (lane & 1) * 8;
        const u32x4 v = *(const u32x4*)(P1 + (size_t)t * NIN1 + 8 * lane);
        *(u32x4*)(UA + ((size_t)g * 512 + b * 256 + c32) * 640 + j * 16 + c0) = v;
    }
}
__device__ __forceinline__ void s5_carry(const float* a_re, const float* a_im, const float* log_dt, const float* E, bf16_t* UA, int th) {
    const int n = th & 63, g = (th >> 6) & 31, b = th >> 11;
    const float lam_re = fminf(a_re[g * 64 + n], -1e-4f), lam_im = a_im[g * 64 + n];
    const float dt = __expf(log_dt[g]);
    const float m = __expf(lam_re * dt * 32.f), ang = lam_im * dt * 32.f;
    const float ar = m * cosf(ang), ai = m * sinf(ang);
    float hr = 0.f, hi = 0.f;
#pragma unroll 8
    for (int c = 0; c < 256; ++c) {
        const size_t row = (size_t)g * 512 + b * 256 + c;
        const float er = E[row * 256 + n], ei = E[row * 256 + 64 + n];
        UA[row * 640 + 512 + n] = f2bf(hr); UA[row * 640 + 576 + n] = f2bf(hi);
        const float nr = ar * hr - ai * hi + er, ni = ar * hi + ai * hr + ei;
        hr = nr; hi = ni;
    }
}

struct Args {
    const float* in[42];
    float* out;
    unsigned char* ws;
    int ph_lo, ph_hi;
};

template <bool DUAL, class AF, class WF, class EF>
__device__ __forceinline__ void naive_gemm(LAS float* lds, int M, int N, int K, AF arow, WF wbase, int ldw, EF epi) {
    LAS float* As = lds;
    LAS float* Bs = lds + 64 * 33;
    LAS float* Bs2 = Bs + 32 * 64;
    const int tid = TIDX, ty = tid >> 4, tx = tid & 15;
    const int tm = (M + 63) / 64, tn = (N + 63) / 64;
    for (int tile = blockIdx.x; tile < tm * tn; tile += gridDim.x) {
        const int m0 = (tile / tn) * 64, n0 = (tile % tn) * 64;
        const float* W = wbase(m0, 0);
        const float* W2 = DUAL ? wbase(m0, 1) : W;
        float acc[2][4], acc2[2][4];
#pragma unroll
        for (int i = 0; i < 2; ++i)
#pragma unroll
            for (int j = 0; j < 4; ++j) { acc[i][j] = 0.f; acc2[i][j] = 0.f; }
        for (int k0 = 0; k0 < K; k0 += 32) {
#pragma unroll
            for (int i = 0; i < 4; ++i) {
                const int idx = tid + i * 512, r = idx >> 5, kk = idx & 31, m = m0 + r;
                As[r * 33 + kk] = (m < M) ? bf2f(arow(m)[k0 + kk]) : 0.f;
            }
#pragma unroll
            for (int i = 0; i < 4; ++i) {
                const int idx = tid + i * 512, kk = idx >> 6, n = idx & 63;
                const bool ok = (n0 + n) < N;
                Bs[kk * 64 + n] = ok ? W[(size_t)(k0 + kk) * ldw + n0 + n] : 0.f;
                if (DUAL) Bs2[kk * 64 + n] = ok ? W2[(size_t)(k0 + kk) * ldw + n0 + n] : 0.f;
            }
            __syncthreads();
#pragma unroll 8
            for (int kk = 0; kk < 32; ++kk) {
                const float a0 = As[(ty * 2) * 33 + kk], a1 = As[(ty * 2 + 1) * 33 + kk];
#pragma unroll
                for (int j = 0; j < 4; ++j) {
                    const float b = Bs[kk * 64 + tx * 4 + j];
                    acc[0][j] += a0 * b; acc[1][j] += a1 * b;
                    if (DUAL) { const float b2 = Bs2[kk * 64 + tx * 4 + j]; acc2[0][j] += a0 * b2; acc2[1][j] += a1 * b2; }
                }
            }
            __syncthreads();
        }
#pragma unroll
        for (int i = 0; i < 2; ++i)
#pragma unroll
            for (int j = 0; j < 4; ++j) {
                const int m = m0 + ty * 2 + i, n = n0 + tx * 4 + j;
                if (m < M && n < N) epi(m, n, acc[i][j], acc2[i][j]);
            }
    }
}

template <class SRC, class DROW>
__device__ __forceinline__ void xpose_item(SRC src, DROW drow, bf16_t* WT, int ldk, LAS float* scr, int k0, int n0, int lane) {
#pragma unroll 8
    for (int i = 0; i < 32; ++i) { const int kk = 2 * i + (lane >> 5); scr[kk * 33 + (lane & 31)] = src(k0 + kk, n0 + (lane & 31)); }
    asm volatile("s_waitcnt lgkmcnt(0)" ::: "memory");
    const int c = lane & 7;
#pragma unroll
    for (int j = 0; j < 4; ++j) {
        const int n = (lane >> 3) + 8 * j; const LAS float* sp = scr + (8 * c) * 33 + n;
        u32x4 o; o.x = pk2(sp[0 * 33], sp[1 * 33]); o.y = pk2(sp[2 * 33], sp[3 * 33]); o.z = pk2(sp[4 * 33], sp[5 * 33]); o.w = pk2(sp[6 * 33], sp[7 * 33]);
        *(u32x4*)(WT + (size_t)drow(n0 + n) * ldk + k0 + 8 * c) = o;
    }
    asm volatile("s_waitcnt lgkmcnt(0)" ::: "memory");
}
__device__ __forceinline__ void convert_plain(const float* W, int K, int N, int NP, bf16_t* WT, LAS float* scr, int gw, int ngw, int lane) {
    const int nblk = NP / 32, nitems = (K / 64) * nblk;
    for (int it = gw; it < nitems; it += ngw) {
        const int k0 = 64 * (it / nblk), n0 = 32 * (it % nblk);
        xpose_item([&](int k, int n) { return n < N ? W[(size_t)k * N + n] : 0.f; }, [&](int n) { return n; }, WT, K, scr, k0, n0, lane);
    }
}
__device__ __forceinline__ void convert_lora(const float* w2, const float* a2, const float* g2, bf16_t* WT, LAS float* scr, int gw, int ngw, int lane) {
    const int nblk = NLORA / 32, nitems = 4 * nblk;
    for (int it = gw; it < nitems; it += ngw) {
        const int k0 = 64 * (it / nblk), n0 = 32 * (it % nblk);
        xpose_item([&](int k, int n) {
            if (n < 512) return k < 64 ? w2[k * 512 + n] : 0.f;
            if (n < 1024) return (k >= 64 && k < 128) ? a2[(k - 64) * 512 + (n - 512)] : 0.f;
            return k >= 128 ? g2[(k - 128) * 512 + (n - 1024)] : 0.f; }, [&](int n) { return n; }, WT, 256, scr, k0, n0, lane);
    }
}
__device__ __forceinline__ void convert_moe(const float* w1, const float* w3, const float* w2, bf16_t* W13, bf16_t* W2T, LAS float* scr, int gw, int ngw, int lane) {
    constexpr int I13 = 16 * 32, I2 = 8 * 32, IE = I13 + I2;
    for (int it = gw; it < 32 * IE; it += ngw) {
        const int e = it / IE, r = it % IE;
        if (r < I13) {
            const int k0 = 64 * (r / 32), n0 = 32 * (r % 32);
            const float* a = w1 + (size_t)e * D_ * 512; const float* b = w3 + (size_t)e * D_ * 512;
            xpose_item([&](int k, int n) { return n < 512 ? a[(size_t)k * 512 + n] : b[(size_t)k * 512 + (n - 512)]; },
                       [&](int n) { const int c = n & 511; return (c >> 2) * 8 + (n >> 9) * 4 + (c & 3); }, W13 + (size_t)e * 1024 * 1024, 1024, scr, k0, n0, lane);
        } else {
            const int rr = r - I13, k0 = 64 * (rr / 32), n0 = 32 * (rr % 32);
            const float* a = w2 + (size_t)e * 512 * D_;
            xpose_item([&](int k, int n) { return a[(size_t)k * D_ + n]; }, [&](int n) { return n; }, W2T + (size_t)e * 1024 * 512, 512, scr, k0, n0, lane);
        }
    }
}

__device__ __forceinline__ void ph_prologue(const float* x, bf16_t* hb) {
    const size_t n4 = (size_t)T_ * D_ / 4;
    for (size_t i = (size_t)blockIdx.x * NTHREADS + TIDX; i < n4; i += (size_t)gridDim.x * NTHREADS) {
        const f32x4 v = ((const f32x4*)x)[i];
        u32x2 o; o.x = pk2(v.x, v.y); o.y = pk2(v.z, v.w);
        ((u32x2*)hb)[i] = o;
    }
    for (size_t i = (size_t)blockIdx.x * NTHREADS + TIDX; i < (size_t)256 * D_ / 2; i += (size_t)gridDim.x * NTHREADS)
        ((unsigned*)(hb + (size_t)T_ * D_))[i] = 0u;
}

__device__ __forceinline__ float p0_shift(const bf16_t* P, const float* mu, int t, int c) {
    const float p = bf2f(P[(size_t)t * NIN0P + c]);
    const float pv = ((t & (L_ - 1)) == 0) ? 0.f : bf2f(P[(size_t)(t - 1) * NIN0P + c]);
    return p + mu[c] * (pv - p);
}
template <bool WITH_GLA>
__device__ __forceinline__ void ph_prepA0(const bf16_t* P, const float* mu, const float* gk_w2, const float* gk_b, bf16_t* Ap, float* gla_la) {
    for (int chunk = blockIdx.x; chunk < T_ / 64; chunk += gridDim.x) {
        for (int idx = TIDX; idx < 64 * 256; idx += NTHREADS) {
            const int tl = idx >> 8, j = idx & 255, t = chunk * 64 + tl;
            float v;
            if (j < 64) v = tanhf(p0_shift(P, mu, t, 512 + j));
            else if (j < 128) v = p0_shift(P, mu, t, 1600 + (j - 64));
            else v = sigm(p0_shift(P, mu, t, 1664 + (j - 128)));
            Ap[(size_t)t * 256 + j] = f2bf(v);
            if (WITH_GLA) {
                float gk = gk_b[j];
#pragma unroll
                for (int i = 0; i < 16; ++i) gk += bf2f(P[(size_t)t * NIN0P + 2816 + i]) * gk_w2[i * 256 + j];
                const float ls = fminf(gk, 0.f) - log1pf(__expf(-fabsf(gk)));
                gla_la[(size_t)t * 256 + j] = ls * (1.f / 16.f);
            }
        }
    }
}

__device__ __forceinline__ void ph_prepB0(const bf16_t* P, const bf16_t* LO, const float* mu, const float* w0, const float* a0, const float* k_k, const float* k_a,
                                          const float* r_k, bf16_t* SC, float* BON) {
    const int wave = TIDX >> 6, lane = TIDX & 63;
    for (int item = blockIdx.x * NWAVES + wave; item < T_ * 8; item += gridDim.x * NWAVES) {
        const int t = item >> 3, h = item & 7, c = h * 64 + lane;
        const float r = p0_shift(P, mu, t, c), k = p0_shift(P, mu, t, 576 + c), v = p0_shift(P, mu, t, 1088 + c);
        const float low = bf2f(LO[(size_t)t * 512 + c]), loa = bf2f(LO[(size_t)T_ * 512 + (size_t)t * 512 + c]);
        const float xw = w0[c] + low;
        const float wraw = -softplusf(-xw) - 0.5f;
        const float ld = -__expf(wraw);
        const float a = sigm(a0[c] + loa);
        const float kkr = k * k_k[c];
        const float ss = wave_sum(kkr * kkr);
        const float kk = kkr / fmaxf(sqrtf(ss), 1e-12f);
        const float kp = k * (1.f + (a - 1.f) * k_a[c]);
        const float bon = wave_sum(r * kp * r_k[c]);
        const size_t o = (size_t)t * 512 + c, S1 = (size_t)T_ * 512;
        SC[o] = f2bf(r); SC[S1 + o] = f2bf(ld); SC[2 * S1 + o] = f2bf(kp); SC[3 * S1 + o] = f2bf(v); SC[4 * S1 + o] = f2bf(kk); SC[5 * S1 + o] = f2bf(a);
        if (lane == 0) BON[(size_t)t * 8 + h] = bon;
    }
}

__device__ __forceinline__ void naive_rwkv_scan(LAS float* lds, const bf16_t* SC, float* YRW, int bh) {
    constexpr int TS = 32;
    const int b = bh >> 3, h = bh & 7;
    LAS float* Lnkk = lds;
    LAS float* Ldec = lds + TS * 64;
    LAS float* Lab = lds + 2 * TS * 64;
    LAS float* Lkp = lds + 3 * TS * 64;
    LAS float* Lr = lds + 4 * TS * 64;
    LAS float* Lv = lds + 5 * TS * 64;
    const size_t S1 = (size_t)T_ * 512;
    float S[64];
#pragma unroll
    for (int k = 0; k < 64; ++k) S[k] = 0.f;
    const int lane = TIDX & 63, wave = TIDX >> 6;
    for (int t0 = 0; t0 < L_; t0 += TS) {
        for (int idx = TIDX; idx < TS * 64; idx += NTHREADS) {
            const int s = idx >> 6, k = idx & 63;
            const size_t o = (size_t)(b * L_ + t0 + s) * 512 + h * 64 + k;
            const float r = bf2f(SC[o]), ld = bf2f(SC[S1 + o]), kp = bf2f(SC[2 * S1 + o]), v = bf2f(SC[3 * S1 + o]), kk = bf2f(SC[4 * S1 + o]), a = bf2f(SC[5 * S1 + o]);
            Lnkk[idx] = -kk; Ldec[idx] = __expf(ld); Lab[idx] = kk * a; Lkp[idx] = kp; Lr[idx] = r; Lv[idx] = v;
        }
        __syncthreads();
        if (wave == 0) {
            for (int s = 0; s < TS; ++s) {
                float sa = 0.f;
#pragma unroll
                for (int k = 0; k < 64; ++k) sa += S[k] * Lnkk[s * 64 + k];
                const float vv = Lv[s * 64 + lane];
                float y = 0.f;
#pragma unroll
                for (int k = 0; k < 64; ++k) {
                    S[k] = S[k] * Ldec[s * 64 + k] + sa * Lab[s * 64 + k] + vv * Lkp[s * 64 + k];
                    y += S[k] * Lr[s * 64 + k];
                }
                YRW[(size_t)(b * L_ + t0 + s) * 512 + h * 64 + lane] = y;
            }
        }
        __syncthreads();
    }
}

template <int K, class LDF, class LVF>
__device__ __forceinline__ void naive_gla_scan(LAS float* lds, LDF ld, LVF lv, float* OG, int b, int h) {
    constexpr int TS = 16;
    LAS float* Lq = lds;
    LAS float* Lk = lds + TS * K;
    LAS float* Le = lds + 2 * TS * K;
    LAS float* Lv = lds + 3 * TS * K;
    float S[K];
#pragma unroll
    for (int k = 0; k < K; ++k) S[k] = 0.f;
    const int tid = TIDX;
    for (int t0 = 0; t0 < L_; t0 += TS) {
        for (int idx = tid; idx < TS * K; idx += NTHREADS) {
            const int s = idx / K, k = idx % K;
            float q, kk, e; ld(b * L_ + t0 + s, h * K + k, q, kk, e);
            Lq[idx] = q; Lk[idx] = kk; Le[idx] = e;
        }
        for (int idx = tid; idx < TS * 128; idx += NTHREADS) {
            const int s = idx >> 7, vc = idx & 127;
            Lv[idx] = lv(b * L_ + t0 + s, h * 128 + vc);
        }
        __syncthreads();
        if (tid < 128) {
            for (int s = 0; s < TS; ++s) {
                const float vv = Lv[s * 128 + tid];
                float o = 0.f;
#pragma unroll
                for (int k = 0; k < K; ++k) {
                    S[k] = S[k] * Le[s * K + k] + Lk[s * K + k] * vv;
                    o += Lq[s * K + k] * S[k];
                }
                OG[(size_t)(b * L_ + t0 + s) * 512 + h * 128 + tid] = o;
            }
        }
        __syncthreads();
    }
}

template <bool WITH_GLA>
__device__ __forceinline__ void ph_fin0(const float* YRW, const float* OG, const bf16_t* P, const bf16_t* LO, const bf16_t* SC, const float* BON,
                                        const float* gn_g, const float* gn_b, const float* norm_g, bf16_t* Ymix) {
    const int wave = TIDX >> 6, lane = TIDX & 63;
    const size_t S1 = (size_t)T_ * 512;
    constexpr int NU = WITH_GLA ? 12 : 8;
    for (int item = blockIdx.x * NWAVES + wave; item < T_ * NU; item += gridDim.x * NWAVES) {
        const int t = item / NU, u = item % NU;
        if (u < 8) {
            const int c = u * 64 + lane;
            const float y = YRW[(size_t)t * 512 + c];
            const float mean = wave_sum(y) * (1.f / 64.f);
            const float d = y - mean;
            const float var = wave_sum(d * d) * (1.f / 64.f);
            const float yn = d * rsqrtf(var + 64e-5f) * gn_g[c] + gn_b[c];
            const float v = bf2f(SC[3 * S1 + (size_t)t * 512 + c]);
            const float g = bf2f(LO[(size_t)2 * T_ * 512 + (size_t)t * 512 + c]);
            Ymix[(size_t)t * D_ + c] = f2bf((yn + BON[(size_t)t * 8 + u] * v) * g);
        } else {
            const int h = u - 8;
            const float o0 = OG[(size_t)t * 512 + h * 128 + lane], o1 = OG[(size_t)t * 512 + h * 128 + 64 + lane];
            const float ms = wave_sum(o0 * o0 + o1 * o1) * (1.f / 128.f);
            const float rs = rsqrtf(ms + LN_EPS);
            const float g0 = bf2f(P[(size_t)t * NIN0P + 2832 + h * 128 + lane]), g1 = bf2f(P[(size_t)t * NIN0P + 2832 + h * 128 + 64 + lane]);
            Ymix[(size_t)t * D_ + 512 + h * 128 + lane] = f2bf(o0 * rs * norm_g[lane] * siluf(g0));
            Ymix[(size_t)t * D_ + 512 + h * 128 + 64 + lane] = f2bf(o1 * rs * norm_g[64 + lane] * siluf(g1));
        }
    }
}

__device__ __forceinline__ void ph_ln_router(const float* src, float* hf, bf16_t* hb, const float* lg, const float* lb, const float* wg, const float* bg,
                                             const float* we, const float* be, int* tok_e, int* tok_slot, float* tok_g, unsigned* cnt) {
    const int wave = TIDX >> 6, lane = TIDX & 63;
    for (int t = blockIdx.x * NWAVES + wave; t < T_; t += gridDim.x * NWAVES) {
        const f32x4* xr = (const f32x4*)(src + (size_t)t * D_) + lane;
        f32x4 v[4]; float s = 0.f;
#pragma unroll
        for (int j = 0; j < 4; ++j) { v[j] = xr[64 * j]; s += (v[j].x + v[j].y) + (v[j].z + v[j].w); }
        const float mean = wave_sum(s) * (1.f / D_);
        float s2 = 0.f;
#pragma unroll
        for (int j = 0; j < 4; ++j) { v[j] = v[j] - mean; s2 += (v[j].x * v[j].x + v[j].y * v[j].y) + (v[j].z * v[j].z + v[j].w * v[j].w); }
        const float rstd = rsqrtf(wave_sum(s2) * (1.f / D_) + LN_EPS);
#pragma unroll
        for (int j = 0; j < 4; ++j) {
            const f32x4 g = ((const f32x4*)lg)[lane + 64 * j], bb = ((const f32x4*)lb)[lane + 64 * j];
            v[j] = v[j] * rstd * g + bb;
            ((f32x4*)(hf + (size_t)t * D_))[lane + 64 * j] = v[j];
            u32x2 o; o.x = pk2(v[j].x, v[j].y); o.y = pk2(v[j].z, v[j].w);
            ((u32x2*)(hb + (size_t)t * D_))[lane + 64 * j] = o;
        }
        float cl[4] = {0.f, 0.f, 0.f, 0.f};
#pragma unroll
        for (int j = 0; j < 4; ++j)
#pragma unroll
            for (int e = 0; e < 4; ++e) {
                const int d = 4 * (lane + 64 * j) + e;
                const f32x4 w = *(const f32x4*)(wg + (size_t)d * 4);
                const float xv = v[j][e];
                cl[0] += xv * w.x; cl[1] += xv * w.y; cl[2] += xv * w.z; cl[3] += xv * w.w;
            }
#pragma unroll
        for (int g = 0; g < 4; ++g) cl[g] = wave_sum(cl[g]) + bg[g];
        int grp = 0; float mx = cl[0];
#pragma unroll
        for (int g = 1; g < 4; ++g) if (cl[g] > mx) { mx = cl[g]; grp = g; }
        float den = 0.f;
#pragma unroll
        for (int g = 0; g < 4; ++g) den += __expf(cl[g] - mx);
        const float p_grp = 1.f / den;
        float fl[8];
#pragma unroll
        for (int e = 0; e < 8; ++e) fl[e] = 0.f;
        const float* weg = we + (size_t)grp * D_ * 8;
#pragma unroll
        for (int j = 0; j < 4; ++j)
#pragma unroll
            for (int e = 0; e < 4; ++e) {
                const int d = 4 * (lane + 64 * j) + e;
                const f32x4 w0 = *(const f32x4*)(weg + (size_t)d * 8), w1 = *(const f32x4*)(weg + (size_t)d * 8 + 4);
                const float xv = v[j][e];
                fl[0] += xv * w0.x; fl[1] += xv * w0.y; fl[2] += xv * w0.z; fl[3] += xv * w0.w;
                fl[4] += xv * w1.x; fl[5] += xv * w1.y; fl[6] += xv * w1.z; fl[7] += xv * w1.w;
            }
#pragma unroll
        for (int e = 0; e < 8; ++e) fl[e] = wave_sum(fl[e]) + be[grp * 8 + e];
        int j0 = 0; float m0 = fl[0];
#pragma unroll
        for (int e = 1; e < 8; ++e) if (fl[e] > m0) { m0 = fl[e]; j0 = e; }
        int j1 = -1; float m1 = -3.0e38f;
#pragma unroll
        for (int e = 0; e < 8; ++e) if (e != j0 && fl[e] > m1) { m1 = fl[e]; j1 = e; }
        const float e1 = __expf(m1 - m0);
        const float g0 = p_grp / (1.f + e1), g1 = p_grp * e1 / (1.f + e1);
        if (lane == 0) {
            const int ex0 = grp * 8 + j0, ex1 = grp * 8 + j1;
            const unsigned s0 = atomicAdd(&cnt[ex0], 1u), s1 = atomicAdd(&cnt[ex1], 1u);
            tok_e[2 * t] = ex0; tok_e[2 * t + 1] = ex1;
            tok_slot[2 * t] = (int)s0; tok_slot[2 * t + 1] = (int)s1;
            tok_g[2 * t] = g0; tok_g[2 * t + 1] = g1;
        }
    }
}

__device__ __forceinline__ void moe_offsets(LAS int* pst, const unsigned* cnt) {
    if (TIDX == 0) {
        int acc = 0;
        for (int e = 0; e < 32; ++e) { pst[e] = acc; const int c = (int)cnt[e]; acc += (c + MOE_PAD - 1) / MOE_PAD * MOE_PAD; }
        pst[32] = acc;
    }
    __syncthreads();
}
__device__ __forceinline__ int moe_expert_of_row(const LAS int* pst, int r) {
    int e = 0;
#pragma unroll 1
    for (int i = 1; i < 32; ++i) if (r >= pst[i]) e = i;
    return e;
}

__device__ __forceinline__ void ph_dispatch(LAS int* pst, const unsigned* cnt, const bf16_t* hb, const int* tok_e, const int* tok_slot, int* tok_dest, bf16_t* XR) {
    moe_offsets(pst, cnt);
    const int wave = TIDX >> 6, lane = TIDX & 63;
    for (int item = blockIdx.x * NWAVES + wave; item < T_ * 2; item += gridDim.x * NWAVES) {
        const int t = item >> 1;
        const int e = tok_e[item], dest = pst[e] + tok_slot[item];
        if (lane == 0) tok_dest[item] = dest;
        const u32x4* src = (const u32x4*)(hb + (size_t)t * D_);
        u32x4* dst = (u32x4*)(XR + (size_t)dest * D_);
        dst[lane] = src[lane]; dst[lane + 64] = src[lane + 64];
    }
    const int R = pst[32];
    for (int r = blockIdx.x * NWAVES + wave; r < R; r += gridDim.x * NWAVES) {
        const int e = moe_expert_of_row(pst, r);
        if (r - pst[e] >= (int)cnt[e]) {
            u32x4* dst = (u32x4*)(XR + (size_t)r * D_);
            const u32x4 z = {0u, 0u, 0u, 0u};
            dst[lane] = z; dst[lane + 64] = z;
        }
    }
}

__device__ __forceinline__ void ph_combine_ln(const float* hf, const bf16_t* Y, const int* tok_dest, const float* tok_g, const float* lg, const float* lb, float* outf, bf16_t* hb) {
    const int wave = TIDX >> 6, lane = TIDX & 63;
    for (int t = blockIdx.x * NWAVES + wave; t < T_; t += gridDim.x * NWAVES) {
        const int d0 = tok_dest[2 * t], d1 = tok_dest[2 * t + 1];
        const float g0 = tok_g[2 * t], g1 = tok_g[2 * t + 1];
        f32x4 v[4]; float s = 0.f;
#pragma unroll
        for (int j = 0; j < 4; ++j) {
            const f32x4 h = ((const f32x4*)(hf + (size_t)t * D_))[lane + 64 * j];
            const u32x2 y0 = ((const u32x2*)(Y + (size_t)d0 * D_))[lane + 64 * j], y1 = ((const u32x2*)(Y + (size_t)d1 * D_))[lane + 64 * j];
            f32x4 a, b;
            a.x = __uint_as_float(y0.x << 16); a.y = __uint_as_float(y0.x & 0xffff0000u); a.z = __uint_as_float(y0.y << 16); a.w = __uint_as_float(y0.y & 0xffff0000u);
            b.x = __uint_as_float(y1.x << 16); b.y = __uint_as_float(y1.x & 0xffff0000u); b.z = __uint_as_float(y1.y << 16); b.w = __uint_as_float(y1.y & 0xffff0000u);
            v[j] = h * DN_ALPHA + (a * g0 + b * g1);
            s += (v[j].x + v[j].y) + (v[j].z + v[j].w);
        }
        const float mean = wave_sum(s) * (1.f / D_);
        float s2 = 0.f;
#pragma unroll
        for (int j = 0; j < 4; ++j) { v[j] = v[j] - mean; s2 += (v[j].x * v[j].x + v[j].y * v[j].y) + (v[j].z * v[j].z + v[j].w * v[j].w); }
        const float rstd = rsqrtf(wave_sum(s2) * (1.f / D_) + LN_EPS);
#pragma unroll
        for (int j = 0; j < 4; ++j) {
            const f32x4 g = ((const f32x4*)lg)[lane + 64 * j], bb = ((const f32x4*)lb)[lane + 64 * j];
            v[j] = v[j] * rstd * g + bb;
            ((f32x4*)(outf + (size_t)t * D_))[lane + 64 * j] = v[j];
            u32x2 o; o.x = pk2(v[j].x, v[j].y); o.y = pk2(v[j].z, v[j].w);
            ((u32x2*)(hb + (size_t)t * D_))[lane + 64 * j] = o;
        }
    }
}

__device__ __forceinline__ void naive_s5_scan(const bf16_t* P1, const float* a_re, const float* a_im, const float* log_dt, const float* b_re, const float* b_im,
                                              const float* c_re, const float* c_im, const float* dvec, float* YS5, bf16_t* YS5B, int pair) {
    const int lane = TIDX & 63;
    const int b = pair >> 5, g = pair & 31, n = lane;
    const float lam_re = fminf(a_re[g * 64 + n], -1e-4f), lam_im = a_im[g * 64 + n];
    const float dt = __expf(log_dt[g]);
    const float mag = __expf(lam_re * dt);
    const float ab_re = mag * cosf(lam_im * dt), ab_im = mag * sinf(lam_im * dt);
    const float den = lam_re * lam_re + lam_im * lam_im;
    const float num_re = ab_re - 1.f;
    const float z_re = (num_re * lam_re + ab_im * lam_im) / den;
    const float z_im = (ab_im * lam_re - num_re * lam_im) / den;
    float bre[16], bim[16], cre[16], cim[16];
#pragma unroll
    for (int c = 0; c < 16; ++c) {
        bre[c] = b_re[(size_t)(g * 64 + n) * 16 + c]; bim[c] = b_im[(size_t)(g * 64 + n) * 16 + c];
        cre[c] = c_re[(size_t)(g * 16 + c) * 64 + n]; cim[c] = c_im[(size_t)(g * 16 + c) * 64 + n];
    }
    const float dd = (lane < 16) ? dvec[g * 16 + lane] : 0.f;
    float h_re = 0.f, h_im = 0.f;
    for (int tt = 0; tt < L_; ++tt) {
        const size_t t = (size_t)b * L_ + tt;
        const float ul = (lane < 16) ? bf2f(P1[t * NIN1 + g * 16 + lane]) : 0.f;
        float bur = 0.f, bui = 0.f;
#pragma unroll
        for (int c = 0; c < 16; ++c) { const float u = __shfl(ul, c); bur += u * bre[c]; bui += u * bim[c]; }
        const float x_re = z_re * bur - z_im * bui, x_im = z_re * bui + z_im * bur;
        const float nh_re = ab_re * h_re - ab_im * h_im + x_re;
        const float nh_im = ab_re * h_im + ab_im * h_re + x_im;
        h_re = nh_re; h_im = nh_im;
        float yv = 0.f;
#pragma unroll
        for (int c = 0; c < 16; ++c) { const float y = wave_sum(h_re * cre[c] - h_im * cim[c]); if (lane == c) yv = y; }
        if (lane < 16) {
            const float y = gelu_tanh(yv + dd * ul);
            YS5[t * 512 + g * 16 + lane] = y;
            YS5B[t * 512 + g * 16 + lane] = f2bf(y);
        }
    }
}

__device__ __forceinline__ void ph_fin1(const float* OG, const bf16_t* P1, const float* norm_g, bf16_t* Ymix) {
    const int wave = TIDX >> 6, lane = TIDX & 63;
    for (int item = blockIdx.x * NWAVES + wave; item < T_ * 4; item += gridDim.x * NWAVES) {
        const int t = item >> 2, h = item & 3;
        const float o0 = OG[(size_t)t * 512 + h * 128 + lane], o1 = OG[(size_t)t * 512 + h * 128 + 64 + lane];
        const float ms = wave_sum(o0 * o0 + o1 * o1) * (1.f / 128.f);
        const float rs = rsqrtf(ms + LN_EPS);
        const float g0 = bf2f(P1[(size_t)t * NIN1 + 2048 + h * 128 + lane]), g1 = bf2f(P1[(size_t)t * NIN1 + 2048 + h * 128 + 64 + lane]);
        Ymix[(size_t)t * D_ + 512 + h * 128 + lane] = f2bf(o0 * rs * norm_g[lane] * siluf(g0));
        Ymix[(size_t)t * D_ + 512 + h * 128 + 64 + lane] = f2bf(o1 * rs * norm_g[64 + lane] * siluf(g1));
    }
}

constexpr int LDS_BYTES = 147456;
constexpr int MISC_OFF = 131072 + 8192;
enum Phase {
    PH_PROLOGUE = 0,
    PH_INPROJ0, PH_PREPA0, PH_LORA0, PH_PREPB0, PH_SCAN0, PH_FIN0, PH_OUTPROJ0, PH_LN1_0, PH_DISP0, PH_UP0, PH_DOWN0, PH_COMB0,
    PH_INPROJ1, PH_L1A, PH_L1B, PH_L1C, PH_L1D, PH_SCAN1, PH_FIN1, PH_GLU1, PH_OUTPROJ1, PH_LN1_1, PH_DISP1, PH_UP1, PH_DOWN1, PH_COMB1,
    PH_COUNT
};

typedef const Args __attribute__((address_space(4)))* KArgsP;
__device__ __forceinline__ KArgsP fresh_args() { KArgsP p = (KArgsP)__builtin_amdgcn_kernarg_segment_ptr(); asm volatile("" : "+s"(p)); return p; }
#define PHASE_BEGIN KArgsP ap = fresh_args(); unsigned char* const ws = ap->ws; (void)ws;
#define INP(i) (ap->in[i])
#define W_CTL ((unsigned*)(ws + WS_CTL))
#define W_HB ((bf16_t*)(ws + WS_HB))
#define W_WIN0 ((bf16_t*)(ws + WS_WIN0))
#define W_WOUT0 ((bf16_t*)(ws + WS_WOUT0))
#define W_WIN1 ((bf16_t*)(ws + WS_WIN1))
#define W_WOUT1 ((bf16_t*)(ws + WS_WOUT1))
#define W_WGLU ((bf16_t*)(ws + WS_WGLU))
#define W_WLORA ((bf16_t*)(ws + WS_WLORA))
#define W_W13 ((bf16_t*)(ws + WS_W13))
#define W_W2 ((bf16_t*)(ws + WS_W2))
#define W_HA ((float*)(ws + WS_HA))
#define W_YRW W_HA
#define W_OG (W_HA + (size_t)T_ * 512)
#define W_P ((bf16_t*)(ws + WS_P))
#define W_LO ((bf16_t*)(ws + WS_LO))
#define W_SC ((bf16_t*)(ws + WS_SCAN))
#define W_GLALA ((float*)(ws + WS_GLALA))
#define W_BON ((float*)(ws + WS_BON))
#define W_AP ((bf16_t*)(ws + WS_APRIME))
#define W_YS5B ((bf16_t*)(ws + WS_YS5B))
#define W_XR ((bf16_t*)(ws + WS_XR))
#define W_HID ((bf16_t*)(ws + WS_HID))
#define W_Y ((bf16_t*)(ws + WS_Y))
#define W_TOKE ((int*)(ws + WS_ROUTE))
#define W_TOKSLOT (W_TOKE + 2 * T_)
#define W_TOKDEST (W_TOKE + 4 * T_)
#define W_TOKG ((float*)(W_TOKE + 6 * T_))
#define W_YMIX W_HB
#define BIGP(mib) (ws + WS_BIG + (size_t)(mib) * MiB)
#define GLA0_BUFS GlaBufs{(bf16_t*)BIGP(256), (bf16_t*)BIGP(264), (bf16_t*)(ws + WS_HB), (bf16_t*)BIGP(273), (float*)BIGP(289), W_HA + (size_t)T_ * 512, (bf16_t*)BIGP(112)}
#define HG_BUFS GlaBufs{(bf16_t*)BIGP(96), (bf16_t*)BIGP(112), (bf16_t*)BIGP(144), (bf16_t*)BIGP(128), (float*)BIGP(176), (float*)BIGP(177), (bf16_t*)BIGP(144)}
#define W_S5WE ((bf16_t*)BIGP(160))
#define W_S5UA ((bf16_t*)BIGP(241))
#define W_S5MB ((bf16_t*)BIGP(261))
#define W_S5E ((float*)BIGP(281))
#define CW_SUB 12288

#define IN(k) (PLO <= (k) && (k) < PHI)
#define SEAM(k) do { if (IN(k) && IN((k) + 1)) { PHASE_BEGIN XcdBarrier bar_; bar_.bar = W_CTL + CW_BAR; bar_.x = xb_xcc_id(); bar_.st = (volatile LAS unsigned*)(lds + MISC_OFF) + 8; xcd_barrier(bar_); } } while (0)
template <int PLO, int PHI, int layer>
__device__ __forceinline__ void moe_layer(LAS unsigned char* lds) {
    LAS float* ldsf = (LAS float*)lds; (void)ldsf;
        const int base = layer == 0 ? PH_OUTPROJ0 : PH_OUTPROJ1;
        if (IN(base + 0)) {
            PHASE_BEGIN
            const float* W = layer == 0 ? INP(16) : INP(30);
            float* V1 = layer == 0 ? ap->out : W_HA;
            const float* resid = layer == 0 ? INP(0) : ap->out;
#if FAST_GEMM
            (void)W;
            { pg8::Gemm g{W_YMIX, layer == 0 ? W_WOUT0 : W_WOUT1, T_, D_, D_}; pg8::StaticOrder S; S.init(T_, D_, (int)gridDim.x, (int)blockIdx.x); pg8::EpiResidF32 E{resid, V1, D_, DN_ALPHA};
              pg8::gemm_phase<pg8::EpiResidF32, pg8::StaticOrder, true, true>(lds, g, S, E); }
#else
            const bf16_t* Ymix = W_YMIX;
            naive_gemm<false>(ldsf, T_, D_, D_, [&](int m) { return Ymix + (size_t)m * D_; }, [&](int, int) { return W; }, D_,
                              [&](int m, int n, float a, float) { V1[(size_t)m * D_ + n] = DN_ALPHA * resid[(size_t)m * D_ + n] + a; });
#endif
        }
        SEAM(base + 0);
        if (IN(base + 1)) {
            PHASE_BEGIN
            const float* V1 = layer == 0 ? ap->out : W_HA;
            ph_ln_router(V1, W_HA, W_HB, INP(31) + layer * D_, INP(32) + layer * D_, INP(33) + (size_t)layer * D_ * 4, INP(34) + layer * 4,
                         INP(35) + (size_t)layer * 4 * D_ * 8, INP(36) + layer * 32, W_TOKE, W_TOKSLOT, W_TOKG, W_CTL + CW_CNT + 64 * layer);
        }
        SEAM(base + 1);
        if (IN(base + 2)) { PHASE_BEGIN ph_dispatch((LAS int*)lds, W_CTL + CW_CNT + 64 * layer, W_HB, W_TOKE, W_TOKSLOT, W_TOKDEST, W_XR); }
        SEAM(base + 2);
        if (IN(base + 3)) {
            PHASE_BEGIN
#if FAST_GEMM
            { LAS int* pst = (LAS int*)(lds + 131072 + 2048); LAS int* tile_e = (LAS int*)(lds + 131072 + 1024);
              moe_offsets(pst, W_CTL + CW_CNT + 64 * layer);
              const int ntiles = pst[32] / 256;
              if ((int)TIDX < ntiles) tile_e[TIDX] = moe_expert_of_row(pst, TIDX * 256);
              __syncthreads();
              pg8::Gemm g{W_XR, W_W13, ntiles * 256, 1024, D_}; pg8::MoeOrder S{ntiles, 4, (int)gridDim.x, (int)blockIdx.x, tile_e}; pg8::EpiSwiglu E{W_HID};
              pg8::gemm_phase<pg8::EpiSwiglu, pg8::MoeOrder, true, true>(lds, g, S, E); }
#else
            LAS int* pst = (LAS int*)(lds + 65536);
            moe_offsets(pst, W_CTL + CW_CNT + 64 * layer);
            const float* w1 = INP(37) + (size_t)layer * 32 * D_ * 512; const float* w3 = INP(38) + (size_t)layer * 32 * D_ * 512;
            const bf16_t* XR = W_XR; bf16_t* HID = W_HID;
            naive_gemm<true>(ldsf, pst[32], 512, D_, [&](int m) { return XR + (size_t)m * D_; },
                             [&](int m0, int which) { const int e = moe_expert_of_row(pst, m0); return (which ? w3 : w1) + (size_t)e * D_ * 512; }, 512,
                             [&](int m, int n, float a, float b) { HID[(size_t)m * 512 + n] = f2bf(siluf(a) * b); });
#endif
        }
        SEAM(base + 3);
        if (IN(base + 4)) {
            PHASE_BEGIN
#if FAST_GEMM
            { LAS int* pst = (LAS int*)(lds + 131072 + 2048); LAS int* tile_e = (LAS int*)(lds + 131072 + 1024);
              moe_offsets(pst, W_CTL + CW_CNT + 64 * layer);
              const int ntiles = pst[32] / 256;
              if ((int)TIDX < ntiles) tile_e[TIDX] = moe_expert_of_row(pst, TIDX * 256);
              __syncthreads();
              pg8::Gemm g{W_HID, W_W2, ntiles * 256, 1024, 512}; pg8::MoeOrder S{ntiles, 4, (int)gridDim.x, (int)blockIdx.x, tile_e}; pg8::EpiStoreBf16 E{W_Y, D_, 0, 0};
              pg8::gemm_phase<pg8::EpiStoreBf16, pg8::MoeOrder, true, true>(lds, g, S, E); }
#else
            LAS int* pst = (LAS int*)(lds + 65536);
            moe_offsets(pst, W_CTL + CW_CNT + 64 * layer);
            const float* w2 = INP(39) + (size_t)layer * 32 * 512 * D_;
            const bf16_t* HID = W_HID; bf16_t* Y = W_Y;
            naive_gemm<false>(ldsf, pst[32], D_, 512, [&](int m) { return HID + (size_t)m * 512; },
                              [&](int m0, int) { const int e = moe_expert_of_row(pst, m0); return w2 + (size_t)e * 512 * D_; }, D_,
                              [&](int m, int n, float a, float) { Y[(size_t)m * D_ + n] = f2bf(a); });
#endif
        }
        SEAM(base + 4);
        if (IN(base + 5)) { PHASE_BEGIN ph_combine_ln(W_HA, W_Y, W_TOKDEST, W_TOKG, INP(40) + layer * D_, INP(41) + layer * D_, ap->out, W_HB); }
        SEAM(base + 5);

}

template <int PLO, int PHI>
__device__ __forceinline__ void mega_body(unsigned char* lds_raw) {
    LAS unsigned char* lds = (LAS unsigned char*)lds_raw;
    LAS float* ldsf = (LAS float*)lds;
    constexpr bool MULTI = (PHI - PLO) > 1;
    if (MULTI) {
        PHASE_BEGIN
        volatile LAS unsigned* MISC = (volatile LAS unsigned*)(lds + MISC_OFF);
        if (TIDX < 32) MISC[TIDX] = 0u;
        __syncthreads();
        (void)xcd_barrier_post(W_CTL + CW_BAR, MISC + 8);
    }

    if (IN(PH_PROLOGUE)) {
        PHASE_BEGIN ph_prologue(INP(0), W_HB);
#if FAST_GEMM
        LAS float* scr = ldsf + (TIDX >> 6) * (64 * 33);
        const int gw = blockIdx.x * NWAVES + (TIDX >> 6), ngw = gridDim.x * NWAVES, lane = TIDX & 63;
        convert_plain(INP(1), D_, NIN0, NIN0P, W_WIN0, scr, gw, ngw, lane);
        convert_plain(INP(16), D_, D_, D_, W_WOUT0, scr, gw, ngw, lane);
        convert_plain(INP(17), D_, NIN1, NIN1, W_WIN1, scr, gw, ngw, lane);
        convert_plain(INP(30), D_, D_, D_, W_WOUT1, scr, gw, ngw, lane);
        convert_plain(INP(26), 512, 512, 512, W_WGLU, scr, gw, ngw, lane);
        convert_lora(INP(4), INP(6), INP(7), W_WLORA, scr, gw, ngw, lane);
        convert_moe(INP(37), INP(38), INP(39), W_W13, W_W2, scr, gw, ngw, lane);
#endif
    }
    SEAM(PH_PROLOGUE);
    if (IN(PH_INPROJ0)) {
        PHASE_BEGIN
#if FAST_GEMM
        { pg8::Gemm g{W_HB, W_WIN0, T_, NIN0P, D_}; pg8::StaticOrder S; S.init(T_, NIN0P, (int)gridDim.x, (int)blockIdx.x); pg8::EpiStoreBf16 E{W_P, NIN0P, 0, 0};
          pg8::gemm_phase<pg8::EpiStoreBf16, pg8::StaticOrder, true, true>(lds, g, S, E); }
#else
        const float* W = INP(1); const bf16_t* A = W_HB; bf16_t* P = W_P;
        naive_gemm<false>(ldsf, T_, NIN0, D_, [&](int m) { return A + (size_t)m * D_; }, [&](int, int) { return W; }, NIN0,
                          [&](int m, int n, float a, float) { P[(size_t)m * NIN0P + n] = f2bf(a); });
#endif
    }
    SEAM(PH_INPROJ0);
    if (IN(PH_PREPA0)) { PHASE_BEGIN ph_prepA0<!FAST_GLA0>(W_P, INP(2), INP(13), INP(14), W_AP, W_GLALA); }
    SEAM(PH_PREPA0);
    if (IN(PH_LORA0)) {
        PHASE_BEGIN
#if FAST_GEMM
        { pg8::Gemm g{W_AP, W_WLORA, T_, NLORA, 256}; pg8::StaticOrder S; S.init(T_, NLORA, (int)gridDim.x, (int)blockIdx.x); pg8::EpiStoreBf16 E{W_LO, 512, 512, (size_t)T_ * 512};
          pg8::gemm_phase<pg8::EpiStoreBf16, pg8::StaticOrder, true, true>(lds, g, S, E); }
#else
        const float* w2 = INP(4); const float* a2 = INP(6); const float* g2 = INP(7); const bf16_t* AP = W_AP; bf16_t* LO = W_LO;
        naive_gemm<false>(ldsf, T_, 512, 64, [&](int m) { return AP + (size_t)m * 256; }, [&](int, int) { return w2; }, 512,
                          [&](int m, int n, float a, float) { LO[(size_t)m * 512 + n] = f2bf(a); });
        naive_gemm<false>(ldsf, T_, 512, 64, [&](int m) { return AP + (size_t)m * 256 + 64; }, [&](int, int) { return a2; }, 512,
                          [&](int m, int n, float a, float) { LO[(size_t)T_ * 512 + (size_t)m * 512 + n] = f2bf(a); });
        naive_gemm<false>(ldsf, T_, 512, 128, [&](int m) { return AP + (size_t)m * 256 + 128; }, [&](int, int) { return g2; }, 512,
                          [&](int m, int n, float a, float) { LO[(size_t)2 * T_ * 512 + (size_t)m * 512 + n] = f2bf(a); });
#endif
    }
    SEAM(PH_LORA0);
    if (IN(PH_PREPB0)) {
        PHASE_BEGIN ph_prepB0(W_P, W_LO, INP(2), INP(3), INP(5), INP(8), INP(9), INP(10), W_SC, W_BON);
#if FAST_GLA0
        { const GlaBufs GB = GLA0_BUFS; __syncthreads();
          for (int cg = blockIdx.x; cg < 256; cg += gridDim.x) gla_prep_tile<64, 0>(ldsf, W_P, INP(13), INP(14), GB, cg); }
#endif
    }
    SEAM(PH_PREPB0);
    if (IN(PH_SCAN0)) {
        PHASE_BEGIN
        const int bid = blockIdx.x;
#if FAST_RWKV
        constexpr int NRW = 64;
        if (bid < NRW) rwkv_scan_v1(ldsf, W_SC, W_YRW, bid);
#else
        constexpr int NRW = 16;
        if (bid < NRW) naive_rwkv_scan(ldsf, W_SC, W_YRW, bid);
#endif
#if FAST_GLA0
        else {
            const GlaBufs GB = GLA0_BUFS;
            const int nb = (int)gridDim.x - NRW, b0 = bid - NRW, wave = TIDX >> 6, lane = TIDX & 63;
            for (int u = b0 * NWAVES + wave; u < 1024 * 4; u += nb * NWAVES) gla_pass1_unit<64>(GB, u, lane);
            sub_barrier(W_CTL + CW_SUB, (unsigned)nb);
            gla_pass2<64>(GB, b0 * NTHREADS + TIDX, nb * NTHREADS);
            sub_barrier(W_CTL + CW_SUB + 64, (unsigned)nb);
            for (int it = b0; it < 1024; it += nb) gla_pass3_item<64, 0>(lds, W_P, INP(15), GB, W_YMIX, it);
        }
#else
        else if (bid < 24) {
            const int bh = bid - 16;
            const bf16_t* P = W_P; const float* GLALA = W_GLALA;
            naive_gla_scan<64>(ldsf,
                [&](int t, int ck, float& q, float& kk, float& e) {
                    q = bf2f(P[(size_t)t * NIN0P + 1792 + ck]) * 0.125f; kk = bf2f(P[(size_t)t * NIN0P + 2048 + ck]); e = __expf(GLALA[(size_t)t * 256 + ck]); },
                [&](int t, int cv) { return bf2f(P[(size_t)t * NIN0P + 2304 + cv]); }, W_OG, bh >> 2, bh & 3);
        }
#endif
    }
    SEAM(PH_SCAN0);
    if (IN(PH_FIN0)) { PHASE_BEGIN ph_fin0<!FAST_GLA0>(W_YRW, W_OG, W_P, W_LO, W_SC, W_BON, INP(11), INP(12), INP(15), W_YMIX); }
    SEAM(PH_FIN0);

    moe_layer<PLO, PHI, 0>(lds);
            if (IN(PH_INPROJ1)) {
                PHASE_BEGIN
#if FAST_GEMM
                { pg8::Gemm g{W_HB, W_WIN1, T_, NIN1, D_}; pg8::StaticOrder S; S.init(T_, NIN1, (int)gridDim.x, (int)blockIdx.x); pg8::EpiStoreBf16 E{W_P, NIN1, 0, 0};
                  pg8::gemm_phase<pg8::EpiStoreBf16, pg8::StaticOrder, true, true>(lds, g, S, E); }
#else
                const float* W = INP(17); const bf16_t* A = W_HB; bf16_t* P = W_P;
                naive_gemm<false>(ldsf, T_, NIN1, D_, [&](int m) { return A + (size_t)m * D_; }, [&](int, int) { return W; }, NIN1,
                                  [&](int m, int n, float a, float) { P[(size_t)m * NIN1 + n] = f2bf(a); });
#endif
            }
            SEAM(PH_INPROJ1);
            if (IN(PH_L1A)) {
                PHASE_BEGIN
#if FAST_S5
                if (blockIdx.x >= 224) s5_tables(ldsf, INP(18), INP(19), INP(20), INP(21), INP(22), INP(23), INP(24), W_S5MB, W_S5WE, (int)blockIdx.x - 224);
                s5_fill_ua(W_P, W_S5UA, blockIdx.x * NWAVES + (TIDX >> 6), gridDim.x * NWAVES, TIDX & 63);
                __syncthreads();
#endif
#if FAST_HG
                { const GlaBufs GB = HG_BUFS;
                  for (int cg = blockIdx.x; cg < 256; cg += gridDim.x) gla_prep_tile<128, 1>(ldsf, W_P, INP(28), nullptr, GB, cg); }
#endif
            }
            SEAM(PH_L1A);
            if (IN(PH_L1B)) {
                PHASE_BEGIN
                const int bid = blockIdx.x;
#if FAST_S5
                if (bid < 64) {
                    LAS int* tile_e = (LAS int*)(lds + 131072 + 1024);
                    if (TIDX < 64) tile_e[TIDX] = TIDX >> 1;
                    __syncthreads();
                    pg8::Gemm g{W_S5UA, W_S5WE, 64 * 256, 256, 512, 640}; pg8::MoeOrder S{64, 1, 64, bid, tile_e}; pg8::EpiStoreF32 E{W_S5E, 256};
                    pg8::gemm_phase<pg8::EpiStoreF32, pg8::MoeOrder, true, true>(lds, g, S, E);
                }
#endif
#if FAST_HG
                if (bid >= 64) {
                    const GlaBufs GB = HG_BUFS;
                    const int nb = (int)gridDim.x - 64, b0 = bid - 64, wave = TIDX >> 6, lane = TIDX & 63;
                    for (int u = b0 * NWAVES + wave; u < 1024 * 8; u += nb * NWAVES) gla_pass1_unit<128>(GB, u, lane);
                }
#endif
            }
            SEAM(PH_L1B);
            if (IN(PH_L1C)) {
                PHASE_BEGIN
                const int bid = blockIdx.x;
#if FAST_S5
                if (bid < 8) s5_carry(INP(18), INP(19), INP(20), W_S5E, W_S5UA, bid * NTHREADS + TIDX);
#endif
#if FAST_HG
                if (bid >= 8) { const GlaBufs GB = HG_BUFS; gla_pass2<128>(GB, (bid - 8) * NTHREADS + TIDX, ((int)gridDim.x - 8) * NTHREADS); }
#endif
#if FAST_GEMM
                { LAS float* scr = ldsf + (TIDX >> 6) * (64 * 33);
                  convert_moe(INP(37) + (size_t)32 * D_ * 512, INP(38) + (size_t)32 * D_ * 512, INP(39) + (size_t)32 * 512 * D_, W_W13, W_W2, scr,
                              bid * NWAVES + (TIDX >> 6), (int)gridDim.x * NWAVES, TIDX & 63); }
#endif
            }
            SEAM(PH_L1C);
            if (IN(PH_L1D)) {
                PHASE_BEGIN
                const int bid = blockIdx.x;
#if FAST_S5
                if (bid < 128) {
                    LAS int* tile_e = (LAS int*)(lds + 131072 + 1024);
                    if (TIDX < 64) tile_e[TIDX] = TIDX >> 1;
                    __syncthreads();
                    pg8::Gemm g{W_S5UA, W_S5MB, 64 * 256, 512, 640, 640}; pg8::MoeOrder S{64, 2, 128, bid, tile_e}; pg8::EpiS5Y E{W_P, INP(25), W_YRW, W_YS5B};
                    pg8::gemm_phase<pg8::EpiS5Y, pg8::MoeOrder, true, true>(lds, g, S, E);
                }
#endif
#if FAST_HG
                if (bid >= 128) {
                    const GlaBufs GB = HG_BUFS;
                    for (int it = bid - 128; it < 1024; it += (int)gridDim.x - 128) gla_pass3_item<128, 1>(lds, W_P, INP(29), GB, W_YMIX, it);
                }
#endif
            }
            SEAM(PH_L1D);
            if (IN(PH_SCAN1)) {
                PHASE_BEGIN
                const int bid = blockIdx.x;
                const bf16_t* P = W_P; (void)P; (void)bid;
#if !FAST_HG
                if (bid < 8) {
                    const float* hg_lb = INP(28);
                    naive_gla_scan<128>(ldsf,
                        [&](int t, int ck, float& q, float& kk, float& e) {
                            const float l0 = hg_lb[ck], l1 = hg_lb[512 + ck];
                            const float lbv = 1.f / (1.f + __expf(l0 - l1));
                            const float f = bf2f(P[(size_t)t * NIN1 + 1024 + ck]);
                            const float sg = sigm(f);
                            q = siluf(bf2f(P[(size_t)t * NIN1 + 512 + ck])); kk = (1.f - lbv) * (1.f - sg); e = lbv + (1.f - lbv) * sg; },
                        [&](int t, int cv) { return bf2f(P[(size_t)t * NIN1 + 1536 + cv]); }, W_OG, bid >> 2, bid & 3);
                }
#endif
#if !FAST_S5
                if (bid >= 8 && bid < 16) {
                    const int pair = (bid - 8) * 8 + (TIDX >> 6);
                    naive_s5_scan(P, INP(18), INP(19), INP(20), INP(21), INP(22), INP(23), INP(24), INP(25), W_YRW, W_YS5B, pair);
                }
#endif
            }
            SEAM(PH_SCAN1);
#if !FAST_HG
            if (IN(PH_FIN1)) { PHASE_BEGIN ph_fin1(W_OG, W_P, INP(29), W_YMIX); }
#endif
            SEAM(PH_FIN1);
            if (IN(PH_GLU1)) {
                PHASE_BEGIN
#if FAST_GEMM
                { pg8::Gemm g{W_YS5B, W_WGLU, T_, 512, 512}; pg8::StaticOrder S; S.init(T_, 512, (int)gridDim.x, (int)blockIdx.x); pg8::EpiGlu E{W_YRW, 512, INP(27), W_YMIX, D_};
                  pg8::gemm_phase<pg8::EpiGlu, pg8::StaticOrder, true, true>(lds, g, S, E); }
#else
                const float* W = INP(26); const float* gb = INP(27); const bf16_t* YS5B = W_YS5B; const float* YRW = W_YRW; bf16_t* Ymix = W_YMIX;
                naive_gemm<false>(ldsf, T_, 512, 512, [&](int m) { return YS5B + (size_t)m * 512; }, [&](int, int) { return W; }, 512,
                                  [&](int m, int n, float a, float) { const float y = YRW[(size_t)m * 512 + n]; Ymix[(size_t)m * D_ + n] = f2bf(y * sigm(a + gb[n])); });
#endif
            }
            SEAM(PH_GLU1);
    moe_layer<PLO, PHI, 1>(lds);
#undef IN
}
template <int PLO, int PHI>
__global__ void __launch_bounds__(NTHREADS, 2) mega(Args args) {
    extern __shared__ __attribute__((aligned(16))) unsigned char lds_raw[];
    mega_body<PLO, PHI>(lds_raw);
}

#include <utility>
template <int... I> static void set_attrs(std::integer_sequence<int, I...>) {
    (void)std::initializer_list<int>{ ((void)hipFuncSetAttribute((const void*)mega<I, I + 1>, hipFuncAttributeMaxDynamicSharedMemorySize, LDS_BYTES), 0)... };
}
template <int I> static int launch_one(int grid, hipStream_t stream, const Args& a) {
    hipLaunchKernelGGL((mega<I, I + 1>), dim3(grid), dim3(NTHREADS), LDS_BYTES, stream, a);
    return 0;
}
template <int... I> static void launch_all(std::integer_sequence<int, I...>, int grid, hipStream_t stream, const Args& a) {
    (void)std::initializer_list<int>{ launch_one<I>(grid, stream, a)... };
}
extern "C" void kernel_launch(void* const* d_in, const int* in_sizes, int n_in, void* d_out, int out_size, void* d_ws, size_t ws_size, hipStream_t stream) {
    static int grid = 0;
    if (grid == 0) {
        if (n_in != 42 || out_size != T_ * D_ || ws_size < WS_END) { fprintf(stderr, "kernel_launch: unexpected shapes n_in %d out %d ws %zu\n", n_in, out_size, ws_size); grid = -1; return; }
        int dev = 0, cus = 0, per_cu = 0;
        hipGetDevice(&dev);
        hipDeviceGetAttribute(&cus, hipDeviceAttributeMultiprocessorCount, dev);
        set_attrs(std::make_integer_sequence<int, PH_COUNT>{});
        hipFuncSetAttribute((const void*)mega<0, PH_COUNT>, hipFuncAttributeMaxDynamicSharedMemorySize, LDS_BYTES);
        hipOccupancyMaxActiveBlocksPerMultiprocessor(&per_cu, (const void*)mega<0, PH_COUNT>, NTHREADS, LDS_BYTES);
        (void)hipGetLastError();
        if (per_cu < 1) per_cu = 1;
        grid = cus * 1;
        fprintf(stderr, "kernel_launch: cus %d per_cu %d grid %d\n", cus, per_cu, grid);
    }
    if (grid < 0) return;
    hipMemsetAsync((char*)d_ws + WS_CTL, 0, CTL_ZERO_BYTES, stream);
    Args a{};
    for (int i = 0; i < 42; ++i) a.in[i] = (const float*)d_in[i];
    a.out = (float*)d_out; a.ws = (unsigned char*)d_ws;
#if MK_SINGLE
    void* kargs[] = {(void*)&a};
    hipError_t e = hipLaunchCooperativeKernel((const void*)mega<0, PH_COUNT>, dim3(grid), dim3(NTHREADS), kargs, LDS_BYTES, stream);
    if (e != hipSuccess) fprintf(stderr, "cooperative launch failed: %s (grid %d)\n", hipGetErrorString(e), grid);
#else
    launch_all(std::make_integer_sequence<int, PH_COUNT>{}, grid, stream, a);
#endif
}
#ifdef TEST_RANGES
template __global__ void mega<0, 2>(Args);
template __global__ void mega<1, 3>(Args);
template __global__ void mega<1, 4>(Args);
template __global__ void mega<3, 8>(Args);
template __global__ void mega<7, 13>(Args);
template __global__ void mega<10, 12>(Args);
template __global__ void mega<13, 17>(Args);
template __global__ void mega<0, 13>(Args);
#endif
```

```cpp
#include <hip/hip_runtime.h>
#include <cstdio>
#include <cstdint>

#define GAS __attribute__((address_space(1)))
#define LAS __attribute__((address_space(3)))
typedef unsigned short bf16_t;
typedef float f32x4 __attribute__((ext_vector_type(4)));
typedef unsigned u32x4 __attribute__((ext_vector_type(4)));
typedef unsigned u32x2 __attribute__((ext_vector_type(2)));
__device__ __forceinline__ int launder_tid() { int t = (int)threadIdx.x; asm volatile("" : "+v"(t)); return t; }
#define TIDX launder_tid()

#ifndef FAST_GEMM
#define FAST_GEMM 1
#endif
#ifndef FAST_RWKV
#define FAST_RWKV 1
#endif
#ifndef FAST_GLA0
#define FAST_GLA0 1
#endif
#ifndef FAST_HG
#define FAST_HG 1
#endif
#ifndef FAST_S5
#define FAST_S5 1
#endif
#ifndef MK_SINGLE
#define MK_SINGLE 1
#endif

constexpr int T_ = 16384, L_ = 8192, D_ = 1024;
constexpr int NIN0 = 3344, NIN0P = 3584, NIN1 = 2560;
constexpr int NLORA = 1536;
constexpr int RMAX = 40960;
constexpr int MOE_PAD = 256;
constexpr float DN_ALPHA = 1.41421356237f;
constexpr float LN_EPS = 1e-5f;
constexpr int NTHREADS = 512, NWAVES = 8;

constexpr size_t MiB = 1u << 20;
constexpr size_t WS_CTL = 0, CTL_ZERO_BYTES = 1 * MiB;
constexpr size_t WS_WIN0 = 2 * MiB;
constexpr size_t WS_WOUT0 = 9 * MiB;
constexpr size_t WS_WIN1 = 11 * MiB;
constexpr size_t WS_WOUT1 = 16 * MiB;
constexpr size_t WS_WGLU = 18 * MiB;
constexpr size_t WS_WLORA = 19 * MiB;
constexpr size_t WS_W13 = 20 * MiB;
constexpr size_t WS_W2 = 84 * MiB;
constexpr size_t WS_HB = 116 * MiB;
constexpr size_t WS_HA = 149 * MiB;
constexpr size_t WS_ROUTE = 213 * MiB;
constexpr size_t WS_BIG = 214 * MiB;
constexpr size_t WS_P = WS_BIG;
constexpr size_t WS_LO = WS_BIG + 112 * MiB;
constexpr size_t WS_SCAN = WS_BIG + 160 * MiB;
constexpr size_t WS_GLALA = WS_BIG + 256 * MiB;
constexpr size_t WS_BON = WS_BIG + 272 * MiB;
constexpr size_t WS_APRIME = WS_BIG + 273 * MiB;
constexpr size_t WS_YS5B = WS_BIG + 80 * MiB;
constexpr size_t WS_XR = WS_BIG;
constexpr size_t WS_HID = WS_BIG + 80 * MiB;
constexpr size_t WS_Y = WS_BIG + 120 * MiB;
constexpr size_t WS_END = 512 * MiB;
constexpr int CW_BAR = 4096;
constexpr int CW_CNT = 8192;

__device__ __forceinline__ float bf2f(bf16_t b) { return __uint_as_float(((unsigned)b) << 16); }
__device__ __forceinline__ bf16_t f2bf(float f) { unsigned u = __float_as_uint(f); u += 0x7fffu + ((u >> 16) & 1u); return (bf16_t)(u >> 16); }
__device__ __forceinline__ unsigned pk2(float lo, float hi) { return (unsigned)f2bf(lo) | ((unsigned)f2bf(hi) << 16); }
__device__ __forceinline__ float sigm(float x) { return 1.f / (1.f + __expf(-x)); }
__device__ __forceinline__ float siluf(float x) { return x * sigm(x); }
__device__ __forceinline__ float softplusf(float x) { return fmaxf(x, 0.f) + log1pf(__expf(-fabsf(x))); }
__device__ __forceinline__ float gelu_tanh(float x) { const float u = 0.7978845608028654f * (x + 0.044715f * x * x * x); return 0.5f * x * (1.f + tanhf(u)); }
__device__ __forceinline__ float wave_sum(float v) {
#pragma unroll
    for (int o = 1; o < 64; o <<= 1) v += __shfl_xor(v, o);
    return v;
}


namespace pg8 {
#define PG8_LAS __attribute__((address_space(3)))
typedef unsigned short bf16_t;
typedef short bf16x8 __attribute__((ext_vector_type(8)));
typedef float f32x4 __attribute__((ext_vector_type(4)));
typedef unsigned u32x4 __attribute__((ext_vector_type(4)));
constexpr int BM = 256, BK = 64, HALF = 128, HTB = HALF * BK * 2  , STAGE_BYTES = 8 * HTB, NXCD = 8, WGM = 8;

__host__ __device__ __forceinline__ int lds_byte(int r, int c) { const int st = (r >> 4) * 2 + (c >> 5), rr = r & 15, cc = c & 31, ob = rr * 64 + cc * 2; return st * 1024 + (ob ^ (((ob >> 9) & 1) << 5)); }
__host__ __device__ __forceinline__ void stage_rc(int b, int& R, int& C) { const int st = b / 1024, sb = b % 1024, swz = sb ^ (((sb >> 9) & 1) << 5); R = (st >> 1) * 16 + swz / 64; C = (st & 1) * 32 + (swz % 64) / 2; }
__host__ __device__ __forceinline__ int perm32(int rho) { const int n = rho >> 4, i = rho & 15; return 8 * (i >> 2) + 4 * n + (i & 3); }

struct Unit { int pm, pn, pb; };
struct Gemm { const bf16_t* A; const bf16_t* Bt; int M, N, K, lda; };

struct StaticOrder {
    int nM, nN, nwg, G, c;
    __host__ __device__ void init(int M, int N, int G_, int c_) { nM = M / BM; nN = N / BM; nwg = nM * nN; G = G_; c = c_; }
    __host__ __device__ bool next(int i, Unit& u) const {
        const long L = (long)i * G + c; if (L >= nwg) return false;
        int wgid = (int)L; { const int q = nwg / NXCD, r = nwg % NXCD, xcd = wgid % NXCD, off = wgid / NXCD; wgid = (xcd < r ? xcd * (q + 1) : r * (q + 1) + (xcd - r) * q) + off; }
        const int nig = WGM * nN, gid = wgid / nig, fm = gid * WGM, gsz = (nM - fm) < WGM ? (nM - fm) : WGM;
        u.pm = fm + ((wgid % nig) % gsz); u.pn = (wgid % nig) / gsz; u.pb = u.pn; return true;
    }
    __device__ __forceinline__ void a_ready(const Unit&) const {}
    __device__ __forceinline__ void done(const Unit&) const {}
};

__device__ __forceinline__ unsigned cvt_pk_bf16(float lo, float hi) { unsigned r; asm volatile("v_cvt_pk_bf16_f32 %0, %1, %2" : "=v"(r) : "v"(lo), "v"(hi)); return r; }
typedef float f32x2 __attribute__((ext_vector_type(2)));

template <class Epi, class Sched, bool ALIGN_EPI = false, bool SP2 = false>
__device__ __forceinline__ void gemm_phase(PG8_LAS unsigned char* lds, const Gemm g, const Sched& S, const Epi& E) {
    const int tid = TIDX, wid = __builtin_amdgcn_readfirstlane(tid >> 6), lane = tid & 63, wr = wid >> 2, wc = wid & 3, fr = lane & 15, fq = lane >> 4;
    const int K = g.K, nt = K / BK, lda = g.lda ? g.lda : g.K;
    unsigned voffA[2], voffB[2];
#pragma unroll
    for (int i = 0; i < 2; ++i) { int R, C; stage_rc(tid * 16 + i * 8192, R, C); const int Rb = Epi::PERM ? ((R & ~31) + perm32(R & 31)) : R;
        voffA[i] = (unsigned)(R * lda + C) * 2u; voffB[i] = (unsigned)(Rb * K + C) * 2u; }
    const size_t kstep = (size_t)(BK * 2);
    const size_t hstep = (size_t)HALF * K * 2;
    const size_t tstep = 2 * hstep;
    const size_t hstepA = (size_t)HALF * lda * 2, tstepA = 2 * hstepA;
    const unsigned ldsw = (unsigned)wid * 1024u;
    const int aoff = lds_byte(wr * 64 + fr, fq * 8), boff = lds_byte(wc * 32 + fr, fq * 8);
#define PG8_SA(b, h) (((b) * 2 + (h)) * HTB)
#define PG8_SB(b, h) ((4 + (b) * 2 + (h)) * HTB)
#define PG8_STAGE(bufoff, gbase, voff) do { _Pragma("unroll") for (int _i = 0; _i < 2; ++_i) \
        __builtin_amdgcn_global_load_lds((const unsigned*)((const char*)(gbase) + (voff)[_i]), (PG8_LAS unsigned*)(lds + (bufoff) + ldsw + _i * 8192), 16, 0, 0); } while (0)
#define PG8_LDA(dst, b, h) do { _Pragma("unroll") for (int m = 0; m < 4; ++m) _Pragma("unroll") for (int k = 0; k < 2; ++k) dst[m][k] = *(const PG8_LAS bf16x8*)(lds + PG8_SA(b, h) + aoff + m * 2048 + k * 1024); } while (0)
#define PG8_LDB(dst, b, h) do { _Pragma("unroll") for (int n = 0; n < 2; ++n) _Pragma("unroll") for (int k = 0; k < 2; ++k) dst[n][k] = *(const PG8_LAS bf16x8*)(lds + PG8_SB(b, h) + boff + n * 2048 + k * 1024); } while (0)
#define PG8_MMA(ai, bj, At, Bt) do { __builtin_amdgcn_s_setprio(1); _Pragma("unroll") for (int m = 0; m < 4; ++m) _Pragma("unroll") for (int n = 0; n < 2; ++n) _Pragma("unroll") for (int k = 0; k < 2; ++k) \
        acc[ai][bj][m][n] = __builtin_amdgcn_mfma_f32_16x16x32_bf16(Bt[n][k], At[m][k], acc[ai][bj][m][n], 0, 0, 0); __builtin_amdgcn_s_setprio(0); } while (0)
#define PG8_WAIT_V(n) asm volatile("s_waitcnt vmcnt(" #n ")" ::: "memory")
#define PG8_WAIT_L(n) asm volatile("s_waitcnt lgkmcnt(" #n ")" ::: "memory")
#define PG8_BAR __builtin_amdgcn_s_barrier()
#define PG8_SCHED __builtin_amdgcn_sched_barrier(0)
    Unit cur, nxt; int ui = 0;
    if (!S.next(0, cur)) return;
    f32x4 acc[2][2][4][2];
#pragma unroll
    for (int a = 0; a < 2; ++a)
#pragma unroll
        for (int b = 0; b < 2; ++b)
#pragma unroll
            for (int m = 0; m < 4; ++m)
#pragma unroll
                for (int n = 0; n < 2; ++n) acc[a][b][m][n] = (f32x4){0.f, 0.f, 0.f, 0.f};
    bf16x8 At[4][2], B0[2][2], B1[2][2];
    const char* cA = (const char*)g.A + (size_t)cur.pm * tstepA; const char* cB = (const char*)g.Bt + (size_t)cur.pb * tstep;
    S.a_ready(cur);
    if constexpr (SP2) {
        PG8_STAGE(PG8_SB(0, 0), cB, voffB); PG8_STAGE(PG8_SB(0, 1), cB + hstep, voffB); PG8_STAGE(PG8_SA(0, 0), cA, voffA); PG8_STAGE(PG8_SA(0, 1), cA + hstepA, voffA);
        if (wr == 1) PG8_BAR;
        PG8_WAIT_V(2); PG8_BAR;
        PG8_STAGE(PG8_SB(1, 0), cB + kstep, voffB); PG8_STAGE(PG8_SA(1, 0), cA + kstep, voffA); PG8_STAGE(PG8_SB(1, 1), cB + hstep + kstep, voffB);
        PG8_WAIT_V(6); PG8_BAR;
    } else {
        PG8_STAGE(PG8_SB(0, 0), cB, voffB); PG8_STAGE(PG8_SA(0, 0), cA, voffA); PG8_STAGE(PG8_SB(0, 1), cB + hstep, voffB); PG8_STAGE(PG8_SA(0, 1), cA + hstepA, voffA);
        if (wr == 1) PG8_BAR;
        PG8_WAIT_V(4); PG8_BAR;
        PG8_STAGE(PG8_SB(1, 0), cB + kstep, voffB); PG8_STAGE(PG8_SA(1, 0), cA + kstep, voffA); PG8_STAGE(PG8_SB(1, 1), cB + hstep + kstep, voffB);
        PG8_WAIT_V(6); PG8_BAR;
    }
    for (;;) {
        const bool has_next = S.next(ui + 1, nxt);
        const char* nA = has_next ? (const char*)g.A + (size_t)nxt.pm * tstepA : cA; const char* nB = has_next ? (const char*)g.Bt + (size_t)nxt.pb * tstep : cB;
        for (int t = 0; t < nt; t += 2) {
            const bool last = (t == nt - 2);
            const char* a1 = cA + (size_t)(t + 1) * kstep;
            const char* a2 = last ? nA : cA + (size_t)(t + 2) * kstep; const char* b2 = last ? nB : cB + (size_t)(t + 2) * kstep;
            const char* a3 = a2 + kstep; const char* b3 = b2 + kstep;
            if (last && has_next) S.a_ready(nxt);
            if constexpr (SP2) {
            PG8_LDB(B0, 0, 0); PG8_LDB(B1, 0, 1); PG8_SCHED; PG8_LDA(At, 0, 0); PG8_STAGE(PG8_SA(1, 1), a1 + hstepA, voffA);
            PG8_WAIT_V(8); PG8_WAIT_L(0); PG8_BAR; PG8_MMA(0, 0, At, B0); PG8_MMA(0, 1, At, B1); PG8_BAR; PG8_SCHED;
            PG8_LDA(At, 0, 1); PG8_STAGE(PG8_SB(0, 0), b2, voffB); PG8_STAGE(PG8_SB(0, 1), b2 + hstep, voffB); PG8_STAGE(PG8_SA(0, 0), a2, voffA);
            PG8_WAIT_V(8); PG8_WAIT_L(0); PG8_BAR; PG8_MMA(1, 0, At, B0); PG8_MMA(1, 1, At, B1); PG8_BAR; PG8_SCHED;
            PG8_LDB(B0, 1, 0); PG8_LDB(B1, 1, 1); PG8_SCHED; PG8_LDA(At, 1, 0); PG8_STAGE(PG8_SA(0, 1), a2 + hstepA, voffA);
            PG8_WAIT_V(8); PG8_WAIT_L(0); PG8_BAR; PG8_MMA(0, 0, At, B0); PG8_MMA(0, 1, At, B1); PG8_BAR; PG8_SCHED;
            PG8_LDA(At, 1, 1); PG8_STAGE(PG8_SB(1, 0), b3, voffB); PG8_STAGE(PG8_SB(1, 1), b3 + hstep, voffB); PG8_STAGE(PG8_SA(1, 0), a3, voffA);
            PG8_WAIT_V(8); PG8_WAIT_L(0); PG8_BAR; PG8_MMA(1, 0, At, B0); PG8_MMA(1, 1, At, B1); PG8_BAR; PG8_SCHED;
            } else {
            PG8_LDB(B0, 0, 0); PG8_SCHED; PG8_LDA(At, 0, 0); PG8_STAGE(PG8_SA(1, 1), a1 + hstepA, voffA);
            PG8_WAIT_L(8); PG8_BAR; PG8_WAIT_L(0); PG8_MMA(0, 0, At, B0); PG8_BAR; PG8_SCHED;
            PG8_LDB(B1, 0, 1); PG8_STAGE(PG8_SB(0, 0), b2, voffB);
            PG8_BAR; PG8_WAIT_L(0); PG8_MMA(0, 1, At, B1); PG8_BAR;
            PG8_LDA(At, 0, 1); PG8_STAGE(PG8_SA(0, 0), a2, voffA);
            PG8_BAR; PG8_WAIT_L(0); PG8_MMA(1, 0, At, B0); PG8_BAR; PG8_SCHED;
            PG8_STAGE(PG8_SB(0, 1), b2 + hstep, voffB);
            PG8_WAIT_V(6); PG8_BAR; PG8_MMA(1, 1, At, B1); PG8_BAR;
            PG8_LDB(B0, 1, 0); PG8_SCHED; PG8_LDA(At, 1, 0); PG8_STAGE(PG8_SA(0, 1), a2 + hstepA, voffA);
            PG8_WAIT_L(8); PG8_BAR; PG8_WAIT_L(0); PG8_MMA(0, 0, At, B0); PG8_BAR; PG8_SCHED;
            PG8_LDB(B1, 1, 1); PG8_STAGE(PG8_SB(1, 0), b3, voffB);
            PG8_BAR; PG8_WAIT_L(0); PG8_MMA(0, 1, At, B1); PG8_BAR;
            PG8_LDA(At, 1, 1); PG8_STAGE(PG8_SA(1, 0), a3, voffA);
            PG8_BAR; PG8_WAIT_L(0); PG8_MMA(1, 0, At, B0); PG8_BAR; PG8_SCHED;
            PG8_STAGE(PG8_SB(1, 1), b3 + hstep, voffB);
            PG8_WAIT_V(6); PG8_BAR; PG8_MMA(1, 1, At, B1); PG8_BAR;
            }
        }
        if constexpr (ALIGN_EPI) { if (wr == 0) PG8_BAR; }
        if constexpr (!Epi::AFTER_DRAIN) { E(acc, cur, wr, wc, fr, fq); S.done(cur); }
        if (!has_next) break;
#pragma unroll
        for (int a = 0; a < 2; ++a)
#pragma unroll
            for (int b = 0; b < 2; ++b)
#pragma unroll
                for (int m = 0; m < 4; ++m)
#pragma unroll
                    for (int n = 0; n < 2; ++n) acc[a][b][m][n] = (f32x4){0.f, 0.f, 0.f, 0.f};
        cur = nxt; cA = nA; cB = nB; ++ui;
        if constexpr (ALIGN_EPI) { if (wr == 1) PG8_BAR; }
    }
    PG8_WAIT_V(0);
    if constexpr (!ALIGN_EPI) { if (wr == 0) PG8_BAR; }
    PG8_BAR;
    if constexpr (Epi::AFTER_DRAIN) { E.fused(acc, cur, wr, wc, fr, fq, lds, wid, lane); S.done(cur); }
#undef PG8_SA
#undef PG8_SB
#undef PG8_STAGE
#undef PG8_LDA
#undef PG8_LDB
#undef PG8_MMA
#undef PG8_WAIT_V
#undef PG8_WAIT_L
#undef PG8_BAR
#undef PG8_SCHED
}

struct EpiStoreBf16 {
    static constexpr bool PERM = true, AFTER_DRAIN = false;
    bf16_t* O; int ldc; int split_cols; size_t split_stride;
    __device__ __forceinline__ void operator()(const f32x4 (&acc)[2][2][4][2], const Unit& u, int wr, int wc, int fr, int fq) const {
        int colt = u.pn * BM; bf16_t* base = O;
        if (split_cols) { const int t = colt / split_cols; base += (size_t)t * split_stride; colt -= t * split_cols; }
        const int row0 = u.pm * BM + wr * 64 + fr, col0 = colt + wc * 32 + 8 * fq;
#pragma unroll
        for (int ai = 0; ai < 2; ++ai)
#pragma unroll
            for (int m = 0; m < 4; ++m) { bf16_t* rowp = base + (size_t)(row0 + ai * HALF + m * 16) * ldc + col0;
#pragma unroll
                for (int bj = 0; bj < 2; ++bj) { const f32x4 v0 = acc[ai][bj][m][0], v1 = acc[ai][bj][m][1];
                    u32x4 w; w.x = cvt_pk_bf16(v0[0], v0[1]); w.y = cvt_pk_bf16(v0[2], v0[3]); w.z = cvt_pk_bf16(v1[0], v1[1]); w.w = cvt_pk_bf16(v1[2], v1[3]);
                    *(u32x4*)(rowp + bj * HALF) = w; } }
    }
};
struct EpiResidF32 {
    static constexpr bool PERM = false, AFTER_DRAIN = false;
    const float* resid; float* out; int ldc; float alpha;
    __device__ __forceinline__ void operator()(const f32x4 (&acc)[2][2][4][2], const Unit& u, int wr, int wc, int fr, int fq) const {
        const int row0 = u.pm * BM + wr * 64 + fr, col0 = u.pn * BM + wc * 32 + 4 * fq;
#pragma unroll
        for (int ai = 0; ai < 2; ++ai)
#pragma unroll
            for (int m = 0; m < 4; ++m) { const size_t off = (size_t)(row0 + ai * HALF + m * 16) * ldc + col0;
#pragma unroll
                for (int bj = 0; bj < 2; ++bj)
#pragma unroll
                    for (int n = 0; n < 2; ++n) { const size_t o = off + bj * HALF + n * 16; *(f32x4*)(out + o) = *(const f32x4*)(resid + o) * alpha + acc[ai][bj][m][n]; } }
    }
};
__device__ __forceinline__ float fast_sigm(float x) { return __builtin_amdgcn_rcpf(1.f + __expf(-x)); }
struct EpiSwiglu {
    static constexpr bool PERM = true, AFTER_DRAIN = false;
    bf16_t* HID;
    __device__ __forceinline__ void operator()(const f32x4 (&acc)[2][2][4][2], const Unit& u, int wr, int wc, int fr, int fq) const {
        const int row0 = u.pm * BM + wr * 64 + fr, h0 = u.pn * 128 + wc * 16 + 4 * fq;
#pragma unroll
        for (int ai = 0; ai < 2; ++ai)
#pragma unroll
            for (int m = 0; m < 4; ++m) { bf16_t* rowp = HID + (size_t)(row0 + ai * HALF + m * 16) * 512 + h0;
#pragma unroll
                for (int bj = 0; bj < 2; ++bj) { const f32x4 a = acc[ai][bj][m][0], b = acc[ai][bj][m][1]; f32x4 h;
#pragma unroll
                    for (int j = 0; j < 4; ++j) h[j] = a[j] * fast_sigm(a[j]) * b[j];
                    typedef unsigned u32x2v __attribute__((ext_vector_type(2)));
                    u32x2v w; w.x = cvt_pk_bf16(h[0], h[1]); w.y = cvt_pk_bf16(h[2], h[3]);
                    *(u32x2v*)(rowp + bj * 64) = w; } }
    }
};
struct EpiGlu {
    static constexpr bool PERM = true, AFTER_DRAIN = false;
    const float* ysrc; int ldy; const float* bias; bf16_t* O; int ldc;
    __device__ __forceinline__ void operator()(const f32x4 (&acc)[2][2][4][2], const Unit& u, int wr, int wc, int fr, int fq) const {
        const int row0 = u.pm * BM + wr * 64 + fr, col0 = u.pn * BM + wc * 32 + 8 * fq;
#pragma unroll
        for (int ai = 0; ai < 2; ++ai)
#pragma unroll
            for (int m = 0; m < 4; ++m) { const int row = row0 + ai * HALF + m * 16;
#pragma unroll
                for (int bj = 0; bj < 2; ++bj) { const int col = col0 + bj * HALF;
                    const f32x4 y0 = *(const f32x4*)(ysrc + (size_t)row * ldy + col), y1 = *(const f32x4*)(ysrc + (size_t)row * ldy + col + 4);
                    const f32x4 b0 = *(const f32x4*)(bias + col), b1 = *(const f32x4*)(bias + col + 4);
                    f32x4 v0 = acc[ai][bj][m][0] + b0, v1 = acc[ai][bj][m][1] + b1;
#pragma unroll
                    for (int j = 0; j < 4; ++j) { v0[j] = y0[j] * fast_sigm(v0[j]); v1[j] = y1[j] * fast_sigm(v1[j]); }
                    u32x4 w; w.x = cvt_pk_bf16(v0[0], v0[1]); w.y = cvt_pk_bf16(v0[2], v0[3]); w.z = cvt_pk_bf16(v1[0], v1[1]); w.w = cvt_pk_bf16(v1[2], v1[3]);
                    *(u32x4*)(O + (size_t)row * ldc + col) = w; } }
    }
};
struct EpiStoreF32 {
    static constexpr bool PERM = false, AFTER_DRAIN = false;
    float* out; int ldc;
    __device__ __forceinline__ void operator()(const f32x4 (&acc)[2][2][4][2], const Unit& u, int wr, int wc, int fr, int fq) const {
        const int row0 = u.pm * BM + wr * 64 + fr, col0 = u.pn * BM + wc * 32 + 4 * fq;
#pragma unroll
        for (int ai = 0; ai < 2; ++ai)
#pragma unroll
            for (int m = 0; m < 4; ++m) { const size_t off = (size_t)(row0 + ai * HALF + m * 16) * ldc + col0;
#pragma unroll
                for (int bj = 0; bj < 2; ++bj)
#pragma unroll
                    for (int n = 0; n < 2; ++n) *(f32x4*)(out + off + bj * HALF + n * 16) = acc[ai][bj][m][n]; }
    }
};
struct EpiS5Y {
    static constexpr bool PERM = false, AFTER_DRAIN = false;
    const bf16_t* P1; const float* dvec; float* YS5; bf16_t* YS5B;
    __device__ __forceinline__ void operator()(const f32x4 (&acc)[2][2][4][2], const Unit& u, int wr, int wc, int fr, int fq) const {
        const int g = u.pm >> 1, ch = g * 16 + 4 * fq;
        const f32x4 dd = *(const f32x4*)(dvec + ch);
#pragma unroll
        for (int ai = 0; ai < 2; ++ai)
#pragma unroll
            for (int m = 0; m < 4; ++m) {
                const int bc = (u.pm & 1) * 256 + ai * HALF + wr * 64 + m * 16 + fr, b = bc >> 8, c32 = bc & 255;
#pragma unroll
                for (int bj = 0; bj < 2; ++bj)
#pragma unroll
                    for (int n = 0; n < 2; ++n) {
                        const int i = 16 * u.pn + 8 * bj + 2 * wc + n;
                        const size_t t = (size_t)b * 8192 + c32 * 32 + i;
                        typedef unsigned u32x2v __attribute__((ext_vector_type(2)));
                        const u32x2v uu = *(const u32x2v*)(P1 + t * 2560 + ch);
                        f32x4 uv; uv[0] = __uint_as_float(uu.x << 16); uv[1] = __uint_as_float(uu.x & 0xffff0000u); uv[2] = __uint_as_float(uu.y << 16); uv[3] = __uint_as_float(uu.y & 0xffff0000u);
                        f32x4 y = acc[ai][bj][m][n] + dd * uv;
#pragma unroll
                        for (int j = 0; j < 4; ++j) { const float x = y[j]; const float tt = 0.7978845608028654f * (x + 0.044715f * x * x * x); y[j] = 0.5f * x * (1.f + tanhf(tt)); }
                        *(f32x4*)(YS5 + t * 512 + ch) = y;
                        u32x2v w; w.x = cvt_pk_bf16(y[0], y[1]); w.y = cvt_pk_bf16(y[2], y[3]);
                        *(u32x2v*)(YS5B + t * 512 + ch) = w;
                    }
            }
    }
};
struct MoeOrder {
    int ntiles, nN, G, c; const PG8_LAS int* tile_e;
    __device__ __forceinline__ bool next(int i, Unit& u) const {
        const int L = i * G + c; if (L >= ntiles * nN) return false;
        u.pm = L / nN; u.pn = L % nN; u.pb = tile_e[u.pm] * nN + u.pn; return true;
    }
    __device__ __forceinline__ void a_ready(const Unit&) const {}
    __device__ __forceinline__ void done(const Unit&) const {}
};
}

#define XB_TMO      128
#define XB_XCNT(j)  (256  + 64 * (j))
#define XB_XSUB(j)  (1280 + 64 * (j))
#define XB_XGEN(j)  (2304 + 64 * (j))
#define XB_TOP      3328
#define XB_TOPGEN   3392
#define XCD_BAR_WORDS 3456
#define XB_SPIN_CAP (1u << 18)
__device__ __forceinline__ unsigned xb_ld(unsigned* p)              { return __hip_atomic_load(p, __ATOMIC_RELAXED, __HIP_MEMORY_SCOPE_AGENT); }
__device__ __forceinline__ unsigned xb_add(unsigned* p, unsigned v) { return __hip_atomic_fetch_add(p, v, __ATOMIC_RELAXED, __HIP_MEMORY_SCOPE_AGENT); }
__device__ __forceinline__ unsigned xb_xcc_id() { return (unsigned)__builtin_amdgcn_s_getreg((3 << 11) | 20) & 0xFu; }
#define XB_SPIN(cond, bar) do { unsigned _sp = 0; while (cond) { __builtin_amdgcn_s_sleep(1); \
    if ((++_sp & 255u) == 0u) { if (xb_ld(&(bar)[XB_TMO])) break; if (_sp > XB_SPIN_CAP) { atomicAdd(&(bar)[XB_TMO], 1u); break; } } } } while (0)
struct XcdBarrier { unsigned* bar; unsigned x; volatile LAS unsigned* st; };
__device__ __forceinline__ XcdBarrier xcd_barrier_post(unsigned* bar, volatile LAS unsigned* st) {
    XcdBarrier b; b.bar = bar; b.x = xb_xcc_id(); b.st = st;
    if (TIDX == 0) (void)xb_add(&bar[XB_XCNT(b.x)], 1u);
    return b;
}
__device__ __forceinline__ void xcd_barrier_complete(unsigned* bar, unsigned x, unsigned& nloc, unsigned& nx) {
    const unsigned G = gridDim.x;
    unsigned sum, cnt, mine, sp = 0u;
    for (;;) {
        sum = 0u; cnt = 0u; mine = 0u;
#pragma unroll
        for (unsigned j = 0; j < 16; ++j) { const unsigned c = xb_ld(&bar[XB_XCNT(j)]); sum += c; cnt += (c > 0u) ? 1u : 0u; mine = (j == x) ? c : mine; }
        if (sum == G) break;
        __builtin_amdgcn_s_sleep(1);
        if ((++sp & 255u) == 0u) { if (xb_ld(&bar[XB_TMO])) break; if (sp > XB_SPIN_CAP) { atomicAdd(&bar[XB_TMO], 1u); break; } }
    }
    nloc = mine > 0u ? mine : 1u; nx = cnt > 0u ? cnt : 1u;
}
__device__ __forceinline__ void xcd_barrier(const XcdBarrier& b) {
    asm volatile("s_waitcnt vmcnt(0)" ::: "memory");
    __syncthreads();
    if (TIDX == 0) {
        unsigned* bar = b.bar;
        __builtin_amdgcn_s_waitcnt(0);
        unsigned nloc = b.st[0], nx = b.st[1];
        if (nloc == 0u) { xcd_barrier_complete(bar, b.x, nloc, nx); b.st[0] = nloc; b.st[1] = nx; }
        const unsigned old = xb_add(&bar[XB_XSUB(b.x)], 1u);
        const unsigned gen = old / nloc;
        if (old + 1u == (gen + 1u) * nloc) {
            __builtin_amdgcn_fence(__ATOMIC_RELEASE, "agent");
            asm volatile("s_waitcnt vmcnt(0)" ::: "memory");
            const unsigned og = xb_add(&bar[XB_TOP], 1u);
            const unsigned tg = og / nx;
            if (og + 1u == (tg + 1u) * nx) xb_add(&bar[XB_TOPGEN], 1u);
            else XB_SPIN(xb_ld(&bar[XB_TOPGEN]) == tg, bar);
            __builtin_amdgcn_fence(__ATOMIC_ACQUIRE, "agent");
            xb_add(&bar[XB_XGEN(b.x)], 1u);
            asm volatile("s_waitcnt vmcnt(0)" ::: "memory");
        } else {
            XB_SPIN(xb_ld(&bar[XB_XGEN(b.x)]) == gen, bar);
            __builtin_amdgcn_fence(__ATOMIC_ACQUIRE, "agent");
            asm volatile("s_waitcnt vmcnt(0)" ::: "memory");
        }
    }
    __syncthreads();
}


typedef short bf16x8 __attribute__((ext_vector_type(8)));
struct GlaBufs { bf16_t* QT; bf16_t* KT; bf16_t* KDT; bf16_t* VT; float* DG; float* DS; bf16_t* SP; };
__device__ __forceinline__ float logsigf(float x) { return fminf(x, 0.f) - log1pf(__expf(-fabsf(x))); }

template <int K, int LAYER>
__device__ __forceinline__ void gla_prep_tile(LAS float* lds, const bf16_t* P, const float* aux0, const float* aux1, const GlaBufs& B, int cg) {
    constexpr int HK = 4 * K, KP = K + 1;
    LAS float* G = lds;
    LAS float* KR = lds + 64 * KP;
    LAS float* LV = lds + 2 * 64 * KP;
    const int tid = TIDX, lane = tid & 63, wave = tid >> 6;
    const int t0 = cg * 64;
    for (int h = 0; h < 4; ++h) {
        for (int idx = tid; idx < 64 * K; idx += NTHREADS) {
            const int t = idx / K, k = idx % K, ck = h * K + k;
            float g, kr;
            if (LAYER == 0) {
                const bf16_t* row = P + (size_t)(t0 + t) * NIN0P;
                float gk = aux1[ck];
#pragma unroll
                for (int i = 0; i < 16; ++i) gk += bf2f(row[2816 + i]) * aux0[i * 256 + ck];
                g = logsigf(gk) * (1.f / 16.f);
                kr = bf2f(row[2048 + ck]);
            } else {
                const bf16_t* row = P + (size_t)(t0 + t) * NIN1;
                const float lbv = 1.f / (1.f + __expf(aux0[ck] - aux0[512 + ck]));
                const float sg = sigm(bf2f(row[1024 + ck]));
                g = __logf(lbv + (1.f - lbv) * sg);
                kr = (1.f - lbv) * (1.f - sg);
            }
            G[t * KP + k] = g; KR[t * KP + k] = kr;
        }
        for (int idx = tid; idx < 64 * 128; idx += NTHREADS) {
            const int t = idx >> 7, vc = idx & 127;
            LV[t * 129 + vc] = bf2f(LAYER == 0 ? P[(size_t)(t0 + t) * NIN0P + 2304 + h * 128 + vc] : P[(size_t)(t0 + t) * NIN1 + 1536 + h * 128 + vc]);
        }
        __syncthreads();
        for (int k = wave; k < K; k += NWAVES) {
            float v = G[lane * KP + k];
#pragma unroll
            for (int o = 1; o < 64; o <<= 1) { const float n = __shfl_up(v, o); if (lane >= o) v += n; }
            G[lane * KP + k] = v;
        }
        __syncthreads();
        for (int idx = tid; idx < 64 * K; idx += NTHREADS) {
            const int t = idx / K, k = idx % K, ck = h * K + k;
            const float b = G[t * KP + k];
            float q;
            if (LAYER == 0) q = bf2f(P[(size_t)(t0 + t) * NIN0P + 1792 + ck]) * 0.125f;
            else q = siluf(bf2f(P[(size_t)(t0 + t) * NIN1 + 512 + ck]));
            B.QT[(size_t)(t0 + t) * HK + ck] = f2bf(q * __expf(b));
            B.KT[(size_t)(t0 + t) * HK + ck] = f2bf(KR[t * KP + k] * __expf(-b));
        }
        for (int idx = tid; idx < 64 * K; idx += NTHREADS) {
            const int k = idx >> 6, t = idx & 63, ck = h * K + k;
            const float bl = G[63 * KP + k];
            B.KDT[((size_t)cg * HK + ck) * 64 + t] = f2bf(KR[t * KP + k] * __expf(bl - G[t * KP + k]));
            if (t == 0) B.DG[(size_t)cg * HK + ck] = __expf(bl);
        }
        for (int idx = tid; idx < 64 * 128; idx += NTHREADS) {
            const int vc = idx >> 6, t = idx & 63;
            B.VT[((size_t)cg * 512 + h * 128 + vc) * 64 + t] = f2bf(LV[t * 129 + vc]);
        }
        __syncthreads();
    }
}

template <int K>
__device__ __forceinline__ void gla_pass1_unit(const GlaBufs& B, int unit, int lane) {
    constexpr int HK = 4 * K, KT16 = K / 16;
    const int item = unit / KT16, kt = unit % KT16, cg = item >> 2, h = item & 3;
    const int r = lane & 15, q = lane >> 4;
    const bf16_t* ap = B.KDT + ((size_t)cg * HK + h * K + kt * 16 + r) * 64 + 8 * q;
    const bf16x8 a0 = *(const bf16x8*)ap, a1 = *(const bf16x8*)(ap + 32);
    float* dsp = B.DS + ((size_t)item * 128 + r) * K + kt * 16 + 4 * q;
#pragma unroll
    for (int vt = 0; vt < 8; ++vt) {
        const bf16_t* bp = B.VT + ((size_t)cg * 512 + h * 128 + vt * 16 + r) * 64 + 8 * q;
        const bf16x8 b0 = *(const bf16x8*)bp, b1 = *(const bf16x8*)(bp + 32);
        f32x4 acc = {0.f, 0.f, 0.f, 0.f};
        acc = __builtin_amdgcn_mfma_f32_16x16x32_bf16(a0, b0, acc, 0, 0, 0);
        acc = __builtin_amdgcn_mfma_f32_16x16x32_bf16(a1, b1, acc, 0, 0, 0);
        *(f32x4*)(dsp + (size_t)vt * 16 * K) = acc;
    }
}

template <int K>
__device__ __forceinline__ void gla_pass2(const GlaBufs& B, int gthread, int gthreads) {
    constexpr int HK = 4 * K;
    const float* __restrict__ DS = B.DS; const float* __restrict__ DG = B.DG; bf16_t* __restrict__ SP = B.SP;
    for (int e = gthread; e < 8 * 128 * K; e += gthreads) {
        const int k = e % K, v = (e / K) & 127, bh = e / (K * 128), b = bh >> 2, h = bh & 3;
        float S = 0.f;
#pragma unroll 8
        for (int c = 0; c < 128; ++c) {
            const int cg = b * 128 + c;
            const size_t idx = ((size_t)(cg * 4 + h) * 128 + v) * K + k;
            const float d = DG[(size_t)cg * HK + h * K + k], ds = DS[idx];
            SP[idx] = f2bf(S);
            S = d * S + ds;
        }
    }
}

template <int K, int LAYER>
__device__ __forceinline__ void gla_pass3_item(LAS unsigned char* lds, const bf16_t* P, const float* norm_g, const GlaBufs& B, bf16_t* Ymix, int item) {
    constexpr int HK = 4 * K, KS = K / 32;
    LAS bf16_t* Ls = (LAS bf16_t*)lds;
    LAS float* Lo = (LAS float*)(lds + 64 * 72 * 2);
    const int tid = TIDX, lane = tid & 63, wave = tid >> 6, r = lane & 15, q = lane >> 4;
    const int cg = item >> 2, h = item & 3, t0 = cg * 64;
    const int it = wave >> 1, i0 = it * 16;
    bf16x8 qf[KS];
#pragma unroll
    for (int s = 0; s < KS; ++s) qf[s] = *(const bf16x8*)(B.QT + (size_t)(t0 + i0 + r) * HK + h * K + 32 * s + 8 * q);
#pragma unroll
    for (int jj2 = 0; jj2 < 2; ++jj2) {
        const int j0 = ((wave & 1) * 2 + jj2) * 16;
        f32x4 acc = {0.f, 0.f, 0.f, 0.f};
        if (j0 <= i0) {
#pragma unroll
            for (int s = 0; s < KS; ++s) {
                const bf16x8 kf = *(const bf16x8*)(B.KT + (size_t)(t0 + j0 + r) * HK + h * K + 32 * s + 8 * q);
                acc = __builtin_amdgcn_mfma_f32_16x16x32_bf16(kf, qf[s], acc, 0, 0, 0);
            }
        }
        const int i = i0 + r;
        u32x2 w;
        w.x = pk2((j0 + 4 * q + 0) <= i ? acc[0] : 0.f, (j0 + 4 * q + 1) <= i ? acc[1] : 0.f);
        w.y = pk2((j0 + 4 * q + 2) <= i ? acc[2] : 0.f, (j0 + 4 * q + 3) <= i ? acc[3] : 0.f);
        *(LAS u32x2*)(Ls + i * 72 + j0 + 4 * q) = w;
    }
    __syncthreads();
    const bf16x8 sf0 = *(const LAS bf16x8*)(Ls + (i0 + r) * 72 + 8 * q), sf1 = *(const LAS bf16x8*)(Ls + (i0 + r) * 72 + 32 + 8 * q);
#pragma unroll
    for (int vv = 0; vv < 4; ++vv) {
        const int v0 = ((wave & 1) * 4 + vv) * 16;
        f32x4 acc = {0.f, 0.f, 0.f, 0.f};
#pragma unroll
        for (int s = 0; s < KS; ++s) {
            const bf16x8 sp = *(const bf16x8*)(B.SP + ((size_t)item * 128 + v0 + r) * K + 32 * s + 8 * q);
            acc = __builtin_amdgcn_mfma_f32_16x16x32_bf16(sp, qf[s], acc, 0, 0, 0);
        }
        const bf16_t* vp = B.VT + ((size_t)cg * 512 + h * 128 + v0 + r) * 64 + 8 * q;
        const bf16x8 vf0 = *(const bf16x8*)vp, vf1 = *(const bf16x8*)(vp + 32);
        acc = __builtin_amdgcn_mfma_f32_16x16x32_bf16(vf0, sf0, acc, 0, 0, 0);
        acc = __builtin_amdgcn_mfma_f32_16x16x32_bf16(vf1, sf1, acc, 0, 0, 0);
        *(LAS f32x4*)(Lo + (i0 + r) * 132 + v0 + 4 * q) = acc;
    }
    __syncthreads();
#pragma unroll 2
    for (int rr = 0; rr < 8; ++rr) {
        const int i = wave * 8 + rr, t = t0 + i;
        const float o0 = Lo[i * 132 + lane], o1 = Lo[i * 132 + 64 + lane];
        const float ms = wave_sum(o0 * o0 + o1 * o1) * (1.f / 128.f);
        const float rs = rsqrtf(ms + LN_EPS);
        float g0, g1;
        if (LAYER == 0) { g0 = bf2f(P[(size_t)t * NIN0P + 2832 + h * 128 + lane]); g1 = bf2f(P[(size_t)t * NIN0P + 2832 + h * 128 + 64 + lane]); }
        else { g0 = bf2f(P[(size_t)t * NIN1 + 2048 + h * 128 + lane]); g1 = bf2f(P[(size_t)t * NIN1 + 2048 + h * 128 + 64 + lane]); }
        Ymix[(size_t)t * D_ + 512 + h * 128 + lane] = f2bf(o0 * rs * norm_g[lane] * siluf(g0));
        Ymix[(size_t)t * D_ + 512 + h * 128 + 64 + lane] = f2bf(o1 * rs * norm_g[64 + lane] * siluf(g1));
    }
    __syncthreads();
}


template <int CTRL> __device__ __forceinline__ float dppf(float x) { return __builtin_bit_cast(float, __builtin_amdgcn_mov_dpp(__builtin_bit_cast(int, x), CTRL, 0xf, 0xf, true)); }
__device__ __forceinline__ float reduce32(float x) {
    x += dppf<0xB1>(x);
    x += dppf<0x4E>(x);
    x += dppf<0x141>(x);
    x += dppf<0x140>(x);
    auto sw = __builtin_amdgcn_permlane16_swap(__float_as_uint(x), __float_as_uint(x), false, false);
    return __uint_as_float(sw[0]) + __uint_as_float(sw[1]);
}
__device__ __forceinline__ void rwkv_scan_v1(LAS float* lds, const bf16_t* SC, float* YRW, int unit) {
    constexpr int TS = 32, TILE = 5 * TS * 64 + TS * 16;
    const int bh = unit >> 3, qr = unit & 7, b = bh >> 3, h = bh & 7;
    const int tid = TIDX, lane = tid & 63, wave = tid >> 6, cp = lane & 31, rl = (wave & 3) * 2 + (lane >> 5);
    const size_t S1 = (size_t)T_ * 512;
    const int chunk = tid & 255, ls = chunk >> 3, lc0 = (chunk & 7) * 8, half = tid >> 8;
    const bf16_t* g0 = SC + (half == 0 ? 0 : 4 * S1) + (size_t)(b * L_ + ls) * 512 + h * 64 + lc0;
    const bf16_t* g1 = SC + (half == 0 ? 1 * S1 : 5 * S1) + (size_t)(b * L_ + ls) * 512 + h * 64 + lc0;
    const bf16_t* g2 = (half == 0) ? SC + 2 * S1 + (size_t)(b * L_ + ls) * 512 + h * 64 + lc0
                                   : SC + 3 * S1 + (size_t)(b * L_ + ls) * 512 + h * 64 + qr * 8;
    u32x4 p0, p1, p2;
    p0 = *(const u32x4*)g0; p1 = *(const u32x4*)g1; p2 = *(const u32x4*)g2;
    float S0 = 0.f, S1v = 0.f;
    auto unpack8 = [](const u32x4 v, float* f) {
        f[0] = __uint_as_float(v.x << 16); f[1] = __uint_as_float(v.x & 0xffff0000u); f[2] = __uint_as_float(v.y << 16); f[3] = __uint_as_float(v.y & 0xffff0000u);
        f[4] = __uint_as_float(v.z << 16); f[5] = __uint_as_float(v.z & 0xffff0000u); f[6] = __uint_as_float(v.w << 16); f[7] = __uint_as_float(v.w & 0xffff0000u); };
    auto stage = [&](LAS float* buf) {
        float f0[8], f1[8], f2[8];
        unpack8(p0, f0); unpack8(p1, f1); unpack8(p2, f2);
        if (half == 0) {
#pragma unroll
            for (int j = 0; j < 8; ++j) { buf[(4 * TS + ls) * 64 + lc0 + j] = f0[j]; buf[(1 * TS + ls) * 64 + lc0 + j] = __expf(f1[j]); buf[(3 * TS + ls) * 64 + lc0 + j] = f2[j]; }
        } else {
#pragma unroll
            for (int j = 0; j < 8; ++j) { buf[(0 * TS + ls) * 64 + lc0 + j] = -f0[j]; buf[(2 * TS + ls) * 64 + lc0 + j] = f0[j] * f1[j]; }
            if ((chunk & 7) == 0) {
#pragma unroll
                for (int j = 0; j < 8; ++j) buf[5 * TS * 64 + ls * 16 + j] = f2[j];
            }
        }
    };
    stage(lds);
    __syncthreads();
    for (int t0 = 0; t0 < L_; t0 += TS) {
        LAS float* cur = lds + ((t0 / TS) & 1) * TILE;
        LAS float* nxt = lds + (((t0 / TS) & 1) ^ 1) * TILE;
        const bool more = (t0 + TS) < L_;
        if (more) { const size_t adv = (size_t)(t0 + TS) * 512; p0 = *(const u32x4*)(g0 + adv); p1 = *(const u32x4*)(g1 + adv); p2 = *(const u32x4*)(g2 + adv); }
        float* yout = YRW + (size_t)(b * L_ + t0) * 512 + h * 64 + qr * 8 + rl;
        if (wave < 4) {
        typedef float f32x2v __attribute__((ext_vector_type(2)));
        f32x2v a2 = *(const LAS f32x2v*)(cur + (0 * TS) * 64 + 2 * cp), w2 = *(const LAS f32x2v*)(cur + (1 * TS) * 64 + 2 * cp), b2 = *(const LAS f32x2v*)(cur + (2 * TS) * 64 + 2 * cp),
               k2 = *(const LAS f32x2v*)(cur + (3 * TS) * 64 + 2 * cp), r2 = *(const LAS f32x2v*)(cur + (4 * TS) * 64 + 2 * cp);
        float vv = cur[5 * TS * 64 + rl];
        float ysel = 0.f;
#pragma unroll
        for (int s = 0; s < TS; ++s) {
            const int sn = (s + 1) & (TS - 1);
            const f32x2v a2n = *(const LAS f32x2v*)(cur + (0 * TS + sn) * 64 + 2 * cp), w2n = *(const LAS f32x2v*)(cur + (1 * TS + sn) * 64 + 2 * cp),
                         b2n = *(const LAS f32x2v*)(cur + (2 * TS + sn) * 64 + 2 * cp), k2n = *(const LAS f32x2v*)(cur + (3 * TS + sn) * 64 + 2 * cp),
                         r2n = *(const LAS f32x2v*)(cur + (4 * TS + sn) * 64 + 2 * cp);
            const float vvn = cur[5 * TS * 64 + sn * 16 + rl];
            const float sa = reduce32(S0 * a2.x + S1v * a2.y);
            S0 = S0 * w2.x + (sa * b2.x + vv * k2.x);
            S1v = S1v * w2.y + (sa * b2.y + vv * k2.y);
            const float y = reduce32(S0 * r2.x + S1v * r2.y);
            ysel = (cp == s) ? y : ysel;
            a2 = a2n; w2 = w2n; b2 = b2n; k2 = k2n; r2 = r2n; vv = vvn;
        }
        yout[(size_t)cp * 512] = ysel;
        }
        if (more) stage(nxt);
        __syncthreads();
    }
}

__device__ __forceinline__ void sub_barrier(unsigned* ctr, unsigned nblocks) {
    asm volatile("s_waitcnt vmcnt(0)" ::: "memory");
    __syncthreads();
    if (TIDX == 0) {
        __builtin_amdgcn_fence(__ATOMIC_RELEASE, "agent");
        asm volatile("s_waitcnt vmcnt(0)" ::: "memory");
        xb_add(ctr, 1u);
        unsigned sp = 0;
        while (xb_ld(ctr) < nblocks) { __builtin_amdgcn_s_sleep(2); if (++sp > (1u << 22)) break; }
        __builtin_amdgcn_fence(__ATOMIC_ACQUIRE, "agent");
        asm volatile("s_waitcnt vmcnt(0)" ::: "memory");
    }
    __syncthreads();
}


__device__ __forceinline__ void s5_tables(LAS float* lds, const float* a_re, const float* a_im, const float* log_dt, const float* b_re, const float* b_im,
                                          const float* c_re, const float* c_im, bf16_t* MB, bf16_t* WE, int g) {
    LAS float* pwr = lds;
    LAS float* pwi = pwr + 33 * 64;
    LAS float* zbr = pwi + 33 * 64;
    LAS float* zbi = zbr + 1024;
    LAS float* cr = zbi + 1024;
    LAS float* ci = cr + 1024;
    LAS float* kern = ci + 1024;
    const int tid = TIDX;
    if (tid < 64) {
        const int n = tid;
        const float lam_re = fminf(a_re[g * 64 + n], -1e-4f), lam_im = a_im[g * 64 + n];
        const float dt = __expf(log_dt[g]);
        const float mag = __expf(lam_re * dt);
        const float ab_re = mag * cosf(lam_im * dt), ab_im = mag * sinf(lam_im * dt);
        const float den = lam_re * lam_re + lam_im * lam_im;
        const float num_re = ab_re - 1.f;
        const float z_re = (num_re * lam_re + ab_im * lam_im) / den;
        const float z_im = (ab_im * lam_re - num_re * lam_im) / den;
        for (int tau = 0; tau <= 32; ++tau) {
            const float m = __expf(lam_re * dt * (float)tau), ang = lam_im * dt * (float)tau;
            pwr[tau * 64 + n] = m * cosf(ang); pwi[tau * 64 + n] = m * sinf(ang);
        }
        for (int c = 0; c < 16; ++c) {
            const float br = b_re[(size_t)(g * 64 + n) * 16 + c], bi = b_im[(size_t)(g * 64 + n) * 16 + c];
            zbr[n * 16 + c] = z_re * br - z_im * bi; zbi[n * 16 + c] = z_re * bi + z_im * br;
        }
    }
    for (int idx = tid; idx < 1024; idx += NTHREADS) { cr[idx] = c_re[(size_t)g * 1024 + idx]; ci[idx] = c_im[(size_t)g * 1024 + idx]; }
    __syncthreads();
    for (int idx = tid; idx < 32 * 256; idx += NTHREADS) {
        const int tau = idx >> 8, c = (idx >> 4) & 15, cp = idx & 15;
        float acc = 0.f;
        for (int n = 0; n < 64; ++n) {
            const float pr = pwr[tau * 64 + n], pi = pwi[tau * 64 + n], zr = zbr[n * 16 + cp], zi = zbi[n * 16 + cp];
            const float wr = pr * zr - pi * zi, wi = pr * zi + pi * zr;
            acc += cr[c * 64 + n] * wr - ci[c * 64 + n] * wi;
        }
        kern[idx] = acc;
    }
    __syncthreads();
    for (int idx = tid; idx < 512 * 640; idx += NTHREADS) {
        const int row = idx / 640, col = idx % 640, i = row >> 4, c = row & 15;
        float v;
        if (col < 512) { const int j = col >> 4, cp = col & 15; v = (j <= i) ? kern[((i - j) * 16 + c) * 16 + cp] : 0.f; }
        else if (col < 576) { const int n = col - 512; v = cr[c * 64 + n] * pwr[(i + 1) * 64 + n] - ci[c * 64 + n] * pwi[(i + 1) * 64 + n]; }
        else { const int n = col - 576; v = -(cr[c * 64 + n] * pwi[(i + 1) * 64 + n] + ci[c * 64 + n] * pwr[(i + 1) * 64 + n]); }
        MB[((size_t)g * 512 + row) * 640 + col] = f2bf(v);
    }
    for (int idx = tid; idx < 256 * 512; idx += NTHREADS) {
        const int np = idx >> 9, col = idx & 511;
        float v = 0.f;
        if (np < 128) {
            const int n = np & 63, j = col >> 4, cp = col & 15;
            const float pr = pwr[(31 - j) * 64 + n], pi = pwi[(31 - j) * 64 + n], zr = zbr[n * 16 + cp], zi = zbi[n * 16 + cp];
            v = np < 64 ? (pr * zr - pi * zi) : (pr * zi + pi * zr);
        }
        WE[((size_t)g * 256 + np) * 512 + col] = f2bf(v);
    }
    __syncthreads();
}
__device__ __forceinline__ void s5_fill_ua(const bf16_t* P1, bf16_t* UA, int gw, int ngw, int lane) {
    for (int t = gw; t < T_; t += ngw) {
        const int b = t >> 13, tt = t & 8191, c32 = tt >> 5, j = tt & 31, g = lane >> 1, c0 = (lane & 1) * 8;
        const u32x4 v = *(const u32x4*)(P1 + (size_t)t * NIN1 + 8 * lane);
        *(u32x4*)(UA + ((size_t)g * 512 + b * 256 + c32) * 640 + j * 16 + c0) = v;
    }
}
__device__ __forceinline__ void s5_carry(const float* a_re, const float* a_im, const float* log_dt, const float* E, bf16_t* UA, int th) {
    const int n = th & 63, g = (th >> 6) & 31, b = th >> 11;
    const float lam_re = fminf(a_re[g * 64 + n], -1e-4f), lam_im = a_im[g * 64 + n];
    const float dt = __expf(log_dt[g]);
    const float m = __expf(lam_re * dt * 32.f), ang = lam_im * dt * 32.f;
    const float ar = m * cosf(ang), ai = m * sinf(ang);
    float hr = 0.f, hi = 0.f;
#pragma unroll 8
    for (int c = 0; c < 256; ++c) {
        const size_t row = (size_t)g * 512 + b * 256 + c;
        const float er = E[row * 256 + n], ei = E[row * 256 + 64 + n];
        UA[row * 640 + 512 + n] = f2bf(hr); UA[row * 640 + 576 + n] = f2bf(hi);
        const float nr = ar * hr - ai * hi + er, ni = ar * hi + ai * hr + ei;
        hr = nr; hi = ni;
    }
}

struct Args {
    const float* in[42];
    float* out;
    unsigned char* ws;
    int ph_lo, ph_hi;
};

template <bool DUAL, class AF, class WF, class EF>
__device__ __forceinline__ void naive_gemm(LAS float* lds, int M, int N, int K, AF arow, WF wbase, int ldw, EF epi) {
    LAS float* As = lds;
    LAS float* Bs = lds + 64 * 33;
    LAS float* Bs2 = Bs + 32 * 64;
    const int tid = TIDX, ty = tid >> 4, tx = tid & 15;
    const int tm = (M + 63) / 64, tn = (N + 63) / 64;
    for (int tile = blockIdx.x; tile < tm * tn; tile += gridDim.x) {
        const int m0 = (tile / tn) * 64, n0 = (tile % tn) * 64;
        const float* W = wbase(m0, 0);
        const float* W2 = DUAL ? wbase(m0, 1) : W;
        float acc[2][4], acc2[2][4];
#pragma unroll
        for (int i = 0; i < 2; ++i)
#pragma unroll
            for (int j = 0; j < 4; ++j) { acc[i][j] = 0.f; acc2[i][j] = 0.f; }
        for (int k0 = 0; k0 < K; k0 += 32) {
#pragma unroll
            for (int i = 0; i < 4; ++i) {
                const int idx = tid + i * 512, r = idx >> 5, kk = idx & 31, m = m0 + r;
                As[r * 33 + kk] = (m < M) ? bf2f(arow(m)[k0 + kk]) : 0.f;
            }
#pragma unroll
            for (int i = 0; i < 4; ++i) {
                const int idx = tid + i * 512, kk = idx >> 6, n = idx & 63;
                const bool ok = (n0 + n) < N;
                Bs[kk * 64 + n] = ok ? W[(size_t)(k0 + kk) * ldw + n0 + n] : 0.f;
                if (DUAL) Bs2[kk * 64 + n] = ok ? W2[(size_t)(k0 + kk) * ldw + n0 + n] : 0.f;
            }
            __syncthreads();
#pragma unroll 8
            for (int kk = 0; kk < 32; ++kk) {
                const float a0 = As[(ty * 2) * 33 + kk], a1 = As[(ty * 2 + 1) * 33 + kk];
#pragma unroll
                for (int j = 0; j < 4; ++j) {
                    const float b = Bs[kk * 64 + tx * 4 + j];
                    acc[0][j] += a0 * b; acc[1][j] += a1 * b;
                    if (DUAL) { const float b2 = Bs2[kk * 64 + tx * 4 + j]; acc2[0][j] += a0 * b2; acc2[1][j] += a1 * b2; }
                }
            }
            __syncthreads();
        }
#pragma unroll
        for (int i = 0; i < 2; ++i)
#pragma unroll
            for (int j = 0; j < 4; ++j) {
                const int m = m0 + ty * 2 + i, n = n0 + tx * 4 + j;
                if (m < M && n < N) epi(m, n, acc[i][j], acc2[i][j]);
            }
    }
}

template <class SRC, class DROW>
__device__ __forceinline__ void xpose_item(SRC src, DROW drow, bf16_t* WT, int ldk, LAS float* scr, int k0, int n0, int lane) {
#pragma unroll 8
    for (int i = 0; i < 32; ++i) { const int kk = 2 * i + (lane >> 5); scr[kk * 33 + (lane & 31)] = src(k0 + kk, n0 + (lane & 31)); }
    asm volatile("s_waitcnt lgkmcnt(0)" ::: "memory");
    const int c = lane & 7;
#pragma unroll
    for (int j = 0; j < 4; ++j) {
        const int n = (lane >> 3) + 8 * j; const LAS float* sp = scr + (8 * c) * 33 + n;
        u32x4 o; o.x = pk2(sp[0 * 33], sp[1 * 33]); o.y = pk2(sp[2 * 33], sp[3 * 33]); o.z = pk2(sp[4 * 33], sp[5 * 33]); o.w = pk2(sp[6 * 33], sp[7 * 33]);
        *(u32x4*)(WT + (size_t)drow(n0 + n) * ldk + k0 + 8 * c) = o;
    }
    asm volatile("s_waitcnt lgkmcnt(0)" ::: "memory");
}
__device__ __forceinline__ void convert_plain(const float* W, int K, int N, int NP, bf16_t* WT, LAS float* scr, int gw, int ngw, int lane) {
    const int nblk = NP / 32, nitems = (K / 64) * nblk;
    for (int it = gw; it < nitems; it += ngw) {
        const int k0 = 64 * (it / nblk), n0 = 32 * (it % nblk);
        xpose_item([&](int k, int n) { return n < N ? W[(size_t)k * N + n] : 0.f; }, [&](int n) { return n; }, WT, K, scr, k0, n0, lane);
    }
}
__device__ __forceinline__ void convert_lora(const float* w2, const float* a2, const float* g2, bf16_t* WT, LAS float* scr, int gw, int ngw, int lane) {
    const int nblk = NLORA / 32, nitems = 4 * nblk;
    for (int it = gw; it < nitems; it += ngw) {
        const int k0 = 64 * (it / nblk), n0 = 32 * (it % nblk);
        xpose_item([&](int k, int n) {
            if (n < 512) return k < 64 ? w2[k * 512 + n] : 0.f;
            if (n < 1024) return (k >= 64 && k < 128) ? a2[(k - 64) * 512 + (n - 512)] : 0.f;
            return k >= 128 ? g2[(k - 128) * 512 + (n - 1024)] : 0.f; }, [&](int n) { return n; }, WT, 256, scr, k0, n0, lane);
    }
}
__device__ __forceinline__ void convert_moe(const float* w1, const float* w3, const float* w2, bf16_t* W13, bf16_t* W2T, LAS float* scr, int gw, int ngw, int lane) {
    constexpr int I13 = 16 * 32, I2 = 8 * 32, IE = I13 + I2;
    for (int it = gw; it < 32 * IE; it += ngw) {
        const int e = it / IE, r = it % IE;
        if (r < I13) {
            const int k0 = 64 * (r / 32), n0 = 32 * (r % 32);
            const float* a = w1 + (size_t)e * D_ * 512; const float* b = w3 + (size_t)e * D_ * 512;
            xpose_item([&](int k, int n) { return n < 512 ? a[(size_t)k * 512 + n] : b[(size_t)k * 512 + (n - 512)]; },
                       [&](int n) { const int c = n & 511; return (c >> 2) * 8 + (n >> 9) * 4 + (c & 3); }, W13 + (size_t)e * 1024 * 1024, 1024, scr, k0, n0, lane);
        } else {
            const int rr = r - I13, k0 = 64 * (rr / 32), n0 = 32 * (rr % 32);
            const float* a = w2 + (size_t)e * 512 * D_;
            xpose_item([&](int k, int n) { return a[(size_t)k * D_ + n]; }, [&](int n) { return n; }, W2T + (size_t)e * 1024 * 512, 512, scr, k0, n0, lane);
        }
    }
}

__device__ __forceinline__ void ph_prologue(const float* x, bf16_t* hb) {
    const size_t n4 = (size_t)T_ * D_ / 4;
    for (size_t i = (size_t)blockIdx.x * NTHREADS + TIDX; i < n4; i += (size_t)gridDim.x * NTHREADS) {
        const f32x4 v = ((const f32x4*)x)[i];
        u32x2 o; o.x = pk2(v.x, v.y); o.y = pk2(v.z, v.w);
        ((u32x2*)hb)[i] = o;
    }
    for (size_t i = (size_t)blockIdx.x * NTHREADS + TIDX; i < (size_t)256 * D_ / 2; i += (size_t)gridDim.x * NTHREADS)
        ((unsigned*)(hb + (size_t)T_ * D_))[i] = 0u;
}

__device__ __forceinline__ float p0_shift(const bf16_t* P, const float* mu, int t, int c) {
    const float p = bf2f(P[(size_t)t * NIN0P + c]);
    const float pv = ((t & (L_ - 1)) == 0) ? 0.f : bf2f(P[(size_t)(t - 1) * NIN0P + c]);
    return p + mu[c] * (pv - p);
}
template <bool WITH_GLA>
__device__ __forceinline__ void ph_prepA0(const bf16_t* P, const float* mu, const float* gk_w2, const float* gk_b, bf16_t* Ap, float* gla_la) {
    for (int chunk = blockIdx.x; chunk < T_ / 64; chunk += gridDim.x) {
        for (int idx = TIDX; idx < 64 * 256; idx += NTHREADS) {
            const int tl = idx >> 8, j = idx & 255, t = chunk * 64 + tl;
            float v;
            if (j < 64) v = tanhf(p0_shift(P, mu, t, 512 + j));
            else if (j < 128) v = p0_shift(P, mu, t, 1600 + (j - 64));
            else v = sigm(p0_shift(P, mu, t, 1664 + (j - 128)));
            Ap[(size_t)t * 256 + j] = f2bf(v);
            if (WITH_GLA) {
                float gk = gk_b[j];
#pragma unroll
                for (int i = 0; i < 16; ++i) gk += bf2f(P[(size_t)t * NIN0P + 2816 + i]) * gk_w2[i * 256 + j];
                const float ls = fminf(gk, 0.f) - log1pf(__expf(-fabsf(gk)));
                gla_la[(size_t)t * 256 + j] = ls * (1.f / 16.f);
            }
        }
    }
}

__device__ __forceinline__ void ph_prepB0(const bf16_t* P, const bf16_t* LO, const float* mu, const float* w0, const float* a0, const float* k_k, const float* k_a,
                                          const float* r_k, bf16_t* SC, float* BON) {
    const int wave = TIDX >> 6, lane = TIDX & 63;
    for (int item = blockIdx.x * NWAVES + wave; item < T_ * 8; item += gridDim.x * NWAVES) {
        const int t = item >> 3, h = item & 7, c = h * 64 + lane;
        const float r = p0_shift(P, mu, t, c), k = p0_shift(P, mu, t, 576 + c), v = p0_shift(P, mu, t, 1088 + c);
        const float low = bf2f(LO[(size_t)t * 512 + c]), loa = bf2f(LO[(size_t)T_ * 512 + (size_t)t * 512 + c]);
        const float xw = w0[c] + low;
        const float wraw = -softplusf(-xw) - 0.5f;
        const float ld = -__expf(wraw);
        const float a = sigm(a0[c] + loa);
        const float kkr = k * k_k[c];
        const float ss = wave_sum(kkr * kkr);
        const float kk = kkr / fmaxf(sqrtf(ss), 1e-12f);
        const float kp = k * (1.f + (a - 1.f) * k_a[c]);
        const float bon = wave_sum(r * kp * r_k[c]);
        const size_t o = (size_t)t * 512 + c, S1 = (size_t)T_ * 512;
        SC[o] = f2bf(r); SC[S1 + o] = f2bf(ld); SC[2 * S1 + o] = f2bf(kp); SC[3 * S1 + o] = f2bf(v); SC[4 * S1 + o] = f2bf(kk); SC[5 * S1 + o] = f2bf(a);
        if (lane == 0) BON[(size_t)t * 8 + h] = bon;
    }
}

__device__ __forceinline__ void naive_rwkv_scan(LAS float* lds, const bf16_t* SC, float* YRW, int bh) {
    constexpr int TS = 32;
    const int b = bh >> 3, h = bh & 7;
    LAS float* Lnkk = lds;
    LAS float* Ldec = lds + TS * 64;
    LAS float* Lab = lds + 2 * TS * 64;
    LAS float* Lkp = lds + 3 * TS * 64;
    LAS float* Lr = lds + 4 * TS * 64;
    LAS float* Lv = lds + 5 * TS * 64;
    const size_t S1 = (size_t)T_ * 512;
    float S[64];
#pragma unroll
    for (int k = 0; k < 64; ++k) S[k] = 0.f;
    const int lane = TIDX & 63, wave = TIDX >> 6;
    for (int t0 = 0; t0 < L_; t0 += TS) {
        for (int idx = TIDX; idx < TS * 64; idx += NTHREADS) {
            const int s = idx >> 6, k = idx & 63;
            const size_t o = (size_t)(b * L_ + t0 + s) * 512 + h * 64 + k;
            const float r = bf2f(SC[o]), ld = bf2f(SC[S1 + o]), kp = bf2f(SC[2 * S1 + o]), v = bf2f(SC[3 * S1 + o]), kk = bf2f(SC[4 * S1 + o]), a = bf2f(SC[5 * S1 + o]);
            Lnkk[idx] = -kk; Ldec[idx] = __expf(ld); Lab[idx] = kk * a; Lkp[idx] = kp; Lr[idx] = r; Lv[idx] = v;
        }
        __syncthreads();
        if (wave == 0) {
            for (int s = 0; s < TS; ++s) {
                float sa = 0.f;
#pragma unroll
                for (int k = 0; k < 64; ++k) sa += S[k] * Lnkk[s * 64 + k];
                const float vv = Lv[s * 64 + lane];
                float y = 0.f;
#pragma unroll
                for (int k = 0; k < 64; ++k) {
                    S[k] = S[k] * Ldec[s * 64 + k] + sa * Lab[s * 64 + k] + vv * Lkp[s * 64 + k];
                    y += S[k] * Lr[s * 64 + k];
                }
                YRW[(size_t)(b * L_ + t0 + s) * 512 + h * 64 + lane] = y;
            }
        }
        __syncthreads();
    }
}

template <int K, class LDF, class LVF>
__device__ __forceinline__ void naive_gla_scan(LAS float* lds, LDF ld, LVF lv, float* OG, int b, int h) {
    constexpr int TS = 16;
    LAS float* Lq = lds;
    LAS float* Lk = lds + TS * K;
    LAS float* Le = lds + 2 * TS * K;
    LAS float* Lv = lds + 3 * TS * K;
    float S[K];
#pragma unroll
    for (int k = 0; k < K; ++k) S[k] = 0.f;
    const int tid = TIDX;
    for (int t0 = 0; t0 < L_; t0 += TS) {
        for (int idx = tid; idx < TS * K; idx += NTHREADS) {
            const int s = idx / K, k = idx % K;
            float q, kk, e; ld(b * L_ + t0 + s, h * K + k, q, kk, e);
            Lq[idx] = q; Lk[idx] = kk; Le[idx] = e;
        }
        for (int idx = tid; idx < TS * 128; idx += NTHREADS) {
            const int s = idx >> 7, vc = idx & 127;
            Lv[idx] = lv(b * L_ + t0 + s, h * 128 + vc);
        }
        __syncthreads();
        if (tid < 128) {
            for (int s = 0; s < TS; ++s) {
                const float vv = Lv[s * 128 + tid];
                float o = 0.f;
#pragma unroll
                for (int k = 0; k < K; ++k) {
                    S[k] = S[k] * Le[s * K + k] + Lk[s * K + k] * vv;
                    o += Lq[s * K + k] * S[k];
                }
                OG[(size_t)(b * L_ + t0 + s) * 512 + h * 128 + tid] = o;
            }
        }
        __syncthreads();
    }
}

template <bool WITH_GLA>
__device__ __forceinline__ void ph_fin0(const float* YRW, const float* OG, const bf16_t* P, const bf16_t* LO, const bf16_t* SC, const float* BON,
                                        const float* gn_g, const float* gn_b, const float* norm_g, bf16_t* Ymix) {
    const int wave = TIDX >> 6, lane = TIDX & 63;
    const size_t S1 = (size_t)T_ * 512;
    constexpr int NU = WITH_GLA ? 12 : 8;
    for (int item = blockIdx.x * NWAVES + wave; item < T_ * NU; item += gridDim.x * NWAVES) {
        const int t = item / NU, u = item % NU;
        if (u < 8) {
            const int c = u * 64 + lane;
            const float y = YRW[(size_t)t * 512 + c];
            const float mean = wave_sum(y) * (1.f / 64.f);
            const float d = y - mean;
            const float var = wave_sum(d * d) * (1.f / 64.f);
            const float yn = d * rsqrtf(var + 64e-5f) * gn_g[c] + gn_b[c];
            const float v = bf2f(SC[3 * S1 + (size_t)t * 512 + c]);
            const float g = bf2f(LO[(size_t)2 * T_ * 512 + (size_t)t * 512 + c]);
            Ymix[(size_t)t * D_ + c] = f2bf((yn + BON[(size_t)t * 8 + u] * v) * g);
        } else {
            const int h = u - 8;
            const float o0 = OG[(size_t)t * 512 + h * 128 + lane], o1 = OG[(size_t)t * 512 + h * 128 + 64 + lane];
            const float ms = wave_sum(o0 * o0 + o1 * o1) * (1.f / 128.f);
            const float rs = rsqrtf(ms + LN_EPS);
            const float g0 = bf2f(P[(size_t)t * NIN0P + 2832 + h * 128 + lane]), g1 = bf2f(P[(size_t)t * NIN0P + 2832 + h * 128 + 64 + lane]);
            Ymix[(size_t)t * D_ + 512 + h * 128 + lane] = f2bf(o0 * rs * norm_g[lane] * siluf(g0));
            Ymix[(size_t)t * D_ + 512 + h * 128 + 64 + lane] = f2bf(o1 * rs * norm_g[64 + lane] * siluf(g1));
        }
    }
}

__device__ __forceinline__ void ph_ln_router(const float* src, float* hf, bf16_t* hb, const float* lg, const float* lb, const float* wg, const float* bg,
                                             const float* we, const float* be, int* tok_e, int* tok_slot, float* tok_g, unsigned* cnt) {
    const int wave = TIDX >> 6, lane = TIDX & 63;
    for (int t = blockIdx.x * NWAVES + wave; t < T_; t += gridDim.x * NWAVES) {
        const f32x4* xr = (const f32x4*)(src + (size_t)t * D_) + lane;
        f32x4 v[4]; float s = 0.f;
#pragma unroll
        for (int j = 0; j < 4; ++j) { v[j] = xr[64 * j]; s += (v[j].x + v[j].y) + (v[j].z + v[j].w); }
        const float mean = wave_sum(s) * (1.f / D_);
        float s2 = 0.f;
#pragma unroll
        for (int j = 0; j < 4; ++j) { v[j] = v[j] - mean; s2 += (v[j].x * v[j].x + v[j].y * v[j].y) + (v[j].z * v[j].z + v[j].w * v[j].w); }
        const float rstd = rsqrtf(wave_sum(s2) * (1.f / D_) + LN_EPS);
#pragma unroll
        for (int j = 0; j < 4; ++j) {
            const f32x4 g = ((const f32x4*)lg)[lane + 64 * j], bb = ((const f32x4*)lb)[lane + 64 * j];
            v[j] = v[j] * rstd * g + bb;
            ((f32x4*)(hf + (size_t)t * D_))[lane + 64 * j] = v[j];
            u32x2 o; o.x = pk2(v[j].x, v[j].y); o.y = pk2(v[j].z, v[j].w);
            ((u32x2*)(hb + (size_t)t * D_))[lane + 64 * j] = o;
        }
        float cl[4] = {0.f, 0.f, 0.f, 0.f};
#pragma unroll
        for (int j = 0; j < 4; ++j)
#pragma unroll
            for (int e = 0; e < 4; ++e) {
                const int d = 4 * (lane + 64 * j) + e;
                const f32x4 w = *(const f32x4*)(wg + (size_t)d * 4);
                const float xv = v[j][e];
                cl[0] += xv * w.x; cl[1] += xv * w.y; cl[2] += xv * w.z; cl[3] += xv * w.w;
            }
#pragma unroll
        for (int g = 0; g < 4; ++g) cl[g] = wave_sum(cl[g]) + bg[g];
        int grp = 0; float mx = cl[0];
#pragma unroll
        for (int g = 1; g < 4; ++g) if (cl[g] > mx) { mx = cl[g]; grp = g; }
        float den = 0.f;
#pragma unroll
        for (int g = 0; g < 4; ++g) den += __expf(cl[g] - mx);
        const float p_grp = 1.f / den;
        float fl[8];
#pragma unroll
        for (int e = 0; e < 8; ++e) fl[e] = 0.f;
        const float* weg = we + (size_t)grp * D_ * 8;
#pragma unroll
        for (int j = 0; j < 4; ++j)
#pragma unroll
            for (int e = 0; e < 4; ++e) {
                const int d = 4 * (lane + 64 * j) + e;
                const f32x4 w0 = *(const f32x4*)(weg + (size_t)d * 8), w1 = *(const f32x4*)(weg + (size_t)d * 8 + 4);
                const float xv = v[j][e];
                fl[0] += xv * w0.x; fl[1] += xv * w0.y; fl[2] += xv * w0.z; fl[3] += xv * w0.w;
                fl[4] += xv * w1.x; fl[5] += xv * w1.y; fl[6] += xv * w1.z; fl[7] += xv * w1.w;
            }
#pragma unroll
        for (int e = 0; e < 8; ++e) fl[e] = wave_sum(fl[e]) + be[grp * 8 + e];
        int j0 = 0; float m0 = fl[0];
#pragma unroll
        for (int e = 1; e < 8; ++e) if (fl[e] > m0) { m0 = fl[e]; j0 = e; }
        int j1 = -1; float m1 = -3.0e38f;
#pragma unroll
        for (int e = 0; e < 8; ++e) if (e != j0 && fl[e] > m1) { m1 = fl[e]; j1 = e; }
        const float e1 = __expf(m1 - m0);
        const float g0 = p_grp / (1.f + e1), g1 = p_grp * e1 / (1.f + e1);
        if (lane == 0) {
            const int ex0 = grp * 8 + j0, ex1 = grp * 8 + j1;
            const unsigned s0 = atomicAdd(&cnt[ex0], 1u), s1 = atomicAdd(&cnt[ex1], 1u);
            tok_e[2 * t] = ex0; tok_e[2 * t + 1] = ex1;
            tok_slot[2 * t] = (int)s0; tok_slot[2 * t + 1] = (int)s1;
            tok_g[2 * t] = g0; tok_g[2 * t + 1] = g1;
        }
    }
}

__device__ __forceinline__ void moe_offsets(LAS int* pst, const unsigned* cnt) {
    if (TIDX == 0) {
        int acc = 0;
        for (int e = 0; e < 32; ++e) { pst[e] = acc; const int c = (int)cnt[e]; acc += (c + MOE_PAD - 1) / MOE_PAD * MOE_PAD; }
        pst[32] = acc;
    }
    __syncthreads();
}
__device__ __forceinline__ int moe_expert_of_row(const LAS int* pst, int r) {
    int e = 0;
#pragma unroll 1
    for (int i = 1; i < 32; ++i) if (r >= pst[i]) e = i;
    return e;
}

__device__ __forceinline__ void ph_dispatch(LAS int* pst, const unsigned* cnt, const bf16_t* hb, const int* tok_e, const int* tok_slot, int* tok_dest, bf16_t* XR) {
    moe_offsets(pst, cnt);
    const int wave = TIDX >> 6, lane = TIDX & 63;
    for (int item = blockIdx.x * NWAVES + wave; item < T_ * 2; item += gridDim.x * NWAVES) {
        const int t = item >> 1;
        const int e = tok_e[item], dest = pst[e] + tok_slot[item];
        if (lane == 0) tok_dest[item] = dest;
        const u32x4* src = (const u32x4*)(hb + (size_t)t * D_);
        u32x4* dst = (u32x4*)(XR + (size_t)dest * D_);
        dst[lane] = src[lane]; dst[lane + 64] = src[lane + 64];
    }
    const int R = pst[32];
    for (int r = blockIdx.x * NWAVES + wave; r < R; r += gridDim.x * NWAVES) {
        const int e = moe_expert_of_row(pst, r);
        if (r - pst[e] >= (int)cnt[e]) {
            u32x4* dst = (u32x4*)(XR + (size_t)r * D_);
            const u32x4 z = {0u, 0u, 0u, 0u};
            dst[lane] = z; dst[lane + 64] = z;
        }
    }
}

__device__ __forceinline__ void ph_combine_ln(const float* hf, const bf16_t* Y, const int* tok_dest, const float* tok_g, const float* lg, const float* lb, float* outf, bf16_t* hb) {
    const int wave = TIDX >> 6, lane = TIDX & 63;
    for (int t = blockIdx.x * NWAVES + wave; t < T_; t += gridDim.x * NWAVES) {
        const int d0 = tok_dest[2 * t], d1 = tok_dest[2 * t + 1];
        const float g0 = tok_g[2 * t], g1 = tok_g[2 * t + 1];
        f32x4 v[4]; float s = 0.f;
#pragma unroll
        for (int j = 0; j < 4; ++j) {
            const f32x4 h = ((const f32x4*)(hf + (size_t)t * D_))[lane + 64 * j];
            const u32x2 y0 = ((const u32x2*)(Y + (size_t)d0 * D_))[lane + 64 * j], y1 = ((const u32x2*)(Y + (size_t)d1 * D_))[lane + 64 * j];
            f32x4 a, b;
            a.x = __uint_as_float(y0.x << 16); a.y = __uint_as_float(y0.x & 0xffff0000u); a.z = __uint_as_float(y0.y << 16); a.w = __uint_as_float(y0.y & 0xffff0000u);
            b.x = __uint_as_float(y1.x << 16); b.y = __uint_as_float(y1.x & 0xffff0000u); b.z = __uint_as_float(y1.y << 16); b.w = __uint_as_float(y1.y & 0xffff0000u);
            v[j] = h * DN_ALPHA + (a * g0 + b * g1);
            s += (v[j].x + v[j].y) + (v[j].z + v[j].w);
        }
        const float mean = wave_sum(s) * (1.f / D_);
        float s2 = 0.f;
#pragma unroll
        for (int j = 0; j < 4; ++j) { v[j] = v[j] - mean; s2 += (v[j].x * v[j].x + v[j].y * v[j].y) + (v[j].z * v[j].z + v[j].w * v[j].w); }
        const float rstd = rsqrtf(wave_sum(s2) * (1.f / D_) + LN_EPS);
#pragma unroll
        for (int j = 0; j < 4; ++j) {
            const f32x4 g = ((const f32x4*)lg)[lane + 64 * j], bb = ((const f32x4*)lb)[lane + 64 * j];
            v[j] = v[j] * rstd * g + bb;
            ((f32x4*)(outf + (size_t)t * D_))[lane + 64 * j] = v[j];
            u32x2 o; o.x = pk2(v[j].x, v[j].y); o.y = pk2(v[j].z, v[j].w);
            ((u32x2*)(hb + (size_t)t * D_))[lane + 64 * j] = o;
        }
    }
}

__device__ __forceinline__ void naive_s5_scan(const bf16_t* P1, const float* a_re, const float* a_im, const float* log_dt, const float* b_re, const float* b_im,
                                              const float* c_re, const float* c_im, const float* dvec, float* YS5, bf16_t* YS5B, int pair) {
    const int lane = TIDX & 63;
    const int b = pair >> 5, g = pair & 31, n = lane;
    const float lam_re = fminf(a_re[g * 64 + n], -1e-4f), lam_im = a_im[g * 64 + n];
    const float dt = __expf(log_dt[g]);
    const float mag = __expf(lam_re * dt);
    const float ab_re = mag * cosf(lam_im * dt), ab_im = mag * sinf(lam_im * dt);
    const float den = lam_re * lam_re + lam_im * lam_im;
    const float num_re = ab_re - 1.f;
    const float z_re = (num_re * lam_re + ab_im * lam_im) / den;
    const float z_im = (ab_im * lam_re - num_re * lam_im) / den;
    float bre[16], bim[16], cre[16], cim[16];
#pragma unroll
    for (int c = 0; c < 16; ++c) {
        bre[c] = b_re[(size_t)(g * 64 + n) * 16 + c]; bim[c] = b_im[(size_t)(g * 64 + n) * 16 + c];
        cre[c] = c_re[(size_t)(g * 16 + c) * 64 + n]; cim[c] = c_im[(size_t)(g * 16 + c) * 64 + n];
    }
    const float dd = (lane < 16) ? dvec[g * 16 + lane] : 0.f;
    float h_re = 0.f, h_im = 0.f;
    for (int tt = 0; tt < L_; ++tt) {
        const size_t t = (size_t)b * L_ + tt;
        const float ul = (lane < 16) ? bf2f(P1[t * NIN1 + g * 16 + lane]) : 0.f;
        float bur = 0.f, bui = 0.f;
#pragma unroll
        for (int c = 0; c < 16; ++c) { const float u = __shfl(ul, c); bur += u * bre[c]; bui += u * bim[c]; }
        const float x_re = z_re * bur - z_im * bui, x_im = z_re * bui + z_im * bur;
        const float nh_re = ab_re * h_re - ab_im * h_im + x_re;
        const float nh_im = ab_re * h_im + ab_im * h_re + x_im;
        h_re = nh_re; h_im = nh_im;
        float yv = 0.f;
#pragma unroll
        for (int c = 0; c < 16; ++c) { const float y = wave_sum(h_re * cre[c] - h_im * cim[c]); if (lane == c) yv = y; }
        if (lane < 16) {
            const float y = gelu_tanh(yv + dd * ul);
            YS5[t * 512 + g * 16 + lane] = y;
            YS5B[t * 512 + g * 16 + lane] = f2bf(y);
        }
    }
}

__device__ __forceinline__ void ph_fin1(const float* OG, const bf16_t* P1, const float* norm_g, bf16_t* Ymix) {
    const int wave = TIDX >> 6, lane = TIDX & 63;
    for (int item = blockIdx.x * NWAVES + wave; item < T_ * 4; item += gridDim.x * NWAVES) {
        const int t = item >> 2, h = item & 3;
        const float o0 = OG[(size_t)t * 512 + h * 128 + lane], o1 = OG[(size_t)t * 512 + h * 128 + 64 + lane];
        const float ms = wave_sum(o0 * o0 + o1 * o1) * (1.f / 128.f);
        const float rs = rsqrtf(ms + LN_EPS);
        const float g0 = bf2f(P1[(size_t)t * NIN1 + 2048 + h * 128 + lane]), g1 = bf2f(P1[(size_t)t * NIN1 + 2048 + h * 128 + 64 + lane]);
        Ymix[(size_t)t * D_ + 512 + h * 128 + lane] = f2bf(o0 * rs * norm_g[lane] * siluf(g0));
        Ymix[(size_t)t * D_ + 512 + h * 128 + 64 + lane] = f2bf(o1 * rs * norm_g[64 + lane] * siluf(g1));
    }
}

constexpr int LDS_BYTES = 147456;
constexpr int MISC_OFF = 131072 + 8192;
enum Phase {
    PH_PROLOGUE = 0,
    PH_INPROJ0, PH_PREPA0, PH_LORA0, PH_PREPB0, PH_SCAN0, PH_FIN0, PH_OUTPROJ0, PH_LN1_0, PH_DISP0, PH_UP0, PH_DOWN0, PH_COMB0,
    PH_INPROJ1, PH_L1A, PH_L1B, PH_L1C, PH_L1D, PH_SCAN1, PH_FIN1, PH_GLU1, PH_OUTPROJ1, PH_LN1_1, PH_DISP1, PH_UP1, PH_DOWN1, PH_COMB1,
    PH_COUNT
};

typedef const Args __attribute__((address_space(4)))* KArgsP;
__device__ __forceinline__ KArgsP fresh_args() { KArgsP p = (KArgsP)__builtin_amdgcn_kernarg_segment_ptr(); asm volatile("" : "+s"(p)); return p; }
#define PHASE_BEGIN KArgsP ap = fresh_args(); unsigned char* const ws = ap->ws; (void)ws;
#define INP(i) (ap->in[i])
#define W_CTL ((unsigned*)(ws + WS_CTL))
#define W_HB ((bf16_t*)(ws + WS_HB))
#define W_WIN0 ((bf16_t*)(ws + WS_WIN0))
#define W_WOUT0 ((bf16_t*)(ws + WS_WOUT0))
#define W_WIN1 ((bf16_t*)(ws + WS_WIN1))
#define W_WOUT1 ((bf16_t*)(ws + WS_WOUT1))
#define W_WGLU ((bf16_t*)(ws + WS_WGLU))
#define W_WLORA ((bf16_t*)(ws + WS_WLORA))
#define W_W13 ((bf16_t*)(ws + WS_W13))
#define W_W2 ((bf16_t*)(ws + WS_W2))
#define W_HA ((float*)(ws + WS_HA))
#define W_YRW W_HA
#define W_OG (W_HA + (size_t)T_ * 512)
#define W_P ((bf16_t*)(ws + WS_P))
#define W_LO ((bf16_t*)(ws + WS_LO))
#define W_SC ((bf16_t*)(ws + WS_SCAN))
#define W_GLALA ((float*)(ws + WS_GLALA))
#define W_BON ((float*)(ws + WS_BON))
#define W_AP ((bf16_t*)(ws + WS_APRIME))
#define W_YS5B ((bf16_t*)(ws + WS_YS5B))
#define W_XR ((bf16_t*)(ws + WS_XR))
#define W_HID ((bf16_t*)(ws + WS_HID))
#define W_Y ((bf16_t*)(ws + WS_Y))
#define W_TOKE ((int*)(ws + WS_ROUTE))
#define W_TOKSLOT (W_TOKE + 2 * T_)
#define W_TOKDEST (W_TOKE + 4 * T_)
#define W_TOKG ((float*)(W_TOKE + 6 * T_))
#define W_YMIX W_HB
#define BIGP(mib) (ws + WS_BIG + (size_t)(mib) * MiB)
#define GLA0_BUFS GlaBufs{(bf16_t*)BIGP(256), (bf16_t*)BIGP(264), (bf16_t*)(ws + WS_HB), (bf16_t*)BIGP(273), (float*)BIGP(289), W_HA + (size_t)T_ * 512, (bf16_t*)BIGP(112)}
#define HG_BUFS GlaBufs{(bf16_t*)BIGP(96), (bf16_t*)BIGP(112), (bf16_t*)BIGP(144), (bf16_t*)BIGP(128), (float*)BIGP(176), (float*)BIGP(177), (bf16_t*)BIGP(144)}
#define W_S5WE ((bf16_t*)BIGP(160))
#define W_S5UA ((bf16_t*)BIGP(241))
#define W_S5MB ((bf16_t*)BIGP(261))
#define W_S5E ((float*)BIGP(281))
#define CW_SUB 12288

#define IN(k) (PLO <= (k) && (k) < PHI)
#define SEAM(k) do { if (IN(k) && IN((k) + 1)) { PHASE_BEGIN XcdBarrier bar_; bar_.bar = W_CTL + CW_BAR; bar_.x = xb_xcc_id(); bar_.st = (volatile LAS unsigned*)(lds + MISC_OFF) + 8; xcd_barrier(bar_); } } while (0)
template <int PLO, int PHI, int layer>
__device__ __forceinline__ void moe_layer(LAS unsigned char* lds) {
    LAS float* ldsf = (LAS float*)lds; (void)ldsf;
        const int base = layer == 0 ? PH_OUTPROJ0 : PH_OUTPROJ1;
        if (IN(base + 0)) {
            PHASE_BEGIN
            const float* W = layer == 0 ? INP(16) : INP(30);
            float* V1 = layer == 0 ? ap->out : W_HA;
            const float* resid = layer == 0 ? INP(0) : ap->out;
#if FAST_GEMM
            (void)W;
            { pg8::Gemm g{W_YMIX, layer == 0 ? W_WOUT0 : W_WOUT1, T_, D_, D_}; pg8::StaticOrder S; S.init(T_, D_, (int)gridDim.x, (int)blockIdx.x); pg8::EpiResidF32 E{resid, V1, D_, DN_ALPHA};
              pg8::gemm_phase<pg8::EpiResidF32, pg8::StaticOrder, true, true>(lds, g, S, E); }
#else
            const bf16_t* Ymix = W_YMIX;
            naive_gemm<false>(ldsf, T_, D_, D_, [&](int m) { return Ymix + (size_t)m * D_; }, [&](int, int) { return W; }, D_,
                              [&](int m, int n, float a, float) { V1[(size_t)m * D_ + n] = DN_ALPHA * resid[(size_t)m * D_ + n] + a; });
#endif
        }
        SEAM(base + 0);
        if (IN(base + 1)) {
            PHASE_BEGIN
            const float* V1 = layer == 0 ? ap->out : W_HA;
            ph_ln_router(V1, W_HA, W_HB, INP(31) + layer * D_, INP(32) + layer * D_, INP(33) + (size_t)layer * D_ * 4, INP(34) + layer * 4,
                         INP(35) + (size_t)layer * 4 * D_ * 8, INP(36) + layer * 32, W_TOKE, W_TOKSLOT, W_TOKG, W_CTL + CW_CNT + 64 * layer);
        }
        SEAM(base + 1);
        if (IN(base + 2)) { PHASE_BEGIN ph_dispatch((LAS int*)lds, W_CTL + CW_CNT + 64 * layer, W_HB, W_TOKE, W_TOKSLOT, W_TOKDEST, W_XR); }
        SEAM(base + 2);
        if (IN(base + 3)) {
            PHASE_BEGIN
#if FAST_GEMM
            { LAS int* pst = (LAS int*)(lds + 131072 + 2048); LAS int* tile_e = (LAS int*)(lds + 131072 + 1024);
              moe_offsets(pst, W_CTL + CW_CNT + 64 * layer);
              const int ntiles = pst[32] / 256;
              if ((int)TIDX < ntiles) tile_e[TIDX] = moe_expert_of_row(pst, TIDX * 256);
              __syncthreads();
              pg8::Gemm g{W_XR, W_W13, ntiles * 256, 1024, D_}; pg8::MoeOrder S{ntiles, 4, (int)gridDim.x, (int)blockIdx.x, tile_e}; pg8::EpiSwiglu E{W_HID};
              pg8::gemm_phase<pg8::EpiSwiglu, pg8::MoeOrder, true, true>(lds, g, S, E); }
#else
            LAS int* pst = (LAS int*)(lds + 65536);
            moe_offsets(pst, W_CTL + CW_CNT + 64 * layer);
            const float* w1 = INP(37) + (size_t)layer * 32 * D_ * 512; const float* w3 = INP(38) + (size_t)layer * 32 * D_ * 512;
            const bf16_t* XR = W_XR; bf16_t* HID = W_HID;
            naive_gemm<true>(ldsf, pst[32], 512, D_, [&](int m) { return XR + (size_t)m * D_; },
                             [&](int m0, int which) { const int e = moe_expert_of_row(pst, m0); return (which ? w3 : w1) + (size_t)e * D_ * 512; }, 512,
                             [&](int m, int n, float a, float b) { HID[(size_t)m * 512 + n] = f2bf(siluf(a) * b); });
#endif
        }
        SEAM(base + 3);
        if (IN(base + 4)) {
            PHASE_BEGIN
#if FAST_GEMM
            { LAS int* pst = (LAS int*)(lds + 131072 + 2048); LAS int* tile_e = (LAS int*)(lds + 131072 + 1024);
              moe_offsets(pst, W_CTL + CW_CNT + 64 * layer);
              const int ntiles = pst[32] / 256;
              if ((int)TIDX < ntiles) tile_e[TIDX] = moe_expert_of_row(pst, TIDX * 256);
              __syncthreads();
              pg8::Gemm g{W_HID, W_W2, ntiles * 256, 1024, 512}; pg8::MoeOrder S{ntiles, 4, (int)gridDim.x, (int)blockIdx.x, tile_e}; pg8::EpiStoreBf16 E{W_Y, D_, 0, 0};
              pg8::gemm_phase<pg8::EpiStoreBf16, pg8::MoeOrder, true, true>(lds, g, S, E); }
#else
            LAS int* pst = (LAS int*)(lds + 65536);
            moe_offsets(pst, W_CTL + CW_CNT + 64 * layer);
            const float* w2 = INP(39) + (size_t)layer * 32 * 512 * D_;
            const bf16_t* HID = W_HID; bf16_t* Y = W_Y;
            naive_gemm<false>(ldsf, pst[32], D_, 512, [&](int m) { return HID + (size_t)m * 512; },
                              [&](int m0, int) { const int e = moe_expert_of_row(pst, m0); return w2 + (size_t)e * 512 * D_; }, D_,
                              [&](int m, int n, float a, float) { Y[(size_t)m * D_ + n] = f2bf(a); });
#endif
        }
        SEAM(base + 4);
        if (IN(base + 5)) { PHASE_BEGIN ph_combine_ln(W_HA, W_Y, W_TOKDEST, W_TOKG, INP(40) + layer * D_, INP(41) + layer * D_, ap->out, W_HB); }
        SEAM(base + 5);

}

template <int PLO, int PHI>
__device__ __forceinline__ void mega_body(unsigned char* lds_raw) {
    LAS unsigned char* lds = (LAS unsigned char*)lds_raw;
    LAS float* ldsf = (LAS float*)lds;
    constexpr bool MULTI = (PHI - PLO) > 1;
    if (MULTI) {
        PHASE_BEGIN
        volatile LAS unsigned* MISC = (volatile LAS unsigned*)(lds + MISC_OFF);
        if (TIDX < 32) MISC[TIDX] = 0u;
        __syncthreads();
        (void)xcd_barrier_post(W_CTL + CW_BAR, MISC + 8);
    }

    if (IN(PH_PROLOGUE)) {
        PHASE_BEGIN ph_prologue(INP(0), W_HB);
#if FAST_GEMM
        LAS float* scr = ldsf + (TIDX >> 6) * (64 * 33);
        const int gw = blockIdx.x * NWAVES + (TIDX >> 6), ngw = gridDim.x * NWAVES, lane = TIDX & 63;
        convert_plain(INP(1), D_, NIN0, NIN0P, W_WIN0, scr, gw, ngw, lane);
        convert_plain(INP(16), D_, D_, D_, W_WOUT0, scr, gw, ngw, lane);
        convert_plain(INP(17), D_, NIN1, NIN1, W_WIN1, scr, gw, ngw, lane);
        convert_plain(INP(30), D_, D_, D_, W_WOUT1, scr, gw, ngw, lane);
        convert_plain(INP(26), 512, 512, 512, W_WGLU, scr, gw, ngw, lane);
        convert_lora(INP(4), INP(6), INP(7), W_WLORA, scr, gw, ngw, lane);
        convert_moe(INP(37), INP(38), INP(39), W_W13, W_W2, scr, gw, ngw, lane);
#endif
    }
    SEAM(PH_PROLOGUE);
    if (IN(PH_INPROJ0)) {
        PHASE_BEGIN
#if FAST_GEMM
        { pg8::Gemm g{W_HB, W_WIN0, T_, NIN0P, D_}; pg8::StaticOrder S; S.init(T_, NIN0P, (int)gridDim.x, (int)blockIdx.x); pg8::EpiStoreBf16 E{W_P, NIN0P, 0, 0};
          pg8::gemm_phase<pg8::EpiStoreBf16, pg8::StaticOrder, true, true>(lds, g, S, E); }
#else
        const float* W = INP(1); const bf16_t* A = W_HB; bf16_t* P = W_P;
        naive_gemm<false>(ldsf, T_, NIN0, D_, [&](int m) { return A + (size_t)m * D_; }, [&](int, int) { return W; }, NIN0,
                          [&](int m, int n, float a, float) { P[(size_t)m * NIN0P + n] = f2bf(a); });
#endif
    }
    SEAM(PH_INPROJ0);
    if (IN(PH_PREPA0)) { PHASE_BEGIN ph_prepA0<!FAST_GLA0>(W_P, INP(2), INP(13), INP(14), W_AP, W_GLALA); }
    SEAM(PH_PREPA0);
    if (IN(PH_LORA0)) {
        PHASE_BEGIN
#if FAST_GEMM
        { pg8::Gemm g{W_AP, W_WLORA, T_, NLORA, 256}; pg8::StaticOrder S; S.init(T_, NLORA, (int)gridDim.x, (int)blockIdx.x); pg8::EpiStoreBf16 E{W_LO, 512, 512, (size_t)T_ * 512};
          pg8::gemm_phase<pg8::EpiStoreBf16, pg8::StaticOrder, true, true>(lds, g, S, E); }
#else
        const float* w2 = INP(4); const float* a2 = INP(6); const float* g2 = INP(7); const bf16_t* AP = W_AP; bf16_t* LO = W_LO;
        naive_gemm<false>(ldsf, T_, 512, 64, [&](int m) { return AP + (size_t)m * 256; }, [&](int, int) { return w2; }, 512,
                          [&](int m, int n, float a, float) { LO[(size_t)m * 512 + n] = f2bf(a); });
        naive_gemm<false>(ldsf, T_, 512, 64, [&](int m) { return AP + (size_t)m * 256 + 64; }, [&](int, int) { return a2; }, 512,
                          [&](int m, int n, float a, float) { LO[(size_t)T_ * 512 + (size_t)m * 512 + n] = f2bf(a); });
        naive_gemm<false>(ldsf, T_, 512, 128, [&](int m) { return AP + (size_t)m * 256 + 128; }, [&](int, int) { return g2; }, 512,
                          [&](int m, int n, float a, float) { LO[(size_t)2 * T_ * 512 + (size_t)m * 512 + n] = f2bf(a); });
#endif
    }
    SEAM(PH_LORA0);
    if (IN(PH_PREPB0)) {
        PHASE_BEGIN ph_prepB0(W_P, W_LO, INP(2), INP(3), INP(5), INP(8), INP(9), INP(10), W_SC, W_BON);
#if FAST_GLA0
        { const GlaBufs GB = GLA0_BUFS; __syncthreads();
          for (int cg = blockIdx.x; cg < 256; cg += gridDim.x) gla_prep_tile<64, 0>(ldsf, W_P, INP(13), INP(14), GB, cg); }
#endif
    }
    SEAM(PH_PREPB0);
    if (IN(PH_SCAN0)) {
        PHASE_BEGIN
        const int bid = blockIdx.x;
#if FAST_RWKV
        constexpr int NRW = 128;
        if (bid < NRW) rwkv_scan_v1(ldsf, W_SC, W_YRW, bid);
#else
        constexpr int NRW = 16;
        if (bid < NRW) naive_rwkv_scan(ldsf, W_SC, W_YRW, bid);
#endif
#if FAST_GLA0
        else {
            const GlaBufs GB = GLA0_BUFS;
            const int nb = (int)gridDim.x - NRW, b0 = bid - NRW, wave = TIDX >> 6, lane = TIDX & 63;
            for (int u = b0 * NWAVES + wave; u < 1024 * 4; u += nb * NWAVES) gla_pass1_unit<64>(GB, u, lane);
            sub_barrier(W_CTL + CW_SUB, (unsigned)nb);
            gla_pass2<64>(GB, b0 * NTHREADS + TIDX, nb * NTHREADS);
            sub_barrier(W_CTL + CW_SUB + 64, (unsigned)nb);
            for (int it = b0; it < 1024; it += nb) gla_pass3_item<64, 0>(lds, W_P, INP(15), GB, W_YMIX, it);
        }
#else
        else if (bid < 24) {
            const int bh = bid - 16;
            const bf16_t* P = W_P; const float* GLALA = W_GLALA;
            naive_gla_scan<64>(ldsf,
                [&](int t, int ck, float& q, float& kk, float& e) {
                    q = bf2f(P[(size_t)t * NIN0P + 1792 + ck]) * 0.125f; kk = bf2f(P[(size_t)t * NIN0P + 2048 + ck]); e = __expf(GLALA[(size_t)t * 256 + ck]); },
                [&](int t, int cv) { return bf2f(P[(size_t)t * NIN0P + 2304 + cv]); }, W_OG, bh >> 2, bh & 3);
        }
#endif
    }
    SEAM(PH_SCAN0);
    if (IN(PH_FIN0)) { PHASE_BEGIN ph_fin0<!FAST_GLA0>(W_YRW, W_OG, W_P, W_LO, W_SC, W_BON, INP(11), INP(12), INP(15), W_YMIX); }
    SEAM(PH_FIN0);

    moe_layer<PLO, PHI, 0>(lds);
            if (IN(PH_INPROJ1)) {
                PHASE_BEGIN
#if FAST_GEMM
                { pg8::Gemm g{W_HB, W_WIN1, T_, NIN1, D_}; pg8::StaticOrder S; S.init(T_, NIN1, (int)gridDim.x, (int)blockIdx.x); pg8::EpiStoreBf16 E{W_P, NIN1, 0, 0};
                  pg8::gemm_phase<pg8::EpiStoreBf16, pg8::StaticOrder, true, true>(lds, g, S, E); }
#else
                const float* W = INP(17); const bf16_t* A = W_HB; bf16_t* P = W_P;
                naive_gemm<false>(ldsf, T_, NIN1, D_, [&](int m) { return A + (size_t)m * D_; }, [&](int, int) { return W; }, NIN1,
                                  [&](int m, int n, float a, float) { P[(size_t)m * NIN1 + n] = f2bf(a); });
#endif
            }
            SEAM(PH_INPROJ1);
            if (IN(PH_L1A)) {
                PHASE_BEGIN
#if FAST_S5
                if (blockIdx.x >= 224) s5_tables(ldsf, INP(18), INP(19), INP(20), INP(21), INP(22), INP(23), INP(24), W_S5MB, W_S5WE, (int)blockIdx.x - 224);
                s5_fill_ua(W_P, W_S5UA, blockIdx.x * NWAVES + (TIDX >> 6), gridDim.x * NWAVES, TIDX & 63);
                __syncthreads();
#endif
#if FAST_HG
                { const GlaBufs GB = HG_BUFS;
                  for (int cg = blockIdx.x; cg < 256; cg += gridDim.x) gla_prep_tile<128, 1>(ldsf, W_P, INP(28), nullptr, GB, cg); }
#endif
            }
            SEAM(PH_L1A);
            if (IN(PH_L1B)) {
                PHASE_BEGIN
                const int bid = blockIdx.x;
#if FAST_S5
                if (bid < 64) {
                    LAS int* tile_e = (LAS int*)(lds + 131072 + 1024);
                    if (TIDX < 64) tile_e[TIDX] = TIDX >> 1;
                    __syncthreads();
                    pg8::Gemm g{W_S5UA, W_S5WE, 64 * 256, 256, 512, 640}; pg8::MoeOrder S{64, 1, 64, bid, tile_e}; pg8::EpiStoreF32 E{W_S5E, 256};
                    pg8::gemm_phase<pg8::EpiStoreF32, pg8::MoeOrder, true, true>(lds, g, S, E);
                }
#endif
#if FAST_HG
                if (bid >= 64) {
                    const GlaBufs GB = HG_BUFS;
                    const int nb = (int)gridDim.x - 64, b0 = bid - 64, wave = TIDX >> 6, lane = TIDX & 63;
                    for (int u = b0 * NWAVES + wave; u < 1024 * 8; u += nb * NWAVES) gla_pass1_unit<128>(GB, u, lane);
                }
#endif
            }
            SEAM(PH_L1B);
            if (IN(PH_L1C)) {
                PHASE_BEGIN
                const int bid = blockIdx.x;
#if FAST_S5
                if (bid < 8) s5_carry(INP(18), INP(19), INP(20), W_S5E, W_S5UA, bid * NTHREADS + TIDX);
#endif
#if FAST_HG
                if (bid >= 8) { const GlaBufs GB = HG_BUFS; gla_pass2<128>(GB, (bid - 8) * NTHREADS + TIDX, ((int)gridDim.x - 8) * NTHREADS); }
#endif
#if FAST_GEMM
                { LAS float* scr = ldsf + (TIDX >> 6) * (64 * 33);
                  convert_moe(INP(37) + (size_t)32 * D_ * 512, INP(38) + (size_t)32 * D_ * 512, INP(39) + (size_t)32 * 512 * D_, W_W13, W_W2, scr,
                              bid * NWAVES + (TIDX >> 6), (int)gridDim.x * NWAVES, TIDX & 63); }
#endif
            }
            SEAM(PH_L1C);
            if (IN(PH_L1D)) {
                PHASE_BEGIN
                const int bid = blockIdx.x;
#if FAST_S5
                if (bid < 128) {
                    LAS int* tile_e = (LAS int*)(lds + 131072 + 1024);
                    if (TIDX < 64) tile_e[TIDX] = TIDX >> 1;
                    __syncthreads();
                    pg8::Gemm g{W_S5UA, W_S5MB, 64 * 256, 512, 640, 640}; pg8::MoeOrder S{64, 2, 128, bid, tile_e}; pg8::EpiS5Y E{W_P, INP(25), W_YRW, W_YS5B};
                    pg8::gemm_phase<pg8::EpiS5Y, pg8::MoeOrder, true, true>(lds, g, S, E);
                }
#endif
#if FAST_HG
                if (bid >= 128) {
                    const GlaBufs GB = HG_BUFS;
                    for (int it = bid - 128; it < 1024; it += (int)gridDim.x - 128) gla_pass3_item<128, 1>(lds, W_P, INP(29), GB, W_YMIX, it);
                }
#endif
            }
            SEAM(PH_L1D);
            if (IN(PH_SCAN1)) {
                PHASE_BEGIN
                const int bid = blockIdx.x;
                const bf16_t* P = W_P; (void)P; (void)bid;
#if !FAST_HG
                if (bid < 8) {
                    const float* hg_lb = INP(28);
                    naive_gla_scan<128>(ldsf,
                        [&](int t, int ck, float& q, float& kk, float& e) {
                            const float l0 = hg_lb[ck], l1 = hg_lb[512 + ck];
                            const float lbv = 1.f / (1.f + __expf(l0 - l1));
                            const float f = bf2f(P[(size_t)t * NIN1 + 1024 + ck]);
                            const float sg = sigm(f);
                            q = siluf(bf2f(P[(size_t)t * NIN1 + 512 + ck])); kk = (1.f - lbv) * (1.f - sg); e = lbv + (1.f - lbv) * sg; },
                        [&](int t, int cv) { return bf2f(P[(size_t)t * NIN1 + 1536 + cv]); }, W_OG, bid >> 2, bid & 3);
                }
#endif
#if !FAST_S5
                if (bid >= 8 && bid < 16) {
                    const int pair = (bid - 8) * 8 + (TIDX >> 6);
                    naive_s5_scan(P, INP(18), INP(19), INP(20), INP(21), INP(22), INP(23), INP(24), INP(25), W_YRW, W_YS5B, pair);
                }
#endif
            }
            SEAM(PH_SCAN1);
#if !FAST_HG
            if (IN(PH_FIN1)) { PHASE_BEGIN ph_fin1(W_OG, W_P, INP(29), W_YMIX); }
#endif
            SEAM(PH_FIN1);
            if (IN(PH_GLU1)) {
                PHASE_BEGIN
#if FAST_GEMM
                { pg8::Gemm g{W_YS5B, W_WGLU, T_, 512, 512}; pg8::StaticOrder S; S.init(T_, 512, (int)gridDim.x, (int)blockIdx.x); pg8::EpiGlu E{W_YRW, 512, INP(27), W_YMIX, D_};
                  pg8::gemm_phase<pg8::EpiGlu, pg8::StaticOrder, true, true>(lds, g, S, E); }
#else
                const float* W = INP(26); const float* gb = INP(27); const bf16_t* YS5B = W_YS5B; const float* YRW = W_YRW; bf16_t* Ymix = W_YMIX;
                naive_gemm<false>(ldsf, T_, 512, 512, [&](int m) { return YS5B + (size_t)m * 512; }, [&](int, int) { return W; }, 512,
                                  [&](int m, int n, float a, float) { const float y = YRW[(size_t)m * 512 + n]; Ymix[(size_t)m * D_ + n] = f2bf(y * sigm(a + gb[n])); });
#endif
            }
            SEAM(PH_GLU1);
    moe_layer<PLO, PHI, 1>(lds);
#undef IN
}
template <int PLO, int PHI>
__global__ void __launch_bounds__(NTHREADS, 2) mega(Args args) {
    extern __shared__ __attribute__((aligned(16))) unsigned char lds_raw[];
    mega_body<PLO, PHI>(lds_raw);
}

#include <utility>
template <int... I> static void set_attrs(std::integer_sequence<int, I...>) {
    (void)std::initializer_list<int>{ ((void)hipFuncSetAttribute((const void*)mega<I, I + 1>, hipFuncAttributeMaxDynamicSharedMemorySize, LDS_BYTES), 0)... };
}
template <int I> static int launch_one(int grid, hipStream_t stream, const Args& a) {
    hipLaunchKernelGGL((mega<I, I + 1>), dim3(grid), dim3(NTHREADS), LDS_BYTES, stream, a);
    return 0;
}
template <int... I> static void launch_all(std::integer_sequence<int, I...>, int grid, hipStream_t stream, const Args& a) {
    (void)std::initializer_list<int>{ launch_one<I>(grid, stream, a)... };
}
extern "C" void kernel_launch(void* const* d_in, const int* in_sizes, int n_in, void* d_out, int out_size, void* d_ws, size_t ws_size, hipStream_t stream) {
    static int grid = 0;
    if (grid == 0) {
        if (n_in != 42 || out_size != T_ * D_ || ws_size < WS_END) { fprintf(stderr, "kernel_launch: unexpected shapes n_in %d out %d ws %zu\n", n_in, out_size, ws_size); grid = -1; return; }
        int dev = 0, cus = 0, per_cu = 0;
        hipGetDevice(&dev);
        hipDeviceGetAttribute(&cus, hipDeviceAttributeMultiprocessorCount, dev);
        set_attrs(std::make_integer_sequence<int, PH_COUNT>{});
        hipFuncSetAttribute((const void*)mega<0, PH_COUNT>, hipFuncAttributeMaxDynamicSharedMemorySize, LDS_BYTES);
        hipOccupancyMaxActiveBlocksPerMultiprocessor(&per_cu, (const void*)mega<0, PH_COUNT>, NTHREADS, LDS_BYTES);
        (void)hipGetLastError();
        if (per_cu < 1) per_cu = 1;
        grid = cus * 1;
        fprintf(stderr, "kernel_launch: cus %d per_cu %d grid %d\n", cus, per_cu, grid);
    }
    if (grid < 0) return;
    hipMemsetAsync((char*)d_ws + WS_CTL, 0, CTL_ZERO_BYTES, stream);
    Args a{};
    for (int i = 0; i < 42; ++i) a.in[i] = (const float*)d_in[i];
    a.out = (float*)d_out; a.ws = (unsigned char*)d_ws;
#if MK_SINGLE
    void* kargs[] = {(void*)&a};
    hipError_t e = hipLaunchCooperativeKernel((const void*)mega<0, PH_COUNT>, dim3(grid), dim3(NTHREADS), kargs, LDS_BYTES, stream);
    if (e != hipSuccess) fprintf(stderr, "cooperative launch failed: %s (grid %d)\n", hipGetErrorString(e), grid);
#else
    launch_all(std::make_integer_sequence<int, PH_COUNT>{}, grid, stream, a);
#endif
}
#ifdef TEST_RANGES
template __global__ void mega<0, 2>(Args);
template __global__ void mega<1, 3>(Args);
template __global__ void mega<1, 4>(Args);
template __global__ void mega<3, 8>(Args);
template __global__ void mega<7, 13>(Args);
template __global__ void mega<10, 12>(Args);
template __global__ void mega<13, 17>(Args);
template __global__ void mega<0, 13>(Args);
#endif
```

```cpp
#include <hip/hip_runtime.h>
#include <cstdio>
#include <cstdint>

#define GAS __attribute__((address_space(1)))
#define LAS __attribute__((address_space(3)))
typedef unsigned short bf16_t;
typedef float f32x4 __attribute__((ext_vector_type(4)));
typedef unsigned u32x4 __attribute__((ext_vector_type(4)));
typedef unsigned u32x2 __attribute__((ext_vector_type(2)));
__device__ __forceinline__ int launder_tid() { int t = (int)threadIdx.x; asm volatile("" : "+v"(t)); return t; }
#define TIDX launder_tid()

#ifndef FAST_GEMM
#define FAST_GEMM 1
#endif
#ifndef FAST_RWKV
#define FAST_RWKV 2
#endif
#ifndef FAST_GLA0
#define FAST_GLA0 1
#endif
#ifndef FAST_HG
#define FAST_HG 1
#endif
#ifndef FAST_S5
#define FAST_S5 1
#endif
#ifndef MK_SINGLE
#define MK_SINGLE 1
#endif

constexpr int T_ = 16384, L_ = 8192, D_ = 1024;
constexpr int NIN0 = 3344, NIN0P = 3584, NIN1 = 2560;
constexpr int NLORA = 1536;
constexpr int RMAX = 40960;
constexpr int MOE_PAD = 256;
constexpr float DN_ALPHA = 1.41421356237f;
constexpr float LN_EPS = 1e-5f;
constexpr int NTHREADS = 512, NWAVES = 8;

constexpr size_t MiB = 1u << 20;
constexpr size_t WS_CTL = 0, CTL_ZERO_BYTES = 1 * MiB;
constexpr size_t WS_WIN0 = 2 * MiB;
constexpr size_t WS_WOUT0 = 9 * MiB;
constexpr size_t WS_WIN1 = 11 * MiB;
constexpr size_t WS_WOUT1 = 16 * MiB;
constexpr size_t WS_WGLU = 18 * MiB;
constexpr size_t WS_WLORA = 19 * MiB;
constexpr size_t WS_W13 = 20 * MiB;
constexpr size_t WS_W2 = 84 * MiB;
constexpr size_t WS_HB = 116 * MiB;
constexpr size_t WS_HA = 149 * MiB;
constexpr size_t WS_ROUTE = 213 * MiB;
constexpr size_t WS_BIG = 214 * MiB;
constexpr size_t WS_P = WS_BIG;
constexpr size_t WS_LO = WS_BIG + 112 * MiB;
constexpr size_t WS_SCAN = WS_BIG + 160 * MiB;
constexpr size_t WS_GLALA = WS_BIG + 256 * MiB;
constexpr size_t WS_BON = WS_BIG + 272 * MiB;
constexpr size_t WS_APRIME = WS_BIG + 273 * MiB;
constexpr size_t WS_YS5B = WS_BIG + 80 * MiB;
constexpr size_t WS_XR = WS_BIG;
constexpr size_t WS_HID = WS_BIG + 80 * MiB;
constexpr size_t WS_Y = WS_BIG + 120 * MiB;
constexpr size_t WS_END = 512 * MiB;
constexpr int CW_BAR = 4096;
constexpr int CW_CNT = 8192;

__device__ __forceinline__ float bf2f(bf16_t b) { return __uint_as_float(((unsigned)b) << 16); }
__device__ __forceinline__ bf16_t f2bf(float f) { unsigned u = __float_as_uint(f); u += 0x7fffu + ((u >> 16) & 1u); return (bf16_t)(u >> 16); }
__device__ __forceinline__ unsigned pk2(float lo, float hi) { return (unsigned)f2bf(lo) | ((unsigned)f2bf(hi) << 16); }
__device__ __forceinline__ float sigm(float x) { return 1.f / (1.f + __expf(-x)); }
__device__ __forceinline__ float siluf(float x) { return x * sigm(x); }
__device__ __forceinline__ float softplusf(float x) { return fmaxf(x, 0.f) + log1pf(__expf(-fabsf(x))); }
__device__ __forceinline__ float gelu_tanh(float x) { const float u = 0.7978845608028654f * (x + 0.044715f * x * x * x); return 0.5f * x * (1.f + tanhf(u)); }
__device__ __forceinline__ float wave_sum(float v) {
#pragma unroll
    for (int o = 1; o < 64; o <<= 1) v += __shfl_xor(v, o);
    return v;
}


namespace pg8 {
#define PG8_LAS __attribute__((address_space(3)))
typedef unsigned short bf16_t;
typedef short bf16x8 __attribute__((ext_vector_type(8)));
typedef float f32x4 __attribute__((ext_vector_type(4)));
typedef unsigned u32x4 __attribute__((ext_vector_type(4)));
constexpr int BM = 256, BK = 64, HALF = 128, HTB = HALF * BK * 2  , STAGE_BYTES = 8 * HTB, NXCD = 8, WGM = 8;

__host__ __device__ __forceinline__ int lds_byte(int r, int c) { const int st = (r >> 4) * 2 + (c >> 5), rr = r & 15, cc = c & 31, ob = rr * 64 + cc * 2; return st * 1024 + (ob ^ (((ob >> 9) & 1) << 5)); }
__host__ __device__ __forceinline__ void stage_rc(int b, int& R, int& C) { const int st = b / 1024, sb = b % 1024, swz = sb ^ (((sb >> 9) & 1) << 5); R = (st >> 1) * 16 + swz / 64; C = (st & 1) * 32 + (swz % 64) / 2; }
__host__ __device__ __forceinline__ int perm32(int rho) { const int n = rho >> 4, i = rho & 15; return 8 * (i >> 2) + 4 * n + (i & 3); }

struct Unit { int pm, pn, pb; };
struct Gemm { const bf16_t* A; const bf16_t* Bt; int M, N, K, lda; };

struct StaticOrder {
    int nM, nN, nwg, G, c;
    __host__ __device__ void init(int M, int N, int G_, int c_) { nM = M / BM; nN = N / BM; nwg = nM * nN; G = G_; c = c_; }
    __host__ __device__ bool next(int i, Unit& u) const {
        const long L = (long)i * G + c; if (L >= nwg) return false;
        int wgid = (int)L; { const int q = nwg / NXCD, r = nwg % NXCD, xcd = wgid % NXCD, off = wgid / NXCD; wgid = (xcd < r ? xcd * (q + 1) : r * (q + 1) + (xcd - r) * q) + off; }
        const int nig = WGM * nN, gid = wgid / nig, fm = gid * WGM, gsz = (nM - fm) < WGM ? (nM - fm) : WGM;
        u.pm = fm + ((wgid % nig) % gsz); u.pn = (wgid % nig) / gsz; u.pb = u.pn; return true;
    }
    __device__ __forceinline__ void a_ready(const Unit&) const {}
    __device__ __forceinline__ void done(const Unit&) const {}
};

__device__ __forceinline__ unsigned cvt_pk_bf16(float lo, float hi) { unsigned r; asm volatile("v_cvt_pk_bf16_f32 %0, %1, %2" : "=v"(r) : "v"(lo), "v"(hi)); return r; }
typedef float f32x2 __attribute__((ext_vector_type(2)));

template <class Epi, class Sched, bool ALIGN_EPI = false, bool SP2 = false>
__device__ __forceinline__ void gemm_phase(PG8_LAS unsigned char* lds, const Gemm g, const Sched& S, const Epi& E) {
    const int tid = TIDX, wid = __builtin_amdgcn_readfirstlane(tid >> 6), lane = tid & 63, wr = wid >> 2, wc = wid & 3, fr = lane & 15, fq = lane >> 4;
    const int K = g.K, nt = K / BK, lda = g.lda ? g.lda : g.K;
    unsigned voffA[2], voffB[2];
#pragma unroll
    for (int i = 0; i < 2; ++i) { int R, C; stage_rc(tid * 16 + i * 8192, R, C); const int Rb = Epi::PERM ? ((R & ~31) + perm32(R & 31)) : R;
        voffA[i] = (unsigned)(R * lda + C) * 2u; voffB[i] = (unsigned)(Rb * K + C) * 2u; }
    const size_t kstep = (size_t)(BK * 2);
    const size_t hstep = (size_t)HALF * K * 2;
    const size_t tstep = 2 * hstep;
    const size_t hstepA = (size_t)HALF * lda * 2, tstepA = 2 * hstepA;
    const unsigned ldsw = (unsigned)wid * 1024u;
    const int aoff = lds_byte(wr * 64 + fr, fq * 8), boff = lds_byte(wc * 32 + fr, fq * 8);
#define PG8_SA(b, h) (((b) * 2 + (h)) * HTB)
#define PG8_SB(b, h) ((4 + (b) * 2 + (h)) * HTB)
#define PG8_STAGE(bufoff, gbase, voff) do { _Pragma("unroll") for (int _i = 0; _i < 2; ++_i) \
        __builtin_amdgcn_global_load_lds((const unsigned*)((const char*)(gbase) + (voff)[_i]), (PG8_LAS unsigned*)(lds + (bufoff) + ldsw + _i * 8192), 16, 0, 0); } while (0)
#define PG8_LDA(dst, b, h) do { _Pragma("unroll") for (int m = 0; m < 4; ++m) _Pragma("unroll") for (int k = 0; k < 2; ++k) dst[m][k] = *(const PG8_LAS bf16x8*)(lds + PG8_SA(b, h) + aoff + m * 2048 + k * 1024); } while (0)
#define PG8_LDB(dst, b, h) do { _Pragma("unroll") for (int n = 0; n < 2; ++n) _Pragma("unroll") for (int k = 0; k < 2; ++k) dst[n][k] = *(const PG8_LAS bf16x8*)(lds + PG8_SB(b, h) + boff + n * 2048 + k * 1024); } while (0)
#define PG8_MMA(ai, bj, At, Bt) do { __builtin_amdgcn_s_setprio(1); _Pragma("unroll") for (int m = 0; m < 4; ++m) _Pragma("unroll") for (int n = 0; n < 2; ++n) _Pragma("unroll") for (int k = 0; k < 2; ++k) \
        acc[ai][bj][m][n] = __builtin_amdgcn_mfma_f32_16x16x32_bf16(Bt[n][k], At[m][k], acc[ai][bj][m][n], 0, 0, 0); __builtin_amdgcn_s_setprio(0); } while (0)
#define PG8_WAIT_V(n) asm volatile("s_waitcnt vmcnt(" #n ")" ::: "memory")
#define PG8_WAIT_L(n) asm volatile("s_waitcnt lgkmcnt(" #n ")" ::: "memory")
#define PG8_BAR __builtin_amdgcn_s_barrier()
#define PG8_SCHED __builtin_amdgcn_sched_barrier(0)
    Unit cur, nxt; int ui = 0;
    if (!S.next(0, cur)) return;
    f32x4 acc[2][2][4][2];
#pragma unroll
    for (int a = 0; a < 2; ++a)
#pragma unroll
        for (int b = 0; b < 2; ++b)
#pragma unroll
            for (int m = 0; m < 4; ++m)
#pragma unroll
                for (int n = 0; n < 2; ++n) acc[a][b][m][n] = (f32x4){0.f, 0.f, 0.f, 0.f};
    bf16x8 At[4][2], B0[2][2], B1[2][2];
    const char* cA = (const char*)g.A + (size_t)cur.pm * tstepA; const char* cB = (const char*)g.Bt + (size_t)cur.pb * tstep;
    S.a_ready(cur);
    if constexpr (SP2) {
        PG8_STAGE(PG8_SB(0, 0), cB, voffB); PG8_STAGE(PG8_SB(0, 1), cB + hstep, voffB); PG8_STAGE(PG8_SA(0, 0), cA, voffA); PG8_STAGE(PG8_SA(0, 1), cA + hstepA, voffA);
        if (wr == 1) PG8_BAR;
        PG8_WAIT_V(2); PG8_BAR;
        PG8_STAGE(PG8_SB(1, 0), cB + kstep, voffB); PG8_STAGE(PG8_SA(1, 0), cA + kstep, voffA); PG8_STAGE(PG8_SB(1, 1), cB + hstep + kstep, voffB);
        PG8_WAIT_V(6); PG8_BAR;
    } else {
        PG8_STAGE(PG8_SB(0, 0), cB, voffB); PG8_STAGE(PG8_SA(0, 0), cA, voffA); PG8_STAGE(PG8_SB(0, 1), cB + hstep, voffB); PG8_STAGE(PG8_SA(0, 1), cA + hstepA, voffA);
        if (wr == 1) PG8_BAR;
        PG8_WAIT_V(4); PG8_BAR;
        PG8_STAGE(PG8_SB(1, 0), cB + kstep, voffB); PG8_STAGE(PG8_SA(1, 0), cA + kstep, voffA); PG8_STAGE(PG8_SB(1, 1), cB + hstep + kstep, voffB);
        PG8_WAIT_V(6); PG8_BAR;
    }
    for (;;) {
        const bool has_next = S.next(ui + 1, nxt);
        const char* nA = has_next ? (const char*)g.A + (size_t)nxt.pm * tstepA : cA; const char* nB = has_next ? (const char*)g.Bt + (size_t)nxt.pb * tstep : cB;
        for (int t = 0; t < nt; t += 2) {
            const bool last = (t == nt - 2);
            const char* a1 = cA + (size_t)(t + 1) * kstep;
            const char* a2 = last ? nA : cA + (size_t)(t + 2) * kstep; const char* b2 = last ? nB : cB + (size_t)(t + 2) * kstep;
            const char* a3 = a2 + kstep; const char* b3 = b2 + kstep;
            if (last && has_next) S.a_ready(nxt);
            if constexpr (SP2) {
            PG8_LDB(B0, 0, 0); PG8_LDB(B1, 0, 1); PG8_SCHED; PG8_LDA(At, 0, 0); PG8_STAGE(PG8_SA(1, 1), a1 + hstepA, voffA);
            PG8_WAIT_V(8); PG8_WAIT_L(0); PG8_BAR; PG8_MMA(0, 0, At, B0); PG8_MMA(0, 1, At, B1); PG8_BAR; PG8_SCHED;
            PG8_LDA(At, 0, 1); PG8_STAGE(PG8_SB(0, 0), b2, voffB); PG8_STAGE(PG8_SB(0, 1), b2 + hstep, voffB); PG8_STAGE(PG8_SA(0, 0), a2, voffA);
            PG8_WAIT_V(8); PG8_WAIT_L(0); PG8_BAR; PG8_MMA(1, 0, At, B0); PG8_MMA(1, 1, At, B1); PG8_BAR; PG8_SCHED;
            PG8_LDB(B0, 1, 0); PG8_LDB(B1, 1, 1); PG8_SCHED; PG8_LDA(At, 1, 0); PG8_STAGE(PG8_SA(0, 1), a2 + hstepA, voffA);
            PG8_WAIT_V(8); PG8_WAIT_L(0); PG8_BAR; PG8_MMA(0, 0, At, B0); PG8_MMA(0, 1, At, B1); PG8_BAR; PG8_SCHED;
            PG8_LDA(At, 1, 1); PG8_STAGE(PG8_SB(1, 0), b3, voffB); PG8_STAGE(PG8_SB(1, 1), b3 + hstep, voffB); PG8_STAGE(PG8_SA(1, 0), a3, voffA);
            PG8_WAIT_V(8); PG8_WAIT_L(0); PG8_BAR; PG8_MMA(1, 0, At, B0); PG8_MMA(1, 1, At, B1); PG8_BAR; PG8_SCHED;
            } else {
            PG8_LDB(B0, 0, 0); PG8_SCHED; PG8_LDA(At, 0, 0); PG8_STAGE(PG8_SA(1, 1), a1 + hstepA, voffA);
            PG8_WAIT_L(8); PG8_BAR; PG8_WAIT_L(0); PG8_MMA(0, 0, At, B0); PG8_BAR; PG8_SCHED;
            PG8_LDB(B1, 0, 1); PG8_STAGE(PG8_SB(0, 0), b2, voffB);
            PG8_BAR; PG8_WAIT_L(0); PG8_MMA(0, 1, At, B1); PG8_BAR;
            PG8_LDA(At, 0, 1); PG8_STAGE(PG8_SA(0, 0), a2, voffA);
            PG8_BAR; PG8_WAIT_L(0); PG8_MMA(1, 0, At, B0); PG8_BAR; PG8_SCHED;
            PG8_STAGE(PG8_SB(0, 1), b2 + hstep, voffB);
            PG8_WAIT_V(6); PG8_BAR; PG8_MMA(1, 1, At, B1); PG8_BAR;
            PG8_LDB(B0, 1, 0); PG8_SCHED; PG8_LDA(At, 1, 0); PG8_STAGE(PG8_SA(0, 1), a2 + hstepA, voffA);
            PG8_WAIT_L(8); PG8_BAR; PG8_WAIT_L(0); PG8_MMA(0, 0, At, B0); PG8_BAR; PG8_SCHED;
            PG8_LDB(B1, 1, 1); PG8_STAGE(PG8_SB(1, 0), b3, voffB);
            PG8_BAR; PG8_WAIT_L(0); PG8_MMA(0, 1, At, B1); PG8_BAR;
            PG8_LDA(At, 1, 1); PG8_STAGE(PG8_SA(1, 0), a3, voffA);
            PG8_BAR; PG8_WAIT_L(0); PG8_MMA(1, 0, At, B0); PG8_BAR; PG8_SCHED;
            PG8_STAGE(PG8_SB(1, 1), b3 + hstep, voffB);
            PG8_WAIT_V(6); PG8_BAR; PG8_MMA(1, 1, At, B1); PG8_BAR;
            }
        }
        if constexpr (ALIGN_EPI) { if (wr == 0) PG8_BAR; }
        if constexpr (!Epi::AFTER_DRAIN) { E(acc, cur, wr, wc, fr, fq); S.done(cur); }
        if (!has_next) break;
#pragma unroll
        for (int a = 0; a < 2; ++a)
#pragma unroll
            for (int b = 0; b < 2; ++b)
#pragma unroll
                for (int m = 0; m < 4; ++m)
#pragma unroll
                    for (int n = 0; n < 2; ++n) acc[a][b][m][n] = (f32x4){0.f, 0.f, 0.f, 0.f};
        cur = nxt; cA = nA; cB = nB; ++ui;
        if constexpr (ALIGN_EPI) { if (wr == 1) PG8_BAR; }
    }
    PG8_WAIT_V(0);
    if constexpr (!ALIGN_EPI) { if (wr == 0) PG8_BAR; }
    PG8_BAR;
    if constexpr (Epi::AFTER_DRAIN) { E.fused(acc, cur, wr, wc, fr, fq, lds, wid, lane); S.done(cur); }
#undef PG8_SA
#undef PG8_SB
#undef PG8_STAGE
#undef PG8_LDA
#undef PG8_LDB
#undef PG8_MMA
#undef PG8_WAIT_V
#undef PG8_WAIT_L
#undef PG8_BAR
#undef PG8_SCHED
}

struct EpiStoreBf16 {
    static constexpr bool PERM = true, AFTER_DRAIN = false;
    bf16_t* O; int ldc; int split_cols; size_t split_stride;
    __device__ __forceinline__ void operator()(const f32x4 (&acc)[2][2][4][2], const Unit& u, int wr, int wc, int fr, int fq) const {
        int colt = u.pn * BM; bf16_t* base = O;
        if (split_cols) { const int t = colt / split_cols; base += (size_t)t * split_stride; colt -= t * split_cols; }
        const int row0 = u.pm * BM + wr * 64 + fr, col0 = colt + wc * 32 + 8 * fq;
#pragma unroll
        for (int ai = 0; ai < 2; ++ai)
#pragma unroll
            for (int m = 0; m < 4; ++m) { bf16_t* rowp = base + (size_t)(row0 + ai * HALF + m * 16) * ldc + col0;
#pragma unroll
                for (int bj = 0; bj < 2; ++bj) { const f32x4 v0 = acc[ai][bj][m][0], v1 = acc[ai][bj][m][1];
                    u32x4 w; w.x = cvt_pk_bf16(v0[0], v0[1]); w.y = cvt_pk_bf16(v0[2], v0[3]); w.z = cvt_pk_bf16(v1[0], v1[1]); w.w = cvt_pk_bf16(v1[2], v1[3]);
                    *(u32x4*)(rowp + bj * HALF) = w; } }
    }
};
struct EpiResidF32 {
    static constexpr bool PERM = false, AFTER_DRAIN = false;
    const float* resid; float* out; int ldc; float alpha;
    __device__ __forceinline__ void operator()(const f32x4 (&acc)[2][2][4][2], const Unit& u, int wr, int wc, int fr, int fq) const {
        const int row0 = u.pm * BM + wr * 64 + fr, col0 = u.pn * BM + wc * 32 + 4 * fq;
#pragma unroll
        for (int ai = 0; ai < 2; ++ai)
#pragma unroll
            for (int m = 0; m < 4; ++m) { const size_t off = (size_t)(row0 + ai * HALF + m * 16) * ldc + col0;
#pragma unroll
                for (int bj = 0; bj < 2; ++bj)
#pragma unroll
                    for (int n = 0; n < 2; ++n) { const size_t o = off + bj * HALF + n * 16; *(f32x4*)(out + o) = *(const f32x4*)(resid + o) * alpha + acc[ai][bj][m][n]; } }
    }
};
__device__ __forceinline__ float fast_sigm(float x) { return __builtin_amdgcn_rcpf(1.f + __expf(-x)); }
struct EpiSwiglu {
    static constexpr bool PERM = true, AFTER_DRAIN = false;
    bf16_t* HID;
    __device__ __forceinline__ void operator()(const f32x4 (&acc)[2][2][4][2], const Unit& u, int wr, int wc, int fr, int fq) const {
        const int row0 = u.pm * BM + wr * 64 + fr, h0 = u.pn * 128 + wc * 16 + 4 * fq;
#pragma unroll
        for (int ai = 0; ai < 2; ++ai)
#pragma unroll
            for (int m = 0; m < 4; ++m) { bf16_t* rowp = HID + (size_t)(row0 + ai * HALF + m * 16) * 512 + h0;
#pragma unroll
                for (int bj = 0; bj < 2; ++bj) { const f32x4 a = acc[ai][bj][m][0], b = acc[ai][bj][m][1]; f32x4 h;
#pragma unroll
                    for (int j = 0; j < 4; ++j) h[j] = a[j] * fast_sigm(a[j]) * b[j];
                    typedef unsigned u32x2v __attribute__((ext_vector_type(2)));
                    u32x2v w; w.x = cvt_pk_bf16(h[0], h[1]); w.y = cvt_pk_bf16(h[2], h[3]);
                    *(u32x2v*)(rowp + bj * 64) = w; } }
    }
};
struct EpiGlu {
    static constexpr bool PERM = true, AFTER_DRAIN = false;
    const float* ysrc; int ldy; const float* bias; bf16_t* O; int ldc;
    __device__ __forceinline__ void operator()(const f32x4 (&acc)[2][2][4][2], const Unit& u, int wr, int wc, int fr, int fq) const {
        const int row0 = u.pm * BM + wr * 64 + fr, col0 = u.pn * BM + wc * 32 + 8 * fq;
#pragma unroll
        for (int ai = 0; ai < 2; ++ai)
#pragma unroll
            for (int m = 0; m < 4; ++m) { const int row = row0 + ai * HALF + m * 16;
#pragma unroll
                for (int bj = 0; bj < 2; ++bj) { const int col = col0 + bj * HALF;
                    const f32x4 y0 = *(const f32x4*)(ysrc + (size_t)row * ldy + col), y1 = *(const f32x4*)(ysrc + (size_t)row * ldy + col + 4);
                    const f32x4 b0 = *(const f32x4*)(bias + col), b1 = *(const f32x4*)(bias + col + 4);
                    f32x4 v0 = acc[ai][bj][m][0] + b0, v1 = acc[ai][bj][m][1] + b1;
#pragma unroll
                    for (int j = 0; j < 4; ++j) { v0[j] = y0[j] * fast_sigm(v0[j]); v1[j] = y1[j] * fast_sigm(v1[j]); }
                    u32x4 w; w.x = cvt_pk_bf16(v0[0], v0[1]); w.y = cvt_pk_bf16(v0[2], v0[3]); w.z = cvt_pk_bf16(v1[0], v1[1]); w.w = cvt_pk_bf16(v1[2], v1[3]);
                    *(u32x4*)(O + (size_t)row * ldc + col) = w; } }
    }
};
struct EpiStoreF32 {
    static constexpr bool PERM = false, AFTER_DRAIN = false;
    float* out; int ldc;
    __device__ __forceinline__ void operator()(const f32x4 (&acc)[2][2][4][2], const Unit& u, int wr, int wc, int fr, int fq) const {
        const int row0 = u.pm * BM + wr * 64 + fr, col0 = u.pn * BM + wc * 32 + 4 * fq;
#pragma unroll
        for (int ai = 0; ai < 2; ++ai)
#pragma unroll
            for (int m = 0; m < 4; ++m) { const size_t off = (size_t)(row0 + ai * HALF + m * 16) * ldc + col0;
#pragma unroll
                for (int bj = 0; bj < 2; ++bj)
#pragma unroll
                    for (int n = 0; n < 2; ++n) *(f32x4*)(out + off + bj * HALF + n * 16) = acc[ai][bj][m][n]; }
    }
};
struct EpiS5Y {
    static constexpr bool PERM = false, AFTER_DRAIN = false;
    const bf16_t* P1; const float* dvec; float* YS5; bf16_t* YS5B;
    __device__ __forceinline__ void operator()(const f32x4 (&acc)[2][2][4][2], const Unit& u, int wr, int wc, int fr, int fq) const {
        const int g = u.pm >> 1, ch = g * 16 + 4 * fq;
        const f32x4 dd = *(const f32x4*)(dvec + ch);
#pragma unroll
        for (int ai = 0; ai < 2; ++ai)
#pragma unroll
            for (int m = 0; m < 4; ++m) {
                const int bc = (u.pm & 1) * 256 + ai * HALF + wr * 64 + m * 16 + fr, b = bc >> 8, c32 = bc & 255;
#pragma unroll
                for (int bj = 0; bj < 2; ++bj)
#pragma unroll
                    for (int n = 0; n < 2; ++n) {
                        const int i = 16 * u.pn + 8 * bj + 2 * wc + n;
                        const size_t t = (size_t)b * 8192 + c32 * 32 + i;
                        typedef unsigned u32x2v __attribute__((ext_vector_type(2)));
                        const u32x2v uu = *(const u32x2v*)(P1 + t * 2560 + ch);
                        f32x4 uv; uv[0] = __uint_as_float(uu.x << 16); uv[1] = __uint_as_float(uu.x & 0xffff0000u); uv[2] = __uint_as_float(uu.y << 16); uv[3] = __uint_as_float(uu.y & 0xffff0000u);
                        f32x4 y = acc[ai][bj][m][n] + dd * uv;
#pragma unroll
                        for (int j = 0; j < 4; ++j) { const float x = y[j]; const float tt = 0.7978845608028654f * (x + 0.044715f * x * x * x); y[j] = 0.5f * x * (1.f + tanhf(tt)); }
                        *(f32x4*)(YS5 + t * 512 + ch) = y;
                        u32x2v w; w.x = cvt_pk_bf16(y[0], y[1]); w.y = cvt_pk_bf16(y[2], y[3]);
                        *(u32x2v*)(YS5B + t * 512 + ch) = w;
                    }
            }
    }
};
struct MoeOrder {
    int ntiles, nN, G, c; const PG8_LAS int* tile_e;
    __device__ __forceinline__ bool next(int i, Unit& u) const {
        const int L = i * G + c; if (L >= ntiles * nN) return false;
        u.pm = L / nN; u.pn = L % nN; u.pb = tile_e[u.pm] * nN + u.pn; return true;
    }
    __device__ __forceinline__ void a_ready(const Unit&) const {}
    __device__ __forceinline__ void done(const Unit&) const {}
};
}

#define XB_TMO      128
#define XB_XCNT(j)  (256  + 64 * (j))
#define XB_XSUB(j)  (1280 + 64 * (j))
#define XB_XGEN(j)  (2304 + 64 * (j))
#define XB_TOP      3328
#define XB_TOPGEN   3392
#define XCD_BAR_WORDS 3456
#define XB_SPIN_CAP (1u << 18)
__device__ __forceinline__ unsigned xb_ld(unsigned* p)              { return __hip_atomic_load(p, __ATOMIC_RELAXED, __HIP_MEMORY_SCOPE_AGENT); }
__device__ __forceinline__ unsigned xb_add(unsigned* p, unsigned v) { return __hip_atomic_fetch_add(p, v, __ATOMIC_RELAXED, __HIP_MEMORY_SCOPE_AGENT); }
__device__ __forceinline__ unsigned xb_xcc_id() { return (unsigned)__builtin_amdgcn_s_getreg((3 << 11) | 20) & 0xFu; }
#define XB_SPIN(cond, bar) do { unsigned _sp = 0; while (cond) { __builtin_amdgcn_s_sleep(1); \
    if ((++_sp & 255u) == 0u) { if (xb_ld(&(bar)[XB_TMO])) break; if (_sp > XB_SPIN_CAP) { atomicAdd(&(bar)[XB_TMO], 1u); break; } } } } while (0)
struct XcdBarrier { unsigned* bar; unsigned x; volatile LAS unsigned* st; };
__device__ __forceinline__ XcdBarrier xcd_barrier_post(unsigned* bar, volatile LAS unsigned* st) {
    XcdBarrier b; b.bar = bar; b.x = xb_xcc_id(); b.st = st;
    if (TIDX == 0) (void)xb_add(&bar[XB_XCNT(b.x)], 1u);
    return b;
}
__device__ __forceinline__ void xcd_barrier_complete(unsigned* bar, unsigned x, unsigned& nloc, unsigned& nx) {
    const unsigned G = gridDim.x;
    unsigned sum, cnt, mine, sp = 0u;
    for (;;) {
        sum = 0u; cnt = 0u; mine = 0u;
#pragma unroll
        for (unsigned j = 0; j < 16; ++j) { const unsigned c = xb_ld(&bar[XB_XCNT(j)]); sum += c; cnt += (c > 0u) ? 1u : 0u; mine = (j == x) ? c : mine; }
        if (sum == G) break;
        __builtin_amdgcn_s_sleep(1);
        if ((++sp & 255u) == 0u) { if (xb_ld(&bar[XB_TMO])) break; if (sp > XB_SPIN_CAP) { atomicAdd(&bar[XB_TMO], 1u); break; } }
    }
    nloc = mine > 0u ? mine : 1u; nx = cnt > 0u ? cnt : 1u;
}
__device__ __forceinline__ void xcd_barrier(const XcdBarrier& b) {
    asm volatile("s_waitcnt vmcnt(0)" ::: "memory");
    __syncthreads();
    if (TIDX == 0) {
        unsigned* bar = b.bar;
        __builtin_amdgcn_s_waitcnt(0);
        unsigned nloc = b.st[0], nx = b.st[1];
        if (nloc == 0u) { xcd_barrier_complete(bar, b.x, nloc, nx); b.st[0] = nloc; b.st[1] = nx; }
        const unsigned old = xb_add(&bar[XB_XSUB(b.x)], 1u);
        const unsigned gen = old / nloc;
        if (old + 1u == (gen + 1u) * nloc) {
            __builtin_amdgcn_fence(__ATOMIC_RELEASE, "agent");
            asm volatile("s_waitcnt vmcnt(0)" ::: "memory");
            const unsigned og = xb_add(&bar[XB_TOP], 1u);
            const unsigned tg = og / nx;
            if (og + 1u == (tg + 1u) * nx) xb_add(&bar[XB_TOPGEN], 1u);
            else XB_SPIN(xb_ld(&bar[XB_TOPGEN]) == tg, bar);
            __builtin_amdgcn_fence(__ATOMIC_ACQUIRE, "agent");
            xb_add(&bar[XB_XGEN(b.x)], 1u);
            asm volatile("s_waitcnt vmcnt(0)" ::: "memory");
        } else {
            XB_SPIN(xb_ld(&bar[XB_XGEN(b.x)]) == gen, bar);
            __builtin_amdgcn_fence(__ATOMIC_ACQUIRE, "agent");
            asm volatile("s_waitcnt vmcnt(0)" ::: "memory");
        }
    }
    __syncthreads();
}


typedef short bf16x8 __attribute__((ext_vector_type(8)));
struct GlaBufs { bf16_t* QT; bf16_t* KT; bf16_t* KDT; bf16_t* VT; float* DG; float* DS; bf16_t* SP; };
__device__ __forceinline__ float logsigf(float x) { return fminf(x, 0.f) - log1pf(__expf(-fabsf(x))); }

template <int K, int LAYER>
__device__ __forceinline__ void gla_prep_tile(LAS float* lds, const bf16_t* P, const float* aux0, const float* aux1, const GlaBufs& B, int cg) {
    constexpr int HK = 4 * K, KP = K + 1;
    LAS float* G = lds;
    LAS float* KR = lds + 64 * KP;
    LAS float* LV = lds + 2 * 64 * KP;
    const int tid = TIDX, lane = tid & 63, wave = tid >> 6;
    const int t0 = cg * 64;
    for (int h = 0; h < 4; ++h) {
        for (int idx = tid; idx < 64 * K; idx += NTHREADS) {
            const int t = idx / K, k = idx % K, ck = h * K + k;
            float g, kr;
            if (LAYER == 0) {
                const bf16_t* row = P + (size_t)(t0 + t) * NIN0P;
                float gk = aux1[ck];
#pragma unroll
                for (int i = 0; i < 16; ++i) gk += bf2f(row[2816 + i]) * aux0[i * 256 + ck];
                g = logsigf(gk) * (1.f / 16.f);
                kr = bf2f(row[2048 + ck]);
            } else {
                const bf16_t* row = P + (size_t)(t0 + t) * NIN1;
                const float lbv = 1.f / (1.f + __expf(aux0[ck] - aux0[512 + ck]));
                const float sg = sigm(bf2f(row[1024 + ck]));
                g = __logf(lbv + (1.f - lbv) * sg);
                kr = (1.f - lbv) * (1.f - sg);
            }
            G[t * KP + k] = g; KR[t * KP + k] = kr;
        }
        for (int idx = tid; idx < 64 * 128; idx += NTHREADS) {
            const int t = idx >> 7, vc = idx & 127;
            LV[t * 129 + vc] = bf2f(LAYER == 0 ? P[(size_t)(t0 + t) * NIN0P + 2304 + h * 128 + vc] : P[(size_t)(t0 + t) * NIN1 + 1536 + h * 128 + vc]);
        }
        __syncthreads();
        for (int k = wave; k < K; k += NWAVES) {
            float v = G[lane * KP + k];
#pragma unroll
            for (int o = 1; o < 64; o <<= 1) { const float n = __shfl_up(v, o); if (lane >= o) v += n; }
            G[lane * KP + k] = v;
        }
        __syncthreads();
        for (int idx = tid; idx < 64 * K; idx += NTHREADS) {
            const int t = idx / K, k = idx % K, ck = h * K + k;
            const float b = G[t * KP + k];
            float q;
            if (LAYER == 0) q = bf2f(P[(size_t)(t0 + t) * NIN0P + 1792 + ck]) * 0.125f;
            else q = siluf(bf2f(P[(size_t)(t0 + t) * NIN1 + 512 + ck]));
            B.QT[(size_t)(t0 + t) * HK + ck] = f2bf(q * __expf(b));
            B.KT[(size_t)(t0 + t) * HK + ck] = f2bf(KR[t * KP + k] * __expf(-b));
        }
        for (int idx = tid; idx < 64 * K; idx += NTHREADS) {
            const int k = idx >> 6, t = idx & 63, ck = h * K + k;
            const float bl = G[63 * KP + k];
            B.KDT[((size_t)cg * HK + ck) * 64 + t] = f2bf(KR[t * KP + k] * __expf(bl - G[t * KP + k]));
            if (t == 0) B.DG[(size_t)cg * HK + ck] = __expf(bl);
        }
        for (int idx = tid; idx < 64 * 128; idx += NTHREADS) {
            const int vc = idx >> 6, t = idx & 63;
            B.VT[((size_t)cg * 512 + h * 128 + vc) * 64 + t] = f2bf(LV[t * 129 + vc]);
        }
        __syncthreads();
    }
}

template <int K>
__device__ __forceinline__ void gla_pass1_unit(const GlaBufs& B, int unit, int lane) {
    constexpr int HK = 4 * K, KT16 = K / 16;
    const int item = unit / KT16, kt = unit % KT16, cg = item >> 2, h = item & 3;
    const int r = lane & 15, q = lane >> 4;
    const bf16_t* ap = B.KDT + ((size_t)cg * HK + h * K + kt * 16 + r) * 64 + 8 * q;
    const bf16x8 a0 = *(const bf16x8*)ap, a1 = *(const bf16x8*)(ap + 32);
    float* dsp = B.DS + ((size_t)item * 128 + r) * K + kt * 16 + 4 * q;
#pragma unroll
    for (int vt = 0; vt < 8; ++vt) {
        const bf16_t* bp = B.VT + ((size_t)cg * 512 + h * 128 + vt * 16 + r) * 64 + 8 * q;
        const bf16x8 b0 = *(const bf16x8*)bp, b1 = *(const bf16x8*)(bp + 32);
        f32x4 acc = {0.f, 0.f, 0.f, 0.f};
        acc = __builtin_amdgcn_mfma_f32_16x16x32_bf16(a0, b0, acc, 0, 0, 0);
        acc = __builtin_amdgcn_mfma_f32_16x16x32_bf16(a1, b1, acc, 0, 0, 0);
        *(f32x4*)(dsp + (size_t)vt * 16 * K) = acc;
    }
}

template <int K>
__device__ __forceinline__ void gla_pass2(const GlaBufs& B, int gthread, int gthreads) {
    constexpr int HK = 4 * K;
    const float* __restrict__ DS = B.DS; const float* __restrict__ DG = B.DG; bf16_t* __restrict__ SP = B.SP;
    for (int e = gthread; e < 8 * 128 * K; e += gthreads) {
        const int k = e % K, v = (e / K) & 127, bh = e / (K * 128), b = bh >> 2, h = bh & 3;
        float S = 0.f;
#pragma unroll 8
        for (int c = 0; c < 128; ++c) {
            const int cg = b * 128 + c;
            const size_t idx = ((size_t)(cg * 4 + h) * 128 + v) * K + k;
            const float d = DG[(size_t)cg * HK + h * K + k], ds = DS[idx];
            SP[idx] = f2bf(S);
            S = d * S + ds;
        }
    }
}

template <int K, int LAYER>
__device__ __forceinline__ void gla_pass3_item(LAS unsigned char* lds, const bf16_t* P, const float* norm_g, const GlaBufs& B, bf16_t* Ymix, int item) {
    constexpr int HK = 4 * K, KS = K / 32;
    LAS bf16_t* Ls = (LAS bf16_t*)lds;
    LAS float* Lo = (LAS float*)(lds + 64 * 72 * 2);
    const int tid = TIDX, lane = tid & 63, wave = tid >> 6, r = lane & 15, q = lane >> 4;
    const int cg = item >> 2, h = item & 3, t0 = cg * 64;
    const int it = wave >> 1, i0 = it * 16;
    bf16x8 qf[KS];
#pragma unroll
    for (int s = 0; s < KS; ++s) qf[s] = *(const bf16x8*)(B.QT + (size_t)(t0 + i0 + r) * HK + h * K + 32 * s + 8 * q);
#pragma unroll
    for (int jj2 = 0; jj2 < 2; ++jj2) {
        const int j0 = ((wave & 1) * 2 + jj2) * 16;
        f32x4 acc = {0.f, 0.f, 0.f, 0.f};
        if (j0 <= i0) {
#pragma unroll
            for (int s = 0; s < KS; ++s) {
                const bf16x8 kf = *(const bf16x8*)(B.KT + (size_t)(t0 + j0 + r) * HK + h * K + 32 * s + 8 * q);
                acc = __builtin_amdgcn_mfma_f32_16x16x32_bf16(kf, qf[s], acc, 0, 0, 0);
            }
        }
        const int i = i0 + r;
        u32x2 w;
        w.x = pk2((j0 + 4 * q + 0) <= i ? acc[0] : 0.f, (j0 + 4 * q + 1) <= i ? acc[1] : 0.f);
        w.y = pk2((j0 + 4 * q + 2) <= i ? acc[2] : 0.f, (j0 + 4 * q + 3) <= i ? acc[3] : 0.f);
        *(LAS u32x2*)(Ls + i * 72 + j0 + 4 * q) = w;
    }
    __syncthreads();
    const bf16x8 sf0 = *(const LAS bf16x8*)(Ls + (i0 + r) * 72 + 8 * q), sf1 = *(const LAS bf16x8*)(Ls + (i0 + r) * 72 + 32 + 8 * q);
#pragma unroll
    for (int vv = 0; vv < 4; ++vv) {
        const int v0 = ((wave & 1) * 4 + vv) * 16;
        f32x4 acc = {0.f, 0.f, 0.f, 0.f};
#pragma unroll
        for (int s = 0; s < KS; ++s) {
            const bf16x8 sp = *(const bf16x8*)(B.SP + ((size_t)item * 128 + v0 + r) * K + 32 * s + 8 * q);
            acc = __builtin_amdgcn_mfma_f32_16x16x32_bf16(sp, qf[s], acc, 0, 0, 0);
        }
        const bf16_t* vp = B.VT + ((size_t)cg * 512 + h * 128 + v0 + r) * 64 + 8 * q;
        const bf16x8 vf0 = *(const bf16x8*)vp, vf1 = *(const bf16x8*)(vp + 32);
        acc = __builtin_amdgcn_mfma_f32_16x16x32_bf16(vf0, sf0, acc, 0, 0, 0);
        acc = __builtin_amdgcn_mfma_f32_16x16x32_bf16(vf1, sf1, acc, 0, 0, 0);
        *(LAS f32x4*)(Lo + (i0 + r) * 132 + v0 + 4 * q) = acc;
    }
    __syncthreads();
#pragma unroll 2
    for (int rr = 0; rr < 8; ++rr) {
        const int i = wave * 8 + rr, t = t0 + i;
        const float o0 = Lo[i * 132 + lane], o1 = Lo[i * 132 + 64 + lane];
        const float ms = wave_sum(o0 * o0 + o1 * o1) * (1.f / 128.f);
        const float rs = rsqrtf(ms + LN_EPS);
        float g0, g1;
        if (LAYER == 0) { g0 = bf2f(P[(size_t)t * NIN0P + 2832 + h * 128 + lane]); g1 = bf2f(P[(size_t)t * NIN0P + 2832 + h * 128 + 64 + lane]); }
        else { g0 = bf2f(P[(size_t)t * NIN1 + 2048 + h * 128 + lane]); g1 = bf2f(P[(size_t)t * NIN1 + 2048 + h * 128 + 64 + lane]); }
        Ymix[(size_t)t * D_ + 512 + h * 128 + lane] = f2bf(o0 * rs * norm_g[lane] * siluf(g0));
        Ymix[(size_t)t * D_ + 512 + h * 128 + 64 + lane] = f2bf(o1 * rs * norm_g[64 + lane] * siluf(g1));
    }
    __syncthreads();
}


template <int CTRL> __device__ __forceinline__ float dppf(float x) { return __builtin_bit_cast(float, __builtin_amdgcn_mov_dpp(__builtin_bit_cast(int, x), CTRL, 0xf, 0xf, true)); }
__device__ __forceinline__ float reduce32(float x) {
    x += dppf<0xB1>(x);
    x += dppf<0x4E>(x);
    x += dppf<0x141>(x);
    x += dppf<0x140>(x);
    auto sw = __builtin_amdgcn_permlane16_swap(__float_as_uint(x), __float_as_uint(x), false, false);
    return __uint_as_float(sw[0]) + __uint_as_float(sw[1]);
}
__device__ __forceinline__ void rwkv_scan_v1(LAS float* lds, const bf16_t* SC, float* YRW, int unit) {
    constexpr int TS = 32, TILE = 5 * TS * 64 + TS * 16;
    const int bh = unit >> 3, qr = unit & 7, b = bh >> 3, h = bh & 7;
    const int tid = TIDX, lane = tid & 63, wave = tid >> 6, cp = lane & 31, rl = (wave & 3) * 2 + (lane >> 5);
    const size_t S1 = (size_t)T_ * 512;
    const int chunk = tid & 255, ls = chunk >> 3, lc0 = (chunk & 7) * 8, half = tid >> 8;
    const bf16_t* g0 = SC + (half == 0 ? 0 : 4 * S1) + (size_t)(b * L_ + ls) * 512 + h * 64 + lc0;
    const bf16_t* g1 = SC + (half == 0 ? 1 * S1 : 5 * S1) + (size_t)(b * L_ + ls) * 512 + h * 64 + lc0;
    const bf16_t* g2 = (half == 0) ? SC + 2 * S1 + (size_t)(b * L_ + ls) * 512 + h * 64 + lc0
                                   : SC + 3 * S1 + (size_t)(b * L_ + ls) * 512 + h * 64 + qr * 8;
    u32x4 p0, p1, p2;
    p0 = *(const u32x4*)g0; p1 = *(const u32x4*)g1; p2 = *(const u32x4*)g2;
    float S0 = 0.f, S1v = 0.f;
    auto unpack8 = [](const u32x4 v, float* f) {
        f[0] = __uint_as_float(v.x << 16); f[1] = __uint_as_float(v.x & 0xffff0000u); f[2] = __uint_as_float(v.y << 16); f[3] = __uint_as_float(v.y & 0xffff0000u);
        f[4] = __uint_as_float(v.z << 16); f[5] = __uint_as_float(v.z & 0xffff0000u); f[6] = __uint_as_float(v.w << 16); f[7] = __uint_as_float(v.w & 0xffff0000u); };
    auto stage = [&](LAS float* buf) {
        float f0[8], f1[8], f2[8];
        unpack8(p0, f0); unpack8(p1, f1); unpack8(p2, f2);
        if (half == 0) {
#pragma unroll
            for (int j = 0; j < 8; ++j) { buf[(4 * TS + ls) * 64 + lc0 + j] = f0[j]; buf[(1 * TS + ls) * 64 + lc0 + j] = __expf(f1[j]); buf[(3 * TS + ls) * 64 + lc0 + j] = f2[j]; }
        } else {
#pragma unroll
            for (int j = 0; j < 8; ++j) { buf[(0 * TS + ls) * 64 + lc0 + j] = -f0[j]; buf[(2 * TS + ls) * 64 + lc0 + j] = f0[j] * f1[j]; }
            if ((chunk & 7) == 0) {
#pragma unroll
                for (int j = 0; j < 8; ++j) buf[5 * TS * 64 + ls * 16 + j] = f2[j];
            }
        }
    };
    stage(lds);
    __syncthreads();
    for (int t0 = 0; t0 < L_; t0 += TS) {
        LAS float* cur = lds + ((t0 / TS) & 1) * TILE;
        LAS float* nxt = lds + (((t0 / TS) & 1) ^ 1) * TILE;
        const bool more = (t0 + TS) < L_;
        if (more) { const size_t adv = (size_t)(t0 + TS) * 512; p0 = *(const u32x4*)(g0 + adv); p1 = *(const u32x4*)(g1 + adv); p2 = *(const u32x4*)(g2 + adv); }
        float* yout = YRW + (size_t)(b * L_ + t0) * 512 + h * 64 + qr * 8 + rl;
        if (wave < 4) {
        typedef float f32x2v __attribute__((ext_vector_type(2)));
        f32x2v a2 = *(const LAS f32x2v*)(cur + (0 * TS) * 64 + 2 * cp), w2 = *(const LAS f32x2v*)(cur + (1 * TS) * 64 + 2 * cp), b2 = *(const LAS f32x2v*)(cur + (2 * TS) * 64 + 2 * cp),
               k2 = *(const LAS f32x2v*)(cur + (3 * TS) * 64 + 2 * cp), r2 = *(const LAS f32x2v*)(cur + (4 * TS) * 64 + 2 * cp);
        float vv = cur[5 * TS * 64 + rl];
        float ysel = 0.f;
#pragma unroll
        for (int s = 0; s < TS; ++s) {
            const int sn = (s + 1) & (TS - 1);
            const f32x2v a2n = *(const LAS f32x2v*)(cur + (0 * TS + sn) * 64 + 2 * cp), w2n = *(const LAS f32x2v*)(cur + (1 * TS + sn) * 64 + 2 * cp),
                         b2n = *(const LAS f32x2v*)(cur + (2 * TS + sn) * 64 + 2 * cp), k2n = *(const LAS f32x2v*)(cur + (3 * TS + sn) * 64 + 2 * cp),
                         r2n = *(const LAS f32x2v*)(cur + (4 * TS + sn) * 64 + 2 * cp);
            const float vvn = cur[5 * TS * 64 + sn * 16 + rl];
            const float sa = reduce32(S0 * a2.x + S1v * a2.y);
            S0 = S0 * w2.x + (sa * b2.x + vv * k2.x);
            S1v = S1v * w2.y + (sa * b2.y + vv * k2.y);
            const float y = reduce32(S0 * r2.x + S1v * r2.y);
            ysel = (cp == s) ? y : ysel;
            a2 = a2n; w2 = w2n; b2 = b2n; k2 = k2n; r2 = r2n; vv = vvn;
        }
        yout[(size_t)cp * 512] = ysel;
        }
        if (more) stage(nxt);
        __syncthreads();
    }
}


__device__ __forceinline__ bf16x8 ldfrag(const LAS bf16_t* tile, int row0, int ks, int r, int q) { return *(const LAS bf16x8*)(tile + (row0 + r) * 72 + 32 * ks + 8 * q); }
__device__ __forceinline__ f32x4 mm64(f32x4 acc, const LAS bf16_t* A, int arow0, const LAS bf16_t* B, int brow0, int r, int q) {
    acc = __builtin_amdgcn_mfma_f32_16x16x32_bf16(ldfrag(A, arow0, 0, r, q), ldfrag(B, brow0, 0, r, q), acc, 0, 0, 0);
    acc = __builtin_amdgcn_mfma_f32_16x16x32_bf16(ldfrag(A, arow0, 1, r, q), ldfrag(B, brow0, 1, r, q), acc, 0, 0, 0);
    return acc;
}
__device__ __forceinline__ void unpack8f(const u32x4 v, float* f) {
    f[0] = __uint_as_float(v.x << 16); f[1] = __uint_as_float(v.x & 0xffff0000u); f[2] = __uint_as_float(v.y << 16); f[3] = __uint_as_float(v.y & 0xffff0000u);
    f[4] = __uint_as_float(v.z << 16); f[5] = __uint_as_float(v.z & 0xffff0000u); f[6] = __uint_as_float(v.w << 16); f[7] = __uint_as_float(v.w & 0xffff0000u);
}
__device__ __forceinline__ u32x4 pack8f(const float* f) { u32x4 o; o.x = pk2(f[0], f[1]); o.y = pk2(f[2], f[3]); o.z = pk2(f[4], f[5]); o.w = pk2(f[6], f[7]); return o; }

__device__ __forceinline__ void rwkv_chunk_pre(LAS unsigned char* lds, const bf16_t* SC, bf16_t* Gout, bf16_t* Rmout, float* HTout, bf16_t* Ymout, int item) {
    const int bh = item >> 7, chn = item & 127, b = bh >> 3, h = bh & 7;
    const size_t S1 = (size_t)T_ * 512, base = (size_t)(b * L_ + chn * 64) * 512 + h * 64;
    LAS bf16_t* TL = (LAS bf16_t*)lds;
#define RTILE(k) (TL + (k) * 4608)
    LAS float* F = (LAS float*)(lds + 12 * 9216);
    LAS float* LL = F + 64 * 68;
    const int tid = TIDX, lane = tid & 63, wave = tid >> 6, r = lane & 15, q = lane >> 4;
    const int t = tid >> 3, c0 = (tid & 7) * 8;
    float ldv[8];
    { const u32x4 v = *(const u32x4*)(SC + 1 * S1 + base + (size_t)t * 512 + c0); unpack8f(v, ldv);
#pragma unroll
      for (int j = 0; j < 8; ++j) F[t * 68 + c0 + j] = ldv[j]; }
    __syncthreads();
#pragma unroll
    for (int cc = 0; cc < 8; ++cc) {
        const int c = wave * 8 + cc;
        float v = F[lane * 68 + c];
#pragma unroll
        for (int o = 1; o < 64; o <<= 1) { const float n = __shfl_up(v, o); if (lane >= o) v += n; }
        F[lane * 68 + c] = v;
    }
    __syncthreads();
    {
        float rr[8], kp[8], vv[8], kk[8], aa[8];
        unpack8f(*(const u32x4*)(SC + 0 * S1 + base + (size_t)t * 512 + c0), rr);
        unpack8f(*(const u32x4*)(SC + 2 * S1 + base + (size_t)t * 512 + c0), kp);
        unpack8f(*(const u32x4*)(SC + 3 * S1 + base + (size_t)t * 512 + c0), vv);
        unpack8f(*(const u32x4*)(SC + 4 * S1 + base + (size_t)t * 512 + c0), kk);
        unpack8f(*(const u32x4*)(SC + 5 * S1 + base + (size_t)t * 512 + c0), aa);
        float at[8], rt[8], bt[8], kt[8];
#pragma unroll
        for (int j = 0; j < 8; ++j) {
            const float cs = F[t * 68 + c0 + j], last = __expf(F[63 * 68 + c0 + j]);
            const float Lt = __expf(cs), Ltm1 = __expf(cs - ldv[j]), inv = __expf(-cs);
            at[j] = -kk[j] * Ltm1; rt[j] = rr[j] * Lt; bt[j] = kk[j] * aa[j] * inv; kt[j] = kp[j] * inv;
            RTILE(4)[(c0 + j) * 72 + t] = f2bf(at[j]);
            RTILE(5)[(c0 + j) * 72 + t] = f2bf(bt[j] * last);
            RTILE(6)[(c0 + j) * 72 + t] = f2bf(kt[j] * last);
            RTILE(7)[(c0 + j) * 72 + t] = f2bf(vv[j]);
            if (t == 63) LL[c0 + j] = last;
        }
        *(LAS u32x4*)(RTILE(0) + t * 72 + c0) = pack8f(at);
        *(LAS u32x4*)(RTILE(1) + t * 72 + c0) = pack8f(bt);
        *(LAS u32x4*)(RTILE(2) + t * 72 + c0) = pack8f(kt);
        *(LAS u32x4*)(RTILE(3) + t * 72 + c0) = pack8f(rt);
    }
    __syncthreads();
    {
        const int mtx = wave >> 1;
        const LAS bf16_t* X = (mtx < 2) ? RTILE(0) : RTILE(3);
        const LAS bf16_t* Y = (mtx & 1) ? RTILE(2) : RTILE(1);
#pragma unroll
        for (int k8 = 0; k8 < 8; ++k8) {
            const int idx = (wave & 1) * 8 + k8, ti = idx >> 2, si = idx & 3;
            f32x4 acc = {0.f, 0.f, 0.f, 0.f};
            if (si <= ti) acc = mm64(acc, Y, si * 16, X, ti * 16, r, q);
            const int tt = ti * 16 + r, s0 = si * 16 + 4 * q;
#pragma unroll
            for (int jj = 0; jj < 4; ++jj) { const bool keep = (mtx < 2) ? (s0 + jj < tt) : (s0 + jj <= tt); acc[jj] = keep ? acc[jj] : 0.f; }
            if (mtx == 0) *(LAS f32x4*)(F + tt * 68 + s0) = acc;
            else { u32x2 w; w.x = pk2(acc[0], acc[1]); w.y = pk2(acc[2], acc[3]); *(LAS u32x2*)(RTILE(7 + mtx) + tt * 72 + s0) = w; }
        }
    }
    __syncthreads();
    if (wave == 0) {
        float X[64];
#pragma unroll
        for (int tt = 0; tt < 64; ++tt) {
            float acc = (tt == lane) ? 1.f : 0.f;
#pragma unroll
            for (int s4 = 0; s4 < (tt + 3) / 4; ++s4) {
                const f32x4 a = *(const LAS f32x4*)(F + tt * 68 + 4 * s4);
#pragma unroll
                for (int j = 0; j < 4; ++j) if (4 * s4 + j < tt) acc += a[j] * X[4 * s4 + j];
            }
            X[tt] = acc;
            RTILE(11)[tt * 72 + lane] = f2bf(acc);
        }
    } else {
        for (int idx = wave - 1; idx < 16; idx += 7) {
            const int vi = idx >> 2, ti = idx & 3;
            f32x4 acc = {0.f, 0.f, 0.f, 0.f};
            acc = mm64(acc, RTILE(8), ti * 16, RTILE(7), vi * 16, r, q);
            u32x2 w; w.x = pk2(acc[0], acc[1]); w.y = pk2(acc[2], acc[3]);
            *(LAS u32x2*)(RTILE(2) + (vi * 16 + r) * 72 + ti * 16 + 4 * q) = w;
        }
    }
    __syncthreads();
#pragma unroll
    for (int k = 0; k < 4; ++k) {
        const int idx = wave * 4 + k, which = idx >> 4, xi = (idx >> 2) & 3, ti = idx & 3;
        f32x4 acc = {0.f, 0.f, 0.f, 0.f};
        acc = mm64(acc, RTILE(11), ti * 16, which ? RTILE(2) : RTILE(4), xi * 16, r, q);
        u32x2 w; w.x = pk2(acc[0], acc[1]); w.y = pk2(acc[2], acc[3]);
        *(LAS u32x2*)((which ? RTILE(1) : RTILE(0)) + (xi * 16 + r) * 72 + ti * 16 + 4 * q) = w;
    }
    __syncthreads();
#pragma unroll
    for (int k = 0; k < 8; ++k) {
        const int idx = wave * 8 + k, which = idx >> 4, i1 = (idx >> 2) & 3, i2 = idx & 3;
        f32x4 acc = {0.f, 0.f, 0.f, 0.f};
        if (which == 0) {
            acc = mm64(acc, RTILE(0), i2 * 16, RTILE(9), i1 * 16, r, q);
            const int tt = i1 * 16 + r, cc = i2 * 16 + 4 * q;
            const u32x2 rv = *(const LAS u32x2*)(RTILE(3) + tt * 72 + cc);
            acc[0] += __uint_as_float(rv.x << 16); acc[1] += __uint_as_float(rv.x & 0xffff0000u); acc[2] += __uint_as_float(rv.y << 16); acc[3] += __uint_as_float(rv.y & 0xffff0000u);
            u32x2 w; w.x = pk2(acc[0], acc[1]); w.y = pk2(acc[2], acc[3]);
            *(u32x2*)(Rmout + (size_t)item * 4096 + tt * 64 + cc) = w;
        } else if (which == 1) {
            acc = mm64(acc, RTILE(9), i1 * 16, RTILE(1), i2 * 16, r, q);
            acc = mm64(acc, RTILE(10), i1 * 16, RTILE(7), i2 * 16, r, q);
            u32x2 w; w.x = pk2(acc[0], acc[1]); w.y = pk2(acc[2], acc[3]);
            *(u32x2*)(Ymout + (((size_t)item * 16 + i1 * 4 + i2) * 64 + lane) * 4) = w;
        } else if (which == 2) {
            acc = mm64(acc, RTILE(0), i2 * 16, RTILE(5), i1 * 16, r, q);
            const int c1 = i1 * 16 + r, c2 = i2 * 16 + 4 * q;
#pragma unroll
            for (int jj = 0; jj < 4; ++jj) if (c2 + jj == c1) acc[jj] += LL[c1];
            u32x2 w; w.x = pk2(acc[0], acc[1]); w.y = pk2(acc[2], acc[3]);
            *(u32x2*)(Gout + (size_t)item * 4096 + c1 * 64 + c2) = w;
        } else {
            acc = mm64(acc, RTILE(5), i1 * 16, RTILE(1), i2 * 16, r, q);
            acc = mm64(acc, RTILE(6), i1 * 16, RTILE(7), i2 * 16, r, q);
            *(f32x4*)(HTout + (((size_t)item * 16 + i1 * 4 + i2) * 64 + lane) * 4) = acc;
        }
    }
    __syncthreads();
#undef RTILE
}

__device__ __forceinline__ void rwkv_chunk_seq(LAS unsigned char* lds, const bf16_t* G, const bf16_t* Rm, const float* HT, const bf16_t* Ym, float* YRW, int bh) {
    const int b = bh >> 3, h = bh & 7;
    const int tid = TIDX, lane = tid & 63, wave = tid >> 6, r = lane & 15, q = lane >> 4;
    const int rt = wave >> 1, vi0 = (wave & 1) * 2;
    LAS bf16_t* Sb0 = (LAS bf16_t*)lds;
    f32x4 Sacc[2] = {{0.f, 0.f, 0.f, 0.f}, {0.f, 0.f, 0.f, 0.f}};
    size_t item = (size_t)bh * 128;
    bf16x8 rmf[2], gf[2]; u32x2 ymf[2]; f32x4 htf[2];
    auto fetch = [&](size_t it, bf16x8* rm, bf16x8* g, u32x2* ym, f32x4* ht) {
#pragma unroll
        for (int ks = 0; ks < 2; ++ks) {
            rm[ks] = *(const bf16x8*)(Rm + it * 4096 + (rt * 16 + r) * 64 + 32 * ks + 8 * q);
            g[ks] = *(const bf16x8*)(G + it * 4096 + (rt * 16 + r) * 64 + 32 * ks + 8 * q);
        }
#pragma unroll
        for (int k = 0; k < 2; ++k) {
            ym[k] = *(const u32x2*)(Ym + ((it * 16 + rt * 4 + vi0 + k) * 64 + lane) * 4);
            ht[k] = *(const f32x4*)(HT + ((it * 16 + rt * 4 + vi0 + k) * 64 + lane) * 4);
        }
    };
    fetch(item, rmf, gf, ymf, htf);
    for (int ch = 0; ch < 128; ++ch) {
        LAS bf16_t* Sb = Sb0 + (ch & 1) * 4608;
#pragma unroll
        for (int k = 0; k < 2; ++k) { u32x2 w; w.x = pk2(Sacc[k][0], Sacc[k][1]); w.y = pk2(Sacc[k][2], Sacc[k][3]); *(LAS u32x2*)(Sb + ((vi0 + k) * 16 + r) * 72 + rt * 16 + 4 * q) = w; }
        __syncthreads();
        bf16x8 nrm[2], ng[2]; u32x2 nym[2]; f32x4 nht[2];
        fetch(item + (ch < 127 ? ch + 1 : ch), nrm, ng, nym, nht);
        float* yb = YRW + (size_t)(b * L_ + ch * 64 + rt * 16 + 4 * q) * 512 + h * 64 + r;
#pragma unroll
        for (int k = 0; k < 2; ++k) {
            const bf16x8 s0 = ldfrag(Sb, (vi0 + k) * 16, 0, r, q), s1 = ldfrag(Sb, (vi0 + k) * 16, 1, r, q);
            f32x4 ya; ya[0] = __uint_as_float(ymf[k].x << 16); ya[1] = __uint_as_float(ymf[k].x & 0xffff0000u); ya[2] = __uint_as_float(ymf[k].y << 16); ya[3] = __uint_as_float(ymf[k].y & 0xffff0000u);
            ya = __builtin_amdgcn_mfma_f32_16x16x32_bf16(rmf[0], s0, ya, 0, 0, 0);
            ya = __builtin_amdgcn_mfma_f32_16x16x32_bf16(rmf[1], s1, ya, 0, 0, 0);
            f32x4 sa = htf[k];
            sa = __builtin_amdgcn_mfma_f32_16x16x32_bf16(gf[0], s0, sa, 0, 0, 0);
            sa = __builtin_amdgcn_mfma_f32_16x16x32_bf16(gf[1], s1, sa, 0, 0, 0);
            Sacc[k] = sa;
#pragma unroll
            for (int jj = 0; jj < 4; ++jj) yb[(size_t)jj * 512 + (vi0 + k) * 16] = ya[jj];
        }
#pragma unroll
        for (int ks = 0; ks < 2; ++ks) { rmf[ks] = nrm[ks]; gf[ks] = ng[ks]; }
#pragma unroll
        for (int k = 0; k < 2; ++k) { ymf[k] = nym[k]; htf[k] = nht[k]; }
    }
}

__device__ __forceinline__ void sub_barrier(unsigned* ctr, unsigned nblocks) {
    asm volatile("s_waitcnt vmcnt(0)" ::: "memory");
    __syncthreads();
    if (TIDX == 0) {
        __builtin_amdgcn_fence(__ATOMIC_RELEASE, "agent");
        asm volatile("s_waitcnt vmcnt(0)" ::: "memory");
        xb_add(ctr, 1u);
        unsigned sp = 0;
        while (xb_ld(ctr) < nblocks) { __builtin_amdgcn_s_sleep(2); if (++sp > (1u << 22)) break; }
        __builtin_amdgcn_fence(__ATOMIC_ACQUIRE, "agent");
        asm volatile("s_waitcnt vmcnt(0)" ::: "memory");
    }
    __syncthreads();
}


__device__ __forceinline__ void s5_tables(LAS float* lds, const float* a_re, const float* a_im, const float* log_dt, const float* b_re, const float* b_im,
                                          const float* c_re, const float* c_im, bf16_t* MB, bf16_t* WE, int g) {
    LAS float* pwr = lds;
    LAS float* pwi = pwr + 33 * 64;
    LAS float* zbr = pwi + 33 * 64;
    LAS float* zbi = zbr + 1024;
    LAS float* cr = zbi + 1024;
    LAS float* ci = cr + 1024;
    LAS float* kern = ci + 1024;
    const int tid = TIDX;
    if (tid < 64) {
        const int n = tid;
        const float lam_re = fminf(a_re[g * 64 + n], -1e-4f), lam_im = a_im[g * 64 + n];
        const float dt = __expf(log_dt[g]);
        const float mag = __expf(lam_re * dt);
        const float ab_re = mag * cosf(lam_im * dt), ab_im = mag * sinf(lam_im * dt);
        const float den = lam_re * lam_re + lam_im * lam_im;
        const float num_re = ab_re - 1.f;
        const float z_re = (num_re * lam_re + ab_im * lam_im) / den;
        const float z_im = (ab_im * lam_re - num_re * lam_im) / den;
        for (int tau = 0; tau <= 32; ++tau) {
            const float m = __expf(lam_re * dt * (float)tau), ang = lam_im * dt * (float)tau;
            pwr[tau * 64 + n] = m * cosf(ang); pwi[tau * 64 + n] = m * sinf(ang);
        }
        for (int c = 0; c < 16; ++c) {
            const float br = b_re[(size_t)(g * 64 + n) * 16 + c], bi = b_im[(size_t)(g * 64 + n) * 16 + c];
            zbr[n * 16 + c] = z_re * br - z_im * bi; zbi[n * 16 + c] = z_re * bi + z_im * br;
        }
    }
    for (int idx = tid; idx < 1024; idx += NTHREADS) { cr[idx] = c_re[(size_t)g * 1024 + idx]; ci[idx] = c_im[(size_t)g * 1024 + idx]; }
    __syncthreads();
    for (int idx = tid; idx < 32 * 256; idx += NTHREADS) {
        const int tau = idx >> 8, c = (idx >> 4) & 15, cp = idx & 15;
        float acc = 0.f;
        for (int n = 0; n < 64; ++n) {
            const float pr = pwr[tau * 64 + n], pi = pwi[tau * 64 + n], zr = zbr[n * 16 + cp], zi = zbi[n * 16 + cp];
            const float wr = pr * zr - pi * zi, wi = pr * zi + pi * zr;
            acc += cr[c * 64 + n] * wr - ci[c * 64 + n] * wi;
        }
        kern[idx] = acc;
    }
    __syncthreads();
    for (int idx = tid; idx < 512 * 640; idx += NTHREADS) {
        const int row = idx / 640, col = idx % 640, i = row >> 4, c = row & 15;
        float v;
        if (col < 512) { const int j = col >> 4, cp = col & 15; v = (j <= i) ? kern[((i - j) * 16 + c) * 16 + cp] : 0.f; }
        else if (col < 576) { const int n = col - 512; v = cr[c * 64 + n] * pwr[(i + 1) * 64 + n] - ci[c * 64 + n] * pwi[(i + 1) * 64 + n]; }
        else { const int n = col - 576; v = -(cr[c * 64 + n] * pwi[(i + 1) * 64 + n] + ci[c * 64 + n] * pwr[(i + 1) * 64 + n]); }
        MB[((size_t)g * 512 + row) * 640 + col] = f2bf(v);
    }
    for (int idx = tid; idx < 256 * 512; idx += NTHREADS) {
        const int np = idx >> 9, col = idx & 511;
        float v = 0.f;
        if (np < 128) {
            const int n = np & 63, j = col >> 4, cp = col & 15;
            const float pr = pwr[(31 - j) * 64 + n], pi = pwi[(31 - j) * 64 + n], zr = zbr[n * 16 + cp], zi = zbi[n * 16 + cp];
            v = np < 64 ? (pr * zr - pi * zi) : (pr * zi + pi * zr);
        }
        WE[((size_t)g * 256 + np) * 512 + col] = f2bf(v);
    }
    __syncthreads();
}
__device__ __forceinline__ void s5_fill_ua(const bf16_t* P1, bf16_t* UA, int gw, int ngw, int lane) {
    for (int t = gw; t < T_; t += ngw) {
        const int b = t >> 13, tt = t & 8191, c32 = tt >> 5, j = tt & 31, g = lane >> 1, c0 = (lane & 1) * 8;
        const u32x4 v = *(const u32x4*)(P1 + (size_t)t * NIN1 + 8 * lane);
        *(u32x4*)(UA + ((size_t)g * 512 + b * 256 + c32) * 640 + j * 16 + c0) = v;
    }
}
__device__ __forceinline__ void s5_carry(const float* a_re, const float* a_im, const float* log_dt, const float* E, bf16_t* UA, int th) {
    const int n = th & 63, g = (th >> 6) & 31, b = th >> 11;
    const float lam_re = fminf(a_re[g * 64 + n], -1e-4f), lam_im = a_im[g * 64 + n];
    const float dt = __expf(log_dt[g]);
    const float m = __expf(lam_re * dt * 32.f), ang = lam_im * dt * 32.f;
    const float ar = m * cosf(ang), ai = m * sinf(ang);
    float hr = 0.f, hi = 0.f;
#pragma unroll 8
    for (int c = 0; c < 256; ++c) {
        const size_t row = (size_t)g * 512 + b * 256 + c;
        const float er = E[row * 256 + n], ei = E[row * 256 + 64 + n];
        UA[row * 640 + 512 + n] = f2bf(hr); UA[row * 640 + 576 + n] = f2bf(hi);
        const float nr = ar * hr - ai * hi + er, ni = ar * hi + ai * hr + ei;
        hr = nr; hi = ni;
    }
}

struct Args {
    const float* in[42];
    float* out;
    unsigned char* ws;
    int ph_lo, ph_hi;
};

template <bool DUAL, class AF, class WF, class EF>
__device__ __forceinline__ void naive_gemm(LAS float* lds, int M, int N, int K, AF arow, WF wbase, int ldw, EF epi) {
    LAS float* As = lds;
    LAS float* Bs = lds + 64 * 33;
    LAS float* Bs2 = Bs + 32 * 64;
    const int tid = TIDX, ty = tid >> 4, tx = tid & 15;
    const int tm = (M + 63) / 64, tn = (N + 63) / 64;
    for (int tile = blockIdx.x; tile < tm * tn; tile += gridDim.x) {
        const int m0 = (tile / tn) * 64, n0 = (tile % tn) * 64;
        const float* W = wbase(m0, 0);
        const float* W2 = DUAL ? wbase(m0, 1) : W;
        float acc[2][4], acc2[2][4];
#pragma unroll
        for (int i = 0; i < 2; ++i)
#pragma unroll
            for (int j = 0; j < 4; ++j) { acc[i][j] = 0.f; acc2[i][j] = 0.f; }
        for (int k0 = 0; k0 < K; k0 += 32) {
#pragma unroll
            for (int i = 0; i < 4; ++i) {
                const int idx = tid + i * 512, r = idx >> 5, kk = idx & 31, m = m0 + r;
                As[r * 33 + kk] = (m < M) ? bf2f(arow(m)[k0 + kk]) : 0.f;
            }
#pragma unroll
            for (int i = 0; i < 4; ++i) {
                const int idx = tid + i * 512, kk = idx >> 6, n = idx & 63;
                const bool ok = (n0 + n) < N;
                Bs[kk * 64 + n] = ok ? W[(size_t)(k0 + kk) * ldw + n0 + n] : 0.f;
                if (DUAL) Bs2[kk * 64 + n] = ok ? W2[(size_t)(k0 + kk) * ldw + n0 + n] : 0.f;
            }
            __syncthreads();
#pragma unroll 8
            for (int kk = 0; kk < 32; ++kk) {
                const float a0 = As[(ty * 2) * 33 + kk], a1 = As[(ty * 2 + 1) * 33 + kk];
#pragma unroll
                for (int j = 0; j < 4; ++j) {
                    const float b = Bs[kk * 64 + tx * 4 + j];
                    acc[0][j] += a0 * b; acc[1][j] += a1 * b;
                    if (DUAL) { const float b2 = Bs2[kk * 64 + tx * 4 + j]; acc2[0][j] += a0 * b2; acc2[1][j] += a1 * b2; }
                }
            }
            __syncthreads();
        }
#pragma unroll
        for (int i = 0; i < 2; ++i)
#pragma unroll
            for (int j = 0; j < 4; ++j) {
                const int m = m0 + ty * 2 + i, n = n0 + tx * 4 + j;
                if (m < M && n < N) epi(m, n, acc[i][j], acc2[i][j]);
            }
    }
}

template <class SRC, class DROW>
__device__ __forceinline__ void xpose_item(SRC src, DROW drow, bf16_t* WT, int ldk, LAS float* scr, int k0, int n0, int lane) {
#pragma unroll 8
    for (int i = 0; i < 32; ++i) { const int kk = 2 * i + (lane >> 5); scr[kk * 33 + (lane & 31)] = src(k0 + kk, n0 + (lane & 31)); }
    asm volatile("s_waitcnt lgkmcnt(0)" ::: "memory");
    const int c = lane & 7;
#pragma unroll
    for (int j = 0; j < 4; ++j) {
        const int n = (lane >> 3) + 8 * j; const LAS float* sp = scr + (8 * c) * 33 + n;
        u32x4 o; o.x = pk2(sp[0 * 33], sp[1 * 33]); o.y = pk2(sp[2 * 33], sp[3 * 33]); o.z = pk2(sp[4 * 33], sp[5 * 33]); o.w = pk2(sp[6 * 33], sp[7 * 33]);
        *(u32x4*)(WT + (size_t)drow(n0 + n) * ldk + k0 + 8 * c) = o;
    }
    asm volatile("s_waitcnt lgkmcnt(0)" ::: "memory");
}
__device__ __forceinline__ void convert_plain(const float* W, int K, int N, int NP, bf16_t* WT, LAS float* scr, int gw, int ngw, int lane) {
    const int nblk = NP / 32, nitems = (K / 64) * nblk;
    for (int it = gw; it < nitems; it += ngw) {
        const int k0 = 64 * (it / nblk), n0 = 32 * (it % nblk);
        xpose_item([&](int k, int n) { return n < N ? W[(size_t)k * N + n] : 0.f; }, [&](int n) { return n; }, WT, K, scr, k0, n0, lane);
    }
}
__device__ __forceinline__ void convert_lora(const float* w2, const float* a2, const float* g2, bf16_t* WT, LAS float* scr, int gw, int ngw, int lane) {
    const int nblk = NLORA / 32, nitems = 4 * nblk;
    for (int it = gw; it < nitems; it += ngw) {
        const int k0 = 64 * (it / nblk), n0 = 32 * (it % nblk);
        xpose_item([&](int k, int n) {
            if (n < 512) return k < 64 ? w2[k * 512 + n] : 0.f;
            if (n < 1024) return (k >= 64 && k < 128) ? a2[(k - 64) * 512 + (n - 512)] : 0.f;
            return k >= 128 ? g2[(k - 128) * 512 + (n - 1024)] : 0.f; }, [&](int n) { return n; }, WT, 256, scr, k0, n0, lane);
    }
}
__device__ __forceinline__ void convert_moe(const float* w1, const float* w3, const float* w2, bf16_t* W13, bf16_t* W2T, LAS float* scr, int gw, int ngw, int lane) {
    constexpr int I13 = 16 * 32, I2 = 8 * 32, IE = I13 + I2;
    for (int it = gw; it < 32 * IE; it += ngw) {
        const int e = it / IE, r = it % IE;
        if (r < I13) {
            const int k0 = 64 * (r / 32), n0 = 32 * (r % 32);
            const float* a = w1 + (size_t)e * D_ * 512; const float* b = w3 + (size_t)e * D_ * 512;
            xpose_item([&](int k, int n) { return n < 512 ? a[(size_t)k * 512 + n] : b[(size_t)k * 512 + (n - 512)]; },
                       [&](int n) { const int c = n & 511; return (c >> 2) * 8 + (n >> 9) * 4 + (c & 3); }, W13 + (size_t)e * 1024 * 1024, 1024, scr, k0, n0, lane);
        } else {
            const int rr = r - I13, k0 = 64 * (rr / 32), n0 = 32 * (rr % 32);
            const float* a = w2 + (size_t)e * 512 * D_;
            xpose_item([&](int k, int n) { return a[(size_t)k * D_ + n]; }, [&](int n) { return n; }, W2T + (size_t)e * 1024 * 512, 512, scr, k0, n0, lane);
        }
    }
}

__device__ __forceinline__ void ph_prologue(const float* x, bf16_t* hb) {
    const size_t n4 = (size_t)T_ * D_ / 4;
    for (size_t i = (size_t)blockIdx.x * NTHREADS + TIDX; i < n4; i += (size_t)gridDim.x * NTHREADS) {
        const f32x4 v = ((const f32x4*)x)[i];
        u32x2 o; o.x = pk2(v.x, v.y); o.y = pk2(v.z, v.w);
        ((u32x2*)hb)[i] = o;
    }
    for (size_t i = (size_t)blockIdx.x * NTHREADS + TIDX; i < (size_t)256 * D_ / 2; i += (size_t)gridDim.x * NTHREADS)
        ((unsigned*)(hb + (size_t)T_ * D_))[i] = 0u;
}

__device__ __forceinline__ float p0_shift(const bf16_t* P, const float* mu, int t, int c) {
    const float p = bf2f(P[(size_t)t * NIN0P + c]);
    const float pv = ((t & (L_ - 1)) == 0) ? 0.f : bf2f(P[(size_t)(t - 1) * NIN0P + c]);
    return p + mu[c] * (pv - p);
}
template <bool WITH_GLA>
__device__ __forceinline__ void ph_prepA0(const bf16_t* P, const float* mu, const float* gk_w2, const float* gk_b, bf16_t* Ap, float* gla_la) {
    for (int chunk = blockIdx.x; chunk < T_ / 64; chunk += gridDim.x) {
        for (int idx = TIDX; idx < 64 * 256; idx += NTHREADS) {
            const int tl = idx >> 8, j = idx & 255, t = chunk * 64 + tl;
            float v;
            if (j < 64) v = tanhf(p0_shift(P, mu, t, 512 + j));
            else if (j < 128) v = p0_shift(P, mu, t, 1600 + (j - 64));
            else v = sigm(p0_shift(P, mu, t, 1664 + (j - 128)));
            Ap[(size_t)t * 256 + j] = f2bf(v);
            if (WITH_GLA) {
                float gk = gk_b[j];
#pragma unroll
                for (int i = 0; i < 16; ++i) gk += bf2f(P[(size_t)t * NIN0P + 2816 + i]) * gk_w2[i * 256 + j];
                const float ls = fminf(gk, 0.f) - log1pf(__expf(-fabsf(gk)));
                gla_la[(size_t)t * 256 + j] = ls * (1.f / 16.f);
            }
        }
    }
}

__device__ __forceinline__ void ph_prepB0(const bf16_t* P, const bf16_t* LO, const float* mu, const float* w0, const float* a0, const float* k_k, const float* k_a,
                                          const float* r_k, bf16_t* SC, float* BON) {
    const int wave = TIDX >> 6, lane = TIDX & 63;
    for (int item = blockIdx.x * NWAVES + wave; item < T_ * 8; item += gridDim.x * NWAVES) {
        const int t = item >> 3, h = item & 7, c = h * 64 + lane;
        const float r = p0_shift(P, mu, t, c), k = p0_shift(P, mu, t, 576 + c), v = p0_shift(P, mu, t, 1088 + c);
        const float low = bf2f(LO[(size_t)t * 512 + c]), loa = bf2f(LO[(size_t)T_ * 512 + (size_t)t * 512 + c]);
        const float xw = w0[c] + low;
        const float wraw = -softplusf(-xw) - 0.5f;
        const float ld = -__expf(wraw);
        const float a = sigm(a0[c] + loa);
        const float kkr = k * k_k[c];
        const float ss = wave_sum(kkr * kkr);
        const float kk = kkr / fmaxf(sqrtf(ss), 1e-12f);
        const float kp = k * (1.f + (a - 1.f) * k_a[c]);
        const float bon = wave_sum(r * kp * r_k[c]);
        const size_t o = (size_t)t * 512 + c, S1 = (size_t)T_ * 512;
        SC[o] = f2bf(r); SC[S1 + o] = f2bf(ld); SC[2 * S1 + o] = f2bf(kp); SC[3 * S1 + o] = f2bf(v); SC[4 * S1 + o] = f2bf(kk); SC[5 * S1 + o] = f2bf(a);
        if (lane == 0) BON[(size_t)t * 8 + h] = bon;
    }
}

__device__ __forceinline__ void naive_rwkv_scan(LAS float* lds, const bf16_t* SC, float* YRW, int bh) {
    constexpr int TS = 32;
    const int b = bh >> 3, h = bh & 7;
    LAS float* Lnkk = lds;
    LAS float* Ldec = lds + TS * 64;
    LAS float* Lab = lds + 2 * TS * 64;
    LAS float* Lkp = lds + 3 * TS * 64;
    LAS float* Lr = lds + 4 * TS * 64;
    LAS float* Lv = lds + 5 * TS * 64;
    const size_t S1 = (size_t)T_ * 512;
    float S[64];
#pragma unroll
    for (int k = 0; k < 64; ++k) S[k] = 0.f;
    const int lane = TIDX & 63, wave = TIDX >> 6;
    for (int t0 = 0; t0 < L_; t0 += TS) {
        for (int idx = TIDX; idx < TS * 64; idx += NTHREADS) {
            const int s = idx >> 6, k = idx & 63;
            const size_t o = (size_t)(b * L_ + t0 + s) * 512 + h * 64 + k;
            const float r = bf2f(SC[o]), ld = bf2f(SC[S1 + o]), kp = bf2f(SC[2 * S1 + o]), v = bf2f(SC[3 * S1 + o]), kk = bf2f(SC[4 * S1 + o]), a = bf2f(SC[5 * S1 + o]);
            Lnkk[idx] = -kk; Ldec[idx] = __expf(ld); Lab[idx] = kk * a; Lkp[idx] = kp; Lr[idx] = r; Lv[idx] = v;
        }
        __syncthreads();
        if (wave == 0) {
            for (int s = 0; s < TS; ++s) {
                float sa = 0.f;
#pragma unroll
                for (int k = 0; k < 64; ++k) sa += S[k] * Lnkk[s * 64 + k];
                const float vv = Lv[s * 64 + lane];
                float y = 0.f;
#pragma unroll
                for (int k = 0; k < 64; ++k) {
                    S[k] = S[k] * Ldec[s * 64 + k] + sa * Lab[s * 64 + k] + vv * Lkp[s * 64 + k];
                    y += S[k] * Lr[s * 64 + k];
                }
                YRW[(size_t)(b * L_ + t0 + s) * 512 + h * 64 + lane] = y;
            }
        }
        __syncthreads();
    }
}

template <int K, class LDF, class LVF>
__device__ __forceinline__ void naive_gla_scan(LAS float* lds, LDF ld, LVF lv, float* OG, int b, int h) {
    constexpr int TS = 16;
    LAS float* Lq = lds;
    LAS float* Lk = lds + TS * K;
    LAS float* Le = lds + 2 * TS * K;
    LAS float* Lv = lds + 3 * TS * K;
    float S[K];
#pragma unroll
    for (int k = 0; k < K; ++k) S[k] = 0.f;
    const int tid = TIDX;
    for (int t0 = 0; t0 < L_; t0 += TS) {
        for (int idx = tid; idx < TS * K; idx += NTHREADS) {
            const int s = idx / K, k = idx % K;
            float q, kk, e; ld(b * L_ + t0 + s, h * K + k, q, kk, e);
            Lq[idx] = q; Lk[idx] = kk; Le[idx] = e;
        }
        for (int idx = tid; idx < TS * 128; idx += NTHREADS) {
            const int s = idx >> 7, vc = idx & 127;
            Lv[idx] = lv(b * L_ + t0 + s, h * 128 + vc);
        }
        __syncthreads();
        if (tid < 128) {
            for (int s = 0; s < TS; ++s) {
                const float vv = Lv[s * 128 + tid];
                float o = 0.f;
#pragma unroll
                for (int k = 0; k < K; ++k) {
                    S[k] = S[k] * Le[s * K + k] + Lk[s * K + k] * vv;
                    o += Lq[s * K + k] * S[k];
                }
                OG[(size_t)(b * L_ + t0 + s) * 512 + h * 128 + tid] = o;
            }
        }
        __syncthreads();
    }
}

template <bool WITH_GLA>
__device__ __forceinline__ void ph_fin0(const float* YRW, const float* OG, const bf16_t* P, const bf16_t* LO, const bf16_t* SC, const float* BON,
                                        const float* gn_g, const float* gn_b, const float* norm_g, bf16_t* Ymix) {
    const int wave = TIDX >> 6, lane = TIDX & 63;
    const size_t S1 = (size_t)T_ * 512;
    constexpr int NU = WITH_GLA ? 12 : 8;
    for (int item = blockIdx.x * NWAVES + wave; item < T_ * NU; item += gridDim.x * NWAVES) {
        const int t = item / NU, u = item % NU;
        if (u < 8) {
            const int c = u * 64 + lane;
            const float y = YRW[(size_t)t * 512 + c];
            const float mean = wave_sum(y) * (1.f / 64.f);
            const float d = y - mean;
            const float var = wave_sum(d * d) * (1.f / 64.f);
            const float yn = d * rsqrtf(var + 64e-5f) * gn_g[c] + gn_b[c];
            const float v = bf2f(SC[3 * S1 + (size_t)t * 512 + c]);
            const float g = bf2f(LO[(size_t)2 * T_ * 512 + (size_t)t * 512 + c]);
            Ymix[(size_t)t * D_ + c] = f2bf((yn + BON[(size_t)t * 8 + u] * v) * g);
        } else {
            const int h = u - 8;
            const float o0 = OG[(size_t)t * 512 + h * 128 + lane], o1 = OG[(size_t)t * 512 + h * 128 + 64 + lane];
            const float ms = wave_sum(o0 * o0 + o1 * o1) * (1.f / 128.f);
            const float rs = rsqrtf(ms + LN_EPS);
            const float g0 = bf2f(P[(size_t)t * NIN0P + 2832 + h * 128 + lane]), g1 = bf2f(P[(size_t)t * NIN0P + 2832 + h * 128 + 64 + lane]);
            Ymix[(size_t)t * D_ + 512 + h * 128 + lane] = f2bf(o0 * rs * norm_g[lane] * siluf(g0));
            Ymix[(size_t)t * D_ + 512 + h * 128 + 64 + lane] = f2bf(o1 * rs * norm_g[64 + lane] * siluf(g1));
        }
    }
}

__device__ __forceinline__ void ph_ln_router(const float* src, float* hf, bf16_t* hb, const float* lg, const float* lb, const float* wg, const float* bg,
                                             const float* we, const float* be, int* tok_e, int* tok_slot, float* tok_g, unsigned* cnt) {
    const int wave = TIDX >> 6, lane = TIDX & 63;
    for (int t = blockIdx.x * NWAVES + wave; t < T_; t += gridDim.x * NWAVES) {
        const f32x4* xr = (const f32x4*)(src + (size_t)t * D_) + lane;
        f32x4 v[4]; float s = 0.f;
#pragma unroll
        for (int j = 0; j < 4; ++j) { v[j] = xr[64 * j]; s += (v[j].x + v[j].y) + (v[j].z + v[j].w); }
        const float mean = wave_sum(s) * (1.f / D_);
        float s2 = 0.f;
#pragma unroll
        for (int j = 0; j < 4; ++j) { v[j] = v[j] - mean; s2 += (v[j].x * v[j].x + v[j].y * v[j].y) + (v[j].z * v[j].z + v[j].w * v[j].w); }
        const float rstd = rsqrtf(wave_sum(s2) * (1.f / D_) + LN_EPS);
#pragma unroll
        for (int j = 0; j < 4; ++j) {
            const f32x4 g = ((const f32x4*)lg)[lane + 64 * j], bb = ((const f32x4*)lb)[lane + 64 * j];
            v[j] = v[j] * rstd * g + bb;
            ((f32x4*)(hf + (size_t)t * D_))[lane + 64 * j] = v[j];
            u32x2 o; o.x = pk2(v[j].x, v[j].y); o.y = pk2(v[j].z, v[j].w);
            ((u32x2*)(hb + (size_t)t * D_))[lane + 64 * j] = o;
        }
        float cl[4] = {0.f, 0.f, 0.f, 0.f};
#pragma unroll
        for (int j = 0; j < 4; ++j)
#pragma unroll
            for (int e = 0; e < 4; ++e) {
                const int d = 4 * (lane + 64 * j) + e;
                const f32x4 w = *(const f32x4*)(wg + (size_t)d * 4);
                const float xv = v[j][e];
                cl[0] += xv * w.x; cl[1] += xv * w.y; cl[2] += xv * w.z; cl[3] += xv * w.w;
            }
#pragma unroll
        for (int g = 0; g < 4; ++g) cl[g] = wave_sum(cl[g]) + bg[g];
        int grp = 0; float mx = cl[0];
#pragma unroll
        for (int g = 1; g < 4; ++g) if (cl[g] > mx) { mx = cl[g]; grp = g; }
        float den = 0.f;
#pragma unroll
        for (int g = 0; g < 4; ++g) den += __expf(cl[g] - mx);
        const float p_grp = 1.f / den;
        float fl[8];
#pragma unroll
        for (int e = 0; e < 8; ++e) fl[e] = 0.f;
        const float* weg = we + (size_t)grp * D_ * 8;
#pragma unroll
        for (int j = 0; j < 4; ++j)
#pragma unroll
            for (int e = 0; e < 4; ++e) {
                const int d = 4 * (lane + 64 * j) + e;
                const f32x4 w0 = *(const f32x4*)(weg + (size_t)d * 8), w1 = *(const f32x4*)(weg + (size_t)d * 8 + 4);
                const float xv = v[j][e];
                fl[0] += xv * w0.x; fl[1] += xv * w0.y; fl[2] += xv * w0.z; fl[3] += xv * w0.w;
                fl[4] += xv * w1.x; fl[5] += xv * w1.y; fl[6] += xv * w1.z; fl[7] += xv * w1.w;
            }
#pragma unroll
        for (int e = 0; e < 8; ++e) fl[e] = wave_sum(fl[e]) + be[grp * 8 + e];
        int j0 = 0; float m0 = fl[0];
#pragma unroll
        for (int e = 1; e < 8; ++e) if (fl[e] > m0) { m0 = fl[e]; j0 = e; }
        int j1 = -1; float m1 = -3.0e38f;
#pragma unroll
        for (int e = 0; e < 8; ++e) if (e != j0 && fl[e] > m1) { m1 = fl[e]; j1 = e; }
        const float e1 = __expf(m1 - m0);
        const float g0 = p_grp / (1.f + e1), g1 = p_grp * e1 / (1.f + e1);
        if (lane == 0) {
            const int ex0 = grp * 8 + j0, ex1 = grp * 8 + j1;
            const unsigned s0 = atomicAdd(&cnt[ex0], 1u), s1 = atomicAdd(&cnt[ex1], 1u);
            tok_e[2 * t] = ex0; tok_e[2 * t + 1] = ex1;
            tok_slot[2 * t] = (int)s0; tok_slot[2 * t + 1] = (int)s1;
            tok_g[2 * t] = g0; tok_g[2 * t + 1] = g1;
        }
    }
}

__device__ __forceinline__ void moe_offsets(LAS int* pst, const unsigned* cnt) {
    if (TIDX == 0) {
        int acc = 0;
        for (int e = 0; e < 32; ++e) { pst[e] = acc; const int c = (int)cnt[e]; acc += (c + MOE_PAD - 1) / MOE_PAD * MOE_PAD; }
        pst[32] = acc;
    }
    __syncthreads();
}
__device__ __forceinline__ int moe_expert_of_row(const LAS int* pst, int r) {
    int e = 0;
#pragma unroll 1
    for (int i = 1; i < 32; ++i) if (r >= pst[i]) e = i;
    return e;
}

__device__ __forceinline__ void ph_dispatch(LAS int* pst, const unsigned* cnt, const bf16_t* hb, const int* tok_e, const int* tok_slot, int* tok_dest, bf16_t* XR) {
    moe_offsets(pst, cnt);
    const int wave = TIDX >> 6, lane = TIDX & 63;
    for (int item = blockIdx.x * NWAVES + wave; item < T_ * 2; item += gridDim.x * NWAVES) {
        const int t = item >> 1;
        const int e = tok_e[item], dest = pst[e] + tok_slot[item];
        if (lane == 0) tok_dest[item] = dest;
        const u32x4* src = (const u32x4*)(hb + (size_t)t * D_);
        u32x4* dst = (u32x4*)(XR + (size_t)dest * D_);
        dst[lane] = src[lane]; dst[lane + 64] = src[lane + 64];
    }
    const int R = pst[32];
    for (int r = blockIdx.x * NWAVES + wave; r < R; r += gridDim.x * NWAVES) {
        const int e = moe_expert_of_row(pst, r);
        if (r - pst[e] >= (int)cnt[e]) {
            u32x4* dst = (u32x4*)(XR + (size_t)r * D_);
            const u32x4 z = {0u, 0u, 0u, 0u};
            dst[lane] = z; dst[lane + 64] = z;
        }
    }
}

__device__ __forceinline__ void ph_combine_ln(const float* hf, const bf16_t* Y, const int* tok_dest, const float* tok_g, const float* lg, const float* lb, float* outf, bf16_t* hb) {
    const int wave = TIDX >> 6, lane = TIDX & 63;
    for (int t = blockIdx.x * NWAVES + wave; t < T_; t += gridDim.x * NWAVES) {
        const int d0 = tok_dest[2 * t], d1 = tok_dest[2 * t + 1];
        const float g0 = tok_g[2 * t], g1 = tok_g[2 * t + 1];
        f32x4 v[4]; float s = 0.f;
#pragma unroll
        for (int j = 0; j < 4; ++j) {
            const f32x4 h = ((const f32x4*)(hf + (size_t)t * D_))[lane + 64 * j];
            const u32x2 y0 = ((const u32x2*)(Y + (size_t)d0 * D_))[lane + 64 * j], y1 = ((const u32x2*)(Y + (size_t)d1 * D_))[lane + 64 * j];
            f32x4 a, b;
            a.x = __uint_as_float(y0.x << 16); a.y = __uint_as_float(y0.x & 0xffff0000u); a.z = __uint_as_float(y0.y << 16); a.w = __uint_as_float(y0.y & 0xffff0000u);
            b.x = __uint_as_float(y1.x << 16); b.y = __uint_as_float(y1.x & 0xffff0000u); b.z = __uint_as_float(y1.y << 16); b.w = __uint_as_float(y1.y & 0xffff0000u);
            v[j] = h * DN_ALPHA + (a * g0 + b * g1);
            s += (v[j].x + v[j].y) + (v[j].z + v[j].w);
        }
        const float mean = wave_sum(s) * (1.f / D_);
        float s2 = 0.f;
#pragma unroll
        for (int j = 0; j < 4; ++j) { v[j] = v[j] - mean; s2 += (v[j].x * v[j].x + v[j].y * v[j].y) + (v[j].z * v[j].z + v[j].w * v[j].w); }
        const float rstd = rsqrtf(wave_sum(s2) * (1.f / D_) + LN_EPS);
#pragma unroll
        for (int j = 0; j < 4; ++j) {
            const f32x4 g = ((const f32x4*)lg)[lane + 64 * j], bb = ((const f32x4*)lb)[lane + 64 * j];
            v[j] = v[j] * rstd * g + bb;
            ((f32x4*)(outf + (size_t)t * D_))[lane + 64 * j] = v[j];
            u32x2 o; o.x = pk2(v[j].x, v[j].y); o.y = pk2(v[j].z, v[j].w);
            ((u32x2*)(hb + (size_t)t * D_))[lane + 64 * j] = o;
        }
    }
}

__device__ __forceinline__ void naive_s5_scan(const bf16_t* P1, const float* a_re, const float* a_im, const float* log_dt, const float* b_re, const float* b_im,
                                              const float* c_re, const float* c_im, const float* dvec, float* YS5, bf16_t* YS5B, int pair) {
    const int lane = TIDX & 63;
    const int b = pair >> 5, g = pair & 31, n = lane;
    const float lam_re = fminf(a_re[g * 64 + n], -1e-4f), lam_im = a_im[g * 64 + n];
    const float dt = __expf(log_dt[g]);
    const float mag = __expf(lam_re * dt);
    const float ab_re = mag * cosf(lam_im * dt), ab_im = mag * sinf(lam_im * dt);
    const float den = lam_re * lam_re + lam_im * lam_im;
    const float num_re = ab_re - 1.f;
    const float z_re = (num_re * lam_re + ab_im * lam_im) / den;
    const float z_im = (ab_im * lam_re - num_re * lam_im) / den;
    float bre[16], bim[16], cre[16], cim[16];
#pragma unroll
    for (int c = 0; c < 16; ++c) {
        bre[c] = b_re[(size_t)(g * 64 + n) * 16 + c]; bim[c] = b_im[(size_t)(g * 64 + n) * 16 + c];
        cre[c] = c_re[(size_t)(g * 16 + c) * 64 + n]; cim[c] = c_im[(size_t)(g * 16 + c) * 64 + n];
    }
    const float dd = (lane < 16) ? dvec[g * 16 + lane] : 0.f;
    float h_re = 0.f, h_im = 0.f;
    for (int tt = 0; tt < L_; ++tt) {
        const size_t t = (size_t)b * L_ + tt;
        const float ul = (lane < 16) ? bf2f(P1[t * NIN1 + g * 16 + lane]) : 0.f;
        float bur = 0.f, bui = 0.f;
#pragma unroll
        for (int c = 0; c < 16; ++c) { const float u = __shfl(ul, c); bur += u * bre[c]; bui += u * bim[c]; }
        const float x_re = z_re * bur - z_im * bui, x_im = z_re * bui + z_im * bur;
        const float nh_re = ab_re * h_re - ab_im * h_im + x_re;
        const float nh_im = ab_re * h_im + ab_im * h_re + x_im;
        h_re = nh_re; h_im = nh_im;
        float yv = 0.f;
#pragma unroll
        for (int c = 0; c < 16; ++c) { const float y = wave_sum(h_re * cre[c] - h_im * cim[c]); if (lane == c) yv = y; }
        if (lane < 16) {
            const float y = gelu_tanh(yv + dd * ul);
            YS5[t * 512 + g * 16 + lane] = y;
            YS5B[t * 512 + g * 16 + lane] = f2bf(y);
        }
    }
}

__device__ __forceinline__ void ph_fin1(const float* OG, const bf16_t* P1, const float* norm_g, bf16_t* Ymix) {
    const int wave = TIDX >> 6, lane = TIDX & 63;
    for (int item = blockIdx.x * NWAVES + wave; item < T_ * 4; item += gridDim.x * NWAVES) {
        const int t = item >> 2, h = item & 3;
        const float o0 = OG[(size_t)t * 512 + h * 128 + lane], o1 = OG[(size_t)t * 512 + h * 128 + 64 + lane];
        const float ms = wave_sum(o0 * o0 + o1 * o1) * (1.f / 128.f);
        const float rs = rsqrtf(ms + LN_EPS);
        const float g0 = bf2f(P1[(size_t)t * NIN1 + 2048 + h * 128 + lane]), g1 = bf2f(P1[(size_t)t * NIN1 + 2048 + h * 128 + 64 + lane]);
        Ymix[(size_t)t * D_ + 512 + h * 128 + lane] = f2bf(o0 * rs * norm_g[lane] * siluf(g0));
        Ymix[(size_t)t * D_ + 512 + h * 128 + 64 + lane] = f2bf(o1 * rs * norm_g[64 + lane] * siluf(g1));
    }
}

constexpr int LDS_BYTES = 147456;
constexpr int MISC_OFF = 131072 + 8192;
enum Phase {
    PH_PROLOGUE = 0,
    PH_INPROJ0, PH_PREPA0, PH_LORA0, PH_PREPB0, PH_SCAN0, PH_SCAN0B, PH_FIN0, PH_OUTPROJ0, PH_LN1_0, PH_DISP0, PH_UP0, PH_DOWN0, PH_COMB0,
    PH_INPROJ1, PH_L1A, PH_L1B, PH_L1C, PH_L1D, PH_SCAN1, PH_FIN1, PH_GLU1, PH_OUTPROJ1, PH_LN1_1, PH_DISP1, PH_UP1, PH_DOWN1, PH_COMB1,
    PH_COUNT
};

typedef const Args __attribute__((address_space(4)))* KArgsP;
__device__ __forceinline__ KArgsP fresh_args() { KArgsP p = (KArgsP)__builtin_amdgcn_kernarg_segment_ptr(); asm volatile("" : "+s"(p)); return p; }
#define PHASE_BEGIN KArgsP ap = fresh_args(); unsigned char* const ws = ap->ws; (void)ws;
#define INP(i) (ap->in[i])
#define W_CTL ((unsigned*)(ws + WS_CTL))
#define W_HB ((bf16_t*)(ws + WS_HB))
#define W_WIN0 ((bf16_t*)(ws + WS_WIN0))
#define W_WOUT0 ((bf16_t*)(ws + WS_WOUT0))
#define W_WIN1 ((bf16_t*)(ws + WS_WIN1))
#define W_WOUT1 ((bf16_t*)(ws + WS_WOUT1))
#define W_WGLU ((bf16_t*)(ws + WS_WGLU))
#define W_WLORA ((bf16_t*)(ws + WS_WLORA))
#define W_W13 ((bf16_t*)(ws + WS_W13))
#define W_W2 ((bf16_t*)(ws + WS_W2))
#define W_HA ((float*)(ws + WS_HA))
#define W_YRW W_HA
#define W_OG (W_HA + (size_t)T_ * 512)
#define W_P ((bf16_t*)(ws + WS_P))
#define W_LO ((bf16_t*)(ws + WS_LO))
#define W_SC ((bf16_t*)(ws + WS_SCAN))
#define W_GLALA ((float*)(ws + WS_GLALA))
#define W_BON ((float*)(ws + WS_BON))
#define W_AP ((bf16_t*)(ws + WS_APRIME))
#define W_YS5B ((bf16_t*)(ws + WS_YS5B))
#define W_XR ((bf16_t*)(ws + WS_XR))
#define W_HID ((bf16_t*)(ws + WS_HID))
#define W_Y ((bf16_t*)(ws + WS_Y))
#define W_TOKE ((int*)(ws + WS_ROUTE))
#define W_TOKSLOT (W_TOKE + 2 * T_)
#define W_TOKDEST (W_TOKE + 4 * T_)
#define W_TOKG ((float*)(W_TOKE + 6 * T_))
#define W_YMIX W_HB
#define BIGP(mib) (ws + WS_BIG + (size_t)(mib) * MiB)
#define GLA0_BUFS GlaBufs{(bf16_t*)BIGP(256), (bf16_t*)BIGP(264), (bf16_t*)(ws + WS_HB), (bf16_t*)BIGP(273), (float*)BIGP(289), W_HA + (size_t)T_ * 512, (bf16_t*)BIGP(112)}
#define HG_BUFS GlaBufs{(bf16_t*)BIGP(96), (bf16_t*)BIGP(112), (bf16_t*)BIGP(144), (bf16_t*)BIGP(128), (float*)BIGP(176), (float*)BIGP(177), (bf16_t*)BIGP(144)}
#define W_S5WE ((bf16_t*)BIGP(160))
#define W_S5UA ((bf16_t*)BIGP(241))
#define W_S5MB ((bf16_t*)BIGP(261))
#define W_S5E ((float*)BIGP(281))
#define CW_SUB 12288

#define IN(k) (PLO <= (k) && (k) < PHI)
#define SEAM(k) do { if (IN(k) && IN((k) + 1)) { PHASE_BEGIN XcdBarrier bar_; bar_.bar = W_CTL + CW_BAR; bar_.x = xb_xcc_id(); bar_.st = (volatile LAS unsigned*)(lds + MISC_OFF) + 8; xcd_barrier(bar_); } } while (0)
template <int PLO, int PHI, int layer>
__device__ __forceinline__ void moe_layer(LAS unsigned char* lds) {
    LAS float* ldsf = (LAS float*)lds; (void)ldsf;
        const int base = layer == 0 ? PH_OUTPROJ0 : PH_OUTPROJ1;
        if (IN(base + 0)) {
            PHASE_BEGIN
            const float* W = layer == 0 ? INP(16) : INP(30);
            float* V1 = layer == 0 ? ap->out : W_HA;
            const float* resid = layer == 0 ? INP(0) : ap->out;
#if FAST_GEMM
            (void)W;
            { pg8::Gemm g{W_YMIX, layer == 0 ? W_WOUT0 : W_WOUT1, T_, D_, D_}; pg8::StaticOrder S; S.init(T_, D_, (int)gridDim.x, (int)blockIdx.x); pg8::EpiResidF32 E{resid, V1, D_, DN_ALPHA};
              pg8::gemm_phase<pg8::EpiResidF32, pg8::StaticOrder, true, true>(lds, g, S, E); }
#else
            const bf16_t* Ymix = W_YMIX;
            naive_gemm<false>(ldsf, T_, D_, D_, [&](int m) { return Ymix + (size_t)m * D_; }, [&](int, int) { return W; }, D_,
                              [&](int m, int n, float a, float) { V1[(size_t)m * D_ + n] = DN_ALPHA * resid[(size_t)m * D_ + n] + a; });
#endif
        }
        SEAM(base + 0);
        if (IN(base + 1)) {
            PHASE_BEGIN
            const float* V1 = layer == 0 ? ap->out : W_HA;
            ph_ln_router(V1, W_HA, W_HB, INP(31) + layer * D_, INP(32) + layer * D_, INP(33) + (size_t)layer * D_ * 4, INP(34) + layer * 4,
                         INP(35) + (size_t)layer * 4 * D_ * 8, INP(36) + layer * 32, W_TOKE, W_TOKSLOT, W_TOKG, W_CTL + CW_CNT + 64 * layer);
        }
        SEAM(base + 1);
        if (IN(base + 2)) { PHASE_BEGIN ph_dispatch((LAS int*)lds, W_CTL + CW_CNT + 64 * layer, W_HB, W_TOKE, W_TOKSLOT, W_TOKDEST, W_XR); }
        SEAM(base + 2);
        if (IN(base + 3)) {
            PHASE_BEGIN
#if FAST_GEMM
            { LAS int* pst = (LAS int*)(lds + 131072 + 2048); LAS int* tile_e = (LAS int*)(lds + 131072 + 1024);
              moe_offsets(pst, W_CTL + CW_CNT + 64 * layer);
              const int ntiles = pst[32] / 256;
              if ((int)TIDX < ntiles) tile_e[TIDX] = moe_expert_of_row(pst, TIDX * 256);
              __syncthreads();
              pg8::Gemm g{W_XR, W_W13, ntiles * 256, 1024, D_}; pg8::MoeOrder S{ntiles, 4, (int)gridDim.x, (int)blockIdx.x, tile_e}; pg8::EpiSwiglu E{W_HID};
              pg8::gemm_phase<pg8::EpiSwiglu, pg8::MoeOrder, true, true>(lds, g, S, E); }
#else
            LAS int* pst = (LAS int*)(lds + 65536);
            moe_offsets(pst, W_CTL + CW_CNT + 64 * layer);
            const float* w1 = INP(37) + (size_t)layer * 32 * D_ * 512; const float* w3 = INP(38) + (size_t)layer * 32 * D_ * 512;
            const bf16_t* XR = W_XR; bf16_t* HID = W_HID;
            naive_gemm<true>(ldsf, pst[32], 512, D_, [&](int m) { return XR + (size_t)m * D_; },
                             [&](int m0, int which) { const int e = moe_expert_of_row(pst, m0); return (which ? w3 : w1) + (size_t)e * D_ * 512; }, 512,
                             [&](int m, int n, float a, float b) { HID[(size_t)m * 512 + n] = f2bf(siluf(a) * b); });
#endif
        }
        SEAM(base + 3);
        if (IN(base + 4)) {
            PHASE_BEGIN
#if FAST_GEMM
            { LAS int* pst = (LAS int*)(lds + 131072 + 2048); LAS int* tile_e = (LAS int*)(lds + 131072 + 1024);
              moe_offsets(pst, W_CTL + CW_CNT + 64 * layer);
              const int ntiles = pst[32] / 256;
              if ((int)TIDX < ntiles) tile_e[TIDX] = moe_expert_of_row(pst, TIDX * 256);
              __syncthreads();
              pg8::Gemm g{W_HID, W_W2, ntiles * 256, 1024, 512}; pg8::MoeOrder S{ntiles, 4, (int)gridDim.x, (int)blockIdx.x, tile_e}; pg8::EpiStoreBf16 E{W_Y, D_, 0, 0};
              pg8::gemm_phase<pg8::EpiStoreBf16, pg8::MoeOrder, true, true>(lds, g, S, E); }
#else
            LAS int* pst = (LAS int*)(lds + 65536);
            moe_offsets(pst, W_CTL + CW_CNT + 64 * layer);
            const float* w2 = INP(39) + (size_t)layer * 32 * 512 * D_;
            const bf16_t* HID = W_HID; bf16_t* Y = W_Y;
            naive_gemm<false>(ldsf, pst[32], D_, 512, [&](int m) { return HID + (size_t)m * 512; },
                              [&](int m0, int) { const int e = moe_expert_of_row(pst, m0); return w2 + (size_t)e * 512 * D_; }, D_,
                              [&](int m, int n, float a, float) { Y[(size_t)m * D_ + n] = f2bf(a); });
#endif
        }
        SEAM(base + 4);
        if (IN(base + 5)) { PHASE_BEGIN ph_combine_ln(W_HA, W_Y, W_TOKDEST, W_TOKG, INP(40) + layer * D_, INP(41) + layer * D_, ap->out, W_HB); }
        SEAM(base + 5);

}

template <int PLO, int PHI>
__device__ __forceinline__ void mega_body(unsigned char* lds_raw) {
    LAS unsigned char* lds = (LAS unsigned char*)lds_raw;
    LAS float* ldsf = (LAS float*)lds;
    constexpr bool MULTI = (PHI - PLO) > 1;
    if (MULTI) {
        PHASE_BEGIN
        volatile LAS unsigned* MISC = (volatile LAS unsigned*)(lds + MISC_OFF);
        if (TIDX < 32) MISC[TIDX] = 0u;
        __syncthreads();
        (void)xcd_barrier_post(W_CTL + CW_BAR, MISC + 8);
    }

    if (IN(PH_PROLOGUE)) {
        PHASE_BEGIN ph_prologue(INP(0), W_HB);
#if FAST_GEMM
        LAS float* scr = ldsf + (TIDX >> 6) * (64 * 33);
        const int gw = blockIdx.x * NWAVES + (TIDX >> 6), ngw = gridDim.x * NWAVES, lane = TIDX & 63;
        convert_plain(INP(1), D_, NIN0, NIN0P, W_WIN0, scr, gw, ngw, lane);
        convert_plain(INP(16), D_, D_, D_, W_WOUT0, scr, gw, ngw, lane);
        convert_plain(INP(17), D_, NIN1, NIN1, W_WIN1, scr, gw, ngw, lane);
        convert_plain(INP(30), D_, D_, D_, W_WOUT1, scr, gw, ngw, lane);
        convert_plain(INP(26), 512, 512, 512, W_WGLU, scr, gw, ngw, lane);
        convert_lora(INP(4), INP(6), INP(7), W_WLORA, scr, gw, ngw, lane);
        convert_moe(INP(37), INP(38), INP(39), W_W13, W_W2, scr, gw, ngw, lane);
#endif
    }
    SEAM(PH_PROLOGUE);
    if (IN(PH_INPROJ0)) {
        PHASE_BEGIN
#if FAST_GEMM
        { pg8::Gemm g{W_HB, W_WIN0, T_, NIN0P, D_}; pg8::StaticOrder S; S.init(T_, NIN0P, (int)gridDim.x, (int)blockIdx.x); pg8::EpiStoreBf16 E{W_P, NIN0P, 0, 0};
          pg8::gemm_phase<pg8::EpiStoreBf16, pg8::StaticOrder, true, true>(lds, g, S, E); }
#else
        const float* W = INP(1); const bf16_t* A = W_HB; bf16_t* P = W_P;
        naive_gemm<false>(ldsf, T_, NIN0, D_, [&](int m) { return A + (size_t)m * D_; }, [&](int, int) { return W; }, NIN0,
                          [&](int m, int n, float a, float) { P[(size_t)m * NIN0P + n] = f2bf(a); });
#endif
    }
    SEAM(PH_INPROJ0);
    if (IN(PH_PREPA0)) { PHASE_BEGIN ph_prepA0<!FAST_GLA0>(W_P, INP(2), INP(13), INP(14), W_AP, W_GLALA); }
    SEAM(PH_PREPA0);
    if (IN(PH_LORA0)) {
        PHASE_BEGIN
#if FAST_GEMM
        { pg8::Gemm g{W_AP, W_WLORA, T_, NLORA, 256}; pg8::StaticOrder S; S.init(T_, NLORA, (int)gridDim.x, (int)blockIdx.x); pg8::EpiStoreBf16 E{W_LO, 512, 512, (size_t)T_ * 512};
          pg8::gemm_phase<pg8::EpiStoreBf16, pg8::StaticOrder, true, true>(lds, g, S, E); }
#else
        const float* w2 = INP(4); const float* a2 = INP(6); const float* g2 = INP(7); const bf16_t* AP = W_AP; bf16_t* LO = W_LO;
        naive_gemm<false>(ldsf, T_, 512, 64, [&](int m) { return AP + (size_t)m * 256; }, [&](int, int) { return w2; }, 512,
                          [&](int m, int n, float a, float) { LO[(size_t)m * 512 + n] = f2bf(a); });
        naive_gemm<false>(ldsf, T_, 512, 64, [&](int m) { return AP + (size_t)m * 256 + 64; }, [&](int, int) { return a2; }, 512,
                          [&](int m, int n, float a, float) { LO[(size_t)T_ * 512 + (size_t)m * 512 + n] = f2bf(a); });
        naive_gemm<false>(ldsf, T_, 512, 128, [&](int m) { return AP + (size_t)m * 256 + 128; }, [&](int, int) { return g2; }, 512,
                          [&](int m, int n, float a, float) { LO[(size_t)2 * T_ * 512 + (size_t)m * 512 + n] = f2bf(a); });
#endif
    }
    SEAM(PH_LORA0);
    if (IN(PH_PREPB0)) {
        PHASE_BEGIN ph_prepB0(W_P, W_LO, INP(2), INP(3), INP(5), INP(8), INP(9), INP(10), W_SC, W_BON);
#if FAST_GLA0
        { const GlaBufs GB = GLA0_BUFS; __syncthreads();
          for (int cg = blockIdx.x; cg < 256; cg += gridDim.x) gla_prep_tile<64, 0>(ldsf, W_P, INP(13), INP(14), GB, cg); }
#endif
    }
    SEAM(PH_PREPB0);
#if FAST_RWKV == 2
#define RW_G ((bf16_t*)BIGP(128))
#define RW_RM ((bf16_t*)ap->out)
#define RW_HT (ap->out + (size_t)4 * 1024 * 1024)
#define RW_YM ((bf16_t*)(ap->out + (size_t)12 * 1024 * 1024))
    if (IN(PH_SCAN0)) {
        PHASE_BEGIN
        for (int it = blockIdx.x; it < 2048; it += gridDim.x) rwkv_chunk_pre(lds, W_SC, RW_G, RW_RM, RW_HT, RW_YM, it);
        { const GlaBufs GB = GLA0_BUFS; const int wave = TIDX >> 6, lane = TIDX & 63;
          for (int u = blockIdx.x * NWAVES + wave; u < 1024 * 4; u += gridDim.x * NWAVES) gla_pass1_unit<64>(GB, u, lane); }
    }
    SEAM(PH_SCAN0);
    if (IN(PH_SCAN0B)) {
        PHASE_BEGIN
        const int bid = blockIdx.x;
        if (bid < 16) rwkv_chunk_seq(lds, RW_G, RW_RM, RW_HT, RW_YM, W_YRW, bid);
        else {
            const GlaBufs GB = GLA0_BUFS;
            const int nb = (int)gridDim.x - 16, b0 = bid - 16;
            gla_pass2<64>(GB, b0 * NTHREADS + TIDX, nb * NTHREADS);
            sub_barrier(W_CTL + CW_SUB + 64, (unsigned)nb);
            for (int it = b0; it < 1024; it += nb) gla_pass3_item<64, 0>(lds, W_P, INP(15), GB, W_YMIX, it);
        }
    }
    SEAM(PH_SCAN0B);
#else
    if (IN(PH_SCAN0)) {
        PHASE_BEGIN
        const int bid = blockIdx.x;
#if FAST_RWKV
        constexpr int NRW = 128;
        if (bid < NRW) rwkv_scan_v1(ldsf, W_SC, W_YRW, bid);
#else
        constexpr int NRW = 16;
        if (bid < NRW) naive_rwkv_scan(ldsf, W_SC, W_YRW, bid);
#endif
#if FAST_GLA0
        else {
            const GlaBufs GB = GLA0_BUFS;
            const int nb = (int)gridDim.x - NRW, b0 = bid - NRW, wave = TIDX >> 6, lane = TIDX & 63;
            for (int u = b0 * NWAVES + wave; u < 1024 * 4; u += nb * NWAVES) gla_pass1_unit<64>(GB, u, lane);
            sub_barrier(W_CTL + CW_SUB, (unsigned)nb);
            gla_pass2<64>(GB, b0 * NTHREADS + TIDX, nb * NTHREADS);
            sub_barrier(W_CTL + CW_SUB + 64, (unsigned)nb);
            for (int it = b0; it < 1024; it += nb) gla_pass3_item<64, 0>(lds, W_P, INP(15), GB, W_YMIX, it);
        }
#else
        else if (bid < 24) {
            const int bh = bid - 16;
            const bf16_t* P = W_P; const float* GLALA = W_GLALA;
            naive_gla_scan<64>(ldsf,
                [&](int t, int ck, float& q, float& kk, float& e) {
                    q = bf2f(P[(size_t)t * NIN0P + 1792 + ck]) * 0.125f; kk = bf2f(P[(size_t)t * NIN0P + 2048 + ck]); e = __expf(GLALA[(size_t)t * 256 + ck]); },
                [&](int t, int cv) { return bf2f(P[(size_t)t * NIN0P + 2304 + cv]); }, W_OG, bh >> 2, bh & 3);
        }
#endif
    }
    SEAM(PH_SCAN0);
    SEAM(PH_SCAN0B);
#endif
    if (IN(PH_FIN0)) { PHASE_BEGIN ph_fin0<!FAST_GLA0>(W_YRW, W_OG, W_P, W_LO, W_SC, W_BON, INP(11), INP(12), INP(15), W_YMIX); }
    SEAM(PH_FIN0);

    moe_layer<PLO, PHI, 0>(lds);
            if (IN(PH_INPROJ1)) {
                PHASE_BEGIN
#if FAST_GEMM
                { pg8::Gemm g{W_HB, W_WIN1, T_, NIN1, D_}; pg8::StaticOrder S; S.init(T_, NIN1, (int)gridDim.x, (int)blockIdx.x); pg8::EpiStoreBf16 E{W_P, NIN1, 0, 0};
                  pg8::gemm_phase<pg8::EpiStoreBf16, pg8::StaticOrder, true, true>(lds, g, S, E); }
#else
                const float* W = INP(17); const bf16_t* A = W_HB; bf16_t* P = W_P;
                naive_gemm<false>(ldsf, T_, NIN1, D_, [&](int m) { return A + (size_t)m * D_; }, [&](int, int) { return W; }, NIN1,
                                  [&](int m, int n, float a, float) { P[(size_t)m * NIN1 + n] = f2bf(a); });
#endif
            }
            SEAM(PH_INPROJ1);
            if (IN(PH_L1A)) {
                PHASE_BEGIN
#if FAST_S5
                if (blockIdx.x >= 224) s5_tables(ldsf, INP(18), INP(19), INP(20), INP(21), INP(22), INP(23), INP(24), W_S5MB, W_S5WE, (int)blockIdx.x - 224);
                s5_fill_ua(W_P, W_S5UA, blockIdx.x * NWAVES + (TIDX >> 6), gridDim.x * NWAVES, TIDX & 63);
                __syncthreads();
#endif
#if FAST_HG
                { const GlaBufs GB = HG_BUFS;
                  for (int cg = blockIdx.x; cg < 256; cg += gridDim.x) gla_prep_tile<128, 1>(ldsf, W_P, INP(28), nullptr, GB, cg); }
#endif
            }
            SEAM(PH_L1A);
            if (IN(PH_L1B)) {
                PHASE_BEGIN
                const int bid = blockIdx.x;
#if FAST_S5
                if (bid < 64) {
                    LAS int* tile_e = (LAS int*)(lds + 131072 + 1024);
                    if (TIDX < 64) tile_e[TIDX] = TIDX >> 1;
                    __syncthreads();
                    pg8::Gemm g{W_S5UA, W_S5WE, 64 * 256, 256, 512, 640}; pg8::MoeOrder S{64, 1, 64, bid, tile_e}; pg8::EpiStoreF32 E{W_S5E, 256};
                    pg8::gemm_phase<pg8::EpiStoreF32, pg8::MoeOrder, true, true>(lds, g, S, E);
                }
#endif
#if FAST_HG
                if (bid >= 64) {
                    const GlaBufs GB = HG_BUFS;
                    const int nb = (int)gridDim.x - 64, b0 = bid - 64, wave = TIDX >> 6, lane = TIDX & 63;
                    for (int u = b0 * NWAVES + wave; u < 1024 * 8; u += nb * NWAVES) gla_pass1_unit<128>(GB, u, lane);
                }
#endif
            }
            SEAM(PH_L1B);
            if (IN(PH_L1C)) {
                PHASE_BEGIN
                const int bid = blockIdx.x;
#if FAST_S5
                if (bid < 8) s5_carry(INP(18), INP(19), INP(20), W_S5E, W_S5UA, bid * NTHREADS + TIDX);
#endif
#if FAST_HG
                if (bid >= 8) { const GlaBufs GB = HG_BUFS; gla_pass2<128>(GB, (bid - 8) * NTHREADS + TIDX, ((int)gridDim.x - 8) * NTHREADS); }
#endif
#if FAST_GEMM
                { LAS float* scr = ldsf + (TIDX >> 6) * (64 * 33);
                  convert_moe(INP(37) + (size_t)32 * D_ * 512, INP(38) + (size_t)32 * D_ * 512, INP(39) + (size_t)32 * 512 * D_, W_W13, W_W2, scr,
                              bid * NWAVES + (TIDX >> 6), (int)gridDim.x * NWAVES, TIDX & 63); }
#endif
            }
            SEAM(PH_L1C);
            if (IN(PH_L1D)) {
                PHASE_BEGIN
                const int bid = blockIdx.x;
#if FAST_S5
                if (bid < 128) {
                    LAS int* tile_e = (LAS int*)(lds + 131072 + 1024);
                    if (TIDX < 64) tile_e[TIDX] = TIDX >> 1;
                    __syncthreads();
                    pg8::Gemm g{W_S5UA, W_S5MB, 64 * 256, 512, 640, 640}; pg8::MoeOrder S{64, 2, 128, bid, tile_e}; pg8::EpiS5Y E{W_P, INP(25), W_YRW, W_YS5B};
                    pg8::gemm_phase<pg8::EpiS5Y, pg8::MoeOrder, true, true>(lds, g, S, E);
                }
#endif
#if FAST_HG
                if (bid >= 128) {
                    const GlaBufs GB = HG_BUFS;
                    for (int it = bid - 128; it < 1024; it += (int)gridDim.x - 128) gla_pass3_item<128, 1>(lds, W_P, INP(29), GB, W_YMIX, it);
                }
#endif
            }
            SEAM(PH_L1D);
            if (IN(PH_SCAN1)) {
                PHASE_BEGIN
                const int bid = blockIdx.x;
                const bf16_t* P = W_P; (void)P; (void)bid;
#if !FAST_HG
                if (bid < 8) {
                    const float* hg_lb = INP(28);
                    naive_gla_scan<128>(ldsf,
                        [&](int t, int ck, float& q, float& kk, float& e) {
                            const float l0 = hg_lb[ck], l1 = hg_lb[512 + ck];
                            const float lbv = 1.f / (1.f + __expf(l0 - l1));
                            const float f = bf2f(P[(size_t)t * NIN1 + 1024 + ck]);
                            const float sg = sigm(f);
                            q = siluf(bf2f(P[(size_t)t * NIN1 + 512 + ck])); kk = (1.f - lbv) * (1.f - sg); e = lbv + (1.f - lbv) * sg; },
                        [&](int t, int cv) { return bf2f(P[(size_t)t * NIN1 + 1536 + cv]); }, W_OG, bid >> 2, bid & 3);
                }
#endif
#if !FAST_S5
                if (bid >= 8 && bid < 16) {
                    const int pair = (bid - 8) * 8 + (TIDX >> 6);
                    naive_s5_scan(P, INP(18), INP(19), INP(20), INP(21), INP(22), INP(23), INP(24), INP(25), W_YRW, W_YS5B, pair);
                }
#endif
            }
            SEAM(PH_SCAN1);
#if !FAST_HG
            if (IN(PH_FIN1)) { PHASE_BEGIN ph_fin1(W_OG, W_P, INP(29), W_YMIX); }
#endif
            SEAM(PH_FIN1);
            if (IN(PH_GLU1)) {
                PHASE_BEGIN
#if FAST_GEMM
                { pg8::Gemm g{W_YS5B, W_WGLU, T_, 512, 512}; pg8::StaticOrder S; S.init(T_, 512, (int)gridDim.x, (int)blockIdx.x); pg8::EpiGlu E{W_YRW, 512, INP(27), W_YMIX, D_};
                  pg8::gemm_phase<pg8::EpiGlu, pg8::StaticOrder, true, true>(lds, g, S, E); }
#else
                const float* W = INP(26); const float* gb = INP(27); const bf16_t* YS5B = W_YS5B; const float* YRW = W_YRW; bf16_t* Ymix = W_YMIX;
                naive_gemm<false>(ldsf, T_, 512, 512, [&](int m) { return YS5B + (size_t)m * 512; }, [&](int, int) { return W; }, 512,
                                  [&](int m, int n, float a, float) { const float y = YRW[(size_t)m * 512 + n]; Ymix[(size_t)m * D_ + n] = f2bf(y * sigm(a + gb[n])); });
#endif
            }
            SEAM(PH_GLU1);
    moe_layer<PLO, PHI, 1>(lds);
#undef IN
}
template <int PLO, int PHI>
__global__ void __launch_bounds__(NTHREADS, 2) mega(Args args) {
    extern __shared__ __attribute__((aligned(16))) unsigned char lds_raw[];
    mega_body<PLO, PHI>(lds_raw);
}

#include <utility>
template <int... I> static void set_attrs(std::integer_sequence<int, I...>) {
    (void)std::initializer_list<int>{ ((void)hipFuncSetAttribute((const void*)mega<I, I + 1>, hipFuncAttributeMaxDynamicSharedMemorySize, LDS_BYTES), 0)... };
}
template <int I> static int launch_one(int grid, hipStream_t stream, const Args& a) {
    hipLaunchKernelGGL((mega<I, I + 1>), dim3(grid), dim3(NTHREADS), LDS_BYTES, stream, a);
    return 0;
}
template <int... I> static void launch_all(std::integer_sequence<int, I...>, int grid, hipStream_t stream, const Args& a) {
    (void)std::initializer_list<int>{ launch_one<I>(grid, stream, a)... };
}
extern "C" void kernel_launch(void* const* d_in, const int* in_sizes, int n_in, void* d_out, int out_size, void* d_ws, size_t ws_size, hipStream_t stream) {
    static int grid = 0;
    if (grid == 0) {
        if (n_in != 42 || out_size != T_ * D_ || ws_size < WS_END) { fprintf(stderr, "kernel_launch: unexpected shapes n_in %d out %d ws %zu\n", n_in, out_size, ws_size); grid = -1; return; }
        int dev = 0, cus = 0, per_cu = 0;
        hipGetDevice(&dev);
        hipDeviceGetAttribute(&cus, hipDeviceAttributeMultiprocessorCount, dev);
        set_attrs(std::make_integer_sequence<int, PH_COUNT>{});
        hipFuncSetAttribute((const void*)mega<0, PH_COUNT>, hipFuncAttributeMaxDynamicSharedMemorySize, LDS_BYTES);
        hipOccupancyMaxActiveBlocksPerMultiprocessor(&per_cu, (const void*)mega<0, PH_COUNT>, NTHREADS, LDS_BYTES);
        (void)hipGetLastError();
        if (per_cu < 1) per_cu = 1;
        grid = cus * 1;
        fprintf(stderr, "kernel_launch: cus %d per_cu %d grid %d\n", cus, per_cu, grid);
    }
    if (grid < 0) return;
    hipMemsetAsync((char*)d_ws + WS_CTL, 0, CTL_ZERO_BYTES, stream);
    Args a{};
    for (int i = 0; i < 42; ++i) a.in[i] = (const float*)d_in[i];
    a.out = (float*)d_out; a.ws = (unsigned char*)d_ws;
#if MK_SINGLE
    void* kargs[] = {(void*)&a};
    hipError_t e = hipLaunchCooperativeKernel((const void*)mega<0, PH_COUNT>, dim3(grid), dim3(NTHREADS), kargs, LDS_BYTES, stream);
    if (e != hipSuccess) fprintf(stderr, "cooperative launch failed: %s (grid %d)\n", hipGetErrorString(e), grid);
#else
    launch_all(std::make_integer_sequence<int, PH_COUNT>{}, grid, stream, a);
#endif
}
#ifdef TEST_RANGES
template __global__ void mega<0, 2>(Args);
template __global__ void mega<1, 3>(Args);
template __global__ void mega<1, 4>(Args);
template __global__ void mega<3, 8>(Args);
template __global__ void mega<7, 13>(Args);
template __global__ void mega<10, 12>(Args);
template __global__ void mega<13, 17>(Args);
template __global__ void mega<0, 13>(Args);
#endif
```

```cpp
#include <hip/hip_runtime.h>
#include <cstdio>
#include <cstdint>

#define GAS __attribute__((address_space(1)))
#define LAS __attribute__((address_space(3)))
typedef unsigned short bf16_t;
typedef float f32x4 __attribute__((ext_vector_type(4)));
typedef unsigned u32x4 __attribute__((ext_vector_type(4)));
typedef unsigned u32x2 __attribute__((ext_vector_type(2)));
__device__ __forceinline__ int launder_tid() { int t = (int)threadIdx.x; asm volatile("" : "+v"(t)); return t; }
#define TIDX launder_tid()

#ifndef FAST_GEMM
#define FAST_GEMM 1
#endif
#ifndef FAST_LN
#define FAST_LN 1
#endif
#ifndef FAST_RWKV
#define FAST_RWKV 2
#endif
#ifndef FAST_GLA0
#define FAST_GLA0 1
#endif
#ifndef FAST_HG
#define FAST_HG 1
#endif
#ifndef FAST_S5
#define FAST_S5 1
#endif
#ifndef MK_SINGLE
#define MK_SINGLE 1
#endif

constexpr int T_ = 16384, L_ = 8192, D_ = 1024;
constexpr int NIN0 = 3344, NIN0P = 3584, NIN1 = 2560;
constexpr int NLORA = 1536;
constexpr int RMAX = 40960;
constexpr int MOE_PAD = 256;
constexpr float DN_ALPHA = 1.41421356237f;
constexpr float LN_EPS = 1e-5f;
constexpr int NTHREADS = 512, NWAVES = 8;

constexpr size_t MiB = 1u << 20;
constexpr size_t WS_CTL = 0, CTL_ZERO_BYTES = 1 * MiB;
constexpr size_t WS_WIN0 = 2 * MiB;
constexpr size_t WS_WOUT0 = 9 * MiB;
constexpr size_t WS_WIN1 = 11 * MiB;
constexpr size_t WS_WOUT1 = 16 * MiB;
constexpr size_t WS_WGLU = 18 * MiB;
constexpr size_t WS_WLORA = 19 * MiB;
constexpr size_t WS_WROUTER = 19 * MiB + 786432;
constexpr size_t WS_W13 = 20 * MiB;
constexpr size_t WS_W2 = 84 * MiB;
constexpr size_t WS_HB = 116 * MiB;
constexpr size_t WS_HA = 149 * MiB;
constexpr size_t WS_ROUTE = 213 * MiB;
constexpr size_t WS_BIG = 214 * MiB;
constexpr size_t WS_P = WS_BIG;
constexpr size_t WS_LO = WS_BIG + 112 * MiB;
constexpr size_t WS_SCAN = WS_BIG + 160 * MiB;
constexpr size_t WS_GLALA = WS_BIG + 256 * MiB;
constexpr size_t WS_BON = WS_BIG + 272 * MiB;
constexpr size_t WS_APRIME = WS_BIG + 273 * MiB;
constexpr size_t WS_YS5B = WS_BIG + 80 * MiB;
constexpr size_t WS_XR = WS_BIG;
constexpr size_t WS_HID = WS_BIG + 80 * MiB;
constexpr size_t WS_Y = WS_BIG + 120 * MiB;
constexpr size_t WS_END = 512 * MiB;
constexpr int CW_BAR = 4096;
constexpr int CW_CNT = 8192;

__device__ __forceinline__ float bf2f(bf16_t b) { return __uint_as_float(((unsigned)b) << 16); }
__device__ __forceinline__ bf16_t f2bf(float f) { unsigned u = __float_as_uint(f); u += 0x7fffu + ((u >> 16) & 1u); return (bf16_t)(u >> 16); }
__device__ __forceinline__ unsigned pk2(float lo, float hi) { return (unsigned)f2bf(lo) | ((unsigned)f2bf(hi) << 16); }
__device__ __forceinline__ float sigm(float x) { return 1.f / (1.f + __expf(-x)); }
__device__ __forceinline__ float siluf(float x) { return x * sigm(x); }
__device__ __forceinline__ float softplusf(float x) { return fmaxf(x, 0.f) + log1pf(__expf(-fabsf(x))); }
__device__ __forceinline__ float gelu_tanh(float x) { const float u = 0.7978845608028654f * (x + 0.044715f * x * x * x); return 0.5f * x * (1.f + tanhf(u)); }
__device__ __forceinline__ float wave_sum(float v) {
#pragma unroll
    for (int o = 1; o < 64; o <<= 1) v += __shfl_xor(v, o);
    return v;
}


namespace pg8 {
#define PG8_LAS __attribute__((address_space(3)))
typedef unsigned short bf16_t;
typedef short bf16x8 __attribute__((ext_vector_type(8)));
typedef float f32x4 __attribute__((ext_vector_type(4)));
typedef unsigned u32x4 __attribute__((ext_vector_type(4)));
constexpr int BM = 256, BK = 64, HALF = 128, HTB = HALF * BK * 2  , STAGE_BYTES = 8 * HTB, NXCD = 8, WGM = 8;

__host__ __device__ __forceinline__ int lds_byte(int r, int c) { const int st = (r >> 4) * 2 + (c >> 5), rr = r & 15, cc = c & 31, ob = rr * 64 + cc * 2; return st * 1024 + (ob ^ (((ob >> 9) & 1) << 5)); }
__host__ __device__ __forceinline__ void stage_rc(int b, int& R, int& C) { const int st = b / 1024, sb = b % 1024, swz = sb ^ (((sb >> 9) & 1) << 5); R = (st >> 1) * 16 + swz / 64; C = (st & 1) * 32 + (swz % 64) / 2; }
__host__ __device__ __forceinline__ int perm32(int rho) { const int n = rho >> 4, i = rho & 15; return 8 * (i >> 2) + 4 * n + (i & 3); }

struct Unit { int pm, pn, pb; };
struct Gemm { const bf16_t* A; const bf16_t* Bt; int M, N, K, lda; };

struct StaticOrder {
    int nM, nN, nwg, G, c;
    __host__ __device__ void init(int M, int N, int G_, int c_) { nM = M / BM; nN = N / BM; nwg = nM * nN; G = G_; c = c_; }
    __host__ __device__ bool next(int i, Unit& u) const {
        const long L = (long)i * G + c; if (L >= nwg) return false;
        int wgid = (int)L; { const int q = nwg / NXCD, r = nwg % NXCD, xcd = wgid % NXCD, off = wgid / NXCD; wgid = (xcd < r ? xcd * (q + 1) : r * (q + 1) + (xcd - r) * q) + off; }
        const int nig = WGM * nN, gid = wgid / nig, fm = gid * WGM, gsz = (nM - fm) < WGM ? (nM - fm) : WGM;
        u.pm = fm + ((wgid % nig) % gsz); u.pn = (wgid % nig) / gsz; u.pb = u.pn; return true;
    }
    __device__ __forceinline__ void a_ready(const Unit&) const {}
    __device__ __forceinline__ void done(const Unit&) const {}
};

__device__ __forceinline__ unsigned cvt_pk_bf16(float lo, float hi) { unsigned r; asm volatile("v_cvt_pk_bf16_f32 %0, %1, %2" : "=v"(r) : "v"(lo), "v"(hi)); return r; }
typedef float f32x2 __attribute__((ext_vector_type(2)));

template <class Epi, class Sched, bool ALIGN_EPI = false, bool SP2 = false>
__device__ __forceinline__ void gemm_phase(PG8_LAS unsigned char* lds, const Gemm g, const Sched& S, const Epi& E) {
    const int tid = TIDX, wid = __builtin_amdgcn_readfirstlane(tid >> 6), lane = tid & 63, wr = wid >> 2, wc = wid & 3, fr = lane & 15, fq = lane >> 4;
    const int K = g.K, nt = K / BK, lda = g.lda ? g.lda : g.K;
    unsigned voffA[2], voffB[2];
#pragma unroll
    for (int i = 0; i < 2; ++i) { int R, C; stage_rc(tid * 16 + i * 8192, R, C); const int Rb = Epi::PERM ? ((R & ~31) + perm32(R & 31)) : R;
        voffA[i] = (unsigned)(R * lda + C) * 2u; voffB[i] = (unsigned)(Rb * K + C) * 2u; }
    const size_t kstep = (size_t)(BK * 2);
    const size_t hstep = (size_t)HALF * K * 2;
    const size_t tstep = 2 * hstep;
    const size_t hstepA = (size_t)HALF * lda * 2, tstepA = 2 * hstepA;
    const unsigned ldsw = (unsigned)wid * 1024u;
    const int aoff = lds_byte(wr * 64 + fr, fq * 8), boff = lds_byte(wc * 32 + fr, fq * 8);
#define PG8_SA(b, h) (((b) * 2 + (h)) * HTB)
#define PG8_SB(b, h) ((4 + (b) * 2 + (h)) * HTB)
#define PG8_STAGE(bufoff, gbase, voff) do { _Pragma("unroll") for (int _i = 0; _i < 2; ++_i) \
        __builtin_amdgcn_global_load_lds((const unsigned*)((const char*)(gbase) + (voff)[_i]), (PG8_LAS unsigned*)(lds + (bufoff) + ldsw + _i * 8192), 16, 0, 0); } while (0)
#define PG8_LDA(dst, b, h) do { _Pragma("unroll") for (int m = 0; m < 4; ++m) _Pragma("unroll") for (int k = 0; k < 2; ++k) dst[m][k] = *(const PG8_LAS bf16x8*)(lds + PG8_SA(b, h) + aoff + m * 2048 + k * 1024); } while (0)
#define PG8_LDB(dst, b, h) do { _Pragma("unroll") for (int n = 0; n < 2; ++n) _Pragma("unroll") for (int k = 0; k < 2; ++k) dst[n][k] = *(const PG8_LAS bf16x8*)(lds + PG8_SB(b, h) + boff + n * 2048 + k * 1024); } while (0)
#define PG8_MMA(ai, bj, At, Bt) do { __builtin_amdgcn_s_setprio(1); _Pragma("unroll") for (int m = 0; m < 4; ++m) _Pragma("unroll") for (int n = 0; n < 2; ++n) _Pragma("unroll") for (int k = 0; k < 2; ++k) \
        acc[ai][bj][m][n] = __builtin_amdgcn_mfma_f32_16x16x32_bf16(Bt[n][k], At[m][k], acc[ai][bj][m][n], 0, 0, 0); __builtin_amdgcn_s_setprio(0); } while (0)
#define PG8_WAIT_V(n) asm volatile("s_waitcnt vmcnt(" #n ")" ::: "memory")
#define PG8_WAIT_L(n) asm volatile("s_waitcnt lgkmcnt(" #n ")" ::: "memory")
#define PG8_BAR __builtin_amdgcn_s_barrier()
#define PG8_SCHED __builtin_amdgcn_sched_barrier(0)
    Unit cur, nxt; int ui = 0;
    if (!S.next(0, cur)) return;
    f32x4 acc[2][2][4][2];
#pragma unroll
    for (int a = 0; a < 2; ++a)
#pragma unroll
        for (int b = 0; b < 2; ++b)
#pragma unroll
            for (int m = 0; m < 4; ++m)
#pragma unroll
                for (int n = 0; n < 2; ++n) acc[a][b][m][n] = (f32x4){0.f, 0.f, 0.f, 0.f};
    bf16x8 At[4][2], B0[2][2], B1[2][2];
    const char* cA = (const char*)g.A + (size_t)cur.pm * tstepA; const char* cB = (const char*)g.Bt + (size_t)cur.pb * tstep;
    S.a_ready(cur);
    if constexpr (SP2) {
        PG8_STAGE(PG8_SB(0, 0), cB, voffB); PG8_STAGE(PG8_SB(0, 1), cB + hstep, voffB); PG8_STAGE(PG8_SA(0, 0), cA, voffA); PG8_STAGE(PG8_SA(0, 1), cA + hstepA, voffA);
        if (wr == 1) PG8_BAR;
        PG8_WAIT_V(2); PG8_BAR;
        PG8_STAGE(PG8_SB(1, 0), cB + kstep, voffB); PG8_STAGE(PG8_SA(1, 0), cA + kstep, voffA); PG8_STAGE(PG8_SB(1, 1), cB + hstep + kstep, voffB);
        PG8_WAIT_V(6); PG8_BAR;
    } else {
        PG8_STAGE(PG8_SB(0, 0), cB, voffB); PG8_STAGE(PG8_SA(0, 0), cA, voffA); PG8_STAGE(PG8_SB(0, 1), cB + hstep, voffB); PG8_STAGE(PG8_SA(0, 1), cA + hstepA, voffA);
        if (wr == 1) PG8_BAR;
        PG8_WAIT_V(4); PG8_BAR;
        PG8_STAGE(PG8_SB(1, 0), cB + kstep, voffB); PG8_STAGE(PG8_SA(1, 0), cA + kstep, voffA); PG8_STAGE(PG8_SB(1, 1), cB + hstep + kstep, voffB);
        PG8_WAIT_V(6); PG8_BAR;
    }
    for (;;) {
        const bool has_next = S.next(ui + 1, nxt);
        const char* nA = has_next ? (const char*)g.A + (size_t)nxt.pm * tstepA : cA; const char* nB = has_next ? (const char*)g.Bt + (size_t)nxt.pb * tstep : cB;
        for (int t = 0; t < nt; t += 2) {
            const bool last = (t == nt - 2);
            const char* a1 = cA + (size_t)(t + 1) * kstep;
            const char* a2 = last ? nA : cA + (size_t)(t + 2) * kstep; const char* b2 = last ? nB : cB + (size_t)(t + 2) * kstep;
            const char* a3 = a2 + kstep; const char* b3 = b2 + kstep;
            if (last && has_next) S.a_ready(nxt);
            if constexpr (SP2) {
            PG8_LDB(B0, 0, 0); PG8_LDB(B1, 0, 1); PG8_SCHED; PG8_LDA(At, 0, 0); PG8_STAGE(PG8_SA(1, 1), a1 + hstepA, voffA);
            PG8_WAIT_V(8); PG8_WAIT_L(0); PG8_BAR; PG8_MMA(0, 0, At, B0); PG8_MMA(0, 1, At, B1); PG8_BAR; PG8_SCHED;
            PG8_LDA(At, 0, 1); PG8_STAGE(PG8_SB(0, 0), b2, voffB); PG8_STAGE(PG8_SB(0, 1), b2 + hstep, voffB); PG8_STAGE(PG8_SA(0, 0), a2, voffA);
            PG8_WAIT_V(8); PG8_WAIT_L(0); PG8_BAR; PG8_MMA(1, 0, At, B0); PG8_MMA(1, 1, At, B1); PG8_BAR; PG8_SCHED;
            PG8_LDB(B0, 1, 0); PG8_LDB(B1, 1, 1); PG8_SCHED; PG8_LDA(At, 1, 0); PG8_STAGE(PG8_SA(0, 1), a2 + hstepA, voffA);
            PG8_WAIT_V(8); PG8_WAIT_L(0); PG8_BAR; PG8_MMA(0, 0, At, B0); PG8_MMA(0, 1, At, B1); PG8_BAR; PG8_SCHED;
            PG8_LDA(At, 1, 1); PG8_STAGE(PG8_SB(1, 0), b3, voffB); PG8_STAGE(PG8_SB(1, 1), b3 + hstep, voffB); PG8_STAGE(PG8_SA(1, 0), a3, voffA);
            PG8_WAIT_V(8); PG8_WAIT_L(0); PG8_BAR; PG8_MMA(1, 0, At, B0); PG8_MMA(1, 1, At, B1); PG8_BAR; PG8_SCHED;
            } else {
            PG8_LDB(B0, 0, 0); PG8_SCHED; PG8_LDA(At, 0, 0); PG8_STAGE(PG8_SA(1, 1), a1 + hstepA, voffA);
            PG8_WAIT_L(8); PG8_BAR; PG8_WAIT_L(0); PG8_MMA(0, 0, At, B0); PG8_BAR; PG8_SCHED;
            PG8_LDB(B1, 0, 1); PG8_STAGE(PG8_SB(0, 0), b2, voffB);
            PG8_BAR; PG8_WAIT_L(0); PG8_MMA(0, 1, At, B1); PG8_BAR;
            PG8_LDA(At, 0, 1); PG8_STAGE(PG8_SA(0, 0), a2, voffA);
            PG8_BAR; PG8_WAIT_L(0); PG8_MMA(1, 0, At, B0); PG8_BAR; PG8_SCHED;
            PG8_STAGE(PG8_SB(0, 1), b2 + hstep, voffB);
            PG8_WAIT_V(6); PG8_BAR; PG8_MMA(1, 1, At, B1); PG8_BAR;
            PG8_LDB(B0, 1, 0); PG8_SCHED; PG8_LDA(At, 1, 0); PG8_STAGE(PG8_SA(0, 1), a2 + hstepA, voffA);
            PG8_WAIT_L(8); PG8_BAR; PG8_WAIT_L(0); PG8_MMA(0, 0, At, B0); PG8_BAR; PG8_SCHED;
            PG8_LDB(B1, 1, 1); PG8_STAGE(PG8_SB(1, 0), b3, voffB);
            PG8_BAR; PG8_WAIT_L(0); PG8_MMA(0, 1, At, B1); PG8_BAR;
            PG8_LDA(At, 1, 1); PG8_STAGE(PG8_SA(1, 0), a3, voffA);
            PG8_BAR; PG8_WAIT_L(0); PG8_MMA(1, 0, At, B0); PG8_BAR; PG8_SCHED;
            PG8_STAGE(PG8_SB(1, 1), b3 + hstep, voffB);
            PG8_WAIT_V(6); PG8_BAR; PG8_MMA(1, 1, At, B1); PG8_BAR;
            }
        }
        if constexpr (ALIGN_EPI) { if (wr == 0) PG8_BAR; }
        if constexpr (!Epi::AFTER_DRAIN) { E(acc, cur, wr, wc, fr, fq); S.done(cur); }
        if (!has_next) break;
#pragma unroll
        for (int a = 0; a < 2; ++a)
#pragma unroll
            for (int b = 0; b < 2; ++b)
#pragma unroll
                for (int m = 0; m < 4; ++m)
#pragma unroll
                    for (int n = 0; n < 2; ++n) acc[a][b][m][n] = (f32x4){0.f, 0.f, 0.f, 0.f};
        cur = nxt; cA = nA; cB = nB; ++ui;
        if constexpr (ALIGN_EPI) { if (wr == 1) PG8_BAR; }
    }
    PG8_WAIT_V(0);
    if constexpr (!ALIGN_EPI) { if (wr == 0) PG8_BAR; }
    PG8_BAR;
    if constexpr (Epi::AFTER_DRAIN) { E.fused(acc, cur, wr, wc, fr, fq, lds, wid, lane); S.done(cur); }
#undef PG8_SA
#undef PG8_SB
#undef PG8_STAGE
#undef PG8_LDA
#undef PG8_LDB
#undef PG8_MMA
#undef PG8_WAIT_V
#undef PG8_WAIT_L
#undef PG8_BAR
#undef PG8_SCHED
}

struct EpiStoreBf16 {
    static constexpr bool PERM = true, AFTER_DRAIN = false;
    bf16_t* O; int ldc; int split_cols; size_t split_stride;
    __device__ __forceinline__ void operator()(const f32x4 (&acc)[2][2][4][2], const Unit& u, int wr, int wc, int fr, int fq) const {
        int colt = u.pn * BM; bf16_t* base = O;
        if (split_cols) { const int t = colt / split_cols; base += (size_t)t * split_stride; colt -= t * split_cols; }
        const int row0 = u.pm * BM + wr * 64 + fr, col0 = colt + wc * 32 + 8 * fq;
#pragma unroll
        for (int ai = 0; ai < 2; ++ai)
#pragma unroll
            for (int m = 0; m < 4; ++m) { bf16_t* rowp = base + (size_t)(row0 + ai * HALF + m * 16) * ldc + col0;
#pragma unroll
                for (int bj = 0; bj < 2; ++bj) { const f32x4 v0 = acc[ai][bj][m][0], v1 = acc[ai][bj][m][1];
                    u32x4 w; w.x = cvt_pk_bf16(v0[0], v0[1]); w.y = cvt_pk_bf16(v0[2], v0[3]); w.z = cvt_pk_bf16(v1[0], v1[1]); w.w = cvt_pk_bf16(v1[2], v1[3]);
                    *(u32x4*)(rowp + bj * HALF) = w; } }
    }
};
struct EpiResidF32 {
    static constexpr bool PERM = false, AFTER_DRAIN = false;
    const float* resid; float* out; int ldc; float alpha;
    __device__ __forceinline__ void operator()(const f32x4 (&acc)[2][2][4][2], const Unit& u, int wr, int wc, int fr, int fq) const {
        const int row0 = u.pm * BM + wr * 64 + fr, col0 = u.pn * BM + wc * 32 + 4 * fq;
#pragma unroll
        for (int ai = 0; ai < 2; ++ai)
#pragma unroll
            for (int m = 0; m < 4; ++m) { const size_t off = (size_t)(row0 + ai * HALF + m * 16) * ldc + col0;
#pragma unroll
                for (int bj = 0; bj < 2; ++bj)
#pragma unroll
                    for (int n = 0; n < 2; ++n) { const size_t o = off + bj * HALF + n * 16; *(f32x4*)(out + o) = *(const f32x4*)(resid + o) * alpha + acc[ai][bj][m][n]; } }
    }
};
__device__ __forceinline__ float fast_sigm(float x) { return __builtin_amdgcn_rcpf(1.f + __expf(-x)); }
struct EpiSwiglu {
    static constexpr bool PERM = true, AFTER_DRAIN = false;
    bf16_t* HID;
    __device__ __forceinline__ void operator()(const f32x4 (&acc)[2][2][4][2], const Unit& u, int wr, int wc, int fr, int fq) const {
        const int row0 = u.pm * BM + wr * 64 + fr, h0 = u.pn * 128 + wc * 16 + 4 * fq;
#pragma unroll
        for (int ai = 0; ai < 2; ++ai)
#pragma unroll
            for (int m = 0; m < 4; ++m) { bf16_t* rowp = HID + (size_t)(row0 + ai * HALF + m * 16) * 512 + h0;
#pragma unroll
                for (int bj = 0; bj < 2; ++bj) { const f32x4 a = acc[ai][bj][m][0], b = acc[ai][bj][m][1]; f32x4 h;
#pragma unroll
                    for (int j = 0; j < 4; ++j) h[j] = a[j] * fast_sigm(a[j]) * b[j];
                    typedef unsigned u32x2v __attribute__((ext_vector_type(2)));
                    u32x2v w; w.x = cvt_pk_bf16(h[0], h[1]); w.y = cvt_pk_bf16(h[2], h[3]);
                    *(u32x2v*)(rowp + bj * 64) = w; } }
    }
};
struct EpiGlu {
    static constexpr bool PERM = true, AFTER_DRAIN = false;
    const float* ysrc; int ldy; const float* bias; bf16_t* O; int ldc;
    __device__ __forceinline__ void operator()(const f32x4 (&acc)[2][2][4][2], const Unit& u, int wr, int wc, int fr, int fq) const {
        const int row0 = u.pm * BM + wr * 64 + fr, col0 = u.pn * BM + wc * 32 + 8 * fq;
#pragma unroll
        for (int ai = 0; ai < 2; ++ai)
#pragma unroll
            for (int m = 0; m < 4; ++m) { const int row = row0 + ai * HALF + m * 16;
#pragma unroll
                for (int bj = 0; bj < 2; ++bj) { const int col = col0 + bj * HALF;
                    const f32x4 y0 = *(const f32x4*)(ysrc + (size_t)row * ldy + col), y1 = *(const f32x4*)(ysrc + (size_t)row * ldy + col + 4);
                    const f32x4 b0 = *(const f32x4*)(bias + col), b1 = *(const f32x4*)(bias + col + 4);
                    f32x4 v0 = acc[ai][bj][m][0] + b0, v1 = acc[ai][bj][m][1] + b1;
#pragma unroll
                    for (int j = 0; j < 4; ++j) { v0[j] = y0[j] * fast_sigm(v0[j]); v1[j] = y1[j] * fast_sigm(v1[j]); }
                    u32x4 w; w.x = cvt_pk_bf16(v0[0], v0[1]); w.y = cvt_pk_bf16(v0[2], v0[3]); w.z = cvt_pk_bf16(v1[0], v1[1]); w.w = cvt_pk_bf16(v1[2], v1[3]);
                    *(u32x4*)(O + (size_t)row * ldc + col) = w; } }
    }
};
struct EpiStoreF32 {
    static constexpr bool PERM = false, AFTER_DRAIN = false;
    float* out; int ldc;
    __device__ __forceinline__ void operator()(const f32x4 (&acc)[2][2][4][2], const Unit& u, int wr, int wc, int fr, int fq) const {
        const int row0 = u.pm * BM + wr * 64 + fr, col0 = u.pn * BM + wc * 32 + 4 * fq;
#pragma unroll
        for (int ai = 0; ai < 2; ++ai)
#pragma unroll
            for (int m = 0; m < 4; ++m) { const size_t off = (size_t)(row0 + ai * HALF + m * 16) * ldc + col0;
#pragma unroll
                for (int bj = 0; bj < 2; ++bj)
#pragma unroll
                    for (int n = 0; n < 2; ++n) *(f32x4*)(out + off + bj * HALF + n * 16) = acc[ai][bj][m][n]; }
    }
};
struct EpiS5Y {
    static constexpr bool PERM = false, AFTER_DRAIN = false;
    const bf16_t* P1; const float* dvec; float* YS5; bf16_t* YS5B;
    __device__ __forceinline__ void operator()(const f32x4 (&acc)[2][2][4][2], const Unit& u, int wr, int wc, int fr, int fq) const {
        const int g = u.pm >> 1, ch = g * 16 + 4 * fq;
        const f32x4 dd = *(const f32x4*)(dvec + ch);
#pragma unroll
        for (int ai = 0; ai < 2; ++ai)
#pragma unroll
            for (int m = 0; m < 4; ++m) {
                const int bc = (u.pm & 1) * 256 + ai * HALF + wr * 64 + m * 16 + fr, b = bc >> 8, c32 = bc & 255;
#pragma unroll
                for (int bj = 0; bj < 2; ++bj)
#pragma unroll
                    for (int n = 0; n < 2; ++n) {
                        const int i = 16 * u.pn + 8 * bj + 2 * wc + n;
                        const size_t t = (size_t)b * 8192 + c32 * 32 + i;
                        typedef unsigned u32x2v __attribute__((ext_vector_type(2)));
                        const u32x2v uu = *(const u32x2v*)(P1 + t * 2560 + ch);
                        f32x4 uv; uv[0] = __uint_as_float(uu.x << 16); uv[1] = __uint_as_float(uu.x & 0xffff0000u); uv[2] = __uint_as_float(uu.y << 16); uv[3] = __uint_as_float(uu.y & 0xffff0000u);
                        f32x4 y = acc[ai][bj][m][n] + dd * uv;
#pragma unroll
                        for (int j = 0; j < 4; ++j) { const float x = y[j]; const float tt = 0.7978845608028654f * (x + 0.044715f * x * x * x); y[j] = 0.5f * x * (1.f + tanhf(tt)); }
                        *(f32x4*)(YS5 + t * 512 + ch) = y;
                        u32x2v w; w.x = cvt_pk_bf16(y[0], y[1]); w.y = cvt_pk_bf16(y[2], y[3]);
                        *(u32x2v*)(YS5B + t * 512 + ch) = w;
                    }
            }
    }
};
struct MoeOrder {
    int ntiles, nN, G, c; const PG8_LAS int* tile_e;
    __device__ __forceinline__ bool next(int i, Unit& u) const {
        const int L = i * G + c; if (L >= ntiles * nN) return false;
        u.pm = L / nN; u.pn = L % nN; u.pb = tile_e[u.pm] * nN + u.pn; return true;
    }
    __device__ __forceinline__ void a_ready(const Unit&) const {}
    __device__ __forceinline__ void done(const Unit&) const {}
};
}

#define XB_TMO      128
#define XB_XCNT(j)  (256  + 64 * (j))
#define XB_XSUB(j)  (1280 + 64 * (j))
#define XB_XGEN(j)  (2304 + 64 * (j))
#define XB_TOP      3328
#define XB_TOPGEN   3392
#define XCD_BAR_WORDS 3456
#define XB_SPIN_CAP (1u << 18)
__device__ __forceinline__ unsigned xb_ld(unsigned* p)              { return __hip_atomic_load(p, __ATOMIC_RELAXED, __HIP_MEMORY_SCOPE_AGENT); }
__device__ __forceinline__ unsigned xb_add(unsigned* p, unsigned v) { return __hip_atomic_fetch_add(p, v, __ATOMIC_RELAXED, __HIP_MEMORY_SCOPE_AGENT); }
__device__ __forceinline__ unsigned xb_xcc_id() { return (unsigned)__builtin_amdgcn_s_getreg((3 << 11) | 20) & 0xFu; }
#define XB_SPIN(cond, bar) do { unsigned _sp = 0; while (cond) { __builtin_amdgcn_s_sleep(1); \
    if ((++_sp & 255u) == 0u) { if (xb_ld(&(bar)[XB_TMO])) break; if (_sp > XB_SPIN_CAP) { atomicAdd(&(bar)[XB_TMO], 1u); break; } } } } while (0)
struct XcdBarrier { unsigned* bar; unsigned x; volatile LAS unsigned* st; };
__device__ __forceinline__ XcdBarrier xcd_barrier_post(unsigned* bar, volatile LAS unsigned* st) {
    XcdBarrier b; b.bar = bar; b.x = xb_xcc_id(); b.st = st;
    if (TIDX == 0) (void)xb_add(&bar[XB_XCNT(b.x)], 1u);
    return b;
}
__device__ __forceinline__ void xcd_barrier_complete(unsigned* bar, unsigned x, unsigned& nloc, unsigned& nx) {
    const unsigned G = gridDim.x;
    unsigned sum, cnt, mine, sp = 0u;
    for (;;) {
        sum = 0u; cnt = 0u; mine = 0u;
#pragma unroll
        for (unsigned j = 0; j < 16; ++j) { const unsigned c = xb_ld(&bar[XB_XCNT(j)]); sum += c; cnt += (c > 0u) ? 1u : 0u; mine = (j == x) ? c : mine; }
        if (sum == G) break;
        __builtin_amdgcn_s_sleep(1);
        if ((++sp & 255u) == 0u) { if (xb_ld(&bar[XB_TMO])) break; if (sp > XB_SPIN_CAP) { atomicAdd(&bar[XB_TMO], 1u); break; } }
    }
    nloc = mine > 0u ? mine : 1u; nx = cnt > 0u ? cnt : 1u;
}
__device__ __forceinline__ void xcd_barrier(const XcdBarrier& b) {
    asm volatile("s_waitcnt vmcnt(0)" ::: "memory");
    __syncthreads();
    if (TIDX == 0) {
        unsigned* bar = b.bar;
        __builtin_amdgcn_s_waitcnt(0);
        unsigned nloc = b.st[0], nx = b.st[1];
        if (nloc == 0u) { xcd_barrier_complete(bar, b.x, nloc, nx); b.st[0] = nloc; b.st[1] = nx; }
        const unsigned old = xb_add(&bar[XB_XSUB(b.x)], 1u);
        const unsigned gen = old / nloc;
        if (old + 1u == (gen + 1u) * nloc) {
            __builtin_amdgcn_fence(__ATOMIC_RELEASE, "agent");
            asm volatile("s_waitcnt vmcnt(0)" ::: "memory");
            const unsigned og = xb_add(&bar[XB_TOP], 1u);
            const unsigned tg = og / nx;
            if (og + 1u == (tg + 1u) * nx) xb_add(&bar[XB_TOPGEN], 1u);
            else XB_SPIN(xb_ld(&bar[XB_TOPGEN]) == tg, bar);
            __builtin_amdgcn_fence(__ATOMIC_ACQUIRE, "agent");
            xb_add(&bar[XB_XGEN(b.x)], 1u);
            asm volatile("s_waitcnt vmcnt(0)" ::: "memory");
        } else {
            XB_SPIN(xb_ld(&bar[XB_XGEN(b.x)]) == gen, bar);
            __builtin_amdgcn_fence(__ATOMIC_ACQUIRE, "agent");
            asm volatile("s_waitcnt vmcnt(0)" ::: "memory");
        }
    }
    __syncthreads();
}


typedef short bf16x8 __attribute__((ext_vector_type(8)));
struct GlaBufs { bf16_t* QT; bf16_t* KT; bf16_t* KDT; bf16_t* VT; float* DG; float* DS; bf16_t* SP; };
__device__ __forceinline__ float logsigf(float x) { return fminf(x, 0.f) - log1pf(__expf(-fabsf(x))); }

template <int K, int LAYER>
__device__ __forceinline__ void gla_prep_tile(LAS float* lds, const bf16_t* P, const float* aux0, const float* aux1, const GlaBufs& B, int cg) {
    constexpr int HK = 4 * K, KP = K + 1;
    LAS float* G = lds;
    LAS float* KR = lds + 64 * KP;
    LAS float* LV = lds + 2 * 64 * KP;
    const int tid = TIDX, lane = tid & 63, wave = tid >> 6;
    const int t0 = cg * 64;
    for (int h = 0; h < 4; ++h) {
        for (int idx = tid; idx < 64 * K; idx += NTHREADS) {
            const int t = idx / K, k = idx % K, ck = h * K + k;
            float g, kr;
            if (LAYER == 0) {
                const bf16_t* row = P + (size_t)(t0 + t) * NIN0P;
                float gk = aux1[ck];
#pragma unroll
                for (int i = 0; i < 16; ++i) gk += bf2f(row[2816 + i]) * aux0[i * 256 + ck];
                g = logsigf(gk) * (1.f / 16.f);
                kr = bf2f(row[2048 + ck]);
            } else {
                const bf16_t* row = P + (size_t)(t0 + t) * NIN1;
                const float lbv = 1.f / (1.f + __expf(aux0[ck] - aux0[512 + ck]));
                const float sg = sigm(bf2f(row[1024 + ck]));
                g = __logf(lbv + (1.f - lbv) * sg);
                kr = (1.f - lbv) * (1.f - sg);
            }
            G[t * KP + k] = g; KR[t * KP + k] = kr;
        }
        for (int idx = tid; idx < 64 * 128; idx += NTHREADS) {
            const int t = idx >> 7, vc = idx & 127;
            LV[t * 129 + vc] = bf2f(LAYER == 0 ? P[(size_t)(t0 + t) * NIN0P + 2304 + h * 128 + vc] : P[(size_t)(t0 + t) * NIN1 + 1536 + h * 128 + vc]);
        }
        __syncthreads();
        for (int k = wave; k < K; k += NWAVES) {
            float v = G[lane * KP + k];
#pragma unroll
            for (int o = 1; o < 64; o <<= 1) { const float n = __shfl_up(v, o); if (lane >= o) v += n; }
            G[lane * KP + k] = v;
        }
        __syncthreads();
        for (int idx = tid; idx < 64 * K; idx += NTHREADS) {
            const int t = idx / K, k = idx % K, ck = h * K + k;
            const float b = G[t * KP + k];
            float q;
            if (LAYER == 0) q = bf2f(P[(size_t)(t0 + t) * NIN0P + 1792 + ck]) * 0.125f;
            else q = siluf(bf2f(P[(size_t)(t0 + t) * NIN1 + 512 + ck]));
            B.QT[(size_t)(t0 + t) * HK + ck] = f2bf(q * __expf(b));
            B.KT[(size_t)(t0 + t) * HK + ck] = f2bf(KR[t * KP + k] * __expf(-b));
        }
        for (int idx = tid; idx < 64 * K; idx += NTHREADS) {
            const int k = idx >> 6, t = idx & 63, ck = h * K + k;
            const float bl = G[63 * KP + k];
            B.KDT[((size_t)cg * HK + ck) * 64 + t] = f2bf(KR[t * KP + k] * __expf(bl - G[t * KP + k]));
            if (t == 0) B.DG[(size_t)cg * HK + ck] = __expf(bl);
        }
        for (int idx = tid; idx < 64 * 128; idx += NTHREADS) {
            const int vc = idx >> 6, t = idx & 63;
            B.VT[((size_t)cg * 512 + h * 128 + vc) * 64 + t] = f2bf(LV[t * 129 + vc]);
        }
        __syncthreads();
    }
}

template <int K>
__device__ __forceinline__ void gla_pass1_unit(const GlaBufs& B, int unit, int lane) {
    constexpr int HK = 4 * K, KT16 = K / 16;
    const int item = unit / KT16, kt = unit % KT16, cg = item >> 2, h = item & 3;
    const int r = lane & 15, q = lane >> 4;
    const bf16_t* ap = B.KDT + ((size_t)cg * HK + h * K + kt * 16 + r) * 64 + 8 * q;
    const bf16x8 a0 = *(const bf16x8*)ap, a1 = *(const bf16x8*)(ap + 32);
    float* dsp = B.DS + ((size_t)item * 128 + r) * K + kt * 16 + 4 * q;
#pragma unroll
    for (int vt = 0; vt < 8; ++vt) {
        const bf16_t* bp = B.VT + ((size_t)cg * 512 + h * 128 + vt * 16 + r) * 64 + 8 * q;
        const bf16x8 b0 = *(const bf16x8*)bp, b1 = *(const bf16x8*)(bp + 32);
        f32x4 acc = {0.f, 0.f, 0.f, 0.f};
        acc = __builtin_amdgcn_mfma_f32_16x16x32_bf16(a0, b0, acc, 0, 0, 0);
        acc = __builtin_amdgcn_mfma_f32_16x16x32_bf16(a1, b1, acc, 0, 0, 0);
        *(f32x4*)(dsp + (size_t)vt * 16 * K) = acc;
    }
}

template <int K>
__device__ __forceinline__ void gla_pass2(const GlaBufs& B, int gthread, int gthreads) {
    constexpr int HK = 4 * K;
    const float* __restrict__ DS = B.DS; const float* __restrict__ DG = B.DG; bf16_t* __restrict__ SP = B.SP;
    for (int e = gthread; e < 8 * 128 * K; e += gthreads) {
        const int k = e % K, v = (e / K) & 127, bh = e / (K * 128), b = bh >> 2, h = bh & 3;
        float S = 0.f;
#pragma unroll 8
        for (int c = 0; c < 128; ++c) {
            const int cg = b * 128 + c;
            const size_t idx = ((size_t)(cg * 4 + h) * 128 + v) * K + k;
            const float d = DG[(size_t)cg * HK + h * K + k], ds = DS[idx];
            SP[idx] = f2bf(S);
            S = d * S + ds;
        }
    }
}

template <int K, int LAYER>
__device__ __forceinline__ void gla_pass3_item(LAS unsigned char* lds, const bf16_t* P, const float* norm_g, const GlaBufs& B, bf16_t* Ymix, int item) {
    constexpr int HK = 4 * K, KS = K / 32;
    LAS bf16_t* Ls = (LAS bf16_t*)lds;
    LAS float* Lo = (LAS float*)(lds + 64 * 72 * 2);
    const int tid = TIDX, lane = tid & 63, wave = tid >> 6, r = lane & 15, q = lane >> 4;
    const int cg = item >> 2, h = item & 3, t0 = cg * 64;
    const int it = wave >> 1, i0 = it * 16;
    bf16x8 qf[KS];
#pragma unroll
    for (int s = 0; s < KS; ++s) qf[s] = *(const bf16x8*)(B.QT + (size_t)(t0 + i0 + r) * HK + h * K + 32 * s + 8 * q);
#pragma unroll
    for (int jj2 = 0; jj2 < 2; ++jj2) {
        const int j0 = ((wave & 1) * 2 + jj2) * 16;
        f32x4 acc = {0.f, 0.f, 0.f, 0.f};
        if (j0 <= i0) {
#pragma unroll
            for (int s = 0; s < KS; ++s) {
                const bf16x8 kf = *(const bf16x8*)(B.KT + (size_t)(t0 + j0 + r) * HK + h * K + 32 * s + 8 * q);
                acc = __builtin_amdgcn_mfma_f32_16x16x32_bf16(kf, qf[s], acc, 0, 0, 0);
            }
        }
        const int i = i0 + r;
        u32x2 w;
        w.x = pk2((j0 + 4 * q + 0) <= i ? acc[0] : 0.f, (j0 + 4 * q + 1) <= i ? acc[1] : 0.f);
        w.y = pk2((j0 + 4 * q + 2) <= i ? acc[2] : 0.f, (j0 + 4 * q + 3) <= i ? acc[3] : 0.f);
        *(LAS u32x2*)(Ls + i * 72 + j0 + 4 * q) = w;
    }
    __syncthreads();
    const bf16x8 sf0 = *(const LAS bf16x8*)(Ls + (i0 + r) * 72 + 8 * q), sf1 = *(const LAS bf16x8*)(Ls + (i0 + r) * 72 + 32 + 8 * q);
#pragma unroll
    for (int vv = 0; vv < 4; ++vv) {
        const int v0 = ((wave & 1) * 4 + vv) * 16;
        f32x4 acc = {0.f, 0.f, 0.f, 0.f};
#pragma unroll
        for (int s = 0; s < KS; ++s) {
            const bf16x8 sp = *(const bf16x8*)(B.SP + ((size_t)item * 128 + v0 + r) * K + 32 * s + 8 * q);
            acc = __builtin_amdgcn_mfma_f32_16x16x32_bf16(sp, qf[s], acc, 0, 0, 0);
        }
        const bf16_t* vp = B.VT + ((size_t)cg * 512 + h * 128 + v0 + r) * 64 + 8 * q;
        const bf16x8 vf0 = *(const bf16x8*)vp, vf1 = *(const bf16x8*)(vp + 32);
        acc = __builtin_amdgcn_mfma_f32_16x16x32_bf16(vf0, sf0, acc, 0, 0, 0);
        acc = __builtin_amdgcn_mfma_f32_16x16x32_bf16(vf1, sf1, acc, 0, 0, 0);
        *(LAS f32x4*)(Lo + (i0 + r) * 132 + v0 + 4 * q) = acc;
    }
    __syncthreads();
#pragma unroll 2
    for (int rr = 0; rr < 8; ++rr) {
        const int i = wave * 8 + rr, t = t0 + i;
        const float o0 = Lo[i * 132 + lane], o1 = Lo[i * 132 + 64 + lane];
        const float ms = wave_sum(o0 * o0 + o1 * o1) * (1.f / 128.f);
        const float rs = rsqrtf(ms + LN_EPS);
        float g0, g1;
        if (LAYER == 0) { g0 = bf2f(P[(size_t)t * NIN0P + 2832 + h * 128 + lane]); g1 = bf2f(P[(size_t)t * NIN0P + 2832 + h * 128 + 64 + lane]); }
        else { g0 = bf2f(P[(size_t)t * NIN1 + 2048 + h * 128 + lane]); g1 = bf2f(P[(size_t)t * NIN1 + 2048 + h * 128 + 64 + lane]); }
        Ymix[(size_t)t * D_ + 512 + h * 128 + lane] = f2bf(o0 * rs * norm_g[lane] * siluf(g0));
        Ymix[(size_t)t * D_ + 512 + h * 128 + 64 + lane] = f2bf(o1 * rs * norm_g[64 + lane] * siluf(g1));
    }
    __syncthreads();
}


template <int CTRL> __device__ __forceinline__ float dppf(float x) { return __builtin_bit_cast(float, __builtin_amdgcn_mov_dpp(__builtin_bit_cast(int, x), CTRL, 0xf, 0xf, true)); }
__device__ __forceinline__ float reduce32(float x) {
    x += dppf<0xB1>(x);
    x += dppf<0x4E>(x);
    x += dppf<0x141>(x);
    x += dppf<0x140>(x);
    auto sw = __builtin_amdgcn_permlane16_swap(__float_as_uint(x), __float_as_uint(x), false, false);
    return __uint_as_float(sw[0]) + __uint_as_float(sw[1]);
}
__device__ __forceinline__ void rwkv_scan_v1(LAS float* lds, const bf16_t* SC, float* YRW, int unit) {
    constexpr int TS = 32, TILE = 5 * TS * 64 + TS * 16;
    const int bh = unit >> 3, qr = unit & 7, b = bh >> 3, h = bh & 7;
    const int tid = TIDX, lane = tid & 63, wave = tid >> 6, cp = lane & 31, rl = (wave & 3) * 2 + (lane >> 5);
    const size_t S1 = (size_t)T_ * 512;
    const int chunk = tid & 255, ls = chunk >> 3, lc0 = (chunk & 7) * 8, half = tid >> 8;
    const bf16_t* g0 = SC + (half == 0 ? 0 : 4 * S1) + (size_t)(b * L_ + ls) * 512 + h * 64 + lc0;
    const bf16_t* g1 = SC + (half == 0 ? 1 * S1 : 5 * S1) + (size_t)(b * L_ + ls) * 512 + h * 64 + lc0;
    const bf16_t* g2 = (half == 0) ? SC + 2 * S1 + (size_t)(b * L_ + ls) * 512 + h * 64 + lc0
                                   : SC + 3 * S1 + (size_t)(b * L_ + ls) * 512 + h * 64 + qr * 8;
    u32x4 p0, p1, p2;
    p0 = *(const u32x4*)g0; p1 = *(const u32x4*)g1; p2 = *(const u32x4*)g2;
    float S0 = 0.f, S1v = 0.f;
    auto unpack8 = [](const u32x4 v, float* f) {
        f[0] = __uint_as_float(v.x << 16); f[1] = __uint_as_float(v.x & 0xffff0000u); f[2] = __uint_as_float(v.y << 16); f[3] = __uint_as_float(v.y & 0xffff0000u);
        f[4] = __uint_as_float(v.z << 16); f[5] = __uint_as_float(v.z & 0xffff0000u); f[6] = __uint_as_float(v.w << 16); f[7] = __uint_as_float(v.w & 0xffff0000u); };
    auto stage = [&](LAS float* buf) {
        float f0[8], f1[8], f2[8];
        unpack8(p0, f0); unpack8(p1, f1); unpack8(p2, f2);
        if (half == 0) {
#pragma unroll
            for (int j = 0; j < 8; ++j) { buf[(4 * TS + ls) * 64 + lc0 + j] = f0[j]; buf[(1 * TS + ls) * 64 + lc0 + j] = __expf(f1[j]); buf[(3 * TS + ls) * 64 + lc0 + j] = f2[j]; }
        } else {
#pragma unroll
            for (int j = 0; j < 8; ++j) { buf[(0 * TS + ls) * 64 + lc0 + j] = -f0[j]; buf[(2 * TS + ls) * 64 + lc0 + j] = f0[j] * f1[j]; }
            if ((chunk & 7) == 0) {
#pragma unroll
                for (int j = 0; j < 8; ++j) buf[5 * TS * 64 + ls * 16 + j] = f2[j];
            }
        }
    };
    stage(lds);
    __syncthreads();
    for (int t0 = 0; t0 < L_; t0 += TS) {
        LAS float* cur = lds + ((t0 / TS) & 1) * TILE;
        LAS float* nxt = lds + (((t0 / TS) & 1) ^ 1) * TILE;
        const bool more = (t0 + TS) < L_;
        if (more) { const size_t adv = (size_t)(t0 + TS) * 512; p0 = *(const u32x4*)(g0 + adv); p1 = *(const u32x4*)(g1 + adv); p2 = *(const u32x4*)(g2 + adv); }
        float* yout = YRW + (size_t)(b * L_ + t0) * 512 + h * 64 + qr * 8 + rl;
        if (wave < 4) {
        typedef float f32x2v __attribute__((ext_vector_type(2)));
        f32x2v a2 = *(const LAS f32x2v*)(cur + (0 * TS) * 64 + 2 * cp), w2 = *(const LAS f32x2v*)(cur + (1 * TS) * 64 + 2 * cp), b2 = *(const LAS f32x2v*)(cur + (2 * TS) * 64 + 2 * cp),
               k2 = *(const LAS f32x2v*)(cur + (3 * TS) * 64 + 2 * cp), r2 = *(const LAS f32x2v*)(cur + (4 * TS) * 64 + 2 * cp);
        float vv = cur[5 * TS * 64 + rl];
        float ysel = 0.f;
#pragma unroll
        for (int s = 0; s < TS; ++s) {
            const int sn = (s + 1) & (TS - 1);
            const f32x2v a2n = *(const LAS f32x2v*)(cur + (0 * TS + sn) * 64 + 2 * cp), w2n = *(const LAS f32x2v*)(cur + (1 * TS + sn) * 64 + 2 * cp),
                         b2n = *(const LAS f32x2v*)(cur + (2 * TS + sn) * 64 + 2 * cp), k2n = *(const LAS f32x2v*)(cur + (3 * TS + sn) * 64 + 2 * cp),
                         r2n = *(const LAS f32x2v*)(cur + (4 * TS + sn) * 64 + 2 * cp);
            const float vvn = cur[5 * TS * 64 + sn * 16 + rl];
            const float sa = reduce32(S0 * a2.x + S1v * a2.y);
            S0 = S0 * w2.x + (sa * b2.x + vv * k2.x);
            S1v = S1v * w2.y + (sa * b2.y + vv * k2.y);
            const float y = reduce32(S0 * r2.x + S1v * r2.y);
            ysel = (cp == s) ? y : ysel;
            a2 = a2n; w2 = w2n; b2 = b2n; k2 = k2n; r2 = r2n; vv = vvn;
        }
        yout[(size_t)cp * 512] = ysel;
        }
        if (more) stage(nxt);
        __syncthreads();
    }
}


__device__ __forceinline__ bf16x8 ldfrag(const LAS bf16_t* tile, int row0, int ks, int r, int q) { return *(const LAS bf16x8*)(tile + (row0 + r) * 72 + 32 * ks + 8 * q); }
__device__ __forceinline__ f32x4 mm64(f32x4 acc, const LAS bf16_t* A, int arow0, const LAS bf16_t* B, int brow0, int r, int q) {
    acc = __builtin_amdgcn_mfma_f32_16x16x32_bf16(ldfrag(A, arow0, 0, r, q), ldfrag(B, brow0, 0, r, q), acc, 0, 0, 0);
    acc = __builtin_amdgcn_mfma_f32_16x16x32_bf16(ldfrag(A, arow0, 1, r, q), ldfrag(B, brow0, 1, r, q), acc, 0, 0, 0);
    return acc;
}
__device__ __forceinline__ void unpack8f(const u32x4 v, float* f) {
    f[0] = __uint_as_float(v.x << 16); f[1] = __uint_as_float(v.x & 0xffff0000u); f[2] = __uint_as_float(v.y << 16); f[3] = __uint_as_float(v.y & 0xffff0000u);
    f[4] = __uint_as_float(v.z << 16); f[5] = __uint_as_float(v.z & 0xffff0000u); f[6] = __uint_as_float(v.w << 16); f[7] = __uint_as_float(v.w & 0xffff0000u);
}
__device__ __forceinline__ u32x4 pack8f(const float* f) { u32x4 o; o.x = pk2(f[0], f[1]); o.y = pk2(f[2], f[3]); o.z = pk2(f[4], f[5]); o.w = pk2(f[6], f[7]); return o; }

__device__ __forceinline__ void rwkv_chunk_pre(LAS unsigned char* lds, const bf16_t* SC, bf16_t* Gout, bf16_t* Rmout, float* HTout, bf16_t* Ymout, int item) {
    const int bh = item >> 7, chn = item & 127, b = bh >> 3, h = bh & 7;
    const size_t S1 = (size_t)T_ * 512, base = (size_t)(b * L_ + chn * 64) * 512 + h * 64;
    LAS bf16_t* TL = (LAS bf16_t*)lds;
#define RTILE(k) (TL + (k) * 4608)
    LAS float* F = (LAS float*)(lds + 12 * 9216);
    LAS float* LL = F + 64 * 68;
    const int tid = TIDX, lane = tid & 63, wave = tid >> 6, r = lane & 15, q = lane >> 4;
    const int t = tid >> 3, c0 = (tid & 7) * 8;
    float ldv[8];
    { const u32x4 v = *(const u32x4*)(SC + 1 * S1 + base + (size_t)t * 512 + c0); unpack8f(v, ldv);
#pragma unroll
      for (int j = 0; j < 8; ++j) F[t * 68 + c0 + j] = ldv[j]; }
    __syncthreads();
#pragma unroll
    for (int cc = 0; cc < 8; ++cc) {
        const int c = wave * 8 + cc;
        float v = F[lane * 68 + c];
#pragma unroll
        for (int o = 1; o < 64; o <<= 1) { const float n = __shfl_up(v, o); if (lane >= o) v += n; }
        F[lane * 68 + c] = v;
    }
    __syncthreads();
    {
        float rr[8], kp[8], vv[8], kk[8], aa[8];
        unpack8f(*(const u32x4*)(SC + 0 * S1 + base + (size_t)t * 512 + c0), rr);
        unpack8f(*(const u32x4*)(SC + 2 * S1 + base + (size_t)t * 512 + c0), kp);
        unpack8f(*(const u32x4*)(SC + 3 * S1 + base + (size_t)t * 512 + c0), vv);
        unpack8f(*(const u32x4*)(SC + 4 * S1 + base + (size_t)t * 512 + c0), kk);
        unpack8f(*(const u32x4*)(SC + 5 * S1 + base + (size_t)t * 512 + c0), aa);
        float at[8], rt[8], bt[8], kt[8];
#pragma unroll
        for (int j = 0; j < 8; ++j) {
            const float cs = F[t * 68 + c0 + j], last = __expf(F[63 * 68 + c0 + j]);
            const float Lt = __expf(cs), Ltm1 = __expf(cs - ldv[j]), inv = __expf(-cs);
            at[j] = -kk[j] * Ltm1; rt[j] = rr[j] * Lt; bt[j] = kk[j] * aa[j] * inv; kt[j] = kp[j] * inv;
            RTILE(4)[(c0 + j) * 72 + t] = f2bf(at[j]);
            RTILE(5)[(c0 + j) * 72 + t] = f2bf(bt[j] * last);
            RTILE(6)[(c0 + j) * 72 + t] = f2bf(kt[j] * last);
            RTILE(7)[(c0 + j) * 72 + t] = f2bf(vv[j]);
            if (t == 63) LL[c0 + j] = last;
        }
        *(LAS u32x4*)(RTILE(0) + t * 72 + c0) = pack8f(at);
        *(LAS u32x4*)(RTILE(1) + t * 72 + c0) = pack8f(bt);
        *(LAS u32x4*)(RTILE(2) + t * 72 + c0) = pack8f(kt);
        *(LAS u32x4*)(RTILE(3) + t * 72 + c0) = pack8f(rt);
    }
    __syncthreads();
    {
        const int mtx = wave >> 1;
        const LAS bf16_t* X = (mtx < 2) ? RTILE(0) : RTILE(3);
        const LAS bf16_t* Y = (mtx & 1) ? RTILE(2) : RTILE(1);
#pragma unroll
        for (int k8 = 0; k8 < 8; ++k8) {
            const int idx = (wave & 1) * 8 + k8, ti = idx >> 2, si = idx & 3;
            f32x4 acc = {0.f, 0.f, 0.f, 0.f};
            if (si <= ti) acc = mm64(acc, Y, si * 16, X, ti * 16, r, q);
            const int tt = ti * 16 + r, s0 = si * 16 + 4 * q;
#pragma unroll
            for (int jj = 0; jj < 4; ++jj) { const bool keep = (mtx < 2) ? (s0 + jj < tt) : (s0 + jj <= tt); acc[jj] = keep ? acc[jj] : 0.f; }
            if (mtx == 0) *(LAS f32x4*)(F + tt * 68 + s0) = acc;
            else { u32x2 w; w.x = pk2(acc[0], acc[1]); w.y = pk2(acc[2], acc[3]); *(LAS u32x2*)(RTILE(7 + mtx) + tt * 72 + s0) = w; }
        }
    }
    __syncthreads();
    if (wave == 0) {
        float X[64];
        int lz = lane; asm volatile("" : "+v"(lz));
        const LAS float* Fb = F; asm volatile("" : "+v"(Fb));
#pragma unroll
        for (int tt = 0; tt < 64; ++tt) {
            float acc = (tt == lz) ? 1.f : 0.f;
#pragma unroll
            for (int s4 = 0; s4 < (tt + 3) / 4; ++s4) {
                const f32x4 a = *(const LAS f32x4*)(Fb + tt * 68 + 4 * s4);
#pragma unroll
                for (int j = 0; j < 4; ++j) if (4 * s4 + j < tt) acc += a[j] * X[4 * s4 + j];
            }
            X[tt] = acc;
            RTILE(11)[tt * 72 + lz] = f2bf(acc);
        }
    } else {
        for (int idx = wave - 1; idx < 16; idx += 7) {
            const int vi = idx >> 2, ti = idx & 3;
            f32x4 acc = {0.f, 0.f, 0.f, 0.f};
            acc = mm64(acc, RTILE(8), ti * 16, RTILE(7), vi * 16, r, q);
            u32x2 w; w.x = pk2(acc[0], acc[1]); w.y = pk2(acc[2], acc[3]);
            *(LAS u32x2*)(RTILE(2) + (vi * 16 + r) * 72 + ti * 16 + 4 * q) = w;
        }
    }
    __syncthreads();
#pragma unroll
    for (int k = 0; k < 4; ++k) {
        const int idx = wave * 4 + k, which = idx >> 4, xi = (idx >> 2) & 3, ti = idx & 3;
        f32x4 acc = {0.f, 0.f, 0.f, 0.f};
        acc = mm64(acc, RTILE(11), ti * 16, which ? RTILE(2) : RTILE(4), xi * 16, r, q);
        u32x2 w; w.x = pk2(acc[0], acc[1]); w.y = pk2(acc[2], acc[3]);
        *(LAS u32x2*)((which ? RTILE(1) : RTILE(0)) + (xi * 16 + r) * 72 + ti * 16 + 4 * q) = w;
    }
    __syncthreads();
#pragma unroll
    for (int k = 0; k < 8; ++k) {
        const int idx = wave * 8 + k, which = idx >> 4, i1 = (idx >> 2) & 3, i2 = idx & 3;
        f32x4 acc = {0.f, 0.f, 0.f, 0.f};
        if (which == 0) {
            acc = mm64(acc, RTILE(0), i2 * 16, RTILE(9), i1 * 16, r, q);
            const int tt = i1 * 16 + r, cc = i2 * 16 + 4 * q;
            const u32x2 rv = *(const LAS u32x2*)(RTILE(3) + tt * 72 + cc);
            acc[0] += __uint_as_float(rv.x << 16); acc[1] += __uint_as_float(rv.x & 0xffff0000u); acc[2] += __uint_as_float(rv.y << 16); acc[3] += __uint_as_float(rv.y & 0xffff0000u);
            u32x2 w; w.x = pk2(acc[0], acc[1]); w.y = pk2(acc[2], acc[3]);
            *(u32x2*)(Rmout + (size_t)item * 4096 + tt * 64 + cc) = w;
        } else if (which == 1) {
            acc = mm64(acc, RTILE(9), i1 * 16, RTILE(1), i2 * 16, r, q);
            acc = mm64(acc, RTILE(10), i1 * 16, RTILE(7), i2 * 16, r, q);
            u32x2 w; w.x = pk2(acc[0], acc[1]); w.y = pk2(acc[2], acc[3]);
            *(u32x2*)(Ymout + (((size_t)item * 16 + i1 * 4 + i2) * 64 + lane) * 4) = w;
        } else if (which == 2) {
            acc = mm64(acc, RTILE(0), i2 * 16, RTILE(5), i1 * 16, r, q);
            const int c1 = i1 * 16 + r, c2 = i2 * 16 + 4 * q;
#pragma unroll
            for (int jj = 0; jj < 4; ++jj) if (c2 + jj == c1) acc[jj] += LL[c1];
            u32x2 w; w.x = pk2(acc[0], acc[1]); w.y = pk2(acc[2], acc[3]);
            *(u32x2*)(Gout + (size_t)item * 4096 + c1 * 64 + c2) = w;
        } else {
            acc = mm64(acc, RTILE(5), i1 * 16, RTILE(1), i2 * 16, r, q);
            acc = mm64(acc, RTILE(6), i1 * 16, RTILE(7), i2 * 16, r, q);
            *(f32x4*)(HTout + (((size_t)item * 16 + i1 * 4 + i2) * 64 + lane) * 4) = acc;
        }
    }
    __syncthreads();
#undef RTILE
}

__device__ __forceinline__ void rwkv_chunk_seq(LAS unsigned char* lds, const bf16_t* G, const bf16_t* Rm, const float* HT, const bf16_t* Ym, float* YRW, int bh) {
    const int b = bh >> 3, h = bh & 7;
    const int tid = TIDX, lane = tid & 63, wave = tid >> 6, r = lane & 15, q = lane >> 4;
    const int rt = wave >> 1, vi0 = (wave & 1) * 2;
    LAS bf16_t* Sb0 = (LAS bf16_t*)lds;
    f32x4 Sacc[2] = {{0.f, 0.f, 0.f, 0.f}, {0.f, 0.f, 0.f, 0.f}};
    size_t item = (size_t)bh * 128;
    auto fetch = [&](size_t it, bf16x8* rm, bf16x8* g, u32x2* ym, f32x4* ht) {
#pragma unroll
        for (int ks = 0; ks < 2; ++ks) {
            rm[ks] = *(const bf16x8*)(Rm + it * 4096 + (rt * 16 + r) * 64 + 32 * ks + 8 * q);
            g[ks] = *(const bf16x8*)(G + it * 4096 + (rt * 16 + r) * 64 + 32 * ks + 8 * q);
        }
#pragma unroll
        for (int k = 0; k < 2; ++k) {
            ym[k] = *(const u32x2*)(Ym + ((it * 16 + rt * 4 + vi0 + k) * 64 + lane) * 4);
            ht[k] = *(const f32x4*)(HT + ((it * 16 + rt * 4 + vi0 + k) * 64 + lane) * 4);
        }
    };
    constexpr int PF = 4;
    bf16x8 prm[PF][2], pg[PF][2]; u32x2 pym[PF][2]; f32x4 pht[PF][2];
#pragma unroll
    for (int u = 0; u < PF; ++u) fetch(item + u, prm[u], pg[u], pym[u], pht[u]);
    for (int ch0 = 0; ch0 < 128; ch0 += PF) {
#pragma unroll
        for (int u = 0; u < PF; ++u) {
            const int ch = ch0 + u;
            LAS bf16_t* Sb = Sb0 + (ch & 1) * 4608;
#pragma unroll
            for (int k = 0; k < 2; ++k) { u32x2 w; w.x = pk2(Sacc[k][0], Sacc[k][1]); w.y = pk2(Sacc[k][2], Sacc[k][3]); *(LAS u32x2*)(Sb + ((vi0 + k) * 16 + r) * 72 + rt * 16 + 4 * q) = w; }
            __syncthreads();
            float* yb = YRW + (size_t)(b * L_ + ch * 64 + rt * 16 + 4 * q) * 512 + h * 64 + r;
#pragma unroll
            for (int k = 0; k < 2; ++k) {
                const bf16x8 s0 = ldfrag(Sb, (vi0 + k) * 16, 0, r, q), s1 = ldfrag(Sb, (vi0 + k) * 16, 1, r, q);
                f32x4 ya; ya[0] = __uint_as_float(pym[u][k].x << 16); ya[1] = __uint_as_float(pym[u][k].x & 0xffff0000u); ya[2] = __uint_as_float(pym[u][k].y << 16); ya[3] = __uint_as_float(pym[u][k].y & 0xffff0000u);
                ya = __builtin_amdgcn_mfma_f32_16x16x32_bf16(prm[u][0], s0, ya, 0, 0, 0);
                ya = __builtin_amdgcn_mfma_f32_16x16x32_bf16(prm[u][1], s1, ya, 0, 0, 0);
                f32x4 sa = pht[u][k];
                sa = __builtin_amdgcn_mfma_f32_16x16x32_bf16(pg[u][0], s0, sa, 0, 0, 0);
                sa = __builtin_amdgcn_mfma_f32_16x16x32_bf16(pg[u][1], s1, sa, 0, 0, 0);
                Sacc[k] = sa;
#pragma unroll
                for (int jj = 0; jj < 4; ++jj) yb[(size_t)jj * 512 + (vi0 + k) * 16] = ya[jj];
            }
            const int nch = ch + PF < 128 ? ch + PF : 127;
            fetch(item + nch, prm[u], pg[u], pym[u], pht[u]);
        }
    }
}

__device__ __forceinline__ void sub_barrier(unsigned* ctr, unsigned nblocks) {
    asm volatile("s_waitcnt vmcnt(0)" ::: "memory");
    __syncthreads();
    if (TIDX == 0) {
        __builtin_amdgcn_fence(__ATOMIC_RELEASE, "agent");
        asm volatile("s_waitcnt vmcnt(0)" ::: "memory");
        xb_add(ctr, 1u);
        unsigned sp = 0;
        while (xb_ld(ctr) < nblocks) { __builtin_amdgcn_s_sleep(2); if (++sp > (1u << 22)) break; }
        __builtin_amdgcn_fence(__ATOMIC_ACQUIRE, "agent");
        asm volatile("s_waitcnt vmcnt(0)" ::: "memory");
    }
    __syncthreads();
}


__device__ __forceinline__ void s5_tables(LAS float* lds, const float* a_re, const float* a_im, const float* log_dt, const float* b_re, const float* b_im,
                                          const float* c_re, const float* c_im, bf16_t* MB, bf16_t* WE, int g) {
    LAS float* pwr = lds;
    LAS float* pwi = pwr + 33 * 64;
    LAS float* zbr = pwi + 33 * 64;
    LAS float* zbi = zbr + 1024;
    LAS float* cr = zbi + 1024;
    LAS float* ci = cr + 1024;
    LAS float* kern = ci + 1024;
    const int tid = TIDX;
    if (tid < 64) {
        const int n = tid;
        const float lam_re = fminf(a_re[g * 64 + n], -1e-4f), lam_im = a_im[g * 64 + n];
        const float dt = __expf(log_dt[g]);
        const float mag = __expf(lam_re * dt);
        const float ab_re = mag * cosf(lam_im * dt), ab_im = mag * sinf(lam_im * dt);
        const float den = lam_re * lam_re + lam_im * lam_im;
        const float num_re = ab_re - 1.f;
        const float z_re = (num_re * lam_re + ab_im * lam_im) / den;
        const float z_im = (ab_im * lam_re - num_re * lam_im) / den;
        for (int tau = 0; tau <= 32; ++tau) {
            const float m = __expf(lam_re * dt * (float)tau), ang = lam_im * dt * (float)tau;
            pwr[tau * 64 + n] = m * cosf(ang); pwi[tau * 64 + n] = m * sinf(ang);
        }
        for (int c = 0; c < 16; ++c) {
            const float br = b_re[(size_t)(g * 64 + n) * 16 + c], bi = b_im[(size_t)(g * 64 + n) * 16 + c];
            zbr[n * 16 + c] = z_re * br - z_im * bi; zbi[n * 16 + c] = z_re * bi + z_im * br;
        }
    }
    for (int idx = tid; idx < 1024; idx += NTHREADS) { cr[idx] = c_re[(size_t)g * 1024 + idx]; ci[idx] = c_im[(size_t)g * 1024 + idx]; }
    __syncthreads();
    for (int idx = tid; idx < 32 * 256; idx += NTHREADS) {
        const int tau = idx >> 8, c = (idx >> 4) & 15, cp = idx & 15;
        float acc = 0.f;
        for (int n = 0; n < 64; ++n) {
            const float pr = pwr[tau * 64 + n], pi = pwi[tau * 64 + n], zr = zbr[n * 16 + cp], zi = zbi[n * 16 + cp];
            const float wr = pr * zr - pi * zi, wi = pr * zi + pi * zr;
            acc += cr[c * 64 + n] * wr - ci[c * 64 + n] * wi;
        }
        kern[idx] = acc;
    }
    __syncthreads();
    for (int idx = tid; idx < 512 * 640; idx += NTHREADS) {
        const int row = idx / 640, col = idx % 640, i = row >> 4, c = row & 15;
        float v;
        if (col < 512) { const int j = col >> 4, cp = col & 15; v = (j <= i) ? kern[((i - j) * 16 + c) * 16 + cp] : 0.f; }
        else if (col < 576) { const int n = col - 512; v = cr[c * 64 + n] * pwr[(i + 1) * 64 + n] - ci[c * 64 + n] * pwi[(i + 1) * 64 + n]; }
        else { const int n = col - 576; v = -(cr[c * 64 + n] * pwi[(i + 1) * 64 + n] + ci[c * 64 + n] * pwr[(i + 1) * 64 + n]); }
        MB[((size_t)g * 512 + row) * 640 + col] = f2bf(v);
    }
    for (int idx = tid; idx < 256 * 512; idx += NTHREADS) {
        const int np = idx >> 9, col = idx & 511;
        float v = 0.f;
        if (np < 128) {
            const int n = np & 63, j = col >> 4, cp = col & 15;
            const float pr = pwr[(31 - j) * 64 + n], pi = pwi[(31 - j) * 64 + n], zr = zbr[n * 16 + cp], zi = zbi[n * 16 + cp];
            v = np < 64 ? (pr * zr - pi * zi) : (pr * zi + pi * zr);
        }
        WE[((size_t)g * 256 + np) * 512 + col] = f2bf(v);
    }
    __syncthreads();
}
__device__ __forceinline__ void s5_fill_ua(const bf16_t* P1, bf16_t* UA, int gw, int ngw, int lane) {
    for (int t = gw; t < T_; t += ngw) {
        const int b = t >> 13, tt = t & 8191, c32 = tt >> 5, j = tt & 31, g = lane >> 1, c0 = (lane & 1) * 8;
        const u32x4 v = *(const u32x4*)(P1 + (size_t)t * NIN1 + 8 * lane);
        *(u32x4*)(UA + ((size_t)g * 512 + b * 256 + c32) * 640 + j * 16 + c0) = v;
    }
}
__device__ __forceinline__ void s5_carry(const float* a_re, const float* a_im, const float* log_dt, const float* E, bf16_t* UA, int th) {
    const int n = th & 63, g = (th >> 6) & 31, b = th >> 11;
    const float lam_re = fminf(a_re[g * 64 + n], -1e-4f), lam_im = a_im[g * 64 + n];
    const float dt = __expf(log_dt[g]);
    const float m = __expf(lam_re * dt * 32.f), ang = lam_im * dt * 32.f;
    const float ar = m * cosf(ang), ai = m * sinf(ang);
    float hr = 0.f, hi = 0.f;
#pragma unroll 8
    for (int c = 0; c < 256; ++c) {
        const size_t row = (size_t)g * 512 + b * 256 + c;
        const float er = E[row * 256 + n], ei = E[row * 256 + 64 + n];
        UA[row * 640 + 512 + n] = f2bf(hr); UA[row * 640 + 576 + n] = f2bf(hi);
        const float nr = ar * hr - ai * hi + er, ni = ar * hi + ai * hr + ei;
        hr = nr; hi = ni;
    }
}

struct Args {
    const float* in[42];
    float* out;
    unsigned char* ws;
    int ph_lo, ph_hi;
};

template <bool DUAL, class AF, class WF, class EF>
__device__ __forceinline__ void naive_gemm(LAS float* lds, int M, int N, int K, AF arow, WF wbase, int ldw, EF epi) {
    LAS float* As = lds;
    LAS float* Bs = lds + 64 * 33;
    LAS float* Bs2 = Bs + 32 * 64;
    const int tid = TIDX, ty = tid >> 4, tx = tid & 15;
    const int tm = (M + 63) / 64, tn = (N + 63) / 64;
    for (int tile = blockIdx.x; tile < tm * tn; tile += gridDim.x) {
        const int m0 = (tile / tn) * 64, n0 = (tile % tn) * 64;
        const float* W = wbase(m0, 0);
        const float* W2 = DUAL ? wbase(m0, 1) : W;
        float acc[2][4], acc2[2][4];
#pragma unroll
        for (int i = 0; i < 2; ++i)
#pragma unroll
            for (int j = 0; j < 4; ++j) { acc[i][j] = 0.f; acc2[i][j] = 0.f; }
        for (int k0 = 0; k0 < K; k0 += 32) {
#pragma unroll
            for (int i = 0; i < 4; ++i) {
                const int idx = tid + i * 512, r = idx >> 5, kk = idx & 31, m = m0 + r;
                As[r * 33 + kk] = (m < M) ? bf2f(arow(m)[k0 + kk]) : 0.f;
            }
#pragma unroll
            for (int i = 0; i < 4; ++i) {
                const int idx = tid + i * 512, kk = idx >> 6, n = idx & 63;
                const bool ok = (n0 + n) < N;
                Bs[kk * 64 + n] = ok ? W[(size_t)(k0 + kk) * ldw + n0 + n] : 0.f;
                if (DUAL) Bs2[kk * 64 + n] = ok ? W2[(size_t)(k0 + kk) * ldw + n0 + n] : 0.f;
            }
            __syncthreads();
#pragma unroll 8
            for (int kk = 0; kk < 32; ++kk) {
                const float a0 = As[(ty * 2) * 33 + kk], a1 = As[(ty * 2 + 1) * 33 + kk];
#pragma unroll
                for (int j = 0; j < 4; ++j) {
                    const float b = Bs[kk * 64 + tx * 4 + j];
                    acc[0][j] += a0 * b; acc[1][j] += a1 * b;
                    if (DUAL) { const float b2 = Bs2[kk * 64 + tx * 4 + j]; acc2[0][j] += a0 * b2; acc2[1][j] += a1 * b2; }
                }
            }
            __syncthreads();
        }
#pragma unroll
        for (int i = 0; i < 2; ++i)
#pragma unroll
            for (int j = 0; j < 4; ++j) {
                const int m = m0 + ty * 2 + i, n = n0 + tx * 4 + j;
                if (m < M && n < N) epi(m, n, acc[i][j], acc2[i][j]);
            }
    }
}

template <class SRC, class DROW>
__device__ __forceinline__ void xpose_item(SRC src, DROW drow, bf16_t* WT, int ldk, LAS float* scr, int k0, int n0, int lane) {
#pragma unroll 8
    for (int i = 0; i < 32; ++i) { const int kk = 2 * i + (lane >> 5); scr[kk * 33 + (lane & 31)] = src(k0 + kk, n0 + (lane & 31)); }
    asm volatile("s_waitcnt lgkmcnt(0)" ::: "memory");
    const int c = lane & 7;
#pragma unroll
    for (int j = 0; j < 4; ++j) {
        const int n = (lane >> 3) + 8 * j; const LAS float* sp = scr + (8 * c) * 33 + n;
        u32x4 o; o.x = pk2(sp[0 * 33], sp[1 * 33]); o.y = pk2(sp[2 * 33], sp[3 * 33]); o.z = pk2(sp[4 * 33], sp[5 * 33]); o.w = pk2(sp[6 * 33], sp[7 * 33]);
        *(u32x4*)(WT + (size_t)drow(n0 + n) * ldk + k0 + 8 * c) = o;
    }
    asm volatile("s_waitcnt lgkmcnt(0)" ::: "memory");
}
__device__ __forceinline__ void convert_plain(const float* W, int K, int N, int NP, bf16_t* WT, LAS float* scr, int gw, int ngw, int lane) {
    const int nblk = NP / 32, nitems = (K / 64) * nblk;
    for (int it = gw; it < nitems; it += ngw) {
        const int k0 = 64 * (it / nblk), n0 = 32 * (it % nblk);
        xpose_item([&](int k, int n) { return n < N ? W[(size_t)k * N + n] : 0.f; }, [&](int n) { return n; }, WT, K, scr, k0, n0, lane);
    }
}
__device__ __forceinline__ void convert_lora(const float* w2, const float* a2, const float* g2, bf16_t* WT, LAS float* scr, int gw, int ngw, int lane) {
    const int nblk = NLORA / 32, nitems = 4 * nblk;
    for (int it = gw; it < nitems; it += ngw) {
        const int k0 = 64 * (it / nblk), n0 = 32 * (it % nblk);
        xpose_item([&](int k, int n) {
            if (n < 512) return k < 64 ? w2[k * 512 + n] : 0.f;
            if (n < 1024) return (k >= 64 && k < 128) ? a2[(k - 64) * 512 + (n - 512)] : 0.f;
            return k >= 128 ? g2[(k - 128) * 512 + (n - 1024)] : 0.f; }, [&](int n) { return n; }, WT, 256, scr, k0, n0, lane);
    }
}
__device__ __forceinline__ void convert_moe(const float* w1, const float* w3, const float* w2, bf16_t* W13, bf16_t* W2T, LAS float* scr, int gw, int ngw, int lane) {
    constexpr int I13 = 16 * 32, I2 = 8 * 32, IE = I13 + I2;
    for (int it = gw; it < 32 * IE; it += ngw) {
        const int e = it / IE, r = it % IE;
        if (r < I13) {
            const int k0 = 64 * (r / 32), n0 = 32 * (r % 32);
            const float* a = w1 + (size_t)e * D_ * 512; const float* b = w3 + (size_t)e * D_ * 512;
            xpose_item([&](int k, int n) { return n < 512 ? a[(size_t)k * 512 + n] : b[(size_t)k * 512 + (n - 512)]; },
                       [&](int n) { const int c = n & 511; return (c >> 2) * 8 + (n >> 9) * 4 + (c & 3); }, W13 + (size_t)e * 1024 * 1024, 1024, scr, k0, n0, lane);
        } else {
            const int rr = r - I13, k0 = 64 * (rr / 32), n0 = 32 * (rr % 32);
            const float* a = w2 + (size_t)e * 512 * D_;
            xpose_item([&](int k, int n) { return a[(size_t)k * D_ + n]; }, [&](int n) { return n; }, W2T + (size_t)e * 1024 * 512, 512, scr, k0, n0, lane);
        }
    }
}

__device__ __forceinline__ void ph_prologue(const float* x, bf16_t* hb) {
    const size_t n4 = (size_t)T_ * D_ / 4;
    for (size_t i = (size_t)blockIdx.x * NTHREADS + TIDX; i < n4; i += (size_t)gridDim.x * NTHREADS) {
        const f32x4 v = ((const f32x4*)x)[i];
        u32x2 o; o.x = pk2(v.x, v.y); o.y = pk2(v.z, v.w);
        ((u32x2*)hb)[i] = o;
    }
    for (size_t i = (size_t)blockIdx.x * NTHREADS + TIDX; i < (size_t)256 * D_ / 2; i += (size_t)gridDim.x * NTHREADS)
        ((unsigned*)(hb + (size_t)T_ * D_))[i] = 0u;
}

__device__ __forceinline__ float p0_shift(const bf16_t* P, const float* mu, int t, int c) {
    const float p = bf2f(P[(size_t)t * NIN0P + c]);
    const float pv = ((t & (L_ - 1)) == 0) ? 0.f : bf2f(P[(size_t)(t - 1) * NIN0P + c]);
    return p + mu[c] * (pv - p);
}
template <bool WITH_GLA>
__device__ __forceinline__ void ph_prepA0(const bf16_t* P, const float* mu, const float* gk_w2, const float* gk_b, bf16_t* Ap, float* gla_la) {
    for (int chunk = blockIdx.x; chunk < T_ / 64; chunk += gridDim.x) {
        for (int idx = TIDX; idx < 64 * 256; idx += NTHREADS) {
            const int tl = idx >> 8, j = idx & 255, t = chunk * 64 + tl;
            float v;
            if (j < 64) v = tanhf(p0_shift(P, mu, t, 512 + j));
            else if (j < 128) v = p0_shift(P, mu, t, 1600 + (j - 64));
            else v = sigm(p0_shift(P, mu, t, 1664 + (j - 128)));
            Ap[(size_t)t * 256 + j] = f2bf(v);
            if (WITH_GLA) {
                float gk = gk_b[j];
#pragma unroll
                for (int i = 0; i < 16; ++i) gk += bf2f(P[(size_t)t * NIN0P + 2816 + i]) * gk_w2[i * 256 + j];
                const float ls = fminf(gk, 0.f) - log1pf(__expf(-fabsf(gk)));
                gla_la[(size_t)t * 256 + j] = ls * (1.f / 16.f);
            }
        }
    }
}

__device__ __forceinline__ void ph_prepB0(const bf16_t* P, const bf16_t* LO, const float* mu, const float* w0, const float* a0, const float* k_k, const float* k_a,
                                          const float* r_k, bf16_t* SC, float* BON) {
    const int wave = TIDX >> 6, lane = TIDX & 63;
    for (int item = blockIdx.x * NWAVES + wave; item < T_ * 8; item += gridDim.x * NWAVES) {
        const int t = item >> 3, h = item & 7, c = h * 64 + lane;
        const float r = p0_shift(P, mu, t, c), k = p0_shift(P, mu, t, 576 + c), v = p0_shift(P, mu, t, 1088 + c);
        const float low = bf2f(LO[(size_t)t * 512 + c]), loa = bf2f(LO[(size_t)T_ * 512 + (size_t)t * 512 + c]);
        const float xw = w0[c] + low;
        const float wraw = -softplusf(-xw) - 0.5f;
        const float ld = -__expf(wraw);
        const float a = sigm(a0[c] + loa);
        const float kkr = k * k_k[c];
        const float ss = wave_sum(kkr * kkr);
        const float kk = kkr / fmaxf(sqrtf(ss), 1e-12f);
        const float kp = k * (1.f + (a - 1.f) * k_a[c]);
        const float bon = wave_sum(r * kp * r_k[c]);
        const size_t o = (size_t)t * 512 + c, S1 = (size_t)T_ * 512;
        SC[o] = f2bf(r); SC[S1 + o] = f2bf(ld); SC[2 * S1 + o] = f2bf(kp); SC[3 * S1 + o] = f2bf(v); SC[4 * S1 + o] = f2bf(kk); SC[5 * S1 + o] = f2bf(a);
        if (lane == 0) BON[(size_t)t * 8 + h] = bon;
    }
}

__device__ __forceinline__ void naive_rwkv_scan(LAS float* lds, const bf16_t* SC, float* YRW, int bh) {
    constexpr int TS = 32;
    const int b = bh >> 3, h = bh & 7;
    LAS float* Lnkk = lds;
    LAS float* Ldec = lds + TS * 64;
    LAS float* Lab = lds + 2 * TS * 64;
    LAS float* Lkp = lds + 3 * TS * 64;
    LAS float* Lr = lds + 4 * TS * 64;
    LAS float* Lv = lds + 5 * TS * 64;
    const size_t S1 = (size_t)T_ * 512;
    float S[64];
#pragma unroll
    for (int k = 0; k < 64; ++k) S[k] = 0.f;
    const int lane = TIDX & 63, wave = TIDX >> 6;
    for (int t0 = 0; t0 < L_; t0 += TS) {
        for (int idx = TIDX; idx < TS * 64; idx += NTHREADS) {
            const int s = idx >> 6, k = idx & 63;
            const size_t o = (size_t)(b * L_ + t0 + s) * 512 + h * 64 + k;
            const float r = bf2f(SC[o]), ld = bf2f(SC[S1 + o]), kp = bf2f(SC[2 * S1 + o]), v = bf2f(SC[3 * S1 + o]), kk = bf2f(SC[4 * S1 + o]), a = bf2f(SC[5 * S1 + o]);
            Lnkk[idx] = -kk; Ldec[idx] = __expf(ld); Lab[idx] = kk * a; Lkp[idx] = kp; Lr[idx] = r; Lv[idx] = v;
        }
        __syncthreads();
        if (wave == 0) {
            for (int s = 0; s < TS; ++s) {
                float sa = 0.f;
#pragma unroll
                for (int k = 0; k < 64; ++k) sa += S[k] * Lnkk[s * 64 + k];
                const float vv = Lv[s * 64 + lane];
                float y = 0.f;
#pragma unroll
                for (int k = 0; k < 64; ++k) {
                    S[k] = S[k] * Ldec[s * 64 + k] + sa * Lab[s * 64 + k] + vv * Lkp[s * 64 + k];
                    y += S[k] * Lr[s * 64 + k];
                }
                YRW[(size_t)(b * L_ + t0 + s) * 512 + h * 64 + lane] = y;
            }
        }
        __syncthreads();
    }
}

template <int K, class LDF, class LVF>
__device__ __forceinline__ void naive_gla_scan(LAS float* lds, LDF ld, LVF lv, float* OG, int b, int h) {
    constexpr int TS = 16;
    LAS float* Lq = lds;
    LAS float* Lk = lds + TS * K;
    LAS float* Le = lds + 2 * TS * K;
    LAS float* Lv = lds + 3 * TS * K;
    float S[K];
#pragma unroll
    for (int k = 0; k < K; ++k) S[k] = 0.f;
    const int tid = TIDX;
    for (int t0 = 0; t0 < L_; t0 += TS) {
        for (int idx = tid; idx < TS * K; idx += NTHREADS) {
            const int s = idx / K, k = idx % K;
            float q, kk, e; ld(b * L_ + t0 + s, h * K + k, q, kk, e);
            Lq[idx] = q; Lk[idx] = kk; Le[idx] = e;
        }
        for (int idx = tid; idx < TS * 128; idx += NTHREADS) {
            const int s = idx >> 7, vc = idx & 127;
            Lv[idx] = lv(b * L_ + t0 + s, h * 128 + vc);
        }
        __syncthreads();
        if (tid < 128) {
            for (int s = 0; s < TS; ++s) {
                const float vv = Lv[s * 128 + tid];
                float o = 0.f;
#pragma unroll
                for (int k = 0; k < K; ++k) {
                    S[k] = S[k] * Le[s * K + k] + Lk[s * K + k] * vv;
                    o += Lq[s * K + k] * S[k];
                }
                OG[(size_t)(b * L_ + t0 + s) * 512 + h * 128 + tid] = o;
            }
        }
        __syncthreads();
    }
}

template <bool WITH_GLA>
__device__ __forceinline__ void ph_fin0(const float* YRW, const float* OG, const bf16_t* P, const bf16_t* LO, const bf16_t* SC, const float* BON,
                                        const float* gn_g, const float* gn_b, const float* norm_g, bf16_t* Ymix) {
    const int wave = TIDX >> 6, lane = TIDX & 63;
    const size_t S1 = (size_t)T_ * 512;
    constexpr int NU = WITH_GLA ? 12 : 8;
    for (int item = blockIdx.x * NWAVES + wave; item < T_ * NU; item += gridDim.x * NWAVES) {
        const int t = item / NU, u = item % NU;
        if (u < 8) {
            const int c = u * 64 + lane;
            const float y = YRW[(size_t)t * 512 + c];
            const float mean = wave_sum(y) * (1.f / 64.f);
            const float d = y - mean;
            const float var = wave_sum(d * d) * (1.f / 64.f);
            const float yn = d * rsqrtf(var + 64e-5f) * gn_g[c] + gn_b[c];
            const float v = bf2f(SC[3 * S1 + (size_t)t * 512 + c]);
            const float g = bf2f(LO[(size_t)2 * T_ * 512 + (size_t)t * 512 + c]);
            Ymix[(size_t)t * D_ + c] = f2bf((yn + BON[(size_t)t * 8 + u] * v) * g);
        } else {
            const int h = u - 8;
            const float o0 = OG[(size_t)t * 512 + h * 128 + lane], o1 = OG[(size_t)t * 512 + h * 128 + 64 + lane];
            const float ms = wave_sum(o0 * o0 + o1 * o1) * (1.f / 128.f);
            const float rs = rsqrtf(ms + LN_EPS);
            const float g0 = bf2f(P[(size_t)t * NIN0P + 2832 + h * 128 + lane]), g1 = bf2f(P[(size_t)t * NIN0P + 2832 + h * 128 + 64 + lane]);
            Ymix[(size_t)t * D_ + 512 + h * 128 + lane] = f2bf(o0 * rs * norm_g[lane] * siluf(g0));
            Ymix[(size_t)t * D_ + 512 + h * 128 + 64 + lane] = f2bf(o1 * rs * norm_g[64 + lane] * siluf(g1));
        }
    }
}

__device__ __forceinline__ void ph_ln_router(const float* src, float* hf, bf16_t* hb, const float* lg, const float* lb, const float* wg, const float* bg,
                                             const float* we, const float* be, int* tok_e, int* tok_slot, float* tok_g, unsigned* cnt) {
    const int wave = TIDX >> 6, lane = TIDX & 63;
    for (int t = blockIdx.x * NWAVES + wave; t < T_; t += gridDim.x * NWAVES) {
        const f32x4* xr = (const f32x4*)(src + (size_t)t * D_) + lane;
        f32x4 v[4]; float s = 0.f;
#pragma unroll
        for (int j = 0; j < 4; ++j) { v[j] = xr[64 * j]; s += (v[j].x + v[j].y) + (v[j].z + v[j].w); }
        const float mean = wave_sum(s) * (1.f / D_);
        float s2 = 0.f;
#pragma unroll
        for (int j = 0; j < 4; ++j) { v[j] = v[j] - mean; s2 += (v[j].x * v[j].x + v[j].y * v[j].y) + (v[j].z * v[j].z + v[j].w * v[j].w); }
        const float rstd = rsqrtf(wave_sum(s2) * (1.f / D_) + LN_EPS);
#pragma unroll
        for (int j = 0; j < 4; ++j) {
            const f32x4 g = ((const f32x4*)lg)[lane + 64 * j], bb = ((const f32x4*)lb)[lane + 64 * j];
            v[j] = v[j] * rstd * g + bb;
            ((f32x4*)(hf + (size_t)t * D_))[lane + 64 * j] = v[j];
            u32x2 o; o.x = pk2(v[j].x, v[j].y); o.y = pk2(v[j].z, v[j].w);
            ((u32x2*)(hb + (size_t)t * D_))[lane + 64 * j] = o;
        }
        float cl[4] = {0.f, 0.f, 0.f, 0.f};
#pragma unroll
        for (int j = 0; j < 4; ++j)
#pragma unroll
            for (int e = 0; e < 4; ++e) {
                const int d = 4 * (lane + 64 * j) + e;
                const f32x4 w = *(const f32x4*)(wg + (size_t)d * 4);
                const float xv = v[j][e];
                cl[0] += xv * w.x; cl[1] += xv * w.y; cl[2] += xv * w.z; cl[3] += xv * w.w;
            }
#pragma unroll
        for (int g = 0; g < 4; ++g) cl[g] = wave_sum(cl[g]) + bg[g];
        int grp = 0; float mx = cl[0];
#pragma unroll
        for (int g = 1; g < 4; ++g) if (cl[g] > mx) { mx = cl[g]; grp = g; }
        float den = 0.f;
#pragma unroll
        for (int g = 0; g < 4; ++g) den += __expf(cl[g] - mx);
        const float p_grp = 1.f / den;
        float fl[8];
#pragma unroll
        for (int e = 0; e < 8; ++e) fl[e] = 0.f;
        const float* weg = we + (size_t)grp * D_ * 8;
#pragma unroll
        for (int j = 0; j < 4; ++j)
#pragma unroll
            for (int e = 0; e < 4; ++e) {
                const int d = 4 * (lane + 64 * j) + e;
                const f32x4 w0 = *(const f32x4*)(weg + (size_t)d * 8), w1 = *(const f32x4*)(weg + (size_t)d * 8 + 4);
                const float xv = v[j][e];
                fl[0] += xv * w0.x; fl[1] += xv * w0.y; fl[2] += xv * w0.z; fl[3] += xv * w0.w;
                fl[4] += xv * w1.x; fl[5] += xv * w1.y; fl[6] += xv * w1.z; fl[7] += xv * w1.w;
            }
#pragma unroll
        for (int e = 0; e < 8; ++e) fl[e] = wave_sum(fl[e]) + be[grp * 8 + e];
        int j0 = 0; float m0 = fl[0];
#pragma unroll
        for (int e = 1; e < 8; ++e) if (fl[e] > m0) { m0 = fl[e]; j0 = e; }
        int j1 = -1; float m1 = -3.0e38f;
#pragma unroll
        for (int e = 0; e < 8; ++e) if (e != j0 && fl[e] > m1) { m1 = fl[e]; j1 = e; }
        const float e1 = __expf(m1 - m0);
        const float g0 = p_grp / (1.f + e1), g1 = p_grp * e1 / (1.f + e1);
        if (lane == 0) {
            const int ex0 = grp * 8 + j0, ex1 = grp * 8 + j1;
            const unsigned s0 = atomicAdd(&cnt[ex0], 1u), s1 = atomicAdd(&cnt[ex1], 1u);
            tok_e[2 * t] = ex0; tok_e[2 * t + 1] = ex1;
            tok_slot[2 * t] = (int)s0; tok_slot[2 * t + 1] = (int)s1;
            tok_g[2 * t] = g0; tok_g[2 * t + 1] = g1;
        }
    }
}


__device__ __forceinline__ void ld8bf(const bf16_t* p, float* f) { unpack8f(*(const u32x4*)p, f); }
__device__ __forceinline__ void ld8f(const float* p, float* f) { const f32x4 a = *(const f32x4*)p, b = *(const f32x4*)(p + 4); f[0] = a.x; f[1] = a.y; f[2] = a.z; f[3] = a.w; f[4] = b.x; f[5] = b.y; f[6] = b.z; f[7] = b.w; }
__device__ __forceinline__ void shift8(const bf16_t* P, const float* mu, int t, int c, float* out) {
    float p[8], pv[8], m[8];
    ld8bf(P + (size_t)t * NIN0P + c, p); ld8f(mu + c, m);
    if ((t & (L_ - 1)) == 0) {
#pragma unroll
        for (int j = 0; j < 8; ++j) pv[j] = 0.f;
    } else ld8bf(P + (size_t)(t - 1) * NIN0P + c, pv);
#pragma unroll
    for (int j = 0; j < 8; ++j) out[j] = p[j] + m[j] * (pv[j] - p[j]);
}
__device__ __forceinline__ void ph_prepA0v(const bf16_t* P, const float* mu, bf16_t* Ap) {
    const int tid = TIDX, wave = tid >> 6, lane = tid & 63, l5 = lane & 31;
    for (int tp = blockIdx.x * NWAVES + wave; tp < T_ / 2; tp += gridDim.x * NWAVES) {
        const int t = tp * 2 + (lane >> 5), j0 = l5 * 8;
        const int c = j0 < 64 ? 512 + j0 : (j0 < 128 ? 1600 + (j0 - 64) : 1664 + (j0 - 128));
        float x[8]; shift8(P, mu, t, c, x);
#pragma unroll
        for (int j = 0; j < 8; ++j) x[j] = j0 < 64 ? tanhf(x[j]) : (j0 < 128 ? x[j] : sigm(x[j]));
        *(u32x4*)(Ap + (size_t)t * 256 + j0) = pack8f(x);
    }
}
__device__ __forceinline__ float sum8lanes(float v) { v += __shfl_xor(v, 1); v += __shfl_xor(v, 2); v += __shfl_xor(v, 4); return v; }
__device__ __forceinline__ void ph_prepB0v(const bf16_t* P, const bf16_t* LO, const float* mu, const float* w0, const float* a0, const float* k_k, const float* k_a,
                                           const float* r_k, bf16_t* SC, float* BON) {
    const int tid = TIDX, wave = tid >> 6, lane = tid & 63, c0 = lane * 8;
    const size_t S1 = (size_t)T_ * 512;
    for (int t = blockIdx.x * NWAVES + wave; t < T_; t += gridDim.x * NWAVES) {
        float r[8], k[8], v[8], low[8], loa[8], pw0[8], pa0[8], pkk[8], pka[8], prk[8];
        shift8(P, mu, t, c0, r); shift8(P, mu, t, 576 + c0, k); shift8(P, mu, t, 1088 + c0, v);
        ld8bf(LO + (size_t)t * 512 + c0, low); ld8bf(LO + S1 + (size_t)t * 512 + c0, loa);
        ld8f(w0 + c0, pw0); ld8f(a0 + c0, pa0); ld8f(k_k + c0, pkk); ld8f(k_a + c0, pka); ld8f(r_k + c0, prk);
        float ld[8], a[8], kkr[8], kp[8], ss = 0.f, bon = 0.f;
#pragma unroll
        for (int j = 0; j < 8; ++j) {
            const float xw = pw0[j] + low[j];
            const float wraw = -softplusf(-xw) - 0.5f;
            ld[j] = -__expf(wraw);
            a[j] = sigm(pa0[j] + loa[j]);
            kkr[j] = k[j] * pkk[j]; ss += kkr[j] * kkr[j];
            kp[j] = k[j] * (1.f + (a[j] - 1.f) * pka[j]);
            bon += r[j] * kp[j] * prk[j];
        }
        ss = sum8lanes(ss); bon = sum8lanes(bon);
        const float inv = 1.f / fmaxf(sqrtf(ss), 1e-12f);
#pragma unroll
        for (int j = 0; j < 8; ++j) kkr[j] *= inv;
        const size_t o = (size_t)t * 512 + c0;
        *(u32x4*)(SC + o) = pack8f(r); *(u32x4*)(SC + S1 + o) = pack8f(ld); *(u32x4*)(SC + 2 * S1 + o) = pack8f(kp);
        *(u32x4*)(SC + 3 * S1 + o) = pack8f(v); *(u32x4*)(SC + 4 * S1 + o) = pack8f(kkr); *(u32x4*)(SC + 5 * S1 + o) = pack8f(a);
        if ((lane & 7) == 0) BON[(size_t)t * 8 + (lane >> 3)] = bon;
    }
}
__device__ __forceinline__ void ph_fin0v(const float* YRW, const bf16_t* LO, const bf16_t* SC, const float* BON, const float* gn_g, const float* gn_b, bf16_t* Ymix) {
    const int tid = TIDX, wave = tid >> 6, lane = tid & 63, c0 = lane * 8;
    const size_t S1 = (size_t)T_ * 512;
    for (int t = blockIdx.x * NWAVES + wave; t < T_; t += gridDim.x * NWAVES) {
        float y[8], v[8], g[8], gg[8], gb[8];
        ld8f(YRW + (size_t)t * 512 + c0, y); ld8bf(SC + 3 * S1 + (size_t)t * 512 + c0, v); ld8bf(LO + 2 * S1 + (size_t)t * 512 + c0, g);
        ld8f(gn_g + c0, gg); ld8f(gn_b + c0, gb);
        const float bon = BON[(size_t)t * 8 + (lane >> 3)];
        float sm = 0.f;
#pragma unroll
        for (int j = 0; j < 8; ++j) sm += y[j];
        const float mean = sum8lanes(sm) * (1.f / 64.f);
        float sq = 0.f;
#pragma unroll
        for (int j = 0; j < 8; ++j) { y[j] -= mean; sq += y[j] * y[j]; }
        const float rs = rsqrtf(sum8lanes(sq) * (1.f / 64.f) + 64e-5f);
        float o[8];
#pragma unroll
        for (int j = 0; j < 8; ++j) o[j] = (y[j] * rs * gg[j] + gb[j] + bon * v[j]) * g[j];
        *(u32x4*)(Ymix + (size_t)t * D_ + c0) = pack8f(o);
    }
}

__device__ __forceinline__ void ph_ln_router2(LAS unsigned char* lds, const float* src, float* hf, bf16_t* hb, const float* lg, const float* lb, const bf16_t* WrT, const float* bg, const float* be,
                                              int* tok_e, int* tok_slot, float* tok_g, unsigned* cnt) {
    LAS bf16_t* LW = (LAS bf16_t*)lds;
    LAS float* LGall = (LAS float*)(lds + 48 * 1032 * 2);
    const int tid = TIDX, wave = tid >> 6, lane = tid & 63, r = lane & 15, q = lane >> 4;
    for (int i = tid; i < 48 * 128; i += NTHREADS) { const int row = i >> 7, c8 = (i & 127) * 8; *(LAS u32x4*)(LW + row * 1032 + c8) = *(const u32x4*)(WrT + (size_t)row * 1024 + c8); }
    for (int rb = blockIdx.x; rb < T_ / 64; rb += gridDim.x) {
        for (int i = 0; i < 8; ++i) {
            const int t = rb * 64 + wave * 8 + i;
            const f32x4* xr = (const f32x4*)(src + (size_t)t * D_) + lane;
            f32x4 v[4]; float sm = 0.f;
#pragma unroll
            for (int j = 0; j < 4; ++j) { v[j] = xr[64 * j]; sm += (v[j].x + v[j].y) + (v[j].z + v[j].w); }
            const float mean = wave_sum(sm) * (1.f / D_);
            float s2 = 0.f;
#pragma unroll
            for (int j = 0; j < 4; ++j) { v[j] = v[j] - mean; s2 += (v[j].x * v[j].x + v[j].y * v[j].y) + (v[j].z * v[j].z + v[j].w * v[j].w); }
            const float rstd = rsqrtf(wave_sum(s2) * (1.f / D_) + LN_EPS);
#pragma unroll
            for (int j = 0; j < 4; ++j) {
                const f32x4 g = ((const f32x4*)lg)[lane + 64 * j], bb = ((const f32x4*)lb)[lane + 64 * j];
                v[j] = v[j] * rstd * g + bb;
                ((f32x4*)(hf + (size_t)t * D_))[lane + 64 * j] = v[j];
                u32x2 o; o.x = pk2(v[j].x, v[j].y); o.y = pk2(v[j].z, v[j].w);
                ((u32x2*)(hb + (size_t)t * D_))[lane + 64 * j] = o;
            }
        }
        asm volatile("s_waitcnt vmcnt(0)" ::: "memory");
        __syncthreads();
        if (wave < 4) {
            const bf16_t* arow = hb + (size_t)(rb * 64 + wave * 16 + r) * D_ + 8 * q;
            f32x4 acc[3] = {{0.f, 0.f, 0.f, 0.f}, {0.f, 0.f, 0.f, 0.f}, {0.f, 0.f, 0.f, 0.f}};
#pragma unroll 8
            for (int ks = 0; ks < 32; ++ks) {
                const bf16x8 af = *(const bf16x8*)(arow + 32 * ks);
#pragma unroll
                for (int ct = 0; ct < 3; ++ct) {
                    const bf16x8 bfr = *(const LAS bf16x8*)(LW + (ct * 16 + r) * 1032 + 32 * ks + 8 * q);
                    acc[ct] = __builtin_amdgcn_mfma_f32_16x16x32_bf16(af, bfr, acc[ct], 0, 0, 0);
                }
            }
            LAS float* LG = LGall + wave * (16 * 49);
#pragma unroll
            for (int ct = 0; ct < 3; ++ct)
#pragma unroll
                for (int j = 0; j < 4; ++j) LG[(4 * q + j) * 49 + ct * 16 + r] = acc[ct][j];
            asm volatile("s_waitcnt lgkmcnt(0)" ::: "memory");
            if (lane < 16) {
                const int t = rb * 64 + wave * 16 + lane;
                const LAS float* L = LG + lane * 49;
                float cl[4];
#pragma unroll
                for (int g = 0; g < 4; ++g) cl[g] = L[g] + bg[g];
                int grp = 0; float mx = cl[0];
#pragma unroll
                for (int g = 1; g < 4; ++g) if (cl[g] > mx) { mx = cl[g]; grp = g; }
                float den = 0.f;
#pragma unroll
                for (int g = 0; g < 4; ++g) den += __expf(cl[g] - mx);
                const float p_grp = 1.f / den;
                float fl[8];
#pragma unroll
                for (int e = 0; e < 8; ++e) fl[e] = L[4 + grp * 8 + e] + be[grp * 8 + e];
                int j0 = 0; float m0 = fl[0];
#pragma unroll
                for (int e = 1; e < 8; ++e) if (fl[e] > m0) { m0 = fl[e]; j0 = e; }
                int j1 = -1; float m1 = -3.0e38f;
#pragma unroll
                for (int e = 0; e < 8; ++e) if (e != j0 && fl[e] > m1) { m1 = fl[e]; j1 = e; }
                const float e1 = __expf(m1 - m0);
                const float g0 = p_grp / (1.f + e1), g1 = p_grp * e1 / (1.f + e1);
                const int ex0 = grp * 8 + j0, ex1 = grp * 8 + j1;
                const unsigned s0 = atomicAdd(&cnt[ex0], 1u), s1 = atomicAdd(&cnt[ex1], 1u);
                tok_e[2 * t] = ex0; tok_e[2 * t + 1] = ex1;
                tok_slot[2 * t] = (int)s0; tok_slot[2 * t + 1] = (int)s1;
                tok_g[2 * t] = g0; tok_g[2 * t + 1] = g1;
            }
        }
        __syncthreads();
    }
}
__device__ __forceinline__ void convert_router(const float* wg, const float* we, bf16_t* WrT, int gthread, int gthreads) {
    for (int i = gthread; i < 2 * 48 * 1024; i += gthreads) {
        const int layer = i / (48 * 1024), rem = i % (48 * 1024), col = rem >> 10, d = rem & 1023;
        float v = 0.f;
        if (col < 4) v = wg[((size_t)layer * D_ + d) * 4 + col];
        else if (col < 36) { const int g = (col - 4) >> 3, e = (col - 4) & 7; v = we[(((size_t)layer * 4 + g) * D_ + d) * 8 + e]; }
        WrT[i] = f2bf(v);
    }
}

__device__ __forceinline__ void moe_offsets(LAS int* pst, const unsigned* cnt) {
    if (TIDX == 0) {
        int acc = 0;
        for (int e = 0; e < 32; ++e) { pst[e] = acc; const int c = (int)cnt[e]; acc += (c + MOE_PAD - 1) / MOE_PAD * MOE_PAD; }
        pst[32] = acc;
    }
    __syncthreads();
}
__device__ __forceinline__ int moe_expert_of_row(const LAS int* pst, int r) {
    int e = 0;
#pragma unroll 1
    for (int i = 1; i < 32; ++i) if (r >= pst[i]) e = i;
    return e;
}

__device__ __forceinline__ void ph_dispatch(LAS int* pst, const unsigned* cnt, const bf16_t* hb, const int* tok_e, const int* tok_slot, int* tok_dest, bf16_t* XR) {
    moe_offsets(pst, cnt);
    const int wave = TIDX >> 6, lane = TIDX & 63;
    for (int item = blockIdx.x * NWAVES + wave; item < T_ * 2; item += gridDim.x * NWAVES) {
        const int t = item >> 1;
        const int e = tok_e[item], dest = pst[e] + tok_slot[item];
        if (lane == 0) tok_dest[item] = dest;
        const u32x4* src = (const u32x4*)(hb + (size_t)t * D_);
        u32x4* dst = (u32x4*)(XR + (size_t)dest * D_);
        dst[lane] = src[lane]; dst[lane + 64] = src[lane + 64];
    }
    const int R = pst[32];
    for (int r = blockIdx.x * NWAVES + wave; r < R; r += gridDim.x * NWAVES) {
        const int e = moe_expert_of_row(pst, r);
        if (r - pst[e] >= (int)cnt[e]) {
            u32x4* dst = (u32x4*)(XR + (size_t)r * D_);
            const u32x4 z = {0u, 0u, 0u, 0u};
            dst[lane] = z; dst[lane + 64] = z;
        }
    }
}

__device__ __forceinline__ void ph_combine_ln(const float* hf, const bf16_t* Y, const int* tok_dest, const float* tok_g, const float* lg, const float* lb, float* outf, bf16_t* hb) {
    const int wave = TIDX >> 6, lane = TIDX & 63;
    for (int t = blockIdx.x * NWAVES + wave; t < T_; t += gridDim.x * NWAVES) {
        const int d0 = tok_dest[2 * t], d1 = tok_dest[2 * t + 1];
        const float g0 = tok_g[2 * t], g1 = tok_g[2 * t + 1];
        f32x4 v[4]; float s = 0.f;
#pragma unroll
        for (int j = 0; j < 4; ++j) {
            const f32x4 h = ((const f32x4*)(hf + (size_t)t * D_))[lane + 64 * j];
            const u32x2 y0 = ((const u32x2*)(Y + (size_t)d0 * D_))[lane + 64 * j], y1 = ((const u32x2*)(Y + (size_t)d1 * D_))[lane + 64 * j];
            f32x4 a, b;
            a.x = __uint_as_float(y0.x << 16); a.y = __uint_as_float(y0.x & 0xffff0000u); a.z = __uint_as_float(y0.y << 16); a.w = __uint_as_float(y0.y & 0xffff0000u);
            b.x = __uint_as_float(y1.x << 16); b.y = __uint_as_float(y1.x & 0xffff0000u); b.z = __uint_as_float(y1.y << 16); b.w = __uint_as_float(y1.y & 0xffff0000u);
            v[j] = h * DN_ALPHA + (a * g0 + b * g1);
            s += (v[j].x + v[j].y) + (v[j].z + v[j].w);
        }
        const float mean = wave_sum(s) * (1.f / D_);
        float s2 = 0.f;
#pragma unroll
        for (int j = 0; j < 4; ++j) { v[j] = v[j] - mean; s2 += (v[j].x * v[j].x + v[j].y * v[j].y) + (v[j].z * v[j].z + v[j].w * v[j].w); }
        const float rstd = rsqrtf(wave_sum(s2) * (1.f / D_) + LN_EPS);
#pragma unroll
        for (int j = 0; j < 4; ++j) {
            const f32x4 g = ((const f32x4*)lg)[lane + 64 * j], bb = ((const f32x4*)lb)[lane + 64 * j];
            v[j] = v[j] * rstd * g + bb;
            ((f32x4*)(outf + (size_t)t * D_))[lane + 64 * j] = v[j];
            u32x2 o; o.x = pk2(v[j].x, v[j].y); o.y = pk2(v[j].z, v[j].w);
            ((u32x2*)(hb + (size_t)t * D_))[lane + 64 * j] = o;
        }
    }
}

__device__ __forceinline__ void naive_s5_scan(const bf16_t* P1, const float* a_re, const float* a_im, const float* log_dt, const float* b_re, const float* b_im,
                                              const float* c_re, const float* c_im, const float* dvec, float* YS5, bf16_t* YS5B, int pair) {
    const int lane = TIDX & 63;
    const int b = pair >> 5, g = pair & 31, n = lane;
    const float lam_re = fminf(a_re[g * 64 + n], -1e-4f), lam_im = a_im[g * 64 + n];
    const float dt = __expf(log_dt[g]);
    const float mag = __expf(lam_re * dt);
    const float ab_re = mag * cosf(lam_im * dt), ab_im = mag * sinf(lam_im * dt);
    const float den = lam_re * lam_re + lam_im * lam_im;
    const float num_re = ab_re - 1.f;
    const float z_re = (num_re * lam_re + ab_im * lam_im) / den;
    const float z_im = (ab_im * lam_re - num_re * lam_im) / den;
    float bre[16], bim[16], cre[16], cim[16];
#pragma unroll
    for (int c = 0; c < 16; ++c) {
        bre[c] = b_re[(size_t)(g * 64 + n) * 16 + c]; bim[c] = b_im[(size_t)(g * 64 + n) * 16 + c];
        cre[c] = c_re[(size_t)(g * 16 + c) * 64 + n]; cim[c] = c_im[(size_t)(g * 16 + c) * 64 + n];
    }
    const float dd = (lane < 16) ? dvec[g * 16 + lane] : 0.f;
    float h_re = 0.f, h_im = 0.f;
    for (int tt = 0; tt < L_; ++tt) {
        const size_t t = (size_t)b * L_ + tt;
        const float ul = (lane < 16) ? bf2f(P1[t * NIN1 + g * 16 + lane]) : 0.f;
        float bur = 0.f, bui = 0.f;
#pragma unroll
        for (int c = 0; c < 16; ++c) { const float u = __shfl(ul, c); bur += u * bre[c]; bui += u * bim[c]; }
        const float x_re = z_re * bur - z_im * bui, x_im = z_re * bui + z_im * bur;
        const float nh_re = ab_re * h_re - ab_im * h_im + x_re;
        const float nh_im = ab_re * h_im + ab_im * h_re + x_im;
        h_re = nh_re; h_im = nh_im;
        float yv = 0.f;
#pragma unroll
        for (int c = 0; c < 16; ++c) { const float y = wave_sum(h_re * cre[c] - h_im * cim[c]); if (lane == c) yv = y; }
        if (lane < 16) {
            const float y = gelu_tanh(yv + dd * ul);
            YS5[t * 512 + g * 16 + lane] = y;
            YS5B[t * 512 + g * 16 + lane] = f2bf(y);
        }
    }
}

__device__ __forceinline__ void ph_fin1(const float* OG, const bf16_t* P1, const float* norm_g, bf16_t* Ymix) {
    const int wave = TIDX >> 6, lane = TIDX & 63;
    for (int item = blockIdx.x * NWAVES + wave; item < T_ * 4; item += gridDim.x * NWAVES) {
        const int t = item >> 2, h = item & 3;
        const float o0 = OG[(size_t)t * 512 + h * 128 + lane], o1 = OG[(size_t)t * 512 + h * 128 + 64 + lane];
        const float ms = wave_sum(o0 * o0 + o1 * o1) * (1.f / 128.f);
        const float rs = rsqrtf(ms + LN_EPS);
        const float g0 = bf2f(P1[(size_t)t * NIN1 + 2048 + h * 128 + lane]), g1 = bf2f(P1[(size_t)t * NIN1 + 2048 + h * 128 + 64 + lane]);
        Ymix[(size_t)t * D_ + 512 + h * 128 + lane] = f2bf(o0 * rs * norm_g[lane] * siluf(g0));
        Ymix[(size_t)t * D_ + 512 + h * 128 + 64 + lane] = f2bf(o1 * rs * norm_g[64 + lane] * siluf(g1));
    }
}

constexpr int LDS_BYTES = 147456;
constexpr int MISC_OFF = 131072 + 8192;
enum Phase {
    PH_PROLOGUE = 0,
    PH_INPROJ0, PH_PREPA0, PH_LORA0, PH_PREPB0, PH_SCAN0, PH_SCAN0B, PH_FIN0, PH_OUTPROJ0, PH_LN1_0, PH_DISP0, PH_UP0, PH_DOWN0, PH_COMB0,
    PH_INPROJ1, PH_L1A, PH_L1B, PH_L1C, PH_L1D, PH_SCAN1, PH_FIN1, PH_GLU1, PH_OUTPROJ1, PH_LN1_1, PH_DISP1, PH_UP1, PH_DOWN1, PH_COMB1,
    PH_COUNT
};

typedef const Args __attribute__((address_space(4)))* KArgsP;
__device__ __forceinline__ KArgsP fresh_args() { KArgsP p = (KArgsP)__builtin_amdgcn_kernarg_segment_ptr(); asm volatile("" : "+s"(p)); return p; }
#define PHASE_BEGIN KArgsP ap = fresh_args(); unsigned char* const ws = ap->ws; (void)ws;
#define INP(i) (ap->in[i])
#define W_CTL ((unsigned*)(ws + WS_CTL))
#define W_HB ((bf16_t*)(ws + WS_HB))
#define W_WIN0 ((bf16_t*)(ws + WS_WIN0))
#define W_WOUT0 ((bf16_t*)(ws + WS_WOUT0))
#define W_WIN1 ((bf16_t*)(ws + WS_WIN1))
#define W_WOUT1 ((bf16_t*)(ws + WS_WOUT1))
#define W_WGLU ((bf16_t*)(ws + WS_WGLU))
#define W_WLORA ((bf16_t*)(ws + WS_WLORA))
#define W_WROUTER ((bf16_t*)(ws + WS_WROUTER))
#define W_W13 ((bf16_t*)(ws + WS_W13))
#define W_W2 ((bf16_t*)(ws + WS_W2))
#define W_HA ((float*)(ws + WS_HA))
#define W_YRW W_HA
#define W_OG (W_HA + (size_t)T_ * 512)
#define W_P ((bf16_t*)(ws + WS_P))
#define W_LO ((bf16_t*)(ws + WS_LO))
#define W_SC ((bf16_t*)(ws + WS_SCAN))
#define W_GLALA ((float*)(ws + WS_GLALA))
#define W_BON ((float*)(ws + WS_BON))
#define W_AP ((bf16_t*)(ws + WS_APRIME))
#define W_YS5B ((bf16_t*)(ws + WS_YS5B))
#define W_XR ((bf16_t*)(ws + WS_XR))
#define W_HID ((bf16_t*)(ws + WS_HID))
#define W_Y ((bf16_t*)(ws + WS_Y))
#define W_TOKE ((int*)(ws + WS_ROUTE))
#define W_TOKSLOT (W_TOKE + 2 * T_)
#define W_TOKDEST (W_TOKE + 4 * T_)
#define W_TOKG ((float*)(W_TOKE + 6 * T_))
#define W_YMIX W_HB
#define BIGP(mib) (ws + WS_BIG + (size_t)(mib) * MiB)
#define GLA0_BUFS GlaBufs{(bf16_t*)BIGP(256), (bf16_t*)BIGP(264), (bf16_t*)(ws + WS_HB), (bf16_t*)BIGP(273), (float*)BIGP(289), W_HA + (size_t)T_ * 512, (bf16_t*)BIGP(112)}
#define HG_BUFS GlaBufs{(bf16_t*)BIGP(96), (bf16_t*)BIGP(112), (bf16_t*)BIGP(144), (bf16_t*)BIGP(128), (float*)BIGP(176), (float*)BIGP(177), (bf16_t*)BIGP(144)}
#define W_S5WE ((bf16_t*)BIGP(160))
#define W_S5UA ((bf16_t*)BIGP(241))
#define W_S5MB ((bf16_t*)BIGP(261))
#define W_S5E ((float*)BIGP(281))
#define CW_SUB 12288

#define IN(k) (PLO <= (k) && (k) < PHI)
#define SEAM(k) do { if (IN(k) && IN((k) + 1)) { PHASE_BEGIN XcdBarrier bar_; bar_.bar = W_CTL + CW_BAR; bar_.x = xb_xcc_id(); bar_.st = (volatile LAS unsigned*)(lds + MISC_OFF) + 8; xcd_barrier(bar_); } } while (0)
template <int PLO, int PHI, int layer>
__device__ __forceinline__ void moe_layer(LAS unsigned char* lds) {
    LAS float* ldsf = (LAS float*)lds; (void)ldsf;
        const int base = layer == 0 ? PH_OUTPROJ0 : PH_OUTPROJ1;
        if (IN(base + 0)) {
            PHASE_BEGIN
            const float* W = layer == 0 ? INP(16) : INP(30);
            float* V1 = layer == 0 ? ap->out : W_HA;
            const float* resid = layer == 0 ? INP(0) : ap->out;
#if FAST_GEMM
            (void)W;
            { pg8::Gemm g{W_YMIX, layer == 0 ? W_WOUT0 : W_WOUT1, T_, D_, D_}; pg8::StaticOrder S; S.init(T_, D_, (int)gridDim.x, (int)blockIdx.x); pg8::EpiResidF32 E{resid, V1, D_, DN_ALPHA};
              pg8::gemm_phase<pg8::EpiResidF32, pg8::StaticOrder, true, true>(lds, g, S, E); }
#else
            const bf16_t* Ymix = W_YMIX;
            naive_gemm<false>(ldsf, T_, D_, D_, [&](int m) { return Ymix + (size_t)m * D_; }, [&](int, int) { return W; }, D_,
                              [&](int m, int n, float a, float) { V1[(size_t)m * D_ + n] = DN_ALPHA * resid[(size_t)m * D_ + n] + a; });
#endif
        }
        SEAM(base + 0);
        if (IN(base + 1)) {
            PHASE_BEGIN
            const float* V1 = layer == 0 ? ap->out : W_HA;
#if FAST_LN
            ph_ln_router2(lds, V1, W_HA, W_HB, INP(31) + layer * D_, INP(32) + layer * D_, W_WROUTER + (size_t)layer * 48 * 1024, INP(34) + layer * 4, INP(36) + layer * 32,
                          W_TOKE, W_TOKSLOT, W_TOKG, W_CTL + CW_CNT + 64 * layer);
#else
            ph_ln_router(V1, W_HA, W_HB, INP(31) + layer * D_, INP(32) + layer * D_, INP(33) + (size_t)layer * D_ * 4, INP(34) + layer * 4,
                         INP(35) + (size_t)layer * 4 * D_ * 8, INP(36) + layer * 32, W_TOKE, W_TOKSLOT, W_TOKG, W_CTL + CW_CNT + 64 * layer);
#endif
#ifdef PROBE_LN
            if (layer == 0) ph_ln_router(V1, W_HA, W_HB, INP(31) + layer * D_, INP(32) + layer * D_, INP(33) + (size_t)layer * D_ * 4, INP(34) + layer * 4,
                         INP(35) + (size_t)layer * 4 * D_ * 8, INP(36) + layer * 32, (int*)BIGP(290), (int*)BIGP(291), (float*)BIGP(292), W_CTL + CW_CNT + 1024);
#endif
        }
        SEAM(base + 1);
        if (IN(base + 2)) { PHASE_BEGIN ph_dispatch((LAS int*)lds, W_CTL + CW_CNT + 64 * layer, W_HB, W_TOKE, W_TOKSLOT, W_TOKDEST, W_XR); }
        SEAM(base + 2);
        if (IN(base + 3)) {
            PHASE_BEGIN
#if FAST_GEMM
            { LAS int* pst = (LAS int*)(lds + 131072 + 2048); LAS int* tile_e = (LAS int*)(lds + 131072 + 1024);
              moe_offsets(pst, W_CTL + CW_CNT + 64 * layer);
              const int ntiles = pst[32] / 256;
              if ((int)TIDX < ntiles) tile_e[TIDX] = moe_expert_of_row(pst, TIDX * 256);
              __syncthreads();
              pg8::Gemm g{W_XR, W_W13, ntiles * 256, 1024, D_}; pg8::MoeOrder S{ntiles, 4, (int)gridDim.x, (int)blockIdx.x, tile_e}; pg8::EpiSwiglu E{W_HID};
              pg8::gemm_phase<pg8::EpiSwiglu, pg8::MoeOrder, true, true>(lds, g, S, E); }
#else
            LAS int* pst = (LAS int*)(lds + 65536);
            moe_offsets(pst, W_CTL + CW_CNT + 64 * layer);
            const float* w1 = INP(37) + (size_t)layer * 32 * D_ * 512; const float* w3 = INP(38) + (size_t)layer * 32 * D_ * 512;
            const bf16_t* XR = W_XR; bf16_t* HID = W_HID;
            naive_gemm<true>(ldsf, pst[32], 512, D_, [&](int m) { return XR + (size_t)m * D_; },
                             [&](int m0, int which) { const int e = moe_expert_of_row(pst, m0); return (which ? w3 : w1) + (size_t)e * D_ * 512; }, 512,
                             [&](int m, int n, float a, float b) { HID[(size_t)m * 512 + n] = f2bf(siluf(a) * b); });
#endif
        }
        SEAM(base + 3);
        if (IN(base + 4)) {
            PHASE_BEGIN
#if FAST_GEMM
            { LAS int* pst = (LAS int*)(lds + 131072 + 2048); LAS int* tile_e = (LAS int*)(lds + 131072 + 1024);
              moe_offsets(pst, W_CTL + CW_CNT + 64 * layer);
              const int ntiles = pst[32] / 256;
              if ((int)TIDX < ntiles) tile_e[TIDX] = moe_expert_of_row(pst, TIDX * 256);
              __syncthreads();
              pg8::Gemm g{W_HID, W_W2, ntiles * 256, 1024, 512}; pg8::MoeOrder S{ntiles, 4, (int)gridDim.x, (int)blockIdx.x, tile_e}; pg8::EpiStoreBf16 E{W_Y, D_, 0, 0};
              pg8::gemm_phase<pg8::EpiStoreBf16, pg8::MoeOrder, true, true>(lds, g, S, E); }
#else
            LAS int* pst = (LAS int*)(lds + 65536);
            moe_offsets(pst, W_CTL + CW_CNT + 64 * layer);
            const float* w2 = INP(39) + (size_t)layer * 32 * 512 * D_;
            const bf16_t* HID = W_HID; bf16_t* Y = W_Y;
            naive_gemm<false>(ldsf, pst[32], D_, 512, [&](int m) { return HID + (size_t)m * 512; },
                              [&](int m0, int) { const int e = moe_expert_of_row(pst, m0); return w2 + (size_t)e * 512 * D_; }, D_,
                              [&](int m, int n, float a, float) { Y[(size_t)m * D_ + n] = f2bf(a); });
#endif
        }
        SEAM(base + 4);
        if (IN(base + 5)) { PHASE_BEGIN ph_combine_ln(W_HA, W_Y, W_TOKDEST, W_TOKG, INP(40) + layer * D_, INP(41) + layer * D_, ap->out, W_HB); }
        SEAM(base + 5);

}

template <int PLO, int PHI>
__device__ __forceinline__ void mega_body(unsigned char* lds_raw) {
    LAS unsigned char* lds = (LAS unsigned char*)lds_raw;
    LAS float* ldsf = (LAS float*)lds;
    constexpr bool MULTI = (PHI - PLO) > 1;
    if (MULTI) {
        PHASE_BEGIN
        volatile LAS unsigned* MISC = (volatile LAS unsigned*)(lds + MISC_OFF);
        if (TIDX < 32) MISC[TIDX] = 0u;
        __syncthreads();
        (void)xcd_barrier_post(W_CTL + CW_BAR, MISC + 8);
    }

    if (IN(PH_PROLOGUE)) {
        PHASE_BEGIN ph_prologue(INP(0), W_HB);
#if FAST_GEMM
        LAS float* scr = ldsf + (TIDX >> 6) * (64 * 33);
        const int gw = blockIdx.x * NWAVES + (TIDX >> 6), ngw = gridDim.x * NWAVES, lane = TIDX & 63;
        convert_plain(INP(1), D_, NIN0, NIN0P, W_WIN0, scr, gw, ngw, lane);
        convert_plain(INP(16), D_, D_, D_, W_WOUT0, scr, gw, ngw, lane);
        convert_plain(INP(17), D_, NIN1, NIN1, W_WIN1, scr, gw, ngw, lane);
        convert_plain(INP(30), D_, D_, D_, W_WOUT1, scr, gw, ngw, lane);
        convert_plain(INP(26), 512, 512, 512, W_WGLU, scr, gw, ngw, lane);
        convert_lora(INP(4), INP(6), INP(7), W_WLORA, scr, gw, ngw, lane);
        convert_router(INP(33), INP(35), W_WROUTER, blockIdx.x * NTHREADS + TIDX, gridDim.x * NTHREADS);
        convert_moe(INP(37), INP(38), INP(39), W_W13, W_W2, scr, gw, ngw, lane);
#endif
    }
    SEAM(PH_PROLOGUE);
    if (IN(PH_INPROJ0)) {
        PHASE_BEGIN
#if FAST_GEMM
        { pg8::Gemm g{W_HB, W_WIN0, T_, NIN0P, D_}; pg8::StaticOrder S; S.init(T_, NIN0P, (int)gridDim.x, (int)blockIdx.x); pg8::EpiStoreBf16 E{W_P, NIN0P, 0, 0};
          pg8::gemm_phase<pg8::EpiStoreBf16, pg8::StaticOrder, true, true>(lds, g, S, E); }
#else
        const float* W = INP(1); const bf16_t* A = W_HB; bf16_t* P = W_P;
        naive_gemm<false>(ldsf, T_, NIN0, D_, [&](int m) { return A + (size_t)m * D_; }, [&](int, int) { return W; }, NIN0,
                          [&](int m, int n, float a, float) { P[(size_t)m * NIN0P + n] = f2bf(a); });
#endif
    }
    SEAM(PH_INPROJ0);
#if FAST_GLA0
    if (IN(PH_PREPA0)) { PHASE_BEGIN ph_prepA0v(W_P, INP(2), W_AP); }
#else
    if (IN(PH_PREPA0)) { PHASE_BEGIN ph_prepA0<!FAST_GLA0>(W_P, INP(2), INP(13), INP(14), W_AP, W_GLALA); }
#endif
    SEAM(PH_PREPA0);
    if (IN(PH_LORA0)) {
        PHASE_BEGIN
#if FAST_GEMM
        { pg8::Gemm g{W_AP, W_WLORA, T_, NLORA, 256}; pg8::StaticOrder S; S.init(T_, NLORA, (int)gridDim.x, (int)blockIdx.x); pg8::EpiStoreBf16 E{W_LO, 512, 512, (size_t)T_ * 512};
          pg8::gemm_phase<pg8::EpiStoreBf16, pg8::StaticOrder, true, true>(lds, g, S, E); }
#else
        const float* w2 = INP(4); const float* a2 = INP(6); const float* g2 = INP(7); const bf16_t* AP = W_AP; bf16_t* LO = W_LO;
        naive_gemm<false>(ldsf, T_, 512, 64, [&](int m) { return AP + (size_t)m * 256; }, [&](int, int) { return w2; }, 512,
                          [&](int m, int n, float a, float) { LO[(size_t)m * 512 + n] = f2bf(a); });
        naive_gemm<false>(ldsf, T_, 512, 64, [&](int m) { return AP + (size_t)m * 256 + 64; }, [&](int, int) { return a2; }, 512,
                          [&](int m, int n, float a, float) { LO[(size_t)T_ * 512 + (size_t)m * 512 + n] = f2bf(a); });
        naive_gemm<false>(ldsf, T_, 512, 128, [&](int m) { return AP + (size_t)m * 256 + 128; }, [&](int, int) { return g2; }, 512,
                          [&](int m, int n, float a, float) { LO[(size_t)2 * T_ * 512 + (size_t)m * 512 + n] = f2bf(a); });
#endif
    }
    SEAM(PH_LORA0);
    if (IN(PH_PREPB0)) {
        PHASE_BEGIN ph_prepB0v(W_P, W_LO, INP(2), INP(3), INP(5), INP(8), INP(9), INP(10), W_SC, W_BON);
#if FAST_GLA0
        { const GlaBufs GB = GLA0_BUFS; __syncthreads();
          for (int cg = blockIdx.x; cg < 256; cg += gridDim.x) gla_prep_tile<64, 0>(ldsf, W_P, INP(13), INP(14), GB, cg); }
#endif
    }
    SEAM(PH_PREPB0);
#if FAST_RWKV == 2
#define RW_G ((bf16_t*)BIGP(128))
#define RW_RM ((bf16_t*)ap->out)
#define RW_HT (ap->out + (size_t)4 * 1024 * 1024)
#define RW_YM ((bf16_t*)(ap->out + (size_t)12 * 1024 * 1024))
    if (IN(PH_SCAN0)) {
        PHASE_BEGIN
        for (int it = blockIdx.x; it < 2048; it += gridDim.x) rwkv_chunk_pre(lds, W_SC, RW_G, RW_RM, RW_HT, RW_YM, it);
        { const GlaBufs GB = GLA0_BUFS; const int wave = TIDX >> 6, lane = TIDX & 63;
          for (int u = blockIdx.x * NWAVES + wave; u < 1024 * 4; u += gridDim.x * NWAVES) gla_pass1_unit<64>(GB, u, lane); }
    }
    SEAM(PH_SCAN0);
    if (IN(PH_SCAN0B)) {
        PHASE_BEGIN
        const int bid = blockIdx.x;
        if (bid < 16) rwkv_chunk_seq(lds, RW_G, RW_RM, RW_HT, RW_YM, W_YRW, bid);
        else {
            const GlaBufs GB = GLA0_BUFS;
            const int nb = (int)gridDim.x - 16, b0 = bid - 16;
            gla_pass2<64>(GB, b0 * NTHREADS + TIDX, nb * NTHREADS);
            sub_barrier(W_CTL + CW_SUB + 64, (unsigned)nb);
            for (int it = b0; it < 1024; it += nb) gla_pass3_item<64, 0>(lds, W_P, INP(15), GB, W_YMIX, it);
        }
    }
    SEAM(PH_SCAN0B);
#else
    if (IN(PH_SCAN0)) {
        PHASE_BEGIN
        const int bid = blockIdx.x;
#if FAST_RWKV
        constexpr int NRW = 128;
        if (bid < NRW) rwkv_scan_v1(ldsf, W_SC, W_YRW, bid);
#else
        constexpr int NRW = 16;
        if (bid < NRW) naive_rwkv_scan(ldsf, W_SC, W_YRW, bid);
#endif
#if FAST_GLA0
        else {
            const GlaBufs GB = GLA0_BUFS;
            const int nb = (int)gridDim.x - NRW, b0 = bid - NRW, wave = TIDX >> 6, lane = TIDX & 63;
            for (int u = b0 * NWAVES + wave; u < 1024 * 4; u += nb * NWAVES) gla_pass1_unit<64>(GB, u, lane);
            sub_barrier(W_CTL + CW_SUB, (unsigned)nb);
            gla_pass2<64>(GB, b0 * NTHREADS + TIDX, nb * NTHREADS);
            sub_barrier(W_CTL + CW_SUB + 64, (unsigned)nb);
            for (int it = b0; it < 1024; it += nb) gla_pass3_item<64, 0>(lds, W_P, INP(15), GB, W_YMIX, it);
        }
#else
        else if (bid < 24) {
            const int bh = bid - 16;
            const bf16_t* P = W_P; const float* GLALA = W_GLALA;
            naive_gla_scan<64>(ldsf,
                [&](int t, int ck, float& q, float& kk, float& e) {
                    q = bf2f(P[(size_t)t * NIN0P + 1792 + ck]) * 0.125f; kk = bf2f(P[(size_t)t * NIN0P + 2048 + ck]); e = __expf(GLALA[(size_t)t * 256 + ck]); },
                [&](int t, int cv) { return bf2f(P[(size_t)t * NIN0P + 2304 + cv]); }, W_OG, bh >> 2, bh & 3);
        }
#endif
    }
    SEAM(PH_SCAN0);
    SEAM(PH_SCAN0B);
#endif
#if FAST_GLA0
    if (IN(PH_FIN0)) { PHASE_BEGIN ph_fin0v(W_YRW, W_LO, W_SC, W_BON, INP(11), INP(12), W_YMIX); }
#else
    if (IN(PH_FIN0)) { PHASE_BEGIN ph_fin0<!FAST_GLA0>(W_YRW, W_OG, W_P, W_LO, W_SC, W_BON, INP(11), INP(12), INP(15), W_YMIX); }
#endif
    SEAM(PH_FIN0);

    moe_layer<PLO, PHI, 0>(lds);
            if (IN(PH_INPROJ1)) {
                PHASE_BEGIN
#if FAST_GEMM
                { pg8::Gemm g{W_HB, W_WIN1, T_, NIN1, D_}; pg8::StaticOrder S; S.init(T_, NIN1, (int)gridDim.x, (int)blockIdx.x); pg8::EpiStoreBf16 E{W_P, NIN1, 0, 0};
                  pg8::gemm_phase<pg8::EpiStoreBf16, pg8::StaticOrder, true, true>(lds, g, S, E); }
#else
                const float* W = INP(17); const bf16_t* A = W_HB; bf16_t* P = W_P;
                naive_gemm<false>(ldsf, T_, NIN1, D_, [&](int m) { return A + (size_t)m * D_; }, [&](int, int) { return W; }, NIN1,
                                  [&](int m, int n, float a, float) { P[(size_t)m * NIN1 + n] = f2bf(a); });
#endif
            }
            SEAM(PH_INPROJ1);
            if (IN(PH_L1A)) {
                PHASE_BEGIN
#if FAST_S5
                if (blockIdx.x >= 224) s5_tables(ldsf, INP(18), INP(19), INP(20), INP(21), INP(22), INP(23), INP(24), W_S5MB, W_S5WE, (int)blockIdx.x - 224);
                s5_fill_ua(W_P, W_S5UA, blockIdx.x * NWAVES + (TIDX >> 6), gridDim.x * NWAVES, TIDX & 63);
                __syncthreads();
#endif
#if FAST_HG
                { const GlaBufs GB = HG_BUFS;
                  for (int cg = blockIdx.x; cg < 256; cg += gridDim.x) gla_prep_tile<128, 1>(ldsf, W_P, INP(28), nullptr, GB, cg); }
#endif
            }
            SEAM(PH_L1A);
            if (IN(PH_L1B)) {
                PHASE_BEGIN
                const int bid = blockIdx.x;
#if FAST_S5
                if (bid < 64) {
                    LAS int* tile_e = (LAS int*)(lds + 131072 + 1024);
                    if (TIDX < 64) tile_e[TIDX] = TIDX >> 1;
                    __syncthreads();
                    pg8::Gemm g{W_S5UA, W_S5WE, 64 * 256, 256, 512, 640}; pg8::MoeOrder S{64, 1, 64, bid, tile_e}; pg8::EpiStoreF32 E{W_S5E, 256};
                    pg8::gemm_phase<pg8::EpiStoreF32, pg8::MoeOrder, true, true>(lds, g, S, E);
                }
#endif
#if FAST_HG
                if (bid >= 64) {
                    const GlaBufs GB = HG_BUFS;
                    const int nb = (int)gridDim.x - 64, b0 = bid - 64, wave = TIDX >> 6, lane = TIDX & 63;
                    for (int u = b0 * NWAVES + wave; u < 1024 * 8; u += nb * NWAVES) gla_pass1_unit<128>(GB, u, lane);
                }
#endif
            }
            SEAM(PH_L1B);
            if (IN(PH_L1C)) {
                PHASE_BEGIN
                const int bid = blockIdx.x;
#if FAST_S5
                if (bid < 8) s5_carry(INP(18), INP(19), INP(20), W_S5E, W_S5UA, bid * NTHREADS + TIDX);
#endif
#if FAST_HG
                if (bid >= 8) { const GlaBufs GB = HG_BUFS; gla_pass2<128>(GB, (bid - 8) * NTHREADS + TIDX, ((int)gridDim.x - 8) * NTHREADS); }
#endif
#if FAST_GEMM
                { LAS float* scr = ldsf + (TIDX >> 6) * (64 * 33);
                  convert_moe(INP(37) + (size_t)32 * D_ * 512, INP(38) + (size_t)32 * D_ * 512, INP(39) + (size_t)32 * 512 * D_, W_W13, W_W2, scr,
                              bid * NWAVES + (TIDX >> 6), (int)gridDim.x * NWAVES, TIDX & 63); }
#endif
            }
            SEAM(PH_L1C);
            if (IN(PH_L1D)) {
                PHASE_BEGIN
                const int bid = blockIdx.x;
#if FAST_S5
                if (bid < 128) {
                    LAS int* tile_e = (LAS int*)(lds + 131072 + 1024);
                    if (TIDX < 64) tile_e[TIDX] = TIDX >> 1;
                    __syncthreads();
                    pg8::Gemm g{W_S5UA, W_S5MB, 64 * 256, 512, 640, 640}; pg8::MoeOrder S{64, 2, 128, bid, tile_e}; pg8::EpiS5Y E{W_P, INP(25), W_YRW, W_YS5B};
                    pg8::gemm_phase<pg8::EpiS5Y, pg8::MoeOrder, true, true>(lds, g, S, E);
                }
#endif
#if FAST_HG
                if (bid >= 128) {
                    const GlaBufs GB = HG_BUFS;
                    for (int it = bid - 128; it < 1024; it += (int)gridDim.x - 128) gla_pass3_item<128, 1>(lds, W_P, INP(29), GB, W_YMIX, it);
                }
#endif
            }
            SEAM(PH_L1D);
            if (IN(PH_SCAN1)) {
                PHASE_BEGIN
                const int bid = blockIdx.x;
                const bf16_t* P = W_P; (void)P; (void)bid;
#if !FAST_HG
                if (bid < 8) {
                    const float* hg_lb = INP(28);
                    naive_gla_scan<128>(ldsf,
                        [&](int t, int ck, float& q, float& kk, float& e) {
                            const float l0 = hg_lb[ck], l1 = hg_lb[512 + ck];
                            const float lbv = 1.f / (1.f + __expf(l0 - l1));
                            const float f = bf2f(P[(size_t)t * NIN1 + 1024 + ck]);
                            const float sg = sigm(f);
                            q = siluf(bf2f(P[(size_t)t * NIN1 + 512 + ck])); kk = (1.f - lbv) * (1.f - sg); e = lbv + (1.f - lbv) * sg; },
                        [&](int t, int cv) { return bf2f(P[(size_t)t * NIN1 + 1536 + cv]); }, W_OG, bid >> 2, bid & 3);
                }
#endif
#if !FAST_S5
                if (bid >= 8 && bid < 16) {
                    const int pair = (bid - 8) * 8 + (TIDX >> 6);
                    naive_s5_scan(P, INP(18), INP(19), INP(20), INP(21), INP(22), INP(23), INP(24), INP(25), W_YRW, W_YS5B, pair);
                }
#endif
            }
            SEAM(PH_SCAN1);
#if !FAST_HG
            if (IN(PH_FIN1)) { PHASE_BEGIN ph_fin1(W_OG, W_P, INP(29), W_YMIX); }
#endif
            SEAM(PH_FIN1);
            if (IN(PH_GLU1)) {
                PHASE_BEGIN
#if FAST_GEMM
                { pg8::Gemm g{W_YS5B, W_WGLU, T_, 512, 512}; pg8::StaticOrder S; S.init(T_, 512, (int)gridDim.x, (int)blockIdx.x); pg8::EpiGlu E{W_YRW, 512, INP(27), W_YMIX, D_};
                  pg8::gemm_phase<pg8::EpiGlu, pg8::StaticOrder, true, true>(lds, g, S, E); }
#else
                const float* W = INP(26); const float* gb = INP(27); const bf16_t* YS5B = W_YS5B; const float* YRW = W_YRW; bf16_t* Ymix = W_YMIX;
                naive_gemm<false>(ldsf, T_, 512, 512, [&](int m) { return YS5B + (size_t)m * 512; }, [&](int, int) { return W; }, 512,
                                  [&](int m, int n, float a, float) { const float y = YRW[(size_t)m * 512 + n]; Ymix[(size_t)m * D_ + n] = f2bf(y * sigm(a + gb[n])); });
#endif
            }
            SEAM(PH_GLU1);
    moe_layer<PLO, PHI, 1>(lds);
#undef IN
}
template <int PLO, int PHI>
__global__ void __launch_bounds__(NTHREADS, 2) mega(Args args) {
    extern __shared__ __attribute__((aligned(16))) unsigned char lds_raw[];
    mega_body<PLO, PHI>(lds_raw);
}

#include <utility>
template <int... I> static void set_attrs(std::integer_sequence<int, I...>) {
    (void)std::initializer_list<int>{ ((void)hipFuncSetAttribute((const void*)mega<I, I + 1>, hipFuncAttributeMaxDynamicSharedMemorySize, LDS_BYTES), 0)... };
}
#ifndef DUP_MASK
#define DUP_MASK 0ull
#endif
template <int I> static int launch_one(int grid, hipStream_t stream, const Args& a) {
    hipLaunchKernelGGL((mega<I, I + 1>), dim3(grid), dim3(NTHREADS), LDS_BYTES, stream, a);
    if ((DUP_MASK >> I) & 1ull) hipLaunchKernelGGL((mega<I, I + 1>), dim3(grid), dim3(NTHREADS), LDS_BYTES, stream, a);
    return 0;
}
template <int... I> static void launch_all(std::integer_sequence<int, I...>, int grid, hipStream_t stream, const Args& a) {
    (void)std::initializer_list<int>{ launch_one<I>(grid, stream, a)... };
}
extern "C" void kernel_launch(void* const* d_in, const int* in_sizes, int n_in, void* d_out, int out_size, void* d_ws, size_t ws_size, hipStream_t stream) {
    static int grid = 0;
    if (grid == 0) {
        if (n_in != 42 || out_size != T_ * D_ || ws_size < WS_END) { fprintf(stderr, "kernel_launch: unexpected shapes n_in %d out %d ws %zu\n", n_in, out_size, ws_size); grid = -1; return; }
        int dev = 0, cus = 0, per_cu = 0;
        hipGetDevice(&dev);
        hipDeviceGetAttribute(&cus, hipDeviceAttributeMultiprocessorCount, dev);
        set_attrs(std::make_integer_sequence<int, PH_COUNT>{});
        hipFuncSetAttribute((const void*)mega<0, PH_COUNT>, hipFuncAttributeMaxDynamicSharedMemorySize, LDS_BYTES);
        hipOccupancyMaxActiveBlocksPerMultiprocessor(&per_cu, (const void*)mega<0, PH_COUNT>, NTHREADS, LDS_BYTES);
        (void)hipGetLastError();
        if (per_cu < 1) per_cu = 1;
        grid = cus * 1;
        fprintf(stderr, "kernel_launch: cus %d per_cu %d grid %d\n", cus, per_cu, grid);
    }
    if (grid < 0) return;
    hipMemsetAsync((char*)d_ws + WS_CTL, 0, CTL_ZERO_BYTES, stream);
    Args a{};
    for (int i = 0; i < 42; ++i) a.in[i] = (const float*)d_in[i];
    a.out = (float*)d_out; a.ws = (unsigned char*)d_ws;
#if MK_SINGLE
    void* kargs[] = {(void*)&a};
    hipError_t e = hipLaunchCooperativeKernel((const void*)mega<0, PH_COUNT>, dim3(grid), dim3(NTHREADS), kargs, LDS_BYTES, stream);
    if (e != hipSuccess) fprintf(stderr, "cooperative launch failed: %s (grid %d)\n", hipGetErrorString(e), grid);
#else
    launch_all(std::make_integer_sequence<int, PH_COUNT>{}, grid, stream, a);
#endif
}
#ifdef TEST_RANGES
template __global__ void mega<0, 2>(Args);
template __global__ void mega<1, 3>(Args);
template __global__ void mega<1, 4>(Args);
template __global__ void mega<3, 8>(Args);
template __global__ void mega<7, 13>(Args);
template __global__ void mega<10, 12>(Args);
template __global__ void mega<13, 17>(Args);
template __global__ void mega<0, 13>(Args);
#endif
```

```cpp
#include <hip/hip_runtime.h>
#include <cstdio>
#include <cstdint>

#define GAS __attribute__((address_space(1)))
#define LAS __attribute__((address_space(3)))
typedef unsigned short bf16_t;
typedef float f32x4 __attribute__((ext_vector_type(4)));
typedef unsigned u32x4 __attribute__((ext_vector_type(4)));
typedef unsigned u32x2 __attribute__((ext_vector_type(2)));
__device__ __forceinline__ int launder_tid() { int t = (int)threadIdx.x; asm volatile("" : "+v"(t)); return t; }
#define TIDX launder_tid()

#ifndef FAST_GEMM
#define FAST_GEMM 1
#endif
#ifndef FAST_LN
#define FAST_LN 1
#endif
#ifndef FAST_RWKV
#define FAST_RWKV 2
#endif
#ifndef FAST_GLA0
#define FAST_GLA0 1
#endif
#ifndef FAST_HG
#define FAST_HG 1
#endif
#ifndef FAST_S5
#define FAST_S5 1
#endif
#ifndef MK_SINGLE
#define MK_SINGLE 1
#endif

constexpr int T_ = 16384, L_ = 8192, D_ = 1024;
constexpr int NIN0 = 3344, NIN0P = 3584, NIN1 = 2560;
constexpr int NLORA = 1536;
constexpr int RMAX = 40960;
constexpr int MOE_PAD = 256;
constexpr float DN_ALPHA = 1.41421356237f;
constexpr float LN_EPS = 1e-5f;
constexpr int NTHREADS = 512, NWAVES = 8;

constexpr size_t MiB = 1u << 20;
constexpr size_t WS_CTL = 0, CTL_ZERO_BYTES = 1 * MiB;
constexpr size_t WS_WIN0 = 2 * MiB;
constexpr size_t WS_WOUT0 = 9 * MiB;
constexpr size_t WS_WIN1 = 11 * MiB;
constexpr size_t WS_WOUT1 = 16 * MiB;
constexpr size_t WS_WGLU = 18 * MiB;
constexpr size_t WS_WLORA = 19 * MiB;
constexpr size_t WS_WROUTER = 19 * MiB + 786432;
constexpr size_t WS_W13 = 20 * MiB;
constexpr size_t WS_W2 = 84 * MiB;
constexpr size_t WS_HB = 116 * MiB;
constexpr size_t WS_HA = 149 * MiB;
constexpr size_t WS_ROUTE = 213 * MiB;
constexpr size_t WS_BIG = 214 * MiB;
constexpr size_t WS_P = WS_BIG;
constexpr size_t WS_LO = WS_BIG + 112 * MiB;
constexpr size_t WS_SCAN = WS_BIG + 160 * MiB;
constexpr size_t WS_GLALA = WS_BIG + 256 * MiB;
constexpr size_t WS_BON = WS_BIG + 272 * MiB;
constexpr size_t WS_APRIME = WS_BIG + 273 * MiB;
constexpr size_t WS_YS5B = WS_BIG + 80 * MiB;
constexpr size_t WS_XR = WS_BIG;
constexpr size_t WS_HID = WS_BIG + 80 * MiB;
constexpr size_t WS_Y = WS_BIG + 120 * MiB;
constexpr size_t WS_END = 512 * MiB;
constexpr int CW_BAR = 4096;
constexpr int CW_CNT = 8192;

__device__ __forceinline__ float bf2f(bf16_t b) { return __uint_as_float(((unsigned)b) << 16); }
__device__ __forceinline__ bf16_t f2bf(float f) { unsigned u = __float_as_uint(f); u += 0x7fffu + ((u >> 16) & 1u); return (bf16_t)(u >> 16); }
__device__ __forceinline__ unsigned pk2(float lo, float hi) { return (unsigned)f2bf(lo) | ((unsigned)f2bf(hi) << 16); }
__device__ __forceinline__ float sigm(float x) { return 1.f / (1.f + __expf(-x)); }
__device__ __forceinline__ float siluf(float x) { return x * sigm(x); }
__device__ __forceinline__ float softplusf(float x) { return fmaxf(x, 0.f) + log1pf(__expf(-fabsf(x))); }
__device__ __forceinline__ float gelu_tanh(float x) { const float u = 0.7978845608028654f * (x + 0.044715f * x * x * x); return 0.5f * x * (1.f + tanhf(u)); }
__device__ __forceinline__ float wave_sum(float v) {
#pragma unroll
    for (int o = 1; o < 64; o <<= 1) v += __shfl_xor(v, o);
    return v;
}


namespace pg8 {
#define PG8_LAS __attribute__((address_space(3)))
typedef unsigned short bf16_t;
typedef short bf16x8 __attribute__((ext_vector_type(8)));
typedef float f32x4 __attribute__((ext_vector_type(4)));
typedef unsigned u32x4 __attribute__((ext_vector_type(4)));
constexpr int BM = 256, BK = 64, HALF = 128, HTB = HALF * BK * 2  , STAGE_BYTES = 8 * HTB, NXCD = 8, WGM = 8;

__host__ __device__ __forceinline__ int lds_byte(int r, int c) { const int st = (r >> 4) * 2 + (c >> 5), rr = r & 15, cc = c & 31, ob = rr * 64 + cc * 2; return st * 1024 + (ob ^ (((ob >> 9) & 1) << 5)); }
__host__ __device__ __forceinline__ void stage_rc(int b, int& R, int& C) { const int st = b / 1024, sb = b % 1024, swz = sb ^ (((sb >> 9) & 1) << 5); R = (st >> 1) * 16 + swz / 64; C = (st & 1) * 32 + (swz % 64) / 2; }
__host__ __device__ __forceinline__ int perm32(int rho) { const int n = rho >> 4, i = rho & 15; return 8 * (i >> 2) + 4 * n + (i & 3); }

struct Unit { int pm, pn, pb; };
struct Gemm { const bf16_t* A; const bf16_t* Bt; int M, N, K, lda; };

struct StaticOrder {
    int nM, nN, nwg, G, c;
    __host__ __device__ void init(int M, int N, int G_, int c_) { nM = M / BM; nN = N / BM; nwg = nM * nN; G = G_; c = c_; }
    __host__ __device__ bool next(int i, Unit& u) const {
        const long L = (long)i * G + c; if (L >= nwg) return false;
        int wgid = (int)L; { const int q = nwg / NXCD, r = nwg % NXCD, xcd = wgid % NXCD, off = wgid / NXCD; wgid = (xcd < r ? xcd * (q + 1) : r * (q + 1) + (xcd - r) * q) + off; }
        const int nig = WGM * nN, gid = wgid / nig, fm = gid * WGM, gsz = (nM - fm) < WGM ? (nM - fm) : WGM;
        u.pm = fm + ((wgid % nig) % gsz); u.pn = (wgid % nig) / gsz; u.pb = u.pn; return true;
    }
    __device__ __forceinline__ void a_ready(const Unit&) const {}
    __device__ __forceinline__ void done(const Unit&) const {}
};

__device__ __forceinline__ unsigned cvt_pk_bf16(float lo, float hi) { unsigned r; asm volatile("v_cvt_pk_bf16_f32 %0, %1, %2" : "=v"(r) : "v"(lo), "v"(hi)); return r; }
typedef float f32x2 __attribute__((ext_vector_type(2)));

template <class Epi, class Sched, bool ALIGN_EPI = false, bool SP2 = false>
__device__ __forceinline__ void gemm_phase(PG8_LAS unsigned char* lds, const Gemm g, const Sched& S, const Epi& E) {
    const int tid = TIDX, wid = __builtin_amdgcn_readfirstlane(tid >> 6), lane = tid & 63, wr = wid >> 2, wc = wid & 3, fr = lane & 15, fq = lane >> 4;
    const int K = g.K, nt = K / BK, lda = g.lda ? g.lda : g.K;
    unsigned voffA[2], voffB[2];
#pragma unroll
    for (int i = 0; i < 2; ++i) { int R, C; stage_rc(tid * 16 + i * 8192, R, C); const int Rb = Epi::PERM ? ((R & ~31) + perm32(R & 31)) : R;
        voffA[i] = (unsigned)(R * lda + C) * 2u; voffB[i] = (unsigned)(Rb * K + C) * 2u; }
    const size_t kstep = (size_t)(BK * 2);
    const size_t hstep = (size_t)HALF * K * 2;
    const size_t tstep = 2 * hstep;
    const size_t hstepA = (size_t)HALF * lda * 2, tstepA = 2 * hstepA;
    const unsigned ldsw = (unsigned)wid * 1024u;
    const int aoff = lds_byte(wr * 64 + fr, fq * 8), boff = lds_byte(wc * 32 + fr, fq * 8);
#define PG8_SA(b, h) (((b) * 2 + (h)) * HTB)
#define PG8_SB(b, h) ((4 + (b) * 2 + (h)) * HTB)
#define PG8_STAGE(bufoff, gbase, voff) do { _Pragma("unroll") for (int _i = 0; _i < 2; ++_i) \
        __builtin_amdgcn_global_load_lds((const unsigned*)((const char*)(gbase) + (voff)[_i]), (PG8_LAS unsigned*)(lds + (bufoff) + ldsw + _i * 8192), 16, 0, 0); } while (0)
#define PG8_LDA(dst, b, h) do { _Pragma("unroll") for (int m = 0; m < 4; ++m) _Pragma("unroll") for (int k = 0; k < 2; ++k) dst[m][k] = *(const PG8_LAS bf16x8*)(lds + PG8_SA(b, h) + aoff + m * 2048 + k * 1024); } while (0)
#define PG8_LDB(dst, b, h) do { _Pragma("unroll") for (int n = 0; n < 2; ++n) _Pragma("unroll") for (int k = 0; k < 2; ++k) dst[n][k] = *(const PG8_LAS bf16x8*)(lds + PG8_SB(b, h) + boff + n * 2048 + k * 1024); } while (0)
#define PG8_MMA(ai, bj, At, Bt) do { __builtin_amdgcn_s_setprio(1); _Pragma("unroll") for (int m = 0; m < 4; ++m) _Pragma("unroll") for (int n = 0; n < 2; ++n) _Pragma("unroll") for (int k = 0; k < 2; ++k) \
        acc[ai][bj][m][n] = __builtin_amdgcn_mfma_f32_16x16x32_bf16(Bt[n][k], At[m][k], acc[ai][bj][m][n], 0, 0, 0); __builtin_amdgcn_s_setprio(0); } while (0)
#define PG8_WAIT_V(n) asm volatile("s_waitcnt vmcnt(" #n ")" ::: "memory")
#define PG8_WAIT_L(n) asm volatile("s_waitcnt lgkmcnt(" #n ")" ::: "memory")
#define PG8_BAR __builtin_amdgcn_s_barrier()
#define PG8_SCHED __builtin_amdgcn_sched_barrier(0)
    Unit cur, nxt; int ui = 0;
    if (!S.next(0, cur)) return;
    f32x4 acc[2][2][4][2];
#pragma unroll
    for (int a = 0; a < 2; ++a)
#pragma unroll
        for (int b = 0; b < 2; ++b)
#pragma unroll
            for (int m = 0; m < 4; ++m)
#pragma unroll
                for (int n = 0; n < 2; ++n) acc[a][b][m][n] = (f32x4){0.f, 0.f, 0.f, 0.f};
    bf16x8 At[4][2], B0[2][2], B1[2][2];
    const char* cA = (const char*)g.A + (size_t)cur.pm * tstepA; const char* cB = (const char*)g.Bt + (size_t)cur.pb * tstep;
    S.a_ready(cur);
    if constexpr (SP2) {
        PG8_STAGE(PG8_SB(0, 0), cB, voffB); PG8_STAGE(PG8_SB(0, 1), cB + hstep, voffB); PG8_STAGE(PG8_SA(0, 0), cA, voffA); PG8_STAGE(PG8_SA(0, 1), cA + hstepA, voffA);
        if (wr == 1) PG8_BAR;
        PG8_WAIT_V(2); PG8_BAR;
        PG8_STAGE(PG8_SB(1, 0), cB + kstep, voffB); PG8_STAGE(PG8_SA(1, 0), cA + kstep, voffA); PG8_STAGE(PG8_SB(1, 1), cB + hstep + kstep, voffB);
        PG8_WAIT_V(6); PG8_BAR;
    } else {
        PG8_STAGE(PG8_SB(0, 0), cB, voffB); PG8_STAGE(PG8_SA(0, 0), cA, voffA); PG8_STAGE(PG8_SB(0, 1), cB + hstep, voffB); PG8_STAGE(PG8_SA(0, 1), cA + hstepA, voffA);
        if (wr == 1) PG8_BAR;
        PG8_WAIT_V(4); PG8_BAR;
        PG8_STAGE(PG8_SB(1, 0), cB + kstep, voffB); PG8_STAGE(PG8_SA(1, 0), cA + kstep, voffA); PG8_STAGE(PG8_SB(1, 1), cB + hstep + kstep, voffB);
        PG8_WAIT_V(6); PG8_BAR;
    }
    for (;;) {
        const bool has_next = S.next(ui + 1, nxt);
        const char* nA = has_next ? (const char*)g.A + (size_t)nxt.pm * tstepA : cA; const char* nB = has_next ? (const char*)g.Bt + (size_t)nxt.pb * tstep : cB;
        for (int t = 0; t < nt; t += 2) {
            const bool last = (t == nt - 2);
            const char* a1 = cA + (size_t)(t + 1) * kstep;
            const char* a2 = last ? nA : cA + (size_t)(t + 2) * kstep; const char* b2 = last ? nB : cB + (size_t)(t + 2) * kstep;
            const char* a3 = a2 + kstep; const char* b3 = b2 + kstep;
            if (last && has_next) S.a_ready(nxt);
            if constexpr (SP2) {
            PG8_LDB(B0, 0, 0); PG8_LDB(B1, 0, 1); PG8_SCHED; PG8_LDA(At, 0, 0); PG8_STAGE(PG8_SA(1, 1), a1 + hstepA, voffA);
            PG8_WAIT_V(8); PG8_WAIT_L(0); PG8_BAR; PG8_MMA(0, 0, At, B0); PG8_MMA(0, 1, At, B1); PG8_BAR; PG8_SCHED;
            PG8_LDA(At, 0, 1); PG8_STAGE(PG8_SB(0, 0), b2, voffB); PG8_STAGE(PG8_SB(0, 1), b2 + hstep, voffB); PG8_STAGE(PG8_SA(0, 0), a2, voffA);
            PG8_WAIT_V(8); PG8_WAIT_L(0); PG8_BAR; PG8_MMA(1, 0, At, B0); PG8_MMA(1, 1, At, B1); PG8_BAR; PG8_SCHED;
            PG8_LDB(B0, 1, 0); PG8_LDB(B1, 1, 1); PG8_SCHED; PG8_LDA(At, 1, 0); PG8_STAGE(PG8_SA(0, 1), a2 + hstepA, voffA);
            PG8_WAIT_V(8); PG8_WAIT_L(0); PG8_BAR; PG8_MMA(0, 0, At, B0); PG8_MMA(0, 1, At, B1); PG8_BAR; PG8_SCHED;
            PG8_LDA(At, 1, 1); PG8_STAGE(PG8_SB(1, 0), b3, voffB); PG8_STAGE(PG8_SB(1, 1), b3 + hstep, voffB); PG8_STAGE(PG8_SA(1, 0), a3, voffA);
            PG8_WAIT_V(8); PG8_WAIT_L(0); PG8_BAR; PG8_MMA(1, 0, At, B0); PG8_MMA(1, 1, At, B1); PG8_BAR; PG8_SCHED;
            } else {
            PG8_LDB(B0, 0, 0); PG8_SCHED; PG8_LDA(At, 0, 0); PG8_STAGE(PG8_SA(1, 1), a1 + hstepA, voffA);
            PG8_WAIT_L(8); PG8_BAR; PG8_WAIT_L(0); PG8_MMA(0, 0, At, B0); PG8_BAR; PG8_SCHED;
            PG8_LDB(B1, 0, 1); PG8_STAGE(PG8_SB(0, 0), b2, voffB);
            PG8_BAR; PG8_WAIT_L(0); PG8_MMA(0, 1, At, B1); PG8_BAR;
            PG8_LDA(At, 0, 1); PG8_STAGE(PG8_SA(0, 0), a2, voffA);
            PG8_BAR; PG8_WAIT_L(0); PG8_MMA(1, 0, At, B0); PG8_BAR; PG8_SCHED;
            PG8_STAGE(PG8_SB(0, 1), b2 + hstep, voffB);
            PG8_WAIT_V(6); PG8_BAR; PG8_MMA(1, 1, At, B1); PG8_BAR;
            PG8_LDB(B0, 1, 0); PG8_SCHED; PG8_LDA(At, 1, 0); PG8_STAGE(PG8_SA(0, 1), a2 + hstepA, voffA);
            PG8_WAIT_L(8); PG8_BAR; PG8_WAIT_L(0); PG8_MMA(0, 0, At, B0); PG8_BAR; PG8_SCHED;
            PG8_LDB(B1, 1, 1); PG8_STAGE(PG8_SB(1, 0), b3, voffB);
            PG8_BAR; PG8_WAIT_L(0); PG8_MMA(0, 1, At, B1); PG8_BAR;
            PG8_LDA(At, 1, 1); PG8_STAGE(PG8_SA(1, 0), a3, voffA);
            PG8_BAR; PG8_WAIT_L(0); PG8_MMA(1, 0, At, B0); PG8_BAR; PG8_SCHED;
            PG8_STAGE(PG8_SB(1, 1), b3 + hstep, voffB);
            PG8_WAIT_V(6); PG8_BAR; PG8_MMA(1, 1, At, B1); PG8_BAR;
            }
        }
        if constexpr (ALIGN_EPI) { if (wr == 0) PG8_BAR; }
        if constexpr (!Epi::AFTER_DRAIN) { E(acc, cur, wr, wc, fr, fq); S.done(cur); }
        if (!has_next) break;
#pragma unroll
        for (int a = 0; a < 2; ++a)
#pragma unroll
            for (int b = 0; b < 2; ++b)
#pragma unroll
                for (int m = 0; m < 4; ++m)
#pragma unroll
                    for (int n = 0; n < 2; ++n) acc[a][b][m][n] = (f32x4){0.f, 0.f, 0.f, 0.f};
        cur = nxt; cA = nA; cB = nB; ++ui;
        if constexpr (ALIGN_EPI) { if (wr == 1) PG8_BAR; }
    }
    PG8_WAIT_V(0);
    if constexpr (!ALIGN_EPI) { if (wr == 0) PG8_BAR; }
    PG8_BAR;
    if constexpr (Epi::AFTER_DRAIN) { E.fused(acc, cur, wr, wc, fr, fq, lds, wid, lane); S.done(cur); }
#undef PG8_SA
#undef PG8_SB
#undef PG8_STAGE
#undef PG8_LDA
#undef PG8_LDB
#undef PG8_MMA
#undef PG8_WAIT_V
#undef PG8_WAIT_L
#undef PG8_BAR
#undef PG8_SCHED
}

struct EpiStoreBf16 {
    static constexpr bool PERM = true, AFTER_DRAIN = false;
    bf16_t* O; int ldc; int split_cols; size_t split_stride;
    __device__ __forceinline__ void operator()(const f32x4 (&acc)[2][2][4][2], const Unit& u, int wr, int wc, int fr, int fq) const {
        int colt = u.pn * BM; bf16_t* base = O;
        if (split_cols) { const int t = colt / split_cols; base += (size_t)t * split_stride; colt -= t * split_cols; }
        const int row0 = u.pm * BM + wr * 64 + fr, col0 = colt + wc * 32 + 8 * fq;
#pragma unroll
        for (int ai = 0; ai < 2; ++ai)
#pragma unroll
            for (int m = 0; m < 4; ++m) { bf16_t* rowp = base + (size_t)(row0 + ai * HALF + m * 16) * ldc + col0;
#pragma unroll
                for (int bj = 0; bj < 2; ++bj) { const f32x4 v0 = acc[ai][bj][m][0], v1 = acc[ai][bj][m][1];
                    u32x4 w; w.x = cvt_pk_bf16(v0[0], v0[1]); w.y = cvt_pk_bf16(v0[2], v0[3]); w.z = cvt_pk_bf16(v1[0], v1[1]); w.w = cvt_pk_bf16(v1[2], v1[3]);
                    *(u32x4*)(rowp + bj * HALF) = w; } }
    }
};
struct EpiResidF32 {
    static constexpr bool PERM = false, AFTER_DRAIN = false;
    const float* resid; float* out; int ldc; float alpha;
    __device__ __forceinline__ void operator()(const f32x4 (&acc)[2][2][4][2], const Unit& u, int wr, int wc, int fr, int fq) const {
        const int row0 = u.pm * BM + wr * 64 + fr, col0 = u.pn * BM + wc * 32 + 4 * fq;
#pragma unroll
        for (int ai = 0; ai < 2; ++ai)
#pragma unroll
            for (int m = 0; m < 4; ++m) { const size_t off = (size_t)(row0 + ai * HALF + m * 16) * ldc + col0;
#pragma unroll
                for (int bj = 0; bj < 2; ++bj)
#pragma unroll
                    for (int n = 0; n < 2; ++n) { const size_t o = off + bj * HALF + n * 16; *(f32x4*)(out + o) = *(const f32x4*)(resid + o) * alpha + acc[ai][bj][m][n]; } }
    }
};
__device__ __forceinline__ float fast_sigm(float x) { return __builtin_amdgcn_rcpf(1.f + __expf(-x)); }
struct EpiSwiglu {
    static constexpr bool PERM = true, AFTER_DRAIN = false;
    bf16_t* HID;
    __device__ __forceinline__ void operator()(const f32x4 (&acc)[2][2][4][2], const Unit& u, int wr, int wc, int fr, int fq) const {
        const int row0 = u.pm * BM + wr * 64 + fr, h0 = u.pn * 128 + wc * 16 + 4 * fq;
#pragma unroll
        for (int ai = 0; ai < 2; ++ai)
#pragma unroll
            for (int m = 0; m < 4; ++m) { bf16_t* rowp = HID + (size_t)(row0 + ai * HALF + m * 16) * 512 + h0;
#pragma unroll
                for (int bj = 0; bj < 2; ++bj) { const f32x4 a = acc[ai][bj][m][0], b = acc[ai][bj][m][1]; f32x4 h;
#pragma unroll
                    for (int j = 0; j < 4; ++j) h[j] = a[j] * fast_sigm(a[j]) * b[j];
                    typedef unsigned u32x2v __attribute__((ext_vector_type(2)));
                    u32x2v w; w.x = cvt_pk_bf16(h[0], h[1]); w.y = cvt_pk_bf16(h[2], h[3]);
                    *(u32x2v*)(rowp + bj * 64) = w; } }
    }
};
struct EpiGlu {
    static constexpr bool PERM = true, AFTER_DRAIN = false;
    const float* ysrc; int ldy; const float* bias; bf16_t* O; int ldc;
    __device__ __forceinline__ void operator()(const f32x4 (&acc)[2][2][4][2], const Unit& u, int wr, int wc, int fr, int fq) const {
        const int row0 = u.pm * BM + wr * 64 + fr, col0 = u.pn * BM + wc * 32 + 8 * fq;
#pragma unroll
        for (int ai = 0; ai < 2; ++ai)
#pragma unroll
            for (int m = 0; m < 4; ++m) { const int row = row0 + ai * HALF + m * 16;
#pragma unroll
                for (int bj = 0; bj < 2; ++bj) { const int col = col0 + bj * HALF;
                    const f32x4 y0 = *(const f32x4*)(ysrc + (size_t)row * ldy + col), y1 = *(const f32x4*)(ysrc + (size_t)row * ldy + col + 4);
                    const f32x4 b0 = *(const f32x4*)(bias + col), b1 = *(const f32x4*)(bias + col + 4);
                    f32x4 v0 = acc[ai][bj][m][0] + b0, v1 = acc[ai][bj][m][1] + b1;
#pragma unroll
                    for (int j = 0; j < 4; ++j) { v0[j] = y0[j] * fast_sigm(v0[j]); v1[j] = y1[j] * fast_sigm(v1[j]); }
                    u32x4 w; w.x = cvt_pk_bf16(v0[0], v0[1]); w.y = cvt_pk_bf16(v0[2], v0[3]); w.z = cvt_pk_bf16(v1[0], v1[1]); w.w = cvt_pk_bf16(v1[2], v1[3]);
                    *(u32x4*)(O + (size_t)row * ldc + col) = w; } }
    }
};
struct EpiStoreF32 {
    static constexpr bool PERM = false, AFTER_DRAIN = false;
    float* out; int ldc;
    __device__ __forceinline__ void operator()(const f32x4 (&acc)[2][2][4][2], const Unit& u, int wr, int wc, int fr, int fq) const {
        const int row0 = u.pm * BM + wr * 64 + fr, col0 = u.pn * BM + wc * 32 + 4 * fq;
#pragma unroll
        for (int ai = 0; ai < 2; ++ai)
#pragma unroll
            for (int m = 0; m < 4; ++m) { const size_t off = (size_t)(row0 + ai * HALF + m * 16) * ldc + col0;
#pragma unroll
                for (int bj = 0; bj < 2; ++bj)
#pragma unroll
                    for (int n = 0; n < 2; ++n) *(f32x4*)(out + off + bj * HALF + n * 16) = acc[ai][bj][m][n]; }
    }
};
struct EpiStoreF32Half {
    static constexpr bool PERM = false, AFTER_DRAIN = false;
    float* out;
    __device__ __forceinline__ void operator()(const f32x4 (&acc)[2][2][4][2], const Unit& u, int wr, int wc, int fr, int fq) const {
        const int row0 = u.pm * BM + wr * 64 + fr, col0 = wc * 32 + 4 * fq;
#pragma unroll
        for (int ai = 0; ai < 2; ++ai)
#pragma unroll
            for (int m = 0; m < 4; ++m) { const size_t off = (size_t)(row0 + ai * HALF + m * 16) * 128 + col0;
#pragma unroll
                for (int n = 0; n < 2; ++n) *(f32x4*)(out + off + n * 16) = acc[ai][0][m][n]; }
    }
};
struct EpiS5Y {
    static constexpr bool PERM = false, AFTER_DRAIN = false;
    const bf16_t* P1; const float* dvec; float* YS5; bf16_t* YS5B;
    __device__ __forceinline__ void operator()(const f32x4 (&acc)[2][2][4][2], const Unit& u, int wr, int wc, int fr, int fq) const {
        const int g = u.pm >> 1, ch = g * 16 + 4 * fq;
        const f32x4 dd = *(const f32x4*)(dvec + ch);
#pragma unroll
        for (int ai = 0; ai < 2; ++ai)
#pragma unroll
            for (int m = 0; m < 4; ++m) {
                const int bc = (u.pm & 1) * 256 + ai * HALF + wr * 64 + m * 16 + fr, b = bc >> 8, c32 = bc & 255;
#pragma unroll
                for (int bj = 0; bj < 2; ++bj)
#pragma unroll
                    for (int n = 0; n < 2; ++n) {
                        const int i = 16 * u.pn + 8 * bj + 2 * wc + n;
                        const size_t t = (size_t)b * 8192 + c32 * 32 + i;
                        typedef unsigned u32x2v __attribute__((ext_vector_type(2)));
                        const u32x2v uu = *(const u32x2v*)(P1 + t * 2560 + ch);
                        f32x4 uv; uv[0] = __uint_as_float(uu.x << 16); uv[1] = __uint_as_float(uu.x & 0xffff0000u); uv[2] = __uint_as_float(uu.y << 16); uv[3] = __uint_as_float(uu.y & 0xffff0000u);
                        f32x4 y = acc[ai][bj][m][n] + dd * uv;
#pragma unroll
                        for (int j = 0; j < 4; ++j) { const float x = y[j]; const float tt = 0.7978845608028654f * (x + 0.044715f * x * x * x); y[j] = 0.5f * x * (1.f + tanhf(tt)); }
                        *(f32x4*)(YS5 + t * 512 + ch) = y;
                        u32x2v w; w.x = cvt_pk_bf16(y[0], y[1]); w.y = cvt_pk_bf16(y[2], y[3]);
                        *(u32x2v*)(YS5B + t * 512 + ch) = w;
                    }
            }
    }
};
struct MoeOrder {
    int ntiles, nN, G, c; const PG8_LAS int* tile_e;
    __device__ __forceinline__ bool next(int i, Unit& u) const {
        const int L = i * G + c; if (L >= ntiles * nN) return false;
        u.pm = L / nN; u.pn = L % nN; u.pb = tile_e[u.pm] * nN + u.pn; return true;
    }
    __device__ __forceinline__ void a_ready(const Unit&) const {}
    __device__ __forceinline__ void done(const Unit&) const {}
};
}

#define XB_TMO      128
#define XB_XCNT(j)  (256  + 64 * (j))
#define XB_XSUB(j)  (1280 + 64 * (j))
#define XB_XGEN(j)  (2304 + 64 * (j))
#define XB_TOP      3328
#define XB_TOPGEN   3392
#define XCD_BAR_WORDS 3456
#define XB_SPIN_CAP (1u << 18)
__device__ __forceinline__ unsigned xb_ld(unsigned* p)              { return __hip_atomic_load(p, __ATOMIC_RELAXED, __HIP_MEMORY_SCOPE_AGENT); }
__device__ __forceinline__ unsigned xb_add(unsigned* p, unsigned v) { return __hip_atomic_fetch_add(p, v, __ATOMIC_RELAXED, __HIP_MEMORY_SCOPE_AGENT); }
__device__ __forceinline__ unsigned xb_xcc_id() { return (unsigned)__builtin_amdgcn_s_getreg((3 << 11) | 20) & 0xFu; }
#define XB_SPIN(cond, bar) do { unsigned _sp = 0; while (cond) { __builtin_amdgcn_s_sleep(1); \
    if ((++_sp & 255u) == 0u) { if (xb_ld(&(bar)[XB_TMO])) break; if (_sp > XB_SPIN_CAP) { atomicAdd(&(bar)[XB_TMO], 1u); break; } } } } while (0)
struct XcdBarrier { unsigned* bar; unsigned x; volatile LAS unsigned* st; };
__device__ __forceinline__ XcdBarrier xcd_barrier_post(unsigned* bar, volatile LAS unsigned* st) {
    XcdBarrier b; b.bar = bar; b.x = xb_xcc_id(); b.st = st;
    if (TIDX == 0) (void)xb_add(&bar[XB_XCNT(b.x)], 1u);
    return b;
}
__device__ __forceinline__ void xcd_barrier_complete(unsigned* bar, unsigned x, unsigned& nloc, unsigned& nx) {
    const unsigned G = gridDim.x;
    unsigned sum, cnt, mine, sp = 0u;
    for (;;) {
        sum = 0u; cnt = 0u; mine = 0u;
#pragma unroll
        for (unsigned j = 0; j < 16; ++j) { const unsigned c = xb_ld(&bar[XB_XCNT(j)]); sum += c; cnt += (c > 0u) ? 1u : 0u; mine = (j == x) ? c : mine; }
        if (sum == G) break;
        __builtin_amdgcn_s_sleep(1);
        if ((++sp & 255u) == 0u) { if (xb_ld(&bar[XB_TMO])) break; if (sp > XB_SPIN_CAP) { atomicAdd(&bar[XB_TMO], 1u); break; } }
    }
    nloc = mine > 0u ? mine : 1u; nx = cnt > 0u ? cnt : 1u;
}
__device__ __forceinline__ void xcd_barrier(const XcdBarrier& b) {
    asm volatile("s_waitcnt vmcnt(0)" ::: "memory");
    __syncthreads();
    if (TIDX == 0) {
        unsigned* bar = b.bar;
        __builtin_amdgcn_s_waitcnt(0);
        unsigned nloc = b.st[0], nx = b.st[1];
        if (nloc == 0u) { xcd_barrier_complete(bar, b.x, nloc, nx); b.st[0] = nloc; b.st[1] = nx; }
        const unsigned old = xb_add(&bar[XB_XSUB(b.x)], 1u);
        const unsigned gen = old / nloc;
        if (old + 1u == (gen + 1u) * nloc) {
            __builtin_amdgcn_fence(__ATOMIC_RELEASE, "agent");
            asm volatile("s_waitcnt vmcnt(0)" ::: "memory");
            const unsigned og = xb_add(&bar[XB_TOP], 1u);
            const unsigned tg = og / nx;
            if (og + 1u == (tg + 1u) * nx) xb_add(&bar[XB_TOPGEN], 1u);
            else XB_SPIN(xb_ld(&bar[XB_TOPGEN]) == tg, bar);
            __builtin_amdgcn_fence(__ATOMIC_ACQUIRE, "agent");
            xb_add(&bar[XB_XGEN(b.x)], 1u);
            asm volatile("s_waitcnt vmcnt(0)" ::: "memory");
        } else {
            XB_SPIN(xb_ld(&bar[XB_XGEN(b.x)]) == gen, bar);
            __builtin_amdgcn_fence(__ATOMIC_ACQUIRE, "agent");
            asm volatile("s_waitcnt vmcnt(0)" ::: "memory");
        }
    }
    __syncthreads();
}


typedef short bf16x8 __attribute__((ext_vector_type(8)));
__device__ __forceinline__ void unpack8f(const u32x4 v, float* f) {
    f[0] = __uint_as_float(v.x << 16); f[1] = __uint_as_float(v.x & 0xffff0000u); f[2] = __uint_as_float(v.y << 16); f[3] = __uint_as_float(v.y & 0xffff0000u);
    f[4] = __uint_as_float(v.z << 16); f[5] = __uint_as_float(v.z & 0xffff0000u); f[6] = __uint_as_float(v.w << 16); f[7] = __uint_as_float(v.w & 0xffff0000u);
}
__device__ __forceinline__ u32x4 pack8f(const float* f) { u32x4 o; o.x = pk2(f[0], f[1]); o.y = pk2(f[2], f[3]); o.z = pk2(f[4], f[5]); o.w = pk2(f[6], f[7]); return o; }
__device__ __forceinline__ void ld8bf(const bf16_t* p, float* f) { unpack8f(*(const u32x4*)p, f); }
__device__ __forceinline__ void ld8f(const float* p, float* f) { const f32x4 a = *(const f32x4*)p, b = *(const f32x4*)(p + 4); f[0] = a.x; f[1] = a.y; f[2] = a.z; f[3] = a.w; f[4] = b.x; f[5] = b.y; f[6] = b.z; f[7] = b.w; }
struct GlaBufs { bf16_t* QT; bf16_t* KT; bf16_t* KDT; bf16_t* VT; float* DG; void* DS; bf16_t* SP; };
__device__ __forceinline__ float logsigf(float x) { return fminf(x, 0.f) - log1pf(__expf(-fabsf(x))); }

template <int K, int LAYER>
__device__ __forceinline__ void gla_prep_tile(LAS float* lds, const bf16_t* P, const float* aux0, const float* aux1, const GlaBufs& B, int cg) {
    constexpr int HK = 4 * K, KP = K + 1;
    LAS float* G = lds;
    LAS float* KR = lds + 64 * KP;
    LAS float* LV = lds + 2 * 64 * KP;
    const int tid = TIDX, lane = tid & 63, wave = tid >> 6;
    const int t0 = cg * 64;
    LAS float* GL = lds + 2 * 64 * KP + 64 * 129;
    LAS float* GA = GL + 64 * 16;
    if (LAYER == 0) {
        for (int idx = tid; idx < 64 * 16; idx += NTHREADS) GL[idx] = bf2f(P[(size_t)(t0 + (idx >> 4)) * NIN0P + 2816 + (idx & 15)]);
        __syncthreads();
        const int ck = tid & 255, th = tid >> 8;
        float w2r[16];
#pragma unroll
        for (int i = 0; i < 16; ++i) w2r[i] = aux0[i * 256 + ck];
        const float gb = aux1[ck];
        for (int t = th * 32; t < th * 32 + 32; ++t) {
            float gk = gb;
#pragma unroll
            for (int i4 = 0; i4 < 4; ++i4) { const f32x4 x = *(const LAS f32x4*)(GL + t * 16 + 4 * i4); gk += x.x * w2r[4 * i4] + x.y * w2r[4 * i4 + 1] + x.z * w2r[4 * i4 + 2] + x.w * w2r[4 * i4 + 3]; }
            GA[t * 257 + ck] = logsigf(gk) * (1.f / 16.f);
        }
        __syncthreads();
    }
    constexpr int NCH = 64 * K / 8 / NTHREADS;
    for (int h = 0; h < 4; ++h) {
        float qv[NCH][8];
#pragma unroll
        for (int it = 0; it < NCH; ++it) {
            const int ch = tid + it * NTHREADS, t = ch / (K / 8), c8 = (ch % (K / 8)) * 8, ck = h * K + c8;
            float kr[8], g[8];
            if (LAYER == 0) {
                ld8bf(P + (size_t)(t0 + t) * NIN0P + 2048 + ck, kr);
                ld8bf(P + (size_t)(t0 + t) * NIN0P + 1792 + ck, qv[it]);
#pragma unroll
                for (int j = 0; j < 8; ++j) { g[j] = GA[t * 257 + ck + j]; qv[it][j] *= 0.125f; }
            } else {
                float f[8], l0[8], l1[8];
                ld8bf(P + (size_t)(t0 + t) * NIN1 + 1024 + ck, f);
                ld8bf(P + (size_t)(t0 + t) * NIN1 + 512 + ck, qv[it]);
                ld8f(aux0 + ck, l0); ld8f(aux0 + 512 + ck, l1);
#pragma unroll
                for (int j = 0; j < 8; ++j) {
                    const float lbv = 1.f / (1.f + __expf(l0[j] - l1[j]));
                    const float sg = sigm(f[j]);
                    g[j] = __logf(lbv + (1.f - lbv) * sg); kr[j] = (1.f - lbv) * (1.f - sg); qv[it][j] = siluf(qv[it][j]);
                }
            }
#pragma unroll
            for (int j = 0; j < 8; ++j) { G[t * KP + c8 + j] = g[j]; KR[t * KP + c8 + j] = kr[j]; }
        }
#pragma unroll
        for (int it = 0; it < 2; ++it) {
            const int ch = tid + it * NTHREADS, t = ch >> 4, v8 = (ch & 15) * 8;
            float vv[8];
            ld8bf(LAYER == 0 ? P + (size_t)(t0 + t) * NIN0P + 2304 + h * 128 + v8 : P + (size_t)(t0 + t) * NIN1 + 1536 + h * 128 + v8, vv);
#pragma unroll
            for (int j = 0; j < 8; ++j) LV[t * 129 + v8 + j] = vv[j];
        }
        __syncthreads();
        for (int k = wave; k < K; k += NWAVES) {
            float v = G[lane * KP + k];
#pragma unroll
            for (int o = 1; o < 64; o <<= 1) { const float n = __shfl_up(v, o); if (lane >= o) v += n; }
            G[lane * KP + k] = v;
        }
        __syncthreads();
#pragma unroll
        for (int it = 0; it < NCH; ++it) {
            const int ch = tid + it * NTHREADS, t = ch / (K / 8), c8 = (ch % (K / 8)) * 8, ck = h * K + c8;
            float qo[8], ko[8];
#pragma unroll
            for (int j = 0; j < 8; ++j) { const float b = G[t * KP + c8 + j]; qo[j] = qv[it][j] * __expf(b); ko[j] = KR[t * KP + c8 + j] * __expf(-b); }
            *(u32x4*)(B.QT + (size_t)(t0 + t) * HK + ck) = pack8f(qo);
            *(u32x4*)(B.KT + (size_t)(t0 + t) * HK + ck) = pack8f(ko);
        }
#pragma unroll
        for (int it = 0; it < NCH; ++it) {
            const int id = tid + it * NTHREADS, t8 = (id & 7) * 8, k = id >> 3;
            const float bl = G[63 * KP + k];
            float o[8];
#pragma unroll
            for (int j = 0; j < 8; ++j) o[j] = KR[(t8 + j) * KP + k] * __expf(bl - G[(t8 + j) * KP + k]);
            *(u32x4*)(B.KDT + ((size_t)cg * HK + h * K + k) * 64 + t8) = pack8f(o);
            if (t8 == 0) B.DG[(size_t)cg * HK + h * K + k] = __expf(bl);
        }
#pragma unroll
        for (int it = 0; it < 2; ++it) {
            const int id = tid + it * NTHREADS, t8 = (id & 7) * 8, vc = id >> 3;
            float o[8];
#pragma unroll
            for (int j = 0; j < 8; ++j) o[j] = LV[(t8 + j) * 129 + vc];
            *(u32x4*)(B.VT + ((size_t)cg * 512 + h * 128 + vc) * 64 + t8) = pack8f(o);
        }
        __syncthreads();
    }
}

template <int K, bool DSBF>
__device__ __forceinline__ void gla_pass1_unit(const GlaBufs& B, int unit, int lane) {
    constexpr int HK = 4 * K, KT16 = K / 16;
    const int item = unit / KT16, kt = unit % KT16, cg = item >> 2, h = item & 3;
    const int r = lane & 15, q = lane >> 4;
    const bf16_t* ap = B.KDT + ((size_t)cg * HK + h * K + kt * 16 + r) * 64 + 8 * q;
    const bf16x8 a0 = *(const bf16x8*)ap, a1 = *(const bf16x8*)(ap + 32);
    const size_t dso = ((size_t)item * 128 + r) * K + kt * 16 + 4 * q;
#pragma unroll
    for (int vt = 0; vt < 8; ++vt) {
        const bf16_t* bp = B.VT + ((size_t)cg * 512 + h * 128 + vt * 16 + r) * 64 + 8 * q;
        const bf16x8 b0 = *(const bf16x8*)bp, b1 = *(const bf16x8*)(bp + 32);
        f32x4 acc = {0.f, 0.f, 0.f, 0.f};
        acc = __builtin_amdgcn_mfma_f32_16x16x32_bf16(a0, b0, acc, 0, 0, 0);
        acc = __builtin_amdgcn_mfma_f32_16x16x32_bf16(a1, b1, acc, 0, 0, 0);
        if (DSBF) { u32x2 w; w.x = pk2(acc[0], acc[1]); w.y = pk2(acc[2], acc[3]); *(u32x2*)((bf16_t*)B.DS + dso + (size_t)vt * 16 * K) = w; }
        else *(f32x4*)((float*)B.DS + dso + (size_t)vt * 16 * K) = acc;
    }
}

template <int K, bool DSBF>
__device__ __forceinline__ void gla_pass2(const GlaBufs& B, int gthread, int gthreads) {
    constexpr int HK = 4 * K;
    const float* __restrict__ DSf = (const float*)B.DS; const bf16_t* __restrict__ DSb = (const bf16_t*)B.DS; const float* __restrict__ DG = B.DG; bf16_t* __restrict__ SP = B.SP;
    for (int e = gthread; e < 8 * 128 * K; e += gthreads) {
        const int k = e % K, v = (e / K) & 127, bh = e / (K * 128), b = bh >> 2, h = bh & 3;
        float S = 0.f;
#pragma unroll 8
        for (int c = 0; c < 128; ++c) {
            const int cg = b * 128 + c;
            const size_t idx = ((size_t)(cg * 4 + h) * 128 + v) * K + k;
            const float d = DG[(size_t)cg * HK + h * K + k], ds = DSBF ? bf2f(DSb[idx]) : DSf[idx];
            SP[idx] = f2bf(S);
            S = d * S + ds;
        }
    }
}

template <int K, int LAYER>
__device__ __forceinline__ void gla_pass3_item(LAS unsigned char* lds, const bf16_t* P, const float* norm_g, const GlaBufs& B, bf16_t* Ymix, int item) {
    constexpr int HK = 4 * K, KS = K / 32;
    LAS bf16_t* Ls = (LAS bf16_t*)lds;
    LAS float* Lo = (LAS float*)(lds + 64 * 72 * 2);
    const int tid = TIDX, lane = tid & 63, wave = tid >> 6, r = lane & 15, q = lane >> 4;
    const int cg = item >> 2, h = item & 3, t0 = cg * 64;
    const int it = wave >> 1, i0 = it * 16;
    bf16x8 qf[KS];
#pragma unroll
    for (int s = 0; s < KS; ++s) qf[s] = *(const bf16x8*)(B.QT + (size_t)(t0 + i0 + r) * HK + h * K + 32 * s + 8 * q);
#pragma unroll
    for (int jj2 = 0; jj2 < 2; ++jj2) {
        const int j0 = ((wave & 1) * 2 + jj2) * 16;
        f32x4 acc = {0.f, 0.f, 0.f, 0.f};
        if (j0 <= i0) {
#pragma unroll
            for (int s = 0; s < KS; ++s) {
                const bf16x8 kf = *(const bf16x8*)(B.KT + (size_t)(t0 + j0 + r) * HK + h * K + 32 * s + 8 * q);
                acc = __builtin_amdgcn_mfma_f32_16x16x32_bf16(kf, qf[s], acc, 0, 0, 0);
            }
        }
        const int i = i0 + r;
        u32x2 w;
        w.x = pk2((j0 + 4 * q + 0) <= i ? acc[0] : 0.f, (j0 + 4 * q + 1) <= i ? acc[1] : 0.f);
        w.y = pk2((j0 + 4 * q + 2) <= i ? acc[2] : 0.f, (j0 + 4 * q + 3) <= i ? acc[3] : 0.f);
        *(LAS u32x2*)(Ls + i * 72 + j0 + 4 * q) = w;
    }
    __syncthreads();
    const bf16x8 sf0 = *(const LAS bf16x8*)(Ls + (i0 + r) * 72 + 8 * q), sf1 = *(const LAS bf16x8*)(Ls + (i0 + r) * 72 + 32 + 8 * q);
#pragma unroll
    for (int vv = 0; vv < 4; ++vv) {
        const int v0 = ((wave & 1) * 4 + vv) * 16;
        f32x4 acc = {0.f, 0.f, 0.f, 0.f};
#pragma unroll
        for (int s = 0; s < KS; ++s) {
            const bf16x8 sp = *(const bf16x8*)(B.SP + ((size_t)item * 128 + v0 + r) * K + 32 * s + 8 * q);
            acc = __builtin_amdgcn_mfma_f32_16x16x32_bf16(sp, qf[s], acc, 0, 0, 0);
        }
        const bf16_t* vp = B.VT + ((size_t)cg * 512 + h * 128 + v0 + r) * 64 + 8 * q;
        const bf16x8 vf0 = *(const bf16x8*)vp, vf1 = *(const bf16x8*)(vp + 32);
        acc = __builtin_amdgcn_mfma_f32_16x16x32_bf16(vf0, sf0, acc, 0, 0, 0);
        acc = __builtin_amdgcn_mfma_f32_16x16x32_bf16(vf1, sf1, acc, 0, 0, 0);
        *(LAS f32x4*)(Lo + (i0 + r) * 132 + v0 + 4 * q) = acc;
    }
    __syncthreads();
#pragma unroll 2
    for (int rr = 0; rr < 8; ++rr) {
        const int i = wave * 8 + rr, t = t0 + i;
        const float o0 = Lo[i * 132 + lane], o1 = Lo[i * 132 + 64 + lane];
        const float ms = wave_sum(o0 * o0 + o1 * o1) * (1.f / 128.f);
        const float rs = rsqrtf(ms + LN_EPS);
        float g0, g1;
        if (LAYER == 0) { g0 = bf2f(P[(size_t)t * NIN0P + 2832 + h * 128 + lane]); g1 = bf2f(P[(size_t)t * NIN0P + 2832 + h * 128 + 64 + lane]); }
        else { g0 = bf2f(P[(size_t)t * NIN1 + 2048 + h * 128 + lane]); g1 = bf2f(P[(size_t)t * NIN1 + 2048 + h * 128 + 64 + lane]); }
        Ymix[(size_t)t * D_ + 512 + h * 128 + lane] = f2bf(o0 * rs * norm_g[lane] * siluf(g0));
        Ymix[(size_t)t * D_ + 512 + h * 128 + 64 + lane] = f2bf(o1 * rs * norm_g[64 + lane] * siluf(g1));
    }
    __syncthreads();
}


template <int CTRL> __device__ __forceinline__ float dppf(float x) { return __builtin_bit_cast(float, __builtin_amdgcn_mov_dpp(__builtin_bit_cast(int, x), CTRL, 0xf, 0xf, true)); }
__device__ __forceinline__ float reduce32(float x) {
    x += dppf<0xB1>(x);
    x += dppf<0x4E>(x);
    x += dppf<0x141>(x);
    x += dppf<0x140>(x);
    auto sw = __builtin_amdgcn_permlane16_swap(__float_as_uint(x), __float_as_uint(x), false, false);
    return __uint_as_float(sw[0]) + __uint_as_float(sw[1]);
}
__device__ __forceinline__ void rwkv_scan_v1(LAS float* lds, const bf16_t* SC, float* YRW, int unit) {
    constexpr int TS = 32, TILE = 5 * TS * 64 + TS * 16;
    const int bh = unit >> 3, qr = unit & 7, b = bh >> 3, h = bh & 7;
    const int tid = TIDX, lane = tid & 63, wave = tid >> 6, cp = lane & 31, rl = (wave & 3) * 2 + (lane >> 5);
    const size_t S1 = (size_t)T_ * 512;
    const int chunk = tid & 255, ls = chunk >> 3, lc0 = (chunk & 7) * 8, half = tid >> 8;
    const bf16_t* g0 = SC + (half == 0 ? 0 : 4 * S1) + (size_t)(b * L_ + ls) * 512 + h * 64 + lc0;
    const bf16_t* g1 = SC + (half == 0 ? 1 * S1 : 5 * S1) + (size_t)(b * L_ + ls) * 512 + h * 64 + lc0;
    const bf16_t* g2 = (half == 0) ? SC + 2 * S1 + (size_t)(b * L_ + ls) * 512 + h * 64 + lc0
                                   : SC + 3 * S1 + (size_t)(b * L_ + ls) * 512 + h * 64 + qr * 8;
    u32x4 p0, p1, p2;
    p0 = *(const u32x4*)g0; p1 = *(const u32x4*)g1; p2 = *(const u32x4*)g2;
    float S0 = 0.f, S1v = 0.f;
    auto unpack8 = [](const u32x4 v, float* f) {
        f[0] = __uint_as_float(v.x << 16); f[1] = __uint_as_float(v.x & 0xffff0000u); f[2] = __uint_as_float(v.y << 16); f[3] = __uint_as_float(v.y & 0xffff0000u);
        f[4] = __uint_as_float(v.z << 16); f[5] = __uint_as_float(v.z & 0xffff0000u); f[6] = __uint_as_float(v.w << 16); f[7] = __uint_as_float(v.w & 0xffff0000u); };
    auto stage = [&](LAS float* buf) {
        float f0[8], f1[8], f2[8];
        unpack8(p0, f0); unpack8(p1, f1); unpack8(p2, f2);
        if (half == 0) {
#pragma unroll
            for (int j = 0; j < 8; ++j) { buf[(4 * TS + ls) * 64 + lc0 + j] = f0[j]; buf[(1 * TS + ls) * 64 + lc0 + j] = __expf(f1[j]); buf[(3 * TS + ls) * 64 + lc0 + j] = f2[j]; }
        } else {
#pragma unroll
            for (int j = 0; j < 8; ++j) { buf[(0 * TS + ls) * 64 + lc0 + j] = -f0[j]; buf[(2 * TS + ls) * 64 + lc0 + j] = f0[j] * f1[j]; }
            if ((chunk & 7) == 0) {
#pragma unroll
                for (int j = 0; j < 8; ++j) buf[5 * TS * 64 + ls * 16 + j] = f2[j];
            }
        }
    };
    stage(lds);
    __syncthreads();
    for (int t0 = 0; t0 < L_; t0 += TS) {
        LAS float* cur = lds + ((t0 / TS) & 1) * TILE;
        LAS float* nxt = lds + (((t0 / TS) & 1) ^ 1) * TILE;
        const bool more = (t0 + TS) < L_;
        if (more) { const size_t adv = (size_t)(t0 + TS) * 512; p0 = *(const u32x4*)(g0 + adv); p1 = *(const u32x4*)(g1 + adv); p2 = *(const u32x4*)(g2 + adv); }
        float* yout = YRW + (size_t)(b * L_ + t0) * 512 + h * 64 + qr * 8 + rl;
        if (wave < 4) {
        typedef float f32x2v __attribute__((ext_vector_type(2)));
        f32x2v a2 = *(const LAS f32x2v*)(cur + (0 * TS) * 64 + 2 * cp), w2 = *(const LAS f32x2v*)(cur + (1 * TS) * 64 + 2 * cp), b2 = *(const LAS f32x2v*)(cur + (2 * TS) * 64 + 2 * cp),
               k2 = *(const LAS f32x2v*)(cur + (3 * TS) * 64 + 2 * cp), r2 = *(const LAS f32x2v*)(cur + (4 * TS) * 64 + 2 * cp);
        float vv = cur[5 * TS * 64 + rl];
        float ysel = 0.f;
#pragma unroll
        for (int s = 0; s < TS; ++s) {
            const int sn = (s + 1) & (TS - 1);
            const f32x2v a2n = *(const LAS f32x2v*)(cur + (0 * TS + sn) * 64 + 2 * cp), w2n = *(const LAS f32x2v*)(cur + (1 * TS + sn) * 64 + 2 * cp),
                         b2n = *(const LAS f32x2v*)(cur + (2 * TS + sn) * 64 + 2 * cp), k2n = *(const LAS f32x2v*)(cur + (3 * TS + sn) * 64 + 2 * cp),
                         r2n = *(const LAS f32x2v*)(cur + (4 * TS + sn) * 64 + 2 * cp);
            const float vvn = cur[5 * TS * 64 + sn * 16 + rl];
            const float sa = reduce32(S0 * a2.x + S1v * a2.y);
            S0 = S0 * w2.x + (sa * b2.x + vv * k2.x);
            S1v = S1v * w2.y + (sa * b2.y + vv * k2.y);
            const float y = reduce32(S0 * r2.x + S1v * r2.y);
            ysel = (cp == s) ? y : ysel;
            a2 = a2n; w2 = w2n; b2 = b2n; k2 = k2n; r2 = r2n; vv = vvn;
        }
        yout[(size_t)cp * 512] = ysel;
        }
        if (more) stage(nxt);
        __syncthreads();
    }
}


__device__ __forceinline__ bf16x8 ldfrag(const LAS bf16_t* tile, int row0, int ks, int r, int q) { return *(const LAS bf16x8*)(tile + (row0 + r) * 72 + 32 * ks + 8 * q); }
__device__ __forceinline__ f32x4 mm64(f32x4 acc, const LAS bf16_t* A, int arow0, const LAS bf16_t* B, int brow0, int r, int q) {
    acc = __builtin_amdgcn_mfma_f32_16x16x32_bf16(ldfrag(A, arow0, 0, r, q), ldfrag(B, brow0, 0, r, q), acc, 0, 0, 0);
    acc = __builtin_amdgcn_mfma_f32_16x16x32_bf16(ldfrag(A, arow0, 1, r, q), ldfrag(B, brow0, 1, r, q), acc, 0, 0, 0);
    return acc;
}
__device__ __forceinline__ void rwkv_chunk_pre(LAS unsigned char* lds, const bf16_t* SC, bf16_t* Gout, bf16_t* Rmout, float* HTout, bf16_t* Ymout, int item) {
    const int bh = item >> 7, chn = item & 127, b = bh >> 3, h = bh & 7;
    const size_t S1 = (size_t)T_ * 512, base = (size_t)(b * L_ + chn * 64) * 512 + h * 64;
    LAS bf16_t* TL = (LAS bf16_t*)lds;
#define RTILE(k) (TL + (k) * 4608)
    LAS float* F = (LAS float*)(lds + 12 * 9216);
    LAS float* LL = F + 64 * 68;
    const int tid = TIDX, lane = tid & 63, wave = tid >> 6, r = lane & 15, q = lane >> 4;
    const int t = tid >> 3, c0 = (tid & 7) * 8;
    float ldv[8];
    { const u32x4 v = *(const u32x4*)(SC + 1 * S1 + base + (size_t)t * 512 + c0); unpack8f(v, ldv);
#pragma unroll
      for (int j = 0; j < 8; ++j) F[t * 68 + c0 + j] = ldv[j]; }
    __syncthreads();
#pragma unroll
    for (int cc = 0; cc < 8; ++cc) {
        const int c = wave * 8 + cc;
        float v = F[lane * 68 + c];
#pragma unroll
        for (int o = 1; o < 64; o <<= 1) { const float n = __shfl_up(v, o); if (lane >= o) v += n; }
        F[lane * 68 + c] = v;
    }
    __syncthreads();
    {
        float rr[8], kp[8], vv[8], kk[8], aa[8];
        unpack8f(*(const u32x4*)(SC + 0 * S1 + base + (size_t)t * 512 + c0), rr);
        unpack8f(*(const u32x4*)(SC + 2 * S1 + base + (size_t)t * 512 + c0), kp);
        unpack8f(*(const u32x4*)(SC + 3 * S1 + base + (size_t)t * 512 + c0), vv);
        unpack8f(*(const u32x4*)(SC + 4 * S1 + base + (size_t)t * 512 + c0), kk);
        unpack8f(*(const u32x4*)(SC + 5 * S1 + base + (size_t)t * 512 + c0), aa);
        float at[8], rt[8], bt[8], kt[8];
#pragma unroll
        for (int j = 0; j < 8; ++j) {
            const float cs = F[t * 68 + c0 + j], last = __expf(F[63 * 68 + c0 + j]);
            const float Lt = __expf(cs), Ltm1 = __expf(cs - ldv[j]), inv = __expf(-cs);
            at[j] = -kk[j] * Ltm1; rt[j] = rr[j] * Lt; bt[j] = kk[j] * aa[j] * inv; kt[j] = kp[j] * inv;
            RTILE(4)[(c0 + j) * 72 + t] = f2bf(at[j]);
            RTILE(5)[(c0 + j) * 72 + t] = f2bf(bt[j] * last);
            RTILE(6)[(c0 + j) * 72 + t] = f2bf(kt[j] * last);
            RTILE(7)[(c0 + j) * 72 + t] = f2bf(vv[j]);
            if (t == 63) LL[c0 + j] = last;
        }
        *(LAS u32x4*)(RTILE(0) + t * 72 + c0) = pack8f(at);
        *(LAS u32x4*)(RTILE(1) + t * 72 + c0) = pack8f(bt);
        *(LAS u32x4*)(RTILE(2) + t * 72 + c0) = pack8f(kt);
        *(LAS u32x4*)(RTILE(3) + t * 72 + c0) = pack8f(rt);
    }
    __syncthreads();
    {
        const int mtx = wave >> 1;
        const LAS bf16_t* X = (mtx < 2) ? RTILE(0) : RTILE(3);
        const LAS bf16_t* Y = (mtx & 1) ? RTILE(2) : RTILE(1);
#pragma unroll
        for (int k8 = 0; k8 < 8; ++k8) {
            const int idx = (wave & 1) * 8 + k8, ti = idx >> 2, si = idx & 3;
            f32x4 acc = {0.f, 0.f, 0.f, 0.f};
            if (si <= ti) acc = mm64(acc, Y, si * 16, X, ti * 16, r, q);
            const int tt = ti * 16 + r, s0 = si * 16 + 4 * q;
#pragma unroll
            for (int jj = 0; jj < 4; ++jj) { const bool keep = (mtx < 2) ? (s0 + jj < tt) : (s0 + jj <= tt); acc[jj] = keep ? acc[jj] : 0.f; }
            if (mtx == 0) *(LAS f32x4*)(F + tt * 68 + s0) = acc;
            else { u32x2 w; w.x = pk2(acc[0], acc[1]); w.y = pk2(acc[2], acc[3]); *(LAS u32x2*)(RTILE(7 + mtx) + tt * 72 + s0) = w; }
        }
    }
    __syncthreads();
    if (wave == 0) {
        float X[64];
        int lz = lane; asm volatile("" : "+v"(lz));
        const LAS float* Fb = F; asm volatile("" : "+v"(Fb));
#pragma unroll
        for (int tt = 0; tt < 64; ++tt) {
            float acc = (tt == lz) ? 1.f : 0.f;
#pragma unroll
            for (int s4 = 0; s4 < (tt + 3) / 4; ++s4) {
                const f32x4 a = *(const LAS f32x4*)(Fb + tt * 68 + 4 * s4);
#pragma unroll
                for (int j = 0; j < 4; ++j) if (4 * s4 + j < tt) acc += a[j] * X[4 * s4 + j];
            }
            X[tt] = acc;
            RTILE(11)[tt * 72 + lz] = f2bf(acc);
        }
    } else {
        for (int idx = wave - 1; idx < 16; idx += 7) {
            const int vi = idx >> 2, ti = idx & 3;
            f32x4 acc = {0.f, 0.f, 0.f, 0.f};
            acc = mm64(acc, RTILE(8), ti * 16, RTILE(7), vi * 16, r, q);
            u32x2 w; w.x = pk2(acc[0], acc[1]); w.y = pk2(acc[2], acc[3]);
            *(LAS u32x2*)(RTILE(2) + (vi * 16 + r) * 72 + ti * 16 + 4 * q) = w;
        }
    }
    __syncthreads();
#pragma unroll
    for (int k = 0; k < 4; ++k) {
        const int idx = wave * 4 + k, which = idx >> 4, xi = (idx >> 2) & 3, ti = idx & 3;
        f32x4 acc = {0.f, 0.f, 0.f, 0.f};
        acc = mm64(acc, RTILE(11), ti * 16, which ? RTILE(2) : RTILE(4), xi * 16, r, q);
        u32x2 w; w.x = pk2(acc[0], acc[1]); w.y = pk2(acc[2], acc[3]);
        *(LAS u32x2*)((which ? RTILE(1) : RTILE(0)) + (xi * 16 + r) * 72 + ti * 16 + 4 * q) = w;
    }
    __syncthreads();
#pragma unroll
    for (int k = 0; k < 8; ++k) {
        const int idx = wave * 8 + k, which = idx >> 4, i1 = (idx >> 2) & 3, i2 = idx & 3;
        f32x4 acc = {0.f, 0.f, 0.f, 0.f};
        if (which == 0) {
            acc = mm64(acc, RTILE(0), i2 * 16, RTILE(9), i1 * 16, r, q);
            const int tt = i1 * 16 + r, cc = i2 * 16 + 4 * q;
            const u32x2 rv = *(const LAS u32x2*)(RTILE(3) + tt * 72 + cc);
            acc[0] += __uint_as_float(rv.x << 16); acc[1] += __uint_as_float(rv.x & 0xffff0000u); acc[2] += __uint_as_float(rv.y << 16); acc[3] += __uint_as_float(rv.y & 0xffff0000u);
            u32x2 w; w.x = pk2(acc[0], acc[1]); w.y = pk2(acc[2], acc[3]);
            *(u32x2*)(Rmout + (size_t)item * 4096 + tt * 64 + cc) = w;
        } else if (which == 1) {
            acc = mm64(acc, RTILE(9), i1 * 16, RTILE(1), i2 * 16, r, q);
            acc = mm64(acc, RTILE(10), i1 * 16, RTILE(7), i2 * 16, r, q);
            u32x2 w; w.x = pk2(acc[0], acc[1]); w.y = pk2(acc[2], acc[3]);
            *(u32x2*)(Ymout + (((size_t)item * 16 + i1 * 4 + i2) * 64 + lane) * 4) = w;
        } else if (which == 2) {
            acc = mm64(acc, RTILE(0), i2 * 16, RTILE(5), i1 * 16, r, q);
            const int c1 = i1 * 16 + r, c2 = i2 * 16 + 4 * q;
#pragma unroll
            for (int jj = 0; jj < 4; ++jj) if (c2 + jj == c1) acc[jj] += LL[c1];
            u32x2 w; w.x = pk2(acc[0], acc[1]); w.y = pk2(acc[2], acc[3]);
            *(u32x2*)(Gout + (size_t)item * 4096 + c1 * 64 + c2) = w;
        } else {
            acc = mm64(acc, RTILE(5), i1 * 16, RTILE(1), i2 * 16, r, q);
            acc = mm64(acc, RTILE(6), i1 * 16, RTILE(7), i2 * 16, r, q);
            *(f32x4*)(HTout + (((size_t)item * 16 + i1 * 4 + i2) * 64 + lane) * 4) = acc;
        }
    }
    __syncthreads();
#undef RTILE
}

__device__ __forceinline__ void rwkv_chunk_seq(LAS unsigned char* lds, const bf16_t* G, const bf16_t* Rm, const float* HT, const bf16_t* Ym, float* YRW, int bh) {
    const int b = bh >> 3, h = bh & 7;
    const int tid = TIDX, lane = tid & 63, wave = tid >> 6, r = lane & 15, q = lane >> 4;
    const int rt = wave >> 1, vi0 = (wave & 1) * 2;
    LAS bf16_t* Sb0 = (LAS bf16_t*)lds;
    f32x4 Sacc[2] = {{0.f, 0.f, 0.f, 0.f}, {0.f, 0.f, 0.f, 0.f}};
    size_t item = (size_t)bh * 128;
    auto fetch = [&](size_t it, bf16x8* rm, bf16x8* g, u32x2* ym, f32x4* ht) {
#pragma unroll
        for (int ks = 0; ks < 2; ++ks) {
            rm[ks] = *(const bf16x8*)(Rm + it * 4096 + (rt * 16 + r) * 64 + 32 * ks + 8 * q);
            g[ks] = *(const bf16x8*)(G + it * 4096 + (rt * 16 + r) * 64 + 32 * ks + 8 * q);
        }
#pragma unroll
        for (int k = 0; k < 2; ++k) {
            ym[k] = *(const u32x2*)(Ym + ((it * 16 + rt * 4 + vi0 + k) * 64 + lane) * 4);
            ht[k] = *(const f32x4*)(HT + ((it * 16 + rt * 4 + vi0 + k) * 64 + lane) * 4);
        }
    };
    constexpr int PF = 4;
    bf16x8 prm[PF][2], pg[PF][2]; u32x2 pym[PF][2]; f32x4 pht[PF][2];
#pragma unroll
    for (int u = 0; u < PF; ++u) fetch(item + u, prm[u], pg[u], pym[u], pht[u]);
    for (int ch0 = 0; ch0 < 128; ch0 += PF) {
#pragma unroll
        for (int u = 0; u < PF; ++u) {
            const int ch = ch0 + u;
            LAS bf16_t* Sb = Sb0 + (ch & 1) * 4608;
#pragma unroll
            for (int k = 0; k < 2; ++k) { u32x2 w; w.x = pk2(Sacc[k][0], Sacc[k][1]); w.y = pk2(Sacc[k][2], Sacc[k][3]); *(LAS u32x2*)(Sb + ((vi0 + k) * 16 + r) * 72 + rt * 16 + 4 * q) = w; }
            __syncthreads();
            float* yb = YRW + (size_t)(b * L_ + ch * 64 + rt * 16 + 4 * q) * 512 + h * 64 + r;
#pragma unroll
            for (int k = 0; k < 2; ++k) {
                const bf16x8 s0 = ldfrag(Sb, (vi0 + k) * 16, 0, r, q), s1 = ldfrag(Sb, (vi0 + k) * 16, 1, r, q);
                f32x4 ya; ya[0] = __uint_as_float(pym[u][k].x << 16); ya[1] = __uint_as_float(pym[u][k].x & 0xffff0000u); ya[2] = __uint_as_float(pym[u][k].y << 16); ya[3] = __uint_as_float(pym[u][k].y & 0xffff0000u);
                ya = __builtin_amdgcn_mfma_f32_16x16x32_bf16(prm[u][0], s0, ya, 0, 0, 0);
                ya = __builtin_amdgcn_mfma_f32_16x16x32_bf16(prm[u][1], s1, ya, 0, 0, 0);
                f32x4 sa = pht[u][k];
                sa = __builtin_amdgcn_mfma_f32_16x16x32_bf16(pg[u][0], s0, sa, 0, 0, 0);
                sa = __builtin_amdgcn_mfma_f32_16x16x32_bf16(pg[u][1], s1, sa, 0, 0, 0);
                Sacc[k] = sa;
#pragma unroll
                for (int jj = 0; jj < 4; ++jj) yb[(size_t)jj * 512 + (vi0 + k) * 16] = ya[jj];
            }
            const int nch = ch + PF < 128 ? ch + PF : 127;
            fetch(item + nch, prm[u], pg[u], pym[u], pht[u]);
        }
    }
}

__device__ __forceinline__ void sub_barrier(unsigned* ctr, unsigned nblocks) {
    asm volatile("s_waitcnt vmcnt(0)" ::: "memory");
    __syncthreads();
    if (TIDX == 0) {
        __builtin_amdgcn_fence(__ATOMIC_RELEASE, "agent");
        asm volatile("s_waitcnt vmcnt(0)" ::: "memory");
        xb_add(ctr, 1u);
        unsigned sp = 0;
        while (xb_ld(ctr) < nblocks) { __builtin_amdgcn_s_sleep(2); if (++sp > (1u << 22)) break; }
        __builtin_amdgcn_fence(__ATOMIC_ACQUIRE, "agent");
        asm volatile("s_waitcnt vmcnt(0)" ::: "memory");
    }
    __syncthreads();
}


__device__ __forceinline__ void s5_tables(LAS float* lds, const float* a_re, const float* a_im, const float* log_dt, const float* b_re, const float* b_im,
                                          const float* c_re, const float* c_im, bf16_t* MB, bf16_t* WE, int g) {
    LAS float* pwr = lds;
    LAS float* pwi = pwr + 33 * 64;
    LAS float* zbr = pwi + 33 * 64;
    LAS float* zbi = zbr + 1024;
    LAS float* cr = zbi + 1024;
    LAS float* ci = cr + 1024;
    LAS float* kern = ci + 1024;
    const int tid = TIDX;
    const float dt = __expf(log_dt[g]);
    for (int idx = tid; idx < 33 * 64; idx += NTHREADS) {
        const int tau = idx >> 6, n = idx & 63;
        const float lam_re = fminf(a_re[g * 64 + n], -1e-4f), lam_im = a_im[g * 64 + n];
        const float m = __expf(lam_re * dt * (float)tau), ang = lam_im * dt * (float)tau;
        pwr[idx] = m * cosf(ang); pwi[idx] = m * sinf(ang);
    }
    for (int idx = tid; idx < 1024; idx += NTHREADS) {
        const int n = idx >> 4;
        const float lam_re = fminf(a_re[g * 64 + n], -1e-4f), lam_im = a_im[g * 64 + n];
        const float mag = __expf(lam_re * dt);
        const float ab_re = mag * cosf(lam_im * dt), ab_im = mag * sinf(lam_im * dt);
        const float den = lam_re * lam_re + lam_im * lam_im, num_re = ab_re - 1.f;
        const float z_re = (num_re * lam_re + ab_im * lam_im) / den, z_im = (ab_im * lam_re - num_re * lam_im) / den;
        const float br = b_re[(size_t)g * 1024 + idx], bi = b_im[(size_t)g * 1024 + idx];
        zbr[idx] = z_re * br - z_im * bi; zbi[idx] = z_re * bi + z_im * br;
        cr[idx] = c_re[(size_t)g * 1024 + idx]; ci[idx] = c_im[(size_t)g * 1024 + idx];
    }
    __syncthreads();
    {
        const int c = (tid >> 4) & 15, cp = tid & 15, th = tid >> 8;
        float acc[16];
#pragma unroll
        for (int i = 0; i < 16; ++i) acc[i] = 0.f;
        for (int n = 0; n < 64; ++n) {
            const float xr = cr[c * 64 + n], xi = ci[c * 64 + n], zr = zbr[n * 16 + cp], zi = zbi[n * 16 + cp];
            const float pr = xr * zr - xi * zi, pi = xr * zi + xi * zr;
#pragma unroll
            for (int i = 0; i < 16; ++i) acc[i] += pr * pwr[(th * 16 + i) * 64 + n] - pi * pwi[(th * 16 + i) * 64 + n];
        }
#pragma unroll
        for (int i = 0; i < 16; ++i) kern[((th * 16 + i) * 16 + c) * 16 + cp] = acc[i];
    }
    __syncthreads();
    {
        const int row = tid, i = row >> 4, c = row & 15;
        bf16_t* dst = MB + ((size_t)g * 512 + row) * 640;
        for (int ch = 0; ch < 64; ++ch) {
            const int j = ch >> 1, cp0 = (ch & 1) * 8;
            float v[8];
            if (j <= i) { const f32x4 a = *(const LAS f32x4*)(kern + ((i - j) * 16 + c) * 16 + cp0), b = *(const LAS f32x4*)(kern + ((i - j) * 16 + c) * 16 + cp0 + 4);
                          v[0] = a.x; v[1] = a.y; v[2] = a.z; v[3] = a.w; v[4] = b.x; v[5] = b.y; v[6] = b.z; v[7] = b.w; }
            else {
#pragma unroll
                for (int k = 0; k < 8; ++k) v[k] = 0.f; }
            *(u32x4*)(dst + ch * 8) = pack8f(v);
        }
        for (int ch = 0; ch < 16; ++ch) {
            const int n0 = (ch & 7) * 8; const bool im = ch >= 8;
            float v[8];
#pragma unroll
            for (int k = 0; k < 8; ++k) {
                const float xr = cr[c * 64 + n0 + k], xi = ci[c * 64 + n0 + k], pr = pwr[(i + 1) * 64 + n0 + k], pi = pwi[(i + 1) * 64 + n0 + k];
                v[k] = im ? -(xr * pi + xi * pr) : (xr * pr - xi * pi);
            }
            *(u32x4*)(dst + 512 + ch * 8) = pack8f(v);
        }
    }
    {
        const int np = tid >> 1, hf = tid & 1, n = np & 63;
        bf16_t* dst = WE + ((size_t)g * 256 + np) * 512 + hf * 256;
        for (int ch = 0; ch < 32; ++ch) {
            const int col = hf * 256 + ch * 8, j = col >> 4, cp0 = col & 15;
            float v[8];
            if (np < 128) {
                const float pr = pwr[(31 - j) * 64 + n], pi = pwi[(31 - j) * 64 + n];
#pragma unroll
                for (int k = 0; k < 8; ++k) { const float zr = zbr[n * 16 + cp0 + k], zi = zbi[n * 16 + cp0 + k]; v[k] = np < 64 ? (pr * zr - pi * zi) : (pr * zi + pi * zr); }
            } else {
#pragma unroll
                for (int k = 0; k < 8; ++k) v[k] = 0.f; }
            *(u32x4*)(dst + ch * 8) = pack8f(v);
        }
    }
    __syncthreads();
}
__device__ __forceinline__ void s5_fill_ua(const bf16_t* P1, bf16_t* UA, int gw, int ngw, int lane) {
    for (int t = gw; t < T_; t += ngw) {
        const int b = t >> 13, tt = t & 8191, c32 = tt >> 5, j = tt & 31, g = lane >> 1, c0 = (lane & 1) * 8;
        const u32x4 v = *(const u32x4*)(P1 + (size_t)t * NIN1 + 8 * lane);
        *(u32x4*)(UA + ((size_t)g * 512 + b * 256 + c32) * 640 + j * 16 + c0) = v;
    }
}
__device__ __forceinline__ void s5_carry(const float* a_re, const float* a_im, const float* log_dt, const float* E, bf16_t* UA, int th) {
    const int n = th & 63, g = (th >> 6) & 31, b = th >> 11;
    const float lam_re = fminf(a_re[g * 64 + n], -1e-4f), lam_im = a_im[g * 64 + n];
    const float dt = __expf(log_dt[g]);
    const float m = __expf(lam_re * dt * 32.f), ang = lam_im * dt * 32.f;
    const float ar = m * cosf(ang), ai = m * sinf(ang);
    float hr = 0.f, hi = 0.f;
#pragma unroll 8
    for (int c = 0; c < 256; ++c) {
        const size_t row = (size_t)g * 512 + b * 256 + c;
        const float er = E[row * 128 + n], ei = E[row * 128 + 64 + n];
        UA[row * 640 + 512 + n] = f2bf(hr); UA[row * 640 + 576 + n] = f2bf(hi);
        const float nr = ar * hr - ai * hi + er, ni = ar * hi + ai * hr + ei;
        hr = nr; hi = ni;
    }
}

struct Args {
    const float* in[42];
    float* out;
    unsigned char* ws;
    int ph_lo, ph_hi;
};

template <bool DUAL, class AF, class WF, class EF>
__device__ __forceinline__ void naive_gemm(LAS float* lds, int M, int N, int K, AF arow, WF wbase, int ldw, EF epi) {
    LAS float* As = lds;
    LAS float* Bs = lds + 64 * 33;
    LAS float* Bs2 = Bs + 32 * 64;
    const int tid = TIDX, ty = tid >> 4, tx = tid & 15;
    const int tm = (M + 63) / 64, tn = (N + 63) / 64;
    for (int tile = blockIdx.x; tile < tm * tn; tile += gridDim.x) {
        const int m0 = (tile / tn) * 64, n0 = (tile % tn) * 64;
        const float* W = wbase(m0, 0);
        const float* W2 = DUAL ? wbase(m0, 1) : W;
        float acc[2][4], acc2[2][4];
#pragma unroll
        for (int i = 0; i < 2; ++i)
#pragma unroll
            for (int j = 0; j < 4; ++j) { acc[i][j] = 0.f; acc2[i][j] = 0.f; }
        for (int k0 = 0; k0 < K; k0 += 32) {
#pragma unroll
            for (int i = 0; i < 4; ++i) {
                const int idx = tid + i * 512, r = idx >> 5, kk = idx & 31, m = m0 + r;
                As[r * 33 + kk] = (m < M) ? bf2f(arow(m)[k0 + kk]) : 0.f;
            }
#pragma unroll
            for (int i = 0; i < 4; ++i) {
                const int idx = tid + i * 512, kk = idx >> 6, n = idx & 63;
                const bool ok = (n0 + n) < N;
                Bs[kk * 64 + n] = ok ? W[(size_t)(k0 + kk) * ldw + n0 + n] : 0.f;
                if (DUAL) Bs2[kk * 64 + n] = ok ? W2[(size_t)(k0 + kk) * ldw + n0 + n] : 0.f;
            }
            __syncthreads();
#pragma unroll 8
            for (int kk = 0; kk < 32; ++kk) {
                const float a0 = As[(ty * 2) * 33 + kk], a1 = As[(ty * 2 + 1) * 33 + kk];
#pragma unroll
                for (int j = 0; j < 4; ++j) {
                    const float b = Bs[kk * 64 + tx * 4 + j];
                    acc[0][j] += a0 * b; acc[1][j] += a1 * b;
                    if (DUAL) { const float b2 = Bs2[kk * 64 + tx * 4 + j]; acc2[0][j] += a0 * b2; acc2[1][j] += a1 * b2; }
                }
            }
            __syncthreads();
        }
#pragma unroll
        for (int i = 0; i < 2; ++i)
#pragma unroll
            for (int j = 0; j < 4; ++j) {
                const int m = m0 + ty * 2 + i, n = n0 + tx * 4 + j;
                if (m < M && n < N) epi(m, n, acc[i][j], acc2[i][j]);
            }
    }
}

template <class SRC, class DROW>
__device__ __forceinline__ void xpose_item(SRC src, DROW drow, bf16_t* WT, int ldk, LAS float* scr, int k0, int n0, int lane) {
#pragma unroll 8
    for (int i = 0; i < 32; ++i) { const int kk = 2 * i + (lane >> 5); scr[kk * 33 + (lane & 31)] = src(k0 + kk, n0 + (lane & 31)); }
    asm volatile("s_waitcnt lgkmcnt(0)" ::: "memory");
    const int c = lane & 7;
#pragma unroll
    for (int j = 0; j < 4; ++j) {
        const int n = (lane >> 3) + 8 * j; const LAS float* sp = scr + (8 * c) * 33 + n;
        u32x4 o; o.x = pk2(sp[0 * 33], sp[1 * 33]); o.y = pk2(sp[2 * 33], sp[3 * 33]); o.z = pk2(sp[4 * 33], sp[5 * 33]); o.w = pk2(sp[6 * 33], sp[7 * 33]);
        *(u32x4*)(WT + (size_t)drow(n0 + n) * ldk + k0 + 8 * c) = o;
    }
    asm volatile("s_waitcnt lgkmcnt(0)" ::: "memory");
}
template <class SRC4, class DROW>
__device__ __forceinline__ void xpose_item4(SRC4 src, DROW drow, bf16_t* WT, int ldk, LAS float* scr, int k0, int n0, int lane) {
    f32x4 v[8];
#pragma unroll
    for (int i = 0; i < 8; ++i) v[i] = src(k0 + 8 * i + (lane >> 3), n0 + 4 * (lane & 7));
#pragma unroll
    for (int i = 0; i < 8; ++i) { LAS float* d = scr + (8 * i + (lane >> 3)) * 33 + 4 * (lane & 7); d[0] = v[i].x; d[1] = v[i].y; d[2] = v[i].z; d[3] = v[i].w; }
    asm volatile("s_waitcnt lgkmcnt(0)" ::: "memory");
    const int c = lane & 7;
#pragma unroll
    for (int j = 0; j < 4; ++j) {
        const int n = (lane >> 3) + 8 * j; const LAS float* sp = scr + (8 * c) * 33 + n;
        u32x4 o; o.x = pk2(sp[0 * 33], sp[1 * 33]); o.y = pk2(sp[2 * 33], sp[3 * 33]); o.z = pk2(sp[4 * 33], sp[5 * 33]); o.w = pk2(sp[6 * 33], sp[7 * 33]);
        *(u32x4*)(WT + (size_t)drow(n0 + n) * ldk + k0 + 8 * c) = o;
    }
    asm volatile("s_waitcnt lgkmcnt(0)" ::: "memory");
}
__device__ __forceinline__ void convert_plain(const float* W, int K, int N, int NP, bf16_t* WT, LAS float* scr, int gw, int ngw, int lane) {
    const int nblk = NP / 32, nitems = (K / 64) * nblk;
    for (int it = gw; it < nitems; it += ngw) {
        const int k0 = 64 * (it / nblk), n0 = 32 * (it % nblk);
        xpose_item4([&](int k, int n4) { return n4 < N ? *(const f32x4*)(W + (size_t)k * N + n4) : (f32x4){0.f, 0.f, 0.f, 0.f}; }, [&](int n) { return n; }, WT, K, scr, k0, n0, lane);
    }
}
__device__ __forceinline__ void convert_lora(const float* w2, const float* a2, const float* g2, bf16_t* WT, LAS float* scr, int gw, int ngw, int lane) {
    const int nblk = NLORA / 32, nitems = 4 * nblk;
    for (int it = gw; it < nitems; it += ngw) {
        const int k0 = 64 * (it / nblk), n0 = 32 * (it % nblk);
        xpose_item([&](int k, int n) {
            if (n < 512) return k < 64 ? w2[k * 512 + n] : 0.f;
            if (n < 1024) return (k >= 64 && k < 128) ? a2[(k - 64) * 512 + (n - 512)] : 0.f;
            return k >= 128 ? g2[(k - 128) * 512 + (n - 1024)] : 0.f; }, [&](int n) { return n; }, WT, 256, scr, k0, n0, lane);
    }
}
__device__ __forceinline__ void convert_moe(const float* w1, const float* w3, const float* w2, bf16_t* W13, bf16_t* W2T, LAS float* scr, int gw, int ngw, int lane) {
    constexpr int I13 = 16 * 32, I2 = 8 * 32, IE = I13 + I2;
    for (int it = gw; it < 32 * IE; it += ngw) {
        const int e = it / IE, r = it % IE;
        if (r < I13) {
            const int k0 = 64 * (r / 32), n0 = 32 * (r % 32);
            const float* a = w1 + (size_t)e * D_ * 512; const float* b = w3 + (size_t)e * D_ * 512;
            xpose_item4([&](int k, int n4) { return n4 < 512 ? *(const f32x4*)(a + (size_t)k * 512 + n4) : *(const f32x4*)(b + (size_t)k * 512 + (n4 - 512)); },
                       [&](int n) { const int c = n & 511; return (c >> 2) * 8 + (n >> 9) * 4 + (c & 3); }, W13 + (size_t)e * 1024 * 1024, 1024, scr, k0, n0, lane);
        } else {
            const int rr = r - I13, k0 = 64 * (rr / 32), n0 = 32 * (rr % 32);
            const float* a = w2 + (size_t)e * 512 * D_;
            xpose_item4([&](int k, int n4) { return *(const f32x4*)(a + (size_t)k * D_ + n4); }, [&](int n) { return n; }, W2T + (size_t)e * 1024 * 512, 512, scr, k0, n0, lane);
        }
    }
}

__device__ __forceinline__ void ph_prologue(const float* x, bf16_t* hb) {
    const size_t n4 = (size_t)T_ * D_ / 4;
    for (size_t i = (size_t)blockIdx.x * NTHREADS + TIDX; i < n4; i += (size_t)gridDim.x * NTHREADS) {
        const f32x4 v = ((const f32x4*)x)[i];
        u32x2 o; o.x = pk2(v.x, v.y); o.y = pk2(v.z, v.w);
        ((u32x2*)hb)[i] = o;
    }
    for (size_t i = (size_t)blockIdx.x * NTHREADS + TIDX; i < (size_t)256 * D_ / 2; i += (size_t)gridDim.x * NTHREADS)
        ((unsigned*)(hb + (size_t)T_ * D_))[i] = 0u;
}

__device__ __forceinline__ float p0_shift(const bf16_t* P, const float* mu, int t, int c) {
    const float p = bf2f(P[(size_t)t * NIN0P + c]);
    const float pv = ((t & (L_ - 1)) == 0) ? 0.f : bf2f(P[(size_t)(t - 1) * NIN0P + c]);
    return p + mu[c] * (pv - p);
}
template <bool WITH_GLA>
__device__ __forceinline__ void ph_prepA0(const bf16_t* P, const float* mu, const float* gk_w2, const float* gk_b, bf16_t* Ap, float* gla_la) {
    for (int chunk = blockIdx.x; chunk < T_ / 64; chunk += gridDim.x) {
        for (int idx = TIDX; idx < 64 * 256; idx += NTHREADS) {
            const int tl = idx >> 8, j = idx & 255, t = chunk * 64 + tl;
            float v;
            if (j < 64) v = tanhf(p0_shift(P, mu, t, 512 + j));
            else if (j < 128) v = p0_shift(P, mu, t, 1600 + (j - 64));
            else v = sigm(p0_shift(P, mu, t, 1664 + (j - 128)));
            Ap[(size_t)t * 256 + j] = f2bf(v);
            if (WITH_GLA) {
                float gk = gk_b[j];
#pragma unroll
                for (int i = 0; i < 16; ++i) gk += bf2f(P[(size_t)t * NIN0P + 2816 + i]) * gk_w2[i * 256 + j];
                const float ls = fminf(gk, 0.f) - log1pf(__expf(-fabsf(gk)));
                gla_la[(size_t)t * 256 + j] = ls * (1.f / 16.f);
            }
        }
    }
}

__device__ __forceinline__ void ph_prepB0(const bf16_t* P, const bf16_t* LO, const float* mu, const float* w0, const float* a0, const float* k_k, const float* k_a,
                                          const float* r_k, bf16_t* SC, float* BON) {
    const int wave = TIDX >> 6, lane = TIDX & 63;
    for (int item = blockIdx.x * NWAVES + wave; item < T_ * 8; item += gridDim.x * NWAVES) {
        const int t = item >> 3, h = item & 7, c = h * 64 + lane;
        const float r = p0_shift(P, mu, t, c), k = p0_shift(P, mu, t, 576 + c), v = p0_shift(P, mu, t, 1088 + c);
        const float low = bf2f(LO[(size_t)t * 512 + c]), loa = bf2f(LO[(size_t)T_ * 512 + (size_t)t * 512 + c]);
        const float xw = w0[c] + low;
        const float wraw = -softplusf(-xw) - 0.5f;
        const float ld = -__expf(wraw);
        const float a = sigm(a0[c] + loa);
        const float kkr = k * k_k[c];
        const float ss = wave_sum(kkr * kkr);
        const float kk = kkr / fmaxf(sqrtf(ss), 1e-12f);
        const float kp = k * (1.f + (a - 1.f) * k_a[c]);
        const float bon = wave_sum(r * kp * r_k[c]);
        const size_t o = (size_t)t * 512 + c, S1 = (size_t)T_ * 512;
        SC[o] = f2bf(r); SC[S1 + o] = f2bf(ld); SC[2 * S1 + o] = f2bf(kp); SC[3 * S1 + o] = f2bf(v); SC[4 * S1 + o] = f2bf(kk); SC[5 * S1 + o] = f2bf(a);
        if (lane == 0) BON[(size_t)t * 8 + h] = bon;
    }
}

__device__ __forceinline__ void naive_rwkv_scan(LAS float* lds, const bf16_t* SC, float* YRW, int bh) {
    constexpr int TS = 32;
    const int b = bh >> 3, h = bh & 7;
    LAS float* Lnkk = lds;
    LAS float* Ldec = lds + TS * 64;
    LAS float* Lab = lds + 2 * TS * 64;
    LAS float* Lkp = lds + 3 * TS * 64;
    LAS float* Lr = lds + 4 * TS * 64;
    LAS float* Lv = lds + 5 * TS * 64;
    const size_t S1 = (size_t)T_ * 512;
    float S[64];
#pragma unroll
    for (int k = 0; k < 64; ++k) S[k] = 0.f;
    const int lane = TIDX & 63, wave = TIDX >> 6;
    for (int t0 = 0; t0 < L_; t0 += TS) {
        for (int idx = TIDX; idx < TS * 64; idx += NTHREADS) {
            const int s = idx >> 6, k = idx & 63;
            const size_t o = (size_t)(b * L_ + t0 + s) * 512 + h * 64 + k;
            const float r = bf2f(SC[o]), ld = bf2f(SC[S1 + o]), kp = bf2f(SC[2 * S1 + o]), v = bf2f(SC[3 * S1 + o]), kk = bf2f(SC[4 * S1 + o]), a = bf2f(SC[5 * S1 + o]);
            Lnkk[idx] = -kk; Ldec[idx] = __expf(ld); Lab[idx] = kk * a; Lkp[idx] = kp; Lr[idx] = r; Lv[idx] = v;
        }
        __syncthreads();
        if (wave == 0) {
            for (int s = 0; s < TS; ++s) {
                float sa = 0.f;
#pragma unroll
                for (int k = 0; k < 64; ++k) sa += S[k] * Lnkk[s * 64 + k];
                const float vv = Lv[s * 64 + lane];
                float y = 0.f;
#pragma unroll
                for (int k = 0; k < 64; ++k) {
                    S[k] = S[k] * Ldec[s * 64 + k] + sa * Lab[s * 64 + k] + vv * Lkp[s * 64 + k];
                    y += S[k] * Lr[s * 64 + k];
                }
                YRW[(size_t)(b * L_ + t0 + s) * 512 + h * 64 + lane] = y;
            }
        }
        __syncthreads();
    }
}

template <int K, class LDF, class LVF>
__device__ __forceinline__ void naive_gla_scan(LAS float* lds, LDF ld, LVF lv, float* OG, int b, int h) {
    constexpr int TS = 16;
    LAS float* Lq = lds;
    LAS float* Lk = lds + TS * K;
    LAS float* Le = lds + 2 * TS * K;
    LAS float* Lv = lds + 3 * TS * K;
    float S[K];
#pragma unroll
    for (int k = 0; k < K; ++k) S[k] = 0.f;
    const int tid = TIDX;
    for (int t0 = 0; t0 < L_; t0 += TS) {
        for (int idx = tid; idx < TS * K; idx += NTHREADS) {
            const int s = idx / K, k = idx % K;
            float q, kk, e; ld(b * L_ + t0 + s, h * K + k, q, kk, e);
            Lq[idx] = q; Lk[idx] = kk; Le[idx] = e;
        }
        for (int idx = tid; idx < TS * 128; idx += NTHREADS) {
            const int s = idx >> 7, vc = idx & 127;
            Lv[idx] = lv(b * L_ + t0 + s, h * 128 + vc);
        }
        __syncthreads();
        if (tid < 128) {
            for (int s = 0; s < TS; ++s) {
                const float vv = Lv[s * 128 + tid];
                float o = 0.f;
#pragma unroll
                for (int k = 0; k < K; ++k) {
                    S[k] = S[k] * Le[s * K + k] + Lk[s * K + k] * vv;
                    o += Lq[s * K + k] * S[k];
                }
                OG[(size_t)(b * L_ + t0 + s) * 512 + h * 128 + tid] = o;
            }
        }
        __syncthreads();
    }
}

template <bool WITH_GLA>
__device__ __forceinline__ void ph_fin0(const float* YRW, const float* OG, const bf16_t* P, const bf16_t* LO, const bf16_t* SC, const float* BON,
                                        const float* gn_g, const float* gn_b, const float* norm_g, bf16_t* Ymix) {
    const int wave = TIDX >> 6, lane = TIDX & 63;
    const size_t S1 = (size_t)T_ * 512;
    constexpr int NU = WITH_GLA ? 12 : 8;
    for (int item = blockIdx.x * NWAVES + wave; item < T_ * NU; item += gridDim.x * NWAVES) {
        const int t = item / NU, u = item % NU;
        if (u < 8) {
            const int c = u * 64 + lane;
            const float y = YRW[(size_t)t * 512 + c];
            const float mean = wave_sum(y) * (1.f / 64.f);
            const float d = y - mean;
            const float var = wave_sum(d * d) * (1.f / 64.f);
            const float yn = d * rsqrtf(var + 64e-5f) * gn_g[c] + gn_b[c];
            const float v = bf2f(SC[3 * S1 + (size_t)t * 512 + c]);
            const float g = bf2f(LO[(size_t)2 * T_ * 512 + (size_t)t * 512 + c]);
            Ymix[(size_t)t * D_ + c] = f2bf((yn + BON[(size_t)t * 8 + u] * v) * g);
        } else {
            const int h = u - 8;
            const float o0 = OG[(size_t)t * 512 + h * 128 + lane], o1 = OG[(size_t)t * 512 + h * 128 + 64 + lane];
            const float ms = wave_sum(o0 * o0 + o1 * o1) * (1.f / 128.f);
            const float rs = rsqrtf(ms + LN_EPS);
            const float g0 = bf2f(P[(size_t)t * NIN0P + 2832 + h * 128 + lane]), g1 = bf2f(P[(size_t)t * NIN0P + 2832 + h * 128 + 64 + lane]);
            Ymix[(size_t)t * D_ + 512 + h * 128 + lane] = f2bf(o0 * rs * norm_g[lane] * siluf(g0));
            Ymix[(size_t)t * D_ + 512 + h * 128 + 64 + lane] = f2bf(o1 * rs * norm_g[64 + lane] * siluf(g1));
        }
    }
}

__device__ __forceinline__ void ph_ln_router(const float* src, float* hf, bf16_t* hb, const float* lg, const float* lb, const float* wg, const float* bg,
                                             const float* we, const float* be, int* tok_e, int* tok_slot, float* tok_g, unsigned* cnt) {
    const int wave = TIDX >> 6, lane = TIDX & 63;
    for (int t = blockIdx.x * NWAVES + wave; t < T_; t += gridDim.x * NWAVES) {
        const f32x4* xr = (const f32x4*)(src + (size_t)t * D_) + lane;
        f32x4 v[4]; float s = 0.f;
#pragma unroll
        for (int j = 0; j < 4; ++j) { v[j] = xr[64 * j]; s += (v[j].x + v[j].y) + (v[j].z + v[j].w); }
        const float mean = wave_sum(s) * (1.f / D_);
        float s2 = 0.f;
#pragma unroll
        for (int j = 0; j < 4; ++j) { v[j] = v[j] - mean; s2 += (v[j].x * v[j].x + v[j].y * v[j].y) + (v[j].z * v[j].z + v[j].w * v[j].w); }
        const float rstd = rsqrtf(wave_sum(s2) * (1.f / D_) + LN_EPS);
#pragma unroll
        for (int j = 0; j < 4; ++j) {
            const f32x4 g = ((const f32x4*)lg)[lane + 64 * j], bb = ((const f32x4*)lb)[lane + 64 * j];
            v[j] = v[j] * rstd * g + bb;
            ((f32x4*)(hf + (size_t)t * D_))[lane + 64 * j] = v[j];
            u32x2 o; o.x = pk2(v[j].x, v[j].y); o.y = pk2(v[j].z, v[j].w);
            ((u32x2*)(hb + (size_t)t * D_))[lane + 64 * j] = o;
        }
        float cl[4] = {0.f, 0.f, 0.f, 0.f};
#pragma unroll
        for (int j = 0; j < 4; ++j)
#pragma unroll
            for (int e = 0; e < 4; ++e) {
                const int d = 4 * (lane + 64 * j) + e;
                const f32x4 w = *(const f32x4*)(wg + (size_t)d * 4);
                const float xv = v[j][e];
                cl[0] += xv * w.x; cl[1] += xv * w.y; cl[2] += xv * w.z; cl[3] += xv * w.w;
            }
#pragma unroll
        for (int g = 0; g < 4; ++g) cl[g] = wave_sum(cl[g]) + bg[g];
        int grp = 0; float mx = cl[0];
#pragma unroll
        for (int g = 1; g < 4; ++g) if (cl[g] > mx) { mx = cl[g]; grp = g; }
        float den = 0.f;
#pragma unroll
        for (int g = 0; g < 4; ++g) den += __expf(cl[g] - mx);
        const float p_grp = 1.f / den;
        float fl[8];
#pragma unroll
        for (int e = 0; e < 8; ++e) fl[e] = 0.f;
        const float* weg = we + (size_t)grp * D_ * 8;
#pragma unroll
        for (int j = 0; j < 4; ++j)
#pragma unroll
            for (int e = 0; e < 4; ++e) {
                const int d = 4 * (lane + 64 * j) + e;
                const f32x4 w0 = *(const f32x4*)(weg + (size_t)d * 8), w1 = *(const f32x4*)(weg + (size_t)d * 8 + 4);
                const float xv = v[j][e];
                fl[0] += xv * w0.x; fl[1] += xv * w0.y; fl[2] += xv * w0.z; fl[3] += xv * w0.w;
                fl[4] += xv * w1.x; fl[5] += xv * w1.y; fl[6] += xv * w1.z; fl[7] += xv * w1.w;
            }
#pragma unroll
        for (int e = 0; e < 8; ++e) fl[e] = wave_sum(fl[e]) + be[grp * 8 + e];
        int j0 = 0; float m0 = fl[0];
#pragma unroll
        for (int e = 1; e < 8; ++e) if (fl[e] > m0) { m0 = fl[e]; j0 = e; }
        int j1 = -1; float m1 = -3.0e38f;
#pragma unroll
        for (int e = 0; e < 8; ++e) if (e != j0 && fl[e] > m1) { m1 = fl[e]; j1 = e; }
        const float e1 = __expf(m1 - m0);
        const float g0 = p_grp / (1.f + e1), g1 = p_grp * e1 / (1.f + e1);
        if (lane == 0) {
            const int ex0 = grp * 8 + j0, ex1 = grp * 8 + j1;
            const unsigned s0 = atomicAdd(&cnt[ex0], 1u), s1 = atomicAdd(&cnt[ex1], 1u);
            tok_e[2 * t] = ex0; tok_e[2 * t + 1] = ex1;
            tok_slot[2 * t] = (int)s0; tok_slot[2 * t + 1] = (int)s1;
            tok_g[2 * t] = g0; tok_g[2 * t + 1] = g1;
        }
    }
}


__device__ __forceinline__ void shift8(const bf16_t* P, const float* mu, int t, int c, float* out) {
    float p[8], pv[8], m[8];
    ld8bf(P + (size_t)t * NIN0P + c, p); ld8f(mu + c, m);
    if ((t & (L_ - 1)) == 0) {
#pragma unroll
        for (int j = 0; j < 8; ++j) pv[j] = 0.f;
    } else ld8bf(P + (size_t)(t - 1) * NIN0P + c, pv);
#pragma unroll
    for (int j = 0; j < 8; ++j) out[j] = p[j] + m[j] * (pv[j] - p[j]);
}
__device__ __forceinline__ void ph_prepA0v(const bf16_t* P, const float* mu, bf16_t* Ap) {
    const int tid = TIDX, wave = tid >> 6, lane = tid & 63, l5 = lane & 31;
    for (int tp = blockIdx.x * NWAVES + wave; tp < T_ / 2; tp += gridDim.x * NWAVES) {
        const int t = tp * 2 + (lane >> 5), j0 = l5 * 8;
        const int c = j0 < 64 ? 512 + j0 : (j0 < 128 ? 1600 + (j0 - 64) : 1664 + (j0 - 128));
        float x[8]; shift8(P, mu, t, c, x);
#pragma unroll
        for (int j = 0; j < 8; ++j) x[j] = j0 < 64 ? tanhf(x[j]) : (j0 < 128 ? x[j] : sigm(x[j]));
        *(u32x4*)(Ap + (size_t)t * 256 + j0) = pack8f(x);
    }
}
__device__ __forceinline__ float sum8lanes(float v) { v += __shfl_xor(v, 1); v += __shfl_xor(v, 2); v += __shfl_xor(v, 4); return v; }
__device__ __forceinline__ void ph_prepB0v(const bf16_t* P, const bf16_t* LO, const float* mu, const float* w0, const float* a0, const float* k_k, const float* k_a,
                                           const float* r_k, bf16_t* SC, float* BON) {
    const int tid = TIDX, wave = tid >> 6, lane = tid & 63, c0 = lane * 8;
    const size_t S1 = (size_t)T_ * 512;
    for (int t = blockIdx.x * NWAVES + wave; t < T_; t += gridDim.x * NWAVES) {
        float r[8], k[8], v[8], low[8], loa[8], pw0[8], pa0[8], pkk[8], pka[8], prk[8];
        shift8(P, mu, t, c0, r); shift8(P, mu, t, 576 + c0, k); shift8(P, mu, t, 1088 + c0, v);
        ld8bf(LO + (size_t)t * 512 + c0, low); ld8bf(LO + S1 + (size_t)t * 512 + c0, loa);
        ld8f(w0 + c0, pw0); ld8f(a0 + c0, pa0); ld8f(k_k + c0, pkk); ld8f(k_a + c0, pka); ld8f(r_k + c0, prk);
        float ld[8], a[8], kkr[8], kp[8], ss = 0.f, bon = 0.f;
#pragma unroll
        for (int j = 0; j < 8; ++j) {
            const float xw = pw0[j] + low[j];
            const float wraw = -softplusf(-xw) - 0.5f;
            ld[j] = -__expf(wraw);
            a[j] = sigm(pa0[j] + loa[j]);
            kkr[j] = k[j] * pkk[j]; ss += kkr[j] * kkr[j];
            kp[j] = k[j] * (1.f + (a[j] - 1.f) * pka[j]);
            bon += r[j] * kp[j] * prk[j];
        }
        ss = sum8lanes(ss); bon = sum8lanes(bon);
        const float inv = 1.f / fmaxf(sqrtf(ss), 1e-12f);
#pragma unroll
        for (int j = 0; j < 8; ++j) kkr[j] *= inv;
        const size_t o = (size_t)t * 512 + c0;
        *(u32x4*)(SC + o) = pack8f(r); *(u32x4*)(SC + S1 + o) = pack8f(ld); *(u32x4*)(SC + 2 * S1 + o) = pack8f(kp);
        *(u32x4*)(SC + 3 * S1 + o) = pack8f(v); *(u32x4*)(SC + 4 * S1 + o) = pack8f(kkr); *(u32x4*)(SC + 5 * S1 + o) = pack8f(a);
        if ((lane & 7) == 0) BON[(size_t)t * 8 + (lane >> 3)] = bon;
    }
}
__device__ __forceinline__ void ph_fin0v(const float* YRW, const bf16_t* LO, const bf16_t* SC, const float* BON, const float* gn_g, const float* gn_b, bf16_t* Ymix) {
    const int tid = TIDX, wave = tid >> 6, lane = tid & 63, c0 = lane * 8;
    const size_t S1 = (size_t)T_ * 512;
    for (int t = blockIdx.x * NWAVES + wave; t < T_; t += gridDim.x * NWAVES) {
        float y[8], v[8], g[8], gg[8], gb[8];
        ld8f(YRW + (size_t)t * 512 + c0, y); ld8bf(SC + 3 * S1 + (size_t)t * 512 + c0, v); ld8bf(LO + 2 * S1 + (size_t)t * 512 + c0, g);
        ld8f(gn_g + c0, gg); ld8f(gn_b + c0, gb);
        const float bon = BON[(size_t)t * 8 + (lane >> 3)];
        float sm = 0.f;
#pragma unroll
        for (int j = 0; j < 8; ++j) sm += y[j];
        const float mean = sum8lanes(sm) * (1.f / 64.f);
        float sq = 0.f;
#pragma unroll
        for (int j = 0; j < 8; ++j) { y[j] -= mean; sq += y[j] * y[j]; }
        const float rs = rsqrtf(sum8lanes(sq) * (1.f / 64.f) + 64e-5f);
        float o[8];
#pragma unroll
        for (int j = 0; j < 8; ++j) o[j] = (y[j] * rs * gg[j] + gb[j] + bon * v[j]) * g[j];
        *(u32x4*)(Ymix + (size_t)t * D_ + c0) = pack8f(o);
    }
}

__device__ __forceinline__ void ph_ln_router2(LAS unsigned char* lds, const float* src, float* hf, bf16_t* hb, const float* lg, const float* lb, const bf16_t* WrT, const float* bg, const float* be,
                                              int* tok_e, int* tok_slot, float* tok_g, unsigned* cnt) {
    LAS bf16_t* LW = (LAS bf16_t*)lds;
    LAS float* LGall = (LAS float*)(lds + 48 * 1032 * 2);
    const int tid = TIDX, wave = tid >> 6, lane = tid & 63, r = lane & 15, q = lane >> 4;
    for (int i = tid; i < 48 * 128; i += NTHREADS) { const int row = i >> 7, c8 = (i & 127) * 8; *(LAS u32x4*)(LW + row * 1032 + c8) = *(const u32x4*)(WrT + (size_t)row * 1024 + c8); }
    for (int rb = blockIdx.x; rb < T_ / 64; rb += gridDim.x) {
        for (int i = 0; i < 8; ++i) {
            const int t = rb * 64 + wave * 8 + i;
            const f32x4* xr = (const f32x4*)(src + (size_t)t * D_) + lane;
            f32x4 v[4]; float sm = 0.f;
#pragma unroll
            for (int j = 0; j < 4; ++j) { v[j] = xr[64 * j]; sm += (v[j].x + v[j].y) + (v[j].z + v[j].w); }
            const float mean = wave_sum(sm) * (1.f / D_);
            float s2 = 0.f;
#pragma unroll
            for (int j = 0; j < 4; ++j) { v[j] = v[j] - mean; s2 += (v[j].x * v[j].x + v[j].y * v[j].y) + (v[j].z * v[j].z + v[j].w * v[j].w); }
            const float rstd = rsqrtf(wave_sum(s2) * (1.f / D_) + LN_EPS);
#pragma unroll
            for (int j = 0; j < 4; ++j) {
                const f32x4 g = ((const f32x4*)lg)[lane + 64 * j], bb = ((const f32x4*)lb)[lane + 64 * j];
                v[j] = v[j] * rstd * g + bb;
                ((f32x4*)(hf + (size_t)t * D_))[lane + 64 * j] = v[j];
                u32x2 o; o.x = pk2(v[j].x, v[j].y); o.y = pk2(v[j].z, v[j].w);
                ((u32x2*)(hb + (size_t)t * D_))[lane + 64 * j] = o;
            }
        }
        asm volatile("s_waitcnt vmcnt(0)" ::: "memory");
        __syncthreads();
        if (wave < 4) {
            const bf16_t* arow = hb + (size_t)(rb * 64 + wave * 16 + r) * D_ + 8 * q;
            f32x4 acc[3] = {{0.f, 0.f, 0.f, 0.f}, {0.f, 0.f, 0.f, 0.f}, {0.f, 0.f, 0.f, 0.f}};
#pragma unroll 8
            for (int ks = 0; ks < 32; ++ks) {
                const bf16x8 af = *(const bf16x8*)(arow + 32 * ks);
#pragma unroll
                for (int ct = 0; ct < 3; ++ct) {
                    const bf16x8 bfr = *(const LAS bf16x8*)(LW + (ct * 16 + r) * 1032 + 32 * ks + 8 * q);
                    acc[ct] = __builtin_amdgcn_mfma_f32_16x16x32_bf16(af, bfr, acc[ct], 0, 0, 0);
                }
            }
            LAS float* LG = LGall + wave * (16 * 49);
#pragma unroll
            for (int ct = 0; ct < 3; ++ct)
#pragma unroll
                for (int j = 0; j < 4; ++j) LG[(4 * q + j) * 49 + ct * 16 + r] = acc[ct][j];
            asm volatile("s_waitcnt lgkmcnt(0)" ::: "memory");
            if (lane < 16) {
                const int t = rb * 64 + wave * 16 + lane;
                const LAS float* L = LG + lane * 49;
                float cl[4];
#pragma unroll
                for (int g = 0; g < 4; ++g) cl[g] = L[g] + bg[g];
                int grp = 0; float mx = cl[0];
#pragma unroll
                for (int g = 1; g < 4; ++g) if (cl[g] > mx) { mx = cl[g]; grp = g; }
                float den = 0.f;
#pragma unroll
                for (int g = 0; g < 4; ++g) den += __expf(cl[g] - mx);
                const float p_grp = 1.f / den;
                float fl[8];
#pragma unroll
                for (int e = 0; e < 8; ++e) fl[e] = L[4 + grp * 8 + e] + be[grp * 8 + e];
                int j0 = 0; float m0 = fl[0];
#pragma unroll
                for (int e = 1; e < 8; ++e) if (fl[e] > m0) { m0 = fl[e]; j0 = e; }
                int j1 = -1; float m1 = -3.0e38f;
#pragma unroll
                for (int e = 0; e < 8; ++e) if (e != j0 && fl[e] > m1) { m1 = fl[e]; j1 = e; }
                const float e1 = __expf(m1 - m0);
                const float g0 = p_grp / (1.f + e1), g1 = p_grp * e1 / (1.f + e1);
                const int ex0 = grp * 8 + j0, ex1 = grp * 8 + j1;
                const unsigned s0 = atomicAdd(&cnt[ex0], 1u), s1 = atomicAdd(&cnt[ex1], 1u);
                tok_e[2 * t] = ex0; tok_e[2 * t + 1] = ex1;
                tok_slot[2 * t] = (int)s0; tok_slot[2 * t + 1] = (int)s1;
                tok_g[2 * t] = g0; tok_g[2 * t + 1] = g1;
            }
        }
        __syncthreads();
    }
}
__device__ __forceinline__ void convert_router(const float* wg, const float* we, bf16_t* WrT, int gthread, int gthreads) {
    for (int i = gthread; i < 2 * 48 * 1024; i += gthreads) {
        const int layer = i / (48 * 1024), rem = i % (48 * 1024), col = rem >> 10, d = rem & 1023;
        float v = 0.f;
        if (col < 4) v = wg[((size_t)layer * D_ + d) * 4 + col];
        else if (col < 36) { const int g = (col - 4) >> 3, e = (col - 4) & 7; v = we[(((size_t)layer * 4 + g) * D_ + d) * 8 + e]; }
        WrT[i] = f2bf(v);
    }
}

__device__ __forceinline__ void moe_offsets(LAS int* pst, const unsigned* cnt) {
    if (TIDX == 0) {
        int acc = 0;
        for (int e = 0; e < 32; ++e) { pst[e] = acc; const int c = (int)cnt[e]; acc += (c + MOE_PAD - 1) / MOE_PAD * MOE_PAD; }
        pst[32] = acc;
    }
    __syncthreads();
}
__device__ __forceinline__ int moe_expert_of_row(const LAS int* pst, int r) {
    int e = 0;
#pragma unroll 1
    for (int i = 1; i < 32; ++i) if (r >= pst[i]) e = i;
    return e;
}

__device__ __forceinline__ void ph_dispatch(LAS int* pst, const unsigned* cnt, const bf16_t* hb, const int* tok_e, const int* tok_slot, int* tok_dest, bf16_t* XR) {
    moe_offsets(pst, cnt);
    const int wave = TIDX >> 6, lane = TIDX & 63;
    for (int item = blockIdx.x * NWAVES + wave; item < T_ * 2; item += gridDim.x * NWAVES) {
        const int t = item >> 1;
        const int e = tok_e[item], dest = pst[e] + tok_slot[item];
        if (lane == 0) tok_dest[item] = dest;
        const u32x4* src = (const u32x4*)(hb + (size_t)t * D_);
        u32x4* dst = (u32x4*)(XR + (size_t)dest * D_);
        dst[lane] = src[lane]; dst[lane + 64] = src[lane + 64];
    }
    const int R = pst[32];
    for (int r = blockIdx.x * NWAVES + wave; r < R; r += gridDim.x * NWAVES) {
        const int e = moe_expert_of_row(pst, r);
        if (r - pst[e] >= (int)cnt[e]) {
            u32x4* dst = (u32x4*)(XR + (size_t)r * D_);
            const u32x4 z = {0u, 0u, 0u, 0u};
            dst[lane] = z; dst[lane + 64] = z;
        }
    }
}

__device__ __forceinline__ void ph_combine_ln(const float* hf, const bf16_t* Y, const int* tok_dest, const float* tok_g, const float* lg, const float* lb, float* outf, bf16_t* hb) {
    const int wave = TIDX >> 6, lane = TIDX & 63;
    for (int t = blockIdx.x * NWAVES + wave; t < T_; t += gridDim.x * NWAVES) {
        const int d0 = tok_dest[2 * t], d1 = tok_dest[2 * t + 1];
        const float g0 = tok_g[2 * t], g1 = tok_g[2 * t + 1];
        f32x4 v[4]; float s = 0.f;
#pragma unroll
        for (int j = 0; j < 4; ++j) {
            const f32x4 h = ((const f32x4*)(hf + (size_t)t * D_))[lane + 64 * j];
            const u32x2 y0 = ((const u32x2*)(Y + (size_t)d0 * D_))[lane + 64 * j], y1 = ((const u32x2*)(Y + (size_t)d1 * D_))[lane + 64 * j];
            f32x4 a, b;
            a.x = __uint_as_float(y0.x << 16); a.y = __uint_as_float(y0.x & 0xffff0000u); a.z = __uint_as_float(y0.y << 16); a.w = __uint_as_float(y0.y & 0xffff0000u);
            b.x = __uint_as_float(y1.x << 16); b.y = __uint_as_float(y1.x & 0xffff0000u); b.z = __uint_as_float(y1.y << 16); b.w = __uint_as_float(y1.y & 0xffff0000u);
            v[j] = h * DN_ALPHA + (a * g0 + b * g1);
            s += (v[j].x + v[j].y) + (v[j].z + v[j].w);
        }
        const float mean = wave_sum(s) * (1.f / D_);
        float s2 = 0.f;
#pragma unroll
        for (int j = 0; j < 4; ++j) { v[j] = v[j] - mean; s2 += (v[j].x * v[j].x + v[j].y * v[j].y) + (v[j].z * v[j].z + v[j].w * v[j].w); }
        const float rstd = rsqrtf(wave_sum(s2) * (1.f / D_) + LN_EPS);
#pragma unroll
        for (int j = 0; j < 4; ++j) {
            const f32x4 g = ((const f32x4*)lg)[lane + 64 * j], bb = ((const f32x4*)lb)[lane + 64 * j];
            v[j] = v[j] * rstd * g + bb;
            ((f32x4*)(outf + (size_t)t * D_))[lane + 64 * j] = v[j];
            u32x2 o; o.x = pk2(v[j].x, v[j].y); o.y = pk2(v[j].z, v[j].w);
            ((u32x2*)(hb + (size_t)t * D_))[lane + 64 * j] = o;
        }
    }
}

__device__ __forceinline__ void naive_s5_scan(const bf16_t* P1, const float* a_re, const float* a_im, const float* log_dt, const float* b_re, const float* b_im,
                                              const float* c_re, const float* c_im, const float* dvec, float* YS5, bf16_t* YS5B, int pair) {
    const int lane = TIDX & 63;
    const int b = pair >> 5, g = pair & 31, n = lane;
    const float lam_re = fminf(a_re[g * 64 + n], -1e-4f), lam_im = a_im[g * 64 + n];
    const float dt = __expf(log_dt[g]);
    const float mag = __expf(lam_re * dt);
    const float ab_re = mag * cosf(lam_im * dt), ab_im = mag * sinf(lam_im * dt);
    const float den = lam_re * lam_re + lam_im * lam_im;
    const float num_re = ab_re - 1.f;
    const float z_re = (num_re * lam_re + ab_im * lam_im) / den;
    const float z_im = (ab_im * lam_re - num_re * lam_im) / den;
    float bre[16], bim[16], cre[16], cim[16];
#pragma unroll
    for (int c = 0; c < 16; ++c) {
        bre[c] = b_re[(size_t)(g * 64 + n) * 16 + c]; bim[c] = b_im[(size_t)(g * 64 + n) * 16 + c];
        cre[c] = c_re[(size_t)(g * 16 + c) * 64 + n]; cim[c] = c_im[(size_t)(g * 16 + c) * 64 + n];
    }
    const float dd = (lane < 16) ? dvec[g * 16 + lane] : 0.f;
    float h_re = 0.f, h_im = 0.f;
    for (int tt = 0; tt < L_; ++tt) {
        const size_t t = (size_t)b * L_ + tt;
        const float ul = (lane < 16) ? bf2f(P1[t * NIN1 + g * 16 + lane]) : 0.f;
        float bur = 0.f, bui = 0.f;
#pragma unroll
        for (int c = 0; c < 16; ++c) { const float u = __shfl(ul, c); bur += u * bre[c]; bui += u * bim[c]; }
        const float x_re = z_re * bur - z_im * bui, x_im = z_re * bui + z_im * bur;
        const float nh_re = ab_re * h_re - ab_im * h_im + x_re;
        const float nh_im = ab_re * h_im + ab_im * h_re + x_im;
        h_re = nh_re; h_im = nh_im;
        float yv = 0.f;
#pragma unroll
        for (int c = 0; c < 16; ++c) { const float y = wave_sum(h_re * cre[c] - h_im * cim[c]); if (lane == c) yv = y; }
        if (lane < 16) {
            const float y = gelu_tanh(yv + dd * ul);
            YS5[t * 512 + g * 16 + lane] = y;
            YS5B[t * 512 + g * 16 + lane] = f2bf(y);
        }
    }
}

__device__ __forceinline__ void ph_fin1(const float* OG, const bf16_t* P1, const float* norm_g, bf16_t* Ymix) {
    const int wave = TIDX >> 6, lane = TIDX & 63;
    for (int item = blockIdx.x * NWAVES + wave; item < T_ * 4; item += gridDim.x * NWAVES) {
        const int t = item >> 2, h = item & 3;
        const float o0 = OG[(size_t)t * 512 + h * 128 + lane], o1 = OG[(size_t)t * 512 + h * 128 + 64 + lane];
        const float ms = wave_sum(o0 * o0 + o1 * o1) * (1.f / 128.f);
        const float rs = rsqrtf(ms + LN_EPS);
        const float g0 = bf2f(P1[(size_t)t * NIN1 + 2048 + h * 128 + lane]), g1 = bf2f(P1[(size_t)t * NIN1 + 2048 + h * 128 + 64 + lane]);
        Ymix[(size_t)t * D_ + 512 + h * 128 + lane] = f2bf(o0 * rs * norm_g[lane] * siluf(g0));
        Ymix[(size_t)t * D_ + 512 + h * 128 + 64 + lane] = f2bf(o1 * rs * norm_g[64 + lane] * siluf(g1));
    }
}

constexpr int LDS_BYTES = 147456;
constexpr int MISC_OFF = 131072 + 8192;
enum Phase {
    PH_PROLOGUE = 0,
    PH_INPROJ0, PH_PREPA0, PH_LORA0, PH_PREPB0, PH_SCAN0, PH_SCAN0B, PH_FIN0, PH_OUTPROJ0, PH_LN1_0, PH_DISP0, PH_UP0, PH_DOWN0, PH_COMB0,
    PH_INPROJ1, PH_L1A, PH_L1B, PH_L1C, PH_L1D,
#if !(FAST_HG && FAST_S5)
    PH_SCAN1, PH_FIN1,
#endif
    PH_GLU1, PH_OUTPROJ1, PH_LN1_1, PH_DISP1, PH_UP1, PH_DOWN1, PH_COMB1,
    PH_COUNT
};

typedef const Args __attribute__((address_space(4)))* KArgsP;
__device__ __forceinline__ KArgsP fresh_args() { KArgsP p = (KArgsP)__builtin_amdgcn_kernarg_segment_ptr(); asm volatile("" : "+s"(p)); return p; }
#define PHASE_BEGIN KArgsP ap = fresh_args(); unsigned char* const ws = ap->ws; (void)ws;
#define INP(i) (ap->in[i])
#define W_CTL ((unsigned*)(ws + WS_CTL))
#define W_HB ((bf16_t*)(ws + WS_HB))
#define W_WIN0 ((bf16_t*)(ws + WS_WIN0))
#define W_WOUT0 ((bf16_t*)(ws + WS_WOUT0))
#define W_WIN1 ((bf16_t*)(ws + WS_WIN1))
#define W_WOUT1 ((bf16_t*)(ws + WS_WOUT1))
#define W_WGLU ((bf16_t*)(ws + WS_WGLU))
#define W_WLORA ((bf16_t*)(ws + WS_WLORA))
#define W_WROUTER ((bf16_t*)(ws + WS_WROUTER))
#define W_W13 ((bf16_t*)(ws + WS_W13))
#define W_W2 ((bf16_t*)(ws + WS_W2))
#define W_HA ((float*)(ws + WS_HA))
#define W_YRW W_HA
#define W_OG (W_HA + (size_t)T_ * 512)
#define W_P ((bf16_t*)(ws + WS_P))
#define W_LO ((bf16_t*)(ws + WS_LO))
#define W_SC ((bf16_t*)(ws + WS_SCAN))
#define W_GLALA ((float*)(ws + WS_GLALA))
#define W_BON ((float*)(ws + WS_BON))
#define W_AP ((bf16_t*)(ws + WS_APRIME))
#define W_YS5B ((bf16_t*)(ws + WS_YS5B))
#define W_XR ((bf16_t*)(ws + WS_XR))
#define W_HID ((bf16_t*)(ws + WS_HID))
#define W_Y ((bf16_t*)(ws + WS_Y))
#define W_TOKE ((int*)(ws + WS_ROUTE))
#define W_TOKSLOT (W_TOKE + 2 * T_)
#define W_TOKDEST (W_TOKE + 4 * T_)
#define W_TOKG ((float*)(W_TOKE + 6 * T_))
#define W_YMIX W_HB
#define BIGP(mib) (ws + WS_BIG + (size_t)(mib) * MiB)
#define GLA0_BUFS GlaBufs{(bf16_t*)BIGP(256), (bf16_t*)BIGP(264), (bf16_t*)(ws + WS_HB), (bf16_t*)BIGP(273), (float*)BIGP(289), W_HA + (size_t)T_ * 512, (bf16_t*)BIGP(112)}
#define HG_BUFS GlaBufs{(bf16_t*)BIGP(96), (bf16_t*)BIGP(112), (bf16_t*)BIGP(144), (bf16_t*)BIGP(128), (float*)BIGP(192), (void*)BIGP(252), (bf16_t*)BIGP(160)}
#define W_S5WE ((bf16_t*)BIGP(244))
#define W_S5UA ((bf16_t*)BIGP(201))
#define W_S5MB ((bf16_t*)BIGP(224))
#define W_S5E ((float*)BIGP(193))
#define CW_SUB 12288

#define IN(k) (PLO <= (k) && (k) < PHI)
#define SEAM(k) do { if (IN(k) && IN((k) + 1)) { PHASE_BEGIN XcdBarrier bar_; bar_.bar = W_CTL + CW_BAR; bar_.x = xb_xcc_id(); bar_.st = (volatile LAS unsigned*)(lds + MISC_OFF) + 8; xcd_barrier(bar_); } } while (0)
template <int PLO, int PHI, int layer>
__device__ __forceinline__ void moe_layer(LAS unsigned char* lds) {
    LAS float* ldsf = (LAS float*)lds; (void)ldsf;
        const int base = layer == 0 ? PH_OUTPROJ0 : PH_OUTPROJ1;
        if (IN(base + 0)) {
            PHASE_BEGIN
            const float* W = layer == 0 ? INP(16) : INP(30);
            float* V1 = layer == 0 ? ap->out : W_HA;
            const float* resid = layer == 0 ? INP(0) : ap->out;
#if FAST_GEMM
            (void)W;
            { pg8::Gemm g{W_YMIX, layer == 0 ? W_WOUT0 : W_WOUT1, T_, D_, D_}; pg8::StaticOrder S; S.init(T_, D_, (int)gridDim.x, (int)blockIdx.x); pg8::EpiResidF32 E{resid, V1, D_, DN_ALPHA};
              pg8::gemm_phase<pg8::EpiResidF32, pg8::StaticOrder, true, true>(lds, g, S, E); }
#else
            const bf16_t* Ymix = W_YMIX;
            naive_gemm<false>(ldsf, T_, D_, D_, [&](int m) { return Ymix + (size_t)m * D_; }, [&](int, int) { return W; }, D_,
                              [&](int m, int n, float a, float) { V1[(size_t)m * D_ + n] = DN_ALPHA * resid[(size_t)m * D_ + n] + a; });
#endif
        }
        SEAM(base + 0);
        if (IN(base + 1)) {
            PHASE_BEGIN
            const float* V1 = layer == 0 ? ap->out : W_HA;
#if FAST_LN
            ph_ln_router2(lds, V1, W_HA, W_HB, INP(31) + layer * D_, INP(32) + layer * D_, W_WROUTER + (size_t)layer * 48 * 1024, INP(34) + layer * 4, INP(36) + layer * 32,
                          W_TOKE, W_TOKSLOT, W_TOKG, W_CTL + CW_CNT + 64 * layer);
#else
            ph_ln_router(V1, W_HA, W_HB, INP(31) + layer * D_, INP(32) + layer * D_, INP(33) + (size_t)layer * D_ * 4, INP(34) + layer * 4,
                         INP(35) + (size_t)layer * 4 * D_ * 8, INP(36) + layer * 32, W_TOKE, W_TOKSLOT, W_TOKG, W_CTL + CW_CNT + 64 * layer);
#endif
#ifdef PROBE_LN
            if (layer == 0) ph_ln_router(V1, W_HA, W_HB, INP(31) + layer * D_, INP(32) + layer * D_, INP(33) + (size_t)layer * D_ * 4, INP(34) + layer * 4,
                         INP(35) + (size_t)layer * 4 * D_ * 8, INP(36) + layer * 32, (int*)BIGP(290), (int*)BIGP(291), (float*)BIGP(292), W_CTL + CW_CNT + 1024);
#endif
        }
        SEAM(base + 1);
        if (IN(base + 2)) { PHASE_BEGIN ph_dispatch((LAS int*)lds, W_CTL + CW_CNT + 64 * layer, W_HB, W_TOKE, W_TOKSLOT, W_TOKDEST, W_XR); }
        SEAM(base + 2);
        if (IN(base + 3)) {
            PHASE_BEGIN
#if FAST_GEMM
            { LAS int* pst = (LAS int*)(lds + 131072 + 2048); LAS int* tile_e = (LAS int*)(lds + 131072 + 1024);
              moe_offsets(pst, W_CTL + CW_CNT + 64 * layer);
              const int ntiles = pst[32] / 256;
              if ((int)TIDX < ntiles) tile_e[TIDX] = moe_expert_of_row(pst, TIDX * 256);
              __syncthreads();
              pg8::Gemm g{W_XR, W_W13, ntiles * 256, 1024, D_}; pg8::MoeOrder S{ntiles, 4, (int)gridDim.x, (int)blockIdx.x, tile_e}; pg8::EpiSwiglu E{W_HID};
              pg8::gemm_phase<pg8::EpiSwiglu, pg8::MoeOrder, true, true>(lds, g, S, E); }
#else
            LAS int* pst = (LAS int*)(lds + 65536);
            moe_offsets(pst, W_CTL + CW_CNT + 64 * layer);
            const float* w1 = INP(37) + (size_t)layer * 32 * D_ * 512; const float* w3 = INP(38) + (size_t)layer * 32 * D_ * 512;
            const bf16_t* XR = W_XR; bf16_t* HID = W_HID;
            naive_gemm<true>(ldsf, pst[32], 512, D_, [&](int m) { return XR + (size_t)m * D_; },
                             [&](int m0, int which) { const int e = moe_expert_of_row(pst, m0); return (which ? w3 : w1) + (size_t)e * D_ * 512; }, 512,
                             [&](int m, int n, float a, float b) { HID[(size_t)m * 512 + n] = f2bf(siluf(a) * b); });
#endif
        }
        SEAM(base + 3);
        if (IN(base + 4)) {
            PHASE_BEGIN
#if FAST_GEMM
            { LAS int* pst = (LAS int*)(lds + 131072 + 2048); LAS int* tile_e = (LAS int*)(lds + 131072 + 1024);
              moe_offsets(pst, W_CTL + CW_CNT + 64 * layer);
              const int ntiles = pst[32] / 256;
              if ((int)TIDX < ntiles) tile_e[TIDX] = moe_expert_of_row(pst, TIDX * 256);
              __syncthreads();
              pg8::Gemm g{W_HID, W_W2, ntiles * 256, 1024, 512}; pg8::MoeOrder S{ntiles, 4, (int)gridDim.x, (int)blockIdx.x, tile_e}; pg8::EpiStoreBf16 E{W_Y, D_, 0, 0};
              pg8::gemm_phase<pg8::EpiStoreBf16, pg8::MoeOrder, true, true>(lds, g, S, E); }
#else
            LAS int* pst = (LAS int*)(lds + 65536);
            moe_offsets(pst, W_CTL + CW_CNT + 64 * layer);
            const float* w2 = INP(39) + (size_t)layer * 32 * 512 * D_;
            const bf16_t* HID = W_HID; bf16_t* Y = W_Y;
            naive_gemm<false>(ldsf, pst[32], D_, 512, [&](int m) { return HID + (size_t)m * 512; },
                              [&](int m0, int) { const int e = moe_expert_of_row(pst, m0); return w2 + (size_t)e * 512 * D_; }, D_,
                              [&](int m, int n, float a, float) { Y[(size_t)m * D_ + n] = f2bf(a); });
#endif
        }
        SEAM(base + 4);
        if (IN(base + 5)) { PHASE_BEGIN ph_combine_ln(W_HA, W_Y, W_TOKDEST, W_TOKG, INP(40) + layer * D_, INP(41) + layer * D_, ap->out, W_HB); }
        SEAM(base + 5);

}

template <int PLO, int PHI>
__device__ __forceinline__ void mega_body(unsigned char* lds_raw) {
    LAS unsigned char* lds = (LAS unsigned char*)lds_raw;
    LAS float* ldsf = (LAS float*)lds;
    constexpr bool MULTI = (PHI - PLO) > 1;
    if (MULTI) {
        PHASE_BEGIN
        volatile LAS unsigned* MISC = (volatile LAS unsigned*)(lds + MISC_OFF);
        if (TIDX < 32) MISC[TIDX] = 0u;
        __syncthreads();
        (void)xcd_barrier_post(W_CTL + CW_BAR, MISC + 8);
    }

    if (IN(PH_PROLOGUE)) {
        PHASE_BEGIN ph_prologue(INP(0), W_HB);
#if FAST_GEMM
        LAS float* scr = ldsf + (TIDX >> 6) * (64 * 33);
        const int gw = blockIdx.x * NWAVES + (TIDX >> 6), ngw = gridDim.x * NWAVES, lane = TIDX & 63;
        convert_plain(INP(1), D_, NIN0, NIN0P, W_WIN0, scr, gw, ngw, lane);
        convert_plain(INP(16), D_, D_, D_, W_WOUT0, scr, gw, ngw, lane);
        convert_plain(INP(17), D_, NIN1, NIN1, W_WIN1, scr, gw, ngw, lane);
        convert_plain(INP(30), D_, D_, D_, W_WOUT1, scr, gw, ngw, lane);
        convert_plain(INP(26), 512, 512, 512, W_WGLU, scr, gw, ngw, lane);
        convert_lora(INP(4), INP(6), INP(7), W_WLORA, scr, gw, ngw, lane);
        convert_router(INP(33), INP(35), W_WROUTER, blockIdx.x * NTHREADS + TIDX, gridDim.x * NTHREADS);
        convert_moe(INP(37), INP(38), INP(39), W_W13, W_W2, scr, gw, ngw, lane);
#endif
    }
    SEAM(PH_PROLOGUE);
    if (IN(PH_INPROJ0)) {
        PHASE_BEGIN
#if FAST_GEMM
        { pg8::Gemm g{W_HB, W_WIN0, T_, NIN0P, D_}; pg8::StaticOrder S; S.init(T_, NIN0P, (int)gridDim.x, (int)blockIdx.x); pg8::EpiStoreBf16 E{W_P, NIN0P, 0, 0};
          pg8::gemm_phase<pg8::EpiStoreBf16, pg8::StaticOrder, true, true>(lds, g, S, E); }
#else
        const float* W = INP(1); const bf16_t* A = W_HB; bf16_t* P = W_P;
        naive_gemm<false>(ldsf, T_, NIN0, D_, [&](int m) { return A + (size_t)m * D_; }, [&](int, int) { return W; }, NIN0,
                          [&](int m, int n, float a, float) { P[(size_t)m * NIN0P + n] = f2bf(a); });
#endif
    }
    SEAM(PH_INPROJ0);
#if FAST_GLA0
    if (IN(PH_PREPA0)) { PHASE_BEGIN ph_prepA0v(W_P, INP(2), W_AP); }
#else
    if (IN(PH_PREPA0)) { PHASE_BEGIN ph_prepA0<!FAST_GLA0>(W_P, INP(2), INP(13), INP(14), W_AP, W_GLALA); }
#endif
    SEAM(PH_PREPA0);
    if (IN(PH_LORA0)) {
        PHASE_BEGIN
#if FAST_GEMM
        { pg8::Gemm g{W_AP, W_WLORA, T_, NLORA, 256}; pg8::StaticOrder S; S.init(T_, NLORA, (int)gridDim.x, (int)blockIdx.x); pg8::EpiStoreBf16 E{W_LO, 512, 512, (size_t)T_ * 512};
          pg8::gemm_phase<pg8::EpiStoreBf16, pg8::StaticOrder, true, true>(lds, g, S, E); }
#else
        const float* w2 = INP(4); const float* a2 = INP(6); const float* g2 = INP(7); const bf16_t* AP = W_AP; bf16_t* LO = W_LO;
        naive_gemm<false>(ldsf, T_, 512, 64, [&](int m) { return AP + (size_t)m * 256; }, [&](int, int) { return w2; }, 512,
                          [&](int m, int n, float a, float) { LO[(size_t)m * 512 + n] = f2bf(a); });
        naive_gemm<false>(ldsf, T_, 512, 64, [&](int m) { return AP + (size_t)m * 256 + 64; }, [&](int, int) { return a2; }, 512,
                          [&](int m, int n, float a, float) { LO[(size_t)T_ * 512 + (size_t)m * 512 + n] = f2bf(a); });
        naive_gemm<false>(ldsf, T_, 512, 128, [&](int m) { return AP + (size_t)m * 256 + 128; }, [&](int, int) { return g2; }, 512,
                          [&](int m, int n, float a, float) { LO[(size_t)2 * T_ * 512 + (size_t)m * 512 + n] = f2bf(a); });
#endif
    }
    SEAM(PH_LORA0);
    if (IN(PH_PREPB0)) {
        PHASE_BEGIN ph_prepB0v(W_P, W_LO, INP(2), INP(3), INP(5), INP(8), INP(9), INP(10), W_SC, W_BON);
#if FAST_GLA0
        { const GlaBufs GB = GLA0_BUFS; __syncthreads();
          for (int cg = blockIdx.x; cg < 256; cg += gridDim.x) gla_prep_tile<64, 0>(ldsf, W_P, INP(13), INP(14), GB, cg); }
#endif
    }
    SEAM(PH_PREPB0);
#if FAST_RWKV == 2
#define RW_G ((bf16_t*)BIGP(128))
#define RW_RM ((bf16_t*)ap->out)
#define RW_HT (ap->out + (size_t)4 * 1024 * 1024)
#define RW_YM ((bf16_t*)(ap->out + (size_t)12 * 1024 * 1024))
    if (IN(PH_SCAN0)) {
        PHASE_BEGIN
        for (int it = blockIdx.x; it < 2048; it += gridDim.x) rwkv_chunk_pre(lds, W_SC, RW_G, RW_RM, RW_HT, RW_YM, it);
        { const GlaBufs GB = GLA0_BUFS; const int wave = TIDX >> 6, lane = TIDX & 63;
          for (int u = blockIdx.x * NWAVES + wave; u < 1024 * 4; u += gridDim.x * NWAVES) gla_pass1_unit<64, false>(GB, u, lane); }
    }
    SEAM(PH_SCAN0);
    if (IN(PH_SCAN0B)) {
        PHASE_BEGIN
        const int bid = blockIdx.x;
        if (bid < 16) rwkv_chunk_seq(lds, RW_G, RW_RM, RW_HT, RW_YM, W_YRW, bid);
#if FAST_S5
        else if (bid < 48) s5_tables(ldsf, INP(18), INP(19), INP(20), INP(21), INP(22), INP(23), INP(24), W_S5MB, W_S5WE, bid - 16);
#endif
        else {
            const GlaBufs GB = GLA0_BUFS;
            const int nb = (int)gridDim.x - 48, b0 = bid - 48;
            gla_pass2<64, false>(GB, b0 * NTHREADS + TIDX, nb * NTHREADS);
            sub_barrier(W_CTL + CW_SUB + 64, (unsigned)nb);
            for (int it = b0; it < 1024; it += nb) gla_pass3_item<64, 0>(lds, W_P, INP(15), GB, W_YMIX, it);
        }
    }
    SEAM(PH_SCAN0B);
#else
    if (IN(PH_SCAN0)) {
        PHASE_BEGIN
        const int bid = blockIdx.x;
#if FAST_RWKV
        constexpr int NRW = 128;
        if (bid < NRW) rwkv_scan_v1(ldsf, W_SC, W_YRW, bid);
#else
        constexpr int NRW = 16;
        if (bid < NRW) naive_rwkv_scan(ldsf, W_SC, W_YRW, bid);
#endif
#if FAST_GLA0
        else {
            const GlaBufs GB = GLA0_BUFS;
            const int nb = (int)gridDim.x - NRW, b0 = bid - NRW, wave = TIDX >> 6, lane = TIDX & 63;
            for (int u = b0 * NWAVES + wave; u < 1024 * 4; u += nb * NWAVES) gla_pass1_unit<64, false>(GB, u, lane);
            sub_barrier(W_CTL + CW_SUB, (unsigned)nb);
            gla_pass2<64, false>(GB, b0 * NTHREADS + TIDX, nb * NTHREADS);
            sub_barrier(W_CTL + CW_SUB + 64, (unsigned)nb);
            for (int it = b0; it < 1024; it += nb) gla_pass3_item<64, 0>(lds, W_P, INP(15), GB, W_YMIX, it);
        }
#else
        else if (bid < 24) {
            const int bh = bid - 16;
            const bf16_t* P = W_P; const float* GLALA = W_GLALA;
            naive_gla_scan<64>(ldsf,
                [&](int t, int ck, float& q, float& kk, float& e) {
                    q = bf2f(P[(size_t)t * NIN0P + 1792 + ck]) * 0.125f; kk = bf2f(P[(size_t)t * NIN0P + 2048 + ck]); e = __expf(GLALA[(size_t)t * 256 + ck]); },
                [&](int t, int cv) { return bf2f(P[(size_t)t * NIN0P + 2304 + cv]); }, W_OG, bh >> 2, bh & 3);
        }
#endif
    }
    SEAM(PH_SCAN0);
    SEAM(PH_SCAN0B);
#endif
#if FAST_GLA0
    if (IN(PH_FIN0)) { PHASE_BEGIN ph_fin0v(W_YRW, W_LO, W_SC, W_BON, INP(11), INP(12), W_YMIX); }
#else
    if (IN(PH_FIN0)) { PHASE_BEGIN ph_fin0<!FAST_GLA0>(W_YRW, W_OG, W_P, W_LO, W_SC, W_BON, INP(11), INP(12), INP(15), W_YMIX); }
#endif
    SEAM(PH_FIN0);

    moe_layer<PLO, PHI, 0>(lds);
            if (IN(PH_INPROJ1)) {
                PHASE_BEGIN
#if FAST_GEMM
                { pg8::Gemm g{W_HB, W_WIN1, T_, NIN1, D_}; pg8::StaticOrder S; S.init(T_, NIN1, (int)gridDim.x, (int)blockIdx.x); pg8::EpiStoreBf16 E{W_P, NIN1, 0, 0};
                  pg8::gemm_phase<pg8::EpiStoreBf16, pg8::StaticOrder, true, true>(lds, g, S, E); }
#else
                const float* W = INP(17); const bf16_t* A = W_HB; bf16_t* P = W_P;
                naive_gemm<false>(ldsf, T_, NIN1, D_, [&](int m) { return A + (size_t)m * D_; }, [&](int, int) { return W; }, NIN1,
                                  [&](int m, int n, float a, float) { P[(size_t)m * NIN1 + n] = f2bf(a); });
#endif
            }
            SEAM(PH_INPROJ1);
            if (IN(PH_L1A)) {
                PHASE_BEGIN
#if FAST_S5
                s5_fill_ua(W_P, W_S5UA, blockIdx.x * NWAVES + (TIDX >> 6), gridDim.x * NWAVES, TIDX & 63);
                __syncthreads();
#endif
#if FAST_HG
                { const GlaBufs GB = HG_BUFS;
                  for (int cg = blockIdx.x; cg < 256; cg += gridDim.x) gla_prep_tile<128, 1>(ldsf, W_P, INP(28), nullptr, GB, cg); }
#endif
            }
            SEAM(PH_L1A);
            if (IN(PH_L1B)) {
                PHASE_BEGIN
                const int bid = blockIdx.x;
#if FAST_S5
                if (bid < 64) {
                    LAS int* tile_e = (LAS int*)(lds + 131072 + 1024);
                    if (TIDX < 64) tile_e[TIDX] = TIDX >> 1;
                    __syncthreads();
                    pg8::Gemm g{W_S5UA, W_S5WE, 64 * 256, 256, 512, 640}; pg8::MoeOrder S{64, 1, 64, bid, tile_e}; pg8::EpiStoreF32Half E{W_S5E};
                    pg8::gemm_phase<pg8::EpiStoreF32Half, pg8::MoeOrder, true, true>(lds, g, S, E);
                }
#endif
#if FAST_HG
                if (bid >= 64) {
                    const GlaBufs GB = HG_BUFS;
                    const int nb = (int)gridDim.x - 64, b0 = bid - 64, wave = TIDX >> 6, lane = TIDX & 63;
                    for (int u = b0 * NWAVES + wave; u < 1024 * 8; u += nb * NWAVES) gla_pass1_unit<128, true>(GB, u, lane);
                }
#endif
            }
            SEAM(PH_L1B);
            if (IN(PH_L1C)) {
                PHASE_BEGIN
                const int bid = blockIdx.x;
#if FAST_S5
                if (bid < 8) s5_carry(INP(18), INP(19), INP(20), W_S5E, W_S5UA, bid * NTHREADS + TIDX);
#endif
#if FAST_HG
                if (bid >= 8) { const GlaBufs GB = HG_BUFS; gla_pass2<128, true>(GB, (bid - 8) * NTHREADS + TIDX, ((int)gridDim.x - 8) * NTHREADS); }
#endif
#if FAST_GEMM
                { LAS float* scr = ldsf + (TIDX >> 6) * (64 * 33);
                  convert_moe(INP(37) + (size_t)32 * D_ * 512, INP(38) + (size_t)32 * D_ * 512, INP(39) + (size_t)32 * 512 * D_, W_W13, W_W2, scr,
                              bid * NWAVES + (TIDX >> 6), (int)gridDim.x * NWAVES, TIDX & 63); }
#endif
            }
            SEAM(PH_L1C);
            if (IN(PH_L1D)) {
                PHASE_BEGIN
                const int bid = blockIdx.x;
#if FAST_S5
                if (bid < 128) {
                    LAS int* tile_e = (LAS int*)(lds + 131072 + 1024);
                    if (TIDX < 64) tile_e[TIDX] = TIDX >> 1;
                    __syncthreads();
                    pg8::Gemm g{W_S5UA, W_S5MB, 64 * 256, 512, 640, 640}; pg8::MoeOrder S{64, 2, 128, bid, tile_e}; pg8::EpiS5Y E{W_P, INP(25), W_YRW, W_YS5B};
                    pg8::gemm_phase<pg8::EpiS5Y, pg8::MoeOrder, true, true>(lds, g, S, E);
                }
#endif
#if FAST_HG
                if (bid >= 128) {
                    const GlaBufs GB = HG_BUFS;
                    for (int it = bid - 128; it < 1024; it += (int)gridDim.x - 128) gla_pass3_item<128, 1>(lds, W_P, INP(29), GB, W_YMIX, it);
                }
#endif
            }
            SEAM(PH_L1D);
#if !(FAST_HG && FAST_S5)
            if (IN(PH_SCAN1)) {
                PHASE_BEGIN
                const int bid = blockIdx.x;
                const bf16_t* P = W_P; (void)P; (void)bid;
#if !FAST_HG
                if (bid < 8) {
                    const float* hg_lb = INP(28);
                    naive_gla_scan<128>(ldsf,
                        [&](int t, int ck, float& q, float& kk, float& e) {
                            const float l0 = hg_lb[ck], l1 = hg_lb[512 + ck];
                            const float lbv = 1.f / (1.f + __expf(l0 - l1));
                            const float f = bf2f(P[(size_t)t * NIN1 + 1024 + ck]);
                            const float sg = sigm(f);
                            q = siluf(bf2f(P[(size_t)t * NIN1 + 512 + ck])); kk = (1.f - lbv) * (1.f - sg); e = lbv + (1.f - lbv) * sg; },
                        [&](int t, int cv) { return bf2f(P[(size_t)t * NIN1 + 1536 + cv]); }, W_OG, bid >> 2, bid & 3);
                }
#endif
#if !FAST_S5
                if (bid >= 8 && bid < 16) {
                    const int pair = (bid - 8) * 8 + (TIDX >> 6);
                    naive_s5_scan(P, INP(18), INP(19), INP(20), INP(21), INP(22), INP(23), INP(24), INP(25), W_YRW, W_YS5B, pair);
                }
#endif
            }
            SEAM(PH_SCAN1);
#if !FAST_HG
            if (IN(PH_FIN1)) { PHASE_BEGIN ph_fin1(W_OG, W_P, INP(29), W_YMIX); }
#endif
            SEAM(PH_FIN1);
#endif
            if (IN(PH_GLU1)) {
                PHASE_BEGIN
#if FAST_GEMM
                { pg8::Gemm g{W_YS5B, W_WGLU, T_, 512, 512}; pg8::StaticOrder S; S.init(T_, 512, (int)gridDim.x, (int)blockIdx.x); pg8::EpiGlu E{W_YRW, 512, INP(27), W_YMIX, D_};
                  pg8::gemm_phase<pg8::EpiGlu, pg8::StaticOrder, true, true>(lds, g, S, E); }
#else
                const float* W = INP(26); const float* gb = INP(27); const bf16_t* YS5B = W_YS5B; const float* YRW = W_YRW; bf16_t* Ymix = W_YMIX;
                naive_gemm<false>(ldsf, T_, 512, 512, [&](int m) { return YS5B + (size_t)m * 512; }, [&](int, int) { return W; }, 512,
                                  [&](int m, int n, float a, float) { const float y = YRW[(size_t)m * 512 + n]; Ymix[(size_t)m * D_ + n] = f2bf(y * sigm(a + gb[n])); });
#endif
            }
            SEAM(PH_GLU1);
    moe_layer<PLO, PHI, 1>(lds);
#undef IN
}
template <int PLO, int PHI>
__global__ void __launch_bounds__(NTHREADS, 2) mega(Args args) {
    extern __shared__ __attribute__((aligned(16))) unsigned char lds_raw[];
    mega_body<PLO, PHI>(lds_raw);
}

#include <utility>
template <int... I> static void set_attrs(std::integer_sequence<int, I...>) {
    (void)std::initializer_list<int>{ ((void)hipFuncSetAttribute((const void*)mega<I, I + 1>, hipFuncAttributeMaxDynamicSharedMemorySize, LDS_BYTES), 0)... };
}
#ifndef DUP_MASK
#define DUP_MASK 0ull
#endif
template <int I> static int launch_one(int grid, hipStream_t stream, const Args& a) {
    hipLaunchKernelGGL((mega<I, I + 1>), dim3(grid), dim3(NTHREADS), LDS_BYTES, stream, a);
    if ((DUP_MASK >> I) & 1ull) hipLaunchKernelGGL((mega<I, I + 1>), dim3(grid), dim3(NTHREADS), LDS_BYTES, stream, a);
    return 0;
}
template <int... I> static void launch_all(std::integer_sequence<int, I...>, int grid, hipStream_t stream, const Args& a) {
    (void)std::initializer_list<int>{ launch_one<I>(grid, stream, a)... };
}
extern "C" void kernel_launch(void* const* d_in, const int* in_sizes, int n_in, void* d_out, int out_size, void* d_ws, size_t ws_size, hipStream_t stream) {
    static int grid = 0;
    if (grid == 0) {
        if (n_in != 42 || out_size != T_ * D_ || ws_size < WS_END) { fprintf(stderr, "kernel_launch: unexpected shapes n_in %d out %d ws %zu\n", n_in, out_size, ws_size); grid = -1; return; }
        int dev = 0, cus = 0, per_cu = 0;
        hipGetDevice(&dev);
        hipDeviceGetAttribute(&cus, hipDeviceAttributeMultiprocessorCount, dev);
        set_attrs(std::make_integer_sequence<int, PH_COUNT>{});
        hipFuncSetAttribute((const void*)mega<0, PH_COUNT>, hipFuncAttributeMaxDynamicSharedMemorySize, LDS_BYTES);
        hipOccupancyMaxActiveBlocksPerMultiprocessor(&per_cu, (const void*)mega<0, PH_COUNT>, NTHREADS, LDS_BYTES);
        (void)hipGetLastError();
        if (per_cu < 1) per_cu = 1;
        grid = cus * 1;
        fprintf(stderr, "kernel_launch: cus %d per_cu %d grid %d\n", cus, per_cu, grid);
    }
    if (grid < 0) return;
    hipMemsetAsync((char*)d_ws + WS_CTL, 0, CTL_ZERO_BYTES, stream);
    Args a{};
    for (int i = 0; i < 42; ++i) a.in[i] = (const float*)d_in[i];
    a.out = (float*)d_out; a.ws = (unsigned char*)d_ws;
#if MK_SINGLE
    void* kargs[] = {(void*)&a};
    hipError_t e = hipLaunchCooperativeKernel((const void*)mega<0, PH_COUNT>, dim3(grid), dim3(NTHREADS), kargs, LDS_BYTES, stream);
    if (e != hipSuccess) fprintf(stderr, "cooperative launch failed: %s (grid %d)\n", hipGetErrorString(e), grid);
#else
    launch_all(std::make_integer_sequence<int, PH_COUNT>{}, grid, stream, a);
#endif
}
#ifdef TEST_RANGES
template __global__ void mega<0, 2>(Args);
template __global__ void mega<1, 3>(Args);
template __global__ void mega<1, 4>(Args);
template __global__ void mega<3, 8>(Args);
template __global__ void mega<7, 13>(Args);
template __global__ void mega<10, 12>(Args);
template __global__ void mega<13, 17>(Args);
template __global__ void mega<0, 13>(Args);
#endif
```

```cpp
#include <hip/hip_runtime.h>
#include <cstdio>
#include <cstdint>

#define GAS __attribute__((address_space(1)))
#define LAS __attribute__((address_space(3)))
typedef unsigned short bf16_t;
typedef float f32x4 __attribute__((ext_vector_type(4)));
typedef unsigned u32x4 __attribute__((ext_vector_type(4)));
typedef unsigned u32x2 __attribute__((ext_vector_type(2)));
__device__ __forceinline__ int launder_tid() { int t = (int)threadIdx.x; asm volatile("" : "+v"(t)); return t; }
#define TIDX launder_tid()

#ifndef FAST_GEMM
#define FAST_GEMM 1
#endif
#ifndef FAST_LN
#define FAST_LN 1
#endif
#ifndef FAST_RWKV
#define FAST_RWKV 2
#endif
#ifndef FAST_GLA0
#define FAST_GLA0 1
#endif
#ifndef FAST_HG
#define FAST_HG 1
#endif
#ifndef FAST_S5
#define FAST_S5 1
#endif
#ifndef MK_SINGLE
#define MK_SINGLE 1
#endif

constexpr int T_ = 16384, L_ = 8192, D_ = 1024;
constexpr int NIN0 = 3344, NIN0P = 3584, NIN1 = 2560;
constexpr int NLORA = 1536;
constexpr int RMAX = 40960;
constexpr int MOE_PAD = 256;
constexpr float DN_ALPHA = 1.41421356237f;
constexpr float LN_EPS = 1e-5f;
constexpr int NTHREADS = 512, NWAVES = 8;

constexpr size_t MiB = 1u << 20;
constexpr size_t WS_CTL = 0, CTL_ZERO_BYTES = 1 * MiB;
constexpr size_t WS_WIN0 = 2 * MiB;
constexpr size_t WS_WOUT0 = 9 * MiB;
constexpr size_t WS_WIN1 = 11 * MiB;
constexpr size_t WS_WOUT1 = 16 * MiB;
constexpr size_t WS_WGLU = 18 * MiB;
constexpr size_t WS_WLORA = 19 * MiB;
constexpr size_t WS_WROUTER = 19 * MiB + 786432;
constexpr size_t WS_W13 = 20 * MiB;
constexpr size_t WS_W2 = 84 * MiB;
constexpr size_t WS_HB = 116 * MiB;
constexpr size_t WS_HA = 149 * MiB;
constexpr size_t WS_ROUTE = 213 * MiB;
constexpr size_t WS_BIG = 214 * MiB;
constexpr size_t WS_P = WS_BIG;
constexpr size_t WS_LO = WS_BIG + 112 * MiB;
constexpr size_t WS_SCAN = WS_BIG + 160 * MiB;
constexpr size_t WS_GLALA = WS_BIG + 256 * MiB;
constexpr size_t WS_BON = WS_BIG + 272 * MiB;
constexpr size_t WS_APRIME = WS_BIG + 273 * MiB;
constexpr size_t WS_YS5B = WS_BIG + 80 * MiB;
constexpr size_t WS_XR = WS_BIG;
constexpr size_t WS_HID = WS_BIG + 80 * MiB;
constexpr size_t WS_Y = WS_BIG + 120 * MiB;
constexpr size_t WS_END = 512 * MiB;
constexpr int CW_BAR = 4096;
constexpr int CW_CNT = 8192;

__device__ __forceinline__ float bf2f(bf16_t b) { return __uint_as_float(((unsigned)b) << 16); }
__device__ __forceinline__ bf16_t f2bf(float f) { unsigned u = __float_as_uint(f); u += 0x7fffu + ((u >> 16) & 1u); return (bf16_t)(u >> 16); }
__device__ __forceinline__ unsigned pk2(float lo, float hi) { return (unsigned)f2bf(lo) | ((unsigned)f2bf(hi) << 16); }
__device__ __forceinline__ float sigm(float x) { return 1.f / (1.f + __expf(-x)); }
__device__ __forceinline__ float siluf(float x) { return x * sigm(x); }
__device__ __forceinline__ float softplusf(float x) { return fmaxf(x, 0.f) + log1pf(__expf(-fabsf(x))); }
__device__ __forceinline__ float gelu_tanh(float x) { const float u = 0.7978845608028654f * (x + 0.044715f * x * x * x); return 0.5f * x * (1.f + tanhf(u)); }
__device__ __forceinline__ float wave_sum(float v) {
#pragma unroll
    for (int o = 1; o < 64; o <<= 1) v += __shfl_xor(v, o);
    return v;
}


namespace pg8 {
#define PG8_LAS __attribute__((address_space(3)))
typedef unsigned short bf16_t;
typedef short bf16x8 __attribute__((ext_vector_type(8)));
typedef float f32x4 __attribute__((ext_vector_type(4)));
typedef unsigned u32x4 __attribute__((ext_vector_type(4)));
constexpr int BM = 256, BK = 64, HALF = 128, HTB = HALF * BK * 2  , STAGE_BYTES = 8 * HTB, NXCD = 8, WGM = 8;

__host__ __device__ __forceinline__ int lds_byte(int r, int c) { const int st = (r >> 4) * 2 + (c >> 5), rr = r & 15, cc = c & 31, ob = rr * 64 + cc * 2; return st * 1024 + (ob ^ (((ob >> 9) & 1) << 5)); }
__host__ __device__ __forceinline__ void stage_rc(int b, int& R, int& C) { const int st = b / 1024, sb = b % 1024, swz = sb ^ (((sb >> 9) & 1) << 5); R = (st >> 1) * 16 + swz / 64; C = (st & 1) * 32 + (swz % 64) / 2; }
__host__ __device__ __forceinline__ int perm32(int rho) { const int n = rho >> 4, i = rho & 15; return 8 * (i >> 2) + 4 * n + (i & 3); }

struct Unit { int pm, pn, pb; };
struct Gemm { const bf16_t* A; const bf16_t* Bt; int M, N, K, lda; };

struct StaticOrder {
    int nM, nN, nwg, G, c;
    __host__ __device__ void init(int M, int N, int G_, int c_) { nM = M / BM; nN = N / BM; nwg = nM * nN; G = G_; c = c_; }
    __host__ __device__ bool next(int i, Unit& u) const {
        const long L = (long)i * G + c; if (L >= nwg) return false;
        int wgid = (int)L; { const int q = nwg / NXCD, r = nwg % NXCD, xcd = wgid % NXCD, off = wgid / NXCD; wgid = (xcd < r ? xcd * (q + 1) : r * (q + 1) + (xcd - r) * q) + off; }
        const int nig = WGM * nN, gid = wgid / nig, fm = gid * WGM, gsz = (nM - fm) < WGM ? (nM - fm) : WGM;
        u.pm = fm + ((wgid % nig) % gsz); u.pn = (wgid % nig) / gsz; u.pb = u.pn; return true;
    }
    __device__ __forceinline__ void a_ready(const Unit&) const {}
    __device__ __forceinline__ void done(const Unit&) const {}
};

__device__ __forceinline__ unsigned cvt_pk_bf16(float lo, float hi) { unsigned r; asm volatile("v_cvt_pk_bf16_f32 %0, %1, %2" : "=v"(r) : "v"(lo), "v"(hi)); return r; }
typedef float f32x2 __attribute__((ext_vector_type(2)));

template <class Epi, class Sched, bool ALIGN_EPI = false, bool SP2 = false>
__device__ __forceinline__ void gemm_phase(PG8_LAS unsigned char* lds, const Gemm g, const Sched& S, const Epi& E) {
    const int tid = TIDX, wid = __builtin_amdgcn_readfirstlane(tid >> 6), lane = tid & 63, wr = wid >> 2, wc = wid & 3, fr = lane & 15, fq = lane >> 4;
    const int K = g.K, nt = K / BK, lda = g.lda ? g.lda : g.K;
    unsigned voffA[2], voffB[2];
#pragma unroll
    for (int i = 0; i < 2; ++i) { int R, C; stage_rc(tid * 16 + i * 8192, R, C); const int Rb = Epi::PERM ? ((R & ~31) + perm32(R & 31)) : R;
        voffA[i] = (unsigned)(R * lda + C) * 2u; voffB[i] = (unsigned)(Rb * K + C) * 2u; }
    const size_t kstep = (size_t)(BK * 2);
    const size_t hstep = (size_t)HALF * K * 2;
    const size_t tstep = 2 * hstep;
    const size_t hstepA = (size_t)HALF * lda * 2, tstepA = 2 * hstepA;
    const unsigned ldsw = (unsigned)wid * 1024u;
    const int aoff = lds_byte(wr * 64 + fr, fq * 8), boff = lds_byte(wc * 32 + fr, fq * 8);
#define PG8_SA(b, h) (((b) * 2 + (h)) * HTB)
#define PG8_SB(b, h) ((4 + (b) * 2 + (h)) * HTB)
#define PG8_STAGE(bufoff, gbase, voff) do { _Pragma("unroll") for (int _i = 0; _i < 2; ++_i) \
        __builtin_amdgcn_global_load_lds((const unsigned*)((const char*)(gbase) + (voff)[_i]), (PG8_LAS unsigned*)(lds + (bufoff) + ldsw + _i * 8192), 16, 0, 0); } while (0)
#define PG8_LDA(dst, b, h) do { _Pragma("unroll") for (int m = 0; m < 4; ++m) _Pragma("unroll") for (int k = 0; k < 2; ++k) dst[m][k] = *(const PG8_LAS bf16x8*)(lds + PG8_SA(b, h) + aoff + m * 2048 + k * 1024); } while (0)
#define PG8_LDB(dst, b, h) do { _Pragma("unroll") for (int n = 0; n < 2; ++n) _Pragma("unroll") for (int k = 0; k < 2; ++k) dst[n][k] = *(const PG8_LAS bf16x8*)(lds + PG8_SB(b, h) + boff + n * 2048 + k * 1024); } while (0)
#define PG8_MMA(ai, bj, At, Bt) do { __builtin_amdgcn_s_setprio(1); _Pragma("unroll") for (int m = 0; m < 4; ++m) _Pragma("unroll") for (int n = 0; n < 2; ++n) _Pragma("unroll") for (int k = 0; k < 2; ++k) \
        acc[ai][bj][m][n] = __builtin_amdgcn_mfma_f32_16x16x32_bf16(Bt[n][k], At[m][k], acc[ai][bj][m][n], 0, 0, 0); __builtin_amdgcn_s_setprio(0); } while (0)
#define PG8_WAIT_V(n) asm volatile("s_waitcnt vmcnt(" #n ")" ::: "memory")
#define PG8_WAIT_L(n) asm volatile("s_waitcnt lgkmcnt(" #n ")" ::: "memory")
#define PG8_BAR __builtin_amdgcn_s_barrier()
#define PG8_SCHED __builtin_amdgcn_sched_barrier(0)
    Unit cur, nxt; int ui = 0;
    if (!S.next(0, cur)) return;
    f32x4 acc[2][2][4][2];
#pragma unroll
    for (int a = 0; a < 2; ++a)
#pragma unroll
        for (int b = 0; b < 2; ++b)
#pragma unroll
            for (int m = 0; m < 4; ++m)
#pragma unroll
                for (int n = 0; n < 2; ++n) acc[a][b][m][n] = (f32x4){0.f, 0.f, 0.f, 0.f};
    bf16x8 At[4][2], B0[2][2], B1[2][2];
    const char* cA = (const char*)g.A + (size_t)cur.pm * tstepA; const char* cB = (const char*)g.Bt + (size_t)cur.pb * tstep;
    S.a_ready(cur);
    if constexpr (SP2) {
        PG8_STAGE(PG8_SB(0, 0), cB, voffB); PG8_STAGE(PG8_SB(0, 1), cB + hstep, voffB); PG8_STAGE(PG8_SA(0, 0), cA, voffA); PG8_STAGE(PG8_SA(0, 1), cA + hstepA, voffA);
        if (wr == 1) PG8_BAR;
        PG8_WAIT_V(2); PG8_BAR;
        PG8_STAGE(PG8_SB(1, 0), cB + kstep, voffB); PG8_STAGE(PG8_SA(1, 0), cA + kstep, voffA); PG8_STAGE(PG8_SB(1, 1), cB + hstep + kstep, voffB);
        PG8_WAIT_V(6); PG8_BAR;
    } else {
        PG8_STAGE(PG8_SB(0, 0), cB, voffB); PG8_STAGE(PG8_SA(0, 0), cA, voffA); PG8_STAGE(PG8_SB(0, 1), cB + hstep, voffB); PG8_STAGE(PG8_SA(0, 1), cA + hstepA, voffA);
        if (wr == 1) PG8_BAR;
        PG8_WAIT_V(4); PG8_BAR;
        PG8_STAGE(PG8_SB(1, 0), cB + kstep, voffB); PG8_STAGE(PG8_SA(1, 0), cA + kstep, voffA); PG8_STAGE(PG8_SB(1, 1), cB + hstep + kstep, voffB);
        PG8_WAIT_V(6); PG8_BAR;
    }
    for (;;) {
        const bool has_next = S.next(ui + 1, nxt);
        const char* nA = has_next ? (const char*)g.A + (size_t)nxt.pm * tstepA : cA; const char* nB = has_next ? (const char*)g.Bt + (size_t)nxt.pb * tstep : cB;
        for (int t = 0; t < nt; t += 2) {
            const bool last = (t == nt - 2);
            const char* a1 = cA + (size_t)(t + 1) * kstep;
            const char* a2 = last ? nA : cA + (size_t)(t + 2) * kstep; const char* b2 = last ? nB : cB + (size_t)(t + 2) * kstep;
            const char* a3 = a2 + kstep; const char* b3 = b2 + kstep;
            if (last && has_next) S.a_ready(nxt);
            if constexpr (SP2) {
            PG8_LDB(B0, 0, 0); PG8_LDB(B1, 0, 1); PG8_SCHED; PG8_LDA(At, 0, 0); PG8_STAGE(PG8_SA(1, 1), a1 + hstepA, voffA);
            PG8_WAIT_V(8); PG8_WAIT_L(0); PG8_BAR; PG8_MMA(0, 0, At, B0); PG8_MMA(0, 1, At, B1); PG8_BAR; PG8_SCHED;
            PG8_LDA(At, 0, 1); PG8_STAGE(PG8_SB(0, 0), b2, voffB); PG8_STAGE(PG8_SB(0, 1), b2 + hstep, voffB); PG8_STAGE(PG8_SA(0, 0), a2, voffA);
            PG8_WAIT_V(8); PG8_WAIT_L(0); PG8_BAR; PG8_MMA(1, 0, At, B0); PG8_MMA(1, 1, At, B1); PG8_BAR; PG8_SCHED;
            PG8_LDB(B0, 1, 0); PG8_LDB(B1, 1, 1); PG8_SCHED; PG8_LDA(At, 1, 0); PG8_STAGE(PG8_SA(0, 1), a2 + hstepA, voffA);
            PG8_WAIT_V(8); PG8_WAIT_L(0); PG8_BAR; PG8_MMA(0, 0, At, B0); PG8_MMA(0, 1, At, B1); PG8_BAR; PG8_SCHED;
            PG8_LDA(At, 1, 1); PG8_STAGE(PG8_SB(1, 0), b3, voffB); PG8_STAGE(PG8_SB(1, 1), b3 + hstep, voffB); PG8_STAGE(PG8_SA(1, 0), a3, voffA);
            PG8_WAIT_V(8); PG8_WAIT_L(0); PG8_BAR; PG8_MMA(1, 0, At, B0); PG8_MMA(1, 1, At, B1); PG8_BAR; PG8_SCHED;
            } else {
            PG8_LDB(B0, 0, 0); PG8_SCHED; PG8_LDA(At, 0, 0); PG8_STAGE(PG8_SA(1, 1), a1 + hstepA, voffA);
            PG8_WAIT_L(8); PG8_BAR; PG8_WAIT_L(0); PG8_MMA(0, 0, At, B0); PG8_BAR; PG8_SCHED;
            PG8_LDB(B1, 0, 1); PG8_STAGE(PG8_SB(0, 0), b2, voffB);
            PG8_BAR; PG8_WAIT_L(0); PG8_MMA(0, 1, At, B1); PG8_BAR;
            PG8_LDA(At, 0, 1); PG8_STAGE(PG8_SA(0, 0), a2, voffA);
            PG8_BAR; PG8_WAIT_L(0); PG8_MMA(1, 0, At, B0); PG8_BAR; PG8_SCHED;
            PG8_STAGE(PG8_SB(0, 1), b2 + hstep, voffB);
            PG8_WAIT_V(6); PG8_BAR; PG8_MMA(1, 1, At, B1); PG8_BAR;
            PG8_LDB(B0, 1, 0); PG8_SCHED; PG8_LDA(At, 1, 0); PG8_STAGE(PG8_SA(0, 1), a2 + hstepA, voffA);
            PG8_WAIT_L(8); PG8_BAR; PG8_WAIT_L(0); PG8_MMA(0, 0, At, B0); PG8_BAR; PG8_SCHED;
            PG8_LDB(B1, 1, 1); PG8_STAGE(PG8_SB(1, 0), b3, voffB);
            PG8_BAR; PG8_WAIT_L(0); PG8_MMA(0, 1, At, B1); PG8_BAR;
            PG8_LDA(At, 1, 1); PG8_STAGE(PG8_SA(1, 0), a3, voffA);
            PG8_BAR; PG8_WAIT_L(0); PG8_MMA(1, 0, At, B0); PG8_BAR; PG8_SCHED;
            PG8_STAGE(PG8_SB(1, 1), b3 + hstep, voffB);
            PG8_WAIT_V(6); PG8_BAR; PG8_MMA(1, 1, At, B1); PG8_BAR;
            }
        }
        if constexpr (ALIGN_EPI) { if (wr == 0) PG8_BAR; }
        if constexpr (!Epi::AFTER_DRAIN) { E(acc, cur, wr, wc, fr, fq); S.done(cur); }
        if (!has_next) break;
#pragma unroll
        for (int a = 0; a < 2; ++a)
#pragma unroll
            for (int b = 0; b < 2; ++b)
#pragma unroll
                for (int m = 0; m < 4; ++m)
#pragma unroll
                    for (int n = 0; n < 2; ++n) acc[a][b][m][n] = (f32x4){0.f, 0.f, 0.f, 0.f};
        cur = nxt; cA = nA; cB = nB; ++ui;
        if constexpr (ALIGN_EPI) { if (wr == 1) PG8_BAR; }
    }
    PG8_WAIT_V(0);
    if constexpr (!ALIGN_EPI) { if (wr == 0) PG8_BAR; }
    PG8_BAR;
    if constexpr (Epi::AFTER_DRAIN) { E.fused(acc, cur, wr, wc, fr, fq, lds, wid, lane); S.done(cur); }
#undef PG8_SA
#undef PG8_SB
#undef PG8_STAGE
#undef PG8_LDA
#undef PG8_LDB
#undef PG8_MMA
#undef PG8_WAIT_V
#undef PG8_WAIT_L
#undef PG8_BAR
#undef PG8_SCHED
}

struct EpiStoreBf16 {
    static constexpr bool PERM = true, AFTER_DRAIN = false;
    bf16_t* O; int ldc; int split_cols; size_t split_stride;
    __device__ __forceinline__ void operator()(const f32x4 (&acc)[2][2][4][2], const Unit& u, int wr, int wc, int fr, int fq) const {
        int colt = u.pn * BM; bf16_t* base = O;
        if (split_cols) { const int t = colt / split_cols; base += (size_t)t * split_stride; colt -= t * split_cols; }
        const int row0 = u.pm * BM + wr * 64 + fr, col0 = colt + wc * 32 + 8 * fq;
#pragma unroll
        for (int ai = 0; ai < 2; ++ai)
#pragma unroll
            for (int m = 0; m < 4; ++m) { bf16_t* rowp = base + (size_t)(row0 + ai * HALF + m * 16) * ldc + col0;
#pragma unroll
                for (int bj = 0; bj < 2; ++bj) { const f32x4 v0 = acc[ai][bj][m][0], v1 = acc[ai][bj][m][1];
                    u32x4 w; w.x = cvt_pk_bf16(v0[0], v0[1]); w.y = cvt_pk_bf16(v0[2], v0[3]); w.z = cvt_pk_bf16(v1[0], v1[1]); w.w = cvt_pk_bf16(v1[2], v1[3]);
                    *(u32x4*)(rowp + bj * HALF) = w; } }
    }
};
struct EpiResidF32 {
    static constexpr bool PERM = false, AFTER_DRAIN = false;
    const float* resid; float* out; int ldc; float alpha;
    __device__ __forceinline__ void operator()(const f32x4 (&acc)[2][2][4][2], const Unit& u, int wr, int wc, int fr, int fq) const {
        const int row0 = u.pm * BM + wr * 64 + fr, col0 = u.pn * BM + wc * 32 + 4 * fq;
#pragma unroll
        for (int ai = 0; ai < 2; ++ai)
#pragma unroll
            for (int m = 0; m < 4; ++m) { const size_t off = (size_t)(row0 + ai * HALF + m * 16) * ldc + col0;
#pragma unroll
                for (int bj = 0; bj < 2; ++bj)
#pragma unroll
                    for (int n = 0; n < 2; ++n) { const size_t o = off + bj * HALF + n * 16; *(f32x4*)(out + o) = *(const f32x4*)(resid + o) * alpha + acc[ai][bj][m][n]; } }
    }
};
__device__ __forceinline__ float fast_sigm(float x) { return __builtin_amdgcn_rcpf(1.f + __expf(-x)); }
struct EpiSwiglu {
    static constexpr bool PERM = true, AFTER_DRAIN = false;
    bf16_t* HID;
    __device__ __forceinline__ void operator()(const f32x4 (&acc)[2][2][4][2], const Unit& u, int wr, int wc, int fr, int fq) const {
        const int row0 = u.pm * BM + wr * 64 + fr, h0 = u.pn * 128 + wc * 16 + 4 * fq;
#pragma unroll
        for (int ai = 0; ai < 2; ++ai)
#pragma unroll
            for (int m = 0; m < 4; ++m) { bf16_t* rowp = HID + (size_t)(row0 + ai * HALF + m * 16) * 512 + h0;
#pragma unroll
                for (int bj = 0; bj < 2; ++bj) { const f32x4 a = acc[ai][bj][m][0], b = acc[ai][bj][m][1]; f32x4 h;
#pragma unroll
                    for (int j = 0; j < 4; ++j) h[j] = a[j] * fast_sigm(a[j]) * b[j];
                    typedef unsigned u32x2v __attribute__((ext_vector_type(2)));
                    u32x2v w; w.x = cvt_pk_bf16(h[0], h[1]); w.y = cvt_pk_bf16(h[2], h[3]);
                    *(u32x2v*)(rowp + bj * 64) = w; } }
    }
};
struct EpiGlu {
    static constexpr bool PERM = true, AFTER_DRAIN = false;
    const float* ysrc; int ldy; const float* bias; bf16_t* O; int ldc;
    __device__ __forceinline__ void operator()(const f32x4 (&acc)[2][2][4][2], const Unit& u, int wr, int wc, int fr, int fq) const {
        const int row0 = u.pm * BM + wr * 64 + fr, col0 = u.pn * BM + wc * 32 + 8 * fq;
#pragma unroll
        for (int ai = 0; ai < 2; ++ai)
#pragma unroll
            for (int m = 0; m < 4; ++m) { const int row = row0 + ai * HALF + m * 16;
#pragma unroll
                for (int bj = 0; bj < 2; ++bj) { const int col = col0 + bj * HALF;
                    const f32x4 y0 = *(const f32x4*)(ysrc + (size_t)row * ldy + col), y1 = *(const f32x4*)(ysrc + (size_t)row * ldy + col + 4);
                    const f32x4 b0 = *(const f32x4*)(bias + col), b1 = *(const f32x4*)(bias + col + 4);
                    f32x4 v0 = acc[ai][bj][m][0] + b0, v1 = acc[ai][bj][m][1] + b1;
#pragma unroll
                    for (int j = 0; j < 4; ++j) { v0[j] = y0[j] * fast_sigm(v0[j]); v1[j] = y1[j] * fast_sigm(v1[j]); }
                    u32x4 w; w.x = cvt_pk_bf16(v0[0], v0[1]); w.y = cvt_pk_bf16(v0[2], v0[3]); w.z = cvt_pk_bf16(v1[0], v1[1]); w.w = cvt_pk_bf16(v1[2], v1[3]);
                    *(u32x4*)(O + (size_t)row * ldc + col) = w; } }
    }
};
struct EpiStoreF32 {
    static constexpr bool PERM = false, AFTER_DRAIN = false;
    float* out; int ldc;
    __device__ __forceinline__ void operator()(const f32x4 (&acc)[2][2][4][2], const Unit& u, int wr, int wc, int fr, int fq) const {
        const int row0 = u.pm * BM + wr * 64 + fr, col0 = u.pn * BM + wc * 32 + 4 * fq;
#pragma unroll
        for (int ai = 0; ai < 2; ++ai)
#pragma unroll
            for (int m = 0; m < 4; ++m) { const size_t off = (size_t)(row0 + ai * HALF + m * 16) * ldc + col0;
#pragma unroll
                for (int bj = 0; bj < 2; ++bj)
#pragma unroll
                    for (int n = 0; n < 2; ++n) *(f32x4*)(out + off + bj * HALF + n * 16) = acc[ai][bj][m][n]; }
    }
};
struct EpiStoreF32Half {
    static constexpr bool PERM = false, AFTER_DRAIN = false;
    float* out;
    __device__ __forceinline__ void operator()(const f32x4 (&acc)[2][2][4][2], const Unit& u, int wr, int wc, int fr, int fq) const {
        const int row0 = u.pm * BM + wr * 64 + fr, col0 = wc * 32 + 4 * fq;
#pragma unroll
        for (int ai = 0; ai < 2; ++ai)
#pragma unroll
            for (int m = 0; m < 4; ++m) { const size_t off = (size_t)(row0 + ai * HALF + m * 16) * 128 + col0;
#pragma unroll
                for (int n = 0; n < 2; ++n) *(f32x4*)(out + off + n * 16) = acc[ai][0][m][n]; }
    }
};
struct EpiS5Y {
    static constexpr bool PERM = false, AFTER_DRAIN = false;
    const bf16_t* P1; const float* dvec; float* YS5; bf16_t* YS5B;
    __device__ __forceinline__ void operator()(const f32x4 (&acc)[2][2][4][2], const Unit& u, int wr, int wc, int fr, int fq) const {
        const int g = u.pm >> 1, ch = g * 16 + 4 * fq;
        const f32x4 dd = *(const f32x4*)(dvec + ch);
#pragma unroll
        for (int ai = 0; ai < 2; ++ai)
#pragma unroll
            for (int m = 0; m < 4; ++m) {
                const int bc = (u.pm & 1) * 256 + ai * HALF + wr * 64 + m * 16 + fr, b = bc >> 8, c32 = bc & 255;
#pragma unroll
                for (int bj = 0; bj < 2; ++bj)
#pragma unroll
                    for (int n = 0; n < 2; ++n) {
                        const int i = 16 * u.pn + 8 * bj + 2 * wc + n;
                        const size_t t = (size_t)b * 8192 + c32 * 32 + i;
                        typedef unsigned u32x2v __attribute__((ext_vector_type(2)));
                        const u32x2v uu = *(const u32x2v*)(P1 + t * 2560 + ch);
                        f32x4 uv; uv[0] = __uint_as_float(uu.x << 16); uv[1] = __uint_as_float(uu.x & 0xffff0000u); uv[2] = __uint_as_float(uu.y << 16); uv[3] = __uint_as_float(uu.y & 0xffff0000u);
                        f32x4 y = acc[ai][bj][m][n] + dd * uv;
#pragma unroll
                        for (int j = 0; j < 4; ++j) { const float x = y[j]; const float tt = 0.7978845608028654f * (x + 0.044715f * x * x * x); y[j] = 0.5f * x * (1.f + tanhf(tt)); }
                        *(f32x4*)(YS5 + t * 512 + ch) = y;
                        u32x2v w; w.x = cvt_pk_bf16(y[0], y[1]); w.y = cvt_pk_bf16(y[2], y[3]);
                        *(u32x2v*)(YS5B + t * 512 + ch) = w;
                    }
            }
    }
};
struct MoeOrder {
    int ntiles, nN, G, c; const PG8_LAS int* tile_e;
    __device__ __forceinline__ bool next(int i, Unit& u) const {
        const int L = i * G + c; if (L >= ntiles * nN) return false;
        u.pm = L / nN; u.pn = L % nN; u.pb = tile_e[u.pm] * nN + u.pn; return true;
    }
    __device__ __forceinline__ void a_ready(const Unit&) const {}
    __device__ __forceinline__ void done(const Unit&) const {}
};
}

#define XB_TMO      128
#define XB_XCNT(j)  (256  + 64 * (j))
#define XB_XSUB(j)  (1280 + 64 * (j))
#define XB_XGEN(j)  (2304 + 64 * (j))
#define XB_TOP      3328
#define XB_TOPGEN   3392
#define XCD_BAR_WORDS 3456
#define XB_SPIN_CAP (1u << 18)
__device__ __forceinline__ unsigned xb_ld(unsigned* p)              { return __hip_atomic_load(p, __ATOMIC_RELAXED, __HIP_MEMORY_SCOPE_AGENT); }
__device__ __forceinline__ unsigned xb_add(unsigned* p, unsigned v) { return __hip_atomic_fetch_add(p, v, __ATOMIC_RELAXED, __HIP_MEMORY_SCOPE_AGENT); }
__device__ __forceinline__ unsigned xb_xcc_id() { return (unsigned)__builtin_amdgcn_s_getreg((3 << 11) | 20) & 0xFu; }
#define XB_SPIN(cond, bar) do { unsigned _sp = 0; while (cond) { __builtin_amdgcn_s_sleep(1); \
    if ((++_sp & 255u) == 0u) { if (xb_ld(&(bar)[XB_TMO])) break; if (_sp > XB_SPIN_CAP) { atomicAdd(&(bar)[XB_TMO], 1u); break; } } } } while (0)
struct XcdBarrier { unsigned* bar; unsigned x; volatile LAS unsigned* st; };
__device__ __forceinline__ XcdBarrier xcd_barrier_post(unsigned* bar, volatile LAS unsigned* st) {
    XcdBarrier b; b.bar = bar; b.x = xb_xcc_id(); b.st = st;
    if (TIDX == 0) (void)xb_add(&bar[XB_XCNT(b.x)], 1u);
    return b;
}
__device__ __forceinline__ void xcd_barrier_complete(unsigned* bar, unsigned x, unsigned& nloc, unsigned& nx) {
    const unsigned G = gridDim.x;
    unsigned sum, cnt, mine, sp = 0u;
    for (;;) {
        sum = 0u; cnt = 0u; mine = 0u;
#pragma unroll
        for (unsigned j = 0; j < 16; ++j) { const unsigned c = xb_ld(&bar[XB_XCNT(j)]); sum += c; cnt += (c > 0u) ? 1u : 0u; mine = (j == x) ? c : mine; }
        if (sum == G) break;
        __builtin_amdgcn_s_sleep(1);
        if ((++sp & 255u) == 0u) { if (xb_ld(&bar[XB_TMO])) break; if (sp > XB_SPIN_CAP) { atomicAdd(&bar[XB_TMO], 1u); break; } }
    }
    nloc = mine > 0u ? mine : 1u; nx = cnt > 0u ? cnt : 1u;
}
__device__ __forceinline__ void xcd_barrier(const XcdBarrier& b) {
    asm volatile("s_waitcnt vmcnt(0)" ::: "memory");
    __syncthreads();
    if (TIDX == 0) {
        unsigned* bar = b.bar;
        __builtin_amdgcn_s_waitcnt(0);
        unsigned nloc = b.st[0], nx = b.st[1];
        if (nloc == 0u) { xcd_barrier_complete(bar, b.x, nloc, nx); b.st[0] = nloc; b.st[1] = nx; }
        const unsigned old = xb_add(&bar[XB_XSUB(b.x)], 1u);
        const unsigned gen = old / nloc;
        if (old + 1u == (gen + 1u) * nloc) {
            __builtin_amdgcn_fence(__ATOMIC_RELEASE, "agent");
            asm volatile("s_waitcnt vmcnt(0)" ::: "memory");
            const unsigned og = xb_add(&bar[XB_TOP], 1u);
            const unsigned tg = og / nx;
            if (og + 1u == (tg + 1u) * nx) xb_add(&bar[XB_TOPGEN], 1u);
            else XB_SPIN(xb_ld(&bar[XB_TOPGEN]) == tg, bar);
            __builtin_amdgcn_fence(__ATOMIC_ACQUIRE, "agent");
            xb_add(&bar[XB_XGEN(b.x)], 1u);
            asm volatile("s_waitcnt vmcnt(0)" ::: "memory");
        } else {
            XB_SPIN(xb_ld(&bar[XB_XGEN(b.x)]) == gen, bar);
            __builtin_amdgcn_fence(__ATOMIC_ACQUIRE, "agent");
            asm volatile("s_waitcnt vmcnt(0)" ::: "memory");
        }
    }
    __syncthreads();
}


typedef short bf16x8 __attribute__((ext_vector_type(8)));
__device__ __forceinline__ void unpack8f(const u32x4 v, float* f) {
    f[0] = __uint_as_float(v.x << 16); f[1] = __uint_as_float(v.x & 0xffff0000u); f[2] = __uint_as_float(v.y << 16); f[3] = __uint_as_float(v.y & 0xffff0000u);
    f[4] = __uint_as_float(v.z << 16); f[5] = __uint_as_float(v.z & 0xffff0000u); f[6] = __uint_as_float(v.w << 16); f[7] = __uint_as_float(v.w & 0xffff0000u);
}
__device__ __forceinline__ u32x4 pack8f(const float* f) { u32x4 o; o.x = pk2(f[0], f[1]); o.y = pk2(f[2], f[3]); o.z = pk2(f[4], f[5]); o.w = pk2(f[6], f[7]); return o; }
__device__ __forceinline__ void ld8bf(const bf16_t* p, float* f) { unpack8f(*(const u32x4*)p, f); }
__device__ __forceinline__ void ld8f(const float* p, float* f) { const f32x4 a = *(const f32x4*)p, b = *(const f32x4*)(p + 4); f[0] = a.x; f[1] = a.y; f[2] = a.z; f[3] = a.w; f[4] = b.x; f[5] = b.y; f[6] = b.z; f[7] = b.w; }
struct GlaBufs { bf16_t* QT; bf16_t* KT; bf16_t* KDT; bf16_t* VT; float* DG; void* DS; bf16_t* SP; };
__device__ __forceinline__ float logsigf(float x) { return fminf(x, 0.f) - log1pf(__expf(-fabsf(x))); }

template <int K, int LAYER>
__device__ __forceinline__ void gla_prep_tile(LAS float* lds, const bf16_t* P, const float* aux0, const float* aux1, const GlaBufs& B, int cg) {
    constexpr int HK = 4 * K, KP = K + 1;
    LAS float* G = lds;
    LAS float* KR = lds + 64 * KP;
    LAS float* LV = lds + 2 * 64 * KP;
    const int tid = TIDX, lane = tid & 63, wave = tid >> 6;
    const int t0 = cg * 64;
    LAS float* GL = lds + 2 * 64 * KP + 64 * 129;
    LAS float* GA = GL + 64 * 16;
    if (LAYER == 0) {
        for (int idx = tid; idx < 64 * 16; idx += NTHREADS) GL[idx] = bf2f(P[(size_t)(t0 + (idx >> 4)) * NIN0P + 2816 + (idx & 15)]);
        __syncthreads();
        const int ck = tid & 255, th = tid >> 8;
        float w2r[16];
#pragma unroll
        for (int i = 0; i < 16; ++i) w2r[i] = aux0[i * 256 + ck];
        const float gb = aux1[ck];
        for (int t = th * 32; t < th * 32 + 32; ++t) {
            float gk = gb;
#pragma unroll
            for (int i4 = 0; i4 < 4; ++i4) { const f32x4 x = *(const LAS f32x4*)(GL + t * 16 + 4 * i4); gk += x.x * w2r[4 * i4] + x.y * w2r[4 * i4 + 1] + x.z * w2r[4 * i4 + 2] + x.w * w2r[4 * i4 + 3]; }
            GA[t * 257 + ck] = logsigf(gk) * (1.f / 16.f);
        }
        __syncthreads();
    }
    constexpr int NCH = 64 * K / 8 / NTHREADS;
    for (int h = 0; h < 4; ++h) {
        float qv[NCH][8];
#pragma unroll
        for (int it = 0; it < NCH; ++it) {
            const int ch = tid + it * NTHREADS, t = ch / (K / 8), c8 = (ch % (K / 8)) * 8, ck = h * K + c8;
            float kr[8], g[8];
            if (LAYER == 0) {
                ld8bf(P + (size_t)(t0 + t) * NIN0P + 2048 + ck, kr);
                ld8bf(P + (size_t)(t0 + t) * NIN0P + 1792 + ck, qv[it]);
#pragma unroll
                for (int j = 0; j < 8; ++j) { g[j] = GA[t * 257 + ck + j]; qv[it][j] *= 0.125f; }
            } else {
                float f[8], l0[8], l1[8];
                ld8bf(P + (size_t)(t0 + t) * NIN1 + 1024 + ck, f);
                ld8bf(P + (size_t)(t0 + t) * NIN1 + 512 + ck, qv[it]);
                ld8f(aux0 + ck, l0); ld8f(aux0 + 512 + ck, l1);
#pragma unroll
                for (int j = 0; j < 8; ++j) {
                    const float lbv = 1.f / (1.f + __expf(l0[j] - l1[j]));
                    const float sg = sigm(f[j]);
                    g[j] = __logf(lbv + (1.f - lbv) * sg); kr[j] = (1.f - lbv) * (1.f - sg); qv[it][j] = siluf(qv[it][j]);
                }
            }
#pragma unroll
            for (int j = 0; j < 8; ++j) { G[t * KP + c8 + j] = g[j]; KR[t * KP + c8 + j] = kr[j]; }
        }
#pragma unroll
        for (int it = 0; it < 2; ++it) {
            const int ch = tid + it * NTHREADS, t = ch >> 4, v8 = (ch & 15) * 8;
            float vv[8];
            ld8bf(LAYER == 0 ? P + (size_t)(t0 + t) * NIN0P + 2304 + h * 128 + v8 : P + (size_t)(t0 + t) * NIN1 + 1536 + h * 128 + v8, vv);
#pragma unroll
            for (int j = 0; j < 8; ++j) LV[t * 129 + v8 + j] = vv[j];
        }
        __syncthreads();
        for (int k = wave; k < K; k += NWAVES) {
            float v = G[lane * KP + k];
#pragma unroll
            for (int o = 1; o < 64; o <<= 1) { const float n = __shfl_up(v, o); if (lane >= o) v += n; }
            G[lane * KP + k] = v;
        }
        __syncthreads();
#pragma unroll
        for (int it = 0; it < NCH; ++it) {
            const int ch = tid + it * NTHREADS, t = ch / (K / 8), c8 = (ch % (K / 8)) * 8, ck = h * K + c8;
            float qo[8], ko[8];
#pragma unroll
            for (int j = 0; j < 8; ++j) { const float b = G[t * KP + c8 + j]; qo[j] = qv[it][j] * __expf(b); ko[j] = KR[t * KP + c8 + j] * __expf(-b); }
            *(u32x4*)(B.QT + (size_t)(t0 + t) * HK + ck) = pack8f(qo);
            *(u32x4*)(B.KT + (size_t)(t0 + t) * HK + ck) = pack8f(ko);
        }
#pragma unroll
        for (int it = 0; it < NCH; ++it) {
            const int id = tid + it * NTHREADS, t8 = (id & 7) * 8, k = id >> 3;
            const float bl = G[63 * KP + k];
            float o[8];
#pragma unroll
            for (int j = 0; j < 8; ++j) o[j] = KR[(t8 + j) * KP + k] * __expf(bl - G[(t8 + j) * KP + k]);
            *(u32x4*)(B.KDT + ((size_t)cg * HK + h * K + k) * 64 + t8) = pack8f(o);
            if (t8 == 0) B.DG[(size_t)cg * HK + h * K + k] = __expf(bl);
        }
#pragma unroll
        for (int it = 0; it < 2; ++it) {
            const int id = tid + it * NTHREADS, t8 = (id & 7) * 8, vc = id >> 3;
            float o[8];
#pragma unroll
            for (int j = 0; j < 8; ++j) o[j] = LV[(t8 + j) * 129 + vc];
            *(u32x4*)(B.VT + ((size_t)cg * 512 + h * 128 + vc) * 64 + t8) = pack8f(o);
        }
        __syncthreads();
    }
}

template <int K, bool DSBF>
__device__ __forceinline__ void gla_pass1_unit(const GlaBufs& B, int unit, int lane) {
    constexpr int HK = 4 * K, KT16 = K / 16;
    const int item = unit / KT16, kt = unit % KT16, cg = item >> 2, h = item & 3;
    const int r = lane & 15, q = lane >> 4;
    const bf16_t* ap = B.KDT + ((size_t)cg * HK + h * K + kt * 16 + r) * 64 + 8 * q;
    const bf16x8 a0 = *(const bf16x8*)ap, a1 = *(const bf16x8*)(ap + 32);
    const size_t dso = ((size_t)item * 128 + r) * K + kt * 16 + 4 * q;
#pragma unroll
    for (int vt = 0; vt < 8; ++vt) {
        const bf16_t* bp = B.VT + ((size_t)cg * 512 + h * 128 + vt * 16 + r) * 64 + 8 * q;
        const bf16x8 b0 = *(const bf16x8*)bp, b1 = *(const bf16x8*)(bp + 32);
        f32x4 acc = {0.f, 0.f, 0.f, 0.f};
        acc = __builtin_amdgcn_mfma_f32_16x16x32_bf16(a0, b0, acc, 0, 0, 0);
        acc = __builtin_amdgcn_mfma_f32_16x16x32_bf16(a1, b1, acc, 0, 0, 0);
        if (DSBF) { u32x2 w; w.x = pk2(acc[0], acc[1]); w.y = pk2(acc[2], acc[3]); *(u32x2*)((bf16_t*)B.DS + dso + (size_t)vt * 16 * K) = w; }
        else *(f32x4*)((float*)B.DS + dso + (size_t)vt * 16 * K) = acc;
    }
}

template <int K, bool DSBF>
__device__ __forceinline__ void gla_pass2(const GlaBufs& B, int gthread, int gthreads) {
    constexpr int HK = 4 * K;
    const float* __restrict__ DSf = (const float*)B.DS; const bf16_t* __restrict__ DSb = (const bf16_t*)B.DS; const float* __restrict__ DG = B.DG; bf16_t* __restrict__ SP = B.SP;
    for (int e = gthread; e < 8 * 128 * K; e += gthreads) {
        const int k = e % K, v = (e / K) & 127, bh = e / (K * 128), b = bh >> 2, h = bh & 3;
        float S = 0.f;
#pragma unroll 8
        for (int c = 0; c < 128; ++c) {
            const int cg = b * 128 + c;
            const size_t idx = ((size_t)(cg * 4 + h) * 128 + v) * K + k;
            const float d = DG[(size_t)cg * HK + h * K + k], ds = DSBF ? bf2f(DSb[idx]) : DSf[idx];
            SP[idx] = f2bf(S);
            S = d * S + ds;
        }
    }
}

template <int K, int LAYER>
__device__ __forceinline__ void gla_pass3_item(LAS unsigned char* lds, const bf16_t* P, const float* norm_g, const GlaBufs& B, bf16_t* Ymix, int item) {
    constexpr int HK = 4 * K, KS = K / 32;
    LAS bf16_t* Ls = (LAS bf16_t*)lds;
    LAS float* Lo = (LAS float*)(lds + 64 * 72 * 2);
    const int tid = TIDX, lane = tid & 63, wave = tid >> 6, r = lane & 15, q = lane >> 4;
    const int cg = item >> 2, h = item & 3, t0 = cg * 64;
    const int it = wave >> 1, i0 = it * 16;
    bf16x8 qf[KS];
#pragma unroll
    for (int s = 0; s < KS; ++s) qf[s] = *(const bf16x8*)(B.QT + (size_t)(t0 + i0 + r) * HK + h * K + 32 * s + 8 * q);
#pragma unroll
    for (int jj2 = 0; jj2 < 2; ++jj2) {
        const int j0 = ((wave & 1) * 2 + jj2) * 16;
        f32x4 acc = {0.f, 0.f, 0.f, 0.f};
        if (j0 <= i0) {
#pragma unroll
            for (int s = 0; s < KS; ++s) {
                const bf16x8 kf = *(const bf16x8*)(B.KT + (size_t)(t0 + j0 + r) * HK + h * K + 32 * s + 8 * q);
                acc = __builtin_amdgcn_mfma_f32_16x16x32_bf16(kf, qf[s], acc, 0, 0, 0);
            }
        }
        const int i = i0 + r;
        u32x2 w;
        w.x = pk2((j0 + 4 * q + 0) <= i ? acc[0] : 0.f, (j0 + 4 * q + 1) <= i ? acc[1] : 0.f);
        w.y = pk2((j0 + 4 * q + 2) <= i ? acc[2] : 0.f, (j0 + 4 * q + 3) <= i ? acc[3] : 0.f);
        *(LAS u32x2*)(Ls + i * 72 + j0 + 4 * q) = w;
    }
    __syncthreads();
    const bf16x8 sf0 = *(const LAS bf16x8*)(Ls + (i0 + r) * 72 + 8 * q), sf1 = *(const LAS bf16x8*)(Ls + (i0 + r) * 72 + 32 + 8 * q);
#pragma unroll
    for (int vv = 0; vv < 4; ++vv) {
        const int v0 = ((wave & 1) * 4 + vv) * 16;
        f32x4 acc = {0.f, 0.f, 0.f, 0.f};
#pragma unroll
        for (int s = 0; s < KS; ++s) {
            const bf16x8 sp = *(const bf16x8*)(B.SP + ((size_t)item * 128 + v0 + r) * K + 32 * s + 8 * q);
            acc = __builtin_amdgcn_mfma_f32_16x16x32_bf16(sp, qf[s], acc, 0, 0, 0);
        }
        const bf16_t* vp = B.VT + ((size_t)cg * 512 + h * 128 + v0 + r) * 64 + 8 * q;
        const bf16x8 vf0 = *(const bf16x8*)vp, vf1 = *(const bf16x8*)(vp + 32);
        acc = __builtin_amdgcn_mfma_f32_16x16x32_bf16(vf0, sf0, acc, 0, 0, 0);
        acc = __builtin_amdgcn_mfma_f32_16x16x32_bf16(vf1, sf1, acc, 0, 0, 0);
        *(LAS f32x4*)(Lo + (i0 + r) * 132 + v0 + 4 * q) = acc;
    }
    __syncthreads();
#pragma unroll 2
    for (int rr = 0; rr < 8; ++rr) {
        const int i = wave * 8 + rr, t = t0 + i;
        const float o0 = Lo[i * 132 + lane], o1 = Lo[i * 132 + 64 + lane];
        const float ms = wave_sum(o0 * o0 + o1 * o1) * (1.f / 128.f);
        const float rs = rsqrtf(ms + LN_EPS);
        float g0, g1;
        if (LAYER == 0) { g0 = bf2f(P[(size_t)t * NIN0P + 2832 + h * 128 + lane]); g1 = bf2f(P[(size_t)t * NIN0P + 2832 + h * 128 + 64 + lane]); }
        else { g0 = bf2f(P[(size_t)t * NIN1 + 2048 + h * 128 + lane]); g1 = bf2f(P[(size_t)t * NIN1 + 2048 + h * 128 + 64 + lane]); }
        Ymix[(size_t)t * D_ + 512 + h * 128 + lane] = f2bf(o0 * rs * norm_g[lane] * siluf(g0));
        Ymix[(size_t)t * D_ + 512 + h * 128 + 64 + lane] = f2bf(o1 * rs * norm_g[64 + lane] * siluf(g1));
    }
    __syncthreads();
}


template <int CTRL> __device__ __forceinline__ float dppf(float x) { return __builtin_bit_cast(float, __builtin_amdgcn_mov_dpp(__builtin_bit_cast(int, x), CTRL, 0xf, 0xf, true)); }
__device__ __forceinline__ float reduce32(float x) {
    x += dppf<0xB1>(x);
    x += dppf<0x4E>(x);
    x += dppf<0x141>(x);
    x += dppf<0x140>(x);
    auto sw = __builtin_amdgcn_permlane16_swap(__float_as_uint(x), __float_as_uint(x), false, false);
    return __uint_as_float(sw[0]) + __uint_as_float(sw[1]);
}
__device__ __forceinline__ void rwkv_scan_v1(LAS float* lds, const bf16_t* SC, float* YRW, int unit) {
    constexpr int TS = 32, TILE = 5 * TS * 64 + TS * 16;
    const int bh = unit >> 3, qr = unit & 7, b = bh >> 3, h = bh & 7;
    const int tid = TIDX, lane = tid & 63, wave = tid >> 6, cp = lane & 31, rl = (wave & 3) * 2 + (lane >> 5);
    const size_t S1 = (size_t)T_ * 512;
    const int chunk = tid & 255, ls = chunk >> 3, lc0 = (chunk & 7) * 8, half = tid >> 8;
    const bf16_t* g0 = SC + (half == 0 ? 0 : 4 * S1) + (size_t)(b * L_ + ls) * 512 + h * 64 + lc0;
    const bf16_t* g1 = SC + (half == 0 ? 1 * S1 : 5 * S1) + (size_t)(b * L_ + ls) * 512 + h * 64 + lc0;
    const bf16_t* g2 = (half == 0) ? SC + 2 * S1 + (size_t)(b * L_ + ls) * 512 + h * 64 + lc0
                                   : SC + 3 * S1 + (size_t)(b * L_ + ls) * 512 + h * 64 + qr * 8;
    u32x4 p0, p1, p2;
    p0 = *(const u32x4*)g0; p1 = *(const u32x4*)g1; p2 = *(const u32x4*)g2;
    float S0 = 0.f, S1v = 0.f;
    auto unpack8 = [](const u32x4 v, float* f) {
        f[0] = __uint_as_float(v.x << 16); f[1] = __uint_as_float(v.x & 0xffff0000u); f[2] = __uint_as_float(v.y << 16); f[3] = __uint_as_float(v.y & 0xffff0000u);
        f[4] = __uint_as_float(v.z << 16); f[5] = __uint_as_float(v.z & 0xffff0000u); f[6] = __uint_as_float(v.w << 16); f[7] = __uint_as_float(v.w & 0xffff0000u); };
    auto stage = [&](LAS float* buf) {
        float f0[8], f1[8], f2[8];
        unpack8(p0, f0); unpack8(p1, f1); unpack8(p2, f2);
        if (half == 0) {
#pragma unroll
            for (int j = 0; j < 8; ++j) { buf[(4 * TS + ls) * 64 + lc0 + j] = f0[j]; buf[(1 * TS + ls) * 64 + lc0 + j] = __expf(f1[j]); buf[(3 * TS + ls) * 64 + lc0 + j] = f2[j]; }
        } else {
#pragma unroll
            for (int j = 0; j < 8; ++j) { buf[(0 * TS + ls) * 64 + lc0 + j] = -f0[j]; buf[(2 * TS + ls) * 64 + lc0 + j] = f0[j] * f1[j]; }
            if ((chunk & 7) == 0) {
#pragma unroll
                for (int j = 0; j < 8; ++j) buf[5 * TS * 64 + ls * 16 + j] = f2[j];
            }
        }
    };
    stage(lds);
    __syncthreads();
    for (int t0 = 0; t0 < L_; t0 += TS) {
        LAS float* cur = lds + ((t0 / TS) & 1) * TILE;
        LAS float* nxt = lds + (((t0 / TS) & 1) ^ 1) * TILE;
        const bool more = (t0 + TS) < L_;
        if (more) { const size_t adv = (size_t)(t0 + TS) * 512; p0 = *(const u32x4*)(g0 + adv); p1 = *(const u32x4*)(g1 + adv); p2 = *(const u32x4*)(g2 + adv); }
        float* yout = YRW + (size_t)(b * L_ + t0) * 512 + h * 64 + qr * 8 + rl;
        if (wave < 4) {
        typedef float f32x2v __attribute__((ext_vector_type(2)));
        f32x2v a2 = *(const LAS f32x2v*)(cur + (0 * TS) * 64 + 2 * cp), w2 = *(const LAS f32x2v*)(cur + (1 * TS) * 64 + 2 * cp), b2 = *(const LAS f32x2v*)(cur + (2 * TS) * 64 + 2 * cp),
               k2 = *(const LAS f32x2v*)(cur + (3 * TS) * 64 + 2 * cp), r2 = *(const LAS f32x2v*)(cur + (4 * TS) * 64 + 2 * cp);
        float vv = cur[5 * TS * 64 + rl];
        float ysel = 0.f;
#pragma unroll
        for (int s = 0; s < TS; ++s) {
            const int sn = (s + 1) & (TS - 1);
            const f32x2v a2n = *(const LAS f32x2v*)(cur + (0 * TS + sn) * 64 + 2 * cp), w2n = *(const LAS f32x2v*)(cur + (1 * TS + sn) * 64 + 2 * cp),
                         b2n = *(const LAS f32x2v*)(cur + (2 * TS + sn) * 64 + 2 * cp), k2n = *(const LAS f32x2v*)(cur + (3 * TS + sn) * 64 + 2 * cp),
                         r2n = *(const LAS f32x2v*)(cur + (4 * TS + sn) * 64 + 2 * cp);
            const float vvn = cur[5 * TS * 64 + sn * 16 + rl];
            const float sa = reduce32(S0 * a2.x + S1v * a2.y);
            S0 = S0 * w2.x + (sa * b2.x + vv * k2.x);
            S1v = S1v * w2.y + (sa * b2.y + vv * k2.y);
            const float y = reduce32(S0 * r2.x + S1v * r2.y);
            ysel = (cp == s) ? y : ysel;
            a2 = a2n; w2 = w2n; b2 = b2n; k2 = k2n; r2 = r2n; vv = vvn;
        }
        yout[(size_t)cp * 512] = ysel;
        }
        if (more) stage(nxt);
        __syncthreads();
    }
}


__device__ __forceinline__ bf16x8 ldfrag(const LAS bf16_t* tile, int row0, int ks, int r, int q) { return *(const LAS bf16x8*)(tile + (row0 + r) * 72 + 32 * ks + 8 * q); }
__device__ __forceinline__ f32x4 mm64(f32x4 acc, const LAS bf16_t* A, int arow0, const LAS bf16_t* B, int brow0, int r, int q) {
    acc = __builtin_amdgcn_mfma_f32_16x16x32_bf16(ldfrag(A, arow0, 0, r, q), ldfrag(B, brow0, 0, r, q), acc, 0, 0, 0);
    acc = __builtin_amdgcn_mfma_f32_16x16x32_bf16(ldfrag(A, arow0, 1, r, q), ldfrag(B, brow0, 1, r, q), acc, 0, 0, 0);
    return acc;
}
__device__ __forceinline__ void rwkv_chunk_pre(LAS unsigned char* lds, const bf16_t* SC, bf16_t* Gout, bf16_t* Rmout, float* HTout, bf16_t* Ymout, int item) {
    const int bh = item >> 7, chn = item & 127, b = bh >> 3, h = bh & 7;
    const size_t S1 = (size_t)T_ * 512, base = (size_t)(b * L_ + chn * 64) * 512 + h * 64;
    LAS bf16_t* TL = (LAS bf16_t*)lds;
#define RTILE(k) (TL + (k) * 4608)
    LAS float* F = (LAS float*)(lds + 12 * 9216);
    LAS float* LL = F + 64 * 68;
    const int tid = TIDX, lane = tid & 63, wave = tid >> 6, r = lane & 15, q = lane >> 4;
    const int t = tid >> 3, c0 = (tid & 7) * 8;
    float ldv[8];
    { const u32x4 v = *(const u32x4*)(SC + 1 * S1 + base + (size_t)t * 512 + c0); unpack8f(v, ldv);
#pragma unroll
      for (int j = 0; j < 8; ++j) F[t * 68 + c0 + j] = ldv[j]; }
    __syncthreads();
#pragma unroll
    for (int cc = 0; cc < 8; ++cc) {
        const int c = wave * 8 + cc;
        float v = F[lane * 68 + c];
#pragma unroll
        for (int o = 1; o < 64; o <<= 1) { const float n = __shfl_up(v, o); if (lane >= o) v += n; }
        F[lane * 68 + c] = v;
    }
    __syncthreads();
    {
        float rr[8], kp[8], vv[8], kk[8], aa[8];
        unpack8f(*(const u32x4*)(SC + 0 * S1 + base + (size_t)t * 512 + c0), rr);
        unpack8f(*(const u32x4*)(SC + 2 * S1 + base + (size_t)t * 512 + c0), kp);
        unpack8f(*(const u32x4*)(SC + 3 * S1 + base + (size_t)t * 512 + c0), vv);
        unpack8f(*(const u32x4*)(SC + 4 * S1 + base + (size_t)t * 512 + c0), kk);
        unpack8f(*(const u32x4*)(SC + 5 * S1 + base + (size_t)t * 512 + c0), aa);
        float at[8], rt[8], bt[8], kt[8];
#pragma unroll
        for (int j = 0; j < 8; ++j) {
            const float cs = F[t * 68 + c0 + j], last = __expf(F[63 * 68 + c0 + j]);
            const float Lt = __expf(cs), Ltm1 = __expf(cs - ldv[j]), inv = __expf(-cs);
            at[j] = -kk[j] * Ltm1; rt[j] = rr[j] * Lt; bt[j] = kk[j] * aa[j] * inv; kt[j] = kp[j] * inv;
            RTILE(4)[(c0 + j) * 72 + t] = f2bf(at[j]);
            RTILE(5)[(c0 + j) * 72 + t] = f2bf(bt[j] * last);
            RTILE(6)[(c0 + j) * 72 + t] = f2bf(kt[j] * last);
            RTILE(7)[(c0 + j) * 72 + t] = f2bf(vv[j]);
            if (t == 63) LL[c0 + j] = last;
        }
        *(LAS u32x4*)(RTILE(0) + t * 72 + c0) = pack8f(at);
        *(LAS u32x4*)(RTILE(1) + t * 72 + c0) = pack8f(bt);
        *(LAS u32x4*)(RTILE(2) + t * 72 + c0) = pack8f(kt);
        *(LAS u32x4*)(RTILE(3) + t * 72 + c0) = pack8f(rt);
    }
    __syncthreads();
    {
        const int mtx = wave >> 1;
        const LAS bf16_t* X = (mtx < 2) ? RTILE(0) : RTILE(3);
        const LAS bf16_t* Y = (mtx & 1) ? RTILE(2) : RTILE(1);
#pragma unroll
        for (int k8 = 0; k8 < 8; ++k8) {
            const int idx = (wave & 1) * 8 + k8, ti = idx >> 2, si = idx & 3;
            f32x4 acc = {0.f, 0.f, 0.f, 0.f};
            if (si <= ti) acc = mm64(acc, Y, si * 16, X, ti * 16, r, q);
            const int tt = ti * 16 + r, s0 = si * 16 + 4 * q;
#pragma unroll
            for (int jj = 0; jj < 4; ++jj) { const bool keep = (mtx < 2) ? (s0 + jj < tt) : (s0 + jj <= tt); acc[jj] = keep ? acc[jj] : 0.f; }
            if (mtx == 0) *(LAS f32x4*)(F + tt * 68 + s0) = acc;
            else { u32x2 w; w.x = pk2(acc[0], acc[1]); w.y = pk2(acc[2], acc[3]); *(LAS u32x2*)(RTILE(7 + mtx) + tt * 72 + s0) = w; }
        }
    }
    __syncthreads();
    if (wave == 0) {
        float X[64];
        int lz = lane; asm volatile("" : "+v"(lz));
        const LAS float* Fb = F; asm volatile("" : "+v"(Fb));
#pragma unroll
        for (int tt = 0; tt < 64; ++tt) {
            float acc = (tt == lz) ? 1.f : 0.f;
#pragma unroll
            for (int s4 = 0; s4 < (tt + 3) / 4; ++s4) {
                const f32x4 a = *(const LAS f32x4*)(Fb + tt * 68 + 4 * s4);
#pragma unroll
                for (int j = 0; j < 4; ++j) if (4 * s4 + j < tt) acc += a[j] * X[4 * s4 + j];
            }
            X[tt] = acc;
            RTILE(11)[tt * 72 + lz] = f2bf(acc);
        }
    } else {
        for (int idx = wave - 1; idx < 16; idx += 7) {
            const int vi = idx >> 2, ti = idx & 3;
            f32x4 acc = {0.f, 0.f, 0.f, 0.f};
            acc = mm64(acc, RTILE(8), ti * 16, RTILE(7), vi * 16, r, q);
            u32x2 w; w.x = pk2(acc[0], acc[1]); w.y = pk2(acc[2], acc[3]);
            *(LAS u32x2*)(RTILE(2) + (vi * 16 + r) * 72 + ti * 16 + 4 * q) = w;
        }
    }
    __syncthreads();
#pragma unroll
    for (int k = 0; k < 4; ++k) {
        const int idx = wave * 4 + k, which = idx >> 4, xi = (idx >> 2) & 3, ti = idx & 3;
        f32x4 acc = {0.f, 0.f, 0.f, 0.f};
        acc = mm64(acc, RTILE(11), ti * 16, which ? RTILE(2) : RTILE(4), xi * 16, r, q);
        u32x2 w; w.x = pk2(acc[0], acc[1]); w.y = pk2(acc[2], acc[3]);
        *(LAS u32x2*)((which ? RTILE(1) : RTILE(0)) + (xi * 16 + r) * 72 + ti * 16 + 4 * q) = w;
    }
    __syncthreads();
#pragma unroll
    for (int k = 0; k < 8; ++k) {
        const int idx = wave * 8 + k, which = idx >> 4, i1 = (idx >> 2) & 3, i2 = idx & 3;
        f32x4 acc = {0.f, 0.f, 0.f, 0.f};
        if (which == 0) {
            acc = mm64(acc, RTILE(0), i2 * 16, RTILE(9), i1 * 16, r, q);
            const int tt = i1 * 16 + r, cc = i2 * 16 + 4 * q;
            const u32x2 rv = *(const LAS u32x2*)(RTILE(3) + tt * 72 + cc);
            acc[0] += __uint_as_float(rv.x << 16); acc[1] += __uint_as_float(rv.x & 0xffff0000u); acc[2] += __uint_as_float(rv.y << 16); acc[3] += __uint_as_float(rv.y & 0xffff0000u);
            u32x2 w; w.x = pk2(acc[0], acc[1]); w.y = pk2(acc[2], acc[3]);
            *(u32x2*)(Rmout + (size_t)item * 4096 + tt * 64 + cc) = w;
        } else if (which == 1) {
            acc = mm64(acc, RTILE(9), i1 * 16, RTILE(1), i2 * 16, r, q);
            acc = mm64(acc, RTILE(10), i1 * 16, RTILE(7), i2 * 16, r, q);
            u32x2 w; w.x = pk2(acc[0], acc[1]); w.y = pk2(acc[2], acc[3]);
            *(u32x2*)(Ymout + (((size_t)item * 16 + i1 * 4 + i2) * 64 + lane) * 4) = w;
        } else if (which == 2) {
            acc = mm64(acc, RTILE(0), i2 * 16, RTILE(5), i1 * 16, r, q);
            const int c1 = i1 * 16 + r, c2 = i2 * 16 + 4 * q;
#pragma unroll
            for (int jj = 0; jj < 4; ++jj) if (c2 + jj == c1) acc[jj] += LL[c1];
            u32x2 w; w.x = pk2(acc[0], acc[1]); w.y = pk2(acc[2], acc[3]);
            *(u32x2*)(Gout + (size_t)item * 4096 + c1 * 64 + c2) = w;
        } else {
            acc = mm64(acc, RTILE(5), i1 * 16, RTILE(1), i2 * 16, r, q);
            acc = mm64(acc, RTILE(6), i1 * 16, RTILE(7), i2 * 16, r, q);
            *(f32x4*)(HTout + (((size_t)item * 16 + i1 * 4 + i2) * 64 + lane) * 4) = acc;
        }
    }
    __syncthreads();
#undef RTILE
}

__device__ __forceinline__ void rwkv_chunk_seq(LAS unsigned char* lds, const bf16_t* G, const bf16_t* Rm, const float* HT, const bf16_t* Ym, float* YRW, int bh) {
    const int b = bh >> 3, h = bh & 7;
    const int tid = TIDX, lane = tid & 63, wave = tid >> 6, r = lane & 15, q = lane >> 4;
    const int rt = wave >> 1, vi0 = (wave & 1) * 2;
    LAS bf16_t* Sb0 = (LAS bf16_t*)lds;
    f32x4 Sacc[2] = {{0.f, 0.f, 0.f, 0.f}, {0.f, 0.f, 0.f, 0.f}};
    size_t item = (size_t)bh * 128;
    auto fetch = [&](size_t it, bf16x8* rm, bf16x8* g, u32x2* ym, f32x4* ht) {
#pragma unroll
        for (int ks = 0; ks < 2; ++ks) {
            rm[ks] = *(const bf16x8*)(Rm + it * 4096 + (rt * 16 + r) * 64 + 32 * ks + 8 * q);
            g[ks] = *(const bf16x8*)(G + it * 4096 + (rt * 16 + r) * 64 + 32 * ks + 8 * q);
        }
#pragma unroll
        for (int k = 0; k < 2; ++k) {
            ym[k] = *(const u32x2*)(Ym + ((it * 16 + rt * 4 + vi0 + k) * 64 + lane) * 4);
            ht[k] = *(const f32x4*)(HT + ((it * 16 + rt * 4 + vi0 + k) * 64 + lane) * 4);
        }
    };
    constexpr int PF = 4;
    bf16x8 prm[PF][2], pg[PF][2]; u32x2 pym[PF][2]; f32x4 pht[PF][2];
#pragma unroll
    for (int u = 0; u < PF; ++u) fetch(item + u, prm[u], pg[u], pym[u], pht[u]);
    for (int ch0 = 0; ch0 < 128; ch0 += PF) {
#pragma unroll
        for (int u = 0; u < PF; ++u) {
            const int ch = ch0 + u;
            LAS bf16_t* Sb = Sb0 + (ch & 1) * 4608;
#pragma unroll
            for (int k = 0; k < 2; ++k) { u32x2 w; w.x = pk2(Sacc[k][0], Sacc[k][1]); w.y = pk2(Sacc[k][2], Sacc[k][3]); *(LAS u32x2*)(Sb + ((vi0 + k) * 16 + r) * 72 + rt * 16 + 4 * q) = w; }
            asm volatile("s_waitcnt lgkmcnt(0)" ::: "memory"); __builtin_amdgcn_s_barrier(); asm volatile("" ::: "memory");
            float* yb = YRW + (size_t)(b * L_ + ch * 64 + rt * 16 + 4 * q) * 512 + h * 64 + r;
#pragma unroll
            for (int k = 0; k < 2; ++k) {
                const bf16x8 s0 = ldfrag(Sb, (vi0 + k) * 16, 0, r, q), s1 = ldfrag(Sb, (vi0 + k) * 16, 1, r, q);
                f32x4 ya; ya[0] = __uint_as_float(pym[u][k].x << 16); ya[1] = __uint_as_float(pym[u][k].x & 0xffff0000u); ya[2] = __uint_as_float(pym[u][k].y << 16); ya[3] = __uint_as_float(pym[u][k].y & 0xffff0000u);
                ya = __builtin_amdgcn_mfma_f32_16x16x32_bf16(prm[u][0], s0, ya, 0, 0, 0);
                ya = __builtin_amdgcn_mfma_f32_16x16x32_bf16(prm[u][1], s1, ya, 0, 0, 0);
                f32x4 sa = pht[u][k];
                sa = __builtin_amdgcn_mfma_f32_16x16x32_bf16(pg[u][0], s0, sa, 0, 0, 0);
                sa = __builtin_amdgcn_mfma_f32_16x16x32_bf16(pg[u][1], s1, sa, 0, 0, 0);
                Sacc[k] = sa;
#pragma unroll
                for (int jj = 0; jj < 4; ++jj) yb[(size_t)jj * 512 + (vi0 + k) * 16] = ya[jj];
            }
            const int nch = ch + PF < 128 ? ch + PF : 127;
            fetch(item + nch, prm[u], pg[u], pym[u], pht[u]);
        }
    }
}


__device__ __forceinline__ void rwkv_chunk_seq2(LAS unsigned char* lds, const bf16_t* G, const bf16_t* Rm, const float* HT, const bf16_t* Ym, float* YRW, int unit) {
    constexpr int PF = 12;
    const int bh = unit >> 2, vq = unit & 3, b = bh >> 3, h = bh & 7;
    const int tid = TIDX, lane = tid & 63, wave = tid >> 6, r = lane & 15, q = lane >> 4;
    const int ti = wave & 3;
    LAS bf16_t* Sb0 = (LAS bf16_t*)lds;
    const size_t item0 = (size_t)bh * 128;
    if (wave < 4) {
        bf16x8 pa[PF][2]; u32x2 py[PF];
        const bf16_t* ra = Rm + item0 * 4096 + (ti * 16 + r) * 64 + 8 * q;
        const bf16_t* ya = Ym + ((item0 * 16 + ti * 4 + vq) * 64 + lane) * 4;
#pragma unroll
        for (int u = 0; u < PF; ++u) { pa[u][0] = *(const bf16x8*)(ra + (size_t)u * 4096); pa[u][1] = *(const bf16x8*)(ra + (size_t)u * 4096 + 32); py[u] = *(const u32x2*)(ya + (size_t)u * 4096); }
        for (int ch0 = 0; ch0 < 132; ch0 += PF) {
#pragma unroll
            for (int u = 0; u < PF; ++u) {
                const int ch = ch0 + u;
                if (ch < 128) {
                    const LAS bf16_t* Sb = Sb0 + (ch & 1) * 1152;
                    asm volatile("s_waitcnt lgkmcnt(0)" ::: "memory"); __builtin_amdgcn_s_barrier(); asm volatile("" ::: "memory");
                    const bf16x8 s0 = ldfrag(Sb, 0, 0, r, q), s1 = ldfrag(Sb, 0, 1, r, q);
                    f32x4 ya4; ya4[0] = __uint_as_float(py[u].x << 16); ya4[1] = __uint_as_float(py[u].x & 0xffff0000u); ya4[2] = __uint_as_float(py[u].y << 16); ya4[3] = __uint_as_float(py[u].y & 0xffff0000u);
                    ya4 = __builtin_amdgcn_mfma_f32_16x16x32_bf16(pa[u][0], s0, ya4, 0, 0, 0);
                    ya4 = __builtin_amdgcn_mfma_f32_16x16x32_bf16(pa[u][1], s1, ya4, 0, 0, 0);
                    float* yb = YRW + (size_t)(b * L_ + ch * 64 + ti * 16 + 4 * q) * 512 + h * 64 + vq * 16 + r;
#pragma unroll
                    for (int jj = 0; jj < 4; ++jj) yb[(size_t)jj * 512] = ya4[jj];
                    const int nch = ch + PF < 128 ? ch + PF : 127;
                    pa[u][0] = *(const bf16x8*)(ra + (size_t)nch * 4096); pa[u][1] = *(const bf16x8*)(ra + (size_t)nch * 4096 + 32); py[u] = *(const u32x2*)(ya + (size_t)nch * 4096);
                }
            }
        }
    } else {
        bf16x8 pa[PF][2]; f32x4 ph[PF];
        const bf16_t* ga = G + item0 * 4096 + (ti * 16 + r) * 64 + 8 * q;
        const float* ha = HT + ((item0 * 16 + ti * 4 + vq) * 64 + lane) * 4;
#pragma unroll
        for (int u = 0; u < PF; ++u) { pa[u][0] = *(const bf16x8*)(ga + (size_t)u * 4096); pa[u][1] = *(const bf16x8*)(ga + (size_t)u * 4096 + 32); ph[u] = *(const f32x4*)(ha + (size_t)u * 4096); }
        f32x4 Sacc = {0.f, 0.f, 0.f, 0.f};
        for (int ch0 = 0; ch0 < 132; ch0 += PF) {
#pragma unroll
            for (int u = 0; u < PF; ++u) {
                const int ch = ch0 + u;
                if (ch < 128) {
                    LAS bf16_t* Sb = Sb0 + (ch & 1) * 1152;
                    { u32x2 w; w.x = pk2(Sacc[0], Sacc[1]); w.y = pk2(Sacc[2], Sacc[3]); *(LAS u32x2*)(Sb + r * 72 + ti * 16 + 4 * q) = w; }
                    asm volatile("s_waitcnt lgkmcnt(0)" ::: "memory"); __builtin_amdgcn_s_barrier(); asm volatile("" ::: "memory");
                    const bf16x8 s0 = ldfrag(Sb, 0, 0, r, q), s1 = ldfrag(Sb, 0, 1, r, q);
                    f32x4 sa = ph[u];
                    sa = __builtin_amdgcn_mfma_f32_16x16x32_bf16(pa[u][0], s0, sa, 0, 0, 0);
                    sa = __builtin_amdgcn_mfma_f32_16x16x32_bf16(pa[u][1], s1, sa, 0, 0, 0);
                    Sacc = sa;
                    const int nch = ch + PF < 128 ? ch + PF : 127;
                    pa[u][0] = *(const bf16x8*)(ga + (size_t)nch * 4096); pa[u][1] = *(const bf16x8*)(ga + (size_t)nch * 4096 + 32); ph[u] = *(const f32x4*)(ha + (size_t)nch * 4096);
                }
            }
        }
    }
}

__device__ __forceinline__ void sub_barrier(unsigned* ctr, unsigned nblocks) {
    asm volatile("s_waitcnt vmcnt(0)" ::: "memory");
    __syncthreads();
    if (TIDX == 0) {
        __builtin_amdgcn_fence(__ATOMIC_RELEASE, "agent");
        asm volatile("s_waitcnt vmcnt(0)" ::: "memory");
        xb_add(ctr, 1u);
        unsigned sp = 0;
        while (xb_ld(ctr) < nblocks) { __builtin_amdgcn_s_sleep(2); if (++sp > (1u << 22)) break; }
        __builtin_amdgcn_fence(__ATOMIC_ACQUIRE, "agent");
        asm volatile("s_waitcnt vmcnt(0)" ::: "memory");
    }
    __syncthreads();
}


__device__ __forceinline__ void s5_tables(LAS float* lds, const float* a_re, const float* a_im, const float* log_dt, const float* b_re, const float* b_im,
                                          const float* c_re, const float* c_im, bf16_t* MB, bf16_t* WE, int g) {
    LAS float* pwr = lds;
    LAS float* pwi = pwr + 33 * 64;
    LAS float* zbr = pwi + 33 * 64;
    LAS float* zbi = zbr + 1024;
    LAS float* cr = zbi + 1024;
    LAS float* ci = cr + 1024;
    LAS float* kern = ci + 1024;
    const int tid = TIDX;
    const float dt = __expf(log_dt[g]);
    for (int idx = tid; idx < 33 * 64; idx += NTHREADS) {
        const int tau = idx >> 6, n = idx & 63;
        const float lam_re = fminf(a_re[g * 64 + n], -1e-4f), lam_im = a_im[g * 64 + n];
        const float m = __expf(lam_re * dt * (float)tau), ang = lam_im * dt * (float)tau;
        pwr[idx] = m * cosf(ang); pwi[idx] = m * sinf(ang);
    }
    for (int idx = tid; idx < 1024; idx += NTHREADS) {
        const int n = idx >> 4;
        const float lam_re = fminf(a_re[g * 64 + n], -1e-4f), lam_im = a_im[g * 64 + n];
        const float mag = __expf(lam_re * dt);
        const float ab_re = mag * cosf(lam_im * dt), ab_im = mag * sinf(lam_im * dt);
        const float den = lam_re * lam_re + lam_im * lam_im, num_re = ab_re - 1.f;
        const float z_re = (num_re * lam_re + ab_im * lam_im) / den, z_im = (ab_im * lam_re - num_re * lam_im) / den;
        const float br = b_re[(size_t)g * 1024 + idx], bi = b_im[(size_t)g * 1024 + idx];
        zbr[idx] = z_re * br - z_im * bi; zbi[idx] = z_re * bi + z_im * br;
        cr[idx] = c_re[(size_t)g * 1024 + idx]; ci[idx] = c_im[(size_t)g * 1024 + idx];
    }
    __syncthreads();
    {
        const int c = (tid >> 4) & 15, cp = tid & 15, th = tid >> 8;
        float acc[16];
#pragma unroll
        for (int i = 0; i < 16; ++i) acc[i] = 0.f;
        for (int n = 0; n < 64; ++n) {
            const float xr = cr[c * 64 + n], xi = ci[c * 64 + n], zr = zbr[n * 16 + cp], zi = zbi[n * 16 + cp];
            const float pr = xr * zr - xi * zi, pi = xr * zi + xi * zr;
#pragma unroll
            for (int i = 0; i < 16; ++i) acc[i] += pr * pwr[(th * 16 + i) * 64 + n] - pi * pwi[(th * 16 + i) * 64 + n];
        }
#pragma unroll
        for (int i = 0; i < 16; ++i) kern[((th * 16 + i) * 16 + c) * 16 + cp] = acc[i];
    }
    __syncthreads();
    {
        const int row = tid, i = row >> 4, c = row & 15;
        bf16_t* dst = MB + ((size_t)g * 512 + row) * 640;
        for (int ch = 0; ch < 64; ++ch) {
            const int j = ch >> 1, cp0 = (ch & 1) * 8;
            float v[8];
            if (j <= i) { const f32x4 a = *(const LAS f32x4*)(kern + ((i - j) * 16 + c) * 16 + cp0), b = *(const LAS f32x4*)(kern + ((i - j) * 16 + c) * 16 + cp0 + 4);
                          v[0] = a.x; v[1] = a.y; v[2] = a.z; v[3] = a.w; v[4] = b.x; v[5] = b.y; v[6] = b.z; v[7] = b.w; }
            else {
#pragma unroll
                for (int k = 0; k < 8; ++k) v[k] = 0.f; }
            *(u32x4*)(dst + ch * 8) = pack8f(v);
        }
        for (int ch = 0; ch < 16; ++ch) {
            const int n0 = (ch & 7) * 8; const bool im = ch >= 8;
            float v[8];
#pragma unroll
            for (int k = 0; k < 8; ++k) {
                const float xr = cr[c * 64 + n0 + k], xi = ci[c * 64 + n0 + k], pr = pwr[(i + 1) * 64 + n0 + k], pi = pwi[(i + 1) * 64 + n0 + k];
                v[k] = im ? -(xr * pi + xi * pr) : (xr * pr - xi * pi);
            }
            *(u32x4*)(dst + 512 + ch * 8) = pack8f(v);
        }
    }
    {
        const int np = tid >> 1, hf = tid & 1, n = np & 63;
        bf16_t* dst = WE + ((size_t)g * 256 + np) * 512 + hf * 256;
        for (int ch = 0; ch < 32; ++ch) {
            const int col = hf * 256 + ch * 8, j = col >> 4, cp0 = col & 15;
            float v[8];
            if (np < 128) {
                const float pr = pwr[(31 - j) * 64 + n], pi = pwi[(31 - j) * 64 + n];
#pragma unroll
                for (int k = 0; k < 8; ++k) { const float zr = zbr[n * 16 + cp0 + k], zi = zbi[n * 16 + cp0 + k]; v[k] = np < 64 ? (pr * zr - pi * zi) : (pr * zi + pi * zr); }
            } else {
#pragma unroll
                for (int k = 0; k < 8; ++k) v[k] = 0.f; }
            *(u32x4*)(dst + ch * 8) = pack8f(v);
        }
    }
    __syncthreads();
}
__device__ __forceinline__ void s5_fill_ua(const bf16_t* P1, bf16_t* UA, int gw, int ngw, int lane) {
    for (int t = gw; t < T_; t += ngw) {
        const int b = t >> 13, tt = t & 8191, c32 = tt >> 5, j = tt & 31, g = lane >> 1, c0 = (lane & 1) * 8;
        const u32x4 v = *(const u32x4*)(P1 + (size_t)t * NIN1 + 8 * lane);
        *(u32x4*)(UA + ((size_t)g * 512 + b * 256 + c32) * 640 + j * 16 + c0) = v;
    }
}
__device__ __forceinline__ void s5_carry(const float* a_re, const float* a_im, const float* log_dt, const float* E, bf16_t* UA, int th) {
    const int n = th & 63, g = (th >> 6) & 31, b = th >> 11;
    const float lam_re = fminf(a_re[g * 64 + n], -1e-4f), lam_im = a_im[g * 64 + n];
    const float dt = __expf(log_dt[g]);
    const float m = __expf(lam_re * dt * 32.f), ang = lam_im * dt * 32.f;
    const float ar = m * cosf(ang), ai = m * sinf(ang);
    float hr = 0.f, hi = 0.f;
#pragma unroll 8
    for (int c = 0; c < 256; ++c) {
        const size_t row = (size_t)g * 512 + b * 256 + c;
        const float er = E[row * 128 + n], ei = E[row * 128 + 64 + n];
        UA[row * 640 + 512 + n] = f2bf(hr); UA[row * 640 + 576 + n] = f2bf(hi);
        const float nr = ar * hr - ai * hi + er, ni = ar * hi + ai * hr + ei;
        hr = nr; hi = ni;
    }
}

struct Args {
    const float* in[42];
    float* out;
    unsigned char* ws;
    int ph_lo, ph_hi;
};

template <bool DUAL, class AF, class WF, class EF>
__device__ __forceinline__ void naive_gemm(LAS float* lds, int M, int N, int K, AF arow, WF wbase, int ldw, EF epi) {
    LAS float* As = lds;
    LAS float* Bs = lds + 64 * 33;
    LAS float* Bs2 = Bs + 32 * 64;
    const int tid = TIDX, ty = tid >> 4, tx = tid & 15;
    const int tm = (M + 63) / 64, tn = (N + 63) / 64;
    for (int tile = blockIdx.x; tile < tm * tn; tile += gridDim.x) {
        const int m0 = (tile / tn) * 64, n0 = (tile % tn) * 64;
        const float* W = wbase(m0, 0);
        const float* W2 = DUAL ? wbase(m0, 1) : W;
        float acc[2][4], acc2[2][4];
#pragma unroll
        for (int i = 0; i < 2; ++i)
#pragma unroll
            for (int j = 0; j < 4; ++j) { acc[i][j] = 0.f; acc2[i][j] = 0.f; }
        for (int k0 = 0; k0 < K; k0 += 32) {
#pragma unroll
            for (int i = 0; i < 4; ++i) {
                const int idx = tid + i * 512, r = idx >> 5, kk = idx & 31, m = m0 + r;
                As[r * 33 + kk] = (m < M) ? bf2f(arow(m)[k0 + kk]) : 0.f;
            }
#pragma unroll
            for (int i = 0; i < 4; ++i) {
                const int idx = tid + i * 512, kk = idx >> 6, n = idx & 63;
                const bool ok = (n0 + n) < N;
                Bs[kk * 64 + n] = ok ? W[(size_t)(k0 + kk) * ldw + n0 + n] : 0.f;
                if (DUAL) Bs2[kk * 64 + n] = ok ? W2[(size_t)(k0 + kk) * ldw + n0 + n] : 0.f;
            }
            __syncthreads();
#pragma unroll 8
            for (int kk = 0; kk < 32; ++kk) {
                const float a0 = As[(ty * 2) * 33 + kk], a1 = As[(ty * 2 + 1) * 33 + kk];
#pragma unroll
                for (int j = 0; j < 4; ++j) {
                    const float b = Bs[kk * 64 + tx * 4 + j];
                    acc[0][j] += a0 * b; acc[1][j] += a1 * b;
                    if (DUAL) { const float b2 = Bs2[kk * 64 + tx * 4 + j]; acc2[0][j] += a0 * b2; acc2[1][j] += a1 * b2; }
                }
            }
            __syncthreads();
        }
#pragma unroll
        for (int i = 0; i < 2; ++i)
#pragma unroll
            for (int j = 0; j < 4; ++j) {
                const int m = m0 + ty * 2 + i, n = n0 + tx * 4 + j;
                if (m < M && n < N) epi(m, n, acc[i][j], acc2[i][j]);
            }
    }
}

template <class SRC, class DROW>
__device__ __forceinline__ void xpose_item(SRC src, DROW drow, bf16_t* WT, int ldk, LAS float* scr, int k0, int n0, int lane) {
#pragma unroll 8
    for (int i = 0; i < 32; ++i) { const int kk = 2 * i + (lane >> 5); scr[kk * 33 + (lane & 31)] = src(k0 + kk, n0 + (lane & 31)); }
    asm volatile("s_waitcnt lgkmcnt(0)" ::: "memory");
    const int c = lane & 7;
#pragma unroll
    for (int j = 0; j < 4; ++j) {
        const int n = (lane >> 3) + 8 * j; const LAS float* sp = scr + (8 * c) * 33 + n;
        u32x4 o; o.x = pk2(sp[0 * 33], sp[1 * 33]); o.y = pk2(sp[2 * 33], sp[3 * 33]); o.z = pk2(sp[4 * 33], sp[5 * 33]); o.w = pk2(sp[6 * 33], sp[7 * 33]);
        *(u32x4*)(WT + (size_t)drow(n0 + n) * ldk + k0 + 8 * c) = o;
    }
    asm volatile("s_waitcnt lgkmcnt(0)" ::: "memory");
}
template <class SRC4, class DROW>
__device__ __forceinline__ void xpose_item4(SRC4 src, DROW drow, bf16_t* WT, int ldk, LAS float* scr, int k0, int n0, int lane) {
    f32x4 v[8];
#pragma unroll
    for (int i = 0; i < 8; ++i) v[i] = src(k0 + 8 * i + (lane >> 3), n0 + 4 * (lane & 7));
#pragma unroll
    for (int i = 0; i < 8; ++i) { LAS float* d = scr + (8 * i + (lane >> 3)) * 33 + 4 * (lane & 7); d[0] = v[i].x; d[1] = v[i].y; d[2] = v[i].z; d[3] = v[i].w; }
    asm volatile("s_waitcnt lgkmcnt(0)" ::: "memory");
    const int c = lane & 7;
#pragma unroll
    for (int j = 0; j < 4; ++j) {
        const int n = (lane >> 3) + 8 * j; const LAS float* sp = scr + (8 * c) * 33 + n;
        u32x4 o; o.x = pk2(sp[0 * 33], sp[1 * 33]); o.y = pk2(sp[2 * 33], sp[3 * 33]); o.z = pk2(sp[4 * 33], sp[5 * 33]); o.w = pk2(sp[6 * 33], sp[7 * 33]);
        *(u32x4*)(WT + (size_t)drow(n0 + n) * ldk + k0 + 8 * c) = o;
    }
    asm volatile("s_waitcnt lgkmcnt(0)" ::: "memory");
}
__device__ __forceinline__ void convert_plain(const float* W, int K, int N, int NP, bf16_t* WT, LAS float* scr, int gw, int ngw, int lane) {
    const int nblk = NP / 32, nitems = (K / 64) * nblk;
    for (int it = gw; it < nitems; it += ngw) {
        const int k0 = 64 * (it / nblk), n0 = 32 * (it % nblk);
        xpose_item4([&](int k, int n4) { return n4 < N ? *(const f32x4*)(W + (size_t)k * N + n4) : (f32x4){0.f, 0.f, 0.f, 0.f}; }, [&](int n) { return n; }, WT, K, scr, k0, n0, lane);
    }
}
__device__ __forceinline__ void convert_lora(const float* w2, const float* a2, const float* g2, bf16_t* WT, LAS float* scr, int gw, int ngw, int lane) {
    const int nblk = NLORA / 32, nitems = 4 * nblk;
    for (int it = gw; it < nitems; it += ngw) {
        const int k0 = 64 * (it / nblk), n0 = 32 * (it % nblk);
        xpose_item([&](int k, int n) {
            if (n < 512) return k < 64 ? w2[k * 512 + n] : 0.f;
            if (n < 1024) return (k >= 64 && k < 128) ? a2[(k - 64) * 512 + (n - 512)] : 0.f;
            return k >= 128 ? g2[(k - 128) * 512 + (n - 1024)] : 0.f; }, [&](int n) { return n; }, WT, 256, scr, k0, n0, lane);
    }
}
__device__ __forceinline__ void convert_moe(const float* w1, const float* w3, const float* w2, bf16_t* W13, bf16_t* W2T, LAS float* scr, int gw, int ngw, int lane) {
    constexpr int I13 = 16 * 32, I2 = 8 * 32, IE = I13 + I2;
    for (int it = gw; it < 32 * IE; it += ngw) {
        const int e = it / IE, r = it % IE;
        if (r < I13) {
            const int k0 = 64 * (r / 32), n0 = 32 * (r % 32);
            const float* a = w1 + (size_t)e * D_ * 512; const float* b = w3 + (size_t)e * D_ * 512;
            xpose_item4([&](int k, int n4) { return n4 < 512 ? *(const f32x4*)(a + (size_t)k * 512 + n4) : *(const f32x4*)(b + (size_t)k * 512 + (n4 - 512)); },
                       [&](int n) { const int c = n & 511; return (c >> 2) * 8 + (n >> 9) * 4 + (c & 3); }, W13 + (size_t)e * 1024 * 1024, 1024, scr, k0, n0, lane);
        } else {
            const int rr = r - I13, k0 = 64 * (rr / 32), n0 = 32 * (rr % 32);
            const float* a = w2 + (size_t)e * 512 * D_;
            xpose_item4([&](int k, int n4) { return *(const f32x4*)(a + (size_t)k * D_ + n4); }, [&](int n) { return n; }, W2T + (size_t)e * 1024 * 512, 512, scr, k0, n0, lane);
        }
    }
}

__device__ __forceinline__ void ph_prologue(const float* x, bf16_t* hb) {
    const size_t n4 = (size_t)T_ * D_ / 4;
    for (size_t i = (size_t)blockIdx.x * NTHREADS + TIDX; i < n4; i += (size_t)gridDim.x * NTHREADS) {
        const f32x4 v = ((const f32x4*)x)[i];
        u32x2 o; o.x = pk2(v.x, v.y); o.y = pk2(v.z, v.w);
        ((u32x2*)hb)[i] = o;
    }
    for (size_t i = (size_t)blockIdx.x * NTHREADS + TIDX; i < (size_t)256 * D_ / 2; i += (size_t)gridDim.x * NTHREADS)
        ((unsigned*)(hb + (size_t)T_ * D_))[i] = 0u;
}

__device__ __forceinline__ float p0_shift(const bf16_t* P, const float* mu, int t, int c) {
    const float p = bf2f(P[(size_t)t * NIN0P + c]);
    const float pv = ((t & (L_ - 1)) == 0) ? 0.f : bf2f(P[(size_t)(t - 1) * NIN0P + c]);
    return p + mu[c] * (pv - p);
}
template <bool WITH_GLA>
__device__ __forceinline__ void ph_prepA0(const bf16_t* P, const float* mu, const float* gk_w2, const float* gk_b, bf16_t* Ap, float* gla_la) {
    for (int chunk = blockIdx.x; chunk < T_ / 64; chunk += gridDim.x) {
        for (int idx = TIDX; idx < 64 * 256; idx += NTHREADS) {
            const int tl = idx >> 8, j = idx & 255, t = chunk * 64 + tl;
            float v;
            if (j < 64) v = tanhf(p0_shift(P, mu, t, 512 + j));
            else if (j < 128) v = p0_shift(P, mu, t, 1600 + (j - 64));
            else v = sigm(p0_shift(P, mu, t, 1664 + (j - 128)));
            Ap[(size_t)t * 256 + j] = f2bf(v);
            if (WITH_GLA) {
                float gk = gk_b[j];
#pragma unroll
                for (int i = 0; i < 16; ++i) gk += bf2f(P[(size_t)t * NIN0P + 2816 + i]) * gk_w2[i * 256 + j];
                const float ls = fminf(gk, 0.f) - log1pf(__expf(-fabsf(gk)));
                gla_la[(size_t)t * 256 + j] = ls * (1.f / 16.f);
            }
        }
    }
}

__device__ __forceinline__ void ph_prepB0(const bf16_t* P, const bf16_t* LO, const float* mu, const float* w0, const float* a0, const float* k_k, const float* k_a,
                                          const float* r_k, bf16_t* SC, float* BON) {
    const int wave = TIDX >> 6, lane = TIDX & 63;
    for (int item = blockIdx.x * NWAVES + wave; item < T_ * 8; item += gridDim.x * NWAVES) {
        const int t = item >> 3, h = item & 7, c = h * 64 + lane;
        const float r = p0_shift(P, mu, t, c), k = p0_shift(P, mu, t, 576 + c), v = p0_shift(P, mu, t, 1088 + c);
        const float low = bf2f(LO[(size_t)t * 512 + c]), loa = bf2f(LO[(size_t)T_ * 512 + (size_t)t * 512 + c]);
        const float xw = w0[c] + low;
        const float wraw = -softplusf(-xw) - 0.5f;
        const float ld = -__expf(wraw);
        const float a = sigm(a0[c] + loa);
        const float kkr = k * k_k[c];
        const float ss = wave_sum(kkr * kkr);
        const float kk = kkr / fmaxf(sqrtf(ss), 1e-12f);
        const float kp = k * (1.f + (a - 1.f) * k_a[c]);
        const float bon = wave_sum(r * kp * r_k[c]);
        const size_t o = (size_t)t * 512 + c, S1 = (size_t)T_ * 512;
        SC[o] = f2bf(r); SC[S1 + o] = f2bf(ld); SC[2 * S1 + o] = f2bf(kp); SC[3 * S1 + o] = f2bf(v); SC[4 * S1 + o] = f2bf(kk); SC[5 * S1 + o] = f2bf(a);
        if (lane == 0) BON[(size_t)t * 8 + h] = bon;
    }
}

__device__ __forceinline__ void naive_rwkv_scan(LAS float* lds, const bf16_t* SC, float* YRW, int bh) {
    constexpr int TS = 32;
    const int b = bh >> 3, h = bh & 7;
    LAS float* Lnkk = lds;
    LAS float* Ldec = lds + TS * 64;
    LAS float* Lab = lds + 2 * TS * 64;
    LAS float* Lkp = lds + 3 * TS * 64;
    LAS float* Lr = lds + 4 * TS * 64;
    LAS float* Lv = lds + 5 * TS * 64;
    const size_t S1 = (size_t)T_ * 512;
    float S[64];
#pragma unroll
    for (int k = 0; k < 64; ++k) S[k] = 0.f;
    const int lane = TIDX & 63, wave = TIDX >> 6;
    for (int t0 = 0; t0 < L_; t0 += TS) {
        for (int idx = TIDX; idx < TS * 64; idx += NTHREADS) {
            const int s = idx >> 6, k = idx & 63;
            const size_t o = (size_t)(b * L_ + t0 + s) * 512 + h * 64 + k;
            const float r = bf2f(SC[o]), ld = bf2f(SC[S1 + o]), kp = bf2f(SC[2 * S1 + o]), v = bf2f(SC[3 * S1 + o]), kk = bf2f(SC[4 * S1 + o]), a = bf2f(SC[5 * S1 + o]);
            Lnkk[idx] = -kk; Ldec[idx] = __expf(ld); Lab[idx] = kk * a; Lkp[idx] = kp; Lr[idx] = r; Lv[idx] = v;
        }
        __syncthreads();
        if (wave == 0) {
            for (int s = 0; s < TS; ++s) {
                float sa = 0.f;
#pragma unroll
                for (int k = 0; k < 64; ++k) sa += S[k] * Lnkk[s * 64 + k];
                const float vv = Lv[s * 64 + lane];
                float y = 0.f;
#pragma unroll
                for (int k = 0; k < 64; ++k) {
                    S[k] = S[k] * Ldec[s * 64 + k] + sa * Lab[s * 64 + k] + vv * Lkp[s * 64 + k];
                    y += S[k] * Lr[s * 64 + k];
                }
                YRW[(size_t)(b * L_ + t0 + s) * 512 + h * 64 + lane] = y;
            }
        }
        __syncthreads();
    }
}

template <int K, class LDF, class LVF>
__device__ __forceinline__ void naive_gla_scan(LAS float* lds, LDF ld, LVF lv, float* OG, int b, int h) {
    constexpr int TS = 16;
    LAS float* Lq = lds;
    LAS float* Lk = lds + TS * K;
    LAS float* Le = lds + 2 * TS * K;
    LAS float* Lv = lds + 3 * TS * K;
    float S[K];
#pragma unroll
    for (int k = 0; k < K; ++k) S[k] = 0.f;
    const int tid = TIDX;
    for (int t0 = 0; t0 < L_; t0 += TS) {
        for (int idx = tid; idx < TS * K; idx += NTHREADS) {
            const int s = idx / K, k = idx % K;
            float q, kk, e; ld(b * L_ + t0 + s, h * K + k, q, kk, e);
            Lq[idx] = q; Lk[idx] = kk; Le[idx] = e;
        }
        for (int idx = tid; idx < TS * 128; idx += NTHREADS) {
            const int s = idx >> 7, vc = idx & 127;
            Lv[idx] = lv(b * L_ + t0 + s, h * 128 + vc);
        }
        __syncthreads();
        if (tid < 128) {
            for (int s = 0; s < TS; ++s) {
                const float vv = Lv[s * 128 + tid];
                float o = 0.f;
#pragma unroll
                for (int k = 0; k < K; ++k) {
                    S[k] = S[k] * Le[s * K + k] + Lk[s * K + k] * vv;
                    o += Lq[s * K + k] * S[k];
                }
                OG[(size_t)(b * L_ + t0 + s) * 512 + h * 128 + tid] = o;
            }
        }
        __syncthreads();
    }
}

template <bool WITH_GLA>
__device__ __forceinline__ void ph_fin0(const float* YRW, const float* OG, const bf16_t* P, const bf16_t* LO, const bf16_t* SC, const float* BON,
                                        const float* gn_g, const float* gn_b, const float* norm_g, bf16_t* Ymix) {
    const int wave = TIDX >> 6, lane = TIDX & 63;
    const size_t S1 = (size_t)T_ * 512;
    constexpr int NU = WITH_GLA ? 12 : 8;
    for (int item = blockIdx.x * NWAVES + wave; item < T_ * NU; item += gridDim.x * NWAVES) {
        const int t = item / NU, u = item % NU;
        if (u < 8) {
            const int c = u * 64 + lane;
            const float y = YRW[(size_t)t * 512 + c];
            const float mean = wave_sum(y) * (1.f / 64.f);
            const float d = y - mean;
            const float var = wave_sum(d * d) * (1.f / 64.f);
            const float yn = d * rsqrtf(var + 64e-5f) * gn_g[c] + gn_b[c];
            const float v = bf2f(SC[3 * S1 + (size_t)t * 512 + c]);
            const float g = bf2f(LO[(size_t)2 * T_ * 512 + (size_t)t * 512 + c]);
            Ymix[(size_t)t * D_ + c] = f2bf((yn + BON[(size_t)t * 8 + u] * v) * g);
        } else {
            const int h = u - 8;
            const float o0 = OG[(size_t)t * 512 + h * 128 + lane], o1 = OG[(size_t)t * 512 + h * 128 + 64 + lane];
            const float ms = wave_sum(o0 * o0 + o1 * o1) * (1.f / 128.f);
            const float rs = rsqrtf(ms + LN_EPS);
            const float g0 = bf2f(P[(size_t)t * NIN0P + 2832 + h * 128 + lane]), g1 = bf2f(P[(size_t)t * NIN0P + 2832 + h * 128 + 64 + lane]);
            Ymix[(size_t)t * D_ + 512 + h * 128 + lane] = f2bf(o0 * rs * norm_g[lane] * siluf(g0));
            Ymix[(size_t)t * D_ + 512 + h * 128 + 64 + lane] = f2bf(o1 * rs * norm_g[64 + lane] * siluf(g1));
        }
    }
}

__device__ __forceinline__ void ph_ln_router(const float* src, float* hf, bf16_t* hb, const float* lg, const float* lb, const float* wg, const float* bg,
                                             const float* we, const float* be, int* tok_e, int* tok_slot, float* tok_g, unsigned* cnt) {
    const int wave = TIDX >> 6, lane = TIDX & 63;
    for (int t = blockIdx.x * NWAVES + wave; t < T_; t += gridDim.x * NWAVES) {
        const f32x4* xr = (const f32x4*)(src + (size_t)t * D_) + lane;
        f32x4 v[4]; float s = 0.f;
#pragma unroll
        for (int j = 0; j < 4; ++j) { v[j] = xr[64 * j]; s += (v[j].x + v[j].y) + (v[j].z + v[j].w); }
        const float mean = wave_sum(s) * (1.f / D_);
        float s2 = 0.f;
#pragma unroll
        for (int j = 0; j < 4; ++j) { v[j] = v[j] - mean; s2 += (v[j].x * v[j].x + v[j].y * v[j].y) + (v[j].z * v[j].z + v[j].w * v[j].w); }
        const float rstd = rsqrtf(wave_sum(s2) * (1.f / D_) + LN_EPS);
#pragma unroll
        for (int j = 0; j < 4; ++j) {
            const f32x4 g = ((const f32x4*)lg)[lane + 64 * j], bb = ((const f32x4*)lb)[lane + 64 * j];
            v[j] = v[j] * rstd * g + bb;
            ((f32x4*)(hf + (size_t)t * D_))[lane + 64 * j] = v[j];
            u32x2 o; o.x = pk2(v[j].x, v[j].y); o.y = pk2(v[j].z, v[j].w);
            ((u32x2*)(hb + (size_t)t * D_))[lane + 64 * j] = o;
        }
        float cl[4] = {0.f, 0.f, 0.f, 0.f};
#pragma unroll
        for (int j = 0; j < 4; ++j)
#pragma unroll
            for (int e = 0; e < 4; ++e) {
                const int d = 4 * (lane + 64 * j) + e;
                const f32x4 w = *(const f32x4*)(wg + (size_t)d * 4);
                const float xv = v[j][e];
                cl[0] += xv * w.x; cl[1] += xv * w.y; cl[2] += xv * w.z; cl[3] += xv * w.w;
            }
#pragma unroll
        for (int g = 0; g < 4; ++g) cl[g] = wave_sum(cl[g]) + bg[g];
        int grp = 0; float mx = cl[0];
#pragma unroll
        for (int g = 1; g < 4; ++g) if (cl[g] > mx) { mx = cl[g]; grp = g; }
        float den = 0.f;
#pragma unroll
        for (int g = 0; g < 4; ++g) den += __expf(cl[g] - mx);
        const float p_grp = 1.f / den;
        float fl[8];
#pragma unroll
        for (int e = 0; e < 8; ++e) fl[e] = 0.f;
        const float* weg = we + (size_t)grp * D_ * 8;
#pragma unroll
        for (int j = 0; j < 4; ++j)
#pragma unroll
            for (int e = 0; e < 4; ++e) {
                const int d = 4 * (lane + 64 * j) + e;
                const f32x4 w0 = *(const f32x4*)(weg + (size_t)d * 8), w1 = *(const f32x4*)(weg + (size_t)d * 8 + 4);
                const float xv = v[j][e];
                fl[0] += xv * w0.x; fl[1] += xv * w0.y; fl[2] += xv * w0.z; fl[3] += xv * w0.w;
                fl[4] += xv * w1.x; fl[5] += xv * w1.y; fl[6] += xv * w1.z; fl[7] += xv * w1.w;
            }
#pragma unroll
        for (int e = 0; e < 8; ++e) fl[e] = wave_sum(fl[e]) + be[grp * 8 + e];
        int j0 = 0; float m0 = fl[0];
#pragma unroll
        for (int e = 1; e < 8; ++e) if (fl[e] > m0) { m0 = fl[e]; j0 = e; }
        int j1 = -1; float m1 = -3.0e38f;
#pragma unroll
        for (int e = 0; e < 8; ++e) if (e != j0 && fl[e] > m1) { m1 = fl[e]; j1 = e; }
        const float e1 = __expf(m1 - m0);
        const float g0 = p_grp / (1.f + e1), g1 = p_grp * e1 / (1.f + e1);
        if (lane == 0) {
            const int ex0 = grp * 8 + j0, ex1 = grp * 8 + j1;
            const unsigned s0 = atomicAdd(&cnt[ex0], 1u), s1 = atomicAdd(&cnt[ex1], 1u);
            tok_e[2 * t] = ex0; tok_e[2 * t + 1] = ex1;
            tok_slot[2 * t] = (int)s0; tok_slot[2 * t + 1] = (int)s1;
            tok_g[2 * t] = g0; tok_g[2 * t + 1] = g1;
        }
    }
}


__device__ __forceinline__ void shift8(const bf16_t* P, const float* mu, int t, int c, float* out) {
    float p[8], pv[8], m[8];
    ld8bf(P + (size_t)t * NIN0P + c, p); ld8f(mu + c, m);
    if ((t & (L_ - 1)) == 0) {
#pragma unroll
        for (int j = 0; j < 8; ++j) pv[j] = 0.f;
    } else ld8bf(P + (size_t)(t - 1) * NIN0P + c, pv);
#pragma unroll
    for (int j = 0; j < 8; ++j) out[j] = p[j] + m[j] * (pv[j] - p[j]);
}
__device__ __forceinline__ void ph_prepA0v(const bf16_t* P, const float* mu, bf16_t* Ap) {
    const int tid = TIDX, wave = tid >> 6, lane = tid & 63, l5 = lane & 31;
    for (int tp = blockIdx.x * NWAVES + wave; tp < T_ / 2; tp += gridDim.x * NWAVES) {
        const int t = tp * 2 + (lane >> 5), j0 = l5 * 8;
        const int c = j0 < 64 ? 512 + j0 : (j0 < 128 ? 1600 + (j0 - 64) : 1664 + (j0 - 128));
        float x[8]; shift8(P, mu, t, c, x);
#pragma unroll
        for (int j = 0; j < 8; ++j) x[j] = j0 < 64 ? tanhf(x[j]) : (j0 < 128 ? x[j] : sigm(x[j]));
        *(u32x4*)(Ap + (size_t)t * 256 + j0) = pack8f(x);
    }
}
__device__ __forceinline__ float sum8lanes(float v) { v += __shfl_xor(v, 1); v += __shfl_xor(v, 2); v += __shfl_xor(v, 4); return v; }
__device__ __forceinline__ void ph_prepB0v(const bf16_t* P, const bf16_t* LO, const float* mu, const float* w0, const float* a0, const float* k_k, const float* k_a,
                                           const float* r_k, bf16_t* SC, float* BON) {
    const int tid = TIDX, wave = tid >> 6, lane = tid & 63, c0 = lane * 8;
    const size_t S1 = (size_t)T_ * 512;
    for (int t = blockIdx.x * NWAVES + wave; t < T_; t += gridDim.x * NWAVES) {
        float r[8], k[8], v[8], low[8], loa[8], pw0[8], pa0[8], pkk[8], pka[8], prk[8];
        shift8(P, mu, t, c0, r); shift8(P, mu, t, 576 + c0, k); shift8(P, mu, t, 1088 + c0, v);
        ld8bf(LO + (size_t)t * 512 + c0, low); ld8bf(LO + S1 + (size_t)t * 512 + c0, loa);
        ld8f(w0 + c0, pw0); ld8f(a0 + c0, pa0); ld8f(k_k + c0, pkk); ld8f(k_a + c0, pka); ld8f(r_k + c0, prk);
        float ld[8], a[8], kkr[8], kp[8], ss = 0.f, bon = 0.f;
#pragma unroll
        for (int j = 0; j < 8; ++j) {
            const float xw = pw0[j] + low[j];
            const float wraw = -softplusf(-xw) - 0.5f;
            ld[j] = -__expf(wraw);
            a[j] = sigm(pa0[j] + loa[j]);
            kkr[j] = k[j] * pkk[j]; ss += kkr[j] * kkr[j];
            kp[j] = k[j] * (1.f + (a[j] - 1.f) * pka[j]);
            bon += r[j] * kp[j] * prk[j];
        }
        ss = sum8lanes(ss); bon = sum8lanes(bon);
        const float inv = 1.f / fmaxf(sqrtf(ss), 1e-12f);
#pragma unroll
        for (int j = 0; j < 8; ++j) kkr[j] *= inv;
        const size_t o = (size_t)t * 512 + c0;
        *(u32x4*)(SC + o) = pack8f(r); *(u32x4*)(SC + S1 + o) = pack8f(ld); *(u32x4*)(SC + 2 * S1 + o) = pack8f(kp);
        *(u32x4*)(SC + 3 * S1 + o) = pack8f(v); *(u32x4*)(SC + 4 * S1 + o) = pack8f(kkr); *(u32x4*)(SC + 5 * S1 + o) = pack8f(a);
        if ((lane & 7) == 0) BON[(size_t)t * 8 + (lane >> 3)] = bon;
    }
}
__device__ __forceinline__ void ph_fin0v(const float* YRW, const bf16_t* LO, const bf16_t* SC, const float* BON, const float* gn_g, const float* gn_b, bf16_t* Ymix) {
    const int tid = TIDX, wave = tid >> 6, lane = tid & 63, c0 = lane * 8;
    const size_t S1 = (size_t)T_ * 512;
    for (int t = blockIdx.x * NWAVES + wave; t < T_; t += gridDim.x * NWAVES) {
        float y[8], v[8], g[8], gg[8], gb[8];
        ld8f(YRW + (size_t)t * 512 + c0, y); ld8bf(SC + 3 * S1 + (size_t)t * 512 + c0, v); ld8bf(LO + 2 * S1 + (size_t)t * 512 + c0, g);
        ld8f(gn_g + c0, gg); ld8f(gn_b + c0, gb);
        const float bon = BON[(size_t)t * 8 + (lane >> 3)];
        float sm = 0.f;
#pragma unroll
        for (int j = 0; j < 8; ++j) sm += y[j];
        const float mean = sum8lanes(sm) * (1.f / 64.f);
        float sq = 0.f;
#pragma unroll
        for (int j = 0; j < 8; ++j) { y[j] -= mean; sq += y[j] * y[j]; }
        const float rs = rsqrtf(sum8lanes(sq) * (1.f / 64.f) + 64e-5f);
        float o[8];
#pragma unroll
        for (int j = 0; j < 8; ++j) o[j] = (y[j] * rs * gg[j] + gb[j] + bon * v[j]) * g[j];
        *(u32x4*)(Ymix + (size_t)t * D_ + c0) = pack8f(o);
    }
}

__device__ __forceinline__ void ph_ln_router2(LAS unsigned char* lds, const float* src, float* hf, bf16_t* hb, const float* lg, const float* lb, const bf16_t* WrT, const float* bg, const float* be,
                                              int* tok_e, int* tok_slot, float* tok_g, unsigned* cnt) {
    LAS bf16_t* LW = (LAS bf16_t*)lds;
    LAS float* LGall = (LAS float*)(lds + 48 * 1032 * 2);
    const int tid = TIDX, wave = tid >> 6, lane = tid & 63, r = lane & 15, q = lane >> 4;
    for (int i = tid; i < 48 * 128; i += NTHREADS) { const int row = i >> 7, c8 = (i & 127) * 8; *(LAS u32x4*)(LW + row * 1032 + c8) = *(const u32x4*)(WrT + (size_t)row * 1024 + c8); }
    for (int rb = blockIdx.x; rb < T_ / 64; rb += gridDim.x) {
        for (int i = 0; i < 8; ++i) {
            const int t = rb * 64 + wave * 8 + i;
            const f32x4* xr = (const f32x4*)(src + (size_t)t * D_) + lane;
            f32x4 v[4]; float sm = 0.f;
#pragma unroll
            for (int j = 0; j < 4; ++j) { v[j] = xr[64 * j]; sm += (v[j].x + v[j].y) + (v[j].z + v[j].w); }
            const float mean = wave_sum(sm) * (1.f / D_);
            float s2 = 0.f;
#pragma unroll
            for (int j = 0; j < 4; ++j) { v[j] = v[j] - mean; s2 += (v[j].x * v[j].x + v[j].y * v[j].y) + (v[j].z * v[j].z + v[j].w * v[j].w); }
            const float rstd = rsqrtf(wave_sum(s2) * (1.f / D_) + LN_EPS);
#pragma unroll
            for (int j = 0; j < 4; ++j) {
                const f32x4 g = ((const f32x4*)lg)[lane + 64 * j], bb = ((const f32x4*)lb)[lane + 64 * j];
                v[j] = v[j] * rstd * g + bb;
                ((f32x4*)(hf + (size_t)t * D_))[lane + 64 * j] = v[j];
                u32x2 o; o.x = pk2(v[j].x, v[j].y); o.y = pk2(v[j].z, v[j].w);
                ((u32x2*)(hb + (size_t)t * D_))[lane + 64 * j] = o;
            }
        }
        asm volatile("s_waitcnt vmcnt(0)" ::: "memory");
        __syncthreads();
        if (wave < 4) {
            const bf16_t* arow = hb + (size_t)(rb * 64 + wave * 16 + r) * D_ + 8 * q;
            f32x4 acc[3] = {{0.f, 0.f, 0.f, 0.f}, {0.f, 0.f, 0.f, 0.f}, {0.f, 0.f, 0.f, 0.f}};
#pragma unroll 8
            for (int ks = 0; ks < 32; ++ks) {
                const bf16x8 af = *(const bf16x8*)(arow + 32 * ks);
#pragma unroll
                for (int ct = 0; ct < 3; ++ct) {
                    const bf16x8 bfr = *(const LAS bf16x8*)(LW + (ct * 16 + r) * 1032 + 32 * ks + 8 * q);
                    acc[ct] = __builtin_amdgcn_mfma_f32_16x16x32_bf16(af, bfr, acc[ct], 0, 0, 0);
                }
            }
            LAS float* LG = LGall + wave * (16 * 49);
#pragma unroll
            for (int ct = 0; ct < 3; ++ct)
#pragma unroll
                for (int j = 0; j < 4; ++j) LG[(4 * q + j) * 49 + ct * 16 + r] = acc[ct][j];
            asm volatile("s_waitcnt lgkmcnt(0)" ::: "memory");
            if (lane < 16) {
                const int t = rb * 64 + wave * 16 + lane;
                const LAS float* L = LG + lane * 49;
                float cl[4];
#pragma unroll
                for (int g = 0; g < 4; ++g) cl[g] = L[g] + bg[g];
                int grp = 0; float mx = cl[0];
#pragma unroll
                for (int g = 1; g < 4; ++g) if (cl[g] > mx) { mx = cl[g]; grp = g; }
                float den = 0.f;
#pragma unroll
                for (int g = 0; g < 4; ++g) den += __expf(cl[g] - mx);
                const float p_grp = 1.f / den;
                float fl[8];
#pragma unroll
                for (int e = 0; e < 8; ++e) fl[e] = L[4 + grp * 8 + e] + be[grp * 8 + e];
                int j0 = 0; float m0 = fl[0];
#pragma unroll
                for (int e = 1; e < 8; ++e) if (fl[e] > m0) { m0 = fl[e]; j0 = e; }
                int j1 = -1; float m1 = -3.0e38f;
#pragma unroll
                for (int e = 0; e < 8; ++e) if (e != j0 && fl[e] > m1) { m1 = fl[e]; j1 = e; }
                const float e1 = __expf(m1 - m0);
                const float g0 = p_grp / (1.f + e1), g1 = p_grp * e1 / (1.f + e1);
                const int ex0 = grp * 8 + j0, ex1 = grp * 8 + j1;
                const unsigned s0 = atomicAdd(&cnt[ex0], 1u), s1 = atomicAdd(&cnt[ex1], 1u);
                tok_e[2 * t] = ex0; tok_e[2 * t + 1] = ex1;
                tok_slot[2 * t] = (int)s0; tok_slot[2 * t + 1] = (int)s1;
                tok_g[2 * t] = g0; tok_g[2 * t + 1] = g1;
            }
        }
        __syncthreads();
    }
}
__device__ __forceinline__ void convert_router(const float* wg, const float* we, bf16_t* WrT, int gthread, int gthreads) {
    for (int i = gthread; i < 2 * 48 * 1024; i += gthreads) {
        const int layer = i / (48 * 1024), rem = i % (48 * 1024), col = rem >> 10, d = rem & 1023;
        float v = 0.f;
        if (col < 4) v = wg[((size_t)layer * D_ + d) * 4 + col];
        else if (col < 36) { const int g = (col - 4) >> 3, e = (col - 4) & 7; v = we[(((size_t)layer * 4 + g) * D_ + d) * 8 + e]; }
        WrT[i] = f2bf(v);
    }
}

__device__ __forceinline__ void moe_offsets(LAS int* pst, const unsigned* cnt) {
    if (TIDX == 0) {
        int acc = 0;
        for (int e = 0; e < 32; ++e) { pst[e] = acc; const int c = (int)cnt[e]; acc += (c + MOE_PAD - 1) / MOE_PAD * MOE_PAD; }
        pst[32] = acc;
    }
    __syncthreads();
}
__device__ __forceinline__ int moe_expert_of_row(const LAS int* pst, int r) {
    int e = 0;
#pragma unroll 1
    for (int i = 1; i < 32; ++i) if (r >= pst[i]) e = i;
    return e;
}

__device__ __forceinline__ void ph_dispatch(LAS int* pst, const unsigned* cnt, const bf16_t* hb, const int* tok_e, const int* tok_slot, int* tok_dest, bf16_t* XR) {
    moe_offsets(pst, cnt);
    const int wave = TIDX >> 6, lane = TIDX & 63;
    for (int item = blockIdx.x * NWAVES + wave; item < T_ * 2; item += gridDim.x * NWAVES) {
        const int t = item >> 1;
        const int e = tok_e[item], dest = pst[e] + tok_slot[item];
        if (lane == 0) tok_dest[item] = dest;
        const u32x4* src = (const u32x4*)(hb + (size_t)t * D_);
        u32x4* dst = (u32x4*)(XR + (size_t)dest * D_);
        dst[lane] = src[lane]; dst[lane + 64] = src[lane + 64];
    }
    const int R = pst[32];
    for (int r = blockIdx.x * NWAVES + wave; r < R; r += gridDim.x * NWAVES) {
        const int e = moe_expert_of_row(pst, r);
        if (r - pst[e] >= (int)cnt[e]) {
            u32x4* dst = (u32x4*)(XR + (size_t)r * D_);
            const u32x4 z = {0u, 0u, 0u, 0u};
            dst[lane] = z; dst[lane + 64] = z;
        }
    }
}

__device__ __forceinline__ void ph_combine_ln(const float* hf, const bf16_t* Y, const int* tok_dest, const float* tok_g, const float* lg, const float* lb, float* outf, bf16_t* hb) {
    const int wave = TIDX >> 6, lane = TIDX & 63;
    for (int t = blockIdx.x * NWAVES + wave; t < T_; t += gridDim.x * NWAVES) {
        const int d0 = tok_dest[2 * t], d1 = tok_dest[2 * t + 1];
        const float g0 = tok_g[2 * t], g1 = tok_g[2 * t + 1];
        f32x4 v[4]; float s = 0.f;
#pragma unroll
        for (int j = 0; j < 4; ++j) {
            const f32x4 h = ((const f32x4*)(hf + (size_t)t * D_))[lane + 64 * j];
            const u32x2 y0 = ((const u32x2*)(Y + (size_t)d0 * D_))[lane + 64 * j], y1 = ((const u32x2*)(Y + (size_t)d1 * D_))[lane + 64 * j];
            f32x4 a, b;
            a.x = __uint_as_float(y0.x << 16); a.y = __uint_as_float(y0.x & 0xffff0000u); a.z = __uint_as_float(y0.y << 16); a.w = __uint_as_float(y0.y & 0xffff0000u);
            b.x = __uint_as_float(y1.x << 16); b.y = __uint_as_float(y1.x & 0xffff0000u); b.z = __uint_as_float(y1.y << 16); b.w = __uint_as_float(y1.y & 0xffff0000u);
            v[j] = h * DN_ALPHA + (a * g0 + b * g1);
            s += (v[j].x + v[j].y) + (v[j].z + v[j].w);
        }
        const float mean = wave_sum(s) * (1.f / D_);
        float s2 = 0.f;
#pragma unroll
        for (int j = 0; j < 4; ++j) { v[j] = v[j] - mean; s2 += (v[j].x * v[j].x + v[j].y * v[j].y) + (v[j].z * v[j].z + v[j].w * v[j].w); }
        const float rstd = rsqrtf(wave_sum(s2) * (1.f / D_) + LN_EPS);
#pragma unroll
        for (int j = 0; j < 4; ++j) {
            const f32x4 g = ((const f32x4*)lg)[lane + 64 * j], bb = ((const f32x4*)lb)[lane + 64 * j];
            v[j] = v[j] * rstd * g + bb;
            ((f32x4*)(outf + (size_t)t * D_))[lane + 64 * j] = v[j];
            u32x2 o; o.x = pk2(v[j].x, v[j].y); o.y = pk2(v[j].z, v[j].w);
            ((u32x2*)(hb + (size_t)t * D_))[lane + 64 * j] = o;
        }
    }
}

__device__ __forceinline__ void naive_s5_scan(const bf16_t* P1, const float* a_re, const float* a_im, const float* log_dt, const float* b_re, const float* b_im,
                                              const float* c_re, const float* c_im, const float* dvec, float* YS5, bf16_t* YS5B, int pair) {
    const int lane = TIDX & 63;
    const int b = pair >> 5, g = pair & 31, n = lane;
    const float lam_re = fminf(a_re[g * 64 + n], -1e-4f), lam_im = a_im[g * 64 + n];
    const float dt = __expf(log_dt[g]);
    const float mag = __expf(lam_re * dt);
    const float ab_re = mag * cosf(lam_im * dt), ab_im = mag * sinf(lam_im * dt);
    const float den = lam_re * lam_re + lam_im * lam_im;
    const float num_re = ab_re - 1.f;
    const float z_re = (num_re * lam_re + ab_im * lam_im) / den;
    const float z_im = (ab_im * lam_re - num_re * lam_im) / den;
    float bre[16], bim[16], cre[16], cim[16];
#pragma unroll
    for (int c = 0; c < 16; ++c) {
        bre[c] = b_re[(size_t)(g * 64 + n) * 16 + c]; bim[c] = b_im[(size_t)(g * 64 + n) * 16 + c];
        cre[c] = c_re[(size_t)(g * 16 + c) * 64 + n]; cim[c] = c_im[(size_t)(g * 16 + c) * 64 + n];
    }
    const float dd = (lane < 16) ? dvec[g * 16 + lane] : 0.f;
    float h_re = 0.f, h_im = 0.f;
    for (int tt = 0; tt < L_; ++tt) {
        const size_t t = (size_t)b * L_ + tt;
        const float ul = (lane < 16) ? bf2f(P1[t * NIN1 + g * 16 + lane]) : 0.f;
        float bur = 0.f, bui = 0.f;
#pragma unroll
        for (int c = 0; c < 16; ++c) { const float u = __shfl(ul, c); bur += u * bre[c]; bui += u * bim[c]; }
        const float x_re = z_re * bur - z_im * bui, x_im = z_re * bui + z_im * bur;
        const float nh_re = ab_re * h_re - ab_im * h_im + x_re;
        const float nh_im = ab_re * h_im + ab_im * h_re + x_im;
        h_re = nh_re; h_im = nh_im;
        float yv = 0.f;
#pragma unroll
        for (int c = 0; c < 16; ++c) { const float y = wave_sum(h_re * cre[c] - h_im * cim[c]); if (lane == c) yv = y; }
        if (lane < 16) {
            const float y = gelu_tanh(yv + dd * ul);
            YS5[t * 512 + g * 16 + lane] = y;
            YS5B[t * 512 + g * 16 + lane] = f2bf(y);
        }
    }
}

__device__ __forceinline__ void ph_fin1(const float* OG, const bf16_t* P1, const float* norm_g, bf16_t* Ymix) {
    const int wave = TIDX >> 6, lane = TIDX & 63;
    for (int item = blockIdx.x * NWAVES + wave; item < T_ * 4; item += gridDim.x * NWAVES) {
        const int t = item >> 2, h = item & 3;
        const float o0 = OG[(size_t)t * 512 + h * 128 + lane], o1 = OG[(size_t)t * 512 + h * 128 + 64 + lane];
        const float ms = wave_sum(o0 * o0 + o1 * o1) * (1.f / 128.f);
        const float rs = rsqrtf(ms + LN_EPS);
        const float g0 = bf2f(P1[(size_t)t * NIN1 + 2048 + h * 128 + lane]), g1 = bf2f(P1[(size_t)t * NIN1 + 2048 + h * 128 + 64 + lane]);
        Ymix[(size_t)t * D_ + 512 + h * 128 + lane] = f2bf(o0 * rs * norm_g[lane] * siluf(g0));
        Ymix[(size_t)t * D_ + 512 + h * 128 + 64 + lane] = f2bf(o1 * rs * norm_g[64 + lane] * siluf(g1));
    }
}

constexpr int LDS_BYTES = 147456;
constexpr int MISC_OFF = 131072 + 8192;
enum Phase {
    PH_PROLOGUE = 0,
    PH_INPROJ0, PH_PREPA0, PH_LORA0, PH_PREPB0, PH_SCAN0, PH_SCAN0B, PH_FIN0, PH_OUTPROJ0, PH_LN1_0, PH_DISP0, PH_UP0, PH_DOWN0, PH_COMB0,
    PH_INPROJ1, PH_L1A, PH_L1B, PH_L1C, PH_L1D,
#if !(FAST_HG && FAST_S5)
    PH_SCAN1, PH_FIN1,
#endif
    PH_GLU1, PH_OUTPROJ1, PH_LN1_1, PH_DISP1, PH_UP1, PH_DOWN1, PH_COMB1,
    PH_COUNT
};

typedef const Args __attribute__((address_space(4)))* KArgsP;
__device__ __forceinline__ KArgsP fresh_args() { KArgsP p = (KArgsP)__builtin_amdgcn_kernarg_segment_ptr(); asm volatile("" : "+s"(p)); return p; }
#define PHASE_BEGIN KArgsP ap = fresh_args(); unsigned char* const ws = ap->ws; (void)ws;
#define INP(i) (ap->in[i])
#define W_CTL ((unsigned*)(ws + WS_CTL))
#define W_HB ((bf16_t*)(ws + WS_HB))
#define W_WIN0 ((bf16_t*)(ws + WS_WIN0))
#define W_WOUT0 ((bf16_t*)(ws + WS_WOUT0))
#define W_WIN1 ((bf16_t*)(ws + WS_WIN1))
#define W_WOUT1 ((bf16_t*)(ws + WS_WOUT1))
#define W_WGLU ((bf16_t*)(ws + WS_WGLU))
#define W_WLORA ((bf16_t*)(ws + WS_WLORA))
#define W_WROUTER ((bf16_t*)(ws + WS_WROUTER))
#define W_W13 ((bf16_t*)(ws + WS_W13))
#define W_W2 ((bf16_t*)(ws + WS_W2))
#define W_HA ((float*)(ws + WS_HA))
#define W_YRW W_HA
#define W_OG (W_HA + (size_t)T_ * 512)
#define W_P ((bf16_t*)(ws + WS_P))
#define W_LO ((bf16_t*)(ws + WS_LO))
#define W_SC ((bf16_t*)(ws + WS_SCAN))
#define W_GLALA ((float*)(ws + WS_GLALA))
#define W_BON ((float*)(ws + WS_BON))
#define W_AP ((bf16_t*)(ws + WS_APRIME))
#define W_YS5B ((bf16_t*)(ws + WS_YS5B))
#define W_XR ((bf16_t*)(ws + WS_XR))
#define W_HID ((bf16_t*)(ws + WS_HID))
#define W_Y ((bf16_t*)(ws + WS_Y))
#define W_TOKE ((int*)(ws + WS_ROUTE))
#define W_TOKSLOT (W_TOKE + 2 * T_)
#define W_TOKDEST (W_TOKE + 4 * T_)
#define W_TOKG ((float*)(W_TOKE + 6 * T_))
#define W_YMIX W_HB
#define BIGP(mib) (ws + WS_BIG + (size_t)(mib) * MiB)
#define GLA0_BUFS GlaBufs{(bf16_t*)BIGP(256), (bf16_t*)BIGP(264), (bf16_t*)(ws + WS_HB), (bf16_t*)BIGP(273), (float*)BIGP(289), W_HA + (size_t)T_ * 512, (bf16_t*)BIGP(112)}
#define HG_BUFS GlaBufs{(bf16_t*)BIGP(96), (bf16_t*)BIGP(112), (bf16_t*)BIGP(144), (bf16_t*)BIGP(128), (float*)BIGP(192), (void*)BIGP(252), (bf16_t*)BIGP(160)}
#define W_S5WE ((bf16_t*)BIGP(244))
#define W_S5UA ((bf16_t*)BIGP(201))
#define W_S5MB ((bf16_t*)BIGP(224))
#define W_S5E ((float*)BIGP(193))
#define CW_SUB 12288

#define IN(k) (PLO <= (k) && (k) < PHI)
#define SEAM(k) do { if (IN(k) && IN((k) + 1)) { PHASE_BEGIN XcdBarrier bar_; bar_.bar = W_CTL + CW_BAR; bar_.x = xb_xcc_id(); bar_.st = (volatile LAS unsigned*)(lds + MISC_OFF) + 8; xcd_barrier(bar_); } } while (0)
template <int PLO, int PHI, int layer>
__device__ __forceinline__ void moe_layer(LAS unsigned char* lds) {
    LAS float* ldsf = (LAS float*)lds; (void)ldsf;
        const int base = layer == 0 ? PH_OUTPROJ0 : PH_OUTPROJ1;
        if (IN(base + 0)) {
            PHASE_BEGIN
            const float* W = layer == 0 ? INP(16) : INP(30);
            float* V1 = layer == 0 ? ap->out : W_HA;
            const float* resid = layer == 0 ? INP(0) : ap->out;
#if FAST_GEMM
            (void)W;
            { pg8::Gemm g{W_YMIX, layer == 0 ? W_WOUT0 : W_WOUT1, T_, D_, D_}; pg8::StaticOrder S; S.init(T_, D_, (int)gridDim.x, (int)blockIdx.x); pg8::EpiResidF32 E{resid, V1, D_, DN_ALPHA};
              pg8::gemm_phase<pg8::EpiResidF32, pg8::StaticOrder, true, true>(lds, g, S, E); }
#else
            const bf16_t* Ymix = W_YMIX;
            naive_gemm<false>(ldsf, T_, D_, D_, [&](int m) { return Ymix + (size_t)m * D_; }, [&](int, int) { return W; }, D_,
                              [&](int m, int n, float a, float) { V1[(size_t)m * D_ + n] = DN_ALPHA * resid[(size_t)m * D_ + n] + a; });
#endif
        }
        SEAM(base + 0);
        if (IN(base + 1)) {
            PHASE_BEGIN
            const float* V1 = layer == 0 ? ap->out : W_HA;
#if FAST_LN
            ph_ln_router2(lds, V1, W_HA, W_HB, INP(31) + layer * D_, INP(32) + layer * D_, W_WROUTER + (size_t)layer * 48 * 1024, INP(34) + layer * 4, INP(36) + layer * 32,
                          W_TOKE, W_TOKSLOT, W_TOKG, W_CTL + CW_CNT + 64 * layer);
#else
            ph_ln_router(V1, W_HA, W_HB, INP(31) + layer * D_, INP(32) + layer * D_, INP(33) + (size_t)layer * D_ * 4, INP(34) + layer * 4,
                         INP(35) + (size_t)layer * 4 * D_ * 8, INP(36) + layer * 32, W_TOKE, W_TOKSLOT, W_TOKG, W_CTL + CW_CNT + 64 * layer);
#endif
#ifdef PROBE_LN
            if (layer == 0) ph_ln_router(V1, W_HA, W_HB, INP(31) + layer * D_, INP(32) + layer * D_, INP(33) + (size_t)layer * D_ * 4, INP(34) + layer * 4,
                         INP(35) + (size_t)layer * 4 * D_ * 8, INP(36) + layer * 32, (int*)BIGP(290), (int*)BIGP(291), (float*)BIGP(292), W_CTL + CW_CNT + 1024);
#endif
        }
        SEAM(base + 1);
        if (IN(base + 2)) { PHASE_BEGIN ph_dispatch((LAS int*)lds, W_CTL + CW_CNT + 64 * layer, W_HB, W_TOKE, W_TOKSLOT, W_TOKDEST, W_XR); }
        SEAM(base + 2);
        if (IN(base + 3)) {
            PHASE_BEGIN
#if FAST_GEMM
            { LAS int* pst = (LAS int*)(lds + 131072 + 2048); LAS int* tile_e = (LAS int*)(lds + 131072 + 1024);
              moe_offsets(pst, W_CTL + CW_CNT + 64 * layer);
              const int ntiles = pst[32] / 256;
              if ((int)TIDX < ntiles) tile_e[TIDX] = moe_expert_of_row(pst, TIDX * 256);
              __syncthreads();
              pg8::Gemm g{W_XR, W_W13, ntiles * 256, 1024, D_}; pg8::MoeOrder S{ntiles, 4, (int)gridDim.x, (int)blockIdx.x, tile_e}; pg8::EpiSwiglu E{W_HID};
              pg8::gemm_phase<pg8::EpiSwiglu, pg8::MoeOrder, true, true>(lds, g, S, E); }
#else
            LAS int* pst = (LAS int*)(lds + 65536);
            moe_offsets(pst, W_CTL + CW_CNT + 64 * layer);
            const float* w1 = INP(37) + (size_t)layer * 32 * D_ * 512; const float* w3 = INP(38) + (size_t)layer * 32 * D_ * 512;
            const bf16_t* XR = W_XR; bf16_t* HID = W_HID;
            naive_gemm<true>(ldsf, pst[32], 512, D_, [&](int m) { return XR + (size_t)m * D_; },
                             [&](int m0, int which) { const int e = moe_expert_of_row(pst, m0); return (which ? w3 : w1) + (size_t)e * D_ * 512; }, 512,
                             [&](int m, int n, float a, float b) { HID[(size_t)m * 512 + n] = f2bf(siluf(a) * b); });
#endif
        }
        SEAM(base + 3);
        if (IN(base + 4)) {
            PHASE_BEGIN
#if FAST_GEMM
            { LAS int* pst = (LAS int*)(lds + 131072 + 2048); LAS int* tile_e = (LAS int*)(lds + 131072 + 1024);
              moe_offsets(pst, W_CTL + CW_CNT + 64 * layer);
              const int ntiles = pst[32] / 256;
              if ((int)TIDX < ntiles) tile_e[TIDX] = moe_expert_of_row(pst, TIDX * 256);
              __syncthreads();
              pg8::Gemm g{W_HID, W_W2, ntiles * 256, 1024, 512}; pg8::MoeOrder S{ntiles, 4, (int)gridDim.x, (int)blockIdx.x, tile_e}; pg8::EpiStoreBf16 E{W_Y, D_, 0, 0};
              pg8::gemm_phase<pg8::EpiStoreBf16, pg8::MoeOrder, true, true>(lds, g, S, E); }
#else
            LAS int* pst = (LAS int*)(lds + 65536);
            moe_offsets(pst, W_CTL + CW_CNT + 64 * layer);
            const float* w2 = INP(39) + (size_t)layer * 32 * 512 * D_;
            const bf16_t* HID = W_HID; bf16_t* Y = W_Y;
            naive_gemm<false>(ldsf, pst[32], D_, 512, [&](int m) { return HID + (size_t)m * 512; },
                              [&](int m0, int) { const int e = moe_expert_of_row(pst, m0); return w2 + (size_t)e * 512 * D_; }, D_,
                              [&](int m, int n, float a, float) { Y[(size_t)m * D_ + n] = f2bf(a); });
#endif
        }
        SEAM(base + 4);
        if (IN(base + 5)) { PHASE_BEGIN ph_combine_ln(W_HA, W_Y, W_TOKDEST, W_TOKG, INP(40) + layer * D_, INP(41) + layer * D_, ap->out, W_HB); }
        SEAM(base + 5);

}

template <int PLO, int PHI>
__device__ __forceinline__ void mega_body(unsigned char* lds_raw) {
    LAS unsigned char* lds = (LAS unsigned char*)lds_raw;
    LAS float* ldsf = (LAS float*)lds;
    constexpr bool MULTI = (PHI - PLO) > 1;
    if (MULTI) {
        PHASE_BEGIN
        volatile LAS unsigned* MISC = (volatile LAS unsigned*)(lds + MISC_OFF);
        if (TIDX < 32) MISC[TIDX] = 0u;
        __syncthreads();
        (void)xcd_barrier_post(W_CTL + CW_BAR, MISC + 8);
    }

    if (IN(PH_PROLOGUE)) {
        PHASE_BEGIN ph_prologue(INP(0), W_HB);
#if FAST_GEMM
        LAS float* scr = ldsf + (TIDX >> 6) * (64 * 33);
        const int gw = blockIdx.x * NWAVES + (TIDX >> 6), ngw = gridDim.x * NWAVES, lane = TIDX & 63;
        convert_plain(INP(1), D_, NIN0, NIN0P, W_WIN0, scr, gw, ngw, lane);
        convert_plain(INP(16), D_, D_, D_, W_WOUT0, scr, gw, ngw, lane);
        convert_plain(INP(17), D_, NIN1, NIN1, W_WIN1, scr, gw, ngw, lane);
        convert_plain(INP(30), D_, D_, D_, W_WOUT1, scr, gw, ngw, lane);
        convert_plain(INP(26), 512, 512, 512, W_WGLU, scr, gw, ngw, lane);
        convert_lora(INP(4), INP(6), INP(7), W_WLORA, scr, gw, ngw, lane);
        convert_router(INP(33), INP(35), W_WROUTER, blockIdx.x * NTHREADS + TIDX, gridDim.x * NTHREADS);
        convert_moe(INP(37), INP(38), INP(39), W_W13, W_W2, scr, gw, ngw, lane);
#endif
    }
    SEAM(PH_PROLOGUE);
    if (IN(PH_INPROJ0)) {
        PHASE_BEGIN
#if FAST_GEMM
        { pg8::Gemm g{W_HB, W_WIN0, T_, NIN0P, D_}; pg8::StaticOrder S; S.init(T_, NIN0P, (int)gridDim.x, (int)blockIdx.x); pg8::EpiStoreBf16 E{W_P, NIN0P, 0, 0};
          pg8::gemm_phase<pg8::EpiStoreBf16, pg8::StaticOrder, true, true>(lds, g, S, E); }
#else
        const float* W = INP(1); const bf16_t* A = W_HB; bf16_t* P = W_P;
        naive_gemm<false>(ldsf, T_, NIN0, D_, [&](int m) { return A + (size_t)m * D_; }, [&](int, int) { return W; }, NIN0,
                          [&](int m, int n, float a, float) { P[(size_t)m * NIN0P + n] = f2bf(a); });
#endif
    }
    SEAM(PH_INPROJ0);
#if FAST_GLA0
    if (IN(PH_PREPA0)) { PHASE_BEGIN ph_prepA0v(W_P, INP(2), W_AP); }
#else
    if (IN(PH_PREPA0)) { PHASE_BEGIN ph_prepA0<!FAST_GLA0>(W_P, INP(2), INP(13), INP(14), W_AP, W_GLALA); }
#endif
    SEAM(PH_PREPA0);
    if (IN(PH_LORA0)) {
        PHASE_BEGIN
#if FAST_GEMM
        { pg8::Gemm g{W_AP, W_WLORA, T_, NLORA, 256}; pg8::StaticOrder S; S.init(T_, NLORA, (int)gridDim.x, (int)blockIdx.x); pg8::EpiStoreBf16 E{W_LO, 512, 512, (size_t)T_ * 512};
          pg8::gemm_phase<pg8::EpiStoreBf16, pg8::StaticOrder, true, true>(lds, g, S, E); }
#else
        const float* w2 = INP(4); const float* a2 = INP(6); const float* g2 = INP(7); const bf16_t* AP = W_AP; bf16_t* LO = W_LO;
        naive_gemm<false>(ldsf, T_, 512, 64, [&](int m) { return AP + (size_t)m * 256; }, [&](int, int) { return w2; }, 512,
                          [&](int m, int n, float a, float) { LO[(size_t)m * 512 + n] = f2bf(a); });
        naive_gemm<false>(ldsf, T_, 512, 64, [&](int m) { return AP + (size_t)m * 256 + 64; }, [&](int, int) { return a2; }, 512,
                          [&](int m, int n, float a, float) { LO[(size_t)T_ * 512 + (size_t)m * 512 + n] = f2bf(a); });
        naive_gemm<false>(ldsf, T_, 512, 128, [&](int m) { return AP + (size_t)m * 256 + 128; }, [&](int, int) { return g2; }, 512,
                          [&](int m, int n, float a, float) { LO[(size_t)2 * T_ * 512 + (size_t)m * 512 + n] = f2bf(a); });
#endif
    }
    SEAM(PH_LORA0);
    if (IN(PH_PREPB0)) {
        PHASE_BEGIN ph_prepB0v(W_P, W_LO, INP(2), INP(3), INP(5), INP(8), INP(9), INP(10), W_SC, W_BON);
#if FAST_GLA0
        { const GlaBufs GB = GLA0_BUFS; __syncthreads();
          for (int cg = blockIdx.x; cg < 256; cg += gridDim.x) gla_prep_tile<64, 0>(ldsf, W_P, INP(13), INP(14), GB, cg); }
#endif
    }
    SEAM(PH_PREPB0);
#if FAST_RWKV == 2
#define RW_G ((bf16_t*)BIGP(128))
#define RW_RM ((bf16_t*)ap->out)
#define RW_HT (ap->out + (size_t)4 * 1024 * 1024)
#define RW_YM ((bf16_t*)(ap->out + (size_t)12 * 1024 * 1024))
    if (IN(PH_SCAN0)) {
        PHASE_BEGIN
        for (int it = blockIdx.x; it < 2048; it += gridDim.x) rwkv_chunk_pre(lds, W_SC, RW_G, RW_RM, RW_HT, RW_YM, it);
        { const GlaBufs GB = GLA0_BUFS; const int wave = TIDX >> 6, lane = TIDX & 63;
          for (int u = blockIdx.x * NWAVES + wave; u < 1024 * 4; u += gridDim.x * NWAVES) gla_pass1_unit<64, false>(GB, u, lane); }
    }
    SEAM(PH_SCAN0);
    if (IN(PH_SCAN0B)) {
        PHASE_BEGIN
        const int bid = blockIdx.x;
        if (bid < 64) rwkv_chunk_seq2(lds, RW_G, RW_RM, RW_HT, RW_YM, W_YRW, bid);
#if FAST_S5
        else if (bid < 96) s5_tables(ldsf, INP(18), INP(19), INP(20), INP(21), INP(22), INP(23), INP(24), W_S5MB, W_S5WE, bid - 64);
#endif
        else {
            const GlaBufs GB = GLA0_BUFS;
            const int nb = (int)gridDim.x - 96, b0 = bid - 96;
            gla_pass2<64, false>(GB, b0 * NTHREADS + TIDX, nb * NTHREADS);
            sub_barrier(W_CTL + CW_SUB + 64, (unsigned)nb);
            for (int it = b0; it < 1024; it += nb) gla_pass3_item<64, 0>(lds, W_P, INP(15), GB, W_YMIX, it);
#ifdef PROBE_B_GLA2
            gla_pass2<64, false>(GB, b0 * NTHREADS + TIDX, nb * NTHREADS);
#endif
#ifdef PROBE_B_GLA3
            for (int it = b0; it < 1024; it += nb) gla_pass3_item<64, 0>(lds, W_P, INP(15), GB, W_YMIX, it);
#endif
        }
    }
    SEAM(PH_SCAN0B);
#else
    if (IN(PH_SCAN0)) {
        PHASE_BEGIN
        const int bid = blockIdx.x;
#if FAST_RWKV
        constexpr int NRW = 128;
        if (bid < NRW) rwkv_scan_v1(ldsf, W_SC, W_YRW, bid);
#else
        constexpr int NRW = 16;
        if (bid < NRW) naive_rwkv_scan(ldsf, W_SC, W_YRW, bid);
#endif
#if FAST_GLA0
        else {
            const GlaBufs GB = GLA0_BUFS;
            const int nb = (int)gridDim.x - NRW, b0 = bid - NRW, wave = TIDX >> 6, lane = TIDX & 63;
            for (int u = b0 * NWAVES + wave; u < 1024 * 4; u += nb * NWAVES) gla_pass1_unit<64, false>(GB, u, lane);
            sub_barrier(W_CTL + CW_SUB, (unsigned)nb);
            gla_pass2<64, false>(GB, b0 * NTHREADS + TIDX, nb * NTHREADS);
            sub_barrier(W_CTL + CW_SUB + 64, (unsigned)nb);
            for (int it = b0; it < 1024; it += nb) gla_pass3_item<64, 0>(lds, W_P, INP(15), GB, W_YMIX, it);
        }
#else
        else if (bid < 24) {
            const int bh = bid - 16;
            const bf16_t* P = W_P; const float* GLALA = W_GLALA;
            naive_gla_scan<64>(ldsf,
                [&](int t, int ck, float& q, float& kk, float& e) {
                    q = bf2f(P[(size_t)t * NIN0P + 1792 + ck]) * 0.125f; kk = bf2f(P[(size_t)t * NIN0P + 2048 + ck]); e = __expf(GLALA[(size_t)t * 256 + ck]); },
                [&](int t, int cv) { return bf2f(P[(size_t)t * NIN0P + 2304 + cv]); }, W_OG, bh >> 2, bh & 3);
        }
#endif
    }
    SEAM(PH_SCAN0);
    SEAM(PH_SCAN0B);
#endif
#if FAST_GLA0
    if (IN(PH_FIN0)) { PHASE_BEGIN ph_fin0v(W_YRW, W_LO, W_SC, W_BON, INP(11), INP(12), W_YMIX); }
#else
    if (IN(PH_FIN0)) { PHASE_BEGIN ph_fin0<!FAST_GLA0>(W_YRW, W_OG, W_P, W_LO, W_SC, W_BON, INP(11), INP(12), INP(15), W_YMIX); }
#endif
    SEAM(PH_FIN0);

    moe_layer<PLO, PHI, 0>(lds);
            if (IN(PH_INPROJ1)) {
                PHASE_BEGIN
#if FAST_GEMM
                { pg8::Gemm g{W_HB, W_WIN1, T_, NIN1, D_}; pg8::StaticOrder S; S.init(T_, NIN1, (int)gridDim.x, (int)blockIdx.x); pg8::EpiStoreBf16 E{W_P, NIN1, 0, 0};
                  pg8::gemm_phase<pg8::EpiStoreBf16, pg8::StaticOrder, true, true>(lds, g, S, E); }
#else
                const float* W = INP(17); const bf16_t* A = W_HB; bf16_t* P = W_P;
                naive_gemm<false>(ldsf, T_, NIN1, D_, [&](int m) { return A + (size_t)m * D_; }, [&](int, int) { return W; }, NIN1,
                                  [&](int m, int n, float a, float) { P[(size_t)m * NIN1 + n] = f2bf(a); });
#endif
            }
            SEAM(PH_INPROJ1);
            if (IN(PH_L1A)) {
                PHASE_BEGIN
#if FAST_S5
                s5_fill_ua(W_P, W_S5UA, blockIdx.x * NWAVES + (TIDX >> 6), gridDim.x * NWAVES, TIDX & 63);
                __syncthreads();
#endif
#if FAST_HG
                { const GlaBufs GB = HG_BUFS;
                  for (int cg = blockIdx.x; cg < 256; cg += gridDim.x) gla_prep_tile<128, 1>(ldsf, W_P, INP(28), nullptr, GB, cg); }
#endif
            }
            SEAM(PH_L1A);
            if (IN(PH_L1B)) {
                PHASE_BEGIN
                const int bid = blockIdx.x;
#if FAST_S5
                if (bid < 64) {
                    LAS int* tile_e = (LAS int*)(lds + 131072 + 1024);
                    if (TIDX < 64) tile_e[TIDX] = TIDX >> 1;
                    __syncthreads();
                    pg8::Gemm g{W_S5UA, W_S5WE, 64 * 256, 256, 512, 640}; pg8::MoeOrder S{64, 1, 64, bid, tile_e}; pg8::EpiStoreF32Half E{W_S5E};
                    pg8::gemm_phase<pg8::EpiStoreF32Half, pg8::MoeOrder, true, true>(lds, g, S, E);
                }
#endif
#if FAST_HG
                if (bid >= 64) {
                    const GlaBufs GB = HG_BUFS;
                    const int nb = (int)gridDim.x - 64, b0 = bid - 64, wave = TIDX >> 6, lane = TIDX & 63;
                    for (int u = b0 * NWAVES + wave; u < 1024 * 8; u += nb * NWAVES) gla_pass1_unit<128, true>(GB, u, lane);
                }
#endif
            }
            SEAM(PH_L1B);
            if (IN(PH_L1C)) {
                PHASE_BEGIN
                const int bid = blockIdx.x;
#if FAST_S5
                if (bid < 8) s5_carry(INP(18), INP(19), INP(20), W_S5E, W_S5UA, bid * NTHREADS + TIDX);
#endif
#if FAST_HG
                if (bid >= 8) { const GlaBufs GB = HG_BUFS; gla_pass2<128, true>(GB, (bid - 8) * NTHREADS + TIDX, ((int)gridDim.x - 8) * NTHREADS); }
#endif
#if FAST_GEMM
                { LAS float* scr = ldsf + (TIDX >> 6) * (64 * 33);
                  convert_moe(INP(37) + (size_t)32 * D_ * 512, INP(38) + (size_t)32 * D_ * 512, INP(39) + (size_t)32 * 512 * D_, W_W13, W_W2, scr,
                              bid * NWAVES + (TIDX >> 6), (int)gridDim.x * NWAVES, TIDX & 63); }
#endif
            }
            SEAM(PH_L1C);
            if (IN(PH_L1D)) {
                PHASE_BEGIN
                const int bid = blockIdx.x;
#if FAST_S5
                if (bid < 64) {
                    LAS int* tile_e = (LAS int*)(lds + 131072 + 1024);
                    if (TIDX < 64) tile_e[TIDX] = TIDX >> 1;
                    __syncthreads();
                    pg8::Gemm g{W_S5UA, W_S5MB, 64 * 256, 512, 640, 640}; pg8::MoeOrder S{64, 2, 64, bid, tile_e}; pg8::EpiS5Y E{W_P, INP(25), W_YRW, W_YS5B};
                    pg8::gemm_phase<pg8::EpiS5Y, pg8::MoeOrder, true, true>(lds, g, S, E);
                }
#endif
#if FAST_HG
                if (bid >= 64) {
                    const GlaBufs GB = HG_BUFS;
                    for (int it = bid - 64; it < 1024; it += (int)gridDim.x - 64) gla_pass3_item<128, 1>(lds, W_P, INP(29), GB, W_YMIX, it);
                }
#endif
            }
            SEAM(PH_L1D);
#if !(FAST_HG && FAST_S5)
            if (IN(PH_SCAN1)) {
                PHASE_BEGIN
                const int bid = blockIdx.x;
                const bf16_t* P = W_P; (void)P; (void)bid;
#if !FAST_HG
                if (bid < 8) {
                    const float* hg_lb = INP(28);
                    naive_gla_scan<128>(ldsf,
                        [&](int t, int ck, float& q, float& kk, float& e) {
                            const float l0 = hg_lb[ck], l1 = hg_lb[512 + ck];
                            const float lbv = 1.f / (1.f + __expf(l0 - l1));
                            const float f = bf2f(P[(size_t)t * NIN1 + 1024 + ck]);
                            const float sg = sigm(f);
                            q = siluf(bf2f(P[(size_t)t * NIN1 + 512 + ck])); kk = (1.f - lbv) * (1.f - sg); e = lbv + (1.f - lbv) * sg; },
                        [&](int t, int cv) { return bf2f(P[(size_t)t * NIN1 + 1536 + cv]); }, W_OG, bid >> 2, bid & 3);
                }
#endif
#if !FAST_S5
                if (bid >= 8 && bid < 16) {
                    const int pair = (bid - 8) * 8 + (TIDX >> 6);
                    naive_s5_scan(P, INP(18), INP(19), INP(20), INP(21), INP(22), INP(23), INP(24), INP(25), W_YRW, W_YS5B, pair);
                }
#endif
            }
            SEAM(PH_SCAN1);
#if !FAST_HG
            if (IN(PH_FIN1)) { PHASE_BEGIN ph_fin1(W_OG, W_P, INP(29), W_YMIX); }
#endif
            SEAM(PH_FIN1);
#endif
            if (IN(PH_GLU1)) {
                PHASE_BEGIN
#if FAST_GEMM
                { pg8::Gemm g{W_YS5B, W_WGLU, T_, 512, 512}; pg8::StaticOrder S; S.init(T_, 512, (int)gridDim.x, (int)blockIdx.x); pg8::EpiGlu E{W_YRW, 512, INP(27), W_YMIX, D_};
                  pg8::gemm_phase<pg8::EpiGlu, pg8::StaticOrder, true, true>(lds, g, S, E); }
#else
                const float* W = INP(26); const float* gb = INP(27); const bf16_t* YS5B = W_YS5B; const float* YRW = W_YRW; bf16_t* Ymix = W_YMIX;
                naive_gemm<false>(ldsf, T_, 512, 512, [&](int m) { return YS5B + (size_t)m * 512; }, [&](int, int) { return W; }, 512,
                                  [&](int m, int n, float a, float) { const float y = YRW[(size_t)m * 512 + n]; Ymix[(size_t)m * D_ + n] = f2bf(y * sigm(a + gb[n])); });
#endif
            }
            SEAM(PH_GLU1);
    moe_layer<PLO, PHI, 1>(lds);
#undef IN
}
template <int PLO, int PHI>
__global__ void __launch_bounds__(NTHREADS, 2) mega(Args args) {
    extern __shared__ __attribute__((aligned(16))) unsigned char lds_raw[];
    mega_body<PLO, PHI>(lds_raw);
}

#include <utility>
template <int... I> static void set_attrs(std::integer_sequence<int, I...>) {
    (void)std::initializer_list<int>{ ((void)hipFuncSetAttribute((const void*)mega<I, I + 1>, hipFuncAttributeMaxDynamicSharedMemorySize, LDS_BYTES), 0)... };
}
#ifndef DUP_MASK
#define DUP_MASK 0ull
#endif
template <int I> static int launch_one(int grid, hipStream_t stream, const Args& a) {
    hipLaunchKernelGGL((mega<I, I + 1>), dim3(grid), dim3(NTHREADS), LDS_BYTES, stream, a);
    if ((DUP_MASK >> I) & 1ull) hipLaunchKernelGGL((mega<I, I + 1>), dim3(grid), dim3(NTHREADS), LDS_BYTES, stream, a);
    return 0;
}
template <int... I> static void launch_all(std::integer_sequence<int, I...>, int grid, hipStream_t stream, const Args& a) {
    (void)std::initializer_list<int>{ launch_one<I>(grid, stream, a)... };
}
extern "C" void kernel_launch(void* const* d_in, const int* in_sizes, int n_in, void* d_out, int out_size, void* d_ws, size_t ws_size, hipStream_t stream) {
    static int grid = 0;
    if (grid == 0) {
        if (n_in != 42 || out_size != T_ * D_ || ws_size < WS_END) { fprintf(stderr, "kernel_launch: unexpected shapes n_in %d out %d ws %zu\n", n_in, out_size, ws_size); grid = -1; return; }
        int dev = 0, cus = 0, per_cu = 0;
        hipGetDevice(&dev);
        hipDeviceGetAttribute(&cus, hipDeviceAttributeMultiprocessorCount, dev);
        set_attrs(std::make_integer_sequence<int, PH_COUNT>{});
        hipFuncSetAttribute((const void*)mega<0, PH_COUNT>, hipFuncAttributeMaxDynamicSharedMemorySize, LDS_BYTES);
        hipOccupancyMaxActiveBlocksPerMultiprocessor(&per_cu, (const void*)mega<0, PH_COUNT>, NTHREADS, LDS_BYTES);
        (void)hipGetLastError();
        if (per_cu < 1) per_cu = 1;
        grid = cus * 1;
        fprintf(stderr, "kernel_launch: cus %d per_cu %d grid %d\n", cus, per_cu, grid);
    }
    if (grid < 0) return;
    hipMemsetAsync((char*)d_ws + WS_CTL, 0, CTL_ZERO_BYTES, stream);
    Args a{};
    for (int i = 0; i < 42; ++i) a.in[i] = (const float*)d_in[i];
    a.out = (float*)d_out; a.ws = (unsigned char*)d_ws;
#if MK_SINGLE
    void* kargs[] = {(void*)&a};
    hipError_t e = hipLaunchCooperativeKernel((const void*)mega<0, PH_COUNT>, dim3(grid), dim3(NTHREADS), kargs, LDS_BYTES, stream);
    if (e != hipSuccess) fprintf(stderr, "cooperative launch failed: %s (grid %d)\n", hipGetErrorString(e), grid);
#else
    launch_all(std::make_integer_sequence<int, PH_COUNT>{}, grid, stream, a);
#endif
}
#ifdef TEST_RANGES
template __global__ void mega<0, 2>(Args);
template __global__ void mega<1, 3>(Args);
template __global__ void mega<1, 4>(Args);
template __global__ void mega<3, 8>(Args);
template __global__ void mega<7, 13>(Args);
template __global__ void mega<10, 12>(Args);
template __global__ void mega<13, 17>(Args);
template __global__ void mega<0, 13>(Args);
#endif
```

```cpp
#include <hip/hip_runtime.h>
#include <cstdio>
#include <cstdint>

#define GAS __attribute__((address_space(1)))
#define LAS __attribute__((address_space(3)))
typedef unsigned short bf16_t;
typedef float f32x4 __attribute__((ext_vector_type(4)));
typedef unsigned u32x4 __attribute__((ext_vector_type(4)));
typedef unsigned u32x2 __attribute__((ext_vector_type(2)));
__device__ __forceinline__ int launder_tid() { int t = (int)threadIdx.x; asm volatile("" : "+v"(t)); return t; }
#define TIDX launder_tid()

#ifndef FAST_GEMM
#define FAST_GEMM 1
#endif
#ifndef FAST_LN
#define FAST_LN 1
#endif
#ifndef FAST_RWKV
#define FAST_RWKV 2
#endif
#ifndef FAST_GLA0
#define FAST_GLA0 1
#endif
#ifndef FAST_HG
#define FAST_HG 1
#endif
#ifndef FAST_S5
#define FAST_S5 1
#endif
#ifndef MK_SINGLE
#define MK_SINGLE 1
#endif

constexpr int T_ = 16384, L_ = 8192, D_ = 1024;
constexpr int NIN0 = 3344, NIN0P = 3584, NIN1 = 2560;
constexpr int NLORA = 1536;
constexpr int RMAX = 40960;
constexpr int MOE_PAD = 256;
constexpr float DN_ALPHA = 1.41421356237f;
constexpr float LN_EPS = 1e-5f;
constexpr int NTHREADS = 512, NWAVES = 8;

constexpr size_t MiB = 1u << 20;
constexpr size_t WS_CTL = 0, CTL_ZERO_BYTES = 1 * MiB;
constexpr size_t WS_WIN0 = 2 * MiB;
constexpr size_t WS_WOUT0 = 9 * MiB;
constexpr size_t WS_WIN1 = 11 * MiB;
constexpr size_t WS_WOUT1 = 16 * MiB;
constexpr size_t WS_WGLU = 18 * MiB;
constexpr size_t WS_WLORA = 19 * MiB;
constexpr size_t WS_WROUTER = 19 * MiB + 786432;
constexpr size_t WS_W13 = 20 * MiB;
constexpr size_t WS_W2 = 84 * MiB;
constexpr size_t WS_HB = 116 * MiB;
constexpr size_t WS_HA = 149 * MiB;
constexpr size_t WS_ROUTE = 213 * MiB;
constexpr size_t WS_BIG = 214 * MiB;
constexpr size_t WS_P = WS_BIG;
constexpr size_t WS_LO = WS_BIG + 112 * MiB;
constexpr size_t WS_SCAN = WS_BIG + 160 * MiB;
constexpr size_t WS_GLALA = WS_BIG + 256 * MiB;
constexpr size_t WS_BON = WS_BIG + 272 * MiB;
constexpr size_t WS_APRIME = WS_BIG + 273 * MiB;
constexpr size_t WS_YS5B = WS_BIG + 80 * MiB;
constexpr size_t WS_XR = WS_BIG;
constexpr size_t WS_HID = WS_BIG + 80 * MiB;
constexpr size_t WS_Y = WS_BIG + 120 * MiB;
constexpr size_t WS_END = 512 * MiB;
constexpr int CW_BAR = 4096;
constexpr int CW_CNT = 8192;

__device__ __forceinline__ float bf2f(bf16_t b) { return __uint_as_float(((unsigned)b) << 16); }
__device__ __forceinline__ bf16_t f2bf(float f) { unsigned u = __float_as_uint(f); u += 0x7fffu + ((u >> 16) & 1u); return (bf16_t)(u >> 16); }
__device__ __forceinline__ unsigned pk2(float lo, float hi) { return (unsigned)f2bf(lo) | ((unsigned)f2bf(hi) << 16); }
__device__ __forceinline__ float sigm(float x) { return 1.f / (1.f + __expf(-x)); }
__device__ __forceinline__ float siluf(float x) { return x * sigm(x); }
__device__ __forceinline__ float softplusf(float x) { return fmaxf(x, 0.f) + log1pf(__expf(-fabsf(x))); }
__device__ __forceinline__ float gelu_tanh(float x) { const float u = 0.7978845608028654f * (x + 0.044715f * x * x * x); return 0.5f * x * (1.f + tanhf(u)); }
__device__ __forceinline__ float wave_sum(float v) {
#pragma unroll
    for (int o = 1; o < 64; o <<= 1) v += __shfl_xor(v, o);
    return v;
}


namespace pg8 {
#define PG8_LAS __attribute__((address_space(3)))
typedef unsigned short bf16_t;
typedef short bf16x8 __attribute__((ext_vector_type(8)));
typedef float f32x4 __attribute__((ext_vector_type(4)));
typedef unsigned u32x4 __attribute__((ext_vector_type(4)));
constexpr int BM = 256, BK = 64, HALF = 128, HTB = HALF * BK * 2  , STAGE_BYTES = 8 * HTB, NXCD = 8, WGM = 8;

__host__ __device__ __forceinline__ int lds_byte(int r, int c) { const int st = (r >> 4) * 2 + (c >> 5), rr = r & 15, cc = c & 31, ob = rr * 64 + cc * 2; return st * 1024 + (ob ^ (((ob >> 9) & 1) << 5)); }
__host__ __device__ __forceinline__ void stage_rc(int b, int& R, int& C) { const int st = b / 1024, sb = b % 1024, swz = sb ^ (((sb >> 9) & 1) << 5); R = (st >> 1) * 16 + swz / 64; C = (st & 1) * 32 + (swz % 64) / 2; }
__host__ __device__ __forceinline__ int perm32(int rho) { const int n = rho >> 4, i = rho & 15; return 8 * (i >> 2) + 4 * n + (i & 3); }

struct Unit { int pm, pn, pb; };
struct Gemm { const bf16_t* A; const bf16_t* Bt; int M, N, K, lda; };

struct StaticOrder {
    int nM, nN, nwg, G, c;
    __host__ __device__ void init(int M, int N, int G_, int c_) { nM = M / BM; nN = N / BM; nwg = nM * nN; G = G_; c = c_; }
    __host__ __device__ bool next(int i, Unit& u) const {
        const long L = (long)i * G + c; if (L >= nwg) return false;
        int wgid = (int)L; { const int q = nwg / NXCD, r = nwg % NXCD, xcd = wgid % NXCD, off = wgid / NXCD; wgid = (xcd < r ? xcd * (q + 1) : r * (q + 1) + (xcd - r) * q) + off; }
        const int nig = WGM * nN, gid = wgid / nig, fm = gid * WGM, gsz = (nM - fm) < WGM ? (nM - fm) : WGM;
        u.pm = fm + ((wgid % nig) % gsz); u.pn = (wgid % nig) / gsz; u.pb = u.pn; return true;
    }
    __device__ __forceinline__ void a_ready(const Unit&) const {}
    __device__ __forceinline__ void done(const Unit&) const {}
};

__device__ __forceinline__ unsigned cvt_pk_bf16(float lo, float hi) { unsigned r; asm volatile("v_cvt_pk_bf16_f32 %0, %1, %2" : "=v"(r) : "v"(lo), "v"(hi)); return r; }
typedef float f32x2 __attribute__((ext_vector_type(2)));

template <class Epi, class Sched, bool ALIGN_EPI = false, bool SP2 = false>
__device__ __forceinline__ void gemm_phase(PG8_LAS unsigned char* lds, const Gemm g, const Sched& S, const Epi& E) {
    const int tid = TIDX, wid = __builtin_amdgcn_readfirstlane(tid >> 6), lane = tid & 63, wr = wid >> 2, wc = wid & 3, fr = lane & 15, fq = lane >> 4;
    const int K = g.K, nt = K / BK, lda = g.lda ? g.lda : g.K;
    unsigned voffA[2], voffB[2];
#pragma unroll
    for (int i = 0; i < 2; ++i) { int R, C; stage_rc(tid * 16 + i * 8192, R, C); const int Rb = Epi::PERM ? ((R & ~31) + perm32(R & 31)) : R;
        voffA[i] = (unsigned)(R * lda + C) * 2u; voffB[i] = (unsigned)(Rb * K + C) * 2u; }
    const size_t kstep = (size_t)(BK * 2);
    const size_t hstep = (size_t)HALF * K * 2;
    const size_t tstep = 2 * hstep;
    const size_t hstepA = (size_t)HALF * lda * 2, tstepA = 2 * hstepA;
    const unsigned ldsw = (unsigned)wid * 1024u;
    const int aoff = lds_byte(wr * 64 + fr, fq * 8), boff = lds_byte(wc * 32 + fr, fq * 8);
#define PG8_SA(b, h) (((b) * 2 + (h)) * HTB)
#define PG8_SB(b, h) ((4 + (b) * 2 + (h)) * HTB)
#define PG8_STAGE(bufoff, gbase, voff) do { _Pragma("unroll") for (int _i = 0; _i < 2; ++_i) \
        __builtin_amdgcn_global_load_lds((const unsigned*)((const char*)(gbase) + (voff)[_i]), (PG8_LAS unsigned*)(lds + (bufoff) + ldsw + _i * 8192), 16, 0, 0); } while (0)
#define PG8_LDA(dst, b, h) do { _Pragma("unroll") for (int m = 0; m < 4; ++m) _Pragma("unroll") for (int k = 0; k < 2; ++k) dst[m][k] = *(const PG8_LAS bf16x8*)(lds + PG8_SA(b, h) + aoff + m * 2048 + k * 1024); } while (0)
#define PG8_LDB(dst, b, h) do { _Pragma("unroll") for (int n = 0; n < 2; ++n) _Pragma("unroll") for (int k = 0; k < 2; ++k) dst[n][k] = *(const PG8_LAS bf16x8*)(lds + PG8_SB(b, h) + boff + n * 2048 + k * 1024); } while (0)
#define PG8_MMA(ai, bj, At, Bt) do { __builtin_amdgcn_s_setprio(1); _Pragma("unroll") for (int m = 0; m < 4; ++m) _Pragma("unroll") for (int n = 0; n < 2; ++n) _Pragma("unroll") for (int k = 0; k < 2; ++k) \
        acc[ai][bj][m][n] = __builtin_amdgcn_mfma_f32_16x16x32_bf16(Bt[n][k], At[m][k], acc[ai][bj][m][n], 0, 0, 0); __builtin_amdgcn_s_setprio(0); } while (0)
#define PG8_WAIT_V(n) asm volatile("s_waitcnt vmcnt(" #n ")" ::: "memory")
#define PG8_WAIT_L(n) asm volatile("s_waitcnt lgkmcnt(" #n ")" ::: "memory")
#define PG8_BAR __builtin_amdgcn_s_barrier()
#define PG8_SCHED __builtin_amdgcn_sched_barrier(0)
    Unit cur, nxt; int ui = 0;
    if (!S.next(0, cur)) return;
    f32x4 acc[2][2][4][2];
#pragma unroll
    for (int a = 0; a < 2; ++a)
#pragma unroll
        for (int b = 0; b < 2; ++b)
#pragma unroll
            for (int m = 0; m < 4; ++m)
#pragma unroll
                for (int n = 0; n < 2; ++n) acc[a][b][m][n] = (f32x4){0.f, 0.f, 0.f, 0.f};
    bf16x8 At[4][2], B0[2][2], B1[2][2];
    const char* cA = (const char*)g.A + (size_t)cur.pm * tstepA; const char* cB = (const char*)g.Bt + (size_t)cur.pb * tstep;
    S.a_ready(cur);
    if constexpr (SP2) {
        PG8_STAGE(PG8_SB(0, 0), cB, voffB); PG8_STAGE(PG8_SB(0, 1), cB + hstep, voffB); PG8_STAGE(PG8_SA(0, 0), cA, voffA); PG8_STAGE(PG8_SA(0, 1), cA + hstepA, voffA);
        if (wr == 1) PG8_BAR;
        PG8_WAIT_V(2); PG8_BAR;
        PG8_STAGE(PG8_SB(1, 0), cB + kstep, voffB); PG8_STAGE(PG8_SA(1, 0), cA + kstep, voffA); PG8_STAGE(PG8_SB(1, 1), cB + hstep + kstep, voffB);
        PG8_WAIT_V(6); PG8_BAR;
    } else {
        PG8_STAGE(PG8_SB(0, 0), cB, voffB); PG8_STAGE(PG8_SA(0, 0), cA, voffA); PG8_STAGE(PG8_SB(0, 1), cB + hstep, voffB); PG8_STAGE(PG8_SA(0, 1), cA + hstepA, voffA);
        if (wr == 1) PG8_BAR;
        PG8_WAIT_V(4); PG8_BAR;
        PG8_STAGE(PG8_SB(1, 0), cB + kstep, voffB); PG8_STAGE(PG8_SA(1, 0), cA + kstep, voffA); PG8_STAGE(PG8_SB(1, 1), cB + hstep + kstep, voffB);
        PG8_WAIT_V(6); PG8_BAR;
    }
    for (;;) {
        const bool has_next = S.next(ui + 1, nxt);
        const char* nA = has_next ? (const char*)g.A + (size_t)nxt.pm * tstepA : cA; const char* nB = has_next ? (const char*)g.Bt + (size_t)nxt.pb * tstep : cB;
        for (int t = 0; t < nt; t += 2) {
            const bool last = (t == nt - 2);
            const char* a1 = cA + (size_t)(t + 1) * kstep;
            const char* a2 = last ? nA : cA + (size_t)(t + 2) * kstep; const char* b2 = last ? nB : cB + (size_t)(t + 2) * kstep;
            const char* a3 = a2 + kstep; const char* b3 = b2 + kstep;
            if (last && has_next) S.a_ready(nxt);
            if constexpr (SP2) {
            PG8_LDB(B0, 0, 0); PG8_LDB(B1, 0, 1); PG8_SCHED; PG8_LDA(At, 0, 0); PG8_STAGE(PG8_SA(1, 1), a1 + hstepA, voffA);
            PG8_WAIT_V(8); PG8_WAIT_L(0); PG8_BAR; PG8_MMA(0, 0, At, B0); PG8_MMA(0, 1, At, B1); PG8_BAR; PG8_SCHED;
            PG8_LDA(At, 0, 1); PG8_STAGE(PG8_SB(0, 0), b2, voffB); PG8_STAGE(PG8_SB(0, 1), b2 + hstep, voffB); PG8_STAGE(PG8_SA(0, 0), a2, voffA);
            PG8_WAIT_V(8); PG8_WAIT_L(0); PG8_BAR; PG8_MMA(1, 0, At, B0); PG8_MMA(1, 1, At, B1); PG8_BAR; PG8_SCHED;
            PG8_LDB(B0, 1, 0); PG8_LDB(B1, 1, 1); PG8_SCHED; PG8_LDA(At, 1, 0); PG8_STAGE(PG8_SA(0, 1), a2 + hstepA, voffA);
            PG8_WAIT_V(8); PG8_WAIT_L(0); PG8_BAR; PG8_MMA(0, 0, At, B0); PG8_MMA(0, 1, At, B1); PG8_BAR; PG8_SCHED;
            PG8_LDA(At, 1, 1); PG8_STAGE(PG8_SB(1, 0), b3, voffB); PG8_STAGE(PG8_SB(1, 1), b3 + hstep, voffB); PG8_STAGE(PG8_SA(1, 0), a3, voffA);
            PG8_WAIT_V(8); PG8_WAIT_L(0); PG8_BAR; PG8_MMA(1, 0, At, B0); PG8_MMA(1, 1, At, B1); PG8_BAR; PG8_SCHED;
            } else {
            PG8_LDB(B0, 0, 0); PG8_SCHED; PG8_LDA(At, 0, 0); PG8_STAGE(PG8_SA(1, 1), a1 + hstepA, voffA);
            PG8_WAIT_L(8); PG8_BAR; PG8_WAIT_L(0); PG8_MMA(0, 0, At, B0); PG8_BAR; PG8_SCHED;
            PG8_LDB(B1, 0, 1); PG8_STAGE(PG8_SB(0, 0), b2, voffB);
            PG8_BAR; PG8_WAIT_L(0); PG8_MMA(0, 1, At, B1); PG8_BAR;
            PG8_LDA(At, 0, 1); PG8_STAGE(PG8_SA(0, 0), a2, voffA);
            PG8_BAR; PG8_WAIT_L(0); PG8_MMA(1, 0, At, B0); PG8_BAR; PG8_SCHED;
            PG8_STAGE(PG8_SB(0, 1), b2 + hstep, voffB);
            PG8_WAIT_V(6); PG8_BAR; PG8_MMA(1, 1, At, B1); PG8_BAR;
            PG8_LDB(B0, 1, 0); PG8_SCHED; PG8_LDA(At, 1, 0); PG8_STAGE(PG8_SA(0, 1), a2 + hstepA, voffA);
            PG8_WAIT_L(8); PG8_BAR; PG8_WAIT_L(0); PG8_MMA(0, 0, At, B0); PG8_BAR; PG8_SCHED;
            PG8_LDB(B1, 1, 1); PG8_STAGE(PG8_SB(1, 0), b3, voffB);
            PG8_BAR; PG8_WAIT_L(0); PG8_MMA(0, 1, At, B1); PG8_BAR;
            PG8_LDA(At, 1, 1); PG8_STAGE(PG8_SA(1, 0), a3, voffA);
            PG8_BAR; PG8_WAIT_L(0); PG8_MMA(1, 0, At, B0); PG8_BAR; PG8_SCHED;
            PG8_STAGE(PG8_SB(1, 1), b3 + hstep, voffB);
            PG8_WAIT_V(6); PG8_BAR; PG8_MMA(1, 1, At, B1); PG8_BAR;
            }
        }
        if constexpr (ALIGN_EPI) { if (wr == 0) PG8_BAR; }
        if constexpr (!Epi::AFTER_DRAIN) { E(acc, cur, wr, wc, fr, fq); S.done(cur); }
        if (!has_next) break;
#pragma unroll
        for (int a = 0; a < 2; ++a)
#pragma unroll
            for (int b = 0; b < 2; ++b)
#pragma unroll
                for (int m = 0; m < 4; ++m)
#pragma unroll
                    for (int n = 0; n < 2; ++n) acc[a][b][m][n] = (f32x4){0.f, 0.f, 0.f, 0.f};
        cur = nxt; cA = nA; cB = nB; ++ui;
        if constexpr (ALIGN_EPI) { if (wr == 1) PG8_BAR; }
    }
    PG8_WAIT_V(0);
    if constexpr (!ALIGN_EPI) { if (wr == 0) PG8_BAR; }
    PG8_BAR;
    if constexpr (Epi::AFTER_DRAIN) { E.fused(acc, cur, wr, wc, fr, fq, lds, wid, lane); S.done(cur); }
#undef PG8_SA
#undef PG8_SB
#undef PG8_STAGE
#undef PG8_LDA
#undef PG8_LDB
#undef PG8_MMA
#undef PG8_WAIT_V
#undef PG8_WAIT_L
#undef PG8_BAR
#undef PG8_SCHED
}

struct EpiStoreBf16 {
    static constexpr bool PERM = true, AFTER_DRAIN = false;
    bf16_t* O; int ldc; int split_cols; size_t split_stride;
    __device__ __forceinline__ void operator()(const f32x4 (&acc)[2][2][4][2], const Unit& u, int wr, int wc, int fr, int fq) const {
        int colt = u.pn * BM; bf16_t* base = O;
        if (split_cols) { const int t = colt / split_cols; base += (size_t)t * split_stride; colt -= t * split_cols; }
        const int row0 = u.pm * BM + wr * 64 + fr, col0 = colt + wc * 32 + 8 * fq;
#pragma unroll
        for (int ai = 0; ai < 2; ++ai)
#pragma unroll
            for (int m = 0; m < 4; ++m) { bf16_t* rowp = base + (size_t)(row0 + ai * HALF + m * 16) * ldc + col0;
#pragma unroll
                for (int bj = 0; bj < 2; ++bj) { const f32x4 v0 = acc[ai][bj][m][0], v1 = acc[ai][bj][m][1];
                    u32x4 w; w.x = cvt_pk_bf16(v0[0], v0[1]); w.y = cvt_pk_bf16(v0[2], v0[3]); w.z = cvt_pk_bf16(v1[0], v1[1]); w.w = cvt_pk_bf16(v1[2], v1[3]);
                    *(u32x4*)(rowp + bj * HALF) = w; } }
    }
};
struct EpiResidF32 {
    static constexpr bool PERM = false, AFTER_DRAIN = false;
    const float* resid; float* out; int ldc; float alpha;
    __device__ __forceinline__ void operator()(const f32x4 (&acc)[2][2][4][2], const Unit& u, int wr, int wc, int fr, int fq) const {
        const int row0 = u.pm * BM + wr * 64 + fr, col0 = u.pn * BM + wc * 32 + 4 * fq;
#pragma unroll
        for (int ai = 0; ai < 2; ++ai)
#pragma unroll
            for (int m = 0; m < 4; ++m) { const size_t off = (size_t)(row0 + ai * HALF + m * 16) * ldc + col0;
#pragma unroll
                for (int bj = 0; bj < 2; ++bj)
#pragma unroll
                    for (int n = 0; n < 2; ++n) { const size_t o = off + bj * HALF + n * 16; *(f32x4*)(out + o) = *(const f32x4*)(resid + o) * alpha + acc[ai][bj][m][n]; } }
    }
};
__device__ __forceinline__ float fast_sigm(float x) { return __builtin_amdgcn_rcpf(1.f + __expf(-x)); }
struct EpiSwiglu {
    static constexpr bool PERM = true, AFTER_DRAIN = false;
    bf16_t* HID;
    __device__ __forceinline__ void operator()(const f32x4 (&acc)[2][2][4][2], const Unit& u, int wr, int wc, int fr, int fq) const {
        const int row0 = u.pm * BM + wr * 64 + fr, h0 = u.pn * 128 + wc * 16 + 4 * fq;
#pragma unroll
        for (int ai = 0; ai < 2; ++ai)
#pragma unroll
            for (int m = 0; m < 4; ++m) { bf16_t* rowp = HID + (size_t)(row0 + ai * HALF + m * 16) * 512 + h0;
#pragma unroll
                for (int bj = 0; bj < 2; ++bj) { const f32x4 a = acc[ai][bj][m][0], b = acc[ai][bj][m][1]; f32x4 h;
#pragma unroll
                    for (int j = 0; j < 4; ++j) h[j] = a[j] * fast_sigm(a[j]) * b[j];
                    typedef unsigned u32x2v __attribute__((ext_vector_type(2)));
                    u32x2v w; w.x = cvt_pk_bf16(h[0], h[1]); w.y = cvt_pk_bf16(h[2], h[3]);
                    *(u32x2v*)(rowp + bj * 64) = w; } }
    }
};
struct EpiGlu {
    static constexpr bool PERM = true, AFTER_DRAIN = false;
    const float* ysrc; int ldy; const float* bias; bf16_t* O; int ldc;
    __device__ __forceinline__ void operator()(const f32x4 (&acc)[2][2][4][2], const Unit& u, int wr, int wc, int fr, int fq) const {
        const int row0 = u.pm * BM + wr * 64 + fr, col0 = u.pn * BM + wc * 32 + 8 * fq;
#pragma unroll
        for (int ai = 0; ai < 2; ++ai)
#pragma unroll
            for (int m = 0; m < 4; ++m) { const int row = row0 + ai * HALF + m * 16;
#pragma unroll
                for (int bj = 0; bj < 2; ++bj) { const int col = col0 + bj * HALF;
                    const f32x4 y0 = *(const f32x4*)(ysrc + (size_t)row * ldy + col), y1 = *(const f32x4*)(ysrc + (size_t)row * ldy + col + 4);
                    const f32x4 b0 = *(const f32x4*)(bias + col), b1 = *(const f32x4*)(bias + col + 4);
                    f32x4 v0 = acc[ai][bj][m][0] + b0, v1 = acc[ai][bj][m][1] + b1;
#pragma unroll
                    for (int j = 0; j < 4; ++j) { v0[j] = y0[j] * fast_sigm(v0[j]); v1[j] = y1[j] * fast_sigm(v1[j]); }
                    u32x4 w; w.x = cvt_pk_bf16(v0[0], v0[1]); w.y = cvt_pk_bf16(v0[2], v0[3]); w.z = cvt_pk_bf16(v1[0], v1[1]); w.w = cvt_pk_bf16(v1[2], v1[3]);
                    *(u32x4*)(O + (size_t)row * ldc + col) = w; } }
    }
};
template <bool RESID_BF16> struct EpiResidBf16 {
    static constexpr bool PERM = true, AFTER_DRAIN = false;
    const void* resid; bf16_t* out; int ldc; float alpha;
    __device__ __forceinline__ void operator()(const f32x4 (&acc)[2][2][4][2], const Unit& u, int wr, int wc, int fr, int fq) const {
        const int row0 = u.pm * BM + wr * 64 + fr, col0 = u.pn * BM + wc * 32 + 8 * fq;
#pragma unroll
        for (int ai = 0; ai < 2; ++ai)
#pragma unroll
            for (int m = 0; m < 4; ++m) { const size_t off = (size_t)(row0 + ai * HALF + m * 16) * ldc + col0;
#pragma unroll
                for (int bj = 0; bj < 2; ++bj) {
                    f32x4 r0, r1;
                    if (RESID_BF16) { const u32x4 rv = *(const u32x4*)((const bf16_t*)resid + off + bj * HALF);
                        r0[0] = __uint_as_float(rv.x << 16); r0[1] = __uint_as_float(rv.x & 0xffff0000u); r0[2] = __uint_as_float(rv.y << 16); r0[3] = __uint_as_float(rv.y & 0xffff0000u);
                        r1[0] = __uint_as_float(rv.z << 16); r1[1] = __uint_as_float(rv.z & 0xffff0000u); r1[2] = __uint_as_float(rv.w << 16); r1[3] = __uint_as_float(rv.w & 0xffff0000u); }
                    else { r0 = *(const f32x4*)((const float*)resid + off + bj * HALF); r1 = *(const f32x4*)((const float*)resid + off + bj * HALF + 4); }
                    const f32x4 v0 = r0 * alpha + acc[ai][bj][m][0], v1 = r1 * alpha + acc[ai][bj][m][1];
                    u32x4 w; w.x = cvt_pk_bf16(v0[0], v0[1]); w.y = cvt_pk_bf16(v0[2], v0[3]); w.z = cvt_pk_bf16(v1[0], v1[1]); w.w = cvt_pk_bf16(v1[2], v1[3]);
                    *(u32x4*)(out + off + bj * HALF) = w; } }
    }
};
struct EpiStoreF32 {
    static constexpr bool PERM = false, AFTER_DRAIN = false;
    float* out; int ldc;
    __device__ __forceinline__ void operator()(const f32x4 (&acc)[2][2][4][2], const Unit& u, int wr, int wc, int fr, int fq) const {
        const int row0 = u.pm * BM + wr * 64 + fr, col0 = u.pn * BM + wc * 32 + 4 * fq;
#pragma unroll
        for (int ai = 0; ai < 2; ++ai)
#pragma unroll
            for (int m = 0; m < 4; ++m) { const size_t off = (size_t)(row0 + ai * HALF + m * 16) * ldc + col0;
#pragma unroll
                for (int bj = 0; bj < 2; ++bj)
#pragma unroll
                    for (int n = 0; n < 2; ++n) *(f32x4*)(out + off + bj * HALF + n * 16) = acc[ai][bj][m][n]; }
    }
};
struct EpiStoreF32Half {
    static constexpr bool PERM = false, AFTER_DRAIN = false;
    float* out;
    __device__ __forceinline__ void operator()(const f32x4 (&acc)[2][2][4][2], const Unit& u, int wr, int wc, int fr, int fq) const {
        const int row0 = u.pm * BM + wr * 64 + fr, col0 = wc * 32 + 4 * fq;
#pragma unroll
        for (int ai = 0; ai < 2; ++ai)
#pragma unroll
            for (int m = 0; m < 4; ++m) { const size_t off = (size_t)(row0 + ai * HALF + m * 16) * 128 + col0;
#pragma unroll
                for (int n = 0; n < 2; ++n) *(f32x4*)(out + off + n * 16) = acc[ai][0][m][n]; }
    }
};
struct EpiS5Y {
    static constexpr bool PERM = false, AFTER_DRAIN = false;
    const bf16_t* P1; const float* dvec; float* YS5; bf16_t* YS5B;
    __device__ __forceinline__ void operator()(const f32x4 (&acc)[2][2][4][2], const Unit& u, int wr, int wc, int fr, int fq) const {
        const int g = u.pm >> 1, ch = g * 16 + 4 * fq;
        const f32x4 dd = *(const f32x4*)(dvec + ch);
#pragma unroll
        for (int ai = 0; ai < 2; ++ai)
#pragma unroll
            for (int m = 0; m < 4; ++m) {
                const int bc = (u.pm & 1) * 256 + ai * HALF + wr * 64 + m * 16 + fr, b = bc >> 8, c32 = bc & 255;
#pragma unroll
                for (int bj = 0; bj < 2; ++bj)
#pragma unroll
                    for (int n = 0; n < 2; ++n) {
                        const int i = 16 * u.pn + 8 * bj + 2 * wc + n;
                        const size_t t = (size_t)b * 8192 + c32 * 32 + i;
                        typedef unsigned u32x2v __attribute__((ext_vector_type(2)));
                        const u32x2v uu = *(const u32x2v*)(P1 + t * 2560 + ch);
                        f32x4 uv; uv[0] = __uint_as_float(uu.x << 16); uv[1] = __uint_as_float(uu.x & 0xffff0000u); uv[2] = __uint_as_float(uu.y << 16); uv[3] = __uint_as_float(uu.y & 0xffff0000u);
                        f32x4 y = acc[ai][bj][m][n] + dd * uv;
#pragma unroll
                        for (int j = 0; j < 4; ++j) { const float x = y[j]; const float tt = 0.7978845608028654f * (x + 0.044715f * x * x * x); y[j] = 0.5f * x * (1.f + tanhf(tt)); }
                        *(f32x4*)(YS5 + t * 512 + ch) = y;
                        u32x2v w; w.x = cvt_pk_bf16(y[0], y[1]); w.y = cvt_pk_bf16(y[2], y[3]);
                        *(u32x2v*)(YS5B + t * 512 + ch) = w;
                    }
            }
    }
};
struct MoeOrder {
    int ntiles, nN, G, c; const PG8_LAS int* tile_e;
    __device__ __forceinline__ bool next(int i, Unit& u) const {
        const int L = i * G + c; if (L >= ntiles * nN) return false;
        u.pm = L / nN; u.pn = L % nN; u.pb = tile_e[u.pm] * nN + u.pn; return true;
    }
    __device__ __forceinline__ void a_ready(const Unit&) const {}
    __device__ __forceinline__ void done(const Unit&) const {}
};
}

#define XB_TMO      128
#define XB_XCNT(j)  (256  + 64 * (j))
#define XB_XSUB(j)  (1280 + 64 * (j))
#define XB_XGEN(j)  (2304 + 64 * (j))
#define XB_TOP      3328
#define XB_TOPGEN   3392
#define XCD_BAR_WORDS 3456
#define XB_SPIN_CAP (1u << 18)
__device__ __forceinline__ unsigned xb_ld(unsigned* p)              { return __hip_atomic_load(p, __ATOMIC_RELAXED, __HIP_MEMORY_SCOPE_AGENT); }
__device__ __forceinline__ unsigned xb_add(unsigned* p, unsigned v) { return __hip_atomic_fetch_add(p, v, __ATOMIC_RELAXED, __HIP_MEMORY_SCOPE_AGENT); }
__device__ __forceinline__ unsigned xb_xcc_id() { return (unsigned)__builtin_amdgcn_s_getreg((3 << 11) | 20) & 0xFu; }
#define XB_SPIN(cond, bar) do { unsigned _sp = 0; while (cond) { __builtin_amdgcn_s_sleep(1); \
    if ((++_sp & 255u) == 0u) { if (xb_ld(&(bar)[XB_TMO])) break; if (_sp > XB_SPIN_CAP) { atomicAdd(&(bar)[XB_TMO], 1u); break; } } } } while (0)
struct XcdBarrier { unsigned* bar; unsigned x; volatile LAS unsigned* st; };
__device__ __forceinline__ XcdBarrier xcd_barrier_post(unsigned* bar, volatile LAS unsigned* st) {
    XcdBarrier b; b.bar = bar; b.x = xb_xcc_id(); b.st = st;
    if (TIDX == 0) (void)xb_add(&bar[XB_XCNT(b.x)], 1u);
    return b;
}
__device__ __forceinline__ void xcd_barrier_complete(unsigned* bar, unsigned x, unsigned& nloc, unsigned& nx) {
    const unsigned G = gridDim.x;
    unsigned sum, cnt, mine, sp = 0u;
    for (;;) {
        sum = 0u; cnt = 0u; mine = 0u;
#pragma unroll
        for (unsigned j = 0; j < 16; ++j) { const unsigned c = xb_ld(&bar[XB_XCNT(j)]); sum += c; cnt += (c > 0u) ? 1u : 0u; mine = (j == x) ? c : mine; }
        if (sum == G) break;
        __builtin_amdgcn_s_sleep(1);
        if ((++sp & 255u) == 0u) { if (xb_ld(&bar[XB_TMO])) break; if (sp > XB_SPIN_CAP) { atomicAdd(&bar[XB_TMO], 1u); break; } }
    }
    nloc = mine > 0u ? mine : 1u; nx = cnt > 0u ? cnt : 1u;
}
__device__ __forceinline__ void xcd_barrier(const XcdBarrier& b) {
    asm volatile("s_waitcnt vmcnt(0)" ::: "memory");
    __syncthreads();
    if (TIDX == 0) {
        unsigned* bar = b.bar;
        __builtin_amdgcn_s_waitcnt(0);
        unsigned nloc = b.st[0], nx = b.st[1];
        if (nloc == 0u) { xcd_barrier_complete(bar, b.x, nloc, nx); b.st[0] = nloc; b.st[1] = nx; }
        const unsigned old = xb_add(&bar[XB_XSUB(b.x)], 1u);
        const unsigned gen = old / nloc;
        if (old + 1u == (gen + 1u) * nloc) {
            __builtin_amdgcn_fence(__ATOMIC_RELEASE, "agent");
            asm volatile("s_waitcnt vmcnt(0)" ::: "memory");
            const unsigned og = xb_add(&bar[XB_TOP], 1u);
            const unsigned tg = og / nx;
            if (og + 1u == (tg + 1u) * nx) xb_add(&bar[XB_TOPGEN], 1u);
            else XB_SPIN(xb_ld(&bar[XB_TOPGEN]) == tg, bar);
            __builtin_amdgcn_fence(__ATOMIC_ACQUIRE, "agent");
            xb_add(&bar[XB_XGEN(b.x)], 1u);
            asm volatile("s_waitcnt vmcnt(0)" ::: "memory");
        } else {
            XB_SPIN(xb_ld(&bar[XB_XGEN(b.x)]) == gen, bar);
            __builtin_amdgcn_fence(__ATOMIC_ACQUIRE, "agent");
            asm volatile("s_waitcnt vmcnt(0)" ::: "memory");
        }
    }
    __syncthreads();
}


typedef short bf16x8 __attribute__((ext_vector_type(8)));
__device__ __forceinline__ void unpack8f(const u32x4 v, float* f) {
    f[0] = __uint_as_float(v.x << 16); f[1] = __uint_as_float(v.x & 0xffff0000u); f[2] = __uint_as_float(v.y << 16); f[3] = __uint_as_float(v.y & 0xffff0000u);
    f[4] = __uint_as_float(v.z << 16); f[5] = __uint_as_float(v.z & 0xffff0000u); f[6] = __uint_as_float(v.w << 16); f[7] = __uint_as_float(v.w & 0xffff0000u);
}
__device__ __forceinline__ u32x4 pack8f(const float* f) { u32x4 o; o.x = pk2(f[0], f[1]); o.y = pk2(f[2], f[3]); o.z = pk2(f[4], f[5]); o.w = pk2(f[6], f[7]); return o; }
__device__ __forceinline__ void ld8bf(const bf16_t* p, float* f) { unpack8f(*(const u32x4*)p, f); }
__device__ __forceinline__ void ld8f(const float* p, float* f) { const f32x4 a = *(const f32x4*)p, b = *(const f32x4*)(p + 4); f[0] = a.x; f[1] = a.y; f[2] = a.z; f[3] = a.w; f[4] = b.x; f[5] = b.y; f[6] = b.z; f[7] = b.w; }
struct GlaBufs { bf16_t* QT; bf16_t* KT; bf16_t* KDT; bf16_t* VT; float* DG; void* DS; bf16_t* SP; };
__device__ __forceinline__ float logsigf(float x) { return fminf(x, 0.f) - log1pf(__expf(-fabsf(x))); }

template <int K, int LAYER>
__device__ __forceinline__ void gla_prep_tile(LAS float* lds, const bf16_t* P, const float* aux0, const float* aux1, const GlaBufs& B, int cg) {
    constexpr int HK = 4 * K, KP = K + 1;
    LAS float* G = lds;
    LAS float* KR = lds + 64 * KP;
    LAS float* LV = lds + 2 * 64 * KP;
    const int tid = TIDX, lane = tid & 63, wave = tid >> 6;
    const int t0 = cg * 64;
    LAS float* GL = lds + 2 * 64 * KP + 64 * 129;
    LAS float* GA = GL + 64 * 16;
    if (LAYER == 0) {
        for (int idx = tid; idx < 64 * 16; idx += NTHREADS) GL[idx] = bf2f(P[(size_t)(t0 + (idx >> 4)) * NIN0P + 2816 + (idx & 15)]);
        __syncthreads();
        const int ck = tid & 255, th = tid >> 8;
        float w2r[16];
#pragma unroll
        for (int i = 0; i < 16; ++i) w2r[i] = aux0[i * 256 + ck];
        const float gb = aux1[ck];
        for (int t = th * 32; t < th * 32 + 32; ++t) {
            float gk = gb;
#pragma unroll
            for (int i4 = 0; i4 < 4; ++i4) { const f32x4 x = *(const LAS f32x4*)(GL + t * 16 + 4 * i4); gk += x.x * w2r[4 * i4] + x.y * w2r[4 * i4 + 1] + x.z * w2r[4 * i4 + 2] + x.w * w2r[4 * i4 + 3]; }
            GA[t * 257 + ck] = logsigf(gk) * (1.f / 16.f);
        }
        __syncthreads();
    }
    constexpr int NCH = 64 * K / 8 / NTHREADS;
    for (int h = 0; h < 4; ++h) {
        float qv[NCH][8];
#pragma unroll
        for (int it = 0; it < NCH; ++it) {
            const int ch = tid + it * NTHREADS, t = ch / (K / 8), c8 = (ch % (K / 8)) * 8, ck = h * K + c8;
            float kr[8], g[8];
            if (LAYER == 0) {
                ld8bf(P + (size_t)(t0 + t) * NIN0P + 2048 + ck, kr);
                ld8bf(P + (size_t)(t0 + t) * NIN0P + 1792 + ck, qv[it]);
#pragma unroll
                for (int j = 0; j < 8; ++j) { g[j] = GA[t * 257 + ck + j]; qv[it][j] *= 0.125f; }
            } else {
                float f[8], l0[8], l1[8];
                ld8bf(P + (size_t)(t0 + t) * NIN1 + 1024 + ck, f);
                ld8bf(P + (size_t)(t0 + t) * NIN1 + 512 + ck, qv[it]);
                ld8f(aux0 + ck, l0); ld8f(aux0 + 512 + ck, l1);
#pragma unroll
                for (int j = 0; j < 8; ++j) {
                    const float lbv = 1.f / (1.f + __expf(l0[j] - l1[j]));
                    const float sg = sigm(f[j]);
                    g[j] = __logf(lbv + (1.f - lbv) * sg); kr[j] = (1.f - lbv) * (1.f - sg); qv[it][j] = siluf(qv[it][j]);
                }
            }
#pragma unroll
            for (int j = 0; j < 8; ++j) { G[t * KP + c8 + j] = g[j]; KR[t * KP + c8 + j] = kr[j]; }
        }
#pragma unroll
        for (int it = 0; it < 2; ++it) {
            const int ch = tid + it * NTHREADS, t = ch >> 4, v8 = (ch & 15) * 8;
            float vv[8];
            ld8bf(LAYER == 0 ? P + (size_t)(t0 + t) * NIN0P + 2304 + h * 128 + v8 : P + (size_t)(t0 + t) * NIN1 + 1536 + h * 128 + v8, vv);
#pragma unroll
            for (int j = 0; j < 8; ++j) LV[t * 129 + v8 + j] = vv[j];
        }
        __syncthreads();
        for (int k = wave; k < K; k += NWAVES) {
            float v = G[lane * KP + k];
#pragma unroll
            for (int o = 1; o < 64; o <<= 1) { const float n = __shfl_up(v, o); if (lane >= o) v += n; }
            G[lane * KP + k] = v;
        }
        __syncthreads();
#pragma unroll
        for (int it = 0; it < NCH; ++it) {
            const int ch = tid + it * NTHREADS, t = ch / (K / 8), c8 = (ch % (K / 8)) * 8, ck = h * K + c8;
            float qo[8], ko[8];
#pragma unroll
            for (int j = 0; j < 8; ++j) { const float b = G[t * KP + c8 + j]; qo[j] = qv[it][j] * __expf(b); ko[j] = KR[t * KP + c8 + j] * __expf(-b); }
            *(u32x4*)(B.QT + (size_t)(t0 + t) * HK + ck) = pack8f(qo);
            *(u32x4*)(B.KT + (size_t)(t0 + t) * HK + ck) = pack8f(ko);
        }
#pragma unroll
        for (int it = 0; it < NCH; ++it) {
            const int id = tid + it * NTHREADS, t8 = (id & 7) * 8, k = id >> 3;
            const float bl = G[63 * KP + k];
            float o[8];
#pragma unroll
            for (int j = 0; j < 8; ++j) o[j] = KR[(t8 + j) * KP + k] * __expf(bl - G[(t8 + j) * KP + k]);
            *(u32x4*)(B.KDT + ((size_t)cg * HK + h * K + k) * 64 + t8) = pack8f(o);
            if (t8 == 0) B.DG[(size_t)cg * HK + h * K + k] = __expf(bl);
        }
#pragma unroll
        for (int it = 0; it < 2; ++it) {
            const int id = tid + it * NTHREADS, t8 = (id & 7) * 8, vc = id >> 3;
            float o[8];
#pragma unroll
            for (int j = 0; j < 8; ++j) o[j] = LV[(t8 + j) * 129 + vc];
            *(u32x4*)(B.VT + ((size_t)cg * 512 + h * 128 + vc) * 64 + t8) = pack8f(o);
        }
        __syncthreads();
    }
}

template <int K, bool DSBF>
__device__ __forceinline__ void gla_pass1_unit(const GlaBufs& B, int unit, int lane) {
    constexpr int HK = 4 * K, KT16 = K / 16;
    const int item = unit / KT16, kt = unit % KT16, cg = item >> 2, h = item & 3;
    const int r = lane & 15, q = lane >> 4;
    const bf16_t* ap = B.KDT + ((size_t)cg * HK + h * K + kt * 16 + r) * 64 + 8 * q;
    const bf16x8 a0 = *(const bf16x8*)ap, a1 = *(const bf16x8*)(ap + 32);
    const size_t dso = ((size_t)item * 128 + r) * K + kt * 16 + 4 * q;
#pragma unroll
    for (int vt = 0; vt < 8; ++vt) {
        const bf16_t* bp = B.VT + ((size_t)cg * 512 + h * 128 + vt * 16 + r) * 64 + 8 * q;
        const bf16x8 b0 = *(const bf16x8*)bp, b1 = *(const bf16x8*)(bp + 32);
        f32x4 acc = {0.f, 0.f, 0.f, 0.f};
        acc = __builtin_amdgcn_mfma_f32_16x16x32_bf16(a0, b0, acc, 0, 0, 0);
        acc = __builtin_amdgcn_mfma_f32_16x16x32_bf16(a1, b1, acc, 0, 0, 0);
        if (DSBF) { u32x2 w; w.x = pk2(acc[0], acc[1]); w.y = pk2(acc[2], acc[3]); *(u32x2*)((bf16_t*)B.DS + dso + (size_t)vt * 16 * K) = w; }
        else *(f32x4*)((float*)B.DS + dso + (size_t)vt * 16 * K) = acc;
    }
}

template <int K, bool DSBF>
__device__ __forceinline__ void gla_pass2(const GlaBufs& B, int gthread, int gthreads) {
    constexpr int HK = 4 * K;
    const float* __restrict__ DSf = (const float*)B.DS; const bf16_t* __restrict__ DSb = (const bf16_t*)B.DS; const float* __restrict__ DG = B.DG; bf16_t* __restrict__ SP = B.SP;
    for (int e = gthread; e < 8 * 128 * K; e += gthreads) {
        const int k = e % K, v = (e / K) & 127, bh = e / (K * 128), b = bh >> 2, h = bh & 3;
        float S = 0.f;
#pragma unroll 8
        for (int c = 0; c < 128; ++c) {
            const int cg = b * 128 + c;
            const size_t idx = ((size_t)(cg * 4 + h) * 128 + v) * K + k;
            const float d = DG[(size_t)cg * HK + h * K + k], ds = DSBF ? bf2f(DSb[idx]) : DSf[idx];
            SP[idx] = f2bf(S);
            S = d * S + ds;
        }
    }
}

template <int K, int LAYER>
__device__ __forceinline__ void gla_pass3_item(LAS unsigned char* lds, const bf16_t* P, const float* norm_g, const GlaBufs& B, bf16_t* Ymix, int item) {
    constexpr int HK = 4 * K, KS = K / 32;
    LAS bf16_t* Ls = (LAS bf16_t*)lds;
    LAS float* Lo = (LAS float*)(lds + 64 * 72 * 2);
    const int tid = TIDX, lane = tid & 63, wave = tid >> 6, r = lane & 15, q = lane >> 4;
    const int cg = item >> 2, h = item & 3, t0 = cg * 64;
    const int it = wave >> 1, i0 = it * 16;
    bf16x8 qf[KS];
#pragma unroll
    for (int s = 0; s < KS; ++s) qf[s] = *(const bf16x8*)(B.QT + (size_t)(t0 + i0 + r) * HK + h * K + 32 * s + 8 * q);
#pragma unroll
    for (int jj2 = 0; jj2 < 2; ++jj2) {
        const int j0 = ((wave & 1) * 2 + jj2) * 16;
        f32x4 acc = {0.f, 0.f, 0.f, 0.f};
        if (j0 <= i0) {
#pragma unroll
            for (int s = 0; s < KS; ++s) {
                const bf16x8 kf = *(const bf16x8*)(B.KT + (size_t)(t0 + j0 + r) * HK + h * K + 32 * s + 8 * q);
                acc = __builtin_amdgcn_mfma_f32_16x16x32_bf16(kf, qf[s], acc, 0, 0, 0);
            }
        }
        const int i = i0 + r;
        u32x2 w;
        w.x = pk2((j0 + 4 * q + 0) <= i ? acc[0] : 0.f, (j0 + 4 * q + 1) <= i ? acc[1] : 0.f);
        w.y = pk2((j0 + 4 * q + 2) <= i ? acc[2] : 0.f, (j0 + 4 * q + 3) <= i ? acc[3] : 0.f);
        *(LAS u32x2*)(Ls + i * 72 + j0 + 4 * q) = w;
    }
    __syncthreads();
    const bf16x8 sf0 = *(const LAS bf16x8*)(Ls + (i0 + r) * 72 + 8 * q), sf1 = *(const LAS bf16x8*)(Ls + (i0 + r) * 72 + 32 + 8 * q);
#pragma unroll
    for (int vv = 0; vv < 4; ++vv) {
        const int v0 = ((wave & 1) * 4 + vv) * 16;
        f32x4 acc = {0.f, 0.f, 0.f, 0.f};
#pragma unroll
        for (int s = 0; s < KS; ++s) {
            const bf16x8 sp = *(const bf16x8*)(B.SP + ((size_t)item * 128 + v0 + r) * K + 32 * s + 8 * q);
            acc = __builtin_amdgcn_mfma_f32_16x16x32_bf16(sp, qf[s], acc, 0, 0, 0);
        }
        const bf16_t* vp = B.VT + ((size_t)cg * 512 + h * 128 + v0 + r) * 64 + 8 * q;
        const bf16x8 vf0 = *(const bf16x8*)vp, vf1 = *(const bf16x8*)(vp + 32);
        acc = __builtin_amdgcn_mfma_f32_16x16x32_bf16(vf0, sf0, acc, 0, 0, 0);
        acc = __builtin_amdgcn_mfma_f32_16x16x32_bf16(vf1, sf1, acc, 0, 0, 0);
        *(LAS f32x4*)(Lo + (i0 + r) * 132 + v0 + 4 * q) = acc;
    }
    __syncthreads();
#pragma unroll 2
    for (int rr = 0; rr < 8; ++rr) {
        const int i = wave * 8 + rr, t = t0 + i;
        const float o0 = Lo[i * 132 + lane], o1 = Lo[i * 132 + 64 + lane];
        const float ms = wave_sum(o0 * o0 + o1 * o1) * (1.f / 128.f);
        const float rs = rsqrtf(ms + LN_EPS);
        float g0, g1;
        if (LAYER == 0) { g0 = bf2f(P[(size_t)t * NIN0P + 2832 + h * 128 + lane]); g1 = bf2f(P[(size_t)t * NIN0P + 2832 + h * 128 + 64 + lane]); }
        else { g0 = bf2f(P[(size_t)t * NIN1 + 2048 + h * 128 + lane]); g1 = bf2f(P[(size_t)t * NIN1 + 2048 + h * 128 + 64 + lane]); }
        Ymix[(size_t)t * D_ + 512 + h * 128 + lane] = f2bf(o0 * rs * norm_g[lane] * siluf(g0));
        Ymix[(size_t)t * D_ + 512 + h * 128 + 64 + lane] = f2bf(o1 * rs * norm_g[64 + lane] * siluf(g1));
    }
    __syncthreads();
}


template <int CTRL> __device__ __forceinline__ float dppf(float x) { return __builtin_bit_cast(float, __builtin_amdgcn_mov_dpp(__builtin_bit_cast(int, x), CTRL, 0xf, 0xf, true)); }
__device__ __forceinline__ float reduce32(float x) {
    x += dppf<0xB1>(x);
    x += dppf<0x4E>(x);
    x += dppf<0x141>(x);
    x += dppf<0x140>(x);
    auto sw = __builtin_amdgcn_permlane16_swap(__float_as_uint(x), __float_as_uint(x), false, false);
    return __uint_as_float(sw[0]) + __uint_as_float(sw[1]);
}
__device__ __forceinline__ void rwkv_scan_v1(LAS float* lds, const bf16_t* SC, float* YRW, int unit) {
    constexpr int TS = 32, TILE = 5 * TS * 64 + TS * 16;
    const int bh = unit >> 3, qr = unit & 7, b = bh >> 3, h = bh & 7;
    const int tid = TIDX, lane = tid & 63, wave = tid >> 6, cp = lane & 31, rl = (wave & 3) * 2 + (lane >> 5);
    const size_t S1 = (size_t)T_ * 512;
    const int chunk = tid & 255, ls = chunk >> 3, lc0 = (chunk & 7) * 8, half = tid >> 8;
    const bf16_t* g0 = SC + (half == 0 ? 0 : 4 * S1) + (size_t)(b * L_ + ls) * 512 + h * 64 + lc0;
    const bf16_t* g1 = SC + (half == 0 ? 1 * S1 : 5 * S1) + (size_t)(b * L_ + ls) * 512 + h * 64 + lc0;
    const bf16_t* g2 = (half == 0) ? SC + 2 * S1 + (size_t)(b * L_ + ls) * 512 + h * 64 + lc0
                                   : SC + 3 * S1 + (size_t)(b * L_ + ls) * 512 + h * 64 + qr * 8;
    u32x4 p0, p1, p2;
    p0 = *(const u32x4*)g0; p1 = *(const u32x4*)g1; p2 = *(const u32x4*)g2;
    float S0 = 0.f, S1v = 0.f;
    auto unpack8 = [](const u32x4 v, float* f) {
        f[0] = __uint_as_float(v.x << 16); f[1] = __uint_as_float(v.x & 0xffff0000u); f[2] = __uint_as_float(v.y << 16); f[3] = __uint_as_float(v.y & 0xffff0000u);
        f[4] = __uint_as_float(v.z << 16); f[5] = __uint_as_float(v.z & 0xffff0000u); f[6] = __uint_as_float(v.w << 16); f[7] = __uint_as_float(v.w & 0xffff0000u); };
    auto stage = [&](LAS float* buf) {
        float f0[8], f1[8], f2[8];
        unpack8(p0, f0); unpack8(p1, f1); unpack8(p2, f2);
        if (half == 0) {
#pragma unroll
            for (int j = 0; j < 8; ++j) { buf[(4 * TS + ls) * 64 + lc0 + j] = f0[j]; buf[(1 * TS + ls) * 64 + lc0 + j] = __expf(f1[j]); buf[(3 * TS + ls) * 64 + lc0 + j] = f2[j]; }
        } else {
#pragma unroll
            for (int j = 0; j < 8; ++j) { buf[(0 * TS + ls) * 64 + lc0 + j] = -f0[j]; buf[(2 * TS + ls) * 64 + lc0 + j] = f0[j] * f1[j]; }
            if ((chunk & 7) == 0) {
#pragma unroll
                for (int j = 0; j < 8; ++j) buf[5 * TS * 64 + ls * 16 + j] = f2[j];
            }
        }
    };
    stage(lds);
    __syncthreads();
    for (int t0 = 0; t0 < L_; t0 += TS) {
        LAS float* cur = lds + ((t0 / TS) & 1) * TILE;
        LAS float* nxt = lds + (((t0 / TS) & 1) ^ 1) * TILE;
        const bool more = (t0 + TS) < L_;
        if (more) { const size_t adv = (size_t)(t0 + TS) * 512; p0 = *(const u32x4*)(g0 + adv); p1 = *(const u32x4*)(g1 + adv); p2 = *(const u32x4*)(g2 + adv); }
        float* yout = YRW + (size_t)(b * L_ + t0) * 512 + h * 64 + qr * 8 + rl;
        if (wave < 4) {
        typedef float f32x2v __attribute__((ext_vector_type(2)));
        f32x2v a2 = *(const LAS f32x2v*)(cur + (0 * TS) * 64 + 2 * cp), w2 = *(const LAS f32x2v*)(cur + (1 * TS) * 64 + 2 * cp), b2 = *(const LAS f32x2v*)(cur + (2 * TS) * 64 + 2 * cp),
               k2 = *(const LAS f32x2v*)(cur + (3 * TS) * 64 + 2 * cp), r2 = *(const LAS f32x2v*)(cur + (4 * TS) * 64 + 2 * cp);
        float vv = cur[5 * TS * 64 + rl];
        float ysel = 0.f;
#pragma unroll
        for (int s = 0; s < TS; ++s) {
            const int sn = (s + 1) & (TS - 1);
            const f32x2v a2n = *(const LAS f32x2v*)(cur + (0 * TS + sn) * 64 + 2 * cp), w2n = *(const LAS f32x2v*)(cur + (1 * TS + sn) * 64 + 2 * cp),
                         b2n = *(const LAS f32x2v*)(cur + (2 * TS + sn) * 64 + 2 * cp), k2n = *(const LAS f32x2v*)(cur + (3 * TS + sn) * 64 + 2 * cp),
                         r2n = *(const LAS f32x2v*)(cur + (4 * TS + sn) * 64 + 2 * cp);
            const float vvn = cur[5 * TS * 64 + sn * 16 + rl];
            const float sa = reduce32(S0 * a2.x + S1v * a2.y);
            S0 = S0 * w2.x + (sa * b2.x + vv * k2.x);
            S1v = S1v * w2.y + (sa * b2.y + vv * k2.y);
            const float y = reduce32(S0 * r2.x + S1v * r2.y);
            ysel = (cp == s) ? y : ysel;
            a2 = a2n; w2 = w2n; b2 = b2n; k2 = k2n; r2 = r2n; vv = vvn;
        }
        yout[(size_t)cp * 512] = ysel;
        }
        if (more) stage(nxt);
        __syncthreads();
    }
}


__device__ __forceinline__ bf16x8 ldfrag(const LAS bf16_t* tile, int row0, int ks, int r, int q) { return *(const LAS bf16x8*)(tile + (row0 + r) * 72 + 32 * ks + 8 * q); }
__device__ __forceinline__ f32x4 mm64(f32x4 acc, const LAS bf16_t* A, int arow0, const LAS bf16_t* B, int brow0, int r, int q) {
    acc = __builtin_amdgcn_mfma_f32_16x16x32_bf16(ldfrag(A, arow0, 0, r, q), ldfrag(B, brow0, 0, r, q), acc, 0, 0, 0);
    acc = __builtin_amdgcn_mfma_f32_16x16x32_bf16(ldfrag(A, arow0, 1, r, q), ldfrag(B, brow0, 1, r, q), acc, 0, 0, 0);
    return acc;
}
__device__ __forceinline__ void rwkv_chunk_pre(LAS unsigned char* lds, const bf16_t* SC, bf16_t* Gout, bf16_t* Rmout, float* HTout, bf16_t* Ymout, int item) {
    const int bh = item >> 7, chn = item & 127, b = bh >> 3, h = bh & 7;
    const size_t S1 = (size_t)T_ * 512, base = (size_t)(b * L_ + chn * 64) * 512 + h * 64;
    LAS bf16_t* TL = (LAS bf16_t*)lds;
#define RTILE(k) (TL + (k) * 4608)
    LAS float* F = (LAS float*)(lds + 12 * 9216);
    LAS float* LL = F + 64 * 68;
    const int tid = TIDX, lane = tid & 63, wave = tid >> 6, r = lane & 15, q = lane >> 4;
    const int t = tid >> 3, c0 = (tid & 7) * 8;
    float ldv[8];
    { const u32x4 v = *(const u32x4*)(SC + 1 * S1 + base + (size_t)t * 512 + c0); unpack8f(v, ldv);
#pragma unroll
      for (int j = 0; j < 8; ++j) F[t * 68 + c0 + j] = ldv[j]; }
    __syncthreads();
#pragma unroll
    for (int cc = 0; cc < 8; ++cc) {
        const int c = wave * 8 + cc;
        float v = F[lane * 68 + c];
#pragma unroll
        for (int o = 1; o < 64; o <<= 1) { const float n = __shfl_up(v, o); if (lane >= o) v += n; }
        F[lane * 68 + c] = v;
    }
    __syncthreads();
    {
        float rr[8], kp[8], vv[8], kk[8], aa[8];
        unpack8f(*(const u32x4*)(SC + 0 * S1 + base + (size_t)t * 512 + c0), rr);
        unpack8f(*(const u32x4*)(SC + 2 * S1 + base + (size_t)t * 512 + c0), kp);
        unpack8f(*(const u32x4*)(SC + 3 * S1 + base + (size_t)t * 512 + c0), vv);
        unpack8f(*(const u32x4*)(SC + 4 * S1 + base + (size_t)t * 512 + c0), kk);
        unpack8f(*(const u32x4*)(SC + 5 * S1 + base + (size_t)t * 512 + c0), aa);
        float at[8], rt[8], bt[8], kt[8];
#pragma unroll
        for (int j = 0; j < 8; ++j) {
            const float cs = F[t * 68 + c0 + j], last = __expf(F[63 * 68 + c0 + j]);
            const float Lt = __expf(cs), Ltm1 = __expf(cs - ldv[j]), inv = __expf(-cs);
            at[j] = -kk[j] * Ltm1; rt[j] = rr[j] * Lt; bt[j] = kk[j] * aa[j] * inv; kt[j] = kp[j] * inv;
            RTILE(4)[(c0 + j) * 72 + t] = f2bf(at[j]);
            RTILE(5)[(c0 + j) * 72 + t] = f2bf(bt[j] * last);
            RTILE(6)[(c0 + j) * 72 + t] = f2bf(kt[j] * last);
            RTILE(7)[(c0 + j) * 72 + t] = f2bf(vv[j]);
            if (t == 63) LL[c0 + j] = last;
        }
        *(LAS u32x4*)(RTILE(0) + t * 72 + c0) = pack8f(at);
        *(LAS u32x4*)(RTILE(1) + t * 72 + c0) = pack8f(bt);
        *(LAS u32x4*)(RTILE(2) + t * 72 + c0) = pack8f(kt);
        *(LAS u32x4*)(RTILE(3) + t * 72 + c0) = pack8f(rt);
    }
    __syncthreads();
    {
        const int mtx = wave >> 1;
        const LAS bf16_t* X = (mtx < 2) ? RTILE(0) : RTILE(3);
        const LAS bf16_t* Y = (mtx & 1) ? RTILE(2) : RTILE(1);
#pragma unroll
        for (int k8 = 0; k8 < 8; ++k8) {
            const int idx = (wave & 1) * 8 + k8, ti = idx >> 2, si = idx & 3;
            f32x4 acc = {0.f, 0.f, 0.f, 0.f};
            if (si <= ti) acc = mm64(acc, Y, si * 16, X, ti * 16, r, q);
            const int tt = ti * 16 + r, s0 = si * 16 + 4 * q;
#pragma unroll
            for (int jj = 0; jj < 4; ++jj) { const bool keep = (mtx < 2) ? (s0 + jj < tt) : (s0 + jj <= tt); acc[jj] = keep ? acc[jj] : 0.f; }
            if (mtx == 0) *(LAS f32x4*)(F + tt * 68 + s0) = acc;
            else { u32x2 w; w.x = pk2(acc[0], acc[1]); w.y = pk2(acc[2], acc[3]); *(LAS u32x2*)(RTILE(7 + mtx) + tt * 72 + s0) = w; }
        }
    }
    __syncthreads();
    if (wave == 0) {
        float X[64];
        int lz = lane; asm volatile("" : "+v"(lz));
        const LAS float* Fb = F; asm volatile("" : "+v"(Fb));
#pragma unroll
        for (int tt = 0; tt < 64; ++tt) {
            float acc = (tt == lz) ? 1.f : 0.f;
#pragma unroll
            for (int s4 = 0; s4 < (tt + 3) / 4; ++s4) {
                const f32x4 a = *(const LAS f32x4*)(Fb + tt * 68 + 4 * s4);
#pragma unroll
                for (int j = 0; j < 4; ++j) if (4 * s4 + j < tt) acc += a[j] * X[4 * s4 + j];
            }
            X[tt] = acc;
            RTILE(11)[tt * 72 + lz] = f2bf(acc);
        }
    } else {
        for (int idx = wave - 1; idx < 16; idx += 7) {
            const int vi = idx >> 2, ti = idx & 3;
            f32x4 acc = {0.f, 0.f, 0.f, 0.f};
            acc = mm64(acc, RTILE(8), ti * 16, RTILE(7), vi * 16, r, q);
            u32x2 w; w.x = pk2(acc[0], acc[1]); w.y = pk2(acc[2], acc[3]);
            *(LAS u32x2*)(RTILE(2) + (vi * 16 + r) * 72 + ti * 16 + 4 * q) = w;
        }
    }
    __syncthreads();
#pragma unroll
    for (int k = 0; k < 4; ++k) {
        const int idx = wave * 4 + k, which = idx >> 4, xi = (idx >> 2) & 3, ti = idx & 3;
        f32x4 acc = {0.f, 0.f, 0.f, 0.f};
        acc = mm64(acc, RTILE(11), ti * 16, which ? RTILE(2) : RTILE(4), xi * 16, r, q);
        u32x2 w; w.x = pk2(acc[0], acc[1]); w.y = pk2(acc[2], acc[3]);
        *(LAS u32x2*)((which ? RTILE(1) : RTILE(0)) + (xi * 16 + r) * 72 + ti * 16 + 4 * q) = w;
    }
    __syncthreads();
#pragma unroll
    for (int k = 0; k < 8; ++k) {
        const int idx = wave * 8 + k, which = idx >> 4, i1 = (idx >> 2) & 3, i2 = idx & 3;
        f32x4 acc = {0.f, 0.f, 0.f, 0.f};
        if (which == 0) {
            acc = mm64(acc, RTILE(0), i2 * 16, RTILE(9), i1 * 16, r, q);
            const int tt = i1 * 16 + r, cc = i2 * 16 + 4 * q;
            const u32x2 rv = *(const LAS u32x2*)(RTILE(3) + tt * 72 + cc);
            acc[0] += __uint_as_float(rv.x << 16); acc[1] += __uint_as_float(rv.x & 0xffff0000u); acc[2] += __uint_as_float(rv.y << 16); acc[3] += __uint_as_float(rv.y & 0xffff0000u);
            u32x2 w; w.x = pk2(acc[0], acc[1]); w.y = pk2(acc[2], acc[3]);
            *(u32x2*)(Rmout + (size_t)item * 4096 + tt * 64 + cc) = w;
        } else if (which == 1) {
            acc = mm64(acc, RTILE(9), i1 * 16, RTILE(1), i2 * 16, r, q);
            acc = mm64(acc, RTILE(10), i1 * 16, RTILE(7), i2 * 16, r, q);
            u32x2 w; w.x = pk2(acc[0], acc[1]); w.y = pk2(acc[2], acc[3]);
            *(u32x2*)(Ymout + (((size_t)item * 16 + i1 * 4 + i2) * 64 + lane) * 4) = w;
        } else if (which == 2) {
            acc = mm64(acc, RTILE(0), i2 * 16, RTILE(5), i1 * 16, r, q);
            const int c1 = i1 * 16 + r, c2 = i2 * 16 + 4 * q;
#pragma unroll
            for (int jj = 0; jj < 4; ++jj) if (c2 + jj == c1) acc[jj] += LL[c1];
            u32x2 w; w.x = pk2(acc[0], acc[1]); w.y = pk2(acc[2], acc[3]);
            *(u32x2*)(Gout + (size_t)item * 4096 + c1 * 64 + c2) = w;
        } else {
            acc = mm64(acc, RTILE(5), i1 * 16, RTILE(1), i2 * 16, r, q);
            acc = mm64(acc, RTILE(6), i1 * 16, RTILE(7), i2 * 16, r, q);
            *(f32x4*)(HTout + (((size_t)item * 16 + i1 * 4 + i2) * 64 + lane) * 4) = acc;
        }
    }
    __syncthreads();
#undef RTILE
}

__device__ __forceinline__ void rwkv_chunk_seq(LAS unsigned char* lds, const bf16_t* G, const bf16_t* Rm, const float* HT, const bf16_t* Ym, float* YRW, int bh) {
    const int b = bh >> 3, h = bh & 7;
    const int tid = TIDX, lane = tid & 63, wave = tid >> 6, r = lane & 15, q = lane >> 4;
    const int rt = wave >> 1, vi0 = (wave & 1) * 2;
    LAS bf16_t* Sb0 = (LAS bf16_t*)lds;
    f32x4 Sacc[2] = {{0.f, 0.f, 0.f, 0.f}, {0.f, 0.f, 0.f, 0.f}};
    size_t item = (size_t)bh * 128;
    auto fetch = [&](size_t it, bf16x8* rm, bf16x8* g, u32x2* ym, f32x4* ht) {
#pragma unroll
        for (int ks = 0; ks < 2; ++ks) {
            rm[ks] = *(const bf16x8*)(Rm + it * 4096 + (rt * 16 + r) * 64 + 32 * ks + 8 * q);
            g[ks] = *(const bf16x8*)(G + it * 4096 + (rt * 16 + r) * 64 + 32 * ks + 8 * q);
        }
#pragma unroll
        for (int k = 0; k < 2; ++k) {
            ym[k] = *(const u32x2*)(Ym + ((it * 16 + rt * 4 + vi0 + k) * 64 + lane) * 4);
            ht[k] = *(const f32x4*)(HT + ((it * 16 + rt * 4 + vi0 + k) * 64 + lane) * 4);
        }
    };
    constexpr int PF = 4;
    bf16x8 prm[PF][2], pg[PF][2]; u32x2 pym[PF][2]; f32x4 pht[PF][2];
#pragma unroll
    for (int u = 0; u < PF; ++u) fetch(item + u, prm[u], pg[u], pym[u], pht[u]);
    for (int ch0 = 0; ch0 < 128; ch0 += PF) {
#pragma unroll
        for (int u = 0; u < PF; ++u) {
            const int ch = ch0 + u;
            LAS bf16_t* Sb = Sb0 + (ch & 1) * 4608;
#pragma unroll
            for (int k = 0; k < 2; ++k) { u32x2 w; w.x = pk2(Sacc[k][0], Sacc[k][1]); w.y = pk2(Sacc[k][2], Sacc[k][3]); *(LAS u32x2*)(Sb + ((vi0 + k) * 16 + r) * 72 + rt * 16 + 4 * q) = w; }
            asm volatile("s_waitcnt lgkmcnt(0)" ::: "memory"); __builtin_amdgcn_s_barrier(); asm volatile("" ::: "memory");
            float* yb = YRW + (size_t)(b * L_ + ch * 64 + rt * 16 + 4 * q) * 512 + h * 64 + r;
#pragma unroll
            for (int k = 0; k < 2; ++k) {
                const bf16x8 s0 = ldfrag(Sb, (vi0 + k) * 16, 0, r, q), s1 = ldfrag(Sb, (vi0 + k) * 16, 1, r, q);
                f32x4 ya; ya[0] = __uint_as_float(pym[u][k].x << 16); ya[1] = __uint_as_float(pym[u][k].x & 0xffff0000u); ya[2] = __uint_as_float(pym[u][k].y << 16); ya[3] = __uint_as_float(pym[u][k].y & 0xffff0000u);
                ya = __builtin_amdgcn_mfma_f32_16x16x32_bf16(prm[u][0], s0, ya, 0, 0, 0);
                ya = __builtin_amdgcn_mfma_f32_16x16x32_bf16(prm[u][1], s1, ya, 0, 0, 0);
                f32x4 sa = pht[u][k];
                sa = __builtin_amdgcn_mfma_f32_16x16x32_bf16(pg[u][0], s0, sa, 0, 0, 0);
                sa = __builtin_amdgcn_mfma_f32_16x16x32_bf16(pg[u][1], s1, sa, 0, 0, 0);
                Sacc[k] = sa;
#pragma unroll
                for (int jj = 0; jj < 4; ++jj) yb[(size_t)jj * 512 + (vi0 + k) * 16] = ya[jj];
            }
            const int nch = ch + PF < 128 ? ch + PF : 127;
            fetch(item + nch, prm[u], pg[u], pym[u], pht[u]);
        }
    }
}


__device__ __forceinline__ void rwkv_chunk_seq2(LAS unsigned char* lds, const bf16_t* G, const bf16_t* Rm, const float* HT, const bf16_t* Ym, float* YRW, int unit) {
    constexpr int PF = 12;
    const int bh = unit >> 2, vq = unit & 3, b = bh >> 3, h = bh & 7;
    const int tid = TIDX, lane = tid & 63, wave = tid >> 6, r = lane & 15, q = lane >> 4;
    const int ti = wave & 3;
    LAS bf16_t* Sb0 = (LAS bf16_t*)lds;
    const size_t item0 = (size_t)bh * 128;
    if (wave < 4) {
        bf16x8 pa[PF][2]; u32x2 py[PF];
        const bf16_t* ra = Rm + item0 * 4096 + (ti * 16 + r) * 64 + 8 * q;
        const bf16_t* ya = Ym + ((item0 * 16 + ti * 4 + vq) * 64 + lane) * 4;
#pragma unroll
        for (int u = 0; u < PF; ++u) { pa[u][0] = *(const bf16x8*)(ra + (size_t)u * 4096); pa[u][1] = *(const bf16x8*)(ra + (size_t)u * 4096 + 32); py[u] = *(const u32x2*)(ya + (size_t)u * 4096); }
        for (int ch0 = 0; ch0 < 132; ch0 += PF) {
#pragma unroll
            for (int u = 0; u < PF; ++u) {
                const int ch = ch0 + u;
                if (ch < 128) {
                    const LAS bf16_t* Sb = Sb0 + (ch & 1) * 1152;
                    asm volatile("s_waitcnt lgkmcnt(0)" ::: "memory"); __builtin_amdgcn_s_barrier(); asm volatile("" ::: "memory");
                    const bf16x8 s0 = ldfrag(Sb, 0, 0, r, q), s1 = ldfrag(Sb, 0, 1, r, q);
                    f32x4 ya4; ya4[0] = __uint_as_float(py[u].x << 16); ya4[1] = __uint_as_float(py[u].x & 0xffff0000u); ya4[2] = __uint_as_float(py[u].y << 16); ya4[3] = __uint_as_float(py[u].y & 0xffff0000u);
                    ya4 = __builtin_amdgcn_mfma_f32_16x16x32_bf16(pa[u][0], s0, ya4, 0, 0, 0);
                    ya4 = __builtin_amdgcn_mfma_f32_16x16x32_bf16(pa[u][1], s1, ya4, 0, 0, 0);
                    float* yb = YRW + (size_t)(b * L_ + ch * 64 + ti * 16 + 4 * q) * 512 + h * 64 + vq * 16 + r;
#pragma unroll
                    for (int jj = 0; jj < 4; ++jj) yb[(size_t)jj * 512] = ya4[jj];
                    const int nch = ch + PF < 128 ? ch + PF : 127;
                    pa[u][0] = *(const bf16x8*)(ra + (size_t)nch * 4096); pa[u][1] = *(const bf16x8*)(ra + (size_t)nch * 4096 + 32); py[u] = *(const u32x2*)(ya + (size_t)nch * 4096);
                }
            }
        }
    } else {
        bf16x8 pa[PF][2]; f32x4 ph[PF];
        const bf16_t* ga = G + item0 * 4096 + (ti * 16 + r) * 64 + 8 * q;
        const float* ha = HT + ((item0 * 16 + ti * 4 + vq) * 64 + lane) * 4;
#pragma unroll
        for (int u = 0; u < PF; ++u) { pa[u][0] = *(const bf16x8*)(ga + (size_t)u * 4096); pa[u][1] = *(const bf16x8*)(ga + (size_t)u * 4096 + 32); ph[u] = *(const f32x4*)(ha + (size_t)u * 4096); }
        f32x4 Sacc = {0.f, 0.f, 0.f, 0.f};
        for (int ch0 = 0; ch0 < 132; ch0 += PF) {
#pragma unroll
            for (int u = 0; u < PF; ++u) {
                const int ch = ch0 + u;
                if (ch < 128) {
                    LAS bf16_t* Sb = Sb0 + (ch & 1) * 1152;
                    { u32x2 w; w.x = pk2(Sacc[0], Sacc[1]); w.y = pk2(Sacc[2], Sacc[3]); *(LAS u32x2*)(Sb + r * 72 + ti * 16 + 4 * q) = w; }
                    asm volatile("s_waitcnt lgkmcnt(0)" ::: "memory"); __builtin_amdgcn_s_barrier(); asm volatile("" ::: "memory");
                    const bf16x8 s0 = ldfrag(Sb, 0, 0, r, q), s1 = ldfrag(Sb, 0, 1, r, q);
                    f32x4 sa = ph[u];
                    sa = __builtin_amdgcn_mfma_f32_16x16x32_bf16(pa[u][0], s0, sa, 0, 0, 0);
                    sa = __builtin_amdgcn_mfma_f32_16x16x32_bf16(pa[u][1], s1, sa, 0, 0, 0);
                    Sacc = sa;
                    const int nch = ch + PF < 128 ? ch + PF : 127;
                    pa[u][0] = *(const bf16x8*)(ga + (size_t)nch * 4096); pa[u][1] = *(const bf16x8*)(ga + (size_t)nch * 4096 + 32); ph[u] = *(const f32x4*)(ha + (size_t)nch * 4096);
                }
            }
        }
    }
}

__device__ __forceinline__ void sub_barrier(unsigned* ctr, unsigned nblocks) {
    asm volatile("s_waitcnt vmcnt(0)" ::: "memory");
    __syncthreads();
    if (TIDX == 0) {
        __builtin_amdgcn_fence(__ATOMIC_RELEASE, "agent");
        asm volatile("s_waitcnt vmcnt(0)" ::: "memory");
        xb_add(ctr, 1u);
        unsigned sp = 0;
        while (xb_ld(ctr) < nblocks) { __builtin_amdgcn_s_sleep(2); if (++sp > (1u << 22)) break; }
        __builtin_amdgcn_fence(__ATOMIC_ACQUIRE, "agent");
        asm volatile("s_waitcnt vmcnt(0)" ::: "memory");
    }
    __syncthreads();
}


__device__ __forceinline__ void s5_tables(LAS float* lds, const float* a_re, const float* a_im, const float* log_dt, const float* b_re, const float* b_im,
                                          const float* c_re, const float* c_im, bf16_t* MB, bf16_t* WE, int g) {
    LAS float* pwr = lds;
    LAS float* pwi = pwr + 33 * 64;
    LAS float* zbr = pwi + 33 * 64;
    LAS float* zbi = zbr + 1024;
    LAS float* cr = zbi + 1024;
    LAS float* ci = cr + 1024;
    LAS float* kern = ci + 1024;
    const int tid = TIDX;
    const float dt = __expf(log_dt[g]);
    for (int idx = tid; idx < 33 * 64; idx += NTHREADS) {
        const int tau = idx >> 6, n = idx & 63;
        const float lam_re = fminf(a_re[g * 64 + n], -1e-4f), lam_im = a_im[g * 64 + n];
        const float m = __expf(lam_re * dt * (float)tau), ang = lam_im * dt * (float)tau;
        pwr[idx] = m * cosf(ang); pwi[idx] = m * sinf(ang);
    }
    for (int idx = tid; idx < 1024; idx += NTHREADS) {
        const int n = idx >> 4;
        const float lam_re = fminf(a_re[g * 64 + n], -1e-4f), lam_im = a_im[g * 64 + n];
        const float mag = __expf(lam_re * dt);
        const float ab_re = mag * cosf(lam_im * dt), ab_im = mag * sinf(lam_im * dt);
        const float den = lam_re * lam_re + lam_im * lam_im, num_re = ab_re - 1.f;
        const float z_re = (num_re * lam_re + ab_im * lam_im) / den, z_im = (ab_im * lam_re - num_re * lam_im) / den;
        const float br = b_re[(size_t)g * 1024 + idx], bi = b_im[(size_t)g * 1024 + idx];
        zbr[idx] = z_re * br - z_im * bi; zbi[idx] = z_re * bi + z_im * br;
        cr[idx] = c_re[(size_t)g * 1024 + idx]; ci[idx] = c_im[(size_t)g * 1024 + idx];
    }
    __syncthreads();
    {
        const int c = (tid >> 4) & 15, cp = tid & 15, th = tid >> 8;
        float acc[16];
#pragma unroll
        for (int i = 0; i < 16; ++i) acc[i] = 0.f;
        for (int n = 0; n < 64; ++n) {
            const float xr = cr[c * 64 + n], xi = ci[c * 64 + n], zr = zbr[n * 16 + cp], zi = zbi[n * 16 + cp];
            const float pr = xr * zr - xi * zi, pi = xr * zi + xi * zr;
#pragma unroll
            for (int i = 0; i < 16; ++i) acc[i] += pr * pwr[(th * 16 + i) * 64 + n] - pi * pwi[(th * 16 + i) * 64 + n];
        }
#pragma unroll
        for (int i = 0; i < 16; ++i) kern[((th * 16 + i) * 16 + c) * 16 + cp] = acc[i];
    }
    __syncthreads();
    {
        const int row = tid, i = row >> 4, c = row & 15;
        bf16_t* dst = MB + ((size_t)g * 512 + row) * 640;
        for (int ch = 0; ch < 64; ++ch) {
            const int j = ch >> 1, cp0 = (ch & 1) * 8;
            float v[8];
            if (j <= i) { const f32x4 a = *(const LAS f32x4*)(kern + ((i - j) * 16 + c) * 16 + cp0), b = *(const LAS f32x4*)(kern + ((i - j) * 16 + c) * 16 + cp0 + 4);
                          v[0] = a.x; v[1] = a.y; v[2] = a.z; v[3] = a.w; v[4] = b.x; v[5] = b.y; v[6] = b.z; v[7] = b.w; }
            else {
#pragma unroll
                for (int k = 0; k < 8; ++k) v[k] = 0.f; }
            *(u32x4*)(dst + ch * 8) = pack8f(v);
        }
        for (int ch = 0; ch < 16; ++ch) {
            const int n0 = (ch & 7) * 8; const bool im = ch >= 8;
            float v[8];
#pragma unroll
            for (int k = 0; k < 8; ++k) {
                const float xr = cr[c * 64 + n0 + k], xi = ci[c * 64 + n0 + k], pr = pwr[(i + 1) * 64 + n0 + k], pi = pwi[(i + 1) * 64 + n0 + k];
                v[k] = im ? -(xr * pi + xi * pr) : (xr * pr - xi * pi);
            }
            *(u32x4*)(dst + 512 + ch * 8) = pack8f(v);
        }
    }
    {
        const int np = tid >> 1, hf = tid & 1, n = np & 63;
        bf16_t* dst = WE + ((size_t)g * 256 + np) * 512 + hf * 256;
        for (int ch = 0; ch < 32; ++ch) {
            const int col = hf * 256 + ch * 8, j = col >> 4, cp0 = col & 15;
            float v[8];
            if (np < 128) {
                const float pr = pwr[(31 - j) * 64 + n], pi = pwi[(31 - j) * 64 + n];
#pragma unroll
                for (int k = 0; k < 8; ++k) { const float zr = zbr[n * 16 + cp0 + k], zi = zbi[n * 16 + cp0 + k]; v[k] = np < 64 ? (pr * zr - pi * zi) : (pr * zi + pi * zr); }
            } else {
#pragma unroll
                for (int k = 0; k < 8; ++k) v[k] = 0.f; }
            *(u32x4*)(dst + ch * 8) = pack8f(v);
        }
    }
    __syncthreads();
}
__device__ __forceinline__ void s5_fill_ua(const bf16_t* P1, bf16_t* UA, int gw, int ngw, int lane) {
    for (int t = gw; t < T_; t += ngw) {
        const int b = t >> 13, tt = t & 8191, c32 = tt >> 5, j = tt & 31, g = lane >> 1, c0 = (lane & 1) * 8;
        const u32x4 v = *(const u32x4*)(P1 + (size_t)t * NIN1 + 8 * lane);
        *(u32x4*)(UA + ((size_t)g * 512 + b * 256 + c32) * 640 + j * 16 + c0) = v;
    }
}
__device__ __forceinline__ void s5_carry(const float* a_re, const float* a_im, const float* log_dt, const float* E, bf16_t* UA, int th) {
    const int n = th & 63, g = (th >> 6) & 31, b = th >> 11;
    const float lam_re = fminf(a_re[g * 64 + n], -1e-4f), lam_im = a_im[g * 64 + n];
    const float dt = __expf(log_dt[g]);
    const float m = __expf(lam_re * dt * 32.f), ang = lam_im * dt * 32.f;
    const float ar = m * cosf(ang), ai = m * sinf(ang);
    float hr = 0.f, hi = 0.f;
#pragma unroll 32
    for (int c = 0; c < 256; ++c) {
        const size_t row = (size_t)g * 512 + b * 256 + c;
        const float er = E[row * 128 + n], ei = E[row * 128 + 64 + n];
        UA[row * 640 + 512 + n] = f2bf(hr); UA[row * 640 + 576 + n] = f2bf(hi);
        const float nr = ar * hr - ai * hi + er, ni = ar * hi + ai * hr + ei;
        hr = nr; hi = ni;
    }
}

struct Args {
    const float* in[42];
    float* out;
    unsigned char* ws;
    int ph_lo, ph_hi;
};

template <bool DUAL, class AF, class WF, class EF>
__device__ __forceinline__ void naive_gemm(LAS float* lds, int M, int N, int K, AF arow, WF wbase, int ldw, EF epi) {
    LAS float* As = lds;
    LAS float* Bs = lds + 64 * 33;
    LAS float* Bs2 = Bs + 32 * 64;
    const int tid = TIDX, ty = tid >> 4, tx = tid & 15;
    const int tm = (M + 63) / 64, tn = (N + 63) / 64;
    for (int tile = blockIdx.x; tile < tm * tn; tile += gridDim.x) {
        const int m0 = (tile / tn) * 64, n0 = (tile % tn) * 64;
        const float* W = wbase(m0, 0);
        const float* W2 = DUAL ? wbase(m0, 1) : W;
        float acc[2][4], acc2[2][4];
#pragma unroll
        for (int i = 0; i < 2; ++i)
#pragma unroll
            for (int j = 0; j < 4; ++j) { acc[i][j] = 0.f; acc2[i][j] = 0.f; }
        for (int k0 = 0; k0 < K; k0 += 32) {
#pragma unroll
            for (int i = 0; i < 4; ++i) {
                const int idx = tid + i * 512, r = idx >> 5, kk = idx & 31, m = m0 + r;
                As[r * 33 + kk] = (m < M) ? bf2f(arow(m)[k0 + kk]) : 0.f;
            }
#pragma unroll
            for (int i = 0; i < 4; ++i) {
                const int idx = tid + i * 512, kk = idx >> 6, n = idx & 63;
                const bool ok = (n0 + n) < N;
                Bs[kk * 64 + n] = ok ? W[(size_t)(k0 + kk) * ldw + n0 + n] : 0.f;
                if (DUAL) Bs2[kk * 64 + n] = ok ? W2[(size_t)(k0 + kk) * ldw + n0 + n] : 0.f;
            }
            __syncthreads();
#pragma unroll 8
            for (int kk = 0; kk < 32; ++kk) {
                const float a0 = As[(ty * 2) * 33 + kk], a1 = As[(ty * 2 + 1) * 33 + kk];
#pragma unroll
                for (int j = 0; j < 4; ++j) {
                    const float b = Bs[kk * 64 + tx * 4 + j];
                    acc[0][j] += a0 * b; acc[1][j] += a1 * b;
                    if (DUAL) { const float b2 = Bs2[kk * 64 + tx * 4 + j]; acc2[0][j] += a0 * b2; acc2[1][j] += a1 * b2; }
                }
            }
            __syncthreads();
        }
#pragma unroll
        for (int i = 0; i < 2; ++i)
#pragma unroll
            for (int j = 0; j < 4; ++j) {
                const int m = m0 + ty * 2 + i, n = n0 + tx * 4 + j;
                if (m < M && n < N) epi(m, n, acc[i][j], acc2[i][j]);
            }
    }
}

template <class SRC, class DROW>
__device__ __forceinline__ void xpose_item(SRC src, DROW drow, bf16_t* WT, int ldk, LAS float* scr, int k0, int n0, int lane) {
#pragma unroll 8
    for (int i = 0; i < 32; ++i) { const int kk = 2 * i + (lane >> 5); scr[kk * 33 + (lane & 31)] = src(k0 + kk, n0 + (lane & 31)); }
    asm volatile("s_waitcnt lgkmcnt(0)" ::: "memory");
    const int c = lane & 7;
#pragma unroll
    for (int j = 0; j < 4; ++j) {
        const int n = (lane >> 3) + 8 * j; const LAS float* sp = scr + (8 * c) * 33 + n;
        u32x4 o; o.x = pk2(sp[0 * 33], sp[1 * 33]); o.y = pk2(sp[2 * 33], sp[3 * 33]); o.z = pk2(sp[4 * 33], sp[5 * 33]); o.w = pk2(sp[6 * 33], sp[7 * 33]);
        *(u32x4*)(WT + (size_t)drow(n0 + n) * ldk + k0 + 8 * c) = o;
    }
    asm volatile("s_waitcnt lgkmcnt(0)" ::: "memory");
}
template <class SRC4, class DROW>
__device__ __forceinline__ void xpose_item4(SRC4 src, DROW drow, bf16_t* WT, int ldk, LAS float* scr, int k0, int n0, int lane) {
    f32x4 v[8];
#pragma unroll
    for (int i = 0; i < 8; ++i) v[i] = src(k0 + 8 * i + (lane >> 3), n0 + 4 * (lane & 7));
#pragma unroll
    for (int i = 0; i < 8; ++i) { LAS float* d = scr + (8 * i + (lane >> 3)) * 33 + 4 * (lane & 7); d[0] = v[i].x; d[1] = v[i].y; d[2] = v[i].z; d[3] = v[i].w; }
    asm volatile("s_waitcnt lgkmcnt(0)" ::: "memory");
    const int c = lane & 7;
#pragma unroll
    for (int j = 0; j < 4; ++j) {
        const int n = (lane >> 3) + 8 * j; const LAS float* sp = scr + (8 * c) * 33 + n;
        u32x4 o; o.x = pk2(sp[0 * 33], sp[1 * 33]); o.y = pk2(sp[2 * 33], sp[3 * 33]); o.z = pk2(sp[4 * 33], sp[5 * 33]); o.w = pk2(sp[6 * 33], sp[7 * 33]);
        *(u32x4*)(WT + (size_t)drow(n0 + n) * ldk + k0 + 8 * c) = o;
    }
    asm volatile("s_waitcnt lgkmcnt(0)" ::: "memory");
}
__device__ __forceinline__ void convert_plain(const float* W, int K, int N, int NP, bf16_t* WT, LAS float* scr, int gw, int ngw, int lane) {
    const int nblk = NP / 32, nitems = (K / 64) * nblk;
    for (int it = gw; it < nitems; it += ngw) {
        const int k0 = 64 * (it / nblk), n0 = 32 * (it % nblk);
        xpose_item4([&](int k, int n4) { return n4 < N ? *(const f32x4*)(W + (size_t)k * N + n4) : (f32x4){0.f, 0.f, 0.f, 0.f}; }, [&](int n) { return n; }, WT, K, scr, k0, n0, lane);
    }
}
__device__ __forceinline__ void convert_lora(const float* w2, const float* a2, const float* g2, bf16_t* WT, LAS float* scr, int gw, int ngw, int lane) {
    const int nblk = NLORA / 32, nitems = 4 * nblk;
    for (int it = gw; it < nitems; it += ngw) {
        const int k0 = 64 * (it / nblk), n0 = 32 * (it % nblk);
        xpose_item([&](int k, int n) {
            if (n < 512) return k < 64 ? w2[k * 512 + n] : 0.f;
            if (n < 1024) return (k >= 64 && k < 128) ? a2[(k - 64) * 512 + (n - 512)] : 0.f;
            return k >= 128 ? g2[(k - 128) * 512 + (n - 1024)] : 0.f; }, [&](int n) { return n; }, WT, 256, scr, k0, n0, lane);
    }
}
__device__ __forceinline__ void convert_moe(const float* w1, const float* w3, const float* w2, bf16_t* W13, bf16_t* W2T, LAS float* scr, int gw, int ngw, int lane) {
    constexpr int I13 = 16 * 32, I2 = 8 * 32, IE = I13 + I2;
    for (int it = gw; it < 32 * IE; it += ngw) {
        const int e = it / IE, r = it % IE;
        if (r < I13) {
            const int k0 = 64 * (r / 32), n0 = 32 * (r % 32);
            const float* a = w1 + (size_t)e * D_ * 512; const float* b = w3 + (size_t)e * D_ * 512;
            xpose_item4([&](int k, int n4) { return n4 < 512 ? *(const f32x4*)(a + (size_t)k * 512 + n4) : *(const f32x4*)(b + (size_t)k * 512 + (n4 - 512)); },
                       [&](int n) { const int c = n & 511; return (c >> 2) * 8 + (n >> 9) * 4 + (c & 3); }, W13 + (size_t)e * 1024 * 1024, 1024, scr, k0, n0, lane);
        } else {
            const int rr = r - I13, k0 = 64 * (rr / 32), n0 = 32 * (rr % 32);
            const float* a = w2 + (size_t)e * 512 * D_;
            xpose_item4([&](int k, int n4) { return *(const f32x4*)(a + (size_t)k * D_ + n4); }, [&](int n) { return n; }, W2T + (size_t)e * 1024 * 512, 512, scr, k0, n0, lane);
        }
    }
}

__device__ __forceinline__ void ph_prologue(const float* x, bf16_t* hb) {
    const size_t n4 = (size_t)T_ * D_ / 4;
    for (size_t i = (size_t)blockIdx.x * NTHREADS + TIDX; i < n4; i += (size_t)gridDim.x * NTHREADS) {
        const f32x4 v = ((const f32x4*)x)[i];
        u32x2 o; o.x = pk2(v.x, v.y); o.y = pk2(v.z, v.w);
        ((u32x2*)hb)[i] = o;
    }
    for (size_t i = (size_t)blockIdx.x * NTHREADS + TIDX; i < (size_t)256 * D_ / 2; i += (size_t)gridDim.x * NTHREADS)
        ((unsigned*)(hb + (size_t)T_ * D_))[i] = 0u;
}

__device__ __forceinline__ float p0_shift(const bf16_t* P, const float* mu, int t, int c) {
    const float p = bf2f(P[(size_t)t * NIN0P + c]);
    const float pv = ((t & (L_ - 1)) == 0) ? 0.f : bf2f(P[(size_t)(t - 1) * NIN0P + c]);
    return p + mu[c] * (pv - p);
}
template <bool WITH_GLA>
__device__ __forceinline__ void ph_prepA0(const bf16_t* P, const float* mu, const float* gk_w2, const float* gk_b, bf16_t* Ap, float* gla_la) {
    for (int chunk = blockIdx.x; chunk < T_ / 64; chunk += gridDim.x) {
        for (int idx = TIDX; idx < 64 * 256; idx += NTHREADS) {
            const int tl = idx >> 8, j = idx & 255, t = chunk * 64 + tl;
            float v;
            if (j < 64) v = tanhf(p0_shift(P, mu, t, 512 + j));
            else if (j < 128) v = p0_shift(P, mu, t, 1600 + (j - 64));
            else v = sigm(p0_shift(P, mu, t, 1664 + (j - 128)));
            Ap[(size_t)t * 256 + j] = f2bf(v);
            if (WITH_GLA) {
                float gk = gk_b[j];
#pragma unroll
                for (int i = 0; i < 16; ++i) gk += bf2f(P[(size_t)t * NIN0P + 2816 + i]) * gk_w2[i * 256 + j];
                const float ls = fminf(gk, 0.f) - log1pf(__expf(-fabsf(gk)));
                gla_la[(size_t)t * 256 + j] = ls * (1.f / 16.f);
            }
        }
    }
}

__device__ __forceinline__ void ph_prepB0(const bf16_t* P, const bf16_t* LO, const float* mu, const float* w0, const float* a0, const float* k_k, const float* k_a,
                                          const float* r_k, bf16_t* SC, float* BON) {
    const int wave = TIDX >> 6, lane = TIDX & 63;
    for (int item = blockIdx.x * NWAVES + wave; item < T_ * 8; item += gridDim.x * NWAVES) {
        const int t = item >> 3, h = item & 7, c = h * 64 + lane;
        const float r = p0_shift(P, mu, t, c), k = p0_shift(P, mu, t, 576 + c), v = p0_shift(P, mu, t, 1088 + c);
        const float low = bf2f(LO[(size_t)t * 512 + c]), loa = bf2f(LO[(size_t)T_ * 512 + (size_t)t * 512 + c]);
        const float xw = w0[c] + low;
        const float wraw = -softplusf(-xw) - 0.5f;
        const float ld = -__expf(wraw);
        const float a = sigm(a0[c] + loa);
        const float kkr = k * k_k[c];
        const float ss = wave_sum(kkr * kkr);
        const float kk = kkr / fmaxf(sqrtf(ss), 1e-12f);
        const float kp = k * (1.f + (a - 1.f) * k_a[c]);
        const float bon = wave_sum(r * kp * r_k[c]);
        const size_t o = (size_t)t * 512 + c, S1 = (size_t)T_ * 512;
        SC[o] = f2bf(r); SC[S1 + o] = f2bf(ld); SC[2 * S1 + o] = f2bf(kp); SC[3 * S1 + o] = f2bf(v); SC[4 * S1 + o] = f2bf(kk); SC[5 * S1 + o] = f2bf(a);
        if (lane == 0) BON[(size_t)t * 8 + h] = bon;
    }
}

__device__ __forceinline__ void naive_rwkv_scan(LAS float* lds, const bf16_t* SC, float* YRW, int bh) {
    constexpr int TS = 32;
    const int b = bh >> 3, h = bh & 7;
    LAS float* Lnkk = lds;
    LAS float* Ldec = lds + TS * 64;
    LAS float* Lab = lds + 2 * TS * 64;
    LAS float* Lkp = lds + 3 * TS * 64;
    LAS float* Lr = lds + 4 * TS * 64;
    LAS float* Lv = lds + 5 * TS * 64;
    const size_t S1 = (size_t)T_ * 512;
    float S[64];
#pragma unroll
    for (int k = 0; k < 64; ++k) S[k] = 0.f;
    const int lane = TIDX & 63, wave = TIDX >> 6;
    for (int t0 = 0; t0 < L_; t0 += TS) {
        for (int idx = TIDX; idx < TS * 64; idx += NTHREADS) {
            const int s = idx >> 6, k = idx & 63;
            const size_t o = (size_t)(b * L_ + t0 + s) * 512 + h * 64 + k;
            const float r = bf2f(SC[o]), ld = bf2f(SC[S1 + o]), kp = bf2f(SC[2 * S1 + o]), v = bf2f(SC[3 * S1 + o]), kk = bf2f(SC[4 * S1 + o]), a = bf2f(SC[5 * S1 + o]);
            Lnkk[idx] = -kk; Ldec[idx] = __expf(ld); Lab[idx] = kk * a; Lkp[idx] = kp; Lr[idx] = r; Lv[idx] = v;
        }
        __syncthreads();
        if (wave == 0) {
            for (int s = 0; s < TS; ++s) {
                float sa = 0.f;
#pragma unroll
                for (int k = 0; k < 64; ++k) sa += S[k] * Lnkk[s * 64 + k];
                const float vv = Lv[s * 64 + lane];
                float y = 0.f;
#pragma unroll
                for (int k = 0; k < 64; ++k) {
                    S[k] = S[k] * Ldec[s * 64 + k] + sa * Lab[s * 64 + k] + vv * Lkp[s * 64 + k];
                    y += S[k] * Lr[s * 64 + k];
                }
                YRW[(size_t)(b * L_ + t0 + s) * 512 + h * 64 + lane] = y;
            }
        }
        __syncthreads();
    }
}

template <int K, class LDF, class LVF>
__device__ __forceinline__ void naive_gla_scan(LAS float* lds, LDF ld, LVF lv, float* OG, int b, int h) {
    constexpr int TS = 16;
    LAS float* Lq = lds;
    LAS float* Lk = lds + TS * K;
    LAS float* Le = lds + 2 * TS * K;
    LAS float* Lv = lds + 3 * TS * K;
    float S[K];
#pragma unroll
    for (int k = 0; k < K; ++k) S[k] = 0.f;
    const int tid = TIDX;
    for (int t0 = 0; t0 < L_; t0 += TS) {
        for (int idx = tid; idx < TS * K; idx += NTHREADS) {
            const int s = idx / K, k = idx % K;
            float q, kk, e; ld(b * L_ + t0 + s, h * K + k, q, kk, e);
            Lq[idx] = q; Lk[idx] = kk; Le[idx] = e;
        }
        for (int idx = tid; idx < TS * 128; idx += NTHREADS) {
            const int s = idx >> 7, vc = idx & 127;
            Lv[idx] = lv(b * L_ + t0 + s, h * 128 + vc);
        }
        __syncthreads();
        if (tid < 128) {
            for (int s = 0; s < TS; ++s) {
                const float vv = Lv[s * 128 + tid];
                float o = 0.f;
#pragma unroll
                for (int k = 0; k < K; ++k) {
                    S[k] = S[k] * Le[s * K + k] + Lk[s * K + k] * vv;
                    o += Lq[s * K + k] * S[k];
                }
                OG[(size_t)(b * L_ + t0 + s) * 512 + h * 128 + tid] = o;
            }
        }
        __syncthreads();
    }
}

template <bool WITH_GLA>
__device__ __forceinline__ void ph_fin0(const float* YRW, const float* OG, const bf16_t* P, const bf16_t* LO, const bf16_t* SC, const float* BON,
                                        const float* gn_g, const float* gn_b, const float* norm_g, bf16_t* Ymix) {
    const int wave = TIDX >> 6, lane = TIDX & 63;
    const size_t S1 = (size_t)T_ * 512;
    constexpr int NU = WITH_GLA ? 12 : 8;
    for (int item = blockIdx.x * NWAVES + wave; item < T_ * NU; item += gridDim.x * NWAVES) {
        const int t = item / NU, u = item % NU;
        if (u < 8) {
            const int c = u * 64 + lane;
            const float y = YRW[(size_t)t * 512 + c];
            const float mean = wave_sum(y) * (1.f / 64.f);
            const float d = y - mean;
            const float var = wave_sum(d * d) * (1.f / 64.f);
            const float yn = d * rsqrtf(var + 64e-5f) * gn_g[c] + gn_b[c];
            const float v = bf2f(SC[3 * S1 + (size_t)t * 512 + c]);
            const float g = bf2f(LO[(size_t)2 * T_ * 512 + (size_t)t * 512 + c]);
            Ymix[(size_t)t * D_ + c] = f2bf((yn + BON[(size_t)t * 8 + u] * v) * g);
        } else {
            const int h = u - 8;
            const float o0 = OG[(size_t)t * 512 + h * 128 + lane], o1 = OG[(size_t)t * 512 + h * 128 + 64 + lane];
            const float ms = wave_sum(o0 * o0 + o1 * o1) * (1.f / 128.f);
            const float rs = rsqrtf(ms + LN_EPS);
            const float g0 = bf2f(P[(size_t)t * NIN0P + 2832 + h * 128 + lane]), g1 = bf2f(P[(size_t)t * NIN0P + 2832 + h * 128 + 64 + lane]);
            Ymix[(size_t)t * D_ + 512 + h * 128 + lane] = f2bf(o0 * rs * norm_g[lane] * siluf(g0));
            Ymix[(size_t)t * D_ + 512 + h * 128 + 64 + lane] = f2bf(o1 * rs * norm_g[64 + lane] * siluf(g1));
        }
    }
}

__device__ __forceinline__ void ph_ln_router(const float* src, float* hf, bf16_t* hb, const float* lg, const float* lb, const float* wg, const float* bg,
                                             const float* we, const float* be, int* tok_e, int* tok_slot, float* tok_g, unsigned* cnt) {
    const int wave = TIDX >> 6, lane = TIDX & 63;
    for (int t = blockIdx.x * NWAVES + wave; t < T_; t += gridDim.x * NWAVES) {
        const f32x4* xr = (const f32x4*)(src + (size_t)t * D_) + lane;
        f32x4 v[4]; float s = 0.f;
#pragma unroll
        for (int j = 0; j < 4; ++j) { v[j] = xr[64 * j]; s += (v[j].x + v[j].y) + (v[j].z + v[j].w); }
        const float mean = wave_sum(s) * (1.f / D_);
        float s2 = 0.f;
#pragma unroll
        for (int j = 0; j < 4; ++j) { v[j] = v[j] - mean; s2 += (v[j].x * v[j].x + v[j].y * v[j].y) + (v[j].z * v[j].z + v[j].w * v[j].w); }
        const float rstd = rsqrtf(wave_sum(s2) * (1.f / D_) + LN_EPS);
#pragma unroll
        for (int j = 0; j < 4; ++j) {
            const f32x4 g = ((const f32x4*)lg)[lane + 64 * j], bb = ((const f32x4*)lb)[lane + 64 * j];
            v[j] = v[j] * rstd * g + bb;
            ((f32x4*)(hf + (size_t)t * D_))[lane + 64 * j] = v[j];
            u32x2 o; o.x = pk2(v[j].x, v[j].y); o.y = pk2(v[j].z, v[j].w);
            ((u32x2*)(hb + (size_t)t * D_))[lane + 64 * j] = o;
        }
        float cl[4] = {0.f, 0.f, 0.f, 0.f};
#pragma unroll
        for (int j = 0; j < 4; ++j)
#pragma unroll
            for (int e = 0; e < 4; ++e) {
                const int d = 4 * (lane + 64 * j) + e;
                const f32x4 w = *(const f32x4*)(wg + (size_t)d * 4);
                const float xv = v[j][e];
                cl[0] += xv * w.x; cl[1] += xv * w.y; cl[2] += xv * w.z; cl[3] += xv * w.w;
            }
#pragma unroll
        for (int g = 0; g < 4; ++g) cl[g] = wave_sum(cl[g]) + bg[g];
        int grp = 0; float mx = cl[0];
#pragma unroll
        for (int g = 1; g < 4; ++g) if (cl[g] > mx) { mx = cl[g]; grp = g; }
        float den = 0.f;
#pragma unroll
        for (int g = 0; g < 4; ++g) den += __expf(cl[g] - mx);
        const float p_grp = 1.f / den;
        float fl[8];
#pragma unroll
        for (int e = 0; e < 8; ++e) fl[e] = 0.f;
        const float* weg = we + (size_t)grp * D_ * 8;
#pragma unroll
        for (int j = 0; j < 4; ++j)
#pragma unroll
            for (int e = 0; e < 4; ++e) {
                const int d = 4 * (lane + 64 * j) + e;
                const f32x4 w0 = *(const f32x4*)(weg + (size_t)d * 8), w1 = *(const f32x4*)(weg + (size_t)d * 8 + 4);
                const float xv = v[j][e];
                fl[0] += xv * w0.x; fl[1] += xv * w0.y; fl[2] += xv * w0.z; fl[3] += xv * w0.w;
                fl[4] += xv * w1.x; fl[5] += xv * w1.y; fl[6] += xv * w1.z; fl[7] += xv * w1.w;
            }
#pragma unroll
        for (int e = 0; e < 8; ++e) fl[e] = wave_sum(fl[e]) + be[grp * 8 + e];
        int j0 = 0; float m0 = fl[0];
#pragma unroll
        for (int e = 1; e < 8; ++e) if (fl[e] > m0) { m0 = fl[e]; j0 = e; }
        int j1 = -1; float m1 = -3.0e38f;
#pragma unroll
        for (int e = 0; e < 8; ++e) if (e != j0 && fl[e] > m1) { m1 = fl[e]; j1 = e; }
        const float e1 = __expf(m1 - m0);
        const float g0 = p_grp / (1.f + e1), g1 = p_grp * e1 / (1.f + e1);
        if (lane == 0) {
            const int ex0 = grp * 8 + j0, ex1 = grp * 8 + j1;
            const unsigned s0 = atomicAdd(&cnt[ex0], 1u), s1 = atomicAdd(&cnt[ex1], 1u);
            tok_e[2 * t] = ex0; tok_e[2 * t + 1] = ex1;
            tok_slot[2 * t] = (int)s0; tok_slot[2 * t + 1] = (int)s1;
            tok_g[2 * t] = g0; tok_g[2 * t + 1] = g1;
        }
    }
}


__device__ __forceinline__ void shift8(const bf16_t* P, const float* mu, int t, int c, float* out) {
    float p[8], pv[8], m[8];
    ld8bf(P + (size_t)t * NIN0P + c, p); ld8f(mu + c, m);
    if ((t & (L_ - 1)) == 0) {
#pragma unroll
        for (int j = 0; j < 8; ++j) pv[j] = 0.f;
    } else ld8bf(P + (size_t)(t - 1) * NIN0P + c, pv);
#pragma unroll
    for (int j = 0; j < 8; ++j) out[j] = p[j] + m[j] * (pv[j] - p[j]);
}
__device__ __forceinline__ void ph_prepA0v(const bf16_t* P, const float* mu, bf16_t* Ap) {
    const int tid = TIDX, wave = tid >> 6, lane = tid & 63, l5 = lane & 31;
    for (int tp = blockIdx.x * NWAVES + wave; tp < T_ / 2; tp += gridDim.x * NWAVES) {
        const int t = tp * 2 + (lane >> 5), j0 = l5 * 8;
        const int c = j0 < 64 ? 512 + j0 : (j0 < 128 ? 1600 + (j0 - 64) : 1664 + (j0 - 128));
        float x[8]; shift8(P, mu, t, c, x);
#pragma unroll
        for (int j = 0; j < 8; ++j) x[j] = j0 < 64 ? tanhf(x[j]) : (j0 < 128 ? x[j] : sigm(x[j]));
        *(u32x4*)(Ap + (size_t)t * 256 + j0) = pack8f(x);
    }
}
__device__ __forceinline__ float sum8lanes(float v) { v += __shfl_xor(v, 1); v += __shfl_xor(v, 2); v += __shfl_xor(v, 4); return v; }
__device__ __forceinline__ void ph_prepB0v(const bf16_t* P, const bf16_t* LO, const float* mu, const float* w0, const float* a0, const float* k_k, const float* k_a,
                                           const float* r_k, bf16_t* SC, float* BON) {
    const int tid = TIDX, wave = tid >> 6, lane = tid & 63, c0 = lane * 8;
    const size_t S1 = (size_t)T_ * 512;
    for (int t = blockIdx.x * NWAVES + wave; t < T_; t += gridDim.x * NWAVES) {
        float r[8], k[8], v[8], low[8], loa[8], pw0[8], pa0[8], pkk[8], pka[8], prk[8];
        shift8(P, mu, t, c0, r); shift8(P, mu, t, 576 + c0, k); shift8(P, mu, t, 1088 + c0, v);
        ld8bf(LO + (size_t)t * 512 + c0, low); ld8bf(LO + S1 + (size_t)t * 512 + c0, loa);
        ld8f(w0 + c0, pw0); ld8f(a0 + c0, pa0); ld8f(k_k + c0, pkk); ld8f(k_a + c0, pka); ld8f(r_k + c0, prk);
        float ld[8], a[8], kkr[8], kp[8], ss = 0.f, bon = 0.f;
#pragma unroll
        for (int j = 0; j < 8; ++j) {
            const float xw = pw0[j] + low[j];
            const float wraw = -softplusf(-xw) - 0.5f;
            ld[j] = -__expf(wraw);
            a[j] = sigm(pa0[j] + loa[j]);
            kkr[j] = k[j] * pkk[j]; ss += kkr[j] * kkr[j];
            kp[j] = k[j] * (1.f + (a[j] - 1.f) * pka[j]);
            bon += r[j] * kp[j] * prk[j];
        }
        ss = sum8lanes(ss); bon = sum8lanes(bon);
        const float inv = 1.f / fmaxf(sqrtf(ss), 1e-12f);
#pragma unroll
        for (int j = 0; j < 8; ++j) kkr[j] *= inv;
        const size_t o = (size_t)t * 512 + c0;
        *(u32x4*)(SC + o) = pack8f(r); *(u32x4*)(SC + S1 + o) = pack8f(ld); *(u32x4*)(SC + 2 * S1 + o) = pack8f(kp);
        *(u32x4*)(SC + 3 * S1 + o) = pack8f(v); *(u32x4*)(SC + 4 * S1 + o) = pack8f(kkr); *(u32x4*)(SC + 5 * S1 + o) = pack8f(a);
        if ((lane & 7) == 0) BON[(size_t)t * 8 + (lane >> 3)] = bon;
    }
}
__device__ __forceinline__ void ph_fin0v(const float* YRW, const bf16_t* LO, const bf16_t* SC, const float* BON, const float* gn_g, const float* gn_b, bf16_t* Ymix) {
    const int tid = TIDX, wave = tid >> 6, lane = tid & 63, c0 = lane * 8;
    const size_t S1 = (size_t)T_ * 512;
    for (int t = blockIdx.x * NWAVES + wave; t < T_; t += gridDim.x * NWAVES) {
        float y[8], v[8], g[8], gg[8], gb[8];
        ld8f(YRW + (size_t)t * 512 + c0, y); ld8bf(SC + 3 * S1 + (size_t)t * 512 + c0, v); ld8bf(LO + 2 * S1 + (size_t)t * 512 + c0, g);
        ld8f(gn_g + c0, gg); ld8f(gn_b + c0, gb);
        const float bon = BON[(size_t)t * 8 + (lane >> 3)];
        float sm = 0.f;
#pragma unroll
        for (int j = 0; j < 8; ++j) sm += y[j];
        const float mean = sum8lanes(sm) * (1.f / 64.f);
        float sq = 0.f;
#pragma unroll
        for (int j = 0; j < 8; ++j) { y[j] -= mean; sq += y[j] * y[j]; }
        const float rs = rsqrtf(sum8lanes(sq) * (1.f / 64.f) + 64e-5f);
        float o[8];
#pragma unroll
        for (int j = 0; j < 8; ++j) o[j] = (y[j] * rs * gg[j] + gb[j] + bon * v[j]) * g[j];
        *(u32x4*)(Ymix + (size_t)t * D_ + c0) = pack8f(o);
    }
}

__device__ __forceinline__ void ph_ln_router2(LAS unsigned char* lds, const bf16_t* src, bf16_t* hb, const float* lg, const float* lb, const bf16_t* WrT, const float* bg, const float* be,
                                              int* tok_e, int* tok_slot, float* tok_g, unsigned* cnt) {
    LAS bf16_t* LW = (LAS bf16_t*)lds;
    LAS float* LGall = (LAS float*)(lds + 48 * 1032 * 2);
    const int tid = TIDX, wave = tid >> 6, lane = tid & 63, r = lane & 15, q = lane >> 4;
    for (int i = tid; i < 48 * 128; i += NTHREADS) { const int row = i >> 7, c8 = (i & 127) * 8; *(LAS u32x4*)(LW + row * 1032 + c8) = *(const u32x4*)(WrT + (size_t)row * 1024 + c8); }
    for (int rb = blockIdx.x; rb < T_ / 64; rb += gridDim.x) {
#pragma unroll 1
        for (int i = 0; i < 8; i += 2) {
            f32x4 v[2][4]; float sm[2], s2[2];
#pragma unroll
            for (int rr = 0; rr < 2; ++rr) {
                const u32x2* xr = (const u32x2*)(src + (size_t)(rb * 64 + wave * 8 + i + rr) * D_) + lane;
                sm[rr] = 0.f;
#pragma unroll
                for (int j = 0; j < 4; ++j) { const u32x2 xv = xr[64 * j];
                    v[rr][j].x = __uint_as_float(xv.x << 16); v[rr][j].y = __uint_as_float(xv.x & 0xffff0000u); v[rr][j].z = __uint_as_float(xv.y << 16); v[rr][j].w = __uint_as_float(xv.y & 0xffff0000u);
                    sm[rr] += (v[rr][j].x + v[rr][j].y) + (v[rr][j].z + v[rr][j].w); }
            }
#pragma unroll
            for (int o = 1; o < 64; o <<= 1) { sm[0] += __shfl_xor(sm[0], o); sm[1] += __shfl_xor(sm[1], o); }
#pragma unroll
            for (int rr = 0; rr < 2; ++rr) { const float mean = sm[rr] * (1.f / D_); s2[rr] = 0.f;
#pragma unroll
                for (int j = 0; j < 4; ++j) { v[rr][j] = v[rr][j] - mean; s2[rr] += (v[rr][j].x * v[rr][j].x + v[rr][j].y * v[rr][j].y) + (v[rr][j].z * v[rr][j].z + v[rr][j].w * v[rr][j].w); } }
#pragma unroll
            for (int o = 1; o < 64; o <<= 1) { s2[0] += __shfl_xor(s2[0], o); s2[1] += __shfl_xor(s2[1], o); }
#pragma unroll
            for (int rr = 0; rr < 2; ++rr) {
                const int t = rb * 64 + wave * 8 + i + rr;
                const float rstd = rsqrtf(s2[rr] * (1.f / D_) + LN_EPS);
#pragma unroll
                for (int j = 0; j < 4; ++j) {
                    const f32x4 g = ((const f32x4*)lg)[lane + 64 * j], bb = ((const f32x4*)lb)[lane + 64 * j];
                    const f32x4 o4 = v[rr][j] * rstd * g + bb;
                    u32x2 o; o.x = pk2(o4.x, o4.y); o.y = pk2(o4.z, o4.w);
                    ((u32x2*)(hb + (size_t)t * D_))[lane + 64 * j] = o;
                }
            }
        }
        asm volatile("s_waitcnt vmcnt(0)" ::: "memory");
        __syncthreads();
        if (wave < 4) {
            const bf16_t* arow = hb + (size_t)(rb * 64 + wave * 16 + r) * D_ + 8 * q;
            f32x4 acc[3] = {{0.f, 0.f, 0.f, 0.f}, {0.f, 0.f, 0.f, 0.f}, {0.f, 0.f, 0.f, 0.f}};
#pragma unroll 8
            for (int ks = 0; ks < 32; ++ks) {
                const bf16x8 af = *(const bf16x8*)(arow + 32 * ks);
#pragma unroll
                for (int ct = 0; ct < 3; ++ct) {
                    const bf16x8 bfr = *(const LAS bf16x8*)(LW + (ct * 16 + r) * 1032 + 32 * ks + 8 * q);
                    acc[ct] = __builtin_amdgcn_mfma_f32_16x16x32_bf16(af, bfr, acc[ct], 0, 0, 0);
                }
            }
            LAS float* LG = LGall + wave * (16 * 49);
#pragma unroll
            for (int ct = 0; ct < 3; ++ct)
#pragma unroll
                for (int j = 0; j < 4; ++j) LG[(4 * q + j) * 49 + ct * 16 + r] = acc[ct][j];
            asm volatile("s_waitcnt lgkmcnt(0)" ::: "memory");
            if (lane < 16) {
                const int t = rb * 64 + wave * 16 + lane;
                const LAS float* L = LG + lane * 49;
                float cl[4];
#pragma unroll
                for (int g = 0; g < 4; ++g) cl[g] = L[g] + bg[g];
                int grp = 0; float mx = cl[0];
#pragma unroll
                for (int g = 1; g < 4; ++g) if (cl[g] > mx) { mx = cl[g]; grp = g; }
                float den = 0.f;
#pragma unroll
                for (int g = 0; g < 4; ++g) den += __expf(cl[g] - mx);
                const float p_grp = 1.f / den;
                float fl[8];
#pragma unroll
                for (int e = 0; e < 8; ++e) fl[e] = L[4 + grp * 8 + e] + be[grp * 8 + e];
                int j0 = 0; float m0 = fl[0];
#pragma unroll
                for (int e = 1; e < 8; ++e) if (fl[e] > m0) { m0 = fl[e]; j0 = e; }
                int j1 = -1; float m1 = -3.0e38f;
#pragma unroll
                for (int e = 0; e < 8; ++e) if (e != j0 && fl[e] > m1) { m1 = fl[e]; j1 = e; }
                const float e1 = __expf(m1 - m0);
                const float g0 = p_grp / (1.f + e1), g1 = p_grp * e1 / (1.f + e1);
                const int ex0 = grp * 8 + j0, ex1 = grp * 8 + j1;
                const unsigned s0 = atomicAdd(&cnt[ex0], 1u), s1 = atomicAdd(&cnt[ex1], 1u);
                tok_e[2 * t] = ex0; tok_e[2 * t + 1] = ex1;
                tok_slot[2 * t] = (int)s0; tok_slot[2 * t + 1] = (int)s1;
                tok_g[2 * t] = g0; tok_g[2 * t + 1] = g1;
            }
        }
        __syncthreads();
    }
}
__device__ __forceinline__ void convert_router(const float* wg, const float* we, bf16_t* WrT, int gthread, int gthreads) {
    for (int i = gthread; i < 2 * 48 * 1024; i += gthreads) {
        const int layer = i / (48 * 1024), rem = i % (48 * 1024), col = rem >> 10, d = rem & 1023;
        float v = 0.f;
        if (col < 4) v = wg[((size_t)layer * D_ + d) * 4 + col];
        else if (col < 36) { const int g = (col - 4) >> 3, e = (col - 4) & 7; v = we[(((size_t)layer * 4 + g) * D_ + d) * 8 + e]; }
        WrT[i] = f2bf(v);
    }
}

__device__ __forceinline__ void moe_offsets(LAS int* pst, const unsigned* cnt) {
    if (TIDX == 0) {
        int acc = 0;
        for (int e = 0; e < 32; ++e) { pst[e] = acc; const int c = (int)cnt[e]; acc += (c + MOE_PAD - 1) / MOE_PAD * MOE_PAD; }
        pst[32] = acc;
    }
    __syncthreads();
}
__device__ __forceinline__ int moe_expert_of_row(const LAS int* pst, int r) {
    int e = 0;
#pragma unroll 1
    for (int i = 1; i < 32; ++i) if (r >= pst[i]) e = i;
    return e;
}

__device__ __forceinline__ void ph_dispatch(LAS int* pst, const unsigned* cnt, const bf16_t* hb, const int* tok_e, const int* tok_slot, int* tok_dest, bf16_t* XR) {
    moe_offsets(pst, cnt);
    const int wave = TIDX >> 6, lane = TIDX & 63;
    for (int item = blockIdx.x * NWAVES + wave; item < T_ * 2; item += gridDim.x * NWAVES) {
        const int t = item >> 1;
        const int e = tok_e[item], dest = pst[e] + tok_slot[item];
        if (lane == 0) tok_dest[item] = dest;
        const u32x4* src = (const u32x4*)(hb + (size_t)t * D_);
        u32x4* dst = (u32x4*)(XR + (size_t)dest * D_);
        dst[lane] = src[lane]; dst[lane + 64] = src[lane + 64];
    }
    const int R = pst[32];
    for (int r = blockIdx.x * NWAVES + wave; r < R; r += gridDim.x * NWAVES) {
        const int e = moe_expert_of_row(pst, r);
        if (r - pst[e] >= (int)cnt[e]) {
            u32x4* dst = (u32x4*)(XR + (size_t)r * D_);
            const u32x4 z = {0u, 0u, 0u, 0u};
            dst[lane] = z; dst[lane + 64] = z;
        }
    }
}

template <bool LAST>
__device__ __forceinline__ void ph_combine_ln(bf16_t* hb, const bf16_t* Y, const int* tok_dest, const float* tok_g, const float* lg, const float* lb, float* outf, bf16_t* hcopy) {
    const int wave = TIDX >> 6, lane = TIDX & 63;
    for (int t0 = (blockIdx.x * NWAVES + wave) * 8; t0 < T_; t0 += gridDim.x * NWAVES * 8) {
        const int dl = lane < 16 ? tok_dest[2 * t0 + lane] : 0;
        const float gl = lane < 16 ? tok_g[2 * t0 + lane] : 0.f;
#pragma unroll 1
        for (int i = 0; i < 8; i += 2) {
            f32x4 v[2][4];
#pragma unroll
            for (int rr = 0; rr < 2; ++rr) {
                const int t = t0 + i + rr;
                const int d0 = __shfl(dl, 2 * (i + rr)), d1 = __shfl(dl, 2 * (i + rr) + 1);
                const float g0 = __shfl(gl, 2 * (i + rr)), g1 = __shfl(gl, 2 * (i + rr) + 1);
#pragma unroll
                for (int j = 0; j < 4; ++j) {
                    const u32x2 hv = ((const u32x2*)(hb + (size_t)t * D_))[lane + 64 * j];
                    f32x4 h; h.x = __uint_as_float(hv.x << 16); h.y = __uint_as_float(hv.x & 0xffff0000u); h.z = __uint_as_float(hv.y << 16); h.w = __uint_as_float(hv.y & 0xffff0000u);
                    const u32x2 y0 = ((const u32x2*)(Y + (size_t)d0 * D_))[lane + 64 * j], y1 = ((const u32x2*)(Y + (size_t)d1 * D_))[lane + 64 * j];
                    f32x4 a, b;
                    a.x = __uint_as_float(y0.x << 16); a.y = __uint_as_float(y0.x & 0xffff0000u); a.z = __uint_as_float(y0.y << 16); a.w = __uint_as_float(y0.y & 0xffff0000u);
                    b.x = __uint_as_float(y1.x << 16); b.y = __uint_as_float(y1.x & 0xffff0000u); b.z = __uint_as_float(y1.y << 16); b.w = __uint_as_float(y1.y & 0xffff0000u);
                    v[rr][j] = h * DN_ALPHA + (a * g0 + b * g1);
                }
            }
            float sm[2], s2[2];
#pragma unroll
            for (int rr = 0; rr < 2; ++rr) { sm[rr] = 0.f;
#pragma unroll
                for (int j = 0; j < 4; ++j) sm[rr] += (v[rr][j].x + v[rr][j].y) + (v[rr][j].z + v[rr][j].w); }
#pragma unroll
            for (int o = 1; o < 64; o <<= 1) { sm[0] += __shfl_xor(sm[0], o); sm[1] += __shfl_xor(sm[1], o); }
#pragma unroll
            for (int rr = 0; rr < 2; ++rr) { const float mean = sm[rr] * (1.f / D_); s2[rr] = 0.f;
#pragma unroll
                for (int j = 0; j < 4; ++j) { v[rr][j] = v[rr][j] - mean; s2[rr] += (v[rr][j].x * v[rr][j].x + v[rr][j].y * v[rr][j].y) + (v[rr][j].z * v[rr][j].z + v[rr][j].w * v[rr][j].w); } }
#pragma unroll
            for (int o = 1; o < 64; o <<= 1) { s2[0] += __shfl_xor(s2[0], o); s2[1] += __shfl_xor(s2[1], o); }
#pragma unroll
            for (int rr = 0; rr < 2; ++rr) {
                const int t = t0 + i + rr;
                const float rstd = rsqrtf(s2[rr] * (1.f / D_) + LN_EPS);
#pragma unroll
                for (int j = 0; j < 4; ++j) {
                    const f32x4 g = ((const f32x4*)lg)[lane + 64 * j], bb = ((const f32x4*)lb)[lane + 64 * j];
                    const f32x4 o4 = v[rr][j] * rstd * g + bb;
                    if (LAST) ((f32x4*)(outf + (size_t)t * D_))[lane + 64 * j] = o4;
                    else { u32x2 o; o.x = pk2(o4.x, o4.y); o.y = pk2(o4.z, o4.w);
                           ((u32x2*)(hb + (size_t)t * D_))[lane + 64 * j] = o; ((u32x2*)(hcopy + (size_t)t * D_))[lane + 64 * j] = o; }
                }
            }
        }
    }
}

__device__ __forceinline__ void naive_s5_scan(const bf16_t* P1, const float* a_re, const float* a_im, const float* log_dt, const float* b_re, const float* b_im,
                                              const float* c_re, const float* c_im, const float* dvec, float* YS5, bf16_t* YS5B, int pair) {
    const int lane = TIDX & 63;
    const int b = pair >> 5, g = pair & 31, n = lane;
    const float lam_re = fminf(a_re[g * 64 + n], -1e-4f), lam_im = a_im[g * 64 + n];
    const float dt = __expf(log_dt[g]);
    const float mag = __expf(lam_re * dt);
    const float ab_re = mag * cosf(lam_im * dt), ab_im = mag * sinf(lam_im * dt);
    const float den = lam_re * lam_re + lam_im * lam_im;
    const float num_re = ab_re - 1.f;
    const float z_re = (num_re * lam_re + ab_im * lam_im) / den;
    const float z_im = (ab_im * lam_re - num_re * lam_im) / den;
    float bre[16], bim[16], cre[16], cim[16];
#pragma unroll
    for (int c = 0; c < 16; ++c) {
        bre[c] = b_re[(size_t)(g * 64 + n) * 16 + c]; bim[c] = b_im[(size_t)(g * 64 + n) * 16 + c];
        cre[c] = c_re[(size_t)(g * 16 + c) * 64 + n]; cim[c] = c_im[(size_t)(g * 16 + c) * 64 + n];
    }
    const float dd = (lane < 16) ? dvec[g * 16 + lane] : 0.f;
    float h_re = 0.f, h_im = 0.f;
    for (int tt = 0; tt < L_; ++tt) {
        const size_t t = (size_t)b * L_ + tt;
        const float ul = (lane < 16) ? bf2f(P1[t * NIN1 + g * 16 + lane]) : 0.f;
        float bur = 0.f, bui = 0.f;
#pragma unroll
        for (int c = 0; c < 16; ++c) { const float u = __shfl(ul, c); bur += u * bre[c]; bui += u * bim[c]; }
        const float x_re = z_re * bur - z_im * bui, x_im = z_re * bui + z_im * bur;
        const float nh_re = ab_re * h_re - ab_im * h_im + x_re;
        const float nh_im = ab_re * h_im + ab_im * h_re + x_im;
        h_re = nh_re; h_im = nh_im;
        float yv = 0.f;
#pragma unroll
        for (int c = 0; c < 16; ++c) { const float y = wave_sum(h_re * cre[c] - h_im * cim[c]); if (lane == c) yv = y; }
        if (lane < 16) {
            const float y = gelu_tanh(yv + dd * ul);
            YS5[t * 512 + g * 16 + lane] = y;
            YS5B[t * 512 + g * 16 + lane] = f2bf(y);
        }
    }
}

__device__ __forceinline__ void ph_fin1(const float* OG, const bf16_t* P1, const float* norm_g, bf16_t* Ymix) {
    const int wave = TIDX >> 6, lane = TIDX & 63;
    for (int item = blockIdx.x * NWAVES + wave; item < T_ * 4; item += gridDim.x * NWAVES) {
        const int t = item >> 2, h = item & 3;
        const float o0 = OG[(size_t)t * 512 + h * 128 + lane], o1 = OG[(size_t)t * 512 + h * 128 + 64 + lane];
        const float ms = wave_sum(o0 * o0 + o1 * o1) * (1.f / 128.f);
        const float rs = rsqrtf(ms + LN_EPS);
        const float g0 = bf2f(P1[(size_t)t * NIN1 + 2048 + h * 128 + lane]), g1 = bf2f(P1[(size_t)t * NIN1 + 2048 + h * 128 + 64 + lane]);
        Ymix[(size_t)t * D_ + 512 + h * 128 + lane] = f2bf(o0 * rs * norm_g[lane] * siluf(g0));
        Ymix[(size_t)t * D_ + 512 + h * 128 + 64 + lane] = f2bf(o1 * rs * norm_g[64 + lane] * siluf(g1));
    }
}

constexpr int LDS_BYTES = 147456;
constexpr int MISC_OFF = 131072 + 8192;
enum Phase {
    PH_PROLOGUE = 0,
    PH_INPROJ0, PH_PREPA0, PH_LORA0, PH_PREPB0, PH_SCAN0, PH_SCAN0B, PH_FIN0, PH_OUTPROJ0, PH_LN1_0, PH_DISP0, PH_UP0, PH_DOWN0, PH_COMB0,
    PH_INPROJ1, PH_L1A, PH_L1B, PH_L1C, PH_L1D,
#if !(FAST_HG && FAST_S5)
    PH_SCAN1, PH_FIN1,
#endif
    PH_GLU1, PH_OUTPROJ1, PH_LN1_1, PH_DISP1, PH_UP1, PH_DOWN1, PH_COMB1,
    PH_COUNT
};

typedef const Args __attribute__((address_space(4)))* KArgsP;
__device__ __forceinline__ KArgsP fresh_args() { KArgsP p = (KArgsP)__builtin_amdgcn_kernarg_segment_ptr(); asm volatile("" : "+s"(p)); return p; }
#define PHASE_BEGIN KArgsP ap = fresh_args(); unsigned char* const ws = ap->ws; (void)ws;
#define INP(i) (ap->in[i])
#define W_CTL ((unsigned*)(ws + WS_CTL))
#define W_HB ((bf16_t*)(ws + WS_HB))
#define W_WIN0 ((bf16_t*)(ws + WS_WIN0))
#define W_WOUT0 ((bf16_t*)(ws + WS_WOUT0))
#define W_WIN1 ((bf16_t*)(ws + WS_WIN1))
#define W_WOUT1 ((bf16_t*)(ws + WS_WOUT1))
#define W_WGLU ((bf16_t*)(ws + WS_WGLU))
#define W_WLORA ((bf16_t*)(ws + WS_WLORA))
#define W_WROUTER ((bf16_t*)(ws + WS_WROUTER))
#define W_W13 ((bf16_t*)(ws + WS_W13))
#define W_W2 ((bf16_t*)(ws + WS_W2))
#define W_HA ((float*)(ws + WS_HA))
#define W_YRW W_HA
#define W_OG (W_HA + (size_t)T_ * 512)
#define W_P ((bf16_t*)(ws + WS_P))
#define W_LO ((bf16_t*)(ws + WS_LO))
#define W_SC ((bf16_t*)(ws + WS_SCAN))
#define W_GLALA ((float*)(ws + WS_GLALA))
#define W_BON ((float*)(ws + WS_BON))
#define W_AP ((bf16_t*)(ws + WS_APRIME))
#define W_YS5B ((bf16_t*)(ws + WS_YS5B))
#define W_XR ((bf16_t*)(ws + WS_XR))
#define W_HID ((bf16_t*)(ws + WS_HID))
#define W_Y ((bf16_t*)(ws + WS_Y))
#define W_TOKE ((int*)(ws + WS_ROUTE))
#define W_TOKSLOT (W_TOKE + 2 * T_)
#define W_TOKDEST (W_TOKE + 4 * T_)
#define W_TOKG ((float*)(W_TOKE + 6 * T_))
#define W_YMIX W_HB
#define BIGP(mib) (ws + WS_BIG + (size_t)(mib) * MiB)
#define GLA0_BUFS GlaBufs{(bf16_t*)BIGP(256), (bf16_t*)BIGP(264), (bf16_t*)(ws + WS_HB), (bf16_t*)BIGP(273), (float*)BIGP(289), W_HA + (size_t)T_ * 512, (bf16_t*)BIGP(112)}
#define HG_BUFS GlaBufs{(bf16_t*)BIGP(96), (bf16_t*)BIGP(112), (bf16_t*)BIGP(144), (bf16_t*)BIGP(128), (float*)BIGP(192), (void*)BIGP(252), (bf16_t*)BIGP(160)}
#define W_S5WE ((bf16_t*)BIGP(244))
#define W_S5UA ((bf16_t*)BIGP(201))
#define W_S5MB ((bf16_t*)BIGP(224))
#define W_S5E ((float*)BIGP(193))
#define CW_SUB 12288

#define IN(k) (PLO <= (k) && (k) < PHI)
#define SEAM(k) do { if (IN(k) && IN((k) + 1)) { PHASE_BEGIN XcdBarrier bar_; bar_.bar = W_CTL + CW_BAR; bar_.x = xb_xcc_id(); bar_.st = (volatile LAS unsigned*)(lds + MISC_OFF) + 8; xcd_barrier(bar_); } } while (0)
template <int PLO, int PHI, int layer>
__device__ __forceinline__ void moe_layer(LAS unsigned char* lds) {
    LAS float* ldsf = (LAS float*)lds; (void)ldsf;
        const int base = layer == 0 ? PH_OUTPROJ0 : PH_OUTPROJ1;
        if (IN(base + 0)) {
            PHASE_BEGIN
            bf16_t* V1b = (bf16_t*)W_HA;
            if (layer == 0) { pg8::Gemm g{W_YMIX, W_WOUT0, T_, D_, D_}; pg8::StaticOrder S; S.init(T_, D_, (int)gridDim.x, (int)blockIdx.x); pg8::EpiResidBf16<false> E{INP(0), V1b, D_, DN_ALPHA};
                              pg8::gemm_phase<pg8::EpiResidBf16<false>, pg8::StaticOrder, true, true>(lds, g, S, E); }
            else { pg8::Gemm g{W_YMIX, W_WOUT1, T_, D_, D_}; pg8::StaticOrder S; S.init(T_, D_, (int)gridDim.x, (int)blockIdx.x); pg8::EpiResidBf16<true> E{(const bf16_t*)W_HA + (size_t)T_ * D_, V1b, D_, DN_ALPHA};
                   pg8::gemm_phase<pg8::EpiResidBf16<true>, pg8::StaticOrder, true, true>(lds, g, S, E); }
        }
        SEAM(base + 0);
        if (IN(base + 1)) {
            PHASE_BEGIN
            ph_ln_router2(lds, (const bf16_t*)W_HA, W_HB, INP(31) + layer * D_, INP(32) + layer * D_, W_WROUTER + (size_t)layer * 48 * 1024, INP(34) + layer * 4, INP(36) + layer * 32,
                          W_TOKE, W_TOKSLOT, W_TOKG, W_CTL + CW_CNT + 64 * layer);
        }
        SEAM(base + 1);
        if (IN(base + 2)) { PHASE_BEGIN ph_dispatch((LAS int*)lds, W_CTL + CW_CNT + 64 * layer, W_HB, W_TOKE, W_TOKSLOT, W_TOKDEST, W_XR); }
        SEAM(base + 2);
        if (IN(base + 3)) {
            PHASE_BEGIN
#if FAST_GEMM
            { LAS int* pst = (LAS int*)(lds + 131072 + 2048); LAS int* tile_e = (LAS int*)(lds + 131072 + 1024);
              moe_offsets(pst, W_CTL + CW_CNT + 64 * layer);
              const int ntiles = pst[32] / 256;
              if ((int)TIDX < ntiles) tile_e[TIDX] = moe_expert_of_row(pst, TIDX * 256);
              __syncthreads();
              pg8::Gemm g{W_XR, W_W13, ntiles * 256, 1024, D_}; pg8::MoeOrder S{ntiles, 4, (int)gridDim.x, (int)blockIdx.x, tile_e}; pg8::EpiSwiglu E{W_HID};
              pg8::gemm_phase<pg8::EpiSwiglu, pg8::MoeOrder, true, true>(lds, g, S, E); }
#else
            LAS int* pst = (LAS int*)(lds + 65536);
            moe_offsets(pst, W_CTL + CW_CNT + 64 * layer);
            const float* w1 = INP(37) + (size_t)layer * 32 * D_ * 512; const float* w3 = INP(38) + (size_t)layer * 32 * D_ * 512;
            const bf16_t* XR = W_XR; bf16_t* HID = W_HID;
            naive_gemm<true>(ldsf, pst[32], 512, D_, [&](int m) { return XR + (size_t)m * D_; },
                             [&](int m0, int which) { const int e = moe_expert_of_row(pst, m0); return (which ? w3 : w1) + (size_t)e * D_ * 512; }, 512,
                             [&](int m, int n, float a, float b) { HID[(size_t)m * 512 + n] = f2bf(siluf(a) * b); });
#endif
        }
        SEAM(base + 3);
        if (IN(base + 4)) {
            PHASE_BEGIN
#if FAST_GEMM
            { LAS int* pst = (LAS int*)(lds + 131072 + 2048); LAS int* tile_e = (LAS int*)(lds + 131072 + 1024);
              moe_offsets(pst, W_CTL + CW_CNT + 64 * layer);
              const int ntiles = pst[32] / 256;
              if ((int)TIDX < ntiles) tile_e[TIDX] = moe_expert_of_row(pst, TIDX * 256);
              __syncthreads();
              pg8::Gemm g{W_HID, W_W2, ntiles * 256, 1024, 512}; pg8::MoeOrder S{ntiles, 4, (int)gridDim.x, (int)blockIdx.x, tile_e}; pg8::EpiStoreBf16 E{W_Y, D_, 0, 0};
              pg8::gemm_phase<pg8::EpiStoreBf16, pg8::MoeOrder, true, true>(lds, g, S, E); }
#else
            LAS int* pst = (LAS int*)(lds + 65536);
            moe_offsets(pst, W_CTL + CW_CNT + 64 * layer);
            const float* w2 = INP(39) + (size_t)layer * 32 * 512 * D_;
            const bf16_t* HID = W_HID; bf16_t* Y = W_Y;
            naive_gemm<false>(ldsf, pst[32], D_, 512, [&](int m) { return HID + (size_t)m * 512; },
                              [&](int m0, int) { const int e = moe_expert_of_row(pst, m0); return w2 + (size_t)e * 512 * D_; }, D_,
                              [&](int m, int n, float a, float) { Y[(size_t)m * D_ + n] = f2bf(a); });
#endif
        }
        SEAM(base + 4);
        if (IN(base + 5)) { PHASE_BEGIN ph_combine_ln<layer == 1>(W_HB, W_Y, W_TOKDEST, W_TOKG, INP(40) + layer * D_, INP(41) + layer * D_, ap->out, (bf16_t*)W_HA + (size_t)T_ * D_); }
        SEAM(base + 5);

}

template <int PLO, int PHI>
__device__ __forceinline__ void mega_body(unsigned char* lds_raw) {
    LAS unsigned char* lds = (LAS unsigned char*)lds_raw;
    LAS float* ldsf = (LAS float*)lds;
    constexpr bool MULTI = (PHI - PLO) > 1;
    if (MULTI) {
        PHASE_BEGIN
        volatile LAS unsigned* MISC = (volatile LAS unsigned*)(lds + MISC_OFF);
        if (TIDX < 32) MISC[TIDX] = 0u;
        __syncthreads();
        (void)xcd_barrier_post(W_CTL + CW_BAR, MISC + 8);
    }

    if (IN(PH_PROLOGUE)) {
        PHASE_BEGIN ph_prologue(INP(0), W_HB);
#if FAST_GEMM
        LAS float* scr = ldsf + (TIDX >> 6) * (64 * 33);
        const int gw = blockIdx.x * NWAVES + (TIDX >> 6), ngw = gridDim.x * NWAVES, lane = TIDX & 63;
        convert_plain(INP(1), D_, NIN0, NIN0P, W_WIN0, scr, gw, ngw, lane);
        convert_plain(INP(16), D_, D_, D_, W_WOUT0, scr, gw, ngw, lane);
        convert_plain(INP(17), D_, NIN1, NIN1, W_WIN1, scr, gw, ngw, lane);
        convert_plain(INP(30), D_, D_, D_, W_WOUT1, scr, gw, ngw, lane);
        convert_plain(INP(26), 512, 512, 512, W_WGLU, scr, gw, ngw, lane);
        convert_lora(INP(4), INP(6), INP(7), W_WLORA, scr, gw, ngw, lane);
        convert_router(INP(33), INP(35), W_WROUTER, blockIdx.x * NTHREADS + TIDX, gridDim.x * NTHREADS);
        convert_moe(INP(37), INP(38), INP(39), W_W13, W_W2, scr, gw, ngw, lane);
#endif
    }
    SEAM(PH_PROLOGUE);
    if (IN(PH_INPROJ0)) {
        PHASE_BEGIN
#if FAST_GEMM
        { pg8::Gemm g{W_HB, W_WIN0, T_, NIN0P, D_}; pg8::StaticOrder S; S.init(T_, NIN0P, (int)gridDim.x, (int)blockIdx.x); pg8::EpiStoreBf16 E{W_P, NIN0P, 0, 0};
          pg8::gemm_phase<pg8::EpiStoreBf16, pg8::StaticOrder, true, true>(lds, g, S, E); }
#else
        const float* W = INP(1); const bf16_t* A = W_HB; bf16_t* P = W_P;
        naive_gemm<false>(ldsf, T_, NIN0, D_, [&](int m) { return A + (size_t)m * D_; }, [&](int, int) { return W; }, NIN0,
                          [&](int m, int n, float a, float) { P[(size_t)m * NIN0P + n] = f2bf(a); });
#endif
    }
    SEAM(PH_INPROJ0);
#if FAST_GLA0
    if (IN(PH_PREPA0)) { PHASE_BEGIN ph_prepA0v(W_P, INP(2), W_AP); }
#else
    if (IN(PH_PREPA0)) { PHASE_BEGIN ph_prepA0<!FAST_GLA0>(W_P, INP(2), INP(13), INP(14), W_AP, W_GLALA); }
#endif
    SEAM(PH_PREPA0);
    if (IN(PH_LORA0)) {
        PHASE_BEGIN
#if FAST_GEMM
        { pg8::Gemm g{W_AP, W_WLORA, T_, NLORA, 256}; pg8::StaticOrder S; S.init(T_, NLORA, (int)gridDim.x, (int)blockIdx.x); pg8::EpiStoreBf16 E{W_LO, 512, 512, (size_t)T_ * 512};
          pg8::gemm_phase<pg8::EpiStoreBf16, pg8::StaticOrder, true, true>(lds, g, S, E); }
#else
        const float* w2 = INP(4); const float* a2 = INP(6); const float* g2 = INP(7); const bf16_t* AP = W_AP; bf16_t* LO = W_LO;
        naive_gemm<false>(ldsf, T_, 512, 64, [&](int m) { return AP + (size_t)m * 256; }, [&](int, int) { return w2; }, 512,
                          [&](int m, int n, float a, float) { LO[(size_t)m * 512 + n] = f2bf(a); });
        naive_gemm<false>(ldsf, T_, 512, 64, [&](int m) { return AP + (size_t)m * 256 + 64; }, [&](int, int) { return a2; }, 512,
                          [&](int m, int n, float a, float) { LO[(size_t)T_ * 512 + (size_t)m * 512 + n] = f2bf(a); });
        naive_gemm<false>(ldsf, T_, 512, 128, [&](int m) { return AP + (size_t)m * 256 + 128; }, [&](int, int) { return g2; }, 512,
                          [&](int m, int n, float a, float) { LO[(size_t)2 * T_ * 512 + (size_t)m * 512 + n] = f2bf(a); });
#endif
    }
    SEAM(PH_LORA0);
    if (IN(PH_PREPB0)) {
        PHASE_BEGIN ph_prepB0v(W_P, W_LO, INP(2), INP(3), INP(5), INP(8), INP(9), INP(10), W_SC, W_BON);
#if FAST_GLA0
        { const GlaBufs GB = GLA0_BUFS; __syncthreads();
          for (int cg = blockIdx.x; cg < 256; cg += gridDim.x) gla_prep_tile<64, 0>(ldsf, W_P, INP(13), INP(14), GB, cg); }
#endif
    }
    SEAM(PH_PREPB0);
#if FAST_RWKV == 2
#define RW_G ((bf16_t*)BIGP(128))
#define RW_RM ((bf16_t*)ap->out)
#define RW_HT (ap->out + (size_t)4 * 1024 * 1024)
#define RW_YM ((bf16_t*)(ap->out + (size_t)12 * 1024 * 1024))
    if (IN(PH_SCAN0)) {
        PHASE_BEGIN
        for (int it = blockIdx.x; it < 2048; it += gridDim.x) rwkv_chunk_pre(lds, W_SC, RW_G, RW_RM, RW_HT, RW_YM, it);
        { const GlaBufs GB = GLA0_BUFS; const int wave = TIDX >> 6, lane = TIDX & 63;
          for (int u = blockIdx.x * NWAVES + wave; u < 1024 * 4; u += gridDim.x * NWAVES) gla_pass1_unit<64, false>(GB, u, lane); }
    }
    SEAM(PH_SCAN0);
    if (IN(PH_SCAN0B)) {
        PHASE_BEGIN
        const int bid = blockIdx.x;
        if (bid < 64) rwkv_chunk_seq2(lds, RW_G, RW_RM, RW_HT, RW_YM, W_YRW, bid);
#if FAST_S5
        else if (bid < 96) s5_tables(ldsf, INP(18), INP(19), INP(20), INP(21), INP(22), INP(23), INP(24), W_S5MB, W_S5WE, bid - 64);
#endif
        else {
            const GlaBufs GB = GLA0_BUFS;
            const int nb = (int)gridDim.x - 96, b0 = bid - 96;
            gla_pass2<64, false>(GB, b0 * NTHREADS + TIDX, nb * NTHREADS);
            sub_barrier(W_CTL + CW_SUB + 64, (unsigned)nb);
            for (int it = b0; it < 1024; it += nb) gla_pass3_item<64, 0>(lds, W_P, INP(15), GB, W_YMIX, it);
#ifdef PROBE_B_GLA2
            gla_pass2<64, false>(GB, b0 * NTHREADS + TIDX, nb * NTHREADS);
#endif
#ifdef PROBE_B_GLA3
            for (int it = b0; it < 1024; it += nb) gla_pass3_item<64, 0>(lds, W_P, INP(15), GB, W_YMIX, it);
#endif
        }
    }
    SEAM(PH_SCAN0B);
#else
    if (IN(PH_SCAN0)) {
        PHASE_BEGIN
        const int bid = blockIdx.x;
#if FAST_RWKV
        constexpr int NRW = 128;
        if (bid < NRW) rwkv_scan_v1(ldsf, W_SC, W_YRW, bid);
#else
        constexpr int NRW = 16;
        if (bid < NRW) naive_rwkv_scan(ldsf, W_SC, W_YRW, bid);
#endif
#if FAST_GLA0
        else {
            const GlaBufs GB = GLA0_BUFS;
            const int nb = (int)gridDim.x - NRW, b0 = bid - NRW, wave = TIDX >> 6, lane = TIDX & 63;
            for (int u = b0 * NWAVES + wave; u < 1024 * 4; u += nb * NWAVES) gla_pass1_unit<64, false>(GB, u, lane);
            sub_barrier(W_CTL + CW_SUB, (unsigned)nb);
            gla_pass2<64, false>(GB, b0 * NTHREADS + TIDX, nb * NTHREADS);
            sub_barrier(W_CTL + CW_SUB + 64, (unsigned)nb);
            for (int it = b0; it < 1024; it += nb) gla_pass3_item<64, 0>(lds, W_P, INP(15), GB, W_YMIX, it);
        }
#else
        else if (bid < 24) {
            const int bh = bid - 16;
            const bf16_t* P = W_P; const float* GLALA = W_GLALA;
            naive_gla_scan<64>(ldsf,
                [&](int t, int ck, float& q, float& kk, float& e) {
                    q = bf2f(P[(size_t)t * NIN0P + 1792 + ck]) * 0.125f; kk = bf2f(P[(size_t)t * NIN0P + 2048 + ck]); e = __expf(GLALA[(size_t)t * 256 + ck]); },
                [&](int t, int cv) { return bf2f(P[(size_t)t * NIN0P + 2304 + cv]); }, W_OG, bh >> 2, bh & 3);
        }
#endif
    }
    SEAM(PH_SCAN0);
    SEAM(PH_SCAN0B);
#endif
#if FAST_GLA0
    if (IN(PH_FIN0)) { PHASE_BEGIN ph_fin0v(W_YRW, W_LO, W_SC, W_BON, INP(11), INP(12), W_YMIX); }
#else
    if (IN(PH_FIN0)) { PHASE_BEGIN ph_fin0<!FAST_GLA0>(W_YRW, W_OG, W_P, W_LO, W_SC, W_BON, INP(11), INP(12), INP(15), W_YMIX); }
#endif
    SEAM(PH_FIN0);

    moe_layer<PLO, PHI, 0>(lds);
            if (IN(PH_INPROJ1)) {
                PHASE_BEGIN
#if FAST_GEMM
                { pg8::Gemm g{W_HB, W_WIN1, T_, NIN1, D_}; pg8::StaticOrder S; S.init(T_, NIN1, (int)gridDim.x, (int)blockIdx.x); pg8::EpiStoreBf16 E{W_P, NIN1, 0, 0};
                  pg8::gemm_phase<pg8::EpiStoreBf16, pg8::StaticOrder, true, true>(lds, g, S, E); }
#else
                const float* W = INP(17); const bf16_t* A = W_HB; bf16_t* P = W_P;
                naive_gemm<false>(ldsf, T_, NIN1, D_, [&](int m) { return A + (size_t)m * D_; }, [&](int, int) { return W; }, NIN1,
                                  [&](int m, int n, float a, float) { P[(size_t)m * NIN1 + n] = f2bf(a); });
#endif
            }
            SEAM(PH_INPROJ1);
            if (IN(PH_L1A)) {
                PHASE_BEGIN
#if FAST_S5
                s5_fill_ua(W_P, W_S5UA, blockIdx.x * NWAVES + (TIDX >> 6), gridDim.x * NWAVES, TIDX & 63);
                __syncthreads();
#endif
#if FAST_HG
                { const GlaBufs GB = HG_BUFS;
                  for (int cg = blockIdx.x; cg < 256; cg += gridDim.x) gla_prep_tile<128, 1>(ldsf, W_P, INP(28), nullptr, GB, cg); }
#endif
            }
            SEAM(PH_L1A);
            if (IN(PH_L1B)) {
                PHASE_BEGIN
                const int bid = blockIdx.x;
#if FAST_S5
                if (bid < 64) {
                    LAS int* tile_e = (LAS int*)(lds + 131072 + 1024);
                    if (TIDX < 64) tile_e[TIDX] = TIDX >> 1;
                    __syncthreads();
                    pg8::Gemm g{W_S5UA, W_S5WE, 64 * 256, 256, 512, 640}; pg8::MoeOrder S{64, 1, 64, bid, tile_e}; pg8::EpiStoreF32Half E{W_S5E};
                    pg8::gemm_phase<pg8::EpiStoreF32Half, pg8::MoeOrder, true, true>(lds, g, S, E);
                }
#endif
#if FAST_HG
                if (bid >= 64) {
                    const GlaBufs GB = HG_BUFS;
                    const int nb = (int)gridDim.x - 64, b0 = bid - 64, wave = TIDX >> 6, lane = TIDX & 63;
                    for (int u = b0 * NWAVES + wave; u < 1024 * 8; u += nb * NWAVES) gla_pass1_unit<128, true>(GB, u, lane);
                }
#endif
            }
            SEAM(PH_L1B);
            if (IN(PH_L1C)) {
                PHASE_BEGIN
                const int bid = blockIdx.x;
#if FAST_S5
                if (bid < 8) s5_carry(INP(18), INP(19), INP(20), W_S5E, W_S5UA, bid * NTHREADS + TIDX);
#endif
#if FAST_HG
                if (bid >= 8) { const GlaBufs GB = HG_BUFS; gla_pass2<128, true>(GB, (bid - 8) * NTHREADS + TIDX, ((int)gridDim.x - 8) * NTHREADS); }
#endif
#if FAST_GEMM
                { LAS float* scr = ldsf + (TIDX >> 6) * (64 * 33);
                  convert_moe(INP(37) + (size_t)32 * D_ * 512, INP(38) + (size_t)32 * D_ * 512, INP(39) + (size_t)32 * 512 * D_, W_W13, W_W2, scr,
                              bid * NWAVES + (TIDX >> 6), (int)gridDim.x * NWAVES, TIDX & 63); }
#endif
            }
            SEAM(PH_L1C);
            if (IN(PH_L1D)) {
                PHASE_BEGIN
                const int bid = blockIdx.x;
#if FAST_S5
                if (bid < 64) {
                    LAS int* tile_e = (LAS int*)(lds + 131072 + 1024);
                    if (TIDX < 64) tile_e[TIDX] = TIDX >> 1;
                    __syncthreads();
                    pg8::Gemm g{W_S5UA, W_S5MB, 64 * 256, 512, 640, 640}; pg8::MoeOrder S{64, 2, 64, bid, tile_e}; pg8::EpiS5Y E{W_P, INP(25), W_YRW, W_YS5B};
                    pg8::gemm_phase<pg8::EpiS5Y, pg8::MoeOrder, true, true>(lds, g, S, E);
                }
#endif
#if FAST_HG
                if (bid >= 64) {
                    const GlaBufs GB = HG_BUFS;
                    for (int it = bid - 64; it < 1024; it += (int)gridDim.x - 64) gla_pass3_item<128, 1>(lds, W_P, INP(29), GB, W_YMIX, it);
                }
#endif
            }
            SEAM(PH_L1D);
#if !(FAST_HG && FAST_S5)
            if (IN(PH_SCAN1)) {
                PHASE_BEGIN
                const int bid = blockIdx.x;
                const bf16_t* P = W_P; (void)P; (void)bid;
#if !FAST_HG
                if (bid < 8) {
                    const float* hg_lb = INP(28);
                    naive_gla_scan<128>(ldsf,
                        [&](int t, int ck, float& q, float& kk, float& e) {
                            const float l0 = hg_lb[ck], l1 = hg_lb[512 + ck];
                            const float lbv = 1.f / (1.f + __expf(l0 - l1));
                            const float f = bf2f(P[(size_t)t * NIN1 + 1024 + ck]);
                            const float sg = sigm(f);
                            q = siluf(bf2f(P[(size_t)t * NIN1 + 512 + ck])); kk = (1.f - lbv) * (1.f - sg); e = lbv + (1.f - lbv) * sg; },
                        [&](int t, int cv) { return bf2f(P[(size_t)t * NIN1 + 1536 + cv]); }, W_OG, bid >> 2, bid & 3);
                }
#endif
#if !FAST_S5
                if (bid >= 8 && bid < 16) {
                    const int pair = (bid - 8) * 8 + (TIDX >> 6);
                    naive_s5_scan(P, INP(18), INP(19), INP(20), INP(21), INP(22), INP(23), INP(24), INP(25), W_YRW, W_YS5B, pair);
                }
#endif
            }
            SEAM(PH_SCAN1);
#if !FAST_HG
            if (IN(PH_FIN1)) { PHASE_BEGIN ph_fin1(W_OG, W_P, INP(29), W_YMIX); }
#endif
            SEAM(PH_FIN1);
#endif
            if (IN(PH_GLU1)) {
                PHASE_BEGIN
#if FAST_GEMM
                { pg8::Gemm g{W_YS5B, W_WGLU, T_, 512, 512}; pg8::StaticOrder S; S.init(T_, 512, (int)gridDim.x, (int)blockIdx.x); pg8::EpiGlu E{W_YRW, 512, INP(27), W_YMIX, D_};
                  pg8::gemm_phase<pg8::EpiGlu, pg8::StaticOrder, true, true>(lds, g, S, E); }
#else
                const float* W = INP(26); const float* gb = INP(27); const bf16_t* YS5B = W_YS5B; const float* YRW = W_YRW; bf16_t* Ymix = W_YMIX;
                naive_gemm<false>(ldsf, T_, 512, 512, [&](int m) { return YS5B + (size_t)m * 512; }, [&](int, int) { return W; }, 512,
                                  [&](int m, int n, float a, float) { const float y = YRW[(size_t)m * 512 + n]; Ymix[(size_t)m * D_ + n] = f2bf(y * sigm(a + gb[n])); });
#endif
            }
            SEAM(PH_GLU1);
    moe_layer<PLO, PHI, 1>(lds);
#undef IN
}
template <int PLO, int PHI>
__global__ void __launch_bounds__(NTHREADS, 2) mega(Args args) {
    extern __shared__ __attribute__((aligned(16))) unsigned char lds_raw[];
    mega_body<PLO, PHI>(lds_raw);
}

#include <utility>
template <int... I> static void set_attrs(std::integer_sequence<int, I...>) {
    (void)std::initializer_list<int>{ ((void)hipFuncSetAttribute((const void*)mega<I, I + 1>, hipFuncAttributeMaxDynamicSharedMemorySize, LDS_BYTES), 0)... };
}
#ifndef DUP_MASK
#define DUP_MASK 0ull
#endif
template <int I> static int launch_one(int grid, hipStream_t stream, const Args& a) {
    hipLaunchKernelGGL((mega<I, I + 1>), dim3(grid), dim3(NTHREADS), LDS_BYTES, stream, a);
    if ((DUP_MASK >> I) & 1ull) hipLaunchKernelGGL((mega<I, I + 1>), dim3(grid), dim3(NTHREADS), LDS_BYTES, stream, a);
    return 0;
}
template <int... I> static void launch_all(std::integer_sequence<int, I...>, int grid, hipStream_t stream, const Args& a) {
    (void)std::initializer_list<int>{ launch_one<I>(grid, stream, a)... };
}
extern "C" void kernel_launch(void* const* d_in, const int* in_sizes, int n_in, void* d_out, int out_size, void* d_ws, size_t ws_size, hipStream_t stream) {
    static int grid = 0;
    if (grid == 0) {
        if (n_in != 42 || out_size != T_ * D_ || ws_size < WS_END) { fprintf(stderr, "kernel_launch: unexpected shapes n_in %d out %d ws %zu\n", n_in, out_size, ws_size); grid = -1; return; }
        int dev = 0, cus = 0, per_cu = 0;
        hipGetDevice(&dev);
        hipDeviceGetAttribute(&cus, hipDeviceAttributeMultiprocessorCount, dev);
        set_attrs(std::make_integer_sequence<int, PH_COUNT>{});
        hipFuncSetAttribute((const void*)mega<0, PH_COUNT>, hipFuncAttributeMaxDynamicSharedMemorySize, LDS_BYTES);
        hipOccupancyMaxActiveBlocksPerMultiprocessor(&per_cu, (const void*)mega<0, PH_COUNT>, NTHREADS, LDS_BYTES);
        (void)hipGetLastError();
        if (per_cu < 1) per_cu = 1;
        grid = cus * 1;
        fprintf(stderr, "kernel_launch: cus %d per_cu %d grid %d\n", cus, per_cu, grid);
    }
    if (grid < 0) return;
    hipMemsetAsync((char*)d_ws + WS_CTL, 0, CTL_ZERO_BYTES, stream);
    Args a{};
    for (int i = 0; i < 42; ++i) a.in[i] = (const float*)d_in[i];
    a.out = (float*)d_out; a.ws = (unsigned char*)d_ws;
#if MK_SINGLE
    void* kargs[] = {(void*)&a};
    hipError_t e = hipLaunchCooperativeKernel((const void*)mega<0, PH_COUNT>, dim3(grid), dim3(NTHREADS), kargs, LDS_BYTES, stream);
    if (e != hipSuccess) fprintf(stderr, "cooperative launch failed: %s (grid %d)\n", hipGetErrorString(e), grid);
#else
    launch_all(std::make_integer_sequence<int, PH_COUNT>{}, grid, stream, a);
#endif
}
#ifdef TEST_RANGES
template __global__ void mega<0, 2>(Args);
template __global__ void mega<1, 3>(Args);
template __global__ void mega<1, 4>(Args);
template __global__ void mega<3, 8>(Args);
template __global__ void mega<7, 13>(Args);
template __global__ void mega<10, 12>(Args);
template __global__ void mega<13, 17>(Args);
template __global__ void mega<0, 13>(Args);
#endif
```

```cpp
#include <hip/hip_runtime.h>
#include <cstdio>
#include <cstdint>

#define GAS __attribute__((address_space(1)))
#define LAS __attribute__((address_space(3)))
typedef unsigned short bf16_t;
typedef float f32x4 __attribute__((ext_vector_type(4)));
typedef unsigned u32x4 __attribute__((ext_vector_type(4)));
typedef unsigned u32x2 __attribute__((ext_vector_type(2)));
__device__ __forceinline__ int launder_tid() { int t = (int)threadIdx.x; asm volatile("" : "+v"(t)); return t; }
#define TIDX launder_tid()

#ifndef FAST_GEMM
#define FAST_GEMM 1
#endif
#ifndef FAST_LN
#define FAST_LN 1
#endif
#ifndef FAST_RWKV
#define FAST_RWKV 2
#endif
#ifndef FAST_GLA0
#define FAST_GLA0 1
#endif
#ifndef FAST_HG
#define FAST_HG 1
#endif
#ifndef FAST_S5
#define FAST_S5 1
#endif
#ifndef MK_SINGLE
#define MK_SINGLE 1
#endif

constexpr int T_ = 16384, L_ = 8192, D_ = 1024;
constexpr int NIN0 = 3344, NIN0P = 3584, NIN1 = 2560;
constexpr int NLORA = 1536;
constexpr int RMAX = 40960;
constexpr int MOE_PAD = 256;
constexpr float DN_ALPHA = 1.41421356237f;
constexpr float LN_EPS = 1e-5f;
constexpr int NTHREADS = 512, NWAVES = 8;

constexpr size_t MiB = 1u << 20;
constexpr size_t WS_CTL = 0, CTL_ZERO_BYTES = 1 * MiB;
constexpr size_t WS_WIN0 = 2 * MiB;
constexpr size_t WS_WOUT0 = 9 * MiB;
constexpr size_t WS_WIN1 = 11 * MiB;
constexpr size_t WS_WOUT1 = 16 * MiB;
constexpr size_t WS_WGLU = 18 * MiB;
constexpr size_t WS_WLORA = 19 * MiB;
constexpr size_t WS_WROUTER = 19 * MiB + 786432;
constexpr size_t WS_W13 = 20 * MiB;
constexpr size_t WS_W2 = 84 * MiB;
constexpr size_t WS_HB = 116 * MiB;
constexpr size_t WS_HA = 149 * MiB;
constexpr size_t WS_ROUTE = 213 * MiB;
constexpr size_t WS_BIG = 214 * MiB;
constexpr size_t WS_P = WS_BIG;
constexpr size_t WS_LO = WS_BIG + 112 * MiB;
constexpr size_t WS_SCAN = WS_BIG + 160 * MiB;
constexpr size_t WS_GLALA = WS_BIG + 256 * MiB;
constexpr size_t WS_BON = WS_BIG + 272 * MiB;
constexpr size_t WS_APRIME = WS_BIG + 273 * MiB;
constexpr size_t WS_YS5B = WS_BIG + 80 * MiB;
constexpr size_t WS_XR = WS_BIG;
constexpr size_t WS_HID = WS_BIG + 80 * MiB;
constexpr size_t WS_Y = WS_BIG + 120 * MiB;
constexpr size_t WS_END = 512 * MiB;
constexpr int CW_BAR = 4096;
constexpr int CW_CNT = 8192;

__device__ __forceinline__ float bf2f(bf16_t b) { return __uint_as_float(((unsigned)b) << 16); }
__device__ __forceinline__ bf16_t f2bf(float f) { unsigned u = __float_as_uint(f); u += 0x7fffu + ((u >> 16) & 1u); return (bf16_t)(u >> 16); }
__device__ __forceinline__ unsigned pk2(float lo, float hi) { return (unsigned)f2bf(lo) | ((unsigned)f2bf(hi) << 16); }
__device__ __forceinline__ float sigm(float x) { return 1.f / (1.f + __expf(-x)); }
__device__ __forceinline__ float siluf(float x) { return x * sigm(x); }
__device__ __forceinline__ float softplusf(float x) { return fmaxf(x, 0.f) + log1pf(__expf(-fabsf(x))); }
__device__ __forceinline__ float gelu_tanh(float x) { const float u = 0.7978845608028654f * (x + 0.044715f * x * x * x); return 0.5f * x * (1.f + tanhf(u)); }
__device__ __forceinline__ float wave_sum(float v) {
#pragma unroll
    for (int o = 1; o < 64; o <<= 1) v += __shfl_xor(v, o);
    return v;
}


namespace pg8 {
#define PG8_LAS __attribute__((address_space(3)))
typedef unsigned short bf16_t;
typedef short bf16x8 __attribute__((ext_vector_type(8)));
typedef float f32x4 __attribute__((ext_vector_type(4)));
typedef unsigned u32x4 __attribute__((ext_vector_type(4)));
constexpr int BM = 256, BK = 64, HALF = 128, HTB = HALF * BK * 2  , STAGE_BYTES = 8 * HTB, NXCD = 8, WGM = 8;

__host__ __device__ __forceinline__ int lds_byte(int r, int c) { const int st = (r >> 4) * 2 + (c >> 5), rr = r & 15, cc = c & 31, ob = rr * 64 + cc * 2; return st * 1024 + (ob ^ (((ob >> 9) & 1) << 5)); }
__host__ __device__ __forceinline__ void stage_rc(int b, int& R, int& C) { const int st = b / 1024, sb = b % 1024, swz = sb ^ (((sb >> 9) & 1) << 5); R = (st >> 1) * 16 + swz / 64; C = (st & 1) * 32 + (swz % 64) / 2; }
__host__ __device__ __forceinline__ int perm32(int rho) { const int n = rho >> 4, i = rho & 15; return 8 * (i >> 2) + 4 * n + (i & 3); }

struct Unit { int pm, pn, pb; };
struct Gemm { const bf16_t* A; const bf16_t* Bt; int M, N, K, lda; const PG8_LAS int* rowlds; };

struct StaticOrder {
    int nM, nN, nwg, G, c;
    __host__ __device__ void init(int M, int N, int G_, int c_) { nM = M / BM; nN = N / BM; nwg = nM * nN; G = G_; c = c_; }
    __host__ __device__ bool next(int i, Unit& u) const {
        const long L = (long)i * G + c; if (L >= nwg) return false;
        int wgid = (int)L; { const int q = nwg / NXCD, r = nwg % NXCD, xcd = wgid % NXCD, off = wgid / NXCD; wgid = (xcd < r ? xcd * (q + 1) : r * (q + 1) + (xcd - r) * q) + off; }
        const int nig = WGM * nN, gid = wgid / nig, fm = gid * WGM, gsz = (nM - fm) < WGM ? (nM - fm) : WGM;
        u.pm = fm + ((wgid % nig) % gsz); u.pn = (wgid % nig) / gsz; u.pb = u.pn; return true;
    }
    __device__ __forceinline__ void a_ready(const Unit&) const {}
    __device__ __forceinline__ void done(const Unit&) const {}
};

__device__ __forceinline__ unsigned cvt_pk_bf16(float lo, float hi) { unsigned r; asm volatile("v_cvt_pk_bf16_f32 %0, %1, %2" : "=v"(r) : "v"(lo), "v"(hi)); return r; }
typedef float f32x2 __attribute__((ext_vector_type(2)));

template <class Epi, class Sched, bool ALIGN_EPI = false, bool SP2 = false>
__device__ __forceinline__ void gemm_phase(PG8_LAS unsigned char* lds, const Gemm g, const Sched& S, const Epi& E) {
    const int tid = TIDX, wid = __builtin_amdgcn_readfirstlane(tid >> 6), lane = tid & 63, wr = wid >> 2, wc = wid & 3, fr = lane & 15, fq = lane >> 4;
    const int K = g.K, nt = K / BK, lda = g.lda ? g.lda : g.K;
    unsigned voffA[2], voffB[2];
    int gR[2]; unsigned gC[2];
#pragma unroll
    for (int i = 0; i < 2; ++i) { int R, C; stage_rc(tid * 16 + i * 8192, R, C); const int Rb = Epi::PERM ? ((R & ~31) + perm32(R & 31)) : R;
        voffA[i] = (unsigned)(R * lda + C) * 2u; voffB[i] = (unsigned)(Rb * K + C) * 2u; gR[i] = R; gC[i] = (unsigned)C * 2u; }
    const bool gather = g.rowlds != nullptr;
    unsigned vA0[2], vA1[2], vN0[2], vN1[2];
#define PG8_GOFS(uidx, o0, o1) do { _Pragma("unroll") for (int _i = 0; _i < 2; ++_i) { \
        if (gather) { const int _r0 = g.rowlds[256 * (uidx) + gR[_i]], _r1 = g.rowlds[256 * (uidx) + HALF + gR[_i]]; o0[_i] = (unsigned)_r0 * (unsigned)(lda * 2) + gC[_i]; o1[_i] = (unsigned)_r1 * (unsigned)(lda * 2) + gC[_i]; } \
        else { o0[_i] = voffA[_i]; o1[_i] = voffA[_i]; } } } while (0)
    const size_t kstep = (size_t)(BK * 2);
    const size_t hstep = (size_t)HALF * K * 2;
    const size_t tstep = 2 * hstep;
    const size_t hstepA = g.rowlds ? 0 : (size_t)HALF * lda * 2, tstepA = 2 * hstepA;
    const unsigned ldsw = (unsigned)wid * 1024u;
    const int aoff = lds_byte(wr * 64 + fr, fq * 8), boff = lds_byte(wc * 32 + fr, fq * 8);
#define PG8_SA(b, h) (((b) * 2 + (h)) * HTB)
#define PG8_SB(b, h) ((4 + (b) * 2 + (h)) * HTB)
#define PG8_STAGE(bufoff, gbase, voff) do { _Pragma("unroll") for (int _i = 0; _i < 2; ++_i) \
        __builtin_amdgcn_global_load_lds((const unsigned*)((const char*)(gbase) + (voff)[_i]), (PG8_LAS unsigned*)(lds + (bufoff) + ldsw + _i * 8192), 16, 0, 0); } while (0)
#define PG8_LDA(dst, b, h) do { _Pragma("unroll") for (int m = 0; m < 4; ++m) _Pragma("unroll") for (int k = 0; k < 2; ++k) dst[m][k] = *(const PG8_LAS bf16x8*)(lds + PG8_SA(b, h) + aoff + m * 2048 + k * 1024); } while (0)
#define PG8_LDB(dst, b, h) do { _Pragma("unroll") for (int n = 0; n < 2; ++n) _Pragma("unroll") for (int k = 0; k < 2; ++k) dst[n][k] = *(const PG8_LAS bf16x8*)(lds + PG8_SB(b, h) + boff + n * 2048 + k * 1024); } while (0)
#define PG8_MMA(ai, bj, At, Bt) do { __builtin_amdgcn_s_setprio(1); _Pragma("unroll") for (int m = 0; m < 4; ++m) _Pragma("unroll") for (int n = 0; n < 2; ++n) _Pragma("unroll") for (int k = 0; k < 2; ++k) \
        acc[ai][bj][m][n] = __builtin_amdgcn_mfma_f32_16x16x32_bf16(Bt[n][k], At[m][k], acc[ai][bj][m][n], 0, 0, 0); __builtin_amdgcn_s_setprio(0); } while (0)
#define PG8_WAIT_V(n) asm volatile("s_waitcnt vmcnt(" #n ")" ::: "memory")
#define PG8_WAIT_L(n) asm volatile("s_waitcnt lgkmcnt(" #n ")" ::: "memory")
#define PG8_BAR __builtin_amdgcn_s_barrier()
#define PG8_SCHED __builtin_amdgcn_sched_barrier(0)
    Unit cur, nxt; int ui = 0;
    if (!S.next(0, cur)) return;
    f32x4 acc[2][2][4][2];
#pragma unroll
    for (int a = 0; a < 2; ++a)
#pragma unroll
        for (int b = 0; b < 2; ++b)
#pragma unroll
            for (int m = 0; m < 4; ++m)
#pragma unroll
                for (int n = 0; n < 2; ++n) acc[a][b][m][n] = (f32x4){0.f, 0.f, 0.f, 0.f};
    bf16x8 At[4][2], B0[2][2], B1[2][2];
    const char* cA = (const char*)g.A + (size_t)cur.pm * tstepA; const char* cB = (const char*)g.Bt + (size_t)cur.pb * tstep;
    S.a_ready(cur);
    PG8_GOFS(0, vA0, vA1);
    if constexpr (SP2) {
        PG8_STAGE(PG8_SB(0, 0), cB, voffB); PG8_STAGE(PG8_SB(0, 1), cB + hstep, voffB); PG8_STAGE(PG8_SA(0, 0), cA, vA0); PG8_STAGE(PG8_SA(0, 1), cA + hstepA, vA1);
        if (wr == 1) PG8_BAR;
        PG8_WAIT_V(2); PG8_BAR;
        PG8_STAGE(PG8_SB(1, 0), cB + kstep, voffB); PG8_STAGE(PG8_SA(1, 0), cA + kstep, vA0); PG8_STAGE(PG8_SB(1, 1), cB + hstep + kstep, voffB);
        PG8_WAIT_V(6); PG8_BAR;
    } else {
        PG8_STAGE(PG8_SB(0, 0), cB, voffB); PG8_STAGE(PG8_SA(0, 0), cA, voffA); PG8_STAGE(PG8_SB(0, 1), cB + hstep, voffB); PG8_STAGE(PG8_SA(0, 1), cA + hstepA, voffA);
        if (wr == 1) PG8_BAR;
        PG8_WAIT_V(4); PG8_BAR;
        PG8_STAGE(PG8_SB(1, 0), cB + kstep, voffB); PG8_STAGE(PG8_SA(1, 0), cA + kstep, voffA); PG8_STAGE(PG8_SB(1, 1), cB + hstep + kstep, voffB);
        PG8_WAIT_V(6); PG8_BAR;
    }
    for (;;) {
        const bool has_next = S.next(ui + 1, nxt);
        if (has_next) PG8_GOFS(ui + 1, vN0, vN1); else { vN0[0] = vA0[0]; vN0[1] = vA0[1]; vN1[0] = vA1[0]; vN1[1] = vA1[1]; }
        const char* nA = has_next ? (const char*)g.A + (size_t)nxt.pm * tstepA : cA; const char* nB = has_next ? (const char*)g.Bt + (size_t)nxt.pb * tstep : cB;
        for (int t = 0; t < nt; t += 2) {
            const bool last = (t == nt - 2);
            const char* a1 = cA + (size_t)(t + 1) * kstep;
            const char* a2 = last ? nA : cA + (size_t)(t + 2) * kstep; const char* b2 = last ? nB : cB + (size_t)(t + 2) * kstep;
            const char* a3 = a2 + kstep; const char* b3 = b2 + kstep;
            if (last && has_next) S.a_ready(nxt);
            const unsigned s0[2] = {last ? vN0[0] : vA0[0], last ? vN0[1] : vA0[1]}, s1[2] = {last ? vN1[0] : vA1[0], last ? vN1[1] : vA1[1]};
            if constexpr (SP2) {
            PG8_LDB(B0, 0, 0); PG8_LDB(B1, 0, 1); PG8_SCHED; PG8_LDA(At, 0, 0); PG8_STAGE(PG8_SA(1, 1), a1 + hstepA, vA1);
            PG8_WAIT_V(8); PG8_WAIT_L(0); PG8_BAR; PG8_MMA(0, 0, At, B0); PG8_MMA(0, 1, At, B1); PG8_BAR; PG8_SCHED;
            PG8_LDA(At, 0, 1); PG8_STAGE(PG8_SB(0, 0), b2, voffB); PG8_STAGE(PG8_SB(0, 1), b2 + hstep, voffB); PG8_STAGE(PG8_SA(0, 0), a2, s0);
            PG8_WAIT_V(8); PG8_WAIT_L(0); PG8_BAR; PG8_MMA(1, 0, At, B0); PG8_MMA(1, 1, At, B1); PG8_BAR; PG8_SCHED;
            PG8_LDB(B0, 1, 0); PG8_LDB(B1, 1, 1); PG8_SCHED; PG8_LDA(At, 1, 0); PG8_STAGE(PG8_SA(0, 1), a2 + hstepA, s1);
            PG8_WAIT_V(8); PG8_WAIT_L(0); PG8_BAR; PG8_MMA(0, 0, At, B0); PG8_MMA(0, 1, At, B1); PG8_BAR; PG8_SCHED;
            PG8_LDA(At, 1, 1); PG8_STAGE(PG8_SB(1, 0), b3, voffB); PG8_STAGE(PG8_SB(1, 1), b3 + hstep, voffB); PG8_STAGE(PG8_SA(1, 0), a3, s0);
            PG8_WAIT_V(8); PG8_WAIT_L(0); PG8_BAR; PG8_MMA(1, 0, At, B0); PG8_MMA(1, 1, At, B1); PG8_BAR; PG8_SCHED;
            } else {
            PG8_LDB(B0, 0, 0); PG8_SCHED; PG8_LDA(At, 0, 0); PG8_STAGE(PG8_SA(1, 1), a1 + hstepA, voffA);
            PG8_WAIT_L(8); PG8_BAR; PG8_WAIT_L(0); PG8_MMA(0, 0, At, B0); PG8_BAR; PG8_SCHED;
            PG8_LDB(B1, 0, 1); PG8_STAGE(PG8_SB(0, 0), b2, voffB);
            PG8_BAR; PG8_WAIT_L(0); PG8_MMA(0, 1, At, B1); PG8_BAR;
            PG8_LDA(At, 0, 1); PG8_STAGE(PG8_SA(0, 0), a2, voffA);
            PG8_BAR; PG8_WAIT_L(0); PG8_MMA(1, 0, At, B0); PG8_BAR; PG8_SCHED;
            PG8_STAGE(PG8_SB(0, 1), b2 + hstep, voffB);
            PG8_WAIT_V(6); PG8_BAR; PG8_MMA(1, 1, At, B1); PG8_BAR;
            PG8_LDB(B0, 1, 0); PG8_SCHED; PG8_LDA(At, 1, 0); PG8_STAGE(PG8_SA(0, 1), a2 + hstepA, voffA);
            PG8_WAIT_L(8); PG8_BAR; PG8_WAIT_L(0); PG8_MMA(0, 0, At, B0); PG8_BAR; PG8_SCHED;
            PG8_LDB(B1, 1, 1); PG8_STAGE(PG8_SB(1, 0), b3, voffB);
            PG8_BAR; PG8_WAIT_L(0); PG8_MMA(0, 1, At, B1); PG8_BAR;
            PG8_LDA(At, 1, 1); PG8_STAGE(PG8_SA(1, 0), a3, voffA);
            PG8_BAR; PG8_WAIT_L(0); PG8_MMA(1, 0, At, B0); PG8_BAR; PG8_SCHED;
            PG8_STAGE(PG8_SB(1, 1), b3 + hstep, voffB);
            PG8_WAIT_V(6); PG8_BAR; PG8_MMA(1, 1, At, B1); PG8_BAR;
            }
        }
        if constexpr (ALIGN_EPI) { if (wr == 0) PG8_BAR; }
        if constexpr (!Epi::AFTER_DRAIN) { E(acc, cur, wr, wc, fr, fq); S.done(cur); }
        if (!has_next) break;
#pragma unroll
        for (int a = 0; a < 2; ++a)
#pragma unroll
            for (int b = 0; b < 2; ++b)
#pragma unroll
                for (int m = 0; m < 4; ++m)
#pragma unroll
                    for (int n = 0; n < 2; ++n) acc[a][b][m][n] = (f32x4){0.f, 0.f, 0.f, 0.f};
        cur = nxt; cA = nA; cB = nB; ++ui; vA0[0] = vN0[0]; vA0[1] = vN0[1]; vA1[0] = vN1[0]; vA1[1] = vN1[1];
        if constexpr (ALIGN_EPI) { if (wr == 1) PG8_BAR; }
    }
    PG8_WAIT_V(0);
    if constexpr (!ALIGN_EPI) { if (wr == 0) PG8_BAR; }
    PG8_BAR;
    if constexpr (Epi::AFTER_DRAIN) { E.fused(acc, cur, wr, wc, fr, fq, lds, wid, lane); S.done(cur); }
#undef PG8_GOFS
#undef PG8_SA
#undef PG8_SB
#undef PG8_STAGE
#undef PG8_LDA
#undef PG8_LDB
#undef PG8_MMA
#undef PG8_WAIT_V
#undef PG8_WAIT_L
#undef PG8_BAR
#undef PG8_SCHED
}

struct EpiStoreBf16 {
    static constexpr bool PERM = true, AFTER_DRAIN = false;
    bf16_t* O; int ldc; int split_cols; size_t split_stride;
    __device__ __forceinline__ void operator()(const f32x4 (&acc)[2][2][4][2], const Unit& u, int wr, int wc, int fr, int fq) const {
        int colt = u.pn * BM; bf16_t* base = O;
        if (split_cols) { const int t = colt / split_cols; base += (size_t)t * split_stride; colt -= t * split_cols; }
        const int row0 = u.pm * BM + wr * 64 + fr, col0 = colt + wc * 32 + 8 * fq;
#pragma unroll
        for (int ai = 0; ai < 2; ++ai)
#pragma unroll
            for (int m = 0; m < 4; ++m) { bf16_t* rowp = base + (size_t)(row0 + ai * HALF + m * 16) * ldc + col0;
#pragma unroll
                for (int bj = 0; bj < 2; ++bj) { const f32x4 v0 = acc[ai][bj][m][0], v1 = acc[ai][bj][m][1];
                    u32x4 w; w.x = cvt_pk_bf16(v0[0], v0[1]); w.y = cvt_pk_bf16(v0[2], v0[3]); w.z = cvt_pk_bf16(v1[0], v1[1]); w.w = cvt_pk_bf16(v1[2], v1[3]);
                    *(u32x4*)(rowp + bj * HALF) = w; } }
    }
};
struct EpiInproj1 {
    static constexpr bool PERM = true, AFTER_DRAIN = false;
    bf16_t* O; bf16_t* UA;
    __device__ __forceinline__ void operator()(const f32x4 (&acc)[2][2][4][2], const Unit& u, int wr, int wc, int fr, int fq) const {
        const int row0 = u.pm * BM + wr * 64 + fr, col0 = u.pn * BM + wc * 32 + 8 * fq;
#pragma unroll
        for (int ai = 0; ai < 2; ++ai)
#pragma unroll
            for (int m = 0; m < 4; ++m) { const int t = row0 + ai * HALF + m * 16; bf16_t* rowp = O + (size_t)t * 2560 + col0;
#pragma unroll
                for (int bj = 0; bj < 2; ++bj) { const f32x4 v0 = acc[ai][bj][m][0], v1 = acc[ai][bj][m][1];
                    u32x4 w; w.x = cvt_pk_bf16(v0[0], v0[1]); w.y = cvt_pk_bf16(v0[2], v0[3]); w.z = cvt_pk_bf16(v1[0], v1[1]); w.w = cvt_pk_bf16(v1[2], v1[3]);
                    *(u32x4*)(rowp + bj * HALF) = w;
                    if (u.pn < 2) { const int c = col0 + bj * HALF, g = c >> 4, b = t >> 13, tt = t & 8191;
                        *(u32x4*)(UA + ((size_t)g * 512 + b * 256 + (tt >> 5)) * 640 + (tt & 31) * 16 + (c & 15)) = w; } } }
    }
};
struct EpiResidF32 {
    static constexpr bool PERM = false, AFTER_DRAIN = false;
    const float* resid; float* out; int ldc; float alpha;
    __device__ __forceinline__ void operator()(const f32x4 (&acc)[2][2][4][2], const Unit& u, int wr, int wc, int fr, int fq) const {
        const int row0 = u.pm * BM + wr * 64 + fr, col0 = u.pn * BM + wc * 32 + 4 * fq;
#pragma unroll
        for (int ai = 0; ai < 2; ++ai)
#pragma unroll
            for (int m = 0; m < 4; ++m) { const size_t off = (size_t)(row0 + ai * HALF + m * 16) * ldc + col0;
#pragma unroll
                for (int bj = 0; bj < 2; ++bj)
#pragma unroll
                    for (int n = 0; n < 2; ++n) { const size_t o = off + bj * HALF + n * 16; *(f32x4*)(out + o) = *(const f32x4*)(resid + o) * alpha + acc[ai][bj][m][n]; } }
    }
};
__device__ __forceinline__ float fast_sigm(float x) { return __builtin_amdgcn_rcpf(1.f + __expf(-x)); }
struct EpiSwiglu {
    static constexpr bool PERM = true, AFTER_DRAIN = false;
    bf16_t* HID;
    __device__ __forceinline__ void operator()(const f32x4 (&acc)[2][2][4][2], const Unit& u, int wr, int wc, int fr, int fq) const {
        const int row0 = u.pm * BM + wr * 64 + fr, h0 = u.pn * 128 + wc * 16 + 4 * fq;
#pragma unroll
        for (int ai = 0; ai < 2; ++ai)
#pragma unroll
            for (int m = 0; m < 4; ++m) { bf16_t* rowp = HID + (size_t)(row0 + ai * HALF + m * 16) * 512 + h0;
#pragma unroll
                for (int bj = 0; bj < 2; ++bj) { const f32x4 a = acc[ai][bj][m][0], b = acc[ai][bj][m][1]; f32x4 h;
#pragma unroll
                    for (int j = 0; j < 4; ++j) h[j] = a[j] * fast_sigm(a[j]) * b[j];
                    typedef unsigned u32x2v __attribute__((ext_vector_type(2)));
                    u32x2v w; w.x = cvt_pk_bf16(h[0], h[1]); w.y = cvt_pk_bf16(h[2], h[3]);
                    *(u32x2v*)(rowp + bj * 64) = w; } }
    }
};
struct EpiGlu {
    static constexpr bool PERM = true, AFTER_DRAIN = false;
    const float* ysrc; int ldy; const float* bias; bf16_t* O; int ldc;
    __device__ __forceinline__ void operator()(const f32x4 (&acc)[2][2][4][2], const Unit& u, int wr, int wc, int fr, int fq) const {
        const int row0 = u.pm * BM + wr * 64 + fr, col0 = u.pn * BM + wc * 32 + 8 * fq;
#pragma unroll
        for (int ai = 0; ai < 2; ++ai)
#pragma unroll
            for (int m = 0; m < 4; ++m) { const int row = row0 + ai * HALF + m * 16;
#pragma unroll
                for (int bj = 0; bj < 2; ++bj) { const int col = col0 + bj * HALF;
                    const f32x4 y0 = *(const f32x4*)(ysrc + (size_t)row * ldy + col), y1 = *(const f32x4*)(ysrc + (size_t)row * ldy + col + 4);
                    const f32x4 b0 = *(const f32x4*)(bias + col), b1 = *(const f32x4*)(bias + col + 4);
                    f32x4 v0 = acc[ai][bj][m][0] + b0, v1 = acc[ai][bj][m][1] + b1;
#pragma unroll
                    for (int j = 0; j < 4; ++j) { v0[j] = y0[j] * fast_sigm(v0[j]); v1[j] = y1[j] * fast_sigm(v1[j]); }
                    u32x4 w; w.x = cvt_pk_bf16(v0[0], v0[1]); w.y = cvt_pk_bf16(v0[2], v0[3]); w.z = cvt_pk_bf16(v1[0], v1[1]); w.w = cvt_pk_bf16(v1[2], v1[3]);
                    *(u32x4*)(O + (size_t)row * ldc + col) = w; } }
    }
};
template <bool RESID_BF16> struct EpiResidBf16 {
    static constexpr bool PERM = true, AFTER_DRAIN = false;
    const void* resid; bf16_t* out; int ldc; float alpha;
    __device__ __forceinline__ void operator()(const f32x4 (&acc)[2][2][4][2], const Unit& u, int wr, int wc, int fr, int fq) const {
        const int row0 = u.pm * BM + wr * 64 + fr, col0 = u.pn * BM + wc * 32 + 8 * fq;
#pragma unroll
        for (int ai = 0; ai < 2; ++ai)
#pragma unroll
            for (int m = 0; m < 4; ++m) { const size_t off = (size_t)(row0 + ai * HALF + m * 16) * ldc + col0;
#pragma unroll
                for (int bj = 0; bj < 2; ++bj) {
                    f32x4 r0, r1;
                    if (RESID_BF16) { const u32x4 rv = *(const u32x4*)((const bf16_t*)resid + off + bj * HALF);
                        r0[0] = __uint_as_float(rv.x << 16); r0[1] = __uint_as_float(rv.x & 0xffff0000u); r0[2] = __uint_as_float(rv.y << 16); r0[3] = __uint_as_float(rv.y & 0xffff0000u);
                        r1[0] = __uint_as_float(rv.z << 16); r1[1] = __uint_as_float(rv.z & 0xffff0000u); r1[2] = __uint_as_float(rv.w << 16); r1[3] = __uint_as_float(rv.w & 0xffff0000u); }
                    else { r0 = *(const f32x4*)((const float*)resid + off + bj * HALF); r1 = *(const f32x4*)((const float*)resid + off + bj * HALF + 4); }
                    const f32x4 v0 = r0 * alpha + acc[ai][bj][m][0], v1 = r1 * alpha + acc[ai][bj][m][1];
                    u32x4 w; w.x = cvt_pk_bf16(v0[0], v0[1]); w.y = cvt_pk_bf16(v0[2], v0[3]); w.z = cvt_pk_bf16(v1[0], v1[1]); w.w = cvt_pk_bf16(v1[2], v1[3]);
                    *(u32x4*)(out + off + bj * HALF) = w; } }
    }
};
struct EpiStoreF32 {
    static constexpr bool PERM = false, AFTER_DRAIN = false;
    float* out; int ldc;
    __device__ __forceinline__ void operator()(const f32x4 (&acc)[2][2][4][2], const Unit& u, int wr, int wc, int fr, int fq) const {
        const int row0 = u.pm * BM + wr * 64 + fr, col0 = u.pn * BM + wc * 32 + 4 * fq;
#pragma unroll
        for (int ai = 0; ai < 2; ++ai)
#pragma unroll
            for (int m = 0; m < 4; ++m) { const size_t off = (size_t)(row0 + ai * HALF + m * 16) * ldc + col0;
#pragma unroll
                for (int bj = 0; bj < 2; ++bj)
#pragma unroll
                    for (int n = 0; n < 2; ++n) *(f32x4*)(out + off + bj * HALF + n * 16) = acc[ai][bj][m][n]; }
    }
};
struct EpiStoreF32Half {
    static constexpr bool PERM = false, AFTER_DRAIN = false;
    float* out;
    __device__ __forceinline__ void operator()(const f32x4 (&acc)[2][2][4][2], const Unit& u, int wr, int wc, int fr, int fq) const {
        const int row0 = u.pm * BM + wr * 64 + fr, col0 = wc * 32 + 4 * fq;
#pragma unroll
        for (int ai = 0; ai < 2; ++ai)
#pragma unroll
            for (int m = 0; m < 4; ++m) { const size_t off = (size_t)(row0 + ai * HALF + m * 16) * 128 + col0;
#pragma unroll
                for (int n = 0; n < 2; ++n) *(f32x4*)(out + off + n * 16) = acc[ai][0][m][n]; }
    }
};
struct EpiS5Y {
    static constexpr bool PERM = false, AFTER_DRAIN = false;
    const bf16_t* P1; const float* dvec; float* YS5; bf16_t* YS5B;
    __device__ __forceinline__ void operator()(const f32x4 (&acc)[2][2][4][2], const Unit& u, int wr, int wc, int fr, int fq) const {
        const int g = u.pm >> 1, ch = g * 16 + 4 * fq;
        const f32x4 dd = *(const f32x4*)(dvec + ch);
#pragma unroll
        for (int ai = 0; ai < 2; ++ai)
#pragma unroll
            for (int m = 0; m < 4; ++m) {
                const int bc = (u.pm & 1) * 256 + ai * HALF + wr * 64 + m * 16 + fr, b = bc >> 8, c32 = bc & 255;
#pragma unroll
                for (int bj = 0; bj < 2; ++bj)
#pragma unroll
                    for (int n = 0; n < 2; ++n) {
                        const int i = 16 * u.pn + 8 * bj + 2 * wc + n;
                        const size_t t = (size_t)b * 8192 + c32 * 32 + i;
                        typedef unsigned u32x2v __attribute__((ext_vector_type(2)));
                        const u32x2v uu = *(const u32x2v*)(P1 + t * 2560 + ch);
                        f32x4 uv; uv[0] = __uint_as_float(uu.x << 16); uv[1] = __uint_as_float(uu.x & 0xffff0000u); uv[2] = __uint_as_float(uu.y << 16); uv[3] = __uint_as_float(uu.y & 0xffff0000u);
                        f32x4 y = acc[ai][bj][m][n] + dd * uv;
#pragma unroll
                        for (int j = 0; j < 4; ++j) { const float x = y[j]; const float tt = 0.7978845608028654f * (x + 0.044715f * x * x * x); y[j] = 0.5f * x * (1.f + tanhf(tt)); }
                        *(f32x4*)(YS5 + t * 512 + ch) = y;
                        u32x2v w; w.x = cvt_pk_bf16(y[0], y[1]); w.y = cvt_pk_bf16(y[2], y[3]);
                        *(u32x2v*)(YS5B + t * 512 + ch) = w;
                    }
            }
    }
};
struct MoeOrder {
    int ntiles, nN, G, c; const PG8_LAS int* tile_e;
    __device__ __forceinline__ bool next(int i, Unit& u) const {
        const int L = i * G + c; if (L >= ntiles * nN) return false;
        u.pm = L / nN; u.pn = L % nN; u.pb = tile_e[u.pm] * nN + u.pn; return true;
    }
    __device__ __forceinline__ void a_ready(const Unit&) const {}
    __device__ __forceinline__ void done(const Unit&) const {}
};
}

#define XB_TMO      128
#define XB_XCNT(j)  (256  + 64 * (j))
#define XB_XSUB(j)  (1280 + 64 * (j))
#define XB_XGEN(j)  (2304 + 64 * (j))
#define XB_TOP      3328
#define XB_TOPGEN   3392
#define XCD_BAR_WORDS 3456
#define XB_SPIN_CAP (1u << 18)
__device__ __forceinline__ unsigned xb_ld(unsigned* p)              { return __hip_atomic_load(p, __ATOMIC_RELAXED, __HIP_MEMORY_SCOPE_AGENT); }
__device__ __forceinline__ unsigned xb_add(unsigned* p, unsigned v) { return __hip_atomic_fetch_add(p, v, __ATOMIC_RELAXED, __HIP_MEMORY_SCOPE_AGENT); }
__device__ __forceinline__ unsigned xb_xcc_id() { return (unsigned)__builtin_amdgcn_s_getreg((3 << 11) | 20) & 0xFu; }
#define XB_SPIN(cond, bar) do { unsigned _sp = 0; while (cond) { __builtin_amdgcn_s_sleep(1); \
    if ((++_sp & 255u) == 0u) { if (xb_ld(&(bar)[XB_TMO])) break; if (_sp > XB_SPIN_CAP) { atomicAdd(&(bar)[XB_TMO], 1u); break; } } } } while (0)
struct XcdBarrier { unsigned* bar; unsigned x; volatile LAS unsigned* st; };
__device__ __forceinline__ XcdBarrier xcd_barrier_post(unsigned* bar, volatile LAS unsigned* st) {
    XcdBarrier b; b.bar = bar; b.x = xb_xcc_id(); b.st = st;
    if (TIDX == 0) (void)xb_add(&bar[XB_XCNT(b.x)], 1u);
    return b;
}
__device__ __forceinline__ void xcd_barrier_complete(unsigned* bar, unsigned x, unsigned& nloc, unsigned& nx) {
    const unsigned G = gridDim.x;
    unsigned sum, cnt, mine, sp = 0u;
    for (;;) {
        sum = 0u; cnt = 0u; mine = 0u;
#pragma unroll
        for (unsigned j = 0; j < 16; ++j) { const unsigned c = xb_ld(&bar[XB_XCNT(j)]); sum += c; cnt += (c > 0u) ? 1u : 0u; mine = (j == x) ? c : mine; }
        if (sum == G) break;
        __builtin_amdgcn_s_sleep(1);
        if ((++sp & 255u) == 0u) { if (xb_ld(&bar[XB_TMO])) break; if (sp > XB_SPIN_CAP) { atomicAdd(&bar[XB_TMO], 1u); break; } }
    }
    nloc = mine > 0u ? mine : 1u; nx = cnt > 0u ? cnt : 1u;
}
__device__ __forceinline__ void xcd_barrier(const XcdBarrier& b) {
    asm volatile("s_waitcnt vmcnt(0)" ::: "memory");
    __syncthreads();
    if (TIDX == 0) {
        unsigned* bar = b.bar;
        __builtin_amdgcn_s_waitcnt(0);
        unsigned nloc = b.st[0], nx = b.st[1];
        if (nloc == 0u) { xcd_barrier_complete(bar, b.x, nloc, nx); b.st[0] = nloc; b.st[1] = nx; }
        const unsigned old = xb_add(&bar[XB_XSUB(b.x)], 1u);
        const unsigned gen = old / nloc;
        if (old + 1u == (gen + 1u) * nloc) {
            __builtin_amdgcn_fence(__ATOMIC_RELEASE, "agent");
            asm volatile("s_waitcnt vmcnt(0)" ::: "memory");
            const unsigned og = xb_add(&bar[XB_TOP], 1u);
            const unsigned tg = og / nx;
            if (og + 1u == (tg + 1u) * nx) xb_add(&bar[XB_TOPGEN], 1u);
            else XB_SPIN(xb_ld(&bar[XB_TOPGEN]) == tg, bar);
            __builtin_amdgcn_fence(__ATOMIC_ACQUIRE, "agent");
            xb_add(&bar[XB_XGEN(b.x)], 1u);
            asm volatile("s_waitcnt vmcnt(0)" ::: "memory");
        } else {
            XB_SPIN(xb_ld(&bar[XB_XGEN(b.x)]) == gen, bar);
            __builtin_amdgcn_fence(__ATOMIC_ACQUIRE, "agent");
            asm volatile("s_waitcnt vmcnt(0)" ::: "memory");
        }
    }
    __syncthreads();
}


typedef short bf16x8 __attribute__((ext_vector_type(8)));
__device__ __forceinline__ void unpack8f(const u32x4 v, float* f) {
    f[0] = __uint_as_float(v.x << 16); f[1] = __uint_as_float(v.x & 0xffff0000u); f[2] = __uint_as_float(v.y << 16); f[3] = __uint_as_float(v.y & 0xffff0000u);
    f[4] = __uint_as_float(v.z << 16); f[5] = __uint_as_float(v.z & 0xffff0000u); f[6] = __uint_as_float(v.w << 16); f[7] = __uint_as_float(v.w & 0xffff0000u);
}
__device__ __forceinline__ u32x4 pack8f(const float* f) { u32x4 o; o.x = pk2(f[0], f[1]); o.y = pk2(f[2], f[3]); o.z = pk2(f[4], f[5]); o.w = pk2(f[6], f[7]); return o; }
__device__ __forceinline__ void ld8bf(const bf16_t* p, float* f) { unpack8f(*(const u32x4*)p, f); }
__device__ __forceinline__ void ld8f(const float* p, float* f) { const f32x4 a = *(const f32x4*)p, b = *(const f32x4*)(p + 4); f[0] = a.x; f[1] = a.y; f[2] = a.z; f[3] = a.w; f[4] = b.x; f[5] = b.y; f[6] = b.z; f[7] = b.w; }
struct GlaBufs { bf16_t* QT; bf16_t* KT; bf16_t* KDT; bf16_t* VT; float* DG; void* DS; bf16_t* SP; };
__device__ __forceinline__ float logsigf(float x) { return fminf(x, 0.f) - log1pf(__expf(-fabsf(x))); }

template <int K, int LAYER>
__device__ __forceinline__ void gla_prep_tile(LAS float* lds, const bf16_t* P, const float* aux0, const float* aux1, const GlaBufs& B, int cg) {
    constexpr int HK = 4 * K, KP = K + 1;
    LAS float* G = lds;
    LAS float* KR = lds + 64 * KP;
    LAS float* LV = lds + 2 * 64 * KP;
    const int tid = TIDX, lane = tid & 63, wave = tid >> 6;
    const int t0 = cg * 64;
    LAS float* GL = lds + 2 * 64 * KP + 64 * 129;
    LAS float* GA = GL + 64 * 16;
    if (LAYER == 0) {
        for (int idx = tid; idx < 64 * 16; idx += NTHREADS) GL[idx] = bf2f(P[(size_t)(t0 + (idx >> 4)) * NIN0P + 2816 + (idx & 15)]);
        __syncthreads();
        const int ck = tid & 255, th = tid >> 8;
        float w2r[16];
#pragma unroll
        for (int i = 0; i < 16; ++i) w2r[i] = aux0[i * 256 + ck];
        const float gb = aux1[ck];
        for (int t = th * 32; t < th * 32 + 32; ++t) {
            float gk = gb;
#pragma unroll
            for (int i4 = 0; i4 < 4; ++i4) { const f32x4 x = *(const LAS f32x4*)(GL + t * 16 + 4 * i4); gk += x.x * w2r[4 * i4] + x.y * w2r[4 * i4 + 1] + x.z * w2r[4 * i4 + 2] + x.w * w2r[4 * i4 + 3]; }
            GA[t * 257 + ck] = logsigf(gk) * (1.f / 16.f);
        }
        __syncthreads();
    }
    constexpr int NCH = 64 * K / 8 / NTHREADS;
    for (int h = 0; h < 4; ++h) {
        float qv[NCH][8];
#pragma unroll
        for (int it = 0; it < NCH; ++it) {
            const int ch = tid + it * NTHREADS, t = ch / (K / 8), c8 = (ch % (K / 8)) * 8, ck = h * K + c8;
            float kr[8], g[8];
            if (LAYER == 0) {
                ld8bf(P + (size_t)(t0 + t) * NIN0P + 2048 + ck, kr);
                ld8bf(P + (size_t)(t0 + t) * NIN0P + 1792 + ck, qv[it]);
#pragma unroll
                for (int j = 0; j < 8; ++j) { g[j] = GA[t * 257 + ck + j]; qv[it][j] *= 0.125f; }
            } else {
                float f[8], l0[8], l1[8];
                ld8bf(P + (size_t)(t0 + t) * NIN1 + 1024 + ck, f);
                ld8bf(P + (size_t)(t0 + t) * NIN1 + 512 + ck, qv[it]);
                ld8f(aux0 + ck, l0); ld8f(aux0 + 512 + ck, l1);
#pragma unroll
                for (int j = 0; j < 8; ++j) {
                    const float lbv = 1.f / (1.f + __expf(l0[j] - l1[j]));
                    const float sg = sigm(f[j]);
                    g[j] = __logf(lbv + (1.f - lbv) * sg); kr[j] = (1.f - lbv) * (1.f - sg); qv[it][j] = siluf(qv[it][j]);
                }
            }
#pragma unroll
            for (int j = 0; j < 8; ++j) { G[t * KP + c8 + j] = g[j]; KR[t * KP + c8 + j] = kr[j]; }
        }
#pragma unroll
        for (int it = 0; it < 2; ++it) {
            const int ch = tid + it * NTHREADS, t = ch >> 4, v8 = (ch & 15) * 8;
            float vv[8];
            ld8bf(LAYER == 0 ? P + (size_t)(t0 + t) * NIN0P + 2304 + h * 128 + v8 : P + (size_t)(t0 + t) * NIN1 + 1536 + h * 128 + v8, vv);
#pragma unroll
            for (int j = 0; j < 8; ++j) LV[t * 129 + v8 + j] = vv[j];
        }
        __syncthreads();
        for (int k = wave; k < K; k += NWAVES) {
            float v = G[lane * KP + k];
#pragma unroll
            for (int o = 1; o < 64; o <<= 1) { const float n = __shfl_up(v, o); if (lane >= o) v += n; }
            G[lane * KP + k] = v;
        }
        __syncthreads();
#pragma unroll
        for (int it = 0; it < NCH; ++it) {
            const int ch = tid + it * NTHREADS, t = ch / (K / 8), c8 = (ch % (K / 8)) * 8, ck = h * K + c8;
            float qo[8], ko[8];
#pragma unroll
            for (int j = 0; j < 8; ++j) { const float b = G[t * KP + c8 + j]; qo[j] = qv[it][j] * __expf(b); ko[j] = KR[t * KP + c8 + j] * __expf(-b); }
            *(u32x4*)(B.QT + (size_t)(t0 + t) * HK + ck) = pack8f(qo);
            *(u32x4*)(B.KT + (size_t)(t0 + t) * HK + ck) = pack8f(ko);
        }
#pragma unroll
        for (int it = 0; it < NCH; ++it) {
            const int id = tid + it * NTHREADS, t8 = (id & 7) * 8, k = id >> 3;
            const float bl = G[63 * KP + k];
            float o[8];
#pragma unroll
            for (int j = 0; j < 8; ++j) o[j] = KR[(t8 + j) * KP + k] * __expf(bl - G[(t8 + j) * KP + k]);
            *(u32x4*)(B.KDT + ((size_t)cg * HK + h * K + k) * 64 + t8) = pack8f(o);
            if (t8 == 0) B.DG[(size_t)cg * HK + h * K + k] = __expf(bl);
        }
#pragma unroll
        for (int it = 0; it < 2; ++it) {
            const int id = tid + it * NTHREADS, t8 = (id & 7) * 8, vc = id >> 3;
            float o[8];
#pragma unroll
            for (int j = 0; j < 8; ++j) o[j] = LV[(t8 + j) * 129 + vc];
            *(u32x4*)(B.VT + ((size_t)cg * 512 + h * 128 + vc) * 64 + t8) = pack8f(o);
        }
        __syncthreads();
    }
}

template <int K, bool DSBF>
__device__ __forceinline__ void gla_pass1_unit(const GlaBufs& B, int unit, int lane) {
    constexpr int HK = 4 * K, KT16 = K / 16;
    const int item = unit / KT16, kt = unit % KT16, cg = item >> 2, h = item & 3;
    const int r = lane & 15, q = lane >> 4;
    const bf16_t* ap = B.KDT + ((size_t)cg * HK + h * K + kt * 16 + r) * 64 + 8 * q;
    const bf16x8 a0 = *(const bf16x8*)ap, a1 = *(const bf16x8*)(ap + 32);
    const size_t dso = ((size_t)item * 128 + r) * K + kt * 16 + 4 * q;
#pragma unroll
    for (int vt = 0; vt < 8; ++vt) {
        const bf16_t* bp = B.VT + ((size_t)cg * 512 + h * 128 + vt * 16 + r) * 64 + 8 * q;
        const bf16x8 b0 = *(const bf16x8*)bp, b1 = *(const bf16x8*)(bp + 32);
        f32x4 acc = {0.f, 0.f, 0.f, 0.f};
        acc = __builtin_amdgcn_mfma_f32_16x16x32_bf16(a0, b0, acc, 0, 0, 0);
        acc = __builtin_amdgcn_mfma_f32_16x16x32_bf16(a1, b1, acc, 0, 0, 0);
        if (DSBF) { u32x2 w; w.x = pk2(acc[0], acc[1]); w.y = pk2(acc[2], acc[3]); *(u32x2*)((bf16_t*)B.DS + dso + (size_t)vt * 16 * K) = w; }
        else *(f32x4*)((float*)B.DS + dso + (size_t)vt * 16 * K) = acc;
    }
}

template <int K, bool DSBF>
__device__ __forceinline__ void gla_pass2(const GlaBufs& B, int gthread, int gthreads) {
    constexpr int HK = 4 * K;
    const float* __restrict__ DSf = (const float*)B.DS; const bf16_t* __restrict__ DSb = (const bf16_t*)B.DS; const float* __restrict__ DG = B.DG; bf16_t* __restrict__ SP = B.SP;
    for (int e = gthread; e < 8 * 128 * K; e += gthreads) {
        const int k = e % K, v = (e / K) & 127, bh = e / (K * 128), b = bh >> 2, h = bh & 3;
        float S = 0.f;
#pragma unroll 8
        for (int c = 0; c < 128; ++c) {
            const int cg = b * 128 + c;
            const size_t idx = ((size_t)(cg * 4 + h) * 128 + v) * K + k;
            const float d = DG[(size_t)cg * HK + h * K + k], ds = DSBF ? bf2f(DSb[idx]) : DSf[idx];
            SP[idx] = f2bf(S);
            S = d * S + ds;
        }
    }
}

template <int K, int LAYER>
__device__ __forceinline__ void gla_pass3_item(LAS unsigned char* lds, const bf16_t* P, const float* norm_g, const GlaBufs& B, bf16_t* Ymix, int item) {
    constexpr int HK = 4 * K, KS = K / 32;
    LAS bf16_t* Ls = (LAS bf16_t*)lds;
    LAS float* Lo = (LAS float*)(lds + 64 * 72 * 2);
    const int tid = TIDX, lane = tid & 63, wave = tid >> 6, r = lane & 15, q = lane >> 4;
    const int cg = item >> 2, h = item & 3, t0 = cg * 64;
    const int it = wave >> 1, i0 = it * 16;
    bf16x8 qf[KS];
#pragma unroll
    for (int s = 0; s < KS; ++s) qf[s] = *(const bf16x8*)(B.QT + (size_t)(t0 + i0 + r) * HK + h * K + 32 * s + 8 * q);
#pragma unroll
    for (int jj2 = 0; jj2 < 2; ++jj2) {
        const int j0 = ((wave & 1) * 2 + jj2) * 16;
        f32x4 acc = {0.f, 0.f, 0.f, 0.f};
        if (j0 <= i0) {
#pragma unroll
            for (int s = 0; s < KS; ++s) {
                const bf16x8 kf = *(const bf16x8*)(B.KT + (size_t)(t0 + j0 + r) * HK + h * K + 32 * s + 8 * q);
                acc = __builtin_amdgcn_mfma_f32_16x16x32_bf16(kf, qf[s], acc, 0, 0, 0);
            }
        }
        const int i = i0 + r;
        u32x2 w;
        w.x = pk2((j0 + 4 * q + 0) <= i ? acc[0] : 0.f, (j0 + 4 * q + 1) <= i ? acc[1] : 0.f);
        w.y = pk2((j0 + 4 * q + 2) <= i ? acc[2] : 0.f, (j0 + 4 * q + 3) <= i ? acc[3] : 0.f);
        *(LAS u32x2*)(Ls + i * 72 + j0 + 4 * q) = w;
    }
    __syncthreads();
    const bf16x8 sf0 = *(const LAS bf16x8*)(Ls + (i0 + r) * 72 + 8 * q), sf1 = *(const LAS bf16x8*)(Ls + (i0 + r) * 72 + 32 + 8 * q);
#pragma unroll
    for (int vv = 0; vv < 4; ++vv) {
        const int v0 = ((wave & 1) * 4 + vv) * 16;
        f32x4 acc = {0.f, 0.f, 0.f, 0.f};
#pragma unroll
        for (int s = 0; s < KS; ++s) {
            const bf16x8 sp = *(const bf16x8*)(B.SP + ((size_t)item * 128 + v0 + r) * K + 32 * s + 8 * q);
            acc = __builtin_amdgcn_mfma_f32_16x16x32_bf16(sp, qf[s], acc, 0, 0, 0);
        }
        const bf16_t* vp = B.VT + ((size_t)cg * 512 + h * 128 + v0 + r) * 64 + 8 * q;
        const bf16x8 vf0 = *(const bf16x8*)vp, vf1 = *(const bf16x8*)(vp + 32);
        acc = __builtin_amdgcn_mfma_f32_16x16x32_bf16(vf0, sf0, acc, 0, 0, 0);
        acc = __builtin_amdgcn_mfma_f32_16x16x32_bf16(vf1, sf1, acc, 0, 0, 0);
        *(LAS f32x4*)(Lo + (i0 + r) * 132 + v0 + 4 * q) = acc;
    }
    __syncthreads();
#pragma unroll 2
    for (int rr = 0; rr < 8; ++rr) {
        const int i = wave * 8 + rr, t = t0 + i;
        const float o0 = Lo[i * 132 + lane], o1 = Lo[i * 132 + 64 + lane];
        const float ms = wave_sum(o0 * o0 + o1 * o1) * (1.f / 128.f);
        const float rs = rsqrtf(ms + LN_EPS);
        float g0, g1;
        if (LAYER == 0) { g0 = bf2f(P[(size_t)t * NIN0P + 2832 + h * 128 + lane]); g1 = bf2f(P[(size_t)t * NIN0P + 2832 + h * 128 + 64 + lane]); }
        else { g0 = bf2f(P[(size_t)t * NIN1 + 2048 + h * 128 + lane]); g1 = bf2f(P[(size_t)t * NIN1 + 2048 + h * 128 + 64 + lane]); }
        Ymix[(size_t)t * D_ + 512 + h * 128 + lane] = f2bf(o0 * rs * norm_g[lane] * siluf(g0));
        Ymix[(size_t)t * D_ + 512 + h * 128 + 64 + lane] = f2bf(o1 * rs * norm_g[64 + lane] * siluf(g1));
    }
    __syncthreads();
}


template <int CTRL> __device__ __forceinline__ float dppf(float x) { return __builtin_bit_cast(float, __builtin_amdgcn_mov_dpp(__builtin_bit_cast(int, x), CTRL, 0xf, 0xf, true)); }
__device__ __forceinline__ float reduce32(float x) {
    x += dppf<0xB1>(x);
    x += dppf<0x4E>(x);
    x += dppf<0x141>(x);
    x += dppf<0x140>(x);
    auto sw = __builtin_amdgcn_permlane16_swap(__float_as_uint(x), __float_as_uint(x), false, false);
    return __uint_as_float(sw[0]) + __uint_as_float(sw[1]);
}
__device__ __forceinline__ void rwkv_scan_v1(LAS float* lds, const bf16_t* SC, float* YRW, int unit) {
    constexpr int TS = 32, TILE = 5 * TS * 64 + TS * 16;
    const int bh = unit >> 3, qr = unit & 7, b = bh >> 3, h = bh & 7;
    const int tid = TIDX, lane = tid & 63, wave = tid >> 6, cp = lane & 31, rl = (wave & 3) * 2 + (lane >> 5);
    const size_t S1 = (size_t)T_ * 512;
    const int chunk = tid & 255, ls = chunk >> 3, lc0 = (chunk & 7) * 8, half = tid >> 8;
    const bf16_t* g0 = SC + (half == 0 ? 0 : 4 * S1) + (size_t)(b * L_ + ls) * 512 + h * 64 + lc0;
    const bf16_t* g1 = SC + (half == 0 ? 1 * S1 : 5 * S1) + (size_t)(b * L_ + ls) * 512 + h * 64 + lc0;
    const bf16_t* g2 = (half == 0) ? SC + 2 * S1 + (size_t)(b * L_ + ls) * 512 + h * 64 + lc0
                                   : SC + 3 * S1 + (size_t)(b * L_ + ls) * 512 + h * 64 + qr * 8;
    u32x4 p0, p1, p2;
    p0 = *(const u32x4*)g0; p1 = *(const u32x4*)g1; p2 = *(const u32x4*)g2;
    float S0 = 0.f, S1v = 0.f;
    auto unpack8 = [](const u32x4 v, float* f) {
        f[0] = __uint_as_float(v.x << 16); f[1] = __uint_as_float(v.x & 0xffff0000u); f[2] = __uint_as_float(v.y << 16); f[3] = __uint_as_float(v.y & 0xffff0000u);
        f[4] = __uint_as_float(v.z << 16); f[5] = __uint_as_float(v.z & 0xffff0000u); f[6] = __uint_as_float(v.w << 16); f[7] = __uint_as_float(v.w & 0xffff0000u); };
    auto stage = [&](LAS float* buf) {
        float f0[8], f1[8], f2[8];
        unpack8(p0, f0); unpack8(p1, f1); unpack8(p2, f2);
        if (half == 0) {
#pragma unroll
            for (int j = 0; j < 8; ++j) { buf[(4 * TS + ls) * 64 + lc0 + j] = f0[j]; buf[(1 * TS + ls) * 64 + lc0 + j] = __expf(f1[j]); buf[(3 * TS + ls) * 64 + lc0 + j] = f2[j]; }
        } else {
#pragma unroll
            for (int j = 0; j < 8; ++j) { buf[(0 * TS + ls) * 64 + lc0 + j] = -f0[j]; buf[(2 * TS + ls) * 64 + lc0 + j] = f0[j] * f1[j]; }
            if ((chunk & 7) == 0) {
#pragma unroll
                for (int j = 0; j < 8; ++j) buf[5 * TS * 64 + ls * 16 + j] = f2[j];
            }
        }
    };
    stage(lds);
    __syncthreads();
    for (int t0 = 0; t0 < L_; t0 += TS) {
        LAS float* cur = lds + ((t0 / TS) & 1) * TILE;
        LAS float* nxt = lds + (((t0 / TS) & 1) ^ 1) * TILE;
        const bool more = (t0 + TS) < L_;
        if (more) { const size_t adv = (size_t)(t0 + TS) * 512; p0 = *(const u32x4*)(g0 + adv); p1 = *(const u32x4*)(g1 + adv); p2 = *(const u32x4*)(g2 + adv); }
        float* yout = YRW + (size_t)(b * L_ + t0) * 512 + h * 64 + qr * 8 + rl;
        if (wave < 4) {
        typedef float f32x2v __attribute__((ext_vector_type(2)));
        f32x2v a2 = *(const LAS f32x2v*)(cur + (0 * TS) * 64 + 2 * cp), w2 = *(const LAS f32x2v*)(cur + (1 * TS) * 64 + 2 * cp), b2 = *(const LAS f32x2v*)(cur + (2 * TS) * 64 + 2 * cp),
               k2 = *(const LAS f32x2v*)(cur + (3 * TS) * 64 + 2 * cp), r2 = *(const LAS f32x2v*)(cur + (4 * TS) * 64 + 2 * cp);
        float vv = cur[5 * TS * 64 + rl];
        float ysel = 0.f;
#pragma unroll
        for (int s = 0; s < TS; ++s) {
            const int sn = (s + 1) & (TS - 1);
            const f32x2v a2n = *(const LAS f32x2v*)(cur + (0 * TS + sn) * 64 + 2 * cp), w2n = *(const LAS f32x2v*)(cur + (1 * TS + sn) * 64 + 2 * cp),
                         b2n = *(const LAS f32x2v*)(cur + (2 * TS + sn) * 64 + 2 * cp), k2n = *(const LAS f32x2v*)(cur + (3 * TS + sn) * 64 + 2 * cp),
                         r2n = *(const LAS f32x2v*)(cur + (4 * TS + sn) * 64 + 2 * cp);
            const float vvn = cur[5 * TS * 64 + sn * 16 + rl];
            const float sa = reduce32(S0 * a2.x + S1v * a2.y);
            S0 = S0 * w2.x + (sa * b2.x + vv * k2.x);
            S1v = S1v * w2.y + (sa * b2.y + vv * k2.y);
            const float y = reduce32(S0 * r2.x + S1v * r2.y);
            ysel = (cp == s) ? y : ysel;
            a2 = a2n; w2 = w2n; b2 = b2n; k2 = k2n; r2 = r2n; vv = vvn;
        }
        yout[(size_t)cp * 512] = ysel;
        }
        if (more) stage(nxt);
        __syncthreads();
    }
}


__device__ __forceinline__ bf16x8 ldfrag(const LAS bf16_t* tile, int row0, int ks, int r, int q) { return *(const LAS bf16x8*)(tile + (row0 + r) * 72 + 32 * ks + 8 * q); }
__device__ __forceinline__ f32x4 mm64(f32x4 acc, const LAS bf16_t* A, int arow0, const LAS bf16_t* B, int brow0, int r, int q) {
    acc = __builtin_amdgcn_mfma_f32_16x16x32_bf16(ldfrag(A, arow0, 0, r, q), ldfrag(B, brow0, 0, r, q), acc, 0, 0, 0);
    acc = __builtin_amdgcn_mfma_f32_16x16x32_bf16(ldfrag(A, arow0, 1, r, q), ldfrag(B, brow0, 1, r, q), acc, 0, 0, 0);
    return acc;
}
__device__ __forceinline__ void rwkv_chunk_pre(LAS unsigned char* lds, const bf16_t* SC, bf16_t* Gout, bf16_t* Rmout, float* HTout, bf16_t* Ymout, int item) {
    const int bh = item >> 7, chn = item & 127, b = bh >> 3, h = bh & 7;
    const size_t S1 = (size_t)T_ * 512, base = (size_t)(b * L_ + chn * 64) * 512 + h * 64;
    LAS bf16_t* TL = (LAS bf16_t*)lds;
#define RTILE(k) (TL + (k) * 4608)
    LAS float* F = (LAS float*)(lds + 12 * 9216);
    LAS float* LL = F + 64 * 68;
    const int tid = TIDX, lane = tid & 63, wave = tid >> 6, r = lane & 15, q = lane >> 4;
    const int t = tid >> 3, c0 = (tid & 7) * 8;
    float ldv[8];
    { const u32x4 v = *(const u32x4*)(SC + 1 * S1 + base + (size_t)t * 512 + c0); unpack8f(v, ldv);
#pragma unroll
      for (int j = 0; j < 8; ++j) F[t * 68 + c0 + j] = ldv[j]; }
    __syncthreads();
#pragma unroll
    for (int cc = 0; cc < 8; ++cc) {
        const int c = wave * 8 + cc;
        float v = F[lane * 68 + c];
#pragma unroll
        for (int o = 1; o < 64; o <<= 1) { const float n = __shfl_up(v, o); if (lane >= o) v += n; }
        F[lane * 68 + c] = v;
    }
    __syncthreads();
    {
        float rr[8], kp[8], vv[8], kk[8], aa[8];
        unpack8f(*(const u32x4*)(SC + 0 * S1 + base + (size_t)t * 512 + c0), rr);
        unpack8f(*(const u32x4*)(SC + 2 * S1 + base + (size_t)t * 512 + c0), kp);
        unpack8f(*(const u32x4*)(SC + 3 * S1 + base + (size_t)t * 512 + c0), vv);
        unpack8f(*(const u32x4*)(SC + 4 * S1 + base + (size_t)t * 512 + c0), kk);
        unpack8f(*(const u32x4*)(SC + 5 * S1 + base + (size_t)t * 512 + c0), aa);
        float at[8], rt[8], bt[8], kt[8];
#pragma unroll
        for (int j = 0; j < 8; ++j) {
            const float cs = F[t * 68 + c0 + j], last = __expf(F[63 * 68 + c0 + j]);
            const float Lt = __expf(cs), Ltm1 = __expf(cs - ldv[j]), inv = __expf(-cs);
            at[j] = -kk[j] * Ltm1; rt[j] = rr[j] * Lt; bt[j] = kk[j] * aa[j] * inv; kt[j] = kp[j] * inv;
            RTILE(4)[(c0 + j) * 72 + t] = f2bf(at[j]);
            RTILE(5)[(c0 + j) * 72 + t] = f2bf(bt[j] * last);
            RTILE(6)[(c0 + j) * 72 + t] = f2bf(kt[j] * last);
            RTILE(7)[(c0 + j) * 72 + t] = f2bf(vv[j]);
            if (t == 63) LL[c0 + j] = last;
        }
        *(LAS u32x4*)(RTILE(0) + t * 72 + c0) = pack8f(at);
        *(LAS u32x4*)(RTILE(1) + t * 72 + c0) = pack8f(bt);
        *(LAS u32x4*)(RTILE(2) + t * 72 + c0) = pack8f(kt);
        *(LAS u32x4*)(RTILE(3) + t * 72 + c0) = pack8f(rt);
    }
    __syncthreads();
    {
        const int mtx = wave >> 1;
        const LAS bf16_t* X = (mtx < 2) ? RTILE(0) : RTILE(3);
        const LAS bf16_t* Y = (mtx & 1) ? RTILE(2) : RTILE(1);
#pragma unroll
        for (int k8 = 0; k8 < 8; ++k8) {
            const int idx = (wave & 1) * 8 + k8, ti = idx >> 2, si = idx & 3;
            f32x4 acc = {0.f, 0.f, 0.f, 0.f};
            if (si <= ti) acc = mm64(acc, Y, si * 16, X, ti * 16, r, q);
            const int tt = ti * 16 + r, s0 = si * 16 + 4 * q;
#pragma unroll
            for (int jj = 0; jj < 4; ++jj) { const bool keep = (mtx < 2) ? (s0 + jj < tt) : (s0 + jj <= tt); acc[jj] = keep ? acc[jj] : 0.f; }
            if (mtx == 0) *(LAS f32x4*)(F + tt * 68 + s0) = acc;
            else { u32x2 w; w.x = pk2(acc[0], acc[1]); w.y = pk2(acc[2], acc[3]); *(LAS u32x2*)(RTILE(7 + mtx) + tt * 72 + s0) = w; }
        }
    }
    __syncthreads();
    if (wave == 0) {
        float X[64];
        int lz = lane; asm volatile("" : "+v"(lz));
        const LAS float* Fb = F; asm volatile("" : "+v"(Fb));
#pragma unroll
        for (int tt = 0; tt < 64; ++tt) {
            float acc = (tt == lz) ? 1.f : 0.f;
#pragma unroll
            for (int s4 = 0; s4 < (tt + 3) / 4; ++s4) {
                const f32x4 a = *(const LAS f32x4*)(Fb + tt * 68 + 4 * s4);
#pragma unroll
                for (int j = 0; j < 4; ++j) if (4 * s4 + j < tt) acc += a[j] * X[4 * s4 + j];
            }
            X[tt] = acc;
            RTILE(11)[tt * 72 + lz] = f2bf(acc);
        }
    } else {
        for (int idx = wave - 1; idx < 16; idx += 7) {
            const int vi = idx >> 2, ti = idx & 3;
            f32x4 acc = {0.f, 0.f, 0.f, 0.f};
            acc = mm64(acc, RTILE(8), ti * 16, RTILE(7), vi * 16, r, q);
            u32x2 w; w.x = pk2(acc[0], acc[1]); w.y = pk2(acc[2], acc[3]);
            *(LAS u32x2*)(RTILE(2) + (vi * 16 + r) * 72 + ti * 16 + 4 * q) = w;
        }
    }
    __syncthreads();
#pragma unroll
    for (int k = 0; k < 4; ++k) {
        const int idx = wave * 4 + k, which = idx >> 4, xi = (idx >> 2) & 3, ti = idx & 3;
        f32x4 acc = {0.f, 0.f, 0.f, 0.f};
        acc = mm64(acc, RTILE(11), ti * 16, which ? RTILE(2) : RTILE(4), xi * 16, r, q);
        u32x2 w; w.x = pk2(acc[0], acc[1]); w.y = pk2(acc[2], acc[3]);
        *(LAS u32x2*)((which ? RTILE(1) : RTILE(0)) + (xi * 16 + r) * 72 + ti * 16 + 4 * q) = w;
    }
    __syncthreads();
#pragma unroll
    for (int k = 0; k < 8; ++k) {
        const int idx = wave * 8 + k, which = idx >> 4, i1 = (idx >> 2) & 3, i2 = idx & 3;
        f32x4 acc = {0.f, 0.f, 0.f, 0.f};
        if (which == 0) {
            acc = mm64(acc, RTILE(0), i2 * 16, RTILE(9), i1 * 16, r, q);
            const int tt = i1 * 16 + r, cc = i2 * 16 + 4 * q;
            const u32x2 rv = *(const LAS u32x2*)(RTILE(3) + tt * 72 + cc);
            acc[0] += __uint_as_float(rv.x << 16); acc[1] += __uint_as_float(rv.x & 0xffff0000u); acc[2] += __uint_as_float(rv.y << 16); acc[3] += __uint_as_float(rv.y & 0xffff0000u);
            u32x2 w; w.x = pk2(acc[0], acc[1]); w.y = pk2(acc[2], acc[3]);
            *(u32x2*)(Rmout + (size_t)item * 4096 + tt * 64 + cc) = w;
        } else if (which == 1) {
            acc = mm64(acc, RTILE(9), i1 * 16, RTILE(1), i2 * 16, r, q);
            acc = mm64(acc, RTILE(10), i1 * 16, RTILE(7), i2 * 16, r, q);
            u32x2 w; w.x = pk2(acc[0], acc[1]); w.y = pk2(acc[2], acc[3]);
            *(u32x2*)(Ymout + (((size_t)item * 16 + i1 * 4 + i2) * 64 + lane) * 4) = w;
        } else if (which == 2) {
            acc = mm64(acc, RTILE(0), i2 * 16, RTILE(5), i1 * 16, r, q);
            const int c1 = i1 * 16 + r, c2 = i2 * 16 + 4 * q;
#pragma unroll
            for (int jj = 0; jj < 4; ++jj) if (c2 + jj == c1) acc[jj] += LL[c1];
            u32x2 w; w.x = pk2(acc[0], acc[1]); w.y = pk2(acc[2], acc[3]);
            *(u32x2*)(Gout + (size_t)item * 4096 + c1 * 64 + c2) = w;
        } else {
            acc = mm64(acc, RTILE(5), i1 * 16, RTILE(1), i2 * 16, r, q);
            acc = mm64(acc, RTILE(6), i1 * 16, RTILE(7), i2 * 16, r, q);
            *(f32x4*)(HTout + (((size_t)item * 16 + i1 * 4 + i2) * 64 + lane) * 4) = acc;
        }
    }
    __syncthreads();
#undef RTILE
}

__device__ __forceinline__ void rwkv_chunk_seq(LAS unsigned char* lds, const bf16_t* G, const bf16_t* Rm, const float* HT, const bf16_t* Ym, float* YRW, int bh) {
    const int b = bh >> 3, h = bh & 7;
    const int tid = TIDX, lane = tid & 63, wave = tid >> 6, r = lane & 15, q = lane >> 4;
    const int rt = wave >> 1, vi0 = (wave & 1) * 2;
    LAS bf16_t* Sb0 = (LAS bf16_t*)lds;
    f32x4 Sacc[2] = {{0.f, 0.f, 0.f, 0.f}, {0.f, 0.f, 0.f, 0.f}};
    size_t item = (size_t)bh * 128;
    auto fetch = [&](size_t it, bf16x8* rm, bf16x8* g, u32x2* ym, f32x4* ht) {
#pragma unroll
        for (int ks = 0; ks < 2; ++ks) {
            rm[ks] = *(const bf16x8*)(Rm + it * 4096 + (rt * 16 + r) * 64 + 32 * ks + 8 * q);
            g[ks] = *(const bf16x8*)(G + it * 4096 + (rt * 16 + r) * 64 + 32 * ks + 8 * q);
        }
#pragma unroll
        for (int k = 0; k < 2; ++k) {
            ym[k] = *(const u32x2*)(Ym + ((it * 16 + rt * 4 + vi0 + k) * 64 + lane) * 4);
            ht[k] = *(const f32x4*)(HT + ((it * 16 + rt * 4 + vi0 + k) * 64 + lane) * 4);
        }
    };
    constexpr int PF = 4;
    bf16x8 prm[PF][2], pg[PF][2]; u32x2 pym[PF][2]; f32x4 pht[PF][2];
#pragma unroll
    for (int u = 0; u < PF; ++u) fetch(item + u, prm[u], pg[u], pym[u], pht[u]);
    for (int ch0 = 0; ch0 < 128; ch0 += PF) {
#pragma unroll
        for (int u = 0; u < PF; ++u) {
            const int ch = ch0 + u;
            LAS bf16_t* Sb = Sb0 + (ch & 1) * 4608;
#pragma unroll
            for (int k = 0; k < 2; ++k) { u32x2 w; w.x = pk2(Sacc[k][0], Sacc[k][1]); w.y = pk2(Sacc[k][2], Sacc[k][3]); *(LAS u32x2*)(Sb + ((vi0 + k) * 16 + r) * 72 + rt * 16 + 4 * q) = w; }
            asm volatile("s_waitcnt lgkmcnt(0)" ::: "memory"); __builtin_amdgcn_s_barrier(); asm volatile("" ::: "memory");
            float* yb = YRW + (size_t)(b * L_ + ch * 64 + rt * 16 + 4 * q) * 512 + h * 64 + r;
#pragma unroll
            for (int k = 0; k < 2; ++k) {
                const bf16x8 s0 = ldfrag(Sb, (vi0 + k) * 16, 0, r, q), s1 = ldfrag(Sb, (vi0 + k) * 16, 1, r, q);
                f32x4 ya; ya[0] = __uint_as_float(pym[u][k].x << 16); ya[1] = __uint_as_float(pym[u][k].x & 0xffff0000u); ya[2] = __uint_as_float(pym[u][k].y << 16); ya[3] = __uint_as_float(pym[u][k].y & 0xffff0000u);
                ya = __builtin_amdgcn_mfma_f32_16x16x32_bf16(prm[u][0], s0, ya, 0, 0, 0);
                ya = __builtin_amdgcn_mfma_f32_16x16x32_bf16(prm[u][1], s1, ya, 0, 0, 0);
                f32x4 sa = pht[u][k];
                sa = __builtin_amdgcn_mfma_f32_16x16x32_bf16(pg[u][0], s0, sa, 0, 0, 0);
                sa = __builtin_amdgcn_mfma_f32_16x16x32_bf16(pg[u][1], s1, sa, 0, 0, 0);
                Sacc[k] = sa;
#pragma unroll
                for (int jj = 0; jj < 4; ++jj) yb[(size_t)jj * 512 + (vi0 + k) * 16] = ya[jj];
            }
            const int nch = ch + PF < 128 ? ch + PF : 127;
            fetch(item + nch, prm[u], pg[u], pym[u], pht[u]);
        }
    }
}


__device__ __forceinline__ void rwkv_chunk_seq2(LAS unsigned char* lds, const bf16_t* G, const bf16_t* Rm, const float* HT, const bf16_t* Ym, float* YRW, int unit) {
    constexpr int PF = 12;
    const int bh = unit >> 2, vq = unit & 3, b = bh >> 3, h = bh & 7;
    const int tid = TIDX, lane = tid & 63, wave = tid >> 6, r = lane & 15, q = lane >> 4;
    const int ti = wave & 3;
    LAS bf16_t* Sb0 = (LAS bf16_t*)lds;
    const size_t item0 = (size_t)bh * 128;
    if (wave < 4) {
        bf16x8 pa[PF][2]; u32x2 py[PF];
        const bf16_t* ra = Rm + item0 * 4096 + (ti * 16 + r) * 64 + 8 * q;
        const bf16_t* ya = Ym + ((item0 * 16 + ti * 4 + vq) * 64 + lane) * 4;
#pragma unroll
        for (int u = 0; u < PF; ++u) { pa[u][0] = *(const bf16x8*)(ra + (size_t)u * 4096); pa[u][1] = *(const bf16x8*)(ra + (size_t)u * 4096 + 32); py[u] = *(const u32x2*)(ya + (size_t)u * 4096); }
        for (int ch0 = 0; ch0 < 132; ch0 += PF) {
#pragma unroll
            for (int u = 0; u < PF; ++u) {
                const int ch = ch0 + u;
                if (ch < 128) {
                    const LAS bf16_t* Sb = Sb0 + (ch & 1) * 1152;
                    asm volatile("s_waitcnt lgkmcnt(0)" ::: "memory"); __builtin_amdgcn_s_barrier(); asm volatile("" ::: "memory");
                    const bf16x8 s0 = ldfrag(Sb, 0, 0, r, q), s1 = ldfrag(Sb, 0, 1, r, q);
                    f32x4 ya4; ya4[0] = __uint_as_float(py[u].x << 16); ya4[1] = __uint_as_float(py[u].x & 0xffff0000u); ya4[2] = __uint_as_float(py[u].y << 16); ya4[3] = __uint_as_float(py[u].y & 0xffff0000u);
                    ya4 = __builtin_amdgcn_mfma_f32_16x16x32_bf16(pa[u][0], s0, ya4, 0, 0, 0);
                    ya4 = __builtin_amdgcn_mfma_f32_16x16x32_bf16(pa[u][1], s1, ya4, 0, 0, 0);
                    float* yb = YRW + (size_t)(b * L_ + ch * 64 + ti * 16 + 4 * q) * 512 + h * 64 + vq * 16 + r;
#pragma unroll
                    for (int jj = 0; jj < 4; ++jj) yb[(size_t)jj * 512] = ya4[jj];
                    const int nch = ch + PF < 128 ? ch + PF : 127;
                    pa[u][0] = *(const bf16x8*)(ra + (size_t)nch * 4096); pa[u][1] = *(const bf16x8*)(ra + (size_t)nch * 4096 + 32); py[u] = *(const u32x2*)(ya + (size_t)nch * 4096);
                }
            }
        }
    } else {
        bf16x8 pa[PF][2]; f32x4 ph[PF];
        const bf16_t* ga = G + item0 * 4096 + (ti * 16 + r) * 64 + 8 * q;
        const float* ha = HT + ((item0 * 16 + ti * 4 + vq) * 64 + lane) * 4;
#pragma unroll
        for (int u = 0; u < PF; ++u) { pa[u][0] = *(const bf16x8*)(ga + (size_t)u * 4096); pa[u][1] = *(const bf16x8*)(ga + (size_t)u * 4096 + 32); ph[u] = *(const f32x4*)(ha + (size_t)u * 4096); }
        f32x4 Sacc = {0.f, 0.f, 0.f, 0.f};
        for (int ch0 = 0; ch0 < 132; ch0 += PF) {
#pragma unroll
            for (int u = 0; u < PF; ++u) {
                const int ch = ch0 + u;
                if (ch < 128) {
                    LAS bf16_t* Sb = Sb0 + (ch & 1) * 1152;
                    { u32x2 w; w.x = pk2(Sacc[0], Sacc[1]); w.y = pk2(Sacc[2], Sacc[3]); *(LAS u32x2*)(Sb + r * 72 + ti * 16 + 4 * q) = w; }
                    asm volatile("s_waitcnt lgkmcnt(0)" ::: "memory"); __builtin_amdgcn_s_barrier(); asm volatile("" ::: "memory");
                    const bf16x8 s0 = ldfrag(Sb, 0, 0, r, q), s1 = ldfrag(Sb, 0, 1, r, q);
                    f32x4 sa = ph[u];
                    sa = __builtin_amdgcn_mfma_f32_16x16x32_bf16(pa[u][0], s0, sa, 0, 0, 0);
                    sa = __builtin_amdgcn_mfma_f32_16x16x32_bf16(pa[u][1], s1, sa, 0, 0, 0);
                    Sacc = sa;
                    const int nch = ch + PF < 128 ? ch + PF : 127;
                    pa[u][0] = *(const bf16x8*)(ga + (size_t)nch * 4096); pa[u][1] = *(const bf16x8*)(ga + (size_t)nch * 4096 + 32); ph[u] = *(const f32x4*)(ha + (size_t)nch * 4096);
                }
            }
        }
    }
}

__device__ __forceinline__ void sub_barrier(unsigned* ctr, unsigned nblocks) {
    asm volatile("s_waitcnt vmcnt(0)" ::: "memory");
    __syncthreads();
    if (TIDX == 0) {
        __builtin_amdgcn_fence(__ATOMIC_RELEASE, "agent");
        asm volatile("s_waitcnt vmcnt(0)" ::: "memory");
        xb_add(ctr, 1u);
        unsigned sp = 0;
        while (xb_ld(ctr) < nblocks) { __builtin_amdgcn_s_sleep(2); if (++sp > (1u << 22)) break; }
        __builtin_amdgcn_fence(__ATOMIC_ACQUIRE, "agent");
        asm volatile("s_waitcnt vmcnt(0)" ::: "memory");
    }
    __syncthreads();
}


__device__ __forceinline__ void s5_tables(LAS float* lds, const float* a_re, const float* a_im, const float* log_dt, const float* b_re, const float* b_im,
                                          const float* c_re, const float* c_im, bf16_t* MB, bf16_t* WE, int g) {
    LAS float* pwr = lds;
    LAS float* pwi = pwr + 33 * 64;
    LAS float* zbr = pwi + 33 * 64;
    LAS float* zbi = zbr + 1024;
    LAS float* cr = zbi + 1024;
    LAS float* ci = cr + 1024;
    LAS float* kern = ci + 1024;
    const int tid = TIDX;
    const float dt = __expf(log_dt[g]);
    for (int idx = tid; idx < 33 * 64; idx += NTHREADS) {
        const int tau = idx >> 6, n = idx & 63;
        const float lam_re = fminf(a_re[g * 64 + n], -1e-4f), lam_im = a_im[g * 64 + n];
        const float m = __expf(lam_re * dt * (float)tau), ang = lam_im * dt * (float)tau;
        pwr[idx] = m * cosf(ang); pwi[idx] = m * sinf(ang);
    }
    for (int idx = tid; idx < 1024; idx += NTHREADS) {
        const int n = idx >> 4;
        const float lam_re = fminf(a_re[g * 64 + n], -1e-4f), lam_im = a_im[g * 64 + n];
        const float mag = __expf(lam_re * dt);
        const float ab_re = mag * cosf(lam_im * dt), ab_im = mag * sinf(lam_im * dt);
        const float den = lam_re * lam_re + lam_im * lam_im, num_re = ab_re - 1.f;
        const float z_re = (num_re * lam_re + ab_im * lam_im) / den, z_im = (ab_im * lam_re - num_re * lam_im) / den;
        const float br = b_re[(size_t)g * 1024 + idx], bi = b_im[(size_t)g * 1024 + idx];
        zbr[idx] = z_re * br - z_im * bi; zbi[idx] = z_re * bi + z_im * br;
        cr[idx] = c_re[(size_t)g * 1024 + idx]; ci[idx] = c_im[(size_t)g * 1024 + idx];
    }
    __syncthreads();
    {
        const int c = (tid >> 4) & 15, cp = tid & 15, th = tid >> 8;
        float acc[16];
#pragma unroll
        for (int i = 0; i < 16; ++i) acc[i] = 0.f;
        for (int n = 0; n < 64; ++n) {
            const float xr = cr[c * 64 + n], xi = ci[c * 64 + n], zr = zbr[n * 16 + cp], zi = zbi[n * 16 + cp];
            const float pr = xr * zr - xi * zi, pi = xr * zi + xi * zr;
#pragma unroll
            for (int i = 0; i < 16; ++i) acc[i] += pr * pwr[(th * 16 + i) * 64 + n] - pi * pwi[(th * 16 + i) * 64 + n];
        }
#pragma unroll
        for (int i = 0; i < 16; ++i) kern[((th * 16 + i) * 16 + c) * 16 + cp] = acc[i];
    }
    __syncthreads();
    {
        const int row = tid, i = row >> 4, c = row & 15;
        bf16_t* dst = MB + ((size_t)g * 512 + row) * 640;
        for (int ch = 0; ch < 64; ++ch) {
            const int j = ch >> 1, cp0 = (ch & 1) * 8;
            float v[8];
            if (j <= i) { const f32x4 a = *(const LAS f32x4*)(kern + ((i - j) * 16 + c) * 16 + cp0), b = *(const LAS f32x4*)(kern + ((i - j) * 16 + c) * 16 + cp0 + 4);
                          v[0] = a.x; v[1] = a.y; v[2] = a.z; v[3] = a.w; v[4] = b.x; v[5] = b.y; v[6] = b.z; v[7] = b.w; }
            else {
#pragma unroll
                for (int k = 0; k < 8; ++k) v[k] = 0.f; }
            *(u32x4*)(dst + ch * 8) = pack8f(v);
        }
        for (int ch = 0; ch < 16; ++ch) {
            const int n0 = (ch & 7) * 8; const bool im = ch >= 8;
            float v[8];
#pragma unroll
            for (int k = 0; k < 8; ++k) {
                const float xr = cr[c * 64 + n0 + k], xi = ci[c * 64 + n0 + k], pr = pwr[(i + 1) * 64 + n0 + k], pi = pwi[(i + 1) * 64 + n0 + k];
                v[k] = im ? -(xr * pi + xi * pr) : (xr * pr - xi * pi);
            }
            *(u32x4*)(dst + 512 + ch * 8) = pack8f(v);
        }
    }
    {
        const int np = tid >> 1, hf = tid & 1, n = np & 63;
        bf16_t* dst = WE + ((size_t)g * 256 + np) * 512 + hf * 256;
        for (int ch = 0; ch < 32; ++ch) {
            const int col = hf * 256 + ch * 8, j = col >> 4, cp0 = col & 15;
            float v[8];
            if (np < 128) {
                const float pr = pwr[(31 - j) * 64 + n], pi = pwi[(31 - j) * 64 + n];
#pragma unroll
                for (int k = 0; k < 8; ++k) { const float zr = zbr[n * 16 + cp0 + k], zi = zbi[n * 16 + cp0 + k]; v[k] = np < 64 ? (pr * zr - pi * zi) : (pr * zi + pi * zr); }
            } else {
#pragma unroll
                for (int k = 0; k < 8; ++k) v[k] = 0.f; }
            *(u32x4*)(dst + ch * 8) = pack8f(v);
        }
    }
    __syncthreads();
}
__device__ __forceinline__ void s5_fill_ua(const bf16_t* P1, bf16_t* UA, int gw, int ngw, int lane) {
    for (int t = gw; t < T_; t += ngw) {
        const int b = t >> 13, tt = t & 8191, c32 = tt >> 5, j = tt & 31, g = lane >> 1, c0 = (lane & 1) * 8;
        const u32x4 v = *(const u32x4*)(P1 + (size_t)t * NIN1 + 8 * lane);
        *(u32x4*)(UA + ((size_t)g * 512 + b * 256 + c32) * 640 + j * 16 + c0) = v;
    }
}
__device__ __forceinline__ void s5_carry(const float* a_re, const float* a_im, const float* log_dt, const float* E, bf16_t* UA, int th) {
    const int n = th & 63, g = (th >> 6) & 31, b = th >> 11;
    const float lam_re = fminf(a_re[g * 64 + n], -1e-4f), lam_im = a_im[g * 64 + n];
    const float dt = __expf(log_dt[g]);
    const float m = __expf(lam_re * dt * 32.f), ang = lam_im * dt * 32.f;
    const float ar = m * cosf(ang), ai = m * sinf(ang);
    float hr = 0.f, hi = 0.f;
#pragma unroll 32
    for (int c = 0; c < 256; ++c) {
        const size_t row = (size_t)g * 512 + b * 256 + c;
        const float er = E[row * 128 + n], ei = E[row * 128 + 64 + n];
        UA[row * 640 + 512 + n] = f2bf(hr); UA[row * 640 + 576 + n] = f2bf(hi);
        const float nr = ar * hr - ai * hi + er, ni = ar * hi + ai * hr + ei;
        hr = nr; hi = ni;
    }
}

struct Args {
    const float* in[42];
    float* out;
    unsigned char* ws;
    int ph_lo, ph_hi;
};

template <bool DUAL, class AF, class WF, class EF>
__device__ __forceinline__ void naive_gemm(LAS float* lds, int M, int N, int K, AF arow, WF wbase, int ldw, EF epi) {
    LAS float* As = lds;
    LAS float* Bs = lds + 64 * 33;
    LAS float* Bs2 = Bs + 32 * 64;
    const int tid = TIDX, ty = tid >> 4, tx = tid & 15;
    const int tm = (M + 63) / 64, tn = (N + 63) / 64;
    for (int tile = blockIdx.x; tile < tm * tn; tile += gridDim.x) {
        const int m0 = (tile / tn) * 64, n0 = (tile % tn) * 64;
        const float* W = wbase(m0, 0);
        const float* W2 = DUAL ? wbase(m0, 1) : W;
        float acc[2][4], acc2[2][4];
#pragma unroll
        for (int i = 0; i < 2; ++i)
#pragma unroll
            for (int j = 0; j < 4; ++j) { acc[i][j] = 0.f; acc2[i][j] = 0.f; }
        for (int k0 = 0; k0 < K; k0 += 32) {
#pragma unroll
            for (int i = 0; i < 4; ++i) {
                const int idx = tid + i * 512, r = idx >> 5, kk = idx & 31, m = m0 + r;
                As[r * 33 + kk] = (m < M) ? bf2f(arow(m)[k0 + kk]) : 0.f;
            }
#pragma unroll
            for (int i = 0; i < 4; ++i) {
                const int idx = tid + i * 512, kk = idx >> 6, n = idx & 63;
                const bool ok = (n0 + n) < N;
                Bs[kk * 64 + n] = ok ? W[(size_t)(k0 + kk) * ldw + n0 + n] : 0.f;
                if (DUAL) Bs2[kk * 64 + n] = ok ? W2[(size_t)(k0 + kk) * ldw + n0 + n] : 0.f;
            }
            __syncthreads();
#pragma unroll 8
            for (int kk = 0; kk < 32; ++kk) {
                const float a0 = As[(ty * 2) * 33 + kk], a1 = As[(ty * 2 + 1) * 33 + kk];
#pragma unroll
                for (int j = 0; j < 4; ++j) {
                    const float b = Bs[kk * 64 + tx * 4 + j];
                    acc[0][j] += a0 * b; acc[1][j] += a1 * b;
                    if (DUAL) { const float b2 = Bs2[kk * 64 + tx * 4 + j]; acc2[0][j] += a0 * b2; acc2[1][j] += a1 * b2; }
                }
            }
            __syncthreads();
        }
#pragma unroll
        for (int i = 0; i < 2; ++i)
#pragma unroll
            for (int j = 0; j < 4; ++j) {
                const int m = m0 + ty * 2 + i, n = n0 + tx * 4 + j;
                if (m < M && n < N) epi(m, n, acc[i][j], acc2[i][j]);
            }
    }
}

template <class SRC, class DROW>
__device__ __forceinline__ void xpose_item(SRC src, DROW drow, bf16_t* WT, int ldk, LAS float* scr, int k0, int n0, int lane) {
#pragma unroll 8
    for (int i = 0; i < 32; ++i) { const int kk = 2 * i + (lane >> 5); scr[kk * 33 + (lane & 31)] = src(k0 + kk, n0 + (lane & 31)); }
    asm volatile("s_waitcnt lgkmcnt(0)" ::: "memory");
    const int c = lane & 7;
#pragma unroll
    for (int j = 0; j < 4; ++j) {
        const int n = (lane >> 3) + 8 * j; const LAS float* sp = scr + (8 * c) * 33 + n;
        u32x4 o; o.x = pk2(sp[0 * 33], sp[1 * 33]); o.y = pk2(sp[2 * 33], sp[3 * 33]); o.z = pk2(sp[4 * 33], sp[5 * 33]); o.w = pk2(sp[6 * 33], sp[7 * 33]);
        *(u32x4*)(WT + (size_t)drow(n0 + n) * ldk + k0 + 8 * c) = o;
    }
    asm volatile("s_waitcnt lgkmcnt(0)" ::: "memory");
}
template <class SRC4, class DROW>
__device__ __forceinline__ void xpose_item4(SRC4 src, DROW drow, bf16_t* WT, int ldk, LAS float* scr, int k0, int n0, int lane) {
    f32x4 v[8];
#pragma unroll
    for (int i = 0; i < 8; ++i) v[i] = src(k0 + 8 * i + (lane >> 3), n0 + 4 * (lane & 7));
#pragma unroll
    for (int i = 0; i < 8; ++i) { LAS float* d = scr + (8 * i + (lane >> 3)) * 33 + 4 * (lane & 7); d[0] = v[i].x; d[1] = v[i].y; d[2] = v[i].z; d[3] = v[i].w; }
    asm volatile("s_waitcnt lgkmcnt(0)" ::: "memory");
    const int c = lane & 7;
#pragma unroll
    for (int j = 0; j < 4; ++j) {
        const int n = (lane >> 3) + 8 * j; const LAS float* sp = scr + (8 * c) * 33 + n;
        u32x4 o; o.x = pk2(sp[0 * 33], sp[1 * 33]); o.y = pk2(sp[2 * 33], sp[3 * 33]); o.z = pk2(sp[4 * 33], sp[5 * 33]); o.w = pk2(sp[6 * 33], sp[7 * 33]);
        *(u32x4*)(WT + (size_t)drow(n0 + n) * ldk + k0 + 8 * c) = o;
    }
    asm volatile("s_waitcnt lgkmcnt(0)" ::: "memory");
}
__device__ __forceinline__ void convert_plain(const float* W, int K, int N, int NP, bf16_t* WT, LAS float* scr, int gw, int ngw, int lane) {
    const int nblk = NP / 32, nitems = (K / 64) * nblk;
    for (int it = gw; it < nitems; it += ngw) {
        const int k0 = 64 * (it / nblk), n0 = 32 * (it % nblk);
        xpose_item4([&](int k, int n4) { return n4 < N ? *(const f32x4*)(W + (size_t)k * N + n4) : (f32x4){0.f, 0.f, 0.f, 0.f}; }, [&](int n) { return n; }, WT, K, scr, k0, n0, lane);
    }
}
__device__ __forceinline__ void convert_lora(const float* w2, const float* a2, const float* g2, bf16_t* WT, LAS float* scr, int gw, int ngw, int lane) {
    const int nblk = NLORA / 32, nitems = 4 * nblk;
    for (int it = gw; it < nitems; it += ngw) {
        const int k0 = 64 * (it / nblk), n0 = 32 * (it % nblk);
        xpose_item([&](int k, int n) {
            if (n < 512) return k < 64 ? w2[k * 512 + n] : 0.f;
            if (n < 1024) return (k >= 64 && k < 128) ? a2[(k - 64) * 512 + (n - 512)] : 0.f;
            return k >= 128 ? g2[(k - 128) * 512 + (n - 1024)] : 0.f; }, [&](int n) { return n; }, WT, 256, scr, k0, n0, lane);
    }
}
__device__ __forceinline__ void convert_moe(const float* w1, const float* w3, const float* w2, bf16_t* W13, bf16_t* W2T, LAS float* scr, int gw, int ngw, int lane) {
    constexpr int I13 = 16 * 32, I2 = 8 * 32, IE = I13 + I2;
    for (int it = gw; it < 32 * IE; it += ngw) {
        const int e = it / IE, r = it % IE;
        if (r < I13) {
            const int k0 = 64 * (r / 32), n0 = 32 * (r % 32);
            const float* a = w1 + (size_t)e * D_ * 512; const float* b = w3 + (size_t)e * D_ * 512;
            xpose_item4([&](int k, int n4) { return n4 < 512 ? *(const f32x4*)(a + (size_t)k * 512 + n4) : *(const f32x4*)(b + (size_t)k * 512 + (n4 - 512)); },
                       [&](int n) { const int c = n & 511; return (c >> 2) * 8 + (n >> 9) * 4 + (c & 3); }, W13 + (size_t)e * 1024 * 1024, 1024, scr, k0, n0, lane);
        } else {
            const int rr = r - I13, k0 = 64 * (rr / 32), n0 = 32 * (rr % 32);
            const float* a = w2 + (size_t)e * 512 * D_;
            xpose_item4([&](int k, int n4) { return *(const f32x4*)(a + (size_t)k * D_ + n4); }, [&](int n) { return n; }, W2T + (size_t)e * 1024 * 512, 512, scr, k0, n0, lane);
        }
    }
}

__device__ __forceinline__ void ph_prologue(const float* x, bf16_t* hb) {
    const size_t n4 = (size_t)T_ * D_ / 4;
    for (size_t i = (size_t)blockIdx.x * NTHREADS + TIDX; i < n4; i += (size_t)gridDim.x * NTHREADS) {
        const f32x4 v = ((const f32x4*)x)[i];
        u32x2 o; o.x = pk2(v.x, v.y); o.y = pk2(v.z, v.w);
        ((u32x2*)hb)[i] = o;
    }
    for (size_t i = (size_t)blockIdx.x * NTHREADS + TIDX; i < (size_t)256 * D_ / 2; i += (size_t)gridDim.x * NTHREADS)
        ((unsigned*)(hb + (size_t)T_ * D_))[i] = 0u;
}

__device__ __forceinline__ float p0_shift(const bf16_t* P, const float* mu, int t, int c) {
    const float p = bf2f(P[(size_t)t * NIN0P + c]);
    const float pv = ((t & (L_ - 1)) == 0) ? 0.f : bf2f(P[(size_t)(t - 1) * NIN0P + c]);
    return p + mu[c] * (pv - p);
}
template <bool WITH_GLA>
__device__ __forceinline__ void ph_prepA0(const bf16_t* P, const float* mu, const float* gk_w2, const float* gk_b, bf16_t* Ap, float* gla_la) {
    for (int chunk = blockIdx.x; chunk < T_ / 64; chunk += gridDim.x) {
        for (int idx = TIDX; idx < 64 * 256; idx += NTHREADS) {
            const int tl = idx >> 8, j = idx & 255, t = chunk * 64 + tl;
            float v;
            if (j < 64) v = tanhf(p0_shift(P, mu, t, 512 + j));
            else if (j < 128) v = p0_shift(P, mu, t, 1600 + (j - 64));
            else v = sigm(p0_shift(P, mu, t, 1664 + (j - 128)));
            Ap[(size_t)t * 256 + j] = f2bf(v);
            if (WITH_GLA) {
                float gk = gk_b[j];
#pragma unroll
                for (int i = 0; i < 16; ++i) gk += bf2f(P[(size_t)t * NIN0P + 2816 + i]) * gk_w2[i * 256 + j];
                const float ls = fminf(gk, 0.f) - log1pf(__expf(-fabsf(gk)));
                gla_la[(size_t)t * 256 + j] = ls * (1.f / 16.f);
            }
        }
    }
}

__device__ __forceinline__ void ph_prepB0(const bf16_t* P, const bf16_t* LO, const float* mu, const float* w0, const float* a0, const float* k_k, const float* k_a,
                                          const float* r_k, bf16_t* SC, float* BON) {
    const int wave = TIDX >> 6, lane = TIDX & 63;
    for (int item = blockIdx.x * NWAVES + wave; item < T_ * 8; item += gridDim.x * NWAVES) {
        const int t = item >> 3, h = item & 7, c = h * 64 + lane;
        const float r = p0_shift(P, mu, t, c), k = p0_shift(P, mu, t, 576 + c), v = p0_shift(P, mu, t, 1088 + c);
        const float low = bf2f(LO[(size_t)t * 512 + c]), loa = bf2f(LO[(size_t)T_ * 512 + (size_t)t * 512 + c]);
        const float xw = w0[c] + low;
        const float wraw = -softplusf(-xw) - 0.5f;
        const float ld = -__expf(wraw);
        const float a = sigm(a0[c] + loa);
        const float kkr = k * k_k[c];
        const float ss = wave_sum(kkr * kkr);
        const float kk = kkr / fmaxf(sqrtf(ss), 1e-12f);
        const float kp = k * (1.f + (a - 1.f) * k_a[c]);
        const float bon = wave_sum(r * kp * r_k[c]);
        const size_t o = (size_t)t * 512 + c, S1 = (size_t)T_ * 512;
        SC[o] = f2bf(r); SC[S1 + o] = f2bf(ld); SC[2 * S1 + o] = f2bf(kp); SC[3 * S1 + o] = f2bf(v); SC[4 * S1 + o] = f2bf(kk); SC[5 * S1 + o] = f2bf(a);
        if (lane == 0) BON[(size_t)t * 8 + h] = bon;
    }
}

__device__ __forceinline__ void naive_rwkv_scan(LAS float* lds, const bf16_t* SC, float* YRW, int bh) {
    constexpr int TS = 32;
    const int b = bh >> 3, h = bh & 7;
    LAS float* Lnkk = lds;
    LAS float* Ldec = lds + TS * 64;
    LAS float* Lab = lds + 2 * TS * 64;
    LAS float* Lkp = lds + 3 * TS * 64;
    LAS float* Lr = lds + 4 * TS * 64;
    LAS float* Lv = lds + 5 * TS * 64;
    const size_t S1 = (size_t)T_ * 512;
    float S[64];
#pragma unroll
    for (int k = 0; k < 64; ++k) S[k] = 0.f;
    const int lane = TIDX & 63, wave = TIDX >> 6;
    for (int t0 = 0; t0 < L_; t0 += TS) {
        for (int idx = TIDX; idx < TS * 64; idx += NTHREADS) {
            const int s = idx >> 6, k = idx & 63;
            const size_t o = (size_t)(b * L_ + t0 + s) * 512 + h * 64 + k;
            const float r = bf2f(SC[o]), ld = bf2f(SC[S1 + o]), kp = bf2f(SC[2 * S1 + o]), v = bf2f(SC[3 * S1 + o]), kk = bf2f(SC[4 * S1 + o]), a = bf2f(SC[5 * S1 + o]);
            Lnkk[idx] = -kk; Ldec[idx] = __expf(ld); Lab[idx] = kk * a; Lkp[idx] = kp; Lr[idx] = r; Lv[idx] = v;
        }
        __syncthreads();
        if (wave == 0) {
            for (int s = 0; s < TS; ++s) {
                float sa = 0.f;
#pragma unroll
                for (int k = 0; k < 64; ++k) sa += S[k] * Lnkk[s * 64 + k];
                const float vv = Lv[s * 64 + lane];
                float y = 0.f;
#pragma unroll
                for (int k = 0; k < 64; ++k) {
                    S[k] = S[k] * Ldec[s * 64 + k] + sa * Lab[s * 64 + k] + vv * Lkp[s * 64 + k];
                    y += S[k] * Lr[s * 64 + k];
                }
                YRW[(size_t)(b * L_ + t0 + s) * 512 + h * 64 + lane] = y;
            }
        }
        __syncthreads();
    }
}

template <int K, class LDF, class LVF>
__device__ __forceinline__ void naive_gla_scan(LAS float* lds, LDF ld, LVF lv, float* OG, int b, int h) {
    constexpr int TS = 16;
    LAS float* Lq = lds;
    LAS float* Lk = lds + TS * K;
    LAS float* Le = lds + 2 * TS * K;
    LAS float* Lv = lds + 3 * TS * K;
    float S[K];
#pragma unroll
    for (int k = 0; k < K; ++k) S[k] = 0.f;
    const int tid = TIDX;
    for (int t0 = 0; t0 < L_; t0 += TS) {
        for (int idx = tid; idx < TS * K; idx += NTHREADS) {
            const int s = idx / K, k = idx % K;
            float q, kk, e; ld(b * L_ + t0 + s, h * K + k, q, kk, e);
            Lq[idx] = q; Lk[idx] = kk; Le[idx] = e;
        }
        for (int idx = tid; idx < TS * 128; idx += NTHREADS) {
            const int s = idx >> 7, vc = idx & 127;
            Lv[idx] = lv(b * L_ + t0 + s, h * 128 + vc);
        }
        __syncthreads();
        if (tid < 128) {
            for (int s = 0; s < TS; ++s) {
                const float vv = Lv[s * 128 + tid];
                float o = 0.f;
#pragma unroll
                for (int k = 0; k < K; ++k) {
                    S[k] = S[k] * Le[s * K + k] + Lk[s * K + k] * vv;
                    o += Lq[s * K + k] * S[k];
                }
                OG[(size_t)(b * L_ + t0 + s) * 512 + h * 128 + tid] = o;
            }
        }
        __syncthreads();
    }
}

template <bool WITH_GLA>
__device__ __forceinline__ void ph_fin0(const float* YRW, const float* OG, const bf16_t* P, const bf16_t* LO, const bf16_t* SC, const float* BON,
                                        const float* gn_g, const float* gn_b, const float* norm_g, bf16_t* Ymix) {
    const int wave = TIDX >> 6, lane = TIDX & 63;
    const size_t S1 = (size_t)T_ * 512;
    constexpr int NU = WITH_GLA ? 12 : 8;
    for (int item = blockIdx.x * NWAVES + wave; item < T_ * NU; item += gridDim.x * NWAVES) {
        const int t = item / NU, u = item % NU;
        if (u < 8) {
            const int c = u * 64 + lane;
            const float y = YRW[(size_t)t * 512 + c];
            const float mean = wave_sum(y) * (1.f / 64.f);
            const float d = y - mean;
            const float var = wave_sum(d * d) * (1.f / 64.f);
            const float yn = d * rsqrtf(var + 64e-5f) * gn_g[c] + gn_b[c];
            const float v = bf2f(SC[3 * S1 + (size_t)t * 512 + c]);
            const float g = bf2f(LO[(size_t)2 * T_ * 512 + (size_t)t * 512 + c]);
            Ymix[(size_t)t * D_ + c] = f2bf((yn + BON[(size_t)t * 8 + u] * v) * g);
        } else {
            const int h = u - 8;
            const float o0 = OG[(size_t)t * 512 + h * 128 + lane], o1 = OG[(size_t)t * 512 + h * 128 + 64 + lane];
            const float ms = wave_sum(o0 * o0 + o1 * o1) * (1.f / 128.f);
            const float rs = rsqrtf(ms + LN_EPS);
            const float g0 = bf2f(P[(size_t)t * NIN0P + 2832 + h * 128 + lane]), g1 = bf2f(P[(size_t)t * NIN0P + 2832 + h * 128 + 64 + lane]);
            Ymix[(size_t)t * D_ + 512 + h * 128 + lane] = f2bf(o0 * rs * norm_g[lane] * siluf(g0));
            Ymix[(size_t)t * D_ + 512 + h * 128 + 64 + lane] = f2bf(o1 * rs * norm_g[64 + lane] * siluf(g1));
        }
    }
}

__device__ __forceinline__ void ph_ln_router(const float* src, float* hf, bf16_t* hb, const float* lg, const float* lb, const float* wg, const float* bg,
                                             const float* we, const float* be, int* tok_e, int* tok_slot, float* tok_g, unsigned* cnt) {
    const int wave = TIDX >> 6, lane = TIDX & 63;
    for (int t = blockIdx.x * NWAVES + wave; t < T_; t += gridDim.x * NWAVES) {
        const f32x4* xr = (const f32x4*)(src + (size_t)t * D_) + lane;
        f32x4 v[4]; float s = 0.f;
#pragma unroll
        for (int j = 0; j < 4; ++j) { v[j] = xr[64 * j]; s += (v[j].x + v[j].y) + (v[j].z + v[j].w); }
        const float mean = wave_sum(s) * (1.f / D_);
        float s2 = 0.f;
#pragma unroll
        for (int j = 0; j < 4; ++j) { v[j] = v[j] - mean; s2 += (v[j].x * v[j].x + v[j].y * v[j].y) + (v[j].z * v[j].z + v[j].w * v[j].w); }
        const float rstd = rsqrtf(wave_sum(s2) * (1.f / D_) + LN_EPS);
#pragma unroll
        for (int j = 0; j < 4; ++j) {
            const f32x4 g = ((const f32x4*)lg)[lane + 64 * j], bb = ((const f32x4*)lb)[lane + 64 * j];
            v[j] = v[j] * rstd * g + bb;
            ((f32x4*)(hf + (size_t)t * D_))[lane + 64 * j] = v[j];
            u32x2 o; o.x = pk2(v[j].x, v[j].y); o.y = pk2(v[j].z, v[j].w);
            ((u32x2*)(hb + (size_t)t * D_))[lane + 64 * j] = o;
        }
        float cl[4] = {0.f, 0.f, 0.f, 0.f};
#pragma unroll
        for (int j = 0; j < 4; ++j)
#pragma unroll
            for (int e = 0; e < 4; ++e) {
                const int d = 4 * (lane + 64 * j) + e;
                const f32x4 w = *(const f32x4*)(wg + (size_t)d * 4);
                const float xv = v[j][e];
                cl[0] += xv * w.x; cl[1] += xv * w.y; cl[2] += xv * w.z; cl[3] += xv * w.w;
            }
#pragma unroll
        for (int g = 0; g < 4; ++g) cl[g] = wave_sum(cl[g]) + bg[g];
        int grp = 0; float mx = cl[0];
#pragma unroll
        for (int g = 1; g < 4; ++g) if (cl[g] > mx) { mx = cl[g]; grp = g; }
        float den = 0.f;
#pragma unroll
        for (int g = 0; g < 4; ++g) den += __expf(cl[g] - mx);
        const float p_grp = 1.f / den;
        float fl[8];
#pragma unroll
        for (int e = 0; e < 8; ++e) fl[e] = 0.f;
        const float* weg = we + (size_t)grp * D_ * 8;
#pragma unroll
        for (int j = 0; j < 4; ++j)
#pragma unroll
            for (int e = 0; e < 4; ++e) {
                const int d = 4 * (lane + 64 * j) + e;
                const f32x4 w0 = *(const f32x4*)(weg + (size_t)d * 8), w1 = *(const f32x4*)(weg + (size_t)d * 8 + 4);
                const float xv = v[j][e];
                fl[0] += xv * w0.x; fl[1] += xv * w0.y; fl[2] += xv * w0.z; fl[3] += xv * w0.w;
                fl[4] += xv * w1.x; fl[5] += xv * w1.y; fl[6] += xv * w1.z; fl[7] += xv * w1.w;
            }
#pragma unroll
        for (int e = 0; e < 8; ++e) fl[e] = wave_sum(fl[e]) + be[grp * 8 + e];
        int j0 = 0; float m0 = fl[0];
#pragma unroll
        for (int e = 1; e < 8; ++e) if (fl[e] > m0) { m0 = fl[e]; j0 = e; }
        int j1 = -1; float m1 = -3.0e38f;
#pragma unroll
        for (int e = 0; e < 8; ++e) if (e != j0 && fl[e] > m1) { m1 = fl[e]; j1 = e; }
        const float e1 = __expf(m1 - m0);
        const float g0 = p_grp / (1.f + e1), g1 = p_grp * e1 / (1.f + e1);
        if (lane == 0) {
            const int ex0 = grp * 8 + j0, ex1 = grp * 8 + j1;
            const unsigned s0 = atomicAdd(&cnt[ex0], 1u), s1 = atomicAdd(&cnt[ex1], 1u);
            tok_e[2 * t] = ex0; tok_e[2 * t + 1] = ex1;
            tok_slot[2 * t] = (int)s0; tok_slot[2 * t + 1] = (int)s1;
            tok_g[2 * t] = g0; tok_g[2 * t + 1] = g1;
        }
    }
}


__device__ __forceinline__ void shift8(const bf16_t* P, const float* mu, int t, int c, float* out) {
    float p[8], pv[8], m[8];
    ld8bf(P + (size_t)t * NIN0P + c, p); ld8f(mu + c, m);
    if ((t & (L_ - 1)) == 0) {
#pragma unroll
        for (int j = 0; j < 8; ++j) pv[j] = 0.f;
    } else ld8bf(P + (size_t)(t - 1) * NIN0P + c, pv);
#pragma unroll
    for (int j = 0; j < 8; ++j) out[j] = p[j] + m[j] * (pv[j] - p[j]);
}
__device__ __forceinline__ void ph_prepA0v(const bf16_t* P, const float* mu, bf16_t* Ap) {
    const int tid = TIDX, wave = tid >> 6, lane = tid & 63, l5 = lane & 31;
    for (int tp = blockIdx.x * NWAVES + wave; tp < T_ / 2; tp += gridDim.x * NWAVES) {
        const int t = tp * 2 + (lane >> 5), j0 = l5 * 8;
        const int c = j0 < 64 ? 512 + j0 : (j0 < 128 ? 1600 + (j0 - 64) : 1664 + (j0 - 128));
        float x[8]; shift8(P, mu, t, c, x);
#pragma unroll
        for (int j = 0; j < 8; ++j) x[j] = j0 < 64 ? tanhf(x[j]) : (j0 < 128 ? x[j] : sigm(x[j]));
        *(u32x4*)(Ap + (size_t)t * 256 + j0) = pack8f(x);
    }
}
__device__ __forceinline__ float sum8lanes(float v) { v += __shfl_xor(v, 1); v += __shfl_xor(v, 2); v += __shfl_xor(v, 4); return v; }
__device__ __forceinline__ void ph_prepB0v(const bf16_t* P, const bf16_t* LO, const float* mu, const float* w0, const float* a0, const float* k_k, const float* k_a,
                                           const float* r_k, bf16_t* SC, float* BON) {
    const int tid = TIDX, wave = tid >> 6, lane = tid & 63, c0 = lane * 8;
    const size_t S1 = (size_t)T_ * 512;
    for (int t = blockIdx.x * NWAVES + wave; t < T_; t += gridDim.x * NWAVES) {
        float r[8], k[8], v[8], low[8], loa[8], pw0[8], pa0[8], pkk[8], pka[8], prk[8];
        shift8(P, mu, t, c0, r); shift8(P, mu, t, 576 + c0, k); shift8(P, mu, t, 1088 + c0, v);
        ld8bf(LO + (size_t)t * 512 + c0, low); ld8bf(LO + S1 + (size_t)t * 512 + c0, loa);
        ld8f(w0 + c0, pw0); ld8f(a0 + c0, pa0); ld8f(k_k + c0, pkk); ld8f(k_a + c0, pka); ld8f(r_k + c0, prk);
        float ld[8], a[8], kkr[8], kp[8], ss = 0.f, bon = 0.f;
#pragma unroll
        for (int j = 0; j < 8; ++j) {
            const float xw = pw0[j] + low[j];
            const float wraw = -softplusf(-xw) - 0.5f;
            ld[j] = -__expf(wraw);
            a[j] = sigm(pa0[j] + loa[j]);
            kkr[j] = k[j] * pkk[j]; ss += kkr[j] * kkr[j];
            kp[j] = k[j] * (1.f + (a[j] - 1.f) * pka[j]);
            bon += r[j] * kp[j] * prk[j];
        }
        ss = sum8lanes(ss); bon = sum8lanes(bon);
        const float inv = 1.f / fmaxf(sqrtf(ss), 1e-12f);
#pragma unroll
        for (int j = 0; j < 8; ++j) kkr[j] *= inv;
        const size_t o = (size_t)t * 512 + c0;
        *(u32x4*)(SC + o) = pack8f(r); *(u32x4*)(SC + S1 + o) = pack8f(ld); *(u32x4*)(SC + 2 * S1 + o) = pack8f(kp);
        *(u32x4*)(SC + 3 * S1 + o) = pack8f(v); *(u32x4*)(SC + 4 * S1 + o) = pack8f(kkr); *(u32x4*)(SC + 5 * S1 + o) = pack8f(a);
        if ((lane & 7) == 0) BON[(size_t)t * 8 + (lane >> 3)] = bon;
    }
}
__device__ __forceinline__ void ph_fin0v(const float* YRW, const bf16_t* LO, const bf16_t* SC, const float* BON, const float* gn_g, const float* gn_b, bf16_t* Ymix) {
    const int tid = TIDX, wave = tid >> 6, lane = tid & 63, c0 = lane * 8;
    const size_t S1 = (size_t)T_ * 512;
    for (int t = blockIdx.x * NWAVES + wave; t < T_; t += gridDim.x * NWAVES) {
        float y[8], v[8], g[8], gg[8], gb[8];
        ld8f(YRW + (size_t)t * 512 + c0, y); ld8bf(SC + 3 * S1 + (size_t)t * 512 + c0, v); ld8bf(LO + 2 * S1 + (size_t)t * 512 + c0, g);
        ld8f(gn_g + c0, gg); ld8f(gn_b + c0, gb);
        const float bon = BON[(size_t)t * 8 + (lane >> 3)];
        float sm = 0.f;
#pragma unroll
        for (int j = 0; j < 8; ++j) sm += y[j];
        const float mean = sum8lanes(sm) * (1.f / 64.f);
        float sq = 0.f;
#pragma unroll
        for (int j = 0; j < 8; ++j) { y[j] -= mean; sq += y[j] * y[j]; }
        const float rs = rsqrtf(sum8lanes(sq) * (1.f / 64.f) + 64e-5f);
        float o[8];
#pragma unroll
        for (int j = 0; j < 8; ++j) o[j] = (y[j] * rs * gg[j] + gb[j] + bon * v[j]) * g[j];
        *(u32x4*)(Ymix + (size_t)t * D_ + c0) = pack8f(o);
    }
}

__device__ __forceinline__ void ph_ln_router2(LAS unsigned char* lds, const bf16_t* src, bf16_t* hb, const float* lg, const float* lb, const bf16_t* WrT, const float* bg, const float* be,
                                              int* tok_e, int* tok_slot, float* tok_g, unsigned* cnt) {
    LAS bf16_t* LW = (LAS bf16_t*)lds;
    LAS float* LGall = (LAS float*)(lds + 48 * 1032 * 2);
    const int tid = TIDX, wave = tid >> 6, lane = tid & 63, r = lane & 15, q = lane >> 4;
    for (int i = tid; i < 48 * 128; i += NTHREADS) { const int row = i >> 7, c8 = (i & 127) * 8; *(LAS u32x4*)(LW + row * 1032 + c8) = *(const u32x4*)(WrT + (size_t)row * 1024 + c8); }
    for (int rb = blockIdx.x; rb < T_ / 64; rb += gridDim.x) {
#pragma unroll 1
        for (int i = 0; i < 8; i += 2) {
            f32x4 v[2][4]; float sm[2], s2[2];
#pragma unroll
            for (int rr = 0; rr < 2; ++rr) {
                const u32x2* xr = (const u32x2*)(src + (size_t)(rb * 64 + wave * 8 + i + rr) * D_) + lane;
                sm[rr] = 0.f;
#pragma unroll
                for (int j = 0; j < 4; ++j) { const u32x2 xv = xr[64 * j];
                    v[rr][j].x = __uint_as_float(xv.x << 16); v[rr][j].y = __uint_as_float(xv.x & 0xffff0000u); v[rr][j].z = __uint_as_float(xv.y << 16); v[rr][j].w = __uint_as_float(xv.y & 0xffff0000u);
                    sm[rr] += (v[rr][j].x + v[rr][j].y) + (v[rr][j].z + v[rr][j].w); }
            }
#pragma unroll
            for (int o = 1; o < 64; o <<= 1) { sm[0] += __shfl_xor(sm[0], o); sm[1] += __shfl_xor(sm[1], o); }
#pragma unroll
            for (int rr = 0; rr < 2; ++rr) { const float mean = sm[rr] * (1.f / D_); s2[rr] = 0.f;
#pragma unroll
                for (int j = 0; j < 4; ++j) { v[rr][j] = v[rr][j] - mean; s2[rr] += (v[rr][j].x * v[rr][j].x + v[rr][j].y * v[rr][j].y) + (v[rr][j].z * v[rr][j].z + v[rr][j].w * v[rr][j].w); } }
#pragma unroll
            for (int o = 1; o < 64; o <<= 1) { s2[0] += __shfl_xor(s2[0], o); s2[1] += __shfl_xor(s2[1], o); }
#pragma unroll
            for (int rr = 0; rr < 2; ++rr) {
                const int t = rb * 64 + wave * 8 + i + rr;
                const float rstd = rsqrtf(s2[rr] * (1.f / D_) + LN_EPS);
#pragma unroll
                for (int j = 0; j < 4; ++j) {
                    const f32x4 g = ((const f32x4*)lg)[lane + 64 * j], bb = ((const f32x4*)lb)[lane + 64 * j];
                    const f32x4 o4 = v[rr][j] * rstd * g + bb;
                    u32x2 o; o.x = pk2(o4.x, o4.y); o.y = pk2(o4.z, o4.w);
                    ((u32x2*)(hb + (size_t)t * D_))[lane + 64 * j] = o;
                }
            }
        }
        asm volatile("s_waitcnt vmcnt(0)" ::: "memory");
        __syncthreads();
        if (wave < 4) {
            const bf16_t* arow = hb + (size_t)(rb * 64 + wave * 16 + r) * D_ + 8 * q;
            f32x4 acc[3] = {{0.f, 0.f, 0.f, 0.f}, {0.f, 0.f, 0.f, 0.f}, {0.f, 0.f, 0.f, 0.f}};
#pragma unroll 8
            for (int ks = 0; ks < 32; ++ks) {
                const bf16x8 af = *(const bf16x8*)(arow + 32 * ks);
#pragma unroll
                for (int ct = 0; ct < 3; ++ct) {
                    const bf16x8 bfr = *(const LAS bf16x8*)(LW + (ct * 16 + r) * 1032 + 32 * ks + 8 * q);
                    acc[ct] = __builtin_amdgcn_mfma_f32_16x16x32_bf16(af, bfr, acc[ct], 0, 0, 0);
                }
            }
            LAS float* LG = LGall + wave * (16 * 49);
#pragma unroll
            for (int ct = 0; ct < 3; ++ct)
#pragma unroll
                for (int j = 0; j < 4; ++j) LG[(4 * q + j) * 49 + ct * 16 + r] = acc[ct][j];
            asm volatile("s_waitcnt lgkmcnt(0)" ::: "memory");
            if (lane < 16) {
                const int t = rb * 64 + wave * 16 + lane;
                const LAS float* L = LG + lane * 49;
                float cl[4];
#pragma unroll
                for (int g = 0; g < 4; ++g) cl[g] = L[g] + bg[g];
                int grp = 0; float mx = cl[0];
#pragma unroll
                for (int g = 1; g < 4; ++g) if (cl[g] > mx) { mx = cl[g]; grp = g; }
                float den = 0.f;
#pragma unroll
                for (int g = 0; g < 4; ++g) den += __expf(cl[g] - mx);
                const float p_grp = 1.f / den;
                float fl[8];
#pragma unroll
                for (int e = 0; e < 8; ++e) fl[e] = L[4 + grp * 8 + e] + be[grp * 8 + e];
                int j0 = 0; float m0 = fl[0];
#pragma unroll
                for (int e = 1; e < 8; ++e) if (fl[e] > m0) { m0 = fl[e]; j0 = e; }
                int j1 = -1; float m1 = -3.0e38f;
#pragma unroll
                for (int e = 0; e < 8; ++e) if (e != j0 && fl[e] > m1) { m1 = fl[e]; j1 = e; }
                const float e1 = __expf(m1 - m0);
                const float g0 = p_grp / (1.f + e1), g1 = p_grp * e1 / (1.f + e1);
                const int ex0 = grp * 8 + j0, ex1 = grp * 8 + j1;
                const unsigned s0 = atomicAdd(&cnt[ex0], 1u), s1 = atomicAdd(&cnt[ex1], 1u);
                tok_e[2 * t] = ex0; tok_e[2 * t + 1] = ex1;
                tok_slot[2 * t] = (int)s0; tok_slot[2 * t + 1] = (int)s1;
                tok_g[2 * t] = g0; tok_g[2 * t + 1] = g1;
            }
        }
        __syncthreads();
    }
}
__device__ __forceinline__ void convert_router(const float* wg, const float* we, bf16_t* WrT, int gthread, int gthreads) {
    for (int i = gthread; i < 2 * 48 * 1024; i += gthreads) {
        const int layer = i / (48 * 1024), rem = i % (48 * 1024), col = rem >> 10, d = rem & 1023;
        float v = 0.f;
        if (col < 4) v = wg[((size_t)layer * D_ + d) * 4 + col];
        else if (col < 36) { const int g = (col - 4) >> 3, e = (col - 4) & 7; v = we[(((size_t)layer * 4 + g) * D_ + d) * 8 + e]; }
        WrT[i] = f2bf(v);
    }
}

__device__ __forceinline__ void moe_offsets(LAS int* pst, const unsigned* cnt) {
    if (TIDX == 0) {
        int acc = 0;
        for (int e = 0; e < 32; ++e) { pst[e] = acc; const int c = (int)cnt[e]; acc += (c + MOE_PAD - 1) / MOE_PAD * MOE_PAD; }
        pst[32] = acc;
    }
    __syncthreads();
}
__device__ __forceinline__ int moe_expert_of_row(const LAS int* pst, int r) {
    int e = 0;
#pragma unroll 1
    for (int i = 1; i < 32; ++i) if (r >= pst[i]) e = i;
    return e;
}

__device__ __forceinline__ void ph_dispatch(LAS int* pst, const unsigned* cnt, const bf16_t* hb, const int* tok_e, const int* tok_slot, int* tok_dest, bf16_t* XR) {
    moe_offsets(pst, cnt);
    const int wave = TIDX >> 6, lane = TIDX & 63;
    for (int item = blockIdx.x * NWAVES + wave; item < T_ * 2; item += gridDim.x * NWAVES) {
        const int t = item >> 1;
        const int e = tok_e[item], dest = pst[e] + tok_slot[item];
        if (lane == 0) tok_dest[item] = dest;
        const u32x4* src = (const u32x4*)(hb + (size_t)t * D_);
        u32x4* dst = (u32x4*)(XR + (size_t)dest * D_);
        dst[lane] = src[lane]; dst[lane + 64] = src[lane + 64];
    }
    const int R = pst[32];
    for (int r = blockIdx.x * NWAVES + wave; r < R; r += gridDim.x * NWAVES) {
        const int e = moe_expert_of_row(pst, r);
        if (r - pst[e] >= (int)cnt[e]) {
            u32x4* dst = (u32x4*)(XR + (size_t)r * D_);
            const u32x4 z = {0u, 0u, 0u, 0u};
            dst[lane] = z; dst[lane + 64] = z;
        }
    }
}

__device__ __forceinline__ void ph_dispatch2(LAS int* pst, const unsigned* cnt, const int* tok_e, const int* tok_slot, int* tok_dest, int* row_tok) {
    moe_offsets(pst, cnt);
    for (int item = blockIdx.x * NTHREADS + TIDX; item < T_ * 2; item += gridDim.x * NTHREADS) {
        const int dest = pst[tok_e[item]] + tok_slot[item];
        tok_dest[item] = dest; row_tok[dest] = item >> 1;
    }
    const int R = pst[32];
    for (int r = blockIdx.x * NTHREADS + TIDX; r < R; r += gridDim.x * NTHREADS) {
        const int e = moe_expert_of_row(pst, r);
        if (r - pst[e] >= (int)cnt[e]) row_tok[r] = T_;
    }
}

template <bool LAST>
__device__ __forceinline__ void ph_combine_ln(bf16_t* hb, const bf16_t* Y, const int* tok_dest, const float* tok_g, const float* lg, const float* lb, float* outf, bf16_t* hcopy) {
    const int wave = TIDX >> 6, lane = TIDX & 63;
    for (int t0 = (blockIdx.x * NWAVES + wave) * 8; t0 < T_; t0 += gridDim.x * NWAVES * 8) {
        const int dl = lane < 16 ? tok_dest[2 * t0 + lane] : 0;
        const float gl = lane < 16 ? tok_g[2 * t0 + lane] : 0.f;
#pragma unroll 1
        for (int i = 0; i < 8; i += 2) {
            f32x4 v[2][4];
#pragma unroll
            for (int rr = 0; rr < 2; ++rr) {
                const int t = t0 + i + rr;
                const int d0 = __shfl(dl, 2 * (i + rr)), d1 = __shfl(dl, 2 * (i + rr) + 1);
                const float g0 = __shfl(gl, 2 * (i + rr)), g1 = __shfl(gl, 2 * (i + rr) + 1);
#pragma unroll
                for (int j = 0; j < 4; ++j) {
                    const u32x2 hv = ((const u32x2*)(hb + (size_t)t * D_))[lane + 64 * j];
                    f32x4 h; h.x = __uint_as_float(hv.x << 16); h.y = __uint_as_float(hv.x & 0xffff0000u); h.z = __uint_as_float(hv.y << 16); h.w = __uint_as_float(hv.y & 0xffff0000u);
                    const u32x2 y0 = ((const u32x2*)(Y + (size_t)d0 * D_))[lane + 64 * j], y1 = ((const u32x2*)(Y + (size_t)d1 * D_))[lane + 64 * j];
                    f32x4 a, b;
                    a.x = __uint_as_float(y0.x << 16); a.y = __uint_as_float(y0.x & 0xffff0000u); a.z = __uint_as_float(y0.y << 16); a.w = __uint_as_float(y0.y & 0xffff0000u);
                    b.x = __uint_as_float(y1.x << 16); b.y = __uint_as_float(y1.x & 0xffff0000u); b.z = __uint_as_float(y1.y << 16); b.w = __uint_as_float(y1.y & 0xffff0000u);
                    v[rr][j] = h * DN_ALPHA + (a * g0 + b * g1);
                }
            }
            float sm[2], s2[2];
#pragma unroll
            for (int rr = 0; rr < 2; ++rr) { sm[rr] = 0.f;
#pragma unroll
                for (int j = 0; j < 4; ++j) sm[rr] += (v[rr][j].x + v[rr][j].y) + (v[rr][j].z + v[rr][j].w); }
#pragma unroll
            for (int o = 1; o < 64; o <<= 1) { sm[0] += __shfl_xor(sm[0], o); sm[1] += __shfl_xor(sm[1], o); }
#pragma unroll
            for (int rr = 0; rr < 2; ++rr) { const float mean = sm[rr] * (1.f / D_); s2[rr] = 0.f;
#pragma unroll
                for (int j = 0; j < 4; ++j) { v[rr][j] = v[rr][j] - mean; s2[rr] += (v[rr][j].x * v[rr][j].x + v[rr][j].y * v[rr][j].y) + (v[rr][j].z * v[rr][j].z + v[rr][j].w * v[rr][j].w); } }
#pragma unroll
            for (int o = 1; o < 64; o <<= 1) { s2[0] += __shfl_xor(s2[0], o); s2[1] += __shfl_xor(s2[1], o); }
#pragma unroll
            for (int rr = 0; rr < 2; ++rr) {
                const int t = t0 + i + rr;
                const float rstd = rsqrtf(s2[rr] * (1.f / D_) + LN_EPS);
#pragma unroll
                for (int j = 0; j < 4; ++j) {
                    const f32x4 g = ((const f32x4*)lg)[lane + 64 * j], bb = ((const f32x4*)lb)[lane + 64 * j];
                    const f32x4 o4 = v[rr][j] * rstd * g + bb;
                    if (LAST) ((f32x4*)(outf + (size_t)t * D_))[lane + 64 * j] = o4;
                    else { u32x2 o; o.x = pk2(o4.x, o4.y); o.y = pk2(o4.z, o4.w);
                           ((u32x2*)(hb + (size_t)t * D_))[lane + 64 * j] = o; ((u32x2*)(hcopy + (size_t)t * D_))[lane + 64 * j] = o; }
                }
            }
        }
    }
}

__device__ __forceinline__ void naive_s5_scan(const bf16_t* P1, const float* a_re, const float* a_im, const float* log_dt, const float* b_re, const float* b_im,
                                              const float* c_re, const float* c_im, const float* dvec, float* YS5, bf16_t* YS5B, int pair) {
    const int lane = TIDX & 63;
    const int b = pair >> 5, g = pair & 31, n = lane;
    const float lam_re = fminf(a_re[g * 64 + n], -1e-4f), lam_im = a_im[g * 64 + n];
    const float dt = __expf(log_dt[g]);
    const float mag = __expf(lam_re * dt);
    const float ab_re = mag * cosf(lam_im * dt), ab_im = mag * sinf(lam_im * dt);
    const float den = lam_re * lam_re + lam_im * lam_im;
    const float num_re = ab_re - 1.f;
    const float z_re = (num_re * lam_re + ab_im * lam_im) / den;
    const float z_im = (ab_im * lam_re - num_re * lam_im) / den;
    float bre[16], bim[16], cre[16], cim[16];
#pragma unroll
    for (int c = 0; c < 16; ++c) {
        bre[c] = b_re[(size_t)(g * 64 + n) * 16 + c]; bim[c] = b_im[(size_t)(g * 64 + n) * 16 + c];
        cre[c] = c_re[(size_t)(g * 16 + c) * 64 + n]; cim[c] = c_im[(size_t)(g * 16 + c) * 64 + n];
    }
    const float dd = (lane < 16) ? dvec[g * 16 + lane] : 0.f;
    float h_re = 0.f, h_im = 0.f;
    for (int tt = 0; tt < L_; ++tt) {
        const size_t t = (size_t)b * L_ + tt;
        const float ul = (lane < 16) ? bf2f(P1[t * NIN1 + g * 16 + lane]) : 0.f;
        float bur = 0.f, bui = 0.f;
#pragma unroll
        for (int c = 0; c < 16; ++c) { const float u = __shfl(ul, c); bur += u * bre[c]; bui += u * bim[c]; }
        const float x_re = z_re * bur - z_im * bui, x_im = z_re * bui + z_im * bur;
        const float nh_re = ab_re * h_re - ab_im * h_im + x_re;
        const float nh_im = ab_re * h_im + ab_im * h_re + x_im;
        h_re = nh_re; h_im = nh_im;
        float yv = 0.f;
#pragma unroll
        for (int c = 0; c < 16; ++c) { const float y = wave_sum(h_re * cre[c] - h_im * cim[c]); if (lane == c) yv = y; }
        if (lane < 16) {
            const float y = gelu_tanh(yv + dd * ul);
            YS5[t * 512 + g * 16 + lane] = y;
            YS5B[t * 512 + g * 16 + lane] = f2bf(y);
        }
    }
}

__device__ __forceinline__ void ph_fin1(const float* OG, const bf16_t* P1, const float* norm_g, bf16_t* Ymix) {
    const int wave = TIDX >> 6, lane = TIDX & 63;
    for (int item = blockIdx.x * NWAVES + wave; item < T_ * 4; item += gridDim.x * NWAVES) {
        const int t = item >> 2, h = item & 3;
        const float o0 = OG[(size_t)t * 512 + h * 128 + lane], o1 = OG[(size_t)t * 512 + h * 128 + 64 + lane];
        const float ms = wave_sum(o0 * o0 + o1 * o1) * (1.f / 128.f);
        const float rs = rsqrtf(ms + LN_EPS);
        const float g0 = bf2f(P1[(size_t)t * NIN1 + 2048 + h * 128 + lane]), g1 = bf2f(P1[(size_t)t * NIN1 + 2048 + h * 128 + 64 + lane]);
        Ymix[(size_t)t * D_ + 512 + h * 128 + lane] = f2bf(o0 * rs * norm_g[lane] * siluf(g0));
        Ymix[(size_t)t * D_ + 512 + h * 128 + 64 + lane] = f2bf(o1 * rs * norm_g[64 + lane] * siluf(g1));
    }
}

constexpr int LDS_BYTES = 147456;
constexpr int MISC_OFF = 131072 + 8192;
enum Phase {
    PH_PROLOGUE = 0,
    PH_INPROJ0, PH_PREPA0, PH_LORA0, PH_PREPB0, PH_SCAN0, PH_SCAN0B, PH_FIN0, PH_OUTPROJ0, PH_LN1_0, PH_DISP0, PH_UP0, PH_DOWN0, PH_COMB0,
    PH_INPROJ1, PH_L1A, PH_L1C, PH_L1D,
#if !(FAST_HG && FAST_S5)
    PH_SCAN1, PH_FIN1,
#endif
    PH_GLU1, PH_OUTPROJ1, PH_LN1_1, PH_DISP1, PH_UP1, PH_DOWN1, PH_COMB1,
    PH_COUNT
};

typedef const Args __attribute__((address_space(4)))* KArgsP;
__device__ __forceinline__ KArgsP fresh_args() { KArgsP p = (KArgsP)__builtin_amdgcn_kernarg_segment_ptr(); asm volatile("" : "+s"(p)); return p; }
#define PHASE_BEGIN KArgsP ap = fresh_args(); unsigned char* const ws = ap->ws; (void)ws;
#define INP(i) (ap->in[i])
#define W_CTL ((unsigned*)(ws + WS_CTL))
#define W_HB ((bf16_t*)(ws + WS_HB))
#define W_WIN0 ((bf16_t*)(ws + WS_WIN0))
#define W_WOUT0 ((bf16_t*)(ws + WS_WOUT0))
#define W_WIN1 ((bf16_t*)(ws + WS_WIN1))
#define W_WOUT1 ((bf16_t*)(ws + WS_WOUT1))
#define W_WGLU ((bf16_t*)(ws + WS_WGLU))
#define W_WLORA ((bf16_t*)(ws + WS_WLORA))
#define W_WROUTER ((bf16_t*)(ws + WS_WROUTER))
#define W_W13 ((bf16_t*)(ws + WS_W13))
#define W_W2 ((bf16_t*)(ws + WS_W2))
#define W_HA ((float*)(ws + WS_HA))
#define W_YRW W_HA
#define W_OG (W_HA + (size_t)T_ * 512)
#define W_P ((bf16_t*)(ws + WS_P))
#define W_LO ((bf16_t*)(ws + WS_LO))
#define W_SC ((bf16_t*)(ws + WS_SCAN))
#define W_GLALA ((float*)(ws + WS_GLALA))
#define W_BON ((float*)(ws + WS_BON))
#define W_AP ((bf16_t*)(ws + WS_APRIME))
#define W_YS5B ((bf16_t*)(ws + WS_YS5B))
#define W_XR ((bf16_t*)(ws + WS_XR))
#define W_HID ((bf16_t*)(ws + WS_HID))
#define W_Y ((bf16_t*)(ws + WS_Y))
#define W_TOKE ((int*)(ws + WS_ROUTE))
#define W_TOKSLOT (W_TOKE + 2 * T_)
#define W_TOKDEST (W_TOKE + 4 * T_)
#define W_TOKG ((float*)(W_TOKE + 6 * T_))
#define W_ROWTOK (W_TOKE + 8 * T_)
#define W_YMIX W_HB
#define BIGP(mib) (ws + WS_BIG + (size_t)(mib) * MiB)
#define GLA0_BUFS GlaBufs{(bf16_t*)BIGP(256), (bf16_t*)BIGP(264), (bf16_t*)(ws + WS_HB), (bf16_t*)BIGP(273), (float*)BIGP(289), W_HA + (size_t)T_ * 512, (bf16_t*)BIGP(112)}
#define HG_BUFS GlaBufs{(bf16_t*)BIGP(96), (bf16_t*)BIGP(112), (bf16_t*)BIGP(144), (bf16_t*)BIGP(128), (float*)BIGP(192), (void*)BIGP(252), (bf16_t*)BIGP(160)}
#define W_S5WE ((bf16_t*)BIGP(244))
#define W_S5UA ((bf16_t*)BIGP(201))
#define W_S5MB ((bf16_t*)BIGP(224))
#define W_S5E ((float*)BIGP(193))
#define CW_SUB 12288

#define IN(k) (PLO <= (k) && (k) < PHI)
#define SEAM(k) do { if (IN(k) && IN((k) + 1)) { PHASE_BEGIN XcdBarrier bar_; bar_.bar = W_CTL + CW_BAR; bar_.x = xb_xcc_id(); bar_.st = (volatile LAS unsigned*)(lds + MISC_OFF) + 8; xcd_barrier(bar_); } } while (0)
template <int PLO, int PHI, int layer>
__device__ __forceinline__ void moe_layer(LAS unsigned char* lds) {
    LAS float* ldsf = (LAS float*)lds; (void)ldsf;
        const int base = layer == 0 ? PH_OUTPROJ0 : PH_OUTPROJ1;
        if (IN(base + 0)) {
            PHASE_BEGIN
            bf16_t* V1b = (bf16_t*)W_HA;
            if (layer == 0) { pg8::Gemm g{W_YMIX, W_WOUT0, T_, D_, D_}; pg8::StaticOrder S; S.init(T_, D_, (int)gridDim.x, (int)blockIdx.x); pg8::EpiResidBf16<false> E{INP(0), V1b, D_, DN_ALPHA};
                              pg8::gemm_phase<pg8::EpiResidBf16<false>, pg8::StaticOrder, true, true>(lds, g, S, E); }
            else { pg8::Gemm g{W_YMIX, W_WOUT1, T_, D_, D_}; pg8::StaticOrder S; S.init(T_, D_, (int)gridDim.x, (int)blockIdx.x); pg8::EpiResidBf16<true> E{(const bf16_t*)W_HA + (size_t)T_ * D_, V1b, D_, DN_ALPHA};
                   pg8::gemm_phase<pg8::EpiResidBf16<true>, pg8::StaticOrder, true, true>(lds, g, S, E); }
        }
        SEAM(base + 0);
        if (IN(base + 1)) {
            PHASE_BEGIN
            ph_ln_router2(lds, (const bf16_t*)W_HA, W_HB, INP(31) + layer * D_, INP(32) + layer * D_, W_WROUTER + (size_t)layer * 48 * 1024, INP(34) + layer * 4, INP(36) + layer * 32,
                          W_TOKE, W_TOKSLOT, W_TOKG, W_CTL + CW_CNT + 64 * layer);
        }
        SEAM(base + 1);
        if (IN(base + 2)) { PHASE_BEGIN ph_dispatch2((LAS int*)lds, W_CTL + CW_CNT + 64 * layer, W_TOKE, W_TOKSLOT, W_TOKDEST, W_ROWTOK); }
        SEAM(base + 2);
        if (IN(base + 3)) {
            PHASE_BEGIN
#if FAST_GEMM
            { LAS int* pst = (LAS int*)(lds + 131072 + 1792); LAS int* tile_e = (LAS int*)(lds + 131072 + 1024); LAS int* rowl = (LAS int*)(lds + 131072 + 2048);
              moe_offsets(pst, W_CTL + CW_CNT + 64 * layer);
              const int ntiles = pst[32] / 256;
              if ((int)TIDX < ntiles) tile_e[TIDX] = moe_expert_of_row(pst, TIDX * 256);
              { const int* rt = W_ROWTOK;
                for (int i = 0; i < 3; ++i) { const int L = i * (int)gridDim.x + (int)blockIdx.x; if (L < ntiles * 4 && TIDX < 256) rowl[i * 256 + TIDX] = rt[(L >> 2) * 256 + TIDX]; } }
              __syncthreads();
              pg8::Gemm g{W_HB, W_W13, ntiles * 256, 1024, D_, D_, rowl}; pg8::MoeOrder S{ntiles, 4, (int)gridDim.x, (int)blockIdx.x, tile_e}; pg8::EpiSwiglu E{W_HID};
              pg8::gemm_phase<pg8::EpiSwiglu, pg8::MoeOrder, true, true>(lds, g, S, E); }
#else
            LAS int* pst = (LAS int*)(lds + 65536);
            moe_offsets(pst, W_CTL + CW_CNT + 64 * layer);
            const float* w1 = INP(37) + (size_t)layer * 32 * D_ * 512; const float* w3 = INP(38) + (size_t)layer * 32 * D_ * 512;
            const bf16_t* XR = W_XR; bf16_t* HID = W_HID;
            naive_gemm<true>(ldsf, pst[32], 512, D_, [&](int m) { return XR + (size_t)m * D_; },
                             [&](int m0, int which) { const int e = moe_expert_of_row(pst, m0); return (which ? w3 : w1) + (size_t)e * D_ * 512; }, 512,
                             [&](int m, int n, float a, float b) { HID[(size_t)m * 512 + n] = f2bf(siluf(a) * b); });
#endif
        }
        SEAM(base + 3);
        if (IN(base + 4)) {
            PHASE_BEGIN
#if FAST_GEMM
            { LAS int* pst = (LAS int*)(lds + 131072 + 1792); LAS int* tile_e = (LAS int*)(lds + 131072 + 1024);
              moe_offsets(pst, W_CTL + CW_CNT + 64 * layer);
              const int ntiles = pst[32] / 256;
              if ((int)TIDX < ntiles) tile_e[TIDX] = moe_expert_of_row(pst, TIDX * 256);
              __syncthreads();
              pg8::Gemm g{W_HID, W_W2, ntiles * 256, 1024, 512}; pg8::MoeOrder S{ntiles, 4, (int)gridDim.x, (int)blockIdx.x, tile_e}; pg8::EpiStoreBf16 E{W_Y, D_, 0, 0};
              pg8::gemm_phase<pg8::EpiStoreBf16, pg8::MoeOrder, true, true>(lds, g, S, E); }
#else
            LAS int* pst = (LAS int*)(lds + 65536);
            moe_offsets(pst, W_CTL + CW_CNT + 64 * layer);
            const float* w2 = INP(39) + (size_t)layer * 32 * 512 * D_;
            const bf16_t* HID = W_HID; bf16_t* Y = W_Y;
            naive_gemm<false>(ldsf, pst[32], D_, 512, [&](int m) { return HID + (size_t)m * 512; },
                              [&](int m0, int) { const int e = moe_expert_of_row(pst, m0); return w2 + (size_t)e * 512 * D_; }, D_,
                              [&](int m, int n, float a, float) { Y[(size_t)m * D_ + n] = f2bf(a); });
#endif
        }
        SEAM(base + 4);
        if (IN(base + 5)) { PHASE_BEGIN ph_combine_ln<layer == 1>(W_HB, W_Y, W_TOKDEST, W_TOKG, INP(40) + layer * D_, INP(41) + layer * D_, ap->out, (bf16_t*)W_HA + (size_t)T_ * D_); }
        SEAM(base + 5);

}

template <int PLO, int PHI>
__device__ __forceinline__ void mega_body(unsigned char* lds_raw) {
    LAS unsigned char* lds = (LAS unsigned char*)lds_raw;
    LAS float* ldsf = (LAS float*)lds;
    constexpr bool MULTI = (PHI - PLO) > 1;
    if (MULTI) {
        PHASE_BEGIN
        volatile LAS unsigned* MISC = (volatile LAS unsigned*)(lds + MISC_OFF);
        if (TIDX < 32) MISC[TIDX] = 0u;
        __syncthreads();
        (void)xcd_barrier_post(W_CTL + CW_BAR, MISC + 8);
    }

    if (IN(PH_PROLOGUE)) {
        PHASE_BEGIN ph_prologue(INP(0), W_HB);
#if FAST_GEMM
        LAS float* scr = ldsf + (TIDX >> 6) * (64 * 33);
        const int gw = blockIdx.x * NWAVES + (TIDX >> 6), ngw = gridDim.x * NWAVES, lane = TIDX & 63;
        convert_plain(INP(1), D_, NIN0, NIN0P, W_WIN0, scr, gw, ngw, lane);
        convert_plain(INP(16), D_, D_, D_, W_WOUT0, scr, gw, ngw, lane);
        convert_plain(INP(17), D_, NIN1, NIN1, W_WIN1, scr, gw, ngw, lane);
        convert_plain(INP(30), D_, D_, D_, W_WOUT1, scr, gw, ngw, lane);
        convert_plain(INP(26), 512, 512, 512, W_WGLU, scr, gw, ngw, lane);
        convert_lora(INP(4), INP(6), INP(7), W_WLORA, scr, gw, ngw, lane);
        convert_router(INP(33), INP(35), W_WROUTER, blockIdx.x * NTHREADS + TIDX, gridDim.x * NTHREADS);
        convert_moe(INP(37), INP(38), INP(39), W_W13, W_W2, scr, gw, ngw, lane);
#endif
    }
    SEAM(PH_PROLOGUE);
    if (IN(PH_INPROJ0)) {
        PHASE_BEGIN
#if FAST_GEMM
        { pg8::Gemm g{W_HB, W_WIN0, T_, NIN0P, D_}; pg8::StaticOrder S; S.init(T_, NIN0P, (int)gridDim.x, (int)blockIdx.x); pg8::EpiStoreBf16 E{W_P, NIN0P, 0, 0};
          pg8::gemm_phase<pg8::EpiStoreBf16, pg8::StaticOrder, true, true>(lds, g, S, E); }
#else
        const float* W = INP(1); const bf16_t* A = W_HB; bf16_t* P = W_P;
        naive_gemm<false>(ldsf, T_, NIN0, D_, [&](int m) { return A + (size_t)m * D_; }, [&](int, int) { return W; }, NIN0,
                          [&](int m, int n, float a, float) { P[(size_t)m * NIN0P + n] = f2bf(a); });
#endif
    }
    SEAM(PH_INPROJ0);
#if FAST_GLA0
    if (IN(PH_PREPA0)) { PHASE_BEGIN ph_prepA0v(W_P, INP(2), W_AP); }
#else
    if (IN(PH_PREPA0)) { PHASE_BEGIN ph_prepA0<!FAST_GLA0>(W_P, INP(2), INP(13), INP(14), W_AP, W_GLALA); }
#endif
    SEAM(PH_PREPA0);
    if (IN(PH_LORA0)) {
        PHASE_BEGIN
#if FAST_GEMM
        { pg8::Gemm g{W_AP, W_WLORA, T_, NLORA, 256}; pg8::StaticOrder S; S.init(T_, NLORA, (int)gridDim.x, (int)blockIdx.x); pg8::EpiStoreBf16 E{W_LO, 512, 512, (size_t)T_ * 512};
          pg8::gemm_phase<pg8::EpiStoreBf16, pg8::StaticOrder, true, true>(lds, g, S, E); }
#else
        const float* w2 = INP(4); const float* a2 = INP(6); const float* g2 = INP(7); const bf16_t* AP = W_AP; bf16_t* LO = W_LO;
        naive_gemm<false>(ldsf, T_, 512, 64, [&](int m) { return AP + (size_t)m * 256; }, [&](int, int) { return w2; }, 512,
                          [&](int m, int n, float a, float) { LO[(size_t)m * 512 + n] = f2bf(a); });
        naive_gemm<false>(ldsf, T_, 512, 64, [&](int m) { return AP + (size_t)m * 256 + 64; }, [&](int, int) { return a2; }, 512,
                          [&](int m, int n, float a, float) { LO[(size_t)T_ * 512 + (size_t)m * 512 + n] = f2bf(a); });
        naive_gemm<false>(ldsf, T_, 512, 128, [&](int m) { return AP + (size_t)m * 256 + 128; }, [&](int, int) { return g2; }, 512,
                          [&](int m, int n, float a, float) { LO[(size_t)2 * T_ * 512 + (size_t)m * 512 + n] = f2bf(a); });
#endif
    }
    SEAM(PH_LORA0);
    if (IN(PH_PREPB0)) {
        PHASE_BEGIN ph_prepB0v(W_P, W_LO, INP(2), INP(3), INP(5), INP(8), INP(9), INP(10), W_SC, W_BON);
#if FAST_GLA0
        { const GlaBufs GB = GLA0_BUFS; __syncthreads();
          const int wave = TIDX >> 6, lane = TIDX & 63;
          for (int cg = blockIdx.x; cg < 256; cg += gridDim.x) {
              gla_prep_tile<64, 0>(ldsf, W_P, INP(13), INP(14), GB, cg);
              asm volatile("s_waitcnt vmcnt(0)" ::: "memory"); __syncthreads();
              for (int u = wave; u < 16; u += NWAVES) gla_pass1_unit<64, false>(GB, cg * 16 + u, lane);
          } }
#endif
    }
    SEAM(PH_PREPB0);
#if FAST_RWKV == 2
#define RW_G ((bf16_t*)BIGP(128))
#define RW_RM ((bf16_t*)ap->out)
#define RW_HT (ap->out + (size_t)4 * 1024 * 1024)
#define RW_YM ((bf16_t*)(ap->out + (size_t)12 * 1024 * 1024))
    if (IN(PH_SCAN0)) {
        PHASE_BEGIN
        for (int it = blockIdx.x; it < 2048; it += gridDim.x) rwkv_chunk_pre(lds, W_SC, RW_G, RW_RM, RW_HT, RW_YM, it);
    }
    SEAM(PH_SCAN0);
    if (IN(PH_SCAN0B)) {
        PHASE_BEGIN
        const int bid = blockIdx.x;
        if (bid < 64) rwkv_chunk_seq2(lds, RW_G, RW_RM, RW_HT, RW_YM, W_YRW, bid);
#if FAST_S5
        else if (bid < 96) s5_tables(ldsf, INP(18), INP(19), INP(20), INP(21), INP(22), INP(23), INP(24), W_S5MB, W_S5WE, bid - 64);
#endif
        else {
            const GlaBufs GB = GLA0_BUFS;
            const int nb = (int)gridDim.x - 96, b0 = bid - 96;
            gla_pass2<64, false>(GB, b0 * NTHREADS + TIDX, nb * NTHREADS);
            sub_barrier(W_CTL + CW_SUB + 64, (unsigned)nb);
            for (int it = b0; it < 1024; it += nb) gla_pass3_item<64, 0>(lds, W_P, INP(15), GB, W_YMIX, it);
#ifdef PROBE_B_GLA2
            gla_pass2<64, false>(GB, b0 * NTHREADS + TIDX, nb * NTHREADS);
#endif
#ifdef PROBE_B_GLA3
            for (int it = b0; it < 1024; it += nb) gla_pass3_item<64, 0>(lds, W_P, INP(15), GB, W_YMIX, it);
#endif
        }
    }
    SEAM(PH_SCAN0B);
#else
    if (IN(PH_SCAN0)) {
        PHASE_BEGIN
        const int bid = blockIdx.x;
#if FAST_RWKV
        constexpr int NRW = 128;
        if (bid < NRW) rwkv_scan_v1(ldsf, W_SC, W_YRW, bid);
#else
        constexpr int NRW = 16;
        if (bid < NRW) naive_rwkv_scan(ldsf, W_SC, W_YRW, bid);
#endif
#if FAST_GLA0
        else {
            const GlaBufs GB = GLA0_BUFS;
            const int nb = (int)gridDim.x - NRW, b0 = bid - NRW, wave = TIDX >> 6, lane = TIDX & 63;
            for (int u = b0 * NWAVES + wave; u < 1024 * 4; u += nb * NWAVES) gla_pass1_unit<64, false>(GB, u, lane);
            sub_barrier(W_CTL + CW_SUB, (unsigned)nb);
            gla_pass2<64, false>(GB, b0 * NTHREADS + TIDX, nb * NTHREADS);
            sub_barrier(W_CTL + CW_SUB + 64, (unsigned)nb);
            for (int it = b0; it < 1024; it += nb) gla_pass3_item<64, 0>(lds, W_P, INP(15), GB, W_YMIX, it);
        }
#else
        else if (bid < 24) {
            const int bh = bid - 16;
            const bf16_t* P = W_P; const float* GLALA = W_GLALA;
            naive_gla_scan<64>(ldsf,
                [&](int t, int ck, float& q, float& kk, float& e) {
                    q = bf2f(P[(size_t)t * NIN0P + 1792 + ck]) * 0.125f; kk = bf2f(P[(size_t)t * NIN0P + 2048 + ck]); e = __expf(GLALA[(size_t)t * 256 + ck]); },
                [&](int t, int cv) { return bf2f(P[(size_t)t * NIN0P + 2304 + cv]); }, W_OG, bh >> 2, bh & 3);
        }
#endif
    }
    SEAM(PH_SCAN0);
    SEAM(PH_SCAN0B);
#endif
#if FAST_GLA0
    if (IN(PH_FIN0)) { PHASE_BEGIN ph_fin0v(W_YRW, W_LO, W_SC, W_BON, INP(11), INP(12), W_YMIX); }
#else
    if (IN(PH_FIN0)) { PHASE_BEGIN ph_fin0<!FAST_GLA0>(W_YRW, W_OG, W_P, W_LO, W_SC, W_BON, INP(11), INP(12), INP(15), W_YMIX); }
#endif
    SEAM(PH_FIN0);

    moe_layer<PLO, PHI, 0>(lds);
            if (IN(PH_INPROJ1)) {
                PHASE_BEGIN
#if FAST_GEMM
                { pg8::Gemm g{W_HB, W_WIN1, T_, NIN1, D_}; pg8::StaticOrder S; S.init(T_, NIN1, (int)gridDim.x, (int)blockIdx.x); pg8::EpiInproj1 E{W_P, W_S5UA};
                  pg8::gemm_phase<pg8::EpiInproj1, pg8::StaticOrder, true, true>(lds, g, S, E); }
#else
                const float* W = INP(17); const bf16_t* A = W_HB; bf16_t* P = W_P;
                naive_gemm<false>(ldsf, T_, NIN1, D_, [&](int m) { return A + (size_t)m * D_; }, [&](int, int) { return W; }, NIN1,
                                  [&](int m, int n, float a, float) { P[(size_t)m * NIN1 + n] = f2bf(a); });
#endif
            }
            SEAM(PH_INPROJ1);
            if (IN(PH_L1A)) {
                PHASE_BEGIN
                const int bid = blockIdx.x;
#if FAST_S5
                if (bid < 64) {
                    LAS int* tile_e = (LAS int*)(lds + 131072 + 1024);
                    if (TIDX < 64) tile_e[TIDX] = TIDX >> 1;
                    __syncthreads();
                    pg8::Gemm g{W_S5UA, W_S5WE, 64 * 256, 256, 512, 640}; pg8::MoeOrder S{64, 1, 64, bid, tile_e}; pg8::EpiStoreF32Half E{W_S5E};
                    pg8::gemm_phase<pg8::EpiStoreF32Half, pg8::MoeOrder, true, true>(lds, g, S, E);
                }
#endif
#if FAST_HG
                { const GlaBufs GB = HG_BUFS; const int wave = TIDX >> 6, lane = TIDX & 63;
                  for (int cg = bid; cg < 256; cg += gridDim.x) {
                      gla_prep_tile<128, 1>(ldsf, W_P, INP(28), nullptr, GB, cg);
                      asm volatile("s_waitcnt vmcnt(0)" ::: "memory"); __syncthreads();
                      for (int u = wave; u < 32; u += NWAVES) gla_pass1_unit<128, true>(GB, cg * 32 + u, lane);
                  } }
#endif
            }
            SEAM(PH_L1A);
            if (IN(PH_L1C)) {
                PHASE_BEGIN
                const int bid = blockIdx.x;
#if FAST_S5
                if (bid < 8) s5_carry(INP(18), INP(19), INP(20), W_S5E, W_S5UA, bid * NTHREADS + TIDX);
#endif
#if FAST_HG
                if (bid >= 8) { const GlaBufs GB = HG_BUFS; gla_pass2<128, true>(GB, (bid - 8) * NTHREADS + TIDX, ((int)gridDim.x - 8) * NTHREADS); }
#endif
#if FAST_GEMM
                { LAS float* scr = ldsf + (TIDX >> 6) * (64 * 33);
                  convert_moe(INP(37) + (size_t)32 * D_ * 512, INP(38) + (size_t)32 * D_ * 512, INP(39) + (size_t)32 * 512 * D_, W_W13, W_W2, scr,
                              bid * NWAVES + (TIDX >> 6), (int)gridDim.x * NWAVES, TIDX & 63); }
#endif
            }
            SEAM(PH_L1C);
            if (IN(PH_L1D)) {
                PHASE_BEGIN
                const int bid = blockIdx.x;
#if FAST_S5
                if (bid < 64) {
                    LAS int* tile_e = (LAS int*)(lds + 131072 + 1024);
                    if (TIDX < 64) tile_e[TIDX] = TIDX >> 1;
                    __syncthreads();
                    pg8::Gemm g{W_S5UA, W_S5MB, 64 * 256, 512, 640, 640}; pg8::MoeOrder S{64, 2, 64, bid, tile_e}; pg8::EpiS5Y E{W_P, INP(25), W_YRW, W_YS5B};
                    pg8::gemm_phase<pg8::EpiS5Y, pg8::MoeOrder, true, true>(lds, g, S, E);
                }
#endif
#if FAST_HG
                if (bid >= 64) {
                    const GlaBufs GB = HG_BUFS;
                    for (int it = bid - 64; it < 1024; it += (int)gridDim.x - 64) gla_pass3_item<128, 1>(lds, W_P, INP(29), GB, W_YMIX, it);
                }
#endif
            }
            SEAM(PH_L1D);
#if !(FAST_HG && FAST_S5)
            if (IN(PH_SCAN1)) {
                PHASE_BEGIN
                const int bid = blockIdx.x;
                const bf16_t* P = W_P; (void)P; (void)bid;
#if !FAST_HG
                if (bid < 8) {
                    const float* hg_lb = INP(28);
                    naive_gla_scan<128>(ldsf,
                        [&](int t, int ck, float& q, float& kk, float& e) {
                            const float l0 = hg_lb[ck], l1 = hg_lb[512 + ck];
                            const float lbv = 1.f / (1.f + __expf(l0 - l1));
                            const float f = bf2f(P[(size_t)t * NIN1 + 1024 + ck]);
                            const float sg = sigm(f);
                            q = siluf(bf2f(P[(size_t)t * NIN1 + 512 + ck])); kk = (1.f - lbv) * (1.f - sg); e = lbv + (1.f - lbv) * sg; },
                        [&](int t, int cv) { return bf2f(P[(size_t)t * NIN1 + 1536 + cv]); }, W_OG, bid >> 2, bid & 3);
                }
#endif
#if !FAST_S5
                if (bid >= 8 && bid < 16) {
                    const int pair = (bid - 8) * 8 + (TIDX >> 6);
                    naive_s5_scan(P, INP(18), INP(19), INP(20), INP(21), INP(22), INP(23), INP(24), INP(25), W_YRW, W_YS5B, pair);
                }
#endif
            }
            SEAM(PH_SCAN1);
#if !FAST_HG
            if (IN(PH_FIN1)) { PHASE_BEGIN ph_fin1(W_OG, W_P, INP(29), W_YMIX); }
#endif
            SEAM(PH_FIN1);
#endif
            if (IN(PH_GLU1)) {
                PHASE_BEGIN
#if FAST_GEMM
                { pg8::Gemm g{W_YS5B, W_WGLU, T_, 512, 512}; pg8::StaticOrder S; S.init(T_, 512, (int)gridDim.x, (int)blockIdx.x); pg8::EpiGlu E{W_YRW, 512, INP(27), W_YMIX, D_};
                  pg8::gemm_phase<pg8::EpiGlu, pg8::StaticOrder, true, true>(lds, g, S, E); }
#else
                const float* W = INP(26); const float* gb = INP(27); const bf16_t* YS5B = W_YS5B; const float* YRW = W_YRW; bf16_t* Ymix = W_YMIX;
                naive_gemm<false>(ldsf, T_, 512, 512, [&](int m) { return YS5B + (size_t)m * 512; }, [&](int, int) { return W; }, 512,
                                  [&](int m, int n, float a, float) { const float y = YRW[(size_t)m * 512 + n]; Ymix[(size_t)m * D_ + n] = f2bf(y * sigm(a + gb[n])); });
#endif
            }
            SEAM(PH_GLU1);
    moe_layer<PLO, PHI, 1>(lds);
#undef IN
}
template <int PLO, int PHI>
__global__ void __launch_bounds__(NTHREADS, 2) mega(Args args) {
    extern __shared__ __attribute__((aligned(16))) unsigned char lds_raw[];
    mega_body<PLO, PHI>(lds_raw);
}

#include <utility>
template <int... I> static void set_attrs(std::integer_sequence<int, I...>) {
    (void)std::initializer_list<int>{ ((void)hipFuncSetAttribute((const void*)mega<I, I + 1>, hipFuncAttributeMaxDynamicSharedMemorySize, LDS_BYTES), 0)... };
}
#ifndef DUP_MASK
#define DUP_MASK 0ull
#endif
template <int I> static int launch_one(int grid, hipStream_t stream, const Args& a) {
    hipLaunchKernelGGL((mega<I, I + 1>), dim3(grid), dim3(NTHREADS), LDS_BYTES, stream, a);
    if ((DUP_MASK >> I) & 1ull) hipLaunchKernelGGL((mega<I, I + 1>), dim3(grid), dim3(NTHREADS), LDS_BYTES, stream, a);
    return 0;
}
template <int... I> static void launch_all(std::integer_sequence<int, I...>, int grid, hipStream_t stream, const Args& a) {
    (void)std::initializer_list<int>{ launch_one<I>(grid, stream, a)... };
}
extern "C" void kernel_launch(void* const* d_in, const int* in_sizes, int n_in, void* d_out, int out_size, void* d_ws, size_t ws_size, hipStream_t stream) {
    static int grid = 0;
    if (grid == 0) {
        if (n_in != 42 || out_size != T_ * D_ || ws_size < WS_END) { fprintf(stderr, "kernel_launch: unexpected shapes n_in %d out %d ws %zu\n", n_in, out_size, ws_size); grid = -1; return; }
        int dev = 0, cus = 0, per_cu = 0;
        hipGetDevice(&dev);
        hipDeviceGetAttribute(&cus, hipDeviceAttributeMultiprocessorCount, dev);
        set_attrs(std::make_integer_sequence<int, PH_COUNT>{});
        hipFuncSetAttribute((const void*)mega<0, PH_COUNT>, hipFuncAttributeMaxDynamicSharedMemorySize, LDS_BYTES);
        hipOccupancyMaxActiveBlocksPerMultiprocessor(&per_cu, (const void*)mega<0, PH_COUNT>, NTHREADS, LDS_BYTES);
        (void)hipGetLastError();
        if (per_cu < 1) per_cu = 1;
        grid = cus * 1;
        fprintf(stderr, "kernel_launch: cus %d per_cu %d grid %d\n", cus, per_cu, grid);
    }
    if (grid < 0) return;
    hipMemsetAsync((char*)d_ws + WS_CTL, 0, CTL_ZERO_BYTES, stream);
    Args a{};
    for (int i = 0; i < 42; ++i) a.in[i] = (const float*)d_in[i];
    a.out = (float*)d_out; a.ws = (unsigned char*)d_ws;
#if MK_SINGLE
    void* kargs[] = {(void*)&a};
    hipError_t e = hipLaunchCooperativeKernel((const void*)mega<0, PH_COUNT>, dim3(grid), dim3(NTHREADS), kargs, LDS_BYTES, stream);
    if (e != hipSuccess) fprintf(stderr, "cooperative launch failed: %s (grid %d)\n", hipGetErrorString(e), grid);
#else
    launch_all(std::make_integer_sequence<int, PH_COUNT>{}, grid, stream, a);
#endif
}
#ifdef TEST_RANGES
template __global__ void mega<0, 2>(Args);
template __global__ void mega<1, 3>(Args);
template __global__ void mega<1, 4>(Args);
template __global__ void mega<3, 8>(Args);
template __global__ void mega<7, 13>(Args);
template __global__ void mega<10, 12>(Args);
template __global__ void mega<13, 17>(Args);
template __global__ void mega<0, 13>(Args);
#endif
```

```cpp
#include <hip/hip_runtime.h>
#include <cstdio>
#include <cstdint>

#define GAS __attribute__((address_space(1)))
#define LAS __attribute__((address_space(3)))
typedef unsigned short bf16_t;
typedef float f32x4 __attribute__((ext_vector_type(4)));
typedef unsigned u32x4 __attribute__((ext_vector_type(4)));
typedef unsigned u32x2 __attribute__((ext_vector_type(2)));
__device__ __forceinline__ int launder_tid() { int t = (int)threadIdx.x; asm volatile("" : "+v"(t)); return t; }
#define TIDX launder_tid()

#ifndef FAST_GEMM
#define FAST_GEMM 1
#endif
#ifndef FAST_LN
#define FAST_LN 1
#endif
#ifndef FAST_RWKV
#define FAST_RWKV 2
#endif
#ifndef FAST_GLA0
#define FAST_GLA0 1
#endif
#ifndef FAST_HG
#define FAST_HG 1
#endif
#ifndef FAST_S5
#define FAST_S5 1
#endif
#ifndef MK_SINGLE
#define MK_SINGLE 1
#endif

constexpr int T_ = 16384, L_ = 8192, D_ = 1024;
constexpr int NIN0 = 3344, NIN0P = 3584, NIN1 = 2560;
constexpr int NLORA = 1536;
constexpr int RMAX = 40960;
constexpr int MOE_PAD = 256;
constexpr float DN_ALPHA = 1.41421356237f;
constexpr float LN_EPS = 1e-5f;
constexpr int NTHREADS = 512, NWAVES = 8;

constexpr size_t MiB = 1u << 20;
constexpr size_t WS_CTL = 0, CTL_ZERO_BYTES = 1 * MiB;
constexpr size_t WS_WIN0 = 2 * MiB;
constexpr size_t WS_WOUT0 = 9 * MiB;
constexpr size_t WS_WIN1 = 11 * MiB;
constexpr size_t WS_WOUT1 = 16 * MiB;
constexpr size_t WS_WGLU = 18 * MiB;
constexpr size_t WS_WLORA = 19 * MiB;
constexpr size_t WS_WROUTER = 19 * MiB + 786432;
constexpr size_t WS_W13 = 20 * MiB;
constexpr size_t WS_W2 = 84 * MiB;
constexpr size_t WS_HB = 116 * MiB;
constexpr size_t WS_HA = 149 * MiB;
constexpr size_t WS_ROUTE = 213 * MiB;
constexpr size_t WS_BIG = 214 * MiB;
constexpr size_t WS_P = WS_BIG;
constexpr size_t WS_LO = WS_BIG + 112 * MiB;
constexpr size_t WS_SCAN = WS_BIG + 160 * MiB;
constexpr size_t WS_GLALA = WS_BIG + 256 * MiB;
constexpr size_t WS_BON = WS_BIG + 272 * MiB;
constexpr size_t WS_APRIME = WS_BIG + 273 * MiB;
constexpr size_t WS_YS5B = WS_BIG + 80 * MiB;
constexpr size_t WS_XR = WS_BIG;
constexpr size_t WS_HID = WS_BIG + 80 * MiB;
constexpr size_t WS_Y = WS_BIG + 120 * MiB;
constexpr size_t WS_END = 512 * MiB;
constexpr int CW_BAR = 4096;
constexpr int CW_CNT = 8192;

__device__ __forceinline__ float bf2f(bf16_t b) { return __uint_as_float(((unsigned)b) << 16); }
__device__ __forceinline__ bf16_t f2bf(float f) { unsigned u = __float_as_uint(f); u += 0x7fffu + ((u >> 16) & 1u); return (bf16_t)(u >> 16); }
__device__ __forceinline__ unsigned pk2(float lo, float hi) { return (unsigned)f2bf(lo) | ((unsigned)f2bf(hi) << 16); }
__device__ __forceinline__ float sigm(float x) { return 1.f / (1.f + __expf(-x)); }
__device__ __forceinline__ float siluf(float x) { return x * sigm(x); }
__device__ __forceinline__ float softplusf(float x) { return fmaxf(x, 0.f) + log1pf(__expf(-fabsf(x))); }
__device__ __forceinline__ float gelu_tanh(float x) { const float u = 0.7978845608028654f * (x + 0.044715f * x * x * x); return 0.5f * x * (1.f + tanhf(u)); }
__device__ __forceinline__ float wave_sum(float v) {
#pragma unroll
    for (int o = 1; o < 64; o <<= 1) v += __shfl_xor(v, o);
    return v;
}


namespace pg8 {
#define PG8_LAS __attribute__((address_space(3)))
typedef unsigned short bf16_t;
typedef short bf16x8 __attribute__((ext_vector_type(8)));
typedef float f32x4 __attribute__((ext_vector_type(4)));
typedef unsigned u32x4 __attribute__((ext_vector_type(4)));
constexpr int BM = 256, BK = 64, HALF = 128, HTB = HALF * BK * 2  , STAGE_BYTES = 8 * HTB, NXCD = 8, WGM = 8;

__host__ __device__ __forceinline__ int lds_byte(int r, int c) { const int st = (r >> 4) * 2 + (c >> 5), rr = r & 15, cc = c & 31, ob = rr * 64 + cc * 2; return st * 1024 + (ob ^ (((ob >> 9) & 1) << 5)); }
__host__ __device__ __forceinline__ void stage_rc(int b, int& R, int& C) { const int st = b / 1024, sb = b % 1024, swz = sb ^ (((sb >> 9) & 1) << 5); R = (st >> 1) * 16 + swz / 64; C = (st & 1) * 32 + (swz % 64) / 2; }
__host__ __device__ __forceinline__ int perm32(int rho) { const int n = rho >> 4, i = rho & 15; return 8 * (i >> 2) + 4 * n + (i & 3); }

struct Unit { int pm, pn, pb; };
struct Gemm { const bf16_t* A; const bf16_t* Bt; int M, N, K, lda; const PG8_LAS int* rowlds; };

struct StaticOrder {
    int nM, nN, nwg, G, c;
    __host__ __device__ void init(int M, int N, int G_, int c_) { nM = M / BM; nN = N / BM; nwg = nM * nN; G = G_; c = c_; }
    __host__ __device__ bool next(int i, Unit& u) const {
        const long L = (long)i * G + c; if (L >= nwg) return false;
        int wgid = (int)L; { const int q = nwg / NXCD, r = nwg % NXCD, xcd = wgid % NXCD, off = wgid / NXCD; wgid = (xcd < r ? xcd * (q + 1) : r * (q + 1) + (xcd - r) * q) + off; }
        const int nig = WGM * nN, gid = wgid / nig, fm = gid * WGM, gsz = (nM - fm) < WGM ? (nM - fm) : WGM;
        u.pm = fm + ((wgid % nig) % gsz); u.pn = (wgid % nig) / gsz; u.pb = u.pn; return true;
    }
    __device__ __forceinline__ void a_ready(const Unit&) const {}
    __device__ __forceinline__ void done(const Unit&) const {}
};

__device__ __forceinline__ unsigned cvt_pk_bf16(float lo, float hi) { unsigned r; asm volatile("v_cvt_pk_bf16_f32 %0, %1, %2" : "=v"(r) : "v"(lo), "v"(hi)); return r; }
typedef float f32x2 __attribute__((ext_vector_type(2)));

template <class Epi, class Sched, bool ALIGN_EPI = false, bool SP2 = false>
__device__ __forceinline__ void gemm_phase(PG8_LAS unsigned char* lds, const Gemm g, const Sched& S, const Epi& E) {
    const int tid = TIDX, wid = __builtin_amdgcn_readfirstlane(tid >> 6), lane = tid & 63, wr = wid >> 2, wc = wid & 3, fr = lane & 15, fq = lane >> 4;
    const int K = g.K, nt = K / BK, lda = g.lda ? g.lda : g.K;
    unsigned voffA[2], voffB[2];
    int gR[2]; unsigned gC[2];
#pragma unroll
    for (int i = 0; i < 2; ++i) { int R, C; stage_rc(tid * 16 + i * 8192, R, C); const int Rb = Epi::PERM ? ((R & ~31) + perm32(R & 31)) : R;
        voffA[i] = (unsigned)(R * lda + C) * 2u; voffB[i] = (unsigned)(Rb * K + C) * 2u; gR[i] = R; gC[i] = (unsigned)C * 2u; }
    const bool gather = g.rowlds != nullptr;
    unsigned vA0[2], vA1[2], vN0[2], vN1[2];
#define PG8_GOFS(uidx, o0, o1) do { _Pragma("unroll") for (int _i = 0; _i < 2; ++_i) { \
        if (gather) { const int _r0 = g.rowlds[256 * (uidx) + gR[_i]], _r1 = g.rowlds[256 * (uidx) + HALF + gR[_i]]; o0[_i] = (unsigned)_r0 * (unsigned)(lda * 2) + gC[_i]; o1[_i] = (unsigned)_r1 * (unsigned)(lda * 2) + gC[_i]; } \
        else { o0[_i] = voffA[_i]; o1[_i] = voffA[_i]; } } } while (0)
    const size_t kstep = (size_t)(BK * 2);
    const size_t hstep = (size_t)HALF * K * 2;
    const size_t tstep = 2 * hstep;
    const size_t hstepA = g.rowlds ? 0 : (size_t)HALF * lda * 2, tstepA = 2 * hstepA;
    const unsigned ldsw = (unsigned)wid * 1024u;
    const int aoff = lds_byte(wr * 64 + fr, fq * 8), boff = lds_byte(wc * 32 + fr, fq * 8);
#define PG8_SA(b, h) (((b) * 2 + (h)) * HTB)
#define PG8_SB(b, h) ((4 + (b) * 2 + (h)) * HTB)
#define PG8_STAGE(bufoff, gbase, voff) do { _Pragma("unroll") for (int _i = 0; _i < 2; ++_i) \
        __builtin_amdgcn_global_load_lds((const unsigned*)((const char*)(gbase) + (voff)[_i]), (PG8_LAS unsigned*)(lds + (bufoff) + ldsw + _i * 8192), 16, 0, 0); } while (0)
#define PG8_LDA(dst, b, h) do { _Pragma("unroll") for (int m = 0; m < 4; ++m) _Pragma("unroll") for (int k = 0; k < 2; ++k) dst[m][k] = *(const PG8_LAS bf16x8*)(lds + PG8_SA(b, h) + aoff + m * 2048 + k * 1024); } while (0)
#define PG8_LDB(dst, b, h) do { _Pragma("unroll") for (int n = 0; n < 2; ++n) _Pragma("unroll") for (int k = 0; k < 2; ++k) dst[n][k] = *(const PG8_LAS bf16x8*)(lds + PG8_SB(b, h) + boff + n * 2048 + k * 1024); } while (0)
#define PG8_MMA(ai, bj, At, Bt) do { __builtin_amdgcn_s_setprio(1); _Pragma("unroll") for (int m = 0; m < 4; ++m) _Pragma("unroll") for (int n = 0; n < 2; ++n) _Pragma("unroll") for (int k = 0; k < 2; ++k) \
        acc[ai][bj][m][n] = __builtin_amdgcn_mfma_f32_16x16x32_bf16(Bt[n][k], At[m][k], acc[ai][bj][m][n], 0, 0, 0); __builtin_amdgcn_s_setprio(0); } while (0)
#define PG8_WAIT_V(n) asm volatile("s_waitcnt vmcnt(" #n ")" ::: "memory")
#define PG8_WAIT_L(n) asm volatile("s_waitcnt lgkmcnt(" #n ")" ::: "memory")
#define PG8_BAR __builtin_amdgcn_s_barrier()
#define PG8_SCHED __builtin_amdgcn_sched_barrier(0)
    Unit cur, nxt; int ui = 0;
    if (!S.next(0, cur)) return;
    f32x4 acc[2][2][4][2];
#pragma unroll
    for (int a = 0; a < 2; ++a)
#pragma unroll
        for (int b = 0; b < 2; ++b)
#pragma unroll
            for (int m = 0; m < 4; ++m)
#pragma unroll
                for (int n = 0; n < 2; ++n) acc[a][b][m][n] = (f32x4){0.f, 0.f, 0.f, 0.f};
    bf16x8 At[4][2], B0[2][2], B1[2][2];
    const char* cA = (const char*)g.A + (size_t)cur.pm * tstepA; const char* cB = (const char*)g.Bt + (size_t)cur.pb * tstep;
    S.a_ready(cur);
    PG8_GOFS(0, vA0, vA1);
    if constexpr (SP2) {
        PG8_STAGE(PG8_SB(0, 0), cB, voffB); PG8_STAGE(PG8_SB(0, 1), cB + hstep, voffB); PG8_STAGE(PG8_SA(0, 0), cA, vA0); PG8_STAGE(PG8_SA(0, 1), cA + hstepA, vA1);
        if (wr == 1) PG8_BAR;
        PG8_WAIT_V(2); PG8_BAR;
        PG8_STAGE(PG8_SB(1, 0), cB + kstep, voffB); PG8_STAGE(PG8_SA(1, 0), cA + kstep, vA0); PG8_STAGE(PG8_SB(1, 1), cB + hstep + kstep, voffB);
        PG8_WAIT_V(6); PG8_BAR;
    } else {
        PG8_STAGE(PG8_SB(0, 0), cB, voffB); PG8_STAGE(PG8_SA(0, 0), cA, voffA); PG8_STAGE(PG8_SB(0, 1), cB + hstep, voffB); PG8_STAGE(PG8_SA(0, 1), cA + hstepA, voffA);
        if (wr == 1) PG8_BAR;
        PG8_WAIT_V(4); PG8_BAR;
        PG8_STAGE(PG8_SB(1, 0), cB + kstep, voffB); PG8_STAGE(PG8_SA(1, 0), cA + kstep, voffA); PG8_STAGE(PG8_SB(1, 1), cB + hstep + kstep, voffB);
        PG8_WAIT_V(6); PG8_BAR;
    }
    for (;;) {
        const bool has_next = S.next(ui + 1, nxt);
        if (has_next) PG8_GOFS(ui + 1, vN0, vN1); else { vN0[0] = vA0[0]; vN0[1] = vA0[1]; vN1[0] = vA1[0]; vN1[1] = vA1[1]; }
        const char* nA = has_next ? (const char*)g.A + (size_t)nxt.pm * tstepA : cA; const char* nB = has_next ? (const char*)g.Bt + (size_t)nxt.pb * tstep : cB;
        for (int t = 0; t < nt; t += 2) {
            const bool last = (t == nt - 2);
            const char* a1 = cA + (size_t)(t + 1) * kstep;
            const char* a2 = last ? nA : cA + (size_t)(t + 2) * kstep; const char* b2 = last ? nB : cB + (size_t)(t + 2) * kstep;
            const char* a3 = a2 + kstep; const char* b3 = b2 + kstep;
            if (last && has_next) S.a_ready(nxt);
            const unsigned s0[2] = {last ? vN0[0] : vA0[0], last ? vN0[1] : vA0[1]}, s1[2] = {last ? vN1[0] : vA1[0], last ? vN1[1] : vA1[1]};
            if constexpr (SP2) {
            PG8_LDB(B0, 0, 0); PG8_LDB(B1, 0, 1); PG8_SCHED; PG8_LDA(At, 0, 0); PG8_STAGE(PG8_SA(1, 1), a1 + hstepA, vA1);
            PG8_WAIT_V(8); PG8_WAIT_L(0); PG8_BAR; PG8_MMA(0, 0, At, B0); PG8_MMA(0, 1, At, B1); PG8_BAR; PG8_SCHED;
            PG8_LDA(At, 0, 1); PG8_STAGE(PG8_SB(0, 0), b2, voffB); PG8_STAGE(PG8_SB(0, 1), b2 + hstep, voffB); PG8_STAGE(PG8_SA(0, 0), a2, s0);
            PG8_WAIT_V(8); PG8_WAIT_L(0); PG8_BAR; PG8_MMA(1, 0, At, B0); PG8_MMA(1, 1, At, B1); PG8_BAR; PG8_SCHED;
            PG8_LDB(B0, 1, 0); PG8_LDB(B1, 1, 1); PG8_SCHED; PG8_LDA(At, 1, 0); PG8_STAGE(PG8_SA(0, 1), a2 + hstepA, s1);
            PG8_WAIT_V(8); PG8_WAIT_L(0); PG8_BAR; PG8_MMA(0, 0, At, B0); PG8_MMA(0, 1, At, B1); PG8_BAR; PG8_SCHED;
            PG8_LDA(At, 1, 1); PG8_STAGE(PG8_SB(1, 0), b3, voffB); PG8_STAGE(PG8_SB(1, 1), b3 + hstep, voffB); PG8_STAGE(PG8_SA(1, 0), a3, s0);
            PG8_WAIT_V(8); PG8_WAIT_L(0); PG8_BAR; PG8_MMA(1, 0, At, B0); PG8_MMA(1, 1, At, B1); PG8_BAR; PG8_SCHED;
            } else {
            PG8_LDB(B0, 0, 0); PG8_SCHED; PG8_LDA(At, 0, 0); PG8_STAGE(PG8_SA(1, 1), a1 + hstepA, voffA);
            PG8_WAIT_L(8); PG8_BAR; PG8_WAIT_L(0); PG8_MMA(0, 0, At, B0); PG8_BAR; PG8_SCHED;
            PG8_LDB(B1, 0, 1); PG8_STAGE(PG8_SB(0, 0), b2, voffB);
            PG8_BAR; PG8_WAIT_L(0); PG8_MMA(0, 1, At, B1); PG8_BAR;
            PG8_LDA(At, 0, 1); PG8_STAGE(PG8_SA(0, 0), a2, voffA);
            PG8_BAR; PG8_WAIT_L(0); PG8_MMA(1, 0, At, B0); PG8_BAR; PG8_SCHED;
            PG8_STAGE(PG8_SB(0, 1), b2 + hstep, voffB);
            PG8_WAIT_V(6); PG8_BAR; PG8_MMA(1, 1, At, B1); PG8_BAR;
            PG8_LDB(B0, 1, 0); PG8_SCHED; PG8_LDA(At, 1, 0); PG8_STAGE(PG8_SA(0, 1), a2 + hstepA, voffA);
            PG8_WAIT_L(8); PG8_BAR; PG8_WAIT_L(0); PG8_MMA(0, 0, At, B0); PG8_BAR; PG8_SCHED;
            PG8_LDB(B1, 1, 1); PG8_STAGE(PG8_SB(1, 0), b3, voffB);
            PG8_BAR; PG8_WAIT_L(0); PG8_MMA(0, 1, At, B1); PG8_BAR;
            PG8_LDA(At, 1, 1); PG8_STAGE(PG8_SA(1, 0), a3, voffA);
            PG8_BAR; PG8_WAIT_L(0); PG8_MMA(1, 0, At, B0); PG8_BAR; PG8_SCHED;
            PG8_STAGE(PG8_SB(1, 1), b3 + hstep, voffB);
            PG8_WAIT_V(6); PG8_BAR; PG8_MMA(1, 1, At, B1); PG8_BAR;
            }
        }
        if constexpr (ALIGN_EPI) { if (wr == 0) PG8_BAR; }
        if constexpr (!Epi::AFTER_DRAIN) { E(acc, cur, wr, wc, fr, fq); S.done(cur); }
        if (!has_next) break;
#pragma unroll
        for (int a = 0; a < 2; ++a)
#pragma unroll
            for (int b = 0; b < 2; ++b)
#pragma unroll
                for (int m = 0; m < 4; ++m)
#pragma unroll
                    for (int n = 0; n < 2; ++n) acc[a][b][m][n] = (f32x4){0.f, 0.f, 0.f, 0.f};
        cur = nxt; cA = nA; cB = nB; ++ui; vA0[0] = vN0[0]; vA0[1] = vN0[1]; vA1[0] = vN1[0]; vA1[1] = vN1[1];
        if constexpr (ALIGN_EPI) { if (wr == 1) PG8_BAR; }
    }
    PG8_WAIT_V(0);
    if constexpr (!ALIGN_EPI) { if (wr == 0) PG8_BAR; }
    PG8_BAR;
    if constexpr (Epi::AFTER_DRAIN) { E.fused(acc, cur, wr, wc, fr, fq, lds, wid, lane); S.done(cur); }
#undef PG8_GOFS
#undef PG8_SA
#undef PG8_SB
#undef PG8_STAGE
#undef PG8_LDA
#undef PG8_LDB
#undef PG8_MMA
#undef PG8_WAIT_V
#undef PG8_WAIT_L
#undef PG8_BAR
#undef PG8_SCHED
}

struct EpiStoreBf16 {
    static constexpr bool PERM = true, AFTER_DRAIN = false;
    bf16_t* O; int ldc; int split_cols; size_t split_stride;
    __device__ __forceinline__ void operator()(const f32x4 (&acc)[2][2][4][2], const Unit& u, int wr, int wc, int fr, int fq) const {
        int colt = u.pn * BM; bf16_t* base = O;
        if (split_cols) { const int t = colt / split_cols; base += (size_t)t * split_stride; colt -= t * split_cols; }
        const int row0 = u.pm * BM + wr * 64 + fr, col0 = colt + wc * 32 + 8 * fq;
#pragma unroll
        for (int ai = 0; ai < 2; ++ai)
#pragma unroll
            for (int m = 0; m < 4; ++m) { bf16_t* rowp = base + (size_t)(row0 + ai * HALF + m * 16) * ldc + col0;
#pragma unroll
                for (int bj = 0; bj < 2; ++bj) { const f32x4 v0 = acc[ai][bj][m][0], v1 = acc[ai][bj][m][1];
                    u32x4 w; w.x = cvt_pk_bf16(v0[0], v0[1]); w.y = cvt_pk_bf16(v0[2], v0[3]); w.z = cvt_pk_bf16(v1[0], v1[1]); w.w = cvt_pk_bf16(v1[2], v1[3]);
                    *(u32x4*)(rowp + bj * HALF) = w; } }
    }
};
struct EpiInproj1 {
    static constexpr bool PERM = true, AFTER_DRAIN = false;
    bf16_t* O; bf16_t* UA;
    __device__ __forceinline__ void operator()(const f32x4 (&acc)[2][2][4][2], const Unit& u, int wr, int wc, int fr, int fq) const {
        const int row0 = u.pm * BM + wr * 64 + fr, col0 = u.pn * BM + wc * 32 + 8 * fq;
#pragma unroll
        for (int ai = 0; ai < 2; ++ai)
#pragma unroll
            for (int m = 0; m < 4; ++m) { const int t = row0 + ai * HALF + m * 16; bf16_t* rowp = O + (size_t)t * 2560 + col0;
#pragma unroll
                for (int bj = 0; bj < 2; ++bj) { const f32x4 v0 = acc[ai][bj][m][0], v1 = acc[ai][bj][m][1];
                    u32x4 w; w.x = cvt_pk_bf16(v0[0], v0[1]); w.y = cvt_pk_bf16(v0[2], v0[3]); w.z = cvt_pk_bf16(v1[0], v1[1]); w.w = cvt_pk_bf16(v1[2], v1[3]);
                    *(u32x4*)(rowp + bj * HALF) = w;
                    if (u.pn < 2) { const int c = col0 + bj * HALF, g = c >> 4, b = t >> 13, tt = t & 8191;
                        *(u32x4*)(UA + ((size_t)g * 512 + b * 256 + (tt >> 5)) * 640 + (tt & 31) * 16 + (c & 15)) = w; } } }
    }
};
struct EpiResidF32 {
    static constexpr bool PERM = false, AFTER_DRAIN = false;
    const float* resid; float* out; int ldc; float alpha;
    __device__ __forceinline__ void operator()(const f32x4 (&acc)[2][2][4][2], const Unit& u, int wr, int wc, int fr, int fq) const {
        const int row0 = u.pm * BM + wr * 64 + fr, col0 = u.pn * BM + wc * 32 + 4 * fq;
#pragma unroll
        for (int ai = 0; ai < 2; ++ai)
#pragma unroll
            for (int m = 0; m < 4; ++m) { const size_t off = (size_t)(row0 + ai * HALF + m * 16) * ldc + col0;
#pragma unroll
                for (int bj = 0; bj < 2; ++bj)
#pragma unroll
                    for (int n = 0; n < 2; ++n) { const size_t o = off + bj * HALF + n * 16; *(f32x4*)(out + o) = *(const f32x4*)(resid + o) * alpha + acc[ai][bj][m][n]; } }
    }
};
__device__ __forceinline__ float fast_sigm(float x) { return __builtin_amdgcn_rcpf(1.f + __expf(-x)); }
struct EpiSwiglu {
    static constexpr bool PERM = true, AFTER_DRAIN = false;
    bf16_t* HID;
    __device__ __forceinline__ void operator()(const f32x4 (&acc)[2][2][4][2], const Unit& u, int wr, int wc, int fr, int fq) const {
        const int row0 = u.pm * BM + wr * 64 + fr, h0 = u.pn * 128 + wc * 16 + 4 * fq;
#pragma unroll
        for (int ai = 0; ai < 2; ++ai)
#pragma unroll
            for (int m = 0; m < 4; ++m) { bf16_t* rowp = HID + (size_t)(row0 + ai * HALF + m * 16) * 512 + h0;
#pragma unroll
                for (int bj = 0; bj < 2; ++bj) { const f32x4 a = acc[ai][bj][m][0], b = acc[ai][bj][m][1]; f32x4 h;
#pragma unroll
                    for (int j = 0; j < 4; ++j) h[j] = a[j] * fast_sigm(a[j]) * b[j];
                    typedef unsigned u32x2v __attribute__((ext_vector_type(2)));
                    u32x2v w; w.x = cvt_pk_bf16(h[0], h[1]); w.y = cvt_pk_bf16(h[2], h[3]);
                    *(u32x2v*)(rowp + bj * 64) = w; } }
    }
};
struct EpiGlu {
    static constexpr bool PERM = true, AFTER_DRAIN = false;
    const float* ysrc; int ldy; const float* bias; bf16_t* O; int ldc;
    __device__ __forceinline__ void operator()(const f32x4 (&acc)[2][2][4][2], const Unit& u, int wr, int wc, int fr, int fq) const {
        const int row0 = u.pm * BM + wr * 64 + fr, col0 = u.pn * BM + wc * 32 + 8 * fq;
#pragma unroll
        for (int ai = 0; ai < 2; ++ai)
#pragma unroll
            for (int m = 0; m < 4; ++m) { const int row = row0 + ai * HALF + m * 16;
#pragma unroll
                for (int bj = 0; bj < 2; ++bj) { const int col = col0 + bj * HALF;
                    const f32x4 y0 = *(const f32x4*)(ysrc + (size_t)row * ldy + col), y1 = *(const f32x4*)(ysrc + (size_t)row * ldy + col + 4);
                    const f32x4 b0 = *(const f32x4*)(bias + col), b1 = *(const f32x4*)(bias + col + 4);
                    f32x4 v0 = acc[ai][bj][m][0] + b0, v1 = acc[ai][bj][m][1] + b1;
#pragma unroll
                    for (int j = 0; j < 4; ++j) { v0[j] = y0[j] * fast_sigm(v0[j]); v1[j] = y1[j] * fast_sigm(v1[j]); }
                    u32x4 w; w.x = cvt_pk_bf16(v0[0], v0[1]); w.y = cvt_pk_bf16(v0[2], v0[3]); w.z = cvt_pk_bf16(v1[0], v1[1]); w.w = cvt_pk_bf16(v1[2], v1[3]);
                    *(u32x4*)(O + (size_t)row * ldc + col) = w; } }
    }
};
template <bool RESID_BF16> struct EpiResidBf16 {
    static constexpr bool PERM = true, AFTER_DRAIN = false;
    const void* resid; bf16_t* out; int ldc; float alpha;
    __device__ __forceinline__ void operator()(const f32x4 (&acc)[2][2][4][2], const Unit& u, int wr, int wc, int fr, int fq) const {
        const int row0 = u.pm * BM + wr * 64 + fr, col0 = u.pn * BM + wc * 32 + 8 * fq;
#pragma unroll
        for (int ai = 0; ai < 2; ++ai)
#pragma unroll
            for (int m = 0; m < 4; ++m) { const size_t off = (size_t)(row0 + ai * HALF + m * 16) * ldc + col0;
#pragma unroll
                for (int bj = 0; bj < 2; ++bj) {
                    f32x4 r0, r1;
                    if (RESID_BF16) { const u32x4 rv = *(const u32x4*)((const bf16_t*)resid + off + bj * HALF);
                        r0[0] = __uint_as_float(rv.x << 16); r0[1] = __uint_as_float(rv.x & 0xffff0000u); r0[2] = __uint_as_float(rv.y << 16); r0[3] = __uint_as_float(rv.y & 0xffff0000u);
                        r1[0] = __uint_as_float(rv.z << 16); r1[1] = __uint_as_float(rv.z & 0xffff0000u); r1[2] = __uint_as_float(rv.w << 16); r1[3] = __uint_as_float(rv.w & 0xffff0000u); }
                    else { r0 = *(const f32x4*)((const float*)resid + off + bj * HALF); r1 = *(const f32x4*)((const float*)resid + off + bj * HALF + 4); }
                    const f32x4 v0 = r0 * alpha + acc[ai][bj][m][0], v1 = r1 * alpha + acc[ai][bj][m][1];
                    u32x4 w; w.x = cvt_pk_bf16(v0[0], v0[1]); w.y = cvt_pk_bf16(v0[2], v0[3]); w.z = cvt_pk_bf16(v1[0], v1[1]); w.w = cvt_pk_bf16(v1[2], v1[3]);
                    *(u32x4*)(out + off + bj * HALF) = w; } }
    }
};
struct EpiStoreF32 {
    static constexpr bool PERM = false, AFTER_DRAIN = false;
    float* out; int ldc;
    __device__ __forceinline__ void operator()(const f32x4 (&acc)[2][2][4][2], const Unit& u, int wr, int wc, int fr, int fq) const {
        const int row0 = u.pm * BM + wr * 64 + fr, col0 = u.pn * BM + wc * 32 + 4 * fq;
#pragma unroll
        for (int ai = 0; ai < 2; ++ai)
#pragma unroll
            for (int m = 0; m < 4; ++m) { const size_t off = (size_t)(row0 + ai * HALF + m * 16) * ldc + col0;
#pragma unroll
                for (int bj = 0; bj < 2; ++bj)
#pragma unroll
                    for (int n = 0; n < 2; ++n) *(f32x4*)(out + off + bj * HALF + n * 16) = acc[ai][bj][m][n]; }
    }
};
struct EpiStoreF32Half {
    static constexpr bool PERM = false, AFTER_DRAIN = false;
    float* out;
    __device__ __forceinline__ void operator()(const f32x4 (&acc)[2][2][4][2], const Unit& u, int wr, int wc, int fr, int fq) const {
        const int row0 = u.pm * BM + wr * 64 + fr, col0 = wc * 32 + 4 * fq;
#pragma unroll
        for (int ai = 0; ai < 2; ++ai)
#pragma unroll
            for (int m = 0; m < 4; ++m) { const size_t off = (size_t)(row0 + ai * HALF + m * 16) * 128 + col0;
#pragma unroll
                for (int n = 0; n < 2; ++n) *(f32x4*)(out + off + n * 16) = acc[ai][0][m][n]; }
    }
};
struct EpiS5Y {
    static constexpr bool PERM = false, AFTER_DRAIN = false;
    const bf16_t* P1; const float* dvec; float* YS5; bf16_t* YS5B;
    __device__ __forceinline__ void operator()(const f32x4 (&acc)[2][2][4][2], const Unit& u, int wr, int wc, int fr, int fq) const {
        const int g = u.pm >> 1, ch = g * 16 + 4 * fq;
        const f32x4 dd = *(const f32x4*)(dvec + ch);
#pragma unroll
        for (int ai = 0; ai < 2; ++ai)
#pragma unroll
            for (int m = 0; m < 4; ++m) {
                const int bc = (u.pm & 1) * 256 + ai * HALF + wr * 64 + m * 16 + fr, b = bc >> 8, c32 = bc & 255;
#pragma unroll
                for (int bj = 0; bj < 2; ++bj)
#pragma unroll
                    for (int n = 0; n < 2; ++n) {
                        const int i = 16 * u.pn + 8 * bj + 2 * wc + n;
                        const size_t t = (size_t)b * 8192 + c32 * 32 + i;
                        typedef unsigned u32x2v __attribute__((ext_vector_type(2)));
                        const u32x2v uu = *(const u32x2v*)(P1 + t * 2560 + ch);
                        f32x4 uv; uv[0] = __uint_as_float(uu.x << 16); uv[1] = __uint_as_float(uu.x & 0xffff0000u); uv[2] = __uint_as_float(uu.y << 16); uv[3] = __uint_as_float(uu.y & 0xffff0000u);
                        f32x4 y = acc[ai][bj][m][n] + dd * uv;
#pragma unroll
                        for (int j = 0; j < 4; ++j) { const float x = y[j]; const float tt = 0.7978845608028654f * (x + 0.044715f * x * x * x); y[j] = 0.5f * x * (1.f + tanhf(tt)); }
                        *(f32x4*)(YS5 + t * 512 + ch) = y;
                        u32x2v w; w.x = cvt_pk_bf16(y[0], y[1]); w.y = cvt_pk_bf16(y[2], y[3]);
                        *(u32x2v*)(YS5B + t * 512 + ch) = w;
                    }
            }
    }
};
struct MoeOrder {
    int ntiles, nN, G, c; const PG8_LAS int* tile_e;
    __device__ __forceinline__ bool next(int i, Unit& u) const {
        const int L = i * G + c; if (L >= ntiles * nN) return false;
        u.pm = L / nN; u.pn = L % nN; u.pb = tile_e[u.pm] * nN + u.pn; return true;
    }
    __device__ __forceinline__ void a_ready(const Unit&) const {}
    __device__ __forceinline__ void done(const Unit&) const {}
};
}

#define XB_TMO      128
#define XB_XCNT(j)  (256  + 64 * (j))
#define XB_XSUB(j)  (1280 + 64 * (j))
#define XB_XGEN(j)  (2304 + 64 * (j))
#define XB_TOP      3328
#define XB_TOPGEN   3392
#define XCD_BAR_WORDS 3456
#define XB_SPIN_CAP (1u << 18)
__device__ __forceinline__ unsigned xb_ld(unsigned* p)              { return __hip_atomic_load(p, __ATOMIC_RELAXED, __HIP_MEMORY_SCOPE_AGENT); }
__device__ __forceinline__ unsigned xb_add(unsigned* p, unsigned v) { return __hip_atomic_fetch_add(p, v, __ATOMIC_RELAXED, __HIP_MEMORY_SCOPE_AGENT); }
__device__ __forceinline__ unsigned xb_xcc_id() { return (unsigned)__builtin_amdgcn_s_getreg((3 << 11) | 20) & 0xFu; }
#define XB_SPIN(cond, bar) do { unsigned _sp = 0; while (cond) { __builtin_amdgcn_s_sleep(1); \
    if ((++_sp & 255u) == 0u) { if (xb_ld(&(bar)[XB_TMO])) break; if (_sp > XB_SPIN_CAP) { atomicAdd(&(bar)[XB_TMO], 1u); break; } } } } while (0)
struct XcdBarrier { unsigned* bar; unsigned x; volatile LAS unsigned* st; };
__device__ __forceinline__ XcdBarrier xcd_barrier_post(unsigned* bar, volatile LAS unsigned* st) {
    XcdBarrier b; b.bar = bar; b.x = xb_xcc_id(); b.st = st;
    if (TIDX == 0) (void)xb_add(&bar[XB_XCNT(b.x)], 1u);
    return b;
}
__device__ __forceinline__ void xcd_barrier_complete(unsigned* bar, unsigned x, unsigned& nloc, unsigned& nx) {
    const unsigned G = gridDim.x;
    unsigned sum, cnt, mine, sp = 0u;
    for (;;) {
        sum = 0u; cnt = 0u; mine = 0u;
#pragma unroll
        for (unsigned j = 0; j < 16; ++j) { const unsigned c = xb_ld(&bar[XB_XCNT(j)]); sum += c; cnt += (c > 0u) ? 1u : 0u; mine = (j == x) ? c : mine; }
        if (sum == G) break;
        __builtin_amdgcn_s_sleep(1);
        if ((++sp & 255u) == 0u) { if (xb_ld(&bar[XB_TMO])) break; if (sp > XB_SPIN_CAP) { atomicAdd(&bar[XB_TMO], 1u); break; } }
    }
    nloc = mine > 0u ? mine : 1u; nx = cnt > 0u ? cnt : 1u;
}
__device__ __forceinline__ void xcd_barrier(const XcdBarrier& b) {
    asm volatile("s_waitcnt vmcnt(0)" ::: "memory");
    __syncthreads();
    if (TIDX == 0) {
        unsigned* bar = b.bar;
        __builtin_amdgcn_s_waitcnt(0);
        unsigned nloc = b.st[0], nx = b.st[1];
        if (nloc == 0u) { xcd_barrier_complete(bar, b.x, nloc, nx); b.st[0] = nloc; b.st[1] = nx; }
        const unsigned old = xb_add(&bar[XB_XSUB(b.x)], 1u);
        const unsigned gen = old / nloc;
        if (old + 1u == (gen + 1u) * nloc) {
            __builtin_amdgcn_fence(__ATOMIC_RELEASE, "agent");
            asm volatile("s_waitcnt vmcnt(0)" ::: "memory");
            const unsigned og = xb_add(&bar[XB_TOP], 1u);
            const unsigned tg = og / nx;
            if (og + 1u == (tg + 1u) * nx) xb_add(&bar[XB_TOPGEN], 1u);
            else XB_SPIN(xb_ld(&bar[XB_TOPGEN]) == tg, bar);
            __builtin_amdgcn_fence(__ATOMIC_ACQUIRE, "agent");
            xb_add(&bar[XB_XGEN(b.x)], 1u);
            asm volatile("s_waitcnt vmcnt(0)" ::: "memory");
        } else {
            XB_SPIN(xb_ld(&bar[XB_XGEN(b.x)]) == gen, bar);
            __builtin_amdgcn_fence(__ATOMIC_ACQUIRE, "agent");
            asm volatile("s_waitcnt vmcnt(0)" ::: "memory");
        }
    }
    __syncthreads();
}


typedef short bf16x8 __attribute__((ext_vector_type(8)));
__device__ __forceinline__ void unpack8f(const u32x4 v, float* f) {
    f[0] = __uint_as_float(v.x << 16); f[1] = __uint_as_float(v.x & 0xffff0000u); f[2] = __uint_as_float(v.y << 16); f[3] = __uint_as_float(v.y & 0xffff0000u);
    f[4] = __uint_as_float(v.z << 16); f[5] = __uint_as_float(v.z & 0xffff0000u); f[6] = __uint_as_float(v.w << 16); f[7] = __uint_as_float(v.w & 0xffff0000u);
}
__device__ __forceinline__ u32x4 pack8f(const float* f) { u32x4 o; o.x = pk2(f[0], f[1]); o.y = pk2(f[2], f[3]); o.z = pk2(f[4], f[5]); o.w = pk2(f[6], f[7]); return o; }
__device__ __forceinline__ void ld8bf(const bf16_t* p, float* f) { unpack8f(*(const u32x4*)p, f); }
__device__ __forceinline__ void ld8f(const float* p, float* f) { const f32x4 a = *(const f32x4*)p, b = *(const f32x4*)(p + 4); f[0] = a.x; f[1] = a.y; f[2] = a.z; f[3] = a.w; f[4] = b.x; f[5] = b.y; f[6] = b.z; f[7] = b.w; }
struct GlaBufs { bf16_t* QT; bf16_t* KT; bf16_t* KDT; bf16_t* VT; float* DG; void* DS; bf16_t* SP; };
__device__ __forceinline__ float logsigf(float x) { return fminf(x, 0.f) - log1pf(__expf(-fabsf(x))); }

template <int K, int LAYER>
__device__ __forceinline__ void gla_prep_tile(LAS float* lds, const bf16_t* P, const float* aux0, const float* aux1, const GlaBufs& B, int cg) {
    constexpr int HK = 4 * K, KP = K + 1;
    LAS float* G = lds;
    LAS float* KR = lds + 64 * KP;
    LAS float* LV = lds + 2 * 64 * KP;
    const int tid = TIDX, lane = tid & 63, wave = tid >> 6;
    const int t0 = cg * 64;
    LAS float* GL = lds + 2 * 64 * KP + 64 * 129;
    LAS float* GA = GL + 64 * 16;
    if (LAYER == 0) {
        for (int idx = tid; idx < 64 * 16; idx += NTHREADS) GL[idx] = bf2f(P[(size_t)(t0 + (idx >> 4)) * NIN0P + 2816 + (idx & 15)]);
        __syncthreads();
        const int ck = tid & 255, th = tid >> 8;
        float w2r[16];
#pragma unroll
        for (int i = 0; i < 16; ++i) w2r[i] = aux0[i * 256 + ck];
        const float gb = aux1[ck];
        for (int t = th * 32; t < th * 32 + 32; ++t) {
            float gk = gb;
#pragma unroll
            for (int i4 = 0; i4 < 4; ++i4) { const f32x4 x = *(const LAS f32x4*)(GL + t * 16 + 4 * i4); gk += x.x * w2r[4 * i4] + x.y * w2r[4 * i4 + 1] + x.z * w2r[4 * i4 + 2] + x.w * w2r[4 * i4 + 3]; }
            GA[t * 257 + ck] = logsigf(gk) * (1.f / 16.f);
        }
        __syncthreads();
    }
    constexpr int NCH = 64 * K / 8 / NTHREADS;
    for (int h = 0; h < 4; ++h) {
        float qv[NCH][8];
#pragma unroll
        for (int it = 0; it < NCH; ++it) {
            const int ch = tid + it * NTHREADS, t = ch / (K / 8), c8 = (ch % (K / 8)) * 8, ck = h * K + c8;
            float kr[8], g[8];
            if (LAYER == 0) {
                ld8bf(P + (size_t)(t0 + t) * NIN0P + 2048 + ck, kr);
                ld8bf(P + (size_t)(t0 + t) * NIN0P + 1792 + ck, qv[it]);
#pragma unroll
                for (int j = 0; j < 8; ++j) { g[j] = GA[t * 257 + ck + j]; qv[it][j] *= 0.125f; }
            } else {
                float f[8], l0[8], l1[8];
                ld8bf(P + (size_t)(t0 + t) * NIN1 + 1024 + ck, f);
                ld8bf(P + (size_t)(t0 + t) * NIN1 + 512 + ck, qv[it]);
                ld8f(aux0 + ck, l0); ld8f(aux0 + 512 + ck, l1);
#pragma unroll
                for (int j = 0; j < 8; ++j) {
                    const float lbv = 1.f / (1.f + __expf(l0[j] - l1[j]));
                    const float sg = sigm(f[j]);
                    g[j] = __logf(lbv + (1.f - lbv) * sg); kr[j] = (1.f - lbv) * (1.f - sg); qv[it][j] = siluf(qv[it][j]);
                }
            }
#pragma unroll
            for (int j = 0; j < 8; ++j) { G[t * KP + c8 + j] = g[j]; KR[t * KP + c8 + j] = kr[j]; }
        }
#pragma unroll
        for (int it = 0; it < 2; ++it) {
            const int ch = tid + it * NTHREADS, t = ch >> 4, v8 = (ch & 15) * 8;
            float vv[8];
            ld8bf(LAYER == 0 ? P + (size_t)(t0 + t) * NIN0P + 2304 + h * 128 + v8 : P + (size_t)(t0 + t) * NIN1 + 1536 + h * 128 + v8, vv);
#pragma unroll
            for (int j = 0; j < 8; ++j) LV[t * 129 + v8 + j] = vv[j];
        }
        __syncthreads();
        for (int k = wave; k < K; k += NWAVES) {
            float v = G[lane * KP + k];
#pragma unroll
            for (int o = 1; o < 64; o <<= 1) { const float n = __shfl_up(v, o); if (lane >= o) v += n; }
            G[lane * KP + k] = v;
        }
        __syncthreads();
#pragma unroll
        for (int it = 0; it < NCH; ++it) {
            const int ch = tid + it * NTHREADS, t = ch / (K / 8), c8 = (ch % (K / 8)) * 8, ck = h * K + c8;
            float qo[8], ko[8];
#pragma unroll
            for (int j = 0; j < 8; ++j) { const float b = G[t * KP + c8 + j]; qo[j] = qv[it][j] * __expf(b); ko[j] = KR[t * KP + c8 + j] * __expf(-b); }
            *(u32x4*)(B.QT + (size_t)(t0 + t) * HK + ck) = pack8f(qo);
            *(u32x4*)(B.KT + (size_t)(t0 + t) * HK + ck) = pack8f(ko);
        }
#pragma unroll
        for (int it = 0; it < NCH; ++it) {
            const int id = tid + it * NTHREADS, t8 = (id & 7) * 8, k = id >> 3;
            const float bl = G[63 * KP + k];
            float o[8];
#pragma unroll
            for (int j = 0; j < 8; ++j) o[j] = KR[(t8 + j) * KP + k] * __expf(bl - G[(t8 + j) * KP + k]);
            *(u32x4*)(B.KDT + ((size_t)cg * HK + h * K + k) * 64 + t8) = pack8f(o);
            if (t8 == 0) B.DG[(size_t)cg * HK + h * K + k] = __expf(bl);
        }
#pragma unroll
        for (int it = 0; it < 2; ++it) {
            const int id = tid + it * NTHREADS, t8 = (id & 7) * 8, vc = id >> 3;
            float o[8];
#pragma unroll
            for (int j = 0; j < 8; ++j) o[j] = LV[(t8 + j) * 129 + vc];
            *(u32x4*)(B.VT + ((size_t)cg * 512 + h * 128 + vc) * 64 + t8) = pack8f(o);
        }
        __syncthreads();
    }
}

template <int K, bool DSBF>
__device__ __forceinline__ void gla_pass1_unit(const GlaBufs& B, int unit, int lane) {
    constexpr int HK = 4 * K, KT16 = K / 16;
    const int item = unit / KT16, kt = unit % KT16, cg = item >> 2, h = item & 3;
    const int r = lane & 15, q = lane >> 4;
    const bf16_t* ap = B.KDT + ((size_t)cg * HK + h * K + kt * 16 + r) * 64 + 8 * q;
    const bf16x8 a0 = *(const bf16x8*)ap, a1 = *(const bf16x8*)(ap + 32);
    const size_t dso = ((size_t)item * 128 + r) * K + kt * 16 + 4 * q;
#pragma unroll
    for (int vt = 0; vt < 8; ++vt) {
        const bf16_t* bp = B.VT + ((size_t)cg * 512 + h * 128 + vt * 16 + r) * 64 + 8 * q;
        const bf16x8 b0 = *(const bf16x8*)bp, b1 = *(const bf16x8*)(bp + 32);
        f32x4 acc = {0.f, 0.f, 0.f, 0.f};
        acc = __builtin_amdgcn_mfma_f32_16x16x32_bf16(a0, b0, acc, 0, 0, 0);
        acc = __builtin_amdgcn_mfma_f32_16x16x32_bf16(a1, b1, acc, 0, 0, 0);
        if (DSBF) { u32x2 w; w.x = pk2(acc[0], acc[1]); w.y = pk2(acc[2], acc[3]); *(u32x2*)((bf16_t*)B.DS + dso + (size_t)vt * 16 * K) = w; }
        else *(f32x4*)((float*)B.DS + dso + (size_t)vt * 16 * K) = acc;
    }
}

template <int K, bool DSBF>
__device__ __forceinline__ void gla_pass2(const GlaBufs& B, int gthread, int gthreads) {
    constexpr int HK = 4 * K, NE = 8 * 128 * K;
    const float* __restrict__ DSf = (const float*)B.DS; const bf16_t* __restrict__ DSb = (const bf16_t*)B.DS; const float* __restrict__ DG = B.DG; bf16_t* __restrict__ SP = B.SP;
    for (int e0 = gthread; e0 < NE / 2; e0 += gthreads) {
        const int k = e0 % K, v = (e0 / K) & 127, bh = e0 / (K * 128), h = bh & 3;
        float S0 = 0.f, S1 = 0.f;
#pragma unroll 16
        for (int c = 0; c < 128; ++c) {
            const size_t i0 = ((size_t)(c * 4 + h) * 128 + v) * K + k, i1 = ((size_t)((128 + c) * 4 + h) * 128 + v) * K + k;
            const float d0 = DG[(size_t)c * HK + h * K + k], d1 = DG[(size_t)(128 + c) * HK + h * K + k];
            const float x0 = DSBF ? bf2f(DSb[i0]) : DSf[i0], x1 = DSBF ? bf2f(DSb[i1]) : DSf[i1];
            SP[i0] = f2bf(S0); SP[i1] = f2bf(S1);
            S0 = d0 * S0 + x0; S1 = d1 * S1 + x1;
        }
    }
}

template <int K, int LAYER>
__device__ __forceinline__ void gla_pass3_item(LAS unsigned char* lds, const bf16_t* P, const float* norm_g, const GlaBufs& B, bf16_t* Ymix, int item) {
    constexpr int HK = 4 * K, KS = K / 32;
    LAS bf16_t* Ls = (LAS bf16_t*)lds;
    LAS float* Lo = (LAS float*)(lds + 64 * 72 * 2);
    const int tid = TIDX, lane = tid & 63, wave = tid >> 6, r = lane & 15, q = lane >> 4;
    const int cg = item >> 2, h = item & 3, t0 = cg * 64;
    const int it = wave >> 1, i0 = it * 16;
    bf16x8 qf[KS], kf[2][KS], spf[4][KS], vf[4][2];
#pragma unroll
    for (int s = 0; s < KS; ++s) qf[s] = *(const bf16x8*)(B.QT + (size_t)(t0 + i0 + r) * HK + h * K + 32 * s + 8 * q);
#pragma unroll
    for (int jj2 = 0; jj2 < 2; ++jj2) { const int j0 = ((wave & 1) * 2 + jj2) * 16;
#pragma unroll
        for (int s = 0; s < KS; ++s) kf[jj2][s] = *(const bf16x8*)(B.KT + (size_t)(t0 + j0 + r) * HK + h * K + 32 * s + 8 * q); }
#pragma unroll
    for (int vv = 0; vv < 4; ++vv) { const int v0 = ((wave & 1) * 4 + vv) * 16;
#pragma unroll
        for (int s = 0; s < KS; ++s) spf[vv][s] = *(const bf16x8*)(B.SP + ((size_t)item * 128 + v0 + r) * K + 32 * s + 8 * q);
        const bf16_t* vp = B.VT + ((size_t)cg * 512 + h * 128 + v0 + r) * 64 + 8 * q;
        vf[vv][0] = *(const bf16x8*)vp; vf[vv][1] = *(const bf16x8*)(vp + 32); }
#pragma unroll
    for (int jj2 = 0; jj2 < 2; ++jj2) {
        const int j0 = ((wave & 1) * 2 + jj2) * 16;
        f32x4 acc = {0.f, 0.f, 0.f, 0.f};
        if (j0 <= i0) {
#pragma unroll
            for (int s = 0; s < KS; ++s) acc = __builtin_amdgcn_mfma_f32_16x16x32_bf16(kf[jj2][s], qf[s], acc, 0, 0, 0);
        }
        const int i = i0 + r;
        u32x2 w;
        w.x = pk2((j0 + 4 * q + 0) <= i ? acc[0] : 0.f, (j0 + 4 * q + 1) <= i ? acc[1] : 0.f);
        w.y = pk2((j0 + 4 * q + 2) <= i ? acc[2] : 0.f, (j0 + 4 * q + 3) <= i ? acc[3] : 0.f);
        *(LAS u32x2*)(Ls + i * 72 + j0 + 4 * q) = w;
    }
    __syncthreads();
    const bf16x8 sf0 = *(const LAS bf16x8*)(Ls + (i0 + r) * 72 + 8 * q), sf1 = *(const LAS bf16x8*)(Ls + (i0 + r) * 72 + 32 + 8 * q);
#pragma unroll
    for (int vv = 0; vv < 4; ++vv) {
        const int v0 = ((wave & 1) * 4 + vv) * 16;
        f32x4 acc = {0.f, 0.f, 0.f, 0.f};
#pragma unroll
        for (int s = 0; s < KS; ++s) acc = __builtin_amdgcn_mfma_f32_16x16x32_bf16(spf[vv][s], qf[s], acc, 0, 0, 0);
        acc = __builtin_amdgcn_mfma_f32_16x16x32_bf16(vf[vv][0], sf0, acc, 0, 0, 0);
        acc = __builtin_amdgcn_mfma_f32_16x16x32_bf16(vf[vv][1], sf1, acc, 0, 0, 0);
        *(LAS f32x4*)(Lo + (i0 + r) * 132 + v0 + 4 * q) = acc;
    }
    __syncthreads();
#pragma unroll 2
    for (int rr = 0; rr < 8; ++rr) {
        const int i = wave * 8 + rr, t = t0 + i;
        const float o0 = Lo[i * 132 + lane], o1 = Lo[i * 132 + 64 + lane];
        const float ms = wave_sum(o0 * o0 + o1 * o1) * (1.f / 128.f);
        const float rs = rsqrtf(ms + LN_EPS);
        float g0, g1;
        if (LAYER == 0) { g0 = bf2f(P[(size_t)t * NIN0P + 2832 + h * 128 + lane]); g1 = bf2f(P[(size_t)t * NIN0P + 2832 + h * 128 + 64 + lane]); }
        else { g0 = bf2f(P[(size_t)t * NIN1 + 2048 + h * 128 + lane]); g1 = bf2f(P[(size_t)t * NIN1 + 2048 + h * 128 + 64 + lane]); }
        Ymix[(size_t)t * D_ + 512 + h * 128 + lane] = f2bf(o0 * rs * norm_g[lane] * siluf(g0));
        Ymix[(size_t)t * D_ + 512 + h * 128 + 64 + lane] = f2bf(o1 * rs * norm_g[64 + lane] * siluf(g1));
    }
    __syncthreads();
}


template <int CTRL> __device__ __forceinline__ float dppf(float x) { return __builtin_bit_cast(float, __builtin_amdgcn_mov_dpp(__builtin_bit_cast(int, x), CTRL, 0xf, 0xf, true)); }
__device__ __forceinline__ float reduce32(float x) {
    x += dppf<0xB1>(x);
    x += dppf<0x4E>(x);
    x += dppf<0x141>(x);
    x += dppf<0x140>(x);
    auto sw = __builtin_amdgcn_permlane16_swap(__float_as_uint(x), __float_as_uint(x), false, false);
    return __uint_as_float(sw[0]) + __uint_as_float(sw[1]);
}
__device__ __forceinline__ void rwkv_scan_v1(LAS float* lds, const bf16_t* SC, float* YRW, int unit) {
    constexpr int TS = 32, TILE = 5 * TS * 64 + TS * 16;
    const int bh = unit >> 3, qr = unit & 7, b = bh >> 3, h = bh & 7;
    const int tid = TIDX, lane = tid & 63, wave = tid >> 6, cp = lane & 31, rl = (wave & 3) * 2 + (lane >> 5);
    const size_t S1 = (size_t)T_ * 512;
    const int chunk = tid & 255, ls = chunk >> 3, lc0 = (chunk & 7) * 8, half = tid >> 8;
    const bf16_t* g0 = SC + (half == 0 ? 0 : 4 * S1) + (size_t)(b * L_ + ls) * 512 + h * 64 + lc0;
    const bf16_t* g1 = SC + (half == 0 ? 1 * S1 : 5 * S1) + (size_t)(b * L_ + ls) * 512 + h * 64 + lc0;
    const bf16_t* g2 = (half == 0) ? SC + 2 * S1 + (size_t)(b * L_ + ls) * 512 + h * 64 + lc0
                                   : SC + 3 * S1 + (size_t)(b * L_ + ls) * 512 + h * 64 + qr * 8;
    u32x4 p0, p1, p2;
    p0 = *(const u32x4*)g0; p1 = *(const u32x4*)g1; p2 = *(const u32x4*)g2;
    float S0 = 0.f, S1v = 0.f;
    auto unpack8 = [](const u32x4 v, float* f) {
        f[0] = __uint_as_float(v.x << 16); f[1] = __uint_as_float(v.x & 0xffff0000u); f[2] = __uint_as_float(v.y << 16); f[3] = __uint_as_float(v.y & 0xffff0000u);
        f[4] = __uint_as_float(v.z << 16); f[5] = __uint_as_float(v.z & 0xffff0000u); f[6] = __uint_as_float(v.w << 16); f[7] = __uint_as_float(v.w & 0xffff0000u); };
    auto stage = [&](LAS float* buf) {
        float f0[8], f1[8], f2[8];
        unpack8(p0, f0); unpack8(p1, f1); unpack8(p2, f2);
        if (half == 0) {
#pragma unroll
            for (int j = 0; j < 8; ++j) { buf[(4 * TS + ls) * 64 + lc0 + j] = f0[j]; buf[(1 * TS + ls) * 64 + lc0 + j] = __expf(f1[j]); buf[(3 * TS + ls) * 64 + lc0 + j] = f2[j]; }
        } else {
#pragma unroll
            for (int j = 0; j < 8; ++j) { buf[(0 * TS + ls) * 64 + lc0 + j] = -f0[j]; buf[(2 * TS + ls) * 64 + lc0 + j] = f0[j] * f1[j]; }
            if ((chunk & 7) == 0) {
#pragma unroll
                for (int j = 0; j < 8; ++j) buf[5 * TS * 64 + ls * 16 + j] = f2[j];
            }
        }
    };
    stage(lds);
    __syncthreads();
    for (int t0 = 0; t0 < L_; t0 += TS) {
        LAS float* cur = lds + ((t0 / TS) & 1) * TILE;
        LAS float* nxt = lds + (((t0 / TS) & 1) ^ 1) * TILE;
        const bool more = (t0 + TS) < L_;
        if (more) { const size_t adv = (size_t)(t0 + TS) * 512; p0 = *(const u32x4*)(g0 + adv); p1 = *(const u32x4*)(g1 + adv); p2 = *(const u32x4*)(g2 + adv); }
        float* yout = YRW + (size_t)(b * L_ + t0) * 512 + h * 64 + qr * 8 + rl;
        if (wave < 4) {
        typedef float f32x2v __attribute__((ext_vector_type(2)));
        f32x2v a2 = *(const LAS f32x2v*)(cur + (0 * TS) * 64 + 2 * cp), w2 = *(const LAS f32x2v*)(cur + (1 * TS) * 64 + 2 * cp), b2 = *(const LAS f32x2v*)(cur + (2 * TS) * 64 + 2 * cp),
               k2 = *(const LAS f32x2v*)(cur + (3 * TS) * 64 + 2 * cp), r2 = *(const LAS f32x2v*)(cur + (4 * TS) * 64 + 2 * cp);
        float vv = cur[5 * TS * 64 + rl];
        float ysel = 0.f;
#pragma unroll
        for (int s = 0; s < TS; ++s) {
            const int sn = (s + 1) & (TS - 1);
            const f32x2v a2n = *(const LAS f32x2v*)(cur + (0 * TS + sn) * 64 + 2 * cp), w2n = *(const LAS f32x2v*)(cur + (1 * TS + sn) * 64 + 2 * cp),
                         b2n = *(const LAS f32x2v*)(cur + (2 * TS + sn) * 64 + 2 * cp), k2n = *(const LAS f32x2v*)(cur + (3 * TS + sn) * 64 + 2 * cp),
                         r2n = *(const LAS f32x2v*)(cur + (4 * TS + sn) * 64 + 2 * cp);
            const float vvn = cur[5 * TS * 64 + sn * 16 + rl];
            const float sa = reduce32(S0 * a2.x + S1v * a2.y);
            S0 = S0 * w2.x + (sa * b2.x + vv * k2.x);
            S1v = S1v * w2.y + (sa * b2.y + vv * k2.y);
            const float y = reduce32(S0 * r2.x + S1v * r2.y);
            ysel = (cp == s) ? y : ysel;
            a2 = a2n; w2 = w2n; b2 = b2n; k2 = k2n; r2 = r2n; vv = vvn;
        }
        yout[(size_t)cp * 512] = ysel;
        }
        if (more) stage(nxt);
        __syncthreads();
    }
}


__device__ __forceinline__ bf16x8 ldfrag(const LAS bf16_t* tile, int row0, int ks, int r, int q) { return *(const LAS bf16x8*)(tile + (row0 + r) * 72 + 32 * ks + 8 * q); }
__device__ __forceinline__ f32x4 mm64(f32x4 acc, const LAS bf16_t* A, int arow0, const LAS bf16_t* B, int brow0, int r, int q) {
    acc = __builtin_amdgcn_mfma_f32_16x16x32_bf16(ldfrag(A, arow0, 0, r, q), ldfrag(B, brow0, 0, r, q), acc, 0, 0, 0);
    acc = __builtin_amdgcn_mfma_f32_16x16x32_bf16(ldfrag(A, arow0, 1, r, q), ldfrag(B, brow0, 1, r, q), acc, 0, 0, 0);
    return acc;
}
__device__ __forceinline__ void rwkv_raw_load(const bf16_t* SC, int item, int tid, u32x4* raw) {
    const int bh = item >> 7, chn = item & 127, b = bh >> 3, h = bh & 7, t = tid >> 3, c0 = (tid & 7) * 8;
    const size_t S1 = (size_t)T_ * 512, o = (size_t)(b * L_ + chn * 64 + t) * 512 + h * 64 + c0;
#pragma unroll
    for (int a = 0; a < 6; ++a) raw[a] = *(const u32x4*)(SC + a * S1 + o);
}
__device__ __forceinline__ void rwkv_chunk_pre(LAS unsigned char* lds, const bf16_t* SC, bf16_t* Gout, bf16_t* Rmout, float* HTout, bf16_t* Ymout, int item, const u32x4* raw, int next_item, u32x4* nraw) {
    const int bh = item >> 7, chn = item & 127, b = bh >> 3, h = bh & 7;
    (void)b; (void)h; (void)chn; (void)SC;
    LAS bf16_t* TL = (LAS bf16_t*)lds;
#define RTILE(k) (TL + (k) * 4608)
    LAS float* F = (LAS float*)(lds + 12 * 9216);
    LAS float* LL = F + 64 * 68;
    LAS bf16_t* A21b = (LAS bf16_t*)(LL + 64);
    LAS bf16_t* TT11 = A21b + 32 * 40;
    LAS bf16_t* M1T = TT11 + 32 * 40;
    const int tid = TIDX, lane = tid & 63, wave = tid >> 6, r = lane & 15, q = lane >> 4;
    const int t = tid >> 3, c0 = (tid & 7) * 8;
    float ldv[8];
    { const u32x4 v = raw[1]; unpack8f(v, ldv);
#pragma unroll
      for (int j = 0; j < 8; ++j) F[t * 68 + c0 + j] = ldv[j]; }
    __syncthreads();
#pragma unroll
    for (int cc = 0; cc < 8; ++cc) {
        const int c = wave * 8 + cc;
        float v = F[lane * 68 + c];
#pragma unroll
        for (int o = 1; o < 64; o <<= 1) { const float n = __shfl_up(v, o); if (lane >= o) v += n; }
        F[lane * 68 + c] = v;
    }
    __syncthreads();
#ifdef PROBE_A_S0
    for (int rep_ = 0; rep_ < 2; ++rep_)
#endif
    {
        float rr[8], kp[8], vv[8], kk[8], aa[8];
        unpack8f(raw[0], rr); unpack8f(raw[2], kp); unpack8f(raw[3], vv); unpack8f(raw[4], kk); unpack8f(raw[5], aa);
        float at[8], rt[8], bt[8], kt[8];
#pragma unroll
        for (int j = 0; j < 8; ++j) {
            const float cs = F[t * 68 + c0 + j], last = __expf(F[63 * 68 + c0 + j]);
            const float Lt = __expf(cs), Ltm1 = __expf(cs - ldv[j]), inv = __expf(-cs);
            at[j] = -kk[j] * Ltm1; rt[j] = rr[j] * Lt; bt[j] = kk[j] * aa[j] * inv; kt[j] = kp[j] * inv;
            RTILE(4)[(c0 + j) * 72 + t] = f2bf(at[j]);
            RTILE(5)[(c0 + j) * 72 + t] = f2bf(bt[j] * last);
            RTILE(6)[(c0 + j) * 72 + t] = f2bf(kt[j] * last);
            RTILE(7)[(c0 + j) * 72 + t] = f2bf(vv[j]);
            if (t == 63) LL[c0 + j] = last;
        }
        *(LAS u32x4*)(RTILE(0) + t * 72 + c0) = pack8f(at);
        *(LAS u32x4*)(RTILE(1) + t * 72 + c0) = pack8f(bt);
        *(LAS u32x4*)(RTILE(2) + t * 72 + c0) = pack8f(kt);
        *(LAS u32x4*)(RTILE(3) + t * 72 + c0) = pack8f(rt);
    }
    __syncthreads();
    {
        const int mtx = wave >> 1;
        const LAS bf16_t* X = (mtx < 2) ? RTILE(0) : RTILE(3);
        const LAS bf16_t* Y = (mtx & 1) ? RTILE(2) : RTILE(1);
#pragma unroll
        for (int k8 = 0; k8 < 8; ++k8) {
            const int idx = (wave & 1) * 8 + k8, ti = idx >> 2, si = idx & 3;
            f32x4 acc = {0.f, 0.f, 0.f, 0.f};
            if (si <= ti) acc = mm64(acc, Y, si * 16, X, ti * 16, r, q);
            const int tt = ti * 16 + r, s0 = si * 16 + 4 * q;
#pragma unroll
            for (int jj = 0; jj < 4; ++jj) { const bool keep = (mtx < 2) ? (s0 + jj < tt) : (s0 + jj <= tt); acc[jj] = keep ? acc[jj] : 0.f; }
            if (mtx == 0) { *(LAS f32x4*)(F + tt * 68 + s0) = acc;
                if (ti >= 2 && si < 2) { u32x2 w; w.x = pk2(acc[0], acc[1]); w.y = pk2(acc[2], acc[3]); *(LAS u32x2*)(A21b + (tt - 32) * 40 + s0) = w; } }
            else { u32x2 w; w.x = pk2(acc[0], acc[1]); w.y = pk2(acc[2], acc[3]); *(LAS u32x2*)(RTILE(7 + mtx) + tt * 72 + s0) = w; }
        }
    }
    __syncthreads();
    if (next_item >= 0) rwkv_raw_load(SC, next_item, tid, nraw);
    if (wave == 0) {
        float X[32];
        const int blk = lane >> 5, j = lane & 31;
        const LAS float* Fb = F + (32 * blk) * 68 + 32 * blk; asm volatile("" : "+v"(Fb));
        int jz = j; asm volatile("" : "+v"(jz));
#pragma unroll
        for (int tt = 0; tt < 32; ++tt) {
            float ac[4] = {(tt == jz) ? 1.f : 0.f, 0.f, 0.f, 0.f};
#pragma unroll
            for (int s4 = 0; s4 < (tt + 3) / 4; ++s4) {
                const f32x4 a = *(const LAS f32x4*)(Fb + tt * 68 + 4 * s4);
#pragma unroll
                for (int jj = 0; jj < 4; ++jj) if (4 * s4 + jj < tt) ac[jj] += a[jj] * X[4 * s4 + jj];
            }
            X[tt] = (ac[0] + ac[1]) + (ac[2] + ac[3]);
            RTILE(11)[(32 * blk + tt) * 72 + 32 * blk + jz] = f2bf(X[tt]);
        }
        if (blk == 0) {
#pragma unroll
            for (int c8 = 0; c8 < 4; ++c8) *(LAS u32x4*)(TT11 + jz * 40 + 8 * c8) = pack8f(X + 8 * c8);
        }
    } else {
        if (wave == 7) { const u32x4 z = {0u, 0u, 0u, 0u}; const int rr = lane >> 1, hh = lane & 1;
            *(LAS u32x4*)(RTILE(11) + rr * 72 + 32 + hh * 16) = z; *(LAS u32x4*)(RTILE(11) + rr * 72 + 32 + hh * 16 + 8) = z; }
        for (int idx = wave - 1; idx < 16; idx += 7) {
            const int vi = idx >> 2, ti = idx & 3;
            f32x4 acc = {0.f, 0.f, 0.f, 0.f};
            acc = mm64(acc, RTILE(8), ti * 16, RTILE(7), vi * 16, r, q);
            u32x2 w; w.x = pk2(acc[0], acc[1]); w.y = pk2(acc[2], acc[3]);
            *(LAS u32x2*)(RTILE(2) + (vi * 16 + r) * 72 + ti * 16 + 4 * q) = w;
        }
    }
    __syncthreads();
    if (wave < 4) {
        const int ui = wave >> 1, ji = wave & 1;
        const bf16x8 af = *(const LAS bf16x8*)(A21b + (ui * 16 + r) * 40 + 8 * q), bfr = *(const LAS bf16x8*)(TT11 + (ji * 16 + r) * 40 + 8 * q);
        f32x4 acc = {0.f, 0.f, 0.f, 0.f};
        acc = __builtin_amdgcn_mfma_f32_16x16x32_bf16(af, bfr, acc, 0, 0, 0);
        u32x2 w; w.x = pk2(acc[0], acc[1]); w.y = pk2(acc[2], acc[3]);
        *(LAS u32x2*)(M1T + (ji * 16 + r) * 40 + ui * 16 + 4 * q) = w;
    }
    __syncthreads();
    if (wave < 4) {
        const int ji = wave >> 1, ti = wave & 1;
        const bf16x8 af = *(const LAS bf16x8*)(M1T + (ji * 16 + r) * 40 + 8 * q), bfr = *(const LAS bf16x8*)(RTILE(11) + (32 + ti * 16 + r) * 72 + 32 + 8 * q);
        f32x4 acc = {0.f, 0.f, 0.f, 0.f};
        acc = __builtin_amdgcn_mfma_f32_16x16x32_bf16(af, bfr, acc, 0, 0, 0);
        u32x2 w; w.x = pk2(acc[0], acc[1]); w.y = pk2(acc[2], acc[3]);
        *(LAS u32x2*)(RTILE(11) + (32 + ti * 16 + r) * 72 + ji * 16 + 4 * q) = w;
    }
    __syncthreads();
#pragma unroll
    for (int k = 0; k < 4; ++k) {
        const int idx = wave * 4 + k, which = idx >> 4, xi = (idx >> 2) & 3, ti = idx & 3;
        f32x4 acc = {0.f, 0.f, 0.f, 0.f};
        acc = mm64(acc, RTILE(11), ti * 16, which ? RTILE(2) : RTILE(4), xi * 16, r, q);
        u32x2 w; w.x = pk2(acc[0], acc[1]); w.y = pk2(acc[2], acc[3]);
        *(LAS u32x2*)((which ? RTILE(1) : RTILE(0)) + (xi * 16 + r) * 72 + ti * 16 + 4 * q) = w;
    }
    __syncthreads();
#ifdef PROBE_A_S4
    for (int rep_ = 0; rep_ < 2; ++rep_)
#endif
#pragma unroll
    for (int k = 0; k < 8; ++k) {
        const int idx = wave * 8 + k, which = idx >> 4, i1 = (idx >> 2) & 3, i2 = idx & 3;
        f32x4 acc = {0.f, 0.f, 0.f, 0.f};
        if (which == 0) {
            acc = mm64(acc, RTILE(0), i2 * 16, RTILE(9), i1 * 16, r, q);
            const int tt = i1 * 16 + r, cc = i2 * 16 + 4 * q;
            const u32x2 rv = *(const LAS u32x2*)(RTILE(3) + tt * 72 + cc);
            acc[0] += __uint_as_float(rv.x << 16); acc[1] += __uint_as_float(rv.x & 0xffff0000u); acc[2] += __uint_as_float(rv.y << 16); acc[3] += __uint_as_float(rv.y & 0xffff0000u);
            u32x2 w; w.x = pk2(acc[0], acc[1]); w.y = pk2(acc[2], acc[3]);
            *(u32x2*)(Rmout + (size_t)item * 4096 + tt * 64 + cc) = w;
        } else if (which == 1) {
            acc = mm64(acc, RTILE(9), i1 * 16, RTILE(1), i2 * 16, r, q);
            acc = mm64(acc, RTILE(10), i1 * 16, RTILE(7), i2 * 16, r, q);
            u32x2 w; w.x = pk2(acc[0], acc[1]); w.y = pk2(acc[2], acc[3]);
            *(u32x2*)(Ymout + (((size_t)item * 16 + i1 * 4 + i2) * 64 + lane) * 4) = w;
        } else if (which == 2) {
            acc = mm64(acc, RTILE(0), i2 * 16, RTILE(5), i1 * 16, r, q);
            const int c1 = i1 * 16 + r, c2 = i2 * 16 + 4 * q;
#pragma unroll
            for (int jj = 0; jj < 4; ++jj) if (c2 + jj == c1) acc[jj] += LL[c1];
            u32x2 w; w.x = pk2(acc[0], acc[1]); w.y = pk2(acc[2], acc[3]);
            *(u32x2*)(Gout + (size_t)item * 4096 + c1 * 64 + c2) = w;
        } else {
            acc = mm64(acc, RTILE(5), i1 * 16, RTILE(1), i2 * 16, r, q);
            acc = mm64(acc, RTILE(6), i1 * 16, RTILE(7), i2 * 16, r, q);
            *(f32x4*)(HTout + (((size_t)item * 16 + i1 * 4 + i2) * 64 + lane) * 4) = acc;
        }
    }
    __syncthreads();
#undef RTILE
}

__device__ __forceinline__ void rwkv_chunk_seq(LAS unsigned char* lds, const bf16_t* G, const bf16_t* Rm, const float* HT, const bf16_t* Ym, float* YRW, int bh) {
    const int b = bh >> 3, h = bh & 7;
    const int tid = TIDX, lane = tid & 63, wave = tid >> 6, r = lane & 15, q = lane >> 4;
    const int rt = wave >> 1, vi0 = (wave & 1) * 2;
    LAS bf16_t* Sb0 = (LAS bf16_t*)lds;
    f32x4 Sacc[2] = {{0.f, 0.f, 0.f, 0.f}, {0.f, 0.f, 0.f, 0.f}};
    size_t item = (size_t)bh * 128;
    auto fetch = [&](size_t it, bf16x8* rm, bf16x8* g, u32x2* ym, f32x4* ht) {
#pragma unroll
        for (int ks = 0; ks < 2; ++ks) {
            rm[ks] = *(const bf16x8*)(Rm + it * 4096 + (rt * 16 + r) * 64 + 32 * ks + 8 * q);
            g[ks] = *(const bf16x8*)(G + it * 4096 + (rt * 16 + r) * 64 + 32 * ks + 8 * q);
        }
#pragma unroll
        for (int k = 0; k < 2; ++k) {
            ym[k] = *(const u32x2*)(Ym + ((it * 16 + rt * 4 + vi0 + k) * 64 + lane) * 4);
            ht[k] = *(const f32x4*)(HT + ((it * 16 + rt * 4 + vi0 + k) * 64 + lane) * 4);
        }
    };
    constexpr int PF = 4;
    bf16x8 prm[PF][2], pg[PF][2]; u32x2 pym[PF][2]; f32x4 pht[PF][2];
#pragma unroll
    for (int u = 0; u < PF; ++u) fetch(item + u, prm[u], pg[u], pym[u], pht[u]);
    for (int ch0 = 0; ch0 < 128; ch0 += PF) {
#pragma unroll
        for (int u = 0; u < PF; ++u) {
            const int ch = ch0 + u;
            LAS bf16_t* Sb = Sb0 + (ch & 1) * 4608;
#pragma unroll
            for (int k = 0; k < 2; ++k) { u32x2 w; w.x = pk2(Sacc[k][0], Sacc[k][1]); w.y = pk2(Sacc[k][2], Sacc[k][3]); *(LAS u32x2*)(Sb + ((vi0 + k) * 16 + r) * 72 + rt * 16 + 4 * q) = w; }
            asm volatile("s_waitcnt lgkmcnt(0)" ::: "memory"); __builtin_amdgcn_s_barrier(); asm volatile("" ::: "memory");
            float* yb = YRW + (size_t)(b * L_ + ch * 64 + rt * 16 + 4 * q) * 512 + h * 64 + r;
#pragma unroll
            for (int k = 0; k < 2; ++k) {
                const bf16x8 s0 = ldfrag(Sb, (vi0 + k) * 16, 0, r, q), s1 = ldfrag(Sb, (vi0 + k) * 16, 1, r, q);
                f32x4 ya; ya[0] = __uint_as_float(pym[u][k].x << 16); ya[1] = __uint_as_float(pym[u][k].x & 0xffff0000u); ya[2] = __uint_as_float(pym[u][k].y << 16); ya[3] = __uint_as_float(pym[u][k].y & 0xffff0000u);
                ya = __builtin_amdgcn_mfma_f32_16x16x32_bf16(prm[u][0], s0, ya, 0, 0, 0);
                ya = __builtin_amdgcn_mfma_f32_16x16x32_bf16(prm[u][1], s1, ya, 0, 0, 0);
                f32x4 sa = pht[u][k];
                sa = __builtin_amdgcn_mfma_f32_16x16x32_bf16(pg[u][0], s0, sa, 0, 0, 0);
                sa = __builtin_amdgcn_mfma_f32_16x16x32_bf16(pg[u][1], s1, sa, 0, 0, 0);
                Sacc[k] = sa;
#pragma unroll
                for (int jj = 0; jj < 4; ++jj) yb[(size_t)jj * 512 + (vi0 + k) * 16] = ya[jj];
            }
            const int nch = ch + PF < 128 ? ch + PF : 127;
            fetch(item + nch, prm[u], pg[u], pym[u], pht[u]);
        }
    }
}


__device__ __forceinline__ void rwkv_chunk_seq2(LAS unsigned char* lds, const bf16_t* G, const bf16_t* Rm, const float* HT, const bf16_t* Ym, float* YRW, int unit) {
    constexpr int PF = 12;
    const int bh = unit >> 2, vq = unit & 3, b = bh >> 3, h = bh & 7;
    const int tid = TIDX, lane = tid & 63, wave = tid >> 6, r = lane & 15, q = lane >> 4;
    const int ti = wave & 3;
    LAS bf16_t* Sb0 = (LAS bf16_t*)lds;
    const size_t item0 = (size_t)bh * 128;
    if (wave < 4) {
        bf16x8 pa[PF][2]; u32x2 py[PF];
        const bf16_t* ra = Rm + item0 * 4096 + (ti * 16 + r) * 64 + 8 * q;
        const bf16_t* ya = Ym + ((item0 * 16 + ti * 4 + vq) * 64 + lane) * 4;
#pragma unroll
        for (int u = 0; u < PF; ++u) { pa[u][0] = *(const bf16x8*)(ra + (size_t)u * 4096); pa[u][1] = *(const bf16x8*)(ra + (size_t)u * 4096 + 32); py[u] = *(const u32x2*)(ya + (size_t)u * 4096); }
        for (int ch0 = 0; ch0 < 132; ch0 += PF) {
#pragma unroll
            for (int u = 0; u < PF; ++u) {
                const int ch = ch0 + u;
                if (ch < 128) {
                    const LAS bf16_t* Sb = Sb0 + (ch & 1) * 1152;
                    asm volatile("s_waitcnt lgkmcnt(0)" ::: "memory"); __builtin_amdgcn_s_barrier(); asm volatile("" ::: "memory");
                    const bf16x8 s0 = ldfrag(Sb, 0, 0, r, q), s1 = ldfrag(Sb, 0, 1, r, q);
                    f32x4 ya4; ya4[0] = __uint_as_float(py[u].x << 16); ya4[1] = __uint_as_float(py[u].x & 0xffff0000u); ya4[2] = __uint_as_float(py[u].y << 16); ya4[3] = __uint_as_float(py[u].y & 0xffff0000u);
                    ya4 = __builtin_amdgcn_mfma_f32_16x16x32_bf16(pa[u][0], s0, ya4, 0, 0, 0);
                    ya4 = __builtin_amdgcn_mfma_f32_16x16x32_bf16(pa[u][1], s1, ya4, 0, 0, 0);
                    float* yb = YRW + (size_t)(b * L_ + ch * 64 + ti * 16 + 4 * q) * 512 + h * 64 + vq * 16 + r;
#pragma unroll
                    for (int jj = 0; jj < 4; ++jj) yb[(size_t)jj * 512] = ya4[jj];
                    const int nch = ch + PF < 128 ? ch + PF : 127;
                    pa[u][0] = *(const bf16x8*)(ra + (size_t)nch * 4096); pa[u][1] = *(const bf16x8*)(ra + (size_t)nch * 4096 + 32); py[u] = *(const u32x2*)(ya + (size_t)nch * 4096);
                }
            }
        }
    } else {
        bf16x8 pa[PF][2]; f32x4 ph[PF];
        const bf16_t* ga = G + item0 * 4096 + (ti * 16 + r) * 64 + 8 * q;
        const float* ha = HT + ((item0 * 16 + ti * 4 + vq) * 64 + lane) * 4;
#pragma unroll
        for (int u = 0; u < PF; ++u) { pa[u][0] = *(const bf16x8*)(ga + (size_t)u * 4096); pa[u][1] = *(const bf16x8*)(ga + (size_t)u * 4096 + 32); ph[u] = *(const f32x4*)(ha + (size_t)u * 4096); }
        f32x4 Sacc = {0.f, 0.f, 0.f, 0.f};
        for (int ch0 = 0; ch0 < 132; ch0 += PF) {
#pragma unroll
            for (int u = 0; u < PF; ++u) {
                const int ch = ch0 + u;
                if (ch < 128) {
                    LAS bf16_t* Sb = Sb0 + (ch & 1) * 1152;
                    { u32x2 w; w.x = pk2(Sacc[0], Sacc[1]); w.y = pk2(Sacc[2], Sacc[3]); *(LAS u32x2*)(Sb + r * 72 + ti * 16 + 4 * q) = w; }
                    asm volatile("s_waitcnt lgkmcnt(0)" ::: "memory"); __builtin_amdgcn_s_barrier(); asm volatile("" ::: "memory");
                    const bf16x8 s0 = ldfrag(Sb, 0, 0, r, q), s1 = ldfrag(Sb, 0, 1, r, q);
                    f32x4 sa = ph[u];
                    sa = __builtin_amdgcn_mfma_f32_16x16x32_bf16(pa[u][0], s0, sa, 0, 0, 0);
                    sa = __builtin_amdgcn_mfma_f32_16x16x32_bf16(pa[u][1], s1, sa, 0, 0, 0);
                    Sacc = sa;
                    const int nch = ch + PF < 128 ? ch + PF : 127;
                    pa[u][0] = *(const bf16x8*)(ga + (size_t)nch * 4096); pa[u][1] = *(const bf16x8*)(ga + (size_t)nch * 4096 + 32); ph[u] = *(const f32x4*)(ha + (size_t)nch * 4096);
                }
            }
        }
    }
}

__device__ __forceinline__ void sub_barrier(unsigned* ctr, unsigned nblocks) {
    asm volatile("s_waitcnt vmcnt(0)" ::: "memory");
    __syncthreads();
    if (TIDX == 0) {
        __builtin_amdgcn_fence(__ATOMIC_RELEASE, "agent");
        asm volatile("s_waitcnt vmcnt(0)" ::: "memory");
        xb_add(ctr, 1u);
        unsigned sp = 0;
        while (xb_ld(ctr) < nblocks) { __builtin_amdgcn_s_sleep(2); if (++sp > (1u << 22)) break; }
        __builtin_amdgcn_fence(__ATOMIC_ACQUIRE, "agent");
        asm volatile("s_waitcnt vmcnt(0)" ::: "memory");
    }
    __syncthreads();
}


__device__ __forceinline__ void s5_tables(LAS float* lds, const float* a_re, const float* a_im, const float* log_dt, const float* b_re, const float* b_im,
                                          const float* c_re, const float* c_im, bf16_t* MB, bf16_t* WE, int g) {
    LAS float* pwr = lds;
    LAS float* pwi = pwr + 33 * 64;
    LAS float* zbr = pwi + 33 * 64;
    LAS float* zbi = zbr + 1024;
    LAS float* cr = zbi + 1024;
    LAS float* ci = cr + 1024;
    LAS float* kern = ci + 1024;
    const int tid = TIDX;
    const float dt = __expf(log_dt[g]);
    for (int idx = tid; idx < 33 * 64; idx += NTHREADS) {
        const int tau = idx >> 6, n = idx & 63;
        const float lam_re = fminf(a_re[g * 64 + n], -1e-4f), lam_im = a_im[g * 64 + n];
        const float m = __expf(lam_re * dt * (float)tau), ang = lam_im * dt * (float)tau;
        pwr[idx] = m * cosf(ang); pwi[idx] = m * sinf(ang);
    }
    for (int idx = tid; idx < 1024; idx += NTHREADS) {
        const int n = idx >> 4;
        const float lam_re = fminf(a_re[g * 64 + n], -1e-4f), lam_im = a_im[g * 64 + n];
        const float mag = __expf(lam_re * dt);
        const float ab_re = mag * cosf(lam_im * dt), ab_im = mag * sinf(lam_im * dt);
        const float den = lam_re * lam_re + lam_im * lam_im, num_re = ab_re - 1.f;
        const float z_re = (num_re * lam_re + ab_im * lam_im) / den, z_im = (ab_im * lam_re - num_re * lam_im) / den;
        const float br = b_re[(size_t)g * 1024 + idx], bi = b_im[(size_t)g * 1024 + idx];
        zbr[idx] = z_re * br - z_im * bi; zbi[idx] = z_re * bi + z_im * br;
        cr[idx] = c_re[(size_t)g * 1024 + idx]; ci[idx] = c_im[(size_t)g * 1024 + idx];
    }
    __syncthreads();
    {
        const int c = (tid >> 4) & 15, cp = tid & 15, th = tid >> 8;
        float acc[16];
#pragma unroll
        for (int i = 0; i < 16; ++i) acc[i] = 0.f;
        for (int n = 0; n < 64; ++n) {
            const float xr = cr[c * 64 + n], xi = ci[c * 64 + n], zr = zbr[n * 16 + cp], zi = zbi[n * 16 + cp];
            const float pr = xr * zr - xi * zi, pi = xr * zi + xi * zr;
#pragma unroll
            for (int i = 0; i < 16; ++i) acc[i] += pr * pwr[(th * 16 + i) * 64 + n] - pi * pwi[(th * 16 + i) * 64 + n];
        }
#pragma unroll
        for (int i = 0; i < 16; ++i) kern[((th * 16 + i) * 16 + c) * 16 + cp] = acc[i];
    }
    __syncthreads();
    {
        const int row = tid, i = row >> 4, c = row & 15;
        bf16_t* dst = MB + ((size_t)g * 512 + row) * 640;
        for (int ch = 0; ch < 64; ++ch) {
            const int j = ch >> 1, cp0 = (ch & 1) * 8;
            float v[8];
            if (j <= i) { const f32x4 a = *(const LAS f32x4*)(kern + ((i - j) * 16 + c) * 16 + cp0), b = *(const LAS f32x4*)(kern + ((i - j) * 16 + c) * 16 + cp0 + 4);
                          v[0] = a.x; v[1] = a.y; v[2] = a.z; v[3] = a.w; v[4] = b.x; v[5] = b.y; v[6] = b.z; v[7] = b.w; }
            else {
#pragma unroll
                for (int k = 0; k < 8; ++k) v[k] = 0.f; }
            *(u32x4*)(dst + ch * 8) = pack8f(v);
        }
        for (int ch = 0; ch < 16; ++ch) {
            const int n0 = (ch & 7) * 8; const bool im = ch >= 8;
            float v[8];
#pragma unroll
            for (int k = 0; k < 8; ++k) {
                const float xr = cr[c * 64 + n0 + k], xi = ci[c * 64 + n0 + k], pr = pwr[(i + 1) * 64 + n0 + k], pi = pwi[(i + 1) * 64 + n0 + k];
                v[k] = im ? -(xr * pi + xi * pr) : (xr * pr - xi * pi);
            }
            *(u32x4*)(dst + 512 + ch * 8) = pack8f(v);
        }
    }
    {
        const int np = tid >> 1, hf = tid & 1, n = np & 63;
        bf16_t* dst = WE + ((size_t)g * 256 + np) * 512 + hf * 256;
        for (int ch = 0; ch < 32; ++ch) {
            const int col = hf * 256 + ch * 8, j = col >> 4, cp0 = col & 15;
            float v[8];
            if (np < 128) {
                const float pr = pwr[(31 - j) * 64 + n], pi = pwi[(31 - j) * 64 + n];
#pragma unroll
                for (int k = 0; k < 8; ++k) { const float zr = zbr[n * 16 + cp0 + k], zi = zbi[n * 16 + cp0 + k]; v[k] = np < 64 ? (pr * zr - pi * zi) : (pr * zi + pi * zr); }
            } else {
#pragma unroll
                for (int k = 0; k < 8; ++k) v[k] = 0.f; }
            *(u32x4*)(dst + ch * 8) = pack8f(v);
        }
    }
    __syncthreads();
}
__device__ __forceinline__ void s5_fill_ua(const bf16_t* P1, bf16_t* UA, int gw, int ngw, int lane) {
    for (int t = gw; t < T_; t += ngw) {
        const int b = t >> 13, tt = t & 8191, c32 = tt >> 5, j = tt & 31, g = lane >> 1, c0 = (lane & 1) * 8;
        const u32x4 v = *(const u32x4*)(P1 + (size_t)t * NIN1 + 8 * lane);
        *(u32x4*)(UA + ((size_t)g * 512 + b * 256 + c32) * 640 + j * 16 + c0) = v;
    }
}
__device__ __forceinline__ void s5_carry(const float* a_re, const float* a_im, const float* log_dt, const float* E, bf16_t* UA, int th) {
    const int n = th & 63, g = (th >> 6) & 31, b = th >> 11;
    const float lam_re = fminf(a_re[g * 64 + n], -1e-4f), lam_im = a_im[g * 64 + n];
    const float dt = __expf(log_dt[g]);
    const float m = __expf(lam_re * dt * 32.f), ang = lam_im * dt * 32.f;
    const float ar = m * cosf(ang), ai = m * sinf(ang);
    float hr = 0.f, hi = 0.f;
#pragma unroll 32
    for (int c = 0; c < 256; ++c) {
        const size_t row = (size_t)g * 512 + b * 256 + c;
        const float er = E[row * 128 + n], ei = E[row * 128 + 64 + n];
        UA[row * 640 + 512 + n] = f2bf(hr); UA[row * 640 + 576 + n] = f2bf(hi);
        const float nr = ar * hr - ai * hi + er, ni = ar * hi + ai * hr + ei;
        hr = nr; hi = ni;
    }
}

struct Args {
    const float* in[42];
    float* out;
    unsigned char* ws;
    int ph_lo, ph_hi;
};

template <bool DUAL, class AF, class WF, class EF>
__device__ __forceinline__ void naive_gemm(LAS float* lds, int M, int N, int K, AF arow, WF wbase, int ldw, EF epi) {
    LAS float* As = lds;
    LAS float* Bs = lds + 64 * 33;
    LAS float* Bs2 = Bs + 32 * 64;
    const int tid = TIDX, ty = tid >> 4, tx = tid & 15;
    const int tm = (M + 63) / 64, tn = (N + 63) / 64;
    for (int tile = blockIdx.x; tile < tm * tn; tile += gridDim.x) {
        const int m0 = (tile / tn) * 64, n0 = (tile % tn) * 64;
        const float* W = wbase(m0, 0);
        const float* W2 = DUAL ? wbase(m0, 1) : W;
        float acc[2][4], acc2[2][4];
#pragma unroll
        for (int i = 0; i < 2; ++i)
#pragma unroll
            for (int j = 0; j < 4; ++j) { acc[i][j] = 0.f; acc2[i][j] = 0.f; }
        for (int k0 = 0; k0 < K; k0 += 32) {
#pragma unroll
            for (int i = 0; i < 4; ++i) {
                const int idx = tid + i * 512, r = idx >> 5, kk = idx & 31, m = m0 + r;
                As[r * 33 + kk] = (m < M) ? bf2f(arow(m)[k0 + kk]) : 0.f;
            }
#pragma unroll
            for (int i = 0; i < 4; ++i) {
                const int idx = tid + i * 512, kk = idx >> 6, n = idx & 63;
                const bool ok = (n0 + n) < N;
                Bs[kk * 64 + n] = ok ? W[(size_t)(k0 + kk) * ldw + n0 + n] : 0.f;
                if (DUAL) Bs2[kk * 64 + n] = ok ? W2[(size_t)(k0 + kk) * ldw + n0 + n] : 0.f;
            }
            __syncthreads();
#pragma unroll 8
            for (int kk = 0; kk < 32; ++kk) {
                const float a0 = As[(ty * 2) * 33 + kk], a1 = As[(ty * 2 + 1) * 33 + kk];
#pragma unroll
                for (int j = 0; j < 4; ++j) {
                    const float b = Bs[kk * 64 + tx * 4 + j];
                    acc[0][j] += a0 * b; acc[1][j] += a1 * b;
                    if (DUAL) { const float b2 = Bs2[kk * 64 + tx * 4 + j]; acc2[0][j] += a0 * b2; acc2[1][j] += a1 * b2; }
                }
            }
            __syncthreads();
        }
#pragma unroll
        for (int i = 0; i < 2; ++i)
#pragma unroll
            for (int j = 0; j < 4; ++j) {
                const int m = m0 + ty * 2 + i, n = n0 + tx * 4 + j;
                if (m < M && n < N) epi(m, n, acc[i][j], acc2[i][j]);
            }
    }
}

template <class SRC, class DROW>
__device__ __forceinline__ void xpose_item(SRC src, DROW drow, bf16_t* WT, int ldk, LAS float* scr, int k0, int n0, int lane) {
#pragma unroll 8
    for (int i = 0; i < 32; ++i) { const int kk = 2 * i + (lane >> 5); scr[kk * 33 + (lane & 31)] = src(k0 + kk, n0 + (lane & 31)); }
    asm volatile("s_waitcnt lgkmcnt(0)" ::: "memory");
    const int c = lane & 7;
#pragma unroll
    for (int j = 0; j < 4; ++j) {
        const int n = (lane >> 3) + 8 * j; const LAS float* sp = scr + (8 * c) * 33 + n;
        u32x4 o; o.x = pk2(sp[0 * 33], sp[1 * 33]); o.y = pk2(sp[2 * 33], sp[3 * 33]); o.z = pk2(sp[4 * 33], sp[5 * 33]); o.w = pk2(sp[6 * 33], sp[7 * 33]);
        *(u32x4*)(WT + (size_t)drow(n0 + n) * ldk + k0 + 8 * c) = o;
    }
    asm volatile("s_waitcnt lgkmcnt(0)" ::: "memory");
}
template <class SRC4, class DROW>
__device__ __forceinline__ void xpose_item4(SRC4 src, DROW drow, bf16_t* WT, int ldk, LAS float* scr, int k0, int n0, int lane) {
    f32x4 v[8];
#pragma unroll
    for (int i = 0; i < 8; ++i) v[i] = src(k0 + 8 * i + (lane >> 3), n0 + 4 * (lane & 7));
#pragma unroll
    for (int i = 0; i < 8; ++i) { LAS float* d = scr + (8 * i + (lane >> 3)) * 33 + 4 * (lane & 7); d[0] = v[i].x; d[1] = v[i].y; d[2] = v[i].z; d[3] = v[i].w; }
    asm volatile("s_waitcnt lgkmcnt(0)" ::: "memory");
    const int c = lane & 7;
#pragma unroll
    for (int j = 0; j < 4; ++j) {
        const int n = (lane >> 3) + 8 * j; const LAS float* sp = scr + (8 * c) * 33 + n;
        u32x4 o; o.x = pk2(sp[0 * 33], sp[1 * 33]); o.y = pk2(sp[2 * 33], sp[3 * 33]); o.z = pk2(sp[4 * 33], sp[5 * 33]); o.w = pk2(sp[6 * 33], sp[7 * 33]);
        *(u32x4*)(WT + (size_t)drow(n0 + n) * ldk + k0 + 8 * c) = o;
    }
    asm volatile("s_waitcnt lgkmcnt(0)" ::: "memory");
}
__device__ __forceinline__ void convert_plain(const float* W, int K, int N, int NP, bf16_t* WT, LAS float* scr, int gw, int ngw, int lane) {
    const int nblk = NP / 32, nitems = (K / 64) * nblk;
    for (int it = gw; it < nitems; it += ngw) {
        const int k0 = 64 * (it / nblk), n0 = 32 * (it % nblk);
        xpose_item4([&](int k, int n4) { return n4 < N ? *(const f32x4*)(W + (size_t)k * N + n4) : (f32x4){0.f, 0.f, 0.f, 0.f}; }, [&](int n) { return n; }, WT, K, scr, k0, n0, lane);
    }
}
__device__ __forceinline__ void convert_lora(const float* w2, const float* a2, const float* g2, bf16_t* WT, LAS float* scr, int gw, int ngw, int lane) {
    const int nblk = NLORA / 32, nitems = 4 * nblk;
    for (int it = gw; it < nitems; it += ngw) {
        const int k0 = 64 * (it / nblk), n0 = 32 * (it % nblk);
        xpose_item([&](int k, int n) {
            if (n < 512) return k < 64 ? w2[k * 512 + n] : 0.f;
            if (n < 1024) return (k >= 64 && k < 128) ? a2[(k - 64) * 512 + (n - 512)] : 0.f;
            return k >= 128 ? g2[(k - 128) * 512 + (n - 1024)] : 0.f; }, [&](int n) { return n; }, WT, 256, scr, k0, n0, lane);
    }
}
__device__ __forceinline__ void convert_moe(const float* w1, const float* w3, const float* w2, bf16_t* W13, bf16_t* W2T, LAS float* scr, int gw, int ngw, int lane) {
    constexpr int I13 = 16 * 32, I2 = 8 * 32, IE = I13 + I2;
    for (int it = gw; it < 32 * IE; it += ngw) {
        const int e = it / IE, r = it % IE;
        if (r < I13) {
            const int k0 = 64 * (r / 32), n0 = 32 * (r % 32);
            const float* a = w1 + (size_t)e * D_ * 512; const float* b = w3 + (size_t)e * D_ * 512;
            xpose_item4([&](int k, int n4) { return n4 < 512 ? *(const f32x4*)(a + (size_t)k * 512 + n4) : *(const f32x4*)(b + (size_t)k * 512 + (n4 - 512)); },
                       [&](int n) { const int c = n & 511; return (c >> 2) * 8 + (n >> 9) * 4 + (c & 3); }, W13 + (size_t)e * 1024 * 1024, 1024, scr, k0, n0, lane);
        } else {
            const int rr = r - I13, k0 = 64 * (rr / 32), n0 = 32 * (rr % 32);
            const float* a = w2 + (size_t)e * 512 * D_;
            xpose_item4([&](int k, int n4) { return *(const f32x4*)(a + (size_t)k * D_ + n4); }, [&](int n) { return n; }, W2T + (size_t)e * 1024 * 512, 512, scr, k0, n0, lane);
        }
    }
}

__device__ __forceinline__ void ph_prologue(const float* x, bf16_t* hb) {
    const size_t n4 = (size_t)T_ * D_ / 4;
    for (size_t i = (size_t)blockIdx.x * NTHREADS + TIDX; i < n4; i += (size_t)gridDim.x * NTHREADS) {
        const f32x4 v = ((const f32x4*)x)[i];
        u32x2 o; o.x = pk2(v.x, v.y); o.y = pk2(v.z, v.w);
        ((u32x2*)hb)[i] = o;
    }
    for (size_t i = (size_t)blockIdx.x * NTHREADS + TIDX; i < (size_t)256 * D_ / 2; i += (size_t)gridDim.x * NTHREADS)
        ((unsigned*)(hb + (size_t)T_ * D_))[i] = 0u;
}

__device__ __forceinline__ float p0_shift(const bf16_t* P, const float* mu, int t, int c) {
    const float p = bf2f(P[(size_t)t * NIN0P + c]);
    const float pv = ((t & (L_ - 1)) == 0) ? 0.f : bf2f(P[(size_t)(t - 1) * NIN0P + c]);
    return p + mu[c] * (pv - p);
}
template <bool WITH_GLA>
__device__ __forceinline__ void ph_prepA0(const bf16_t* P, const float* mu, const float* gk_w2, const float* gk_b, bf16_t* Ap, float* gla_la) {
    for (int chunk = blockIdx.x; chunk < T_ / 64; chunk += gridDim.x) {
        for (int idx = TIDX; idx < 64 * 256; idx += NTHREADS) {
            const int tl = idx >> 8, j = idx & 255, t = chunk * 64 + tl;
            float v;
            if (j < 64) v = tanhf(p0_shift(P, mu, t, 512 + j));
            else if (j < 128) v = p0_shift(P, mu, t, 1600 + (j - 64));
            else v = sigm(p0_shift(P, mu, t, 1664 + (j - 128)));
            Ap[(size_t)t * 256 + j] = f2bf(v);
            if (WITH_GLA) {
                float gk = gk_b[j];
#pragma unroll
                for (int i = 0; i < 16; ++i) gk += bf2f(P[(size_t)t * NIN0P + 2816 + i]) * gk_w2[i * 256 + j];
                const float ls = fminf(gk, 0.f) - log1pf(__expf(-fabsf(gk)));
                gla_la[(size_t)t * 256 + j] = ls * (1.f / 16.f);
            }
        }
    }
}

__device__ __forceinline__ void ph_prepB0(const bf16_t* P, const bf16_t* LO, const float* mu, const float* w0, const float* a0, const float* k_k, const float* k_a,
                                          const float* r_k, bf16_t* SC, float* BON) {
    const int wave = TIDX >> 6, lane = TIDX & 63;
    for (int item = blockIdx.x * NWAVES + wave; item < T_ * 8; item += gridDim.x * NWAVES) {
        const int t = item >> 3, h = item & 7, c = h * 64 + lane;
        const float r = p0_shift(P, mu, t, c), k = p0_shift(P, mu, t, 576 + c), v = p0_shift(P, mu, t, 1088 + c);
        const float low = bf2f(LO[(size_t)t * 512 + c]), loa = bf2f(LO[(size_t)T_ * 512 + (size_t)t * 512 + c]);
        const float xw = w0[c] + low;
        const float wraw = -softplusf(-xw) - 0.5f;
        const float ld = -__expf(wraw);
        const float a = sigm(a0[c] + loa);
        const float kkr = k * k_k[c];
        const float ss = wave_sum(kkr * kkr);
        const float kk = kkr / fmaxf(sqrtf(ss), 1e-12f);
        const float kp = k * (1.f + (a - 1.f) * k_a[c]);
        const float bon = wave_sum(r * kp * r_k[c]);
        const size_t o = (size_t)t * 512 + c, S1 = (size_t)T_ * 512;
        SC[o] = f2bf(r); SC[S1 + o] = f2bf(ld); SC[2 * S1 + o] = f2bf(kp); SC[3 * S1 + o] = f2bf(v); SC[4 * S1 + o] = f2bf(kk); SC[5 * S1 + o] = f2bf(a);
        if (lane == 0) BON[(size_t)t * 8 + h] = bon;
    }
}

__device__ __forceinline__ void naive_rwkv_scan(LAS float* lds, const bf16_t* SC, float* YRW, int bh) {
    constexpr int TS = 32;
    const int b = bh >> 3, h = bh & 7;
    LAS float* Lnkk = lds;
    LAS float* Ldec = lds + TS * 64;
    LAS float* Lab = lds + 2 * TS * 64;
    LAS float* Lkp = lds + 3 * TS * 64;
    LAS float* Lr = lds + 4 * TS * 64;
    LAS float* Lv = lds + 5 * TS * 64;
    const size_t S1 = (size_t)T_ * 512;
    float S[64];
#pragma unroll
    for (int k = 0; k < 64; ++k) S[k] = 0.f;
    const int lane = TIDX & 63, wave = TIDX >> 6;
    for (int t0 = 0; t0 < L_; t0 += TS) {
        for (int idx = TIDX; idx < TS * 64; idx += NTHREADS) {
            const int s = idx >> 6, k = idx & 63;
            const size_t o = (size_t)(b * L_ + t0 + s) * 512 + h * 64 + k;
            const float r = bf2f(SC[o]), ld = bf2f(SC[S1 + o]), kp = bf2f(SC[2 * S1 + o]), v = bf2f(SC[3 * S1 + o]), kk = bf2f(SC[4 * S1 + o]), a = bf2f(SC[5 * S1 + o]);
            Lnkk[idx] = -kk; Ldec[idx] = __expf(ld); Lab[idx] = kk * a; Lkp[idx] = kp; Lr[idx] = r; Lv[idx] = v;
        }
        __syncthreads();
        if (wave == 0) {
            for (int s = 0; s < TS; ++s) {
                float sa = 0.f;
#pragma unroll
                for (int k = 0; k < 64; ++k) sa += S[k] * Lnkk[s * 64 + k];
                const float vv = Lv[s * 64 + lane];
                float y = 0.f;
#pragma unroll
                for (int k = 0; k < 64; ++k) {
                    S[k] = S[k] * Ldec[s * 64 + k] + sa * Lab[s * 64 + k] + vv * Lkp[s * 64 + k];
                    y += S[k] * Lr[s * 64 + k];
                }
                YRW[(size_t)(b * L_ + t0 + s) * 512 + h * 64 + lane] = y;
            }
        }
        __syncthreads();
    }
}

template <int K, class LDF, class LVF>
__device__ __forceinline__ void naive_gla_scan(LAS float* lds, LDF ld, LVF lv, float* OG, int b, int h) {
    constexpr int TS = 16;
    LAS float* Lq = lds;
    LAS float* Lk = lds + TS * K;
    LAS float* Le = lds + 2 * TS * K;
    LAS float* Lv = lds + 3 * TS * K;
    float S[K];
#pragma unroll
    for (int k = 0; k < K; ++k) S[k] = 0.f;
    const int tid = TIDX;
    for (int t0 = 0; t0 < L_; t0 += TS) {
        for (int idx = tid; idx < TS * K; idx += NTHREADS) {
            const int s = idx / K, k = idx % K;
            float q, kk, e; ld(b * L_ + t0 + s, h * K + k, q, kk, e);
            Lq[idx] = q; Lk[idx] = kk; Le[idx] = e;
        }
        for (int idx = tid; idx < TS * 128; idx += NTHREADS) {
            const int s = idx >> 7, vc = idx & 127;
            Lv[idx] = lv(b * L_ + t0 + s, h * 128 + vc);
        }
        __syncthreads();
        if (tid < 128) {
            for (int s = 0; s < TS; ++s) {
                const float vv = Lv[s * 128 + tid];
                float o = 0.f;
#pragma unroll
                for (int k = 0; k < K; ++k) {
                    S[k] = S[k] * Le[s * K + k] + Lk[s * K + k] * vv;
                    o += Lq[s * K + k] * S[k];
                }
                OG[(size_t)(b * L_ + t0 + s) * 512 + h * 128 + tid] = o;
            }
        }
        __syncthreads();
    }
}

template <bool WITH_GLA>
__device__ __forceinline__ void ph_fin0(const float* YRW, const float* OG, const bf16_t* P, const bf16_t* LO, const bf16_t* SC, const float* BON,
                                        const float* gn_g, const float* gn_b, const float* norm_g, bf16_t* Ymix) {
    const int wave = TIDX >> 6, lane = TIDX & 63;
    const size_t S1 = (size_t)T_ * 512;
    constexpr int NU = WITH_GLA ? 12 : 8;
    for (int item = blockIdx.x * NWAVES + wave; item < T_ * NU; item += gridDim.x * NWAVES) {
        const int t = item / NU, u = item % NU;
        if (u < 8) {
            const int c = u * 64 + lane;
            const float y = YRW[(size_t)t * 512 + c];
            const float mean = wave_sum(y) * (1.f / 64.f);
            const float d = y - mean;
            const float var = wave_sum(d * d) * (1.f / 64.f);
            const float yn = d * rsqrtf(var + 64e-5f) * gn_g[c] + gn_b[c];
            const float v = bf2f(SC[3 * S1 + (size_t)t * 512 + c]);
            const float g = bf2f(LO[(size_t)2 * T_ * 512 + (size_t)t * 512 + c]);
            Ymix[(size_t)t * D_ + c] = f2bf((yn + BON[(size_t)t * 8 + u] * v) * g);
        } else {
            const int h = u - 8;
            const float o0 = OG[(size_t)t * 512 + h * 128 + lane], o1 = OG[(size_t)t * 512 + h * 128 + 64 + lane];
            const float ms = wave_sum(o0 * o0 + o1 * o1) * (1.f / 128.f);
            const float rs = rsqrtf(ms + LN_EPS);
            const float g0 = bf2f(P[(size_t)t * NIN0P + 2832 + h * 128 + lane]), g1 = bf2f(P[(size_t)t * NIN0P + 2832 + h * 128 + 64 + lane]);
            Ymix[(size_t)t * D_ + 512 + h * 128 + lane] = f2bf(o0 * rs * norm_g[lane] * siluf(g0));
            Ymix[(size_t)t * D_ + 512 + h * 128 + 64 + lane] = f2bf(o1 * rs * norm_g[64 + lane] * siluf(g1));
        }
    }
}

__device__ __forceinline__ void ph_ln_router(const float* src, float* hf, bf16_t* hb, const float* lg, const float* lb, const float* wg, const float* bg,
                                             const float* we, const float* be, int* tok_e, int* tok_slot, float* tok_g, unsigned* cnt) {
    const int wave = TIDX >> 6, lane = TIDX & 63;
    for (int t = blockIdx.x * NWAVES + wave; t < T_; t += gridDim.x * NWAVES) {
        const f32x4* xr = (const f32x4*)(src + (size_t)t * D_) + lane;
        f32x4 v[4]; float s = 0.f;
#pragma unroll
        for (int j = 0; j < 4; ++j) { v[j] = xr[64 * j]; s += (v[j].x + v[j].y) + (v[j].z + v[j].w); }
        const float mean = wave_sum(s) * (1.f / D_);
        float s2 = 0.f;
#pragma unroll
        for (int j = 0; j < 4; ++j) { v[j] = v[j] - mean; s2 += (v[j].x * v[j].x + v[j].y * v[j].y) + (v[j].z * v[j].z + v[j].w * v[j].w); }
        const float rstd = rsqrtf(wave_sum(s2) * (1.f / D_) + LN_EPS);
#pragma unroll
        for (int j = 0; j < 4; ++j) {
            const f32x4 g = ((const f32x4*)lg)[lane + 64 * j], bb = ((const f32x4*)lb)[lane + 64 * j];
            v[j] = v[j] * rstd * g + bb;
            ((f32x4*)(hf + (size_t)t * D_))[lane + 64 * j] = v[j];
            u32x2 o; o.x = pk2(v[j].x, v[j].y); o.y = pk2(v[j].z, v[j].w);
            ((u32x2*)(hb + (size_t)t * D_))[lane + 64 * j] = o;
        }
        float cl[4] = {0.f, 0.f, 0.f, 0.f};
#pragma unroll
        for (int j = 0; j < 4; ++j)
#pragma unroll
            for (int e = 0; e < 4; ++e) {
                const int d = 4 * (lane + 64 * j) + e;
                const f32x4 w = *(const f32x4*)(wg + (size_t)d * 4);
                const float xv = v[j][e];
                cl[0] += xv * w.x; cl[1] += xv * w.y; cl[2] += xv * w.z; cl[3] += xv * w.w;
            }
#pragma unroll
        for (int g = 0; g < 4; ++g) cl[g] = wave_sum(cl[g]) + bg[g];
        int grp = 0; float mx = cl[0];
#pragma unroll
        for (int g = 1; g < 4; ++g) if (cl[g] > mx) { mx = cl[g]; grp = g; }
        float den = 0.f;
#pragma unroll
        for (int g = 0; g < 4; ++g) den += __expf(cl[g] - mx);
        const float p_grp = 1.f / den;
        float fl[8];
#pragma unroll
        for (int e = 0; e < 8; ++e) fl[e] = 0.f;
        const float* weg = we + (size_t)grp * D_ * 8;
#pragma unroll
        for (int j = 0; j < 4; ++j)
#pragma unroll
            for (int e = 0; e < 4; ++e) {
                const int d = 4 * (lane + 64 * j) + e;
                const f32x4 w0 = *(const f32x4*)(weg + (size_t)d * 8), w1 = *(const f32x4*)(weg + (size_t)d * 8 + 4);
                const float xv = v[j][e];
                fl[0] += xv * w0.x; fl[1] += xv * w0.y; fl[2] += xv * w0.z; fl[3] += xv * w0.w;
                fl[4] += xv * w1.x; fl[5] += xv * w1.y; fl[6] += xv * w1.z; fl[7] += xv * w1.w;
            }
#pragma unroll
        for (int e = 0; e < 8; ++e) fl[e] = wave_sum(fl[e]) + be[grp * 8 + e];
        int j0 = 0; float m0 = fl[0];
#pragma unroll
        for (int e = 1; e < 8; ++e) if (fl[e] > m0) { m0 = fl[e]; j0 = e; }
        int j1 = -1; float m1 = -3.0e38f;
#pragma unroll
        for (int e = 0; e < 8; ++e) if (e != j0 && fl[e] > m1) { m1 = fl[e]; j1 = e; }
        const float e1 = __expf(m1 - m0);
        const float g0 = p_grp / (1.f + e1), g1 = p_grp * e1 / (1.f + e1);
        if (lane == 0) {
            const int ex0 = grp * 8 + j0, ex1 = grp * 8 + j1;
            const unsigned s0 = atomicAdd(&cnt[ex0], 1u), s1 = atomicAdd(&cnt[ex1], 1u);
            tok_e[2 * t] = ex0; tok_e[2 * t + 1] = ex1;
            tok_slot[2 * t] = (int)s0; tok_slot[2 * t + 1] = (int)s1;
            tok_g[2 * t] = g0; tok_g[2 * t + 1] = g1;
        }
    }
}


__device__ __forceinline__ void shift8(const bf16_t* P, const float* mu, int t, int c, float* out) {
    float p[8], pv[8], m[8];
    ld8bf(P + (size_t)t * NIN0P + c, p); ld8f(mu + c, m);
    if ((t & (L_ - 1)) == 0) {
#pragma unroll
        for (int j = 0; j < 8; ++j) pv[j] = 0.f;
    } else ld8bf(P + (size_t)(t - 1) * NIN0P + c, pv);
#pragma unroll
    for (int j = 0; j < 8; ++j) out[j] = p[j] + m[j] * (pv[j] - p[j]);
}
__device__ __forceinline__ void ph_prepA0v(const bf16_t* P, const float* mu, bf16_t* Ap) {
    const int tid = TIDX, wave = tid >> 6, lane = tid & 63, l5 = lane & 31;
    for (int tp = blockIdx.x * NWAVES + wave; tp < T_ / 2; tp += gridDim.x * NWAVES) {
        const int t = tp * 2 + (lane >> 5), j0 = l5 * 8;
        const int c = j0 < 64 ? 512 + j0 : (j0 < 128 ? 1600 + (j0 - 64) : 1664 + (j0 - 128));
        float x[8]; shift8(P, mu, t, c, x);
#pragma unroll
        for (int j = 0; j < 8; ++j) x[j] = j0 < 64 ? tanhf(x[j]) : (j0 < 128 ? x[j] : sigm(x[j]));
        *(u32x4*)(Ap + (size_t)t * 256 + j0) = pack8f(x);
    }
}
__device__ __forceinline__ float sum8lanes(float v) { v += __shfl_xor(v, 1); v += __shfl_xor(v, 2); v += __shfl_xor(v, 4); return v; }
__device__ __forceinline__ void ph_prepB0v(const bf16_t* P, const bf16_t* LO, const float* mu, const float* w0, const float* a0, const float* k_k, const float* k_a,
                                           const float* r_k, bf16_t* SC, float* BON) {
    const int tid = TIDX, wave = tid >> 6, lane = tid & 63, c0 = lane * 8;
    const size_t S1 = (size_t)T_ * 512;
    for (int t = blockIdx.x * NWAVES + wave; t < T_; t += gridDim.x * NWAVES) {
        float r[8], k[8], v[8], low[8], loa[8], pw0[8], pa0[8], pkk[8], pka[8], prk[8];
        shift8(P, mu, t, c0, r); shift8(P, mu, t, 576 + c0, k); shift8(P, mu, t, 1088 + c0, v);
        ld8bf(LO + (size_t)t * 512 + c0, low); ld8bf(LO + S1 + (size_t)t * 512 + c0, loa);
        ld8f(w0 + c0, pw0); ld8f(a0 + c0, pa0); ld8f(k_k + c0, pkk); ld8f(k_a + c0, pka); ld8f(r_k + c0, prk);
        float ld[8], a[8], kkr[8], kp[8], ss = 0.f, bon = 0.f;
#pragma unroll
        for (int j = 0; j < 8; ++j) {
            const float xw = pw0[j] + low[j];
            const float wraw = -softplusf(-xw) - 0.5f;
            ld[j] = -__expf(wraw);
            a[j] = sigm(pa0[j] + loa[j]);
            kkr[j] = k[j] * pkk[j]; ss += kkr[j] * kkr[j];
            kp[j] = k[j] * (1.f + (a[j] - 1.f) * pka[j]);
            bon += r[j] * kp[j] * prk[j];
        }
        ss = sum8lanes(ss); bon = sum8lanes(bon);
        const float inv = 1.f / fmaxf(sqrtf(ss), 1e-12f);
#pragma unroll
        for (int j = 0; j < 8; ++j) kkr[j] *= inv;
        const size_t o = (size_t)t * 512 + c0;
        *(u32x4*)(SC + o) = pack8f(r); *(u32x4*)(SC + S1 + o) = pack8f(ld); *(u32x4*)(SC + 2 * S1 + o) = pack8f(kp);
        *(u32x4*)(SC + 3 * S1 + o) = pack8f(v); *(u32x4*)(SC + 4 * S1 + o) = pack8f(kkr); *(u32x4*)(SC + 5 * S1 + o) = pack8f(a);
        if ((lane & 7) == 0) BON[(size_t)t * 8 + (lane >> 3)] = bon;
    }
}
__device__ __forceinline__ void ph_fin0v(const float* YRW, const bf16_t* LO, const bf16_t* SC, const float* BON, const float* gn_g, const float* gn_b, bf16_t* Ymix) {
    const int tid = TIDX, wave = tid >> 6, lane = tid & 63, c0 = lane * 8;
    const size_t S1 = (size_t)T_ * 512;
    for (int t = blockIdx.x * NWAVES + wave; t < T_; t += gridDim.x * NWAVES) {
        float y[8], v[8], g[8], gg[8], gb[8];
        ld8f(YRW + (size_t)t * 512 + c0, y); ld8bf(SC + 3 * S1 + (size_t)t * 512 + c0, v); ld8bf(LO + 2 * S1 + (size_t)t * 512 + c0, g);
        ld8f(gn_g + c0, gg); ld8f(gn_b + c0, gb);
        const float bon = BON[(size_t)t * 8 + (lane >> 3)];
        float sm = 0.f;
#pragma unroll
        for (int j = 0; j < 8; ++j) sm += y[j];
        const float mean = sum8lanes(sm) * (1.f / 64.f);
        float sq = 0.f;
#pragma unroll
        for (int j = 0; j < 8; ++j) { y[j] -= mean; sq += y[j] * y[j]; }
        const float rs = rsqrtf(sum8lanes(sq) * (1.f / 64.f) + 64e-5f);
        float o[8];
#pragma unroll
        for (int j = 0; j < 8; ++j) o[j] = (y[j] * rs * gg[j] + gb[j] + bon * v[j]) * g[j];
        *(u32x4*)(Ymix + (size_t)t * D_ + c0) = pack8f(o);
    }
}

__device__ __forceinline__ void ph_ln_router2(LAS unsigned char* lds, const bf16_t* src, bf16_t* hb, const float* lg, const float* lb, const bf16_t* WrT, const float* bg, const float* be,
                                              int* tok_e, int* tok_slot, float* tok_g, unsigned* cnt) {
    LAS bf16_t* LW = (LAS bf16_t*)lds;
    LAS float* LGall = (LAS float*)(lds + 48 * 1032 * 2);
    const int tid = TIDX, wave = tid >> 6, lane = tid & 63, r = lane & 15, q = lane >> 4;
    for (int i = tid; i < 48 * 128; i += NTHREADS) { const int row = i >> 7, c8 = (i & 127) * 8; *(LAS u32x4*)(LW + row * 1032 + c8) = *(const u32x4*)(WrT + (size_t)row * 1024 + c8); }
    for (int rb = blockIdx.x; rb < T_ / 64; rb += gridDim.x) {
#pragma unroll 1
        for (int i = 0; i < 8; i += 2) {
            f32x4 v[2][4]; float sm[2], s2[2];
#pragma unroll
            for (int rr = 0; rr < 2; ++rr) {
                const u32x2* xr = (const u32x2*)(src + (size_t)(rb * 64 + wave * 8 + i + rr) * D_) + lane;
                sm[rr] = 0.f;
#pragma unroll
                for (int j = 0; j < 4; ++j) { const u32x2 xv = xr[64 * j];
                    v[rr][j].x = __uint_as_float(xv.x << 16); v[rr][j].y = __uint_as_float(xv.x & 0xffff0000u); v[rr][j].z = __uint_as_float(xv.y << 16); v[rr][j].w = __uint_as_float(xv.y & 0xffff0000u);
                    sm[rr] += (v[rr][j].x + v[rr][j].y) + (v[rr][j].z + v[rr][j].w); }
            }
#pragma unroll
            for (int o = 1; o < 64; o <<= 1) { sm[0] += __shfl_xor(sm[0], o); sm[1] += __shfl_xor(sm[1], o); }
#pragma unroll
            for (int rr = 0; rr < 2; ++rr) { const float mean = sm[rr] * (1.f / D_); s2[rr] = 0.f;
#pragma unroll
                for (int j = 0; j < 4; ++j) { v[rr][j] = v[rr][j] - mean; s2[rr] += (v[rr][j].x * v[rr][j].x + v[rr][j].y * v[rr][j].y) + (v[rr][j].z * v[rr][j].z + v[rr][j].w * v[rr][j].w); } }
#pragma unroll
            for (int o = 1; o < 64; o <<= 1) { s2[0] += __shfl_xor(s2[0], o); s2[1] += __shfl_xor(s2[1], o); }
#pragma unroll
            for (int rr = 0; rr < 2; ++rr) {
                const int t = rb * 64 + wave * 8 + i + rr;
                const float rstd = rsqrtf(s2[rr] * (1.f / D_) + LN_EPS);
#pragma unroll
                for (int j = 0; j < 4; ++j) {
                    const f32x4 g = ((const f32x4*)lg)[lane + 64 * j], bb = ((const f32x4*)lb)[lane + 64 * j];
                    const f32x4 o4 = v[rr][j] * rstd * g + bb;
                    u32x2 o; o.x = pk2(o4.x, o4.y); o.y = pk2(o4.z, o4.w);
                    ((u32x2*)(hb + (size_t)t * D_))[lane + 64 * j] = o;
                }
            }
        }
        asm volatile("s_waitcnt vmcnt(0)" ::: "memory");
        __syncthreads();
        if (wave < 4) {
            const bf16_t* arow = hb + (size_t)(rb * 64 + wave * 16 + r) * D_ + 8 * q;
            f32x4 acc[3] = {{0.f, 0.f, 0.f, 0.f}, {0.f, 0.f, 0.f, 0.f}, {0.f, 0.f, 0.f, 0.f}};
#pragma unroll 8
            for (int ks = 0; ks < 32; ++ks) {
                const bf16x8 af = *(const bf16x8*)(arow + 32 * ks);
#pragma unroll
                for (int ct = 0; ct < 3; ++ct) {
                    const bf16x8 bfr = *(const LAS bf16x8*)(LW + (ct * 16 + r) * 1032 + 32 * ks + 8 * q);
                    acc[ct] = __builtin_amdgcn_mfma_f32_16x16x32_bf16(af, bfr, acc[ct], 0, 0, 0);
                }
            }
            LAS float* LG = LGall + wave * (16 * 49);
#pragma unroll
            for (int ct = 0; ct < 3; ++ct)
#pragma unroll
                for (int j = 0; j < 4; ++j) LG[(4 * q + j) * 49 + ct * 16 + r] = acc[ct][j];
            asm volatile("s_waitcnt lgkmcnt(0)" ::: "memory");
            if (lane < 16) {
                const int t = rb * 64 + wave * 16 + lane;
                const LAS float* L = LG + lane * 49;
                float cl[4];
#pragma unroll
                for (int g = 0; g < 4; ++g) cl[g] = L[g] + bg[g];
                int grp = 0; float mx = cl[0];
#pragma unroll
                for (int g = 1; g < 4; ++g) if (cl[g] > mx) { mx = cl[g]; grp = g; }
                float den = 0.f;
#pragma unroll
                for (int g = 0; g < 4; ++g) den += __expf(cl[g] - mx);
                const float p_grp = 1.f / den;
                float fl[8];
#pragma unroll
                for (int e = 0; e < 8; ++e) fl[e] = L[4 + grp * 8 + e] + be[grp * 8 + e];
                int j0 = 0; float m0 = fl[0];
#pragma unroll
                for (int e = 1; e < 8; ++e) if (fl[e] > m0) { m0 = fl[e]; j0 = e; }
                int j1 = -1; float m1 = -3.0e38f;
#pragma unroll
                for (int e = 0; e < 8; ++e) if (e != j0 && fl[e] > m1) { m1 = fl[e]; j1 = e; }
                const float e1 = __expf(m1 - m0);
                const float g0 = p_grp / (1.f + e1), g1 = p_grp * e1 / (1.f + e1);
                const int ex0 = grp * 8 + j0, ex1 = grp * 8 + j1;
                const unsigned s0 = atomicAdd(&cnt[ex0], 1u), s1 = atomicAdd(&cnt[ex1], 1u);
                tok_e[2 * t] = ex0; tok_e[2 * t + 1] = ex1;
                tok_slot[2 * t] = (int)s0; tok_slot[2 * t + 1] = (int)s1;
                tok_g[2 * t] = g0; tok_g[2 * t + 1] = g1;
            }
        }
        __syncthreads();
    }
}
__device__ __forceinline__ void convert_router(const float* wg, const float* we, bf16_t* WrT, int gthread, int gthreads) {
    for (int i = gthread; i < 2 * 48 * 1024; i += gthreads) {
        const int layer = i / (48 * 1024), rem = i % (48 * 1024), col = rem >> 10, d = rem & 1023;
        float v = 0.f;
        if (col < 4) v = wg[((size_t)layer * D_ + d) * 4 + col];
        else if (col < 36) { const int g = (col - 4) >> 3, e = (col - 4) & 7; v = we[(((size_t)layer * 4 + g) * D_ + d) * 8 + e]; }
        WrT[i] = f2bf(v);
    }
}

__device__ __forceinline__ void moe_offsets(LAS int* pst, const unsigned* cnt) {
    if (TIDX == 0) {
        int acc = 0;
        for (int e = 0; e < 32; ++e) { pst[e] = acc; const int c = (int)cnt[e]; acc += (c + MOE_PAD - 1) / MOE_PAD * MOE_PAD; }
        pst[32] = acc;
    }
    __syncthreads();
}
__device__ __forceinline__ int moe_expert_of_row(const LAS int* pst, int r) {
    int e = 0;
#pragma unroll 1
    for (int i = 1; i < 32; ++i) if (r >= pst[i]) e = i;
    return e;
}

__device__ __forceinline__ void ph_dispatch(LAS int* pst, const unsigned* cnt, const bf16_t* hb, const int* tok_e, const int* tok_slot, int* tok_dest, bf16_t* XR) {
    moe_offsets(pst, cnt);
    const int wave = TIDX >> 6, lane = TIDX & 63;
    for (int item = blockIdx.x * NWAVES + wave; item < T_ * 2; item += gridDim.x * NWAVES) {
        const int t = item >> 1;
        const int e = tok_e[item], dest = pst[e] + tok_slot[item];
        if (lane == 0) tok_dest[item] = dest;
        const u32x4* src = (const u32x4*)(hb + (size_t)t * D_);
        u32x4* dst = (u32x4*)(XR + (size_t)dest * D_);
        dst[lane] = src[lane]; dst[lane + 64] = src[lane + 64];
    }
    const int R = pst[32];
    for (int r = blockIdx.x * NWAVES + wave; r < R; r += gridDim.x * NWAVES) {
        const int e = moe_expert_of_row(pst, r);
        if (r - pst[e] >= (int)cnt[e]) {
            u32x4* dst = (u32x4*)(XR + (size_t)r * D_);
            const u32x4 z = {0u, 0u, 0u, 0u};
            dst[lane] = z; dst[lane + 64] = z;
        }
    }
}

__device__ __forceinline__ void ph_dispatch2(LAS int* pst, const unsigned* cnt, const int* tok_e, const int* tok_slot, int* tok_dest, int* row_tok) {
    moe_offsets(pst, cnt);
    for (int item = blockIdx.x * NTHREADS + TIDX; item < T_ * 2; item += gridDim.x * NTHREADS) {
        const int dest = pst[tok_e[item]] + tok_slot[item];
        tok_dest[item] = dest; row_tok[dest] = item >> 1;
    }
    const int R = pst[32];
    for (int r = blockIdx.x * NTHREADS + TIDX; r < R; r += gridDim.x * NTHREADS) {
        const int e = moe_expert_of_row(pst, r);
        if (r - pst[e] >= (int)cnt[e]) row_tok[r] = T_;
    }
}

template <bool LAST>
__device__ __forceinline__ void ph_combine_ln(bf16_t* hb, const bf16_t* Y, const int* tok_dest, const float* tok_g, const float* lg, const float* lb, float* outf, bf16_t* hcopy) {
    const int wave = TIDX >> 6, lane = TIDX & 63;
    for (int t0 = (blockIdx.x * NWAVES + wave) * 8; t0 < T_; t0 += gridDim.x * NWAVES * 8) {
        const int dl = lane < 16 ? tok_dest[2 * t0 + lane] : 0;
        const float gl = lane < 16 ? tok_g[2 * t0 + lane] : 0.f;
#pragma unroll 1
        for (int i = 0; i < 8; i += 2) {
            f32x4 v[2][4];
#pragma unroll
            for (int rr = 0; rr < 2; ++rr) {
                const int t = t0 + i + rr;
                const int d0 = __shfl(dl, 2 * (i + rr)), d1 = __shfl(dl, 2 * (i + rr) + 1);
                const float g0 = __shfl(gl, 2 * (i + rr)), g1 = __shfl(gl, 2 * (i + rr) + 1);
#pragma unroll
                for (int j = 0; j < 4; ++j) {
                    const u32x2 hv = ((const u32x2*)(hb + (size_t)t * D_))[lane + 64 * j];
                    f32x4 h; h.x = __uint_as_float(hv.x << 16); h.y = __uint_as_float(hv.x & 0xffff0000u); h.z = __uint_as_float(hv.y << 16); h.w = __uint_as_float(hv.y & 0xffff0000u);
                    const u32x2 y0 = ((const u32x2*)(Y + (size_t)d0 * D_))[lane + 64 * j], y1 = ((const u32x2*)(Y + (size_t)d1 * D_))[lane + 64 * j];
                    f32x4 a, b;
                    a.x = __uint_as_float(y0.x << 16); a.y = __uint_as_float(y0.x & 0xffff0000u); a.z = __uint_as_float(y0.y << 16); a.w = __uint_as_float(y0.y & 0xffff0000u);
                    b.x = __uint_as_float(y1.x << 16); b.y = __uint_as_float(y1.x & 0xffff0000u); b.z = __uint_as_float(y1.y << 16); b.w = __uint_as_float(y1.y & 0xffff0000u);
                    v[rr][j] = h * DN_ALPHA + (a * g0 + b * g1);
                }
            }
            float sm[2], s2[2];
#pragma unroll
            for (int rr = 0; rr < 2; ++rr) { sm[rr] = 0.f;
#pragma unroll
                for (int j = 0; j < 4; ++j) sm[rr] += (v[rr][j].x + v[rr][j].y) + (v[rr][j].z + v[rr][j].w); }
#pragma unroll
            for (int o = 1; o < 64; o <<= 1) { sm[0] += __shfl_xor(sm[0], o); sm[1] += __shfl_xor(sm[1], o); }
#pragma unroll
            for (int rr = 0; rr < 2; ++rr) { const float mean = sm[rr] * (1.f / D_); s2[rr] = 0.f;
#pragma unroll
                for (int j = 0; j < 4; ++j) { v[rr][j] = v[rr][j] - mean; s2[rr] += (v[rr][j].x * v[rr][j].x + v[rr][j].y * v[rr][j].y) + (v[rr][j].z * v[rr][j].z + v[rr][j].w * v[rr][j].w); } }
#pragma unroll
            for (int o = 1; o < 64; o <<= 1) { s2[0] += __shfl_xor(s2[0], o); s2[1] += __shfl_xor(s2[1], o); }
#pragma unroll
            for (int rr = 0; rr < 2; ++rr) {
                const int t = t0 + i + rr;
                const float rstd = rsqrtf(s2[rr] * (1.f / D_) + LN_EPS);
#pragma unroll
                for (int j = 0; j < 4; ++j) {
                    const f32x4 g = ((const f32x4*)lg)[lane + 64 * j], bb = ((const f32x4*)lb)[lane + 64 * j];
                    const f32x4 o4 = v[rr][j] * rstd * g + bb;
                    if (LAST) ((f32x4*)(outf + (size_t)t * D_))[lane + 64 * j] = o4;
                    else { u32x2 o; o.x = pk2(o4.x, o4.y); o.y = pk2(o4.z, o4.w);
                           ((u32x2*)(hb + (size_t)t * D_))[lane + 64 * j] = o; ((u32x2*)(hcopy + (size_t)t * D_))[lane + 64 * j] = o; }
                }
            }
        }
    }
}

__device__ __forceinline__ void naive_s5_scan(const bf16_t* P1, const float* a_re, const float* a_im, const float* log_dt, const float* b_re, const float* b_im,
                                              const float* c_re, const float* c_im, const float* dvec, float* YS5, bf16_t* YS5B, int pair) {
    const int lane = TIDX & 63;
    const int b = pair >> 5, g = pair & 31, n = lane;
    const float lam_re = fminf(a_re[g * 64 + n], -1e-4f), lam_im = a_im[g * 64 + n];
    const float dt = __expf(log_dt[g]);
    const float mag = __expf(lam_re * dt);
    const float ab_re = mag * cosf(lam_im * dt), ab_im = mag * sinf(lam_im * dt);
    const float den = lam_re * lam_re + lam_im * lam_im;
    const float num_re = ab_re - 1.f;
    const float z_re = (num_re * lam_re + ab_im * lam_im) / den;
    const float z_im = (ab_im * lam_re - num_re * lam_im) / den;
    float bre[16], bim[16], cre[16], cim[16];
#pragma unroll
    for (int c = 0; c < 16; ++c) {
        bre[c] = b_re[(size_t)(g * 64 + n) * 16 + c]; bim[c] = b_im[(size_t)(g * 64 + n) * 16 + c];
        cre[c] = c_re[(size_t)(g * 16 + c) * 64 + n]; cim[c] = c_im[(size_t)(g * 16 + c) * 64 + n];
    }
    const float dd = (lane < 16) ? dvec[g * 16 + lane] : 0.f;
    float h_re = 0.f, h_im = 0.f;
    for (int tt = 0; tt < L_; ++tt) {
        const size_t t = (size_t)b * L_ + tt;
        const float ul = (lane < 16) ? bf2f(P1[t * NIN1 + g * 16 + lane]) : 0.f;
        float bur = 0.f, bui = 0.f;
#pragma unroll
        for (int c = 0; c < 16; ++c) { const float u = __shfl(ul, c); bur += u * bre[c]; bui += u * bim[c]; }
        const float x_re = z_re * bur - z_im * bui, x_im = z_re * bui + z_im * bur;
        const float nh_re = ab_re * h_re - ab_im * h_im + x_re;
        const float nh_im = ab_re * h_im + ab_im * h_re + x_im;
        h_re = nh_re; h_im = nh_im;
        float yv = 0.f;
#pragma unroll
        for (int c = 0; c < 16; ++c) { const float y = wave_sum(h_re * cre[c] - h_im * cim[c]); if (lane == c) yv = y; }
        if (lane < 16) {
            const float y = gelu_tanh(yv + dd * ul);
            YS5[t * 512 + g * 16 + lane] = y;
            YS5B[t * 512 + g * 16 + lane] = f2bf(y);
        }
    }
}

__device__ __forceinline__ void ph_fin1(const float* OG, const bf16_t* P1, const float* norm_g, bf16_t* Ymix) {
    const int wave = TIDX >> 6, lane = TIDX & 63;
    for (int item = blockIdx.x * NWAVES + wave; item < T_ * 4; item += gridDim.x * NWAVES) {
        const int t = item >> 2, h = item & 3;
        const float o0 = OG[(size_t)t * 512 + h * 128 + lane], o1 = OG[(size_t)t * 512 + h * 128 + 64 + lane];
        const float ms = wave_sum(o0 * o0 + o1 * o1) * (1.f / 128.f);
        const float rs = rsqrtf(ms + LN_EPS);
        const float g0 = bf2f(P1[(size_t)t * NIN1 + 2048 + h * 128 + lane]), g1 = bf2f(P1[(size_t)t * NIN1 + 2048 + h * 128 + 64 + lane]);
        Ymix[(size_t)t * D_ + 512 + h * 128 + lane] = f2bf(o0 * rs * norm_g[lane] * siluf(g0));
        Ymix[(size_t)t * D_ + 512 + h * 128 + 64 + lane] = f2bf(o1 * rs * norm_g[64 + lane] * siluf(g1));
    }
}

constexpr int LDS_BYTES = 147456;
constexpr int MISC_OFF = 131072 + 8192;
enum Phase {
    PH_PROLOGUE = 0,
    PH_INPROJ0, PH_PREPA0, PH_LORA0, PH_PREPB0, PH_SCAN0, PH_SCAN0B, PH_FIN0, PH_OUTPROJ0, PH_LN1_0, PH_DISP0, PH_UP0, PH_DOWN0, PH_COMB0,
    PH_INPROJ1, PH_L1A, PH_L1C, PH_L1D,
#if !(FAST_HG && FAST_S5)
    PH_SCAN1, PH_FIN1,
#endif
    PH_GLU1, PH_OUTPROJ1, PH_LN1_1, PH_DISP1, PH_UP1, PH_DOWN1, PH_COMB1,
    PH_COUNT
};

typedef const Args __attribute__((address_space(4)))* KArgsP;
__device__ __forceinline__ KArgsP fresh_args() { KArgsP p = (KArgsP)__builtin_amdgcn_kernarg_segment_ptr(); asm volatile("" : "+s"(p)); return p; }
#define PHASE_BEGIN KArgsP ap = fresh_args(); unsigned char* const ws = ap->ws; (void)ws;
#define INP(i) (ap->in[i])
#define W_CTL ((unsigned*)(ws + WS_CTL))
#define W_HB ((bf16_t*)(ws + WS_HB))
#define W_WIN0 ((bf16_t*)(ws + WS_WIN0))
#define W_WOUT0 ((bf16_t*)(ws + WS_WOUT0))
#define W_WIN1 ((bf16_t*)(ws + WS_WIN1))
#define W_WOUT1 ((bf16_t*)(ws + WS_WOUT1))
#define W_WGLU ((bf16_t*)(ws + WS_WGLU))
#define W_WLORA ((bf16_t*)(ws + WS_WLORA))
#define W_WROUTER ((bf16_t*)(ws + WS_WROUTER))
#define W_W13 ((bf16_t*)(ws + WS_W13))
#define W_W2 ((bf16_t*)(ws + WS_W2))
#define W_HA ((float*)(ws + WS_HA))
#define W_YRW W_HA
#define W_OG (W_HA + (size_t)T_ * 512)
#define W_P ((bf16_t*)(ws + WS_P))
#define W_LO ((bf16_t*)(ws + WS_LO))
#define W_SC ((bf16_t*)(ws + WS_SCAN))
#define W_GLALA ((float*)(ws + WS_GLALA))
#define W_BON ((float*)(ws + WS_BON))
#define W_AP ((bf16_t*)(ws + WS_APRIME))
#define W_YS5B ((bf16_t*)(ws + WS_YS5B))
#define W_XR ((bf16_t*)(ws + WS_XR))
#define W_HID ((bf16_t*)(ws + WS_HID))
#define W_Y ((bf16_t*)(ws + WS_Y))
#define W_TOKE ((int*)(ws + WS_ROUTE))
#define W_TOKSLOT (W_TOKE + 2 * T_)
#define W_TOKDEST (W_TOKE + 4 * T_)
#define W_TOKG ((float*)(W_TOKE + 6 * T_))
#define W_ROWTOK (W_TOKE + 8 * T_)
#define W_YMIX W_HB
#define BIGP(mib) (ws + WS_BIG + (size_t)(mib) * MiB)
#define GLA0_BUFS GlaBufs{(bf16_t*)BIGP(256), (bf16_t*)BIGP(264), (bf16_t*)(ws + WS_HB), (bf16_t*)BIGP(273), (float*)BIGP(289), W_HA + (size_t)T_ * 512, (bf16_t*)BIGP(112)}
#define HG_BUFS GlaBufs{(bf16_t*)BIGP(96), (bf16_t*)BIGP(112), (bf16_t*)BIGP(144), (bf16_t*)BIGP(128), (float*)BIGP(192), (void*)BIGP(252), (bf16_t*)BIGP(160)}
#define W_S5WE ((bf16_t*)BIGP(244))
#define W_S5UA ((bf16_t*)BIGP(201))
#define W_S5MB ((bf16_t*)BIGP(224))
#define W_S5E ((float*)BIGP(193))
#define CW_SUB 12288

#define IN(k) (PLO <= (k) && (k) < PHI)
#define SEAM(k) do { if (IN(k) && IN((k) + 1)) { PHASE_BEGIN XcdBarrier bar_; bar_.bar = W_CTL + CW_BAR; bar_.x = xb_xcc_id(); bar_.st = (volatile LAS unsigned*)(lds + MISC_OFF) + 8; xcd_barrier(bar_); } } while (0)
template <int PLO, int PHI, int layer>
__device__ __forceinline__ void moe_layer(LAS unsigned char* lds) {
    LAS float* ldsf = (LAS float*)lds; (void)ldsf;
        const int base = layer == 0 ? PH_OUTPROJ0 : PH_OUTPROJ1;
        if (IN(base + 0)) {
            PHASE_BEGIN
            bf16_t* V1b = (bf16_t*)W_HA;
            if (layer == 0) { pg8::Gemm g{W_YMIX, W_WOUT0, T_, D_, D_}; pg8::StaticOrder S; S.init(T_, D_, (int)gridDim.x, (int)blockIdx.x); pg8::EpiResidBf16<false> E{INP(0), V1b, D_, DN_ALPHA};
                              pg8::gemm_phase<pg8::EpiResidBf16<false>, pg8::StaticOrder, true, true>(lds, g, S, E); }
            else { pg8::Gemm g{W_YMIX, W_WOUT1, T_, D_, D_}; pg8::StaticOrder S; S.init(T_, D_, (int)gridDim.x, (int)blockIdx.x); pg8::EpiResidBf16<true> E{(const bf16_t*)W_HA + (size_t)T_ * D_, V1b, D_, DN_ALPHA};
                   pg8::gemm_phase<pg8::EpiResidBf16<true>, pg8::StaticOrder, true, true>(lds, g, S, E); }
        }
        SEAM(base + 0);
        if (IN(base + 1)) {
            PHASE_BEGIN
            ph_ln_router2(lds, (const bf16_t*)W_HA, W_HB, INP(31) + layer * D_, INP(32) + layer * D_, W_WROUTER + (size_t)layer * 48 * 1024, INP(34) + layer * 4, INP(36) + layer * 32,
                          W_TOKE, W_TOKSLOT, W_TOKG, W_CTL + CW_CNT + 64 * layer);
        }
        SEAM(base + 1);
        if (IN(base + 2)) { PHASE_BEGIN ph_dispatch2((LAS int*)lds, W_CTL + CW_CNT + 64 * layer, W_TOKE, W_TOKSLOT, W_TOKDEST, W_ROWTOK); }
        SEAM(base + 2);
        if (IN(base + 3)) {
            PHASE_BEGIN
#if FAST_GEMM
            { LAS int* pst = (LAS int*)(lds + 131072 + 1792); LAS int* tile_e = (LAS int*)(lds + 131072 + 1024); LAS int* rowl = (LAS int*)(lds + 131072 + 2048);
              moe_offsets(pst, W_CTL + CW_CNT + 64 * layer);
              const int ntiles = pst[32] / 256;
              if ((int)TIDX < ntiles) tile_e[TIDX] = moe_expert_of_row(pst, TIDX * 256);
              { const int* rt = W_ROWTOK;
                for (int i = 0; i < 3; ++i) { const int L = i * (int)gridDim.x + (int)blockIdx.x; if (L < ntiles * 4 && TIDX < 256) rowl[i * 256 + TIDX] = rt[(L >> 2) * 256 + TIDX]; } }
              __syncthreads();
              pg8::Gemm g{W_HB, W_W13, ntiles * 256, 1024, D_, D_, rowl}; pg8::MoeOrder S{ntiles, 4, (int)gridDim.x, (int)blockIdx.x, tile_e}; pg8::EpiSwiglu E{W_HID};
              pg8::gemm_phase<pg8::EpiSwiglu, pg8::MoeOrder, true, true>(lds, g, S, E); }
#else
            LAS int* pst = (LAS int*)(lds + 65536);
            moe_offsets(pst, W_CTL + CW_CNT + 64 * layer);
            const float* w1 = INP(37) + (size_t)layer * 32 * D_ * 512; const float* w3 = INP(38) + (size_t)layer * 32 * D_ * 512;
            const bf16_t* XR = W_XR; bf16_t* HID = W_HID;
            naive_gemm<true>(ldsf, pst[32], 512, D_, [&](int m) { return XR + (size_t)m * D_; },
                             [&](int m0, int which) { const int e = moe_expert_of_row(pst, m0); return (which ? w3 : w1) + (size_t)e * D_ * 512; }, 512,
                             [&](int m, int n, float a, float b) { HID[(size_t)m * 512 + n] = f2bf(siluf(a) * b); });
#endif
        }
        SEAM(base + 3);
        if (IN(base + 4)) {
            PHASE_BEGIN
#if FAST_GEMM
            { LAS int* pst = (LAS int*)(lds + 131072 + 1792); LAS int* tile_e = (LAS int*)(lds + 131072 + 1024);
              moe_offsets(pst, W_CTL + CW_CNT + 64 * layer);
              const int ntiles = pst[32] / 256;
              if ((int)TIDX < ntiles) tile_e[TIDX] = moe_expert_of_row(pst, TIDX * 256);
              __syncthreads();
              pg8::Gemm g{W_HID, W_W2, ntiles * 256, 1024, 512}; pg8::MoeOrder S{ntiles, 4, (int)gridDim.x, (int)blockIdx.x, tile_e}; pg8::EpiStoreBf16 E{W_Y, D_, 0, 0};
              pg8::gemm_phase<pg8::EpiStoreBf16, pg8::MoeOrder, true, true>(lds, g, S, E); }
#else
            LAS int* pst = (LAS int*)(lds + 65536);
            moe_offsets(pst, W_CTL + CW_CNT + 64 * layer);
            const float* w2 = INP(39) + (size_t)layer * 32 * 512 * D_;
            const bf16_t* HID = W_HID; bf16_t* Y = W_Y;
            naive_gemm<false>(ldsf, pst[32], D_, 512, [&](int m) { return HID + (size_t)m * 512; },
                              [&](int m0, int) { const int e = moe_expert_of_row(pst, m0); return w2 + (size_t)e * 512 * D_; }, D_,
                              [&](int m, int n, float a, float) { Y[(size_t)m * D_ + n] = f2bf(a); });
#endif
        }
        SEAM(base + 4);
        if (IN(base + 5)) { PHASE_BEGIN ph_combine_ln<layer == 1>(W_HB, W_Y, W_TOKDEST, W_TOKG, INP(40) + layer * D_, INP(41) + layer * D_, ap->out, (bf16_t*)W_HA + (size_t)T_ * D_); }
        SEAM(base + 5);

}

template <int PLO, int PHI>
__device__ __forceinline__ void mega_body(unsigned char* lds_raw) {
    LAS unsigned char* lds = (LAS unsigned char*)lds_raw;
    LAS float* ldsf = (LAS float*)lds;
    constexpr bool MULTI = (PHI - PLO) > 1;
    if (MULTI) {
        PHASE_BEGIN
        volatile LAS unsigned* MISC = (volatile LAS unsigned*)(lds + MISC_OFF);
        if (TIDX < 32) MISC[TIDX] = 0u;
        __syncthreads();
        (void)xcd_barrier_post(W_CTL + CW_BAR, MISC + 8);
    }

    if (IN(PH_PROLOGUE)) {
        PHASE_BEGIN ph_prologue(INP(0), W_HB);
#if FAST_GEMM
        LAS float* scr = ldsf + (TIDX >> 6) * (64 * 33);
        const int gw = blockIdx.x * NWAVES + (TIDX >> 6), ngw = gridDim.x * NWAVES, lane = TIDX & 63;
        convert_plain(INP(1), D_, NIN0, NIN0P, W_WIN0, scr, gw, ngw, lane);
        convert_plain(INP(16), D_, D_, D_, W_WOUT0, scr, gw, ngw, lane);
        convert_plain(INP(17), D_, NIN1, NIN1, W_WIN1, scr, gw, ngw, lane);
        convert_plain(INP(30), D_, D_, D_, W_WOUT1, scr, gw, ngw, lane);
        convert_plain(INP(26), 512, 512, 512, W_WGLU, scr, gw, ngw, lane);
        convert_lora(INP(4), INP(6), INP(7), W_WLORA, scr, gw, ngw, lane);
        convert_router(INP(33), INP(35), W_WROUTER, blockIdx.x * NTHREADS + TIDX, gridDim.x * NTHREADS);
        convert_moe(INP(37), INP(38), INP(39), W_W13, W_W2, scr, gw, ngw, lane);
#endif
    }
    SEAM(PH_PROLOGUE);
    if (IN(PH_INPROJ0)) {
        PHASE_BEGIN
#if FAST_GEMM
        { pg8::Gemm g{W_HB, W_WIN0, T_, NIN0P, D_}; pg8::StaticOrder S; S.init(T_, NIN0P, (int)gridDim.x, (int)blockIdx.x); pg8::EpiStoreBf16 E{W_P, NIN0P, 0, 0};
          pg8::gemm_phase<pg8::EpiStoreBf16, pg8::StaticOrder, true, true>(lds, g, S, E); }
#else
        const float* W = INP(1); const bf16_t* A = W_HB; bf16_t* P = W_P;
        naive_gemm<false>(ldsf, T_, NIN0, D_, [&](int m) { return A + (size_t)m * D_; }, [&](int, int) { return W; }, NIN0,
                          [&](int m, int n, float a, float) { P[(size_t)m * NIN0P + n] = f2bf(a); });
#endif
    }
    SEAM(PH_INPROJ0);
#if FAST_GLA0
    if (IN(PH_PREPA0)) { PHASE_BEGIN ph_prepA0v(W_P, INP(2), W_AP); }
#else
    if (IN(PH_PREPA0)) { PHASE_BEGIN ph_prepA0<!FAST_GLA0>(W_P, INP(2), INP(13), INP(14), W_AP, W_GLALA); }
#endif
    SEAM(PH_PREPA0);
    if (IN(PH_LORA0)) {
        PHASE_BEGIN
#if FAST_GEMM
        { pg8::Gemm g{W_AP, W_WLORA, T_, NLORA, 256}; pg8::StaticOrder S; S.init(T_, NLORA, (int)gridDim.x, (int)blockIdx.x); pg8::EpiStoreBf16 E{W_LO, 512, 512, (size_t)T_ * 512};
          pg8::gemm_phase<pg8::EpiStoreBf16, pg8::StaticOrder, true, true>(lds, g, S, E); }
#else
        const float* w2 = INP(4); const float* a2 = INP(6); const float* g2 = INP(7); const bf16_t* AP = W_AP; bf16_t* LO = W_LO;
        naive_gemm<false>(ldsf, T_, 512, 64, [&](int m) { return AP + (size_t)m * 256; }, [&](int, int) { return w2; }, 512,
                          [&](int m, int n, float a, float) { LO[(size_t)m * 512 + n] = f2bf(a); });
        naive_gemm<false>(ldsf, T_, 512, 64, [&](int m) { return AP + (size_t)m * 256 + 64; }, [&](int, int) { return a2; }, 512,
                          [&](int m, int n, float a, float) { LO[(size_t)T_ * 512 + (size_t)m * 512 + n] = f2bf(a); });
        naive_gemm<false>(ldsf, T_, 512, 128, [&](int m) { return AP + (size_t)m * 256 + 128; }, [&](int, int) { return g2; }, 512,
                          [&](int m, int n, float a, float) { LO[(size_t)2 * T_ * 512 + (size_t)m * 512 + n] = f2bf(a); });
#endif
    }
    SEAM(PH_LORA0);
    if (IN(PH_PREPB0)) {
        PHASE_BEGIN ph_prepB0v(W_P, W_LO, INP(2), INP(3), INP(5), INP(8), INP(9), INP(10), W_SC, W_BON);
#if FAST_GLA0
        { const GlaBufs GB = GLA0_BUFS; __syncthreads();
          const int wave = TIDX >> 6, lane = TIDX & 63;
          for (int cg = blockIdx.x; cg < 256; cg += gridDim.x) {
              gla_prep_tile<64, 0>(ldsf, W_P, INP(13), INP(14), GB, cg);
              asm volatile("s_waitcnt vmcnt(0)" ::: "memory"); __syncthreads();
              for (int u = wave; u < 16; u += NWAVES) gla_pass1_unit<64, false>(GB, cg * 16 + u, lane);
          } }
#endif
    }
    SEAM(PH_PREPB0);
#if FAST_RWKV == 2
#define RW_G ((bf16_t*)BIGP(128))
#define RW_RM ((bf16_t*)ap->out)
#define RW_HT (ap->out + (size_t)4 * 1024 * 1024)
#define RW_YM ((bf16_t*)(ap->out + (size_t)12 * 1024 * 1024))
    if (IN(PH_SCAN0)) {
        PHASE_BEGIN
        { u32x4 raw[6], nraw[6];
          int it = blockIdx.x;
          if (it < 2048) rwkv_raw_load(W_SC, it, TIDX, raw);
          for (; it < 2048; it += gridDim.x) {
              const int nit = it + (int)gridDim.x < 2048 ? it + (int)gridDim.x : -1;
              rwkv_chunk_pre(lds, W_SC, RW_G, RW_RM, RW_HT, RW_YM, it, raw, nit, nraw);
#pragma unroll
              for (int a = 0; a < 6; ++a) raw[a] = nraw[a];
          } }
    }
    SEAM(PH_SCAN0);
    if (IN(PH_SCAN0B)) {
        PHASE_BEGIN
        const int bid = blockIdx.x;
        if (bid < 64) rwkv_chunk_seq2(lds, RW_G, RW_RM, RW_HT, RW_YM, W_YRW, bid);
#if FAST_S5
        else if (bid < 96) s5_tables(ldsf, INP(18), INP(19), INP(20), INP(21), INP(22), INP(23), INP(24), W_S5MB, W_S5WE, bid - 64);
#endif
        else {
            const GlaBufs GB = GLA0_BUFS;
            const int nb = (int)gridDim.x - 96, b0 = bid - 96;
            gla_pass2<64, false>(GB, b0 * NTHREADS + TIDX, nb * NTHREADS);
            sub_barrier(W_CTL + CW_SUB + 64, (unsigned)nb);
            for (int it = b0; it < 1024; it += nb) gla_pass3_item<64, 0>(lds, W_P, INP(15), GB, W_YMIX, it);
#ifdef PROBE_B_GLA2
            gla_pass2<64, false>(GB, b0 * NTHREADS + TIDX, nb * NTHREADS);
#endif
#ifdef PROBE_B_GLA3
            for (int it = b0; it < 1024; it += nb) gla_pass3_item<64, 0>(lds, W_P, INP(15), GB, W_YMIX, it);
#endif
        }
    }
    SEAM(PH_SCAN0B);
#else
    if (IN(PH_SCAN0)) {
        PHASE_BEGIN
        const int bid = blockIdx.x;
#if FAST_RWKV
        constexpr int NRW = 128;
        if (bid < NRW) rwkv_scan_v1(ldsf, W_SC, W_YRW, bid);
#else
        constexpr int NRW = 16;
        if (bid < NRW) naive_rwkv_scan(ldsf, W_SC, W_YRW, bid);
#endif
#if FAST_GLA0
        else {
            const GlaBufs GB = GLA0_BUFS;
            const int nb = (int)gridDim.x - NRW, b0 = bid - NRW, wave = TIDX >> 6, lane = TIDX & 63;
            for (int u = b0 * NWAVES + wave; u < 1024 * 4; u += nb * NWAVES) gla_pass1_unit<64, false>(GB, u, lane);
            sub_barrier(W_CTL + CW_SUB, (unsigned)nb);
            gla_pass2<64, false>(GB, b0 * NTHREADS + TIDX, nb * NTHREADS);
            sub_barrier(W_CTL + CW_SUB + 64, (unsigned)nb);
            for (int it = b0; it < 1024; it += nb) gla_pass3_item<64, 0>(lds, W_P, INP(15), GB, W_YMIX, it);
        }
#else
        else if (bid < 24) {
            const int bh = bid - 16;
            const bf16_t* P = W_P; const float* GLALA = W_GLALA;
            naive_gla_scan<64>(ldsf,
                [&](int t, int ck, float& q, float& kk, float& e) {
                    q = bf2f(P[(size_t)t * NIN0P + 1792 + ck]) * 0.125f; kk = bf2f(P[(size_t)t * NIN0P + 2048 + ck]); e = __expf(GLALA[(size_t)t * 256 + ck]); },
                [&](int t, int cv) { return bf2f(P[(size_t)t * NIN0P + 2304 + cv]); }, W_OG, bh >> 2, bh & 3);
        }
#endif
    }
    SEAM(PH_SCAN0);
    SEAM(PH_SCAN0B);
#endif
#if FAST_GLA0
    if (IN(PH_FIN0)) { PHASE_BEGIN ph_fin0v(W_YRW, W_LO, W_SC, W_BON, INP(11), INP(12), W_YMIX); }
#else
    if (IN(PH_FIN0)) { PHASE_BEGIN ph_fin0<!FAST_GLA0>(W_YRW, W_OG, W_P, W_LO, W_SC, W_BON, INP(11), INP(12), INP(15), W_YMIX); }
#endif
    SEAM(PH_FIN0);

    moe_layer<PLO, PHI, 0>(lds);
            if (IN(PH_INPROJ1)) {
                PHASE_BEGIN
#if FAST_GEMM
                { pg8::Gemm g{W_HB, W_WIN1, T_, NIN1, D_}; pg8::StaticOrder S; S.init(T_, NIN1, (int)gridDim.x, (int)blockIdx.x); pg8::EpiInproj1 E{W_P, W_S5UA};
                  pg8::gemm_phase<pg8::EpiInproj1, pg8::StaticOrder, true, true>(lds, g, S, E); }
#else
                const float* W = INP(17); const bf16_t* A = W_HB; bf16_t* P = W_P;
                naive_gemm<false>(ldsf, T_, NIN1, D_, [&](int m) { return A + (size_t)m * D_; }, [&](int, int) { return W; }, NIN1,
                                  [&](int m, int n, float a, float) { P[(size_t)m * NIN1 + n] = f2bf(a); });
#endif
            }
            SEAM(PH_INPROJ1);
            if (IN(PH_L1A)) {
                PHASE_BEGIN
                const int bid = blockIdx.x;
#if FAST_S5
                if (bid < 64) {
                    LAS int* tile_e = (LAS int*)(lds + 131072 + 1024);
                    if (TIDX < 64) tile_e[TIDX] = TIDX >> 1;
                    __syncthreads();
                    pg8::Gemm g{W_S5UA, W_S5WE, 64 * 256, 256, 512, 640}; pg8::MoeOrder S{64, 1, 64, bid, tile_e}; pg8::EpiStoreF32Half E{W_S5E};
                    pg8::gemm_phase<pg8::EpiStoreF32Half, pg8::MoeOrder, true, true>(lds, g, S, E);
                }
#endif
#if FAST_HG
                { const GlaBufs GB = HG_BUFS; const int wave = TIDX >> 6, lane = TIDX & 63;
                  for (int cg = bid; cg < 256; cg += gridDim.x) {
                      gla_prep_tile<128, 1>(ldsf, W_P, INP(28), nullptr, GB, cg);
                      asm volatile("s_waitcnt vmcnt(0)" ::: "memory"); __syncthreads();
                      for (int u = wave; u < 32; u += NWAVES) gla_pass1_unit<128, true>(GB, cg * 32 + u, lane);
                  } }
#endif
            }
            SEAM(PH_L1A);
            if (IN(PH_L1C)) {
                PHASE_BEGIN
                const int bid = blockIdx.x;
#if FAST_S5
                if (bid < 8) s5_carry(INP(18), INP(19), INP(20), W_S5E, W_S5UA, bid * NTHREADS + TIDX);
#endif
#if FAST_HG
                if (bid >= 8) { const GlaBufs GB = HG_BUFS; gla_pass2<128, true>(GB, (bid - 8) * NTHREADS + TIDX, ((int)gridDim.x - 8) * NTHREADS); }
#endif
#if FAST_GEMM
                { LAS float* scr = ldsf + (TIDX >> 6) * (64 * 33);
                  convert_moe(INP(37) + (size_t)32 * D_ * 512, INP(38) + (size_t)32 * D_ * 512, INP(39) + (size_t)32 * 512 * D_, W_W13, W_W2, scr,
                              bid * NWAVES + (TIDX >> 6), (int)gridDim.x * NWAVES, TIDX & 63); }
#endif
            }
            SEAM(PH_L1C);
            if (IN(PH_L1D)) {
                PHASE_BEGIN
                const int bid = blockIdx.x;
#if FAST_S5
                if (bid < 64) {
                    LAS int* tile_e = (LAS int*)(lds + 131072 + 1024);
                    if (TIDX < 64) tile_e[TIDX] = TIDX >> 1;
                    __syncthreads();
                    pg8::Gemm g{W_S5UA, W_S5MB, 64 * 256, 512, 640, 640}; pg8::MoeOrder S{64, 2, 64, bid, tile_e}; pg8::EpiS5Y E{W_P, INP(25), W_YRW, W_YS5B};
                    pg8::gemm_phase<pg8::EpiS5Y, pg8::MoeOrder, true, true>(lds, g, S, E);
                }
#endif
#if FAST_HG
                if (bid >= 64) {
                    const GlaBufs GB = HG_BUFS;
                    for (int it = bid - 64; it < 1024; it += (int)gridDim.x - 64) gla_pass3_item<128, 1>(lds, W_P, INP(29), GB, W_YMIX, it);
                }
#endif
            }
            SEAM(PH_L1D);
#if !(FAST_HG && FAST_S5)
            if (IN(PH_SCAN1)) {
                PHASE_BEGIN
                const int bid = blockIdx.x;
                const bf16_t* P = W_P; (void)P; (void)bid;
#if !FAST_HG
                if (bid < 8) {
                    const float* hg_lb = INP(28);
                    naive_gla_scan<128>(ldsf,
                        [&](int t, int ck, float& q, float& kk, float& e) {
                            const float l0 = hg_lb[ck], l1 = hg_lb[512 + ck];
                            const float lbv = 1.f / (1.f + __expf(l0 - l1));
                            const float f = bf2f(P[(size_t)t * NIN1 + 1024 + ck]);
                            const float sg = sigm(f);
                            q = siluf(bf2f(P[(size_t)t * NIN1 + 512 + ck])); kk = (1.f - lbv) * (1.f - sg); e = lbv + (1.f - lbv) * sg; },
                        [&](int t, int cv) { return bf2f(P[(size_t)t * NIN1 + 1536 + cv]); }, W_OG, bid >> 2, bid & 3);
                }
#endif
#if !FAST_S5
                if (bid >= 8 && bid < 16) {
                    const int pair = (bid - 8) * 8 + (TIDX >> 6);
                    naive_s5_scan(P, INP(18), INP(19), INP(20), INP(21), INP(22), INP(23), INP(24), INP(25), W_YRW, W_YS5B, pair);
                }
#endif
            }
            SEAM(PH_SCAN1);
#if !FAST_HG
            if (IN(PH_FIN1)) { PHASE_BEGIN ph_fin1(W_OG, W_P, INP(29), W_YMIX); }
#endif
            SEAM(PH_FIN1);
#endif
            if (IN(PH_GLU1)) {
                PHASE_BEGIN
#if FAST_GEMM
                { pg8::Gemm g{W_YS5B, W_WGLU, T_, 512, 512}; pg8::StaticOrder S; S.init(T_, 512, (int)gridDim.x, (int)blockIdx.x); pg8::EpiGlu E{W_YRW, 512, INP(27), W_YMIX, D_};
                  pg8::gemm_phase<pg8::EpiGlu, pg8::StaticOrder, true, true>(lds, g, S, E); }
#else
                const float* W = INP(26); const float* gb = INP(27); const bf16_t* YS5B = W_YS5B; const float* YRW = W_YRW; bf16_t* Ymix = W_YMIX;
                naive_gemm<false>(ldsf, T_, 512, 512, [&](int m) { return YS5B + (size_t)m * 512; }, [&](int, int) { return W; }, 512,
                                  [&](int m, int n, float a, float) { const float y = YRW[(size_t)m * 512 + n]; Ymix[(size_t)m * D_ + n] = f2bf(y * sigm(a + gb[n])); });
#endif
            }
            SEAM(PH_GLU1);
    moe_layer<PLO, PHI, 1>(lds);
#undef IN
}
template <int PLO, int PHI>
__global__ void __launch_bounds__(NTHREADS, 2) mega(Args args) {
    extern __shared__ __attribute__((aligned(16))) unsigned char lds_raw[];
    mega_body<PLO, PHI>(lds_raw);
}

#include <utility>
template <int... I> static void set_attrs(std::integer_sequence<int, I...>) {
    (void)std::initializer_list<int>{ ((void)hipFuncSetAttribute((const void*)mega<I, I + 1>, hipFuncAttributeMaxDynamicSharedMemorySize, LDS_BYTES), 0)... };
}
#ifndef DUP_MASK
#define DUP_MASK 0ull
#endif
template <int I> static int launch_one(int grid, hipStream_t stream, const Args& a) {
    hipLaunchKernelGGL((mega<I, I + 1>), dim3(grid), dim3(NTHREADS), LDS_BYTES, stream, a);
    if ((DUP_MASK >> I) & 1ull) hipLaunchKernelGGL((mega<I, I + 1>), dim3(grid), dim3(NTHREADS), LDS_BYTES, stream, a);
    return 0;
}
template <int... I> static void launch_all(std::integer_sequence<int, I...>, int grid, hipStream_t stream, const Args& a) {
    (void)std::initializer_list<int>{ launch_one<I>(grid, stream, a)... };
}
extern "C" void kernel_launch(void* const* d_in, const int* in_sizes, int n_in, void* d_out, int out_size, void* d_ws, size_t ws_size, hipStream_t stream) {
    static int grid = 0;
    if (grid == 0) {
        if (n_in != 42 || out_size != T_ * D_ || ws_size < WS_END) { fprintf(stderr, "kernel_launch: unexpected shapes n_in %d out %d ws %zu\n", n_in, out_size, ws_size); grid = -1; return; }
        int dev = 0, cus = 0, per_cu = 0;
        hipGetDevice(&dev);
        hipDeviceGetAttribute(&cus, hipDeviceAttributeMultiprocessorCount, dev);
        set_attrs(std::make_integer_sequence<int, PH_COUNT>{});
        hipFuncSetAttribute((const void*)mega<0, PH_COUNT>, hipFuncAttributeMaxDynamicSharedMemorySize, LDS_BYTES);
        hipOccupancyMaxActiveBlocksPerMultiprocessor(&per_cu, (const void*)mega<0, PH_COUNT>, NTHREADS, LDS_BYTES);
        (void)hipGetLastError();
        if (per_cu < 1) per_cu = 1;
        grid = cus * 1;
        fprintf(stderr, "kernel_launch: cus %d per_cu %d grid %d\n", cus, per_cu, grid);
    }
    if (grid < 0) return;
    hipMemsetAsync((char*)d_ws + WS_CTL, 0, CTL_ZERO_BYTES, stream);
    Args a{};
    for (int i = 0; i < 42; ++i) a.in[i] = (const float*)d_in[i];
    a.out = (float*)d_out; a.ws = (unsigned char*)d_ws;
#if MK_SINGLE
    void* kargs[] = {(void*)&a};
    hipError_t e = hipLaunchCooperativeKernel((const void*)mega<0, PH_COUNT>, dim3(grid), dim3(NTHREADS), kargs, LDS_BYTES, stream);
    if (e != hipSuccess) fprintf(stderr, "cooperative launch failed: %s (grid %d)\n", hipGetErrorString(e), grid);
#else
    launch_all(std::make_integer_sequence<int, PH_COUNT>{}, grid, stream, a);
#endif
}
#ifdef TEST_RANGES
template __global__ void mega<0, 2>(Args);
template __global__ void mega<1, 3>(Args);
template __global__ void mega<1, 4>(Args);
template __global__ void mega<3, 8>(Args);
template __global__ void mega<7, 13>(Args);
template __global__ void mega<10, 12>(Args);
template __global__ void mega<13, 17>(Args);
template __global__ void mega<0, 13>(Args);
#endif
```
